# Optimizing an MI355X kernel written in HIP

```python
import math
import jax
import jax.numpy as jnp
from jax import lax
import numpy as np

D_MODEL = 2048
BATCH = 8
SEQ = 4096
DEPTH = 2

CTX_LEN = 256
GRID_W = 64
EPS = 1e-6
N_MOD = 6

DN_HEADS = 4
DN_DK = 128
DN_DV = 128
DN_CONV = 5
DN_CHUNK = 64
DN_CONV_CH = 2 * DN_HEADS * DN_DK + DN_HEADS * DN_DV
GLA_HEADS = 4
GLA_DK = 64
GLA_DV = 128
GLA_RANK = 16
GLA_TAU = 16.0
GLA_CHUNK = 64
MLA_HEADS = 4
MLA_NOPE = 128
MLA_ROPE = 64
MLA_V = 128
MLA_Q_RANK = 448
MLA_KV_RANK = 128
MLA_Q_BLOCK = 128
ROPE_BASE = 10000.0
FN_GROUPS = 4
FN_CH = 128
MIX_W = DN_HEADS * DN_DV + GLA_HEADS * GLA_DV + MLA_HEADS * MLA_V + FN_GROUPS * FN_CH
PEER_HEADS = 8
PEER_N_KEYS = 128
PEER_EXPERTS = PEER_N_KEYS * PEER_N_KEYS
PEER_KEY_DIM = 256
PEER_HALF = PEER_KEY_DIM // 2
PEER_TOPK = 16
PEER_BLOCK = 128

IN_LAYOUT = (
    ("dn_qkv", DN_CONV_CH),
    ("dn_gate", DN_HEADS * DN_DV),
    ("dn_a", 2 * DN_HEADS),
    ("dn_b", 2 * DN_HEADS),
    ("gla_q", GLA_HEADS * GLA_DK),
    ("gla_k", GLA_HEADS * GLA_DK),
    ("gla_v", GLA_HEADS * GLA_DV),
    ("gla_gate", GLA_HEADS * GLA_DV),
    ("gla_alpha", 2 * GLA_RANK),
    ("mla_cq", MLA_Q_RANK),
    ("mla_ckv", MLA_KV_RANK),
    ("mla_kr", MLA_ROPE),
    ("fn", FN_GROUPS * FN_CH),
)
IN_WIDTH = sum(w for _, w in IN_LAYOUT)

kernel_name = "hybrid_parallel_heads_peer_dit_block"

F32 = jnp.float32


def rms_norm(x, w=None):
    xf = x.astype(F32)
    y = xf * lax.rsqrt(jnp.mean(xf * xf, axis=-1, keepdims=True) + EPS)
    if w is not None:
        y = y * w.astype(F32)
    return y.astype(x.dtype)


def modulate(x, shift, scale):
    return rms_norm(x) * (1 + scale) + shift


def l2_normalize(x):
    xf = x.astype(F32)
    return xf * lax.rsqrt(jnp.sum(xf * xf, axis=-1, keepdims=True) + EPS)


def split_projection(z):
    names = [n for n, _ in IN_LAYOUT]
    bounds = np.cumsum([w for _, w in IN_LAYOUT])[:-1].tolist()
    return dict(zip(names, jnp.split(z, bounds, axis=-1)))


def to_chunks(t, size):
    b, l = t.shape[:2]
    t = t.reshape(b, l // size, size, *t.shape[2:])
    return jnp.moveaxis(t, (1, 3), (0, 2))


def from_chunks(t):
    t = jnp.moveaxis(t, (0, 2), (1, 3))
    b, n, c = t.shape[:3]
    return t.reshape(b, n * c, *t.shape[3:])


def centred_conv(u, w):
    ch = u.shape[-1]
    return lax.conv_general_dilated(
        u, w[:, None, :].astype(u.dtype), window_strides=(1,),
        padding=[(DN_CONV // 2, DN_CONV // 2)],
        dimension_numbers=("NWC", "WIO", "NWC"), feature_group_count=ch)


def gated_rms(o, gate, w):
    b, l, h, dv = o.shape
    y = rms_norm(o, w) * jax.nn.silu(gate.reshape(b, l, h, dv).astype(F32))
    return y.reshape(b, l, h * dv).astype(gate.dtype)


def deltanet_inputs(p, conv_w, a_log, dt_bias):
    b, l, _ = p["dn_qkv"].shape
    qkv = jax.nn.silu(centred_conv(p["dn_qkv"], conv_w))
    q, k, v = jnp.split(qkv, [DN_HEADS * DN_DK, 2 * DN_HEADS * DN_DK], axis=-1)
    q = l2_normalize(q.reshape(b, l, DN_HEADS, DN_DK)) * DN_DK ** -0.5
    k = l2_normalize(k.reshape(b, l, DN_HEADS, DN_DK))
    v = v.reshape(b, l, DN_HEADS, DN_DV).astype(F32)
    a = p["dn_a"].astype(F32).reshape(b, l, 2, DN_HEADS)
    bb = p["dn_b"].astype(F32).reshape(b, l, 2, DN_HEADS)
    g = -jnp.exp(a_log.astype(F32)) * jax.nn.softplus(a + dt_bias.astype(F32))
    beta = jax.nn.sigmoid(bb)
    return ((q, k, v, g[:, :, 0], beta[:, :, 0]), (q, k, v, g[:, :, 1], beta[:, :, 1]))


def delta_chunked(q, k, v, g, beta, s0):
    c = DN_CHUNK
    qc, kc, vc = to_chunks(q, c), to_chunks(k, c), to_chunks(v, c)
    gc = jnp.cumsum(to_chunks(g, c), axis=-1)
    bc = to_chunks(beta, c)
    lower = jnp.tril(jnp.ones((c, c), dtype=bool))
    strict = jnp.tril(jnp.ones((c, c), dtype=bool), -1)
    diff = gc[..., :, None] - gc[..., None, :]
    decay = jnp.where(lower, jnp.exp(jnp.where(lower, diff, 0.0)), 0.0)
    a_mat = jnp.where(strict, bc[..., :, None] * jnp.einsum("nbhcd,nbhed->nbhce", kc, kc) * decay, 0.0)
    t_mat = a_mat + jnp.eye(c, dtype=a_mat.dtype)
    rhs = jnp.concatenate([vc * bc[..., None], kc * (bc * jnp.exp(gc))[..., None]], axis=-1)
    uw = lax.linalg.triangular_solve(t_mat, rhs, left_side=True, lower=True, unit_diagonal=True)
    u, w = jnp.split(uw, [vc.shape[-1]], axis=-1)
    p_mat = jnp.einsum("nbhcd,nbhed->nbhce", qc, kc) * decay
    q_dec = qc * jnp.exp(gc)[..., None]
    g_last = gc[..., -1]
    k_dec = kc * jnp.exp(g_last[..., None] - gc)[..., None]

    def step(s, xs):
        u_i, w_i, p_i, qd_i, kd_i, gl_i = xs
        v_new = u_i - jnp.einsum("bhcd,bhdf->bhcf", w_i, s)
        o_i = jnp.einsum("bhcd,bhdf->bhcf", qd_i, s) + jnp.einsum("bhce,bhef->bhcf", p_i, v_new)
        s = jnp.exp(gl_i)[..., None, None] * s + jnp.einsum("bhcd,bhcf->bhdf", kd_i, v_new)
        return s, o_i

    s_fin, o = lax.scan(step, s0, (u, w, p_mat, q_dec, k_dec, g_last))
    return from_chunks(o), s_fin


def gla_inputs(p, w2, b2):
    b, l, _ = p["gla_q"].shape
    q = p["gla_q"].astype(F32).reshape(b, l, GLA_HEADS, GLA_DK) * GLA_DK ** -0.5
    k = p["gla_k"].astype(F32).reshape(b, l, GLA_HEADS, GLA_DK)
    v = p["gla_v"].astype(F32).reshape(b, l, GLA_HEADS, GLA_DV)
    r = p["gla_alpha"].astype(F32).reshape(b, l, 2, GLA_RANK)
    z = jnp.einsum("blpr,prk->blpk", r, w2.astype(F32)) + b2.astype(F32)
    log_a = (jax.nn.log_sigmoid(z) / GLA_TAU).reshape(b, l, 2, GLA_HEADS, GLA_DK)
    return ((q, k, v, log_a[:, :, 0]), (q, k, v, log_a[:, :, 1]))


def gla_chunked(q, k, v, log_a, s0):
    c = GLA_CHUNK
    qc, kc, vc, ac = (to_chunks(t, c) for t in (q, k, v, log_a))
    bcum = jnp.cumsum(ac, axis=-2)
    b_last = bcum[..., -1:, :]
    q_in = qc * jnp.exp(bcum)
    q_rel = qc * jnp.exp(bcum - b_last)
    k_rel = kc * jnp.exp(b_last - bcum)
    lower = jnp.tril(jnp.ones((c, c), dtype=bool))
    att = jnp.where(lower, jnp.einsum("nbhcd,nbhed->nbhce", q_rel, k_rel), 0.0)
    o_intra = jnp.einsum("nbhce,nbhef->nbhcf", att, vc)

    def step(s, xs):
        qi, ki, vi, bl = xs
        o_i = jnp.einsum("bhcd,bhdf->bhcf", qi, s)
        s = jnp.exp(bl)[..., 0, :, None] * s + jnp.einsum("bhcd,bhcf->bhdf", ki, vi)
        return s, o_i

    s_fin, o_inter = lax.scan(step, s0, (q_in, k_rel, vc, b_last))
    return from_chunks(o_intra + o_inter), s_fin


def bidirectional(scan_fn, lat_dirs, ctx_dirs, s_zero):
    outs_l, outs_c = [], []
    for reverse, lat_args, ctx_args in zip((False, True), lat_dirs, ctx_dirs):
        flip = (lambda t: jnp.flip(t, axis=1)) if reverse else (lambda t: t)
        o_c, s_c = scan_fn(*[flip(a) for a in ctx_args], s_zero)
        o_l, _ = scan_fn(*[flip(a) for a in lat_args], s_c)
        outs_c.append(flip(o_c))
        outs_l.append(flip(o_l))
    return outs_l[0] + outs_l[1], outs_c[0] + outs_c[1]


def axial_rope_tables(rows):
    row = jnp.repeat(jnp.arange(rows), GRID_W).astype(F32)
    col = jnp.tile(jnp.arange(GRID_W), rows).astype(F32)
    half = MLA_ROPE // 2
    inv_freq = ROPE_BASE ** (-jnp.arange(0, half, 2, dtype=F32) / half)
    ang_r = row[:, None] * inv_freq
    ang_c = col[:, None] * inv_freq
    return (jnp.cos(ang_r)[:, None, :], jnp.sin(ang_r)[:, None, :],
            jnp.cos(ang_c)[:, None, :], jnp.sin(ang_c)[:, None, :])


def rotate_half(x, cos, sin):
    x1, x2 = jnp.split(x, 2, axis=-1)
    return jnp.concatenate([x1 * cos - x2 * sin, x2 * cos + x1 * sin], axis=-1)


def axial_rope(x, tabs):
    cr, sr, cc, sc = tabs
    xf = x.astype(F32)
    x_row, x_col = jnp.split(xf, 2, axis=-1)
    return jnp.concatenate([rotate_half(x_row, cr, sr), rotate_half(x_col, cc, sc)], axis=-1).astype(x.dtype)


def mla_inputs(p, q_norm, w_uq, kv_norm, w_ukv, rope):
    b, l, _ = p["mla_cq"].shape
    q = (rms_norm(p["mla_cq"], q_norm) @ w_uq).reshape(b, l, MLA_HEADS, MLA_NOPE + MLA_ROPE)
    kv = (rms_norm(p["mla_ckv"], kv_norm) @ w_ukv).reshape(b, l, MLA_HEADS, MLA_NOPE + MLA_V)
    q_nope, q_rope = jnp.split(q, [MLA_NOPE], axis=-1)
    k_nope, v = jnp.split(kv, [MLA_NOPE], axis=-1)
    k_rope = p["mla_kr"][:, :, None, :]
    if rope is not None:
        q_rope = axial_rope(q_rope, rope)
        k_rope = axial_rope(k_rope, rope)
    k = jnp.concatenate([k_nope, jnp.broadcast_to(k_rope, (b, l, MLA_HEADS, MLA_ROPE))], axis=-1)
    return jnp.concatenate([q_nope, q_rope], axis=-1), k, v


def softmax_attend(q, k, v):
    s = jnp.einsum("bqhd,bkhd->bhqk", q, k).astype(F32) * (q.shape[-1] ** -0.5)
    p = jax.nn.softmax(s, axis=-1).astype(v.dtype)
    return jnp.einsum("bhqk,bkhd->bqhd", p, v)


def mla_latent_attend(q, k_all, v_all):
    b, l, h, dq = q.shape
    nb = l // MLA_Q_BLOCK
    qb = jnp.moveaxis(q.reshape(b, nb, MLA_Q_BLOCK, h, dq), 1, 0)
    o = lax.map(lambda qi: softmax_attend(qi, k_all, v_all), qb)
    return jnp.moveaxis(o, 0, 1).reshape(b, l, h * v_all.shape[-1])


def fourier_mix(z):
    b, l, _ = z.shape
    zg = z.astype(F32).reshape(b, l, FN_GROUPS, FN_CH)
    y = jnp.fft.fftn(zg, axes=(1, 3), norm="ortho").real
    return y.reshape(b, l, FN_GROUPS * FN_CH).astype(z.dtype)


def peer_ffn(h, wq, keys, u_tab, v_tab):
    b, l, d = h.shape
    q = (h @ wq).reshape(b, l, PEER_HEADS, 2, PEER_HALF)
    s = jnp.einsum("blhpk,hpnk->blhpn", q, keys).astype(F32)
    s1, i1 = lax.top_k(s[..., 0, :], PEER_TOPK)
    s2, i2 = lax.top_k(s[..., 1, :], PEER_TOPK)
    cand = (s1[..., :, None] + s2[..., None, :]).reshape(b, l, PEER_HEADS, PEER_TOPK * PEER_TOPK)
    cidx = (i1[..., :, None] * PEER_N_KEYS + i2[..., None, :]).reshape(b, l, PEER_HEADS, PEER_TOPK * PEER_TOPK)
    top, pos = lax.top_k(cand, PEER_TOPK)
    idx = jnp.take_along_axis(cidx, pos, axis=-1)
    gate = jax.nn.softmax(top, axis=-1).astype(h.dtype)
    nblk = (b * l) // PEER_BLOCK
    hb = h.reshape(nblk, PEER_BLOCK, d)
    ib = idx.reshape(nblk, PEER_BLOCK, PEER_HEADS * PEER_TOPK)
    gb = gate.reshape(nblk, PEER_BLOCK, PEER_HEADS * PEER_TOPK)

    def block(args):
        hh, ii, gg = args
        act = jnp.einsum("td,tkd->tk", hh, u_tab[ii])
        wgt = gg * jax.nn.gelu(act, approximate=False)
        return jnp.einsum("tk,tkd->td", wgt, v_tab[ii])

    return lax.map(block, (hb, ib, gb)).reshape(b, l, d)


def token_mixers(pl, pc, rope, dn_conv, dn_a_log, dn_dt_bias, dn_norm, gla_w2, gla_b2, gla_norm,
                 mla_q_norm, mla_w_uq, mla_kv_norm, mla_w_ukv, ctx_out):
    b = pl["fn"].shape[0]
    s0_dn = jnp.zeros((b, DN_HEADS, DN_DK, DN_DV), F32)
    oa_l, oa_c = bidirectional(delta_chunked,
                               deltanet_inputs(pl, dn_conv, dn_a_log, dn_dt_bias),
                               deltanet_inputs(pc, dn_conv, dn_a_log, dn_dt_bias), s0_dn)
    s0_gla = jnp.zeros((b, GLA_HEADS, GLA_DK, GLA_DV), F32)
    ob_l, ob_c = bidirectional(gla_chunked, gla_inputs(pl, gla_w2, gla_b2),
                               gla_inputs(pc, gla_w2, gla_b2), s0_gla)
    q_l, k_l, v_l = mla_inputs(pl, mla_q_norm, mla_w_uq, mla_kv_norm, mla_w_ukv, rope)
    q_c, k_c, v_c = mla_inputs(pc, mla_q_norm, mla_w_uq, mla_kv_norm, mla_w_ukv, None)
    yc_l = mla_latent_attend(q_l, jnp.concatenate([k_l, k_c], axis=1), jnp.concatenate([v_l, v_c], axis=1))
    y_l = jnp.concatenate([gated_rms(oa_l, pl["dn_gate"], dn_norm),
                           gated_rms(ob_l, pl["gla_gate"], gla_norm),
                           yc_l, fourier_mix(pl["fn"])], axis=-1)
    if not ctx_out:
        return y_l, None
    bc, lc = q_c.shape[:2]
    y_c = jnp.concatenate([gated_rms(oa_c, pc["dn_gate"], dn_norm),
                           gated_rms(ob_c, pc["gla_gate"], gla_norm),
                           softmax_attend(q_c, k_c, v_c).reshape(bc, lc, MLA_HEADS * MLA_V),
                           fourier_mix(pc["fn"])], axis=-1)
    return y_l, y_c


def hybrid_layer(x, xc, mod, mod_c, rope, w_in, dn_conv, dn_a_log, dn_dt_bias, dn_norm,
                 gla_w2, gla_b2, gla_norm, mla_q_norm, mla_w_uq, mla_kv_norm, mla_w_ukv,
                 w_out, peer_wq, peer_keys, peer_u, peer_v, ctx_out):
    sh1, sc1, g1, sh2, sc2, g2 = jnp.split(mod[:, None, :], N_MOD, axis=-1)
    csh1, csc1, cg1, csh2, csc2, cg2 = jnp.split(mod_c, N_MOD, axis=-1)
    pl = split_projection(modulate(x, sh1, sc1) @ w_in)
    pc = split_projection(modulate(xc, csh1, csc1) @ w_in)
    y_l, y_c = token_mixers(pl, pc, rope, dn_conv, dn_a_log, dn_dt_bias, dn_norm, gla_w2, gla_b2,
                            gla_norm, mla_q_norm, mla_w_uq, mla_kv_norm, mla_w_ukv, ctx_out)
    x = x + g1 * (y_l @ w_out)
    x = x + g2 * peer_ffn(modulate(x, sh2, sc2), peer_wq, peer_keys, peer_u, peer_v)
    if ctx_out:
        xc = xc + cg1 * (y_c @ w_out)
        xc = xc + cg2 * peer_ffn(modulate(xc, csh2, csc2), peer_wq, peer_keys, peer_u, peer_v)
    return x, xc


def setup_inputs(seed: int = 0) -> dict:
    key = jax.random.key(seed)
    ks = jax.random.split(key, 26)
    d = D_MODEL

    def nrm(k, shape, scale):
        return jax.random.normal(k, shape, F32) * scale

    dt_init = jnp.exp(jax.random.uniform(ks[9], (DEPTH, 2, DN_HEADS), F32, math.log(1e-3), math.log(1e-1)))
    return {
        "x": nrm(ks[0], (BATCH, SEQ, d), 1.0),
        "c": nrm(ks[1], (BATCH, d), 1.0),
        "ctx": nrm(ks[2], (BATCH, CTX_LEN, d), 1.0),
        "c_ctx": nrm(ks[3], (d,), 1.0),
        "w_ada": nrm(ks[4], (DEPTH, d, N_MOD * d), 0.5 * d ** -0.5),
        "b_ada": nrm(ks[5], (DEPTH, N_MOD * d), 0.02),
        "w_in": nrm(ks[6], (DEPTH, d, IN_WIDTH), d ** -0.5),
        "dn_conv": nrm(ks[7], (DEPTH, DN_CONV, DN_CONV_CH), DN_CONV ** -0.5),
        "dn_a_log": jnp.log(jax.random.uniform(ks[8], (DEPTH, 2, DN_HEADS), F32, 1.0, 16.0)),
        "dn_dt_bias": dt_init + jnp.log(-jnp.expm1(-dt_init)),
        "dn_norm": 1.0 + nrm(ks[10], (DEPTH, DN_DV), 0.02),
        "gla_w2": nrm(ks[11], (DEPTH, 2, GLA_RANK, GLA_HEADS * GLA_DK), GLA_RANK ** -0.5),
        "gla_b2": nrm(ks[12], (DEPTH, 2, GLA_HEADS * GLA_DK), 0.02),
        "gla_norm": 1.0 + nrm(ks[13], (DEPTH, GLA_DV), 0.02),
        "mla_q_norm": 1.0 + nrm(ks[14], (DEPTH, MLA_Q_RANK), 0.02),
        "mla_w_uq": nrm(ks[15], (DEPTH, MLA_Q_RANK, MLA_HEADS * (MLA_NOPE + MLA_ROPE)), MLA_Q_RANK ** -0.5),
        "mla_kv_norm": 1.0 + nrm(ks[16], (DEPTH, MLA_KV_RANK), 0.02),
        "mla_w_ukv": nrm(ks[17], (DEPTH, MLA_KV_RANK, MLA_HEADS * (MLA_NOPE + MLA_V)), MLA_KV_RANK ** -0.5),
        "w_out": nrm(ks[18], (DEPTH, MIX_W, d), MIX_W ** -0.5),
        "peer_wq": nrm(ks[19], (DEPTH, d, PEER_HEADS * PEER_KEY_DIM), d ** -0.5),
        "peer_keys": nrm(ks[20], (DEPTH, PEER_HEADS, 2, PEER_N_KEYS, PEER_HALF), PEER_HALF ** -0.5),
        "peer_u": nrm(ks[21], (DEPTH, PEER_EXPERTS, d), d ** -0.5),
        "peer_v": nrm(ks[22], (DEPTH, PEER_EXPERTS, d), 1.0),
        "final_norm": 1.0 + nrm(ks[23], (d,), 0.02),
    }


def reference(x, c, ctx, c_ctx, w_ada, b_ada, w_in, dn_conv, dn_a_log, dn_dt_bias, dn_norm,
              gla_w2, gla_b2, gla_norm, mla_q_norm, mla_w_uq, mla_kv_norm, mla_w_ukv,
              w_out, peer_wq, peer_keys, peer_u, peer_v, final_norm):
    rows = x.shape[1] // GRID_W
    rope = axial_rope_tables(rows)
    xc = ctx
    for l in range(DEPTH):
        mod = jax.nn.silu(c) @ w_ada[l] + b_ada[l]
        mod_c = jax.nn.silu(c_ctx) @ w_ada[l] + b_ada[l]
        x, xc = hybrid_layer(x, xc, mod, mod_c, rope, w_in[l], dn_conv[l], dn_a_log[l], dn_dt_bias[l],
                             dn_norm[l], gla_w2[l], gla_b2[l], gla_norm[l], mla_q_norm[l], mla_w_uq[l],
                             mla_kv_norm[l], mla_w_ukv[l], w_out[l], peer_wq[l], peer_keys[l],
                             peer_u[l], peer_v[l], ctx_out=(l < DEPTH - 1))
    return rms_norm(x, final_norm)
```

```cpp
#include <hip/hip_runtime.h>
#include <stdint.h>

constexpr int DM = 2048, NB = 8, LL = 4096, LCX = 256, LT = LL + LCX  , MR = NB * LT  ;
constexpr int NZ = 4864;
constexpr int C_DNQ = 0, C_DNK = 512, C_DNV = 1024, C_DNGATE = 1536, C_DNA = 2048, C_DNB = 2056, C_GQ = 2064, C_GK = 2320, C_GV = 2576,
              C_GGATE = 3088, C_GALPHA = 3600, C_CQ = 3632, C_CKV = 4080, C_KR = 4208, C_FN = 4272, IN_W = 4784;
constexpr int NMOD = 6 * DM;
constexpr float EPSV = 1e-6f;
constexpr int NTHR = 512;

typedef unsigned short bf16_t;
typedef short bf16x8 __attribute__((ext_vector_type(8)));
typedef short s16x4 __attribute__((ext_vector_type(4)));
typedef float f32x4 __attribute__((ext_vector_type(4)));
typedef float f32x16 __attribute__((ext_vector_type(16)));
typedef unsigned u32x4 __attribute__((ext_vector_type(4)));
typedef unsigned u32x2 __attribute__((ext_vector_type(2)));

#define DI __device__ __forceinline__
DI float bf2f(bf16_t b) { return __uint_as_float(((unsigned)b) << 16); }
DI bf16_t f2bf(float f) { unsigned u = __float_as_uint(f); u += 0x7FFFu + ((u >> 16) & 1u); return (bf16_t)(u >> 16); }
DI unsigned pack2(float lo, float hi) { return (unsigned)f2bf(lo) | ((unsigned)f2bf(hi) << 16); }
DI float wsum(float v) { for (int o = 32; o >= 1; o >>= 1) v += __shfl_xor(v, o); return v; }
DI float wmax(float v) { for (int o = 32; o >= 1; o >>= 1) v = fmaxf(v, __shfl_xor(v, o)); return v; }
DI float siluf(float x) { return x / (1.f + __expf(-x)); }
DI float sigmf(float x) { return 1.f / (1.f + __expf(-x)); }

DI int ltid() { int t = (int)threadIdx.x; asm volatile("" : "+v"(t)); return t; }
DI int lsg(int v) { asm volatile("" : "+s"(v)); return v; }

struct Prm {
  const float *x, *c, *ctx, *c_ctx, *w_ada, *b_ada, *w_in, *dn_conv, *dn_a_log, *dn_dt_bias, *dn_norm, *gla_w2, *gla_b2, *gla_norm,
      *mla_q_norm, *mla_w_uq, *mla_kv_norm, *mla_w_ukv, *w_out, *peer_wq, *peer_keys, *peer_u, *peer_v, *final_norm;
  float* out;
  bf16_t *WinT, *WoutT, *WqT, *WuqT, *WukvT;
  float *mod, *GB, *CCS;
  bf16_t *DFTM, *DFTC;
  float* X;
  bf16_t* Z;
  bf16_t *H, *DNQ, *OB;
  bf16_t *KV, *KR;
  bf16_t *Y, *PQT, *PQTc, *Qraw, *Aq, *Akv;
  bf16_t *H2, *Qp;
  int* IDX;
  float* GATE;
  unsigned* bar;
};
#define XB_TMO      128
#define XB_XCNT(j)  (256  + 64 * (j))
#define XB_XSUB(j)  (1280 + 64 * (j))
#define XB_XGEN(j)  (2304 + 64 * (j))
#define XB_TOP      3328
#define XB_TOPGEN   3392
#define XCD_BAR_WORDS 3456
#define XB_SPIN_CAP (1u << 18)
#define LAS __attribute__((address_space(3)))

__device__ __forceinline__ unsigned xb_ld(unsigned* p)              { return __hip_atomic_load(p, __ATOMIC_RELAXED, __HIP_MEMORY_SCOPE_AGENT); }
__device__ __forceinline__ unsigned xb_add(unsigned* p, unsigned v) { return __hip_atomic_fetch_add(p, v, __ATOMIC_RELAXED, __HIP_MEMORY_SCOPE_AGENT); }
__device__ __forceinline__ unsigned xb_xcc_id() { return (unsigned)__builtin_amdgcn_s_getreg((3 << 11) | 20) & 0xFu; }
#define XB_SPIN(cond, bar) do { unsigned _sp = 0; while (cond) { __builtin_amdgcn_s_sleep(1); \
    if ((++_sp & 255u) == 0u) { if (xb_ld(&(bar)[XB_TMO])) break; if (_sp > XB_SPIN_CAP) { atomicAdd(&(bar)[XB_TMO], 1u); break; } } } } while (0)

struct XcdBarrier {
    unsigned* bar; unsigned x;
    volatile LAS unsigned* st;
};

__device__ __forceinline__ XcdBarrier xcd_barrier_post(unsigned* bar, volatile LAS unsigned* st) {
    XcdBarrier b; b.bar = bar; b.x = xb_xcc_id(); b.st = st;
    if (threadIdx.x == 0) (void)xb_add(&bar[XB_XCNT(b.x)], 1u);
    return b;
}
__device__ __forceinline__ void xcd_barrier_complete(unsigned* bar, unsigned x, unsigned& nloc, unsigned& nx) {
    const unsigned G = gridDim.x * gridDim.y * gridDim.z;
    unsigned sum, cnt, mine, sp = 0u;
    for (;;) {
        sum = 0u; cnt = 0u; mine = 0u;
#pragma unroll
        for (unsigned j = 0; j < 16; ++j) { const unsigned c = xb_ld(&bar[XB_XCNT(j)]); sum += c; cnt += (c > 0u) ? 1u : 0u; mine = (j == x) ? c : mine; }
        if (sum == G) break;
        __builtin_amdgcn_s_sleep(1);
        if ((++sp & 255u) == 0u) { if (xb_ld(&bar[XB_TMO])) break; if (sp > XB_SPIN_CAP) { atomicAdd(&bar[XB_TMO], 1u); break; } }
    }
    nloc = mine > 0u ? mine : 1u; nx = cnt > 0u ? cnt : 1u;
}

__device__ __forceinline__ void xcd_barrier(const XcdBarrier& b) {
    asm volatile("s_waitcnt vmcnt(0)" ::: "memory");
    __syncthreads();
    if (threadIdx.x == 0) {
        unsigned* bar = b.bar;
        __builtin_amdgcn_s_waitcnt(0);
        unsigned nloc = b.st[0], nx = b.st[1];
        if (nloc == 0u) { xcd_barrier_complete(bar, b.x, nloc, nx); b.st[0] = nloc; b.st[1] = nx; }
        const unsigned old = xb_add(&bar[XB_XSUB(b.x)], 1u);
        const unsigned gen = old / nloc;
        if (old + 1u == (gen + 1u) * nloc) {
            __builtin_amdgcn_fence(__ATOMIC_RELEASE, "agent");
            asm volatile("s_waitcnt vmcnt(0)" ::: "memory");
            const unsigned og = xb_add(&bar[XB_TOP], 1u);
            const unsigned tg = og / nx;
            if (og + 1u == (tg + 1u) * nx) xb_add(&bar[XB_TOPGEN], 1u);
            else XB_SPIN(xb_ld(&bar[XB_TOPGEN]) == tg, bar);
            __builtin_amdgcn_fence(__ATOMIC_ACQUIRE, "agent");
            xb_add(&bar[XB_XGEN(b.x)], 1u);
            asm volatile("s_waitcnt vmcnt(0)" ::: "memory");
        } else {
            XB_SPIN(xb_ld(&bar[XB_XGEN(b.x)]) == gen, bar);
            __builtin_amdgcn_fence(__ATOMIC_ACQUIRE, "agent");
            asm volatile("s_waitcnt vmcnt(0)" ::: "memory");
        }
    }
    __syncthreads();
}

namespace pg8 {
#define PG8_LAS __attribute__((address_space(3)))
typedef unsigned short bf16_t;
typedef short bf16x8 __attribute__((ext_vector_type(8)));
typedef float f32x4 __attribute__((ext_vector_type(4)));
typedef unsigned u32x4 __attribute__((ext_vector_type(4)));
constexpr int BM = 256, BK = 64, HALF = 128, HTB = HALF * BK * 2  , STAGE_BYTES = 8 * HTB, NXCD = 8, WGM = 8;

__host__ __device__ __forceinline__ int lds_byte(int r, int c) { const int st = (r >> 4) * 2 + (c >> 5), rr = r & 15, cc = c & 31, ob = rr * 64 + cc * 2; return st * 1024 + (ob ^ (((ob >> 9) & 1) << 5)); }
__host__ __device__ __forceinline__ void stage_rc(int b, int& R, int& C) { const int st = b / 1024, sb = b % 1024, swz = sb ^ (((sb >> 9) & 1) << 5); R = (st >> 1) * 16 + swz / 64; C = (st & 1) * 32 + (swz % 64) / 2; }
__host__ __device__ __forceinline__ int perm32(int rho) { const int n = rho >> 4, i = rho & 15; return 8 * (i >> 2) + 4 * n + (i & 3); }

struct Unit { int pm, pn; };
struct Gemm { const bf16_t* A; const bf16_t* Bt; int M, N, K; };

struct StaticOrder {
    int nM, nN, nwg, G, c;
    __host__ __device__ void init(int M, int N, int G_, int c_) { nM = M / BM; nN = N / BM; nwg = nM * nN; G = G_; c = c_; }
    __host__ __device__ bool next(int i, Unit& u) const {
        const long L = (long)i * G + c; if (L >= nwg) return false;
        int wgid = (int)L; { const int q = nwg / NXCD, r = nwg % NXCD, xcd = wgid % NXCD, off = wgid / NXCD; wgid = (xcd < r ? xcd * (q + 1) : r * (q + 1) + (xcd - r) * q) + off; }
        const int nig = WGM * nN, gid = wgid / nig, fm = gid * WGM, gsz = (nM - fm) < WGM ? (nM - fm) : WGM;
        u.pm = fm + ((wgid % nig) % gsz); u.pn = (wgid % nig) / gsz; return true;
    }
    __device__ __forceinline__ void a_ready(const Unit&) const {}
    __device__ __forceinline__ void done(const Unit&) const {}
};
struct CountedOrder : StaticOrder {
    const unsigned* ready; unsigned need; unsigned* tmo;
    __device__ __forceinline__ void a_ready(const Unit& u) const {
        if (threadIdx.x < 64) {
            const unsigned long long t0 = __builtin_amdgcn_s_memrealtime(); unsigned polls = 0;
            while ((unsigned)__builtin_amdgcn_readfirstlane(__hip_atomic_load(ready + 64 * u.pm, __ATOMIC_RELAXED, __HIP_MEMORY_SCOPE_AGENT)) < need) {
                if ((++polls & 255u) == 0u && __builtin_amdgcn_readfirstlane(__hip_atomic_load(tmo, __ATOMIC_RELAXED, __HIP_MEMORY_SCOPE_AGENT)) != 0u) break;
                if (__builtin_amdgcn_s_memrealtime() - t0 > 2000000ull) {
                    if (threadIdx.x == 0) { unsigned expect = 0u; __hip_atomic_compare_exchange_strong(tmo + 1, &expect, 0x600u | (unsigned)(u.pm & 0xff), __ATOMIC_RELAXED, __ATOMIC_RELAXED, __HIP_MEMORY_SCOPE_AGENT); __hip_atomic_store(tmo, 1u, __ATOMIC_RELAXED, __HIP_MEMORY_SCOPE_AGENT); }
                    break; }
                __builtin_amdgcn_s_sleep(2); }
            __builtin_amdgcn_fence(__ATOMIC_ACQUIRE, "agent");
            asm volatile("s_waitcnt vmcnt(0)" ::: "memory");
        }
#if !defined(BROKEN_HOOK_NO_BARRIER)
        asm volatile("" ::: "memory"); __builtin_amdgcn_s_barrier(); asm volatile("" ::: "memory");
#endif
    }
};

__device__ __forceinline__ unsigned cvt_pk_bf16(float lo, float hi) { unsigned r; asm volatile("v_cvt_pk_bf16_f32 %0, %1, %2" : "=v"(r) : "v"(lo), "v"(hi)); return r; }
typedef float f32x2 __attribute__((ext_vector_type(2)));
__device__ __forceinline__ f32x2 gelu_pk(f32x2 v) {
    const f32x2 av = __builtin_elementwise_abs(v), d = av * 0.2316418882f + 1.0f;
    f32x2 t; t.x = __builtin_amdgcn_rcpf(d.x); t.y = __builtin_amdgcn_rcpf(d.y);
    f32x2 q = t * 0.5307027145f + (-0.7265760135f); q = q * t + 0.7107068705f; q = q * t + (-0.142248368f); q = q * t + 0.127414796f; q = q * t;
    const f32x2 s = (v * v) * (-0.72134752044f);
    f32x2 e; e.x = __builtin_amdgcn_exp2f(s.x); e.y = __builtin_amdgcn_exp2f(s.y);
    const f32x2 m = v * (q * e), r = v - m;
    f32x2 o; o.x = v.x < 0.f ? m.x : r.x; o.y = v.y < 0.f ? m.y : r.y; return o;
}

struct EpiF32 {
    static constexpr bool PERM = false, AFTER_DRAIN = false;
    float* C; int ldc; const float* bias;
    __device__ __forceinline__ void operator()(const f32x4 (&acc)[2][2][4][2], const Unit& u, int wr, int wc, int fr, int fq) const {
        const int row0 = u.pm * BM + wr * 64 + fr, col0 = u.pn * BM + wc * 32 + 4 * fq;
        f32x4 bv[2][2];
#pragma unroll
        for (int bj = 0; bj < 2; ++bj)
#pragma unroll
            for (int n = 0; n < 2; ++n) bv[bj][n] = bias ? *(const f32x4*)(bias + col0 + bj * HALF + n * 16) : (f32x4){0.f, 0.f, 0.f, 0.f};
#pragma unroll
        for (int ai = 0; ai < 2; ++ai)
#pragma unroll
            for (int m = 0; m < 4; ++m) { float* rowp = C + (size_t)(row0 + ai * HALF + m * 16) * ldc + col0;
#pragma unroll
                for (int bj = 0; bj < 2; ++bj)
#pragma unroll
                    for (int n = 0; n < 2; ++n) *(f32x4*)(rowp + bj * HALF + n * 16) = acc[ai][bj][m][n] + bv[bj][n]; }
    }
};
template <int ACT  > struct EpiBf16 {
    static constexpr bool PERM = true, AFTER_DRAIN = false;
    bf16_t* O; int ldc; const float* bias; int split_cols; size_t split_stride;
    __device__ __forceinline__ void operator()(const f32x4 (&acc)[2][2][4][2], const Unit& u, int wr, int wc, int fr, int fq) const {
        const int row0 = u.pm * BM + wr * 64 + fr; int colt = u.pn * BM; bf16_t* base = O;
        if (split_cols) { const int t = colt / split_cols; base += (size_t)t * split_stride; colt -= t * split_cols; }
        const int col0 = colt + wc * 32 + 8 * fq, bcol0 = u.pn * BM + wc * 32 + 8 * fq;
        f32x4 bv[2][2];
#pragma unroll
        for (int bj = 0; bj < 2; ++bj)
#pragma unroll
            for (int n = 0; n < 2; ++n) bv[bj][n] = bias ? *(const f32x4*)(bias + bcol0 + bj * HALF + 4 * n) : (f32x4){0.f, 0.f, 0.f, 0.f};
#pragma unroll
        for (int ai = 0; ai < 2; ++ai)
#pragma unroll
            for (int m = 0; m < 4; ++m) { bf16_t* rowp = base + (size_t)(row0 + ai * HALF + m * 16) * ldc + col0;
#pragma unroll
                for (int bj = 0; bj < 2; ++bj) { f32x4 v0 = acc[ai][bj][m][0] + bv[bj][0], v1 = acc[ai][bj][m][1] + bv[bj][1];
                    if (ACT == 1) { f32x2 a = gelu_pk((f32x2){v0[0], v0[1]}), b = gelu_pk((f32x2){v0[2], v0[3]}), c = gelu_pk((f32x2){v1[0], v1[1]}), d = gelu_pk((f32x2){v1[2], v1[3]});
                        v0 = (f32x4){a.x, a.y, b.x, b.y}; v1 = (f32x4){c.x, c.y, d.x, d.y}; }
                    if (ACT == 2) {
#pragma unroll
                        for (int j = 0; j < 4; ++j) { v0[j] = 0.5f * v0[j] * (1.0f + erff(v0[j] * 0.70710678f)); v1[j] = 0.5f * v1[j] * (1.0f + erff(v1[j] * 0.70710678f)); } }
                    u32x4 w; w.x = cvt_pk_bf16(v0[0], v0[1]); w.y = cvt_pk_bf16(v0[2], v0[3]); w.z = cvt_pk_bf16(v1[0], v1[1]); w.w = cvt_pk_bf16(v1[2], v1[3]);
                    *(u32x4*)(rowp + bj * HALF) = w; } }
    }
};
template <class Epi, class Sched, bool STAMP = false>
__device__ __forceinline__ void gemm_phase(PG8_LAS unsigned char* lds, const Gemm g, const Sched& S, const Epi& E, unsigned long long* stamps) {
    const int tid = ltid(), wid = __builtin_amdgcn_readfirstlane(tid >> 6), lane = tid & 63, wr = wid >> 2, wc = wid & 3, fr = lane & 15, fq = lane >> 4;
    const int K = g.K, nt = K / BK;
    int ts_lo = 0, ts_hi = 0, nts = 0; const unsigned long long rt_entry = STAMP ? (unsigned long long)wall_clock64() : 0ull;
#define PG8_STAMP() do { if (STAMP && wid == 0 && nts < 64) { const unsigned long long _c = (unsigned long long)clock64(); \
        ts_lo = (lane == nts) ? (int)(unsigned)_c : ts_lo; ts_hi = (lane == nts) ? (int)(unsigned)(_c >> 32) : ts_hi; ++nts; } } while (0)
    PG8_STAMP();
    unsigned voffA[2], voffB[2];
#pragma unroll
    for (int i = 0; i < 2; ++i) { int R, C; stage_rc(tid * 16 + i * 8192, R, C); const int Rb = Epi::PERM ? ((R & ~31) + perm32(R & 31)) : R;
        voffA[i] = (unsigned)(R * K + C) * 2u; voffB[i] = (unsigned)(Rb * K + C) * 2u; }
    const size_t kstep = (size_t)(BK * 2);
    const size_t hstep = (size_t)HALF * K * 2;
    const size_t tstep = 2 * hstep;
    const unsigned ldsw = (unsigned)wid * 1024u;
    const int aoff = lds_byte(wr * 64 + fr, fq * 8), boff = lds_byte(wc * 32 + fr, fq * 8);
#define PG8_SA(b, h) (((b) * 2 + (h)) * HTB)
#define PG8_SB(b, h) ((4 + (b) * 2 + (h)) * HTB)
#define PG8_STAGE(bufoff, gbase, voff) do { _Pragma("unroll") for (int _i = 0; _i < 2; ++_i) \
        __builtin_amdgcn_global_load_lds((const unsigned*)((const char*)(gbase) + (voff)[_i]), (PG8_LAS unsigned*)(lds + (bufoff) + ldsw + _i * 8192), 16, 0, 0); } while (0)
#define PG8_LDA(dst, b, h) do { _Pragma("unroll") for (int m = 0; m < 4; ++m) _Pragma("unroll") for (int k = 0; k < 2; ++k) dst[m][k] = *(const PG8_LAS bf16x8*)(lds + PG8_SA(b, h) + aoff + m * 2048 + k * 1024); } while (0)
#define PG8_LDB(dst, b, h) do { _Pragma("unroll") for (int n = 0; n < 2; ++n) _Pragma("unroll") for (int k = 0; k < 2; ++k) dst[n][k] = *(const PG8_LAS bf16x8*)(lds + PG8_SB(b, h) + boff + n * 2048 + k * 1024); } while (0)
#define PG8_MMA(ai, bj, At, Bt) do { __builtin_amdgcn_s_setprio(1); _Pragma("unroll") for (int m = 0; m < 4; ++m) _Pragma("unroll") for (int n = 0; n < 2; ++n) _Pragma("unroll") for (int k = 0; k < 2; ++k) \
        acc[ai][bj][m][n] = __builtin_amdgcn_mfma_f32_16x16x32_bf16(Bt[n][k], At[m][k], acc[ai][bj][m][n], 0, 0, 0); __builtin_amdgcn_s_setprio(0); } while (0)
#define PG8_WAIT_V(n) asm volatile("s_waitcnt vmcnt(" #n ")" ::: "memory")
#define PG8_WAIT_L(n) asm volatile("s_waitcnt lgkmcnt(" #n ")" ::: "memory")
#define PG8_BAR __builtin_amdgcn_s_barrier()
#define PG8_SCHED __builtin_amdgcn_sched_barrier(0)
    Unit cur, nxt; int ui = 0;
    if (!S.next(0, cur)) return;
    f32x4 acc[2][2][4][2];
#pragma unroll
    for (int a = 0; a < 2; ++a)
#pragma unroll
        for (int b = 0; b < 2; ++b)
#pragma unroll
            for (int m = 0; m < 4; ++m)
#pragma unroll
                for (int n = 0; n < 2; ++n) acc[a][b][m][n] = (f32x4){0.f, 0.f, 0.f, 0.f};
    bf16x8 At[4][2], B0[2][2], B1[2][2];
    const char* cA = (const char*)g.A + (size_t)cur.pm * tstep; const char* cB = (const char*)g.Bt + (size_t)cur.pn * tstep;
    S.a_ready(cur);
    PG8_STAGE(PG8_SB(0, 0), cB, voffB); PG8_STAGE(PG8_SA(0, 0), cA, voffA); PG8_STAGE(PG8_SB(0, 1), cB + hstep, voffB); PG8_STAGE(PG8_SA(0, 1), cA + hstep, voffA);
    if (wr == 1) PG8_BAR;
    PG8_WAIT_V(4); PG8_BAR;
    PG8_STAGE(PG8_SB(1, 0), cB + kstep, voffB); PG8_STAGE(PG8_SA(1, 0), cA + kstep, voffA); PG8_STAGE(PG8_SB(1, 1), cB + hstep + kstep, voffB);
    PG8_WAIT_V(6); PG8_BAR;
    PG8_STAMP();
    for (;;) {
        const bool has_next = S.next(ui + 1, nxt);
        const char* nA = has_next ? (const char*)g.A + (size_t)nxt.pm * tstep : cA; const char* nB = has_next ? (const char*)g.Bt + (size_t)nxt.pn * tstep : cB;
        for (int t = 0; t < nt; t += 2) {
            const bool last = (t == nt - 2);
            const char* a1 = cA + (size_t)(t + 1) * kstep;
            const char* a2 = last ? nA : cA + (size_t)(t + 2) * kstep; const char* b2 = last ? nB : cB + (size_t)(t + 2) * kstep;
            const char* a3 = a2 + kstep; const char* b3 = b2 + kstep;
            if (last && has_next) S.a_ready(nxt);
            PG8_LDB(B0, 0, 0); PG8_SCHED; PG8_LDA(At, 0, 0); PG8_STAGE(PG8_SA(1, 1), a1 + hstep, voffA);
            PG8_WAIT_L(8); PG8_BAR; PG8_WAIT_L(0); PG8_MMA(0, 0, At, B0); PG8_BAR; PG8_SCHED;
            PG8_LDB(B1, 0, 1); PG8_STAGE(PG8_SB(0, 0), b2, voffB);
            PG8_BAR; PG8_WAIT_L(0); PG8_MMA(0, 1, At, B1); PG8_BAR;
            PG8_LDA(At, 0, 1); PG8_STAGE(PG8_SA(0, 0), a2, voffA);
            PG8_BAR; PG8_WAIT_L(0); PG8_MMA(1, 0, At, B0); PG8_BAR; PG8_SCHED;
            PG8_STAGE(PG8_SB(0, 1), b2 + hstep, voffB);
            PG8_WAIT_V(6); PG8_BAR; PG8_MMA(1, 1, At, B1); PG8_BAR;
            PG8_LDB(B0, 1, 0); PG8_SCHED; PG8_LDA(At, 1, 0); PG8_STAGE(PG8_SA(0, 1), a2 + hstep, voffA);
            PG8_WAIT_L(8); PG8_BAR; PG8_WAIT_L(0); PG8_MMA(0, 0, At, B0); PG8_BAR; PG8_SCHED;
            PG8_LDB(B1, 1, 1); PG8_STAGE(PG8_SB(1, 0), b3, voffB);
            PG8_BAR; PG8_WAIT_L(0); PG8_MMA(0, 1, At, B1); PG8_BAR;
            PG8_LDA(At, 1, 1); PG8_STAGE(PG8_SA(1, 0), a3, voffA);
            PG8_BAR; PG8_WAIT_L(0); PG8_MMA(1, 0, At, B0); PG8_BAR; PG8_SCHED;
            PG8_STAGE(PG8_SB(1, 1), b3 + hstep, voffB);
            PG8_WAIT_V(6); PG8_BAR; PG8_MMA(1, 1, At, B1); PG8_BAR;
        }
        PG8_STAMP();
        if constexpr (!Epi::AFTER_DRAIN) { E(acc, cur, wr, wc, fr, fq); S.done(cur); }
        PG8_STAMP();
        if (!has_next) break;
#pragma unroll
        for (int a = 0; a < 2; ++a)
#pragma unroll
            for (int b = 0; b < 2; ++b)
#pragma unroll
                for (int m = 0; m < 4; ++m)
#pragma unroll
                    for (int n = 0; n < 2; ++n) acc[a][b][m][n] = (f32x4){0.f, 0.f, 0.f, 0.f};
        cur = nxt; cA = nA; cB = nB; ++ui;
    }
    PG8_WAIT_V(0);
    if (wr == 0) PG8_BAR;
    PG8_BAR;
    if constexpr (Epi::AFTER_DRAIN) { E.fused(acc, cur, wr, wc, fr, fq, lds, wid, lane); S.done(cur); }
    PG8_STAMP();
    if (STAMP && wid == 0) { stamps[lane] = lane < nts ? (((unsigned long long)(unsigned)ts_hi << 32) | (unsigned)ts_lo) : 0ull;
        if (lane == 62) stamps[62] = rt_entry; if (lane == 63) stamps[63] = (unsigned long long)wall_clock64(); }
#undef PG8_STAMP
#undef PG8_SA
#undef PG8_SB
#undef PG8_STAGE
#undef PG8_LDA
#undef PG8_LDB
#undef PG8_MMA
#undef PG8_WAIT_V
#undef PG8_WAIT_L
#undef PG8_BAR
#undef PG8_SCHED
}
}

DI void st_transpose(const float* __restrict__ src, bf16_t* __restrict__ dst, int K, int N, int Kpad, int Npad, float* lds, int bid, int nb) {
  const int tk = Kpad / 64, tn = Npad / 64;
  for (int it = bid; it < tk * tn; it += nb) {
    const int k0 = (it % tk) * 64, n0 = (it / tk) * 64;
    __syncthreads();
    for (int e = ltid(); e < 4096; e += NTHR) { const int i = e >> 6, j = e & 63, k = k0 + i, n = n0 + j; lds[i * 65 + j] = (k < K && n < N) ? src[(size_t)k * N + n] : 0.f; }
    __syncthreads();
    for (int e = ltid(); e < 4096; e += NTHR) { const int j = e >> 6, i = e & 63; dst[(size_t)(n0 + j) * Kpad + k0 + i] = f2bf(lds[i * 65 + j]); }
  }
}

DI void st_mods(const Prm& p, float* lds, int bid, int nb) {
  float* s = lds; float* red = lds + 9 * 2048;
  for (int e = ltid(); e < 9 * 2048; e += NTHR) { const int r = e >> 11, k = e & 2047; const float v = r < 8 ? p.c[r * 2048 + k] : p.c_ctx[k]; s[e] = siluf(v); }
  __syncthreads();
  const int kg = ltid() >> 6, cl = ltid() & 63;
  for (int it = bid; it < 2 * 192; it += nb) {
    const int l = it / 192, cb = (it % 192) * 64;
    const float* w = p.w_ada + (size_t)l * 2048 * NMOD + cb + cl;
    float acc[9];
#pragma unroll
    for (int r = 0; r < 9; ++r) acc[r] = 0.f;
    for (int k = kg * 256; k < kg * 256 + 256; ++k) { const float wv = w[(size_t)k * NMOD];
#pragma unroll
      for (int r = 0; r < 9; ++r) acc[r] += s[r * 2048 + k] * wv; }
#pragma unroll
    for (int r = 0; r < 9; ++r) red[(kg * 9 + r) * 64 + cl] = acc[r];
    __syncthreads();
    for (int e = ltid(); e < 576; e += NTHR) { const int r = e >> 6, c2 = e & 63; float t = 0.f;
      for (int g = 0; g < 8; ++g) t += red[(g * 9 + r) * 64 + c2];
      p.mod[((size_t)l * 9 + r) * NMOD + cb + c2] = t + p.b_ada[l * NMOD + cb + c2]; }
    __syncthreads();
  }
}

DI void st_tables(const Prm& p, int bid, int nb) {
  const size_t stride = (size_t)nb * NTHR, t0 = (size_t)bid * NTHR + ltid();
  for (size_t e = t0; e < (size_t)4096 * 8192; e += stride) { const int k1 = (int)(e >> 13), n = (int)(e & 8191), n1 = n & 4095, idx = (k1 * n1) & 4095;
    float sv, cv; sincosf((float)idx * (6.283185307179586f / 4096.f), &sv, &cv); p.DFTM[e] = f2bf((n < 4096 ? cv : -sv) * (1.f / 64.f)); }
  for (size_t e = t0; e < (size_t)256 * 512; e += stride) { const int k1 = (int)(e >> 9), n = (int)(e & 511), n1 = n & 255, idx = (k1 * n1) & 255;
    float sv, cv; sincosf((float)idx * (6.283185307179586f / 256.f), &sv, &cv); p.DFTC[e] = f2bf((n < 256 ? cv : -sv) * (1.f / 16.f)); }
  for (size_t e = t0; e < (size_t)2 * 128 * 128; e += stride) { const int tb = (int)(e >> 14), k2 = (int)((e >> 7) & 127), n2 = (int)(e & 127), idx = (k2 * n2) & 127;
    float sv, cv; sincosf((float)idx * (6.283185307179586f / 128.f), &sv, &cv); p.CCS[e] = (tb ? sv : cv) * 0.08838834764831845f; }
}

DI void st_modulate(const Prm& p, int layer, int which, bf16_t* __restrict__ dst, int bid, int nb) {
  const int wave = ltid() >> 6, lane = ltid() & 63;
  const int shoff = which ? 3 * DM : 0, scoff = which ? 4 * DM : DM;
  for (int row = bid * 8 + wave; row < MR; row += nb * 8) {
    const int b = row / LT, t = row - b * LT; const bool isc = t >= LL;
    const float* src = (layer == 0 && which == 0) ? (isc ? p.ctx + (size_t)(b * LCX + t - LL) * DM : p.x + (size_t)(b * LL + t) * DM) : p.X + (size_t)row * DM;
    f32x4 v[8]; float ss = 0.f;
#pragma unroll
    for (int i = 0; i < 8; ++i) { v[i] = *(const f32x4*)(src + (i * 64 + lane) * 4); ss += v[i][0] * v[i][0] + v[i][1] * v[i][1] + v[i][2] * v[i][2] + v[i][3] * v[i][3]; }
    ss = wsum(ss); const float rstd = rsqrtf(ss * (1.f / 2048.f) + EPSV);
    const float* mr = p.mod + ((size_t)layer * 9 + (isc ? 8 : b)) * NMOD;
#pragma unroll
    for (int i = 0; i < 8; ++i) { const int col = (i * 64 + lane) * 4; const f32x4 sc = *(const f32x4*)(mr + scoff + col), sh = *(const f32x4*)(mr + shoff + col);
      const f32x4 o = v[i] * rstd * (sc + 1.f) + sh; u32x2 w; w.x = pack2(o[0], o[1]); w.y = pack2(o[2], o[3]); *(u32x2*)(dst + (size_t)row * DM + col) = w; }
  }
}

DI void st_dnprep(const Prm& p, int layer, int bid, int nb) {
  const int wave = ltid() >> 6, lane = ltid() & 63;
  const float* conv = p.dn_conv + (size_t)layer * 5 * 1536;
  for (long task = (long)bid * 8 + wave; task < (long)MR * 13; task += (long)nb * 8) {
    const int row = (int)(task / 13), grp = (int)(task - (long)row * 13);
    const int b = row / LT, t = row - b * LT; const bool isc = t >= LL;
    const int segbase = isc ? b * LT + LL : b * LT, segt = isc ? t - LL : t, seglen = isc ? LCX : LL;
    if (grp < 12) {
      const int c = grp * 128 + lane * 2; float a0 = 0.f, a1 = 0.f;
#pragma unroll
      for (int j = 0; j < 5; ++j) { const int tt = segt + j - 2;
        if (tt >= 0 && tt < seglen) { const unsigned zz = *(const unsigned*)(p.Z + (size_t)(segbase + tt) * NZ + c);
          a0 += bf2f((bf16_t)(zz & 0xffffu)) * conv[j * 1536 + c]; a1 += bf2f((bf16_t)(zz >> 16)) * conv[j * 1536 + c + 1]; } }
      a0 = siluf(a0); a1 = siluf(a1);
      if (grp < 8) { const float ss = wsum(a0 * a0 + a1 * a1); const float sc = rsqrtf(ss + EPSV) * (grp < 4 ? 0.08838834764831845f : 1.f); a0 *= sc; a1 *= sc; }
      *(unsigned*)(p.DNQ + (size_t)row * 1536 + c) = pack2(a0, a1);
    } else if (lane < 16) {
      const int isb = lane >> 3, dh = lane & 7; const float z = bf2f(p.Z[(size_t)row * NZ + (isb ? C_DNB : C_DNA) + dh]); float o;
      if (!isb) { const float xx = z + p.dn_dt_bias[layer * 8 + dh]; const float sp = xx > 20.f ? xx : log1pf(expf(xx)); o = -expf(p.dn_a_log[layer * 8 + dh]) * sp; }
      else o = sigmf(z);
      p.GB[(size_t)row * 16 + lane] = o;
    }
  }
}

DI void st_mlaprep(const Prm& p, int layer, int bid, int nb) {
  const int wave = ltid() >> 6, lane = ltid() & 63;
  const float* qn = p.mla_q_norm + layer * 448; const float* kvn = p.mla_kv_norm + layer * 128;
  for (int row = bid * 8 + wave; row < MR; row += nb * 8) {
    const bf16_t* z = p.Z + (size_t)row * NZ; const int b = row / LT, t = row - b * LT;
    float v[7]; float ss = 0.f;
#pragma unroll
    for (int i = 0; i < 7; ++i) { v[i] = bf2f(z[C_CQ + i * 64 + lane]); ss += v[i] * v[i]; }
    ss = wsum(ss); float rstd = rsqrtf(ss * (1.f / 448.f) + EPSV);
#pragma unroll
    for (int i = 0; i < 7; ++i) p.Aq[(size_t)row * 512 + i * 64 + lane] = f2bf(v[i] * rstd * qn[i * 64 + lane]);
    p.Aq[(size_t)row * 512 + 448 + lane] = 0;
    const float u0 = bf2f(z[C_CKV + lane]), u1 = bf2f(z[C_CKV + 64 + lane]);
    ss = wsum(u0 * u0 + u1 * u1); rstd = rsqrtf(ss * (1.f / 128.f) + EPSV);
    p.Akv[(size_t)row * 256 + lane] = f2bf(u0 * rstd * kvn[lane]); p.Akv[(size_t)row * 256 + 64 + lane] = f2bf(u1 * rstd * kvn[64 + lane]);
    p.Akv[(size_t)row * 256 + 128 + lane] = 0; p.Akv[(size_t)row * 256 + 192 + lane] = 0;
    if (t < LL) {
      if (lane < 32) { const int half = lane >> 4, i = lane & 15; const float x1 = bf2f(z[C_KR + half * 32 + i]), x2 = bf2f(z[C_KR + half * 32 + 16 + i]);
        const float pos = (float)(half ? (t & 63) : (t >> 6)); const float ang = pos * exp2f(-(float)i * (13.287712379549449f / 16.f)); float sv, cv; sincosf(ang, &sv, &cv);
        p.KR[(size_t)row * 64 + half * 32 + i] = f2bf(x1 * cv - x2 * sv); p.KR[(size_t)row * 64 + half * 32 + 16 + i] = f2bf(x2 * cv + x1 * sv); }
    } else p.KR[(size_t)row * 64 + lane] = z[C_KR + lane];
  }
}

DI void st_qrope(const Prm& p, int bid, int nb) {
  const int wave = ltid() >> 6, lane = ltid() & 63;
  for (int row = bid * 8 + wave; row < MR; row += nb * 8) {
    const int b = row / LT, t = row - b * LT; if (t >= LL) continue;
#pragma unroll
    for (int k = 0; k < 2; ++k) { const int pid = lane + 64 * k, h = pid >> 5, r = pid & 31, half = r >> 4, i = r & 15;
      bf16_t* q = p.Qraw + (size_t)row * 768 + h * 192 + 128 + half * 32; const float x1 = bf2f(q[i]), x2 = bf2f(q[16 + i]);
      const float pos = (float)(half ? (t & 63) : (t >> 6)); const float ang = pos * exp2f(-(float)i * (13.287712379549449f / 16.f)); float sv, cv; sincosf(ang, &sv, &cv);
      q[i] = f2bf(x1 * cv - x2 * sv); q[16 + i] = f2bf(x2 * cv + x1 * sv); }
  }
}

DI void st_fnchan(const Prm& p, float* lds, int bid, int nb) {
  float* zt = lds;
  const int wave = __builtin_amdgcn_readfirstlane(ltid() >> 6), lane = ltid() & 63;
  for (int it = bid; it < (MR / 64) * 4; it += nb) {
    const int tile = it >> 2, g = it & 3, row0 = tile * 64, b = row0 / LT, t0 = row0 - b * LT;
    __syncthreads();
    for (int e = ltid(); e < 64 * 128; e += NTHR) { const int i = e >> 7, n2 = e & 127; zt[i * 129 + n2] = bf2f(p.Z[(size_t)(row0 + i) * NZ + C_FN + g * 128 + n2]); }
    __syncthreads();
    for (int kk = 0; kk < 16; ++kk) { const int k2 = wave + 8 * kk; const float* cc = p.CCS + k2 * 128; const float* cs = p.CCS + 16384 + k2 * 128;
      float ap = 0.f, aq = 0.f;
      for (int n2 = 0; n2 < 128; ++n2) { const float zv = zt[lane * 129 + n2]; ap += zv * cc[n2]; aq += zv * cs[n2]; }
      if (t0 < LL) { bf16_t* d = p.PQT + ((size_t)(b * 512 + g * 128 + k2)) * 8192 + t0 + lane; d[0] = f2bf(ap); d[4096] = f2bf(aq); }
      else { bf16_t* d = p.PQTc + ((size_t)(b * 512 + g * 128 + k2)) * 512 + (t0 - LL) + lane; d[0] = f2bf(ap); d[256] = f2bf(aq); } }
  }
}

DI int scan_row(int b, int dir, int s) { return s < LCX ? b * LT + LL + (dir ? LCX - 1 - s : s) : b * LT + (dir ? LL - 1 - (s - LCX) : (s - LCX)); }

DI void st_dnscan(const Prm& p, float* lds, int bid, int nb) {
  float* q_s = lds; float* k_s = lds + 4096; float* v_s = lds + 8192; float* o_s = lds + 12288; float* gb_s = lds + 16384;
  const int tid = ltid(), c = tid >> 2, part = tid & 3;
  for (int chain = bid; chain < 64; chain += nb) {
    const int b = chain >> 3, h = (chain >> 1) & 3, dir = chain & 1;
    float S[32];
#pragma unroll
    for (int j = 0; j < 32; ++j) S[j] = 0.f;
    for (int batch = 0; batch < LT / 32; ++batch) {
      __syncthreads();
      for (int e = tid; e < 32 * 48; e += NTHR) { const int i = e / 48, ch = e - i * 48, pq = ch >> 4, c8 = (ch & 15) * 8; const int row = scan_row(b, dir, batch * 32 + i);
        const bf16x8 vv = *(const bf16x8*)(p.DNQ + (size_t)row * 1536 + pq * 512 + h * 128 + c8); float* d = lds + pq * 4096 + i * 128 + c8;
#pragma unroll
        for (int j = 0; j < 8; ++j) d[j] = bf2f((bf16_t)vv[j]); }
      if (tid < 32) { const int row = scan_row(b, dir, batch * 32 + tid); gb_s[tid * 2] = expf(p.GB[(size_t)row * 16 + dir * 4 + h]); gb_s[tid * 2 + 1] = p.GB[(size_t)row * 16 + 8 + dir * 4 + h]; }
      __syncthreads();
#pragma unroll 1
      for (int i = 0; i < 32; ++i) {
        const float a = gb_s[i * 2], beta = gb_s[i * 2 + 1]; const float* kk = k_s + i * 128 + part * 32; const float* qq = q_s + i * 128 + part * 32;
        float kv[32]; float ks = 0.f;
#pragma unroll
        for (int j = 0; j < 32; j += 4) { const f32x4 t4 = *(const f32x4*)(kk + j); kv[j] = t4[0]; kv[j + 1] = t4[1]; kv[j + 2] = t4[2]; kv[j + 3] = t4[3]; }
#pragma unroll
        for (int j = 0; j < 32; ++j) { S[j] *= a; ks += kv[j] * S[j]; }
        ks += __shfl_xor(ks, 1); ks += __shfl_xor(ks, 2);
        const float vn = beta * (v_s[i * 128 + c] - ks); float o = 0.f;
#pragma unroll
        for (int j = 0; j < 32; j += 4) { const f32x4 q4 = *(const f32x4*)(qq + j);
          S[j] += kv[j] * vn; S[j + 1] += kv[j + 1] * vn; S[j + 2] += kv[j + 2] * vn; S[j + 3] += kv[j + 3] * vn;
          o += q4[0] * S[j] + q4[1] * S[j + 1] + q4[2] * S[j + 2] + q4[3] * S[j + 3]; }
        o += __shfl_xor(o, 1); o += __shfl_xor(o, 2);
        if (part == 0) o_s[i * 128 + c] = o;
      }
      __syncthreads();
      { const int i = tid >> 4, c8 = (tid & 15) * 8; const int row = scan_row(b, dir, batch * 32 + i); const float* s = o_s + i * 128 + c8;
        u32x4 w; w.x = pack2(s[0], s[1]); w.y = pack2(s[2], s[3]); w.z = pack2(s[4], s[5]); w.w = pack2(s[6], s[7]);
        *(u32x4*)(p.OB + ((size_t)(0 * 2 + dir) * MR + row) * 512 + h * 128 + c8) = w; }
    }
  }
}

DI void st_glascan(const Prm& p, int layer, float* lds, int bid, int nb) {
  float* q_s = lds; float* k_s = lds + 2048; float* a_s = lds + 4096; float* v_s = lds + 6144; float* o_s = lds + 10240; float* al_s = lds + 14336;
  const int tid = ltid(), c = tid >> 2, part = tid & 3;
  for (int chain = bid; chain < 64; chain += nb) {
    const int b = chain >> 3, h = (chain >> 1) & 3, dir = chain & 1;
    const float* w2 = p.gla_w2 + (size_t)(layer * 2 + dir) * 16 * 256 + h * 64; const float* b2 = p.gla_b2 + (layer * 2 + dir) * 256 + h * 64;
    float S[16];
#pragma unroll
    for (int j = 0; j < 16; ++j) S[j] = 0.f;
    for (int batch = 0; batch < LT / 32; ++batch) {
      __syncthreads();
      for (int e = tid; e < 32 * 34; e += NTHR) { const int i = e / 34, ch = e - i * 34; const int row = scan_row(b, dir, batch * 32 + i); const bf16_t* z = p.Z + (size_t)row * NZ;
        if (ch < 8) { const bf16x8 vv = *(const bf16x8*)(z + C_GQ + h * 64 + ch * 8);
#pragma unroll
          for (int j = 0; j < 8; ++j) q_s[i * 64 + ch * 8 + j] = bf2f((bf16_t)vv[j]) * 0.125f; }
        else if (ch < 16) { const bf16x8 vv = *(const bf16x8*)(z + C_GK + h * 64 + (ch - 8) * 8);
#pragma unroll
          for (int j = 0; j < 8; ++j) k_s[i * 64 + (ch - 8) * 8 + j] = bf2f((bf16_t)vv[j]); }
        else if (ch < 32) { const bf16x8 vv = *(const bf16x8*)(z + C_GV + h * 128 + (ch - 16) * 8);
#pragma unroll
          for (int j = 0; j < 8; ++j) v_s[i * 128 + (ch - 16) * 8 + j] = bf2f((bf16_t)vv[j]); }
        else { const bf16x8 vv = *(const bf16x8*)(z + C_GALPHA + dir * 16 + (ch - 32) * 8);
#pragma unroll
          for (int j = 0; j < 8; ++j) al_s[i * 16 + (ch - 32) * 8 + j] = bf2f((bf16_t)vv[j]); } }
      __syncthreads();
#pragma unroll
      for (int k = 0; k < 4; ++k) { const int e = tid + NTHR * k, i = e >> 6, d = e & 63; float zz = b2[d];
#pragma unroll
        for (int r = 0; r < 16; ++r) zz += al_s[i * 16 + r] * w2[r * 256 + d];
        const float nz = -zz; const float sp = nz > 20.f ? nz : log1pf(expf(nz));
        a_s[i * 64 + d] = expf(-sp * (1.f / 16.f)); }
      __syncthreads();
#pragma unroll 1
      for (int i = 0; i < 32; ++i) {
        const float vv = v_s[i * 128 + c]; const float* aa = a_s + i * 64 + part * 16; const float* kk = k_s + i * 64 + part * 16; const float* qq = q_s + i * 64 + part * 16; float o = 0.f;
#pragma unroll
        for (int j = 0; j < 16; j += 4) { const f32x4 a4 = *(const f32x4*)(aa + j), k4 = *(const f32x4*)(kk + j), q4 = *(const f32x4*)(qq + j);
          S[j] = a4[0] * S[j] + k4[0] * vv; S[j + 1] = a4[1] * S[j + 1] + k4[1] * vv; S[j + 2] = a4[2] * S[j + 2] + k4[2] * vv; S[j + 3] = a4[3] * S[j + 3] + k4[3] * vv;
          o += q4[0] * S[j] + q4[1] * S[j + 1] + q4[2] * S[j + 2] + q4[3] * S[j + 3]; }
        o += __shfl_xor(o, 1); o += __shfl_xor(o, 2);
        if (part == 0) o_s[i * 128 + c] = o;
      }
      __syncthreads();
      { const int i = tid >> 4, c8 = (tid & 15) * 8; const int row = scan_row(b, dir, batch * 32 + i); const float* s = o_s + i * 128 + c8;
        u32x4 w; w.x = pack2(s[0], s[1]); w.y = pack2(s[2], s[3]); w.z = pack2(s[4], s[5]); w.w = pack2(s[6], s[7]);
        *(u32x4*)(p.OB + ((size_t)(1 * 2 + dir) * MR + row) * 512 + h * 128 + c8) = w; }
    }
  }
}

DI void st_combine(const Prm& p, int layer, int bid, int nb) {
  const int wave = ltid() >> 6, lane = ltid() & 63;
  for (long task = (long)bid * 8 + wave; task < (long)MR * 8; task += (long)nb * 8) {
    const int row = (int)(task >> 3), mh = (int)(task & 7), mixer = mh >> 2, h = mh & 3;
    const unsigned f = *(const unsigned*)(p.OB + ((size_t)(mixer * 2 + 0) * MR + row) * 512 + h * 128 + lane * 2), g = *(const unsigned*)(p.OB + ((size_t)(mixer * 2 + 1) * MR + row) * 512 + h * 128 + lane * 2);
    const float o0 = bf2f((bf16_t)(f & 0xffffu)) + bf2f((bf16_t)(g & 0xffffu)), o1 = bf2f((bf16_t)(f >> 16)) + bf2f((bf16_t)(g >> 16));
    const float ss = wsum(o0 * o0 + o1 * o1), rstd = rsqrtf(ss * (1.f / 128.f) + EPSV);
    const float* w = (mixer ? p.gla_norm : p.dn_norm) + layer * 128 + lane * 2;
    const unsigned gz = *(const unsigned*)(p.Z + (size_t)row * NZ + (mixer ? C_GGATE : C_DNGATE) + h * 128 + lane * 2);
    const float g0 = bf2f((bf16_t)(gz & 0xffffu)), g1 = bf2f((bf16_t)(gz >> 16));
    *(unsigned*)(p.Y + (size_t)row * DM + mixer * 512 + h * 128 + lane * 2) = pack2(o0 * rstd * w[0] * siluf(g0), o1 * rstd * w[1] * siluf(g1));
  }
}

DI void st_peertopk(const Prm& p, int layer, unsigned char* lds, int bid, int nb) {
  bf16_t* ks = (bf16_t*)lds;
  float* qsb = (float*)(lds + 2 * 128 * 272);
  const int tid = ltid(), wave = tid >> 6, lane = tid & 63;
  float* qs = qsb + wave * 256;
  int hcur = -1;
  const int nchunk = MR / 64;
  for (int it = bid; it < 8 * nchunk; it += nb) {
    const int h = it / nchunk, chunk = it - h * nchunk;
    if (h != hcur) { __syncthreads();
      const float* kg = p.peer_keys + ((size_t)(layer * 8 + h) * 2) * 128 * 128;
      for (int e = tid; e < 2 * 128 * 128; e += NTHR) { const int pn = e >> 7, k = e & 127; ks[pn * 136 + k] = f2bf(kg[e]); }
      hcur = h; __syncthreads(); }
    for (int rr = 0; rr < 8; ++rr) {
      const int row = chunk * 64 + wave * 8 + rr;
      { const bf16_t* q = p.Qp + (size_t)row * DM + h * 256; const u32x2 w = *(const u32x2*)(q + lane * 4);
        qs[lane * 4] = bf2f((bf16_t)(w.x & 0xffffu)); qs[lane * 4 + 1] = bf2f((bf16_t)(w.x >> 16)); qs[lane * 4 + 2] = bf2f((bf16_t)(w.y & 0xffffu)); qs[lane * 4 + 3] = bf2f((bf16_t)(w.y >> 16)); }
      float s[2][2] = {{0.f, 0.f}, {0.f, 0.f}};
#pragma unroll
      for (int pp = 0; pp < 2; ++pp)
        for (int kc = 0; kc < 16; ++kc) { const f32x4 qa = *(const f32x4*)(qs + pp * 128 + kc * 8), qb = *(const f32x4*)(qs + pp * 128 + kc * 8 + 4);
#pragma unroll
          for (int hh = 0; hh < 2; ++hh) { const bf16x8 kv = *(const bf16x8*)(ks + (pp * 128 + hh * 64 + lane) * 136 + kc * 8);
            s[pp][hh] += qa[0] * bf2f((bf16_t)kv[0]) + qa[1] * bf2f((bf16_t)kv[1]) + qa[2] * bf2f((bf16_t)kv[2]) + qa[3] * bf2f((bf16_t)kv[3])
                       + qb[0] * bf2f((bf16_t)kv[4]) + qb[1] * bf2f((bf16_t)kv[5]) + qb[2] * bf2f((bf16_t)kv[6]) + qb[3] * bf2f((bf16_t)kv[7]); } }
      float tv[2]; int ti[2];
#pragma unroll
      for (int pp = 0; pp < 2; ++pp) { float v0 = s[pp][0], v1 = s[pp][1]; tv[pp] = 0.f; ti[pp] = 0;
        for (int r = 0; r < 16; ++r) { const float m = wmax(fmaxf(v0, v1)); int idx;
          const unsigned long long b0 = __ballot(v0 == m);
          if (b0) { const int ln = __ffsll((long long)b0) - 1; idx = ln; if (lane == ln) v0 = -3.0e38f; }
          else { const unsigned long long b1 = __ballot(v1 == m); const int ln = __ffsll((long long)b1) - 1; idx = ln + 64; if (lane == ln) v1 = -3.0e38f; }
          if (lane == r) { tv[pp] = m; ti[pp] = idx; } } }
      float cd[4]; { const float sa = __shfl(tv[0], lane >> 2);
#pragma unroll
        for (int q = 0; q < 4; ++q) cd[q] = sa + __shfl(tv[1], (lane & 3) * 4 + q); }
      float top = 0.f; int pos = 0;
      for (int r = 0; r < 16; ++r) { const float m = wmax(fmaxf(fmaxf(cd[0], cd[1]), fmaxf(cd[2], cd[3])));
        int mypos = 99999;
#pragma unroll
        for (int q = 3; q >= 0; --q) if (cd[q] == m) mypos = lane * 4 + q;
        int pm = mypos; for (int o = 32; o >= 1; o >>= 1) pm = min(pm, __shfl_xor(pm, o));
        if ((pm >> 2) == lane) {
#pragma unroll
          for (int q = 0; q < 4; ++q) if ((pm & 3) == q) cd[q] = -3.0e38f; }
        if (lane == r) { top = m; pos = pm; } }
      const int i1 = __shfl(ti[0], (pos >> 4) & 15), i2 = __shfl(ti[1], pos & 15);
      const float t0 = __shfl(top, 0); float e = lane < 16 ? __expf(top - t0) : 0.f; float sum = e;
      for (int o = 8; o >= 1; o >>= 1) sum += __shfl_xor(sum, o);
      if (lane < 16) { p.IDX[(size_t)row * 128 + h * 16 + lane] = i1 * 128 + i2; p.GATE[(size_t)row * 128 + h * 16 + lane] = e / sum; }
    }
  }
}

DI void st_peergather(const Prm& p, int layer, float* lds, int bid, int nb) {
  const int tid = ltid(), wave = tid >> 6, lane = tid & 63;
  const float* U = p.peer_u + (size_t)layer * 16384 * DM; const float* V = p.peer_v + (size_t)layer * 16384 * DM;
  for (int row = bid; row < MR; row += nb) {
    const int b = row / LT, t = row - b * LT; const bool isc = t >= LL;
    f32x4 hv[8];
#pragma unroll
    for (int i = 0; i < 8; ++i) { const u32x2 w = *(const u32x2*)(p.H2 + (size_t)row * DM + (i * 64 + lane) * 4);
      hv[i][0] = bf2f((bf16_t)(w.x & 0xffffu)); hv[i][1] = bf2f((bf16_t)(w.x >> 16)); hv[i][2] = bf2f((bf16_t)(w.y & 0xffffu)); hv[i][3] = bf2f((bf16_t)(w.y >> 16)); }
    f32x4 acc[8];
#pragma unroll
    for (int i = 0; i < 8; ++i) acc[i] = (f32x4){0.f, 0.f, 0.f, 0.f};
    const int myidx = lane < 16 ? p.IDX[(size_t)row * 128 + wave * 16 + lane] : 0; const float mygate = lane < 16 ? p.GATE[(size_t)row * 128 + wave * 16 + lane] : 0.f;
    for (int k = 0; k < 16; ++k) {
      const int e = __builtin_amdgcn_readfirstlane(__shfl(myidx, k)); const float gt = __shfl(mygate, k);
      const float* ur = U + (size_t)e * DM; float d = 0.f;
#pragma unroll
      for (int i = 0; i < 8; ++i) { const f32x4 uv = *(const f32x4*)(ur + (i * 64 + lane) * 4); d += uv[0] * hv[i][0] + uv[1] * hv[i][1] + uv[2] * hv[i][2] + uv[3] * hv[i][3]; }
      d = wsum(d);
      const float wgt = gt * 0.5f * d * (1.f + erff(d * 0.70710678118654752f));
      const float* vr = V + (size_t)e * DM;
#pragma unroll
      for (int i = 0; i < 8; ++i) { const f32x4 vv = *(const f32x4*)(vr + (i * 64 + lane) * 4); acc[i] += vv * wgt; }
    }
    __syncthreads();
#pragma unroll
    for (int i = 0; i < 8; ++i) *(f32x4*)(lds + wave * 2048 + (i * 64 + lane) * 4) = acc[i];
    __syncthreads();
    { const int col = tid * 4; f32x4 sum = (f32x4){0.f, 0.f, 0.f, 0.f};
#pragma unroll
      for (int w = 0; w < 8; ++w) sum += *(const f32x4*)(lds + w * 2048 + col);
      const f32x4 g2 = *(const f32x4*)(p.mod + ((size_t)layer * 9 + (isc ? 8 : b)) * NMOD + 5 * DM + col);
      float* xr = p.X + (size_t)row * DM + col; *(f32x4*)xr = *(const f32x4*)xr + g2 * sum; }
  }
}

DI void st_final(const Prm& p, int bid, int nb) {
  const int wave = ltid() >> 6, lane = ltid() & 63;
  for (int r = bid * 8 + wave; r < NB * LL; r += nb * 8) {
    const int b = r / LL, t = r - b * LL; const float* src = p.X + (size_t)(b * LT + t) * DM;
    f32x4 v[8]; float ss = 0.f;
#pragma unroll
    for (int i = 0; i < 8; ++i) { v[i] = *(const f32x4*)(src + (i * 64 + lane) * 4); ss += v[i][0] * v[i][0] + v[i][1] * v[i][1] + v[i][2] * v[i][2] + v[i][3] * v[i][3]; }
    ss = wsum(ss); const float rstd = rsqrtf(ss * (1.f / 2048.f) + EPSV);
#pragma unroll
    for (int i = 0; i < 8; ++i) { const int col = (i * 64 + lane) * 4; *(f32x4*)(p.out + (size_t)r * DM + col) = v[i] * rstd * *(const f32x4*)(p.final_norm + col); }
  }
}

namespace att {
constexpr int NW = 8, QBLK = 32, KVBLK = 64;
constexpr float SCALE = 0.07216878364870322f;
constexpr float THR = 8.f;
constexpr int LDQ = 768, LDK = 1024, LDKR = 64, LDO = DM;
constexpr int SHM_V = KVBLK * 128 * 2, SHM_K = KVBLK * 128 * 2, SHM_KR = KVBLK * 64 * 2, SHM_ATTN = 2 * SHM_V + 2 * SHM_K + 2 * SHM_KR + NW * 64 * 4;
#define KSWZ(row, colB) ((row) * 256 + ((colB) ^ (((row) & 7) << 4)))
#define KRSWZ(row, colB) ((row) * 128 + ((colB) ^ ((((row) >> 1) & 7) << 4)))
#define SBAR() __builtin_amdgcn_sched_barrier(0)
DI int crow(int r, int hi) { return (r & 3) + 8 * (r >> 2) + 4 * hi; }
DI unsigned cvtpk(float lo, float hi) { unsigned r; asm volatile("v_cvt_pk_bf16_f32 %0, %1, %2" : "=v"(r) : "v"(lo), "v"(hi)); return r; }

DI void partialSM(f32x16& p0, f32x16& p1, float& m_reg, float& mn, float& alpha) {
  constexpr float C = SCALE * 1.4426950408889634f;
  float pmax = p0[0];
#pragma unroll
  for (int r = 1; r < 16; ++r) pmax = fmaxf(pmax, p0[r]);
#pragma unroll
  for (int r = 0; r < 16; ++r) pmax = fmaxf(pmax, p1[r]);
  { auto rr = __builtin_amdgcn_permlane32_swap(__float_as_uint(pmax), __float_as_uint(pmax), false, false);
    pmax = fmaxf(__uint_as_float(rr[0]), __uint_as_float(rr[1])); }
  if (__builtin_expect(__all(pmax - m_reg <= THR / SCALE), 1)) { mn = m_reg; alpha = 1.f; }
  else { mn = fmaxf(m_reg, pmax); alpha = __builtin_amdgcn_exp2f((m_reg - mn) * C); m_reg = mn; }
  const float mnC = -mn * C;
#pragma unroll
  for (int r = 0; r < 16; ++r) p0[r] = fmaf(p0[r], C, mnC);
#pragma unroll
  for (int r = 0; r < 16; ++r) p1[r] = fmaf(p1[r], C, mnC);
#pragma unroll
  for (int r = 0; r < 16; ++r) p0[r] = __builtin_amdgcn_exp2f(p0[r]);
}
DI void finishSM(f32x16& p0, f32x16& p1, float alpha, float& l_reg, bf16x8& pa0, bf16x8& pa1, bf16x8& pa2, bf16x8& pa3) {
#pragma unroll
  for (int r = 0; r < 16; ++r) p1[r] = __builtin_amdgcn_exp2f(p1[r]);
  float ps = 0;
#pragma unroll
  for (int r = 0; r < 16; ++r) ps += p0[r];
#pragma unroll
  for (int r = 0; r < 16; ++r) ps += p1[r];
  { auto rr = __builtin_amdgcn_permlane32_swap(__float_as_uint(ps), __float_as_uint(ps), false, false);
    ps = __uint_as_float(rr[0]) + __uint_as_float(rr[1]); }
  l_reg = l_reg * alpha + ps;
#define PK4(P, BASE, OUT) do { unsigned a0 = cvtpk(P[BASE + 0], P[BASE + 1]), a1 = cvtpk(P[BASE + 2], P[BASE + 3]);   \
    unsigned b0 = cvtpk(P[BASE + 4], P[BASE + 5]), b1 = cvtpk(P[BASE + 6], P[BASE + 7]);                              \
    auto r0 = __builtin_amdgcn_permlane32_swap(a0, b0, false, false); auto r1 = __builtin_amdgcn_permlane32_swap(a1, b1, false, false); \
    u32x4 w = {r0[0], r1[0], r0[1], r1[1]}; OUT = *reinterpret_cast<bf16x8*>(&w); } while (0)
  PK4(p0, 0, pa0); PK4(p0, 8, pa1); PK4(p1, 0, pa2); PK4(p1, 8, pa3);
#undef PK4
}
DI void qkt(f32x16& p0, f32x16& p1, const char* Ks, const char* KRs, const bf16x8* qr, int r32, int hi) {
  p0 = f32x16{}; p1 = f32x16{};
#pragma unroll
  for (int d0 = 0; d0 < 8; ++d0) { const int cb = (d0 * 16 + hi * 8) * 2;
    const bf16x8 b0 = *reinterpret_cast<const bf16x8*>(Ks + KSWZ(r32, cb));
    const bf16x8 b1 = *reinterpret_cast<const bf16x8*>(Ks + KSWZ(32 + r32, cb));
    p0 = __builtin_amdgcn_mfma_f32_32x32x16_bf16(b0, qr[d0], p0, 0, 0, 0);
    p1 = __builtin_amdgcn_mfma_f32_32x32x16_bf16(b1, qr[d0], p1, 0, 0, 0); }
#pragma unroll
  for (int d0 = 0; d0 < 4; ++d0) { const int cb = (d0 * 16 + hi * 8) * 2;
    const bf16x8 b0 = *reinterpret_cast<const bf16x8*>(KRs + KRSWZ(r32, cb));
    const bf16x8 b1 = *reinterpret_cast<const bf16x8*>(KRs + KRSWZ(32 + r32, cb));
    p0 = __builtin_amdgcn_mfma_f32_32x32x16_bf16(b0, qr[8 + d0], p0, 0, 0, 0);
    p1 = __builtin_amdgcn_mfma_f32_32x32x16_bf16(b1, qr[8 + d0], p1, 0, 0, 0); }
}
DI int v_st(int k, int c) { const int kk = (k & ~0xC) | ((k & 4) << 1) | ((k & 8) >> 1); return ((kk >> 3) * 4 + (c >> 5)) * 512 + ((kk & 7) * 32 + (c & 31)) * 2; }
DI int v_rd_base(int lane) { return ((lane & 3) << 3) | (((lane >> 2) & 3) << 6) | (((lane >> 4) & 1) << 5) | (((lane >> 5) & 1) << 8); }
constexpr int v_rd_off(int d0, int ks, int half) { return d0 * 512 + ks * 4096 + half * 2048; }
template <int OFF> DI s16x4 tr_read(int vb) { s16x4 r; asm volatile("ds_read_b64_tr_b16 %0, %1 offset:%2" : "=&v"(r) : "v"(vb), "i"(OFF) : "memory"); return r; }
template <int D0> DI void pv_one(f32x16& od, int vb, bf16x8 pa0, bf16x8 pa1, bf16x8 pa2, bf16x8 pa3) {
  const s16x4 l0 = tr_read<v_rd_off(D0, 0, 0)>(vb), h0 = tr_read<v_rd_off(D0, 0, 1)>(vb), l1 = tr_read<v_rd_off(D0, 1, 0)>(vb), h1 = tr_read<v_rd_off(D0, 1, 1)>(vb);
  const s16x4 l2 = tr_read<v_rd_off(D0, 2, 0)>(vb), h2 = tr_read<v_rd_off(D0, 2, 1)>(vb), l3 = tr_read<v_rd_off(D0, 3, 0)>(vb), h3 = tr_read<v_rd_off(D0, 3, 1)>(vb);
  asm volatile("s_waitcnt lgkmcnt(0)" ::: "memory"); SBAR();
#define PK(L, H) (bf16x8){L[0], L[1], L[2], L[3], H[0], H[1], H[2], H[3]}
  od = __builtin_amdgcn_mfma_f32_32x32x16_bf16(pa0, PK(l0, h0), od, 0, 0, 0);
  od = __builtin_amdgcn_mfma_f32_32x32x16_bf16(pa1, PK(l1, h1), od, 0, 0, 0);
  od = __builtin_amdgcn_mfma_f32_32x32x16_bf16(pa2, PK(l2, h2), od, 0, 0, 0);
  od = __builtin_amdgcn_mfma_f32_32x32x16_bf16(pa3, PK(l3, h3), od, 0, 0, 0);
#undef PK
}
DI void pv_d0(f32x16* o, int vb, bf16x8 pa0, bf16x8 pa1, bf16x8 pa2, bf16x8 pa3) {
  pv_one<0>(o[0], vb, pa0, pa1, pa2, pa3); pv_one<1>(o[1], vb, pa0, pa1, pa2, pa3); pv_one<2>(o[2], vb, pa0, pa1, pa2, pa3); pv_one<3>(o[3], vb, pa0, pa1, pa2, pa3);
}

DI void attn_body(const bf16_t* __restrict__ Qb, const bf16_t* __restrict__ Kh, const bf16_t* __restrict__ Vh, const bf16_t* __restrict__ KRh, bf16_t* __restrict__ Ob, int seq, int tpos0, char* lds) {
  const int tid = ltid(), wid = tid >> 6, lane = tid & 63, r32 = lane & 31, hi = lane >> 5;
  char* V_lds = lds; char* K_lds = lds + 2 * SHM_V; char* KR_lds = lds + 2 * SHM_V + 2 * SHM_K;
  float* ws = (float*)(lds + 2 * SHM_V + 2 * SHM_K + 2 * SHM_KR) + wid * 64; float* li_l = ws; float* al_l = ws + 32;
  float m_reg = -1e30f, l_reg = 0; f32x16 o[4] = {}; bf16x8 qr[12];
  const bf16_t* Qw = Qb + (long)(wid * QBLK + r32) * LDQ + hi * 8;
#pragma unroll
  for (int d0 = 0; d0 < 12; ++d0) qr[d0] = *reinterpret_cast<const bf16x8*>(Qw + d0 * 16);
  if (tpos0 >= 0) {
    const int t = tpos0 + wid * QBLK + r32;
#pragma unroll
    for (int hf = 0; hf < 2; ++hf) { const float pos = (float)(hf ? (t & 63) : (t >> 6));
#pragma unroll
      for (int j = 0; j < 8; ++j) { const float ang = pos * exp2f(-(float)(hi * 8 + j) * (13.287712379549449f / 16.f)); float sv, cv; sincosf(ang, &sv, &cv);
        const float x1 = bf2f((bf16_t)qr[8 + 2 * hf][j]), x2 = bf2f((bf16_t)qr[9 + 2 * hf][j]);
        qr[8 + 2 * hf][j] = (short)f2bf(x1 * cv - x2 * sv); qr[9 + 2 * hf][j] = (short)f2bf(x2 * cv + x1 * sv); } }
  }
  const int sr = tid >> 4, sc = (tid & 15) * 8, vst0 = v_st(sr, sc), vst1 = v_st(32 + sr, sc);
  const int krr = tid >> 3, krc = (tid & 7) * 8;
  const int vb0 = (int)(uintptr_t)V_lds + v_rd_base(lane);
  bf16x8 vs0, vs1, ks0, ks1, kr0;
#define SLOAD(k0) do { vs0 = *reinterpret_cast<const bf16x8*>(&Vh[(long)((k0) + sr) * LDK + sc]); vs1 = *reinterpret_cast<const bf16x8*>(&Vh[(long)((k0) + 32 + sr) * LDK + sc]); \
    ks0 = *reinterpret_cast<const bf16x8*>(&Kh[(long)((k0) + sr) * LDK + sc]); ks1 = *reinterpret_cast<const bf16x8*>(&Kh[(long)((k0) + 32 + sr) * LDK + sc]); \
    kr0 = *reinterpret_cast<const bf16x8*>(&KRh[(long)((k0) + krr) * LDKR + krc]); } while (0)
#define SWRITE(b) do { *(bf16x8*)(V_lds + (b) * SHM_V + vst0) = vs0; *(bf16x8*)(V_lds + (b) * SHM_V + vst1) = vs1; const int kc = sc * 2;               \
    *(bf16x8*)(K_lds + (b) * SHM_K + KSWZ(sr, kc)) = ks0; *(bf16x8*)(K_lds + (b) * SHM_K + KSWZ(32 + sr, kc)) = ks1;                       \
    *(bf16x8*)(KR_lds + (b) * SHM_KR + KRSWZ(krr, krc * 2)) = kr0; } while (0)
#define SWAIT() asm volatile("s_waitcnt vmcnt(0)" ::: "memory")
#define RESC(a) do { if (__any((a) < 1.f)) { if (hi == 0) al_l[r32] = (a); asm volatile("s_waitcnt lgkmcnt(0)" ::: "memory"); \
    _Pragma("unroll") for (int d = 0; d < 4; ++d) _Pragma("unroll") for (int r = 0; r < 16; ++r) o[d][r] *= al_l[crow(r, hi)]; } } while (0)
  f32x16 p0, p1; float mn, al; bf16x8 pa0, pa1, pa2, pa3; const int NT = seq / KVBLK;
  SLOAD(0); SWAIT(); SWRITE(0); __syncthreads();
  for (int j = 0; j < NT; ++j) {
    const int buf = j & 1; const bool more = j + 1 < NT;
    if (more) SLOAD((j + 1) * KVBLK);
    SBAR(); qkt(p0, p1, K_lds + buf * SHM_K, KR_lds + buf * SHM_KR, qr, r32, hi);
    partialSM(p0, p1, m_reg, mn, al); RESC(al);
    finishSM(p0, p1, al, l_reg, pa0, pa1, pa2, pa3); SBAR();
    pv_d0(o, vb0 + buf * SHM_V, pa0, pa1, pa2, pa3);
    if (more) { SWAIT(); SWRITE(buf ^ 1); }
    __syncthreads();
  }
  if (hi == 0) li_l[r32] = l_reg; asm volatile("s_waitcnt lgkmcnt(0)" ::: "memory");
  float rli[16];
#pragma unroll
  for (int r = 0; r < 16; ++r) rli[r] = __builtin_amdgcn_rcpf(li_l[crow(r, hi)]);
  bf16_t* Ow = Ob + (long)(wid * QBLK) * LDO;
#pragma unroll
  for (int r = 0; r < 16; ++r) { const int orow = crow(r, hi);
#pragma unroll
    for (int d0 = 0; d0 < 4; ++d0) Ow[(long)orow * LDO + d0 * 32 + r32] = f2bf(o[d0][r] * rli[r]); }
  __syncthreads();
#undef SLOAD
#undef SWRITE
#undef SWAIT
#undef RESC
}
}

DI void st_attn(const Prm& p, int layer, char* lds, int bid, int nb) {
  const int nlat = NB * 4 * 16, nitem = nlat + (layer == 0 ? NB * 4 : 0);
  for (int it = bid; it < nitem; it += nb) {
    if (it < nlat) { const int b = it >> 6, h = (it >> 4) & 3, qb = it & 15; const size_t r0 = (size_t)b * LT;
      att::attn_body(p.Qraw + (r0 + qb * 256) * 768 + h * 192, p.KV + r0 * 1024 + h * 256, p.KV + r0 * 1024 + h * 256 + 128, p.KR + r0 * 64,
                     p.Y + (r0 + qb * 256) * DM + 1024 + h * 128, LT, qb * 256, lds); }
    else { const int k = it - nlat, b = k >> 2, h = k & 3; const size_t r0 = (size_t)b * LT + LL;
      att::attn_body(p.Qraw + r0 * 768 + h * 192, p.KV + r0 * 1024 + h * 256, p.KV + r0 * 1024 + h * 256 + 128, p.KR + r0 * 64, p.Y + r0 * DM + 1024 + h * 128, LCX, -1, lds); }
  }
}

struct EpiResid {
  static constexpr bool PERM = false, AFTER_DRAIN = false;
  const float* xlat; const float* xctx; float* X; const float* modl; int first;
  __device__ __forceinline__ void operator()(const pg8::f32x4 (&acc)[2][2][4][2], const pg8::Unit& u, int wr, int wc, int fr, int fq) const {
    const int b = u.pm / 17, tl = u.pm - b * 17; const bool isc = tl == 16;
    const float* g = modl + (size_t)(isc ? 8 : b) * NMOD + 2 * DM;
    const int rloc0 = wr * 64 + fr, col0 = u.pn * 256 + wc * 32 + 4 * fq;
    pg8::f32x4 gv[2][2];
#pragma unroll
    for (int bj = 0; bj < 2; ++bj)
#pragma unroll
      for (int n = 0; n < 2; ++n) gv[bj][n] = *(const pg8::f32x4*)(g + col0 + bj * 128 + n * 16);
#pragma unroll
    for (int ai = 0; ai < 2; ++ai)
#pragma unroll
      for (int m = 0; m < 4; ++m) { const int rl = rloc0 + ai * 128 + m * 16; const size_t row = (size_t)u.pm * 256 + rl;
        const float* src = first ? (isc ? xctx + ((size_t)b * LCX + rl) * DM : xlat + ((size_t)b * LL + tl * 256 + rl) * DM) : X + row * DM;
        float* dst = X + row * DM;
#pragma unroll
        for (int bj = 0; bj < 2; ++bj)
#pragma unroll
          for (int n = 0; n < 2; ++n) { const int c = col0 + bj * 128 + n * 16; *(pg8::f32x4*)(dst + c) = *(const pg8::f32x4*)(src + c) + gv[bj][n] * acc[ai][bj][m][n]; } }
  }
};

template <class Epi> DI void run_gemm(unsigned char* lds, const bf16_t* A, const bf16_t* Bt, int M, int N, int K, const Epi& E, int bid, int nb) {
  pg8::Gemm g; g.A = A; g.Bt = Bt; g.M = M; g.N = N; g.K = K;
  pg8::StaticOrder S; S.init(M, N, nb, bid);
  pg8::gemm_phase<Epi, pg8::StaticOrder, false>((PG8_LAS unsigned char*)lds, g, S, E, nullptr);
}
DI pg8::EpiBf16<0> epi_bf16(bf16_t* O, int ldc, int split_cols = 0, size_t split_stride = 0) { pg8::EpiBf16<0> e; e.O = O; e.ldc = ldc; e.bias = nullptr; e.split_cols = split_cols; e.split_stride = split_stride; return e; }

constexpr int LDS_MAIN = 131072, LDS_TOTAL = LDS_MAIN + 64;
#define PRM() (*(const __attribute__((address_space(4))) Prm*)launder_k(kp))
typedef const __attribute__((address_space(4))) void* kptr_t;
DI kptr_t launder_k(kptr_t q) { asm volatile("" : "+s"(q)); return q; }
extern __shared__ __attribute__((aligned(16))) unsigned char shm[];
__global__ void __launch_bounds__(NTHR, 2) mega(Prm p_unused) {
#if defined(__HIP_DEVICE_COMPILE__)
  kptr_t kp = (kptr_t)__builtin_amdgcn_kernarg_segment_ptr();
  const int bid0 = blockIdx.x, nb0 = gridDim.x;
#define bid lsg(bid0)
#define nb lsg(nb0)
  uint4* xbw = (uint4*)(shm + LDS_MAIN);
  if (threadIdx.x == 0) *xbw = make_uint4(0u, 0u, 0u, 0u);
  __syncthreads();
  { const Prm p = PRM(); (void)xcd_barrier_post(p.bar, (volatile LAS unsigned*)xbw); }
#define GRID_BAR() do { XcdBarrier b_; b_.bar = PRM().bar; b_.x = xb_xcc_id(); b_.st = (volatile LAS unsigned*)(shm + LDS_MAIN); xcd_barrier(b_); } while (0)
  float* lf = (float*)shm;
  for (int ly = 0; ly < 2; ++ly) { const Prm p = PRM();
    st_transpose(p.w_in + (size_t)ly * DM * IN_W, p.WinT + (size_t)ly * NZ * DM, DM, IN_W, DM, NZ, lf, bid, nb);
    st_transpose(p.w_out + (size_t)ly * DM * DM, p.WoutT + (size_t)ly * DM * DM, DM, DM, DM, DM, lf, bid, nb);
    st_transpose(p.peer_wq + (size_t)ly * DM * DM, p.WqT + (size_t)ly * DM * DM, DM, DM, DM, DM, lf, bid, nb);
    st_transpose(p.mla_w_uq + (size_t)ly * 448 * 768, p.WuqT + (size_t)ly * 768 * 512, 448, 768, 512, 768, lf, bid, nb);
    st_transpose(p.mla_w_ukv + (size_t)ly * 128 * 1024, p.WukvT + (size_t)ly * 1024 * 256, 128, 1024, 256, 1024, lf, bid, nb);
  }
  { const Prm p = PRM(); st_tables(p, bid, nb); }
  __syncthreads();
  { const Prm p = PRM(); st_mods(p, lf, bid, nb); }
  GRID_BAR();
  for (int l = 0; l < 2; ++l) {
    { const Prm p = PRM(); st_modulate(p, l, 0, p.H, bid, nb); }
    GRID_BAR();
    { const Prm p = PRM(); run_gemm(shm, p.H, p.WinT + (size_t)l * NZ * DM, MR, NZ, DM, epi_bf16(p.Z, NZ), bid, nb); }
    GRID_BAR();
    { const Prm p = PRM(); st_dnprep(p, l, bid, nb); }
    { const Prm p = PRM(); st_mlaprep(p, l, bid, nb); }
    { const Prm p = PRM(); st_fnchan(p, lf, bid, nb); }
    GRID_BAR();
    if (bid < 64) { const Prm p = PRM(); st_dnscan(p, lf, bid, 64); }
    else if (bid < 128) { const Prm p = PRM(); st_glascan(p, l, lf, bid - 64, 64); }
    else {
      const int b2 = bid - 128, n2 = nb - 128;
      { const Prm p = PRM(); run_gemm(shm, p.Aq, p.WuqT + (size_t)l * 768 * 512, MR, 768, 512, epi_bf16(p.Qraw, 768), b2, n2); }
      { const Prm p = PRM(); run_gemm(shm, p.Akv, p.WukvT + (size_t)l * 1024 * 256, MR, 1024, 256, epi_bf16(p.KV, 1024), b2, n2); }
      { const Prm p = PRM(); run_gemm(shm, p.DFTM, p.PQT, 4096, 4096, 8192, epi_bf16(p.Y + 1536, DM, 512, (size_t)LT * DM), b2, n2); }
      if (l == 0) { const Prm p = PRM(); run_gemm(shm, p.DFTC, p.PQTc, 256, 4096, 512, epi_bf16(p.Y + (size_t)LL * DM + 1536, DM, 512, (size_t)LT * DM), b2, n2); }
    }
    GRID_BAR();
    { const Prm p = PRM(); st_attn(p, l, (char*)shm, bid, nb); }
    { const Prm p = PRM(); st_combine(p, l, bid, nb); }
    GRID_BAR();
    { const Prm p = PRM(); EpiResid e; e.xlat = p.x; e.xctx = p.ctx; e.X = p.X; e.modl = p.mod + (size_t)l * 9 * NMOD; e.first = l == 0;
      run_gemm(shm, p.Y, p.WoutT + (size_t)l * DM * DM, MR, DM, DM, e, bid, nb); }
    GRID_BAR();
    { const Prm p = PRM(); st_modulate(p, l, 1, p.H2, bid, nb); }
    GRID_BAR();
    { const Prm p = PRM(); run_gemm(shm, p.H2, p.WqT + (size_t)l * DM * DM, MR, DM, DM, epi_bf16(p.Qp, DM), bid, nb); }
    GRID_BAR();
    { const Prm p = PRM(); st_peertopk(p, l, shm, bid, nb); }
    GRID_BAR();
    { const Prm p = PRM(); st_peergather(p, l, lf, bid, nb); }
    GRID_BAR();
  }
  { const Prm p = PRM(); st_final(p, bid, nb); }
#endif
#undef bid
#undef nb
#undef GRID_BAR
}

static size_t al256(size_t x) { return (x + 255) / 256 * 256; }
extern "C" void kernel_launch(void* const* d_in, const int* in_sizes, int n_in, void* d_out, int out_size, void* d_ws, size_t ws_size, hipStream_t stream) {
  Prm p{};
  const float** f = (const float**)&p.x;
  for (int i = 0; i < 24; ++i) f[i] = (const float*)d_in[i];
  p.out = (float*)d_out;
  char* w = (char*)d_ws; size_t o = 0;
  auto take = [&](size_t bytes) { char* r = w + o; o += al256(bytes); return r; };
  p.bar = (unsigned*)take(16384);
  p.WinT = (bf16_t*)take((size_t)2 * NZ * DM * 2); p.WoutT = (bf16_t*)take((size_t)2 * DM * DM * 2); p.WqT = (bf16_t*)take((size_t)2 * DM * DM * 2);
  p.WuqT = (bf16_t*)take((size_t)2 * 768 * 512 * 2); p.WukvT = (bf16_t*)take((size_t)2 * 1024 * 256 * 2);
  p.mod = (float*)take((size_t)2 * 9 * NMOD * 4); p.GB = (float*)take((size_t)MR * 16 * 4); p.CCS = (float*)take((size_t)2 * 128 * 128 * 4);
  p.DFTM = (bf16_t*)take((size_t)4096 * 8192 * 2); p.DFTC = (bf16_t*)take((size_t)256 * 512 * 2);
  p.X = (float*)take((size_t)MR * DM * 4);
  p.Z = (bf16_t*)take((size_t)MR * NZ * 2);
  char* ra = take((size_t)MR * 1536 * 2 + (size_t)4 * MR * 512 * 2);
  p.DNQ = (bf16_t*)ra; p.OB = (bf16_t*)(ra + (size_t)MR * 1536 * 2); p.H = (bf16_t*)ra;
  p.KV = (bf16_t*)take((size_t)MR * 1024 * 2); p.KR = (bf16_t*)take((size_t)MR * 64 * 2);
  if (o > ws_size) return;
  char* q = (char*)d_out; size_t oo = 0;
  p.Y = (bf16_t*)q; oo += (size_t)MR * DM * 2; p.PQT = (bf16_t*)(q + oo); oo += (size_t)8 * 512 * 8192 * 2; p.PQTc = (bf16_t*)(q + oo); oo += (size_t)8 * 512 * 512 * 2;
  p.Qraw = (bf16_t*)(q + oo); oo += (size_t)MR * 768 * 2;
  p.Aq = (bf16_t*)q; p.Akv = (bf16_t*)(q + (size_t)MR * 512 * 2);
  char* z = (char*)p.Z; p.H2 = (bf16_t*)z; p.Qp = (bf16_t*)(z + (size_t)MR * DM * 2); p.IDX = (int*)(z + (size_t)2 * MR * DM * 2); p.GATE = (float*)(z + (size_t)2 * MR * DM * 2 + (size_t)MR * 128 * 4);

  static int grid = 0;
  if (!grid) {
    (void)hipFuncSetAttribute((const void*)mega, hipFuncAttributeMaxDynamicSharedMemorySize, LDS_TOTAL);
    int dev = 0, cus = 0, per_cu = 0;
    (void)hipGetDevice(&dev); (void)hipDeviceGetAttribute(&cus, hipDeviceAttributeMultiprocessorCount, dev);
    (void)hipOccupancyMaxActiveBlocksPerMultiprocessor(&per_cu, (const void*)mega, NTHR, LDS_TOTAL);
    grid = per_cu >= 1 ? cus : 0;
    if (grid > 256) grid = 256;
  }
  if (grid < 256) return;
  (void)hipMemsetAsync(p.bar, 0, XCD_BAR_WORDS * sizeof(unsigned), stream);
  hipLaunchKernelGGL(mega, dim3(grid), dim3(NTHR), LDS_TOTAL, stream, p);
}
```

```cpp
#include <hip/hip_runtime.h>
#include <stdint.h>

constexpr int DM = 2048, NB = 8, LL = 4096, LCX = 256, LT = LL + LCX  , MR = NB * LT  ;
constexpr int NZ = 4864;
constexpr int C_DNQ = 0, C_DNK = 512, C_DNV = 1024, C_DNGATE = 1536, C_DNA = 2048, C_DNB = 2056, C_GQ = 2064, C_GK = 2320, C_GV = 2576,
              C_GGATE = 3088, C_GALPHA = 3600, C_CQ = 3632, C_CKV = 4080, C_KR = 4208, C_FN = 4272, IN_W = 4784;
constexpr int NMOD = 6 * DM;
constexpr float EPSV = 1e-6f;
constexpr int NTHR = 512;

typedef unsigned short bf16_t;
typedef short bf16x8 __attribute__((ext_vector_type(8)));
typedef short s16x4 __attribute__((ext_vector_type(4)));
typedef float f32x4 __attribute__((ext_vector_type(4)));
typedef float f32x16 __attribute__((ext_vector_type(16)));
typedef unsigned u32x4 __attribute__((ext_vector_type(4)));
typedef unsigned u32x2 __attribute__((ext_vector_type(2)));

#define DI __device__ __forceinline__
DI float bf2f(bf16_t b) { return __uint_as_float(((unsigned)b) << 16); }
DI bf16_t f2bf(float f) { unsigned u = __float_as_uint(f); u += 0x7FFFu + ((u >> 16) & 1u); return (bf16_t)(u >> 16); }
DI unsigned pack2(float lo, float hi) { return (unsigned)f2bf(lo) | ((unsigned)f2bf(hi) << 16); }
DI float wsum(float v) { for (int o = 32; o >= 1; o >>= 1) v += __shfl_xor(v, o); return v; }
DI float wmax(float v) { for (int o = 32; o >= 1; o >>= 1) v = fmaxf(v, __shfl_xor(v, o)); return v; }
DI float siluf(float x) { return x / (1.f + __expf(-x)); }
DI float sigmf(float x) { return 1.f / (1.f + __expf(-x)); }

DI int ltid() { int t = (int)threadIdx.x; asm volatile("" : "+v"(t)); return t; }
DI int lsg(int v) { asm volatile("" : "+s"(v)); return v; }

struct Prm {
  const float *x, *c, *ctx, *c_ctx, *w_ada, *b_ada, *w_in, *dn_conv, *dn_a_log, *dn_dt_bias, *dn_norm, *gla_w2, *gla_b2, *gla_norm,
      *mla_q_norm, *mla_w_uq, *mla_kv_norm, *mla_w_ukv, *w_out, *peer_wq, *peer_keys, *peer_u, *peer_v, *final_norm;
  float* out;
  bf16_t *WinT, *WoutT, *WqT, *WuqT, *WukvT;
  float *mod, *GB, *CCS;
  bf16_t *DFTM, *DFTC;
  float* X;
  bf16_t* Z;
  bf16_t *H, *DNQ, *OB;
  bf16_t *KV, *KR;
  bf16_t *Y, *PQT, *PQTc, *Qraw, *Aq, *Akv;
  bf16_t *H2, *Qp;
  bf16_t *Ub, *Vb;
  int* IDX;
  float* GATE;
  unsigned* bar;
};
#define XB_TMO      128
#define XB_XCNT(j)  (256  + 64 * (j))
#define XB_XSUB(j)  (1280 + 64 * (j))
#define XB_XGEN(j)  (2304 + 64 * (j))
#define XB_TOP      3328
#define XB_TOPGEN   3392
#define XCD_BAR_WORDS 3456
#define XB_SPIN_CAP (1u << 18)
#define LAS __attribute__((address_space(3)))

__device__ __forceinline__ unsigned xb_ld(unsigned* p)              { return __hip_atomic_load(p, __ATOMIC_RELAXED, __HIP_MEMORY_SCOPE_AGENT); }
__device__ __forceinline__ unsigned xb_add(unsigned* p, unsigned v) { return __hip_atomic_fetch_add(p, v, __ATOMIC_RELAXED, __HIP_MEMORY_SCOPE_AGENT); }
__device__ __forceinline__ unsigned xb_xcc_id() { return (unsigned)__builtin_amdgcn_s_getreg((3 << 11) | 20) & 0xFu; }
#define XB_SPIN(cond, bar) do { unsigned _sp = 0; while (cond) { __builtin_amdgcn_s_sleep(1); \
    if ((++_sp & 255u) == 0u) { if (xb_ld(&(bar)[XB_TMO])) break; if (_sp > XB_SPIN_CAP) { atomicAdd(&(bar)[XB_TMO], 1u); break; } } } } while (0)

struct XcdBarrier {
    unsigned* bar; unsigned x;
    volatile LAS unsigned* st;
};

__device__ __forceinline__ XcdBarrier xcd_barrier_post(unsigned* bar, volatile LAS unsigned* st) {
    XcdBarrier b; b.bar = bar; b.x = xb_xcc_id(); b.st = st;
    if (threadIdx.x == 0) (void)xb_add(&bar[XB_XCNT(b.x)], 1u);
    return b;
}
__device__ __forceinline__ void xcd_barrier_complete(unsigned* bar, unsigned x, unsigned& nloc, unsigned& nx) {
    const unsigned G = gridDim.x * gridDim.y * gridDim.z;
    unsigned sum, cnt, mine, sp = 0u;
    for (;;) {
        sum = 0u; cnt = 0u; mine = 0u;
#pragma unroll
        for (unsigned j = 0; j < 16; ++j) { const unsigned c = xb_ld(&bar[XB_XCNT(j)]); sum += c; cnt += (c > 0u) ? 1u : 0u; mine = (j == x) ? c : mine; }
        if (sum == G) break;
        __builtin_amdgcn_s_sleep(1);
        if ((++sp & 255u) == 0u) { if (xb_ld(&bar[XB_TMO])) break; if (sp > XB_SPIN_CAP) { atomicAdd(&bar[XB_TMO], 1u); break; } }
    }
    nloc = mine > 0u ? mine : 1u; nx = cnt > 0u ? cnt : 1u;
}

__device__ __forceinline__ void xcd_barrier(const XcdBarrier& b) {
    asm volatile("s_waitcnt vmcnt(0)" ::: "memory");
    __syncthreads();
    if (threadIdx.x == 0) {
        unsigned* bar = b.bar;
        __builtin_amdgcn_s_waitcnt(0);
        unsigned nloc = b.st[0], nx = b.st[1];
        if (nloc == 0u) { xcd_barrier_complete(bar, b.x, nloc, nx); b.st[0] = nloc; b.st[1] = nx; }
        const unsigned old = xb_add(&bar[XB_XSUB(b.x)], 1u);
        const unsigned gen = old / nloc;
        if (old + 1u == (gen + 1u) * nloc) {
            __builtin_amdgcn_fence(__ATOMIC_RELEASE, "agent");
            asm volatile("s_waitcnt vmcnt(0)" ::: "memory");
            const unsigned og = xb_add(&bar[XB_TOP], 1u);
            const unsigned tg = og / nx;
            if (og + 1u == (tg + 1u) * nx) xb_add(&bar[XB_TOPGEN], 1u);
            else XB_SPIN(xb_ld(&bar[XB_TOPGEN]) == tg, bar);
            __builtin_amdgcn_fence(__ATOMIC_ACQUIRE, "agent");
            xb_add(&bar[XB_XGEN(b.x)], 1u);
            asm volatile("s_waitcnt vmcnt(0)" ::: "memory");
        } else {
            XB_SPIN(xb_ld(&bar[XB_XGEN(b.x)]) == gen, bar);
            __builtin_amdgcn_fence(__ATOMIC_ACQUIRE, "agent");
            asm volatile("s_waitcnt vmcnt(0)" ::: "memory");
        }
    }
    __syncthreads();
}

namespace pg8 {
#define PG8_LAS __attribute__((address_space(3)))
typedef unsigned short bf16_t;
typedef short bf16x8 __attribute__((ext_vector_type(8)));
typedef float f32x4 __attribute__((ext_vector_type(4)));
typedef unsigned u32x4 __attribute__((ext_vector_type(4)));
constexpr int BM = 256, BK = 64, HALF = 128, HTB = HALF * BK * 2  , STAGE_BYTES = 8 * HTB, NXCD = 8, WGM = 8;

__host__ __device__ __forceinline__ int lds_byte(int r, int c) { const int st = (r >> 4) * 2 + (c >> 5), rr = r & 15, cc = c & 31, ob = rr * 64 + cc * 2; return st * 1024 + (ob ^ (((ob >> 9) & 1) << 5)); }
__host__ __device__ __forceinline__ void stage_rc(int b, int& R, int& C) { const int st = b / 1024, sb = b % 1024, swz = sb ^ (((sb >> 9) & 1) << 5); R = (st >> 1) * 16 + swz / 64; C = (st & 1) * 32 + (swz % 64) / 2; }
__host__ __device__ __forceinline__ int perm32(int rho) { const int n = rho >> 4, i = rho & 15; return 8 * (i >> 2) + 4 * n + (i & 3); }

struct Unit { int pm, pn; };
struct Gemm { const bf16_t* A; const bf16_t* Bt; int M, N, K; };

struct StaticOrder {
    int nM, nN, nwg, G, c;
    __host__ __device__ void init(int M, int N, int G_, int c_) { nM = M / BM; nN = N / BM; nwg = nM * nN; G = G_; c = c_; }
    __host__ __device__ bool next(int i, Unit& u) const {
        const long L = (long)i * G + c; if (L >= nwg) return false;
        int wgid = (int)L; { const int q = nwg / NXCD, r = nwg % NXCD, xcd = wgid % NXCD, off = wgid / NXCD; wgid = (xcd < r ? xcd * (q + 1) : r * (q + 1) + (xcd - r) * q) + off; }
        const int nig = WGM * nN, gid = wgid / nig, fm = gid * WGM, gsz = (nM - fm) < WGM ? (nM - fm) : WGM;
        u.pm = fm + ((wgid % nig) % gsz); u.pn = (wgid % nig) / gsz; return true;
    }
    __device__ __forceinline__ void a_ready(const Unit&) const {}
    __device__ __forceinline__ void done(const Unit&) const {}
};
struct CountedOrder : StaticOrder {
    const unsigned* ready; unsigned need; unsigned* tmo;
    __device__ __forceinline__ void a_ready(const Unit& u) const {
        if (threadIdx.x < 64) {
            const unsigned long long t0 = __builtin_amdgcn_s_memrealtime(); unsigned polls = 0;
            while ((unsigned)__builtin_amdgcn_readfirstlane(__hip_atomic_load(ready + 64 * u.pm, __ATOMIC_RELAXED, __HIP_MEMORY_SCOPE_AGENT)) < need) {
                if ((++polls & 255u) == 0u && __builtin_amdgcn_readfirstlane(__hip_atomic_load(tmo, __ATOMIC_RELAXED, __HIP_MEMORY_SCOPE_AGENT)) != 0u) break;
                if (__builtin_amdgcn_s_memrealtime() - t0 > 2000000ull) {
                    if (threadIdx.x == 0) { unsigned expect = 0u; __hip_atomic_compare_exchange_strong(tmo + 1, &expect, 0x600u | (unsigned)(u.pm & 0xff), __ATOMIC_RELAXED, __ATOMIC_RELAXED, __HIP_MEMORY_SCOPE_AGENT); __hip_atomic_store(tmo, 1u, __ATOMIC_RELAXED, __HIP_MEMORY_SCOPE_AGENT); }
                    break; }
                __builtin_amdgcn_s_sleep(2); }
            __builtin_amdgcn_fence(__ATOMIC_ACQUIRE, "agent");
            asm volatile("s_waitcnt vmcnt(0)" ::: "memory");
        }
#if !defined(BROKEN_HOOK_NO_BARRIER)
        asm volatile("" ::: "memory"); __builtin_amdgcn_s_barrier(); asm volatile("" ::: "memory");
#endif
    }
};

__device__ __forceinline__ unsigned cvt_pk_bf16(float lo, float hi) { unsigned r; asm volatile("v_cvt_pk_bf16_f32 %0, %1, %2" : "=v"(r) : "v"(lo), "v"(hi)); return r; }
typedef float f32x2 __attribute__((ext_vector_type(2)));
__device__ __forceinline__ f32x2 gelu_pk(f32x2 v) {
    const f32x2 av = __builtin_elementwise_abs(v), d = av * 0.2316418882f + 1.0f;
    f32x2 t; t.x = __builtin_amdgcn_rcpf(d.x); t.y = __builtin_amdgcn_rcpf(d.y);
    f32x2 q = t * 0.5307027145f + (-0.7265760135f); q = q * t + 0.7107068705f; q = q * t + (-0.142248368f); q = q * t + 0.127414796f; q = q * t;
    const f32x2 s = (v * v) * (-0.72134752044f);
    f32x2 e; e.x = __builtin_amdgcn_exp2f(s.x); e.y = __builtin_amdgcn_exp2f(s.y);
    const f32x2 m = v * (q * e), r = v - m;
    f32x2 o; o.x = v.x < 0.f ? m.x : r.x; o.y = v.y < 0.f ? m.y : r.y; return o;
}

struct EpiF32 {
    static constexpr bool PERM = false, AFTER_DRAIN = false;
    float* C; int ldc; const float* bias;
    __device__ __forceinline__ void operator()(const f32x4 (&acc)[2][2][4][2], const Unit& u, int wr, int wc, int fr, int fq) const {
        const int row0 = u.pm * BM + wr * 64 + fr, col0 = u.pn * BM + wc * 32 + 4 * fq;
        f32x4 bv[2][2];
#pragma unroll
        for (int bj = 0; bj < 2; ++bj)
#pragma unroll
            for (int n = 0; n < 2; ++n) bv[bj][n] = bias ? *(const f32x4*)(bias + col0 + bj * HALF + n * 16) : (f32x4){0.f, 0.f, 0.f, 0.f};
#pragma unroll
        for (int ai = 0; ai < 2; ++ai)
#pragma unroll
            for (int m = 0; m < 4; ++m) { float* rowp = C + (size_t)(row0 + ai * HALF + m * 16) * ldc + col0;
#pragma unroll
                for (int bj = 0; bj < 2; ++bj)
#pragma unroll
                    for (int n = 0; n < 2; ++n) *(f32x4*)(rowp + bj * HALF + n * 16) = acc[ai][bj][m][n] + bv[bj][n]; }
    }
};
template <int ACT  > struct EpiBf16 {
    static constexpr bool PERM = true, AFTER_DRAIN = false;
    bf16_t* O; int ldc; const float* bias; int split_cols; size_t split_stride;
    __device__ __forceinline__ void operator()(const f32x4 (&acc)[2][2][4][2], const Unit& u, int wr, int wc, int fr, int fq) const {
        const int row0 = u.pm * BM + wr * 64 + fr; int colt = u.pn * BM; bf16_t* base = O;
        if (split_cols) { const int t = colt / split_cols; base += (size_t)t * split_stride; colt -= t * split_cols; }
        const int col0 = colt + wc * 32 + 8 * fq, bcol0 = u.pn * BM + wc * 32 + 8 * fq;
        f32x4 bv[2][2];
#pragma unroll
        for (int bj = 0; bj < 2; ++bj)
#pragma unroll
            for (int n = 0; n < 2; ++n) bv[bj][n] = bias ? *(const f32x4*)(bias + bcol0 + bj * HALF + 4 * n) : (f32x4){0.f, 0.f, 0.f, 0.f};
#pragma unroll
        for (int ai = 0; ai < 2; ++ai)
#pragma unroll
            for (int m = 0; m < 4; ++m) { bf16_t* rowp = base + (size_t)(row0 + ai * HALF + m * 16) * ldc + col0;
#pragma unroll
                for (int bj = 0; bj < 2; ++bj) { f32x4 v0 = acc[ai][bj][m][0] + bv[bj][0], v1 = acc[ai][bj][m][1] + bv[bj][1];
                    if (ACT == 1) { f32x2 a = gelu_pk((f32x2){v0[0], v0[1]}), b = gelu_pk((f32x2){v0[2], v0[3]}), c = gelu_pk((f32x2){v1[0], v1[1]}), d = gelu_pk((f32x2){v1[2], v1[3]});
                        v0 = (f32x4){a.x, a.y, b.x, b.y}; v1 = (f32x4){c.x, c.y, d.x, d.y}; }
                    if (ACT == 2) {
#pragma unroll
                        for (int j = 0; j < 4; ++j) { v0[j] = 0.5f * v0[j] * (1.0f + erff(v0[j] * 0.70710678f)); v1[j] = 0.5f * v1[j] * (1.0f + erff(v1[j] * 0.70710678f)); } }
                    u32x4 w; w.x = cvt_pk_bf16(v0[0], v0[1]); w.y = cvt_pk_bf16(v0[2], v0[3]); w.z = cvt_pk_bf16(v1[0], v1[1]); w.w = cvt_pk_bf16(v1[2], v1[3]);
                    *(u32x4*)(rowp + bj * HALF) = w; } }
    }
};
template <class Epi, class Sched, bool STAMP = false>
__device__ __forceinline__ void gemm_phase(PG8_LAS unsigned char* lds, const Gemm g, const Sched& S, const Epi& E, unsigned long long* stamps) {
    const int tid = ltid(), wid = __builtin_amdgcn_readfirstlane(tid >> 6), lane = tid & 63, wr = wid >> 2, wc = wid & 3, fr = lane & 15, fq = lane >> 4;
    const int K = g.K, nt = K / BK;
    int ts_lo = 0, ts_hi = 0, nts = 0; const unsigned long long rt_entry = STAMP ? (unsigned long long)wall_clock64() : 0ull;
#define PG8_STAMP() do { if (STAMP && wid == 0 && nts < 64) { const unsigned long long _c = (unsigned long long)clock64(); \
        ts_lo = (lane == nts) ? (int)(unsigned)_c : ts_lo; ts_hi = (lane == nts) ? (int)(unsigned)(_c >> 32) : ts_hi; ++nts; } } while (0)
    PG8_STAMP();
    unsigned voffA[2], voffB[2];
#pragma unroll
    for (int i = 0; i < 2; ++i) { int R, C; stage_rc(tid * 16 + i * 8192, R, C); const int Rb = Epi::PERM ? ((R & ~31) + perm32(R & 31)) : R;
        voffA[i] = (unsigned)(R * K + C) * 2u; voffB[i] = (unsigned)(Rb * K + C) * 2u; }
    const size_t kstep = (size_t)(BK * 2);
    const size_t hstep = (size_t)HALF * K * 2;
    const size_t tstep = 2 * hstep;
    const unsigned ldsw = (unsigned)wid * 1024u;
    const int aoff = lds_byte(wr * 64 + fr, fq * 8), boff = lds_byte(wc * 32 + fr, fq * 8);
#define PG8_SA(b, h) (((b) * 2 + (h)) * HTB)
#define PG8_SB(b, h) ((4 + (b) * 2 + (h)) * HTB)
#define PG8_STAGE(bufoff, gbase, voff) do { _Pragma("unroll") for (int _i = 0; _i < 2; ++_i) \
        __builtin_amdgcn_global_load_lds((const unsigned*)((const char*)(gbase) + (voff)[_i]), (PG8_LAS unsigned*)(lds + (bufoff) + ldsw + _i * 8192), 16, 0, 0); } while (0)
#define PG8_LDA(dst, b, h) do { _Pragma("unroll") for (int m = 0; m < 4; ++m) _Pragma("unroll") for (int k = 0; k < 2; ++k) dst[m][k] = *(const PG8_LAS bf16x8*)(lds + PG8_SA(b, h) + aoff + m * 2048 + k * 1024); } while (0)
#define PG8_LDB(dst, b, h) do { _Pragma("unroll") for (int n = 0; n < 2; ++n) _Pragma("unroll") for (int k = 0; k < 2; ++k) dst[n][k] = *(const PG8_LAS bf16x8*)(lds + PG8_SB(b, h) + boff + n * 2048 + k * 1024); } while (0)
#define PG8_MMA(ai, bj, At, Bt) do { __builtin_amdgcn_s_setprio(1); _Pragma("unroll") for (int m = 0; m < 4; ++m) _Pragma("unroll") for (int n = 0; n < 2; ++n) _Pragma("unroll") for (int k = 0; k < 2; ++k) \
        acc[ai][bj][m][n] = __builtin_amdgcn_mfma_f32_16x16x32_bf16(Bt[n][k], At[m][k], acc[ai][bj][m][n], 0, 0, 0); __builtin_amdgcn_s_setprio(0); } while (0)
#define PG8_WAIT_V(n) asm volatile("s_waitcnt vmcnt(" #n ")" ::: "memory")
#define PG8_WAIT_L(n) asm volatile("s_waitcnt lgkmcnt(" #n ")" ::: "memory")
#define PG8_BAR __builtin_amdgcn_s_barrier()
#define PG8_SCHED __builtin_amdgcn_sched_barrier(0)
    Unit cur, nxt; int ui = 0;
    if (!S.next(0, cur)) return;
    f32x4 acc[2][2][4][2];
#pragma unroll
    for (int a = 0; a < 2; ++a)
#pragma unroll
        for (int b = 0; b < 2; ++b)
#pragma unroll
            for (int m = 0; m < 4; ++m)
#pragma unroll
                for (int n = 0; n < 2; ++n) acc[a][b][m][n] = (f32x4){0.f, 0.f, 0.f, 0.f};
    bf16x8 At[4][2], B0[2][2], B1[2][2];
    const char* cA = (const char*)g.A + (size_t)cur.pm * tstep; const char* cB = (const char*)g.Bt + (size_t)cur.pn * tstep;
    S.a_ready(cur);
    PG8_STAGE(PG8_SB(0, 0), cB, voffB); PG8_STAGE(PG8_SA(0, 0), cA, voffA); PG8_STAGE(PG8_SB(0, 1), cB + hstep, voffB); PG8_STAGE(PG8_SA(0, 1), cA + hstep, voffA);
    if (wr == 1) PG8_BAR;
    PG8_WAIT_V(4); PG8_BAR;
    PG8_STAGE(PG8_SB(1, 0), cB + kstep, voffB); PG8_STAGE(PG8_SA(1, 0), cA + kstep, voffA); PG8_STAGE(PG8_SB(1, 1), cB + hstep + kstep, voffB);
    PG8_WAIT_V(6); PG8_BAR;
    PG8_STAMP();
    for (;;) {
        const bool has_next = S.next(ui + 1, nxt);
        const char* nA = has_next ? (const char*)g.A + (size_t)nxt.pm * tstep : cA; const char* nB = has_next ? (const char*)g.Bt + (size_t)nxt.pn * tstep : cB;
        for (int t = 0; t < nt; t += 2) {
            const bool last = (t == nt - 2);
            const char* a1 = cA + (size_t)(t + 1) * kstep;
            const char* a2 = last ? nA : cA + (size_t)(t + 2) * kstep; const char* b2 = last ? nB : cB + (size_t)(t + 2) * kstep;
            const char* a3 = a2 + kstep; const char* b3 = b2 + kstep;
            if (last && has_next) S.a_ready(nxt);
            PG8_LDB(B0, 0, 0); PG8_SCHED; PG8_LDA(At, 0, 0); PG8_STAGE(PG8_SA(1, 1), a1 + hstep, voffA);
            PG8_WAIT_L(8); PG8_BAR; PG8_WAIT_L(0); PG8_MMA(0, 0, At, B0); PG8_BAR; PG8_SCHED;
            PG8_LDB(B1, 0, 1); PG8_STAGE(PG8_SB(0, 0), b2, voffB);
            PG8_BAR; PG8_WAIT_L(0); PG8_MMA(0, 1, At, B1); PG8_BAR;
            PG8_LDA(At, 0, 1); PG8_STAGE(PG8_SA(0, 0), a2, voffA);
            PG8_BAR; PG8_WAIT_L(0); PG8_MMA(1, 0, At, B0); PG8_BAR; PG8_SCHED;
            PG8_STAGE(PG8_SB(0, 1), b2 + hstep, voffB);
            PG8_WAIT_V(6); PG8_BAR; PG8_MMA(1, 1, At, B1); PG8_BAR;
            PG8_LDB(B0, 1, 0); PG8_SCHED; PG8_LDA(At, 1, 0); PG8_STAGE(PG8_SA(0, 1), a2 + hstep, voffA);
            PG8_WAIT_L(8); PG8_BAR; PG8_WAIT_L(0); PG8_MMA(0, 0, At, B0); PG8_BAR; PG8_SCHED;
            PG8_LDB(B1, 1, 1); PG8_STAGE(PG8_SB(1, 0), b3, voffB);
            PG8_BAR; PG8_WAIT_L(0); PG8_MMA(0, 1, At, B1); PG8_BAR;
            PG8_LDA(At, 1, 1); PG8_STAGE(PG8_SA(1, 0), a3, voffA);
            PG8_BAR; PG8_WAIT_L(0); PG8_MMA(1, 0, At, B0); PG8_BAR; PG8_SCHED;
            PG8_STAGE(PG8_SB(1, 1), b3 + hstep, voffB);
            PG8_WAIT_V(6); PG8_BAR; PG8_MMA(1, 1, At, B1); PG8_BAR;
        }
        PG8_STAMP();
        if constexpr (!Epi::AFTER_DRAIN) { E(acc, cur, wr, wc, fr, fq); S.done(cur); }
        PG8_STAMP();
        if (!has_next) break;
#pragma unroll
        for (int a = 0; a < 2; ++a)
#pragma unroll
            for (int b = 0; b < 2; ++b)
#pragma unroll
                for (int m = 0; m < 4; ++m)
#pragma unroll
                    for (int n = 0; n < 2; ++n) acc[a][b][m][n] = (f32x4){0.f, 0.f, 0.f, 0.f};
        cur = nxt; cA = nA; cB = nB; ++ui;
    }
    PG8_WAIT_V(0);
    if (wr == 0) PG8_BAR;
    PG8_BAR;
    if constexpr (Epi::AFTER_DRAIN) { E.fused(acc, cur, wr, wc, fr, fq, lds, wid, lane); S.done(cur); }
    PG8_STAMP();
    if (STAMP && wid == 0) { stamps[lane] = lane < nts ? (((unsigned long long)(unsigned)ts_hi << 32) | (unsigned)ts_lo) : 0ull;
        if (lane == 62) stamps[62] = rt_entry; if (lane == 63) stamps[63] = (unsigned long long)wall_clock64(); }
#undef PG8_STAMP
#undef PG8_SA
#undef PG8_SB
#undef PG8_STAGE
#undef PG8_LDA
#undef PG8_LDB
#undef PG8_MMA
#undef PG8_WAIT_V
#undef PG8_WAIT_L
#undef PG8_BAR
#undef PG8_SCHED
}
}

DI void st_transpose(const float* __restrict__ src, bf16_t* __restrict__ dst, int K, int N, int Kpad, int Npad, float* lds, int bid, int nb) {
  const int tk = Kpad / 64, tn = Npad / 64;
  for (int it = bid; it < tk * tn; it += nb) {
    const int k0 = (it % tk) * 64, n0 = (it / tk) * 64;
    __syncthreads();
    for (int e = ltid(); e < 4096; e += NTHR) { const int i = e >> 6, j = e & 63, k = k0 + i, n = n0 + j; lds[i * 65 + j] = (k < K && n < N) ? src[(size_t)k * N + n] : 0.f; }
    __syncthreads();
    for (int e = ltid(); e < 4096; e += NTHR) { const int j = e >> 6, i = e & 63; dst[(size_t)(n0 + j) * Kpad + k0 + i] = f2bf(lds[i * 65 + j]); }
  }
}

DI void st_mods(const Prm& p, float* lds, int bid, int nb) {
  float* s = lds; float* red = lds + 9 * 2048;
  for (int e = ltid(); e < 9 * 2048; e += NTHR) { const int r = e >> 11, k = e & 2047; const float v = r < 8 ? p.c[r * 2048 + k] : p.c_ctx[k]; s[e] = siluf(v); }
  __syncthreads();
  const int kg = ltid() >> 6, cl = ltid() & 63;
  for (int it = bid; it < 2 * 192; it += nb) {
    const int l = it / 192, cb = (it % 192) * 64;
    const float* w = p.w_ada + (size_t)l * 2048 * NMOD + cb + cl;
    float acc[9];
#pragma unroll
    for (int r = 0; r < 9; ++r) acc[r] = 0.f;
    for (int k = kg * 256; k < kg * 256 + 256; ++k) { const float wv = w[(size_t)k * NMOD];
#pragma unroll
      for (int r = 0; r < 9; ++r) acc[r] += s[r * 2048 + k] * wv; }
#pragma unroll
    for (int r = 0; r < 9; ++r) red[(kg * 9 + r) * 64 + cl] = acc[r];
    __syncthreads();
    for (int e = ltid(); e < 576; e += NTHR) { const int r = e >> 6, c2 = e & 63; float t = 0.f;
      for (int g = 0; g < 8; ++g) t += red[(g * 9 + r) * 64 + c2];
      p.mod[((size_t)l * 9 + r) * NMOD + cb + c2] = t + p.b_ada[l * NMOD + cb + c2]; }
    __syncthreads();
  }
}

DI void st_tables(const Prm& p, int bid, int nb) {
  const size_t stride = (size_t)nb * NTHR, t0 = (size_t)bid * NTHR + ltid();
  for (size_t e = t0; e < (size_t)4096 * 8192; e += stride) { const int k1 = (int)(e >> 13), n = (int)(e & 8191), n1 = n & 4095, idx = (k1 * n1) & 4095;
    float sv, cv; sincosf((float)idx * (6.283185307179586f / 4096.f), &sv, &cv); p.DFTM[e] = f2bf((n < 4096 ? cv : -sv) * (1.f / 64.f)); }
  for (size_t e = t0; e < (size_t)256 * 512; e += stride) { const int k1 = (int)(e >> 9), n = (int)(e & 511), n1 = n & 255, idx = (k1 * n1) & 255;
    float sv, cv; sincosf((float)idx * (6.283185307179586f / 256.f), &sv, &cv); p.DFTC[e] = f2bf((n < 256 ? cv : -sv) * (1.f / 16.f)); }
  for (size_t e = t0; e < (size_t)2 * 128 * 128; e += stride) { const int tb = (int)(e >> 14), k2 = (int)((e >> 7) & 127), n2 = (int)(e & 127), idx = (k2 * n2) & 127;
    float sv, cv; sincosf((float)idx * (6.283185307179586f / 128.f), &sv, &cv); p.CCS[e] = (tb ? sv : cv) * 0.08838834764831845f; }
}

DI void st_modulate(const Prm& p, int layer, int which, bf16_t* __restrict__ dst, int bid, int nb) {
  const int wave = ltid() >> 6, lane = ltid() & 63;
  const int shoff = which ? 3 * DM : 0, scoff = which ? 4 * DM : DM;
  for (int row = bid * 8 + wave; row < MR; row += nb * 8) {
    const int b = row / LT, t = row - b * LT; const bool isc = t >= LL;
    const float* src = (layer == 0 && which == 0) ? (isc ? p.ctx + (size_t)(b * LCX + t - LL) * DM : p.x + (size_t)(b * LL + t) * DM) : p.X + (size_t)row * DM;
    f32x4 v[8]; float ss = 0.f;
#pragma unroll
    for (int i = 0; i < 8; ++i) { v[i] = *(const f32x4*)(src + (i * 64 + lane) * 4); ss += v[i][0] * v[i][0] + v[i][1] * v[i][1] + v[i][2] * v[i][2] + v[i][3] * v[i][3]; }
    ss = wsum(ss); const float rstd = rsqrtf(ss * (1.f / 2048.f) + EPSV);
    const float* mr = p.mod + ((size_t)layer * 9 + (isc ? 8 : b)) * NMOD;
#pragma unroll
    for (int i = 0; i < 8; ++i) { const int col = (i * 64 + lane) * 4; const f32x4 sc = *(const f32x4*)(mr + scoff + col), sh = *(const f32x4*)(mr + shoff + col);
      const f32x4 o = v[i] * rstd * (sc + 1.f) + sh; u32x2 w; w.x = pack2(o[0], o[1]); w.y = pack2(o[2], o[3]); *(u32x2*)(dst + (size_t)row * DM + col) = w; }
  }
}

DI void st_dnprep(const Prm& p, int layer, int bid, int nb) {
  const int wave = ltid() >> 6, lane = ltid() & 63;
  const float* conv = p.dn_conv + (size_t)layer * 5 * 1536;
  for (long task = (long)bid * 8 + wave; task < (long)MR * 13; task += (long)nb * 8) {
    const int row = (int)(task / 13), grp = (int)(task - (long)row * 13);
    const int b = row / LT, t = row - b * LT; const bool isc = t >= LL;
    const int segbase = isc ? b * LT + LL : b * LT, segt = isc ? t - LL : t, seglen = isc ? LCX : LL;
    if (grp < 12) {
      const int c = grp * 128 + lane * 2; float a0 = 0.f, a1 = 0.f;
#pragma unroll
      for (int j = 0; j < 5; ++j) { const int tt = segt + j - 2;
        if (tt >= 0 && tt < seglen) { const unsigned zz = *(const unsigned*)(p.Z + (size_t)(segbase + tt) * NZ + c);
          a0 += bf2f((bf16_t)(zz & 0xffffu)) * conv[j * 1536 + c]; a1 += bf2f((bf16_t)(zz >> 16)) * conv[j * 1536 + c + 1]; } }
      a0 = siluf(a0); a1 = siluf(a1);
      if (grp < 8) { const float ss = wsum(a0 * a0 + a1 * a1); const float sc = rsqrtf(ss + EPSV) * (grp < 4 ? 0.08838834764831845f : 1.f); a0 *= sc; a1 *= sc; }
      *(unsigned*)(p.DNQ + (size_t)row * 1536 + c) = pack2(a0, a1);
    } else if (lane < 16) {
      const int isb = lane >> 3, dh = lane & 7; const float z = bf2f(p.Z[(size_t)row * NZ + (isb ? C_DNB : C_DNA) + dh]); float o;
      if (!isb) { const float xx = z + p.dn_dt_bias[layer * 8 + dh]; const float sp = xx > 20.f ? xx : log1pf(expf(xx)); o = -expf(p.dn_a_log[layer * 8 + dh]) * sp; }
      else o = sigmf(z);
      p.GB[(size_t)row * 16 + lane] = o;
    }
  }
}

DI void st_mlaprep(const Prm& p, int layer, int bid, int nb) {
  const int wave = ltid() >> 6, lane = ltid() & 63;
  const float* qn = p.mla_q_norm + layer * 448; const float* kvn = p.mla_kv_norm + layer * 128;
  for (int row = bid * 8 + wave; row < MR; row += nb * 8) {
    const bf16_t* z = p.Z + (size_t)row * NZ; const int b = row / LT, t = row - b * LT;
    float v[7]; float ss = 0.f;
#pragma unroll
    for (int i = 0; i < 7; ++i) { v[i] = bf2f(z[C_CQ + i * 64 + lane]); ss += v[i] * v[i]; }
    ss = wsum(ss); float rstd = rsqrtf(ss * (1.f / 448.f) + EPSV);
#pragma unroll
    for (int i = 0; i < 7; ++i) p.Aq[(size_t)row * 512 + i * 64 + lane] = f2bf(v[i] * rstd * qn[i * 64 + lane]);
    p.Aq[(size_t)row * 512 + 448 + lane] = 0;
    const float u0 = bf2f(z[C_CKV + lane]), u1 = bf2f(z[C_CKV + 64 + lane]);
    ss = wsum(u0 * u0 + u1 * u1); rstd = rsqrtf(ss * (1.f / 128.f) + EPSV);
    p.Akv[(size_t)row * 256 + lane] = f2bf(u0 * rstd * kvn[lane]); p.Akv[(size_t)row * 256 + 64 + lane] = f2bf(u1 * rstd * kvn[64 + lane]);
    p.Akv[(size_t)row * 256 + 128 + lane] = 0; p.Akv[(size_t)row * 256 + 192 + lane] = 0;
    if (t < LL) {
      if (lane < 32) { const int half = lane >> 4, i = lane & 15; const float x1 = bf2f(z[C_KR + half * 32 + i]), x2 = bf2f(z[C_KR + half * 32 + 16 + i]);
        const float pos = (float)(half ? (t & 63) : (t >> 6)); const float ang = pos * exp2f(-(float)i * (13.287712379549449f / 16.f)); float sv, cv; sincosf(ang, &sv, &cv);
        p.KR[(size_t)row * 64 + half * 32 + i] = f2bf(x1 * cv - x2 * sv); p.KR[(size_t)row * 64 + half * 32 + 16 + i] = f2bf(x2 * cv + x1 * sv); }
    } else p.KR[(size_t)row * 64 + lane] = z[C_KR + lane];
  }
}

DI void st_qrope(const Prm& p, int bid, int nb) {
  const int wave = ltid() >> 6, lane = ltid() & 63;
  for (int row = bid * 8 + wave; row < MR; row += nb * 8) {
    const int b = row / LT, t = row - b * LT; if (t >= LL) continue;
#pragma unroll
    for (int k = 0; k < 2; ++k) { const int pid = lane + 64 * k, h = pid >> 5, r = pid & 31, half = r >> 4, i = r & 15;
      bf16_t* q = p.Qraw + (size_t)row * 768 + h * 192 + 128 + half * 32; const float x1 = bf2f(q[i]), x2 = bf2f(q[16 + i]);
      const float pos = (float)(half ? (t & 63) : (t >> 6)); const float ang = pos * exp2f(-(float)i * (13.287712379549449f / 16.f)); float sv, cv; sincosf(ang, &sv, &cv);
      q[i] = f2bf(x1 * cv - x2 * sv); q[16 + i] = f2bf(x2 * cv + x1 * sv); }
  }
}

DI void st_fnchan(const Prm& p, float* lds, int bid, int nb) {
  float* zt = lds;
  const int wave = __builtin_amdgcn_readfirstlane(ltid() >> 6), lane = ltid() & 63;
  for (int it = bid; it < (MR / 64) * 4; it += nb) {
    const int tile = it >> 2, g = it & 3, row0 = tile * 64, b = row0 / LT, t0 = row0 - b * LT;
    __syncthreads();
    for (int e = ltid(); e < 64 * 128; e += NTHR) { const int i = e >> 7, n2 = e & 127; zt[i * 129 + n2] = bf2f(p.Z[(size_t)(row0 + i) * NZ + C_FN + g * 128 + n2]); }
    __syncthreads();
    for (int kk = 0; kk < 16; ++kk) { const int k2 = wave + 8 * kk; const float* cc = p.CCS + k2 * 128; const float* cs = p.CCS + 16384 + k2 * 128;
      float ap = 0.f, aq = 0.f;
      for (int n2 = 0; n2 < 128; ++n2) { const float zv = zt[lane * 129 + n2]; ap += zv * cc[n2]; aq += zv * cs[n2]; }
      if (t0 < LL) { bf16_t* d = p.PQT + ((size_t)(b * 512 + g * 128 + k2)) * 8192 + t0 + lane; d[0] = f2bf(ap); d[4096] = f2bf(aq); }
      else { bf16_t* d = p.PQTc + ((size_t)(b * 512 + g * 128 + k2)) * 512 + (t0 - LL) + lane; d[0] = f2bf(ap); d[256] = f2bf(aq); } }
  }
}

DI int scan_row(int b, int dir, int s) { return s < LCX ? b * LT + LL + (dir ? LCX - 1 - s : s) : b * LT + (dir ? LL - 1 - (s - LCX) : (s - LCX)); }

DI void st_dnscan(const Prm& p, float* lds, int bid, int nb) {
  float* q_s = lds; float* k_s = lds + 4096; float* v_s = lds + 8192; float* o_s = lds + 12288; float* gb_s = lds + 16384;
  const int tid = ltid(), c = tid >> 2, part = tid & 3;
  for (int chain = bid; chain < 64; chain += nb) {
    const int b = chain >> 3, h = (chain >> 1) & 3, dir = chain & 1;
    float S[32];
#pragma unroll
    for (int j = 0; j < 32; ++j) S[j] = 0.f;
    for (int batch = 0; batch < LT / 32; ++batch) {
      __syncthreads();
      for (int e = tid; e < 32 * 48; e += NTHR) { const int i = e / 48, ch = e - i * 48, pq = ch >> 4, c8 = (ch & 15) * 8; const int row = scan_row(b, dir, batch * 32 + i);
        const bf16x8 vv = *(const bf16x8*)(p.DNQ + (size_t)row * 1536 + pq * 512 + h * 128 + c8); float* d = lds + pq * 4096 + i * 128 + c8;
#pragma unroll
        for (int j = 0; j < 8; ++j) d[j] = bf2f((bf16_t)vv[j]); }
      if (tid < 32) { const int row = scan_row(b, dir, batch * 32 + tid); gb_s[tid * 2] = expf(p.GB[(size_t)row * 16 + dir * 4 + h]); gb_s[tid * 2 + 1] = p.GB[(size_t)row * 16 + 8 + dir * 4 + h]; }
      __syncthreads();
#pragma unroll 1
      for (int i = 0; i < 32; ++i) {
        const float a = gb_s[i * 2], beta = gb_s[i * 2 + 1]; const float* kk = k_s + i * 128 + part * 32; const float* qq = q_s + i * 128 + part * 32;
        float kv[32]; float ks = 0.f;
#pragma unroll
        for (int j = 0; j < 32; j += 4) { const f32x4 t4 = *(const f32x4*)(kk + j); kv[j] = t4[0]; kv[j + 1] = t4[1]; kv[j + 2] = t4[2]; kv[j + 3] = t4[3]; }
#pragma unroll
        for (int j = 0; j < 32; ++j) { S[j] *= a; ks += kv[j] * S[j]; }
        ks += __shfl_xor(ks, 1); ks += __shfl_xor(ks, 2);
        const float vn = beta * (v_s[i * 128 + c] - ks); float o = 0.f;
#pragma unroll
        for (int j = 0; j < 32; j += 4) { const f32x4 q4 = *(const f32x4*)(qq + j);
          S[j] += kv[j] * vn; S[j + 1] += kv[j + 1] * vn; S[j + 2] += kv[j + 2] * vn; S[j + 3] += kv[j + 3] * vn;
          o += q4[0] * S[j] + q4[1] * S[j + 1] + q4[2] * S[j + 2] + q4[3] * S[j + 3]; }
        o += __shfl_xor(o, 1); o += __shfl_xor(o, 2);
        if (part == 0) o_s[i * 128 + c] = o;
      }
      __syncthreads();
      { const int i = tid >> 4, c8 = (tid & 15) * 8; const int row = scan_row(b, dir, batch * 32 + i); const float* s = o_s + i * 128 + c8;
        u32x4 w; w.x = pack2(s[0], s[1]); w.y = pack2(s[2], s[3]); w.z = pack2(s[4], s[5]); w.w = pack2(s[6], s[7]);
        *(u32x4*)(p.OB + ((size_t)(0 * 2 + dir) * MR + row) * 512 + h * 128 + c8) = w; }
    }
  }
}

DI void st_glascan(const Prm& p, int layer, float* lds, int bid, int nb) {
  float* q_s = lds; float* k_s = lds + 2048; float* a_s = lds + 4096; float* v_s = lds + 6144; float* o_s = lds + 10240; float* al_s = lds + 14336;
  const int tid = ltid(), c = tid >> 2, part = tid & 3;
  for (int chain = bid; chain < 64; chain += nb) {
    const int b = chain >> 3, h = (chain >> 1) & 3, dir = chain & 1;
    const float* w2 = p.gla_w2 + (size_t)(layer * 2 + dir) * 16 * 256 + h * 64; const float* b2 = p.gla_b2 + (layer * 2 + dir) * 256 + h * 64;
    float S[16];
#pragma unroll
    for (int j = 0; j < 16; ++j) S[j] = 0.f;
    for (int batch = 0; batch < LT / 32; ++batch) {
      __syncthreads();
      for (int e = tid; e < 32 * 34; e += NTHR) { const int i = e / 34, ch = e - i * 34; const int row = scan_row(b, dir, batch * 32 + i); const bf16_t* z = p.Z + (size_t)row * NZ;
        if (ch < 8) { const bf16x8 vv = *(const bf16x8*)(z + C_GQ + h * 64 + ch * 8);
#pragma unroll
          for (int j = 0; j < 8; ++j) q_s[i * 64 + ch * 8 + j] = bf2f((bf16_t)vv[j]) * 0.125f; }
        else if (ch < 16) { const bf16x8 vv = *(const bf16x8*)(z + C_GK + h * 64 + (ch - 8) * 8);
#pragma unroll
          for (int j = 0; j < 8; ++j) k_s[i * 64 + (ch - 8) * 8 + j] = bf2f((bf16_t)vv[j]); }
        else if (ch < 32) { const bf16x8 vv = *(const bf16x8*)(z + C_GV + h * 128 + (ch - 16) * 8);
#pragma unroll
          for (int j = 0; j < 8; ++j) v_s[i * 128 + (ch - 16) * 8 + j] = bf2f((bf16_t)vv[j]); }
        else { const bf16x8 vv = *(const bf16x8*)(z + C_GALPHA + dir * 16 + (ch - 32) * 8);
#pragma unroll
          for (int j = 0; j < 8; ++j) al_s[i * 16 + (ch - 32) * 8 + j] = bf2f((bf16_t)vv[j]); } }
      __syncthreads();
#pragma unroll
      for (int k = 0; k < 4; ++k) { const int e = tid + NTHR * k, i = e >> 6, d = e & 63; float zz = b2[d];
#pragma unroll
        for (int r = 0; r < 16; ++r) zz += al_s[i * 16 + r] * w2[r * 256 + d];
        const float nz = -zz; const float sp = nz > 20.f ? nz : log1pf(expf(nz));
        a_s[i * 64 + d] = expf(-sp * (1.f / 16.f)); }
      __syncthreads();
#pragma unroll 1
      for (int i = 0; i < 32; ++i) {
        const float vv = v_s[i * 128 + c]; const float* aa = a_s + i * 64 + part * 16; const float* kk = k_s + i * 64 + part * 16; const float* qq = q_s + i * 64 + part * 16; float o = 0.f;
#pragma unroll
        for (int j = 0; j < 16; j += 4) { const f32x4 a4 = *(const f32x4*)(aa + j), k4 = *(const f32x4*)(kk + j), q4 = *(const f32x4*)(qq + j);
          S[j] = a4[0] * S[j] + k4[0] * vv; S[j + 1] = a4[1] * S[j + 1] + k4[1] * vv; S[j + 2] = a4[2] * S[j + 2] + k4[2] * vv; S[j + 3] = a4[3] * S[j + 3] + k4[3] * vv;
          o += q4[0] * S[j] + q4[1] * S[j + 1] + q4[2] * S[j + 2] + q4[3] * S[j + 3]; }
        o += __shfl_xor(o, 1); o += __shfl_xor(o, 2);
        if (part == 0) o_s[i * 128 + c] = o;
      }
      __syncthreads();
      { const int i = tid >> 4, c8 = (tid & 15) * 8; const int row = scan_row(b, dir, batch * 32 + i); const float* s = o_s + i * 128 + c8;
        u32x4 w; w.x = pack2(s[0], s[1]); w.y = pack2(s[2], s[3]); w.z = pack2(s[4], s[5]); w.w = pack2(s[6], s[7]);
        *(u32x4*)(p.OB + ((size_t)(1 * 2 + dir) * MR + row) * 512 + h * 128 + c8) = w; }
    }
  }
}

DI void st_combine(const Prm& p, int layer, int bid, int nb) {
  const int wave = ltid() >> 6, lane = ltid() & 63;
  for (long task = (long)bid * 8 + wave; task < (long)MR * 8; task += (long)nb * 8) {
    const int row = (int)(task >> 3), mh = (int)(task & 7), mixer = mh >> 2, h = mh & 3;
    const unsigned f = *(const unsigned*)(p.OB + ((size_t)(mixer * 2 + 0) * MR + row) * 512 + h * 128 + lane * 2), g = *(const unsigned*)(p.OB + ((size_t)(mixer * 2 + 1) * MR + row) * 512 + h * 128 + lane * 2);
    const float o0 = bf2f((bf16_t)(f & 0xffffu)) + bf2f((bf16_t)(g & 0xffffu)), o1 = bf2f((bf16_t)(f >> 16)) + bf2f((bf16_t)(g >> 16));
    const float ss = wsum(o0 * o0 + o1 * o1), rstd = rsqrtf(ss * (1.f / 128.f) + EPSV);
    const float* w = (mixer ? p.gla_norm : p.dn_norm) + layer * 128 + lane * 2;
    const unsigned gz = *(const unsigned*)(p.Z + (size_t)row * NZ + (mixer ? C_GGATE : C_DNGATE) + h * 128 + lane * 2);
    const float g0 = bf2f((bf16_t)(gz & 0xffffu)), g1 = bf2f((bf16_t)(gz >> 16));
    *(unsigned*)(p.Y + (size_t)row * DM + mixer * 512 + h * 128 + lane * 2) = pack2(o0 * rstd * w[0] * siluf(g0), o1 * rstd * w[1] * siluf(g1));
  }
}

DI void st_peertopk(const Prm& p, int layer, unsigned char* lds, int bid, int nb) {
  bf16_t* ks = (bf16_t*)lds;
  float* qsb = (float*)(lds + 2 * 128 * 272);
  const int tid = ltid(), wave = tid >> 6, lane = tid & 63;
  float* qs = qsb + wave * 256;
  int hcur = -1;
  const int nchunk = MR / 64;
  for (int it = bid; it < 8 * nchunk; it += nb) {
    const int h = it / nchunk, chunk = it - h * nchunk;
    if (h != hcur) { __syncthreads();
      const float* kg = p.peer_keys + ((size_t)(layer * 8 + h) * 2) * 128 * 128;
      for (int e = tid; e < 2 * 128 * 128; e += NTHR) { const int pn = e >> 7, k = e & 127; ks[pn * 136 + k] = f2bf(kg[e]); }
      hcur = h; __syncthreads(); }
    for (int rr = 0; rr < 8; ++rr) {
      const int row = chunk * 64 + wave * 8 + rr;
      { const bf16_t* q = p.Qp + (size_t)row * DM + h * 256; const u32x2 w = *(const u32x2*)(q + lane * 4);
        qs[lane * 4] = bf2f((bf16_t)(w.x & 0xffffu)); qs[lane * 4 + 1] = bf2f((bf16_t)(w.x >> 16)); qs[lane * 4 + 2] = bf2f((bf16_t)(w.y & 0xffffu)); qs[lane * 4 + 3] = bf2f((bf16_t)(w.y >> 16)); }
      float s[2][2] = {{0.f, 0.f}, {0.f, 0.f}};
#pragma unroll
      for (int pp = 0; pp < 2; ++pp)
        for (int kc = 0; kc < 16; ++kc) { const f32x4 qa = *(const f32x4*)(qs + pp * 128 + kc * 8), qb = *(const f32x4*)(qs + pp * 128 + kc * 8 + 4);
#pragma unroll
          for (int hh = 0; hh < 2; ++hh) { const bf16x8 kv = *(const bf16x8*)(ks + (pp * 128 + hh * 64 + lane) * 136 + kc * 8);
            s[pp][hh] += qa[0] * bf2f((bf16_t)kv[0]) + qa[1] * bf2f((bf16_t)kv[1]) + qa[2] * bf2f((bf16_t)kv[2]) + qa[3] * bf2f((bf16_t)kv[3])
                       + qb[0] * bf2f((bf16_t)kv[4]) + qb[1] * bf2f((bf16_t)kv[5]) + qb[2] * bf2f((bf16_t)kv[6]) + qb[3] * bf2f((bf16_t)kv[7]); } }
      float tv[2]; int ti[2];
#pragma unroll
      for (int pp = 0; pp < 2; ++pp) { float v0 = s[pp][0], v1 = s[pp][1]; tv[pp] = 0.f; ti[pp] = 0;
        for (int r = 0; r < 16; ++r) { const float m = wmax(fmaxf(v0, v1)); int idx;
          const unsigned long long b0 = __ballot(v0 == m);
          if (b0) { const int ln = __ffsll((long long)b0) - 1; idx = ln; if (lane == ln) v0 = -3.0e38f; }
          else { const unsigned long long b1 = __ballot(v1 == m); const int ln = __ffsll((long long)b1) - 1; idx = ln + 64; if (lane == ln) v1 = -3.0e38f; }
          if (lane == r) { tv[pp] = m; ti[pp] = idx; } } }
      float cd[4]; { const float sa = __shfl(tv[0], lane >> 2);
#pragma unroll
        for (int q = 0; q < 4; ++q) cd[q] = sa + __shfl(tv[1], (lane & 3) * 4 + q); }
      float top = 0.f; int pos = 0;
      for (int r = 0; r < 16; ++r) { const float m = wmax(fmaxf(fmaxf(cd[0], cd[1]), fmaxf(cd[2], cd[3])));
        int mypos = 99999;
#pragma unroll
        for (int q = 3; q >= 0; --q) if (cd[q] == m) mypos = lane * 4 + q;
        int pm = mypos; for (int o = 32; o >= 1; o >>= 1) pm = min(pm, __shfl_xor(pm, o));
        if ((pm >> 2) == lane) {
#pragma unroll
          for (int q = 0; q < 4; ++q) if ((pm & 3) == q) cd[q] = -3.0e38f; }
        if (lane == r) { top = m; pos = pm; } }
      const int i1 = __shfl(ti[0], (pos >> 4) & 15), i2 = __shfl(ti[1], pos & 15);
      const float t0 = __shfl(top, 0); float e = lane < 16 ? __expf(top - t0) : 0.f; float sum = e;
      for (int o = 8; o >= 1; o >>= 1) sum += __shfl_xor(sum, o);
      if (lane < 16) { p.IDX[(size_t)row * 128 + h * 16 + lane] = i1 * 128 + i2; p.GATE[(size_t)row * 128 + h * 16 + lane] = e / sum; }
    }
  }
}

DI void st_cvt_tables(const Prm& p, int layer, int bid, int nb) {
  const size_t n8 = (size_t)16384 * DM / 8, stride = (size_t)nb * NTHR;
  const float* U = p.peer_u + (size_t)layer * 16384 * DM; const float* V = p.peer_v + (size_t)layer * 16384 * DM;
  for (size_t e = (size_t)bid * NTHR + ltid(); e < 2 * n8; e += stride) { const bool isv = e >= n8; const size_t k = isv ? e - n8 : e;
    const float* src = (isv ? V : U) + k * 8; const f32x4 a = *(const f32x4*)src, b = *(const f32x4*)(src + 4);
    u32x4 w; w.x = pack2(a[0], a[1]); w.y = pack2(a[2], a[3]); w.z = pack2(b[0], b[1]); w.w = pack2(b[2], b[3]);
    *(u32x4*)((isv ? p.Vb : p.Ub) + k * 8) = w; }
}

typedef __bf16 bf2_t __attribute__((ext_vector_type(2)));
DI float dot2bf(unsigned a, unsigned b, float c) { return __builtin_amdgcn_fdot2_f32_bf16(__builtin_bit_cast(bf2_t, a), __builtin_bit_cast(bf2_t, b), c, false); }
DI void st_peergather(const Prm& p, int layer, float* lds, int bid, int nb) {
  const int tid = ltid(), wave = tid >> 6, lane = tid & 63;
  for (int row = bid; row < MR; row += nb) {
    const int b = row / LT, t = row - b * LT; const bool isc = t >= LL;
    if (isc && layer == 1) continue;
    u32x4 hv[4];
#pragma unroll
    for (int i = 0; i < 4; ++i) hv[i] = *(const u32x4*)(p.H2 + (size_t)row * DM + i * 512 + lane * 8);
    float acc[32];
#pragma unroll
    for (int i = 0; i < 32; ++i) acc[i] = 0.f;
    const int myidx = lane < 16 ? p.IDX[(size_t)row * 128 + wave * 16 + lane] : 0; const float mygate = lane < 16 ? p.GATE[(size_t)row * 128 + wave * 16 + lane] : 0.f;
#pragma unroll 1
    for (int k0 = 0; k0 < 16; k0 += 4) {
      u32x4 uu[4][4], vv[4][4];
#pragma unroll
      for (int q = 0; q < 4; ++q) { const int e = __builtin_amdgcn_readfirstlane(__shfl(myidx, k0 + q));
        const bf16_t* ur = p.Ub + (size_t)e * DM + lane * 8; const bf16_t* vr = p.Vb + (size_t)e * DM + lane * 8;
#pragma unroll
        for (int i = 0; i < 4; ++i) { uu[q][i] = *(const u32x4*)(ur + i * 512); vv[q][i] = *(const u32x4*)(vr + i * 512); } }
#pragma unroll
      for (int q = 0; q < 4; ++q) { float d = 0.f;
#pragma unroll
        for (int i = 0; i < 4; ++i) { d = dot2bf(uu[q][i].x, hv[i].x, d); d = dot2bf(uu[q][i].y, hv[i].y, d); d = dot2bf(uu[q][i].z, hv[i].z, d); d = dot2bf(uu[q][i].w, hv[i].w, d); }
        d = wsum(d);
        const float wgt = __shfl(mygate, k0 + q) * 0.5f * d * (1.f + erff(d * 0.70710678118654752f));
#pragma unroll
        for (int i = 0; i < 4; ++i) {
          acc[i * 8 + 0] += wgt * __uint_as_float(vv[q][i].x << 16); acc[i * 8 + 1] += wgt * __uint_as_float(vv[q][i].x & 0xffff0000u);
          acc[i * 8 + 2] += wgt * __uint_as_float(vv[q][i].y << 16); acc[i * 8 + 3] += wgt * __uint_as_float(vv[q][i].y & 0xffff0000u);
          acc[i * 8 + 4] += wgt * __uint_as_float(vv[q][i].z << 16); acc[i * 8 + 5] += wgt * __uint_as_float(vv[q][i].z & 0xffff0000u);
          acc[i * 8 + 6] += wgt * __uint_as_float(vv[q][i].w << 16); acc[i * 8 + 7] += wgt * __uint_as_float(vv[q][i].w & 0xffff0000u); } }
    }
    __syncthreads();
#pragma unroll
    for (int i = 0; i < 4; ++i) { float* d = lds + wave * 2048 + i * 512 + lane * 8;
      *(f32x4*)d = (f32x4){acc[i * 8], acc[i * 8 + 1], acc[i * 8 + 2], acc[i * 8 + 3]}; *(f32x4*)(d + 4) = (f32x4){acc[i * 8 + 4], acc[i * 8 + 5], acc[i * 8 + 6], acc[i * 8 + 7]}; }
    __syncthreads();
    { const int col = tid * 4; f32x4 sum = (f32x4){0.f, 0.f, 0.f, 0.f};
#pragma unroll
      for (int w = 0; w < 8; ++w) sum += *(const f32x4*)(lds + w * 2048 + col);
      const f32x4 g2 = *(const f32x4*)(p.mod + ((size_t)layer * 9 + (isc ? 8 : b)) * NMOD + 5 * DM + col);
      float* xr = p.X + (size_t)row * DM + col; *(f32x4*)xr = *(const f32x4*)xr + g2 * sum; }
  }
}

DI void st_final(const Prm& p, int bid, int nb) {
  const int wave = ltid() >> 6, lane = ltid() & 63;
  for (int r = bid * 8 + wave; r < NB * LL; r += nb * 8) {
    const int b = r / LL, t = r - b * LL; const float* src = p.X + (size_t)(b * LT + t) * DM;
    f32x4 v[8]; float ss = 0.f;
#pragma unroll
    for (int i = 0; i < 8; ++i) { v[i] = *(const f32x4*)(src + (i * 64 + lane) * 4); ss += v[i][0] * v[i][0] + v[i][1] * v[i][1] + v[i][2] * v[i][2] + v[i][3] * v[i][3]; }
    ss = wsum(ss); const float rstd = rsqrtf(ss * (1.f / 2048.f) + EPSV);
#pragma unroll
    for (int i = 0; i < 8; ++i) { const int col = (i * 64 + lane) * 4; *(f32x4*)(p.out + (size_t)r * DM + col) = v[i] * rstd * *(const f32x4*)(p.final_norm + col); }
  }
}

namespace att {
constexpr int NW = 8, QBLK = 32, KVBLK = 64;
constexpr float SCALE = 0.07216878364870322f;
constexpr float THR = 8.f;
constexpr int LDQ = 768, LDK = 1024, LDKR = 64, LDO = DM;
constexpr int SHM_V = KVBLK * 128 * 2, SHM_K = KVBLK * 128 * 2, SHM_KR = KVBLK * 64 * 2, SHM_ATTN = 2 * SHM_V + 2 * SHM_K + 2 * SHM_KR + NW * 64 * 4;
#define KSWZ(row, colB) ((row) * 256 + ((colB) ^ (((row) & 7) << 4)))
#define KRSWZ(row, colB) ((row) * 128 + ((colB) ^ ((((row) >> 1) & 7) << 4)))
#define SBAR() __builtin_amdgcn_sched_barrier(0)
DI int crow(int r, int hi) { return (r & 3) + 8 * (r >> 2) + 4 * hi; }
DI unsigned cvtpk(float lo, float hi) { unsigned r; asm volatile("v_cvt_pk_bf16_f32 %0, %1, %2" : "=v"(r) : "v"(lo), "v"(hi)); return r; }

DI void partialSM(f32x16& p0, f32x16& p1, float& m_reg, float& mn, float& alpha) {
  constexpr float C = SCALE * 1.4426950408889634f;
  float pmax = p0[0];
#pragma unroll
  for (int r = 1; r < 16; ++r) pmax = fmaxf(pmax, p0[r]);
#pragma unroll
  for (int r = 0; r < 16; ++r) pmax = fmaxf(pmax, p1[r]);
  { auto rr = __builtin_amdgcn_permlane32_swap(__float_as_uint(pmax), __float_as_uint(pmax), false, false);
    pmax = fmaxf(__uint_as_float(rr[0]), __uint_as_float(rr[1])); }
  if (__builtin_expect(__all(pmax - m_reg <= THR / SCALE), 1)) { mn = m_reg; alpha = 1.f; }
  else { mn = fmaxf(m_reg, pmax); alpha = __builtin_amdgcn_exp2f((m_reg - mn) * C); m_reg = mn; }
  const float mnC = -mn * C;
#pragma unroll
  for (int r = 0; r < 16; ++r) p0[r] = fmaf(p0[r], C, mnC);
#pragma unroll
  for (int r = 0; r < 16; ++r) p1[r] = fmaf(p1[r], C, mnC);
#pragma unroll
  for (int r = 0; r < 16; ++r) p0[r] = __builtin_amdgcn_exp2f(p0[r]);
}
DI void finishSM(f32x16& p0, f32x16& p1, float alpha, float& l_reg, bf16x8& pa0, bf16x8& pa1, bf16x8& pa2, bf16x8& pa3) {
#pragma unroll
  for (int r = 0; r < 16; ++r) p1[r] = __builtin_amdgcn_exp2f(p1[r]);
  float ps = 0;
#pragma unroll
  for (int r = 0; r < 16; ++r) ps += p0[r];
#pragma unroll
  for (int r = 0; r < 16; ++r) ps += p1[r];
  { auto rr = __builtin_amdgcn_permlane32_swap(__float_as_uint(ps), __float_as_uint(ps), false, false);
    ps = __uint_as_float(rr[0]) + __uint_as_float(rr[1]); }
  l_reg = l_reg * alpha + ps;
#define PK4(P, BASE, OUT) do { unsigned a0 = cvtpk(P[BASE + 0], P[BASE + 1]), a1 = cvtpk(P[BASE + 2], P[BASE + 3]);   \
    unsigned b0 = cvtpk(P[BASE + 4], P[BASE + 5]), b1 = cvtpk(P[BASE + 6], P[BASE + 7]);                              \
    auto r0 = __builtin_amdgcn_permlane32_swap(a0, b0, false, false); auto r1 = __builtin_amdgcn_permlane32_swap(a1, b1, false, false); \
    u32x4 w = {r0[0], r1[0], r0[1], r1[1]}; OUT = *reinterpret_cast<bf16x8*>(&w); } while (0)
  PK4(p0, 0, pa0); PK4(p0, 8, pa1); PK4(p1, 0, pa2); PK4(p1, 8, pa3);
#undef PK4
}
DI void qkt(f32x16& p0, f32x16& p1, const char* Ks, const char* KRs, const bf16x8* qr, int r32, int hi) {
  p0 = f32x16{}; p1 = f32x16{};
#pragma unroll
  for (int d0 = 0; d0 < 8; ++d0) { const int cb = (d0 * 16 + hi * 8) * 2;
    const bf16x8 b0 = *reinterpret_cast<const bf16x8*>(Ks + KSWZ(r32, cb));
    const bf16x8 b1 = *reinterpret_cast<const bf16x8*>(Ks + KSWZ(32 + r32, cb));
    p0 = __builtin_amdgcn_mfma_f32_32x32x16_bf16(b0, qr[d0], p0, 0, 0, 0);
    p1 = __builtin_amdgcn_mfma_f32_32x32x16_bf16(b1, qr[d0], p1, 0, 0, 0); }
#pragma unroll
  for (int d0 = 0; d0 < 4; ++d0) { const int cb = (d0 * 16 + hi * 8) * 2;
    const bf16x8 b0 = *reinterpret_cast<const bf16x8*>(KRs + KRSWZ(r32, cb));
    const bf16x8 b1 = *reinterpret_cast<const bf16x8*>(KRs + KRSWZ(32 + r32, cb));
    p0 = __builtin_amdgcn_mfma_f32_32x32x16_bf16(b0, qr[8 + d0], p0, 0, 0, 0);
    p1 = __builtin_amdgcn_mfma_f32_32x32x16_bf16(b1, qr[8 + d0], p1, 0, 0, 0); }
}
DI int v_st(int k, int c) { const int kk = (k & ~0xC) | ((k & 4) << 1) | ((k & 8) >> 1); return ((kk >> 3) * 4 + (c >> 5)) * 512 + ((kk & 7) * 32 + (c & 31)) * 2; }
DI int v_rd_base(int lane) { return ((lane & 3) << 3) | (((lane >> 2) & 3) << 6) | (((lane >> 4) & 1) << 5) | (((lane >> 5) & 1) << 8); }
constexpr int v_rd_off(int d0, int ks, int half) { return d0 * 512 + ks * 4096 + half * 2048; }
template <int OFF> DI s16x4 tr_read(int vb) { s16x4 r; asm volatile("ds_read_b64_tr_b16 %0, %1 offset:%2" : "=&v"(r) : "v"(vb), "i"(OFF) : "memory"); return r; }
template <int D0> DI void pv_one(f32x16& od, int vb, bf16x8 pa0, bf16x8 pa1, bf16x8 pa2, bf16x8 pa3) {
  const s16x4 l0 = tr_read<v_rd_off(D0, 0, 0)>(vb), h0 = tr_read<v_rd_off(D0, 0, 1)>(vb), l1 = tr_read<v_rd_off(D0, 1, 0)>(vb), h1 = tr_read<v_rd_off(D0, 1, 1)>(vb);
  const s16x4 l2 = tr_read<v_rd_off(D0, 2, 0)>(vb), h2 = tr_read<v_rd_off(D0, 2, 1)>(vb), l3 = tr_read<v_rd_off(D0, 3, 0)>(vb), h3 = tr_read<v_rd_off(D0, 3, 1)>(vb);
  asm volatile("s_waitcnt lgkmcnt(0)" ::: "memory"); SBAR();
#define PK(L, H) (bf16x8){L[0], L[1], L[2], L[3], H[0], H[1], H[2], H[3]}
  od = __builtin_amdgcn_mfma_f32_32x32x16_bf16(pa0, PK(l0, h0), od, 0, 0, 0);
  od = __builtin_amdgcn_mfma_f32_32x32x16_bf16(pa1, PK(l1, h1), od, 0, 0, 0);
  od = __builtin_amdgcn_mfma_f32_32x32x16_bf16(pa2, PK(l2, h2), od, 0, 0, 0);
  od = __builtin_amdgcn_mfma_f32_32x32x16_bf16(pa3, PK(l3, h3), od, 0, 0, 0);
#undef PK
}
DI void pv_d0(f32x16* o, int vb, bf16x8 pa0, bf16x8 pa1, bf16x8 pa2, bf16x8 pa3) {
  pv_one<0>(o[0], vb, pa0, pa1, pa2, pa3); pv_one<1>(o[1], vb, pa0, pa1, pa2, pa3); pv_one<2>(o[2], vb, pa0, pa1, pa2, pa3); pv_one<3>(o[3], vb, pa0, pa1, pa2, pa3);
}

DI void attn_body(const bf16_t* __restrict__ Qb, const bf16_t* __restrict__ Kh, const bf16_t* __restrict__ Vh, const bf16_t* __restrict__ KRh, bf16_t* __restrict__ Ob, int seq, int tpos0, char* lds) {
  const int tid = ltid(), wid = tid >> 6, lane = tid & 63, r32 = lane & 31, hi = lane >> 5;
  char* V_lds = lds; char* K_lds = lds + 2 * SHM_V; char* KR_lds = lds + 2 * SHM_V + 2 * SHM_K;
  float* ws = (float*)(lds + 2 * SHM_V + 2 * SHM_K + 2 * SHM_KR) + wid * 64; float* li_l = ws; float* al_l = ws + 32;
  float m_reg = -1e30f, l_reg = 0; f32x16 o[4] = {}; bf16x8 qr[12];
  const bf16_t* Qw = Qb + (long)(wid * QBLK + r32) * LDQ + hi * 8;
#pragma unroll
  for (int d0 = 0; d0 < 12; ++d0) qr[d0] = *reinterpret_cast<const bf16x8*>(Qw + d0 * 16);
  if (tpos0 >= 0) {
    const int t = tpos0 + wid * QBLK + r32;
#pragma unroll
    for (int hf = 0; hf < 2; ++hf) { const float pos = (float)(hf ? (t & 63) : (t >> 6));
#pragma unroll
      for (int j = 0; j < 8; ++j) { const float ang = pos * exp2f(-(float)(hi * 8 + j) * (13.287712379549449f / 16.f)); float sv, cv; sincosf(ang, &sv, &cv);
        const float x1 = bf2f((bf16_t)qr[8 + 2 * hf][j]), x2 = bf2f((bf16_t)qr[9 + 2 * hf][j]);
        qr[8 + 2 * hf][j] = (short)f2bf(x1 * cv - x2 * sv); qr[9 + 2 * hf][j] = (short)f2bf(x2 * cv + x1 * sv); } }
  }
  const int sr = tid >> 4, sc = (tid & 15) * 8, vst0 = v_st(sr, sc), vst1 = v_st(32 + sr, sc);
  const int krr = tid >> 3, krc = (tid & 7) * 8;
  const int vb0 = (int)(uintptr_t)V_lds + v_rd_base(lane);
  bf16x8 vs0, vs1, ks0, ks1, kr0;
#define SLOAD(k0) do { vs0 = *reinterpret_cast<const bf16x8*>(&Vh[(long)((k0) + sr) * LDK + sc]); vs1 = *reinterpret_cast<const bf16x8*>(&Vh[(long)((k0) + 32 + sr) * LDK + sc]); \
    ks0 = *reinterpret_cast<const bf16x8*>(&Kh[(long)((k0) + sr) * LDK + sc]); ks1 = *reinterpret_cast<const bf16x8*>(&Kh[(long)((k0) + 32 + sr) * LDK + sc]); \
    kr0 = *reinterpret_cast<const bf16x8*>(&KRh[(long)((k0) + krr) * LDKR + krc]); } while (0)
#define SWRITE(b) do { *(bf16x8*)(V_lds + (b) * SHM_V + vst0) = vs0; *(bf16x8*)(V_lds + (b) * SHM_V + vst1) = vs1; const int kc = sc * 2;               \
    *(bf16x8*)(K_lds + (b) * SHM_K + KSWZ(sr, kc)) = ks0; *(bf16x8*)(K_lds + (b) * SHM_K + KSWZ(32 + sr, kc)) = ks1;                       \
    *(bf16x8*)(KR_lds + (b) * SHM_KR + KRSWZ(krr, krc * 2)) = kr0; } while (0)
#define SWAIT() asm volatile("s_waitcnt vmcnt(0)" ::: "memory")
#define RESC(a) do { if (__any((a) < 1.f)) { if (hi == 0) al_l[r32] = (a); asm volatile("s_waitcnt lgkmcnt(0)" ::: "memory"); \
    _Pragma("unroll") for (int d = 0; d < 4; ++d) _Pragma("unroll") for (int r = 0; r < 16; ++r) o[d][r] *= al_l[crow(r, hi)]; } } while (0)
  f32x16 p0, p1; float mn, al; bf16x8 pa0, pa1, pa2, pa3; const int NT = seq / KVBLK;
  SLOAD(0); SWAIT(); SWRITE(0); __syncthreads();
  for (int j = 0; j < NT; ++j) {
    const int buf = j & 1; const bool more = j + 1 < NT;
    if (more) SLOAD((j + 1) * KVBLK);
    SBAR(); qkt(p0, p1, K_lds + buf * SHM_K, KR_lds + buf * SHM_KR, qr, r32, hi);
    partialSM(p0, p1, m_reg, mn, al); RESC(al);
    finishSM(p0, p1, al, l_reg, pa0, pa1, pa2, pa3); SBAR();
    pv_d0(o, vb0 + buf * SHM_V, pa0, pa1, pa2, pa3);
    if (more) { SWAIT(); SWRITE(buf ^ 1); }
    __syncthreads();
  }
  if (hi == 0) li_l[r32] = l_reg; asm volatile("s_waitcnt lgkmcnt(0)" ::: "memory");
  float rli[16];
#pragma unroll
  for (int r = 0; r < 16; ++r) rli[r] = __builtin_amdgcn_rcpf(li_l[crow(r, hi)]);
  bf16_t* Ow = Ob + (long)(wid * QBLK) * LDO;
#pragma unroll
  for (int r = 0; r < 16; ++r) { const int orow = crow(r, hi);
#pragma unroll
    for (int d0 = 0; d0 < 4; ++d0) Ow[(long)orow * LDO + d0 * 32 + r32] = f2bf(o[d0][r] * rli[r]); }
  __syncthreads();
#undef SLOAD
#undef SWRITE
#undef SWAIT
#undef RESC
}
}

DI void st_attn(const Prm& p, int layer, char* lds, int bid, int nb) {
  const int nlat = NB * 4 * 16, nitem = nlat + (layer == 0 ? NB * 4 : 0);
  for (int it = bid; it < nitem; it += nb) {
    if (it < nlat) { const int b = it >> 6, h = (it >> 4) & 3, qb = it & 15; const size_t r0 = (size_t)b * LT;
      att::attn_body(p.Qraw + (r0 + qb * 256) * 768 + h * 192, p.KV + r0 * 1024 + h * 256, p.KV + r0 * 1024 + h * 256 + 128, p.KR + r0 * 64,
                     p.Y + (r0 + qb * 256) * DM + 1024 + h * 128, LT, qb * 256, lds); }
    else { const int k = it - nlat, b = k >> 2, h = k & 3; const size_t r0 = (size_t)b * LT + LL;
      att::attn_body(p.Qraw + r0 * 768 + h * 192, p.KV + r0 * 1024 + h * 256, p.KV + r0 * 1024 + h * 256 + 128, p.KR + r0 * 64, p.Y + r0 * DM + 1024 + h * 128, LCX, -1, lds); }
  }
}

struct EpiResid {
  static constexpr bool PERM = false, AFTER_DRAIN = false;
  const float* xlat; const float* xctx; float* X; const float* modl; int first;
  __device__ __forceinline__ void operator()(const pg8::f32x4 (&acc)[2][2][4][2], const pg8::Unit& u, int wr, int wc, int fr, int fq) const {
    const int b = u.pm / 17, tl = u.pm - b * 17; const bool isc = tl == 16;
    const float* g = modl + (size_t)(isc ? 8 : b) * NMOD + 2 * DM;
    const int rloc0 = wr * 64 + fr, col0 = u.pn * 256 + wc * 32 + 4 * fq;
    pg8::f32x4 gv[2][2];
#pragma unroll
    for (int bj = 0; bj < 2; ++bj)
#pragma unroll
      for (int n = 0; n < 2; ++n) gv[bj][n] = *(const pg8::f32x4*)(g + col0 + bj * 128 + n * 16);
#pragma unroll
    for (int ai = 0; ai < 2; ++ai)
#pragma unroll
      for (int m = 0; m < 4; ++m) { const int rl = rloc0 + ai * 128 + m * 16; const size_t row = (size_t)u.pm * 256 + rl;
        const float* src = first ? (isc ? xctx + ((size_t)b * LCX + rl) * DM : xlat + ((size_t)b * LL + tl * 256 + rl) * DM) : X + row * DM;
        float* dst = X + row * DM;
#pragma unroll
        for (int bj = 0; bj < 2; ++bj)
#pragma unroll
          for (int n = 0; n < 2; ++n) { const int c = col0 + bj * 128 + n * 16; *(pg8::f32x4*)(dst + c) = *(const pg8::f32x4*)(src + c) + gv[bj][n] * acc[ai][bj][m][n]; } }
  }
};

template <class Epi> DI void run_gemm(unsigned char* lds, const bf16_t* A, const bf16_t* Bt, int M, int N, int K, const Epi& E, int bid, int nb) {
  pg8::Gemm g; g.A = A; g.Bt = Bt; g.M = M; g.N = N; g.K = K;
  pg8::StaticOrder S; S.init(M, N, nb, bid);
  pg8::gemm_phase<Epi, pg8::StaticOrder, false>((PG8_LAS unsigned char*)lds, g, S, E, nullptr);
}
DI pg8::EpiBf16<0> epi_bf16(bf16_t* O, int ldc, int split_cols = 0, size_t split_stride = 0) { pg8::EpiBf16<0> e; e.O = O; e.ldc = ldc; e.bias = nullptr; e.split_cols = split_cols; e.split_stride = split_stride; return e; }

constexpr int LDS_MAIN = 131072, LDS_TOTAL = LDS_MAIN + 64;
#define PRM() (*(const __attribute__((address_space(4))) Prm*)launder_k(kp))
typedef const __attribute__((address_space(4))) void* kptr_t;
DI kptr_t launder_k(kptr_t q) { asm volatile("" : "+s"(q)); return q; }
extern __shared__ __attribute__((aligned(16))) unsigned char shm[];
__global__ void __launch_bounds__(NTHR, 2) mega(Prm p_unused) {
#if defined(__HIP_DEVICE_COMPILE__)
  kptr_t kp = (kptr_t)__builtin_amdgcn_kernarg_segment_ptr();
  const int bid0 = blockIdx.x, nb0 = gridDim.x;
#define bid lsg(bid0)
#define nb lsg(nb0)
  uint4* xbw = (uint4*)(shm + LDS_MAIN);
  if (threadIdx.x == 0) *xbw = make_uint4(0u, 0u, 0u, 0u);
  __syncthreads();
  { const Prm p = PRM(); (void)xcd_barrier_post(p.bar, (volatile LAS unsigned*)xbw); }
#define GRID_BAR() do { XcdBarrier b_; b_.bar = PRM().bar; b_.x = xb_xcc_id(); b_.st = (volatile LAS unsigned*)(shm + LDS_MAIN); xcd_barrier(b_); } while (0)
  float* lf = (float*)shm;
  for (int ly = 0; ly < 2; ++ly) { const Prm p = PRM();
    st_transpose(p.w_in + (size_t)ly * DM * IN_W, p.WinT + (size_t)ly * NZ * DM, DM, IN_W, DM, NZ, lf, bid, nb);
    st_transpose(p.w_out + (size_t)ly * DM * DM, p.WoutT + (size_t)ly * DM * DM, DM, DM, DM, DM, lf, bid, nb);
    st_transpose(p.peer_wq + (size_t)ly * DM * DM, p.WqT + (size_t)ly * DM * DM, DM, DM, DM, DM, lf, bid, nb);
    st_transpose(p.mla_w_uq + (size_t)ly * 448 * 768, p.WuqT + (size_t)ly * 768 * 512, 448, 768, 512, 768, lf, bid, nb);
    st_transpose(p.mla_w_ukv + (size_t)ly * 128 * 1024, p.WukvT + (size_t)ly * 1024 * 256, 128, 1024, 256, 1024, lf, bid, nb);
  }
  { const Prm p = PRM(); st_tables(p, bid, nb); }
  __syncthreads();
  { const Prm p = PRM(); st_mods(p, lf, bid, nb); }
  GRID_BAR();
  for (int l = 0; l < 2; ++l) {
    { const Prm p = PRM(); st_modulate(p, l, 0, p.H, bid, nb); }
    GRID_BAR();
    { const Prm p = PRM(); run_gemm(shm, p.H, p.WinT + (size_t)l * NZ * DM, MR, NZ, DM, epi_bf16(p.Z, NZ), bid, nb); }
    GRID_BAR();
    { const Prm p = PRM(); st_dnprep(p, l, bid, nb); }
    { const Prm p = PRM(); st_mlaprep(p, l, bid, nb); }
    { const Prm p = PRM(); st_fnchan(p, lf, bid, nb); }
    GRID_BAR();
    if (bid < 64) { const Prm p = PRM(); st_dnscan(p, lf, bid, 64); }
    else if (bid < 128) { const Prm p = PRM(); st_glascan(p, l, lf, bid - 64, 64); }
    else {
      const int b2 = bid - 128, n2 = nb - 128;
      { const Prm p = PRM(); run_gemm(shm, p.Aq, p.WuqT + (size_t)l * 768 * 512, MR, 768, 512, epi_bf16(p.Qraw, 768), b2, n2); }
      { const Prm p = PRM(); run_gemm(shm, p.Akv, p.WukvT + (size_t)l * 1024 * 256, MR, 1024, 256, epi_bf16(p.KV, 1024), b2, n2); }
      { const Prm p = PRM(); run_gemm(shm, p.DFTM, p.PQT, 4096, 4096, 8192, epi_bf16(p.Y + 1536, DM, 512, (size_t)LT * DM), b2, n2); }
      if (l == 0) { const Prm p = PRM(); run_gemm(shm, p.DFTC, p.PQTc, 256, 4096, 512, epi_bf16(p.Y + (size_t)LL * DM + 1536, DM, 512, (size_t)LT * DM), b2, n2); }
    }
    GRID_BAR();
    { const Prm p = PRM(); st_attn(p, l, (char*)shm, bid, nb); }
    { const Prm p = PRM(); st_combine(p, l, bid, nb); }
    GRID_BAR();
    { const Prm p = PRM(); EpiResid e; e.xlat = p.x; e.xctx = p.ctx; e.X = p.X; e.modl = p.mod + (size_t)l * 9 * NMOD; e.first = l == 0;
      run_gemm(shm, p.Y, p.WoutT + (size_t)l * DM * DM, MR, DM, DM, e, bid, nb); }
    GRID_BAR();
    { const Prm p = PRM(); st_modulate(p, l, 1, p.H2, bid, nb); }
    { const Prm p = PRM(); st_cvt_tables(p, l, bid, nb); }
    GRID_BAR();
    { const Prm p = PRM(); run_gemm(shm, p.H2, p.WqT + (size_t)l * DM * DM, MR, DM, DM, epi_bf16(p.Qp, DM), bid, nb); }
    GRID_BAR();
    { const Prm p = PRM(); st_peertopk(p, l, shm, bid, nb); }
    GRID_BAR();
    { const Prm p = PRM(); st_peergather(p, l, lf, bid, nb); }
    GRID_BAR();
  }
  { const Prm p = PRM(); st_final(p, bid, nb); }
#endif
#undef bid
#undef nb
#undef GRID_BAR
}

static size_t al256(size_t x) { return (x + 255) / 256 * 256; }
extern "C" void kernel_launch(void* const* d_in, const int* in_sizes, int n_in, void* d_out, int out_size, void* d_ws, size_t ws_size, hipStream_t stream) {
  Prm p{};
  const float** f = (const float**)&p.x;
  for (int i = 0; i < 24; ++i) f[i] = (const float*)d_in[i];
  p.out = (float*)d_out;
  char* w = (char*)d_ws; size_t o = 0;
  auto take = [&](size_t bytes) { char* r = w + o; o += al256(bytes); return r; };
  p.bar = (unsigned*)take(16384);
  p.WinT = (bf16_t*)take((size_t)2 * NZ * DM * 2); p.WoutT = (bf16_t*)take((size_t)2 * DM * DM * 2); p.WqT = (bf16_t*)take((size_t)2 * DM * DM * 2);
  p.WuqT = (bf16_t*)take((size_t)2 * 768 * 512 * 2); p.WukvT = (bf16_t*)take((size_t)2 * 1024 * 256 * 2);
  p.mod = (float*)take((size_t)2 * 9 * NMOD * 4); p.GB = (float*)take((size_t)MR * 16 * 4); p.CCS = (float*)take((size_t)2 * 128 * 128 * 4);
  p.DFTM = (bf16_t*)take((size_t)4096 * 8192 * 2); p.DFTC = (bf16_t*)take((size_t)256 * 512 * 2);
  p.X = (float*)take((size_t)MR * DM * 4);
  p.Z = (bf16_t*)take((size_t)MR * NZ * 2);
  char* ra = take((size_t)MR * 1536 * 2 + (size_t)4 * MR * 512 * 2);
  p.DNQ = (bf16_t*)ra; p.OB = (bf16_t*)(ra + (size_t)MR * 1536 * 2); p.H = (bf16_t*)ra;
  p.Ub = (bf16_t*)ra; p.Vb = (bf16_t*)(ra + (size_t)16384 * DM * 2);
  p.KV = (bf16_t*)take((size_t)MR * 1024 * 2); p.KR = (bf16_t*)take((size_t)MR * 64 * 2);
  if (o > ws_size) return;
  char* q = (char*)d_out; size_t oo = 0;
  p.Y = (bf16_t*)q; oo += (size_t)MR * DM * 2; p.PQT = (bf16_t*)(q + oo); oo += (size_t)8 * 512 * 8192 * 2; p.PQTc = (bf16_t*)(q + oo); oo += (size_t)8 * 512 * 512 * 2;
  p.Qraw = (bf16_t*)(q + oo); oo += (size_t)MR * 768 * 2;
  p.Aq = (bf16_t*)q; p.Akv = (bf16_t*)(q + (size_t)MR * 512 * 2);
  char* z = (char*)p.Z; p.H2 = (bf16_t*)z; p.Qp = (bf16_t*)(z + (size_t)MR * DM * 2); p.IDX = (int*)(z + (size_t)2 * MR * DM * 2); p.GATE = (float*)(z + (size_t)2 * MR * DM * 2 + (size_t)MR * 128 * 4);

  static int grid = 0;
  if (!grid) {
    (void)hipFuncSetAttribute((const void*)mega, hipFuncAttributeMaxDynamicSharedMemorySize, LDS_TOTAL);
    int dev = 0, cus = 0, per_cu = 0;
    (void)hipGetDevice(&dev); (void)hipDeviceGetAttribute(&cus, hipDeviceAttributeMultiprocessorCount, dev);
    (void)hipOccupancyMaxActiveBlocksPerMultiprocessor(&per_cu, (const void*)mega, NTHR, LDS_TOTAL);
    grid = per_cu >= 1 ? cus : 0;
    if (grid > 256) grid = 256;
  }
  if (grid < 256) return;
  (void)hipMemsetAsync(p.bar, 0, XCD_BAR_WORDS * sizeof(unsigned), stream);
  hipLaunchKernelGGL(mega, dim3(grid), dim3(NTHR), LDS_TOTAL, stream, p);
}
```

```cpp
#include <hip/hip_runtime.h>
#include <stdint.h>

constexpr int DM = 2048, NB = 8, LL = 4096, LCX = 256, LT = LL + LCX  , MR = NB * LT  ;
constexpr int NZ = 4864;
constexpr int C_DNQ = 0, C_DNK = 512, C_DNV = 1024, C_DNGATE = 1536, C_DNA = 2048, C_DNB = 2056, C_GQ = 2064, C_GK = 2320, C_GV = 2576,
              C_GGATE = 3088, C_GALPHA = 3600, C_CQ = 3632, C_CKV = 4080, C_KR = 4208, C_FN = 4272, IN_W = 4784;
constexpr int NMOD = 6 * DM;
constexpr float EPSV = 1e-6f;
constexpr int NTHR = 512;

typedef unsigned short bf16_t;
typedef short bf16x8 __attribute__((ext_vector_type(8)));
typedef short s16x4 __attribute__((ext_vector_type(4)));
typedef float f32x4 __attribute__((ext_vector_type(4)));
typedef float f32x16 __attribute__((ext_vector_type(16)));
typedef unsigned u32x4 __attribute__((ext_vector_type(4)));
typedef unsigned u32x2 __attribute__((ext_vector_type(2)));

#define DI __device__ __forceinline__
DI float bf2f(bf16_t b) { return __uint_as_float(((unsigned)b) << 16); }
DI bf16_t f2bf(float f) { unsigned u = __float_as_uint(f); u += 0x7FFFu + ((u >> 16) & 1u); return (bf16_t)(u >> 16); }
DI unsigned pack2(float lo, float hi) { return (unsigned)f2bf(lo) | ((unsigned)f2bf(hi) << 16); }
DI float wsum(float v) { for (int o = 32; o >= 1; o >>= 1) v += __shfl_xor(v, o); return v; }
DI float wmax(float v) { for (int o = 32; o >= 1; o >>= 1) v = fmaxf(v, __shfl_xor(v, o)); return v; }
DI float siluf(float x) { return x / (1.f + __expf(-x)); }
DI float sigmf(float x) { return 1.f / (1.f + __expf(-x)); }

DI int ltid() { int t = (int)threadIdx.x; asm volatile("" : "+v"(t)); return t; }
DI int lsg(int v) { asm volatile("" : "+s"(v)); return v; }

struct Prm {
  const float *x, *c, *ctx, *c_ctx, *w_ada, *b_ada, *w_in, *dn_conv, *dn_a_log, *dn_dt_bias, *dn_norm, *gla_w2, *gla_b2, *gla_norm,
      *mla_q_norm, *mla_w_uq, *mla_kv_norm, *mla_w_ukv, *w_out, *peer_wq, *peer_keys, *peer_u, *peer_v, *final_norm;
  float* out;
  bf16_t *WinT, *WoutT, *WqT, *WuqT, *WukvT;
  float *mod, *GB, *CCS;
  bf16_t *DFTM, *DFTC;
  float* X;
  bf16_t* Z;
  bf16_t *H, *DNQ, *OB;
  bf16_t *KV, *KR;
  bf16_t *Y, *PQT, *PQTc, *Qraw, *Aq, *Akv;
  bf16_t *H2, *Qp;
  bf16_t *Ub, *Vb;
  int* IDX;
  float* GATE;
  unsigned* bar;
};
#define XB_TMO      128
#define XB_XCNT(j)  (256  + 64 * (j))
#define XB_XSUB(j)  (1280 + 64 * (j))
#define XB_XGEN(j)  (2304 + 64 * (j))
#define XB_TOP      3328
#define XB_TOPGEN   3392
#define XCD_BAR_WORDS 3456
#define XB_SPIN_CAP (1u << 18)
#define LAS __attribute__((address_space(3)))

__device__ __forceinline__ unsigned xb_ld(unsigned* p)              { return __hip_atomic_load(p, __ATOMIC_RELAXED, __HIP_MEMORY_SCOPE_AGENT); }
__device__ __forceinline__ unsigned xb_add(unsigned* p, unsigned v) { return __hip_atomic_fetch_add(p, v, __ATOMIC_RELAXED, __HIP_MEMORY_SCOPE_AGENT); }
__device__ __forceinline__ unsigned xb_xcc_id() { return (unsigned)__builtin_amdgcn_s_getreg((3 << 11) | 20) & 0xFu; }
#define XB_SPIN(cond, bar) do { unsigned _sp = 0; while (cond) { __builtin_amdgcn_s_sleep(1); \
    if ((++_sp & 255u) == 0u) { if (xb_ld(&(bar)[XB_TMO])) break; if (_sp > XB_SPIN_CAP) { atomicAdd(&(bar)[XB_TMO], 1u); break; } } } } while (0)

struct XcdBarrier {
    unsigned* bar; unsigned x;
    volatile LAS unsigned* st;
};

__device__ __forceinline__ XcdBarrier xcd_barrier_post(unsigned* bar, volatile LAS unsigned* st) {
    XcdBarrier b; b.bar = bar; b.x = xb_xcc_id(); b.st = st;
    if (threadIdx.x == 0) (void)xb_add(&bar[XB_XCNT(b.x)], 1u);
    return b;
}
__device__ __forceinline__ void xcd_barrier_complete(unsigned* bar, unsigned x, unsigned& nloc, unsigned& nx) {
    const unsigned G = gridDim.x * gridDim.y * gridDim.z;
    unsigned sum, cnt, mine, sp = 0u;
    for (;;) {
        sum = 0u; cnt = 0u; mine = 0u;
#pragma unroll
        for (unsigned j = 0; j < 16; ++j) { const unsigned c = xb_ld(&bar[XB_XCNT(j)]); sum += c; cnt += (c > 0u) ? 1u : 0u; mine = (j == x) ? c : mine; }
        if (sum == G) break;
        __builtin_amdgcn_s_sleep(1);
        if ((++sp & 255u) == 0u) { if (xb_ld(&bar[XB_TMO])) break; if (sp > XB_SPIN_CAP) { atomicAdd(&bar[XB_TMO], 1u); break; } }
    }
    nloc = mine > 0u ? mine : 1u; nx = cnt > 0u ? cnt : 1u;
}

__device__ __forceinline__ void xcd_barrier(const XcdBarrier& b) {
    asm volatile("s_waitcnt vmcnt(0)" ::: "memory");
    __syncthreads();
    if (threadIdx.x == 0) {
        unsigned* bar = b.bar;
        __builtin_amdgcn_s_waitcnt(0);
        unsigned nloc = b.st[0], nx = b.st[1];
        if (nloc == 0u) { xcd_barrier_complete(bar, b.x, nloc, nx); b.st[0] = nloc; b.st[1] = nx; }
        const unsigned old = xb_add(&bar[XB_XSUB(b.x)], 1u);
        const unsigned gen = old / nloc;
        if (old + 1u == (gen + 1u) * nloc) {
            __builtin_amdgcn_fence(__ATOMIC_RELEASE, "agent");
            asm volatile("s_waitcnt vmcnt(0)" ::: "memory");
            const unsigned og = xb_add(&bar[XB_TOP], 1u);
            const unsigned tg = og / nx;
            if (og + 1u == (tg + 1u) * nx) xb_add(&bar[XB_TOPGEN], 1u);
            else XB_SPIN(xb_ld(&bar[XB_TOPGEN]) == tg, bar);
            __builtin_amdgcn_fence(__ATOMIC_ACQUIRE, "agent");
            xb_add(&bar[XB_XGEN(b.x)], 1u);
            asm volatile("s_waitcnt vmcnt(0)" ::: "memory");
        } else {
            XB_SPIN(xb_ld(&bar[XB_XGEN(b.x)]) == gen, bar);
            __builtin_amdgcn_fence(__ATOMIC_ACQUIRE, "agent");
            asm volatile("s_waitcnt vmcnt(0)" ::: "memory");
        }
    }
    __syncthreads();
}

namespace pg8 {
#define PG8_LAS __attribute__((address_space(3)))
typedef unsigned short bf16_t;
typedef short bf16x8 __attribute__((ext_vector_type(8)));
typedef float f32x4 __attribute__((ext_vector_type(4)));
typedef unsigned u32x4 __attribute__((ext_vector_type(4)));
constexpr int BM = 256, BK = 64, HALF = 128, HTB = HALF * BK * 2  , STAGE_BYTES = 8 * HTB, NXCD = 8, WGM = 8;

__host__ __device__ __forceinline__ int lds_byte(int r, int c) { const int st = (r >> 4) * 2 + (c >> 5), rr = r & 15, cc = c & 31, ob = rr * 64 + cc * 2; return st * 1024 + (ob ^ (((ob >> 9) & 1) << 5)); }
__host__ __device__ __forceinline__ void stage_rc(int b, int& R, int& C) { const int st = b / 1024, sb = b % 1024, swz = sb ^ (((sb >> 9) & 1) << 5); R = (st >> 1) * 16 + swz / 64; C = (st & 1) * 32 + (swz % 64) / 2; }
__host__ __device__ __forceinline__ int perm32(int rho) { const int n = rho >> 4, i = rho & 15; return 8 * (i >> 2) + 4 * n + (i & 3); }

struct Unit { int pm, pn; };
struct Gemm { const bf16_t* A; const bf16_t* Bt; int M, N, K; };

struct StaticOrder {
    int nM, nN, nwg, G, c;
    __host__ __device__ void init(int M, int N, int G_, int c_) { nM = M / BM; nN = N / BM; nwg = nM * nN; G = G_; c = c_; }
    __host__ __device__ bool next(int i, Unit& u) const {
        const long L = (long)i * G + c; if (L >= nwg) return false;
        int wgid = (int)L; { const int q = nwg / NXCD, r = nwg % NXCD, xcd = wgid % NXCD, off = wgid / NXCD; wgid = (xcd < r ? xcd * (q + 1) : r * (q + 1) + (xcd - r) * q) + off; }
        const int nig = WGM * nN, gid = wgid / nig, fm = gid * WGM, gsz = (nM - fm) < WGM ? (nM - fm) : WGM;
        u.pm = fm + ((wgid % nig) % gsz); u.pn = (wgid % nig) / gsz; return true;
    }
    __device__ __forceinline__ void a_ready(const Unit&) const {}
    __device__ __forceinline__ void done(const Unit&) const {}
};
struct CountedOrder : StaticOrder {
    const unsigned* ready; unsigned need; unsigned* tmo;
    __device__ __forceinline__ void a_ready(const Unit& u) const {
        if (threadIdx.x < 64) {
            const unsigned long long t0 = __builtin_amdgcn_s_memrealtime(); unsigned polls = 0;
            while ((unsigned)__builtin_amdgcn_readfirstlane(__hip_atomic_load(ready + 64 * u.pm, __ATOMIC_RELAXED, __HIP_MEMORY_SCOPE_AGENT)) < need) {
                if ((++polls & 255u) == 0u && __builtin_amdgcn_readfirstlane(__hip_atomic_load(tmo, __ATOMIC_RELAXED, __HIP_MEMORY_SCOPE_AGENT)) != 0u) break;
                if (__builtin_amdgcn_s_memrealtime() - t0 > 2000000ull) {
                    if (threadIdx.x == 0) { unsigned expect = 0u; __hip_atomic_compare_exchange_strong(tmo + 1, &expect, 0x600u | (unsigned)(u.pm & 0xff), __ATOMIC_RELAXED, __ATOMIC_RELAXED, __HIP_MEMORY_SCOPE_AGENT); __hip_atomic_store(tmo, 1u, __ATOMIC_RELAXED, __HIP_MEMORY_SCOPE_AGENT); }
                    break; }
                __builtin_amdgcn_s_sleep(2); }
            __builtin_amdgcn_fence(__ATOMIC_ACQUIRE, "agent");
            asm volatile("s_waitcnt vmcnt(0)" ::: "memory");
        }
#if !defined(BROKEN_HOOK_NO_BARRIER)
        asm volatile("" ::: "memory"); __builtin_amdgcn_s_barrier(); asm volatile("" ::: "memory");
#endif
    }
};

__device__ __forceinline__ unsigned cvt_pk_bf16(float lo, float hi) { unsigned r; asm volatile("v_cvt_pk_bf16_f32 %0, %1, %2" : "=v"(r) : "v"(lo), "v"(hi)); return r; }
typedef float f32x2 __attribute__((ext_vector_type(2)));
__device__ __forceinline__ f32x2 gelu_pk(f32x2 v) {
    const f32x2 av = __builtin_elementwise_abs(v), d = av * 0.2316418882f + 1.0f;
    f32x2 t; t.x = __builtin_amdgcn_rcpf(d.x); t.y = __builtin_amdgcn_rcpf(d.y);
    f32x2 q = t * 0.5307027145f + (-0.7265760135f); q = q * t + 0.7107068705f; q = q * t + (-0.142248368f); q = q * t + 0.127414796f; q = q * t;
    const f32x2 s = (v * v) * (-0.72134752044f);
    f32x2 e; e.x = __builtin_amdgcn_exp2f(s.x); e.y = __builtin_amdgcn_exp2f(s.y);
    const f32x2 m = v * (q * e), r = v - m;
    f32x2 o; o.x = v.x < 0.f ? m.x : r.x; o.y = v.y < 0.f ? m.y : r.y; return o;
}

struct EpiF32 {
    static constexpr bool PERM = false, AFTER_DRAIN = false;
    float* C; int ldc; const float* bias;
    __device__ __forceinline__ void operator()(const f32x4 (&acc)[2][2][4][2], const Unit& u, int wr, int wc, int fr, int fq) const {
        const int row0 = u.pm * BM + wr * 64 + fr, col0 = u.pn * BM + wc * 32 + 4 * fq;
        f32x4 bv[2][2];
#pragma unroll
        for (int bj = 0; bj < 2; ++bj)
#pragma unroll
            for (int n = 0; n < 2; ++n) bv[bj][n] = bias ? *(const f32x4*)(bias + col0 + bj * HALF + n * 16) : (f32x4){0.f, 0.f, 0.f, 0.f};
#pragma unroll
        for (int ai = 0; ai < 2; ++ai)
#pragma unroll
            for (int m = 0; m < 4; ++m) { float* rowp = C + (size_t)(row0 + ai * HALF + m * 16) * ldc + col0;
#pragma unroll
                for (int bj = 0; bj < 2; ++bj)
#pragma unroll
                    for (int n = 0; n < 2; ++n) *(f32x4*)(rowp + bj * HALF + n * 16) = acc[ai][bj][m][n] + bv[bj][n]; }
    }
};
template <int ACT  > struct EpiBf16 {
    static constexpr bool PERM = true, AFTER_DRAIN = false;
    bf16_t* O; int ldc; const float* bias; int split_cols; size_t split_stride;
    __device__ __forceinline__ void operator()(const f32x4 (&acc)[2][2][4][2], const Unit& u, int wr, int wc, int fr, int fq) const {
        const int row0 = u.pm * BM + wr * 64 + fr; int colt = u.pn * BM; bf16_t* base = O;
        if (split_cols) { const int t = colt / split_cols; base += (size_t)t * split_stride; colt -= t * split_cols; }
        const int col0 = colt + wc * 32 + 8 * fq, bcol0 = u.pn * BM + wc * 32 + 8 * fq;
        f32x4 bv[2][2];
#pragma unroll
        for (int bj = 0; bj < 2; ++bj)
#pragma unroll
            for (int n = 0; n < 2; ++n) bv[bj][n] = bias ? *(const f32x4*)(bias + bcol0 + bj * HALF + 4 * n) : (f32x4){0.f, 0.f, 0.f, 0.f};
#pragma unroll
        for (int ai = 0; ai < 2; ++ai)
#pragma unroll
            for (int m = 0; m < 4; ++m) { bf16_t* rowp = base + (size_t)(row0 + ai * HALF + m * 16) * ldc + col0;
#pragma unroll
                for (int bj = 0; bj < 2; ++bj) { f32x4 v0 = acc[ai][bj][m][0] + bv[bj][0], v1 = acc[ai][bj][m][1] + bv[bj][1];
                    if (ACT == 1) { f32x2 a = gelu_pk((f32x2){v0[0], v0[1]}), b = gelu_pk((f32x2){v0[2], v0[3]}), c = gelu_pk((f32x2){v1[0], v1[1]}), d = gelu_pk((f32x2){v1[2], v1[3]});
                        v0 = (f32x4){a.x, a.y, b.x, b.y}; v1 = (f32x4){c.x, c.y, d.x, d.y}; }
                    if (ACT == 2) {
#pragma unroll
                        for (int j = 0; j < 4; ++j) { v0[j] = 0.5f * v0[j] * (1.0f + erff(v0[j] * 0.70710678f)); v1[j] = 0.5f * v1[j] * (1.0f + erff(v1[j] * 0.70710678f)); } }
                    u32x4 w; w.x = cvt_pk_bf16(v0[0], v0[1]); w.y = cvt_pk_bf16(v0[2], v0[3]); w.z = cvt_pk_bf16(v1[0], v1[1]); w.w = cvt_pk_bf16(v1[2], v1[3]);
                    *(u32x4*)(rowp + bj * HALF) = w; } }
    }
};
template <class Epi, class Sched, bool STAMP = false>
__device__ __forceinline__ void gemm_phase(PG8_LAS unsigned char* lds, const Gemm g, const Sched& S, const Epi& E, unsigned long long* stamps) {
    const int tid = ltid(), wid = __builtin_amdgcn_readfirstlane(tid >> 6), lane = tid & 63, wr = wid >> 2, wc = wid & 3, fr = lane & 15, fq = lane >> 4;
    const int K = g.K, nt = K / BK;
    int ts_lo = 0, ts_hi = 0, nts = 0; const unsigned long long rt_entry = STAMP ? (unsigned long long)wall_clock64() : 0ull;
#define PG8_STAMP() do { if (STAMP && wid == 0 && nts < 64) { const unsigned long long _c = (unsigned long long)clock64(); \
        ts_lo = (lane == nts) ? (int)(unsigned)_c : ts_lo; ts_hi = (lane == nts) ? (int)(unsigned)(_c >> 32) : ts_hi; ++nts; } } while (0)
    PG8_STAMP();
    unsigned voffA[2], voffB[2];
#pragma unroll
    for (int i = 0; i < 2; ++i) { int R, C; stage_rc(tid * 16 + i * 8192, R, C); const int Rb = Epi::PERM ? ((R & ~31) + perm32(R & 31)) : R;
        voffA[i] = (unsigned)(R * K + C) * 2u; voffB[i] = (unsigned)(Rb * K + C) * 2u; }
    const size_t kstep = (size_t)(BK * 2);
    const size_t hstep = (size_t)HALF * K * 2;
    const size_t tstep = 2 * hstep;
    const unsigned ldsw = (unsigned)wid * 1024u;
    const int aoff = lds_byte(wr * 64 + fr, fq * 8), boff = lds_byte(wc * 32 + fr, fq * 8);
#define PG8_SA(b, h) (((b) * 2 + (h)) * HTB)
#define PG8_SB(b, h) ((4 + (b) * 2 + (h)) * HTB)
#define PG8_STAGE(bufoff, gbase, voff) do { _Pragma("unroll") for (int _i = 0; _i < 2; ++_i) \
        __builtin_amdgcn_global_load_lds((const unsigned*)((const char*)(gbase) + (voff)[_i]), (PG8_LAS unsigned*)(lds + (bufoff) + ldsw + _i * 8192), 16, 0, 0); } while (0)
#define PG8_LDA(dst, b, h) do { _Pragma("unroll") for (int m = 0; m < 4; ++m) _Pragma("unroll") for (int k = 0; k < 2; ++k) dst[m][k] = *(const PG8_LAS bf16x8*)(lds + PG8_SA(b, h) + aoff + m * 2048 + k * 1024); } while (0)
#define PG8_LDB(dst, b, h) do { _Pragma("unroll") for (int n = 0; n < 2; ++n) _Pragma("unroll") for (int k = 0; k < 2; ++k) dst[n][k] = *(const PG8_LAS bf16x8*)(lds + PG8_SB(b, h) + boff + n * 2048 + k * 1024); } while (0)
#define PG8_MMA(ai, bj, At, Bt) do { __builtin_amdgcn_s_setprio(1); _Pragma("unroll") for (int m = 0; m < 4; ++m) _Pragma("unroll") for (int n = 0; n < 2; ++n) _Pragma("unroll") for (int k = 0; k < 2; ++k) \
        acc[ai][bj][m][n] = __builtin_amdgcn_mfma_f32_16x16x32_bf16(Bt[n][k], At[m][k], acc[ai][bj][m][n], 0, 0, 0); __builtin_amdgcn_s_setprio(0); } while (0)
#define PG8_WAIT_V(n) asm volatile("s_waitcnt vmcnt(" #n ")" ::: "memory")
#define PG8_WAIT_L(n) asm volatile("s_waitcnt lgkmcnt(" #n ")" ::: "memory")
#define PG8_BAR __builtin_amdgcn_s_barrier()
#define PG8_SCHED __builtin_amdgcn_sched_barrier(0)
    Unit cur, nxt; int ui = 0;
    if (!S.next(0, cur)) return;
    f32x4 acc[2][2][4][2];
#pragma unroll
    for (int a = 0; a < 2; ++a)
#pragma unroll
        for (int b = 0; b < 2; ++b)
#pragma unroll
            for (int m = 0; m < 4; ++m)
#pragma unroll
                for (int n = 0; n < 2; ++n) acc[a][b][m][n] = (f32x4){0.f, 0.f, 0.f, 0.f};
    bf16x8 At[4][2], B0[2][2], B1[2][2];
    const char* cA = (const char*)g.A + (size_t)cur.pm * tstep; const char* cB = (const char*)g.Bt + (size_t)cur.pn * tstep;
    S.a_ready(cur);
    PG8_STAGE(PG8_SB(0, 0), cB, voffB); PG8_STAGE(PG8_SA(0, 0), cA, voffA); PG8_STAGE(PG8_SB(0, 1), cB + hstep, voffB); PG8_STAGE(PG8_SA(0, 1), cA + hstep, voffA);
    if (wr == 1) PG8_BAR;
    PG8_WAIT_V(4); PG8_BAR;
    PG8_STAGE(PG8_SB(1, 0), cB + kstep, voffB); PG8_STAGE(PG8_SA(1, 0), cA + kstep, voffA); PG8_STAGE(PG8_SB(1, 1), cB + hstep + kstep, voffB);
    PG8_WAIT_V(6); PG8_BAR;
    PG8_STAMP();
    for (;;) {
        const bool has_next = S.next(ui + 1, nxt);
        const char* nA = has_next ? (const char*)g.A + (size_t)nxt.pm * tstep : cA; const char* nB = has_next ? (const char*)g.Bt + (size_t)nxt.pn * tstep : cB;
        for (int t = 0; t < nt; t += 2) {
            const bool last = (t == nt - 2);
            const char* a1 = cA + (size_t)(t + 1) * kstep;
            const char* a2 = last ? nA : cA + (size_t)(t + 2) * kstep; const char* b2 = last ? nB : cB + (size_t)(t + 2) * kstep;
            const char* a3 = a2 + kstep; const char* b3 = b2 + kstep;
            if (last && has_next) S.a_ready(nxt);
            PG8_LDB(B0, 0, 0); PG8_SCHED; PG8_LDA(At, 0, 0); PG8_STAGE(PG8_SA(1, 1), a1 + hstep, voffA);
            PG8_WAIT_L(8); PG8_BAR; PG8_WAIT_L(0); PG8_MMA(0, 0, At, B0); PG8_BAR; PG8_SCHED;
            PG8_LDB(B1, 0, 1); PG8_STAGE(PG8_SB(0, 0), b2, voffB);
            PG8_BAR; PG8_WAIT_L(0); PG8_MMA(0, 1, At, B1); PG8_BAR;
            PG8_LDA(At, 0, 1); PG8_STAGE(PG8_SA(0, 0), a2, voffA);
            PG8_BAR; PG8_WAIT_L(0); PG8_MMA(1, 0, At, B0); PG8_BAR; PG8_SCHED;
            PG8_STAGE(PG8_SB(0, 1), b2 + hstep, voffB);
            PG8_WAIT_V(6); PG8_BAR; PG8_MMA(1, 1, At, B1); PG8_BAR;
            PG8_LDB(B0, 1, 0); PG8_SCHED; PG8_LDA(At, 1, 0); PG8_STAGE(PG8_SA(0, 1), a2 + hstep, voffA);
            PG8_WAIT_L(8); PG8_BAR; PG8_WAIT_L(0); PG8_MMA(0, 0, At, B0); PG8_BAR; PG8_SCHED;
            PG8_LDB(B1, 1, 1); PG8_STAGE(PG8_SB(1, 0), b3, voffB);
            PG8_BAR; PG8_WAIT_L(0); PG8_MMA(0, 1, At, B1); PG8_BAR;
            PG8_LDA(At, 1, 1); PG8_STAGE(PG8_SA(1, 0), a3, voffA);
            PG8_BAR; PG8_WAIT_L(0); PG8_MMA(1, 0, At, B0); PG8_BAR; PG8_SCHED;
            PG8_STAGE(PG8_SB(1, 1), b3 + hstep, voffB);
            PG8_WAIT_V(6); PG8_BAR; PG8_MMA(1, 1, At, B1); PG8_BAR;
        }
        PG8_STAMP();
        if constexpr (!Epi::AFTER_DRAIN) { E(acc, cur, wr, wc, fr, fq); S.done(cur); }
        PG8_STAMP();
        if (!has_next) break;
#pragma unroll
        for (int a = 0; a < 2; ++a)
#pragma unroll
            for (int b = 0; b < 2; ++b)
#pragma unroll
                for (int m = 0; m < 4; ++m)
#pragma unroll
                    for (int n = 0; n < 2; ++n) acc[a][b][m][n] = (f32x4){0.f, 0.f, 0.f, 0.f};
        cur = nxt; cA = nA; cB = nB; ++ui;
    }
    PG8_WAIT_V(0);
    if (wr == 0) PG8_BAR;
    PG8_BAR;
    if constexpr (Epi::AFTER_DRAIN) { E.fused(acc, cur, wr, wc, fr, fq, lds, wid, lane); S.done(cur); }
    PG8_STAMP();
    if (STAMP && wid == 0) { stamps[lane] = lane < nts ? (((unsigned long long)(unsigned)ts_hi << 32) | (unsigned)ts_lo) : 0ull;
        if (lane == 62) stamps[62] = rt_entry; if (lane == 63) stamps[63] = (unsigned long long)wall_clock64(); }
#undef PG8_STAMP
#undef PG8_SA
#undef PG8_SB
#undef PG8_STAGE
#undef PG8_LDA
#undef PG8_LDB
#undef PG8_MMA
#undef PG8_WAIT_V
#undef PG8_WAIT_L
#undef PG8_BAR
#undef PG8_SCHED
}
}

DI void st_transpose(const float* __restrict__ src, bf16_t* __restrict__ dst, int K, int N, int Kpad, int Npad, float* lds, int bid, int nb) {
  const int tk = Kpad / 64, tn = Npad / 64;
  for (int it = bid; it < tk * tn; it += nb) {
    const int k0 = (it % tk) * 64, n0 = (it / tk) * 64;
    __syncthreads();
    for (int e = ltid(); e < 4096; e += NTHR) { const int i = e >> 6, j = e & 63, k = k0 + i, n = n0 + j; lds[i * 65 + j] = (k < K && n < N) ? src[(size_t)k * N + n] : 0.f; }
    __syncthreads();
    for (int e = ltid(); e < 4096; e += NTHR) { const int j = e >> 6, i = e & 63; dst[(size_t)(n0 + j) * Kpad + k0 + i] = f2bf(lds[i * 65 + j]); }
  }
}

DI void st_mods(const Prm& p, float* lds, int bid, int nb) {
  float* s = lds; float* red = lds + 9 * 2048;
  for (int e = ltid(); e < 9 * 2048; e += NTHR) { const int r = e >> 11, k = e & 2047; const float v = r < 8 ? p.c[r * 2048 + k] : p.c_ctx[k]; s[e] = siluf(v); }
  __syncthreads();
  const int kg = ltid() >> 6, cl = ltid() & 63;
  for (int it = bid; it < 2 * 192; it += nb) {
    const int l = it / 192, cb = (it % 192) * 64;
    const float* w = p.w_ada + (size_t)l * 2048 * NMOD + cb + cl;
    float acc[9];
#pragma unroll
    for (int r = 0; r < 9; ++r) acc[r] = 0.f;
    for (int k = kg * 256; k < kg * 256 + 256; ++k) { const float wv = w[(size_t)k * NMOD];
#pragma unroll
      for (int r = 0; r < 9; ++r) acc[r] += s[r * 2048 + k] * wv; }
#pragma unroll
    for (int r = 0; r < 9; ++r) red[(kg * 9 + r) * 64 + cl] = acc[r];
    __syncthreads();
    for (int e = ltid(); e < 576; e += NTHR) { const int r = e >> 6, c2 = e & 63; float t = 0.f;
      for (int g = 0; g < 8; ++g) t += red[(g * 9 + r) * 64 + c2];
      p.mod[((size_t)l * 9 + r) * NMOD + cb + c2] = t + p.b_ada[l * NMOD + cb + c2]; }
    __syncthreads();
  }
}

DI void st_tables(const Prm& p, int bid, int nb) {
  const size_t stride = (size_t)nb * NTHR, t0 = (size_t)bid * NTHR + ltid();
  for (size_t e = t0; e < (size_t)4096 * 8192; e += stride) { const int k1 = (int)(e >> 13), n = (int)(e & 8191), n1 = n & 4095, idx = (k1 * n1) & 4095;
    float sv, cv; sincosf((float)idx * (6.283185307179586f / 4096.f), &sv, &cv); p.DFTM[e] = f2bf((n < 4096 ? cv : -sv) * (1.f / 64.f)); }
  for (size_t e = t0; e < (size_t)256 * 512; e += stride) { const int k1 = (int)(e >> 9), n = (int)(e & 511), n1 = n & 255, idx = (k1 * n1) & 255;
    float sv, cv; sincosf((float)idx * (6.283185307179586f / 256.f), &sv, &cv); p.DFTC[e] = f2bf((n < 256 ? cv : -sv) * (1.f / 16.f)); }
  for (size_t e = t0; e < (size_t)2 * 128 * 128; e += stride) { const int tb = (int)(e >> 14), k2 = (int)((e >> 7) & 127), n2 = (int)(e & 127), idx = (k2 * n2) & 127;
    float sv, cv; sincosf((float)idx * (6.283185307179586f / 128.f), &sv, &cv); p.CCS[e] = (tb ? sv : cv) * 0.08838834764831845f; }
}

DI void st_modulate(const Prm& p, int layer, int which, bf16_t* __restrict__ dst, int bid, int nb) {
  const int wave = ltid() >> 6, lane = ltid() & 63;
  const int shoff = which ? 3 * DM : 0, scoff = which ? 4 * DM : DM;
  for (int row = bid * 8 + wave; row < MR; row += nb * 8) {
    const int b = row / LT, t = row - b * LT; const bool isc = t >= LL;
    const float* src = (layer == 0 && which == 0) ? (isc ? p.ctx + (size_t)(b * LCX + t - LL) * DM : p.x + (size_t)(b * LL + t) * DM) : p.X + (size_t)row * DM;
    f32x4 v[8]; float ss = 0.f;
#pragma unroll
    for (int i = 0; i < 8; ++i) { v[i] = *(const f32x4*)(src + (i * 64 + lane) * 4); ss += v[i][0] * v[i][0] + v[i][1] * v[i][1] + v[i][2] * v[i][2] + v[i][3] * v[i][3]; }
    ss = wsum(ss); const float rstd = rsqrtf(ss * (1.f / 2048.f) + EPSV);
    const float* mr = p.mod + ((size_t)layer * 9 + (isc ? 8 : b)) * NMOD;
#pragma unroll
    for (int i = 0; i < 8; ++i) { const int col = (i * 64 + lane) * 4; const f32x4 sc = *(const f32x4*)(mr + scoff + col), sh = *(const f32x4*)(mr + shoff + col);
      const f32x4 o = v[i] * rstd * (sc + 1.f) + sh; u32x2 w; w.x = pack2(o[0], o[1]); w.y = pack2(o[2], o[3]); *(u32x2*)(dst + (size_t)row * DM + col) = w; }
  }
}

DI void st_dnprep(const Prm& p, int layer, int bid, int nb) {
  const int wave = ltid() >> 6, lane = ltid() & 63;
  const float* conv = p.dn_conv + (size_t)layer * 5 * 1536;
  for (long task = (long)bid * 8 + wave; task < (long)MR * 13; task += (long)nb * 8) {
    const int row = (int)(task / 13), grp = (int)(task - (long)row * 13);
    const int b = row / LT, t = row - b * LT; const bool isc = t >= LL;
    const int segbase = isc ? b * LT + LL : b * LT, segt = isc ? t - LL : t, seglen = isc ? LCX : LL;
    if (grp < 12) {
      const int c = grp * 128 + lane * 2; float a0 = 0.f, a1 = 0.f;
#pragma unroll
      for (int j = 0; j < 5; ++j) { const int tt = segt + j - 2;
        if (tt >= 0 && tt < seglen) { const unsigned zz = *(const unsigned*)(p.Z + (size_t)(segbase + tt) * NZ + c);
          a0 += bf2f((bf16_t)(zz & 0xffffu)) * conv[j * 1536 + c]; a1 += bf2f((bf16_t)(zz >> 16)) * conv[j * 1536 + c + 1]; } }
      a0 = siluf(a0); a1 = siluf(a1);
      if (grp < 8) { const float ss = wsum(a0 * a0 + a1 * a1); const float sc = rsqrtf(ss + EPSV) * (grp < 4 ? 0.08838834764831845f : 1.f); a0 *= sc; a1 *= sc; }
      *(unsigned*)(p.DNQ + (size_t)row * 1536 + c) = pack2(a0, a1);
    } else if (lane < 16) {
      const int isb = lane >> 3, dh = lane & 7; const float z = bf2f(p.Z[(size_t)row * NZ + (isb ? C_DNB : C_DNA) + dh]); float o;
      if (!isb) { const float xx = z + p.dn_dt_bias[layer * 8 + dh]; const float sp = xx > 20.f ? xx : log1pf(expf(xx)); o = -expf(p.dn_a_log[layer * 8 + dh]) * sp; }
      else o = sigmf(z);
      p.GB[(size_t)row * 16 + lane] = o;
    }
  }
}

DI void st_mlaprep(const Prm& p, int layer, int bid, int nb) {
  const int wave = ltid() >> 6, lane = ltid() & 63;
  const float* qn = p.mla_q_norm + layer * 448; const float* kvn = p.mla_kv_norm + layer * 128;
  for (int row = bid * 8 + wave; row < MR; row += nb * 8) {
    const bf16_t* z = p.Z + (size_t)row * NZ; const int b = row / LT, t = row - b * LT;
    float v[7]; float ss = 0.f;
#pragma unroll
    for (int i = 0; i < 7; ++i) { v[i] = bf2f(z[C_CQ + i * 64 + lane]); ss += v[i] * v[i]; }
    ss = wsum(ss); float rstd = rsqrtf(ss * (1.f / 448.f) + EPSV);
#pragma unroll
    for (int i = 0; i < 7; ++i) p.Aq[(size_t)row * 512 + i * 64 + lane] = f2bf(v[i] * rstd * qn[i * 64 + lane]);
    p.Aq[(size_t)row * 512 + 448 + lane] = 0;
    const float u0 = bf2f(z[C_CKV + lane]), u1 = bf2f(z[C_CKV + 64 + lane]);
    ss = wsum(u0 * u0 + u1 * u1); rstd = rsqrtf(ss * (1.f / 128.f) + EPSV);
    p.Akv[(size_t)row * 256 + lane] = f2bf(u0 * rstd * kvn[lane]); p.Akv[(size_t)row * 256 + 64 + lane] = f2bf(u1 * rstd * kvn[64 + lane]);
    p.Akv[(size_t)row * 256 + 128 + lane] = 0; p.Akv[(size_t)row * 256 + 192 + lane] = 0;
    if (t < LL) {
      if (lane < 32) { const int half = lane >> 4, i = lane & 15; const float x1 = bf2f(z[C_KR + half * 32 + i]), x2 = bf2f(z[C_KR + half * 32 + 16 + i]);
        const float pos = (float)(half ? (t & 63) : (t >> 6)); const float ang = pos * exp2f(-(float)i * (13.287712379549449f / 16.f)); float sv, cv; sincosf(ang, &sv, &cv);
        p.KR[(size_t)row * 64 + half * 32 + i] = f2bf(x1 * cv - x2 * sv); p.KR[(size_t)row * 64 + half * 32 + 16 + i] = f2bf(x2 * cv + x1 * sv); }
    } else p.KR[(size_t)row * 64 + lane] = z[C_KR + lane];
  }
}

DI void st_qrope(const Prm& p, int bid, int nb) {
  const int wave = ltid() >> 6, lane = ltid() & 63;
  for (int row = bid * 8 + wave; row < MR; row += nb * 8) {
    const int b = row / LT, t = row - b * LT; if (t >= LL) continue;
#pragma unroll
    for (int k = 0; k < 2; ++k) { const int pid = lane + 64 * k, h = pid >> 5, r = pid & 31, half = r >> 4, i = r & 15;
      bf16_t* q = p.Qraw + (size_t)row * 768 + h * 192 + 128 + half * 32; const float x1 = bf2f(q[i]), x2 = bf2f(q[16 + i]);
      const float pos = (float)(half ? (t & 63) : (t >> 6)); const float ang = pos * exp2f(-(float)i * (13.287712379549449f / 16.f)); float sv, cv; sincosf(ang, &sv, &cv);
      q[i] = f2bf(x1 * cv - x2 * sv); q[16 + i] = f2bf(x2 * cv + x1 * sv); }
  }
}

DI void st_fnchan(const Prm& p, float* lds, int bid, int nb) {
  float* zt = lds;
  const int wave = __builtin_amdgcn_readfirstlane(ltid() >> 6), lane = ltid() & 63;
  for (int it = bid; it < (MR / 64) * 4; it += nb) {
    const int tile = it >> 2, g = it & 3, row0 = tile * 64, b = row0 / LT, t0 = row0 - b * LT;
    __syncthreads();
    for (int e = ltid(); e < 64 * 128; e += NTHR) { const int i = e >> 7, n2 = e & 127; zt[i * 129 + n2] = bf2f(p.Z[(size_t)(row0 + i) * NZ + C_FN + g * 128 + n2]); }
    __syncthreads();
    for (int kk = 0; kk < 16; ++kk) { const int k2 = wave + 8 * kk; const float* cc = p.CCS + k2 * 128; const float* cs = p.CCS + 16384 + k2 * 128;
      float ap = 0.f, aq = 0.f;
      for (int n2 = 0; n2 < 128; ++n2) { const float zv = zt[lane * 129 + n2]; ap += zv * cc[n2]; aq += zv * cs[n2]; }
      if (t0 < LL) { bf16_t* d = p.PQT + ((size_t)(b * 512 + g * 128 + k2)) * 8192 + t0 + lane; d[0] = f2bf(ap); d[4096] = f2bf(aq); }
      else { bf16_t* d = p.PQTc + ((size_t)(b * 512 + g * 128 + k2)) * 512 + (t0 - LL) + lane; d[0] = f2bf(ap); d[256] = f2bf(aq); } }
  }
}

DI int scan_row(int b, int dir, int s) { return s < LCX ? b * LT + LL + (dir ? LCX - 1 - s : s) : b * LT + (dir ? LL - 1 - (s - LCX) : (s - LCX)); }

DI void st_dnscan(const Prm& p, float* lds, int bid, int nb) {
  float* q_s = lds; float* k_s = lds + 4096; float* v_s = lds + 8192; float* o_s = lds + 12288; float* gb_s = lds + 16384;
  const int tid = ltid(), c = tid >> 2, part = tid & 3;
  for (int chain = bid; chain < 64; chain += nb) {
    const int b = chain >> 3, h = (chain >> 1) & 3, dir = chain & 1;
    float S[32];
#pragma unroll
    for (int j = 0; j < 32; ++j) S[j] = 0.f;
    for (int batch = 0; batch < LT / 32; ++batch) {
      __syncthreads();
      for (int e = tid; e < 32 * 48; e += NTHR) { const int i = e / 48, ch = e - i * 48, pq = ch >> 4, c8 = (ch & 15) * 8; const int row = scan_row(b, dir, batch * 32 + i);
        const bf16x8 vv = *(const bf16x8*)(p.DNQ + (size_t)row * 1536 + pq * 512 + h * 128 + c8); float* d = lds + pq * 4096 + i * 128 + c8;
#pragma unroll
        for (int j = 0; j < 8; ++j) d[j] = bf2f((bf16_t)vv[j]); }
      if (tid < 32) { const int row = scan_row(b, dir, batch * 32 + tid); gb_s[tid * 2] = expf(p.GB[(size_t)row * 16 + dir * 4 + h]); gb_s[tid * 2 + 1] = p.GB[(size_t)row * 16 + 8 + dir * 4 + h]; }
      __syncthreads();
#pragma unroll 1
      for (int i = 0; i < 32; ++i) {
        const float a = gb_s[i * 2], beta = gb_s[i * 2 + 1]; const float* kk = k_s + i * 128 + part * 32; const float* qq = q_s + i * 128 + part * 32;
        float kv[32]; float ks = 0.f;
#pragma unroll
        for (int j = 0; j < 32; j += 4) { const f32x4 t4 = *(const f32x4*)(kk + j); kv[j] = t4[0]; kv[j + 1] = t4[1]; kv[j + 2] = t4[2]; kv[j + 3] = t4[3]; }
#pragma unroll
        for (int j = 0; j < 32; ++j) { S[j] *= a; ks += kv[j] * S[j]; }
        ks += __shfl_xor(ks, 1); ks += __shfl_xor(ks, 2);
        const float vn = beta * (v_s[i * 128 + c] - ks); float o = 0.f;
#pragma unroll
        for (int j = 0; j < 32; j += 4) { const f32x4 q4 = *(const f32x4*)(qq + j);
          S[j] += kv[j] * vn; S[j + 1] += kv[j + 1] * vn; S[j + 2] += kv[j + 2] * vn; S[j + 3] += kv[j + 3] * vn;
          o += q4[0] * S[j] + q4[1] * S[j + 1] + q4[2] * S[j + 2] + q4[3] * S[j + 3]; }
        o += __shfl_xor(o, 1); o += __shfl_xor(o, 2);
        if (part == 0) o_s[i * 128 + c] = o;
      }
      __syncthreads();
      { const int i = tid >> 4, c8 = (tid & 15) * 8; const int row = scan_row(b, dir, batch * 32 + i); const float* s = o_s + i * 128 + c8;
        u32x4 w; w.x = pack2(s[0], s[1]); w.y = pack2(s[2], s[3]); w.z = pack2(s[4], s[5]); w.w = pack2(s[6], s[7]);
        *(u32x4*)(p.OB + ((size_t)(0 * 2 + dir) * MR + row) * 512 + h * 128 + c8) = w; }
    }
  }
}

DI void st_glascan(const Prm& p, int layer, float* lds, int bid, int nb) {
  float* q_s = lds; float* k_s = lds + 2048; float* a_s = lds + 4096; float* v_s = lds + 6144; float* o_s = lds + 10240; float* al_s = lds + 14336;
  const int tid = ltid(), c = tid >> 2, part = tid & 3;
  for (int chain = bid; chain < 64; chain += nb) {
    const int b = chain >> 3, h = (chain >> 1) & 3, dir = chain & 1;
    const float* w2 = p.gla_w2 + (size_t)(layer * 2 + dir) * 16 * 256 + h * 64; const float* b2 = p.gla_b2 + (layer * 2 + dir) * 256 + h * 64;
    float S[16];
#pragma unroll
    for (int j = 0; j < 16; ++j) S[j] = 0.f;
    for (int batch = 0; batch < LT / 32; ++batch) {
      __syncthreads();
      for (int e = tid; e < 32 * 34; e += NTHR) { const int i = e / 34, ch = e - i * 34; const int row = scan_row(b, dir, batch * 32 + i); const bf16_t* z = p.Z + (size_t)row * NZ;
        if (ch < 8) { const bf16x8 vv = *(const bf16x8*)(z + C_GQ + h * 64 + ch * 8);
#pragma unroll
          for (int j = 0; j < 8; ++j) q_s[i * 64 + ch * 8 + j] = bf2f((bf16_t)vv[j]) * 0.125f; }
        else if (ch < 16) { const bf16x8 vv = *(const bf16x8*)(z + C_GK + h * 64 + (ch - 8) * 8);
#pragma unroll
          for (int j = 0; j < 8; ++j) k_s[i * 64 + (ch - 8) * 8 + j] = bf2f((bf16_t)vv[j]); }
        else if (ch < 32) { const bf16x8 vv = *(const bf16x8*)(z + C_GV + h * 128 + (ch - 16) * 8);
#pragma unroll
          for (int j = 0; j < 8; ++j) v_s[i * 128 + (ch - 16) * 8 + j] = bf2f((bf16_t)vv[j]); }
        else { const bf16x8 vv = *(const bf16x8*)(z + C_GALPHA + dir * 16 + (ch - 32) * 8);
#pragma unroll
          for (int j = 0; j < 8; ++j) al_s[i * 16 + (ch - 32) * 8 + j] = bf2f((bf16_t)vv[j]); } }
      __syncthreads();
#pragma unroll
      for (int k = 0; k < 4; ++k) { const int e = tid + NTHR * k, i = e >> 6, d = e & 63; float zz = b2[d];
#pragma unroll
        for (int r = 0; r < 16; ++r) zz += al_s[i * 16 + r] * w2[r * 256 + d];
        const float nz = -zz; const float sp = nz > 20.f ? nz : log1pf(expf(nz));
        a_s[i * 64 + d] = expf(-sp * (1.f / 16.f)); }
      __syncthreads();
#pragma unroll 1
      for (int i = 0; i < 32; ++i) {
        const float vv = v_s[i * 128 + c]; const float* aa = a_s + i * 64 + part * 16; const float* kk = k_s + i * 64 + part * 16; const float* qq = q_s + i * 64 + part * 16; float o = 0.f;
#pragma unroll
        for (int j = 0; j < 16; j += 4) { const f32x4 a4 = *(const f32x4*)(aa + j), k4 = *(const f32x4*)(kk + j), q4 = *(const f32x4*)(qq + j);
          S[j] = a4[0] * S[j] + k4[0] * vv; S[j + 1] = a4[1] * S[j + 1] + k4[1] * vv; S[j + 2] = a4[2] * S[j + 2] + k4[2] * vv; S[j + 3] = a4[3] * S[j + 3] + k4[3] * vv;
          o += q4[0] * S[j] + q4[1] * S[j + 1] + q4[2] * S[j + 2] + q4[3] * S[j + 3]; }
        o += __shfl_xor(o, 1); o += __shfl_xor(o, 2);
        if (part == 0) o_s[i * 128 + c] = o;
      }
      __syncthreads();
      { const int i = tid >> 4, c8 = (tid & 15) * 8; const int row = scan_row(b, dir, batch * 32 + i); const float* s = o_s + i * 128 + c8;
        u32x4 w; w.x = pack2(s[0], s[1]); w.y = pack2(s[2], s[3]); w.z = pack2(s[4], s[5]); w.w = pack2(s[6], s[7]);
        *(u32x4*)(p.OB + ((size_t)(1 * 2 + dir) * MR + row) * 512 + h * 128 + c8) = w; }
    }
  }
}

DI void st_combine(const Prm& p, int layer, int bid, int nb) {
  const int wave = ltid() >> 6, lane = ltid() & 63;
  for (long task = (long)bid * 8 + wave; task < (long)MR * 8; task += (long)nb * 8) {
    const int row = (int)(task >> 3), mh = (int)(task & 7), mixer = mh >> 2, h = mh & 3;
    const unsigned f = *(const unsigned*)(p.OB + ((size_t)(mixer * 2 + 0) * MR + row) * 512 + h * 128 + lane * 2), g = *(const unsigned*)(p.OB + ((size_t)(mixer * 2 + 1) * MR + row) * 512 + h * 128 + lane * 2);
    const float o0 = bf2f((bf16_t)(f & 0xffffu)) + bf2f((bf16_t)(g & 0xffffu)), o1 = bf2f((bf16_t)(f >> 16)) + bf2f((bf16_t)(g >> 16));
    const float ss = wsum(o0 * o0 + o1 * o1), rstd = rsqrtf(ss * (1.f / 128.f) + EPSV);
    const float* w = (mixer ? p.gla_norm : p.dn_norm) + layer * 128 + lane * 2;
    const unsigned gz = *(const unsigned*)(p.Z + (size_t)row * NZ + (mixer ? C_GGATE : C_DNGATE) + h * 128 + lane * 2);
    const float g0 = bf2f((bf16_t)(gz & 0xffffu)), g1 = bf2f((bf16_t)(gz >> 16));
    *(unsigned*)(p.Y + (size_t)row * DM + mixer * 512 + h * 128 + lane * 2) = pack2(o0 * rstd * w[0] * siluf(g0), o1 * rstd * w[1] * siluf(g1));
  }
}

DI unsigned fkey(float f) { const unsigned u = __float_as_uint(f); return u ^ ((u >> 31) ? 0xffffffffu : 0x80000000u); }
DI int pcnt(unsigned long long m) { return __builtin_popcountll(m); }
DI int lanes_below(unsigned long long m) { return (int)__builtin_amdgcn_mbcnt_hi((unsigned)(m >> 32), __builtin_amdgcn_mbcnt_lo((unsigned)m, 0u)); }
DI void st_peertopk(const Prm& p, int layer, unsigned char* lds, int bid, int nb) {
  bf16_t* ks = (bf16_t*)lds;
  float* qsb = (float*)(lds + 2 * 128 * 272);
  const int tid = ltid(), wave = tid >> 6, lane = tid & 63;
  float* qs = qsb + wave * 320; float* selv = qs + 256; int* seli = (int*)(qs + 288);
  int hcur = -1;
  const int nchunk = MR / 64;
  for (int it = bid; it < 8 * nchunk; it += nb) {
    const int h = it / nchunk, chunk = it - h * nchunk;
    if (h != hcur) { __syncthreads();
      const float* kg = p.peer_keys + ((size_t)(layer * 8 + h) * 2) * 128 * 128;
      for (int e = tid; e < 2 * 128 * 128; e += NTHR) { const int pn = e >> 7, k = e & 127; ks[pn * 136 + k] = f2bf(kg[e]); }
      hcur = h; __syncthreads(); }
    for (int rr = 0; rr < 8; ++rr) {
      const int row = chunk * 64 + wave * 8 + rr;
      { const bf16_t* q = p.Qp + (size_t)row * DM + h * 256; const u32x2 w = *(const u32x2*)(q + lane * 4);
        qs[lane * 4] = bf2f((bf16_t)(w.x & 0xffffu)); qs[lane * 4 + 1] = bf2f((bf16_t)(w.x >> 16)); qs[lane * 4 + 2] = bf2f((bf16_t)(w.y & 0xffffu)); qs[lane * 4 + 3] = bf2f((bf16_t)(w.y >> 16)); }
      float s[2][2] = {{0.f, 0.f}, {0.f, 0.f}};
#pragma unroll
      for (int pp = 0; pp < 2; ++pp)
        for (int kc = 0; kc < 16; ++kc) { const f32x4 qa = *(const f32x4*)(qs + pp * 128 + kc * 8), qb = *(const f32x4*)(qs + pp * 128 + kc * 8 + 4);
#pragma unroll
          for (int hh = 0; hh < 2; ++hh) { const bf16x8 kv = *(const bf16x8*)(ks + (pp * 128 + hh * 64 + lane) * 136 + kc * 8);
            s[pp][hh] += qa[0] * bf2f((bf16_t)kv[0]) + qa[1] * bf2f((bf16_t)kv[1]) + qa[2] * bf2f((bf16_t)kv[2]) + qa[3] * bf2f((bf16_t)kv[3])
                       + qb[0] * bf2f((bf16_t)kv[4]) + qb[1] * bf2f((bf16_t)kv[5]) + qb[2] * bf2f((bf16_t)kv[6]) + qb[3] * bf2f((bf16_t)kv[7]); } }
#pragma unroll
      for (int pp = 0; pp < 2; ++pp) { const unsigned k0 = fkey(s[pp][0]), k1 = fkey(s[pp][1]); unsigned T = 0u;
        for (int bit = 31; bit >= 0; --bit) { const unsigned c = T | (1u << bit); if (pcnt(__ballot(k0 >= c)) + pcnt(__ballot(k1 >= c)) >= 16) T = c; }
        const unsigned long long g0 = __ballot(k0 > T), g1 = __ballot(k1 > T), e0 = __ballot(k0 == T), e1 = __ballot(k1 == T);
        const int ng0 = pcnt(g0), ng = ng0 + pcnt(g1), need = 16 - ng, ne0 = pcnt(e0);
        if (k0 > T) { const int r = lanes_below(g0); selv[pp * 16 + r] = s[pp][0]; seli[pp * 16 + r] = lane; }
        if (k1 > T) { const int r = ng0 + lanes_below(g1); selv[pp * 16 + r] = s[pp][1]; seli[pp * 16 + r] = lane + 64; }
        if (k0 == T) { const int r = lanes_below(e0); if (r < need) { selv[pp * 16 + ng + r] = s[pp][0]; seli[pp * 16 + ng + r] = lane; } }
        if (k1 == T) { const int r = ne0 + lanes_below(e1); if (r < need) { selv[pp * 16 + ng + r] = s[pp][1]; seli[pp * 16 + ng + r] = lane + 64; } } }
      __builtin_amdgcn_wave_barrier();
      float cd[4]; unsigned ck[4]; { const float sa = selv[lane >> 2]; const f32x4 sb = *(const f32x4*)(selv + 16 + (lane & 3) * 4);
#pragma unroll
        for (int q = 0; q < 4; ++q) { cd[q] = sa + sb[q]; ck[q] = fkey(cd[q]); } }
      unsigned T = 0u;
      for (int bit = 31; bit >= 0; --bit) { const unsigned c = T | (1u << bit);
        if (pcnt(__ballot(ck[0] >= c)) + pcnt(__ballot(ck[1] >= c)) + pcnt(__ballot(ck[2] >= c)) + pcnt(__ballot(ck[3] >= c)) >= 16) T = c; }
      float mx = fmaxf(fmaxf(cd[0], cd[1]), fmaxf(cd[2], cd[3])); mx = wmax(mx);
      int base = 0; float esum = 0.f; const int ia = seli[lane >> 2]; int rk[4]; float ev[4];
#pragma unroll
      for (int q = 0; q < 4; ++q) { const unsigned long long g = __ballot(ck[q] > T); rk[q] = ck[q] > T ? base + lanes_below(g) : 99; base += pcnt(g); }
#pragma unroll
      for (int q = 0; q < 4; ++q) { const unsigned long long g = __ballot(ck[q] == T); if (ck[q] == T) rk[q] = base + lanes_below(g); base += pcnt(g); }
#pragma unroll
      for (int q = 0; q < 4; ++q) { ev[q] = rk[q] < 16 ? __expf(cd[q] - mx) : 0.f; esum += ev[q]; }
      esum = wsum(esum); const float inv = 1.f / esum;
      int* orow = p.IDX + (size_t)row * 128 + h * 16; float* grow = p.GATE + (size_t)row * 128 + h * 16;
#pragma unroll
      for (int q = 0; q < 4; ++q) if (rk[q] < 16) { orow[rk[q]] = ia * 128 + seli[16 + (lane & 3) * 4 + q]; grow[rk[q]] = ev[q] * inv; }
      __builtin_amdgcn_wave_barrier();
    }
  }
}

DI void st_cvt_tables(const Prm& p, int layer, int bid, int nb) {
  const size_t n8 = (size_t)16384 * DM / 8, stride = (size_t)nb * NTHR;
  const float* U = p.peer_u + (size_t)layer * 16384 * DM; const float* V = p.peer_v + (size_t)layer * 16384 * DM;
  for (size_t e = (size_t)bid * NTHR + ltid(); e < 2 * n8; e += stride) { const bool isv = e >= n8; const size_t k = isv ? e - n8 : e;
    const float* src = (isv ? V : U) + k * 8; const f32x4 a = *(const f32x4*)src, b = *(const f32x4*)(src + 4);
    u32x4 w; w.x = pack2(a[0], a[1]); w.y = pack2(a[2], a[3]); w.z = pack2(b[0], b[1]); w.w = pack2(b[2], b[3]);
    *(u32x4*)((isv ? p.Vb : p.Ub) + k * 8) = w; }
}

typedef __bf16 bf2_t __attribute__((ext_vector_type(2)));
DI float dot2bf(unsigned a, unsigned b, float c) { return __builtin_amdgcn_fdot2_f32_bf16(__builtin_bit_cast(bf2_t, a), __builtin_bit_cast(bf2_t, b), c, false); }
DI void st_peergather(const Prm& p, int layer, float* lds, int bid, int nb, bool dry = false) {
  const int tid = ltid(), wave = tid >> 6, lane = tid & 63;
  for (int row = bid; row < MR; row += nb) {
    const int b = row / LT, t = row - b * LT; const bool isc = t >= LL;
    if (isc && layer == 1) continue;
    u32x4 hv[4];
#pragma unroll
    for (int i = 0; i < 4; ++i) hv[i] = *(const u32x4*)(p.H2 + (size_t)row * DM + i * 512 + lane * 8);
    float acc[32];
#pragma unroll
    for (int i = 0; i < 32; ++i) acc[i] = 0.f;
    const int myidx = lane < 16 ? p.IDX[(size_t)row * 128 + wave * 16 + lane] : 0; const float mygate = lane < 16 ? p.GATE[(size_t)row * 128 + wave * 16 + lane] : 0.f;
#pragma unroll 1
    for (int k0 = 0; k0 < 16; k0 += 4) {
      u32x4 uu[4][4], vv[4][4];
#pragma unroll
      for (int q = 0; q < 4; ++q) { const int e = __builtin_amdgcn_readfirstlane(__shfl(myidx, k0 + q));
        const bf16_t* ur = p.Ub + (size_t)e * DM + lane * 8; const bf16_t* vr = p.Vb + (size_t)e * DM + lane * 8;
#pragma unroll
        for (int i = 0; i < 4; ++i) { uu[q][i] = *(const u32x4*)(ur + i * 512); vv[q][i] = *(const u32x4*)(vr + i * 512); } }
#pragma unroll
      for (int q = 0; q < 4; ++q) { float d = 0.f;
#pragma unroll
        for (int i = 0; i < 4; ++i) { d = dot2bf(uu[q][i].x, hv[i].x, d); d = dot2bf(uu[q][i].y, hv[i].y, d); d = dot2bf(uu[q][i].z, hv[i].z, d); d = dot2bf(uu[q][i].w, hv[i].w, d); }
        d = wsum(d);
        const float wgt = __shfl(mygate, k0 + q) * 0.5f * d * (1.f + erff(d * 0.70710678118654752f));
#pragma unroll
        for (int i = 0; i < 4; ++i) {
          acc[i * 8 + 0] += wgt * __uint_as_float(vv[q][i].x << 16); acc[i * 8 + 1] += wgt * __uint_as_float(vv[q][i].x & 0xffff0000u);
          acc[i * 8 + 2] += wgt * __uint_as_float(vv[q][i].y << 16); acc[i * 8 + 3] += wgt * __uint_as_float(vv[q][i].y & 0xffff0000u);
          acc[i * 8 + 4] += wgt * __uint_as_float(vv[q][i].z << 16); acc[i * 8 + 5] += wgt * __uint_as_float(vv[q][i].z & 0xffff0000u);
          acc[i * 8 + 6] += wgt * __uint_as_float(vv[q][i].w << 16); acc[i * 8 + 7] += wgt * __uint_as_float(vv[q][i].w & 0xffff0000u); } }
    }
    __syncthreads();
#pragma unroll
    for (int i = 0; i < 4; ++i) { float* d = lds + wave * 2048 + i * 512 + lane * 8;
      *(f32x4*)d = (f32x4){acc[i * 8], acc[i * 8 + 1], acc[i * 8 + 2], acc[i * 8 + 3]}; *(f32x4*)(d + 4) = (f32x4){acc[i * 8 + 4], acc[i * 8 + 5], acc[i * 8 + 6], acc[i * 8 + 7]}; }
    __syncthreads();
    { const int col = tid * 4; f32x4 sum = (f32x4){0.f, 0.f, 0.f, 0.f};
#pragma unroll
      for (int w = 0; w < 8; ++w) sum += *(const f32x4*)(lds + w * 2048 + col);
      const f32x4 g2 = *(const f32x4*)(p.mod + ((size_t)layer * 9 + (isc ? 8 : b)) * NMOD + 5 * DM + col);
      float* xr = p.X + (size_t)row * DM + col; if (!dry) *(f32x4*)xr = *(const f32x4*)xr + g2 * sum; }
  }
}

DI void st_final(const Prm& p, int bid, int nb) {
  const int wave = ltid() >> 6, lane = ltid() & 63;
  for (int r = bid * 8 + wave; r < NB * LL; r += nb * 8) {
    const int b = r / LL, t = r - b * LL; const float* src = p.X + (size_t)(b * LT + t) * DM;
    f32x4 v[8]; float ss = 0.f;
#pragma unroll
    for (int i = 0; i < 8; ++i) { v[i] = *(const f32x4*)(src + (i * 64 + lane) * 4); ss += v[i][0] * v[i][0] + v[i][1] * v[i][1] + v[i][2] * v[i][2] + v[i][3] * v[i][3]; }
    ss = wsum(ss); const float rstd = rsqrtf(ss * (1.f / 2048.f) + EPSV);
#pragma unroll
    for (int i = 0; i < 8; ++i) { const int col = (i * 64 + lane) * 4; *(f32x4*)(p.out + (size_t)r * DM + col) = v[i] * rstd * *(const f32x4*)(p.final_norm + col); }
  }
}

namespace att {
constexpr int NW = 8, QBLK = 32, KVBLK = 64;
constexpr float SCALE = 0.07216878364870322f;
constexpr float THR = 8.f;
constexpr int LDQ = 768, LDK = 1024, LDKR = 64, LDO = DM;
constexpr int SHM_V = KVBLK * 128 * 2, SHM_K = KVBLK * 128 * 2, SHM_KR = KVBLK * 64 * 2, SHM_ATTN = 2 * SHM_V + 2 * SHM_K + 2 * SHM_KR + NW * 64 * 4;
#define KSWZ(row, colB) ((row) * 256 + ((colB) ^ (((row) & 7) << 4)))
#define KRSWZ(row, colB) ((row) * 128 + ((colB) ^ ((((row) >> 1) & 7) << 4)))
#define SBAR() __builtin_amdgcn_sched_barrier(0)
DI int crow(int r, int hi) { return (r & 3) + 8 * (r >> 2) + 4 * hi; }
DI unsigned cvtpk(float lo, float hi) { unsigned r; asm volatile("v_cvt_pk_bf16_f32 %0, %1, %2" : "=v"(r) : "v"(lo), "v"(hi)); return r; }

DI void partialSM(f32x16& p0, f32x16& p1, float& m_reg, float& mn, float& alpha) {
  constexpr float C = SCALE * 1.4426950408889634f;
  float pmax = p0[0];
#pragma unroll
  for (int r = 1; r < 16; ++r) pmax = fmaxf(pmax, p0[r]);
#pragma unroll
  for (int r = 0; r < 16; ++r) pmax = fmaxf(pmax, p1[r]);
  { auto rr = __builtin_amdgcn_permlane32_swap(__float_as_uint(pmax), __float_as_uint(pmax), false, false);
    pmax = fmaxf(__uint_as_float(rr[0]), __uint_as_float(rr[1])); }
  if (__builtin_expect(__all(pmax - m_reg <= THR / SCALE), 1)) { mn = m_reg; alpha = 1.f; }
  else { mn = fmaxf(m_reg, pmax); alpha = __builtin_amdgcn_exp2f((m_reg - mn) * C); m_reg = mn; }
  const float mnC = -mn * C;
#pragma unroll
  for (int r = 0; r < 16; ++r) p0[r] = fmaf(p0[r], C, mnC);
#pragma unroll
  for (int r = 0; r < 16; ++r) p1[r] = fmaf(p1[r], C, mnC);
#pragma unroll
  for (int r = 0; r < 16; ++r) p0[r] = __builtin_amdgcn_exp2f(p0[r]);
}
DI void finishSM(f32x16& p0, f32x16& p1, float alpha, float& l_reg, bf16x8& pa0, bf16x8& pa1, bf16x8& pa2, bf16x8& pa3) {
#pragma unroll
  for (int r = 0; r < 16; ++r) p1[r] = __builtin_amdgcn_exp2f(p1[r]);
  float ps = 0;
#pragma unroll
  for (int r = 0; r < 16; ++r) ps += p0[r];
#pragma unroll
  for (int r = 0; r < 16; ++r) ps += p1[r];
  { auto rr = __builtin_amdgcn_permlane32_swap(__float_as_uint(ps), __float_as_uint(ps), false, false);
    ps = __uint_as_float(rr[0]) + __uint_as_float(rr[1]); }
  l_reg = l_reg * alpha + ps;
#define PK4(P, BASE, OUT) do { unsigned a0 = cvtpk(P[BASE + 0], P[BASE + 1]), a1 = cvtpk(P[BASE + 2], P[BASE + 3]);   \
    unsigned b0 = cvtpk(P[BASE + 4], P[BASE + 5]), b1 = cvtpk(P[BASE + 6], P[BASE + 7]);                              \
    auto r0 = __builtin_amdgcn_permlane32_swap(a0, b0, false, false); auto r1 = __builtin_amdgcn_permlane32_swap(a1, b1, false, false); \
    u32x4 w = {r0[0], r1[0], r0[1], r1[1]}; OUT = *reinterpret_cast<bf16x8*>(&w); } while (0)
  PK4(p0, 0, pa0); PK4(p0, 8, pa1); PK4(p1, 0, pa2); PK4(p1, 8, pa3);
#undef PK4
}
DI void qkt(f32x16& p0, f32x16& p1, const char* Ks, const char* KRs, const bf16x8* qr, int r32, int hi) {
  p0 = f32x16{}; p1 = f32x16{};
#pragma unroll
  for (int d0 = 0; d0 < 8; ++d0) { const int cb = (d0 * 16 + hi * 8) * 2;
    const bf16x8 b0 = *reinterpret_cast<const bf16x8*>(Ks + KSWZ(r32, cb));
    const bf16x8 b1 = *reinterpret_cast<const bf16x8*>(Ks + KSWZ(32 + r32, cb));
    p0 = __builtin_amdgcn_mfma_f32_32x32x16_bf16(b0, qr[d0], p0, 0, 0, 0);
    p1 = __builtin_amdgcn_mfma_f32_32x32x16_bf16(b1, qr[d0], p1, 0, 0, 0); }
#pragma unroll
  for (int d0 = 0; d0 < 4; ++d0) { const int cb = (d0 * 16 + hi * 8) * 2;
    const bf16x8 b0 = *reinterpret_cast<const bf16x8*>(KRs + KRSWZ(r32, cb));
    const bf16x8 b1 = *reinterpret_cast<const bf16x8*>(KRs + KRSWZ(32 + r32, cb));
    p0 = __builtin_amdgcn_mfma_f32_32x32x16_bf16(b0, qr[8 + d0], p0, 0, 0, 0);
    p1 = __builtin_amdgcn_mfma_f32_32x32x16_bf16(b1, qr[8 + d0], p1, 0, 0, 0); }
}
DI int v_st(int k, int c) { const int kk = (k & ~0xC) | ((k & 4) << 1) | ((k & 8) >> 1); return ((kk >> 3) * 4 + (c >> 5)) * 512 + ((kk & 7) * 32 + (c & 31)) * 2; }
DI int v_rd_base(int lane) { return ((lane & 3) << 3) | (((lane >> 2) & 3) << 6) | (((lane >> 4) & 1) << 5) | (((lane >> 5) & 1) << 8); }
constexpr int v_rd_off(int d0, int ks, int half) { return d0 * 512 + ks * 4096 + half * 2048; }
template <int OFF> DI s16x4 tr_read(int vb) { s16x4 r; asm volatile("ds_read_b64_tr_b16 %0, %1 offset:%2" : "=&v"(r) : "v"(vb), "i"(OFF) : "memory"); return r; }
template <int D0> DI void pv_one(f32x16& od, int vb, bf16x8 pa0, bf16x8 pa1, bf16x8 pa2, bf16x8 pa3) {
  const s16x4 l0 = tr_read<v_rd_off(D0, 0, 0)>(vb), h0 = tr_read<v_rd_off(D0, 0, 1)>(vb), l1 = tr_read<v_rd_off(D0, 1, 0)>(vb), h1 = tr_read<v_rd_off(D0, 1, 1)>(vb);
  const s16x4 l2 = tr_read<v_rd_off(D0, 2, 0)>(vb), h2 = tr_read<v_rd_off(D0, 2, 1)>(vb), l3 = tr_read<v_rd_off(D0, 3, 0)>(vb), h3 = tr_read<v_rd_off(D0, 3, 1)>(vb);
  asm volatile("s_waitcnt lgkmcnt(0)" ::: "memory"); SBAR();
#define PK(L, H) (bf16x8){L[0], L[1], L[2], L[3], H[0], H[1], H[2], H[3]}
  od = __builtin_amdgcn_mfma_f32_32x32x16_bf16(pa0, PK(l0, h0), od, 0, 0, 0);
  od = __builtin_amdgcn_mfma_f32_32x32x16_bf16(pa1, PK(l1, h1), od, 0, 0, 0);
  od = __builtin_amdgcn_mfma_f32_32x32x16_bf16(pa2, PK(l2, h2), od, 0, 0, 0);
  od = __builtin_amdgcn_mfma_f32_32x32x16_bf16(pa3, PK(l3, h3), od, 0, 0, 0);
#undef PK
}
DI void pv_d0(f32x16* o, int vb, bf16x8 pa0, bf16x8 pa1, bf16x8 pa2, bf16x8 pa3) {
  pv_one<0>(o[0], vb, pa0, pa1, pa2, pa3); pv_one<1>(o[1], vb, pa0, pa1, pa2, pa3); pv_one<2>(o[2], vb, pa0, pa1, pa2, pa3); pv_one<3>(o[3], vb, pa0, pa1, pa2, pa3);
}

DI void attn_body(const bf16_t* __restrict__ Qb, const bf16_t* __restrict__ Kh, const bf16_t* __restrict__ Vh, const bf16_t* __restrict__ KRh, bf16_t* __restrict__ Ob, int seq, int tpos0, char* lds) {
  const int tid = ltid(), wid = tid >> 6, lane = tid & 63, r32 = lane & 31, hi = lane >> 5;
  char* V_lds = lds; char* K_lds = lds + 2 * SHM_V; char* KR_lds = lds + 2 * SHM_V + 2 * SHM_K;
  float* ws = (float*)(lds + 2 * SHM_V + 2 * SHM_K + 2 * SHM_KR) + wid * 64; float* li_l = ws; float* al_l = ws + 32;
  float m_reg = -1e30f, l_reg = 0; f32x16 o[4] = {}; bf16x8 qr[12];
  const bf16_t* Qw = Qb + (long)(wid * QBLK + r32) * LDQ + hi * 8;
#pragma unroll
  for (int d0 = 0; d0 < 12; ++d0) qr[d0] = *reinterpret_cast<const bf16x8*>(Qw + d0 * 16);
  if (tpos0 >= 0) {
    const int t = tpos0 + wid * QBLK + r32;
#pragma unroll
    for (int hf = 0; hf < 2; ++hf) { const float pos = (float)(hf ? (t & 63) : (t >> 6));
#pragma unroll
      for (int j = 0; j < 8; ++j) { const float ang = pos * exp2f(-(float)(hi * 8 + j) * (13.287712379549449f / 16.f)); float sv, cv; sincosf(ang, &sv, &cv);
        const float x1 = bf2f((bf16_t)qr[8 + 2 * hf][j]), x2 = bf2f((bf16_t)qr[9 + 2 * hf][j]);
        qr[8 + 2 * hf][j] = (short)f2bf(x1 * cv - x2 * sv); qr[9 + 2 * hf][j] = (short)f2bf(x2 * cv + x1 * sv); } }
  }
  const int sr = tid >> 4, sc = (tid & 15) * 8, vst0 = v_st(sr, sc), vst1 = v_st(32 + sr, sc);
  const int krr = tid >> 3, krc = (tid & 7) * 8;
  const int vb0 = (int)(uintptr_t)V_lds + v_rd_base(lane);
  bf16x8 vs0, vs1, ks0, ks1, kr0;
#define SLOAD(k0) do { vs0 = *reinterpret_cast<const bf16x8*>(&Vh[(long)((k0) + sr) * LDK + sc]); vs1 = *reinterpret_cast<const bf16x8*>(&Vh[(long)((k0) + 32 + sr) * LDK + sc]); \
    ks0 = *reinterpret_cast<const bf16x8*>(&Kh[(long)((k0) + sr) * LDK + sc]); ks1 = *reinterpret_cast<const bf16x8*>(&Kh[(long)((k0) + 32 + sr) * LDK + sc]); \
    kr0 = *reinterpret_cast<const bf16x8*>(&KRh[(long)((k0) + krr) * LDKR + krc]); } while (0)
#define SWRITE(b) do { *(bf16x8*)(V_lds + (b) * SHM_V + vst0) = vs0; *(bf16x8*)(V_lds + (b) * SHM_V + vst1) = vs1; const int kc = sc * 2;               \
    *(bf16x8*)(K_lds + (b) * SHM_K + KSWZ(sr, kc)) = ks0; *(bf16x8*)(K_lds + (b) * SHM_K + KSWZ(32 + sr, kc)) = ks1;                       \
    *(bf16x8*)(KR_lds + (b) * SHM_KR + KRSWZ(krr, krc * 2)) = kr0; } while (0)
#define SWAIT() asm volatile("s_waitcnt vmcnt(0)" ::: "memory")
#define RESC(a) do { if (__any((a) < 1.f)) { if (hi == 0) al_l[r32] = (a); asm volatile("s_waitcnt lgkmcnt(0)" ::: "memory"); \
    _Pragma("unroll") for (int d = 0; d < 4; ++d) _Pragma("unroll") for (int r = 0; r < 16; ++r) o[d][r] *= al_l[crow(r, hi)]; } } while (0)
  f32x16 p0, p1; float mn, al; bf16x8 pa0, pa1, pa2, pa3; const int NT = seq / KVBLK;
  SLOAD(0); SWAIT(); SWRITE(0); __syncthreads();
  for (int j = 0; j < NT; ++j) {
    const int buf = j & 1; const bool more = j + 1 < NT;
    if (more) SLOAD((j + 1) * KVBLK);
    SBAR(); qkt(p0, p1, K_lds + buf * SHM_K, KR_lds + buf * SHM_KR, qr, r32, hi);
    partialSM(p0, p1, m_reg, mn, al); RESC(al);
    finishSM(p0, p1, al, l_reg, pa0, pa1, pa2, pa3); SBAR();
    pv_d0(o, vb0 + buf * SHM_V, pa0, pa1, pa2, pa3);
    if (more) { SWAIT(); SWRITE(buf ^ 1); }
    __syncthreads();
  }
  if (hi == 0) li_l[r32] = l_reg; asm volatile("s_waitcnt lgkmcnt(0)" ::: "memory");
  float rli[16];
#pragma unroll
  for (int r = 0; r < 16; ++r) rli[r] = __builtin_amdgcn_rcpf(li_l[crow(r, hi)]);
  bf16_t* Ow = Ob + (long)(wid * QBLK) * LDO;
#pragma unroll
  for (int r = 0; r < 16; ++r) { const int orow = crow(r, hi);
#pragma unroll
    for (int d0 = 0; d0 < 4; ++d0) Ow[(long)orow * LDO + d0 * 32 + r32] = f2bf(o[d0][r] * rli[r]); }
  __syncthreads();
#undef SLOAD
#undef SWRITE
#undef SWAIT
#undef RESC
}
}

DI void st_attn(const Prm& p, int layer, char* lds, int bid, int nb) {
  const int nlat = NB * 4 * 16, nitem = nlat + (layer == 0 ? NB * 4 : 0);
  for (int it = bid; it < nitem; it += nb) {
    if (it < nlat) { const int b = it >> 6, h = (it >> 4) & 3, qb = it & 15; const size_t r0 = (size_t)b * LT;
      att::attn_body(p.Qraw + (r0 + qb * 256) * 768 + h * 192, p.KV + r0 * 1024 + h * 256, p.KV + r0 * 1024 + h * 256 + 128, p.KR + r0 * 64,
                     p.Y + (r0 + qb * 256) * DM + 1024 + h * 128, LT, qb * 256, lds); }
    else { const int k = it - nlat, b = k >> 2, h = k & 3; const size_t r0 = (size_t)b * LT + LL;
      att::attn_body(p.Qraw + r0 * 768 + h * 192, p.KV + r0 * 1024 + h * 256, p.KV + r0 * 1024 + h * 256 + 128, p.KR + r0 * 64, p.Y + r0 * DM + 1024 + h * 128, LCX, -1, lds); }
  }
}

struct EpiResid {
  static constexpr bool PERM = false, AFTER_DRAIN = false;
  const float* xlat; const float* xctx; float* X; const float* modl; int first;
  __device__ __forceinline__ void operator()(const pg8::f32x4 (&acc)[2][2][4][2], const pg8::Unit& u, int wr, int wc, int fr, int fq) const {
    const int b = u.pm / 17, tl = u.pm - b * 17; const bool isc = tl == 16;
    const float* g = modl + (size_t)(isc ? 8 : b) * NMOD + 2 * DM;
    const int rloc0 = wr * 64 + fr, col0 = u.pn * 256 + wc * 32 + 4 * fq;
    pg8::f32x4 gv[2][2];
#pragma unroll
    for (int bj = 0; bj < 2; ++bj)
#pragma unroll
      for (int n = 0; n < 2; ++n) gv[bj][n] = *(const pg8::f32x4*)(g + col0 + bj * 128 + n * 16);
#pragma unroll
    for (int ai = 0; ai < 2; ++ai)
#pragma unroll
      for (int m = 0; m < 4; ++m) { const int rl = rloc0 + ai * 128 + m * 16; const size_t row = (size_t)u.pm * 256 + rl;
        const float* src = first ? (isc ? xctx + ((size_t)b * LCX + rl) * DM : xlat + ((size_t)b * LL + tl * 256 + rl) * DM) : X + row * DM;
        float* dst = X + row * DM;
#pragma unroll
        for (int bj = 0; bj < 2; ++bj)
#pragma unroll
          for (int n = 0; n < 2; ++n) { const int c = col0 + bj * 128 + n * 16; *(pg8::f32x4*)(dst + c) = *(const pg8::f32x4*)(src + c) + gv[bj][n] * acc[ai][bj][m][n]; } }
  }
};

template <class Epi> DI void run_gemm(unsigned char* lds, const bf16_t* A, const bf16_t* Bt, int M, int N, int K, const Epi& E, int bid, int nb) {
  pg8::Gemm g; g.A = A; g.Bt = Bt; g.M = M; g.N = N; g.K = K;
  pg8::StaticOrder S; S.init(M, N, nb, bid);
  pg8::gemm_phase<Epi, pg8::StaticOrder, false>((PG8_LAS unsigned char*)lds, g, S, E, nullptr);
}
DI pg8::EpiBf16<0> epi_bf16(bf16_t* O, int ldc, int split_cols = 0, size_t split_stride = 0) { pg8::EpiBf16<0> e; e.O = O; e.ldc = ldc; e.bias = nullptr; e.split_cols = split_cols; e.split_stride = split_stride; return e; }

#ifndef PROBE
#define PROBE 0
#endif
constexpr int LDS_MAIN = 131072, LDS_TOTAL = LDS_MAIN + 64;
#define PRM() (*(const __attribute__((address_space(4))) Prm*)launder_k(kp))
typedef const __attribute__((address_space(4))) void* kptr_t;
DI kptr_t launder_k(kptr_t q) { asm volatile("" : "+s"(q)); return q; }
extern __shared__ __attribute__((aligned(16))) unsigned char shm[];
__global__ void __launch_bounds__(NTHR, 2) mega(Prm p_unused) {
#if defined(__HIP_DEVICE_COMPILE__)
  kptr_t kp = (kptr_t)__builtin_amdgcn_kernarg_segment_ptr();
  const int bid0 = blockIdx.x, nb0 = gridDim.x;
#define bid lsg(bid0)
#define nb lsg(nb0)
  uint4* xbw = (uint4*)(shm + LDS_MAIN);
  if (threadIdx.x == 0) *xbw = make_uint4(0u, 0u, 0u, 0u);
  __syncthreads();
  { const Prm p = PRM(); (void)xcd_barrier_post(p.bar, (volatile LAS unsigned*)xbw); }
#define GRID_BAR() do { XcdBarrier b_; b_.bar = PRM().bar; b_.x = xb_xcc_id(); b_.st = (volatile LAS unsigned*)(shm + LDS_MAIN); xcd_barrier(b_); } while (0)
  float* lf = (float*)shm;
  for (int ly = 0; ly < 2; ++ly) { const Prm p = PRM();
    st_transpose(p.w_in + (size_t)ly * DM * IN_W, p.WinT + (size_t)ly * NZ * DM, DM, IN_W, DM, NZ, lf, bid, nb);
    st_transpose(p.w_out + (size_t)ly * DM * DM, p.WoutT + (size_t)ly * DM * DM, DM, DM, DM, DM, lf, bid, nb);
    st_transpose(p.peer_wq + (size_t)ly * DM * DM, p.WqT + (size_t)ly * DM * DM, DM, DM, DM, DM, lf, bid, nb);
    st_transpose(p.mla_w_uq + (size_t)ly * 448 * 768, p.WuqT + (size_t)ly * 768 * 512, 448, 768, 512, 768, lf, bid, nb);
    st_transpose(p.mla_w_ukv + (size_t)ly * 128 * 1024, p.WukvT + (size_t)ly * 1024 * 256, 128, 1024, 256, 1024, lf, bid, nb);
  }
  { const Prm p = PRM(); st_tables(p, bid, nb); }
  __syncthreads();
  { const Prm p = PRM(); st_mods(p, lf, bid, nb); }
  GRID_BAR();
  for (int l = 0; l < 2; ++l) {
    { const Prm p = PRM(); st_modulate(p, l, 0, p.H, bid, nb); }
    GRID_BAR();
    { const Prm p = PRM(); run_gemm(shm, p.H, p.WinT + (size_t)l * NZ * DM, MR, NZ, DM, epi_bf16(p.Z, NZ), bid, nb); }
    if (PROBE == 6) { const Prm p = PRM(); run_gemm(shm, p.H, p.WinT + (size_t)l * NZ * DM, MR, NZ, DM, epi_bf16(p.Z, NZ), bid, nb); }
    GRID_BAR();
    { const Prm p = PRM(); st_dnprep(p, l, bid, nb); }
    { const Prm p = PRM(); st_mlaprep(p, l, bid, nb); }
    { const Prm p = PRM(); st_fnchan(p, lf, bid, nb); }
    GRID_BAR();
    if (bid < 64) { const Prm p = PRM(); st_dnscan(p, lf, bid, 64); }
    else if (bid < 128) { const Prm p = PRM(); st_glascan(p, l, lf, bid - 64, 64); }
    else {
      const int b2 = bid - 128, n2 = nb - 128;
      { const Prm p = PRM(); run_gemm(shm, p.Aq, p.WuqT + (size_t)l * 768 * 512, MR, 768, 512, epi_bf16(p.Qraw, 768), b2, n2); }
      { const Prm p = PRM(); run_gemm(shm, p.Akv, p.WukvT + (size_t)l * 1024 * 256, MR, 1024, 256, epi_bf16(p.KV, 1024), b2, n2); }
      { const Prm p = PRM(); run_gemm(shm, p.DFTM, p.PQT, 4096, 4096, 8192, epi_bf16(p.Y + 1536, DM, 512, (size_t)LT * DM), b2, n2); }
      if (l == 0) { const Prm p = PRM(); run_gemm(shm, p.DFTC, p.PQTc, 256, 4096, 512, epi_bf16(p.Y + (size_t)LL * DM + 1536, DM, 512, (size_t)LT * DM), b2, n2); }
    }
    if (PROBE == 2) { GRID_BAR();
      if (bid < 64) { const Prm p = PRM(); st_dnscan(p, lf, bid, 64); }
      else if (bid < 128) { const Prm p = PRM(); st_glascan(p, l, lf, bid - 64, 64); }
      else { const int b2 = bid - 128, n2 = nb - 128;
        { const Prm p = PRM(); run_gemm(shm, p.Aq, p.WuqT + (size_t)l * 768 * 512, MR, 768, 512, epi_bf16(p.Qraw, 768), b2, n2); }
        { const Prm p = PRM(); run_gemm(shm, p.Akv, p.WukvT + (size_t)l * 1024 * 256, MR, 1024, 256, epi_bf16(p.KV, 1024), b2, n2); }
        { const Prm p = PRM(); run_gemm(shm, p.DFTM, p.PQT, 4096, 4096, 8192, epi_bf16(p.Y + 1536, DM, 512, (size_t)LT * DM), b2, n2); } } }
    if (PROBE == 7) { GRID_BAR(); if (bid < 64) { const Prm p = PRM(); st_dnscan(p, lf, bid, 64); } }
    if (PROBE == 8) { GRID_BAR(); if (bid < 64) { const Prm p = PRM(); st_glascan(p, l, lf, bid, 64); } }
    GRID_BAR();
    { const Prm p = PRM(); st_attn(p, l, (char*)shm, bid, nb); }
    if (PROBE == 3) { const Prm p = PRM(); st_attn(p, l, (char*)shm, bid, nb); }
    { const Prm p = PRM(); st_combine(p, l, bid, nb); }
    GRID_BAR();
    { const Prm p = PRM(); EpiResid e; e.xlat = p.x; e.xctx = p.ctx; e.X = p.X; e.modl = p.mod + (size_t)l * 9 * NMOD; e.first = l == 0;
      run_gemm(shm, p.Y, p.WoutT + (size_t)l * DM * DM, MR, DM, DM, e, bid, nb); }
    GRID_BAR();
    { const Prm p = PRM(); st_modulate(p, l, 1, p.H2, bid, nb); }
    { const Prm p = PRM(); st_cvt_tables(p, l, bid, nb); }
    GRID_BAR();
    { const Prm p = PRM(); run_gemm(shm, p.H2, p.WqT + (size_t)l * DM * DM, MR, DM, DM, epi_bf16(p.Qp, DM), bid, nb); }
    GRID_BAR();
    { const Prm p = PRM(); st_peertopk(p, l, shm, bid, nb); }
    if (PROBE == 4) { __syncthreads(); const Prm p = PRM(); st_peertopk(p, l, shm, bid, nb); }
    GRID_BAR();
    { const Prm p = PRM(); st_peergather(p, l, lf, bid, nb); }
    if (PROBE == 1) { __syncthreads(); const Prm p = PRM(); st_peergather(p, l, lf, bid, nb, true); }
    GRID_BAR();
  }
  { const Prm p = PRM(); st_final(p, bid, nb); }
#endif
#undef bid
#undef nb
#undef GRID_BAR
}

static size_t al256(size_t x) { return (x + 255) / 256 * 256; }
extern "C" void kernel_launch(void* const* d_in, const int* in_sizes, int n_in, void* d_out, int out_size, void* d_ws, size_t ws_size, hipStream_t stream) {
  Prm p{};
  const float** f = (const float**)&p.x;
  for (int i = 0; i < 24; ++i) f[i] = (const float*)d_in[i];
  p.out = (float*)d_out;
  char* w = (char*)d_ws; size_t o = 0;
  auto take = [&](size_t bytes) { char* r = w + o; o += al256(bytes); return r; };
  p.bar = (unsigned*)take(16384);
  p.WinT = (bf16_t*)take((size_t)2 * NZ * DM * 2); p.WoutT = (bf16_t*)take((size_t)2 * DM * DM * 2); p.WqT = (bf16_t*)take((size_t)2 * DM * DM * 2);
  p.WuqT = (bf16_t*)take((size_t)2 * 768 * 512 * 2); p.WukvT = (bf16_t*)take((size_t)2 * 1024 * 256 * 2);
  p.mod = (float*)take((size_t)2 * 9 * NMOD * 4); p.GB = (float*)take((size_t)MR * 16 * 4); p.CCS = (float*)take((size_t)2 * 128 * 128 * 4);
  p.DFTM = (bf16_t*)take((size_t)4096 * 8192 * 2); p.DFTC = (bf16_t*)take((size_t)256 * 512 * 2);
  p.X = (float*)take((size_t)MR * DM * 4);
  p.Z = (bf16_t*)take((size_t)MR * NZ * 2);
  char* ra = take((size_t)MR * 1536 * 2 + (size_t)4 * MR * 512 * 2);
  p.DNQ = (bf16_t*)ra; p.OB = (bf16_t*)(ra + (size_t)MR * 1536 * 2); p.H = (bf16_t*)ra;
  p.Ub = (bf16_t*)ra; p.Vb = (bf16_t*)(ra + (size_t)16384 * DM * 2);
  p.KV = (bf16_t*)take((size_t)MR * 1024 * 2); p.KR = (bf16_t*)take((size_t)MR * 64 * 2);
  p.Aq = (bf16_t*)take((size_t)MR * 512 * 2); p.Akv = (bf16_t*)take((size_t)MR * 256 * 2);
  if (o > ws_size) return;
  char* q = (char*)d_out; size_t oo = 0;
  p.Y = (bf16_t*)q; oo += (size_t)MR * DM * 2; p.PQT = (bf16_t*)(q + oo); oo += (size_t)8 * 512 * 8192 * 2; p.PQTc = (bf16_t*)(q + oo); oo += (size_t)8 * 512 * 512 * 2;
  p.Qraw = (bf16_t*)(q + oo); oo += (size_t)MR * 768 * 2;
  char* z = (char*)p.Z; p.H2 = (bf16_t*)z; p.Qp = (bf16_t*)(z + (size_t)MR * DM * 2); p.IDX = (int*)(z + (size_t)2 * MR * DM * 2); p.GATE = (float*)(z + (size_t)2 * MR * DM * 2 + (size_t)MR * 128 * 4);

  static int grid = 0;
  if (!grid) {
    (void)hipFuncSetAttribute((const void*)mega, hipFuncAttributeMaxDynamicSharedMemorySize, LDS_TOTAL);
    int dev = 0, cus = 0, per_cu = 0;
    (void)hipGetDevice(&dev); (void)hipDeviceGetAttribute(&cus, hipDeviceAttributeMultiprocessorCount, dev);
    (void)hipOccupancyMaxActiveBlocksPerMultiprocessor(&per_cu, (const void*)mega, NTHR, LDS_TOTAL);
    grid = per_cu >= 1 ? cus : 0;
    if (grid > 256) grid = 256;
  }
  if (grid < 256) return;
  (void)hipMemsetAsync(p.bar, 0, XCD_BAR_WORDS * sizeof(unsigned), stream);
  hipLaunchKernelGGL(mega, dim3(grid), dim3(NTHR), LDS_TOTAL, stream, p);
}
```

```cpp
#include <hip/hip_runtime.h>
#include <stdint.h>

constexpr int DM = 2048, NB = 8, LL = 4096, LCX = 256, LT = LL + LCX  , MR = NB * LT  ;
constexpr int NZ = 4864;
constexpr int C_DNQ = 0, C_DNK = 512, C_DNV = 1024, C_DNGATE = 1536, C_DNA = 2048, C_DNB = 2056, C_GQ = 2064, C_GK = 2320, C_GV = 2576,
              C_GGATE = 3088, C_GALPHA = 3600, C_CQ = 3632, C_CKV = 4080, C_KR = 4208, C_FN = 4272, IN_W = 4784;
constexpr int NMOD = 6 * DM;
constexpr float EPSV = 1e-6f;
constexpr int NTHR = 512;

typedef unsigned short bf16_t;
typedef short bf16x8 __attribute__((ext_vector_type(8)));
typedef short s16x4 __attribute__((ext_vector_type(4)));
typedef float f32x4 __attribute__((ext_vector_type(4)));
typedef float f32x16 __attribute__((ext_vector_type(16)));
typedef unsigned u32x4 __attribute__((ext_vector_type(4)));
typedef unsigned u32x2 __attribute__((ext_vector_type(2)));

#define DI __device__ __forceinline__
DI float bf2f(bf16_t b) { return __uint_as_float(((unsigned)b) << 16); }
DI bf16_t f2bf(float f) { unsigned u = __float_as_uint(f); u += 0x7FFFu + ((u >> 16) & 1u); return (bf16_t)(u >> 16); }
DI unsigned pack2(float lo, float hi) { return (unsigned)f2bf(lo) | ((unsigned)f2bf(hi) << 16); }
DI float wsum(float v) { for (int o = 32; o >= 1; o >>= 1) v += __shfl_xor(v, o); return v; }
DI float wmax(float v) { for (int o = 32; o >= 1; o >>= 1) v = fmaxf(v, __shfl_xor(v, o)); return v; }
DI float siluf(float x) { return x / (1.f + __expf(-x)); }
DI float sigmf(float x) { return 1.f / (1.f + __expf(-x)); }

DI int ltid() { int t = (int)threadIdx.x; asm volatile("" : "+v"(t)); return t; }
DI int lsg(int v) { asm volatile("" : "+s"(v)); return v; }

struct Prm {
  const float *x, *c, *ctx, *c_ctx, *w_ada, *b_ada, *w_in, *dn_conv, *dn_a_log, *dn_dt_bias, *dn_norm, *gla_w2, *gla_b2, *gla_norm,
      *mla_q_norm, *mla_w_uq, *mla_kv_norm, *mla_w_ukv, *w_out, *peer_wq, *peer_keys, *peer_u, *peer_v, *final_norm;
  float* out;
  bf16_t *WinT, *WoutT, *WqT, *WuqT, *WukvT;
  float *mod, *GB, *CCS;
  bf16_t *DFTM, *DFTC;
  float* X;
  bf16_t* Z;
  bf16_t *H, *DNQ, *OB;
  bf16_t *KV, *KR;
  bf16_t *Y, *PQT, *PQTc, *Qraw, *Aq, *Akv;
  bf16_t *H2, *Qp;
  bf16_t *Ub, *Vb;
  int* IDX;
  float* GATE;
  unsigned* bar;
};
#define XB_TMO      128
#define XB_XCNT(j)  (256  + 64 * (j))
#define XB_XSUB(j)  (1280 + 64 * (j))
#define XB_XGEN(j)  (2304 + 64 * (j))
#define XB_TOP      3328
#define XB_TOPGEN   3392
#define XCD_BAR_WORDS 3456
#define XB_SPIN_CAP (1u << 18)
#define LAS __attribute__((address_space(3)))

__device__ __forceinline__ unsigned xb_ld(unsigned* p)              { return __hip_atomic_load(p, __ATOMIC_RELAXED, __HIP_MEMORY_SCOPE_AGENT); }
__device__ __forceinline__ unsigned xb_add(unsigned* p, unsigned v) { return __hip_atomic_fetch_add(p, v, __ATOMIC_RELAXED, __HIP_MEMORY_SCOPE_AGENT); }
__device__ __forceinline__ unsigned xb_xcc_id() { return (unsigned)__builtin_amdgcn_s_getreg((3 << 11) | 20) & 0xFu; }
#define XB_SPIN(cond, bar) do { unsigned _sp = 0; while (cond) { __builtin_amdgcn_s_sleep(1); \
    if ((++_sp & 255u) == 0u) { if (xb_ld(&(bar)[XB_TMO])) break; if (_sp > XB_SPIN_CAP) { atomicAdd(&(bar)[XB_TMO], 1u); break; } } } } while (0)

struct XcdBarrier {
    unsigned* bar; unsigned x;
    volatile LAS unsigned* st;
};

__device__ __forceinline__ XcdBarrier xcd_barrier_post(unsigned* bar, volatile LAS unsigned* st) {
    XcdBarrier b; b.bar = bar; b.x = xb_xcc_id(); b.st = st;
    if (threadIdx.x == 0) (void)xb_add(&bar[XB_XCNT(b.x)], 1u);
    return b;
}
__device__ __forceinline__ void xcd_barrier_complete(unsigned* bar, unsigned x, unsigned& nloc, unsigned& nx) {
    const unsigned G = gridDim.x * gridDim.y * gridDim.z;
    unsigned sum, cnt, mine, sp = 0u;
    for (;;) {
        sum = 0u; cnt = 0u; mine = 0u;
#pragma unroll
        for (unsigned j = 0; j < 16; ++j) { const unsigned c = xb_ld(&bar[XB_XCNT(j)]); sum += c; cnt += (c > 0u) ? 1u : 0u; mine = (j == x) ? c : mine; }
        if (sum == G) break;
        __builtin_amdgcn_s_sleep(1);
        if ((++sp & 255u) == 0u) { if (xb_ld(&bar[XB_TMO])) break; if (sp > XB_SPIN_CAP) { atomicAdd(&bar[XB_TMO], 1u); break; } }
    }
    nloc = mine > 0u ? mine : 1u; nx = cnt > 0u ? cnt : 1u;
}

__device__ __forceinline__ void xcd_barrier(const XcdBarrier& b) {
    asm volatile("s_waitcnt vmcnt(0)" ::: "memory");
    __syncthreads();
    if (threadIdx.x == 0) {
        unsigned* bar = b.bar;
        __builtin_amdgcn_s_waitcnt(0);
        unsigned nloc = b.st[0], nx = b.st[1];
        if (nloc == 0u) { xcd_barrier_complete(bar, b.x, nloc, nx); b.st[0] = nloc; b.st[1] = nx; }
        const unsigned old = xb_add(&bar[XB_XSUB(b.x)], 1u);
        const unsigned gen = old / nloc;
        if (old + 1u == (gen + 1u) * nloc) {
            __builtin_amdgcn_fence(__ATOMIC_RELEASE, "agent");
            asm volatile("s_waitcnt vmcnt(0)" ::: "memory");
            const unsigned og = xb_add(&bar[XB_TOP], 1u);
            const unsigned tg = og / nx;
            if (og + 1u == (tg + 1u) * nx) xb_add(&bar[XB_TOPGEN], 1u);
            else XB_SPIN(xb_ld(&bar[XB_TOPGEN]) == tg, bar);
            __builtin_amdgcn_fence(__ATOMIC_ACQUIRE, "agent");
            xb_add(&bar[XB_XGEN(b.x)], 1u);
            asm volatile("s_waitcnt vmcnt(0)" ::: "memory");
        } else {
            XB_SPIN(xb_ld(&bar[XB_XGEN(b.x)]) == gen, bar);
            __builtin_amdgcn_fence(__ATOMIC_ACQUIRE, "agent");
            asm volatile("s_waitcnt vmcnt(0)" ::: "memory");
        }
    }
    __syncthreads();
}

namespace pg8 {
#define PG8_LAS __attribute__((address_space(3)))
typedef unsigned short bf16_t;
typedef short bf16x8 __attribute__((ext_vector_type(8)));
typedef float f32x4 __attribute__((ext_vector_type(4)));
typedef unsigned u32x4 __attribute__((ext_vector_type(4)));
constexpr int BM = 256, BK = 64, HALF = 128, HTB = HALF * BK * 2  , STAGE_BYTES = 8 * HTB, NXCD = 8, WGM = 8;

__host__ __device__ __forceinline__ int lds_byte(int r, int c) { const int st = (r >> 4) * 2 + (c >> 5), rr = r & 15, cc = c & 31, ob = rr * 64 + cc * 2; return st * 1024 + (ob ^ (((ob >> 9) & 1) << 5)); }
__host__ __device__ __forceinline__ void stage_rc(int b, int& R, int& C) { const int st = b / 1024, sb = b % 1024, swz = sb ^ (((sb >> 9) & 1) << 5); R = (st >> 1) * 16 + swz / 64; C = (st & 1) * 32 + (swz % 64) / 2; }
__host__ __device__ __forceinline__ int perm32(int rho) { const int n = rho >> 4, i = rho & 15; return 8 * (i >> 2) + 4 * n + (i & 3); }

struct Unit { int pm, pn; };
struct Gemm { const bf16_t* A; const bf16_t* Bt; int M, N, K; };

struct StaticOrder {
    int nM, nN, nwg, G, c;
    __host__ __device__ void init(int M, int N, int G_, int c_) { nM = M / BM; nN = N / BM; nwg = nM * nN; G = G_; c = c_; }
    __host__ __device__ bool next(int i, Unit& u) const {
        const long L = (long)i * G + c; if (L >= nwg) return false;
        int wgid = (int)L; { const int q = nwg / NXCD, r = nwg % NXCD, xcd = wgid % NXCD, off = wgid / NXCD; wgid = (xcd < r ? xcd * (q + 1) : r * (q + 1) + (xcd - r) * q) + off; }
        const int nig = WGM * nN, gid = wgid / nig, fm = gid * WGM, gsz = (nM - fm) < WGM ? (nM - fm) : WGM;
        u.pm = fm + ((wgid % nig) % gsz); u.pn = (wgid % nig) / gsz; return true;
    }
    __device__ __forceinline__ void a_ready(const Unit&) const {}
    __device__ __forceinline__ void done(const Unit&) const {}
};
struct CountedOrder : StaticOrder {
    const unsigned* ready; unsigned need; unsigned* tmo;
    __device__ __forceinline__ void a_ready(const Unit& u) const {
        if (threadIdx.x < 64) {
            const unsigned long long t0 = __builtin_amdgcn_s_memrealtime(); unsigned polls = 0;
            while ((unsigned)__builtin_amdgcn_readfirstlane(__hip_atomic_load(ready + 64 * u.pm, __ATOMIC_RELAXED, __HIP_MEMORY_SCOPE_AGENT)) < need) {
                if ((++polls & 255u) == 0u && __builtin_amdgcn_readfirstlane(__hip_atomic_load(tmo, __ATOMIC_RELAXED, __HIP_MEMORY_SCOPE_AGENT)) != 0u) break;
                if (__builtin_amdgcn_s_memrealtime() - t0 > 2000000ull) {
                    if (threadIdx.x == 0) { unsigned expect = 0u; __hip_atomic_compare_exchange_strong(tmo + 1, &expect, 0x600u | (unsigned)(u.pm & 0xff), __ATOMIC_RELAXED, __ATOMIC_RELAXED, __HIP_MEMORY_SCOPE_AGENT); __hip_atomic_store(tmo, 1u, __ATOMIC_RELAXED, __HIP_MEMORY_SCOPE_AGENT); }
                    break; }
                __builtin_amdgcn_s_sleep(2); }
            __builtin_amdgcn_fence(__ATOMIC_ACQUIRE, "agent");
            asm volatile("s_waitcnt vmcnt(0)" ::: "memory");
        }
#if !defined(BROKEN_HOOK_NO_BARRIER)
        asm volatile("" ::: "memory"); __builtin_amdgcn_s_barrier(); asm volatile("" ::: "memory");
#endif
    }
};

__device__ __forceinline__ unsigned cvt_pk_bf16(float lo, float hi) { unsigned r; asm volatile("v_cvt_pk_bf16_f32 %0, %1, %2" : "=v"(r) : "v"(lo), "v"(hi)); return r; }
typedef float f32x2 __attribute__((ext_vector_type(2)));
__device__ __forceinline__ f32x2 gelu_pk(f32x2 v) {
    const f32x2 av = __builtin_elementwise_abs(v), d = av * 0.2316418882f + 1.0f;
    f32x2 t; t.x = __builtin_amdgcn_rcpf(d.x); t.y = __builtin_amdgcn_rcpf(d.y);
    f32x2 q = t * 0.5307027145f + (-0.7265760135f); q = q * t + 0.7107068705f; q = q * t + (-0.142248368f); q = q * t + 0.127414796f; q = q * t;
    const f32x2 s = (v * v) * (-0.72134752044f);
    f32x2 e; e.x = __builtin_amdgcn_exp2f(s.x); e.y = __builtin_amdgcn_exp2f(s.y);
    const f32x2 m = v * (q * e), r = v - m;
    f32x2 o; o.x = v.x < 0.f ? m.x : r.x; o.y = v.y < 0.f ? m.y : r.y; return o;
}

struct EpiF32 {
    static constexpr bool PERM = false, AFTER_DRAIN = false;
    float* C; int ldc; const float* bias;
    __device__ __forceinline__ void operator()(const f32x4 (&acc)[2][2][4][2], const Unit& u, int wr, int wc, int fr, int fq) const {
        const int row0 = u.pm * BM + wr * 64 + fr, col0 = u.pn * BM + wc * 32 + 4 * fq;
        f32x4 bv[2][2];
#pragma unroll
        for (int bj = 0; bj < 2; ++bj)
#pragma unroll
            for (int n = 0; n < 2; ++n) bv[bj][n] = bias ? *(const f32x4*)(bias + col0 + bj * HALF + n * 16) : (f32x4){0.f, 0.f, 0.f, 0.f};
#pragma unroll
        for (int ai = 0; ai < 2; ++ai)
#pragma unroll
            for (int m = 0; m < 4; ++m) { float* rowp = C + (size_t)(row0 + ai * HALF + m * 16) * ldc + col0;
#pragma unroll
                for (int bj = 0; bj < 2; ++bj)
#pragma unroll
                    for (int n = 0; n < 2; ++n) *(f32x4*)(rowp + bj * HALF + n * 16) = acc[ai][bj][m][n] + bv[bj][n]; }
    }
};
template <int ACT  > struct EpiBf16 {
    static constexpr bool PERM = true, AFTER_DRAIN = false;
    bf16_t* O; int ldc; const float* bias; int split_cols; size_t split_stride;
    __device__ __forceinline__ void operator()(const f32x4 (&acc)[2][2][4][2], const Unit& u, int wr, int wc, int fr, int fq) const {
        const int row0 = u.pm * BM + wr * 64 + fr; int colt = u.pn * BM; bf16_t* base = O;
        if (split_cols) { const int t = colt / split_cols; base += (size_t)t * split_stride; colt -= t * split_cols; }
        const int col0 = colt + wc * 32 + 8 * fq, bcol0 = u.pn * BM + wc * 32 + 8 * fq;
        f32x4 bv[2][2];
#pragma unroll
        for (int bj = 0; bj < 2; ++bj)
#pragma unroll
            for (int n = 0; n < 2; ++n) bv[bj][n] = bias ? *(const f32x4*)(bias + bcol0 + bj * HALF + 4 * n) : (f32x4){0.f, 0.f, 0.f, 0.f};
#pragma unroll
        for (int ai = 0; ai < 2; ++ai)
#pragma unroll
            for (int m = 0; m < 4; ++m) { bf16_t* rowp = base + (size_t)(row0 + ai * HALF + m * 16) * ldc + col0;
#pragma unroll
                for (int bj = 0; bj < 2; ++bj) { f32x4 v0 = acc[ai][bj][m][0] + bv[bj][0], v1 = acc[ai][bj][m][1] + bv[bj][1];
                    if (ACT == 1) { f32x2 a = gelu_pk((f32x2){v0[0], v0[1]}), b = gelu_pk((f32x2){v0[2], v0[3]}), c = gelu_pk((f32x2){v1[0], v1[1]}), d = gelu_pk((f32x2){v1[2], v1[3]});
                        v0 = (f32x4){a.x, a.y, b.x, b.y}; v1 = (f32x4){c.x, c.y, d.x, d.y}; }
                    if (ACT == 2) {
#pragma unroll
                        for (int j = 0; j < 4; ++j) { v0[j] = 0.5f * v0[j] * (1.0f + erff(v0[j] * 0.70710678f)); v1[j] = 0.5f * v1[j] * (1.0f + erff(v1[j] * 0.70710678f)); } }
                    u32x4 w; w.x = cvt_pk_bf16(v0[0], v0[1]); w.y = cvt_pk_bf16(v0[2], v0[3]); w.z = cvt_pk_bf16(v1[0], v1[1]); w.w = cvt_pk_bf16(v1[2], v1[3]);
                    *(u32x4*)(rowp + bj * HALF) = w; } }
    }
};
template <class Epi, class Sched, bool STAMP = false>
__device__ __forceinline__ void gemm_phase(PG8_LAS unsigned char* lds, const Gemm g, const Sched& S, const Epi& E, unsigned long long* stamps) {
    const int tid = ltid(), wid = __builtin_amdgcn_readfirstlane(tid >> 6), lane = tid & 63, wr = wid >> 2, wc = wid & 3, fr = lane & 15, fq = lane >> 4;
    const int K = g.K, nt = K / BK;
    int ts_lo = 0, ts_hi = 0, nts = 0; const unsigned long long rt_entry = STAMP ? (unsigned long long)wall_clock64() : 0ull;
#define PG8_STAMP() do { if (STAMP && wid == 0 && nts < 64) { const unsigned long long _c = (unsigned long long)clock64(); \
        ts_lo = (lane == nts) ? (int)(unsigned)_c : ts_lo; ts_hi = (lane == nts) ? (int)(unsigned)(_c >> 32) : ts_hi; ++nts; } } while (0)
    PG8_STAMP();
    unsigned voffA[2], voffB[2];
#pragma unroll
    for (int i = 0; i < 2; ++i) { int R, C; stage_rc(tid * 16 + i * 8192, R, C); const int Rb = Epi::PERM ? ((R & ~31) + perm32(R & 31)) : R;
        voffA[i] = (unsigned)(R * K + C) * 2u; voffB[i] = (unsigned)(Rb * K + C) * 2u; }
    const size_t kstep = (size_t)(BK * 2);
    const size_t hstep = (size_t)HALF * K * 2;
    const size_t tstep = 2 * hstep;
    const unsigned ldsw = (unsigned)wid * 1024u;
    const int aoff = lds_byte(wr * 64 + fr, fq * 8), boff = lds_byte(wc * 32 + fr, fq * 8);
#define PG8_SA(b, h) (((b) * 2 + (h)) * HTB)
#define PG8_SB(b, h) ((4 + (b) * 2 + (h)) * HTB)
#define PG8_STAGE(bufoff, gbase, voff) do { _Pragma("unroll") for (int _i = 0; _i < 2; ++_i) \
        __builtin_amdgcn_global_load_lds((const unsigned*)((const char*)(gbase) + (voff)[_i]), (PG8_LAS unsigned*)(lds + (bufoff) + ldsw + _i * 8192), 16, 0, 0); } while (0)
#define PG8_LDA(dst, b, h) do { _Pragma("unroll") for (int m = 0; m < 4; ++m) _Pragma("unroll") for (int k = 0; k < 2; ++k) dst[m][k] = *(const PG8_LAS bf16x8*)(lds + PG8_SA(b, h) + aoff + m * 2048 + k * 1024); } while (0)
#define PG8_LDB(dst, b, h) do { _Pragma("unroll") for (int n = 0; n < 2; ++n) _Pragma("unroll") for (int k = 0; k < 2; ++k) dst[n][k] = *(const PG8_LAS bf16x8*)(lds + PG8_SB(b, h) + boff + n * 2048 + k * 1024); } while (0)
#define PG8_MMA(ai, bj, At, Bt) do { __builtin_amdgcn_s_setprio(1); _Pragma("unroll") for (int m = 0; m < 4; ++m) _Pragma("unroll") for (int n = 0; n < 2; ++n) _Pragma("unroll") for (int k = 0; k < 2; ++k) \
        acc[ai][bj][m][n] = __builtin_amdgcn_mfma_f32_16x16x32_bf16(Bt[n][k], At[m][k], acc[ai][bj][m][n], 0, 0, 0); __builtin_amdgcn_s_setprio(0); } while (0)
#define PG8_WAIT_V(n) asm volatile("s_waitcnt vmcnt(" #n ")" ::: "memory")
#define PG8_WAIT_L(n) asm volatile("s_waitcnt lgkmcnt(" #n ")" ::: "memory")
#define PG8_BAR __builtin_amdgcn_s_barrier()
#define PG8_SCHED __builtin_amdgcn_sched_barrier(0)
    Unit cur, nxt; int ui = 0;
    if (!S.next(0, cur)) return;
    f32x4 acc[2][2][4][2];
#pragma unroll
    for (int a = 0; a < 2; ++a)
#pragma unroll
        for (int b = 0; b < 2; ++b)
#pragma unroll
            for (int m = 0; m < 4; ++m)
#pragma unroll
                for (int n = 0; n < 2; ++n) acc[a][b][m][n] = (f32x4){0.f, 0.f, 0.f, 0.f};
    bf16x8 At[4][2], B0[2][2], B1[2][2];
    const char* cA = (const char*)g.A + (size_t)cur.pm * tstep; const char* cB = (const char*)g.Bt + (size_t)cur.pn * tstep;
    S.a_ready(cur);
    PG8_STAGE(PG8_SB(0, 0), cB, voffB); PG8_STAGE(PG8_SA(0, 0), cA, voffA); PG8_STAGE(PG8_SB(0, 1), cB + hstep, voffB); PG8_STAGE(PG8_SA(0, 1), cA + hstep, voffA);
    if (wr == 1) PG8_BAR;
    PG8_WAIT_V(4); PG8_BAR;
    PG8_STAGE(PG8_SB(1, 0), cB + kstep, voffB); PG8_STAGE(PG8_SA(1, 0), cA + kstep, voffA); PG8_STAGE(PG8_SB(1, 1), cB + hstep + kstep, voffB);
    PG8_WAIT_V(6); PG8_BAR;
    PG8_STAMP();
    for (;;) {
        const bool has_next = S.next(ui + 1, nxt);
        const char* nA = has_next ? (const char*)g.A + (size_t)nxt.pm * tstep : cA; const char* nB = has_next ? (const char*)g.Bt + (size_t)nxt.pn * tstep : cB;
        for (int t = 0; t < nt; t += 2) {
            const bool last = (t == nt - 2);
            const char* a1 = cA + (size_t)(t + 1) * kstep;
            const char* a2 = last ? nA : cA + (size_t)(t + 2) * kstep; const char* b2 = last ? nB : cB + (size_t)(t + 2) * kstep;
            const char* a3 = a2 + kstep; const char* b3 = b2 + kstep;
            if (last && has_next) S.a_ready(nxt);
            PG8_LDB(B0, 0, 0); PG8_SCHED; PG8_LDA(At, 0, 0); PG8_STAGE(PG8_SA(1, 1), a1 + hstep, voffA);
            PG8_WAIT_L(8); PG8_BAR; PG8_WAIT_L(0); PG8_MMA(0, 0, At, B0); PG8_BAR; PG8_SCHED;
            PG8_LDB(B1, 0, 1); PG8_STAGE(PG8_SB(0, 0), b2, voffB);
            PG8_BAR; PG8_WAIT_L(0); PG8_MMA(0, 1, At, B1); PG8_BAR;
            PG8_LDA(At, 0, 1); PG8_STAGE(PG8_SA(0, 0), a2, voffA);
            PG8_BAR; PG8_WAIT_L(0); PG8_MMA(1, 0, At, B0); PG8_BAR; PG8_SCHED;
            PG8_STAGE(PG8_SB(0, 1), b2 + hstep, voffB);
            PG8_WAIT_V(6); PG8_BAR; PG8_MMA(1, 1, At, B1); PG8_BAR;
            PG8_LDB(B0, 1, 0); PG8_SCHED; PG8_LDA(At, 1, 0); PG8_STAGE(PG8_SA(0, 1), a2 + hstep, voffA);
            PG8_WAIT_L(8); PG8_BAR; PG8_WAIT_L(0); PG8_MMA(0, 0, At, B0); PG8_BAR; PG8_SCHED;
            PG8_LDB(B1, 1, 1); PG8_STAGE(PG8_SB(1, 0), b3, voffB);
            PG8_BAR; PG8_WAIT_L(0); PG8_MMA(0, 1, At, B1); PG8_BAR;
            PG8_LDA(At, 1, 1); PG8_STAGE(PG8_SA(1, 0), a3, voffA);
            PG8_BAR; PG8_WAIT_L(0); PG8_MMA(1, 0, At, B0); PG8_BAR; PG8_SCHED;
            PG8_STAGE(PG8_SB(1, 1), b3 + hstep, voffB);
            PG8_WAIT_V(6); PG8_BAR; PG8_MMA(1, 1, At, B1); PG8_BAR;
        }
        PG8_STAMP();
        if constexpr (!Epi::AFTER_DRAIN) { E(acc, cur, wr, wc, fr, fq); S.done(cur); }
        PG8_STAMP();
        if (!has_next) break;
#pragma unroll
        for (int a = 0; a < 2; ++a)
#pragma unroll
            for (int b = 0; b < 2; ++b)
#pragma unroll
                for (int m = 0; m < 4; ++m)
#pragma unroll
                    for (int n = 0; n < 2; ++n) acc[a][b][m][n] = (f32x4){0.f, 0.f, 0.f, 0.f};
        cur = nxt; cA = nA; cB = nB; ++ui;
    }
    PG8_WAIT_V(0);
    if (wr == 0) PG8_BAR;
    PG8_BAR;
    if constexpr (Epi::AFTER_DRAIN) { E.fused(acc, cur, wr, wc, fr, fq, lds, wid, lane); S.done(cur); }
    PG8_STAMP();
    if (STAMP && wid == 0) { stamps[lane] = lane < nts ? (((unsigned long long)(unsigned)ts_hi << 32) | (unsigned)ts_lo) : 0ull;
        if (lane == 62) stamps[62] = rt_entry; if (lane == 63) stamps[63] = (unsigned long long)wall_clock64(); }
#undef PG8_STAMP
#undef PG8_SA
#undef PG8_SB
#undef PG8_STAGE
#undef PG8_LDA
#undef PG8_LDB
#undef PG8_MMA
#undef PG8_WAIT_V
#undef PG8_WAIT_L
#undef PG8_BAR
#undef PG8_SCHED
}
}

DI void st_transpose(const float* __restrict__ src, bf16_t* __restrict__ dst, int K, int N, int Kpad, int Npad, float* lds, int bid, int nb) {
  const int tk = Kpad / 64, tn = Npad / 64;
  for (int it = bid; it < tk * tn; it += nb) {
    const int k0 = (it % tk) * 64, n0 = (it / tk) * 64;
    __syncthreads();
    for (int e = ltid(); e < 4096; e += NTHR) { const int i = e >> 6, j = e & 63, k = k0 + i, n = n0 + j; lds[i * 65 + j] = (k < K && n < N) ? src[(size_t)k * N + n] : 0.f; }
    __syncthreads();
    for (int e = ltid(); e < 4096; e += NTHR) { const int j = e >> 6, i = e & 63; dst[(size_t)(n0 + j) * Kpad + k0 + i] = f2bf(lds[i * 65 + j]); }
  }
}

DI void st_mods(const Prm& p, float* lds, int bid, int nb) {
  float* s = lds; float* red = lds + 9 * 2048;
  for (int e = ltid(); e < 9 * 2048; e += NTHR) { const int r = e >> 11, k = e & 2047; const float v = r < 8 ? p.c[r * 2048 + k] : p.c_ctx[k]; s[e] = siluf(v); }
  __syncthreads();
  const int kg = ltid() >> 6, cl = ltid() & 63;
  for (int it = bid; it < 2 * 192; it += nb) {
    const int l = it / 192, cb = (it % 192) * 64;
    const float* w = p.w_ada + (size_t)l * 2048 * NMOD + cb + cl;
    float acc[9];
#pragma unroll
    for (int r = 0; r < 9; ++r) acc[r] = 0.f;
    for (int k = kg * 256; k < kg * 256 + 256; ++k) { const float wv = w[(size_t)k * NMOD];
#pragma unroll
      for (int r = 0; r < 9; ++r) acc[r] += s[r * 2048 + k] * wv; }
#pragma unroll
    for (int r = 0; r < 9; ++r) red[(kg * 9 + r) * 64 + cl] = acc[r];
    __syncthreads();
    for (int e = ltid(); e < 576; e += NTHR) { const int r = e >> 6, c2 = e & 63; float t = 0.f;
      for (int g = 0; g < 8; ++g) t += red[(g * 9 + r) * 64 + c2];
      p.mod[((size_t)l * 9 + r) * NMOD + cb + c2] = t + p.b_ada[l * NMOD + cb + c2]; }
    __syncthreads();
  }
}

DI void st_tables(const Prm& p, int bid, int nb) {
  const size_t stride = (size_t)nb * NTHR, t0 = (size_t)bid * NTHR + ltid();
  for (size_t e = t0; e < (size_t)4096 * 8192; e += stride) { const int k1 = (int)(e >> 13), n = (int)(e & 8191), n1 = n & 4095, idx = (k1 * n1) & 4095;
    float sv, cv; sincosf((float)idx * (6.283185307179586f / 4096.f), &sv, &cv); p.DFTM[e] = f2bf((n < 4096 ? cv : -sv) * (1.f / 64.f)); }
  for (size_t e = t0; e < (size_t)256 * 512; e += stride) { const int k1 = (int)(e >> 9), n = (int)(e & 511), n1 = n & 255, idx = (k1 * n1) & 255;
    float sv, cv; sincosf((float)idx * (6.283185307179586f / 256.f), &sv, &cv); p.DFTC[e] = f2bf((n < 256 ? cv : -sv) * (1.f / 16.f)); }
  for (size_t e = t0; e < (size_t)2 * 128 * 128; e += stride) { const int tb = (int)(e >> 14), k2 = (int)((e >> 7) & 127), n2 = (int)(e & 127), idx = (k2 * n2) & 127;
    float sv, cv; sincosf((float)idx * (6.283185307179586f / 128.f), &sv, &cv); p.CCS[e] = (tb ? sv : cv) * 0.08838834764831845f; }
}

DI void st_modulate(const Prm& p, int layer, int which, bf16_t* __restrict__ dst, int bid, int nb) {
  const int wave = ltid() >> 6, lane = ltid() & 63;
  const int shoff = which ? 3 * DM : 0, scoff = which ? 4 * DM : DM;
  for (int row = bid * 8 + wave; row < MR; row += nb * 8) {
    const int b = row / LT, t = row - b * LT; const bool isc = t >= LL;
    const float* src = (layer == 0 && which == 0) ? (isc ? p.ctx + (size_t)(b * LCX + t - LL) * DM : p.x + (size_t)(b * LL + t) * DM) : p.X + (size_t)row * DM;
    f32x4 v[8]; float ss = 0.f;
#pragma unroll
    for (int i = 0; i < 8; ++i) { v[i] = *(const f32x4*)(src + (i * 64 + lane) * 4); ss += v[i][0] * v[i][0] + v[i][1] * v[i][1] + v[i][2] * v[i][2] + v[i][3] * v[i][3]; }
    ss = wsum(ss); const float rstd = rsqrtf(ss * (1.f / 2048.f) + EPSV);
    const float* mr = p.mod + ((size_t)layer * 9 + (isc ? 8 : b)) * NMOD;
#pragma unroll
    for (int i = 0; i < 8; ++i) { const int col = (i * 64 + lane) * 4; const f32x4 sc = *(const f32x4*)(mr + scoff + col), sh = *(const f32x4*)(mr + shoff + col);
      const f32x4 o = v[i] * rstd * (sc + 1.f) + sh; u32x2 w; w.x = pack2(o[0], o[1]); w.y = pack2(o[2], o[3]); *(u32x2*)(dst + (size_t)row * DM + col) = w; }
  }
}

DI void st_dnprep(const Prm& p, int layer, int bid, int nb) {
  const int wave = ltid() >> 6, lane = ltid() & 63;
  const float* conv = p.dn_conv + (size_t)layer * 5 * 1536;
  for (long task = (long)bid * 8 + wave; task < (long)MR * 13; task += (long)nb * 8) {
    const int row = (int)(task / 13), grp = (int)(task - (long)row * 13);
    const int b = row / LT, t = row - b * LT; const bool isc = t >= LL;
    const int segbase = isc ? b * LT + LL : b * LT, segt = isc ? t - LL : t, seglen = isc ? LCX : LL;
    if (grp < 12) {
      const int c = grp * 128 + lane * 2; float a0 = 0.f, a1 = 0.f;
#pragma unroll
      for (int j = 0; j < 5; ++j) { const int tt = segt + j - 2;
        if (tt >= 0 && tt < seglen) { const unsigned zz = *(const unsigned*)(p.Z + (size_t)(segbase + tt) * NZ + c);
          a0 += bf2f((bf16_t)(zz & 0xffffu)) * conv[j * 1536 + c]; a1 += bf2f((bf16_t)(zz >> 16)) * conv[j * 1536 + c + 1]; } }
      a0 = siluf(a0); a1 = siluf(a1);
      if (grp < 8) { const float ss = wsum(a0 * a0 + a1 * a1); const float sc = rsqrtf(ss + EPSV) * (grp < 4 ? 0.08838834764831845f : 1.f); a0 *= sc; a1 *= sc; }
      *(unsigned*)(p.DNQ + (size_t)row * 1536 + c) = pack2(a0, a1);
    } else if (lane < 16) {
      const int isb = lane >> 3, dh = lane & 7; const float z = bf2f(p.Z[(size_t)row * NZ + (isb ? C_DNB : C_DNA) + dh]); float o;
      if (!isb) { const float xx = z + p.dn_dt_bias[layer * 8 + dh]; const float sp = xx > 20.f ? xx : log1pf(expf(xx)); o = -expf(p.dn_a_log[layer * 8 + dh]) * sp; }
      else o = sigmf(z);
      p.GB[(size_t)row * 16 + lane] = o;
    }
  }
}

DI void st_mlaprep(const Prm& p, int layer, int bid, int nb) {
  const int wave = ltid() >> 6, lane = ltid() & 63;
  const float* qn = p.mla_q_norm + layer * 448; const float* kvn = p.mla_kv_norm + layer * 128;
  for (int row = bid * 8 + wave; row < MR; row += nb * 8) {
    const bf16_t* z = p.Z + (size_t)row * NZ; const int b = row / LT, t = row - b * LT;
    float v[7]; float ss = 0.f;
#pragma unroll
    for (int i = 0; i < 7; ++i) { v[i] = bf2f(z[C_CQ + i * 64 + lane]); ss += v[i] * v[i]; }
    ss = wsum(ss); float rstd = rsqrtf(ss * (1.f / 448.f) + EPSV);
#pragma unroll
    for (int i = 0; i < 7; ++i) p.Aq[(size_t)row * 512 + i * 64 + lane] = f2bf(v[i] * rstd * qn[i * 64 + lane]);
    p.Aq[(size_t)row * 512 + 448 + lane] = 0;
    const float u0 = bf2f(z[C_CKV + lane]), u1 = bf2f(z[C_CKV + 64 + lane]);
    ss = wsum(u0 * u0 + u1 * u1); rstd = rsqrtf(ss * (1.f / 128.f) + EPSV);
    p.Akv[(size_t)row * 256 + lane] = f2bf(u0 * rstd * kvn[lane]); p.Akv[(size_t)row * 256 + 64 + lane] = f2bf(u1 * rstd * kvn[64 + lane]);
    p.Akv[(size_t)row * 256 + 128 + lane] = 0; p.Akv[(size_t)row * 256 + 192 + lane] = 0;
    if (t < LL) {
      if (lane < 32) { const int half = lane >> 4, i = lane & 15; const float x1 = bf2f(z[C_KR + half * 32 + i]), x2 = bf2f(z[C_KR + half * 32 + 16 + i]);
        const float pos = (float)(half ? (t & 63) : (t >> 6)); const float ang = pos * exp2f(-(float)i * (13.287712379549449f / 16.f)); float sv, cv; sincosf(ang, &sv, &cv);
        p.KR[(size_t)row * 64 + half * 32 + i] = f2bf(x1 * cv - x2 * sv); p.KR[(size_t)row * 64 + half * 32 + 16 + i] = f2bf(x2 * cv + x1 * sv); }
    } else p.KR[(size_t)row * 64 + lane] = z[C_KR + lane];
  }
}

DI void st_qrope(const Prm& p, int bid, int nb) {
  const int wave = ltid() >> 6, lane = ltid() & 63;
  for (int row = bid * 8 + wave; row < MR; row += nb * 8) {
    const int b = row / LT, t = row - b * LT; if (t >= LL) continue;
#pragma unroll
    for (int k = 0; k < 2; ++k) { const int pid = lane + 64 * k, h = pid >> 5, r = pid & 31, half = r >> 4, i = r & 15;
      bf16_t* q = p.Qraw + (size_t)row * 768 + h * 192 + 128 + half * 32; const float x1 = bf2f(q[i]), x2 = bf2f(q[16 + i]);
      const float pos = (float)(half ? (t & 63) : (t >> 6)); const float ang = pos * exp2f(-(float)i * (13.287712379549449f / 16.f)); float sv, cv; sincosf(ang, &sv, &cv);
      q[i] = f2bf(x1 * cv - x2 * sv); q[16 + i] = f2bf(x2 * cv + x1 * sv); }
  }
}

DI void st_fnchan(const Prm& p, float* lds, int bid, int nb) {
  float* zt = lds;
  const int wave = __builtin_amdgcn_readfirstlane(ltid() >> 6), lane = ltid() & 63;
  for (int it = bid; it < (MR / 64) * 4; it += nb) {
    const int tile = it >> 2, g = it & 3, row0 = tile * 64, b = row0 / LT, t0 = row0 - b * LT;
    __syncthreads();
    for (int e = ltid(); e < 64 * 128; e += NTHR) { const int i = e >> 7, n2 = e & 127; zt[i * 129 + n2] = bf2f(p.Z[(size_t)(row0 + i) * NZ + C_FN + g * 128 + n2]); }
    __syncthreads();
    for (int kk = 0; kk < 16; ++kk) { const int k2 = wave + 8 * kk; const float* cc = p.CCS + k2 * 128; const float* cs = p.CCS + 16384 + k2 * 128;
      float ap = 0.f, aq = 0.f;
      for (int n2 = 0; n2 < 128; ++n2) { const float zv = zt[lane * 129 + n2]; ap += zv * cc[n2]; aq += zv * cs[n2]; }
      if (t0 < LL) { bf16_t* d = p.PQT + ((size_t)(b * 512 + g * 128 + k2)) * 8192 + t0 + lane; d[0] = f2bf(ap); d[4096] = f2bf(aq); }
      else { bf16_t* d = p.PQTc + ((size_t)(b * 512 + g * 128 + k2)) * 512 + (t0 - LL) + lane; d[0] = f2bf(ap); d[256] = f2bf(aq); } }
  }
}

DI int scan_row(int b, int dir, int s) { return s < LCX ? b * LT + LL + (dir ? LCX - 1 - s : s) : b * LT + (dir ? LL - 1 - (s - LCX) : (s - LCX)); }

typedef float f32x2 __attribute__((ext_vector_type(2)));
DI float dpp_x1(float v) { return __int_as_float(__builtin_amdgcn_mov_dpp(__float_as_int(v), 0xB1, 0xf, 0xf, true)); }
DI float dpp_x2(float v) { return __int_as_float(__builtin_amdgcn_mov_dpp(__float_as_int(v), 0x4E, 0xf, 0xf, true)); }
DI float dpp_hm(float v) { return __int_as_float(__builtin_amdgcn_mov_dpp(__float_as_int(v), 0x141, 0xf, 0xf, true)); }
DI float red4(float v) { v += dpp_x1(v); v += dpp_x2(v); return v; }
DI float red8(float v) { v += dpp_x1(v); v += dpp_x2(v); v += dpp_hm(v); return v; }

DI void st_dnscan(const Prm& p, float* lds, int bid, int nb) {
  const int tid = ltid(), cc = tid >> 3, part = tid & 7;
  for (int item = bid; item < 128; item += nb) {
    const int chain = item >> 1, half = item & 1, b = chain >> 3, h = (chain >> 1) & 3, dir = chain & 1;
    f32x2 S[8];
#pragma unroll
    for (int j = 0; j < 8; ++j) S[j] = (f32x2){0.f, 0.f};
    constexpr int BUF = 4096 + 4096 + 2048 + 64 + 2048;
    bf16x8 pf[3]; float pg = 0.f;
    auto gload = [&](int batch) {
#pragma unroll
      for (int r = 0; r < 3; ++r) { const int e = tid + NTHR * r; if (e < 1280) { const int i = e / 40, ch = e - i * 40; const int row = scan_row(b, dir, batch * 32 + i);
          const int col = ch < 16 ? h * 128 + ch * 8 : (ch < 32 ? 512 + h * 128 + (ch - 16) * 8 : 1024 + h * 128 + half * 64 + (ch - 32) * 8);
          pf[r] = *(const bf16x8*)(p.DNQ + (size_t)row * 1536 + col); } }
      if (tid < 64) { const int i = tid >> 1, wh = tid & 1; const int row = scan_row(b, dir, batch * 32 + i); pg = p.GB[(size_t)row * 16 + wh * 8 + dir * 4 + h]; }
    };
    auto lstore = [&](float* bufp) {
#pragma unroll
      for (int r = 0; r < 3; ++r) { const int e = tid + NTHR * r; if (e < 1280) { const int i = e / 40, ch = e - i * 40;
          float* d = ch < 16 ? bufp + i * 128 + ch * 8 : (ch < 32 ? bufp + 4096 + i * 128 + (ch - 16) * 8 : bufp + 8192 + i * 64 + (ch - 32) * 8);
#pragma unroll
          for (int j = 0; j < 8; ++j) d[j] = bf2f((bf16_t)pf[r][j]); } }
      if (tid < 64) { const int i = tid >> 1, wh = tid & 1; bufp[10240 + i * 2 + wh] = wh ? pg : expf(pg); }
    };
    __syncthreads();
    gload(0); lstore(lds); __syncthreads();
    for (int batch = 0; batch < LT / 32; ++batch) {
      float* cur = lds + (batch & 1) * BUF; float* nxt = lds + ((batch + 1) & 1) * BUF;
      if (batch + 1 < LT / 32) gload(batch + 1);
      const float* q_s = cur + part * 16; const float* k_s = cur + 4096 + part * 16; const float* v_s = cur + 8192 + cc; const float* gb_s = cur + 10240; float* o_s = cur + 10304;
#pragma unroll 2
      for (int i = 0; i < 32; ++i) {
        f32x2 k2[8], q2[8];
#pragma unroll
        for (int j = 0; j < 4; ++j) { const f32x4 t4 = *(const f32x4*)(k_s + i * 128 + j * 4); k2[2 * j] = (f32x2){t4[0], t4[1]}; k2[2 * j + 1] = (f32x2){t4[2], t4[3]};
          const f32x4 u4 = *(const f32x4*)(q_s + i * 128 + j * 4); q2[2 * j] = (f32x2){u4[0], u4[1]}; q2[2 * j + 1] = (f32x2){u4[2], u4[3]}; }
        const f32x2 ab = *(const f32x2*)(gb_s + i * 2); const float a = ab[0], beta = ab[1], vv = v_s[i * 64];
        f32x2 d0 = k2[0] * S[0], d1 = k2[1] * S[1];
#pragma unroll
        for (int j = 2; j < 8; j += 2) { d0 += k2[j] * S[j]; d1 += k2[j + 1] * S[j + 1]; }
        d0 += d1; const float ks = a * red8(d0[0] + d0[1]);
        const float vn = beta * (vv - ks); const f32x2 vn2 = (f32x2){vn, vn}, a2 = (f32x2){a, a};
        f32x2 o0 = (f32x2){0.f, 0.f}, o1 = (f32x2){0.f, 0.f};
#pragma unroll
        for (int j = 0; j < 8; j += 2) { S[j] = S[j] * a2 + k2[j] * vn2; S[j + 1] = S[j + 1] * a2 + k2[j + 1] * vn2; o0 += q2[j] * S[j]; o1 += q2[j + 1] * S[j + 1]; }
        o0 += o1; const float o = red8(o0[0] + o0[1]);
        if (part == 0) o_s[i * 64 + cc] = o;
      }
      __syncthreads();
      { const int i = tid >> 4, c4 = (tid & 15) * 4; const int row = scan_row(b, dir, batch * 32 + i); const float* s = o_s + i * 64 + c4;
        u32x2 w; w.x = pack2(s[0], s[1]); w.y = pack2(s[2], s[3]);
        *(u32x2*)(p.OB + ((size_t)(0 * 2 + dir) * MR + row) * 512 + h * 128 + half * 64 + c4) = w; }
      if (batch + 1 < LT / 32) lstore(nxt);
      __syncthreads();
    }
  }
}

DI void st_glascan(const Prm& p, int layer, float* lds, int bid, int nb) {
  const int tid = ltid(), c = tid >> 2, part = tid & 3;
  for (int chain = bid; chain < 64; chain += nb) {
    const int b = chain >> 3, h = (chain >> 1) & 3, dir = chain & 1;
    const float* w2 = p.gla_w2 + (size_t)(layer * 2 + dir) * 16 * 256 + h * 64; const float* b2 = p.gla_b2 + (layer * 2 + dir) * 256 + h * 64;
    f32x2 S[8];
#pragma unroll
    for (int j = 0; j < 8; ++j) S[j] = (f32x2){0.f, 0.f};
    constexpr int BUF = 2048 * 3 + 4096 * 2 + 512;
    bf16x8 pf[3];
    auto gload = [&](int batch) {
#pragma unroll
      for (int r = 0; r < 3; ++r) { const int e = tid + NTHR * r; if (e < 1088) { const int i = e / 34, ch = e - i * 34; const int row = scan_row(b, dir, batch * 32 + i);
          const int col = ch < 8 ? C_GQ + h * 64 + ch * 8 : (ch < 16 ? C_GK + h * 64 + (ch - 8) * 8 : (ch < 32 ? C_GV + h * 128 + (ch - 16) * 8 : C_GALPHA + dir * 16 + (ch - 32) * 8));
          pf[r] = *(const bf16x8*)(p.Z + (size_t)row * NZ + col); } }
    };
    auto lstore = [&](float* bufp) {
#pragma unroll
      for (int r = 0; r < 3; ++r) { const int e = tid + NTHR * r; if (e < 1088) { const int i = e / 34, ch = e - i * 34;
          float* d = ch < 8 ? bufp + i * 64 + ch * 8 : (ch < 16 ? bufp + 2048 + i * 64 + (ch - 8) * 8 : (ch < 32 ? bufp + 6144 + i * 128 + (ch - 16) * 8 : bufp + 14336 + i * 16 + (ch - 32) * 8));
          const float sc = ch < 8 ? 0.125f : 1.f;
#pragma unroll
          for (int j = 0; j < 8; ++j) d[j] = bf2f((bf16_t)pf[r][j]) * sc; } }
    };
    auto decay = [&](float* bufp) {
#pragma unroll
      for (int k = 0; k < 4; ++k) { const int e = tid + NTHR * k, i = e >> 6, d = e & 63; float zz = b2[d];
#pragma unroll
        for (int r = 0; r < 16; ++r) zz += bufp[14336 + i * 16 + r] * w2[r * 256 + d];
        const float nz = -zz; const float sp = nz > 20.f ? nz : log1pf(expf(nz));
        bufp[4096 + i * 64 + d] = expf(-sp * (1.f / 16.f)); }
    };
    __syncthreads();
    gload(0); lstore(lds); __syncthreads(); decay(lds); __syncthreads();
    for (int batch = 0; batch < LT / 32; ++batch) {
      float* cur = lds + (batch & 1) * BUF; float* nxt = lds + ((batch + 1) & 1) * BUF;
      if (batch + 1 < LT / 32) gload(batch + 1);
      const float* q_s = cur + part * 16; const float* k_s = cur + 2048 + part * 16; const float* a_s = cur + 4096 + part * 16; const float* v_s = cur + 6144 + c; float* o_s = cur + 10240;
#pragma unroll 2
      for (int i = 0; i < 32; ++i) {
        const float vv = v_s[i * 128]; const f32x2 v2 = (f32x2){vv, vv}; f32x2 o0 = (f32x2){0.f, 0.f}, o1 = (f32x2){0.f, 0.f};
#pragma unroll
        for (int j = 0; j < 4; ++j) { const f32x4 a4 = *(const f32x4*)(a_s + i * 64 + j * 4), k4 = *(const f32x4*)(k_s + i * 64 + j * 4), q4 = *(const f32x4*)(q_s + i * 64 + j * 4);
          S[2 * j] = S[2 * j] * (f32x2){a4[0], a4[1]} + (f32x2){k4[0], k4[1]} * v2; S[2 * j + 1] = S[2 * j + 1] * (f32x2){a4[2], a4[3]} + (f32x2){k4[2], k4[3]} * v2;
          o0 += (f32x2){q4[0], q4[1]} * S[2 * j]; o1 += (f32x2){q4[2], q4[3]} * S[2 * j + 1]; }
        o0 += o1; const float o = red4(o0[0] + o0[1]);
        if (part == 0) o_s[i * 128 + c] = o;
      }
      __syncthreads();
      { const int i = tid >> 4, c8 = (tid & 15) * 8; const int row = scan_row(b, dir, batch * 32 + i); const float* s = o_s + i * 128 + c8;
        u32x4 w; w.x = pack2(s[0], s[1]); w.y = pack2(s[2], s[3]); w.z = pack2(s[4], s[5]); w.w = pack2(s[6], s[7]);
        *(u32x4*)(p.OB + ((size_t)(1 * 2 + dir) * MR + row) * 512 + h * 128 + c8) = w; }
      if (batch + 1 < LT / 32) lstore(nxt);
      __syncthreads();
      if (batch + 1 < LT / 32) decay(nxt);
      __syncthreads();
    }
  }
}

DI void st_combine(const Prm& p, int layer, int bid, int nb) {
  const int wave = ltid() >> 6, lane = ltid() & 63;
  for (long task = (long)bid * 8 + wave; task < (long)MR * 8; task += (long)nb * 8) {
    const int row = (int)(task >> 3), mh = (int)(task & 7), mixer = mh >> 2, h = mh & 3;
    const unsigned f = *(const unsigned*)(p.OB + ((size_t)(mixer * 2 + 0) * MR + row) * 512 + h * 128 + lane * 2), g = *(const unsigned*)(p.OB + ((size_t)(mixer * 2 + 1) * MR + row) * 512 + h * 128 + lane * 2);
    const float o0 = bf2f((bf16_t)(f & 0xffffu)) + bf2f((bf16_t)(g & 0xffffu)), o1 = bf2f((bf16_t)(f >> 16)) + bf2f((bf16_t)(g >> 16));
    const float ss = wsum(o0 * o0 + o1 * o1), rstd = rsqrtf(ss * (1.f / 128.f) + EPSV);
    const float* w = (mixer ? p.gla_norm : p.dn_norm) + layer * 128 + lane * 2;
    const unsigned gz = *(const unsigned*)(p.Z + (size_t)row * NZ + (mixer ? C_GGATE : C_DNGATE) + h * 128 + lane * 2);
    const float g0 = bf2f((bf16_t)(gz & 0xffffu)), g1 = bf2f((bf16_t)(gz >> 16));
    *(unsigned*)(p.Y + (size_t)row * DM + mixer * 512 + h * 128 + lane * 2) = pack2(o0 * rstd * w[0] * siluf(g0), o1 * rstd * w[1] * siluf(g1));
  }
}

DI unsigned fkey(float f) { const unsigned u = __float_as_uint(f); return u ^ ((u >> 31) ? 0xffffffffu : 0x80000000u); }
DI int pcnt(unsigned long long m) { return __builtin_popcountll(m); }
DI int lanes_below(unsigned long long m) { return (int)__builtin_amdgcn_mbcnt_hi((unsigned)(m >> 32), __builtin_amdgcn_mbcnt_lo((unsigned)m, 0u)); }
DI void st_peertopk(const Prm& p, int layer, unsigned char* lds, int bid, int nb) {
  bf16_t* ks = (bf16_t*)lds;
  bf16_t* qt = (bf16_t*)(lds + 69632);
  float* sc = (float*)(lds + 69632);
  const int tid = ltid(), wave = tid >> 6, lane = tid & 63, r32 = lane & 31, hi = lane >> 5;
  float* selv = (float*)(lds + 69632 + 33280) + wave * 64; int* seli = (int*)(selv + 32);
  int hcur = -1;
  const int nchunk = MR / 32;
  for (int it = bid; it < 8 * nchunk; it += nb) {
    const int h = it / nchunk, chunk = it - h * nchunk, row0 = chunk * 32;
    __syncthreads();
    if (h != hcur) {
      const float* kg = p.peer_keys + ((size_t)(layer * 8 + h) * 2) * 128 * 128;
      for (int e = tid; e < 2 * 128 * 128; e += NTHR) { const int pn = e >> 7, k = e & 127; ks[pn * 136 + k] = f2bf(kg[e]); }
      hcur = h; }
    for (int e = tid; e < 1024; e += NTHR) { const int r = e >> 5, c8 = (e & 31) * 8; *(u32x4*)(qt + r * 264 + c8) = *(const u32x4*)(p.Qp + (size_t)(row0 + r) * DM + h * 256 + c8); }
    __syncthreads();
    { const int pt = wave >> 2, nt = wave & 3; f32x16 acc = {};
#pragma unroll
      for (int k8 = 0; k8 < 8; ++k8) { const bf16x8 a = *(const bf16x8*)(qt + r32 * 264 + pt * 128 + k8 * 16 + hi * 8), b = *(const bf16x8*)(ks + (pt * 128 + nt * 32 + r32) * 136 + k8 * 16 + hi * 8);
        acc = __builtin_amdgcn_mfma_f32_32x32x16_bf16(a, b, acc, 0, 0, 0); }
      __syncthreads();
#pragma unroll
      for (int r = 0; r < 16; ++r) sc[((r & 3) + 8 * (r >> 2) + 4 * hi) * 260 + pt * 128 + nt * 32 + r32] = acc[r]; }
    __syncthreads();
    for (int rr = 0; rr < 4; ++rr) {
      const int m = wave * 4 + rr, row = row0 + m;
      float s[2][2];
#pragma unroll
      for (int pp = 0; pp < 2; ++pp)
#pragma unroll
        for (int hh = 0; hh < 2; ++hh) s[pp][hh] = sc[m * 260 + pp * 128 + hh * 64 + lane];
      unsigned kk[2][2], T[2] = {0u, 0u}; bool dn[2] = {false, false};
#pragma unroll
      for (int pp = 0; pp < 2; ++pp) { kk[pp][0] = fkey(s[pp][0]); kk[pp][1] = fkey(s[pp][1]); }
      for (int bit = 31; bit >= 0; --bit) {
#pragma unroll
        for (int pp = 0; pp < 2; ++pp) { const unsigned c = T[pp] | (1u << bit); const int n = pcnt(__ballot(kk[pp][0] >= c)) + pcnt(__ballot(kk[pp][1] >= c));
          if (!dn[pp] && n >= 16) { T[pp] = c; dn[pp] = n == 16; } }
        if (dn[0] && dn[1]) break; }
#pragma unroll
      for (int pp = 0; pp < 2; ++pp) { const unsigned k0 = kk[pp][0], k1 = kk[pp][1], TT = T[pp];
        const unsigned long long g0 = __ballot(k0 > TT), g1 = __ballot(k1 > TT), e0 = __ballot(k0 == TT), e1 = __ballot(k1 == TT);
        const int ng0 = pcnt(g0), ng = ng0 + pcnt(g1), need = 16 - ng, ne0 = pcnt(e0);
        if (k0 > TT) { const int r = lanes_below(g0); selv[pp * 16 + r] = s[pp][0]; seli[pp * 16 + r] = lane; }
        if (k1 > TT) { const int r = ng0 + lanes_below(g1); selv[pp * 16 + r] = s[pp][1]; seli[pp * 16 + r] = lane + 64; }
        if (k0 == TT) { const int r = lanes_below(e0); if (r < need) { selv[pp * 16 + ng + r] = s[pp][0]; seli[pp * 16 + ng + r] = lane; } }
        if (k1 == TT) { const int r = ne0 + lanes_below(e1); if (r < need) { selv[pp * 16 + ng + r] = s[pp][1]; seli[pp * 16 + ng + r] = lane + 64; } } }
      __builtin_amdgcn_wave_barrier();
      float cd[4]; unsigned ck[4]; { const float sa = selv[lane >> 2]; const f32x4 sb = *(const f32x4*)(selv + 16 + (lane & 3) * 4);
#pragma unroll
        for (int q = 0; q < 4; ++q) { cd[q] = sa + sb[q]; ck[q] = fkey(cd[q]); } }
      unsigned T2 = 0u;
      for (int bit = 31; bit >= 0; --bit) { const unsigned c = T2 | (1u << bit);
        const int n = pcnt(__ballot(ck[0] >= c)) + pcnt(__ballot(ck[1] >= c)) + pcnt(__ballot(ck[2] >= c)) + pcnt(__ballot(ck[3] >= c));
        if (n >= 16) { T2 = c; if (n == 16) break; } }
      float mx = fmaxf(fmaxf(cd[0], cd[1]), fmaxf(cd[2], cd[3])); mx = wmax(mx);
      int base = 0; float esum = 0.f; const int ia = seli[lane >> 2]; int rk[4]; float ev[4];
#pragma unroll
      for (int q = 0; q < 4; ++q) { const unsigned long long g = __ballot(ck[q] > T2); rk[q] = ck[q] > T2 ? base + lanes_below(g) : 99; base += pcnt(g); }
#pragma unroll
      for (int q = 0; q < 4; ++q) { const unsigned long long g = __ballot(ck[q] == T2); if (ck[q] == T2) rk[q] = base + lanes_below(g); base += pcnt(g); }
#pragma unroll
      for (int q = 0; q < 4; ++q) { ev[q] = rk[q] < 16 ? __expf(cd[q] - mx) : 0.f; esum += ev[q]; }
      esum = wsum(esum); const float inv = 1.f / esum;
      int* orow = p.IDX + (size_t)row * 128 + h * 16; float* grow = p.GATE + (size_t)row * 128 + h * 16;
#pragma unroll
      for (int q = 0; q < 4; ++q) if (rk[q] < 16) { orow[rk[q]] = ia * 128 + seli[16 + (lane & 3) * 4 + q]; grow[rk[q]] = ev[q] * inv; }
      __builtin_amdgcn_wave_barrier();
    }
  }
}

DI void st_cvt_tables(const Prm& p, int layer, int bid, int nb) {
  const size_t n8 = (size_t)16384 * DM / 8, stride = (size_t)nb * NTHR;
  const float* U = p.peer_u + (size_t)layer * 16384 * DM; const float* V = p.peer_v + (size_t)layer * 16384 * DM;
  for (size_t e = (size_t)bid * NTHR + ltid(); e < 2 * n8; e += stride) { const bool isv = e >= n8; const size_t k = isv ? e - n8 : e;
    const float* src = (isv ? V : U) + k * 8; const f32x4 a = *(const f32x4*)src, b = *(const f32x4*)(src + 4);
    u32x4 w; w.x = pack2(a[0], a[1]); w.y = pack2(a[2], a[3]); w.z = pack2(b[0], b[1]); w.w = pack2(b[2], b[3]);
    *(u32x4*)((isv ? p.Vb : p.Ub) + k * 8) = w; }
}

typedef __bf16 bf2_t __attribute__((ext_vector_type(2)));
DI float dot2bf(unsigned a, unsigned b, float c) { return __builtin_amdgcn_fdot2_f32_bf16(__builtin_bit_cast(bf2_t, a), __builtin_bit_cast(bf2_t, b), c, false); }
DI void st_peergather(const Prm& p, int layer, float* lds, int bid, int nb, bool dry = false) {
  const int tid = ltid(), wave = tid >> 6, lane = tid & 63;
  for (int row = bid; row < MR; row += nb) {
    const int b = row / LT, t = row - b * LT; const bool isc = t >= LL;
    if (isc && layer == 1) continue;
    u32x4 hv[4];
#pragma unroll
    for (int i = 0; i < 4; ++i) hv[i] = *(const u32x4*)(p.H2 + (size_t)row * DM + i * 512 + lane * 8);
    float acc[32];
#pragma unroll
    for (int i = 0; i < 32; ++i) acc[i] = 0.f;
    const int myidx = lane < 16 ? p.IDX[(size_t)row * 128 + wave * 16 + lane] : 0; const float mygate = lane < 16 ? p.GATE[(size_t)row * 128 + wave * 16 + lane] : 0.f;
#pragma unroll 1
    for (int k0 = 0; k0 < 16; k0 += 4) {
      u32x4 uu[4][4], vv[4][4];
#pragma unroll
      for (int q = 0; q < 4; ++q) { const int e = __builtin_amdgcn_readfirstlane(__shfl(myidx, k0 + q));
        const bf16_t* ur = p.Ub + (size_t)e * DM + lane * 8; const bf16_t* vr = p.Vb + (size_t)e * DM + lane * 8;
#pragma unroll
        for (int i = 0; i < 4; ++i) { uu[q][i] = *(const u32x4*)(ur + i * 512); vv[q][i] = *(const u32x4*)(vr + i * 512); } }
#pragma unroll
      for (int q = 0; q < 4; ++q) { float d = 0.f;
#pragma unroll
        for (int i = 0; i < 4; ++i) { d = dot2bf(uu[q][i].x, hv[i].x, d); d = dot2bf(uu[q][i].y, hv[i].y, d); d = dot2bf(uu[q][i].z, hv[i].z, d); d = dot2bf(uu[q][i].w, hv[i].w, d); }
        d = wsum(d);
        const float wgt = __shfl(mygate, k0 + q) * 0.5f * d * (1.f + erff(d * 0.70710678118654752f));
#pragma unroll
        for (int i = 0; i < 4; ++i) {
          acc[i * 8 + 0] += wgt * __uint_as_float(vv[q][i].x << 16); acc[i * 8 + 1] += wgt * __uint_as_float(vv[q][i].x & 0xffff0000u);
          acc[i * 8 + 2] += wgt * __uint_as_float(vv[q][i].y << 16); acc[i * 8 + 3] += wgt * __uint_as_float(vv[q][i].y & 0xffff0000u);
          acc[i * 8 + 4] += wgt * __uint_as_float(vv[q][i].z << 16); acc[i * 8 + 5] += wgt * __uint_as_float(vv[q][i].z & 0xffff0000u);
          acc[i * 8 + 6] += wgt * __uint_as_float(vv[q][i].w << 16); acc[i * 8 + 7] += wgt * __uint_as_float(vv[q][i].w & 0xffff0000u); } }
    }
    __syncthreads();
#pragma unroll
    for (int i = 0; i < 4; ++i) { float* d = lds + wave * 2048 + i * 512 + lane * 8;
      *(f32x4*)d = (f32x4){acc[i * 8], acc[i * 8 + 1], acc[i * 8 + 2], acc[i * 8 + 3]}; *(f32x4*)(d + 4) = (f32x4){acc[i * 8 + 4], acc[i * 8 + 5], acc[i * 8 + 6], acc[i * 8 + 7]}; }
    __syncthreads();
    { const int col = tid * 4; f32x4 sum = (f32x4){0.f, 0.f, 0.f, 0.f};
#pragma unroll
      for (int w = 0; w < 8; ++w) sum += *(const f32x4*)(lds + w * 2048 + col);
      const f32x4 g2 = *(const f32x4*)(p.mod + ((size_t)layer * 9 + (isc ? 8 : b)) * NMOD + 5 * DM + col);
      float* xr = p.X + (size_t)row * DM + col; if (!dry) *(f32x4*)xr = *(const f32x4*)xr + g2 * sum; }
  }
}

DI void st_final(const Prm& p, int bid, int nb) {
  const int wave = ltid() >> 6, lane = ltid() & 63;
  for (int r = bid * 8 + wave; r < NB * LL; r += nb * 8) {
    const int b = r / LL, t = r - b * LL; const float* src = p.X + (size_t)(b * LT + t) * DM;
    f32x4 v[8]; float ss = 0.f;
#pragma unroll
    for (int i = 0; i < 8; ++i) { v[i] = *(const f32x4*)(src + (i * 64 + lane) * 4); ss += v[i][0] * v[i][0] + v[i][1] * v[i][1] + v[i][2] * v[i][2] + v[i][3] * v[i][3]; }
    ss = wsum(ss); const float rstd = rsqrtf(ss * (1.f / 2048.f) + EPSV);
#pragma unroll
    for (int i = 0; i < 8; ++i) { const int col = (i * 64 + lane) * 4; *(f32x4*)(p.out + (size_t)r * DM + col) = v[i] * rstd * *(const f32x4*)(p.final_norm + col); }
  }
}

namespace att {
constexpr int NW = 8, QBLK = 32, KVBLK = 64;
constexpr float SCALE = 0.07216878364870322f;
constexpr float THR = 8.f;
constexpr int LDQ = 768, LDK = 1024, LDKR = 64, LDO = DM;
constexpr int SHM_V = KVBLK * 128 * 2, SHM_K = KVBLK * 128 * 2, SHM_KR = KVBLK * 64 * 2, SHM_ATTN = 2 * SHM_V + 2 * SHM_K + 2 * SHM_KR + NW * 64 * 4;
#define KSWZ(row, colB) ((row) * 256 + ((colB) ^ (((row) & 7) << 4)))
#define KRSWZ(row, colB) ((row) * 128 + ((colB) ^ ((((row) >> 1) & 7) << 4)))
#define SBAR() __builtin_amdgcn_sched_barrier(0)
DI int crow(int r, int hi) { return (r & 3) + 8 * (r >> 2) + 4 * hi; }
DI unsigned cvtpk(float lo, float hi) { unsigned r; asm volatile("v_cvt_pk_bf16_f32 %0, %1, %2" : "=v"(r) : "v"(lo), "v"(hi)); return r; }

DI void partialSM(f32x16& p0, f32x16& p1, float& m_reg, float& mn, float& alpha) {
  constexpr float C = SCALE * 1.4426950408889634f;
  float pmax = p0[0];
#pragma unroll
  for (int r = 1; r < 16; ++r) pmax = fmaxf(pmax, p0[r]);
#pragma unroll
  for (int r = 0; r < 16; ++r) pmax = fmaxf(pmax, p1[r]);
  { auto rr = __builtin_amdgcn_permlane32_swap(__float_as_uint(pmax), __float_as_uint(pmax), false, false);
    pmax = fmaxf(__uint_as_float(rr[0]), __uint_as_float(rr[1])); }
  if (__builtin_expect(__all(pmax - m_reg <= THR / SCALE), 1)) { mn = m_reg; alpha = 1.f; }
  else { mn = fmaxf(m_reg, pmax); alpha = __builtin_amdgcn_exp2f((m_reg - mn) * C); m_reg = mn; }
  const float mnC = -mn * C;
#pragma unroll
  for (int r = 0; r < 16; ++r) p0[r] = fmaf(p0[r], C, mnC);
#pragma unroll
  for (int r = 0; r < 16; ++r) p1[r] = fmaf(p1[r], C, mnC);
#pragma unroll
  for (int r = 0; r < 16; ++r) p0[r] = __builtin_amdgcn_exp2f(p0[r]);
}
DI void finishSM(f32x16& p0, f32x16& p1, float alpha, float& l_reg, bf16x8& pa0, bf16x8& pa1, bf16x8& pa2, bf16x8& pa3) {
#pragma unroll
  for (int r = 0; r < 16; ++r) p1[r] = __builtin_amdgcn_exp2f(p1[r]);
  float ps = 0;
#pragma unroll
  for (int r = 0; r < 16; ++r) ps += p0[r];
#pragma unroll
  for (int r = 0; r < 16; ++r) ps += p1[r];
  { auto rr = __builtin_amdgcn_permlane32_swap(__float_as_uint(ps), __float_as_uint(ps), false, false);
    ps = __uint_as_float(rr[0]) + __uint_as_float(rr[1]); }
  l_reg = l_reg * alpha + ps;
#define PK4(P, BASE, OUT) do { unsigned a0 = cvtpk(P[BASE + 0], P[BASE + 1]), a1 = cvtpk(P[BASE + 2], P[BASE + 3]);   \
    unsigned b0 = cvtpk(P[BASE + 4], P[BASE + 5]), b1 = cvtpk(P[BASE + 6], P[BASE + 7]);                              \
    auto r0 = __builtin_amdgcn_permlane32_swap(a0, b0, false, false); auto r1 = __builtin_amdgcn_permlane32_swap(a1, b1, false, false); \
    u32x4 w = {r0[0], r1[0], r0[1], r1[1]}; OUT = *reinterpret_cast<bf16x8*>(&w); } while (0)
  PK4(p0, 0, pa0); PK4(p0, 8, pa1); PK4(p1, 0, pa2); PK4(p1, 8, pa3);
#undef PK4
}
DI void qkt(f32x16& p0, f32x16& p1, const char* Ks, const char* KRs, const bf16x8* qr, int r32, int hi) {
  p0 = f32x16{}; p1 = f32x16{};
#pragma unroll
  for (int d0 = 0; d0 < 8; ++d0) { const int cb = (d0 * 16 + hi * 8) * 2;
    const bf16x8 b0 = *reinterpret_cast<const bf16x8*>(Ks + KSWZ(r32, cb));
    const bf16x8 b1 = *reinterpret_cast<const bf16x8*>(Ks + KSWZ(32 + r32, cb));
    p0 = __builtin_amdgcn_mfma_f32_32x32x16_bf16(b0, qr[d0], p0, 0, 0, 0);
    p1 = __builtin_amdgcn_mfma_f32_32x32x16_bf16(b1, qr[d0], p1, 0, 0, 0); }
#pragma unroll
  for (int d0 = 0; d0 < 4; ++d0) { const int cb = (d0 * 16 + hi * 8) * 2;
    const bf16x8 b0 = *reinterpret_cast<const bf16x8*>(KRs + KRSWZ(r32, cb));
    const bf16x8 b1 = *reinterpret_cast<const bf16x8*>(KRs + KRSWZ(32 + r32, cb));
    p0 = __builtin_amdgcn_mfma_f32_32x32x16_bf16(b0, qr[8 + d0], p0, 0, 0, 0);
    p1 = __builtin_amdgcn_mfma_f32_32x32x16_bf16(b1, qr[8 + d0], p1, 0, 0, 0); }
}
DI int v_st(int k, int c) { const int kk = (k & ~0xC) | ((k & 4) << 1) | ((k & 8) >> 1); return ((kk >> 3) * 4 + (c >> 5)) * 512 + ((kk & 7) * 32 + (c & 31)) * 2; }
DI int v_rd_base(int lane) { return ((lane & 3) << 3) | (((lane >> 2) & 3) << 6) | (((lane >> 4) & 1) << 5) | (((lane >> 5) & 1) << 8); }
constexpr int v_rd_off(int d0, int ks, int half) { return d0 * 512 + ks * 4096 + half * 2048; }
template <int OFF> DI s16x4 tr_read(int vb) { s16x4 r; asm volatile("ds_read_b64_tr_b16 %0, %1 offset:%2" : "=&v"(r) : "v"(vb), "i"(OFF) : "memory"); return r; }
template <int D0> DI void pv_one(f32x16& od, int vb, bf16x8 pa0, bf16x8 pa1, bf16x8 pa2, bf16x8 pa3) {
  const s16x4 l0 = tr_read<v_rd_off(D0, 0, 0)>(vb), h0 = tr_read<v_rd_off(D0, 0, 1)>(vb), l1 = tr_read<v_rd_off(D0, 1, 0)>(vb), h1 = tr_read<v_rd_off(D0, 1, 1)>(vb);
  const s16x4 l2 = tr_read<v_rd_off(D0, 2, 0)>(vb), h2 = tr_read<v_rd_off(D0, 2, 1)>(vb), l3 = tr_read<v_rd_off(D0, 3, 0)>(vb), h3 = tr_read<v_rd_off(D0, 3, 1)>(vb);
  asm volatile("s_waitcnt lgkmcnt(0)" ::: "memory"); SBAR();
#define PK(L, H) (bf16x8){L[0], L[1], L[2], L[3], H[0], H[1], H[2], H[3]}
  od = __builtin_amdgcn_mfma_f32_32x32x16_bf16(pa0, PK(l0, h0), od, 0, 0, 0);
  od = __builtin_amdgcn_mfma_f32_32x32x16_bf16(pa1, PK(l1, h1), od, 0, 0, 0);
  od = __builtin_amdgcn_mfma_f32_32x32x16_bf16(pa2, PK(l2, h2), od, 0, 0, 0);
  od = __builtin_amdgcn_mfma_f32_32x32x16_bf16(pa3, PK(l3, h3), od, 0, 0, 0);
#undef PK
}
DI void pv_d0(f32x16* o, int vb, bf16x8 pa0, bf16x8 pa1, bf16x8 pa2, bf16x8 pa3) {
  pv_one<0>(o[0], vb, pa0, pa1, pa2, pa3); pv_one<1>(o[1], vb, pa0, pa1, pa2, pa3); pv_one<2>(o[2], vb, pa0, pa1, pa2, pa3); pv_one<3>(o[3], vb, pa0, pa1, pa2, pa3);
}

DI void attn_body(const bf16_t* __restrict__ Qb, const bf16_t* __restrict__ Kh, const bf16_t* __restrict__ Vh, const bf16_t* __restrict__ KRh, bf16_t* __restrict__ Ob, int seq, int tpos0, char* lds) {
  const int tid = ltid(), wid = tid >> 6, lane = tid & 63, r32 = lane & 31, hi = lane >> 5;
  char* V_lds = lds; char* K_lds = lds + 2 * SHM_V; char* KR_lds = lds + 2 * SHM_V + 2 * SHM_K;
  float* ws = (float*)(lds + 2 * SHM_V + 2 * SHM_K + 2 * SHM_KR) + wid * 64; float* li_l = ws; float* al_l = ws + 32;
  float m_reg = -1e30f, l_reg = 0; f32x16 o[4] = {}; bf16x8 qr[12];
  const bf16_t* Qw = Qb + (long)(wid * QBLK + r32) * LDQ + hi * 8;
#pragma unroll
  for (int d0 = 0; d0 < 12; ++d0) qr[d0] = *reinterpret_cast<const bf16x8*>(Qw + d0 * 16);
  if (tpos0 >= 0) {
    const int t = tpos0 + wid * QBLK + r32;
#pragma unroll
    for (int hf = 0; hf < 2; ++hf) { const float pos = (float)(hf ? (t & 63) : (t >> 6));
#pragma unroll
      for (int j = 0; j < 8; ++j) { const float ang = pos * exp2f(-(float)(hi * 8 + j) * (13.287712379549449f / 16.f)); float sv, cv; sincosf(ang, &sv, &cv);
        const float x1 = bf2f((bf16_t)qr[8 + 2 * hf][j]), x2 = bf2f((bf16_t)qr[9 + 2 * hf][j]);
        qr[8 + 2 * hf][j] = (short)f2bf(x1 * cv - x2 * sv); qr[9 + 2 * hf][j] = (short)f2bf(x2 * cv + x1 * sv); } }
  }
  const int sr = tid >> 4, sc = (tid & 15) * 8, vst0 = v_st(sr, sc), vst1 = v_st(32 + sr, sc);
  const int krr = tid >> 3, krc = (tid & 7) * 8;
  const int vb0 = (int)(uintptr_t)V_lds + v_rd_base(lane);
  bf16x8 vs0, vs1, ks0, ks1, kr0;
#define SLOAD(k0) do { vs0 = *reinterpret_cast<const bf16x8*>(&Vh[(long)((k0) + sr) * LDK + sc]); vs1 = *reinterpret_cast<const bf16x8*>(&Vh[(long)((k0) + 32 + sr) * LDK + sc]); \
    ks0 = *reinterpret_cast<const bf16x8*>(&Kh[(long)((k0) + sr) * LDK + sc]); ks1 = *reinterpret_cast<const bf16x8*>(&Kh[(long)((k0) + 32 + sr) * LDK + sc]); \
    kr0 = *reinterpret_cast<const bf16x8*>(&KRh[(long)((k0) + krr) * LDKR + krc]); } while (0)
#define SWRITE(b) do { *(bf16x8*)(V_lds + (b) * SHM_V + vst0) = vs0; *(bf16x8*)(V_lds + (b) * SHM_V + vst1) = vs1; const int kc = sc * 2;               \
    *(bf16x8*)(K_lds + (b) * SHM_K + KSWZ(sr, kc)) = ks0; *(bf16x8*)(K_lds + (b) * SHM_K + KSWZ(32 + sr, kc)) = ks1;                       \
    *(bf16x8*)(KR_lds + (b) * SHM_KR + KRSWZ(krr, krc * 2)) = kr0; } while (0)
#define SWAIT() asm volatile("s_waitcnt vmcnt(0)" ::: "memory")
#define RESC(a) do { if (__any((a) < 1.f)) { if (hi == 0) al_l[r32] = (a); asm volatile("s_waitcnt lgkmcnt(0)" ::: "memory"); \
    _Pragma("unroll") for (int d = 0; d < 4; ++d) _Pragma("unroll") for (int r = 0; r < 16; ++r) o[d][r] *= al_l[crow(r, hi)]; } } while (0)
  f32x16 p0, p1; float mn, al; bf16x8 pa0, pa1, pa2, pa3; const int NT = seq / KVBLK;
  SLOAD(0); SWAIT(); SWRITE(0); __syncthreads();
  for (int j = 0; j < NT; ++j) {
    const int buf = j & 1; const bool more = j + 1 < NT;
    if (more) SLOAD((j + 1) * KVBLK);
    SBAR(); qkt(p0, p1, K_lds + buf * SHM_K, KR_lds + buf * SHM_KR, qr, r32, hi);
    partialSM(p0, p1, m_reg, mn, al); RESC(al);
    finishSM(p0, p1, al, l_reg, pa0, pa1, pa2, pa3); SBAR();
    pv_d0(o, vb0 + buf * SHM_V, pa0, pa1, pa2, pa3);
    if (more) { SWAIT(); SWRITE(buf ^ 1); }
    __syncthreads();
  }
  if (hi == 0) li_l[r32] = l_reg; asm volatile("s_waitcnt lgkmcnt(0)" ::: "memory");
  float rli[16];
#pragma unroll
  for (int r = 0; r < 16; ++r) rli[r] = __builtin_amdgcn_rcpf(li_l[crow(r, hi)]);
  bf16_t* Ow = Ob + (long)(wid * QBLK) * LDO;
#pragma unroll
  for (int r = 0; r < 16; ++r) { const int orow = crow(r, hi);
#pragma unroll
    for (int d0 = 0; d0 < 4; ++d0) Ow[(long)orow * LDO + d0 * 32 + r32] = f2bf(o[d0][r] * rli[r]); }
  __syncthreads();
#undef SLOAD
#undef SWRITE
#undef SWAIT
#undef RESC
}
}

DI void st_attn(const Prm& p, int layer, char* lds, int bid, int nb) {
  const int nlat = NB * 4 * 16, nitem = nlat + (layer == 0 ? NB * 4 : 0);
  for (int it = bid; it < nitem; it += nb) {
    if (it < nlat) { const int b = it >> 6, h = (it >> 4) & 3, qb = it & 15; const size_t r0 = (size_t)b * LT;
      att::attn_body(p.Qraw + (r0 + qb * 256) * 768 + h * 192, p.KV + r0 * 1024 + h * 256, p.KV + r0 * 1024 + h * 256 + 128, p.KR + r0 * 64,
                     p.Y + (r0 + qb * 256) * DM + 1024 + h * 128, LT, qb * 256, lds); }
    else { const int k = it - nlat, b = k >> 2, h = k & 3; const size_t r0 = (size_t)b * LT + LL;
      att::attn_body(p.Qraw + r0 * 768 + h * 192, p.KV + r0 * 1024 + h * 256, p.KV + r0 * 1024 + h * 256 + 128, p.KR + r0 * 64, p.Y + r0 * DM + 1024 + h * 128, LCX, -1, lds); }
  }
}

struct EpiResid {
  static constexpr bool PERM = false, AFTER_DRAIN = false;
  const float* xlat; const float* xctx; float* X; const float* modl; int first;
  __device__ __forceinline__ void operator()(const pg8::f32x4 (&acc)[2][2][4][2], const pg8::Unit& u, int wr, int wc, int fr, int fq) const {
    const int b = u.pm / 17, tl = u.pm - b * 17; const bool isc = tl == 16;
    const float* g = modl + (size_t)(isc ? 8 : b) * NMOD + 2 * DM;
    const int rloc0 = wr * 64 + fr, col0 = u.pn * 256 + wc * 32 + 4 * fq;
    pg8::f32x4 gv[2][2];
#pragma unroll
    for (int bj = 0; bj < 2; ++bj)
#pragma unroll
      for (int n = 0; n < 2; ++n) gv[bj][n] = *(const pg8::f32x4*)(g + col0 + bj * 128 + n * 16);
#pragma unroll
    for (int ai = 0; ai < 2; ++ai)
#pragma unroll
      for (int m = 0; m < 4; ++m) { const int rl = rloc0 + ai * 128 + m * 16; const size_t row = (size_t)u.pm * 256 + rl;
        const float* src = first ? (isc ? xctx + ((size_t)b * LCX + rl) * DM : xlat + ((size_t)b * LL + tl * 256 + rl) * DM) : X + row * DM;
        float* dst = X + row * DM;
#pragma unroll
        for (int bj = 0; bj < 2; ++bj)
#pragma unroll
          for (int n = 0; n < 2; ++n) { const int c = col0 + bj * 128 + n * 16; *(pg8::f32x4*)(dst + c) = *(const pg8::f32x4*)(src + c) + gv[bj][n] * acc[ai][bj][m][n]; } }
  }
};

template <class Epi> DI void run_gemm(unsigned char* lds, const bf16_t* A, const bf16_t* Bt, int M, int N, int K, const Epi& E, int bid, int nb) {
  pg8::Gemm g; g.A = A; g.Bt = Bt; g.M = M; g.N = N; g.K = K;
  pg8::StaticOrder S; S.init(M, N, nb, bid);
  pg8::gemm_phase<Epi, pg8::StaticOrder, false>((PG8_LAS unsigned char*)lds, g, S, E, nullptr);
}
DI pg8::EpiBf16<0> epi_bf16(bf16_t* O, int ldc, int split_cols = 0, size_t split_stride = 0) { pg8::EpiBf16<0> e; e.O = O; e.ldc = ldc; e.bias = nullptr; e.split_cols = split_cols; e.split_stride = split_stride; return e; }

#ifndef PROBE
#define PROBE 0
#endif
constexpr int LDS_MAIN = 131072, LDS_TOTAL = LDS_MAIN + 64;
#define PRM() (*(const __attribute__((address_space(4))) Prm*)launder_k(kp))
typedef const __attribute__((address_space(4))) void* kptr_t;
DI kptr_t launder_k(kptr_t q) { asm volatile("" : "+s"(q)); return q; }
extern __shared__ __attribute__((aligned(16))) unsigned char shm[];
__global__ void __launch_bounds__(NTHR, 2) mega(Prm p_unused) {
#if defined(__HIP_DEVICE_COMPILE__)
  kptr_t kp = (kptr_t)__builtin_amdgcn_kernarg_segment_ptr();
  const int bid0 = blockIdx.x, nb0 = gridDim.x;
#define bid lsg(bid0)
#define nb lsg(nb0)
  uint4* xbw = (uint4*)(shm + LDS_MAIN);
  if (threadIdx.x == 0) *xbw = make_uint4(0u, 0u, 0u, 0u);
  __syncthreads();
  { const Prm p = PRM(); (void)xcd_barrier_post(p.bar, (volatile LAS unsigned*)xbw); }
#define GRID_BAR() do { XcdBarrier b_; b_.bar = PRM().bar; b_.x = xb_xcc_id(); b_.st = (volatile LAS unsigned*)(shm + LDS_MAIN); xcd_barrier(b_); } while (0)
  float* lf = (float*)shm;
  for (int ly = 0; ly < 2; ++ly) { const Prm p = PRM();
    st_transpose(p.w_in + (size_t)ly * DM * IN_W, p.WinT + (size_t)ly * NZ * DM, DM, IN_W, DM, NZ, lf, bid, nb);
    st_transpose(p.w_out + (size_t)ly * DM * DM, p.WoutT + (size_t)ly * DM * DM, DM, DM, DM, DM, lf, bid, nb);
    st_transpose(p.peer_wq + (size_t)ly * DM * DM, p.WqT + (size_t)ly * DM * DM, DM, DM, DM, DM, lf, bid, nb);
    st_transpose(p.mla_w_uq + (size_t)ly * 448 * 768, p.WuqT + (size_t)ly * 768 * 512, 448, 768, 512, 768, lf, bid, nb);
    st_transpose(p.mla_w_ukv + (size_t)ly * 128 * 1024, p.WukvT + (size_t)ly * 1024 * 256, 128, 1024, 256, 1024, lf, bid, nb);
  }
  { const Prm p = PRM(); st_tables(p, bid, nb); }
  __syncthreads();
  { const Prm p = PRM(); st_mods(p, lf, bid, nb); }
  GRID_BAR();
  for (int l = 0; l < 2; ++l) {
    { const Prm p = PRM(); st_modulate(p, l, 0, p.H, bid, nb); }
    GRID_BAR();
    { const Prm p = PRM(); run_gemm(shm, p.H, p.WinT + (size_t)l * NZ * DM, MR, NZ, DM, epi_bf16(p.Z, NZ), bid, nb); }
    if (PROBE == 6) { const Prm p = PRM(); run_gemm(shm, p.H, p.WinT + (size_t)l * NZ * DM, MR, NZ, DM, epi_bf16(p.Z, NZ), bid, nb); }
    GRID_BAR();
    { const Prm p = PRM(); st_dnprep(p, l, bid, nb); }
    { const Prm p = PRM(); st_mlaprep(p, l, bid, nb); }
    { const Prm p = PRM(); st_fnchan(p, lf, bid, nb); }
    GRID_BAR();
    if (bid < 128) { const Prm p = PRM(); st_dnscan(p, lf, bid, 128); }
    else if (bid < 192) { const Prm p = PRM(); st_glascan(p, l, lf, bid - 128, 64); }
    else {
      const int b2 = bid - 192, n2 = nb - 192;
      { const Prm p = PRM(); run_gemm(shm, p.Aq, p.WuqT + (size_t)l * 768 * 512, MR, 768, 512, epi_bf16(p.Qraw, 768), b2, n2); }
      { const Prm p = PRM(); run_gemm(shm, p.Akv, p.WukvT + (size_t)l * 1024 * 256, MR, 1024, 256, epi_bf16(p.KV, 1024), b2, n2); }
    }
    if (PROBE == 2) { GRID_BAR();
      if (bid < 128) { const Prm p = PRM(); st_dnscan(p, lf, bid, 128); }
      else if (bid < 192) { const Prm p = PRM(); st_glascan(p, l, lf, bid - 128, 64); } }
    GRID_BAR();
    { const Prm p = PRM(); st_attn(p, l, (char*)shm, bid, nb); }
    if (PROBE == 3) { const Prm p = PRM(); st_attn(p, l, (char*)shm, bid, nb); }
    { const Prm p = PRM(); run_gemm(shm, p.DFTM, p.PQT, 4096, 4096, 8192, epi_bf16(p.Y + 1536, DM, 512, (size_t)LT * DM), bid, nb); }
    if (l == 0) { const Prm p = PRM(); run_gemm(shm, p.DFTC, p.PQTc, 256, 4096, 512, epi_bf16(p.Y + (size_t)LL * DM + 1536, DM, 512, (size_t)LT * DM), bid, nb); }
    { const Prm p = PRM(); st_combine(p, l, bid, nb); }
    GRID_BAR();
    { const Prm p = PRM(); EpiResid e; e.xlat = p.x; e.xctx = p.ctx; e.X = p.X; e.modl = p.mod + (size_t)l * 9 * NMOD; e.first = l == 0;
      run_gemm(shm, p.Y, p.WoutT + (size_t)l * DM * DM, MR, DM, DM, e, bid, nb); }
    GRID_BAR();
    { const Prm p = PRM(); st_modulate(p, l, 1, p.H2, bid, nb); }
    { const Prm p = PRM(); st_cvt_tables(p, l, bid, nb); }
    GRID_BAR();
    { const Prm p = PRM(); run_gemm(shm, p.H2, p.WqT + (size_t)l * DM * DM, MR, DM, DM, epi_bf16(p.Qp, DM), bid, nb); }
    GRID_BAR();
    { const Prm p = PRM(); st_peertopk(p, l, shm, bid, nb); }
    if (PROBE == 4) { __syncthreads(); const Prm p = PRM(); st_peertopk(p, l, shm, bid, nb); }
    GRID_BAR();
    { const Prm p = PRM(); st_peergather(p, l, lf, bid, nb); }
    if (PROBE == 1) { __syncthreads(); const Prm p = PRM(); st_peergather(p, l, lf, bid, nb, true); }
    GRID_BAR();
  }
  { const Prm p = PRM(); st_final(p, bid, nb); }
#endif
#undef bid
#undef nb
#undef GRID_BAR
}

static size_t al256(size_t x) { return (x + 255) / 256 * 256; }
extern "C" void kernel_launch(void* const* d_in, const int* in_sizes, int n_in, void* d_out, int out_size, void* d_ws, size_t ws_size, hipStream_t stream) {
  Prm p{};
  const float** f = (const float**)&p.x;
  for (int i = 0; i < 24; ++i) f[i] = (const float*)d_in[i];
  p.out = (float*)d_out;
  char* w = (char*)d_ws; size_t o = 0;
  auto take = [&](size_t bytes) { char* r = w + o; o += al256(bytes); return r; };
  p.bar = (unsigned*)take(16384);
  p.WinT = (bf16_t*)take((size_t)2 * NZ * DM * 2); p.WoutT = (bf16_t*)take((size_t)2 * DM * DM * 2); p.WqT = (bf16_t*)take((size_t)2 * DM * DM * 2);
  p.WuqT = (bf16_t*)take((size_t)2 * 768 * 512 * 2); p.WukvT = (bf16_t*)take((size_t)2 * 1024 * 256 * 2);
  p.mod = (float*)take((size_t)2 * 9 * NMOD * 4); p.GB = (float*)take((size_t)MR * 16 * 4); p.CCS = (float*)take((size_t)2 * 128 * 128 * 4);
  p.DFTM = (bf16_t*)take((size_t)4096 * 8192 * 2); p.DFTC = (bf16_t*)take((size_t)256 * 512 * 2);
  p.X = (float*)take((size_t)MR * DM * 4);
  p.Z = (bf16_t*)take((size_t)MR * NZ * 2);
  char* ra = take((size_t)MR * 1536 * 2 + (size_t)4 * MR * 512 * 2);
  p.DNQ = (bf16_t*)ra; p.OB = (bf16_t*)(ra + (size_t)MR * 1536 * 2); p.H = (bf16_t*)ra;
  p.Ub = (bf16_t*)ra; p.Vb = (bf16_t*)(ra + (size_t)16384 * DM * 2);
  p.KV = (bf16_t*)take((size_t)MR * 1024 * 2); p.KR = (bf16_t*)take((size_t)MR * 64 * 2);
  p.Aq = (bf16_t*)take((size_t)MR * 512 * 2); p.Akv = (bf16_t*)take((size_t)MR * 256 * 2);
  if (o > ws_size) return;
  char* q = (char*)d_out; size_t oo = 0;
  p.Y = (bf16_t*)q; oo += (size_t)MR * DM * 2; p.PQT = (bf16_t*)(q + oo); oo += (size_t)8 * 512 * 8192 * 2; p.PQTc = (bf16_t*)(q + oo); oo += (size_t)8 * 512 * 512 * 2;
  p.Qraw = (bf16_t*)(q + oo); oo += (size_t)MR * 768 * 2;
  char* z = (char*)p.Z; p.H2 = (bf16_t*)z; p.Qp = (bf16_t*)(z + (size_t)MR * DM * 2); p.IDX = (int*)(z + (size_t)2 * MR * DM * 2); p.GATE = (float*)(z + (size_t)2 * MR * DM * 2 + (size_t)MR * 128 * 4);

  static int grid = 0;
  if (!grid) {
    (void)hipFuncSetAttribute((const void*)mega, hipFuncAttributeMaxDynamicSharedMemorySize, LDS_TOTAL);
    int dev = 0, cus = 0, per_cu = 0;
    (void)hipGetDevice(&dev); (void)hipDeviceGetAttribute(&cus, hipDeviceAttributeMultiprocessorCount, dev);
    (void)hipOccupancyMaxActiveBlocksPerMultiprocessor(&per_cu, (const void*)mega, NTHR, LDS_TOTAL);
    grid = per_cu >= 1 ? cus : 0;
    if (grid > 256) grid = 256;
  }
  if (grid < 256) return;
  (void)hipMemsetAsync(p.bar, 0, XCD_BAR_WORDS * sizeof(unsigned), stream);
  hipLaunchKernelGGL(mega, dim3(grid), dim3(NTHR), LDS_TOTAL, stream, p);
}
```

```cpp
#include <hip/hip_runtime.h>
#include <stdint.h>

constexpr int DM = 2048, NB = 8, LL = 4096, LCX = 256, LT = LL + LCX  , MR = NB * LT  ;
constexpr int NZ = 4864;
constexpr int C_DNQ = 0, C_DNK = 512, C_DNV = 1024, C_DNGATE = 1536, C_DNA = 2048, C_DNB = 2056, C_GQ = 2064, C_GK = 2320, C_GV = 2576,
              C_GGATE = 3088, C_GALPHA = 3600, C_CQ = 3632, C_CKV = 4080, C_KR = 4208, C_FN = 4272, IN_W = 4784;
constexpr int NMOD = 6 * DM;
constexpr float EPSV = 1e-6f;
constexpr int NTHR = 512;

typedef unsigned short bf16_t;
typedef short bf16x8 __attribute__((ext_vector_type(8)));
typedef short s16x4 __attribute__((ext_vector_type(4)));
typedef float f32x4 __attribute__((ext_vector_type(4)));
typedef float f32x16 __attribute__((ext_vector_type(16)));
typedef unsigned u32x4 __attribute__((ext_vector_type(4)));
typedef unsigned u32x2 __attribute__((ext_vector_type(2)));

#define DI __device__ __forceinline__
DI float bf2f(bf16_t b) { return __uint_as_float(((unsigned)b) << 16); }
DI bf16_t f2bf(float f) { unsigned u = __float_as_uint(f); u += 0x7FFFu + ((u >> 16) & 1u); return (bf16_t)(u >> 16); }
DI unsigned pack2(float lo, float hi) { return (unsigned)f2bf(lo) | ((unsigned)f2bf(hi) << 16); }
DI float wsum(float v) { for (int o = 32; o >= 1; o >>= 1) v += __shfl_xor(v, o); return v; }
DI float wmax(float v) { for (int o = 32; o >= 1; o >>= 1) v = fmaxf(v, __shfl_xor(v, o)); return v; }
DI float siluf(float x) { return x / (1.f + __expf(-x)); }
DI float sigmf(float x) { return 1.f / (1.f + __expf(-x)); }

DI int ltid() { int t = (int)threadIdx.x; asm volatile("" : "+v"(t)); return t; }
DI int lsg(int v) { asm volatile("" : "+s"(v)); return v; }

struct Prm {
  const float *x, *c, *ctx, *c_ctx, *w_ada, *b_ada, *w_in, *dn_conv, *dn_a_log, *dn_dt_bias, *dn_norm, *gla_w2, *gla_b2, *gla_norm,
      *mla_q_norm, *mla_w_uq, *mla_kv_norm, *mla_w_ukv, *w_out, *peer_wq, *peer_keys, *peer_u, *peer_v, *final_norm;
  float* out;
  bf16_t *WinT, *WoutT, *WqT, *WuqT, *WukvT;
  float *mod, *GB, *CCS;
  bf16_t *DFTM, *DFTC;
  float* X;
  bf16_t* Z;
  bf16_t *H, *DNQ, *OB;
  bf16_t *KV, *KR;
  bf16_t *Y, *PQT, *PQTc, *Qraw, *Aq, *Akv;
  bf16_t *H2, *Qp;
  bf16_t *Ub, *Vb;
  int* IDX;
  float* GATE;
  unsigned* bar;
};
#define XB_TMO      128
#define XB_XCNT(j)  (256  + 64 * (j))
#define XB_XSUB(j)  (1280 + 64 * (j))
#define XB_XGEN(j)  (2304 + 64 * (j))
#define XB_TOP      3328
#define XB_TOPGEN   3392
#define XCD_BAR_WORDS 3456
#define XB_SPIN_CAP (1u << 18)
#define LAS __attribute__((address_space(3)))

__device__ __forceinline__ unsigned xb_ld(unsigned* p)              { return __hip_atomic_load(p, __ATOMIC_RELAXED, __HIP_MEMORY_SCOPE_AGENT); }
__device__ __forceinline__ unsigned xb_add(unsigned* p, unsigned v) { return __hip_atomic_fetch_add(p, v, __ATOMIC_RELAXED, __HIP_MEMORY_SCOPE_AGENT); }
__device__ __forceinline__ unsigned xb_xcc_id() { return (unsigned)__builtin_amdgcn_s_getreg((3 << 11) | 20) & 0xFu; }
#define XB_SPIN(cond, bar) do { unsigned _sp = 0; while (cond) { __builtin_amdgcn_s_sleep(1); \
    if ((++_sp & 255u) == 0u) { if (xb_ld(&(bar)[XB_TMO])) break; if (_sp > XB_SPIN_CAP) { atomicAdd(&(bar)[XB_TMO], 1u); break; } } } } while (0)

struct XcdBarrier {
    unsigned* bar; unsigned x;
    volatile LAS unsigned* st;
};

__device__ __forceinline__ XcdBarrier xcd_barrier_post(unsigned* bar, volatile LAS unsigned* st) {
    XcdBarrier b; b.bar = bar; b.x = xb_xcc_id(); b.st = st;
    if (threadIdx.x == 0) (void)xb_add(&bar[XB_XCNT(b.x)], 1u);
    return b;
}
__device__ __forceinline__ void xcd_barrier_complete(unsigned* bar, unsigned x, unsigned& nloc, unsigned& nx) {
    const unsigned G = gridDim.x * gridDim.y * gridDim.z;
    unsigned sum, cnt, mine, sp = 0u;
    for (;;) {
        sum = 0u; cnt = 0u; mine = 0u;
#pragma unroll
        for (unsigned j = 0; j < 16; ++j) { const unsigned c = xb_ld(&bar[XB_XCNT(j)]); sum += c; cnt += (c > 0u) ? 1u : 0u; mine = (j == x) ? c : mine; }
        if (sum == G) break;
        __builtin_amdgcn_s_sleep(1);
        if ((++sp & 255u) == 0u) { if (xb_ld(&bar[XB_TMO])) break; if (sp > XB_SPIN_CAP) { atomicAdd(&bar[XB_TMO], 1u); break; } }
    }
    nloc = mine > 0u ? mine : 1u; nx = cnt > 0u ? cnt : 1u;
}

__device__ __forceinline__ void xcd_barrier(const XcdBarrier& b) {
    asm volatile("s_waitcnt vmcnt(0)" ::: "memory");
    __syncthreads();
    if (threadIdx.x == 0) {
        unsigned* bar = b.bar;
        __builtin_amdgcn_s_waitcnt(0);
        unsigned nloc = b.st[0], nx = b.st[1];
        if (nloc == 0u) { xcd_barrier_complete(bar, b.x, nloc, nx); b.st[0] = nloc; b.st[1] = nx; }
        const unsigned old = xb_add(&bar[XB_XSUB(b.x)], 1u);
        const unsigned gen = old / nloc;
        if (old + 1u == (gen + 1u) * nloc) {
            __builtin_amdgcn_fence(__ATOMIC_RELEASE, "agent");
            asm volatile("s_waitcnt vmcnt(0)" ::: "memory");
            const unsigned og = xb_add(&bar[XB_TOP], 1u);
            const unsigned tg = og / nx;
            if (og + 1u == (tg + 1u) * nx) xb_add(&bar[XB_TOPGEN], 1u);
            else XB_SPIN(xb_ld(&bar[XB_TOPGEN]) == tg, bar);
            __builtin_amdgcn_fence(__ATOMIC_ACQUIRE, "agent");
            xb_add(&bar[XB_XGEN(b.x)], 1u);
            asm volatile("s_waitcnt vmcnt(0)" ::: "memory");
        } else {
            XB_SPIN(xb_ld(&bar[XB_XGEN(b.x)]) == gen, bar);
            __builtin_amdgcn_fence(__ATOMIC_ACQUIRE, "agent");
            asm volatile("s_waitcnt vmcnt(0)" ::: "memory");
        }
    }
    __syncthreads();
}

namespace pg8 {
#define PG8_LAS __attribute__((address_space(3)))
typedef unsigned short bf16_t;
typedef short bf16x8 __attribute__((ext_vector_type(8)));
typedef float f32x4 __attribute__((ext_vector_type(4)));
typedef unsigned u32x4 __attribute__((ext_vector_type(4)));
constexpr int BM = 256, BK = 64, HALF = 128, HTB = HALF * BK * 2  , STAGE_BYTES = 8 * HTB, NXCD = 8, WGM = 8;

__host__ __device__ __forceinline__ int lds_byte(int r, int c) { const int st = (r >> 4) * 2 + (c >> 5), rr = r & 15, cc = c & 31, ob = rr * 64 + cc * 2; return st * 1024 + (ob ^ (((ob >> 9) & 1) << 5)); }
__host__ __device__ __forceinline__ void stage_rc(int b, int& R, int& C) { const int st = b / 1024, sb = b % 1024, swz = sb ^ (((sb >> 9) & 1) << 5); R = (st >> 1) * 16 + swz / 64; C = (st & 1) * 32 + (swz % 64) / 2; }
__host__ __device__ __forceinline__ int perm32(int rho) { const int n = rho >> 4, i = rho & 15; return 8 * (i >> 2) + 4 * n + (i & 3); }

struct Unit { int pm, pn; };
struct Gemm { const bf16_t* A; const bf16_t* Bt; int M, N, K; };

struct StaticOrder {
    int nM, nN, nwg, G, c;
    __host__ __device__ void init(int M, int N, int G_, int c_) { nM = M / BM; nN = N / BM; nwg = nM * nN; G = G_; c = c_; }
    __host__ __device__ bool next(int i, Unit& u) const {
        const long L = (long)i * G + c; if (L >= nwg) return false;
        int wgid = (int)L; { const int q = nwg / NXCD, r = nwg % NXCD, xcd = wgid % NXCD, off = wgid / NXCD; wgid = (xcd < r ? xcd * (q + 1) : r * (q + 1) + (xcd - r) * q) + off; }
        const int nig = WGM * nN, gid = wgid / nig, fm = gid * WGM, gsz = (nM - fm) < WGM ? (nM - fm) : WGM;
        u.pm = fm + ((wgid % nig) % gsz); u.pn = (wgid % nig) / gsz; return true;
    }
    __device__ __forceinline__ void a_ready(const Unit&) const {}
    __device__ __forceinline__ void done(const Unit&) const {}
};
struct CountedOrder : StaticOrder {
    const unsigned* ready; unsigned need; unsigned* tmo;
    __device__ __forceinline__ void a_ready(const Unit& u) const {
        if (threadIdx.x < 64) {
            const unsigned long long t0 = __builtin_amdgcn_s_memrealtime(); unsigned polls = 0;
            while ((unsigned)__builtin_amdgcn_readfirstlane(__hip_atomic_load(ready + 64 * u.pm, __ATOMIC_RELAXED, __HIP_MEMORY_SCOPE_AGENT)) < need) {
                if ((++polls & 255u) == 0u && __builtin_amdgcn_readfirstlane(__hip_atomic_load(tmo, __ATOMIC_RELAXED, __HIP_MEMORY_SCOPE_AGENT)) != 0u) break;
                if (__builtin_amdgcn_s_memrealtime() - t0 > 2000000ull) {
                    if (threadIdx.x == 0) { unsigned expect = 0u; __hip_atomic_compare_exchange_strong(tmo + 1, &expect, 0x600u | (unsigned)(u.pm & 0xff), __ATOMIC_RELAXED, __ATOMIC_RELAXED, __HIP_MEMORY_SCOPE_AGENT); __hip_atomic_store(tmo, 1u, __ATOMIC_RELAXED, __HIP_MEMORY_SCOPE_AGENT); }
                    break; }
                __builtin_amdgcn_s_sleep(2); }
            __builtin_amdgcn_fence(__ATOMIC_ACQUIRE, "agent");
            asm volatile("s_waitcnt vmcnt(0)" ::: "memory");
        }
#if !defined(BROKEN_HOOK_NO_BARRIER)
        asm volatile("" ::: "memory"); __builtin_amdgcn_s_barrier(); asm volatile("" ::: "memory");
#endif
    }
};

__device__ __forceinline__ unsigned cvt_pk_bf16(float lo, float hi) { unsigned r; asm volatile("v_cvt_pk_bf16_f32 %0, %1, %2" : "=v"(r) : "v"(lo), "v"(hi)); return r; }
typedef float f32x2 __attribute__((ext_vector_type(2)));
__device__ __forceinline__ f32x2 gelu_pk(f32x2 v) {
    const f32x2 av = __builtin_elementwise_abs(v), d = av * 0.2316418882f + 1.0f;
    f32x2 t; t.x = __builtin_amdgcn_rcpf(d.x); t.y = __builtin_amdgcn_rcpf(d.y);
    f32x2 q = t * 0.5307027145f + (-0.7265760135f); q = q * t + 0.7107068705f; q = q * t + (-0.142248368f); q = q * t + 0.127414796f; q = q * t;
    const f32x2 s = (v * v) * (-0.72134752044f);
    f32x2 e; e.x = __builtin_amdgcn_exp2f(s.x); e.y = __builtin_amdgcn_exp2f(s.y);
    const f32x2 m = v * (q * e), r = v - m;
    f32x2 o; o.x = v.x < 0.f ? m.x : r.x; o.y = v.y < 0.f ? m.y : r.y; return o;
}

struct EpiF32 {
    static constexpr bool PERM = false, AFTER_DRAIN = false;
    float* C; int ldc; const float* bias;
    __device__ __forceinline__ void operator()(const f32x4 (&acc)[2][2][4][2], const Unit& u, int wr, int wc, int fr, int fq) const {
        const int row0 = u.pm * BM + wr * 64 + fr, col0 = u.pn * BM + wc * 32 + 4 * fq;
        f32x4 bv[2][2];
#pragma unroll
        for (int bj = 0; bj < 2; ++bj)
#pragma unroll
            for (int n = 0; n < 2; ++n) bv[bj][n] = bias ? *(const f32x4*)(bias + col0 + bj * HALF + n * 16) : (f32x4){0.f, 0.f, 0.f, 0.f};
#pragma unroll
        for (int ai = 0; ai < 2; ++ai)
#pragma unroll
            for (int m = 0; m < 4; ++m) { float* rowp = C + (size_t)(row0 + ai * HALF + m * 16) * ldc + col0;
#pragma unroll
                for (int bj = 0; bj < 2; ++bj)
#pragma unroll
                    for (int n = 0; n < 2; ++n) *(f32x4*)(rowp + bj * HALF + n * 16) = acc[ai][bj][m][n] + bv[bj][n]; }
    }
};
template <int ACT  > struct EpiBf16 {
    static constexpr bool PERM = true, AFTER_DRAIN = false;
    bf16_t* O; int ldc; const float* bias; int split_cols; size_t split_stride;
    __device__ __forceinline__ void operator()(const f32x4 (&acc)[2][2][4][2], const Unit& u, int wr, int wc, int fr, int fq) const {
        const int row0 = u.pm * BM + wr * 64 + fr; int colt = u.pn * BM; bf16_t* base = O;
        if (split_cols) { const int t = colt / split_cols; base += (size_t)t * split_stride; colt -= t * split_cols; }
        const int col0 = colt + wc * 32 + 8 * fq, bcol0 = u.pn * BM + wc * 32 + 8 * fq;
        f32x4 bv[2][2];
#pragma unroll
        for (int bj = 0; bj < 2; ++bj)
#pragma unroll
            for (int n = 0; n < 2; ++n) bv[bj][n] = bias ? *(const f32x4*)(bias + bcol0 + bj * HALF + 4 * n) : (f32x4){0.f, 0.f, 0.f, 0.f};
#pragma unroll
        for (int ai = 0; ai < 2; ++ai)
#pragma unroll
            for (int m = 0; m < 4; ++m) { bf16_t* rowp = base + (size_t)(row0 + ai * HALF + m * 16) * ldc + col0;
#pragma unroll
                for (int bj = 0; bj < 2; ++bj) { f32x4 v0 = acc[ai][bj][m][0] + bv[bj][0], v1 = acc[ai][bj][m][1] + bv[bj][1];
                    if (ACT == 1) { f32x2 a = gelu_pk((f32x2){v0[0], v0[1]}), b = gelu_pk((f32x2){v0[2], v0[3]}), c = gelu_pk((f32x2){v1[0], v1[1]}), d = gelu_pk((f32x2){v1[2], v1[3]});
                        v0 = (f32x4){a.x, a.y, b.x, b.y}; v1 = (f32x4){c.x, c.y, d.x, d.y}; }
                    if (ACT == 2) {
#pragma unroll
                        for (int j = 0; j < 4; ++j) { v0[j] = 0.5f * v0[j] * (1.0f + erff(v0[j] * 0.70710678f)); v1[j] = 0.5f * v1[j] * (1.0f + erff(v1[j] * 0.70710678f)); } }
                    u32x4 w; w.x = cvt_pk_bf16(v0[0], v0[1]); w.y = cvt_pk_bf16(v0[2], v0[3]); w.z = cvt_pk_bf16(v1[0], v1[1]); w.w = cvt_pk_bf16(v1[2], v1[3]);
                    *(u32x4*)(rowp + bj * HALF) = w; } }
    }
};
template <class Epi, class Sched, bool STAMP = false>
__device__ __forceinline__ void gemm_phase(PG8_LAS unsigned char* lds, const Gemm g, const Sched& S, const Epi& E, unsigned long long* stamps) {
    const int tid = ltid(), wid = __builtin_amdgcn_readfirstlane(tid >> 6), lane = tid & 63, wr = wid >> 2, wc = wid & 3, fr = lane & 15, fq = lane >> 4;
    const int K = g.K, nt = K / BK;
    int ts_lo = 0, ts_hi = 0, nts = 0; const unsigned long long rt_entry = STAMP ? (unsigned long long)wall_clock64() : 0ull;
#define PG8_STAMP() do { if (STAMP && wid == 0 && nts < 64) { const unsigned long long _c = (unsigned long long)clock64(); \
        ts_lo = (lane == nts) ? (int)(unsigned)_c : ts_lo; ts_hi = (lane == nts) ? (int)(unsigned)(_c >> 32) : ts_hi; ++nts; } } while (0)
    PG8_STAMP();
    unsigned voffA[2], voffB[2];
#pragma unroll
    for (int i = 0; i < 2; ++i) { int R, C; stage_rc(tid * 16 + i * 8192, R, C); const int Rb = Epi::PERM ? ((R & ~31) + perm32(R & 31)) : R;
        voffA[i] = (unsigned)(R * K + C) * 2u; voffB[i] = (unsigned)(Rb * K + C) * 2u; }
    const size_t kstep = (size_t)(BK * 2);
    const size_t hstep = (size_t)HALF * K * 2;
    const size_t tstep = 2 * hstep;
    const unsigned ldsw = (unsigned)wid * 1024u;
    const int aoff = lds_byte(wr * 64 + fr, fq * 8), boff = lds_byte(wc * 32 + fr, fq * 8);
#define PG8_SA(b, h) (((b) * 2 + (h)) * HTB)
#define PG8_SB(b, h) ((4 + (b) * 2 + (h)) * HTB)
#define PG8_STAGE(bufoff, gbase, voff) do { _Pragma("unroll") for (int _i = 0; _i < 2; ++_i) \
        __builtin_amdgcn_global_load_lds((const unsigned*)((const char*)(gbase) + (voff)[_i]), (PG8_LAS unsigned*)(lds + (bufoff) + ldsw + _i * 8192), 16, 0, 0); } while (0)
#define PG8_LDA(dst, b, h) do { _Pragma("unroll") for (int m = 0; m < 4; ++m) _Pragma("unroll") for (int k = 0; k < 2; ++k) dst[m][k] = *(const PG8_LAS bf16x8*)(lds + PG8_SA(b, h) + aoff + m * 2048 + k * 1024); } while (0)
#define PG8_LDB(dst, b, h) do { _Pragma("unroll") for (int n = 0; n < 2; ++n) _Pragma("unroll") for (int k = 0; k < 2; ++k) dst[n][k] = *(const PG8_LAS bf16x8*)(lds + PG8_SB(b, h) + boff + n * 2048 + k * 1024); } while (0)
#define PG8_MMA(ai, bj, At, Bt) do { __builtin_amdgcn_s_setprio(1); _Pragma("unroll") for (int m = 0; m < 4; ++m) _Pragma("unroll") for (int n = 0; n < 2; ++n) _Pragma("unroll") for (int k = 0; k < 2; ++k) \
        acc[ai][bj][m][n] = __builtin_amdgcn_mfma_f32_16x16x32_bf16(Bt[n][k], At[m][k], acc[ai][bj][m][n], 0, 0, 0); __builtin_amdgcn_s_setprio(0); } while (0)
#define PG8_WAIT_V(n) asm volatile("s_waitcnt vmcnt(" #n ")" ::: "memory")
#define PG8_WAIT_L(n) asm volatile("s_waitcnt lgkmcnt(" #n ")" ::: "memory")
#define PG8_BAR __builtin_amdgcn_s_barrier()
#define PG8_SCHED __builtin_amdgcn_sched_barrier(0)
    Unit cur, nxt; int ui = 0;
    if (!S.next(0, cur)) return;
    f32x4 acc[2][2][4][2];
#pragma unroll
    for (int a = 0; a < 2; ++a)
#pragma unroll
        for (int b = 0; b < 2; ++b)
#pragma unroll
            for (int m = 0; m < 4; ++m)
#pragma unroll
                for (int n = 0; n < 2; ++n) acc[a][b][m][n] = (f32x4){0.f, 0.f, 0.f, 0.f};
    bf16x8 At[4][2], B0[2][2], B1[2][2];
    const char* cA = (const char*)g.A + (size_t)cur.pm * tstep; const char* cB = (const char*)g.Bt + (size_t)cur.pn * tstep;
    S.a_ready(cur);
    PG8_STAGE(PG8_SB(0, 0), cB, voffB); PG8_STAGE(PG8_SA(0, 0), cA, voffA); PG8_STAGE(PG8_SB(0, 1), cB + hstep, voffB); PG8_STAGE(PG8_SA(0, 1), cA + hstep, voffA);
    if (wr == 1) PG8_BAR;
    PG8_WAIT_V(4); PG8_BAR;
    PG8_STAGE(PG8_SB(1, 0), cB + kstep, voffB); PG8_STAGE(PG8_SA(1, 0), cA + kstep, voffA); PG8_STAGE(PG8_SB(1, 1), cB + hstep + kstep, voffB);
    PG8_WAIT_V(6); PG8_BAR;
    PG8_STAMP();
    for (;;) {
        const bool has_next = S.next(ui + 1, nxt);
        const char* nA = has_next ? (const char*)g.A + (size_t)nxt.pm * tstep : cA; const char* nB = has_next ? (const char*)g.Bt + (size_t)nxt.pn * tstep : cB;
        for (int t = 0; t < nt; t += 2) {
            const bool last = (t == nt - 2);
            const char* a1 = cA + (size_t)(t + 1) * kstep;
            const char* a2 = last ? nA : cA + (size_t)(t + 2) * kstep; const char* b2 = last ? nB : cB + (size_t)(t + 2) * kstep;
            const char* a3 = a2 + kstep; const char* b3 = b2 + kstep;
            if (last && has_next) S.a_ready(nxt);
            PG8_LDB(B0, 0, 0); PG8_SCHED; PG8_LDA(At, 0, 0); PG8_STAGE(PG8_SA(1, 1), a1 + hstep, voffA);
            PG8_WAIT_L(8); PG8_BAR; PG8_WAIT_L(0); PG8_MMA(0, 0, At, B0); PG8_BAR; PG8_SCHED;
            PG8_LDB(B1, 0, 1); PG8_STAGE(PG8_SB(0, 0), b2, voffB);
            PG8_BAR; PG8_WAIT_L(0); PG8_MMA(0, 1, At, B1); PG8_BAR;
            PG8_LDA(At, 0, 1); PG8_STAGE(PG8_SA(0, 0), a2, voffA);
            PG8_BAR; PG8_WAIT_L(0); PG8_MMA(1, 0, At, B0); PG8_BAR; PG8_SCHED;
            PG8_STAGE(PG8_SB(0, 1), b2 + hstep, voffB);
            PG8_WAIT_V(6); PG8_BAR; PG8_MMA(1, 1, At, B1); PG8_BAR;
            PG8_LDB(B0, 1, 0); PG8_SCHED; PG8_LDA(At, 1, 0); PG8_STAGE(PG8_SA(0, 1), a2 + hstep, voffA);
            PG8_WAIT_L(8); PG8_BAR; PG8_WAIT_L(0); PG8_MMA(0, 0, At, B0); PG8_BAR; PG8_SCHED;
            PG8_LDB(B1, 1, 1); PG8_STAGE(PG8_SB(1, 0), b3, voffB);
            PG8_BAR; PG8_WAIT_L(0); PG8_MMA(0, 1, At, B1); PG8_BAR;
            PG8_LDA(At, 1, 1); PG8_STAGE(PG8_SA(1, 0), a3, voffA);
            PG8_BAR; PG8_WAIT_L(0); PG8_MMA(1, 0, At, B0); PG8_BAR; PG8_SCHED;
            PG8_STAGE(PG8_SB(1, 1), b3 + hstep, voffB);
            PG8_WAIT_V(6); PG8_BAR; PG8_MMA(1, 1, At, B1); PG8_BAR;
        }
        PG8_STAMP();
        if constexpr (!Epi::AFTER_DRAIN) { E(acc, cur, wr, wc, fr, fq); S.done(cur); }
        PG8_STAMP();
        if (!has_next) break;
#pragma unroll
        for (int a = 0; a < 2; ++a)
#pragma unroll
            for (int b = 0; b < 2; ++b)
#pragma unroll
                for (int m = 0; m < 4; ++m)
#pragma unroll
                    for (int n = 0; n < 2; ++n) acc[a][b][m][n] = (f32x4){0.f, 0.f, 0.f, 0.f};
        cur = nxt; cA = nA; cB = nB; ++ui;
    }
    PG8_WAIT_V(0);
    if (wr == 0) PG8_BAR;
    PG8_BAR;
    if constexpr (Epi::AFTER_DRAIN) { E.fused(acc, cur, wr, wc, fr, fq, lds, wid, lane); S.done(cur); }
    PG8_STAMP();
    if (STAMP && wid == 0) { stamps[lane] = lane < nts ? (((unsigned long long)(unsigned)ts_hi << 32) | (unsigned)ts_lo) : 0ull;
        if (lane == 62) stamps[62] = rt_entry; if (lane == 63) stamps[63] = (unsigned long long)wall_clock64(); }
#undef PG8_STAMP
#undef PG8_SA
#undef PG8_SB
#undef PG8_STAGE
#undef PG8_LDA
#undef PG8_LDB
#undef PG8_MMA
#undef PG8_WAIT_V
#undef PG8_WAIT_L
#undef PG8_BAR
#undef PG8_SCHED
}
}

DI void st_transpose(const float* __restrict__ src, bf16_t* __restrict__ dst, int K, int N, int Kpad, int Npad, float* lds, int bid, int nb) {
  const int tk = Kpad / 64, tn = Npad / 64;
  for (int it = bid; it < tk * tn; it += nb) {
    const int k0 = (it % tk) * 64, n0 = (it / tk) * 64;
    __syncthreads();
    for (int e = ltid(); e < 4096; e += NTHR) { const int i = e >> 6, j = e & 63, k = k0 + i, n = n0 + j; lds[i * 65 + j] = (k < K && n < N) ? src[(size_t)k * N + n] : 0.f; }
    __syncthreads();
    for (int e = ltid(); e < 4096; e += NTHR) { const int j = e >> 6, i = e & 63; dst[(size_t)(n0 + j) * Kpad + k0 + i] = f2bf(lds[i * 65 + j]); }
  }
}

DI void st_mods(const Prm& p, float* lds, int bid, int nb) {
  float* s = lds; float* red = lds + 9 * 2048;
  for (int e = ltid(); e < 9 * 2048; e += NTHR) { const int r = e >> 11, k = e & 2047; const float v = r < 8 ? p.c[r * 2048 + k] : p.c_ctx[k]; s[e] = siluf(v); }
  __syncthreads();
  const int kg = ltid() >> 6, cl = ltid() & 63;
  for (int it = bid; it < 2 * 192; it += nb) {
    const int l = it / 192, cb = (it % 192) * 64;
    const float* w = p.w_ada + (size_t)l * 2048 * NMOD + cb + cl;
    float acc[9];
#pragma unroll
    for (int r = 0; r < 9; ++r) acc[r] = 0.f;
    for (int k = kg * 256; k < kg * 256 + 256; ++k) { const float wv = w[(size_t)k * NMOD];
#pragma unroll
      for (int r = 0; r < 9; ++r) acc[r] += s[r * 2048 + k] * wv; }
#pragma unroll
    for (int r = 0; r < 9; ++r) red[(kg * 9 + r) * 64 + cl] = acc[r];
    __syncthreads();
    for (int e = ltid(); e < 576; e += NTHR) { const int r = e >> 6, c2 = e & 63; float t = 0.f;
      for (int g = 0; g < 8; ++g) t += red[(g * 9 + r) * 64 + c2];
      p.mod[((size_t)l * 9 + r) * NMOD + cb + c2] = t + p.b_ada[l * NMOD + cb + c2]; }
    __syncthreads();
  }
}

DI void st_tables(const Prm& p, int bid, int nb) {
  const size_t stride = (size_t)nb * NTHR, t0 = (size_t)bid * NTHR + ltid();
  for (size_t e = t0; e < (size_t)4096 * 8192; e += stride) { const int k1 = (int)(e >> 13), n = (int)(e & 8191), n1 = n & 4095, idx = (k1 * n1) & 4095;
    float sv, cv; sincosf((float)idx * (6.283185307179586f / 4096.f), &sv, &cv); p.DFTM[e] = f2bf((n < 4096 ? cv : -sv) * (1.f / 64.f)); }
  for (size_t e = t0; e < (size_t)256 * 512; e += stride) { const int k1 = (int)(e >> 9), n = (int)(e & 511), n1 = n & 255, idx = (k1 * n1) & 255;
    float sv, cv; sincosf((float)idx * (6.283185307179586f / 256.f), &sv, &cv); p.DFTC[e] = f2bf((n < 256 ? cv : -sv) * (1.f / 16.f)); }
  for (size_t e = t0; e < (size_t)2 * 128 * 128; e += stride) { const int tb = (int)(e >> 14), k2 = (int)((e >> 7) & 127), n2 = (int)(e & 127), idx = (k2 * n2) & 127;
    float sv, cv; sincosf((float)idx * (6.283185307179586f / 128.f), &sv, &cv); p.CCS[e] = (tb ? sv : cv) * 0.08838834764831845f; }
}

DI void st_modulate(const Prm& p, int layer, int which, bf16_t* __restrict__ dst, int bid, int nb) {
  const int wave = ltid() >> 6, lane = ltid() & 63;
  const int shoff = which ? 3 * DM : 0, scoff = which ? 4 * DM : DM;
  for (int row = bid * 8 + wave; row < MR; row += nb * 8) {
    const int b = row / LT, t = row - b * LT; const bool isc = t >= LL;
    const float* src = (layer == 0 && which == 0) ? (isc ? p.ctx + (size_t)(b * LCX + t - LL) * DM : p.x + (size_t)(b * LL + t) * DM) : p.X + (size_t)row * DM;
    f32x4 v[8]; float ss = 0.f;
#pragma unroll
    for (int i = 0; i < 8; ++i) { v[i] = *(const f32x4*)(src + (i * 64 + lane) * 4); ss += v[i][0] * v[i][0] + v[i][1] * v[i][1] + v[i][2] * v[i][2] + v[i][3] * v[i][3]; }
    ss = wsum(ss); const float rstd = rsqrtf(ss * (1.f / 2048.f) + EPSV);
    const float* mr = p.mod + ((size_t)layer * 9 + (isc ? 8 : b)) * NMOD;
#pragma unroll
    for (int i = 0; i < 8; ++i) { const int col = (i * 64 + lane) * 4; const f32x4 sc = *(const f32x4*)(mr + scoff + col), sh = *(const f32x4*)(mr + shoff + col);
      const f32x4 o = v[i] * rstd * (sc + 1.f) + sh; u32x2 w; w.x = pack2(o[0], o[1]); w.y = pack2(o[2], o[3]); *(u32x2*)(dst + (size_t)row * DM + col) = w; }
  }
}

DI void st_dnprep(const Prm& p, int layer, int bid, int nb) {
  const int wave = ltid() >> 6, lane = ltid() & 63;
  const float* conv = p.dn_conv + (size_t)layer * 5 * 1536;
  for (long task = (long)bid * 8 + wave; task < (long)MR * 13; task += (long)nb * 8) {
    const int row = (int)(task / 13), grp = (int)(task - (long)row * 13);
    const int b = row / LT, t = row - b * LT; const bool isc = t >= LL;
    const int segbase = isc ? b * LT + LL : b * LT, segt = isc ? t - LL : t, seglen = isc ? LCX : LL;
    if (grp < 12) {
      const int c = grp * 128 + lane * 2; float a0 = 0.f, a1 = 0.f;
#pragma unroll
      for (int j = 0; j < 5; ++j) { const int tt = segt + j - 2;
        if (tt >= 0 && tt < seglen) { const unsigned zz = *(const unsigned*)(p.Z + (size_t)(segbase + tt) * NZ + c);
          a0 += bf2f((bf16_t)(zz & 0xffffu)) * conv[j * 1536 + c]; a1 += bf2f((bf16_t)(zz >> 16)) * conv[j * 1536 + c + 1]; } }
      a0 = siluf(a0); a1 = siluf(a1);
      if (grp < 8) { const float ss = wsum(a0 * a0 + a1 * a1); const float sc = rsqrtf(ss + EPSV) * (grp < 4 ? 0.08838834764831845f : 1.f); a0 *= sc; a1 *= sc; }
      *(unsigned*)(p.DNQ + (size_t)row * 1536 + c) = pack2(a0, a1);
    } else if (lane < 16) {
      const int isb = lane >> 3, dh = lane & 7; const float z = bf2f(p.Z[(size_t)row * NZ + (isb ? C_DNB : C_DNA) + dh]); float o;
      if (!isb) { const float xx = z + p.dn_dt_bias[layer * 8 + dh]; const float sp = xx > 20.f ? xx : log1pf(expf(xx)); o = -expf(p.dn_a_log[layer * 8 + dh]) * sp; }
      else o = sigmf(z);
      p.GB[(size_t)row * 16 + lane] = o;
    }
  }
}

DI void st_mlaprep(const Prm& p, int layer, int bid, int nb) {
  const int wave = ltid() >> 6, lane = ltid() & 63;
  const float* qn = p.mla_q_norm + layer * 448; const float* kvn = p.mla_kv_norm + layer * 128;
  for (int row = bid * 8 + wave; row < MR; row += nb * 8) {
    const bf16_t* z = p.Z + (size_t)row * NZ; const int b = row / LT, t = row - b * LT;
    float v[7]; float ss = 0.f;
#pragma unroll
    for (int i = 0; i < 7; ++i) { v[i] = bf2f(z[C_CQ + i * 64 + lane]); ss += v[i] * v[i]; }
    ss = wsum(ss); float rstd = rsqrtf(ss * (1.f / 448.f) + EPSV);
#pragma unroll
    for (int i = 0; i < 7; ++i) p.Aq[(size_t)row * 512 + i * 64 + lane] = f2bf(v[i] * rstd * qn[i * 64 + lane]);
    p.Aq[(size_t)row * 512 + 448 + lane] = 0;
    const float u0 = bf2f(z[C_CKV + lane]), u1 = bf2f(z[C_CKV + 64 + lane]);
    ss = wsum(u0 * u0 + u1 * u1); rstd = rsqrtf(ss * (1.f / 128.f) + EPSV);
    p.Akv[(size_t)row * 256 + lane] = f2bf(u0 * rstd * kvn[lane]); p.Akv[(size_t)row * 256 + 64 + lane] = f2bf(u1 * rstd * kvn[64 + lane]);
    p.Akv[(size_t)row * 256 + 128 + lane] = 0; p.Akv[(size_t)row * 256 + 192 + lane] = 0;
    if (t < LL) {
      if (lane < 32) { const int half = lane >> 4, i = lane & 15; const float x1 = bf2f(z[C_KR + half * 32 + i]), x2 = bf2f(z[C_KR + half * 32 + 16 + i]);
        const float pos = (float)(half ? (t & 63) : (t >> 6)); const float ang = pos * exp2f(-(float)i * (13.287712379549449f / 16.f)); float sv, cv; sincosf(ang, &sv, &cv);
        p.KR[(size_t)row * 64 + half * 32 + i] = f2bf(x1 * cv - x2 * sv); p.KR[(size_t)row * 64 + half * 32 + 16 + i] = f2bf(x2 * cv + x1 * sv); }
    } else p.KR[(size_t)row * 64 + lane] = z[C_KR + lane];
  }
}

DI void st_qrope(const Prm& p, int bid, int nb) {
  const int wave = ltid() >> 6, lane = ltid() & 63;
  for (int row = bid * 8 + wave; row < MR; row += nb * 8) {
    const int b = row / LT, t = row - b * LT; if (t >= LL) continue;
#pragma unroll
    for (int k = 0; k < 2; ++k) { const int pid = lane + 64 * k, h = pid >> 5, r = pid & 31, half = r >> 4, i = r & 15;
      bf16_t* q = p.Qraw + (size_t)row * 768 + h * 192 + 128 + half * 32; const float x1 = bf2f(q[i]), x2 = bf2f(q[16 + i]);
      const float pos = (float)(half ? (t & 63) : (t >> 6)); const float ang = pos * exp2f(-(float)i * (13.287712379549449f / 16.f)); float sv, cv; sincosf(ang, &sv, &cv);
      q[i] = f2bf(x1 * cv - x2 * sv); q[16 + i] = f2bf(x2 * cv + x1 * sv); }
  }
}

DI void st_fnchan(const Prm& p, float* lds, int bid, int nb) {
  float* zt = lds;
  const int wave = __builtin_amdgcn_readfirstlane(ltid() >> 6), lane = ltid() & 63;
  for (int it = bid; it < (MR / 64) * 4; it += nb) {
    const int tile = it >> 2, g = it & 3, row0 = tile * 64, b = row0 / LT, t0 = row0 - b * LT;
    __syncthreads();
    for (int e = ltid(); e < 64 * 128; e += NTHR) { const int i = e >> 7, n2 = e & 127; zt[i * 129 + n2] = bf2f(p.Z[(size_t)(row0 + i) * NZ + C_FN + g * 128 + n2]); }
    __syncthreads();
    for (int kk = 0; kk < 16; ++kk) { const int k2 = wave + 8 * kk; const float* cc = p.CCS + k2 * 128; const float* cs = p.CCS + 16384 + k2 * 128;
      float ap = 0.f, aq = 0.f;
      for (int n2 = 0; n2 < 128; ++n2) { const float zv = zt[lane * 129 + n2]; ap += zv * cc[n2]; aq += zv * cs[n2]; }
      if (t0 < LL) { bf16_t* d = p.PQT + ((size_t)(b * 512 + g * 128 + k2)) * 8192 + t0 + lane; d[0] = f2bf(ap); d[4096] = f2bf(aq); }
      else { bf16_t* d = p.PQTc + ((size_t)(b * 512 + g * 128 + k2)) * 512 + (t0 - LL) + lane; d[0] = f2bf(ap); d[256] = f2bf(aq); } }
  }
}

DI int scan_row(int b, int dir, int s) { return s < LCX ? b * LT + LL + (dir ? LCX - 1 - s : s) : b * LT + (dir ? LL - 1 - (s - LCX) : (s - LCX)); }

typedef float f32x2 __attribute__((ext_vector_type(2)));
DI float dpp_x1(float v) { return __int_as_float(__builtin_amdgcn_mov_dpp(__float_as_int(v), 0xB1, 0xf, 0xf, true)); }
DI float dpp_x2(float v) { return __int_as_float(__builtin_amdgcn_mov_dpp(__float_as_int(v), 0x4E, 0xf, 0xf, true)); }
DI float dpp_hm(float v) { return __int_as_float(__builtin_amdgcn_mov_dpp(__float_as_int(v), 0x141, 0xf, 0xf, true)); }
DI float red4(float v) { v += dpp_x1(v); v += dpp_x2(v); return v; }
DI float red8(float v) { v += dpp_x1(v); v += dpp_x2(v); v += dpp_hm(v); return v; }

DI void st_dnscan(const Prm& p, float* lds, int bid, int nb) {
  const int tid = ltid(), cc = tid >> 3, part = tid & 7;
  for (int item = bid; item < 128; item += nb) {
    const int chain = item >> 1, half = item & 1, b = chain >> 3, h = (chain >> 1) & 3, dir = chain & 1;
    f32x2 S[8];
#pragma unroll
    for (int j = 0; j < 8; ++j) S[j] = (f32x2){0.f, 0.f};
    constexpr int QP = 132, OQ = 0, OK_ = 32 * QP, OV = 2 * 32 * QP, OG = OV + 2048, OO = OG + 64, BUF = OO + 2048;
    bf16x8 pf[3]; float pg = 0.f;
    auto gload = [&](int batch) {
#pragma unroll
      for (int r = 0; r < 3; ++r) { const int e = tid + NTHR * r; if (e < 1280) { const int i = e / 40, ch = e - i * 40; const int row = scan_row(b, dir, batch * 32 + i);
          const int col = ch < 16 ? h * 128 + ch * 8 : (ch < 32 ? 512 + h * 128 + (ch - 16) * 8 : 1024 + h * 128 + half * 64 + (ch - 32) * 8);
          pf[r] = *(const bf16x8*)(p.DNQ + (size_t)row * 1536 + col); } }
      if (tid < 64) { const int i = tid >> 1, wh = tid & 1; const int row = scan_row(b, dir, batch * 32 + i); pg = p.GB[(size_t)row * 16 + wh * 8 + dir * 4 + h]; }
    };
    auto lstore = [&](float* bufp) {
#pragma unroll
      for (int r = 0; r < 3; ++r) { const int e = tid + NTHR * r; if (e < 1280) { const int i = e / 40, ch = e - i * 40;
          float* d = ch < 16 ? bufp + OQ + i * QP + ch * 8 + (ch >> 3) * 4 : (ch < 32 ? bufp + OK_ + i * QP + (ch - 16) * 8 + ((ch - 16) >> 3) * 4 : bufp + OV + i * 64 + (ch - 32) * 8);
#pragma unroll
          for (int j = 0; j < 8; ++j) d[j] = bf2f((bf16_t)pf[r][j]); } }
      if (tid < 64) { const int i = tid >> 1, wh = tid & 1; bufp[OG + i * 2 + wh] = wh ? pg : expf(pg); }
    };
    __syncthreads();
    gload(0); lstore(lds); __syncthreads();
    const int poff = part * 16 + (part >> 2) * 4;
    for (int batch = 0; batch < LT / 32; ++batch) {
      float* cur = lds + (batch & 1) * BUF; float* nxt = lds + ((batch + 1) & 1) * BUF;
      if (batch + 1 < LT / 32) gload(batch + 1);
      const float* q_s = cur + OQ + poff; const float* k_s = cur + OK_ + poff; const float* v_s = cur + OV + cc; const float* gb_s = cur + OG; float* o_s = cur + OO;
      f32x4 kn[4], qn[4]; f32x2 abn; float vvn;
#pragma unroll
      for (int j = 0; j < 4; ++j) { kn[j] = *(const f32x4*)(k_s + j * 4); qn[j] = *(const f32x4*)(q_s + j * 4); }
      abn = *(const f32x2*)gb_s; vvn = v_s[0];
#pragma unroll 2
      for (int i = 0; i < 32; ++i) {
        f32x2 k2[8], q2[8];
#pragma unroll
        for (int j = 0; j < 4; ++j) { k2[2 * j] = (f32x2){kn[j][0], kn[j][1]}; k2[2 * j + 1] = (f32x2){kn[j][2], kn[j][3]}; q2[2 * j] = (f32x2){qn[j][0], qn[j][1]}; q2[2 * j + 1] = (f32x2){qn[j][2], qn[j][3]}; }
        const float a = abn[0], beta = abn[1], vv = vvn;
        { const int in = i < 31 ? i + 1 : 31;
#pragma unroll
          for (int j = 0; j < 4; ++j) { kn[j] = *(const f32x4*)(k_s + in * QP + j * 4); qn[j] = *(const f32x4*)(q_s + in * QP + j * 4); }
          abn = *(const f32x2*)(gb_s + in * 2); vvn = v_s[in * 64]; }
        f32x2 d0 = k2[0] * S[0], d1 = k2[1] * S[1];
#pragma unroll
        for (int j = 2; j < 8; j += 2) { d0 += k2[j] * S[j]; d1 += k2[j + 1] * S[j + 1]; }
        d0 += d1; const float ks = a * red8(d0[0] + d0[1]);
        const float vn = beta * (vv - ks); const f32x2 vn2 = (f32x2){vn, vn}, a2 = (f32x2){a, a};
        f32x2 o0 = (f32x2){0.f, 0.f}, o1 = (f32x2){0.f, 0.f};
#pragma unroll
        for (int j = 0; j < 8; j += 2) { S[j] = S[j] * a2 + k2[j] * vn2; S[j + 1] = S[j + 1] * a2 + k2[j + 1] * vn2; o0 += q2[j] * S[j]; o1 += q2[j + 1] * S[j + 1]; }
        o0 += o1; const float o = red8(o0[0] + o0[1]);
        if (part == 0) o_s[i * 64 + cc] = o;
      }
      __syncthreads();
      { const int i = tid >> 4, c4 = (tid & 15) * 4; const int row = scan_row(b, dir, batch * 32 + i); const float* s = o_s + i * 64 + c4;
        u32x2 w; w.x = pack2(s[0], s[1]); w.y = pack2(s[2], s[3]);
        *(u32x2*)(p.OB + ((size_t)(0 * 2 + dir) * MR + row) * 512 + h * 128 + half * 64 + c4) = w; }
      if (batch + 1 < LT / 32) lstore(nxt);
      __syncthreads();
    }
  }
}

DI void st_glascan(const Prm& p, int layer, float* lds, int bid, int nb) {
  const int tid = ltid(), c = tid >> 2, part = tid & 3;
  for (int chain = bid; chain < 64; chain += nb) {
    const int b = chain >> 3, h = (chain >> 1) & 3, dir = chain & 1;
    const float* w2 = p.gla_w2 + (size_t)(layer * 2 + dir) * 16 * 256 + h * 64; const float* b2 = p.gla_b2 + (layer * 2 + dir) * 256 + h * 64;
    f32x2 S[8];
#pragma unroll
    for (int j = 0; j < 8; ++j) S[j] = (f32x2){0.f, 0.f};
    constexpr int BUF = 2048 * 3 + 4096 * 2 + 512;
    bf16x8 pf[3];
    auto gload = [&](int batch) {
#pragma unroll
      for (int r = 0; r < 3; ++r) { const int e = tid + NTHR * r; if (e < 1088) { const int i = e / 34, ch = e - i * 34; const int row = scan_row(b, dir, batch * 32 + i);
          const int col = ch < 8 ? C_GQ + h * 64 + ch * 8 : (ch < 16 ? C_GK + h * 64 + (ch - 8) * 8 : (ch < 32 ? C_GV + h * 128 + (ch - 16) * 8 : C_GALPHA + dir * 16 + (ch - 32) * 8));
          pf[r] = *(const bf16x8*)(p.Z + (size_t)row * NZ + col); } }
    };
    auto lstore = [&](float* bufp) {
#pragma unroll
      for (int r = 0; r < 3; ++r) { const int e = tid + NTHR * r; if (e < 1088) { const int i = e / 34, ch = e - i * 34;
          float* d = ch < 8 ? bufp + i * 64 + ch * 8 : (ch < 16 ? bufp + 2048 + i * 64 + (ch - 8) * 8 : (ch < 32 ? bufp + 6144 + i * 128 + (ch - 16) * 8 : bufp + 14336 + i * 16 + (ch - 32) * 8));
          const float sc = ch < 8 ? 0.125f : 1.f;
#pragma unroll
          for (int j = 0; j < 8; ++j) d[j] = bf2f((bf16_t)pf[r][j]) * sc; } }
    };
    auto decay = [&](float* bufp) {
#pragma unroll
      for (int k = 0; k < 4; ++k) { const int e = tid + NTHR * k, i = e >> 6, d = e & 63; float zz = b2[d];
#pragma unroll
        for (int r = 0; r < 16; ++r) zz += bufp[14336 + i * 16 + r] * w2[r * 256 + d];
        const float nz = -zz; const float sp = nz > 20.f ? nz : log1pf(expf(nz));
        bufp[4096 + i * 64 + d] = expf(-sp * (1.f / 16.f)); }
    };
    __syncthreads();
    gload(0); lstore(lds); __syncthreads(); decay(lds); __syncthreads();
    for (int batch = 0; batch < LT / 32; ++batch) {
      float* cur = lds + (batch & 1) * BUF; float* nxt = lds + ((batch + 1) & 1) * BUF;
      if (batch + 1 < LT / 32) gload(batch + 1);
      const float* q_s = cur + part * 16; const float* k_s = cur + 2048 + part * 16; const float* a_s = cur + 4096 + part * 16; const float* v_s = cur + 6144 + c; float* o_s = cur + 10240;
#pragma unroll 2
      for (int i = 0; i < 32; ++i) {
        const float vv = v_s[i * 128]; const f32x2 v2 = (f32x2){vv, vv}; f32x2 o0 = (f32x2){0.f, 0.f}, o1 = (f32x2){0.f, 0.f};
#pragma unroll
        for (int j = 0; j < 4; ++j) { const f32x4 a4 = *(const f32x4*)(a_s + i * 64 + j * 4), k4 = *(const f32x4*)(k_s + i * 64 + j * 4), q4 = *(const f32x4*)(q_s + i * 64 + j * 4);
          S[2 * j] = S[2 * j] * (f32x2){a4[0], a4[1]} + (f32x2){k4[0], k4[1]} * v2; S[2 * j + 1] = S[2 * j + 1] * (f32x2){a4[2], a4[3]} + (f32x2){k4[2], k4[3]} * v2;
          o0 += (f32x2){q4[0], q4[1]} * S[2 * j]; o1 += (f32x2){q4[2], q4[3]} * S[2 * j + 1]; }
        o0 += o1; const float o = red4(o0[0] + o0[1]);
        if (part == 0) o_s[i * 128 + c] = o;
      }
      __syncthreads();
      { const int i = tid >> 4, c8 = (tid & 15) * 8; const int row = scan_row(b, dir, batch * 32 + i); const float* s = o_s + i * 128 + c8;
        u32x4 w; w.x = pack2(s[0], s[1]); w.y = pack2(s[2], s[3]); w.z = pack2(s[4], s[5]); w.w = pack2(s[6], s[7]);
        *(u32x4*)(p.OB + ((size_t)(1 * 2 + dir) * MR + row) * 512 + h * 128 + c8) = w; }
      if (batch + 1 < LT / 32) lstore(nxt);
      __syncthreads();
      if (batch + 1 < LT / 32) decay(nxt);
      __syncthreads();
    }
  }
}

DI void st_combine(const Prm& p, int layer, int bid, int nb) {
  const int wave = ltid() >> 6, lane = ltid() & 63;
  for (long task = (long)bid * 8 + wave; task < (long)MR * 8; task += (long)nb * 8) {
    const int row = (int)(task >> 3), mh = (int)(task & 7), mixer = mh >> 2, h = mh & 3;
    const unsigned f = *(const unsigned*)(p.OB + ((size_t)(mixer * 2 + 0) * MR + row) * 512 + h * 128 + lane * 2), g = *(const unsigned*)(p.OB + ((size_t)(mixer * 2 + 1) * MR + row) * 512 + h * 128 + lane * 2);
    const float o0 = bf2f((bf16_t)(f & 0xffffu)) + bf2f((bf16_t)(g & 0xffffu)), o1 = bf2f((bf16_t)(f >> 16)) + bf2f((bf16_t)(g >> 16));
    const float ss = wsum(o0 * o0 + o1 * o1), rstd = rsqrtf(ss * (1.f / 128.f) + EPSV);
    const float* w = (mixer ? p.gla_norm : p.dn_norm) + layer * 128 + lane * 2;
    const unsigned gz = *(const unsigned*)(p.Z + (size_t)row * NZ + (mixer ? C_GGATE : C_DNGATE) + h * 128 + lane * 2);
    const float g0 = bf2f((bf16_t)(gz & 0xffffu)), g1 = bf2f((bf16_t)(gz >> 16));
    *(unsigned*)(p.Y + (size_t)row * DM + mixer * 512 + h * 128 + lane * 2) = pack2(o0 * rstd * w[0] * siluf(g0), o1 * rstd * w[1] * siluf(g1));
  }
}

DI unsigned fkey(float f) { const unsigned u = __float_as_uint(f); return u ^ ((u >> 31) ? 0xffffffffu : 0x80000000u); }
DI int pcnt(unsigned long long m) { return __builtin_popcountll(m); }
DI int lanes_below(unsigned long long m) { return (int)__builtin_amdgcn_mbcnt_hi((unsigned)(m >> 32), __builtin_amdgcn_mbcnt_lo((unsigned)m, 0u)); }
DI void st_peertopk(const Prm& p, int layer, unsigned char* lds, int bid, int nb) {
  bf16_t* ks = (bf16_t*)lds;
  bf16_t* qt = (bf16_t*)(lds + 69632);
  float* sc = (float*)(lds + 69632);
  const int tid = ltid(), wave = tid >> 6, lane = tid & 63, r32 = lane & 31, hi = lane >> 5;
  float* selv = (float*)(lds + 69632 + 33280) + wave * 64; int* seli = (int*)(selv + 32);
  int hcur = -1;
  const int nchunk = MR / 32;
  for (int it = bid; it < 8 * nchunk; it += nb) {
    const int h = it / nchunk, chunk = it - h * nchunk, row0 = chunk * 32;
    __syncthreads();
    if (h != hcur) {
      const float* kg = p.peer_keys + ((size_t)(layer * 8 + h) * 2) * 128 * 128;
      for (int e = tid; e < 2 * 128 * 128; e += NTHR) { const int pn = e >> 7, k = e & 127; ks[pn * 136 + k] = f2bf(kg[e]); }
      hcur = h; }
    for (int e = tid; e < 1024; e += NTHR) { const int r = e >> 5, c8 = (e & 31) * 8; *(u32x4*)(qt + r * 264 + c8) = *(const u32x4*)(p.Qp + (size_t)(row0 + r) * DM + h * 256 + c8); }
    __syncthreads();
    { const int pt = wave >> 2, nt = wave & 3; f32x16 acc = {};
#pragma unroll
      for (int k8 = 0; k8 < 8; ++k8) { const bf16x8 a = *(const bf16x8*)(qt + r32 * 264 + pt * 128 + k8 * 16 + hi * 8), b = *(const bf16x8*)(ks + (pt * 128 + nt * 32 + r32) * 136 + k8 * 16 + hi * 8);
        acc = __builtin_amdgcn_mfma_f32_32x32x16_bf16(a, b, acc, 0, 0, 0); }
      __syncthreads();
#pragma unroll
      for (int r = 0; r < 16; ++r) sc[((r & 3) + 8 * (r >> 2) + 4 * hi) * 260 + pt * 128 + nt * 32 + r32] = acc[r]; }
    __syncthreads();
    for (int rr = 0; rr < 4; ++rr) {
      const int m = wave * 4 + rr, row = row0 + m;
      float s[2][2];
#pragma unroll
      for (int pp = 0; pp < 2; ++pp)
#pragma unroll
        for (int hh = 0; hh < 2; ++hh) s[pp][hh] = sc[m * 260 + pp * 128 + hh * 64 + lane];
      unsigned kk[2][2], T[2] = {0u, 0u}; bool dn[2] = {false, false};
#pragma unroll
      for (int pp = 0; pp < 2; ++pp) { kk[pp][0] = fkey(s[pp][0]); kk[pp][1] = fkey(s[pp][1]); }
      for (int bit = 31; bit >= 0; --bit) {
#pragma unroll
        for (int pp = 0; pp < 2; ++pp) { const unsigned c = T[pp] | (1u << bit); const int n = pcnt(__ballot(kk[pp][0] >= c)) + pcnt(__ballot(kk[pp][1] >= c));
          if (!dn[pp] && n >= 16) { T[pp] = c; dn[pp] = n == 16; } }
        if (dn[0] && dn[1]) break; }
#pragma unroll
      for (int pp = 0; pp < 2; ++pp) { const unsigned k0 = kk[pp][0], k1 = kk[pp][1], TT = T[pp];
        const unsigned long long g0 = __ballot(k0 > TT), g1 = __ballot(k1 > TT), e0 = __ballot(k0 == TT), e1 = __ballot(k1 == TT);
        const int ng0 = pcnt(g0), ng = ng0 + pcnt(g1), need = 16 - ng, ne0 = pcnt(e0);
        if (k0 > TT) { const int r = lanes_below(g0); selv[pp * 16 + r] = s[pp][0]; seli[pp * 16 + r] = lane; }
        if (k1 > TT) { const int r = ng0 + lanes_below(g1); selv[pp * 16 + r] = s[pp][1]; seli[pp * 16 + r] = lane + 64; }
        if (k0 == TT) { const int r = lanes_below(e0); if (r < need) { selv[pp * 16 + ng + r] = s[pp][0]; seli[pp * 16 + ng + r] = lane; } }
        if (k1 == TT) { const int r = ne0 + lanes_below(e1); if (r < need) { selv[pp * 16 + ng + r] = s[pp][1]; seli[pp * 16 + ng + r] = lane + 64; } } }
      __builtin_amdgcn_wave_barrier();
      float cd[4]; unsigned ck[4]; { const float sa = selv[lane >> 2]; const f32x4 sb = *(const f32x4*)(selv + 16 + (lane & 3) * 4);
#pragma unroll
        for (int q = 0; q < 4; ++q) { cd[q] = sa + sb[q]; ck[q] = fkey(cd[q]); } }
      unsigned T2 = 0u;
      for (int bit = 31; bit >= 0; --bit) { const unsigned c = T2 | (1u << bit);
        const int n = pcnt(__ballot(ck[0] >= c)) + pcnt(__ballot(ck[1] >= c)) + pcnt(__ballot(ck[2] >= c)) + pcnt(__ballot(ck[3] >= c));
        if (n >= 16) { T2 = c; if (n == 16) break; } }
      float mx = fmaxf(fmaxf(cd[0], cd[1]), fmaxf(cd[2], cd[3])); mx = wmax(mx);
      int base = 0; float esum = 0.f; const int ia = seli[lane >> 2]; int rk[4]; float ev[4];
#pragma unroll
      for (int q = 0; q < 4; ++q) { const unsigned long long g = __ballot(ck[q] > T2); rk[q] = ck[q] > T2 ? base + lanes_below(g) : 99; base += pcnt(g); }
#pragma unroll
      for (int q = 0; q < 4; ++q) { const unsigned long long g = __ballot(ck[q] == T2); if (ck[q] == T2) rk[q] = base + lanes_below(g); base += pcnt(g); }
#pragma unroll
      for (int q = 0; q < 4; ++q) { ev[q] = rk[q] < 16 ? __expf(cd[q] - mx) : 0.f; esum += ev[q]; }
      esum = wsum(esum); const float inv = 1.f / esum;
      int* orow = p.IDX + (size_t)row * 128 + h * 16; float* grow = p.GATE + (size_t)row * 128 + h * 16;
#pragma unroll
      for (int q = 0; q < 4; ++q) if (rk[q] < 16) { orow[rk[q]] = ia * 128 + seli[16 + (lane & 3) * 4 + q]; grow[rk[q]] = ev[q] * inv; }
      __builtin_amdgcn_wave_barrier();
    }
  }
}

constexpr float U_SC = 1024.f, V_SC = 16.f;
DI void st_cvt_tables(const Prm& p, int layer, int bid, int nb) {
  const size_t n16 = (size_t)16384 * DM / 16, stride = (size_t)nb * NTHR;
  const float* U = p.peer_u + (size_t)layer * 16384 * DM; const float* V = p.peer_v + (size_t)layer * 16384 * DM;
  for (size_t e = (size_t)bid * NTHR + ltid(); e < 2 * n16; e += stride) { const bool isv = e >= n16; const size_t k = isv ? e - n16 : e;
    const float* src = (isv ? V : U) + k * 16; const float sc = isv ? V_SC : U_SC; u32x4 w;
#pragma unroll
    for (int q = 0; q < 4; ++q) { const f32x4 a = *(const f32x4*)(src + q * 4) * sc; int r = 0;
      r = __builtin_amdgcn_cvt_pk_fp8_f32(a[0], a[1], r, false); r = __builtin_amdgcn_cvt_pk_fp8_f32(a[2], a[3], r, true); w[q] = (unsigned)r; }
    *(u32x4*)((unsigned char*)(isv ? p.Vb : p.Ub) + k * 16) = w; }
}

DI void st_peergather(const Prm& p, int layer, float* lds, int bid, int nb, bool dry = false) {
  const int tid = ltid(), wave = tid >> 6, lane = tid & 63;
  const unsigned char* Ub = (const unsigned char*)p.Ub; const unsigned char* Vb = (const unsigned char*)p.Vb;
  for (int row = bid; row < MR; row += nb) {
    const int b = row / LT, t = row - b * LT; const bool isc = t >= LL;
    if (isc && layer == 1) continue;
    f32x2 hv[16];
#pragma unroll
    for (int i = 0; i < 2; ++i) {
#pragma unroll
      for (int q = 0; q < 2; ++q) { const u32x4 w = *(const u32x4*)(p.H2 + (size_t)row * DM + i * 1024 + lane * 16 + q * 8);
#pragma unroll
        for (int k = 0; k < 4; ++k) hv[i * 8 + q * 4 + k] = (f32x2){__uint_as_float(w[k] << 16), __uint_as_float(w[k] & 0xffff0000u)}; } }
    f32x2 acc[16];
#pragma unroll
    for (int i = 0; i < 16; ++i) acc[i] = (f32x2){0.f, 0.f};
    const int myidx = lane < 16 ? p.IDX[(size_t)row * 128 + wave * 16 + lane] : 0; const float mygate = lane < 16 ? p.GATE[(size_t)row * 128 + wave * 16 + lane] : 0.f;
#pragma unroll 1
    for (int k0 = 0; k0 < 16; k0 += 4) {
      u32x4 uu[4][2], vv[4][2];
#pragma unroll
      for (int q = 0; q < 4; ++q) { const int e = __builtin_amdgcn_readfirstlane(__shfl(myidx, k0 + q));
        const unsigned char* ur = Ub + (size_t)e * DM + lane * 16; const unsigned char* vr = Vb + (size_t)e * DM + lane * 16;
#pragma unroll
        for (int i = 0; i < 2; ++i) { uu[q][i] = *(const u32x4*)(ur + i * 1024); vv[q][i] = *(const u32x4*)(vr + i * 1024); } }
#pragma unroll
      for (int q = 0; q < 4; ++q) { f32x2 d0 = (f32x2){0.f, 0.f}, d1 = (f32x2){0.f, 0.f};
#pragma unroll
        for (int i = 0; i < 2; ++i)
#pragma unroll
          for (int k = 0; k < 4; ++k) { d0 += __builtin_amdgcn_cvt_pk_f32_fp8((int)uu[q][i][k], false) * hv[i * 8 + k * 2]; d1 += __builtin_amdgcn_cvt_pk_f32_fp8((int)uu[q][i][k], true) * hv[i * 8 + k * 2 + 1]; }
        d0 += d1; float d = wsum(d0[0] + d0[1]) * (1.f / U_SC);
        const float wgt = __shfl(mygate, k0 + q) * 0.5f * d * (1.f + erff(d * 0.70710678118654752f)); const f32x2 w2 = (f32x2){wgt, wgt};
#pragma unroll
        for (int i = 0; i < 2; ++i)
#pragma unroll
          for (int k = 0; k < 4; ++k) { acc[i * 8 + k * 2] += w2 * __builtin_amdgcn_cvt_pk_f32_fp8((int)vv[q][i][k], false); acc[i * 8 + k * 2 + 1] += w2 * __builtin_amdgcn_cvt_pk_f32_fp8((int)vv[q][i][k], true); } }
    }
    __syncthreads();
#pragma unroll
    for (int i = 0; i < 2; ++i) { float* d = lds + wave * 2048 + i * 1024 + lane * 16;
#pragma unroll
      for (int k = 0; k < 4; ++k) *(f32x4*)(d + k * 4) = (f32x4){acc[i * 8 + k * 2][0], acc[i * 8 + k * 2][1], acc[i * 8 + k * 2 + 1][0], acc[i * 8 + k * 2 + 1][1]}; }
    __syncthreads();
    { const int col = tid * 4; f32x4 sum = (f32x4){0.f, 0.f, 0.f, 0.f};
#pragma unroll
      for (int w = 0; w < 8; ++w) sum += *(const f32x4*)(lds + w * 2048 + col);
      const f32x4 g2 = *(const f32x4*)(p.mod + ((size_t)layer * 9 + (isc ? 8 : b)) * NMOD + 5 * DM + col) * (1.f / V_SC);
      float* xr = p.X + (size_t)row * DM + col; if (!dry) *(f32x4*)xr = *(const f32x4*)xr + g2 * sum; }
  }
}

DI void st_final(const Prm& p, int bid, int nb) {
  const int wave = ltid() >> 6, lane = ltid() & 63;
  for (int r = bid * 8 + wave; r < NB * LL; r += nb * 8) {
    const int b = r / LL, t = r - b * LL; const float* src = p.X + (size_t)(b * LT + t) * DM;
    f32x4 v[8]; float ss = 0.f;
#pragma unroll
    for (int i = 0; i < 8; ++i) { v[i] = *(const f32x4*)(src + (i * 64 + lane) * 4); ss += v[i][0] * v[i][0] + v[i][1] * v[i][1] + v[i][2] * v[i][2] + v[i][3] * v[i][3]; }
    ss = wsum(ss); const float rstd = rsqrtf(ss * (1.f / 2048.f) + EPSV);
#pragma unroll
    for (int i = 0; i < 8; ++i) { const int col = (i * 64 + lane) * 4; *(f32x4*)(p.out + (size_t)r * DM + col) = v[i] * rstd * *(const f32x4*)(p.final_norm + col); }
  }
}

namespace att {
constexpr int NW = 8, QBLK = 32, KVBLK = 64;
constexpr float SCALE = 0.07216878364870322f;
constexpr float THR = 8.f;
constexpr int LDQ = 768, LDK = 1024, LDKR = 64, LDO = DM;
constexpr int SHM_V = KVBLK * 128 * 2, SHM_K = KVBLK * 128 * 2, SHM_KR = KVBLK * 64 * 2, SHM_ATTN = 2 * SHM_V + 2 * SHM_K + 2 * SHM_KR + NW * 64 * 4;
#define KSWZ(row, colB) ((row) * 256 + ((colB) ^ (((row) & 7) << 4)))
#define KRSWZ(row, colB) ((row) * 128 + ((colB) ^ ((((row) >> 1) & 7) << 4)))
#define SBAR() __builtin_amdgcn_sched_barrier(0)
DI int crow(int r, int hi) { return (r & 3) + 8 * (r >> 2) + 4 * hi; }
DI unsigned cvtpk(float lo, float hi) { unsigned r; asm volatile("v_cvt_pk_bf16_f32 %0, %1, %2" : "=v"(r) : "v"(lo), "v"(hi)); return r; }

DI void partialSM(f32x16& p0, f32x16& p1, float& m_reg, float& mn, float& alpha) {
  constexpr float C = SCALE * 1.4426950408889634f;
  float pmax = p0[0];
#pragma unroll
  for (int r = 1; r < 16; ++r) pmax = fmaxf(pmax, p0[r]);
#pragma unroll
  for (int r = 0; r < 16; ++r) pmax = fmaxf(pmax, p1[r]);
  { auto rr = __builtin_amdgcn_permlane32_swap(__float_as_uint(pmax), __float_as_uint(pmax), false, false);
    pmax = fmaxf(__uint_as_float(rr[0]), __uint_as_float(rr[1])); }
  if (__builtin_expect(__all(pmax - m_reg <= THR / SCALE), 1)) { mn = m_reg; alpha = 1.f; }
  else { mn = fmaxf(m_reg, pmax); alpha = __builtin_amdgcn_exp2f((m_reg - mn) * C); m_reg = mn; }
  const float mnC = -mn * C;
#pragma unroll
  for (int r = 0; r < 16; ++r) p0[r] = fmaf(p0[r], C, mnC);
#pragma unroll
  for (int r = 0; r < 16; ++r) p1[r] = fmaf(p1[r], C, mnC);
#pragma unroll
  for (int r = 0; r < 16; ++r) p0[r] = __builtin_amdgcn_exp2f(p0[r]);
}
DI void finishSM(f32x16& p0, f32x16& p1, float alpha, float& l_reg, bf16x8& pa0, bf16x8& pa1, bf16x8& pa2, bf16x8& pa3) {
#pragma unroll
  for (int r = 0; r < 16; ++r) p1[r] = __builtin_amdgcn_exp2f(p1[r]);
  float ps = 0;
#pragma unroll
  for (int r = 0; r < 16; ++r) ps += p0[r];
#pragma unroll
  for (int r = 0; r < 16; ++r) ps += p1[r];
  { auto rr = __builtin_amdgcn_permlane32_swap(__float_as_uint(ps), __float_as_uint(ps), false, false);
    ps = __uint_as_float(rr[0]) + __uint_as_float(rr[1]); }
  l_reg = l_reg * alpha + ps;
#define PK4(P, BASE, OUT) do { unsigned a0 = cvtpk(P[BASE + 0], P[BASE + 1]), a1 = cvtpk(P[BASE + 2], P[BASE + 3]);   \
    unsigned b0 = cvtpk(P[BASE + 4], P[BASE + 5]), b1 = cvtpk(P[BASE + 6], P[BASE + 7]);                              \
    auto r0 = __builtin_amdgcn_permlane32_swap(a0, b0, false, false); auto r1 = __builtin_amdgcn_permlane32_swap(a1, b1, false, false); \
    u32x4 w = {r0[0], r1[0], r0[1], r1[1]}; OUT = *reinterpret_cast<bf16x8*>(&w); } while (0)
  PK4(p0, 0, pa0); PK4(p0, 8, pa1); PK4(p1, 0, pa2); PK4(p1, 8, pa3);
#undef PK4
}
DI void qkt(f32x16& p0, f32x16& p1, const char* Ks, const char* KRs, const bf16x8* qr, int r32, int hi) {
  p0 = f32x16{}; p1 = f32x16{};
#pragma unroll
  for (int d0 = 0; d0 < 8; ++d0) { const int cb = (d0 * 16 + hi * 8) * 2;
    const bf16x8 b0 = *reinterpret_cast<const bf16x8*>(Ks + KSWZ(r32, cb));
    const bf16x8 b1 = *reinterpret_cast<const bf16x8*>(Ks + KSWZ(32 + r32, cb));
    p0 = __builtin_amdgcn_mfma_f32_32x32x16_bf16(b0, qr[d0], p0, 0, 0, 0);
    p1 = __builtin_amdgcn_mfma_f32_32x32x16_bf16(b1, qr[d0], p1, 0, 0, 0); }
#pragma unroll
  for (int d0 = 0; d0 < 4; ++d0) { const int cb = (d0 * 16 + hi * 8) * 2;
    const bf16x8 b0 = *reinterpret_cast<const bf16x8*>(KRs + KRSWZ(r32, cb));
    const bf16x8 b1 = *reinterpret_cast<const bf16x8*>(KRs + KRSWZ(32 + r32, cb));
    p0 = __builtin_amdgcn_mfma_f32_32x32x16_bf16(b0, qr[8 + d0], p0, 0, 0, 0);
    p1 = __builtin_amdgcn_mfma_f32_32x32x16_bf16(b1, qr[8 + d0], p1, 0, 0, 0); }
}
DI int v_st(int k, int c) { const int kk = (k & ~0xC) | ((k & 4) << 1) | ((k & 8) >> 1); return ((kk >> 3) * 4 + (c >> 5)) * 512 + ((kk & 7) * 32 + (c & 31)) * 2; }
DI int v_rd_base(int lane) { return ((lane & 3) << 3) | (((lane >> 2) & 3) << 6) | (((lane >> 4) & 1) << 5) | (((lane >> 5) & 1) << 8); }
constexpr int v_rd_off(int d0, int ks, int half) { return d0 * 512 + ks * 4096 + half * 2048; }
template <int OFF> DI s16x4 tr_read(int vb) { s16x4 r; asm volatile("ds_read_b64_tr_b16 %0, %1 offset:%2" : "=&v"(r) : "v"(vb), "i"(OFF) : "memory"); return r; }
template <int D0> DI void pv_one(f32x16& od, int vb, bf16x8 pa0, bf16x8 pa1, bf16x8 pa2, bf16x8 pa3) {
  const s16x4 l0 = tr_read<v_rd_off(D0, 0, 0)>(vb), h0 = tr_read<v_rd_off(D0, 0, 1)>(vb), l1 = tr_read<v_rd_off(D0, 1, 0)>(vb), h1 = tr_read<v_rd_off(D0, 1, 1)>(vb);
  const s16x4 l2 = tr_read<v_rd_off(D0, 2, 0)>(vb), h2 = tr_read<v_rd_off(D0, 2, 1)>(vb), l3 = tr_read<v_rd_off(D0, 3, 0)>(vb), h3 = tr_read<v_rd_off(D0, 3, 1)>(vb);
  asm volatile("s_waitcnt lgkmcnt(0)" ::: "memory"); SBAR();
#define PK(L, H) (bf16x8){L[0], L[1], L[2], L[3], H[0], H[1], H[2], H[3]}
  od = __builtin_amdgcn_mfma_f32_32x32x16_bf16(pa0, PK(l0, h0), od, 0, 0, 0);
  od = __builtin_amdgcn_mfma_f32_32x32x16_bf16(pa1, PK(l1, h1), od, 0, 0, 0);
  od = __builtin_amdgcn_mfma_f32_32x32x16_bf16(pa2, PK(l2, h2), od, 0, 0, 0);
  od = __builtin_amdgcn_mfma_f32_32x32x16_bf16(pa3, PK(l3, h3), od, 0, 0, 0);
#undef PK
}
DI void pv_d0(f32x16* o, int vb, bf16x8 pa0, bf16x8 pa1, bf16x8 pa2, bf16x8 pa3) {
  pv_one<0>(o[0], vb, pa0, pa1, pa2, pa3); pv_one<1>(o[1], vb, pa0, pa1, pa2, pa3); pv_one<2>(o[2], vb, pa0, pa1, pa2, pa3); pv_one<3>(o[3], vb, pa0, pa1, pa2, pa3);
}

DI void attn_body(const bf16_t* __restrict__ Qb, const bf16_t* __restrict__ Kh, const bf16_t* __restrict__ Vh, const bf16_t* __restrict__ KRh, bf16_t* __restrict__ Ob, int seq, int tpos0, char* lds) {
  const int tid = ltid(), wid = tid >> 6, lane = tid & 63, r32 = lane & 31, hi = lane >> 5;
  char* V_lds = lds; char* K_lds = lds + 2 * SHM_V; char* KR_lds = lds + 2 * SHM_V + 2 * SHM_K;
  float* ws = (float*)(lds + 2 * SHM_V + 2 * SHM_K + 2 * SHM_KR) + wid * 64; float* li_l = ws; float* al_l = ws + 32;
  float m_reg = -1e30f, l_reg = 0; f32x16 o[4] = {}; bf16x8 qr[12];
  const bf16_t* Qw = Qb + (long)(wid * QBLK + r32) * LDQ + hi * 8;
#pragma unroll
  for (int d0 = 0; d0 < 12; ++d0) qr[d0] = *reinterpret_cast<const bf16x8*>(Qw + d0 * 16);
  if (tpos0 >= 0) {
    const int t = tpos0 + wid * QBLK + r32;
#pragma unroll
    for (int hf = 0; hf < 2; ++hf) { const float pos = (float)(hf ? (t & 63) : (t >> 6));
#pragma unroll
      for (int j = 0; j < 8; ++j) { const float ang = pos * exp2f(-(float)(hi * 8 + j) * (13.287712379549449f / 16.f)); float sv, cv; sincosf(ang, &sv, &cv);
        const float x1 = bf2f((bf16_t)qr[8 + 2 * hf][j]), x2 = bf2f((bf16_t)qr[9 + 2 * hf][j]);
        qr[8 + 2 * hf][j] = (short)f2bf(x1 * cv - x2 * sv); qr[9 + 2 * hf][j] = (short)f2bf(x2 * cv + x1 * sv); } }
  }
  const int sr = tid >> 4, sc = (tid & 15) * 8, vst0 = v_st(sr, sc), vst1 = v_st(32 + sr, sc);
  const int krr = tid >> 3, krc = (tid & 7) * 8;
  const int vb0 = (int)(uintptr_t)V_lds + v_rd_base(lane);
  bf16x8 vs0, vs1, ks0, ks1, kr0;
#define SLOAD(k0) do { vs0 = *reinterpret_cast<const bf16x8*>(&Vh[(long)((k0) + sr) * LDK + sc]); vs1 = *reinterpret_cast<const bf16x8*>(&Vh[(long)((k0) + 32 + sr) * LDK + sc]); \
    ks0 = *reinterpret_cast<const bf16x8*>(&Kh[(long)((k0) + sr) * LDK + sc]); ks1 = *reinterpret_cast<const bf16x8*>(&Kh[(long)((k0) + 32 + sr) * LDK + sc]); \
    kr0 = *reinterpret_cast<const bf16x8*>(&KRh[(long)((k0) + krr) * LDKR + krc]); } while (0)
#define SWRITE(b) do { *(bf16x8*)(V_lds + (b) * SHM_V + vst0) = vs0; *(bf16x8*)(V_lds + (b) * SHM_V + vst1) = vs1; const int kc = sc * 2;               \
    *(bf16x8*)(K_lds + (b) * SHM_K + KSWZ(sr, kc)) = ks0; *(bf16x8*)(K_lds + (b) * SHM_K + KSWZ(32 + sr, kc)) = ks1;                       \
    *(bf16x8*)(KR_lds + (b) * SHM_KR + KRSWZ(krr, krc * 2)) = kr0; } while (0)
#define SWAIT() asm volatile("s_waitcnt vmcnt(0)" ::: "memory")
#define RESC(a) do { if (__any((a) < 1.f)) { if (hi == 0) al_l[r32] = (a); asm volatile("s_waitcnt lgkmcnt(0)" ::: "memory"); \
    _Pragma("unroll") for (int d = 0; d < 4; ++d) _Pragma("unroll") for (int r = 0; r < 16; ++r) o[d][r] *= al_l[crow(r, hi)]; } } while (0)
  f32x16 p0, p1; float mn, al; bf16x8 pa0, pa1, pa2, pa3; const int NT = seq / KVBLK;
  SLOAD(0); SWAIT(); SWRITE(0); __syncthreads();
  for (int j = 0; j < NT; ++j) {
    const int buf = j & 1; const bool more = j + 1 < NT;
    if (more) SLOAD((j + 1) * KVBLK);
    SBAR(); qkt(p0, p1, K_lds + buf * SHM_K, KR_lds + buf * SHM_KR, qr, r32, hi);
    partialSM(p0, p1, m_reg, mn, al); RESC(al);
    finishSM(p0, p1, al, l_reg, pa0, pa1, pa2, pa3); SBAR();
    pv_d0(o, vb0 + buf * SHM_V, pa0, pa1, pa2, pa3);
    if (more) { SWAIT(); SWRITE(buf ^ 1); }
    __syncthreads();
  }
  if (hi == 0) li_l[r32] = l_reg; asm volatile("s_waitcnt lgkmcnt(0)" ::: "memory");
  float rli[16];
#pragma unroll
  for (int r = 0; r < 16; ++r) rli[r] = __builtin_amdgcn_rcpf(li_l[crow(r, hi)]);
  bf16_t* Ow = Ob + (long)(wid * QBLK) * LDO;
#pragma unroll
  for (int r = 0; r < 16; ++r) { const int orow = crow(r, hi);
#pragma unroll
    for (int d0 = 0; d0 < 4; ++d0) Ow[(long)orow * LDO + d0 * 32 + r32] = f2bf(o[d0][r] * rli[r]); }
  __syncthreads();
#undef SLOAD
#undef SWRITE
#undef SWAIT
#undef RESC
}
}

DI void st_attn(const Prm& p, int layer, char* lds, int bid, int nb) {
  const int nlat = NB * 4 * 16, nitem = nlat + (layer == 0 ? NB * 4 : 0);
  for (int it = bid; it < nitem; it += nb) {
    if (it < nlat) { const int b = it >> 6, h = (it >> 4) & 3, qb = it & 15; const size_t r0 = (size_t)b * LT;
      att::attn_body(p.Qraw + (r0 + qb * 256) * 768 + h * 192, p.KV + r0 * 1024 + h * 256, p.KV + r0 * 1024 + h * 256 + 128, p.KR + r0 * 64,
                     p.Y + (r0 + qb * 256) * DM + 1024 + h * 128, LT, qb * 256, lds); }
    else { const int k = it - nlat, b = k >> 2, h = k & 3; const size_t r0 = (size_t)b * LT + LL;
      att::attn_body(p.Qraw + r0 * 768 + h * 192, p.KV + r0 * 1024 + h * 256, p.KV + r0 * 1024 + h * 256 + 128, p.KR + r0 * 64, p.Y + r0 * DM + 1024 + h * 128, LCX, -1, lds); }
  }
}

struct EpiResid {
  static constexpr bool PERM = false, AFTER_DRAIN = false;
  const float* xlat; const float* xctx; float* X; const float* modl; int first;
  __device__ __forceinline__ void operator()(const pg8::f32x4 (&acc)[2][2][4][2], const pg8::Unit& u, int wr, int wc, int fr, int fq) const {
    const int b = u.pm / 17, tl = u.pm - b * 17; const bool isc = tl == 16;
    const float* g = modl + (size_t)(isc ? 8 : b) * NMOD + 2 * DM;
    const int rloc0 = wr * 64 + fr, col0 = u.pn * 256 + wc * 32 + 4 * fq;
    pg8::f32x4 gv[2][2];
#pragma unroll
    for (int bj = 0; bj < 2; ++bj)
#pragma unroll
      for (int n = 0; n < 2; ++n) gv[bj][n] = *(const pg8::f32x4*)(g + col0 + bj * 128 + n * 16);
#pragma unroll
    for (int ai = 0; ai < 2; ++ai)
#pragma unroll
      for (int m = 0; m < 4; ++m) { const int rl = rloc0 + ai * 128 + m * 16; const size_t row = (size_t)u.pm * 256 + rl;
        const float* src = first ? (isc ? xctx + ((size_t)b * LCX + rl) * DM : xlat + ((size_t)b * LL + tl * 256 + rl) * DM) : X + row * DM;
        float* dst = X + row * DM;
#pragma unroll
        for (int bj = 0; bj < 2; ++bj)
#pragma unroll
          for (int n = 0; n < 2; ++n) { const int c = col0 + bj * 128 + n * 16; *(pg8::f32x4*)(dst + c) = *(const pg8::f32x4*)(src + c) + gv[bj][n] * acc[ai][bj][m][n]; } }
  }
};

template <class Epi> DI void run_gemm(unsigned char* lds, const bf16_t* A, const bf16_t* Bt, int M, int N, int K, const Epi& E, int bid, int nb) {
  pg8::Gemm g; g.A = A; g.Bt = Bt; g.M = M; g.N = N; g.K = K;
  pg8::StaticOrder S; S.init(M, N, nb, bid);
  pg8::gemm_phase<Epi, pg8::StaticOrder, false>((PG8_LAS unsigned char*)lds, g, S, E, nullptr);
}
DI pg8::EpiBf16<0> epi_bf16(bf16_t* O, int ldc, int split_cols = 0, size_t split_stride = 0) { pg8::EpiBf16<0> e; e.O = O; e.ldc = ldc; e.bias = nullptr; e.split_cols = split_cols; e.split_stride = split_stride; return e; }

#ifndef PROBE
#define PROBE 0
#endif
constexpr int LDS_MAIN = 131072, LDS_TOTAL = LDS_MAIN + 64;
#define PRM() (*(const __attribute__((address_space(4))) Prm*)launder_k(kp))
typedef const __attribute__((address_space(4))) void* kptr_t;
DI kptr_t launder_k(kptr_t q) { asm volatile("" : "+s"(q)); return q; }
extern __shared__ __attribute__((aligned(16))) unsigned char shm[];
__global__ void __launch_bounds__(NTHR, 2) mega(Prm p_unused) {
#if defined(__HIP_DEVICE_COMPILE__)
  kptr_t kp = (kptr_t)__builtin_amdgcn_kernarg_segment_ptr();
  const int bid0 = blockIdx.x, nb0 = gridDim.x;
#define bid lsg(bid0)
#define nb lsg(nb0)
  uint4* xbw = (uint4*)(shm + LDS_MAIN);
  if (threadIdx.x == 0) *xbw = make_uint4(0u, 0u, 0u, 0u);
  __syncthreads();
  { const Prm p = PRM(); (void)xcd_barrier_post(p.bar, (volatile LAS unsigned*)xbw); }
#define GRID_BAR() do { XcdBarrier b_; b_.bar = PRM().bar; b_.x = xb_xcc_id(); b_.st = (volatile LAS unsigned*)(shm + LDS_MAIN); xcd_barrier(b_); } while (0)
  float* lf = (float*)shm;
  for (int ly = 0; ly < 2; ++ly) { const Prm p = PRM();
    st_transpose(p.w_in + (size_t)ly * DM * IN_W, p.WinT + (size_t)ly * NZ * DM, DM, IN_W, DM, NZ, lf, bid, nb);
    st_transpose(p.w_out + (size_t)ly * DM * DM, p.WoutT + (size_t)ly * DM * DM, DM, DM, DM, DM, lf, bid, nb);
    st_transpose(p.peer_wq + (size_t)ly * DM * DM, p.WqT + (size_t)ly * DM * DM, DM, DM, DM, DM, lf, bid, nb);
    st_transpose(p.mla_w_uq + (size_t)ly * 448 * 768, p.WuqT + (size_t)ly * 768 * 512, 448, 768, 512, 768, lf, bid, nb);
    st_transpose(p.mla_w_ukv + (size_t)ly * 128 * 1024, p.WukvT + (size_t)ly * 1024 * 256, 128, 1024, 256, 1024, lf, bid, nb);
  }
  { const Prm p = PRM(); st_tables(p, bid, nb); }
  __syncthreads();
  { const Prm p = PRM(); st_mods(p, lf, bid, nb); }
  GRID_BAR();
  for (int l = 0; l < 2; ++l) {
    { const Prm p = PRM(); st_modulate(p, l, 0, p.H, bid, nb); }
    GRID_BAR();
    { const Prm p = PRM(); run_gemm(shm, p.H, p.WinT + (size_t)l * NZ * DM, MR, NZ, DM, epi_bf16(p.Z, NZ), bid, nb); }
    if (PROBE == 6) { const Prm p = PRM(); run_gemm(shm, p.H, p.WinT + (size_t)l * NZ * DM, MR, NZ, DM, epi_bf16(p.Z, NZ), bid, nb); }
    GRID_BAR();
    { const Prm p = PRM(); st_dnprep(p, l, bid, nb); }
    { const Prm p = PRM(); st_mlaprep(p, l, bid, nb); }
    { const Prm p = PRM(); st_fnchan(p, lf, bid, nb); }
    GRID_BAR();
    if (bid < 128) { const Prm p = PRM(); st_dnscan(p, lf, bid, 128); }
    else if (bid < 192) { const Prm p = PRM(); st_glascan(p, l, lf, bid - 128, 64); }
    else {
      const int b2 = bid - 192, n2 = nb - 192;
      { const Prm p = PRM(); run_gemm(shm, p.Aq, p.WuqT + (size_t)l * 768 * 512, MR, 768, 512, epi_bf16(p.Qraw, 768), b2, n2); }
      { const Prm p = PRM(); run_gemm(shm, p.Akv, p.WukvT + (size_t)l * 1024 * 256, MR, 1024, 256, epi_bf16(p.KV, 1024), b2, n2); }
    }
    if (PROBE == 7) { GRID_BAR(); if (bid < 128) { const Prm p = PRM(); st_dnscan(p, lf, bid, 128); } }
    if (PROBE == 8) { GRID_BAR(); if (bid < 64) { const Prm p = PRM(); st_glascan(p, l, lf, bid, 64); } }
    if (PROBE == 2) { GRID_BAR();
      if (bid < 128) { const Prm p = PRM(); st_dnscan(p, lf, bid, 128); }
      else if (bid < 192) { const Prm p = PRM(); st_glascan(p, l, lf, bid - 128, 64); } }
    GRID_BAR();
    { const Prm p = PRM(); st_attn(p, l, (char*)shm, bid, nb); }
    if (PROBE == 3) { const Prm p = PRM(); st_attn(p, l, (char*)shm, bid, nb); }
    { const Prm p = PRM(); run_gemm(shm, p.DFTM, p.PQT, 4096, 4096, 8192, epi_bf16(p.Y + 1536, DM, 512, (size_t)LT * DM), bid, nb); }
    if (l == 0) { const Prm p = PRM(); run_gemm(shm, p.DFTC, p.PQTc, 256, 4096, 512, epi_bf16(p.Y + (size_t)LL * DM + 1536, DM, 512, (size_t)LT * DM), bid, nb); }
    { const Prm p = PRM(); st_combine(p, l, bid, nb); }
    GRID_BAR();
    { const Prm p = PRM(); EpiResid e; e.xlat = p.x; e.xctx = p.ctx; e.X = p.X; e.modl = p.mod + (size_t)l * 9 * NMOD; e.first = l == 0;
      run_gemm(shm, p.Y, p.WoutT + (size_t)l * DM * DM, MR, DM, DM, e, bid, nb); }
    GRID_BAR();
    { const Prm p = PRM(); st_modulate(p, l, 1, p.H2, bid, nb); }
    { const Prm p = PRM(); st_cvt_tables(p, l, bid, nb); }
    GRID_BAR();
    { const Prm p = PRM(); run_gemm(shm, p.H2, p.WqT + (size_t)l * DM * DM, MR, DM, DM, epi_bf16(p.Qp, DM), bid, nb); }
    GRID_BAR();
    { const Prm p = PRM(); st_peertopk(p, l, shm, bid, nb); }
    if (PROBE == 4) { __syncthreads(); const Prm p = PRM(); st_peertopk(p, l, shm, bid, nb); }
    GRID_BAR();
    { const Prm p = PRM(); st_peergather(p, l, lf, bid, nb); }
    if (PROBE == 1) { __syncthreads(); const Prm p = PRM(); st_peergather(p, l, lf, bid, nb, true); }
    GRID_BAR();
  }
  { const Prm p = PRM(); st_final(p, bid, nb); }
#endif
#undef bid
#undef nb
#undef GRID_BAR
}

static size_t al256(size_t x) { return (x + 255) / 256 * 256; }
extern "C" void kernel_launch(void* const* d_in, const int* in_sizes, int n_in, void* d_out, int out_size, void* d_ws, size_t ws_size, hipStream_t stream) {
  Prm p{};
  const float** f = (const float**)&p.x;
  for (int i = 0; i < 24; ++i) f[i] = (const float*)d_in[i];
  p.out = (float*)d_out;
  char* w = (char*)d_ws; size_t o = 0;
  auto take = [&](size_t bytes) { char* r = w + o; o += al256(bytes); return r; };
  p.bar = (unsigned*)take(16384);
  p.WinT = (bf16_t*)take((size_t)2 * NZ * DM * 2); p.WoutT = (bf16_t*)take((size_t)2 * DM * DM * 2); p.WqT = (bf16_t*)take((size_t)2 * DM * DM * 2);
  p.WuqT = (bf16_t*)take((size_t)2 * 768 * 512 * 2); p.WukvT = (bf16_t*)take((size_t)2 * 1024 * 256 * 2);
  p.mod = (float*)take((size_t)2 * 9 * NMOD * 4); p.GB = (float*)take((size_t)MR * 16 * 4); p.CCS = (float*)take((size_t)2 * 128 * 128 * 4);
  p.DFTM = (bf16_t*)take((size_t)4096 * 8192 * 2); p.DFTC = (bf16_t*)take((size_t)256 * 512 * 2);
  p.X = (float*)take((size_t)MR * DM * 4);
  p.Z = (bf16_t*)take((size_t)MR * NZ * 2);
  char* ra = take((size_t)MR * 1536 * 2 + (size_t)4 * MR * 512 * 2);
  p.DNQ = (bf16_t*)ra; p.OB = (bf16_t*)(ra + (size_t)MR * 1536 * 2); p.H = (bf16_t*)ra;
  p.Ub = (bf16_t*)ra; p.Vb = (bf16_t*)(ra + (size_t)16384 * DM);
  p.KV = (bf16_t*)take((size_t)MR * 1024 * 2); p.KR = (bf16_t*)take((size_t)MR * 64 * 2);
  p.Aq = (bf16_t*)take((size_t)MR * 512 * 2); p.Akv = (bf16_t*)take((size_t)MR * 256 * 2);
  if (o > ws_size) return;
  char* q = (char*)d_out; size_t oo = 0;
  p.Y = (bf16_t*)q; oo += (size_t)MR * DM * 2; p.PQT = (bf16_t*)(q + oo); oo += (size_t)8 * 512 * 8192 * 2; p.PQTc = (bf16_t*)(q + oo); oo += (size_t)8 * 512 * 512 * 2;
  p.Qraw = (bf16_t*)(q + oo); oo += (size_t)MR * 768 * 2;
  char* z = (char*)p.Z; p.H2 = (bf16_t*)z; p.Qp = (bf16_t*)(z + (size_t)MR * DM * 2); p.IDX = (int*)(z + (size_t)2 * MR * DM * 2); p.GATE = (float*)(z + (size_t)2 * MR * DM * 2 + (size_t)MR * 128 * 4);

  static int grid = 0;
  if (!grid) {
    (void)hipFuncSetAttribute((const void*)mega, hipFuncAttributeMaxDynamicSharedMemorySize, LDS_TOTAL);
    int dev = 0, cus = 0, per_cu = 0;
    (void)hipGetDevice(&dev); (void)hipDeviceGetAttribute(&cus, hipDeviceAttributeMultiprocessorCount, dev);
    (void)hipOccupancyMaxActiveBlocksPerMultiprocessor(&per_cu, (const void*)mega, NTHR, LDS_TOTAL);
    grid = per_cu >= 1 ? cus : 0;
    if (grid > 256) grid = 256;
  }
  if (grid < 256) return;
  (void)hipMemsetAsync(p.bar, 0, XCD_BAR_WORDS * sizeof(unsigned), stream);
  hipLaunchKernelGGL(mega, dim3(grid), dim3(NTHR), LDS_TOTAL, stream, p);
}
```

```cpp
#include <hip/hip_runtime.h>
#include <stdint.h>

constexpr int DM = 2048, NB = 8, LL = 4096, LCX = 256, LT = LL + LCX  , MR = NB * LT  ;
constexpr int NZ = 4864;
constexpr int C_DNQ = 0, C_DNK = 512, C_DNV = 1024, C_DNGATE = 1536, C_DNA = 2048, C_DNB = 2056, C_GQ = 2064, C_GK = 2320, C_GV = 2576,
              C_GGATE = 3088, C_GALPHA = 3600, C_CQ = 3632, C_CKV = 4080, C_KR = 4208, C_FN = 4272, IN_W = 4784;
constexpr int NMOD = 6 * DM;
constexpr float EPSV = 1e-6f;
constexpr int NTHR = 512;

typedef unsigned short bf16_t;
typedef short bf16x8 __attribute__((ext_vector_type(8)));
typedef short s16x4 __attribute__((ext_vector_type(4)));
typedef float f32x4 __attribute__((ext_vector_type(4)));
typedef float f32x16 __attribute__((ext_vector_type(16)));
typedef unsigned u32x4 __attribute__((ext_vector_type(4)));
typedef unsigned u32x2 __attribute__((ext_vector_type(2)));

#define DI __device__ __forceinline__
DI float bf2f(bf16_t b) { return __uint_as_float(((unsigned)b) << 16); }
DI bf16_t f2bf(float f) { unsigned u = __float_as_uint(f); u += 0x7FFFu + ((u >> 16) & 1u); return (bf16_t)(u >> 16); }
DI unsigned pack2(float lo, float hi) { return (unsigned)f2bf(lo) | ((unsigned)f2bf(hi) << 16); }
typedef float f32x2 __attribute__((ext_vector_type(2)));
DI float dpp_x1(float v) { return __int_as_float(__builtin_amdgcn_mov_dpp(__float_as_int(v), 0xB1, 0xf, 0xf, true)); }
DI float dpp_x2(float v) { return __int_as_float(__builtin_amdgcn_mov_dpp(__float_as_int(v), 0x4E, 0xf, 0xf, true)); }
DI float dpp_hm(float v) { return __int_as_float(__builtin_amdgcn_mov_dpp(__float_as_int(v), 0x141, 0xf, 0xf, true)); }
DI float dpp_rm(float v) { return __int_as_float(__builtin_amdgcn_mov_dpp(__float_as_int(v), 0x140, 0xf, 0xf, true)); }
DI float red4(float v) { v += dpp_x1(v); v += dpp_x2(v); return v; }
DI float red8(float v) { v += dpp_x1(v); v += dpp_x2(v); v += dpp_hm(v); return v; }
DI float rdl(float v, int l) { return __int_as_float(__builtin_amdgcn_readlane(__float_as_int(v), l)); }
DI float wsum(float v) { v += dpp_x1(v); v += dpp_x2(v); v += dpp_hm(v); v += dpp_rm(v); return (rdl(v, 0) + rdl(v, 16)) + (rdl(v, 32) + rdl(v, 48)); }
DI float wmax(float v) { v = fmaxf(v, dpp_x1(v)); v = fmaxf(v, dpp_x2(v)); v = fmaxf(v, dpp_hm(v)); v = fmaxf(v, dpp_rm(v)); return fmaxf(fmaxf(rdl(v, 0), rdl(v, 16)), fmaxf(rdl(v, 32), rdl(v, 48))); }
DI float siluf(float x) { return x / (1.f + __expf(-x)); }
DI float sigmf(float x) { return 1.f / (1.f + __expf(-x)); }

DI int ltid() { int t = (int)threadIdx.x; asm volatile("" : "+v"(t)); return t; }
DI int lsg(int v) { asm volatile("" : "+s"(v)); return v; }

struct Prm {
  const float *x, *c, *ctx, *c_ctx, *w_ada, *b_ada, *w_in, *dn_conv, *dn_a_log, *dn_dt_bias, *dn_norm, *gla_w2, *gla_b2, *gla_norm,
      *mla_q_norm, *mla_w_uq, *mla_kv_norm, *mla_w_ukv, *w_out, *peer_wq, *peer_keys, *peer_u, *peer_v, *final_norm;
  float* out;
  bf16_t *WinT, *WoutT, *WqT, *WuqT, *WukvT;
  float *mod, *GB, *CCS;
  bf16_t *DFTM, *DFTC;
  float* X;
  bf16_t* Z;
  bf16_t *H, *DNQ, *OB;
  bf16_t *KV, *KR;
  bf16_t *Y, *PQT, *PQTc, *Qraw, *Aq, *Akv;
  bf16_t *H2, *Qp;
  bf16_t *Ub, *Vb;
  int* IDX;
  float* GATE;
  unsigned* bar;
};
#define XB_TMO      128
#define XB_XCNT(j)  (256  + 64 * (j))
#define XB_XSUB(j)  (1280 + 64 * (j))
#define XB_XGEN(j)  (2304 + 64 * (j))
#define XB_TOP      3328
#define XB_TOPGEN   3392
#define XCD_BAR_WORDS 3456
#define XB_SPIN_CAP (1u << 18)
#define LAS __attribute__((address_space(3)))

__device__ __forceinline__ unsigned xb_ld(unsigned* p)              { return __hip_atomic_load(p, __ATOMIC_RELAXED, __HIP_MEMORY_SCOPE_AGENT); }
__device__ __forceinline__ unsigned xb_add(unsigned* p, unsigned v) { return __hip_atomic_fetch_add(p, v, __ATOMIC_RELAXED, __HIP_MEMORY_SCOPE_AGENT); }
__device__ __forceinline__ unsigned xb_xcc_id() { return (unsigned)__builtin_amdgcn_s_getreg((3 << 11) | 20) & 0xFu; }
#define XB_SPIN(cond, bar) do { unsigned _sp = 0; while (cond) { __builtin_amdgcn_s_sleep(1); \
    if ((++_sp & 255u) == 0u) { if (xb_ld(&(bar)[XB_TMO])) break; if (_sp > XB_SPIN_CAP) { atomicAdd(&(bar)[XB_TMO], 1u); break; } } } } while (0)

struct XcdBarrier {
    unsigned* bar; unsigned x;
    volatile LAS unsigned* st;
};

__device__ __forceinline__ XcdBarrier xcd_barrier_post(unsigned* bar, volatile LAS unsigned* st) {
    XcdBarrier b; b.bar = bar; b.x = xb_xcc_id(); b.st = st;
    if (threadIdx.x == 0) (void)xb_add(&bar[XB_XCNT(b.x)], 1u);
    return b;
}
__device__ __forceinline__ void xcd_barrier_complete(unsigned* bar, unsigned x, unsigned& nloc, unsigned& nx) {
    const unsigned G = gridDim.x * gridDim.y * gridDim.z;
    unsigned sum, cnt, mine, sp = 0u;
    for (;;) {
        sum = 0u; cnt = 0u; mine = 0u;
#pragma unroll
        for (unsigned j = 0; j < 16; ++j) { const unsigned c = xb_ld(&bar[XB_XCNT(j)]); sum += c; cnt += (c > 0u) ? 1u : 0u; mine = (j == x) ? c : mine; }
        if (sum == G) break;
        __builtin_amdgcn_s_sleep(1);
        if ((++sp & 255u) == 0u) { if (xb_ld(&bar[XB_TMO])) break; if (sp > XB_SPIN_CAP) { atomicAdd(&bar[XB_TMO], 1u); break; } }
    }
    nloc = mine > 0u ? mine : 1u; nx = cnt > 0u ? cnt : 1u;
}

__device__ __forceinline__ void xcd_barrier(const XcdBarrier& b) {
    asm volatile("s_waitcnt vmcnt(0)" ::: "memory");
    __syncthreads();
    if (threadIdx.x == 0) {
        unsigned* bar = b.bar;
        __builtin_amdgcn_s_waitcnt(0);
        unsigned nloc = b.st[0], nx = b.st[1];
        if (nloc == 0u) { xcd_barrier_complete(bar, b.x, nloc, nx); b.st[0] = nloc; b.st[1] = nx; }
        const unsigned old = xb_add(&bar[XB_XSUB(b.x)], 1u);
        const unsigned gen = old / nloc;
        if (old + 1u == (gen + 1u) * nloc) {
            __builtin_amdgcn_fence(__ATOMIC_RELEASE, "agent");
            asm volatile("s_waitcnt vmcnt(0)" ::: "memory");
            const unsigned og = xb_add(&bar[XB_TOP], 1u);
            const unsigned tg = og / nx;
            if (og + 1u == (tg + 1u) * nx) xb_add(&bar[XB_TOPGEN], 1u);
            else XB_SPIN(xb_ld(&bar[XB_TOPGEN]) == tg, bar);
            __builtin_amdgcn_fence(__ATOMIC_ACQUIRE, "agent");
            xb_add(&bar[XB_XGEN(b.x)], 1u);
            asm volatile("s_waitcnt vmcnt(0)" ::: "memory");
        } else {
            XB_SPIN(xb_ld(&bar[XB_XGEN(b.x)]) == gen, bar);
            __builtin_amdgcn_fence(__ATOMIC_ACQUIRE, "agent");
            asm volatile("s_waitcnt vmcnt(0)" ::: "memory");
        }
    }
    __syncthreads();
}

namespace pg8 {
#define PG8_LAS __attribute__((address_space(3)))
typedef unsigned short bf16_t;
typedef short bf16x8 __attribute__((ext_vector_type(8)));
typedef float f32x4 __attribute__((ext_vector_type(4)));
typedef unsigned u32x4 __attribute__((ext_vector_type(4)));
constexpr int BM = 256, BK = 64, HALF = 128, HTB = HALF * BK * 2  , STAGE_BYTES = 8 * HTB, NXCD = 8, WGM = 8;

__host__ __device__ __forceinline__ int lds_byte(int r, int c) { const int st = (r >> 4) * 2 + (c >> 5), rr = r & 15, cc = c & 31, ob = rr * 64 + cc * 2; return st * 1024 + (ob ^ (((ob >> 9) & 1) << 5)); }
__host__ __device__ __forceinline__ void stage_rc(int b, int& R, int& C) { const int st = b / 1024, sb = b % 1024, swz = sb ^ (((sb >> 9) & 1) << 5); R = (st >> 1) * 16 + swz / 64; C = (st & 1) * 32 + (swz % 64) / 2; }
__host__ __device__ __forceinline__ int perm32(int rho) { const int n = rho >> 4, i = rho & 15; return 8 * (i >> 2) + 4 * n + (i & 3); }

struct Unit { int pm, pn; };
struct Gemm { const bf16_t* A; const bf16_t* Bt; int M, N, K; };

struct StaticOrder {
    int nM, nN, nwg, G, c;
    __host__ __device__ void init(int M, int N, int G_, int c_) { nM = M / BM; nN = N / BM; nwg = nM * nN; G = G_; c = c_; }
    __host__ __device__ bool next(int i, Unit& u) const {
        const long L = (long)i * G + c; if (L >= nwg) return false;
        int wgid = (int)L; { const int q = nwg / NXCD, r = nwg % NXCD, xcd = wgid % NXCD, off = wgid / NXCD; wgid = (xcd < r ? xcd * (q + 1) : r * (q + 1) + (xcd - r) * q) + off; }
        const int nig = WGM * nN, gid = wgid / nig, fm = gid * WGM, gsz = (nM - fm) < WGM ? (nM - fm) : WGM;
        u.pm = fm + ((wgid % nig) % gsz); u.pn = (wgid % nig) / gsz; return true;
    }
    __device__ __forceinline__ void a_ready(const Unit&) const {}
    __device__ __forceinline__ void done(const Unit&) const {}
};
struct CountedOrder : StaticOrder {
    const unsigned* ready; unsigned need; unsigned* tmo;
    __device__ __forceinline__ void a_ready(const Unit& u) const {
        if (threadIdx.x < 64) {
            const unsigned long long t0 = __builtin_amdgcn_s_memrealtime(); unsigned polls = 0;
            while ((unsigned)__builtin_amdgcn_readfirstlane(__hip_atomic_load(ready + 64 * u.pm, __ATOMIC_RELAXED, __HIP_MEMORY_SCOPE_AGENT)) < need) {
                if ((++polls & 255u) == 0u && __builtin_amdgcn_readfirstlane(__hip_atomic_load(tmo, __ATOMIC_RELAXED, __HIP_MEMORY_SCOPE_AGENT)) != 0u) break;
                if (__builtin_amdgcn_s_memrealtime() - t0 > 2000000ull) {
                    if (threadIdx.x == 0) { unsigned expect = 0u; __hip_atomic_compare_exchange_strong(tmo + 1, &expect, 0x600u | (unsigned)(u.pm & 0xff), __ATOMIC_RELAXED, __ATOMIC_RELAXED, __HIP_MEMORY_SCOPE_AGENT); __hip_atomic_store(tmo, 1u, __ATOMIC_RELAXED, __HIP_MEMORY_SCOPE_AGENT); }
                    break; }
                __builtin_amdgcn_s_sleep(2); }
            __builtin_amdgcn_fence(__ATOMIC_ACQUIRE, "agent");
            asm volatile("s_waitcnt vmcnt(0)" ::: "memory");
        }
#if !defined(BROKEN_HOOK_NO_BARRIER)
        asm volatile("" ::: "memory"); __builtin_amdgcn_s_barrier(); asm volatile("" ::: "memory");
#endif
    }
};

__device__ __forceinline__ unsigned cvt_pk_bf16(float lo, float hi) { unsigned r; asm volatile("v_cvt_pk_bf16_f32 %0, %1, %2" : "=v"(r) : "v"(lo), "v"(hi)); return r; }
typedef float f32x2 __attribute__((ext_vector_type(2)));
__device__ __forceinline__ f32x2 gelu_pk(f32x2 v) {
    const f32x2 av = __builtin_elementwise_abs(v), d = av * 0.2316418882f + 1.0f;
    f32x2 t; t.x = __builtin_amdgcn_rcpf(d.x); t.y = __builtin_amdgcn_rcpf(d.y);
    f32x2 q = t * 0.5307027145f + (-0.7265760135f); q = q * t + 0.7107068705f; q = q * t + (-0.142248368f); q = q * t + 0.127414796f; q = q * t;
    const f32x2 s = (v * v) * (-0.72134752044f);
    f32x2 e; e.x = __builtin_amdgcn_exp2f(s.x); e.y = __builtin_amdgcn_exp2f(s.y);
    const f32x2 m = v * (q * e), r = v - m;
    f32x2 o; o.x = v.x < 0.f ? m.x : r.x; o.y = v.y < 0.f ? m.y : r.y; return o;
}

struct EpiF32 {
    static constexpr bool PERM = false, AFTER_DRAIN = false;
    float* C; int ldc; const float* bias;
    __device__ __forceinline__ void operator()(const f32x4 (&acc)[2][2][4][2], const Unit& u, int wr, int wc, int fr, int fq) const {
        const int row0 = u.pm * BM + wr * 64 + fr, col0 = u.pn * BM + wc * 32 + 4 * fq;
        f32x4 bv[2][2];
#pragma unroll
        for (int bj = 0; bj < 2; ++bj)
#pragma unroll
            for (int n = 0; n < 2; ++n) bv[bj][n] = bias ? *(const f32x4*)(bias + col0 + bj * HALF + n * 16) : (f32x4){0.f, 0.f, 0.f, 0.f};
#pragma unroll
        for (int ai = 0; ai < 2; ++ai)
#pragma unroll
            for (int m = 0; m < 4; ++m) { float* rowp = C + (size_t)(row0 + ai * HALF + m * 16) * ldc + col0;
#pragma unroll
                for (int bj = 0; bj < 2; ++bj)
#pragma unroll
                    for (int n = 0; n < 2; ++n) *(f32x4*)(rowp + bj * HALF + n * 16) = acc[ai][bj][m][n] + bv[bj][n]; }
    }
};
template <int ACT  > struct EpiBf16 {
    static constexpr bool PERM = true, AFTER_DRAIN = false;
    bf16_t* O; int ldc; const float* bias; int split_cols; size_t split_stride;
    __device__ __forceinline__ void operator()(const f32x4 (&acc)[2][2][4][2], const Unit& u, int wr, int wc, int fr, int fq) const {
        const int row0 = u.pm * BM + wr * 64 + fr; int colt = u.pn * BM; bf16_t* base = O;
        if (split_cols) { const int t = colt / split_cols; base += (size_t)t * split_stride; colt -= t * split_cols; }
        const int col0 = colt + wc * 32 + 8 * fq, bcol0 = u.pn * BM + wc * 32 + 8 * fq;
        f32x4 bv[2][2];
#pragma unroll
        for (int bj = 0; bj < 2; ++bj)
#pragma unroll
            for (int n = 0; n < 2; ++n) bv[bj][n] = bias ? *(const f32x4*)(bias + bcol0 + bj * HALF + 4 * n) : (f32x4){0.f, 0.f, 0.f, 0.f};
#pragma unroll
        for (int ai = 0; ai < 2; ++ai)
#pragma unroll
            for (int m = 0; m < 4; ++m) { bf16_t* rowp = base + (size_t)(row0 + ai * HALF + m * 16) * ldc + col0;
#pragma unroll
                for (int bj = 0; bj < 2; ++bj) { f32x4 v0 = acc[ai][bj][m][0] + bv[bj][0], v1 = acc[ai][bj][m][1] + bv[bj][1];
                    if (ACT == 1) { f32x2 a = gelu_pk((f32x2){v0[0], v0[1]}), b = gelu_pk((f32x2){v0[2], v0[3]}), c = gelu_pk((f32x2){v1[0], v1[1]}), d = gelu_pk((f32x2){v1[2], v1[3]});
                        v0 = (f32x4){a.x, a.y, b.x, b.y}; v1 = (f32x4){c.x, c.y, d.x, d.y}; }
                    if (ACT == 2) {
#pragma unroll
                        for (int j = 0; j < 4; ++j) { v0[j] = 0.5f * v0[j] * (1.0f + erff(v0[j] * 0.70710678f)); v1[j] = 0.5f * v1[j] * (1.0f + erff(v1[j] * 0.70710678f)); } }
                    u32x4 w; w.x = cvt_pk_bf16(v0[0], v0[1]); w.y = cvt_pk_bf16(v0[2], v0[3]); w.z = cvt_pk_bf16(v1[0], v1[1]); w.w = cvt_pk_bf16(v1[2], v1[3]);
                    *(u32x4*)(rowp + bj * HALF) = w; } }
    }
};
template <class Epi, class Sched, bool STAMP = false>
__device__ __forceinline__ void gemm_phase(PG8_LAS unsigned char* lds, const Gemm g, const Sched& S, const Epi& E, unsigned long long* stamps) {
    const int tid = ltid(), wid = __builtin_amdgcn_readfirstlane(tid >> 6), lane = tid & 63, wr = wid >> 2, wc = wid & 3, fr = lane & 15, fq = lane >> 4;
    const int K = g.K, nt = K / BK;
    int ts_lo = 0, ts_hi = 0, nts = 0; const unsigned long long rt_entry = STAMP ? (unsigned long long)wall_clock64() : 0ull;
#define PG8_STAMP() do { if (STAMP && wid == 0 && nts < 64) { const unsigned long long _c = (unsigned long long)clock64(); \
        ts_lo = (lane == nts) ? (int)(unsigned)_c : ts_lo; ts_hi = (lane == nts) ? (int)(unsigned)(_c >> 32) : ts_hi; ++nts; } } while (0)
    PG8_STAMP();
    unsigned voffA[2], voffB[2];
#pragma unroll
    for (int i = 0; i < 2; ++i) { int R, C; stage_rc(tid * 16 + i * 8192, R, C); const int Rb = Epi::PERM ? ((R & ~31) + perm32(R & 31)) : R;
        voffA[i] = (unsigned)(R * K + C) * 2u; voffB[i] = (unsigned)(Rb * K + C) * 2u; }
    const size_t kstep = (size_t)(BK * 2);
    const size_t hstep = (size_t)HALF * K * 2;
    const size_t tstep = 2 * hstep;
    const unsigned ldsw = (unsigned)wid * 1024u;
    const int aoff = lds_byte(wr * 64 + fr, fq * 8), boff = lds_byte(wc * 32 + fr, fq * 8);
#define PG8_SA(b, h) (((b) * 2 + (h)) * HTB)
#define PG8_SB(b, h) ((4 + (b) * 2 + (h)) * HTB)
#define PG8_STAGE(bufoff, gbase, voff) do { _Pragma("unroll") for (int _i = 0; _i < 2; ++_i) \
        __builtin_amdgcn_global_load_lds((const unsigned*)((const char*)(gbase) + (voff)[_i]), (PG8_LAS unsigned*)(lds + (bufoff) + ldsw + _i * 8192), 16, 0, 0); } while (0)
#define PG8_LDA(dst, b, h) do { _Pragma("unroll") for (int m = 0; m < 4; ++m) _Pragma("unroll") for (int k = 0; k < 2; ++k) dst[m][k] = *(const PG8_LAS bf16x8*)(lds + PG8_SA(b, h) + aoff + m * 2048 + k * 1024); } while (0)
#define PG8_LDB(dst, b, h) do { _Pragma("unroll") for (int n = 0; n < 2; ++n) _Pragma("unroll") for (int k = 0; k < 2; ++k) dst[n][k] = *(const PG8_LAS bf16x8*)(lds + PG8_SB(b, h) + boff + n * 2048 + k * 1024); } while (0)
#define PG8_MMA(ai, bj, At, Bt) do { __builtin_amdgcn_s_setprio(1); _Pragma("unroll") for (int m = 0; m < 4; ++m) _Pragma("unroll") for (int n = 0; n < 2; ++n) _Pragma("unroll") for (int k = 0; k < 2; ++k) \
        acc[ai][bj][m][n] = __builtin_amdgcn_mfma_f32_16x16x32_bf16(Bt[n][k], At[m][k], acc[ai][bj][m][n], 0, 0, 0); __builtin_amdgcn_s_setprio(0); } while (0)
#define PG8_WAIT_V(n) asm volatile("s_waitcnt vmcnt(" #n ")" ::: "memory")
#define PG8_WAIT_L(n) asm volatile("s_waitcnt lgkmcnt(" #n ")" ::: "memory")
#define PG8_BAR __builtin_amdgcn_s_barrier()
#define PG8_SCHED __builtin_amdgcn_sched_barrier(0)
    Unit cur, nxt; int ui = 0;
    if (!S.next(0, cur)) return;
    f32x4 acc[2][2][4][2];
#pragma unroll
    for (int a = 0; a < 2; ++a)
#pragma unroll
        for (int b = 0; b < 2; ++b)
#pragma unroll
            for (int m = 0; m < 4; ++m)
#pragma unroll
                for (int n = 0; n < 2; ++n) acc[a][b][m][n] = (f32x4){0.f, 0.f, 0.f, 0.f};
    bf16x8 At[4][2], B0[2][2], B1[2][2];
    const char* cA = (const char*)g.A + (size_t)cur.pm * tstep; const char* cB = (const char*)g.Bt + (size_t)cur.pn * tstep;
    S.a_ready(cur);
    PG8_STAGE(PG8_SB(0, 0), cB, voffB); PG8_STAGE(PG8_SA(0, 0), cA, voffA); PG8_STAGE(PG8_SB(0, 1), cB + hstep, voffB); PG8_STAGE(PG8_SA(0, 1), cA + hstep, voffA);
    if (wr == 1) PG8_BAR;
    PG8_WAIT_V(4); PG8_BAR;
    PG8_STAGE(PG8_SB(1, 0), cB + kstep, voffB); PG8_STAGE(PG8_SA(1, 0), cA + kstep, voffA); PG8_STAGE(PG8_SB(1, 1), cB + hstep + kstep, voffB);
    PG8_WAIT_V(6); PG8_BAR;
    PG8_STAMP();
    for (;;) {
        const bool has_next = S.next(ui + 1, nxt);
        const char* nA = has_next ? (const char*)g.A + (size_t)nxt.pm * tstep : cA; const char* nB = has_next ? (const char*)g.Bt + (size_t)nxt.pn * tstep : cB;
        for (int t = 0; t < nt; t += 2) {
            const bool last = (t == nt - 2);
            const char* a1 = cA + (size_t)(t + 1) * kstep;
            const char* a2 = last ? nA : cA + (size_t)(t + 2) * kstep; const char* b2 = last ? nB : cB + (size_t)(t + 2) * kstep;
            const char* a3 = a2 + kstep; const char* b3 = b2 + kstep;
            if (last && has_next) S.a_ready(nxt);
            PG8_LDB(B0, 0, 0); PG8_SCHED; PG8_LDA(At, 0, 0); PG8_STAGE(PG8_SA(1, 1), a1 + hstep, voffA);
            PG8_WAIT_L(8); PG8_BAR; PG8_WAIT_L(0); PG8_MMA(0, 0, At, B0); PG8_BAR; PG8_SCHED;
            PG8_LDB(B1, 0, 1); PG8_STAGE(PG8_SB(0, 0), b2, voffB);
            PG8_BAR; PG8_WAIT_L(0); PG8_MMA(0, 1, At, B1); PG8_BAR;
            PG8_LDA(At, 0, 1); PG8_STAGE(PG8_SA(0, 0), a2, voffA);
            PG8_BAR; PG8_WAIT_L(0); PG8_MMA(1, 0, At, B0); PG8_BAR; PG8_SCHED;
            PG8_STAGE(PG8_SB(0, 1), b2 + hstep, voffB);
            PG8_WAIT_V(6); PG8_BAR; PG8_MMA(1, 1, At, B1); PG8_BAR;
            PG8_LDB(B0, 1, 0); PG8_SCHED; PG8_LDA(At, 1, 0); PG8_STAGE(PG8_SA(0, 1), a2 + hstep, voffA);
            PG8_WAIT_L(8); PG8_BAR; PG8_WAIT_L(0); PG8_MMA(0, 0, At, B0); PG8_BAR; PG8_SCHED;
            PG8_LDB(B1, 1, 1); PG8_STAGE(PG8_SB(1, 0), b3, voffB);
            PG8_BAR; PG8_WAIT_L(0); PG8_MMA(0, 1, At, B1); PG8_BAR;
            PG8_LDA(At, 1, 1); PG8_STAGE(PG8_SA(1, 0), a3, voffA);
            PG8_BAR; PG8_WAIT_L(0); PG8_MMA(1, 0, At, B0); PG8_BAR; PG8_SCHED;
            PG8_STAGE(PG8_SB(1, 1), b3 + hstep, voffB);
            PG8_WAIT_V(6); PG8_BAR; PG8_MMA(1, 1, At, B1); PG8_BAR;
        }
        PG8_STAMP();
        if constexpr (!Epi::AFTER_DRAIN) { E(acc, cur, wr, wc, fr, fq); S.done(cur); }
        PG8_STAMP();
        if (!has_next) break;
#pragma unroll
        for (int a = 0; a < 2; ++a)
#pragma unroll
            for (int b = 0; b < 2; ++b)
#pragma unroll
                for (int m = 0; m < 4; ++m)
#pragma unroll
                    for (int n = 0; n < 2; ++n) acc[a][b][m][n] = (f32x4){0.f, 0.f, 0.f, 0.f};
        cur = nxt; cA = nA; cB = nB; ++ui;
    }
    PG8_WAIT_V(0);
    if (wr == 0) PG8_BAR;
    PG8_BAR;
    if constexpr (Epi::AFTER_DRAIN) { E.fused(acc, cur, wr, wc, fr, fq, lds, wid, lane); S.done(cur); }
    PG8_STAMP();
    if (STAMP && wid == 0) { stamps[lane] = lane < nts ? (((unsigned long long)(unsigned)ts_hi << 32) | (unsigned)ts_lo) : 0ull;
        if (lane == 62) stamps[62] = rt_entry; if (lane == 63) stamps[63] = (unsigned long long)wall_clock64(); }
#undef PG8_STAMP
#undef PG8_SA
#undef PG8_SB
#undef PG8_STAGE
#undef PG8_LDA
#undef PG8_LDB
#undef PG8_MMA
#undef PG8_WAIT_V
#undef PG8_WAIT_L
#undef PG8_BAR
#undef PG8_SCHED
}
}

DI void st_transpose(const float* __restrict__ src, bf16_t* __restrict__ dst, int K, int N, int Kpad, int Npad, float* lds, int bid, int nb) {
  const int tk = Kpad / 64, tn = Npad / 64;
  for (int it = bid; it < tk * tn; it += nb) {
    const int k0 = (it % tk) * 64, n0 = (it / tk) * 64;
    __syncthreads();
    for (int e = ltid(); e < 4096; e += NTHR) { const int i = e >> 6, j = e & 63, k = k0 + i, n = n0 + j; lds[i * 65 + j] = (k < K && n < N) ? src[(size_t)k * N + n] : 0.f; }
    __syncthreads();
    for (int e = ltid(); e < 4096; e += NTHR) { const int j = e >> 6, i = e & 63; dst[(size_t)(n0 + j) * Kpad + k0 + i] = f2bf(lds[i * 65 + j]); }
  }
}

DI void st_mods(const Prm& p, float* lds, int bid, int nb) {
  float* s = lds; float* red = lds + 9 * 2048;
  for (int e = ltid(); e < 9 * 2048; e += NTHR) { const int r = e >> 11, k = e & 2047; const float v = r < 8 ? p.c[r * 2048 + k] : p.c_ctx[k]; s[e] = siluf(v); }
  __syncthreads();
  const int kg = ltid() >> 6, cl = ltid() & 63;
  for (int it = bid; it < 2 * 192; it += nb) {
    const int l = it / 192, cb = (it % 192) * 64;
    const float* w = p.w_ada + (size_t)l * 2048 * NMOD + cb + cl;
    float acc[9];
#pragma unroll
    for (int r = 0; r < 9; ++r) acc[r] = 0.f;
    for (int k = kg * 256; k < kg * 256 + 256; ++k) { const float wv = w[(size_t)k * NMOD];
#pragma unroll
      for (int r = 0; r < 9; ++r) acc[r] += s[r * 2048 + k] * wv; }
#pragma unroll
    for (int r = 0; r < 9; ++r) red[(kg * 9 + r) * 64 + cl] = acc[r];
    __syncthreads();
    for (int e = ltid(); e < 576; e += NTHR) { const int r = e >> 6, c2 = e & 63; float t = 0.f;
      for (int g = 0; g < 8; ++g) t += red[(g * 9 + r) * 64 + c2];
      p.mod[((size_t)l * 9 + r) * NMOD + cb + c2] = t + p.b_ada[l * NMOD + cb + c2]; }
    __syncthreads();
  }
}

DI void st_tables(const Prm& p, int bid, int nb) {
  const size_t stride = (size_t)nb * NTHR, t0 = (size_t)bid * NTHR + ltid();
  for (size_t e = t0; e < (size_t)4096 * 8192; e += stride) { const int k1 = (int)(e >> 13), n = (int)(e & 8191), n1 = n & 4095, idx = (k1 * n1) & 4095;
    float sv, cv; sincosf((float)idx * (6.283185307179586f / 4096.f), &sv, &cv); p.DFTM[e] = f2bf((n < 4096 ? cv : -sv) * (1.f / 64.f)); }
  for (size_t e = t0; e < (size_t)256 * 512; e += stride) { const int k1 = (int)(e >> 9), n = (int)(e & 511), n1 = n & 255, idx = (k1 * n1) & 255;
    float sv, cv; sincosf((float)idx * (6.283185307179586f / 256.f), &sv, &cv); p.DFTC[e] = f2bf((n < 256 ? cv : -sv) * (1.f / 16.f)); }
  for (size_t e = t0; e < (size_t)2 * 128 * 128; e += stride) { const int tb = (int)(e >> 14), k2 = (int)((e >> 7) & 127), n2 = (int)(e & 127), idx = (k2 * n2) & 127;
    float sv, cv; sincosf((float)idx * (6.283185307179586f / 128.f), &sv, &cv); p.CCS[e] = (tb ? sv : cv) * 0.08838834764831845f; }
}

DI void st_modulate(const Prm& p, int layer, int which, bf16_t* __restrict__ dst, int bid, int nb) {
  const int wave = ltid() >> 6, lane = ltid() & 63;
  const int shoff = which ? 3 * DM : 0, scoff = which ? 4 * DM : DM;
  for (int row = bid * 8 + wave; row < MR; row += nb * 8) {
    const int b = row / LT, t = row - b * LT; const bool isc = t >= LL;
    const float* src = (layer == 0 && which == 0) ? (isc ? p.ctx + (size_t)(b * LCX + t - LL) * DM : p.x + (size_t)(b * LL + t) * DM) : p.X + (size_t)row * DM;
    f32x4 v[8]; float ss = 0.f;
#pragma unroll
    for (int i = 0; i < 8; ++i) { v[i] = *(const f32x4*)(src + (i * 64 + lane) * 4); ss += v[i][0] * v[i][0] + v[i][1] * v[i][1] + v[i][2] * v[i][2] + v[i][3] * v[i][3]; }
    ss = wsum(ss); const float rstd = rsqrtf(ss * (1.f / 2048.f) + EPSV);
    const float* mr = p.mod + ((size_t)layer * 9 + (isc ? 8 : b)) * NMOD;
#pragma unroll
    for (int i = 0; i < 8; ++i) { const int col = (i * 64 + lane) * 4; const f32x4 sc = *(const f32x4*)(mr + scoff + col), sh = *(const f32x4*)(mr + shoff + col);
      const f32x4 o = v[i] * rstd * (sc + 1.f) + sh; u32x2 w; w.x = pack2(o[0], o[1]); w.y = pack2(o[2], o[3]); *(u32x2*)(dst + (size_t)row * DM + col) = w; }
  }
}

DI void st_dnprep(const Prm& p, int layer, int bid, int nb) {
  const int wave = ltid() >> 6, lane = ltid() & 63;
  const float* conv = p.dn_conv + (size_t)layer * 5 * 1536;
  for (int task = bid * 8 + wave; task < (MR / 32) * 13; task += nb * 8) {
    const int tile = task / 13, grp = task - tile * 13, row0 = tile * 32;
    const int b = row0 / LT, t0 = row0 - b * LT; const bool isc = t0 >= LL;
    const int segt0 = isc ? t0 - LL : t0, seglen = isc ? LCX : LL;
    if (grp < 12) {
      const int c = grp * 128 + lane * 2;
      float w0[5], w1[5];
#pragma unroll
      for (int j = 0; j < 5; ++j) { w0[j] = conv[j * 1536 + c]; w1[j] = conv[j * 1536 + c + 1]; }
      unsigned zz[36];
#pragma unroll
      for (int r = 0; r < 36; ++r) { const int tt = segt0 + r - 2; zz[r] = (tt >= 0 && tt < seglen) ? *(const unsigned*)(p.Z + (size_t)(row0 + r - 2) * NZ + c) : 0u; }
#pragma unroll
      for (int r = 0; r < 32; ++r) { float a0 = 0.f, a1 = 0.f;
#pragma unroll
        for (int j = 0; j < 5; ++j) { a0 += __uint_as_float(zz[r + j] << 16) * w0[j]; a1 += __uint_as_float(zz[r + j] & 0xffff0000u) * w1[j]; }
        a0 = siluf(a0); a1 = siluf(a1);
        if (grp < 8) { const float ss = wsum(a0 * a0 + a1 * a1); const float sc = rsqrtf(ss + EPSV) * (grp < 4 ? 0.08838834764831845f : 1.f); a0 *= sc; a1 *= sc; }
        *(unsigned*)(p.DNQ + (size_t)(row0 + r) * 1536 + c) = pack2(a0, a1); }
    } else {
#pragma unroll
      for (int rr = 0; rr < 8; ++rr) { const int idx = lane + 64 * rr, row = row0 + (idx >> 4), wh = idx & 15, isb = wh >> 3, dh = wh & 7;
        const float z = bf2f(p.Z[(size_t)row * NZ + (isb ? C_DNB : C_DNA) + dh]); float o;
        if (!isb) { const float xx = z + p.dn_dt_bias[layer * 8 + dh]; const float sp = xx > 20.f ? xx : log1pf(expf(xx)); o = -expf(p.dn_a_log[layer * 8 + dh]) * sp; }
        else o = sigmf(z);
        p.GB[(size_t)row * 16 + wh] = o; }
    }
  }
}

DI void st_mlaprep(const Prm& p, int layer, int bid, int nb) {
  const int wave = ltid() >> 6, lane = ltid() & 63;
  const float* qn = p.mla_q_norm + layer * 448; const float* kvn = p.mla_kv_norm + layer * 128;
  for (int row = bid * 8 + wave; row < MR; row += nb * 8) {
    const bf16_t* z = p.Z + (size_t)row * NZ; const int b = row / LT, t = row - b * LT;
    float v[8]; float ss = 0.f;
#pragma unroll
    for (int k = 0; k < 8; ++k) v[k] = 0.f;
    if (lane < 56) { const u32x4 w = *(const u32x4*)(z + C_CQ + lane * 8);
#pragma unroll
      for (int k = 0; k < 4; ++k) { v[2 * k] = __uint_as_float(w[k] << 16); v[2 * k + 1] = __uint_as_float(w[k] & 0xffff0000u); ss += v[2 * k] * v[2 * k] + v[2 * k + 1] * v[2 * k + 1]; } }
    ss = wsum(ss); float rstd = rsqrtf(ss * (1.f / 448.f) + EPSV);
    { u32x4 o = {0u, 0u, 0u, 0u};
      if (lane < 56) { const f32x4 n0 = *(const f32x4*)(qn + lane * 8), n1 = *(const f32x4*)(qn + lane * 8 + 4);
        o.x = pack2(v[0] * rstd * n0[0], v[1] * rstd * n0[1]); o.y = pack2(v[2] * rstd * n0[2], v[3] * rstd * n0[3]); o.z = pack2(v[4] * rstd * n1[0], v[5] * rstd * n1[1]); o.w = pack2(v[6] * rstd * n1[2], v[7] * rstd * n1[3]); }
      *(u32x4*)(p.Aq + (size_t)row * 512 + lane * 8) = o; }
    ss = 0.f;
    if (lane < 16) { const u32x4 w = *(const u32x4*)(z + C_CKV + lane * 8);
#pragma unroll
      for (int k = 0; k < 4; ++k) { v[2 * k] = __uint_as_float(w[k] << 16); v[2 * k + 1] = __uint_as_float(w[k] & 0xffff0000u); ss += v[2 * k] * v[2 * k] + v[2 * k + 1] * v[2 * k + 1]; } }
    ss = wsum(ss); rstd = rsqrtf(ss * (1.f / 128.f) + EPSV);
    if (lane < 32) { u32x4 o = {0u, 0u, 0u, 0u};
      if (lane < 16) { const f32x4 n0 = *(const f32x4*)(kvn + lane * 8), n1 = *(const f32x4*)(kvn + lane * 8 + 4);
        o.x = pack2(v[0] * rstd * n0[0], v[1] * rstd * n0[1]); o.y = pack2(v[2] * rstd * n0[2], v[3] * rstd * n0[3]); o.z = pack2(v[4] * rstd * n1[0], v[5] * rstd * n1[1]); o.w = pack2(v[6] * rstd * n1[2], v[7] * rstd * n1[3]); }
      *(u32x4*)(p.Akv + (size_t)row * 256 + lane * 8) = o; }
    if (t < LL) {
      if (lane < 32) { const int half = lane >> 4, i = lane & 15; const float x1 = bf2f(z[C_KR + half * 32 + i]), x2 = bf2f(z[C_KR + half * 32 + 16 + i]);
        const float pos = (float)(half ? (t & 63) : (t >> 6)); const float ang = pos * exp2f(-(float)i * (13.287712379549449f / 16.f)); float sv, cv; sincosf(ang, &sv, &cv);
        p.KR[(size_t)row * 64 + half * 32 + i] = f2bf(x1 * cv - x2 * sv); p.KR[(size_t)row * 64 + half * 32 + 16 + i] = f2bf(x2 * cv + x1 * sv); }
    } else p.KR[(size_t)row * 64 + lane] = z[C_KR + lane];
  }
}

DI void st_qrope(const Prm& p, int bid, int nb) {
  const int wave = ltid() >> 6, lane = ltid() & 63;
  for (int row = bid * 8 + wave; row < MR; row += nb * 8) {
    const int b = row / LT, t = row - b * LT; if (t >= LL) continue;
#pragma unroll
    for (int k = 0; k < 2; ++k) { const int pid = lane + 64 * k, h = pid >> 5, r = pid & 31, half = r >> 4, i = r & 15;
      bf16_t* q = p.Qraw + (size_t)row * 768 + h * 192 + 128 + half * 32; const float x1 = bf2f(q[i]), x2 = bf2f(q[16 + i]);
      const float pos = (float)(half ? (t & 63) : (t >> 6)); const float ang = pos * exp2f(-(float)i * (13.287712379549449f / 16.f)); float sv, cv; sincosf(ang, &sv, &cv);
      q[i] = f2bf(x1 * cv - x2 * sv); q[16 + i] = f2bf(x2 * cv + x1 * sv); }
  }
}

DI void st_fnchan(const Prm& p, unsigned char* lds, int bid, int nb) {
  bf16_t* wt = (bf16_t*)lds;
  bf16_t* zt = (bf16_t*)(lds + 256 * 272);
  const int tid = ltid(), wave = tid >> 6, lane = tid & 63, r32 = lane & 31, hi = lane >> 5;
  __syncthreads();
  for (int e = tid; e < 256 * 128; e += NTHR) wt[(e >> 7) * 136 + (e & 127)] = f2bf(p.CCS[e]);
  for (int it = bid; it < (MR / 64) * 4; it += nb) {
    const int tile = it >> 2, g = it & 3, row0 = tile * 64, b = row0 / LT, t0 = row0 - b * LT;
    __syncthreads();
    for (int e = tid; e < 1024; e += NTHR) { const int r = e >> 4, c8 = (e & 15) * 8; *(u32x4*)(zt + r * 136 + c8) = *(const u32x4*)(p.Z + (size_t)(row0 + r) * NZ + C_FN + g * 128 + c8); }
    __syncthreads();
    f32x16 acc[2] = {};
#pragma unroll
    for (int k8 = 0; k8 < 8; ++k8) { const bf16x8 a = *(const bf16x8*)(wt + (wave * 32 + r32) * 136 + k8 * 16 + hi * 8);
#pragma unroll
      for (int tt = 0; tt < 2; ++tt) { const bf16x8 bb = *(const bf16x8*)(zt + (tt * 32 + r32) * 136 + k8 * 16 + hi * 8); acc[tt] = __builtin_amdgcn_mfma_f32_32x32x16_bf16(a, bb, acc[tt], 0, 0, 0); } }
    const int tb = wave >> 2;
#pragma unroll
    for (int tt = 0; tt < 2; ++tt)
#pragma unroll
      for (int r = 0; r < 16; ++r) { const int k2 = (wave & 3) * 32 + (r & 3) + 8 * (r >> 2) + 4 * hi;
        if (t0 < LL) p.PQT[((size_t)(b * 512 + g * 128 + k2)) * 8192 + tb * 4096 + t0 + tt * 32 + r32] = f2bf(acc[tt][r]);
        else p.PQTc[((size_t)(b * 512 + g * 128 + k2)) * 512 + tb * 256 + (t0 - LL) + tt * 32 + r32] = f2bf(acc[tt][r]); }
  }
}

DI int scan_row(int b, int dir, int s) { return s < LCX ? b * LT + LL + (dir ? LCX - 1 - s : s) : b * LT + (dir ? LL - 1 - (s - LCX) : (s - LCX)); }

DI void st_dnscan(const Prm& p, float* lds, int bid, int nb) {
  const int tid = ltid(), cc = tid >> 3, part = tid & 7;
  for (int item = bid; item < 128; item += nb) {
    const int chain = item >> 1, half = item & 1, b = chain >> 3, h = (chain >> 1) & 3, dir = chain & 1;
    f32x2 S[8];
#pragma unroll
    for (int j = 0; j < 8; ++j) S[j] = (f32x2){0.f, 0.f};
    constexpr int QP = 132, OQ = 0, OK_ = 32 * QP, OV = 2 * 32 * QP, OG = OV + 2048, OO = OG + 64, BUF = OO + 2048;
    bf16x8 pf[3]; float pg = 0.f;
    auto gload = [&](int batch) {
#pragma unroll
      for (int r = 0; r < 3; ++r) { const int e = tid + NTHR * r; if (e < 1280) { const int i = e / 40, ch = e - i * 40; const int row = scan_row(b, dir, batch * 32 + i);
          const int col = ch < 16 ? h * 128 + ch * 8 : (ch < 32 ? 512 + h * 128 + (ch - 16) * 8 : 1024 + h * 128 + half * 64 + (ch - 32) * 8);
          pf[r] = *(const bf16x8*)(p.DNQ + (size_t)row * 1536 + col); } }
      if (tid < 64) { const int i = tid >> 1, wh = tid & 1; const int row = scan_row(b, dir, batch * 32 + i); pg = p.GB[(size_t)row * 16 + wh * 8 + dir * 4 + h]; }
    };
    auto lstore = [&](float* bufp) {
#pragma unroll
      for (int r = 0; r < 3; ++r) { const int e = tid + NTHR * r; if (e < 1280) { const int i = e / 40, ch = e - i * 40;
          float* d = ch < 16 ? bufp + OQ + i * QP + ch * 8 + (ch >> 3) * 4 : (ch < 32 ? bufp + OK_ + i * QP + (ch - 16) * 8 + ((ch - 16) >> 3) * 4 : bufp + OV + i * 64 + (ch - 32) * 8);
#pragma unroll
          for (int j = 0; j < 8; ++j) d[j] = bf2f((bf16_t)pf[r][j]); } }
      if (tid < 64) { const int i = tid >> 1, wh = tid & 1; bufp[OG + i * 2 + wh] = wh ? pg : expf(pg); }
    };
    __syncthreads();
    gload(0); lstore(lds); __syncthreads();
    const int poff = part * 16 + (part >> 2) * 4;
    for (int batch = 0; batch < LT / 32; ++batch) {
      float* cur = lds + (batch & 1) * BUF; float* nxt = lds + ((batch + 1) & 1) * BUF;
      if (batch + 1 < LT / 32) gload(batch + 1);
      const float* q_s = cur + OQ + poff; const float* k_s = cur + OK_ + poff; const float* v_s = cur + OV + cc; const float* gb_s = cur + OG; float* o_s = cur + OO;
      f32x4 kn[4], qn[4]; f32x2 abn; float vvn;
#pragma unroll
      for (int j = 0; j < 4; ++j) { kn[j] = *(const f32x4*)(k_s + j * 4); qn[j] = *(const f32x4*)(q_s + j * 4); }
      abn = *(const f32x2*)gb_s; vvn = v_s[0];
#pragma unroll 2
      for (int i = 0; i < 32; ++i) {
        f32x2 k2[8], q2[8];
#pragma unroll
        for (int j = 0; j < 4; ++j) { k2[2 * j] = (f32x2){kn[j][0], kn[j][1]}; k2[2 * j + 1] = (f32x2){kn[j][2], kn[j][3]}; q2[2 * j] = (f32x2){qn[j][0], qn[j][1]}; q2[2 * j + 1] = (f32x2){qn[j][2], qn[j][3]}; }
        const float a = abn[0], beta = abn[1], vv = vvn;
        { const int in = i < 31 ? i + 1 : 31;
#pragma unroll
          for (int j = 0; j < 4; ++j) { kn[j] = *(const f32x4*)(k_s + in * QP + j * 4); qn[j] = *(const f32x4*)(q_s + in * QP + j * 4); }
          abn = *(const f32x2*)(gb_s + in * 2); vvn = v_s[in * 64]; }
        f32x2 d0 = k2[0] * S[0], d1 = k2[1] * S[1];
#pragma unroll
        for (int j = 2; j < 8; j += 2) { d0 += k2[j] * S[j]; d1 += k2[j + 1] * S[j + 1]; }
        d0 += d1; const float ks = a * red8(d0[0] + d0[1]);
        const float vn = beta * (vv - ks); const f32x2 vn2 = (f32x2){vn, vn}, a2 = (f32x2){a, a};
        f32x2 o0 = (f32x2){0.f, 0.f}, o1 = (f32x2){0.f, 0.f};
#pragma unroll
        for (int j = 0; j < 8; j += 2) { S[j] = S[j] * a2 + k2[j] * vn2; S[j + 1] = S[j + 1] * a2 + k2[j + 1] * vn2; o0 += q2[j] * S[j]; o1 += q2[j + 1] * S[j + 1]; }
        o0 += o1; const float o = red8(o0[0] + o0[1]);
        if (part == 0) o_s[i * 64 + cc] = o;
      }
      __syncthreads();
      { const int i = tid >> 4, c4 = (tid & 15) * 4; const int row = scan_row(b, dir, batch * 32 + i); const float* s = o_s + i * 64 + c4;
        u32x2 w; w.x = pack2(s[0], s[1]); w.y = pack2(s[2], s[3]);
        *(u32x2*)(p.OB + ((size_t)(0 * 2 + dir) * MR + row) * 512 + h * 128 + half * 64 + c4) = w; }
      if (batch + 1 < LT / 32) lstore(nxt);
      __syncthreads();
    }
  }
}

DI void st_glascan(const Prm& p, int layer, float* lds, int bid, int nb) {
  const int tid = ltid(), c = tid >> 2, part = tid & 3;
  for (int chain = bid; chain < 64; chain += nb) {
    const int b = chain >> 3, h = (chain >> 1) & 3, dir = chain & 1;
    const float* w2 = p.gla_w2 + (size_t)(layer * 2 + dir) * 16 * 256 + h * 64; const float* b2 = p.gla_b2 + (layer * 2 + dir) * 256 + h * 64;
    f32x2 S[8];
#pragma unroll
    for (int j = 0; j < 8; ++j) S[j] = (f32x2){0.f, 0.f};
    constexpr int BUF = 2048 * 3 + 4096 * 2 + 512;
    bf16x8 pf[3];
    auto gload = [&](int batch) {
#pragma unroll
      for (int r = 0; r < 3; ++r) { const int e = tid + NTHR * r; if (e < 1088) { const int i = e / 34, ch = e - i * 34; const int row = scan_row(b, dir, batch * 32 + i);
          const int col = ch < 8 ? C_GQ + h * 64 + ch * 8 : (ch < 16 ? C_GK + h * 64 + (ch - 8) * 8 : (ch < 32 ? C_GV + h * 128 + (ch - 16) * 8 : C_GALPHA + dir * 16 + (ch - 32) * 8));
          pf[r] = *(const bf16x8*)(p.Z + (size_t)row * NZ + col); } }
    };
    auto lstore = [&](float* bufp) {
#pragma unroll
      for (int r = 0; r < 3; ++r) { const int e = tid + NTHR * r; if (e < 1088) { const int i = e / 34, ch = e - i * 34;
          float* d = ch < 8 ? bufp + i * 64 + ch * 8 : (ch < 16 ? bufp + 2048 + i * 64 + (ch - 8) * 8 : (ch < 32 ? bufp + 6144 + i * 128 + (ch - 16) * 8 : bufp + 14336 + i * 16 + (ch - 32) * 8));
          const float sc = ch < 8 ? 0.125f : 1.f;
#pragma unroll
          for (int j = 0; j < 8; ++j) d[j] = bf2f((bf16_t)pf[r][j]) * sc; } }
    };
    auto decay = [&](float* bufp) {
#pragma unroll
      for (int k = 0; k < 4; ++k) { const int e = tid + NTHR * k, i = e >> 6, d = e & 63; float zz = b2[d];
#pragma unroll
        for (int r = 0; r < 16; ++r) zz += bufp[14336 + i * 16 + r] * w2[r * 256 + d];
        const float nz = -zz; const float sp = nz > 20.f ? nz : log1pf(expf(nz));
        bufp[4096 + i * 64 + d] = expf(-sp * (1.f / 16.f)); }
    };
    __syncthreads();
    gload(0); lstore(lds); __syncthreads(); decay(lds); __syncthreads();
    for (int batch = 0; batch < LT / 32; ++batch) {
      float* cur = lds + (batch & 1) * BUF; float* nxt = lds + ((batch + 1) & 1) * BUF;
      if (batch + 1 < LT / 32) gload(batch + 1);
      const float* q_s = cur + part * 16; const float* k_s = cur + 2048 + part * 16; const float* a_s = cur + 4096 + part * 16; const float* v_s = cur + 6144 + c; float* o_s = cur + 10240;
#pragma unroll 2
      for (int i = 0; i < 32; ++i) {
        const float vv = v_s[i * 128]; const f32x2 v2 = (f32x2){vv, vv}; f32x2 o0 = (f32x2){0.f, 0.f}, o1 = (f32x2){0.f, 0.f};
#pragma unroll
        for (int j = 0; j < 4; ++j) { const f32x4 a4 = *(const f32x4*)(a_s + i * 64 + j * 4), k4 = *(const f32x4*)(k_s + i * 64 + j * 4), q4 = *(const f32x4*)(q_s + i * 64 + j * 4);
          S[2 * j] = S[2 * j] * (f32x2){a4[0], a4[1]} + (f32x2){k4[0], k4[1]} * v2; S[2 * j + 1] = S[2 * j + 1] * (f32x2){a4[2], a4[3]} + (f32x2){k4[2], k4[3]} * v2;
          o0 += (f32x2){q4[0], q4[1]} * S[2 * j]; o1 += (f32x2){q4[2], q4[3]} * S[2 * j + 1]; }
        o0 += o1; const float o = red4(o0[0] + o0[1]);
        if (part == 0) o_s[i * 128 + c] = o;
      }
      __syncthreads();
      { const int i = tid >> 4, c8 = (tid & 15) * 8; const int row = scan_row(b, dir, batch * 32 + i); const float* s = o_s + i * 128 + c8;
        u32x4 w; w.x = pack2(s[0], s[1]); w.y = pack2(s[2], s[3]); w.z = pack2(s[4], s[5]); w.w = pack2(s[6], s[7]);
        *(u32x4*)(p.OB + ((size_t)(1 * 2 + dir) * MR + row) * 512 + h * 128 + c8) = w; }
      if (batch + 1 < LT / 32) lstore(nxt);
      __syncthreads();
      if (batch + 1 < LT / 32) decay(nxt);
      __syncthreads();
    }
  }
}

DI void st_combine(const Prm& p, int layer, int bid, int nb) {
  const int wave = ltid() >> 6, lane = ltid() & 63;
  for (long task = (long)bid * 8 + wave; task < (long)MR * 8; task += (long)nb * 8) {
    const int row = (int)(task >> 3), mh = (int)(task & 7), mixer = mh >> 2, h = mh & 3;
    const unsigned f = *(const unsigned*)(p.OB + ((size_t)(mixer * 2 + 0) * MR + row) * 512 + h * 128 + lane * 2), g = *(const unsigned*)(p.OB + ((size_t)(mixer * 2 + 1) * MR + row) * 512 + h * 128 + lane * 2);
    const float o0 = bf2f((bf16_t)(f & 0xffffu)) + bf2f((bf16_t)(g & 0xffffu)), o1 = bf2f((bf16_t)(f >> 16)) + bf2f((bf16_t)(g >> 16));
    const float ss = wsum(o0 * o0 + o1 * o1), rstd = rsqrtf(ss * (1.f / 128.f) + EPSV);
    const float* w = (mixer ? p.gla_norm : p.dn_norm) + layer * 128 + lane * 2;
    const unsigned gz = *(const unsigned*)(p.Z + (size_t)row * NZ + (mixer ? C_GGATE : C_DNGATE) + h * 128 + lane * 2);
    const float g0 = bf2f((bf16_t)(gz & 0xffffu)), g1 = bf2f((bf16_t)(gz >> 16));
    *(unsigned*)(p.Y + (size_t)row * DM + mixer * 512 + h * 128 + lane * 2) = pack2(o0 * rstd * w[0] * siluf(g0), o1 * rstd * w[1] * siluf(g1));
  }
}

DI unsigned fkey(float f) { const unsigned u = __float_as_uint(f); return u ^ ((u >> 31) ? 0xffffffffu : 0x80000000u); }
DI int pcnt(unsigned long long m) { return __builtin_popcountll(m); }
DI int lanes_below(unsigned long long m) { return (int)__builtin_amdgcn_mbcnt_hi((unsigned)(m >> 32), __builtin_amdgcn_mbcnt_lo((unsigned)m, 0u)); }
DI void st_peertopk(const Prm& p, int layer, unsigned char* lds, int bid, int nb) {
  bf16_t* ks = (bf16_t*)lds;
  bf16_t* qt = (bf16_t*)(lds + 69632);
  float* sc = (float*)(lds + 69632);
  const int tid = ltid(), wave = tid >> 6, lane = tid & 63, r32 = lane & 31, hi = lane >> 5;
  float* selv = (float*)(lds + 69632 + 33280) + wave * 64; int* seli = (int*)(selv + 32);
  int hcur = -1;
  const int nchunk = MR / 32;
  for (int it = bid; it < 8 * nchunk; it += nb) {
    const int h = it / nchunk, chunk = it - h * nchunk, row0 = chunk * 32;
    __syncthreads();
    if (h != hcur) {
      const float* kg = p.peer_keys + ((size_t)(layer * 8 + h) * 2) * 128 * 128;
      for (int e = tid; e < 2 * 128 * 128; e += NTHR) { const int pn = e >> 7, k = e & 127; ks[pn * 136 + k] = f2bf(kg[e]); }
      hcur = h; }
    for (int e = tid; e < 1024; e += NTHR) { const int r = e >> 5, c8 = (e & 31) * 8; *(u32x4*)(qt + r * 264 + c8) = *(const u32x4*)(p.Qp + (size_t)(row0 + r) * DM + h * 256 + c8); }
    __syncthreads();
    { const int pt = wave >> 2, nt = wave & 3; f32x16 acc = {};
#pragma unroll
      for (int k8 = 0; k8 < 8; ++k8) { const bf16x8 a = *(const bf16x8*)(qt + r32 * 264 + pt * 128 + k8 * 16 + hi * 8), b = *(const bf16x8*)(ks + (pt * 128 + nt * 32 + r32) * 136 + k8 * 16 + hi * 8);
        acc = __builtin_amdgcn_mfma_f32_32x32x16_bf16(a, b, acc, 0, 0, 0); }
      __syncthreads();
#pragma unroll
      for (int r = 0; r < 16; ++r) sc[((r & 3) + 8 * (r >> 2) + 4 * hi) * 260 + pt * 128 + nt * 32 + r32] = acc[r]; }
    __syncthreads();
    for (int rr = 0; rr < 4; ++rr) {
      const int m = wave * 4 + rr, row = row0 + m;
      float s[2][2];
#pragma unroll
      for (int pp = 0; pp < 2; ++pp)
#pragma unroll
        for (int hh = 0; hh < 2; ++hh) s[pp][hh] = sc[m * 260 + pp * 128 + hh * 64 + lane];
      unsigned kk[2][2], T[2] = {0u, 0u}; bool dn[2] = {false, false};
#pragma unroll
      for (int pp = 0; pp < 2; ++pp) { kk[pp][0] = fkey(s[pp][0]); kk[pp][1] = fkey(s[pp][1]); }
      for (int bit = 31; bit >= 0; --bit) {
#pragma unroll
        for (int pp = 0; pp < 2; ++pp) { const unsigned c = T[pp] | (1u << bit); const int n = pcnt(__ballot(kk[pp][0] >= c)) + pcnt(__ballot(kk[pp][1] >= c));
          if (!dn[pp] && n >= 16) { T[pp] = c; dn[pp] = n == 16; } }
        if (dn[0] && dn[1]) break; }
#pragma unroll
      for (int pp = 0; pp < 2; ++pp) { const unsigned k0 = kk[pp][0], k1 = kk[pp][1], TT = T[pp];
        const unsigned long long g0 = __ballot(k0 > TT), g1 = __ballot(k1 > TT), e0 = __ballot(k0 == TT), e1 = __ballot(k1 == TT);
        const int ng0 = pcnt(g0), ng = ng0 + pcnt(g1), need = 16 - ng, ne0 = pcnt(e0);
        if (k0 > TT) { const int r = lanes_below(g0); selv[pp * 16 + r] = s[pp][0]; seli[pp * 16 + r] = lane; }
        if (k1 > TT) { const int r = ng0 + lanes_below(g1); selv[pp * 16 + r] = s[pp][1]; seli[pp * 16 + r] = lane + 64; }
        if (k0 == TT) { const int r = lanes_below(e0); if (r < need) { selv[pp * 16 + ng + r] = s[pp][0]; seli[pp * 16 + ng + r] = lane; } }
        if (k1 == TT) { const int r = ne0 + lanes_below(e1); if (r < need) { selv[pp * 16 + ng + r] = s[pp][1]; seli[pp * 16 + ng + r] = lane + 64; } } }
      __builtin_amdgcn_wave_barrier();
      float cd[4]; unsigned ck[4]; { const float sa = selv[lane >> 2]; const f32x4 sb = *(const f32x4*)(selv + 16 + (lane & 3) * 4);
#pragma unroll
        for (int q = 0; q < 4; ++q) { cd[q] = sa + sb[q]; ck[q] = fkey(cd[q]); } }
      unsigned T2 = 0u;
      for (int bit = 31; bit >= 0; --bit) { const unsigned c = T2 | (1u << bit);
        const int n = pcnt(__ballot(ck[0] >= c)) + pcnt(__ballot(ck[1] >= c)) + pcnt(__ballot(ck[2] >= c)) + pcnt(__ballot(ck[3] >= c));
        if (n >= 16) { T2 = c; if (n == 16) break; } }
      float mx = fmaxf(fmaxf(cd[0], cd[1]), fmaxf(cd[2], cd[3])); mx = wmax(mx);
      int base = 0; float esum = 0.f; const int ia = seli[lane >> 2]; int rk[4]; float ev[4];
#pragma unroll
      for (int q = 0; q < 4; ++q) { const unsigned long long g = __ballot(ck[q] > T2); rk[q] = ck[q] > T2 ? base + lanes_below(g) : 99; base += pcnt(g); }
#pragma unroll
      for (int q = 0; q < 4; ++q) { const unsigned long long g = __ballot(ck[q] == T2); if (ck[q] == T2) rk[q] = base + lanes_below(g); base += pcnt(g); }
#pragma unroll
      for (int q = 0; q < 4; ++q) { ev[q] = rk[q] < 16 ? __expf(cd[q] - mx) : 0.f; esum += ev[q]; }
      esum = wsum(esum); const float inv = 1.f / esum;
      int* orow = p.IDX + (size_t)row * 128 + h * 16; float* grow = p.GATE + (size_t)row * 128 + h * 16;
#pragma unroll
      for (int q = 0; q < 4; ++q) if (rk[q] < 16) { orow[rk[q]] = ia * 128 + seli[16 + (lane & 3) * 4 + q]; grow[rk[q]] = ev[q] * inv; }
      __builtin_amdgcn_wave_barrier();
    }
  }
}

constexpr float U_SC = 1024.f, V_SC = 16.f;
DI void st_cvt_tables(const Prm& p, int layer, int bid, int nb) {
  const size_t n16 = (size_t)16384 * DM / 16, stride = (size_t)nb * NTHR;
  const float* U = p.peer_u + (size_t)layer * 16384 * DM; const float* V = p.peer_v + (size_t)layer * 16384 * DM;
  for (size_t e = (size_t)bid * NTHR + ltid(); e < 2 * n16; e += stride) { const bool isv = e >= n16; const size_t k = isv ? e - n16 : e;
    const float* src = (isv ? V : U) + k * 16; const float sc = isv ? V_SC : U_SC; u32x4 w;
#pragma unroll
    for (int q = 0; q < 4; ++q) { const f32x4 a = *(const f32x4*)(src + q * 4) * sc; int r = 0;
      r = __builtin_amdgcn_cvt_pk_fp8_f32(a[0], a[1], r, false); r = __builtin_amdgcn_cvt_pk_fp8_f32(a[2], a[3], r, true); w[q] = (unsigned)r; }
    *(u32x4*)((unsigned char*)(isv ? p.Vb : p.Ub) + k * 16) = w; }
}

DI void st_peergather(const Prm& p, int layer, float* lds, int bid, int nb, bool dry = false) {
  const int tid = ltid(), wave = tid >> 6, lane = tid & 63;
  const unsigned char* Ub = (const unsigned char*)p.Ub; const unsigned char* Vb = (const unsigned char*)p.Vb;
  for (int row = bid; row < MR; row += nb) {
    const int b = row / LT, t = row - b * LT; const bool isc = t >= LL;
    if (isc && layer == 1) continue;
    f32x2 hv[16];
#pragma unroll
    for (int i = 0; i < 2; ++i) {
#pragma unroll
      for (int q = 0; q < 2; ++q) { const u32x4 w = *(const u32x4*)(p.H2 + (size_t)row * DM + i * 1024 + lane * 16 + q * 8);
#pragma unroll
        for (int k = 0; k < 4; ++k) hv[i * 8 + q * 4 + k] = (f32x2){__uint_as_float(w[k] << 16), __uint_as_float(w[k] & 0xffff0000u)}; } }
    f32x2 acc[16];
#pragma unroll
    for (int i = 0; i < 16; ++i) acc[i] = (f32x2){0.f, 0.f};
    const int myidx = lane < 16 ? p.IDX[(size_t)row * 128 + wave * 16 + lane] : 0; const float mygate = lane < 16 ? p.GATE[(size_t)row * 128 + wave * 16 + lane] : 0.f;
#pragma unroll 1
    for (int k0 = 0; k0 < 16; k0 += 4) {
      u32x4 uu[4][2], vv[4][2];
#pragma unroll
      for (int q = 0; q < 4; ++q) { const int e = __builtin_amdgcn_readfirstlane(__shfl(myidx, k0 + q));
        const unsigned char* ur = Ub + (size_t)e * DM + lane * 16; const unsigned char* vr = Vb + (size_t)e * DM + lane * 16;
#pragma unroll
        for (int i = 0; i < 2; ++i) { uu[q][i] = *(const u32x4*)(ur + i * 1024); vv[q][i] = *(const u32x4*)(vr + i * 1024); } }
#pragma unroll
      for (int q = 0; q < 4; ++q) { f32x2 d0 = (f32x2){0.f, 0.f}, d1 = (f32x2){0.f, 0.f};
#pragma unroll
        for (int i = 0; i < 2; ++i)
#pragma unroll
          for (int k = 0; k < 4; ++k) { d0 += __builtin_amdgcn_cvt_pk_f32_fp8((int)uu[q][i][k], false) * hv[i * 8 + k * 2]; d1 += __builtin_amdgcn_cvt_pk_f32_fp8((int)uu[q][i][k], true) * hv[i * 8 + k * 2 + 1]; }
        d0 += d1; float d = wsum(d0[0] + d0[1]) * (1.f / U_SC);
        const float wgt = __shfl(mygate, k0 + q) * 0.5f * d * (1.f + erff(d * 0.70710678118654752f)); const f32x2 w2 = (f32x2){wgt, wgt};
#pragma unroll
        for (int i = 0; i < 2; ++i)
#pragma unroll
          for (int k = 0; k < 4; ++k) { acc[i * 8 + k * 2] += w2 * __builtin_amdgcn_cvt_pk_f32_fp8((int)vv[q][i][k], false); acc[i * 8 + k * 2 + 1] += w2 * __builtin_amdgcn_cvt_pk_f32_fp8((int)vv[q][i][k], true); } }
    }
    __syncthreads();
#pragma unroll
    for (int i = 0; i < 2; ++i) { float* d = lds + wave * 2048 + i * 1024 + lane * 16;
#pragma unroll
      for (int k = 0; k < 4; ++k) *(f32x4*)(d + k * 4) = (f32x4){acc[i * 8 + k * 2][0], acc[i * 8 + k * 2][1], acc[i * 8 + k * 2 + 1][0], acc[i * 8 + k * 2 + 1][1]}; }
    __syncthreads();
    { const int col = tid * 4; f32x4 sum = (f32x4){0.f, 0.f, 0.f, 0.f};
#pragma unroll
      for (int w = 0; w < 8; ++w) sum += *(const f32x4*)(lds + w * 2048 + col);
      const f32x4 g2 = *(const f32x4*)(p.mod + ((size_t)layer * 9 + (isc ? 8 : b)) * NMOD + 5 * DM + col) * (1.f / V_SC);
      float* xr = p.X + (size_t)row * DM + col; if (!dry) *(f32x4*)xr = *(const f32x4*)xr + g2 * sum; }
  }
}

DI void st_final(const Prm& p, int bid, int nb) {
  const int wave = ltid() >> 6, lane = ltid() & 63;
  for (int r = bid * 8 + wave; r < NB * LL; r += nb * 8) {
    const int b = r / LL, t = r - b * LL; const float* src = p.X + (size_t)(b * LT + t) * DM;
    f32x4 v[8]; float ss = 0.f;
#pragma unroll
    for (int i = 0; i < 8; ++i) { v[i] = *(const f32x4*)(src + (i * 64 + lane) * 4); ss += v[i][0] * v[i][0] + v[i][1] * v[i][1] + v[i][2] * v[i][2] + v[i][3] * v[i][3]; }
    ss = wsum(ss); const float rstd = rsqrtf(ss * (1.f / 2048.f) + EPSV);
#pragma unroll
    for (int i = 0; i < 8; ++i) { const int col = (i * 64 + lane) * 4; *(f32x4*)(p.out + (size_t)r * DM + col) = v[i] * rstd * *(const f32x4*)(p.final_norm + col); }
  }
}

namespace att {
constexpr int NW = 8, QBLK = 32, KVBLK = 64;
constexpr float SCALE = 0.07216878364870322f;
constexpr float THR = 8.f;
constexpr int LDQ = 768, LDK = 1024, LDKR = 64, LDO = DM;
constexpr int SHM_V = KVBLK * 128 * 2, SHM_K = KVBLK * 128 * 2, SHM_KR = KVBLK * 64 * 2, SHM_ATTN = 2 * SHM_V + 2 * SHM_K + 2 * SHM_KR + NW * 64 * 4;
#define KSWZ(row, colB) ((row) * 256 + ((colB) ^ (((row) & 7) << 4)))
#define KRSWZ(row, colB) ((row) * 128 + ((colB) ^ ((((row) >> 1) & 7) << 4)))
#define SBAR() __builtin_amdgcn_sched_barrier(0)
DI int crow(int r, int hi) { return (r & 3) + 8 * (r >> 2) + 4 * hi; }
DI unsigned cvtpk(float lo, float hi) { unsigned r; asm volatile("v_cvt_pk_bf16_f32 %0, %1, %2" : "=v"(r) : "v"(lo), "v"(hi)); return r; }

DI void partialSM(f32x16& p0, f32x16& p1, float& m_reg, float& mn, float& alpha) {
  constexpr float C = SCALE * 1.4426950408889634f;
  float pmax = p0[0];
#pragma unroll
  for (int r = 1; r < 16; ++r) pmax = fmaxf(pmax, p0[r]);
#pragma unroll
  for (int r = 0; r < 16; ++r) pmax = fmaxf(pmax, p1[r]);
  { auto rr = __builtin_amdgcn_permlane32_swap(__float_as_uint(pmax), __float_as_uint(pmax), false, false);
    pmax = fmaxf(__uint_as_float(rr[0]), __uint_as_float(rr[1])); }
  if (__builtin_expect(__all(pmax - m_reg <= THR / SCALE), 1)) { mn = m_reg; alpha = 1.f; }
  else { mn = fmaxf(m_reg, pmax); alpha = __builtin_amdgcn_exp2f((m_reg - mn) * C); m_reg = mn; }
  const float mnC = -mn * C;
#pragma unroll
  for (int r = 0; r < 16; ++r) p0[r] = fmaf(p0[r], C, mnC);
#pragma unroll
  for (int r = 0; r < 16; ++r) p1[r] = fmaf(p1[r], C, mnC);
#pragma unroll
  for (int r = 0; r < 16; ++r) p0[r] = __builtin_amdgcn_exp2f(p0[r]);
}
DI void finishSM(f32x16& p0, f32x16& p1, float alpha, float& l_reg, bf16x8& pa0, bf16x8& pa1, bf16x8& pa2, bf16x8& pa3) {
#pragma unroll
  for (int r = 0; r < 16; ++r) p1[r] = __builtin_amdgcn_exp2f(p1[r]);
  float ps = 0;
#pragma unroll
  for (int r = 0; r < 16; ++r) ps += p0[r];
#pragma unroll
  for (int r = 0; r < 16; ++r) ps += p1[r];
  { auto rr = __builtin_amdgcn_permlane32_swap(__float_as_uint(ps), __float_as_uint(ps), false, false);
    ps = __uint_as_float(rr[0]) + __uint_as_float(rr[1]); }
  l_reg = l_reg * alpha + ps;
#define PK4(P, BASE, OUT) do { unsigned a0 = cvtpk(P[BASE + 0], P[BASE + 1]), a1 = cvtpk(P[BASE + 2], P[BASE + 3]);   \
    unsigned b0 = cvtpk(P[BASE + 4], P[BASE + 5]), b1 = cvtpk(P[BASE + 6], P[BASE + 7]);                              \
    auto r0 = __builtin_amdgcn_permlane32_swap(a0, b0, false, false); auto r1 = __builtin_amdgcn_permlane32_swap(a1, b1, false, false); \
    u32x4 w = {r0[0], r1[0], r0[1], r1[1]}; OUT = *reinterpret_cast<bf16x8*>(&w); } while (0)
  PK4(p0, 0, pa0); PK4(p0, 8, pa1); PK4(p1, 0, pa2); PK4(p1, 8, pa3);
#undef PK4
}
DI void qkt(f32x16& p0, f32x16& p1, const char* Ks, const char* KRs, const bf16x8* qr, int r32, int hi) {
  p0 = f32x16{}; p1 = f32x16{};
#pragma unroll
  for (int d0 = 0; d0 < 8; ++d0) { const int cb = (d0 * 16 + hi * 8) * 2;
    const bf16x8 b0 = *reinterpret_cast<const bf16x8*>(Ks + KSWZ(r32, cb));
    const bf16x8 b1 = *reinterpret_cast<const bf16x8*>(Ks + KSWZ(32 + r32, cb));
    p0 = __builtin_amdgcn_mfma_f32_32x32x16_bf16(b0, qr[d0], p0, 0, 0, 0);
    p1 = __builtin_amdgcn_mfma_f32_32x32x16_bf16(b1, qr[d0], p1, 0, 0, 0); }
#pragma unroll
  for (int d0 = 0; d0 < 4; ++d0) { const int cb = (d0 * 16 + hi * 8) * 2;
    const bf16x8 b0 = *reinterpret_cast<const bf16x8*>(KRs + KRSWZ(r32, cb));
    const bf16x8 b1 = *reinterpret_cast<const bf16x8*>(KRs + KRSWZ(32 + r32, cb));
    p0 = __builtin_amdgcn_mfma_f32_32x32x16_bf16(b0, qr[8 + d0], p0, 0, 0, 0);
    p1 = __builtin_amdgcn_mfma_f32_32x32x16_bf16(b1, qr[8 + d0], p1, 0, 0, 0); }
}
DI int v_st(int k, int c) { const int kk = (k & ~0xC) | ((k & 4) << 1) | ((k & 8) >> 1); return ((kk >> 3) * 4 + (c >> 5)) * 512 + ((kk & 7) * 32 + (c & 31)) * 2; }
DI int v_rd_base(int lane) { return ((lane & 3) << 3) | (((lane >> 2) & 3) << 6) | (((lane >> 4) & 1) << 5) | (((lane >> 5) & 1) << 8); }
constexpr int v_rd_off(int d0, int ks, int half) { return d0 * 512 + ks * 4096 + half * 2048; }
template <int OFF> DI s16x4 tr_read(int vb) { s16x4 r; asm volatile("ds_read_b64_tr_b16 %0, %1 offset:%2" : "=&v"(r) : "v"(vb), "i"(OFF) : "memory"); return r; }
template <int D0> DI void pv_one(f32x16& od, int vb, bf16x8 pa0, bf16x8 pa1, bf16x8 pa2, bf16x8 pa3) {
  const s16x4 l0 = tr_read<v_rd_off(D0, 0, 0)>(vb), h0 = tr_read<v_rd_off(D0, 0, 1)>(vb), l1 = tr_read<v_rd_off(D0, 1, 0)>(vb), h1 = tr_read<v_rd_off(D0, 1, 1)>(vb);
  const s16x4 l2 = tr_read<v_rd_off(D0, 2, 0)>(vb), h2 = tr_read<v_rd_off(D0, 2, 1)>(vb), l3 = tr_read<v_rd_off(D0, 3, 0)>(vb), h3 = tr_read<v_rd_off(D0, 3, 1)>(vb);
  asm volatile("s_waitcnt lgkmcnt(0)" ::: "memory"); SBAR();
#define PK(L, H) (bf16x8){L[0], L[1], L[2], L[3], H[0], H[1], H[2], H[3]}
  od = __builtin_amdgcn_mfma_f32_32x32x16_bf16(pa0, PK(l0, h0), od, 0, 0, 0);
  od = __builtin_amdgcn_mfma_f32_32x32x16_bf16(pa1, PK(l1, h1), od, 0, 0, 0);
  od = __builtin_amdgcn_mfma_f32_32x32x16_bf16(pa2, PK(l2, h2), od, 0, 0, 0);
  od = __builtin_amdgcn_mfma_f32_32x32x16_bf16(pa3, PK(l3, h3), od, 0, 0, 0);
#undef PK
}
DI void pv_d0(f32x16* o, int vb, bf16x8 pa0, bf16x8 pa1, bf16x8 pa2, bf16x8 pa3) {
  pv_one<0>(o[0], vb, pa0, pa1, pa2, pa3); pv_one<1>(o[1], vb, pa0, pa1, pa2, pa3); pv_one<2>(o[2], vb, pa0, pa1, pa2, pa3); pv_one<3>(o[3], vb, pa0, pa1, pa2, pa3);
}

DI void attn_body(const bf16_t* __restrict__ Qb, const bf16_t* __restrict__ Kh, const bf16_t* __restrict__ Vh, const bf16_t* __restrict__ KRh, bf16_t* __restrict__ Ob, int seq, int tpos0, char* lds) {
  const int tid = ltid(), wid = tid >> 6, lane = tid & 63, r32 = lane & 31, hi = lane >> 5;
  char* V_lds = lds; char* K_lds = lds + 2 * SHM_V; char* KR_lds = lds + 2 * SHM_V + 2 * SHM_K;
  float* ws = (float*)(lds + 2 * SHM_V + 2 * SHM_K + 2 * SHM_KR) + wid * 64; float* li_l = ws; float* al_l = ws + 32;
  float m_reg = -1e30f, l_reg = 0; f32x16 o[4] = {}; bf16x8 qr[12];
  const bf16_t* Qw = Qb + (long)(wid * QBLK + r32) * LDQ + hi * 8;
#pragma unroll
  for (int d0 = 0; d0 < 12; ++d0) qr[d0] = *reinterpret_cast<const bf16x8*>(Qw + d0 * 16);
  if (tpos0 >= 0) {
    const int t = tpos0 + wid * QBLK + r32;
#pragma unroll
    for (int hf = 0; hf < 2; ++hf) { const float pos = (float)(hf ? (t & 63) : (t >> 6));
#pragma unroll
      for (int j = 0; j < 8; ++j) { const float ang = pos * exp2f(-(float)(hi * 8 + j) * (13.287712379549449f / 16.f)); float sv, cv; sincosf(ang, &sv, &cv);
        const float x1 = bf2f((bf16_t)qr[8 + 2 * hf][j]), x2 = bf2f((bf16_t)qr[9 + 2 * hf][j]);
        qr[8 + 2 * hf][j] = (short)f2bf(x1 * cv - x2 * sv); qr[9 + 2 * hf][j] = (short)f2bf(x2 * cv + x1 * sv); } }
  }
  const int sr = tid >> 4, sc = (tid & 15) * 8, vst0 = v_st(sr, sc), vst1 = v_st(32 + sr, sc);
  const int krr = tid >> 3, krc = (tid & 7) * 8;
  const int vb0 = (int)(uintptr_t)V_lds + v_rd_base(lane);
  bf16x8 vs0, vs1, ks0, ks1, kr0;
#define SLOAD(k0) do { vs0 = *reinterpret_cast<const bf16x8*>(&Vh[(long)((k0) + sr) * LDK + sc]); vs1 = *reinterpret_cast<const bf16x8*>(&Vh[(long)((k0) + 32 + sr) * LDK + sc]); \
    ks0 = *reinterpret_cast<const bf16x8*>(&Kh[(long)((k0) + sr) * LDK + sc]); ks1 = *reinterpret_cast<const bf16x8*>(&Kh[(long)((k0) + 32 + sr) * LDK + sc]); \
    kr0 = *reinterpret_cast<const bf16x8*>(&KRh[(long)((k0) + krr) * LDKR + krc]); } while (0)
#define SWRITE(b) do { *(bf16x8*)(V_lds + (b) * SHM_V + vst0) = vs0; *(bf16x8*)(V_lds + (b) * SHM_V + vst1) = vs1; const int kc = sc * 2;               \
    *(bf16x8*)(K_lds + (b) * SHM_K + KSWZ(sr, kc)) = ks0; *(bf16x8*)(K_lds + (b) * SHM_K + KSWZ(32 + sr, kc)) = ks1;                       \
    *(bf16x8*)(KR_lds + (b) * SHM_KR + KRSWZ(krr, krc * 2)) = kr0; } while (0)
#define SWAIT() asm volatile("s_waitcnt vmcnt(0)" ::: "memory")
#define RESC(a) do { if (__any((a) < 1.f)) { if (hi == 0) al_l[r32] = (a); asm volatile("s_waitcnt lgkmcnt(0)" ::: "memory"); \
    _Pragma("unroll") for (int d = 0; d < 4; ++d) _Pragma("unroll") for (int r = 0; r < 16; ++r) o[d][r] *= al_l[crow(r, hi)]; } } while (0)
  f32x16 p0, p1; float mn, al; bf16x8 pa0, pa1, pa2, pa3; const int NT = seq / KVBLK;
  SLOAD(0); SWAIT(); SWRITE(0); __syncthreads();
  for (int j = 0; j < NT; ++j) {
    const int buf = j & 1; const bool more = j + 1 < NT;
    if (more) SLOAD((j + 1) * KVBLK);
    SBAR(); qkt(p0, p1, K_lds + buf * SHM_K, KR_lds + buf * SHM_KR, qr, r32, hi);
    partialSM(p0, p1, m_reg, mn, al); RESC(al);
    finishSM(p0, p1, al, l_reg, pa0, pa1, pa2, pa3); SBAR();
    pv_d0(o, vb0 + buf * SHM_V, pa0, pa1, pa2, pa3);
    if (more) { SWAIT(); SWRITE(buf ^ 1); }
    __syncthreads();
  }
  if (hi == 0) li_l[r32] = l_reg; asm volatile("s_waitcnt lgkmcnt(0)" ::: "memory");
  float rli[16];
#pragma unroll
  for (int r = 0; r < 16; ++r) rli[r] = __builtin_amdgcn_rcpf(li_l[crow(r, hi)]);
  bf16_t* Ow = Ob + (long)(wid * QBLK) * LDO;
#pragma unroll
  for (int r = 0; r < 16; ++r) { const int orow = crow(r, hi);
#pragma unroll
    for (int d0 = 0; d0 < 4; ++d0) Ow[(long)orow * LDO + d0 * 32 + r32] = f2bf(o[d0][r] * rli[r]); }
  __syncthreads();
#undef SLOAD
#undef SWRITE
#undef SWAIT
#undef RESC
}
}

DI void st_attn(const Prm& p, int layer, char* lds, int bid, int nb) {
  const int nlat = NB * 4 * 16, nitem = nlat + (layer == 0 ? NB * 4 : 0);
  for (int it = bid; it < nitem; it += nb) {
    if (it < nlat) { const int b = it >> 6, h = (it >> 4) & 3, qb = it & 15; const size_t r0 = (size_t)b * LT;
      att::attn_body(p.Qraw + (r0 + qb * 256) * 768 + h * 192, p.KV + r0 * 1024 + h * 256, p.KV + r0 * 1024 + h * 256 + 128, p.KR + r0 * 64,
                     p.Y + (r0 + qb * 256) * DM + 1024 + h * 128, LT, qb * 256, lds); }
    else { const int k = it - nlat, b = k >> 2, h = k & 3; const size_t r0 = (size_t)b * LT + LL;
      att::attn_body(p.Qraw + r0 * 768 + h * 192, p.KV + r0 * 1024 + h * 256, p.KV + r0 * 1024 + h * 256 + 128, p.KR + r0 * 64, p.Y + r0 * DM + 1024 + h * 128, LCX, -1, lds); }
  }
}

struct EpiResid {
  static constexpr bool PERM = false, AFTER_DRAIN = false;
  const float* xlat; const float* xctx; float* X; const float* modl; int first;
  __device__ __forceinline__ void operator()(const pg8::f32x4 (&acc)[2][2][4][2], const pg8::Unit& u, int wr, int wc, int fr, int fq) const {
    const int b = u.pm / 17, tl = u.pm - b * 17; const bool isc = tl == 16;
    const float* g = modl + (size_t)(isc ? 8 : b) * NMOD + 2 * DM;
    const int rloc0 = wr * 64 + fr, col0 = u.pn * 256 + wc * 32 + 4 * fq;
    pg8::f32x4 gv[2][2];
#pragma unroll
    for (int bj = 0; bj < 2; ++bj)
#pragma unroll
      for (int n = 0; n < 2; ++n) gv[bj][n] = *(const pg8::f32x4*)(g + col0 + bj * 128 + n * 16);
#pragma unroll
    for (int ai = 0; ai < 2; ++ai)
#pragma unroll
      for (int m = 0; m < 4; ++m) { const int rl = rloc0 + ai * 128 + m * 16; const size_t row = (size_t)u.pm * 256 + rl;
        const float* src = first ? (isc ? xctx + ((size_t)b * LCX + rl) * DM : xlat + ((size_t)b * LL + tl * 256 + rl) * DM) : X + row * DM;
        float* dst = X + row * DM;
#pragma unroll
        for (int bj = 0; bj < 2; ++bj)
#pragma unroll
          for (int n = 0; n < 2; ++n) { const int c = col0 + bj * 128 + n * 16; *(pg8::f32x4*)(dst + c) = *(const pg8::f32x4*)(src + c) + gv[bj][n] * acc[ai][bj][m][n]; } }
  }
};

template <class Epi> DI void run_gemm(unsigned char* lds, const bf16_t* A, const bf16_t* Bt, int M, int N, int K, const Epi& E, int bid, int nb) {
  pg8::Gemm g; g.A = A; g.Bt = Bt; g.M = M; g.N = N; g.K = K;
  pg8::StaticOrder S; S.init(M, N, nb, bid);
  pg8::gemm_phase<Epi, pg8::StaticOrder, false>((PG8_LAS unsigned char*)lds, g, S, E, nullptr);
}
DI pg8::EpiBf16<0> epi_bf16(bf16_t* O, int ldc, int split_cols = 0, size_t split_stride = 0) { pg8::EpiBf16<0> e; e.O = O; e.ldc = ldc; e.bias = nullptr; e.split_cols = split_cols; e.split_stride = split_stride; return e; }

#ifndef PROBE
#define PROBE 0
#endif
constexpr int LDS_MAIN = 131072, LDS_TOTAL = LDS_MAIN + 64;
#define PRM() (*(const __attribute__((address_space(4))) Prm*)launder_k(kp))
typedef const __attribute__((address_space(4))) void* kptr_t;
DI kptr_t launder_k(kptr_t q) { asm volatile("" : "+s"(q)); return q; }
extern __shared__ __attribute__((aligned(16))) unsigned char shm[];
__global__ void __launch_bounds__(NTHR, 2) mega(Prm p_unused) {
#if defined(__HIP_DEVICE_COMPILE__)
  kptr_t kp = (kptr_t)__builtin_amdgcn_kernarg_segment_ptr();
  const int bid0 = blockIdx.x, nb0 = gridDim.x;
#define bid lsg(bid0)
#define nb lsg(nb0)
  uint4* xbw = (uint4*)(shm + LDS_MAIN);
  if (threadIdx.x == 0) *xbw = make_uint4(0u, 0u, 0u, 0u);
  __syncthreads();
  { const Prm p = PRM(); (void)xcd_barrier_post(p.bar, (volatile LAS unsigned*)xbw); }
#define GRID_BAR() do { XcdBarrier b_; b_.bar = PRM().bar; b_.x = xb_xcc_id(); b_.st = (volatile LAS unsigned*)(shm + LDS_MAIN); xcd_barrier(b_); } while (0)
  float* lf = (float*)shm;
  for (int ly = 0; ly < 2; ++ly) { const Prm p = PRM();
    st_transpose(p.w_in + (size_t)ly * DM * IN_W, p.WinT + (size_t)ly * NZ * DM, DM, IN_W, DM, NZ, lf, bid, nb);
    st_transpose(p.w_out + (size_t)ly * DM * DM, p.WoutT + (size_t)ly * DM * DM, DM, DM, DM, DM, lf, bid, nb);
    st_transpose(p.peer_wq + (size_t)ly * DM * DM, p.WqT + (size_t)ly * DM * DM, DM, DM, DM, DM, lf, bid, nb);
    st_transpose(p.mla_w_uq + (size_t)ly * 448 * 768, p.WuqT + (size_t)ly * 768 * 512, 448, 768, 512, 768, lf, bid, nb);
    st_transpose(p.mla_w_ukv + (size_t)ly * 128 * 1024, p.WukvT + (size_t)ly * 1024 * 256, 128, 1024, 256, 1024, lf, bid, nb);
  }
  { const Prm p = PRM(); st_tables(p, bid, nb); }
  __syncthreads();
  { const Prm p = PRM(); st_mods(p, lf, bid, nb); }
  if (PROBE == 5) { __syncthreads();
    for (int ly = 0; ly < 2; ++ly) { const Prm p = PRM();
      st_transpose(p.w_in + (size_t)ly * DM * IN_W, p.WinT + (size_t)ly * NZ * DM, DM, IN_W, DM, NZ, lf, bid, nb);
      st_transpose(p.w_out + (size_t)ly * DM * DM, p.WoutT + (size_t)ly * DM * DM, DM, DM, DM, DM, lf, bid, nb);
      st_transpose(p.peer_wq + (size_t)ly * DM * DM, p.WqT + (size_t)ly * DM * DM, DM, DM, DM, DM, lf, bid, nb); }
    { const Prm p = PRM(); st_tables(p, bid, nb); }
    __syncthreads();
    { const Prm p = PRM(); st_mods(p, lf, bid, nb); } }
  GRID_BAR();
  for (int l = 0; l < 2; ++l) {
    { const Prm p = PRM(); st_modulate(p, l, 0, p.H, bid, nb); }
    GRID_BAR();
    { const Prm p = PRM(); run_gemm(shm, p.H, p.WinT + (size_t)l * NZ * DM, MR, NZ, DM, epi_bf16(p.Z, NZ), bid, nb); }
    if (PROBE == 6) { const Prm p = PRM(); run_gemm(shm, p.H, p.WinT + (size_t)l * NZ * DM, MR, NZ, DM, epi_bf16(p.Z, NZ), bid, nb); }
    GRID_BAR();
    { const Prm p = PRM(); st_dnprep(p, l, bid, nb); }
    { const Prm p = PRM(); st_mlaprep(p, l, bid, nb); }
    { const Prm p = PRM(); st_fnchan(p, shm, bid, nb); }
    if (PROBE == 9) { { const Prm p = PRM(); st_dnprep(p, l, bid, nb); } { const Prm p = PRM(); st_mlaprep(p, l, bid, nb); } }
    if (PROBE == 10) { const Prm p = PRM(); st_fnchan(p, shm, bid, nb); }
    GRID_BAR();
    if (bid < 128) { const Prm p = PRM(); st_dnscan(p, lf, bid, 128); }
    else if (bid < 192) { const Prm p = PRM(); st_glascan(p, l, lf, bid - 128, 64); }
    else {
      const int b2 = bid - 192, n2 = nb - 192;
      { const Prm p = PRM(); run_gemm(shm, p.Aq, p.WuqT + (size_t)l * 768 * 512, MR, 768, 512, epi_bf16(p.Qraw, 768), b2, n2); }
      { const Prm p = PRM(); run_gemm(shm, p.Akv, p.WukvT + (size_t)l * 1024 * 256, MR, 1024, 256, epi_bf16(p.KV, 1024), b2, n2); }
    }
    if (PROBE == 7) { GRID_BAR(); if (bid < 128) { const Prm p = PRM(); st_dnscan(p, lf, bid, 128); } }
    if (PROBE == 8) { GRID_BAR(); if (bid < 64) { const Prm p = PRM(); st_glascan(p, l, lf, bid, 64); } }
    if (PROBE == 2) { GRID_BAR();
      if (bid < 128) { const Prm p = PRM(); st_dnscan(p, lf, bid, 128); }
      else if (bid < 192) { const Prm p = PRM(); st_glascan(p, l, lf, bid - 128, 64); } }
    GRID_BAR();
    { const Prm p = PRM(); st_attn(p, l, (char*)shm, bid, nb); }
    if (PROBE == 3) { const Prm p = PRM(); st_attn(p, l, (char*)shm, bid, nb); }
    { const Prm p = PRM(); run_gemm(shm, p.DFTM, p.PQT, 4096, 4096, 8192, epi_bf16(p.Y + 1536, DM, 512, (size_t)LT * DM), bid, nb); }
    if (l == 0) { const Prm p = PRM(); run_gemm(shm, p.DFTC, p.PQTc, 256, 4096, 512, epi_bf16(p.Y + (size_t)LL * DM + 1536, DM, 512, (size_t)LT * DM), bid, nb); }
    { const Prm p = PRM(); st_combine(p, l, bid, nb); }
    GRID_BAR();
    { const Prm p = PRM(); EpiResid e; e.xlat = p.x; e.xctx = p.ctx; e.X = p.X; e.modl = p.mod + (size_t)l * 9 * NMOD; e.first = l == 0;
      run_gemm(shm, p.Y, p.WoutT + (size_t)l * DM * DM, MR, DM, DM, e, bid, nb); }
    GRID_BAR();
    { const Prm p = PRM(); st_modulate(p, l, 1, p.H2, bid, nb); }
    { const Prm p = PRM(); st_cvt_tables(p, l, bid, nb); }
    GRID_BAR();
    { const Prm p = PRM(); run_gemm(shm, p.H2, p.WqT + (size_t)l * DM * DM, MR, DM, DM, epi_bf16(p.Qp, DM), bid, nb); }
    GRID_BAR();
    { const Prm p = PRM(); st_peertopk(p, l, shm, bid, nb); }
    if (PROBE == 4) { __syncthreads(); const Prm p = PRM(); st_peertopk(p, l, shm, bid, nb); }
    GRID_BAR();
    { const Prm p = PRM(); st_peergather(p, l, lf, bid, nb); }
    if (PROBE == 1) { __syncthreads(); const Prm p = PRM(); st_peergather(p, l, lf, bid, nb, true); }
    GRID_BAR();
  }
  { const Prm p = PRM(); st_final(p, bid, nb); }
#endif
#undef bid
#undef nb
#undef GRID_BAR
}

static size_t al256(size_t x) { return (x + 255) / 256 * 256; }
extern "C" void kernel_launch(void* const* d_in, const int* in_sizes, int n_in, void* d_out, int out_size, void* d_ws, size_t ws_size, hipStream_t stream) {
  Prm p{};
  const float** f = (const float**)&p.x;
  for (int i = 0; i < 24; ++i) f[i] = (const float*)d_in[i];
  p.out = (float*)d_out;
  char* w = (char*)d_ws; size_t o = 0;
  auto take = [&](size_t bytes) { char* r = w + o; o += al256(bytes); return r; };
  p.bar = (unsigned*)take(16384);
  p.WinT = (bf16_t*)take((size_t)2 * NZ * DM * 2); p.WoutT = (bf16_t*)take((size_t)2 * DM * DM * 2); p.WqT = (bf16_t*)take((size_t)2 * DM * DM * 2);
  p.WuqT = (bf16_t*)take((size_t)2 * 768 * 512 * 2); p.WukvT = (bf16_t*)take((size_t)2 * 1024 * 256 * 2);
  p.mod = (float*)take((size_t)2 * 9 * NMOD * 4); p.GB = (float*)take((size_t)MR * 16 * 4); p.CCS = (float*)take((size_t)2 * 128 * 128 * 4);
  p.DFTM = (bf16_t*)take((size_t)4096 * 8192 * 2); p.DFTC = (bf16_t*)take((size_t)256 * 512 * 2);
  p.X = (float*)take((size_t)MR * DM * 4);
  p.Z = (bf16_t*)take((size_t)MR * NZ * 2);
  char* ra = take((size_t)MR * 1536 * 2 + (size_t)4 * MR * 512 * 2);
  p.DNQ = (bf16_t*)ra; p.OB = (bf16_t*)(ra + (size_t)MR * 1536 * 2); p.H = (bf16_t*)ra;
  p.Ub = (bf16_t*)ra; p.Vb = (bf16_t*)(ra + (size_t)16384 * DM);
  p.KV = (bf16_t*)take((size_t)MR * 1024 * 2); p.KR = (bf16_t*)take((size_t)MR * 64 * 2);
  p.Aq = (bf16_t*)take((size_t)MR * 512 * 2); p.Akv = (bf16_t*)take((size_t)MR * 256 * 2);
  if (o > ws_size) return;
  char* q = (char*)d_out; size_t oo = 0;
  p.Y = (bf16_t*)q; oo += (size_t)MR * DM * 2; p.PQT = (bf16_t*)(q + oo); oo += (size_t)8 * 512 * 8192 * 2; p.PQTc = (bf16_t*)(q + oo); oo += (size_t)8 * 512 * 512 * 2;
  p.Qraw = (bf16_t*)(q + oo); oo += (size_t)MR * 768 * 2;
  char* z = (char*)p.Z; p.H2 = (bf16_t*)z; p.Qp = (bf16_t*)(z + (size_t)MR * DM * 2); p.IDX = (int*)(z + (size_t)2 * MR * DM * 2); p.GATE = (float*)(z + (size_t)2 * MR * DM * 2 + (size_t)MR * 128 * 4);

  static int grid = 0;
  if (!grid) {
    (void)hipFuncSetAttribute((const void*)mega, hipFuncAttributeMaxDynamicSharedMemorySize, LDS_TOTAL);
    int dev = 0, cus = 0, per_cu = 0;
    (void)hipGetDevice(&dev); (void)hipDeviceGetAttribute(&cus, hipDeviceAttributeMultiprocessorCount, dev);
    (void)hipOccupancyMaxActiveBlocksPerMultiprocessor(&per_cu, (const void*)mega, NTHR, LDS_TOTAL);
    grid = per_cu >= 1 ? cus : 0;
    if (grid > 256) grid = 256;
  }
  if (grid < 256) return;
  (void)hipMemsetAsync(p.bar, 0, XCD_BAR_WORDS * sizeof(unsigned), stream);
  hipLaunchKernelGGL(mega, dim3(grid), dim3(NTHR), LDS_TOTAL, stream, p);
}
```

```cpp
#include <hip/hip_runtime.h>
#include <stdint.h>

constexpr int DM = 2048, NB = 8, LL = 4096, LCX = 256, LT = LL + LCX  , MR = NB * LT  ;
constexpr int NZ = 4864;
constexpr int C_DNQ = 0, C_DNK = 512, C_DNV = 1024, C_DNGATE = 1536, C_DNA = 2048, C_DNB = 2056, C_GQ = 2064, C_GK = 2320, C_GV = 2576,
              C_GGATE = 3088, C_GALPHA = 3600, C_CQ = 3632, C_CKV = 4080, C_KR = 4208, C_FN = 4272, IN_W = 4784;
constexpr int NMOD = 6 * DM;
constexpr float EPSV = 1e-6f;
constexpr int NTHR = 512;

typedef unsigned short bf16_t;
typedef short bf16x8 __attribute__((ext_vector_type(8)));
typedef short s16x4 __attribute__((ext_vector_type(4)));
typedef float f32x4 __attribute__((ext_vector_type(4)));
typedef float f32x16 __attribute__((ext_vector_type(16)));
typedef unsigned u32x4 __attribute__((ext_vector_type(4)));
typedef unsigned u32x2 __attribute__((ext_vector_type(2)));

#define DI __device__ __forceinline__
DI float bf2f(bf16_t b) { return __uint_as_float(((unsigned)b) << 16); }
DI bf16_t f2bf(float f) { unsigned u = __float_as_uint(f); u += 0x7FFFu + ((u >> 16) & 1u); return (bf16_t)(u >> 16); }
DI unsigned pack2(float lo, float hi) { return (unsigned)f2bf(lo) | ((unsigned)f2bf(hi) << 16); }
typedef float f32x2 __attribute__((ext_vector_type(2)));
DI float dpp_x1(float v) { return __int_as_float(__builtin_amdgcn_mov_dpp(__float_as_int(v), 0xB1, 0xf, 0xf, true)); }
DI float dpp_x2(float v) { return __int_as_float(__builtin_amdgcn_mov_dpp(__float_as_int(v), 0x4E, 0xf, 0xf, true)); }
DI float dpp_hm(float v) { return __int_as_float(__builtin_amdgcn_mov_dpp(__float_as_int(v), 0x141, 0xf, 0xf, true)); }
DI float dpp_rm(float v) { return __int_as_float(__builtin_amdgcn_mov_dpp(__float_as_int(v), 0x140, 0xf, 0xf, true)); }
DI float red4(float v) { v += dpp_x1(v); v += dpp_x2(v); return v; }
DI float red8(float v) { v += dpp_x1(v); v += dpp_x2(v); v += dpp_hm(v); return v; }
DI float rdl(float v, int l) { return __int_as_float(__builtin_amdgcn_readlane(__float_as_int(v), l)); }
DI float wsum(float v) { v += dpp_x1(v); v += dpp_x2(v); v += dpp_hm(v); v += dpp_rm(v); return (rdl(v, 0) + rdl(v, 16)) + (rdl(v, 32) + rdl(v, 48)); }
DI float wmax(float v) { v = fmaxf(v, dpp_x1(v)); v = fmaxf(v, dpp_x2(v)); v = fmaxf(v, dpp_hm(v)); v = fmaxf(v, dpp_rm(v)); return fmaxf(fmaxf(rdl(v, 0), rdl(v, 16)), fmaxf(rdl(v, 32), rdl(v, 48))); }
DI float siluf(float x) { return x / (1.f + __expf(-x)); }
DI float sigmf(float x) { return 1.f / (1.f + __expf(-x)); }

DI int ltid() { int t = (int)threadIdx.x; asm volatile("" : "+v"(t)); return t; }
DI int lsg(int v) { asm volatile("" : "+s"(v)); return v; }

struct Prm {
  const float *x, *c, *ctx, *c_ctx, *w_ada, *b_ada, *w_in, *dn_conv, *dn_a_log, *dn_dt_bias, *dn_norm, *gla_w2, *gla_b2, *gla_norm,
      *mla_q_norm, *mla_w_uq, *mla_kv_norm, *mla_w_ukv, *w_out, *peer_wq, *peer_keys, *peer_u, *peer_v, *final_norm;
  float* out;
  bf16_t *WinT, *WoutT, *WqT, *WuqT, *WukvT;
  float *mod, *GB, *CCS;
  bf16_t *DFTM, *DFTC;
  float* X;
  bf16_t* Z;
  bf16_t *H, *DNQ, *OB;
  bf16_t *KV, *KR;
  bf16_t *Y, *PQT, *PQTc, *Qraw, *Aq, *Akv;
  bf16_t *H2, *Qp;
  bf16_t *Ub, *Vb;
  int* IDX;
  float* GATE;
  unsigned* bar;
};
#define XB_TMO      128
#define XB_XCNT(j)  (256  + 64 * (j))
#define XB_XSUB(j)  (1280 + 64 * (j))
#define XB_XGEN(j)  (2304 + 64 * (j))
#define XB_TOP      3328
#define XB_TOPGEN   3392
#define XCD_BAR_WORDS 3456
#define XB_SPIN_CAP (1u << 18)
#define LAS __attribute__((address_space(3)))

__device__ __forceinline__ unsigned xb_ld(unsigned* p)              { return __hip_atomic_load(p, __ATOMIC_RELAXED, __HIP_MEMORY_SCOPE_AGENT); }
__device__ __forceinline__ unsigned xb_add(unsigned* p, unsigned v) { return __hip_atomic_fetch_add(p, v, __ATOMIC_RELAXED, __HIP_MEMORY_SCOPE_AGENT); }
__device__ __forceinline__ unsigned xb_xcc_id() { return (unsigned)__builtin_amdgcn_s_getreg((3 << 11) | 20) & 0xFu; }
#define XB_SPIN(cond, bar) do { unsigned _sp = 0; while (cond) { __builtin_amdgcn_s_sleep(1); \
    if ((++_sp & 255u) == 0u) { if (xb_ld(&(bar)[XB_TMO])) break; if (_sp > XB_SPIN_CAP) { atomicAdd(&(bar)[XB_TMO], 1u); break; } } } } while (0)

struct XcdBarrier {
    unsigned* bar; unsigned x;
    volatile LAS unsigned* st;
};

__device__ __forceinline__ XcdBarrier xcd_barrier_post(unsigned* bar, volatile LAS unsigned* st) {
    XcdBarrier b; b.bar = bar; b.x = xb_xcc_id(); b.st = st;
    if (threadIdx.x == 0) (void)xb_add(&bar[XB_XCNT(b.x)], 1u);
    return b;
}
__device__ __forceinline__ void xcd_barrier_complete(unsigned* bar, unsigned x, unsigned& nloc, unsigned& nx) {
    const unsigned G = gridDim.x * gridDim.y * gridDim.z;
    unsigned sum, cnt, mine, sp = 0u;
    for (;;) {
        sum = 0u; cnt = 0u; mine = 0u;
#pragma unroll
        for (unsigned j = 0; j < 16; ++j) { const unsigned c = xb_ld(&bar[XB_XCNT(j)]); sum += c; cnt += (c > 0u) ? 1u : 0u; mine = (j == x) ? c : mine; }
        if (sum == G) break;
        __builtin_amdgcn_s_sleep(1);
        if ((++sp & 255u) == 0u) { if (xb_ld(&bar[XB_TMO])) break; if (sp > XB_SPIN_CAP) { atomicAdd(&bar[XB_TMO], 1u); break; } }
    }
    nloc = mine > 0u ? mine : 1u; nx = cnt > 0u ? cnt : 1u;
}

__device__ __forceinline__ void xcd_barrier(const XcdBarrier& b) {
    asm volatile("s_waitcnt vmcnt(0)" ::: "memory");
    __syncthreads();
    if (threadIdx.x == 0) {
        unsigned* bar = b.bar;
        __builtin_amdgcn_s_waitcnt(0);
        unsigned nloc = b.st[0], nx = b.st[1];
        if (nloc == 0u) { xcd_barrier_complete(bar, b.x, nloc, nx); b.st[0] = nloc; b.st[1] = nx; }
        const unsigned old = xb_add(&bar[XB_XSUB(b.x)], 1u);
        const unsigned gen = old / nloc;
        if (old + 1u == (gen + 1u) * nloc) {
            __builtin_amdgcn_fence(__ATOMIC_RELEASE, "agent");
            asm volatile("s_waitcnt vmcnt(0)" ::: "memory");
            const unsigned og = xb_add(&bar[XB_TOP], 1u);
            const unsigned tg = og / nx;
            if (og + 1u == (tg + 1u) * nx) xb_add(&bar[XB_TOPGEN], 1u);
            else XB_SPIN(xb_ld(&bar[XB_TOPGEN]) == tg, bar);
            __builtin_amdgcn_fence(__ATOMIC_ACQUIRE, "agent");
            xb_add(&bar[XB_XGEN(b.x)], 1u);
            asm volatile("s_waitcnt vmcnt(0)" ::: "memory");
        } else {
            XB_SPIN(xb_ld(&bar[XB_XGEN(b.x)]) == gen, bar);
            __builtin_amdgcn_fence(__ATOMIC_ACQUIRE, "agent");
            asm volatile("s_waitcnt vmcnt(0)" ::: "memory");
        }
    }
    __syncthreads();
}

namespace pg8 {
#define PG8_LAS __attribute__((address_space(3)))
typedef unsigned short bf16_t;
typedef short bf16x8 __attribute__((ext_vector_type(8)));
typedef float f32x4 __attribute__((ext_vector_type(4)));
typedef unsigned u32x4 __attribute__((ext_vector_type(4)));
constexpr int BM = 256, BK = 64, HALF = 128, HTB = HALF * BK * 2  , STAGE_BYTES = 8 * HTB, NXCD = 8, WGM = 8;

__host__ __device__ __forceinline__ int lds_byte(int r, int c) { const int st = (r >> 4) * 2 + (c >> 5), rr = r & 15, cc = c & 31, ob = rr * 64 + cc * 2; return st * 1024 + (ob ^ (((ob >> 9) & 1) << 5)); }
__host__ __device__ __forceinline__ void stage_rc(int b, int& R, int& C) { const int st = b / 1024, sb = b % 1024, swz = sb ^ (((sb >> 9) & 1) << 5); R = (st >> 1) * 16 + swz / 64; C = (st & 1) * 32 + (swz % 64) / 2; }
__host__ __device__ __forceinline__ int perm32(int rho) { const int n = rho >> 4, i = rho & 15; return 8 * (i >> 2) + 4 * n + (i & 3); }

struct Unit { int pm, pn; };
struct Gemm { const bf16_t* A; const bf16_t* Bt; int M, N, K; };

struct StaticOrder {
    int nM, nN, nwg, G, c;
    __host__ __device__ void init(int M, int N, int G_, int c_) { nM = M / BM; nN = N / BM; nwg = nM * nN; G = G_; c = c_; }
    __host__ __device__ bool next(int i, Unit& u) const {
        const long L = (long)i * G + c; if (L >= nwg) return false;
        int wgid = (int)L; { const int q = nwg / NXCD, r = nwg % NXCD, xcd = wgid % NXCD, off = wgid / NXCD; wgid = (xcd < r ? xcd * (q + 1) : r * (q + 1) + (xcd - r) * q) + off; }
        const int nig = WGM * nN, gid = wgid / nig, fm = gid * WGM, gsz = (nM - fm) < WGM ? (nM - fm) : WGM;
        u.pm = fm + ((wgid % nig) % gsz); u.pn = (wgid % nig) / gsz; return true;
    }
    __device__ __forceinline__ void a_ready(const Unit&) const {}
    __device__ __forceinline__ void done(const Unit&) const {}
};
struct CountedOrder : StaticOrder {
    const unsigned* ready; unsigned need; unsigned* tmo;
    __device__ __forceinline__ void a_ready(const Unit& u) const {
        if (threadIdx.x < 64) {
            const unsigned long long t0 = __builtin_amdgcn_s_memrealtime(); unsigned polls = 0;
            while ((unsigned)__builtin_amdgcn_readfirstlane(__hip_atomic_load(ready + 64 * u.pm, __ATOMIC_RELAXED, __HIP_MEMORY_SCOPE_AGENT)) < need) {
                if ((++polls & 255u) == 0u && __builtin_amdgcn_readfirstlane(__hip_atomic_load(tmo, __ATOMIC_RELAXED, __HIP_MEMORY_SCOPE_AGENT)) != 0u) break;
                if (__builtin_amdgcn_s_memrealtime() - t0 > 2000000ull) {
                    if (threadIdx.x == 0) { unsigned expect = 0u; __hip_atomic_compare_exchange_strong(tmo + 1, &expect, 0x600u | (unsigned)(u.pm & 0xff), __ATOMIC_RELAXED, __ATOMIC_RELAXED, __HIP_MEMORY_SCOPE_AGENT); __hip_atomic_store(tmo, 1u, __ATOMIC_RELAXED, __HIP_MEMORY_SCOPE_AGENT); }
                    break; }
                __builtin_amdgcn_s_sleep(2); }
            __builtin_amdgcn_fence(__ATOMIC_ACQUIRE, "agent");
            asm volatile("s_waitcnt vmcnt(0)" ::: "memory");
        }
#if !defined(BROKEN_HOOK_NO_BARRIER)
        asm volatile("" ::: "memory"); __builtin_amdgcn_s_barrier(); asm volatile("" ::: "memory");
#endif
    }
};

__device__ __forceinline__ unsigned cvt_pk_bf16(float lo, float hi) { unsigned r; asm volatile("v_cvt_pk_bf16_f32 %0, %1, %2" : "=v"(r) : "v"(lo), "v"(hi)); return r; }
typedef float f32x2 __attribute__((ext_vector_type(2)));
__device__ __forceinline__ f32x2 gelu_pk(f32x2 v) {
    const f32x2 av = __builtin_elementwise_abs(v), d = av * 0.2316418882f + 1.0f;
    f32x2 t; t.x = __builtin_amdgcn_rcpf(d.x); t.y = __builtin_amdgcn_rcpf(d.y);
    f32x2 q = t * 0.5307027145f + (-0.7265760135f); q = q * t + 0.7107068705f; q = q * t + (-0.142248368f); q = q * t + 0.127414796f; q = q * t;
    const f32x2 s = (v * v) * (-0.72134752044f);
    f32x2 e; e.x = __builtin_amdgcn_exp2f(s.x); e.y = __builtin_amdgcn_exp2f(s.y);
    const f32x2 m = v * (q * e), r = v - m;
    f32x2 o; o.x = v.x < 0.f ? m.x : r.x; o.y = v.y < 0.f ? m.y : r.y; return o;
}

struct EpiF32 {
    static constexpr bool PERM = false, AFTER_DRAIN = false;
    float* C; int ldc; const float* bias;
    __device__ __forceinline__ void operator()(const f32x4 (&acc)[2][2][4][2], const Unit& u, int wr, int wc, int fr, int fq) const {
        const int row0 = u.pm * BM + wr * 64 + fr, col0 = u.pn * BM + wc * 32 + 4 * fq;
        f32x4 bv[2][2];
#pragma unroll
        for (int bj = 0; bj < 2; ++bj)
#pragma unroll
            for (int n = 0; n < 2; ++n) bv[bj][n] = bias ? *(const f32x4*)(bias + col0 + bj * HALF + n * 16) : (f32x4){0.f, 0.f, 0.f, 0.f};
#pragma unroll
        for (int ai = 0; ai < 2; ++ai)
#pragma unroll
            for (int m = 0; m < 4; ++m) { float* rowp = C + (size_t)(row0 + ai * HALF + m * 16) * ldc + col0;
#pragma unroll
                for (int bj = 0; bj < 2; ++bj)
#pragma unroll
                    for (int n = 0; n < 2; ++n) *(f32x4*)(rowp + bj * HALF + n * 16) = acc[ai][bj][m][n] + bv[bj][n]; }
    }
};
template <int ACT  > struct EpiBf16 {
    static constexpr bool PERM = true, AFTER_DRAIN = false;
    bf16_t* O; int ldc; const float* bias; int split_cols; size_t split_stride;
    __device__ __forceinline__ void operator()(const f32x4 (&acc)[2][2][4][2], const Unit& u, int wr, int wc, int fr, int fq) const {
        const int row0 = u.pm * BM + wr * 64 + fr; int colt = u.pn * BM; bf16_t* base = O;
        if (split_cols) { const int t = colt / split_cols; base += (size_t)t * split_stride; colt -= t * split_cols; }
        const int col0 = colt + wc * 32 + 8 * fq, bcol0 = u.pn * BM + wc * 32 + 8 * fq;
        f32x4 bv[2][2];
#pragma unroll
        for (int bj = 0; bj < 2; ++bj)
#pragma unroll
            for (int n = 0; n < 2; ++n) bv[bj][n] = bias ? *(const f32x4*)(bias + bcol0 + bj * HALF + 4 * n) : (f32x4){0.f, 0.f, 0.f, 0.f};
#pragma unroll
        for (int ai = 0; ai < 2; ++ai)
#pragma unroll
            for (int m = 0; m < 4; ++m) { bf16_t* rowp = base + (size_t)(row0 + ai * HALF + m * 16) * ldc + col0;
#pragma unroll
                for (int bj = 0; bj < 2; ++bj) { f32x4 v0 = acc[ai][bj][m][0] + bv[bj][0], v1 = acc[ai][bj][m][1] + bv[bj][1];
                    if (ACT == 1) { f32x2 a = gelu_pk((f32x2){v0[0], v0[1]}), b = gelu_pk((f32x2){v0[2], v0[3]}), c = gelu_pk((f32x2){v1[0], v1[1]}), d = gelu_pk((f32x2){v1[2], v1[3]});
                        v0 = (f32x4){a.x, a.y, b.x, b.y}; v1 = (f32x4){c.x, c.y, d.x, d.y}; }
                    if (ACT == 2) {
#pragma unroll
                        for (int j = 0; j < 4; ++j) { v0[j] = 0.5f * v0[j] * (1.0f + erff(v0[j] * 0.70710678f)); v1[j] = 0.5f * v1[j] * (1.0f + erff(v1[j] * 0.70710678f)); } }
                    u32x4 w; w.x = cvt_pk_bf16(v0[0], v0[1]); w.y = cvt_pk_bf16(v0[2], v0[3]); w.z = cvt_pk_bf16(v1[0], v1[1]); w.w = cvt_pk_bf16(v1[2], v1[3]);
                    *(u32x4*)(rowp + bj * HALF) = w; } }
    }
};
template <class Epi, class Sched, bool STAMP = false>
__device__ __forceinline__ void gemm_phase(PG8_LAS unsigned char* lds, const Gemm g, const Sched& S, const Epi& E, unsigned long long* stamps) {
    const int tid = ltid(), wid = __builtin_amdgcn_readfirstlane(tid >> 6), lane = tid & 63, wr = wid >> 2, wc = wid & 3, fr = lane & 15, fq = lane >> 4;
    const int K = g.K, nt = K / BK;
    int ts_lo = 0, ts_hi = 0, nts = 0; const unsigned long long rt_entry = STAMP ? (unsigned long long)wall_clock64() : 0ull;
#define PG8_STAMP() do { if (STAMP && wid == 0 && nts < 64) { const unsigned long long _c = (unsigned long long)clock64(); \
        ts_lo = (lane == nts) ? (int)(unsigned)_c : ts_lo; ts_hi = (lane == nts) ? (int)(unsigned)(_c >> 32) : ts_hi; ++nts; } } while (0)
    PG8_STAMP();
    unsigned voffA[2], voffB[2];
#pragma unroll
    for (int i = 0; i < 2; ++i) { int R, C; stage_rc(tid * 16 + i * 8192, R, C); const int Rb = Epi::PERM ? ((R & ~31) + perm32(R & 31)) : R;
        voffA[i] = (unsigned)(R * K + C) * 2u; voffB[i] = (unsigned)(Rb * K + C) * 2u; }
    const size_t kstep = (size_t)(BK * 2);
    const size_t hstep = (size_t)HALF * K * 2;
    const size_t tstep = 2 * hstep;
    const unsigned ldsw = (unsigned)wid * 1024u;
    const int aoff = lds_byte(wr * 64 + fr, fq * 8), boff = lds_byte(wc * 32 + fr, fq * 8);
#define PG8_SA(b, h) (((b) * 2 + (h)) * HTB)
#define PG8_SB(b, h) ((4 + (b) * 2 + (h)) * HTB)
#define PG8_STAGE(bufoff, gbase, voff) do { _Pragma("unroll") for (int _i = 0; _i < 2; ++_i) \
        __builtin_amdgcn_global_load_lds((const unsigned*)((const char*)(gbase) + (voff)[_i]), (PG8_LAS unsigned*)(lds + (bufoff) + ldsw + _i * 8192), 16, 0, 0); } while (0)
#define PG8_LDA(dst, b, h) do { _Pragma("unroll") for (int m = 0; m < 4; ++m) _Pragma("unroll") for (int k = 0; k < 2; ++k) dst[m][k] = *(const PG8_LAS bf16x8*)(lds + PG8_SA(b, h) + aoff + m * 2048 + k * 1024); } while (0)
#define PG8_LDB(dst, b, h) do { _Pragma("unroll") for (int n = 0; n < 2; ++n) _Pragma("unroll") for (int k = 0; k < 2; ++k) dst[n][k] = *(const PG8_LAS bf16x8*)(lds + PG8_SB(b, h) + boff + n * 2048 + k * 1024); } while (0)
#define PG8_MMA(ai, bj, At, Bt) do { __builtin_amdgcn_s_setprio(1); _Pragma("unroll") for (int m = 0; m < 4; ++m) _Pragma("unroll") for (int n = 0; n < 2; ++n) _Pragma("unroll") for (int k = 0; k < 2; ++k) \
        acc[ai][bj][m][n] = __builtin_amdgcn_mfma_f32_16x16x32_bf16(Bt[n][k], At[m][k], acc[ai][bj][m][n], 0, 0, 0); __builtin_amdgcn_s_setprio(0); } while (0)
#define PG8_WAIT_V(n) asm volatile("s_waitcnt vmcnt(" #n ")" ::: "memory")
#define PG8_WAIT_L(n) asm volatile("s_waitcnt lgkmcnt(" #n ")" ::: "memory")
#define PG8_BAR __builtin_amdgcn_s_barrier()
#define PG8_SCHED __builtin_amdgcn_sched_barrier(0)
    Unit cur, nxt; int ui = 0;
    if (!S.next(0, cur)) return;
    f32x4 acc[2][2][4][2];
#pragma unroll
    for (int a = 0; a < 2; ++a)
#pragma unroll
        for (int b = 0; b < 2; ++b)
#pragma unroll
            for (int m = 0; m < 4; ++m)
#pragma unroll
                for (int n = 0; n < 2; ++n) acc[a][b][m][n] = (f32x4){0.f, 0.f, 0.f, 0.f};
    bf16x8 At[4][2], B0[2][2], B1[2][2];
    const char* cA = (const char*)g.A + (size_t)cur.pm * tstep; const char* cB = (const char*)g.Bt + (size_t)cur.pn * tstep;
    S.a_ready(cur);
    PG8_STAGE(PG8_SB(0, 0), cB, voffB); PG8_STAGE(PG8_SA(0, 0), cA, voffA); PG8_STAGE(PG8_SB(0, 1), cB + hstep, voffB); PG8_STAGE(PG8_SA(0, 1), cA + hstep, voffA);
    if (wr == 1) PG8_BAR;
    PG8_WAIT_V(4); PG8_BAR;
    PG8_STAGE(PG8_SB(1, 0), cB + kstep, voffB); PG8_STAGE(PG8_SA(1, 0), cA + kstep, voffA); PG8_STAGE(PG8_SB(1, 1), cB + hstep + kstep, voffB);
    PG8_WAIT_V(6); PG8_BAR;
    PG8_STAMP();
    for (;;) {
        const bool has_next = S.next(ui + 1, nxt);
        const char* nA = has_next ? (const char*)g.A + (size_t)nxt.pm * tstep : cA; const char* nB = has_next ? (const char*)g.Bt + (size_t)nxt.pn * tstep : cB;
        for (int t = 0; t < nt; t += 2) {
            const bool last = (t == nt - 2);
            const char* a1 = cA + (size_t)(t + 1) * kstep;
            const char* a2 = last ? nA : cA + (size_t)(t + 2) * kstep; const char* b2 = last ? nB : cB + (size_t)(t + 2) * kstep;
            const char* a3 = a2 + kstep; const char* b3 = b2 + kstep;
            if (last && has_next) S.a_ready(nxt);
            PG8_LDB(B0, 0, 0); PG8_SCHED; PG8_LDA(At, 0, 0); PG8_STAGE(PG8_SA(1, 1), a1 + hstep, voffA);
            PG8_WAIT_L(8); PG8_BAR; PG8_WAIT_L(0); PG8_MMA(0, 0, At, B0); PG8_BAR; PG8_SCHED;
            PG8_LDB(B1, 0, 1); PG8_STAGE(PG8_SB(0, 0), b2, voffB);
            PG8_BAR; PG8_WAIT_L(0); PG8_MMA(0, 1, At, B1); PG8_BAR;
            PG8_LDA(At, 0, 1); PG8_STAGE(PG8_SA(0, 0), a2, voffA);
            PG8_BAR; PG8_WAIT_L(0); PG8_MMA(1, 0, At, B0); PG8_BAR; PG8_SCHED;
            PG8_STAGE(PG8_SB(0, 1), b2 + hstep, voffB);
            PG8_WAIT_V(6); PG8_BAR; PG8_MMA(1, 1, At, B1); PG8_BAR;
            PG8_LDB(B0, 1, 0); PG8_SCHED; PG8_LDA(At, 1, 0); PG8_STAGE(PG8_SA(0, 1), a2 + hstep, voffA);
            PG8_WAIT_L(8); PG8_BAR; PG8_WAIT_L(0); PG8_MMA(0, 0, At, B0); PG8_BAR; PG8_SCHED;
            PG8_LDB(B1, 1, 1); PG8_STAGE(PG8_SB(1, 0), b3, voffB);
            PG8_BAR; PG8_WAIT_L(0); PG8_MMA(0, 1, At, B1); PG8_BAR;
            PG8_LDA(At, 1, 1); PG8_STAGE(PG8_SA(1, 0), a3, voffA);
            PG8_BAR; PG8_WAIT_L(0); PG8_MMA(1, 0, At, B0); PG8_BAR; PG8_SCHED;
            PG8_STAGE(PG8_SB(1, 1), b3 + hstep, voffB);
            PG8_WAIT_V(6); PG8_BAR; PG8_MMA(1, 1, At, B1); PG8_BAR;
        }
        PG8_STAMP();
        if constexpr (!Epi::AFTER_DRAIN) { E(acc, cur, wr, wc, fr, fq); S.done(cur); }
        PG8_STAMP();
        if (!has_next) break;
#pragma unroll
        for (int a = 0; a < 2; ++a)
#pragma unroll
            for (int b = 0; b < 2; ++b)
#pragma unroll
                for (int m = 0; m < 4; ++m)
#pragma unroll
                    for (int n = 0; n < 2; ++n) acc[a][b][m][n] = (f32x4){0.f, 0.f, 0.f, 0.f};
        cur = nxt; cA = nA; cB = nB; ++ui;
    }
    PG8_WAIT_V(0);
    if (wr == 0) PG8_BAR;
    PG8_BAR;
    if constexpr (Epi::AFTER_DRAIN) { E.fused(acc, cur, wr, wc, fr, fq, lds, wid, lane); S.done(cur); }
    PG8_STAMP();
    if (STAMP && wid == 0) { stamps[lane] = lane < nts ? (((unsigned long long)(unsigned)ts_hi << 32) | (unsigned)ts_lo) : 0ull;
        if (lane == 62) stamps[62] = rt_entry; if (lane == 63) stamps[63] = (unsigned long long)wall_clock64(); }
#undef PG8_STAMP
#undef PG8_SA
#undef PG8_SB
#undef PG8_STAGE
#undef PG8_LDA
#undef PG8_LDB
#undef PG8_MMA
#undef PG8_WAIT_V
#undef PG8_WAIT_L
#undef PG8_BAR
#undef PG8_SCHED
}
}

DI void st_transpose(const float* __restrict__ src, bf16_t* __restrict__ dst, int K, int N, int Kpad, int Npad, float* lds, int bid, int nb) {
  const int tk = Kpad / 64, tn = Npad / 64;
  for (int it = bid; it < tk * tn; it += nb) {
    const int k0 = (it % tk) * 64, n0 = (it / tk) * 64;
    __syncthreads();
    for (int e = ltid(); e < 4096; e += NTHR) { const int i = e >> 6, j = e & 63, k = k0 + i, n = n0 + j; lds[i * 65 + j] = (k < K && n < N) ? src[(size_t)k * N + n] : 0.f; }
    __syncthreads();
    for (int e = ltid(); e < 4096; e += NTHR) { const int j = e >> 6, i = e & 63; dst[(size_t)(n0 + j) * Kpad + k0 + i] = f2bf(lds[i * 65 + j]); }
  }
}

DI void st_mods(const Prm& p, float* lds, int bid, int nb) {
  float* s = lds; float* red = lds + 9 * 2048;
  for (int e = ltid(); e < 9 * 2048; e += NTHR) { const int r = e >> 11, k = e & 2047; const float v = r < 8 ? p.c[r * 2048 + k] : p.c_ctx[k]; s[e] = siluf(v); }
  __syncthreads();
  const int kg = ltid() >> 6, cl = ltid() & 63;
  for (int it = bid; it < 2 * 192; it += nb) {
    const int l = it / 192, cb = (it % 192) * 64;
    const float* w = p.w_ada + (size_t)l * 2048 * NMOD + cb + cl;
    float acc[9];
#pragma unroll
    for (int r = 0; r < 9; ++r) acc[r] = 0.f;
    for (int k = kg * 256; k < kg * 256 + 256; ++k) { const float wv = w[(size_t)k * NMOD];
#pragma unroll
      for (int r = 0; r < 9; ++r) acc[r] += s[r * 2048 + k] * wv; }
#pragma unroll
    for (int r = 0; r < 9; ++r) red[(kg * 9 + r) * 64 + cl] = acc[r];
    __syncthreads();
    for (int e = ltid(); e < 576; e += NTHR) { const int r = e >> 6, c2 = e & 63; float t = 0.f;
      for (int g = 0; g < 8; ++g) t += red[(g * 9 + r) * 64 + c2];
      p.mod[((size_t)l * 9 + r) * NMOD + cb + c2] = t + p.b_ada[l * NMOD + cb + c2]; }
    __syncthreads();
  }
}

DI void st_tables(const Prm& p, int bid, int nb) {
  const size_t stride = (size_t)nb * NTHR, t0 = (size_t)bid * NTHR + ltid();
  for (size_t e = t0; e < (size_t)4096 * 8192; e += stride) { const int k1 = (int)(e >> 13), n = (int)(e & 8191), n1 = n & 4095, idx = (k1 * n1) & 4095;
    float sv, cv; sincosf((float)idx * (6.283185307179586f / 4096.f), &sv, &cv); p.DFTM[e] = f2bf((n < 4096 ? cv : -sv) * (1.f / 64.f)); }
  for (size_t e = t0; e < (size_t)256 * 512; e += stride) { const int k1 = (int)(e >> 9), n = (int)(e & 511), n1 = n & 255, idx = (k1 * n1) & 255;
    float sv, cv; sincosf((float)idx * (6.283185307179586f / 256.f), &sv, &cv); p.DFTC[e] = f2bf((n < 256 ? cv : -sv) * (1.f / 16.f)); }
  for (size_t e = t0; e < (size_t)2 * 128 * 128; e += stride) { const int tb = (int)(e >> 14), k2 = (int)((e >> 7) & 127), n2 = (int)(e & 127), idx = (k2 * n2) & 127;
    float sv, cv; sincosf((float)idx * (6.283185307179586f / 128.f), &sv, &cv); p.CCS[e] = (tb ? sv : cv) * 0.08838834764831845f; }
}

DI void st_modulate(const Prm& p, int layer, int which, bf16_t* __restrict__ dst, int bid, int nb) {
  const int wave = ltid() >> 6, lane = ltid() & 63;
  const int shoff = which ? 3 * DM : 0, scoff = which ? 4 * DM : DM;
  for (int row = bid * 8 + wave; row < MR; row += nb * 8) {
    const int b = row / LT, t = row - b * LT; const bool isc = t >= LL;
    const float* src = (layer == 0 && which == 0) ? (isc ? p.ctx + (size_t)(b * LCX + t - LL) * DM : p.x + (size_t)(b * LL + t) * DM) : p.X + (size_t)row * DM;
    f32x4 v[8]; float ss = 0.f;
#pragma unroll
    for (int i = 0; i < 8; ++i) { v[i] = *(const f32x4*)(src + (i * 64 + lane) * 4); ss += v[i][0] * v[i][0] + v[i][1] * v[i][1] + v[i][2] * v[i][2] + v[i][3] * v[i][3]; }
    ss = wsum(ss); const float rstd = rsqrtf(ss * (1.f / 2048.f) + EPSV);
    const float* mr = p.mod + ((size_t)layer * 9 + (isc ? 8 : b)) * NMOD;
#pragma unroll
    for (int i = 0; i < 8; ++i) { const int col = (i * 64 + lane) * 4; const f32x4 sc = *(const f32x4*)(mr + scoff + col), sh = *(const f32x4*)(mr + shoff + col);
      const f32x4 o = v[i] * rstd * (sc + 1.f) + sh; u32x2 w; w.x = pack2(o[0], o[1]); w.y = pack2(o[2], o[3]); *(u32x2*)(dst + (size_t)row * DM + col) = w; }
  }
}

DI void st_dnprep(const Prm& p, int layer, int bid, int nb) {
  const int wave = ltid() >> 6, lane = ltid() & 63;
  const float* conv = p.dn_conv + (size_t)layer * 5 * 1536;
  for (int task = bid * 8 + wave; task < (MR / 32) * 13; task += nb * 8) {
    const int tile = task / 13, grp = task - tile * 13, row0 = tile * 32;
    const int b = row0 / LT, t0 = row0 - b * LT; const bool isc = t0 >= LL;
    const int segt0 = isc ? t0 - LL : t0, seglen = isc ? LCX : LL;
    if (grp < 12) {
      const int c = grp * 128 + lane * 2;
      float w0[5], w1[5];
#pragma unroll
      for (int j = 0; j < 5; ++j) { w0[j] = conv[j * 1536 + c]; w1[j] = conv[j * 1536 + c + 1]; }
      unsigned zz[36];
#pragma unroll
      for (int r = 0; r < 36; ++r) { const int tt = segt0 + r - 2; zz[r] = (tt >= 0 && tt < seglen) ? *(const unsigned*)(p.Z + (size_t)(row0 + r - 2) * NZ + c) : 0u; }
#pragma unroll
      for (int r = 0; r < 32; ++r) { float a0 = 0.f, a1 = 0.f;
#pragma unroll
        for (int j = 0; j < 5; ++j) { a0 += __uint_as_float(zz[r + j] << 16) * w0[j]; a1 += __uint_as_float(zz[r + j] & 0xffff0000u) * w1[j]; }
        a0 = siluf(a0); a1 = siluf(a1);
        if (grp < 8) { const float ss = wsum(a0 * a0 + a1 * a1); const float sc = rsqrtf(ss + EPSV) * (grp < 4 ? 0.08838834764831845f : 1.f); a0 *= sc; a1 *= sc; }
        *(unsigned*)(p.DNQ + (size_t)(row0 + r) * 1536 + c) = pack2(a0, a1); }
    } else {
#pragma unroll
      for (int rr = 0; rr < 8; ++rr) { const int idx = lane + 64 * rr, row = row0 + (idx >> 4), wh = idx & 15, isb = wh >> 3, dh = wh & 7;
        const float z = bf2f(p.Z[(size_t)row * NZ + (isb ? C_DNB : C_DNA) + dh]); float o;
        if (!isb) { const float xx = z + p.dn_dt_bias[layer * 8 + dh]; const float sp = xx > 20.f ? xx : log1pf(expf(xx)); o = -expf(p.dn_a_log[layer * 8 + dh]) * sp; }
        else o = sigmf(z);
        p.GB[(size_t)row * 16 + wh] = o; }
    }
  }
}

DI void st_mlaprep(const Prm& p, int layer, int bid, int nb) {
  const int wave = ltid() >> 6, lane = ltid() & 63;
  const float* qn = p.mla_q_norm + layer * 448; const float* kvn = p.mla_kv_norm + layer * 128;
  for (int row = bid * 8 + wave; row < MR; row += nb * 8) {
    const bf16_t* z = p.Z + (size_t)row * NZ; const int b = row / LT, t = row - b * LT;
    float v[8]; float ss = 0.f;
#pragma unroll
    for (int k = 0; k < 8; ++k) v[k] = 0.f;
    if (lane < 56) { const u32x4 w = *(const u32x4*)(z + C_CQ + lane * 8);
#pragma unroll
      for (int k = 0; k < 4; ++k) { v[2 * k] = __uint_as_float(w[k] << 16); v[2 * k + 1] = __uint_as_float(w[k] & 0xffff0000u); ss += v[2 * k] * v[2 * k] + v[2 * k + 1] * v[2 * k + 1]; } }
    ss = wsum(ss); float rstd = rsqrtf(ss * (1.f / 448.f) + EPSV);
    { u32x4 o = {0u, 0u, 0u, 0u};
      if (lane < 56) { const f32x4 n0 = *(const f32x4*)(qn + lane * 8), n1 = *(const f32x4*)(qn + lane * 8 + 4);
        o.x = pack2(v[0] * rstd * n0[0], v[1] * rstd * n0[1]); o.y = pack2(v[2] * rstd * n0[2], v[3] * rstd * n0[3]); o.z = pack2(v[4] * rstd * n1[0], v[5] * rstd * n1[1]); o.w = pack2(v[6] * rstd * n1[2], v[7] * rstd * n1[3]); }
      *(u32x4*)(p.Aq + (size_t)row * 512 + lane * 8) = o; }
    ss = 0.f;
    if (lane < 16) { const u32x4 w = *(const u32x4*)(z + C_CKV + lane * 8);
#pragma unroll
      for (int k = 0; k < 4; ++k) { v[2 * k] = __uint_as_float(w[k] << 16); v[2 * k + 1] = __uint_as_float(w[k] & 0xffff0000u); ss += v[2 * k] * v[2 * k] + v[2 * k + 1] * v[2 * k + 1]; } }
    ss = wsum(ss); rstd = rsqrtf(ss * (1.f / 128.f) + EPSV);
    if (lane < 32) { u32x4 o = {0u, 0u, 0u, 0u};
      if (lane < 16) { const f32x4 n0 = *(const f32x4*)(kvn + lane * 8), n1 = *(const f32x4*)(kvn + lane * 8 + 4);
        o.x = pack2(v[0] * rstd * n0[0], v[1] * rstd * n0[1]); o.y = pack2(v[2] * rstd * n0[2], v[3] * rstd * n0[3]); o.z = pack2(v[4] * rstd * n1[0], v[5] * rstd * n1[1]); o.w = pack2(v[6] * rstd * n1[2], v[7] * rstd * n1[3]); }
      *(u32x4*)(p.Akv + (size_t)row * 256 + lane * 8) = o; }
    if (t < LL) {
      if (lane < 32) { const int half = lane >> 4, i = lane & 15; const float x1 = bf2f(z[C_KR + half * 32 + i]), x2 = bf2f(z[C_KR + half * 32 + 16 + i]);
        const float pos = (float)(half ? (t & 63) : (t >> 6)); const float ang = pos * exp2f(-(float)i * (13.287712379549449f / 16.f)); float sv, cv; sincosf(ang, &sv, &cv);
        p.KR[(size_t)row * 64 + half * 32 + i] = f2bf(x1 * cv - x2 * sv); p.KR[(size_t)row * 64 + half * 32 + 16 + i] = f2bf(x2 * cv + x1 * sv); }
    } else p.KR[(size_t)row * 64 + lane] = z[C_KR + lane];
  }
}

DI void st_qrope(const Prm& p, int bid, int nb) {
  const int wave = ltid() >> 6, lane = ltid() & 63;
  for (int row = bid * 8 + wave; row < MR; row += nb * 8) {
    const int b = row / LT, t = row - b * LT; if (t >= LL) continue;
#pragma unroll
    for (int k = 0; k < 2; ++k) { const int pid = lane + 64 * k, h = pid >> 5, r = pid & 31, half = r >> 4, i = r & 15;
      bf16_t* q = p.Qraw + (size_t)row * 768 + h * 192 + 128 + half * 32; const float x1 = bf2f(q[i]), x2 = bf2f(q[16 + i]);
      const float pos = (float)(half ? (t & 63) : (t >> 6)); const float ang = pos * exp2f(-(float)i * (13.287712379549449f / 16.f)); float sv, cv; sincosf(ang, &sv, &cv);
      q[i] = f2bf(x1 * cv - x2 * sv); q[16 + i] = f2bf(x2 * cv + x1 * sv); }
  }
}

DI void st_fnchan(const Prm& p, unsigned char* lds, int bid, int nb) {
  bf16_t* wt = (bf16_t*)lds;
  bf16_t* zt = (bf16_t*)(lds + 256 * 272);
  const int tid = ltid(), wave = tid >> 6, lane = tid & 63, r32 = lane & 31, hi = lane >> 5;
  __syncthreads();
  for (int e = tid; e < 256 * 128; e += NTHR) wt[(e >> 7) * 136 + (e & 127)] = f2bf(p.CCS[e]);
  for (int it = bid; it < (MR / 64) * 4; it += nb) {
    const int tile = it >> 2, g = it & 3, row0 = tile * 64, b = row0 / LT, t0 = row0 - b * LT;
    __syncthreads();
    for (int e = tid; e < 1024; e += NTHR) { const int r = e >> 4, c8 = (e & 15) * 8; *(u32x4*)(zt + r * 136 + c8) = *(const u32x4*)(p.Z + (size_t)(row0 + r) * NZ + C_FN + g * 128 + c8); }
    __syncthreads();
    f32x16 acc[2] = {};
#pragma unroll
    for (int k8 = 0; k8 < 8; ++k8) { const bf16x8 a = *(const bf16x8*)(wt + (wave * 32 + r32) * 136 + k8 * 16 + hi * 8);
#pragma unroll
      for (int tt = 0; tt < 2; ++tt) { const bf16x8 bb = *(const bf16x8*)(zt + (tt * 32 + r32) * 136 + k8 * 16 + hi * 8); acc[tt] = __builtin_amdgcn_mfma_f32_32x32x16_bf16(a, bb, acc[tt], 0, 0, 0); } }
    const int tb = wave >> 2;
#pragma unroll
    for (int tt = 0; tt < 2; ++tt)
#pragma unroll
      for (int r = 0; r < 16; ++r) { const int k2 = (wave & 3) * 32 + (r & 3) + 8 * (r >> 2) + 4 * hi;
        if (t0 < LL) p.PQT[((size_t)(b * 512 + g * 128 + k2)) * 8192 + tb * 4096 + t0 + tt * 32 + r32] = f2bf(acc[tt][r]);
        else p.PQTc[((size_t)(b * 512 + g * 128 + k2)) * 512 + tb * 256 + (t0 - LL) + tt * 32 + r32] = f2bf(acc[tt][r]); }
  }
}

DI int scan_row(int b, int dir, int s) { return s < LCX ? b * LT + LL + (dir ? LCX - 1 - s : s) : b * LT + (dir ? LL - 1 - (s - LCX) : (s - LCX)); }

DI void st_dnscan(const Prm& p, float* lds, int bid, int nb) {
  const int tid = ltid(), cc = tid >> 3, part = tid & 7;
  for (int item = bid; item < 128; item += nb) {
    const int chain = item >> 1, half = item & 1, b = chain >> 3, h = (chain >> 1) & 3, dir = chain & 1;
    f32x2 S[8];
#pragma unroll
    for (int j = 0; j < 8; ++j) S[j] = (f32x2){0.f, 0.f};
    constexpr int QP = 132, OQ = 0, OK_ = 32 * QP, OV = 2 * 32 * QP, OG = OV + 2048, OO = OG + 64, BUF = OO + 2048;
    bf16x8 pf[3]; float pg = 0.f;
    auto gload = [&](int batch) {
#pragma unroll
      for (int r = 0; r < 3; ++r) { const int e = tid + NTHR * r; if (e < 1280) { const int i = e / 40, ch = e - i * 40; const int row = scan_row(b, dir, batch * 32 + i);
          const int col = ch < 16 ? h * 128 + ch * 8 : (ch < 32 ? 512 + h * 128 + (ch - 16) * 8 : 1024 + h * 128 + half * 64 + (ch - 32) * 8);
          pf[r] = *(const bf16x8*)(p.DNQ + (size_t)row * 1536 + col); } }
      if (tid < 64) { const int i = tid >> 1, wh = tid & 1; const int row = scan_row(b, dir, batch * 32 + i); pg = p.GB[(size_t)row * 16 + wh * 8 + dir * 4 + h]; }
    };
    auto lstore = [&](float* bufp) {
#pragma unroll
      for (int r = 0; r < 3; ++r) { const int e = tid + NTHR * r; if (e < 1280) { const int i = e / 40, ch = e - i * 40;
          float* d = ch < 16 ? bufp + OQ + i * QP + ch * 8 + (ch >> 3) * 4 : (ch < 32 ? bufp + OK_ + i * QP + (ch - 16) * 8 + ((ch - 16) >> 3) * 4 : bufp + OV + i * 64 + (ch - 32) * 8);
#pragma unroll
          for (int j = 0; j < 8; ++j) d[j] = bf2f((bf16_t)pf[r][j]); } }
      if (tid < 64) { const int i = tid >> 1, wh = tid & 1; bufp[OG + i * 2 + wh] = wh ? pg : expf(pg); }
    };
    __syncthreads();
    gload(0); lstore(lds); __syncthreads();
    const int poff = part * 16 + (part >> 2) * 4;
    for (int batch = 0; batch < LT / 32; ++batch) {
      float* cur = lds + (batch & 1) * BUF; float* nxt = lds + ((batch + 1) & 1) * BUF;
      if (batch + 1 < LT / 32) gload(batch + 1);
      const float* q_s = cur + OQ + poff; const float* k_s = cur + OK_ + poff; const float* v_s = cur + OV + cc; const float* gb_s = cur + OG; float* o_s = cur + OO;
      f32x4 kn[4], qn[4]; f32x2 abn; float vvn;
#pragma unroll
      for (int j = 0; j < 4; ++j) { kn[j] = *(const f32x4*)(k_s + j * 4); qn[j] = *(const f32x4*)(q_s + j * 4); }
      abn = *(const f32x2*)gb_s; vvn = v_s[0];
#pragma unroll 2
      for (int i = 0; i < 32; ++i) {
        f32x2 k2[8], q2[8];
#pragma unroll
        for (int j = 0; j < 4; ++j) { k2[2 * j] = (f32x2){kn[j][0], kn[j][1]}; k2[2 * j + 1] = (f32x2){kn[j][2], kn[j][3]}; q2[2 * j] = (f32x2){qn[j][0], qn[j][1]}; q2[2 * j + 1] = (f32x2){qn[j][2], qn[j][3]}; }
        const float a = abn[0], beta = abn[1], vv = vvn;
        { const int in = i < 31 ? i + 1 : 31;
#pragma unroll
          for (int j = 0; j < 4; ++j) { kn[j] = *(const f32x4*)(k_s + in * QP + j * 4); qn[j] = *(const f32x4*)(q_s + in * QP + j * 4); }
          abn = *(const f32x2*)(gb_s + in * 2); vvn = v_s[in * 64]; }
        f32x2 d0 = k2[0] * S[0], d1 = k2[1] * S[1];
#pragma unroll
        for (int j = 2; j < 8; j += 2) { d0 += k2[j] * S[j]; d1 += k2[j + 1] * S[j + 1]; }
        d0 += d1; const float ks = a * red8(d0[0] + d0[1]);
        const float vn = beta * (vv - ks); const f32x2 vn2 = (f32x2){vn, vn}, a2 = (f32x2){a, a};
        f32x2 o0 = (f32x2){0.f, 0.f}, o1 = (f32x2){0.f, 0.f};
#pragma unroll
        for (int j = 0; j < 8; j += 2) { S[j] = S[j] * a2 + k2[j] * vn2; S[j + 1] = S[j + 1] * a2 + k2[j + 1] * vn2; o0 += q2[j] * S[j]; o1 += q2[j + 1] * S[j + 1]; }
        o0 += o1; const float o = red8(o0[0] + o0[1]);
        if (part == 0) o_s[i * 64 + cc] = o;
      }
      __syncthreads();
      { const int i = tid >> 4, c4 = (tid & 15) * 4; const int row = scan_row(b, dir, batch * 32 + i); const float* s = o_s + i * 64 + c4;
        u32x2 w; w.x = pack2(s[0], s[1]); w.y = pack2(s[2], s[3]);
        *(u32x2*)(p.OB + ((size_t)(0 * 2 + dir) * MR + row) * 512 + h * 128 + half * 64 + c4) = w; }
      if (batch + 1 < LT / 32) lstore(nxt);
      __syncthreads();
    }
  }
}

DI void st_glascan(const Prm& p, int layer, float* lds, int bid, int nb) {
  const int tid = ltid(), cc = tid >> 3, part = tid & 7;
  for (int item = bid; item < 128; item += nb) {
    const int chain = item >> 1, half = item & 1, b = chain >> 3, h = (chain >> 1) & 3, dir = chain & 1;
    const float* w2 = p.gla_w2 + (size_t)(layer * 2 + dir) * 16 * 256 + h * 64; const float* b2 = p.gla_b2 + (layer * 2 + dir) * 256 + h * 64;
    f32x2 S[4];
#pragma unroll
    for (int j = 0; j < 4; ++j) S[j] = (f32x2){0.f, 0.f};
    constexpr int OQ = 0, OK_ = 2048, OA = 4096, OV = 6144, OO = 8192, OAL = 10240, BUF = 10752;
    bf16x8 pf[2];
    auto gload = [&](int batch) {
#pragma unroll
      for (int r = 0; r < 2; ++r) { const int e = tid + NTHR * r; if (e < 832) { const int i = e / 26, ch = e - i * 26; const int row = scan_row(b, dir, batch * 32 + i);
          const int col = ch < 8 ? C_GQ + h * 64 + ch * 8 : (ch < 16 ? C_GK + h * 64 + (ch - 8) * 8 : (ch < 24 ? C_GV + h * 128 + half * 64 + (ch - 16) * 8 : C_GALPHA + dir * 16 + (ch - 24) * 8));
          pf[r] = *(const bf16x8*)(p.Z + (size_t)row * NZ + col); } }
    };
    auto lstore = [&](float* bufp) {
#pragma unroll
      for (int r = 0; r < 2; ++r) { const int e = tid + NTHR * r; if (e < 832) { const int i = e / 26, ch = e - i * 26;
          float* d = ch < 8 ? bufp + OQ + i * 64 + ch * 8 : (ch < 16 ? bufp + OK_ + i * 64 + (ch - 8) * 8 : (ch < 24 ? bufp + OV + i * 64 + (ch - 16) * 8 : bufp + OAL + i * 16 + (ch - 24) * 8));
          const float sc = ch < 8 ? 0.125f : 1.f;
#pragma unroll
          for (int j = 0; j < 8; ++j) d[j] = bf2f((bf16_t)pf[r][j]) * sc; } }
    };
    auto decay = [&](float* bufp) {
#pragma unroll
      for (int k = 0; k < 4; ++k) { const int e = tid + NTHR * k, i = e >> 6, d = e & 63; float zz = b2[d];
#pragma unroll
        for (int r = 0; r < 16; ++r) zz += bufp[OAL + i * 16 + r] * w2[r * 256 + d];
        const float nz = -zz; const float sp = nz > 20.f ? nz : log1pf(expf(nz));
        bufp[OA + i * 64 + d] = expf(-sp * (1.f / 16.f)); }
    };
    __syncthreads();
    gload(0); lstore(lds); __syncthreads(); decay(lds); __syncthreads();
    for (int batch = 0; batch < LT / 32; ++batch) {
      float* cur = lds + (batch & 1) * BUF; float* nxt = lds + ((batch + 1) & 1) * BUF;
      if (batch + 1 < LT / 32) gload(batch + 1);
      const float* q_s = cur + OQ + part * 8; const float* k_s = cur + OK_ + part * 8; const float* a_s = cur + OA + part * 8; const float* v_s = cur + OV + cc; float* o_s = cur + OO;
      f32x4 an[2], kn[2], qn[2]; float vvn;
#pragma unroll
      for (int j = 0; j < 2; ++j) { an[j] = *(const f32x4*)(a_s + j * 4); kn[j] = *(const f32x4*)(k_s + j * 4); qn[j] = *(const f32x4*)(q_s + j * 4); }
      vvn = v_s[0];
#pragma unroll 2
      for (int i = 0; i < 32; ++i) {
        f32x4 a4[2], k4[2], q4[2];
#pragma unroll
        for (int j = 0; j < 2; ++j) { a4[j] = an[j]; k4[j] = kn[j]; q4[j] = qn[j]; }
        const float vv = vvn; const f32x2 v2 = (f32x2){vv, vv};
        { const int in = i < 31 ? i + 1 : 31;
#pragma unroll
          for (int j = 0; j < 2; ++j) { an[j] = *(const f32x4*)(a_s + in * 64 + j * 4); kn[j] = *(const f32x4*)(k_s + in * 64 + j * 4); qn[j] = *(const f32x4*)(q_s + in * 64 + j * 4); }
          vvn = v_s[in * 64]; }
        f32x2 o0 = (f32x2){0.f, 0.f}, o1 = (f32x2){0.f, 0.f};
#pragma unroll
        for (int j = 0; j < 2; ++j) {
          S[2 * j] = S[2 * j] * (f32x2){a4[j][0], a4[j][1]} + (f32x2){k4[j][0], k4[j][1]} * v2; S[2 * j + 1] = S[2 * j + 1] * (f32x2){a4[j][2], a4[j][3]} + (f32x2){k4[j][2], k4[j][3]} * v2;
          o0 += (f32x2){q4[j][0], q4[j][1]} * S[2 * j]; o1 += (f32x2){q4[j][2], q4[j][3]} * S[2 * j + 1]; }
        o0 += o1; const float o = red8(o0[0] + o0[1]);
        if (part == 0) o_s[i * 64 + cc] = o;
      }
      __syncthreads();
      { const int i = tid >> 4, c4 = (tid & 15) * 4; const int row = scan_row(b, dir, batch * 32 + i); const float* s = o_s + i * 64 + c4;
        u32x2 w; w.x = pack2(s[0], s[1]); w.y = pack2(s[2], s[3]);
        *(u32x2*)(p.OB + ((size_t)(1 * 2 + dir) * MR + row) * 512 + h * 128 + half * 64 + c4) = w; }
      if (batch + 1 < LT / 32) lstore(nxt);
      __syncthreads();
      if (batch + 1 < LT / 32) decay(nxt);
      __syncthreads();
    }
  }
}

DI void st_combine(const Prm& p, int layer, int bid, int nb) {
  const int wave = ltid() >> 6, lane = ltid() & 63;
  for (long task = (long)bid * 8 + wave; task < (long)MR * 8; task += (long)nb * 8) {
    const int row = (int)(task >> 3), mh = (int)(task & 7), mixer = mh >> 2, h = mh & 3;
    const unsigned f = *(const unsigned*)(p.OB + ((size_t)(mixer * 2 + 0) * MR + row) * 512 + h * 128 + lane * 2), g = *(const unsigned*)(p.OB + ((size_t)(mixer * 2 + 1) * MR + row) * 512 + h * 128 + lane * 2);
    const float o0 = bf2f((bf16_t)(f & 0xffffu)) + bf2f((bf16_t)(g & 0xffffu)), o1 = bf2f((bf16_t)(f >> 16)) + bf2f((bf16_t)(g >> 16));
    const float ss = wsum(o0 * o0 + o1 * o1), rstd = rsqrtf(ss * (1.f / 128.f) + EPSV);
    const float* w = (mixer ? p.gla_norm : p.dn_norm) + layer * 128 + lane * 2;
    const unsigned gz = *(const unsigned*)(p.Z + (size_t)row * NZ + (mixer ? C_GGATE : C_DNGATE) + h * 128 + lane * 2);
    const float g0 = bf2f((bf16_t)(gz & 0xffffu)), g1 = bf2f((bf16_t)(gz >> 16));
    *(unsigned*)(p.Y + (size_t)row * DM + mixer * 512 + h * 128 + lane * 2) = pack2(o0 * rstd * w[0] * siluf(g0), o1 * rstd * w[1] * siluf(g1));
  }
}

DI unsigned fkey(float f) { const unsigned u = __float_as_uint(f); return u ^ ((u >> 31) ? 0xffffffffu : 0x80000000u); }
DI int pcnt(unsigned long long m) { return __builtin_popcountll(m); }
DI int lanes_below(unsigned long long m) { return (int)__builtin_amdgcn_mbcnt_hi((unsigned)(m >> 32), __builtin_amdgcn_mbcnt_lo((unsigned)m, 0u)); }
DI void st_peertopk(const Prm& p, int layer, unsigned char* lds, int bid, int nb) {
  bf16_t* ks = (bf16_t*)lds;
  bf16_t* qt = (bf16_t*)(lds + 69632);
  float* sc = (float*)(lds + 69632);
  const int tid = ltid(), wave = tid >> 6, lane = tid & 63, r32 = lane & 31, hi = lane >> 5;
  float* selv = (float*)(lds + 69632 + 33280) + wave * 64; int* seli = (int*)(selv + 32);
  int hcur = -1;
  const int nchunk = MR / 32;
  for (int it = bid; it < 8 * nchunk; it += nb) {
    const int h = it / nchunk, chunk = it - h * nchunk, row0 = chunk * 32;
    __syncthreads();
    if (h != hcur) {
      const float* kg = p.peer_keys + ((size_t)(layer * 8 + h) * 2) * 128 * 128;
      for (int e = tid; e < 2 * 128 * 128; e += NTHR) { const int pn = e >> 7, k = e & 127; ks[pn * 136 + k] = f2bf(kg[e]); }
      hcur = h; }
    for (int e = tid; e < 1024; e += NTHR) { const int r = e >> 5, c8 = (e & 31) * 8; *(u32x4*)(qt + r * 264 + c8) = *(const u32x4*)(p.Qp + (size_t)(row0 + r) * DM + h * 256 + c8); }
    __syncthreads();
    { const int pt = wave >> 2, nt = wave & 3; f32x16 acc = {};
#pragma unroll
      for (int k8 = 0; k8 < 8; ++k8) { const bf16x8 a = *(const bf16x8*)(qt + r32 * 264 + pt * 128 + k8 * 16 + hi * 8), b = *(const bf16x8*)(ks + (pt * 128 + nt * 32 + r32) * 136 + k8 * 16 + hi * 8);
        acc = __builtin_amdgcn_mfma_f32_32x32x16_bf16(a, b, acc, 0, 0, 0); }
      __syncthreads();
#pragma unroll
      for (int r = 0; r < 16; ++r) sc[((r & 3) + 8 * (r >> 2) + 4 * hi) * 260 + pt * 128 + nt * 32 + r32] = acc[r]; }
    __syncthreads();
    for (int rr = 0; rr < 4; ++rr) {
      const int m = wave * 4 + rr, row = row0 + m;
      float s[2][2];
#pragma unroll
      for (int pp = 0; pp < 2; ++pp)
#pragma unroll
        for (int hh = 0; hh < 2; ++hh) s[pp][hh] = sc[m * 260 + pp * 128 + hh * 64 + lane];
      unsigned kk[2][2], T[2] = {0u, 0u}; bool dn[2] = {false, false};
#pragma unroll
      for (int pp = 0; pp < 2; ++pp) { kk[pp][0] = fkey(s[pp][0]); kk[pp][1] = fkey(s[pp][1]); }
      for (int bit = 31; bit >= 0; --bit) {
#pragma unroll
        for (int pp = 0; pp < 2; ++pp) { const unsigned c = T[pp] | (1u << bit); const int n = pcnt(__ballot(kk[pp][0] >= c)) + pcnt(__ballot(kk[pp][1] >= c));
          if (!dn[pp] && n >= 16) { T[pp] = c; dn[pp] = n == 16; } }
        if (dn[0] && dn[1]) break; }
#pragma unroll
      for (int pp = 0; pp < 2; ++pp) { const unsigned k0 = kk[pp][0], k1 = kk[pp][1], TT = T[pp];
        const unsigned long long g0 = __ballot(k0 > TT), g1 = __ballot(k1 > TT), e0 = __ballot(k0 == TT), e1 = __ballot(k1 == TT);
        const int ng0 = pcnt(g0), ng = ng0 + pcnt(g1), need = 16 - ng, ne0 = pcnt(e0);
        if (k0 > TT) { const int r = lanes_below(g0); selv[pp * 16 + r] = s[pp][0]; seli[pp * 16 + r] = lane; }
        if (k1 > TT) { const int r = ng0 + lanes_below(g1); selv[pp * 16 + r] = s[pp][1]; seli[pp * 16 + r] = lane + 64; }
        if (k0 == TT) { const int r = lanes_below(e0); if (r < need) { selv[pp * 16 + ng + r] = s[pp][0]; seli[pp * 16 + ng + r] = lane; } }
        if (k1 == TT) { const int r = ne0 + lanes_below(e1); if (r < need) { selv[pp * 16 + ng + r] = s[pp][1]; seli[pp * 16 + ng + r] = lane + 64; } } }
      __builtin_amdgcn_wave_barrier();
      float cd[4]; unsigned ck[4]; { const float sa = selv[lane >> 2]; const f32x4 sb = *(const f32x4*)(selv + 16 + (lane & 3) * 4);
#pragma unroll
        for (int q = 0; q < 4; ++q) { cd[q] = sa + sb[q]; ck[q] = fkey(cd[q]); } }
      unsigned T2 = 0u;
      for (int bit = 31; bit >= 0; --bit) { const unsigned c = T2 | (1u << bit);
        const int n = pcnt(__ballot(ck[0] >= c)) + pcnt(__ballot(ck[1] >= c)) + pcnt(__ballot(ck[2] >= c)) + pcnt(__ballot(ck[3] >= c));
        if (n >= 16) { T2 = c; if (n == 16) break; } }
      float mx = fmaxf(fmaxf(cd[0], cd[1]), fmaxf(cd[2], cd[3])); mx = wmax(mx);
      int base = 0; float esum = 0.f; const int ia = seli[lane >> 2]; int rk[4]; float ev[4];
#pragma unroll
      for (int q = 0; q < 4; ++q) { const unsigned long long g = __ballot(ck[q] > T2); rk[q] = ck[q] > T2 ? base + lanes_below(g) : 99; base += pcnt(g); }
#pragma unroll
      for (int q = 0; q < 4; ++q) { const unsigned long long g = __ballot(ck[q] == T2); if (ck[q] == T2) rk[q] = base + lanes_below(g); base += pcnt(g); }
#pragma unroll
      for (int q = 0; q < 4; ++q) { ev[q] = rk[q] < 16 ? __expf(cd[q] - mx) : 0.f; esum += ev[q]; }
      esum = wsum(esum); const float inv = 1.f / esum;
      int* orow = p.IDX + (size_t)row * 128 + h * 16; float* grow = p.GATE + (size_t)row * 128 + h * 16;
#pragma unroll
      for (int q = 0; q < 4; ++q) if (rk[q] < 16) { orow[rk[q]] = ia * 128 + seli[16 + (lane & 3) * 4 + q]; grow[rk[q]] = ev[q] * inv; }
      __builtin_amdgcn_wave_barrier();
    }
  }
}

constexpr float U_SC = 1024.f, V_SC = 16.f;
DI void st_cvt_tables(const Prm& p, int layer, int bid, int nb) {
  const size_t n16 = (size_t)16384 * DM / 16, stride = (size_t)nb * NTHR;
  const float* U = p.peer_u + (size_t)layer * 16384 * DM; const float* V = p.peer_v + (size_t)layer * 16384 * DM;
  for (size_t e = (size_t)bid * NTHR + ltid(); e < 2 * n16; e += stride) { const bool isv = e >= n16; const size_t k = isv ? e - n16 : e;
    const float* src = (isv ? V : U) + k * 16; const float sc = isv ? V_SC : U_SC; u32x4 w;
#pragma unroll
    for (int q = 0; q < 4; ++q) { const f32x4 a = *(const f32x4*)(src + q * 4) * sc; int r = 0;
      r = __builtin_amdgcn_cvt_pk_fp8_f32(a[0], a[1], r, false); r = __builtin_amdgcn_cvt_pk_fp8_f32(a[2], a[3], r, true); w[q] = (unsigned)r; }
    *(u32x4*)((unsigned char*)(isv ? p.Vb : p.Ub) + k * 16) = w; }
}

DI void st_peergather(const Prm& p, int layer, float* lds, int bid, int nb, bool dry = false) {
  const int tid = ltid(), wave = tid >> 6, lane = tid & 63;
  const unsigned char* Ub = (const unsigned char*)p.Ub; const unsigned char* Vb = (const unsigned char*)p.Vb;
  for (int row = bid; row < MR; row += nb) {
    const int b = row / LT, t = row - b * LT; const bool isc = t >= LL;
    if (isc && layer == 1) continue;
    f32x2 hv[16];
#pragma unroll
    for (int i = 0; i < 2; ++i) {
#pragma unroll
      for (int q = 0; q < 2; ++q) { const u32x4 w = *(const u32x4*)(p.H2 + (size_t)row * DM + i * 1024 + lane * 16 + q * 8);
#pragma unroll
        for (int k = 0; k < 4; ++k) hv[i * 8 + q * 4 + k] = (f32x2){__uint_as_float(w[k] << 16), __uint_as_float(w[k] & 0xffff0000u)}; } }
    f32x2 acc[16];
#pragma unroll
    for (int i = 0; i < 16; ++i) acc[i] = (f32x2){0.f, 0.f};
    const int myidx = lane < 16 ? p.IDX[(size_t)row * 128 + wave * 16 + lane] : 0; const float mygate = lane < 16 ? p.GATE[(size_t)row * 128 + wave * 16 + lane] : 0.f;
#pragma unroll 1
    for (int k0 = 0; k0 < 16; k0 += 4) {
      u32x4 uu[4][2], vv[4][2];
#pragma unroll
      for (int q = 0; q < 4; ++q) { const int e = __builtin_amdgcn_readfirstlane(__shfl(myidx, k0 + q));
        const unsigned char* ur = Ub + (size_t)e * DM + lane * 16; const unsigned char* vr = Vb + (size_t)e * DM + lane * 16;
#pragma unroll
        for (int i = 0; i < 2; ++i) { uu[q][i] = *(const u32x4*)(ur + i * 1024); vv[q][i] = *(const u32x4*)(vr + i * 1024); } }
#pragma unroll
      for (int q = 0; q < 4; ++q) { f32x2 d0 = (f32x2){0.f, 0.f}, d1 = (f32x2){0.f, 0.f};
#pragma unroll
        for (int i = 0; i < 2; ++i)
#pragma unroll
          for (int k = 0; k < 4; ++k) { d0 += __builtin_amdgcn_cvt_pk_f32_fp8((int)uu[q][i][k], false) * hv[i * 8 + k * 2]; d1 += __builtin_amdgcn_cvt_pk_f32_fp8((int)uu[q][i][k], true) * hv[i * 8 + k * 2 + 1]; }
        d0 += d1; float d = wsum(d0[0] + d0[1]) * (1.f / U_SC);
        const float wgt = __shfl(mygate, k0 + q) * 0.5f * d * (1.f + erff(d * 0.70710678118654752f)); const f32x2 w2 = (f32x2){wgt, wgt};
#pragma unroll
        for (int i = 0; i < 2; ++i)
#pragma unroll
          for (int k = 0; k < 4; ++k) { acc[i * 8 + k * 2] += w2 * __builtin_amdgcn_cvt_pk_f32_fp8((int)vv[q][i][k], false); acc[i * 8 + k * 2 + 1] += w2 * __builtin_amdgcn_cvt_pk_f32_fp8((int)vv[q][i][k], true); } }
    }
    __syncthreads();
#pragma unroll
    for (int i = 0; i < 2; ++i) { float* d = lds + wave * 2048 + i * 1024 + lane * 16;
#pragma unroll
      for (int k = 0; k < 4; ++k) *(f32x4*)(d + k * 4) = (f32x4){acc[i * 8 + k * 2][0], acc[i * 8 + k * 2][1], acc[i * 8 + k * 2 + 1][0], acc[i * 8 + k * 2 + 1][1]}; }
    __syncthreads();
    { const int col = tid * 4; f32x4 sum = (f32x4){0.f, 0.f, 0.f, 0.f};
#pragma unroll
      for (int w = 0; w < 8; ++w) sum += *(const f32x4*)(lds + w * 2048 + col);
      const f32x4 g2 = *(const f32x4*)(p.mod + ((size_t)layer * 9 + (isc ? 8 : b)) * NMOD + 5 * DM + col) * (1.f / V_SC);
      float* xr = p.X + (size_t)row * DM + col; if (!dry) *(f32x4*)xr = *(const f32x4*)xr + g2 * sum; }
  }
}

DI void st_final(const Prm& p, int bid, int nb) {
  const int wave = ltid() >> 6, lane = ltid() & 63;
  for (int r = bid * 8 + wave; r < NB * LL; r += nb * 8) {
    const int b = r / LL, t = r - b * LL; const float* src = p.X + (size_t)(b * LT + t) * DM;
    f32x4 v[8]; float ss = 0.f;
#pragma unroll
    for (int i = 0; i < 8; ++i) { v[i] = *(const f32x4*)(src + (i * 64 + lane) * 4); ss += v[i][0] * v[i][0] + v[i][1] * v[i][1] + v[i][2] * v[i][2] + v[i][3] * v[i][3]; }
    ss = wsum(ss); const float rstd = rsqrtf(ss * (1.f / 2048.f) + EPSV);
#pragma unroll
    for (int i = 0; i < 8; ++i) { const int col = (i * 64 + lane) * 4; *(f32x4*)(p.out + (size_t)r * DM + col) = v[i] * rstd * *(const f32x4*)(p.final_norm + col); }
  }
}

namespace att {
constexpr int NW = 8, QBLK = 32, KVBLK = 64;
constexpr float SCALE = 0.07216878364870322f;
constexpr float THR = 8.f;
constexpr int LDQ = 768, LDK = 1024, LDKR = 64, LDO = DM;
constexpr int SHM_V = KVBLK * 128 * 2, SHM_K = KVBLK * 128 * 2, SHM_KR = KVBLK * 64 * 2, SHM_ATTN = 2 * SHM_V + 2 * SHM_K + 2 * SHM_KR + NW * 64 * 4;
#define KSWZ(row, colB) ((row) * 256 + ((colB) ^ (((row) & 7) << 4)))
#define KRSWZ(row, colB) ((row) * 128 + ((colB) ^ ((((row) >> 1) & 7) << 4)))
#define SBAR() __builtin_amdgcn_sched_barrier(0)
DI int crow(int r, int hi) { return (r & 3) + 8 * (r >> 2) + 4 * hi; }
DI unsigned cvtpk(float lo, float hi) { unsigned r; asm volatile("v_cvt_pk_bf16_f32 %0, %1, %2" : "=v"(r) : "v"(lo), "v"(hi)); return r; }

DI void partialSM(f32x16& p0, f32x16& p1, float& m_reg, float& mn, float& alpha) {
  constexpr float C = SCALE * 1.4426950408889634f;
  float pmax = p0[0];
#pragma unroll
  for (int r = 1; r < 16; ++r) pmax = fmaxf(pmax, p0[r]);
#pragma unroll
  for (int r = 0; r < 16; ++r) pmax = fmaxf(pmax, p1[r]);
  { auto rr = __builtin_amdgcn_permlane32_swap(__float_as_uint(pmax), __float_as_uint(pmax), false, false);
    pmax = fmaxf(__uint_as_float(rr[0]), __uint_as_float(rr[1])); }
  if (__builtin_expect(__all(pmax - m_reg <= THR / SCALE), 1)) { mn = m_reg; alpha = 1.f; }
  else { mn = fmaxf(m_reg, pmax); alpha = __builtin_amdgcn_exp2f((m_reg - mn) * C); m_reg = mn; }
  const float mnC = -mn * C;
#pragma unroll
  for (int r = 0; r < 16; ++r) p0[r] = fmaf(p0[r], C, mnC);
#pragma unroll
  for (int r = 0; r < 16; ++r) p1[r] = fmaf(p1[r], C, mnC);
#pragma unroll
  for (int r = 0; r < 16; ++r) p0[r] = __builtin_amdgcn_exp2f(p0[r]);
}
DI void finishSM(f32x16& p0, f32x16& p1, float alpha, float& l_reg, bf16x8& pa0, bf16x8& pa1, bf16x8& pa2, bf16x8& pa3) {
#pragma unroll
  for (int r = 0; r < 16; ++r) p1[r] = __builtin_amdgcn_exp2f(p1[r]);
  float ps = 0;
#pragma unroll
  for (int r = 0; r < 16; ++r) ps += p0[r];
#pragma unroll
  for (int r = 0; r < 16; ++r) ps += p1[r];
  { auto rr = __builtin_amdgcn_permlane32_swap(__float_as_uint(ps), __float_as_uint(ps), false, false);
    ps = __uint_as_float(rr[0]) + __uint_as_float(rr[1]); }
  l_reg = l_reg * alpha + ps;
#define PK4(P, BASE, OUT) do { unsigned a0 = cvtpk(P[BASE + 0], P[BASE + 1]), a1 = cvtpk(P[BASE + 2], P[BASE + 3]);   \
    unsigned b0 = cvtpk(P[BASE + 4], P[BASE + 5]), b1 = cvtpk(P[BASE + 6], P[BASE + 7]);                              \
    auto r0 = __builtin_amdgcn_permlane32_swap(a0, b0, false, false); auto r1 = __builtin_amdgcn_permlane32_swap(a1, b1, false, false); \
    u32x4 w = {r0[0], r1[0], r0[1], r1[1]}; OUT = *reinterpret_cast<bf16x8*>(&w); } while (0)
  PK4(p0, 0, pa0); PK4(p0, 8, pa1); PK4(p1, 0, pa2); PK4(p1, 8, pa3);
#undef PK4
}
DI void qkt(f32x16& p0, f32x16& p1, const char* Ks, const char* KRs, const bf16x8* qr, int r32, int hi) {
  p0 = f32x16{}; p1 = f32x16{};
#pragma unroll
  for (int d0 = 0; d0 < 8; ++d0) { const int cb = (d0 * 16 + hi * 8) * 2;
    const bf16x8 b0 = *reinterpret_cast<const bf16x8*>(Ks + KSWZ(r32, cb));
    const bf16x8 b1 = *reinterpret_cast<const bf16x8*>(Ks + KSWZ(32 + r32, cb));
    p0 = __builtin_amdgcn_mfma_f32_32x32x16_bf16(b0, qr[d0], p0, 0, 0, 0);
    p1 = __builtin_amdgcn_mfma_f32_32x32x16_bf16(b1, qr[d0], p1, 0, 0, 0); }
#pragma unroll
  for (int d0 = 0; d0 < 4; ++d0) { const int cb = (d0 * 16 + hi * 8) * 2;
    const bf16x8 b0 = *reinterpret_cast<const bf16x8*>(KRs + KRSWZ(r32, cb));
    const bf16x8 b1 = *reinterpret_cast<const bf16x8*>(KRs + KRSWZ(32 + r32, cb));
    p0 = __builtin_amdgcn_mfma_f32_32x32x16_bf16(b0, qr[8 + d0], p0, 0, 0, 0);
    p1 = __builtin_amdgcn_mfma_f32_32x32x16_bf16(b1, qr[8 + d0], p1, 0, 0, 0); }
}
DI int v_st(int k, int c) { const int kk = (k & ~0xC) | ((k & 4) << 1) | ((k & 8) >> 1); return ((kk >> 3) * 4 + (c >> 5)) * 512 + ((kk & 7) * 32 + (c & 31)) * 2; }
DI int v_rd_base(int lane) { return ((lane & 3) << 3) | (((lane >> 2) & 3) << 6) | (((lane >> 4) & 1) << 5) | (((lane >> 5) & 1) << 8); }
constexpr int v_rd_off(int d0, int ks, int half) { return d0 * 512 + ks * 4096 + half * 2048; }
template <int OFF> DI s16x4 tr_read(int vb) { s16x4 r; asm volatile("ds_read_b64_tr_b16 %0, %1 offset:%2" : "=&v"(r) : "v"(vb), "i"(OFF) : "memory"); return r; }
template <int D0> DI void pv_one(f32x16& od, int vb, bf16x8 pa0, bf16x8 pa1, bf16x8 pa2, bf16x8 pa3) {
  const s16x4 l0 = tr_read<v_rd_off(D0, 0, 0)>(vb), h0 = tr_read<v_rd_off(D0, 0, 1)>(vb), l1 = tr_read<v_rd_off(D0, 1, 0)>(vb), h1 = tr_read<v_rd_off(D0, 1, 1)>(vb);
  const s16x4 l2 = tr_read<v_rd_off(D0, 2, 0)>(vb), h2 = tr_read<v_rd_off(D0, 2, 1)>(vb), l3 = tr_read<v_rd_off(D0, 3, 0)>(vb), h3 = tr_read<v_rd_off(D0, 3, 1)>(vb);
  asm volatile("s_waitcnt lgkmcnt(0)" ::: "memory"); SBAR();
#define PK(L, H) (bf16x8){L[0], L[1], L[2], L[3], H[0], H[1], H[2], H[3]}
  od = __builtin_amdgcn_mfma_f32_32x32x16_bf16(pa0, PK(l0, h0), od, 0, 0, 0);
  od = __builtin_amdgcn_mfma_f32_32x32x16_bf16(pa1, PK(l1, h1), od, 0, 0, 0);
  od = __builtin_amdgcn_mfma_f32_32x32x16_bf16(pa2, PK(l2, h2), od, 0, 0, 0);
  od = __builtin_amdgcn_mfma_f32_32x32x16_bf16(pa3, PK(l3, h3), od, 0, 0, 0);
#undef PK
}
DI void pv_d0(f32x16* o, int vb, bf16x8 pa0, bf16x8 pa1, bf16x8 pa2, bf16x8 pa3) {
  pv_one<0>(o[0], vb, pa0, pa1, pa2, pa3); pv_one<1>(o[1], vb, pa0, pa1, pa2, pa3); pv_one<2>(o[2], vb, pa0, pa1, pa2, pa3); pv_one<3>(o[3], vb, pa0, pa1, pa2, pa3);
}

DI void attn_body(const bf16_t* __restrict__ Qb, const bf16_t* __restrict__ Kh, const bf16_t* __restrict__ Vh, const bf16_t* __restrict__ KRh, bf16_t* __restrict__ Ob, int seq, int tpos0, char* lds) {
  const int tid = ltid(), wid = tid >> 6, lane = tid & 63, r32 = lane & 31, hi = lane >> 5;
  char* V_lds = lds; char* K_lds = lds + 2 * SHM_V; char* KR_lds = lds + 2 * SHM_V + 2 * SHM_K;
  float* ws = (float*)(lds + 2 * SHM_V + 2 * SHM_K + 2 * SHM_KR) + wid * 64; float* li_l = ws; float* al_l = ws + 32;
  float m_reg = -1e30f, l_reg = 0; f32x16 o[4] = {}; bf16x8 qr[12];
  const bf16_t* Qw = Qb + (long)(wid * QBLK + r32) * LDQ + hi * 8;
#pragma unroll
  for (int d0 = 0; d0 < 12; ++d0) qr[d0] = *reinterpret_cast<const bf16x8*>(Qw + d0 * 16);
  if (tpos0 >= 0) {
    const int t = tpos0 + wid * QBLK + r32;
#pragma unroll
    for (int hf = 0; hf < 2; ++hf) { const float pos = (float)(hf ? (t & 63) : (t >> 6));
#pragma unroll
      for (int j = 0; j < 8; ++j) { const float ang = pos * exp2f(-(float)(hi * 8 + j) * (13.287712379549449f / 16.f)); float sv, cv; sincosf(ang, &sv, &cv);
        const float x1 = bf2f((bf16_t)qr[8 + 2 * hf][j]), x2 = bf2f((bf16_t)qr[9 + 2 * hf][j]);
        qr[8 + 2 * hf][j] = (short)f2bf(x1 * cv - x2 * sv); qr[9 + 2 * hf][j] = (short)f2bf(x2 * cv + x1 * sv); } }
  }
  const int sr = tid >> 4, sc = (tid & 15) * 8, vst0 = v_st(sr, sc), vst1 = v_st(32 + sr, sc);
  const int krr = tid >> 3, krc = (tid & 7) * 8;
  const int vb0 = (int)(uintptr_t)V_lds + v_rd_base(lane);
  bf16x8 vs0, vs1, ks0, ks1, kr0;
#define SLOAD(k0) do { vs0 = *reinterpret_cast<const bf16x8*>(&Vh[(long)((k0) + sr) * LDK + sc]); vs1 = *reinterpret_cast<const bf16x8*>(&Vh[(long)((k0) + 32 + sr) * LDK + sc]); \
    ks0 = *reinterpret_cast<const bf16x8*>(&Kh[(long)((k0) + sr) * LDK + sc]); ks1 = *reinterpret_cast<const bf16x8*>(&Kh[(long)((k0) + 32 + sr) * LDK + sc]); \
    kr0 = *reinterpret_cast<const bf16x8*>(&KRh[(long)((k0) + krr) * LDKR + krc]); } while (0)
#define SWRITE(b) do { *(bf16x8*)(V_lds + (b) * SHM_V + vst0) = vs0; *(bf16x8*)(V_lds + (b) * SHM_V + vst1) = vs1; const int kc = sc * 2;               \
    *(bf16x8*)(K_lds + (b) * SHM_K + KSWZ(sr, kc)) = ks0; *(bf16x8*)(K_lds + (b) * SHM_K + KSWZ(32 + sr, kc)) = ks1;                       \
    *(bf16x8*)(KR_lds + (b) * SHM_KR + KRSWZ(krr, krc * 2)) = kr0; } while (0)
#define SWAIT() asm volatile("s_waitcnt vmcnt(0)" ::: "memory")
#define RESC(a) do { if (__any((a) < 1.f)) { if (hi == 0) al_l[r32] = (a); asm volatile("s_waitcnt lgkmcnt(0)" ::: "memory"); \
    _Pragma("unroll") for (int d = 0; d < 4; ++d) _Pragma("unroll") for (int r = 0; r < 16; ++r) o[d][r] *= al_l[crow(r, hi)]; } } while (0)
  f32x16 p0, p1; float mn, al; bf16x8 pa0, pa1, pa2, pa3; const int NT = seq / KVBLK;
  SLOAD(0); SWAIT(); SWRITE(0); __syncthreads();
  for (int j = 0; j < NT; ++j) {
    const int buf = j & 1; const bool more = j + 1 < NT;
    if (more) SLOAD((j + 1) * KVBLK);
    SBAR(); qkt(p0, p1, K_lds + buf * SHM_K, KR_lds + buf * SHM_KR, qr, r32, hi);
    partialSM(p0, p1, m_reg, mn, al); RESC(al);
    finishSM(p0, p1, al, l_reg, pa0, pa1, pa2, pa3); SBAR();
    pv_d0(o, vb0 + buf * SHM_V, pa0, pa1, pa2, pa3);
    if (more) { SWAIT(); SWRITE(buf ^ 1); }
    __syncthreads();
  }
  if (hi == 0) li_l[r32] = l_reg; asm volatile("s_waitcnt lgkmcnt(0)" ::: "memory");
  float rli[16];
#pragma unroll
  for (int r = 0; r < 16; ++r) rli[r] = __builtin_amdgcn_rcpf(li_l[crow(r, hi)]);
  bf16_t* Ow = Ob + (long)(wid * QBLK) * LDO;
#pragma unroll
  for (int r = 0; r < 16; ++r) { const int orow = crow(r, hi);
#pragma unroll
    for (int d0 = 0; d0 < 4; ++d0) Ow[(long)orow * LDO + d0 * 32 + r32] = f2bf(o[d0][r] * rli[r]); }
  __syncthreads();
#undef SLOAD
#undef SWRITE
#undef SWAIT
#undef RESC
}
}

DI void st_attn(const Prm& p, int layer, char* lds, int bid, int nb) {
  const int nlat = NB * 4 * 16, nitem = nlat + (layer == 0 ? NB * 4 : 0);
  for (int it = bid; it < nitem; it += nb) {
    if (it < nlat) { const int b = it >> 6, h = (it >> 4) & 3, qb = it & 15; const size_t r0 = (size_t)b * LT;
      att::attn_body(p.Qraw + (r0 + qb * 256) * 768 + h * 192, p.KV + r0 * 1024 + h * 256, p.KV + r0 * 1024 + h * 256 + 128, p.KR + r0 * 64,
                     p.Y + (r0 + qb * 256) * DM + 1024 + h * 128, LT, qb * 256, lds); }
    else { const int k = it - nlat, b = k >> 2, h = k & 3; const size_t r0 = (size_t)b * LT + LL;
      att::attn_body(p.Qraw + r0 * 768 + h * 192, p.KV + r0 * 1024 + h * 256, p.KV + r0 * 1024 + h * 256 + 128, p.KR + r0 * 64, p.Y + r0 * DM + 1024 + h * 128, LCX, -1, lds); }
  }
}

struct EpiResid {
  static constexpr bool PERM = false, AFTER_DRAIN = false;
  const float* xlat; const float* xctx; float* X; const float* modl; int first;
  __device__ __forceinline__ void operator()(const pg8::f32x4 (&acc)[2][2][4][2], const pg8::Unit& u, int wr, int wc, int fr, int fq) const {
    const int b = u.pm / 17, tl = u.pm - b * 17; const bool isc = tl == 16;
    const float* g = modl + (size_t)(isc ? 8 : b) * NMOD + 2 * DM;
    const int rloc0 = wr * 64 + fr, col0 = u.pn * 256 + wc * 32 + 4 * fq;
    pg8::f32x4 gv[2][2];
#pragma unroll
    for (int bj = 0; bj < 2; ++bj)
#pragma unroll
      for (int n = 0; n < 2; ++n) gv[bj][n] = *(const pg8::f32x4*)(g + col0 + bj * 128 + n * 16);
#pragma unroll
    for (int ai = 0; ai < 2; ++ai)
#pragma unroll
      for (int m = 0; m < 4; ++m) { const int rl = rloc0 + ai * 128 + m * 16; const size_t row = (size_t)u.pm * 256 + rl;
        const float* src = first ? (isc ? xctx + ((size_t)b * LCX + rl) * DM : xlat + ((size_t)b * LL + tl * 256 + rl) * DM) : X + row * DM;
        float* dst = X + row * DM;
#pragma unroll
        for (int bj = 0; bj < 2; ++bj)
#pragma unroll
          for (int n = 0; n < 2; ++n) { const int c = col0 + bj * 128 + n * 16; *(pg8::f32x4*)(dst + c) = *(const pg8::f32x4*)(src + c) + gv[bj][n] * acc[ai][bj][m][n]; } }
  }
};

template <class Epi> DI void run_gemm(unsigned char* lds, const bf16_t* A, const bf16_t* Bt, int M, int N, int K, const Epi& E, int bid, int nb) {
  pg8::Gemm g; g.A = A; g.Bt = Bt; g.M = M; g.N = N; g.K = K;
  pg8::StaticOrder S; S.init(M, N, nb, bid);
  pg8::gemm_phase<Epi, pg8::StaticOrder, false>((PG8_LAS unsigned char*)lds, g, S, E, nullptr);
}
DI pg8::EpiBf16<0> epi_bf16(bf16_t* O, int ldc, int split_cols = 0, size_t split_stride = 0) { pg8::EpiBf16<0> e; e.O = O; e.ldc = ldc; e.bias = nullptr; e.split_cols = split_cols; e.split_stride = split_stride; return e; }

#ifndef PROBE
#define PROBE 0
#endif
constexpr int LDS_MAIN = 131072, LDS_TOTAL = LDS_MAIN + 64;
#define PRM() (*(const __attribute__((address_space(4))) Prm*)launder_k(kp))
typedef const __attribute__((address_space(4))) void* kptr_t;
DI kptr_t launder_k(kptr_t q) { asm volatile("" : "+s"(q)); return q; }
extern __shared__ __attribute__((aligned(16))) unsigned char shm[];
__global__ void __launch_bounds__(NTHR, 2) mega(Prm p_unused) {
#if defined(__HIP_DEVICE_COMPILE__)
  kptr_t kp = (kptr_t)__builtin_amdgcn_kernarg_segment_ptr();
  const int bid0 = blockIdx.x, nb0 = gridDim.x;
#define bid lsg(bid0)
#define nb lsg(nb0)
  uint4* xbw = (uint4*)(shm + LDS_MAIN);
  if (threadIdx.x == 0) *xbw = make_uint4(0u, 0u, 0u, 0u);
  __syncthreads();
  { const Prm p = PRM(); (void)xcd_barrier_post(p.bar, (volatile LAS unsigned*)xbw); }
#define GRID_BAR() do { XcdBarrier b_; b_.bar = PRM().bar; b_.x = xb_xcc_id(); b_.st = (volatile LAS unsigned*)(shm + LDS_MAIN); xcd_barrier(b_); } while (0)
  float* lf = (float*)shm;
  for (int ly = 0; ly < 2; ++ly) { const Prm p = PRM();
    st_transpose(p.w_in + (size_t)ly * DM * IN_W, p.WinT + (size_t)ly * NZ * DM, DM, IN_W, DM, NZ, lf, bid, nb);
    st_transpose(p.w_out + (size_t)ly * DM * DM, p.WoutT + (size_t)ly * DM * DM, DM, DM, DM, DM, lf, bid, nb);
    st_transpose(p.peer_wq + (size_t)ly * DM * DM, p.WqT + (size_t)ly * DM * DM, DM, DM, DM, DM, lf, bid, nb);
    st_transpose(p.mla_w_uq + (size_t)ly * 448 * 768, p.WuqT + (size_t)ly * 768 * 512, 448, 768, 512, 768, lf, bid, nb);
    st_transpose(p.mla_w_ukv + (size_t)ly * 128 * 1024, p.WukvT + (size_t)ly * 1024 * 256, 128, 1024, 256, 1024, lf, bid, nb);
  }
  { const Prm p = PRM(); st_tables(p, bid, nb); }
  __syncthreads();
  { const Prm p = PRM(); st_mods(p, lf, bid, nb); }
  if (PROBE == 5) { __syncthreads();
    for (int ly = 0; ly < 2; ++ly) { const Prm p = PRM();
      st_transpose(p.w_in + (size_t)ly * DM * IN_W, p.WinT + (size_t)ly * NZ * DM, DM, IN_W, DM, NZ, lf, bid, nb);
      st_transpose(p.w_out + (size_t)ly * DM * DM, p.WoutT + (size_t)ly * DM * DM, DM, DM, DM, DM, lf, bid, nb);
      st_transpose(p.peer_wq + (size_t)ly * DM * DM, p.WqT + (size_t)ly * DM * DM, DM, DM, DM, DM, lf, bid, nb); }
    { const Prm p = PRM(); st_tables(p, bid, nb); }
    __syncthreads();
    { const Prm p = PRM(); st_mods(p, lf, bid, nb); } }
  GRID_BAR();
  for (int l = 0; l < 2; ++l) {
    { const Prm p = PRM(); st_modulate(p, l, 0, p.H, bid, nb); }
    GRID_BAR();
    { const Prm p = PRM(); run_gemm(shm, p.H, p.WinT + (size_t)l * NZ * DM, MR, NZ, DM, epi_bf16(p.Z, NZ), bid, nb); }
    if (PROBE == 6) { const Prm p = PRM(); run_gemm(shm, p.H, p.WinT + (size_t)l * NZ * DM, MR, NZ, DM, epi_bf16(p.Z, NZ), bid, nb); }
    GRID_BAR();
    { const Prm p = PRM(); st_dnprep(p, l, bid, nb); }
    { const Prm p = PRM(); st_mlaprep(p, l, bid, nb); }
    { const Prm p = PRM(); st_fnchan(p, shm, bid, nb); }
    if (PROBE == 9) { { const Prm p = PRM(); st_dnprep(p, l, bid, nb); } { const Prm p = PRM(); st_mlaprep(p, l, bid, nb); } }
    if (PROBE == 10) { const Prm p = PRM(); st_fnchan(p, shm, bid, nb); }
    GRID_BAR();
    { const Prm p = PRM(); run_gemm(shm, p.Aq, p.WuqT + (size_t)l * 768 * 512, MR, 768, 512, epi_bf16(p.Qraw, 768), bid, nb); }
    { const Prm p = PRM(); run_gemm(shm, p.Akv, p.WukvT + (size_t)l * 1024 * 256, MR, 1024, 256, epi_bf16(p.KV, 1024), bid, nb); }
    if (bid < 128) { const Prm p = PRM(); st_dnscan(p, lf, bid, 128); }
    else { const Prm p = PRM(); st_glascan(p, l, lf, bid - 128, 128); }
    if (PROBE == 7) { GRID_BAR(); if (bid < 128) { const Prm p = PRM(); st_dnscan(p, lf, bid, 128); } }
    if (PROBE == 8) { GRID_BAR(); if (bid < 128) { const Prm p = PRM(); st_glascan(p, l, lf, bid, 128); } }
    if (PROBE == 2) { GRID_BAR(); if (bid < 128) { const Prm p = PRM(); st_dnscan(p, lf, bid, 128); } else { const Prm p = PRM(); st_glascan(p, l, lf, bid - 128, 128); } }
    GRID_BAR();
    { const Prm p = PRM(); st_attn(p, l, (char*)shm, bid, nb); }
    if (PROBE == 3) { const Prm p = PRM(); st_attn(p, l, (char*)shm, bid, nb); }
    { const Prm p = PRM(); run_gemm(shm, p.DFTM, p.PQT, 4096, 4096, 8192, epi_bf16(p.Y + 1536, DM, 512, (size_t)LT * DM), bid, nb); }
    if (l == 0) { const Prm p = PRM(); run_gemm(shm, p.DFTC, p.PQTc, 256, 4096, 512, epi_bf16(p.Y + (size_t)LL * DM + 1536, DM, 512, (size_t)LT * DM), bid, nb); }
    { const Prm p = PRM(); st_combine(p, l, bid, nb); }
    GRID_BAR();
    { const Prm p = PRM(); EpiResid e; e.xlat = p.x; e.xctx = p.ctx; e.X = p.X; e.modl = p.mod + (size_t)l * 9 * NMOD; e.first = l == 0;
      run_gemm(shm, p.Y, p.WoutT + (size_t)l * DM * DM, MR, DM, DM, e, bid, nb); }
    GRID_BAR();
    { const Prm p = PRM(); st_modulate(p, l, 1, p.H2, bid, nb); }
    { const Prm p = PRM(); st_cvt_tables(p, l, bid, nb); }
    GRID_BAR();
    { const Prm p = PRM(); run_gemm(shm, p.H2, p.WqT + (size_t)l * DM * DM, MR, DM, DM, epi_bf16(p.Qp, DM), bid, nb); }
    GRID_BAR();
    { const Prm p = PRM(); st_peertopk(p, l, shm, bid, nb); }
    if (PROBE == 4) { __syncthreads(); const Prm p = PRM(); st_peertopk(p, l, shm, bid, nb); }
    GRID_BAR();
    { const Prm p = PRM(); st_peergather(p, l, lf, bid, nb); }
    if (PROBE == 1) { __syncthreads(); const Prm p = PRM(); st_peergather(p, l, lf, bid, nb, true); }
    GRID_BAR();
  }
  { const Prm p = PRM(); st_final(p, bid, nb); }
#endif
#undef bid
#undef nb
#undef GRID_BAR
}

static size_t al256(size_t x) { return (x + 255) / 256 * 256; }
extern "C" void kernel_launch(void* const* d_in, const int* in_sizes, int n_in, void* d_out, int out_size, void* d_ws, size_t ws_size, hipStream_t stream) {
  Prm p{};
  const float** f = (const float**)&p.x;
  for (int i = 0; i < 24; ++i) f[i] = (const float*)d_in[i];
  p.out = (float*)d_out;
  char* w = (char*)d_ws; size_t o = 0;
  auto take = [&](size_t bytes) { char* r = w + o; o += al256(bytes); return r; };
  p.bar = (unsigned*)take(16384);
  p.WinT = (bf16_t*)take((size_t)2 * NZ * DM * 2); p.WoutT = (bf16_t*)take((size_t)2 * DM * DM * 2); p.WqT = (bf16_t*)take((size_t)2 * DM * DM * 2);
  p.WuqT = (bf16_t*)take((size_t)2 * 768 * 512 * 2); p.WukvT = (bf16_t*)take((size_t)2 * 1024 * 256 * 2);
  p.mod = (float*)take((size_t)2 * 9 * NMOD * 4); p.GB = (float*)take((size_t)MR * 16 * 4); p.CCS = (float*)take((size_t)2 * 128 * 128 * 4);
  p.DFTM = (bf16_t*)take((size_t)4096 * 8192 * 2); p.DFTC = (bf16_t*)take((size_t)256 * 512 * 2);
  p.X = (float*)take((size_t)MR * DM * 4);
  p.Z = (bf16_t*)take((size_t)MR * NZ * 2);
  char* ra = take((size_t)MR * 1536 * 2 + (size_t)4 * MR * 512 * 2);
  p.DNQ = (bf16_t*)ra; p.OB = (bf16_t*)(ra + (size_t)MR * 1536 * 2); p.H = (bf16_t*)ra;
  p.Ub = (bf16_t*)ra; p.Vb = (bf16_t*)(ra + (size_t)16384 * DM);
  p.KV = (bf16_t*)take((size_t)MR * 1024 * 2); p.KR = (bf16_t*)take((size_t)MR * 64 * 2);
  p.Aq = (bf16_t*)take((size_t)MR * 512 * 2); p.Akv = (bf16_t*)take((size_t)MR * 256 * 2);
  if (o > ws_size) return;
  char* q = (char*)d_out; size_t oo = 0;
  p.Y = (bf16_t*)q; oo += (size_t)MR * DM * 2; p.PQT = (bf16_t*)(q + oo); oo += (size_t)8 * 512 * 8192 * 2; p.PQTc = (bf16_t*)(q + oo); oo += (size_t)8 * 512 * 512 * 2;
  p.Qraw = (bf16_t*)(q + oo); oo += (size_t)MR * 768 * 2;
  char* z = (char*)p.Z; p.H2 = (bf16_t*)z; p.Qp = (bf16_t*)(z + (size_t)MR * DM * 2); p.IDX = (int*)(z + (size_t)2 * MR * DM * 2); p.GATE = (float*)(z + (size_t)2 * MR * DM * 2 + (size_t)MR * 128 * 4);

  static int grid = 0;
  if (!grid) {
    (void)hipFuncSetAttribute((const void*)mega, hipFuncAttributeMaxDynamicSharedMemorySize, LDS_TOTAL);
    int dev = 0, cus = 0, per_cu = 0;
    (void)hipGetDevice(&dev); (void)hipDeviceGetAttribute(&cus, hipDeviceAttributeMultiprocessorCount, dev);
    (void)hipOccupancyMaxActiveBlocksPerMultiprocessor(&per_cu, (const void*)mega, NTHR, LDS_TOTAL);
    grid = per_cu >= 1 ? cus : 0;
    if (grid > 256) grid = 256;
  }
  if (grid < 256) return;
  (void)hipMemsetAsync(p.bar, 0, XCD_BAR_WORDS * sizeof(unsigned), stream);
  hipLaunchKernelGGL(mega, dim3(grid), dim3(NTHR), LDS_TOTAL, stream, p);
}
```

```cpp
#include <hip/hip_runtime.h>
#include <stdint.h>

constexpr int DM = 2048, NB = 8, LL = 4096, LCX = 256, LT = LL + LCX  , MR = NB * LT  ;
constexpr int NZ = 4864;
constexpr int C_DNQ = 0, C_DNK = 512, C_DNV = 1024, C_DNGATE = 1536, C_DNA = 2048, C_DNB = 2056, C_GQ = 2064, C_GK = 2320, C_GV = 2576,
              C_GGATE = 3088, C_GALPHA = 3600, C_CQ = 3632, C_CKV = 4080, C_KR = 4208, C_FN = 4272, IN_W = 4784;
constexpr int NMOD = 6 * DM;
constexpr float EPSV = 1e-6f;
constexpr int NTHR = 512;

typedef unsigned short bf16_t;
typedef short bf16x8 __attribute__((ext_vector_type(8)));
typedef short s16x4 __attribute__((ext_vector_type(4)));
typedef float f32x4 __attribute__((ext_vector_type(4)));
typedef float f32x16 __attribute__((ext_vector_type(16)));
typedef unsigned u32x4 __attribute__((ext_vector_type(4)));
typedef unsigned u32x2 __attribute__((ext_vector_type(2)));

#define DI __device__ __forceinline__
DI float bf2f(bf16_t b) { return __uint_as_float(((unsigned)b) << 16); }
DI bf16_t f2bf(float f) { unsigned u = __float_as_uint(f); u += 0x7FFFu + ((u >> 16) & 1u); return (bf16_t)(u >> 16); }
DI unsigned pack2(float lo, float hi) { return (unsigned)f2bf(lo) | ((unsigned)f2bf(hi) << 16); }
typedef float f32x2 __attribute__((ext_vector_type(2)));
DI float dpp_x1(float v) { return __int_as_float(__builtin_amdgcn_mov_dpp(__float_as_int(v), 0xB1, 0xf, 0xf, true)); }
DI float dpp_x2(float v) { return __int_as_float(__builtin_amdgcn_mov_dpp(__float_as_int(v), 0x4E, 0xf, 0xf, true)); }
DI float dpp_hm(float v) { return __int_as_float(__builtin_amdgcn_mov_dpp(__float_as_int(v), 0x141, 0xf, 0xf, true)); }
DI float dpp_rm(float v) { return __int_as_float(__builtin_amdgcn_mov_dpp(__float_as_int(v), 0x140, 0xf, 0xf, true)); }
DI float red4(float v) { v += dpp_x1(v); v += dpp_x2(v); return v; }
DI float red8(float v) { v += dpp_x1(v); v += dpp_x2(v); v += dpp_hm(v); return v; }
DI float rdl(float v, int l) { return __int_as_float(__builtin_amdgcn_readlane(__float_as_int(v), l)); }
DI float wsum(float v) { v += dpp_x1(v); v += dpp_x2(v); v += dpp_hm(v); v += dpp_rm(v); return (rdl(v, 0) + rdl(v, 16)) + (rdl(v, 32) + rdl(v, 48)); }
DI float wmax(float v) { v = fmaxf(v, dpp_x1(v)); v = fmaxf(v, dpp_x2(v)); v = fmaxf(v, dpp_hm(v)); v = fmaxf(v, dpp_rm(v)); return fmaxf(fmaxf(rdl(v, 0), rdl(v, 16)), fmaxf(rdl(v, 32), rdl(v, 48))); }
DI float siluf(float x) { return x / (1.f + __expf(-x)); }
DI float sigmf(float x) { return 1.f / (1.f + __expf(-x)); }

DI int ltid() { int t = (int)threadIdx.x; asm volatile("" : "+v"(t)); return t; }
DI int lsg(int v) { asm volatile("" : "+s"(v)); return v; }

struct Prm {
  const float *x, *c, *ctx, *c_ctx, *w_ada, *b_ada, *w_in, *dn_conv, *dn_a_log, *dn_dt_bias, *dn_norm, *gla_w2, *gla_b2, *gla_norm,
      *mla_q_norm, *mla_w_uq, *mla_kv_norm, *mla_w_ukv, *w_out, *peer_wq, *peer_keys, *peer_u, *peer_v, *final_norm;
  float* out;
  bf16_t *WinT, *WoutT, *WqT, *WuqT, *WukvT;
  float *mod, *GB, *CCS;
  bf16_t *DFTM, *DFTC;
  float* X;
  bf16_t* Z;
  bf16_t *H, *DNQ, *OB;
  bf16_t *KV, *KR;
  bf16_t *Y, *PQT, *PQTc, *Qraw, *Aq, *Akv;
  bf16_t *H2, *Qp;
  bf16_t *Ub, *Vb;
  int* IDX;
  float* GATE;
  unsigned* bar;
};
#define XB_TMO      128
#define XB_XCNT(j)  (256  + 64 * (j))
#define XB_XSUB(j)  (1280 + 64 * (j))
#define XB_XGEN(j)  (2304 + 64 * (j))
#define XB_TOP      3328
#define XB_TOPGEN   3392
#define XCD_BAR_WORDS 3456
#define XB_SPIN_CAP (1u << 18)
#define LAS __attribute__((address_space(3)))

__device__ __forceinline__ unsigned xb_ld(unsigned* p)              { return __hip_atomic_load(p, __ATOMIC_RELAXED, __HIP_MEMORY_SCOPE_AGENT); }
__device__ __forceinline__ unsigned xb_add(unsigned* p, unsigned v) { return __hip_atomic_fetch_add(p, v, __ATOMIC_RELAXED, __HIP_MEMORY_SCOPE_AGENT); }
__device__ __forceinline__ unsigned xb_xcc_id() { return (unsigned)__builtin_amdgcn_s_getreg((3 << 11) | 20) & 0xFu; }
#define XB_SPIN(cond, bar) do { unsigned _sp = 0; while (cond) { __builtin_amdgcn_s_sleep(1); \
    if ((++_sp & 255u) == 0u) { if (xb_ld(&(bar)[XB_TMO])) break; if (_sp > XB_SPIN_CAP) { atomicAdd(&(bar)[XB_TMO], 1u); break; } } } } while (0)

struct XcdBarrier {
    unsigned* bar; unsigned x;
    volatile LAS unsigned* st;
};

__device__ __forceinline__ XcdBarrier xcd_barrier_post(unsigned* bar, volatile LAS unsigned* st) {
    XcdBarrier b; b.bar = bar; b.x = xb_xcc_id(); b.st = st;
    if (threadIdx.x == 0) (void)xb_add(&bar[XB_XCNT(b.x)], 1u);
    return b;
}
__device__ __forceinline__ void xcd_barrier_complete(unsigned* bar, unsigned x, unsigned& nloc, unsigned& nx) {
    const unsigned G = gridDim.x * gridDim.y * gridDim.z;
    unsigned sum, cnt, mine, sp = 0u;
    for (;;) {
        sum = 0u; cnt = 0u; mine = 0u;
#pragma unroll
        for (unsigned j = 0; j < 16; ++j) { const unsigned c = xb_ld(&bar[XB_XCNT(j)]); sum += c; cnt += (c > 0u) ? 1u : 0u; mine = (j == x) ? c : mine; }
        if (sum == G) break;
        __builtin_amdgcn_s_sleep(1);
        if ((++sp & 255u) == 0u) { if (xb_ld(&bar[XB_TMO])) break; if (sp > XB_SPIN_CAP) { atomicAdd(&bar[XB_TMO], 1u); break; } }
    }
    nloc = mine > 0u ? mine : 1u; nx = cnt > 0u ? cnt : 1u;
}

__device__ __forceinline__ void xcd_barrier(const XcdBarrier& b) {
    asm volatile("s_waitcnt vmcnt(0)" ::: "memory");
    __syncthreads();
    if (threadIdx.x == 0) {
        unsigned* bar = b.bar;
        __builtin_amdgcn_s_waitcnt(0);
        unsigned nloc = b.st[0], nx = b.st[1];
        if (nloc == 0u) { xcd_barrier_complete(bar, b.x, nloc, nx); b.st[0] = nloc; b.st[1] = nx; }
        const unsigned old = xb_add(&bar[XB_XSUB(b.x)], 1u);
        const unsigned gen = old / nloc;
        if (old + 1u == (gen + 1u) * nloc) {
            __builtin_amdgcn_fence(__ATOMIC_RELEASE, "agent");
            asm volatile("s_waitcnt vmcnt(0)" ::: "memory");
            const unsigned og = xb_add(&bar[XB_TOP], 1u);
            const unsigned tg = og / nx;
            if (og + 1u == (tg + 1u) * nx) xb_add(&bar[XB_TOPGEN], 1u);
            else XB_SPIN(xb_ld(&bar[XB_TOPGEN]) == tg, bar);
            __builtin_amdgcn_fence(__ATOMIC_ACQUIRE, "agent");
            xb_add(&bar[XB_XGEN(b.x)], 1u);
            asm volatile("s_waitcnt vmcnt(0)" ::: "memory");
        } else {
            XB_SPIN(xb_ld(&bar[XB_XGEN(b.x)]) == gen, bar);
            __builtin_amdgcn_fence(__ATOMIC_ACQUIRE, "agent");
            asm volatile("s_waitcnt vmcnt(0)" ::: "memory");
        }
    }
    __syncthreads();
}

namespace pg8 {
#define PG8_LAS __attribute__((address_space(3)))
typedef unsigned short bf16_t;
typedef short bf16x8 __attribute__((ext_vector_type(8)));
typedef float f32x4 __attribute__((ext_vector_type(4)));
typedef unsigned u32x4 __attribute__((ext_vector_type(4)));
constexpr int BM = 256, BK = 64, HALF = 128, HTB = HALF * BK * 2  , STAGE_BYTES = 8 * HTB, NXCD = 8, WGM = 8;

__host__ __device__ __forceinline__ int lds_byte(int r, int c) { const int st = (r >> 4) * 2 + (c >> 5), rr = r & 15, cc = c & 31, ob = rr * 64 + cc * 2; return st * 1024 + (ob ^ (((ob >> 9) & 1) << 5)); }
__host__ __device__ __forceinline__ void stage_rc(int b, int& R, int& C) { const int st = b / 1024, sb = b % 1024, swz = sb ^ (((sb >> 9) & 1) << 5); R = (st >> 1) * 16 + swz / 64; C = (st & 1) * 32 + (swz % 64) / 2; }
__host__ __device__ __forceinline__ int perm32(int rho) { const int n = rho >> 4, i = rho & 15; return 8 * (i >> 2) + 4 * n + (i & 3); }

struct Unit { int pm, pn; };
struct Gemm { const bf16_t* A; const bf16_t* Bt; int M, N, K; };

struct StaticOrder {
    int nM, nN, nwg, G, c;
    __host__ __device__ void init(int M, int N, int G_, int c_) { nM = M / BM; nN = N / BM; nwg = nM * nN; G = G_; c = c_; }
    __host__ __device__ bool next(int i, Unit& u) const {
        const long L = (long)i * G + c; if (L >= nwg) return false;
        int wgid = (int)L; { const int q = nwg / NXCD, r = nwg % NXCD, xcd = wgid % NXCD, off = wgid / NXCD; wgid = (xcd < r ? xcd * (q + 1) : r * (q + 1) + (xcd - r) * q) + off; }
        const int nig = WGM * nN, gid = wgid / nig, fm = gid * WGM, gsz = (nM - fm) < WGM ? (nM - fm) : WGM;
        u.pm = fm + ((wgid % nig) % gsz); u.pn = (wgid % nig) / gsz; return true;
    }
    __device__ __forceinline__ void a_ready(const Unit&) const {}
    __device__ __forceinline__ void done(const Unit&) const {}
};
struct CountedOrder : StaticOrder {
    const unsigned* ready; unsigned need; unsigned* tmo;
    __device__ __forceinline__ void a_ready(const Unit& u) const {
        if (threadIdx.x < 64) {
            const unsigned long long t0 = __builtin_amdgcn_s_memrealtime(); unsigned polls = 0;
            while ((unsigned)__builtin_amdgcn_readfirstlane(__hip_atomic_load(ready + 64 * u.pm, __ATOMIC_RELAXED, __HIP_MEMORY_SCOPE_AGENT)) < need) {
                if ((++polls & 255u) == 0u && __builtin_amdgcn_readfirstlane(__hip_atomic_load(tmo, __ATOMIC_RELAXED, __HIP_MEMORY_SCOPE_AGENT)) != 0u) break;
                if (__builtin_amdgcn_s_memrealtime() - t0 > 2000000ull) {
                    if (threadIdx.x == 0) { unsigned expect = 0u; __hip_atomic_compare_exchange_strong(tmo + 1, &expect, 0x600u | (unsigned)(u.pm & 0xff), __ATOMIC_RELAXED, __ATOMIC_RELAXED, __HIP_MEMORY_SCOPE_AGENT); __hip_atomic_store(tmo, 1u, __ATOMIC_RELAXED, __HIP_MEMORY_SCOPE_AGENT); }
                    break; }
                __builtin_amdgcn_s_sleep(2); }
            __builtin_amdgcn_fence(__ATOMIC_ACQUIRE, "agent");
            asm volatile("s_waitcnt vmcnt(0)" ::: "memory");
        }
#if !defined(BROKEN_HOOK_NO_BARRIER)
        asm volatile("" ::: "memory"); __builtin_amdgcn_s_barrier(); asm volatile("" ::: "memory");
#endif
    }
};

__device__ __forceinline__ unsigned cvt_pk_bf16(float lo, float hi) { unsigned r; asm volatile("v_cvt_pk_bf16_f32 %0, %1, %2" : "=v"(r) : "v"(lo), "v"(hi)); return r; }
typedef float f32x2 __attribute__((ext_vector_type(2)));
__device__ __forceinline__ f32x2 gelu_pk(f32x2 v) {
    const f32x2 av = __builtin_elementwise_abs(v), d = av * 0.2316418882f + 1.0f;
    f32x2 t; t.x = __builtin_amdgcn_rcpf(d.x); t.y = __builtin_amdgcn_rcpf(d.y);
    f32x2 q = t * 0.5307027145f + (-0.7265760135f); q = q * t + 0.7107068705f; q = q * t + (-0.142248368f); q = q * t + 0.127414796f; q = q * t;
    const f32x2 s = (v * v) * (-0.72134752044f);
    f32x2 e; e.x = __builtin_amdgcn_exp2f(s.x); e.y = __builtin_amdgcn_exp2f(s.y);
    const f32x2 m = v * (q * e), r = v - m;
    f32x2 o; o.x = v.x < 0.f ? m.x : r.x; o.y = v.y < 0.f ? m.y : r.y; return o;
}

struct EpiF32 {
    static constexpr bool PERM = false, AFTER_DRAIN = false;
    float* C; int ldc; const float* bias;
    __device__ __forceinline__ void operator()(const f32x4 (&acc)[2][2][4][2], const Unit& u, int wr, int wc, int fr, int fq) const {
        const int row0 = u.pm * BM + wr * 64 + fr, col0 = u.pn * BM + wc * 32 + 4 * fq;
        f32x4 bv[2][2];
#pragma unroll
        for (int bj = 0; bj < 2; ++bj)
#pragma unroll
            for (int n = 0; n < 2; ++n) bv[bj][n] = bias ? *(const f32x4*)(bias + col0 + bj * HALF + n * 16) : (f32x4){0.f, 0.f, 0.f, 0.f};
#pragma unroll
        for (int ai = 0; ai < 2; ++ai)
#pragma unroll
            for (int m = 0; m < 4; ++m) { float* rowp = C + (size_t)(row0 + ai * HALF + m * 16) * ldc + col0;
#pragma unroll
                for (int bj = 0; bj < 2; ++bj)
#pragma unroll
                    for (int n = 0; n < 2; ++n) *(f32x4*)(rowp + bj * HALF + n * 16) = acc[ai][bj][m][n] + bv[bj][n]; }
    }
};
template <int ACT  > struct EpiBf16 {
    static constexpr bool PERM = true, AFTER_DRAIN = false;
    bf16_t* O; int ldc; const float* bias; int split_cols; size_t split_stride;
    __device__ __forceinline__ void operator()(const f32x4 (&acc)[2][2][4][2], const Unit& u, int wr, int wc, int fr, int fq) const {
        const int row0 = u.pm * BM + wr * 64 + fr; int colt = u.pn * BM; bf16_t* base = O;
        if (split_cols) { const int t = colt / split_cols; base += (size_t)t * split_stride; colt -= t * split_cols; }
        const int col0 = colt + wc * 32 + 8 * fq, bcol0 = u.pn * BM + wc * 32 + 8 * fq;
        f32x4 bv[2][2];
#pragma unroll
        for (int bj = 0; bj < 2; ++bj)
#pragma unroll
            for (int n = 0; n < 2; ++n) bv[bj][n] = bias ? *(const f32x4*)(bias + bcol0 + bj * HALF + 4 * n) : (f32x4){0.f, 0.f, 0.f, 0.f};
#pragma unroll
        for (int ai = 0; ai < 2; ++ai)
#pragma unroll
            for (int m = 0; m < 4; ++m) { bf16_t* rowp = base + (size_t)(row0 + ai * HALF + m * 16) * ldc + col0;
#pragma unroll
                for (int bj = 0; bj < 2; ++bj) { f32x4 v0 = acc[ai][bj][m][0] + bv[bj][0], v1 = acc[ai][bj][m][1] + bv[bj][1];
                    if (ACT == 1) { f32x2 a = gelu_pk((f32x2){v0[0], v0[1]}), b = gelu_pk((f32x2){v0[2], v0[3]}), c = gelu_pk((f32x2){v1[0], v1[1]}), d = gelu_pk((f32x2){v1[2], v1[3]});
                        v0 = (f32x4){a.x, a.y, b.x, b.y}; v1 = (f32x4){c.x, c.y, d.x, d.y}; }
                    if (ACT == 2) {
#pragma unroll
                        for (int j = 0; j < 4; ++j) { v0[j] = 0.5f * v0[j] * (1.0f + erff(v0[j] * 0.70710678f)); v1[j] = 0.5f * v1[j] * (1.0f + erff(v1[j] * 0.70710678f)); } }
                    u32x4 w; w.x = cvt_pk_bf16(v0[0], v0[1]); w.y = cvt_pk_bf16(v0[2], v0[3]); w.z = cvt_pk_bf16(v1[0], v1[1]); w.w = cvt_pk_bf16(v1[2], v1[3]);
                    *(u32x4*)(rowp + bj * HALF) = w; } }
    }
};
template <class Epi, class Sched, bool STAMP = false>
__device__ __forceinline__ void gemm_phase(PG8_LAS unsigned char* lds, const Gemm g, const Sched& S, const Epi& E, unsigned long long* stamps) {
    const int tid = ltid(), wid = __builtin_amdgcn_readfirstlane(tid >> 6), lane = tid & 63, wr = wid >> 2, wc = wid & 3, fr = lane & 15, fq = lane >> 4;
    const int K = g.K, nt = K / BK;
    int ts_lo = 0, ts_hi = 0, nts = 0; const unsigned long long rt_entry = STAMP ? (unsigned long long)wall_clock64() : 0ull;
#define PG8_STAMP() do { if (STAMP && wid == 0 && nts < 64) { const unsigned long long _c = (unsigned long long)clock64(); \
        ts_lo = (lane == nts) ? (int)(unsigned)_c : ts_lo; ts_hi = (lane == nts) ? (int)(unsigned)(_c >> 32) : ts_hi; ++nts; } } while (0)
    PG8_STAMP();
    unsigned voffA[2], voffB[2];
#pragma unroll
    for (int i = 0; i < 2; ++i) { int R, C; stage_rc(tid * 16 + i * 8192, R, C); const int Rb = Epi::PERM ? ((R & ~31) + perm32(R & 31)) : R;
        voffA[i] = (unsigned)(R * K + C) * 2u; voffB[i] = (unsigned)(Rb * K + C) * 2u; }
    const size_t kstep = (size_t)(BK * 2);
    const size_t hstep = (size_t)HALF * K * 2;
    const size_t tstep = 2 * hstep;
    const unsigned ldsw = (unsigned)wid * 1024u;
    const int aoff = lds_byte(wr * 64 + fr, fq * 8), boff = lds_byte(wc * 32 + fr, fq * 8);
#define PG8_SA(b, h) (((b) * 2 + (h)) * HTB)
#define PG8_SB(b, h) ((4 + (b) * 2 + (h)) * HTB)
#define PG8_STAGE(bufoff, gbase, voff) do { _Pragma("unroll") for (int _i = 0; _i < 2; ++_i) \
        __builtin_amdgcn_global_load_lds((const unsigned*)((const char*)(gbase) + (voff)[_i]), (PG8_LAS unsigned*)(lds + (bufoff) + ldsw + _i * 8192), 16, 0, 0); } while (0)
#define PG8_LDA(dst, b, h) do { _Pragma("unroll") for (int m = 0; m < 4; ++m) _Pragma("unroll") for (int k = 0; k < 2; ++k) dst[m][k] = *(const PG8_LAS bf16x8*)(lds + PG8_SA(b, h) + aoff + m * 2048 + k * 1024); } while (0)
#define PG8_LDB(dst, b, h) do { _Pragma("unroll") for (int n = 0; n < 2; ++n) _Pragma("unroll") for (int k = 0; k < 2; ++k) dst[n][k] = *(const PG8_LAS bf16x8*)(lds + PG8_SB(b, h) + boff + n * 2048 + k * 1024); } while (0)
#define PG8_MMA(ai, bj, At, Bt) do { __builtin_amdgcn_s_setprio(1); _Pragma("unroll") for (int m = 0; m < 4; ++m) _Pragma("unroll") for (int n = 0; n < 2; ++n) _Pragma("unroll") for (int k = 0; k < 2; ++k) \
        acc[ai][bj][m][n] = __builtin_amdgcn_mfma_f32_16x16x32_bf16(Bt[n][k], At[m][k], acc[ai][bj][m][n], 0, 0, 0); __builtin_amdgcn_s_setprio(0); } while (0)
#define PG8_WAIT_V(n) asm volatile("s_waitcnt vmcnt(" #n ")" ::: "memory")
#define PG8_WAIT_L(n) asm volatile("s_waitcnt lgkmcnt(" #n ")" ::: "memory")
#define PG8_BAR __builtin_amdgcn_s_barrier()
#define PG8_SCHED __builtin_amdgcn_sched_barrier(0)
    Unit cur, nxt; int ui = 0;
    if (!S.next(0, cur)) return;
    f32x4 acc[2][2][4][2];
#pragma unroll
    for (int a = 0; a < 2; ++a)
#pragma unroll
        for (int b = 0; b < 2; ++b)
#pragma unroll
            for (int m = 0; m < 4; ++m)
#pragma unroll
                for (int n = 0; n < 2; ++n) acc[a][b][m][n] = (f32x4){0.f, 0.f, 0.f, 0.f};
    bf16x8 At[4][2], B0[2][2], B1[2][2];
    const char* cA = (const char*)g.A + (size_t)cur.pm * tstep; const char* cB = (const char*)g.Bt + (size_t)cur.pn * tstep;
    S.a_ready(cur);
    PG8_STAGE(PG8_SB(0, 0), cB, voffB); PG8_STAGE(PG8_SA(0, 0), cA, voffA); PG8_STAGE(PG8_SB(0, 1), cB + hstep, voffB); PG8_STAGE(PG8_SA(0, 1), cA + hstep, voffA);
    if (wr == 1) PG8_BAR;
    PG8_WAIT_V(4); PG8_BAR;
    PG8_STAGE(PG8_SB(1, 0), cB + kstep, voffB); PG8_STAGE(PG8_SA(1, 0), cA + kstep, voffA); PG8_STAGE(PG8_SB(1, 1), cB + hstep + kstep, voffB);
    PG8_WAIT_V(6); PG8_BAR;
    PG8_STAMP();
    for (;;) {
        const bool has_next = S.next(ui + 1, nxt);
        const char* nA = has_next ? (const char*)g.A + (size_t)nxt.pm * tstep : cA; const char* nB = has_next ? (const char*)g.Bt + (size_t)nxt.pn * tstep : cB;
        for (int t = 0; t < nt; t += 2) {
            const bool last = (t == nt - 2);
            const char* a1 = cA + (size_t)(t + 1) * kstep;
            const char* a2 = last ? nA : cA + (size_t)(t + 2) * kstep; const char* b2 = last ? nB : cB + (size_t)(t + 2) * kstep;
            const char* a3 = a2 + kstep; const char* b3 = b2 + kstep;
            if (last && has_next) S.a_ready(nxt);
            PG8_LDB(B0, 0, 0); PG8_SCHED; PG8_LDA(At, 0, 0); PG8_STAGE(PG8_SA(1, 1), a1 + hstep, voffA);
            PG8_WAIT_L(8); PG8_BAR; PG8_WAIT_L(0); PG8_MMA(0, 0, At, B0); PG8_BAR; PG8_SCHED;
            PG8_LDB(B1, 0, 1); PG8_STAGE(PG8_SB(0, 0), b2, voffB);
            PG8_BAR; PG8_WAIT_L(0); PG8_MMA(0, 1, At, B1); PG8_BAR;
            PG8_LDA(At, 0, 1); PG8_STAGE(PG8_SA(0, 0), a2, voffA);
            PG8_BAR; PG8_WAIT_L(0); PG8_MMA(1, 0, At, B0); PG8_BAR; PG8_SCHED;
            PG8_STAGE(PG8_SB(0, 1), b2 + hstep, voffB);
            PG8_WAIT_V(6); PG8_BAR; PG8_MMA(1, 1, At, B1); PG8_BAR;
            PG8_LDB(B0, 1, 0); PG8_SCHED; PG8_LDA(At, 1, 0); PG8_STAGE(PG8_SA(0, 1), a2 + hstep, voffA);
            PG8_WAIT_L(8); PG8_BAR; PG8_WAIT_L(0); PG8_MMA(0, 0, At, B0); PG8_BAR; PG8_SCHED;
            PG8_LDB(B1, 1, 1); PG8_STAGE(PG8_SB(1, 0), b3, voffB);
            PG8_BAR; PG8_WAIT_L(0); PG8_MMA(0, 1, At, B1); PG8_BAR;
            PG8_LDA(At, 1, 1); PG8_STAGE(PG8_SA(1, 0), a3, voffA);
            PG8_BAR; PG8_WAIT_L(0); PG8_MMA(1, 0, At, B0); PG8_BAR; PG8_SCHED;
            PG8_STAGE(PG8_SB(1, 1), b3 + hstep, voffB);
            PG8_WAIT_V(6); PG8_BAR; PG8_MMA(1, 1, At, B1); PG8_BAR;
        }
        PG8_STAMP();
        if constexpr (!Epi::AFTER_DRAIN) { E(acc, cur, wr, wc, fr, fq); S.done(cur); }
        PG8_STAMP();
        if (!has_next) break;
#pragma unroll
        for (int a = 0; a < 2; ++a)
#pragma unroll
            for (int b = 0; b < 2; ++b)
#pragma unroll
                for (int m = 0; m < 4; ++m)
#pragma unroll
                    for (int n = 0; n < 2; ++n) acc[a][b][m][n] = (f32x4){0.f, 0.f, 0.f, 0.f};
        cur = nxt; cA = nA; cB = nB; ++ui;
    }
    PG8_WAIT_V(0);
    if (wr == 0) PG8_BAR;
    PG8_BAR;
    if constexpr (Epi::AFTER_DRAIN) { E.fused(acc, cur, wr, wc, fr, fq, lds, wid, lane); S.done(cur); }
    PG8_STAMP();
    if (STAMP && wid == 0) { stamps[lane] = lane < nts ? (((unsigned long long)(unsigned)ts_hi << 32) | (unsigned)ts_lo) : 0ull;
        if (lane == 62) stamps[62] = rt_entry; if (lane == 63) stamps[63] = (unsigned long long)wall_clock64(); }
#undef PG8_STAMP
#undef PG8_SA
#undef PG8_SB
#undef PG8_STAGE
#undef PG8_LDA
#undef PG8_LDB
#undef PG8_MMA
#undef PG8_WAIT_V
#undef PG8_WAIT_L
#undef PG8_BAR
#undef PG8_SCHED
}
}

DI void st_transpose(const float* __restrict__ src, bf16_t* __restrict__ dst, int K, int N, int Kpad, int Npad, float* lds, int bid, int nb) {
  const int tk = Kpad / 64, tn = Npad / 64;
  for (int it = bid; it < tk * tn; it += nb) {
    const int k0 = (it % tk) * 64, n0 = (it / tk) * 64;
    __syncthreads();
    for (int e = ltid(); e < 4096; e += NTHR) { const int i = e >> 6, j = e & 63, k = k0 + i, n = n0 + j; lds[i * 65 + j] = (k < K && n < N) ? src[(size_t)k * N + n] : 0.f; }
    __syncthreads();
    for (int e = ltid(); e < 4096; e += NTHR) { const int j = e >> 6, i = e & 63; dst[(size_t)(n0 + j) * Kpad + k0 + i] = f2bf(lds[i * 65 + j]); }
  }
}

DI void st_mods(const Prm& p, float* lds, int bid, int nb) {
  float* s = lds; float* red = lds + 9 * 2048;
  for (int e = ltid(); e < 9 * 2048; e += NTHR) { const int r = e >> 11, k = e & 2047; const float v = r < 8 ? p.c[r * 2048 + k] : p.c_ctx[k]; s[e] = siluf(v); }
  __syncthreads();
  const int kg = ltid() >> 6, cl = ltid() & 63;
  for (int it = bid; it < 2 * 192; it += nb) {
    const int l = it / 192, cb = (it % 192) * 64;
    const float* w = p.w_ada + (size_t)l * 2048 * NMOD + cb + cl;
    float acc[9];
#pragma unroll
    for (int r = 0; r < 9; ++r) acc[r] = 0.f;
    for (int k = kg * 256; k < kg * 256 + 256; ++k) { const float wv = w[(size_t)k * NMOD];
#pragma unroll
      for (int r = 0; r < 9; ++r) acc[r] += s[r * 2048 + k] * wv; }
#pragma unroll
    for (int r = 0; r < 9; ++r) red[(kg * 9 + r) * 64 + cl] = acc[r];
    __syncthreads();
    for (int e = ltid(); e < 576; e += NTHR) { const int r = e >> 6, c2 = e & 63; float t = 0.f;
      for (int g = 0; g < 8; ++g) t += red[(g * 9 + r) * 64 + c2];
      p.mod[((size_t)l * 9 + r) * NMOD + cb + c2] = t + p.b_ada[l * NMOD + cb + c2]; }
    __syncthreads();
  }
}

DI void st_tables(const Prm& p, int bid, int nb) {
  const size_t stride = (size_t)nb * NTHR, t0 = (size_t)bid * NTHR + ltid();
  for (size_t e = t0; e < (size_t)4096 * 8192; e += stride) { const int k1 = (int)(e >> 13), n = (int)(e & 8191), n1 = n & 4095, idx = (k1 * n1) & 4095;
    float sv, cv; sincosf((float)idx * (6.283185307179586f / 4096.f), &sv, &cv); p.DFTM[e] = f2bf((n < 4096 ? cv : -sv) * (1.f / 64.f)); }
  for (size_t e = t0; e < (size_t)256 * 512; e += stride) { const int k1 = (int)(e >> 9), n = (int)(e & 511), n1 = n & 255, idx = (k1 * n1) & 255;
    float sv, cv; sincosf((float)idx * (6.283185307179586f / 256.f), &sv, &cv); p.DFTC[e] = f2bf((n < 256 ? cv : -sv) * (1.f / 16.f)); }
  for (size_t e = t0; e < (size_t)2 * 128 * 128; e += stride) { const int tb = (int)(e >> 14), k2 = (int)((e >> 7) & 127), n2 = (int)(e & 127), idx = (k2 * n2) & 127;
    float sv, cv; sincosf((float)idx * (6.283185307179586f / 128.f), &sv, &cv); p.CCS[e] = (tb ? sv : cv) * 0.08838834764831845f; }
}

DI void st_modulate(const Prm& p, int layer, int which, bf16_t* __restrict__ dst, int bid, int nb) {
  const int wave = ltid() >> 6, lane = ltid() & 63;
  const int shoff = which ? 3 * DM : 0, scoff = which ? 4 * DM : DM;
  for (int row = bid * 8 + wave; row < MR; row += nb * 8) {
    const int b = row / LT, t = row - b * LT; const bool isc = t >= LL;
    const float* src = (layer == 0 && which == 0) ? (isc ? p.ctx + (size_t)(b * LCX + t - LL) * DM : p.x + (size_t)(b * LL + t) * DM) : p.X + (size_t)row * DM;
    f32x4 v[8]; float ss = 0.f;
#pragma unroll
    for (int i = 0; i < 8; ++i) { v[i] = *(const f32x4*)(src + (i * 64 + lane) * 4); ss += v[i][0] * v[i][0] + v[i][1] * v[i][1] + v[i][2] * v[i][2] + v[i][3] * v[i][3]; }
    ss = wsum(ss); const float rstd = rsqrtf(ss * (1.f / 2048.f) + EPSV);
    const float* mr = p.mod + ((size_t)layer * 9 + (isc ? 8 : b)) * NMOD;
#pragma unroll
    for (int i = 0; i < 8; ++i) { const int col = (i * 64 + lane) * 4; const f32x4 sc = *(const f32x4*)(mr + scoff + col), sh = *(const f32x4*)(mr + shoff + col);
      const f32x4 o = v[i] * rstd * (sc + 1.f) + sh; u32x2 w; w.x = pack2(o[0], o[1]); w.y = pack2(o[2], o[3]); *(u32x2*)(dst + (size_t)row * DM + col) = w; }
  }
}

DI void st_dnprep(const Prm& p, int layer, int bid, int nb) {
  const int wave = ltid() >> 6, lane = ltid() & 63;
  const float* conv = p.dn_conv + (size_t)layer * 5 * 1536;
  for (int task = bid * 8 + wave; task < (MR / 32) * 13; task += nb * 8) {
    const int tile = task / 13, grp = task - tile * 13, row0 = tile * 32;
    const int b = row0 / LT, t0 = row0 - b * LT; const bool isc = t0 >= LL;
    const int segt0 = isc ? t0 - LL : t0, seglen = isc ? LCX : LL;
    if (grp < 12) {
      const int c = grp * 128 + lane * 2;
      float w0[5], w1[5];
#pragma unroll
      for (int j = 0; j < 5; ++j) { w0[j] = conv[j * 1536 + c]; w1[j] = conv[j * 1536 + c + 1]; }
      unsigned zz[36];
#pragma unroll
      for (int r = 0; r < 36; ++r) { const int tt = segt0 + r - 2; zz[r] = (tt >= 0 && tt < seglen) ? *(const unsigned*)(p.Z + (size_t)(row0 + r - 2) * NZ + c) : 0u; }
#pragma unroll
      for (int r = 0; r < 32; ++r) { float a0 = 0.f, a1 = 0.f;
#pragma unroll
        for (int j = 0; j < 5; ++j) { a0 += __uint_as_float(zz[r + j] << 16) * w0[j]; a1 += __uint_as_float(zz[r + j] & 0xffff0000u) * w1[j]; }
        a0 = siluf(a0); a1 = siluf(a1);
        if (grp < 8) { const float ss = wsum(a0 * a0 + a1 * a1); const float sc = rsqrtf(ss + EPSV) * (grp < 4 ? 0.08838834764831845f : 1.f); a0 *= sc; a1 *= sc; }
        *(unsigned*)(p.DNQ + (size_t)(row0 + r) * 1536 + c) = pack2(a0, a1); }
    } else {
#pragma unroll
      for (int rr = 0; rr < 8; ++rr) { const int idx = lane + 64 * rr, row = row0 + (idx >> 4), wh = idx & 15, isb = wh >> 3, dh = wh & 7;
        const float z = bf2f(p.Z[(size_t)row * NZ + (isb ? C_DNB : C_DNA) + dh]); float o;
        if (!isb) { const float xx = z + p.dn_dt_bias[layer * 8 + dh]; const float sp = xx > 20.f ? xx : log1pf(expf(xx)); o = -expf(p.dn_a_log[layer * 8 + dh]) * sp; }
        else o = sigmf(z);
        p.GB[(size_t)row * 16 + wh] = o; }
    }
  }
}

DI void st_mlaprep(const Prm& p, int layer, int bid, int nb) {
  const int wave = ltid() >> 6, lane = ltid() & 63;
  const float* qn = p.mla_q_norm + layer * 448; const float* kvn = p.mla_kv_norm + layer * 128;
  for (int row = bid * 8 + wave; row < MR; row += nb * 8) {
    const bf16_t* z = p.Z + (size_t)row * NZ; const int b = row / LT, t = row - b * LT;
    float v[8]; float ss = 0.f;
#pragma unroll
    for (int k = 0; k < 8; ++k) v[k] = 0.f;
    if (lane < 56) { const u32x4 w = *(const u32x4*)(z + C_CQ + lane * 8);
#pragma unroll
      for (int k = 0; k < 4; ++k) { v[2 * k] = __uint_as_float(w[k] << 16); v[2 * k + 1] = __uint_as_float(w[k] & 0xffff0000u); ss += v[2 * k] * v[2 * k] + v[2 * k + 1] * v[2 * k + 1]; } }
    ss = wsum(ss); float rstd = rsqrtf(ss * (1.f / 448.f) + EPSV);
    { u32x4 o = {0u, 0u, 0u, 0u};
      if (lane < 56) { const f32x4 n0 = *(const f32x4*)(qn + lane * 8), n1 = *(const f32x4*)(qn + lane * 8 + 4);
        o.x = pack2(v[0] * rstd * n0[0], v[1] * rstd * n0[1]); o.y = pack2(v[2] * rstd * n0[2], v[3] * rstd * n0[3]); o.z = pack2(v[4] * rstd * n1[0], v[5] * rstd * n1[1]); o.w = pack2(v[6] * rstd * n1[2], v[7] * rstd * n1[3]); }
      *(u32x4*)(p.Aq + (size_t)row * 512 + lane * 8) = o; }
    ss = 0.f;
    if (lane < 16) { const u32x4 w = *(const u32x4*)(z + C_CKV + lane * 8);
#pragma unroll
      for (int k = 0; k < 4; ++k) { v[2 * k] = __uint_as_float(w[k] << 16); v[2 * k + 1] = __uint_as_float(w[k] & 0xffff0000u); ss += v[2 * k] * v[2 * k] + v[2 * k + 1] * v[2 * k + 1]; } }
    ss = wsum(ss); rstd = rsqrtf(ss * (1.f / 128.f) + EPSV);
    if (lane < 32) { u32x4 o = {0u, 0u, 0u, 0u};
      if (lane < 16) { const f32x4 n0 = *(const f32x4*)(kvn + lane * 8), n1 = *(const f32x4*)(kvn + lane * 8 + 4);
        o.x = pack2(v[0] * rstd * n0[0], v[1] * rstd * n0[1]); o.y = pack2(v[2] * rstd * n0[2], v[3] * rstd * n0[3]); o.z = pack2(v[4] * rstd * n1[0], v[5] * rstd * n1[1]); o.w = pack2(v[6] * rstd * n1[2], v[7] * rstd * n1[3]); }
      *(u32x4*)(p.Akv + (size_t)row * 256 + lane * 8) = o; }
    if (t < LL) {
      if (lane < 32) { const int half = lane >> 4, i = lane & 15; const float x1 = bf2f(z[C_KR + half * 32 + i]), x2 = bf2f(z[C_KR + half * 32 + 16 + i]);
        const float pos = (float)(half ? (t & 63) : (t >> 6)); const float ang = pos * exp2f(-(float)i * (13.287712379549449f / 16.f)); float sv, cv; sincosf(ang, &sv, &cv);
        p.KR[(size_t)row * 64 + half * 32 + i] = f2bf(x1 * cv - x2 * sv); p.KR[(size_t)row * 64 + half * 32 + 16 + i] = f2bf(x2 * cv + x1 * sv); }
    } else p.KR[(size_t)row * 64 + lane] = z[C_KR + lane];
  }
}

DI void st_qrope(const Prm& p, int bid, int nb) {
  const int wave = ltid() >> 6, lane = ltid() & 63;
  for (int row = bid * 8 + wave; row < MR; row += nb * 8) {
    const int b = row / LT, t = row - b * LT; if (t >= LL) continue;
#pragma unroll
    for (int k = 0; k < 2; ++k) { const int pid = lane + 64 * k, h = pid >> 5, r = pid & 31, half = r >> 4, i = r & 15;
      bf16_t* q = p.Qraw + (size_t)row * 768 + h * 192 + 128 + half * 32; const float x1 = bf2f(q[i]), x2 = bf2f(q[16 + i]);
      const float pos = (float)(half ? (t & 63) : (t >> 6)); const float ang = pos * exp2f(-(float)i * (13.287712379549449f / 16.f)); float sv, cv; sincosf(ang, &sv, &cv);
      q[i] = f2bf(x1 * cv - x2 * sv); q[16 + i] = f2bf(x2 * cv + x1 * sv); }
  }
}

DI void st_fnchan(const Prm& p, unsigned char* lds, int bid, int nb) {
  bf16_t* wt = (bf16_t*)lds;
  bf16_t* zt = (bf16_t*)(lds + 256 * 272);
  const int tid = ltid(), wave = tid >> 6, lane = tid & 63, r32 = lane & 31, hi = lane >> 5;
  __syncthreads();
  for (int e = tid; e < 256 * 128; e += NTHR) wt[(e >> 7) * 136 + (e & 127)] = f2bf(p.CCS[e]);
  for (int it = bid; it < (MR / 64) * 4; it += nb) {
    const int tile = it >> 2, g = it & 3, row0 = tile * 64, b = row0 / LT, t0 = row0 - b * LT;
    __syncthreads();
    for (int e = tid; e < 1024; e += NTHR) { const int r = e >> 4, c8 = (e & 15) * 8; *(u32x4*)(zt + r * 136 + c8) = *(const u32x4*)(p.Z + (size_t)(row0 + r) * NZ + C_FN + g * 128 + c8); }
    __syncthreads();
    f32x16 acc[2] = {};
#pragma unroll
    for (int k8 = 0; k8 < 8; ++k8) { const bf16x8 a = *(const bf16x8*)(wt + (wave * 32 + r32) * 136 + k8 * 16 + hi * 8);
#pragma unroll
      for (int tt = 0; tt < 2; ++tt) { const bf16x8 bb = *(const bf16x8*)(zt + (tt * 32 + r32) * 136 + k8 * 16 + hi * 8); acc[tt] = __builtin_amdgcn_mfma_f32_32x32x16_bf16(a, bb, acc[tt], 0, 0, 0); } }
    const int tb = wave >> 2;
#pragma unroll
    for (int tt = 0; tt < 2; ++tt)
#pragma unroll
      for (int r = 0; r < 16; ++r) { const int k2 = (wave & 3) * 32 + (r & 3) + 8 * (r >> 2) + 4 * hi;
        if (t0 < LL) p.PQT[((size_t)(b * 512 + g * 128 + k2)) * 8192 + tb * 4096 + t0 + tt * 32 + r32] = f2bf(acc[tt][r]);
        else p.PQTc[((size_t)(b * 512 + g * 128 + k2)) * 512 + tb * 256 + (t0 - LL) + tt * 32 + r32] = f2bf(acc[tt][r]); }
  }
}

DI int scan_row(int b, int dir, int s) { return s < LCX ? b * LT + LL + (dir ? LCX - 1 - s : s) : b * LT + (dir ? LL - 1 - (s - LCX) : (s - LCX)); }

DI void st_dnscan(const Prm& p, float* lds, int bid, int nb) {
  const int tid = ltid(), cc = tid >> 3, part = tid & 7;
  for (int item = bid; item < 128; item += nb) {
    const int chain = item >> 1, half = item & 1, b = chain >> 3, h = (chain >> 1) & 3, dir = chain & 1;
    f32x2 S[8];
#pragma unroll
    for (int j = 0; j < 8; ++j) S[j] = (f32x2){0.f, 0.f};
    constexpr int QP = 132, OQ = 0, OK_ = 32 * QP, OV = 2 * 32 * QP, OG = OV + 2048, OO = OG + 64, BUF = OO + 2048;
    bf16x8 pf[3]; float pg = 0.f;
    auto gload = [&](int batch) {
#pragma unroll
      for (int r = 0; r < 3; ++r) { const int e = tid + NTHR * r; if (e < 1280) { const int i = e / 40, ch = e - i * 40; const int row = scan_row(b, dir, batch * 32 + i);
          const int col = ch < 16 ? h * 128 + ch * 8 : (ch < 32 ? 512 + h * 128 + (ch - 16) * 8 : 1024 + h * 128 + half * 64 + (ch - 32) * 8);
          pf[r] = *(const bf16x8*)(p.DNQ + (size_t)row * 1536 + col); } }
      if (tid < 64) { const int i = tid >> 1, wh = tid & 1; const int row = scan_row(b, dir, batch * 32 + i); pg = p.GB[(size_t)row * 16 + wh * 8 + dir * 4 + h]; }
    };
    auto lstore = [&](float* bufp) {
#pragma unroll
      for (int r = 0; r < 3; ++r) { const int e = tid + NTHR * r; if (e < 1280) { const int i = e / 40, ch = e - i * 40;
          float* d = ch < 16 ? bufp + OQ + i * QP + ch * 8 + (ch >> 3) * 4 : (ch < 32 ? bufp + OK_ + i * QP + (ch - 16) * 8 + ((ch - 16) >> 3) * 4 : bufp + OV + i * 64 + (ch - 32) * 8);
#pragma unroll
          for (int j = 0; j < 8; ++j) d[j] = bf2f((bf16_t)pf[r][j]); } }
      if (tid < 64) { const int i = tid >> 1, wh = tid & 1; bufp[OG + i * 2 + wh] = wh ? pg : expf(pg); }
    };
    __syncthreads();
    gload(0); lstore(lds); __syncthreads();
    const int poff = part * 16 + (part >> 2) * 4;
    for (int batch = 0; batch < LT / 32; ++batch) {
      float* cur = lds + (batch & 1) * BUF; float* nxt = lds + ((batch + 1) & 1) * BUF;
      if (batch + 1 < LT / 32) gload(batch + 1);
      const float* q_s = cur + OQ + poff; const float* k_s = cur + OK_ + poff; const float* v_s = cur + OV + cc; const float* gb_s = cur + OG; float* o_s = cur + OO;
      f32x4 kn[4], qn[4]; f32x2 abn; float vvn;
#pragma unroll
      for (int j = 0; j < 4; ++j) { kn[j] = *(const f32x4*)(k_s + j * 4); qn[j] = *(const f32x4*)(q_s + j * 4); }
      abn = *(const f32x2*)gb_s; vvn = v_s[0];
#pragma unroll 2
      for (int i = 0; i < 32; ++i) {
        f32x2 k2[8], q2[8];
#pragma unroll
        for (int j = 0; j < 4; ++j) { k2[2 * j] = (f32x2){kn[j][0], kn[j][1]}; k2[2 * j + 1] = (f32x2){kn[j][2], kn[j][3]}; q2[2 * j] = (f32x2){qn[j][0], qn[j][1]}; q2[2 * j + 1] = (f32x2){qn[j][2], qn[j][3]}; }
        const float a = abn[0], beta = abn[1], vv = vvn;
        { const int in = i < 31 ? i + 1 : 31;
#pragma unroll
          for (int j = 0; j < 4; ++j) { kn[j] = *(const f32x4*)(k_s + in * QP + j * 4); qn[j] = *(const f32x4*)(q_s + in * QP + j * 4); }
          abn = *(const f32x2*)(gb_s + in * 2); vvn = v_s[in * 64]; }
        f32x2 d0 = k2[0] * S[0], d1 = k2[1] * S[1];
#pragma unroll
        for (int j = 2; j < 8; j += 2) { d0 += k2[j] * S[j]; d1 += k2[j + 1] * S[j + 1]; }
        d0 += d1; const float ks = a * red8(d0[0] + d0[1]);
        const float vn = beta * (vv - ks); const f32x2 vn2 = (f32x2){vn, vn}, a2 = (f32x2){a, a};
        f32x2 o0 = (f32x2){0.f, 0.f}, o1 = (f32x2){0.f, 0.f};
#pragma unroll
        for (int j = 0; j < 8; j += 2) { S[j] = S[j] * a2 + k2[j] * vn2; S[j + 1] = S[j + 1] * a2 + k2[j + 1] * vn2; o0 += q2[j] * S[j]; o1 += q2[j + 1] * S[j + 1]; }
        o0 += o1; const float o = red8(o0[0] + o0[1]);
        if (part == 0) o_s[i * 64 + cc] = o;
      }
      __syncthreads();
      { const int i = tid >> 4, c4 = (tid & 15) * 4; const int row = scan_row(b, dir, batch * 32 + i); const float* s = o_s + i * 64 + c4;
        u32x2 w; w.x = pack2(s[0], s[1]); w.y = pack2(s[2], s[3]);
        *(u32x2*)(p.OB + ((size_t)(0 * 2 + dir) * MR + row) * 512 + h * 128 + half * 64 + c4) = w; }
      if (batch + 1 < LT / 32) lstore(nxt);
      __syncthreads();
    }
  }
}

DI void st_glascan(const Prm& p, int layer, float* lds, int bid, int nb) {
  const int tid = ltid(), cc = tid >> 3, part = tid & 7;
  for (int item = bid; item < 128; item += nb) {
    const int chain = item >> 1, half = item & 1, b = chain >> 3, h = (chain >> 1) & 3, dir = chain & 1;
    const float* w2 = p.gla_w2 + (size_t)(layer * 2 + dir) * 16 * 256 + h * 64; const float* b2 = p.gla_b2 + (layer * 2 + dir) * 256 + h * 64;
    f32x2 S[4];
#pragma unroll
    for (int j = 0; j < 4; ++j) S[j] = (f32x2){0.f, 0.f};
    constexpr int OQ = 0, OK_ = 2048, OA = 4096, OV = 6144, OO = 8192, OAL = 10240, BUF = 10752;
    bf16x8 pf[2];
    auto gload = [&](int batch) {
#pragma unroll
      for (int r = 0; r < 2; ++r) { const int e = tid + NTHR * r; if (e < 832) { const int i = e / 26, ch = e - i * 26; const int row = scan_row(b, dir, batch * 32 + i);
          const int col = ch < 8 ? C_GQ + h * 64 + ch * 8 : (ch < 16 ? C_GK + h * 64 + (ch - 8) * 8 : (ch < 24 ? C_GV + h * 128 + half * 64 + (ch - 16) * 8 : C_GALPHA + dir * 16 + (ch - 24) * 8));
          pf[r] = *(const bf16x8*)(p.Z + (size_t)row * NZ + col); } }
    };
    auto lstore = [&](float* bufp) {
#pragma unroll
      for (int r = 0; r < 2; ++r) { const int e = tid + NTHR * r; if (e < 832) { const int i = e / 26, ch = e - i * 26;
          float* d = ch < 8 ? bufp + OQ + i * 64 + ch * 8 : (ch < 16 ? bufp + OK_ + i * 64 + (ch - 8) * 8 : (ch < 24 ? bufp + OV + i * 64 + (ch - 16) * 8 : bufp + OAL + i * 16 + (ch - 24) * 8));
          const float sc = ch < 8 ? 0.125f : 1.f;
#pragma unroll
          for (int j = 0; j < 8; ++j) d[j] = bf2f((bf16_t)pf[r][j]) * sc; } }
    };
    auto decay = [&](float* bufp) {
#pragma unroll
      for (int k = 0; k < 4; ++k) { const int e = tid + NTHR * k, i = e >> 6, d = e & 63; float zz = b2[d];
#pragma unroll
        for (int r = 0; r < 16; ++r) zz += bufp[OAL + i * 16 + r] * w2[r * 256 + d];
        const float nz = -zz; const float sp = nz > 20.f ? nz : log1pf(expf(nz));
        bufp[OA + i * 64 + d] = expf(-sp * (1.f / 16.f)); }
    };
    __syncthreads();
    gload(0); lstore(lds); __syncthreads(); decay(lds); __syncthreads();
    for (int batch = 0; batch < LT / 32; ++batch) {
      float* cur = lds + (batch & 1) * BUF; float* nxt = lds + ((batch + 1) & 1) * BUF;
      if (batch + 1 < LT / 32) gload(batch + 1);
      const float* q_s = cur + OQ + part * 8; const float* k_s = cur + OK_ + part * 8; const float* a_s = cur + OA + part * 8; const float* v_s = cur + OV + cc; float* o_s = cur + OO;
      f32x4 an[2], kn[2], qn[2]; float vvn;
#pragma unroll
      for (int j = 0; j < 2; ++j) { an[j] = *(const f32x4*)(a_s + j * 4); kn[j] = *(const f32x4*)(k_s + j * 4); qn[j] = *(const f32x4*)(q_s + j * 4); }
      vvn = v_s[0];
#pragma unroll 2
      for (int i = 0; i < 32; ++i) {
        f32x4 a4[2], k4[2], q4[2];
#pragma unroll
        for (int j = 0; j < 2; ++j) { a4[j] = an[j]; k4[j] = kn[j]; q4[j] = qn[j]; }
        const float vv = vvn; const f32x2 v2 = (f32x2){vv, vv};
        { const int in = i < 31 ? i + 1 : 31;
#pragma unroll
          for (int j = 0; j < 2; ++j) { an[j] = *(const f32x4*)(a_s + in * 64 + j * 4); kn[j] = *(const f32x4*)(k_s + in * 64 + j * 4); qn[j] = *(const f32x4*)(q_s + in * 64 + j * 4); }
          vvn = v_s[in * 64]; }
        f32x2 o0 = (f32x2){0.f, 0.f}, o1 = (f32x2){0.f, 0.f};
#pragma unroll
        for (int j = 0; j < 2; ++j) {
          S[2 * j] = S[2 * j] * (f32x2){a4[j][0], a4[j][1]} + (f32x2){k4[j][0], k4[j][1]} * v2; S[2 * j + 1] = S[2 * j + 1] * (f32x2){a4[j][2], a4[j][3]} + (f32x2){k4[j][2], k4[j][3]} * v2;
          o0 += (f32x2){q4[j][0], q4[j][1]} * S[2 * j]; o1 += (f32x2){q4[j][2], q4[j][3]} * S[2 * j + 1]; }
        o0 += o1; const float o = red8(o0[0] + o0[1]);
        if (part == 0) o_s[i * 64 + cc] = o;
      }
      __syncthreads();
      { const int i = tid >> 4, c4 = (tid & 15) * 4; const int row = scan_row(b, dir, batch * 32 + i); const float* s = o_s + i * 64 + c4;
        u32x2 w; w.x = pack2(s[0], s[1]); w.y = pack2(s[2], s[3]);
        *(u32x2*)(p.OB + ((size_t)(1 * 2 + dir) * MR + row) * 512 + h * 128 + half * 64 + c4) = w; }
      if (batch + 1 < LT / 32) lstore(nxt);
      __syncthreads();
      if (batch + 1 < LT / 32) decay(nxt);
      __syncthreads();
    }
  }
}

DI void st_combine(const Prm& p, int layer, int bid, int nb) {
  const int wave = ltid() >> 6, lane = ltid() & 63;
  for (long task = (long)bid * 8 + wave; task < (long)MR * 8; task += (long)nb * 8) {
    const int row = (int)(task >> 3), mh = (int)(task & 7), mixer = mh >> 2, h = mh & 3;
    const unsigned f = *(const unsigned*)(p.OB + ((size_t)(mixer * 2 + 0) * MR + row) * 512 + h * 128 + lane * 2), g = *(const unsigned*)(p.OB + ((size_t)(mixer * 2 + 1) * MR + row) * 512 + h * 128 + lane * 2);
    const float o0 = bf2f((bf16_t)(f & 0xffffu)) + bf2f((bf16_t)(g & 0xffffu)), o1 = bf2f((bf16_t)(f >> 16)) + bf2f((bf16_t)(g >> 16));
    const float ss = wsum(o0 * o0 + o1 * o1), rstd = rsqrtf(ss * (1.f / 128.f) + EPSV);
    const float* w = (mixer ? p.gla_norm : p.dn_norm) + layer * 128 + lane * 2;
    const unsigned gz = *(const unsigned*)(p.Z + (size_t)row * NZ + (mixer ? C_GGATE : C_DNGATE) + h * 128 + lane * 2);
    const float g0 = bf2f((bf16_t)(gz & 0xffffu)), g1 = bf2f((bf16_t)(gz >> 16));
    *(unsigned*)(p.Y + (size_t)row * DM + mixer * 512 + h * 128 + lane * 2) = pack2(o0 * rstd * w[0] * siluf(g0), o1 * rstd * w[1] * siluf(g1));
  }
}

DI unsigned fkey(float f) { const unsigned u = __float_as_uint(f); return u ^ ((u >> 31) ? 0xffffffffu : 0x80000000u); }
DI int pcnt(unsigned long long m) { return __builtin_popcountll(m); }
DI int lanes_below(unsigned long long m) { return (int)__builtin_amdgcn_mbcnt_hi((unsigned)(m >> 32), __builtin_amdgcn_mbcnt_lo((unsigned)m, 0u)); }
DI void st_peertopk(const Prm& p, int layer, unsigned char* lds, int bid, int nb) {
  bf16_t* ks = (bf16_t*)lds;
  bf16_t* qt = (bf16_t*)(lds + 69632);
  float* sc = (float*)(lds + 69632);
  const int tid = ltid(), wave = tid >> 6, lane = tid & 63, r32 = lane & 31, hi = lane >> 5;
  float* selv = (float*)(lds + 69632 + 33280) + wave * 64; int* seli = (int*)(selv + 32);
  int hcur = -1;
  const int nchunk = MR / 32;
  for (int it = bid; it < 8 * nchunk; it += nb) {
    const int h = it / nchunk, chunk = it - h * nchunk, row0 = chunk * 32;
    __syncthreads();
    if (h != hcur) {
      const float* kg = p.peer_keys + ((size_t)(layer * 8 + h) * 2) * 128 * 128;
      for (int e = tid; e < 2 * 128 * 128; e += NTHR) { const int pn = e >> 7, k = e & 127; ks[pn * 136 + k] = f2bf(kg[e]); }
      hcur = h; }
    for (int e = tid; e < 1024; e += NTHR) { const int r = e >> 5, c8 = (e & 31) * 8; *(u32x4*)(qt + r * 264 + c8) = *(const u32x4*)(p.Qp + (size_t)(row0 + r) * DM + h * 256 + c8); }
    __syncthreads();
    { const int pt = wave >> 2, nt = wave & 3; f32x16 acc = {};
#pragma unroll
      for (int k8 = 0; k8 < 8; ++k8) { const bf16x8 a = *(const bf16x8*)(qt + r32 * 264 + pt * 128 + k8 * 16 + hi * 8), b = *(const bf16x8*)(ks + (pt * 128 + nt * 32 + r32) * 136 + k8 * 16 + hi * 8);
        acc = __builtin_amdgcn_mfma_f32_32x32x16_bf16(a, b, acc, 0, 0, 0); }
      __syncthreads();
#pragma unroll
      for (int r = 0; r < 16; ++r) sc[((r & 3) + 8 * (r >> 2) + 4 * hi) * 260 + pt * 128 + nt * 32 + r32] = acc[r]; }
    __syncthreads();
    for (int rr = 0; rr < 4; ++rr) {
      const int m = wave * 4 + rr, row = row0 + m;
      float s[2][2];
#pragma unroll
      for (int pp = 0; pp < 2; ++pp)
#pragma unroll
        for (int hh = 0; hh < 2; ++hh) s[pp][hh] = sc[m * 260 + pp * 128 + hh * 64 + lane];
      unsigned kk[2][2], T[2] = {0u, 0u};
#pragma unroll
      for (int pp = 0; pp < 2; ++pp) { kk[pp][0] = fkey(s[pp][0]); kk[pp][1] = fkey(s[pp][1]); }
      { unsigned ta = 0u, tb = 0u, da = 0u, db = 0u;
        for (int bit = 31; bit >= 0; --bit) { const unsigned m = 1u << bit;
          const unsigned ca = ta | m, cb = tb | m;
          const unsigned na = (unsigned)(pcnt(__ballot(kk[0][0] >= ca)) + pcnt(__ballot(kk[0][1] >= ca))), nb2 = (unsigned)(pcnt(__ballot(kk[1][0] >= cb)) + pcnt(__ballot(kk[1][1] >= cb)));
          const unsigned oa = (na >= 16u ? 1u : 0u) & ~da, ob = (nb2 >= 16u ? 1u : 0u) & ~db;
          ta |= (0u - oa) & m; tb |= (0u - ob) & m; da |= oa & (na == 16u ? 1u : 0u); db |= ob & (nb2 == 16u ? 1u : 0u);
          if (da & db) break; }
        T[0] = __builtin_amdgcn_readfirstlane(ta); T[1] = __builtin_amdgcn_readfirstlane(tb); }
#pragma unroll
      for (int pp = 0; pp < 2; ++pp) { const unsigned k0 = kk[pp][0], k1 = kk[pp][1], TT = T[pp];
        const unsigned long long g0 = __ballot(k0 > TT), g1 = __ballot(k1 > TT), e0 = __ballot(k0 == TT), e1 = __ballot(k1 == TT);
        const int ng0 = pcnt(g0), ng = ng0 + pcnt(g1), need = 16 - ng, ne0 = pcnt(e0);
        if (k0 > TT) { const int r = lanes_below(g0); selv[pp * 16 + r] = s[pp][0]; seli[pp * 16 + r] = lane; }
        if (k1 > TT) { const int r = ng0 + lanes_below(g1); selv[pp * 16 + r] = s[pp][1]; seli[pp * 16 + r] = lane + 64; }
        if (k0 == TT) { const int r = lanes_below(e0); if (r < need) { selv[pp * 16 + ng + r] = s[pp][0]; seli[pp * 16 + ng + r] = lane; } }
        if (k1 == TT) { const int r = ne0 + lanes_below(e1); if (r < need) { selv[pp * 16 + ng + r] = s[pp][1]; seli[pp * 16 + ng + r] = lane + 64; } } }
      __builtin_amdgcn_wave_barrier();
      float cd[4]; unsigned ck[4]; { const float sa = selv[lane >> 2]; const f32x4 sb = *(const f32x4*)(selv + 16 + (lane & 3) * 4);
#pragma unroll
        for (int q = 0; q < 4; ++q) { cd[q] = sa + sb[q]; ck[q] = fkey(cd[q]); } }
      unsigned T2 = 0u;
      for (int bit = 31; bit >= 0; --bit) { const unsigned m = 1u << bit, c = T2 | m;
        const unsigned n = (unsigned)(pcnt(__ballot(ck[0] >= c)) + pcnt(__ballot(ck[1] >= c)) + pcnt(__ballot(ck[2] >= c)) + pcnt(__ballot(ck[3] >= c)));
        T2 |= (0u - (n >= 16u ? 1u : 0u)) & m; if (n == 16u) break; }
      T2 = __builtin_amdgcn_readfirstlane(T2);
      float mx = fmaxf(fmaxf(cd[0], cd[1]), fmaxf(cd[2], cd[3])); mx = wmax(mx);
      int base = 0; float esum = 0.f; const int ia = seli[lane >> 2]; int rk[4]; float ev[4];
#pragma unroll
      for (int q = 0; q < 4; ++q) { const unsigned long long g = __ballot(ck[q] > T2); rk[q] = ck[q] > T2 ? base + lanes_below(g) : 99; base += pcnt(g); }
#pragma unroll
      for (int q = 0; q < 4; ++q) { const unsigned long long g = __ballot(ck[q] == T2); if (ck[q] == T2) rk[q] = base + lanes_below(g); base += pcnt(g); }
#pragma unroll
      for (int q = 0; q < 4; ++q) { ev[q] = rk[q] < 16 ? __expf(cd[q] - mx) : 0.f; esum += ev[q]; }
      esum = wsum(esum); const float inv = 1.f / esum;
      int* orow = p.IDX + (size_t)row * 128 + h * 16; float* grow = p.GATE + (size_t)row * 128 + h * 16;
#pragma unroll
      for (int q = 0; q < 4; ++q) if (rk[q] < 16) { orow[rk[q]] = ia * 128 + seli[16 + (lane & 3) * 4 + q]; grow[rk[q]] = ev[q] * inv; }
      __builtin_amdgcn_wave_barrier();
    }
  }
}

constexpr float U_SC = 1024.f, V_SC = 16.f;
DI void st_cvt_tables(const Prm& p, int layer, int bid, int nb) {
  const size_t n16 = (size_t)16384 * DM / 16, stride = (size_t)nb * NTHR;
  const float* U = p.peer_u + (size_t)layer * 16384 * DM; const float* V = p.peer_v + (size_t)layer * 16384 * DM;
  for (size_t e = (size_t)bid * NTHR + ltid(); e < 2 * n16; e += stride) { const bool isv = e >= n16; const size_t k = isv ? e - n16 : e;
    const float* src = (isv ? V : U) + k * 16; const float sc = isv ? V_SC : U_SC; u32x4 w;
#pragma unroll
    for (int q = 0; q < 4; ++q) { const f32x4 a = *(const f32x4*)(src + q * 4) * sc; int r = 0;
      r = __builtin_amdgcn_cvt_pk_fp8_f32(a[0], a[1], r, false); r = __builtin_amdgcn_cvt_pk_fp8_f32(a[2], a[3], r, true); w[q] = (unsigned)r; }
    *(u32x4*)((unsigned char*)(isv ? p.Vb : p.Ub) + k * 16) = w; }
}

DI void st_peergather(const Prm& p, int layer, float* lds, int bid, int nb, bool dry = false) {
  const int tid = ltid(), wave = tid >> 6, lane = tid & 63;
  const unsigned char* Ub = (const unsigned char*)p.Ub; const unsigned char* Vb = (const unsigned char*)p.Vb;
  for (int row = bid; row < MR; row += nb) {
    const int b = row / LT, t = row - b * LT; const bool isc = t >= LL;
    if (isc && layer == 1) continue;
    f32x2 hv[16];
#pragma unroll
    for (int i = 0; i < 2; ++i) {
#pragma unroll
      for (int q = 0; q < 2; ++q) { const u32x4 w = *(const u32x4*)(p.H2 + (size_t)row * DM + i * 1024 + lane * 16 + q * 8);
#pragma unroll
        for (int k = 0; k < 4; ++k) hv[i * 8 + q * 4 + k] = (f32x2){__uint_as_float(w[k] << 16), __uint_as_float(w[k] & 0xffff0000u)}; } }
    f32x2 acc[16];
#pragma unroll
    for (int i = 0; i < 16; ++i) acc[i] = (f32x2){0.f, 0.f};
    const int myidx = lane < 16 ? p.IDX[(size_t)row * 128 + wave * 16 + lane] : 0; const float mygate = lane < 16 ? p.GATE[(size_t)row * 128 + wave * 16 + lane] : 0.f;
#pragma unroll 1
    for (int k0 = 0; k0 < 16; k0 += 4) {
      u32x4 uu[4][2], vv[4][2];
#pragma unroll
      for (int q = 0; q < 4; ++q) { const int e = __builtin_amdgcn_readfirstlane(__shfl(myidx, k0 + q));
        const unsigned char* ur = Ub + (size_t)e * DM + lane * 16; const unsigned char* vr = Vb + (size_t)e * DM + lane * 16;
#pragma unroll
        for (int i = 0; i < 2; ++i) { uu[q][i] = *(const u32x4*)(ur + i * 1024); vv[q][i] = *(const u32x4*)(vr + i * 1024); } }
#pragma unroll
      for (int q = 0; q < 4; ++q) { f32x2 d0 = (f32x2){0.f, 0.f}, d1 = (f32x2){0.f, 0.f};
#pragma unroll
        for (int i = 0; i < 2; ++i)
#pragma unroll
          for (int k = 0; k < 4; ++k) { d0 += __builtin_amdgcn_cvt_pk_f32_fp8((int)uu[q][i][k], false) * hv[i * 8 + k * 2]; d1 += __builtin_amdgcn_cvt_pk_f32_fp8((int)uu[q][i][k], true) * hv[i * 8 + k * 2 + 1]; }
        d0 += d1; float d = wsum(d0[0] + d0[1]) * (1.f / U_SC);
        const float wgt = __shfl(mygate, k0 + q) * 0.5f * d * (1.f + erff(d * 0.70710678118654752f)); const f32x2 w2 = (f32x2){wgt, wgt};
#pragma unroll
        for (int i = 0; i < 2; ++i)
#pragma unroll
          for (int k = 0; k < 4; ++k) { acc[i * 8 + k * 2] += w2 * __builtin_amdgcn_cvt_pk_f32_fp8((int)vv[q][i][k], false); acc[i * 8 + k * 2 + 1] += w2 * __builtin_amdgcn_cvt_pk_f32_fp8((int)vv[q][i][k], true); } }
    }
    __syncthreads();
#pragma unroll
    for (int i = 0; i < 2; ++i) { float* d = lds + wave * 2048 + i * 1024 + lane * 16;
#pragma unroll
      for (int k = 0; k < 4; ++k) *(f32x4*)(d + k * 4) = (f32x4){acc[i * 8 + k * 2][0], acc[i * 8 + k * 2][1], acc[i * 8 + k * 2 + 1][0], acc[i * 8 + k * 2 + 1][1]}; }
    __syncthreads();
    { const int col = tid * 4; f32x4 sum = (f32x4){0.f, 0.f, 0.f, 0.f};
#pragma unroll
      for (int w = 0; w < 8; ++w) sum += *(const f32x4*)(lds + w * 2048 + col);
      const f32x4 g2 = *(const f32x4*)(p.mod + ((size_t)layer * 9 + (isc ? 8 : b)) * NMOD + 5 * DM + col) * (1.f / V_SC);
      float* xr = p.X + (size_t)row * DM + col; if (!dry) *(f32x4*)xr = *(const f32x4*)xr + g2 * sum; }
  }
}

DI void st_final(const Prm& p, int bid, int nb) {
  const int wave = ltid() >> 6, lane = ltid() & 63;
  for (int r = bid * 8 + wave; r < NB * LL; r += nb * 8) {
    const int b = r / LL, t = r - b * LL; const float* src = p.X + (size_t)(b * LT + t) * DM;
    f32x4 v[8]; float ss = 0.f;
#pragma unroll
    for (int i = 0; i < 8; ++i) { v[i] = *(const f32x4*)(src + (i * 64 + lane) * 4); ss += v[i][0] * v[i][0] + v[i][1] * v[i][1] + v[i][2] * v[i][2] + v[i][3] * v[i][3]; }
    ss = wsum(ss); const float rstd = rsqrtf(ss * (1.f / 2048.f) + EPSV);
#pragma unroll
    for (int i = 0; i < 8; ++i) { const int col = (i * 64 + lane) * 4; *(f32x4*)(p.out + (size_t)r * DM + col) = v[i] * rstd * *(const f32x4*)(p.final_norm + col); }
  }
}

namespace att {
constexpr int NW = 8, QBLK = 32, KVBLK = 64;
constexpr float SCALE = 0.07216878364870322f;
constexpr float THR = 8.f;
constexpr int LDQ = 768, LDK = 1024, LDKR = 64, LDO = DM;
constexpr int SHM_V = KVBLK * 128 * 2, SHM_K = KVBLK * 128 * 2, SHM_KR = KVBLK * 64 * 2, SHM_ATTN = 2 * SHM_V + 2 * SHM_K + 2 * SHM_KR + NW * 64 * 4;
#define KSWZ(row, colB) ((row) * 256 + ((colB) ^ (((row) & 7) << 4)))
#define KRSWZ(row, colB) ((row) * 128 + ((colB) ^ ((((row) >> 1) & 7) << 4)))
#define SBAR() __builtin_amdgcn_sched_barrier(0)
DI int crow(int r, int hi) { return (r & 3) + 8 * (r >> 2) + 4 * hi; }
DI unsigned cvtpk(float lo, float hi) { unsigned r; asm volatile("v_cvt_pk_bf16_f32 %0, %1, %2" : "=v"(r) : "v"(lo), "v"(hi)); return r; }

DI void partialSM(f32x16& p0, f32x16& p1, float& m_reg, float& mn, float& alpha) {
  constexpr float C = SCALE * 1.4426950408889634f;
  float pmax = p0[0];
#pragma unroll
  for (int r = 1; r < 16; ++r) pmax = fmaxf(pmax, p0[r]);
#pragma unroll
  for (int r = 0; r < 16; ++r) pmax = fmaxf(pmax, p1[r]);
  { auto rr = __builtin_amdgcn_permlane32_swap(__float_as_uint(pmax), __float_as_uint(pmax), false, false);
    pmax = fmaxf(__uint_as_float(rr[0]), __uint_as_float(rr[1])); }
  if (__builtin_expect(__all(pmax - m_reg <= THR / SCALE), 1)) { mn = m_reg; alpha = 1.f; }
  else { mn = fmaxf(m_reg, pmax); alpha = __builtin_amdgcn_exp2f((m_reg - mn) * C); m_reg = mn; }
  const float mnC = -mn * C;
#pragma unroll
  for (int r = 0; r < 16; ++r) p0[r] = fmaf(p0[r], C, mnC);
#pragma unroll
  for (int r = 0; r < 16; ++r) p1[r] = fmaf(p1[r], C, mnC);
#pragma unroll
  for (int r = 0; r < 16; ++r) p0[r] = __builtin_amdgcn_exp2f(p0[r]);
}
DI void finishSM(f32x16& p0, f32x16& p1, float alpha, float& l_reg, bf16x8& pa0, bf16x8& pa1, bf16x8& pa2, bf16x8& pa3) {
#pragma unroll
  for (int r = 0; r < 16; ++r) p1[r] = __builtin_amdgcn_exp2f(p1[r]);
  float ps = 0;
#pragma unroll
  for (int r = 0; r < 16; ++r) ps += p0[r];
#pragma unroll
  for (int r = 0; r < 16; ++r) ps += p1[r];
  { auto rr = __builtin_amdgcn_permlane32_swap(__float_as_uint(ps), __float_as_uint(ps), false, false);
    ps = __uint_as_float(rr[0]) + __uint_as_float(rr[1]); }
  l_reg = l_reg * alpha + ps;
#define PK4(P, BASE, OUT) do { unsigned a0 = cvtpk(P[BASE + 0], P[BASE + 1]), a1 = cvtpk(P[BASE + 2], P[BASE + 3]);   \
    unsigned b0 = cvtpk(P[BASE + 4], P[BASE + 5]), b1 = cvtpk(P[BASE + 6], P[BASE + 7]);                              \
    auto r0 = __builtin_amdgcn_permlane32_swap(a0, b0, false, false); auto r1 = __builtin_amdgcn_permlane32_swap(a1, b1, false, false); \
    u32x4 w = {r0[0], r1[0], r0[1], r1[1]}; OUT = *reinterpret_cast<bf16x8*>(&w); } while (0)
  PK4(p0, 0, pa0); PK4(p0, 8, pa1); PK4(p1, 0, pa2); PK4(p1, 8, pa3);
#undef PK4
}
DI void qkt(f32x16& p0, f32x16& p1, const char* Ks, const char* KRs, const bf16x8* qr, int r32, int hi) {
  p0 = f32x16{}; p1 = f32x16{};
#pragma unroll
  for (int d0 = 0; d0 < 8; ++d0) { const int cb = (d0 * 16 + hi * 8) * 2;
    const bf16x8 b0 = *reinterpret_cast<const bf16x8*>(Ks + KSWZ(r32, cb));
    const bf16x8 b1 = *reinterpret_cast<const bf16x8*>(Ks + KSWZ(32 + r32, cb));
    p0 = __builtin_amdgcn_mfma_f32_32x32x16_bf16(b0, qr[d0], p0, 0, 0, 0);
    p1 = __builtin_amdgcn_mfma_f32_32x32x16_bf16(b1, qr[d0], p1, 0, 0, 0); }
#pragma unroll
  for (int d0 = 0; d0 < 4; ++d0) { const int cb = (d0 * 16 + hi * 8) * 2;
    const bf16x8 b0 = *reinterpret_cast<const bf16x8*>(KRs + KRSWZ(r32, cb));
    const bf16x8 b1 = *reinterpret_cast<const bf16x8*>(KRs + KRSWZ(32 + r32, cb));
    p0 = __builtin_amdgcn_mfma_f32_32x32x16_bf16(b0, qr[8 + d0], p0, 0, 0, 0);
    p1 = __builtin_amdgcn_mfma_f32_32x32x16_bf16(b1, qr[8 + d0], p1, 0, 0, 0); }
}
DI int v_st(int k, int c) { const int kk = (k & ~0xC) | ((k & 4) << 1) | ((k & 8) >> 1); return ((kk >> 3) * 4 + (c >> 5)) * 512 + ((kk & 7) * 32 + (c & 31)) * 2; }
DI int v_rd_base(int lane) { return ((lane & 3) << 3) | (((lane >> 2) & 3) << 6) | (((lane >> 4) & 1) << 5) | (((lane >> 5) & 1) << 8); }
constexpr int v_rd_off(int d0, int ks, int half) { return d0 * 512 + ks * 4096 + half * 2048; }
template <int OFF> DI s16x4 tr_read(int vb) { s16x4 r; asm volatile("ds_read_b64_tr_b16 %0, %1 offset:%2" : "=&v"(r) : "v"(vb), "i"(OFF) : "memory"); return r; }
template <int D0> DI void pv_one(f32x16& od, int vb, bf16x8 pa0, bf16x8 pa1, bf16x8 pa2, bf16x8 pa3) {
  const s16x4 l0 = tr_read<v_rd_off(D0, 0, 0)>(vb), h0 = tr_read<v_rd_off(D0, 0, 1)>(vb), l1 = tr_read<v_rd_off(D0, 1, 0)>(vb), h1 = tr_read<v_rd_off(D0, 1, 1)>(vb);
  const s16x4 l2 = tr_read<v_rd_off(D0, 2, 0)>(vb), h2 = tr_read<v_rd_off(D0, 2, 1)>(vb), l3 = tr_read<v_rd_off(D0, 3, 0)>(vb), h3 = tr_read<v_rd_off(D0, 3, 1)>(vb);
  asm volatile("s_waitcnt lgkmcnt(0)" ::: "memory"); SBAR();
#define PK(L, H) (bf16x8){L[0], L[1], L[2], L[3], H[0], H[1], H[2], H[3]}
  od = __builtin_amdgcn_mfma_f32_32x32x16_bf16(pa0, PK(l0, h0), od, 0, 0, 0);
  od = __builtin_amdgcn_mfma_f32_32x32x16_bf16(pa1, PK(l1, h1), od, 0, 0, 0);
  od = __builtin_amdgcn_mfma_f32_32x32x16_bf16(pa2, PK(l2, h2), od, 0, 0, 0);
  od = __builtin_amdgcn_mfma_f32_32x32x16_bf16(pa3, PK(l3, h3), od, 0, 0, 0);
#undef PK
}
DI void pv_d0(f32x16* o, int vb, bf16x8 pa0, bf16x8 pa1, bf16x8 pa2, bf16x8 pa3) {
  pv_one<0>(o[0], vb, pa0, pa1, pa2, pa3); pv_one<1>(o[1], vb, pa0, pa1, pa2, pa3); pv_one<2>(o[2], vb, pa0, pa1, pa2, pa3); pv_one<3>(o[3], vb, pa0, pa1, pa2, pa3);
}

DI void attn_body(const bf16_t* __restrict__ Qb, const bf16_t* __restrict__ Kh, const bf16_t* __restrict__ Vh, const bf16_t* __restrict__ KRh, bf16_t* __restrict__ Ob, int seq, int tpos0, char* lds) {
  const int tid = ltid(), wid = tid >> 6, lane = tid & 63, r32 = lane & 31, hi = lane >> 5;
  char* V_lds = lds; char* K_lds = lds + 2 * SHM_V; char* KR_lds = lds + 2 * SHM_V + 2 * SHM_K;
  float* ws = (float*)(lds + 2 * SHM_V + 2 * SHM_K + 2 * SHM_KR) + wid * 64; float* li_l = ws; float* al_l = ws + 32;
  float m_reg = -1e30f, l_reg = 0; f32x16 o[4] = {}; bf16x8 qr[12];
  const bf16_t* Qw = Qb + (long)(wid * QBLK + r32) * LDQ + hi * 8;
#pragma unroll
  for (int d0 = 0; d0 < 12; ++d0) qr[d0] = *reinterpret_cast<const bf16x8*>(Qw + d0 * 16);
  if (tpos0 >= 0) {
    const int t = tpos0 + wid * QBLK + r32;
#pragma unroll
    for (int hf = 0; hf < 2; ++hf) { const float pos = (float)(hf ? (t & 63) : (t >> 6));
#pragma unroll
      for (int j = 0; j < 8; ++j) { const float ang = pos * exp2f(-(float)(hi * 8 + j) * (13.287712379549449f / 16.f)); float sv, cv; sincosf(ang, &sv, &cv);
        const float x1 = bf2f((bf16_t)qr[8 + 2 * hf][j]), x2 = bf2f((bf16_t)qr[9 + 2 * hf][j]);
        qr[8 + 2 * hf][j] = (short)f2bf(x1 * cv - x2 * sv); qr[9 + 2 * hf][j] = (short)f2bf(x2 * cv + x1 * sv); } }
  }
  const int sr = tid >> 4, sc = (tid & 15) * 8, vst0 = v_st(sr, sc), vst1 = v_st(32 + sr, sc);
  const int krr = tid >> 3, krc = (tid & 7) * 8;
  const int vb0 = (int)(uintptr_t)V_lds + v_rd_base(lane);
  bf16x8 vs0, vs1, ks0, ks1, kr0;
#define SLOAD(k0) do { vs0 = *reinterpret_cast<const bf16x8*>(&Vh[(long)((k0) + sr) * LDK + sc]); vs1 = *reinterpret_cast<const bf16x8*>(&Vh[(long)((k0) + 32 + sr) * LDK + sc]); \
    ks0 = *reinterpret_cast<const bf16x8*>(&Kh[(long)((k0) + sr) * LDK + sc]); ks1 = *reinterpret_cast<const bf16x8*>(&Kh[(long)((k0) + 32 + sr) * LDK + sc]); \
    kr0 = *reinterpret_cast<const bf16x8*>(&KRh[(long)((k0) + krr) * LDKR + krc]); } while (0)
#define SWRITE(b) do { *(bf16x8*)(V_lds + (b) * SHM_V + vst0) = vs0; *(bf16x8*)(V_lds + (b) * SHM_V + vst1) = vs1; const int kc = sc * 2;               \
    *(bf16x8*)(K_lds + (b) * SHM_K + KSWZ(sr, kc)) = ks0; *(bf16x8*)(K_lds + (b) * SHM_K + KSWZ(32 + sr, kc)) = ks1;                       \
    *(bf16x8*)(KR_lds + (b) * SHM_KR + KRSWZ(krr, krc * 2)) = kr0; } while (0)
#define SWAIT() asm volatile("s_waitcnt vmcnt(0)" ::: "memory")
#define RESC(a) do { if (__any((a) < 1.f)) { if (hi == 0) al_l[r32] = (a); asm volatile("s_waitcnt lgkmcnt(0)" ::: "memory"); \
    _Pragma("unroll") for (int d = 0; d < 4; ++d) _Pragma("unroll") for (int r = 0; r < 16; ++r) o[d][r] *= al_l[crow(r, hi)]; } } while (0)
  f32x16 p0, p1; float mn, al; bf16x8 pa0, pa1, pa2, pa3; const int NT = seq / KVBLK;
  SLOAD(0); SWAIT(); SWRITE(0); __syncthreads();
  for (int j = 0; j < NT; ++j) {
    const int buf = j & 1; const bool more = j + 1 < NT;
    if (more) SLOAD((j + 1) * KVBLK);
    SBAR(); qkt(p0, p1, K_lds + buf * SHM_K, KR_lds + buf * SHM_KR, qr, r32, hi);
    partialSM(p0, p1, m_reg, mn, al); RESC(al);
    finishSM(p0, p1, al, l_reg, pa0, pa1, pa2, pa3); SBAR();
    pv_d0(o, vb0 + buf * SHM_V, pa0, pa1, pa2, pa3);
    if (more) { SWAIT(); SWRITE(buf ^ 1); }
    __syncthreads();
  }
  if (hi == 0) li_l[r32] = l_reg; asm volatile("s_waitcnt lgkmcnt(0)" ::: "memory");
  float rli[16];
#pragma unroll
  for (int r = 0; r < 16; ++r) rli[r] = __builtin_amdgcn_rcpf(li_l[crow(r, hi)]);
  bf16_t* Ow = Ob + (long)(wid * QBLK) * LDO;
#pragma unroll
  for (int r = 0; r < 16; ++r) { const int orow = crow(r, hi);
#pragma unroll
    for (int d0 = 0; d0 < 4; ++d0) Ow[(long)orow * LDO + d0 * 32 + r32] = f2bf(o[d0][r] * rli[r]); }
  __syncthreads();
#undef SLOAD
#undef SWRITE
#undef SWAIT
#undef RESC
}
}

DI void st_attn(const Prm& p, int layer, char* lds, int bid, int nb) {
  const int nlat = NB * 4 * 16, nitem = nlat + (layer == 0 ? NB * 4 : 0);
  for (int it = bid; it < nitem; it += nb) {
    if (it < nlat) { const int b = it >> 6, h = (it >> 4) & 3, qb = it & 15; const size_t r0 = (size_t)b * LT;
      att::attn_body(p.Qraw + (r0 + qb * 256) * 768 + h * 192, p.KV + r0 * 1024 + h * 256, p.KV + r0 * 1024 + h * 256 + 128, p.KR + r0 * 64,
                     p.Y + (r0 + qb * 256) * DM + 1024 + h * 128, LT, qb * 256, lds); }
    else { const int k = it - nlat, b = k >> 2, h = k & 3; const size_t r0 = (size_t)b * LT + LL;
      att::attn_body(p.Qraw + r0 * 768 + h * 192, p.KV + r0 * 1024 + h * 256, p.KV + r0 * 1024 + h * 256 + 128, p.KR + r0 * 64, p.Y + r0 * DM + 1024 + h * 128, LCX, -1, lds); }
  }
}

struct EpiResid {
  static constexpr bool PERM = false, AFTER_DRAIN = false;
  const float* xlat; const float* xctx; float* X; const float* modl; int first;
  __device__ __forceinline__ void operator()(const pg8::f32x4 (&acc)[2][2][4][2], const pg8::Unit& u, int wr, int wc, int fr, int fq) const {
    const int b = u.pm / 17, tl = u.pm - b * 17; const bool isc = tl == 16;
    const float* g = modl + (size_t)(isc ? 8 : b) * NMOD + 2 * DM;
    const int rloc0 = wr * 64 + fr, col0 = u.pn * 256 + wc * 32 + 4 * fq;
    pg8::f32x4 gv[2][2];
#pragma unroll
    for (int bj = 0; bj < 2; ++bj)
#pragma unroll
      for (int n = 0; n < 2; ++n) gv[bj][n] = *(const pg8::f32x4*)(g + col0 + bj * 128 + n * 16);
#pragma unroll
    for (int ai = 0; ai < 2; ++ai)
#pragma unroll
      for (int m = 0; m < 4; ++m) { const int rl = rloc0 + ai * 128 + m * 16; const size_t row = (size_t)u.pm * 256 + rl;
        const float* src = first ? (isc ? xctx + ((size_t)b * LCX + rl) * DM : xlat + ((size_t)b * LL + tl * 256 + rl) * DM) : X + row * DM;
        float* dst = X + row * DM;
#pragma unroll
        for (int bj = 0; bj < 2; ++bj)
#pragma unroll
          for (int n = 0; n < 2; ++n) { const int c = col0 + bj * 128 + n * 16; *(pg8::f32x4*)(dst + c) = *(const pg8::f32x4*)(src + c) + gv[bj][n] * acc[ai][bj][m][n]; } }
  }
};

template <class Epi> DI void run_gemm(unsigned char* lds, const bf16_t* A, const bf16_t* Bt, int M, int N, int K, const Epi& E, int bid, int nb) {
  pg8::Gemm g; g.A = A; g.Bt = Bt; g.M = M; g.N = N; g.K = K;
  pg8::StaticOrder S; S.init(M, N, nb, bid);
  pg8::gemm_phase<Epi, pg8::StaticOrder, false>((PG8_LAS unsigned char*)lds, g, S, E, nullptr);
}
DI pg8::EpiBf16<0> epi_bf16(bf16_t* O, int ldc, int split_cols = 0, size_t split_stride = 0) { pg8::EpiBf16<0> e; e.O = O; e.ldc = ldc; e.bias = nullptr; e.split_cols = split_cols; e.split_stride = split_stride; return e; }

#ifndef PROBE
#define PROBE 0
#endif
constexpr int LDS_MAIN = 131072, LDS_TOTAL = LDS_MAIN + 64;
#define PRM() (*(const __attribute__((address_space(4))) Prm*)launder_k(kp))
typedef const __attribute__((address_space(4))) void* kptr_t;
DI kptr_t launder_k(kptr_t q) { asm volatile("" : "+s"(q)); return q; }
extern __shared__ __attribute__((aligned(16))) unsigned char shm[];
__global__ void __launch_bounds__(NTHR, 2) mega(Prm p_unused) {
#if defined(__HIP_DEVICE_COMPILE__)
  kptr_t kp = (kptr_t)__builtin_amdgcn_kernarg_segment_ptr();
  const int bid0 = blockIdx.x, nb0 = gridDim.x;
#define bid lsg(bid0)
#define nb lsg(nb0)
  uint4* xbw = (uint4*)(shm + LDS_MAIN);
  if (threadIdx.x == 0) *xbw = make_uint4(0u, 0u, 0u, 0u);
  __syncthreads();
  { const Prm p = PRM(); (void)xcd_barrier_post(p.bar, (volatile LAS unsigned*)xbw); }
#define GRID_BAR() do { XcdBarrier b_; b_.bar = PRM().bar; b_.x = xb_xcc_id(); b_.st = (volatile LAS unsigned*)(shm + LDS_MAIN); xcd_barrier(b_); } while (0)
  float* lf = (float*)shm;
  for (int ly = 0; ly < 2; ++ly) { const Prm p = PRM();
    st_transpose(p.w_in + (size_t)ly * DM * IN_W, p.WinT + (size_t)ly * NZ * DM, DM, IN_W, DM, NZ, lf, bid, nb);
    st_transpose(p.w_out + (size_t)ly * DM * DM, p.WoutT + (size_t)ly * DM * DM, DM, DM, DM, DM, lf, bid, nb);
    st_transpose(p.peer_wq + (size_t)ly * DM * DM, p.WqT + (size_t)ly * DM * DM, DM, DM, DM, DM, lf, bid, nb);
    st_transpose(p.mla_w_uq + (size_t)ly * 448 * 768, p.WuqT + (size_t)ly * 768 * 512, 448, 768, 512, 768, lf, bid, nb);
    st_transpose(p.mla_w_ukv + (size_t)ly * 128 * 1024, p.WukvT + (size_t)ly * 1024 * 256, 128, 1024, 256, 1024, lf, bid, nb);
  }
  { const Prm p = PRM(); st_tables(p, bid, nb); }
  __syncthreads();
  { const Prm p = PRM(); st_mods(p, lf, bid, nb); }
  if (PROBE == 5) { __syncthreads();
    for (int ly = 0; ly < 2; ++ly) { const Prm p = PRM();
      st_transpose(p.w_in + (size_t)ly * DM * IN_W, p.WinT + (size_t)ly * NZ * DM, DM, IN_W, DM, NZ, lf, bid, nb);
      st_transpose(p.w_out + (size_t)ly * DM * DM, p.WoutT + (size_t)ly * DM * DM, DM, DM, DM, DM, lf, bid, nb);
      st_transpose(p.peer_wq + (size_t)ly * DM * DM, p.WqT + (size_t)ly * DM * DM, DM, DM, DM, DM, lf, bid, nb); }
    { const Prm p = PRM(); st_tables(p, bid, nb); }
    __syncthreads();
    { const Prm p = PRM(); st_mods(p, lf, bid, nb); } }
  GRID_BAR();
  for (int l = 0; l < 2; ++l) {
    { const Prm p = PRM(); st_modulate(p, l, 0, p.H, bid, nb); }
    GRID_BAR();
    { const Prm p = PRM(); run_gemm(shm, p.H, p.WinT + (size_t)l * NZ * DM, MR, NZ, DM, epi_bf16(p.Z, NZ), bid, nb); }
    if (PROBE == 6) { const Prm p = PRM(); run_gemm(shm, p.H, p.WinT + (size_t)l * NZ * DM, MR, NZ, DM, epi_bf16(p.Z, NZ), bid, nb); }
    GRID_BAR();
    { const Prm p = PRM(); st_dnprep(p, l, bid, nb); }
    { const Prm p = PRM(); st_mlaprep(p, l, bid, nb); }
    { const Prm p = PRM(); st_fnchan(p, shm, bid, nb); }
    if (PROBE == 9) { { const Prm p = PRM(); st_dnprep(p, l, bid, nb); } { const Prm p = PRM(); st_mlaprep(p, l, bid, nb); } }
    if (PROBE == 10) { const Prm p = PRM(); st_fnchan(p, shm, bid, nb); }
    GRID_BAR();
    { const Prm p = PRM(); run_gemm(shm, p.Aq, p.WuqT + (size_t)l * 768 * 512, MR, 768, 512, epi_bf16(p.Qraw, 768), bid, nb); }
    { const Prm p = PRM(); run_gemm(shm, p.Akv, p.WukvT + (size_t)l * 1024 * 256, MR, 1024, 256, epi_bf16(p.KV, 1024), bid, nb); }
    if (bid < 128) { const Prm p = PRM(); st_dnscan(p, lf, bid, 128); }
    else { const Prm p = PRM(); st_glascan(p, l, lf, bid - 128, 128); }
    if (PROBE == 7) { GRID_BAR(); if (bid < 128) { const Prm p = PRM(); st_dnscan(p, lf, bid, 128); } }
    if (PROBE == 8) { GRID_BAR(); if (bid < 128) { const Prm p = PRM(); st_glascan(p, l, lf, bid, 128); } }
    if (PROBE == 2) { GRID_BAR(); if (bid < 128) { const Prm p = PRM(); st_dnscan(p, lf, bid, 128); } else { const Prm p = PRM(); st_glascan(p, l, lf, bid - 128, 128); } }
    GRID_BAR();
    { const Prm p = PRM(); st_attn(p, l, (char*)shm, bid, nb); }
    if (PROBE == 3) { const Prm p = PRM(); st_attn(p, l, (char*)shm, bid, nb); }
    { const Prm p = PRM(); run_gemm(shm, p.DFTM, p.PQT, 4096, 4096, 8192, epi_bf16(p.Y + 1536, DM, 512, (size_t)LT * DM), bid, nb); }
    if (l == 0) { const Prm p = PRM(); run_gemm(shm, p.DFTC, p.PQTc, 256, 4096, 512, epi_bf16(p.Y + (size_t)LL * DM + 1536, DM, 512, (size_t)LT * DM), bid, nb); }
    { const Prm p = PRM(); st_combine(p, l, bid, nb); }
    GRID_BAR();
    { const Prm p = PRM(); EpiResid e; e.xlat = p.x; e.xctx = p.ctx; e.X = p.X; e.modl = p.mod + (size_t)l * 9 * NMOD; e.first = l == 0;
      run_gemm(shm, p.Y, p.WoutT + (size_t)l * DM * DM, MR, DM, DM, e, bid, nb); }
    GRID_BAR();
    { const Prm p = PRM(); st_modulate(p, l, 1, p.H2, bid, nb); }
    { const Prm p = PRM(); st_cvt_tables(p, l, bid, nb); }
    GRID_BAR();
    { const Prm p = PRM(); run_gemm(shm, p.H2, p.WqT + (size_t)l * DM * DM, MR, DM, DM, epi_bf16(p.Qp, DM), bid, nb); }
    GRID_BAR();
    { const Prm p = PRM(); st_peertopk(p, l, shm, bid, nb); }
    if (PROBE == 4) { __syncthreads(); const Prm p = PRM(); st_peertopk(p, l, shm, bid, nb); }
    GRID_BAR();
    { const Prm p = PRM(); st_peergather(p, l, lf, bid, nb); }
    if (PROBE == 1) { __syncthreads(); const Prm p = PRM(); st_peergather(p, l, lf, bid, nb, true); }
    GRID_BAR();
  }
  { const Prm p = PRM(); st_final(p, bid, nb); }
#endif
#undef bid
#undef nb
#undef GRID_BAR
}

static size_t al256(size_t x) { return (x + 255) / 256 * 256; }
extern "C" void kernel_launch(void* const* d_in, const int* in_sizes, int n_in, void* d_out, int out_size, void* d_ws, size_t ws_size, hipStream_t stream) {
  Prm p{};
  const float** f = (const float**)&p.x;
  for (int i = 0; i < 24; ++i) f[i] = (const float*)d_in[i];
  p.out = (float*)d_out;
  char* w = (char*)d_ws; size_t o = 0;
  auto take = [&](size_t bytes) { char* r = w + o; o += al256(bytes); return r; };
  p.bar = (unsigned*)take(16384);
  p.WinT = (bf16_t*)take((size_t)2 * NZ * DM * 2); p.WoutT = (bf16_t*)take((size_t)2 * DM * DM * 2); p.WqT = (bf16_t*)take((size_t)2 * DM * DM * 2);
  p.WuqT = (bf16_t*)take((size_t)2 * 768 * 512 * 2); p.WukvT = (bf16_t*)take((size_t)2 * 1024 * 256 * 2);
  p.mod = (float*)take((size_t)2 * 9 * NMOD * 4); p.GB = (float*)take((size_t)MR * 16 * 4); p.CCS = (float*)take((size_t)2 * 128 * 128 * 4);
  p.DFTM = (bf16_t*)take((size_t)4096 * 8192 * 2); p.DFTC = (bf16_t*)take((size_t)256 * 512 * 2);
  p.X = (float*)take((size_t)MR * DM * 4);
  p.Z = (bf16_t*)take((size_t)MR * NZ * 2);
  char* ra = take((size_t)MR * 1536 * 2 + (size_t)4 * MR * 512 * 2);
  p.DNQ = (bf16_t*)ra; p.OB = (bf16_t*)(ra + (size_t)MR * 1536 * 2); p.H = (bf16_t*)ra;
  p.Ub = (bf16_t*)ra; p.Vb = (bf16_t*)(ra + (size_t)16384 * DM);
  p.KV = (bf16_t*)take((size_t)MR * 1024 * 2); p.KR = (bf16_t*)take((size_t)MR * 64 * 2);
  p.Aq = (bf16_t*)take((size_t)MR * 512 * 2); p.Akv = (bf16_t*)take((size_t)MR * 256 * 2);
  if (o > ws_size) return;
  char* q = (char*)d_out; size_t oo = 0;
  p.Y = (bf16_t*)q; oo += (size_t)MR * DM * 2; p.PQT = (bf16_t*)(q + oo); oo += (size_t)8 * 512 * 8192 * 2; p.PQTc = (bf16_t*)(q + oo); oo += (size_t)8 * 512 * 512 * 2;
  p.Qraw = (bf16_t*)(q + oo); oo += (size_t)MR * 768 * 2;
  char* z = (char*)p.Z; p.H2 = (bf16_t*)z; p.Qp = (bf16_t*)(z + (size_t)MR * DM * 2); p.IDX = (int*)(z + (size_t)2 * MR * DM * 2); p.GATE = (float*)(z + (size_t)2 * MR * DM * 2 + (size_t)MR * 128 * 4);

  static int grid = 0;
  if (!grid) {
    (void)hipFuncSetAttribute((const void*)mega, hipFuncAttributeMaxDynamicSharedMemorySize, LDS_TOTAL);
    int dev = 0, cus = 0, per_cu = 0;
    (void)hipGetDevice(&dev); (void)hipDeviceGetAttribute(&cus, hipDeviceAttributeMultiprocessorCount, dev);
    (void)hipOccupancyMaxActiveBlocksPerMultiprocessor(&per_cu, (const void*)mega, NTHR, LDS_TOTAL);
    grid = per_cu >= 1 ? cus : 0;
    if (grid > 256) grid = 256;
  }
  if (grid < 256) return;
  (void)hipMemsetAsync(p.bar, 0, XCD_BAR_WORDS * sizeof(unsigned), stream);
  hipLaunchKernelGGL(mega, dim3(grid), dim3(NTHR), LDS_TOTAL, stream, p);
}
```

```cpp
#include <hip/hip_runtime.h>
#include <stdint.h>

constexpr int DM = 2048, NB = 8, LL = 4096, LCX = 256, LT = LL + LCX  , MR = NB * LT  ;
constexpr int NZ = 4864;
constexpr int C_DNQ = 0, C_DNK = 512, C_DNV = 1024, C_DNGATE = 1536, C_DNA = 2048, C_DNB = 2056, C_GQ = 2064, C_GK = 2320, C_GV = 2576,
              C_GGATE = 3088, C_GALPHA = 3600, C_CQ = 3632, C_CKV = 4080, C_KR = 4208, C_FN = 4272, IN_W = 4784;
constexpr int NMOD = 6 * DM;
constexpr float EPSV = 1e-6f;
constexpr int NTHR = 512;

typedef unsigned short bf16_t;
typedef short bf16x8 __attribute__((ext_vector_type(8)));
typedef short s16x4 __attribute__((ext_vector_type(4)));
typedef float f32x4 __attribute__((ext_vector_type(4)));
typedef float f32x16 __attribute__((ext_vector_type(16)));
typedef unsigned u32x4 __attribute__((ext_vector_type(4)));
typedef unsigned u32x2 __attribute__((ext_vector_type(2)));

#define DI __device__ __forceinline__
DI float bf2f(bf16_t b) { return __uint_as_float(((unsigned)b) << 16); }
DI bf16_t f2bf(float f) { unsigned u = __float_as_uint(f); u += 0x7FFFu + ((u >> 16) & 1u); return (bf16_t)(u >> 16); }
DI unsigned pack2(float lo, float hi) { return (unsigned)f2bf(lo) | ((unsigned)f2bf(hi) << 16); }
typedef float f32x2 __attribute__((ext_vector_type(2)));
DI float dpp_x1(float v) { return __int_as_float(__builtin_amdgcn_mov_dpp(__float_as_int(v), 0xB1, 0xf, 0xf, true)); }
DI float dpp_x2(float v) { return __int_as_float(__builtin_amdgcn_mov_dpp(__float_as_int(v), 0x4E, 0xf, 0xf, true)); }
DI float dpp_hm(float v) { return __int_as_float(__builtin_amdgcn_mov_dpp(__float_as_int(v), 0x141, 0xf, 0xf, true)); }
DI float dpp_rm(float v) { return __int_as_float(__builtin_amdgcn_mov_dpp(__float_as_int(v), 0x140, 0xf, 0xf, true)); }
DI float red4(float v) { v += dpp_x1(v); v += dpp_x2(v); return v; }
DI float red8(float v) { v += dpp_x1(v); v += dpp_x2(v); v += dpp_hm(v); return v; }
DI float rdl(float v, int l) { return __int_as_float(__builtin_amdgcn_readlane(__float_as_int(v), l)); }
DI float wsum(float v) { v += dpp_x1(v); v += dpp_x2(v); v += dpp_hm(v); v += dpp_rm(v); return (rdl(v, 0) + rdl(v, 16)) + (rdl(v, 32) + rdl(v, 48)); }
DI float wmax(float v) { v = fmaxf(v, dpp_x1(v)); v = fmaxf(v, dpp_x2(v)); v = fmaxf(v, dpp_hm(v)); v = fmaxf(v, dpp_rm(v)); return fmaxf(fmaxf(rdl(v, 0), rdl(v, 16)), fmaxf(rdl(v, 32), rdl(v, 48))); }
DI float siluf(float x) { return x / (1.f + __expf(-x)); }
DI float sigmf(float x) { return 1.f / (1.f + __expf(-x)); }

DI int ltid() { int t = (int)threadIdx.x; asm volatile("" : "+v"(t)); return t; }
DI int lsg(int v) { asm volatile("" : "+s"(v)); return v; }

struct Prm {
  const float *x, *c, *ctx, *c_ctx, *w_ada, *b_ada, *w_in, *dn_conv, *dn_a_log, *dn_dt_bias, *dn_norm, *gla_w2, *gla_b2, *gla_norm,
      *mla_q_norm, *mla_w_uq, *mla_kv_norm, *mla_w_ukv, *w_out, *peer_wq, *peer_keys, *peer_u, *peer_v, *final_norm;
  float* out;
  bf16_t *WinT, *WoutT, *WqT, *WuqT, *WukvT;
  float *mod, *GB, *CCS;
  bf16_t *DFTM, *DFTC;
  float* X;
  bf16_t* Z;
  bf16_t *H, *DNQ, *OB;
  bf16_t *KV, *KR;
  bf16_t *Y, *PQT, *PQTc, *Qraw, *Aq, *Akv;
  bf16_t *H2, *Qp;
  bf16_t *Ub, *Vb;
  int* IDX;
  float* GATE;
  unsigned* bar;
};
#define XB_TMO      128
#define XB_XCNT(j)  (256  + 64 * (j))
#define XB_XSUB(j)  (1280 + 64 * (j))
#define XB_XGEN(j)  (2304 + 64 * (j))
#define XB_TOP      3328
#define XB_TOPGEN   3392
#define XCD_BAR_WORDS 3456
#define XB_SPIN_CAP (1u << 18)
#define LAS __attribute__((address_space(3)))

__device__ __forceinline__ unsigned xb_ld(unsigned* p)              { return __hip_atomic_load(p, __ATOMIC_RELAXED, __HIP_MEMORY_SCOPE_AGENT); }
__device__ __forceinline__ unsigned xb_add(unsigned* p, unsigned v) { return __hip_atomic_fetch_add(p, v, __ATOMIC_RELAXED, __HIP_MEMORY_SCOPE_AGENT); }
__device__ __forceinline__ unsigned xb_xcc_id() { return (unsigned)__builtin_amdgcn_s_getreg((3 << 11) | 20) & 0xFu; }
#define XB_SPIN(cond, bar) do { unsigned _sp = 0; while (cond) { __builtin_amdgcn_s_sleep(1); \
    if ((++_sp & 255u) == 0u) { if (xb_ld(&(bar)[XB_TMO])) break; if (_sp > XB_SPIN_CAP) { atomicAdd(&(bar)[XB_TMO], 1u); break; } } } } while (0)

struct XcdBarrier {
    unsigned* bar; unsigned x;
    volatile LAS unsigned* st;
};

__device__ __forceinline__ XcdBarrier xcd_barrier_post(unsigned* bar, volatile LAS unsigned* st) {
    XcdBarrier b; b.bar = bar; b.x = xb_xcc_id(); b.st = st;
    if (threadIdx.x == 0) (void)xb_add(&bar[XB_XCNT(b.x)], 1u);
    return b;
}
__device__ __forceinline__ void xcd_barrier_complete(unsigned* bar, unsigned x, unsigned& nloc, unsigned& nx) {
    const unsigned G = gridDim.x * gridDim.y * gridDim.z;
    unsigned sum, cnt, mine, sp = 0u;
    for (;;) {
        sum = 0u; cnt = 0u; mine = 0u;
#pragma unroll
        for (unsigned j = 0; j < 16; ++j) { const unsigned c = xb_ld(&bar[XB_XCNT(j)]); sum += c; cnt += (c > 0u) ? 1u : 0u; mine = (j == x) ? c : mine; }
        if (sum == G) break;
        __builtin_amdgcn_s_sleep(1);
        if ((++sp & 255u) == 0u) { if (xb_ld(&bar[XB_TMO])) break; if (sp > XB_SPIN_CAP) { atomicAdd(&bar[XB_TMO], 1u); break; } }
    }
    nloc = mine > 0u ? mine : 1u; nx = cnt > 0u ? cnt : 1u;
}

__device__ __forceinline__ void xcd_barrier(const XcdBarrier& b) {
    asm volatile("s_waitcnt vmcnt(0)" ::: "memory");
    __syncthreads();
    if (threadIdx.x == 0) {
        unsigned* bar = b.bar;
        __builtin_amdgcn_s_waitcnt(0);
        unsigned nloc = b.st[0], nx = b.st[1];
        if (nloc == 0u) { xcd_barrier_complete(bar, b.x, nloc, nx); b.st[0] = nloc; b.st[1] = nx; }
        const unsigned old = xb_add(&bar[XB_XSUB(b.x)], 1u);
        const unsigned gen = old / nloc;
        if (old + 1u == (gen + 1u) * nloc) {
            __builtin_amdgcn_fence(__ATOMIC_RELEASE, "agent");
            asm volatile("s_waitcnt vmcnt(0)" ::: "memory");
            const unsigned og = xb_add(&bar[XB_TOP], 1u);
            const unsigned tg = og / nx;
            if (og + 1u == (tg + 1u) * nx) xb_add(&bar[XB_TOPGEN], 1u);
            else XB_SPIN(xb_ld(&bar[XB_TOPGEN]) == tg, bar);
            __builtin_amdgcn_fence(__ATOMIC_ACQUIRE, "agent");
            xb_add(&bar[XB_XGEN(b.x)], 1u);
            asm volatile("s_waitcnt vmcnt(0)" ::: "memory");
        } else {
            XB_SPIN(xb_ld(&bar[XB_XGEN(b.x)]) == gen, bar);
            __builtin_amdgcn_fence(__ATOMIC_ACQUIRE, "agent");
            asm volatile("s_waitcnt vmcnt(0)" ::: "memory");
        }
    }
    __syncthreads();
}

namespace pg8 {
#define PG8_LAS __attribute__((address_space(3)))
typedef unsigned short bf16_t;
typedef short bf16x8 __attribute__((ext_vector_type(8)));
typedef float f32x4 __attribute__((ext_vector_type(4)));
typedef unsigned u32x4 __attribute__((ext_vector_type(4)));
constexpr int BM = 256, BK = 64, HALF = 128, HTB = HALF * BK * 2  , STAGE_BYTES = 8 * HTB, NXCD = 8, WGM = 8;

__host__ __device__ __forceinline__ int lds_byte(int r, int c) { const int st = (r >> 4) * 2 + (c >> 5), rr = r & 15, cc = c & 31, ob = rr * 64 + cc * 2; return st * 1024 + (ob ^ (((ob >> 9) & 1) << 5)); }
__host__ __device__ __forceinline__ void stage_rc(int b, int& R, int& C) { const int st = b / 1024, sb = b % 1024, swz = sb ^ (((sb >> 9) & 1) << 5); R = (st >> 1) * 16 + swz / 64; C = (st & 1) * 32 + (swz % 64) / 2; }
__host__ __device__ __forceinline__ int perm32(int rho) { const int n = rho >> 4, i = rho & 15; return 8 * (i >> 2) + 4 * n + (i & 3); }

struct Unit { int pm, pn; };
struct Gemm { const bf16_t* A; const bf16_t* Bt; int M, N, K; };

struct StaticOrder {
    int nM, nN, nwg, G, c;
    __host__ __device__ void init(int M, int N, int G_, int c_) { nM = M / BM; nN = N / BM; nwg = nM * nN; G = G_; c = c_; }
    __host__ __device__ bool next(int i, Unit& u) const {
        const long L = (long)i * G + c; if (L >= nwg) return false;
        int wgid = (int)L; { const int q = nwg / NXCD, r = nwg % NXCD, xcd = wgid % NXCD, off = wgid / NXCD; wgid = (xcd < r ? xcd * (q + 1) : r * (q + 1) + (xcd - r) * q) + off; }
        const int nig = WGM * nN, gid = wgid / nig, fm = gid * WGM, gsz = (nM - fm) < WGM ? (nM - fm) : WGM;
        u.pm = fm + ((wgid % nig) % gsz); u.pn = (wgid % nig) / gsz; return true;
    }
    __device__ __forceinline__ void a_ready(const Unit&) const {}
    __device__ __forceinline__ void done(const Unit&) const {}
};
struct CountedOrder : StaticOrder {
    const unsigned* ready; unsigned need; unsigned* tmo;
    __device__ __forceinline__ void a_ready(const Unit& u) const {
        if (threadIdx.x < 64) {
            const unsigned long long t0 = __builtin_amdgcn_s_memrealtime(); unsigned polls = 0;
            while ((unsigned)__builtin_amdgcn_readfirstlane(__hip_atomic_load(ready + 64 * u.pm, __ATOMIC_RELAXED, __HIP_MEMORY_SCOPE_AGENT)) < need) {
                if ((++polls & 255u) == 0u && __builtin_amdgcn_readfirstlane(__hip_atomic_load(tmo, __ATOMIC_RELAXED, __HIP_MEMORY_SCOPE_AGENT)) != 0u) break;
                if (__builtin_amdgcn_s_memrealtime() - t0 > 2000000ull) {
                    if (threadIdx.x == 0) { unsigned expect = 0u; __hip_atomic_compare_exchange_strong(tmo + 1, &expect, 0x600u | (unsigned)(u.pm & 0xff), __ATOMIC_RELAXED, __ATOMIC_RELAXED, __HIP_MEMORY_SCOPE_AGENT); __hip_atomic_store(tmo, 1u, __ATOMIC_RELAXED, __HIP_MEMORY_SCOPE_AGENT); }
                    break; }
                __builtin_amdgcn_s_sleep(2); }
            __builtin_amdgcn_fence(__ATOMIC_ACQUIRE, "agent");
            asm volatile("s_waitcnt vmcnt(0)" ::: "memory");
        }
#if !defined(BROKEN_HOOK_NO_BARRIER)
        asm volatile("" ::: "memory"); __builtin_amdgcn_s_barrier(); asm volatile("" ::: "memory");
#endif
    }
};

__device__ __forceinline__ unsigned cvt_pk_bf16(float lo, float hi) { unsigned r; asm volatile("v_cvt_pk_bf16_f32 %0, %1, %2" : "=v"(r) : "v"(lo), "v"(hi)); return r; }
typedef float f32x2 __attribute__((ext_vector_type(2)));
__device__ __forceinline__ f32x2 gelu_pk(f32x2 v) {
    const f32x2 av = __builtin_elementwise_abs(v), d = av * 0.2316418882f + 1.0f;
    f32x2 t; t.x = __builtin_amdgcn_rcpf(d.x); t.y = __builtin_amdgcn_rcpf(d.y);
    f32x2 q = t * 0.5307027145f + (-0.7265760135f); q = q * t + 0.7107068705f; q = q * t + (-0.142248368f); q = q * t + 0.127414796f; q = q * t;
    const f32x2 s = (v * v) * (-0.72134752044f);
    f32x2 e; e.x = __builtin_amdgcn_exp2f(s.x); e.y = __builtin_amdgcn_exp2f(s.y);
    const f32x2 m = v * (q * e), r = v - m;
    f32x2 o; o.x = v.x < 0.f ? m.x : r.x; o.y = v.y < 0.f ? m.y : r.y; return o;
}

struct EpiF32 {
    static constexpr bool PERM = false, AFTER_DRAIN = false;
    float* C; int ldc; const float* bias;
    __device__ __forceinline__ void operator()(const f32x4 (&acc)[2][2][4][2], const Unit& u, int wr, int wc, int fr, int fq) const {
        const int row0 = u.pm * BM + wr * 64 + fr, col0 = u.pn * BM + wc * 32 + 4 * fq;
        f32x4 bv[2][2];
#pragma unroll
        for (int bj = 0; bj < 2; ++bj)
#pragma unroll
            for (int n = 0; n < 2; ++n) bv[bj][n] = bias ? *(const f32x4*)(bias + col0 + bj * HALF + n * 16) : (f32x4){0.f, 0.f, 0.f, 0.f};
#pragma unroll
        for (int ai = 0; ai < 2; ++ai)
#pragma unroll
            for (int m = 0; m < 4; ++m) { float* rowp = C + (size_t)(row0 + ai * HALF + m * 16) * ldc + col0;
#pragma unroll
                for (int bj = 0; bj < 2; ++bj)
#pragma unroll
                    for (int n = 0; n < 2; ++n) *(f32x4*)(rowp + bj * HALF + n * 16) = acc[ai][bj][m][n] + bv[bj][n]; }
    }
};
template <int ACT  > struct EpiBf16 {
    static constexpr bool PERM = true, AFTER_DRAIN = false;
    bf16_t* O; int ldc; const float* bias; int split_cols; size_t split_stride;
    __device__ __forceinline__ void operator()(const f32x4 (&acc)[2][2][4][2], const Unit& u, int wr, int wc, int fr, int fq) const {
        const int row0 = u.pm * BM + wr * 64 + fr; int colt = u.pn * BM; bf16_t* base = O;
        if (split_cols) { const int t = colt / split_cols; base += (size_t)t * split_stride; colt -= t * split_cols; }
        const int col0 = colt + wc * 32 + 8 * fq, bcol0 = u.pn * BM + wc * 32 + 8 * fq;
        f32x4 bv[2][2];
#pragma unroll
        for (int bj = 0; bj < 2; ++bj)
#pragma unroll
            for (int n = 0; n < 2; ++n) bv[bj][n] = bias ? *(const f32x4*)(bias + bcol0 + bj * HALF + 4 * n) : (f32x4){0.f, 0.f, 0.f, 0.f};
#pragma unroll
        for (int ai = 0; ai < 2; ++ai)
#pragma unroll
            for (int m = 0; m < 4; ++m) { bf16_t* rowp = base + (size_t)(row0 + ai * HALF + m * 16) * ldc + col0;
#pragma unroll
                for (int bj = 0; bj < 2; ++bj) { f32x4 v0 = acc[ai][bj][m][0] + bv[bj][0], v1 = acc[ai][bj][m][1] + bv[bj][1];
                    if (ACT == 1) { f32x2 a = gelu_pk((f32x2){v0[0], v0[1]}), b = gelu_pk((f32x2){v0[2], v0[3]}), c = gelu_pk((f32x2){v1[0], v1[1]}), d = gelu_pk((f32x2){v1[2], v1[3]});
                        v0 = (f32x4){a.x, a.y, b.x, b.y}; v1 = (f32x4){c.x, c.y, d.x, d.y}; }
                    if (ACT == 2) {
#pragma unroll
                        for (int j = 0; j < 4; ++j) { v0[j] = 0.5f * v0[j] * (1.0f + erff(v0[j] * 0.70710678f)); v1[j] = 0.5f * v1[j] * (1.0f + erff(v1[j] * 0.70710678f)); } }
                    u32x4 w; w.x = cvt_pk_bf16(v0[0], v0[1]); w.y = cvt_pk_bf16(v0[2], v0[3]); w.z = cvt_pk_bf16(v1[0], v1[1]); w.w = cvt_pk_bf16(v1[2], v1[3]);
                    *(u32x4*)(rowp + bj * HALF) = w; } }
    }
};
template <class Epi, class Sched, bool STAMP = false>
__device__ __forceinline__ void gemm_phase(PG8_LAS unsigned char* lds, const Gemm g, const Sched& S, const Epi& E, unsigned long long* stamps) {
    const int tid = ltid(), wid = __builtin_amdgcn_readfirstlane(tid >> 6), lane = tid & 63, wr = wid >> 2, wc = wid & 3, fr = lane & 15, fq = lane >> 4;
    const int K = g.K, nt = K / BK;
    int ts_lo = 0, ts_hi = 0, nts = 0; const unsigned long long rt_entry = STAMP ? (unsigned long long)wall_clock64() : 0ull;
#define PG8_STAMP() do { if (STAMP && wid == 0 && nts < 64) { const unsigned long long _c = (unsigned long long)clock64(); \
        ts_lo = (lane == nts) ? (int)(unsigned)_c : ts_lo; ts_hi = (lane == nts) ? (int)(unsigned)(_c >> 32) : ts_hi; ++nts; } } while (0)
    PG8_STAMP();
    unsigned voffA[2], voffB[2];
#pragma unroll
    for (int i = 0; i < 2; ++i) { int R, C; stage_rc(tid * 16 + i * 8192, R, C); const int Rb = Epi::PERM ? ((R & ~31) + perm32(R & 31)) : R;
        voffA[i] = (unsigned)(R * K + C) * 2u; voffB[i] = (unsigned)(Rb * K + C) * 2u; }
    const size_t kstep = (size_t)(BK * 2);
    const size_t hstep = (size_t)HALF * K * 2;
    const size_t tstep = 2 * hstep;
    const unsigned ldsw = (unsigned)wid * 1024u;
    const int aoff = lds_byte(wr * 64 + fr, fq * 8), boff = lds_byte(wc * 32 + fr, fq * 8);
#define PG8_SA(b, h) (((b) * 2 + (h)) * HTB)
#define PG8_SB(b, h) ((4 + (b) * 2 + (h)) * HTB)
#define PG8_STAGE(bufoff, gbase, voff) do { _Pragma("unroll") for (int _i = 0; _i < 2; ++_i) \
        __builtin_amdgcn_global_load_lds((const unsigned*)((const char*)(gbase) + (voff)[_i]), (PG8_LAS unsigned*)(lds + (bufoff) + ldsw + _i * 8192), 16, 0, 0); } while (0)
#define PG8_LDA(dst, b, h) do { _Pragma("unroll") for (int m = 0; m < 4; ++m) _Pragma("unroll") for (int k = 0; k < 2; ++k) dst[m][k] = *(const PG8_LAS bf16x8*)(lds + PG8_SA(b, h) + aoff + m * 2048 + k * 1024); } while (0)
#define PG8_LDB(dst, b, h) do { _Pragma("unroll") for (int n = 0; n < 2; ++n) _Pragma("unroll") for (int k = 0; k < 2; ++k) dst[n][k] = *(const PG8_LAS bf16x8*)(lds + PG8_SB(b, h) + boff + n * 2048 + k * 1024); } while (0)
#define PG8_MMA(ai, bj, At, Bt) do { __builtin_amdgcn_s_setprio(1); _Pragma("unroll") for (int m = 0; m < 4; ++m) _Pragma("unroll") for (int n = 0; n < 2; ++n) _Pragma("unroll") for (int k = 0; k < 2; ++k) \
        acc[ai][bj][m][n] = __builtin_amdgcn_mfma_f32_16x16x32_bf16(Bt[n][k], At[m][k], acc[ai][bj][m][n], 0, 0, 0); __builtin_amdgcn_s_setprio(0); } while (0)
#define PG8_WAIT_V(n) asm volatile("s_waitcnt vmcnt(" #n ")" ::: "memory")
#define PG8_WAIT_L(n) asm volatile("s_waitcnt lgkmcnt(" #n ")" ::: "memory")
#define PG8_BAR __builtin_amdgcn_s_barrier()
#define PG8_SCHED __builtin_amdgcn_sched_barrier(0)
    Unit cur, nxt; int ui = 0;
    if (!S.next(0, cur)) return;
    f32x4 acc[2][2][4][2];
#pragma unroll
    for (int a = 0; a < 2; ++a)
#pragma unroll
        for (int b = 0; b < 2; ++b)
#pragma unroll
            for (int m = 0; m < 4; ++m)
#pragma unroll
                for (int n = 0; n < 2; ++n) acc[a][b][m][n] = (f32x4){0.f, 0.f, 0.f, 0.f};
    bf16x8 At[4][2], B0[2][2], B1[2][2];
    const char* cA = (const char*)g.A + (size_t)cur.pm * tstep; const char* cB = (const char*)g.Bt + (size_t)cur.pn * tstep;
    S.a_ready(cur);
    PG8_STAGE(PG8_SB(0, 0), cB, voffB); PG8_STAGE(PG8_SA(0, 0), cA, voffA); PG8_STAGE(PG8_SB(0, 1), cB + hstep, voffB); PG8_STAGE(PG8_SA(0, 1), cA + hstep, voffA);
    if (wr == 1) PG8_BAR;
    PG8_WAIT_V(4); PG8_BAR;
    PG8_STAGE(PG8_SB(1, 0), cB + kstep, voffB); PG8_STAGE(PG8_SA(1, 0), cA + kstep, voffA); PG8_STAGE(PG8_SB(1, 1), cB + hstep + kstep, voffB);
    PG8_WAIT_V(6); PG8_BAR;
    PG8_STAMP();
    for (;;) {
        const bool has_next = S.next(ui + 1, nxt);
        const char* nA = has_next ? (const char*)g.A + (size_t)nxt.pm * tstep : cA; const char* nB = has_next ? (const char*)g.Bt + (size_t)nxt.pn * tstep : cB;
        for (int t = 0; t < nt; t += 2) {
            const bool last = (t == nt - 2);
            const char* a1 = cA + (size_t)(t + 1) * kstep;
            const char* a2 = last ? nA : cA + (size_t)(t + 2) * kstep; const char* b2 = last ? nB : cB + (size_t)(t + 2) * kstep;
            const char* a3 = a2 + kstep; const char* b3 = b2 + kstep;
            if (last && has_next) S.a_ready(nxt);
            PG8_LDB(B0, 0, 0); PG8_SCHED; PG8_LDA(At, 0, 0); PG8_STAGE(PG8_SA(1, 1), a1 + hstep, voffA);
            PG8_WAIT_L(8); PG8_BAR; PG8_WAIT_L(0); PG8_MMA(0, 0, At, B0); PG8_BAR; PG8_SCHED;
            PG8_LDB(B1, 0, 1); PG8_STAGE(PG8_SB(0, 0), b2, voffB);
            PG8_BAR; PG8_WAIT_L(0); PG8_MMA(0, 1, At, B1); PG8_BAR;
            PG8_LDA(At, 0, 1); PG8_STAGE(PG8_SA(0, 0), a2, voffA);
            PG8_BAR; PG8_WAIT_L(0); PG8_MMA(1, 0, At, B0); PG8_BAR; PG8_SCHED;
            PG8_STAGE(PG8_SB(0, 1), b2 + hstep, voffB);
            PG8_WAIT_V(6); PG8_BAR; PG8_MMA(1, 1, At, B1); PG8_BAR;
            PG8_LDB(B0, 1, 0); PG8_SCHED; PG8_LDA(At, 1, 0); PG8_STAGE(PG8_SA(0, 1), a2 + hstep, voffA);
            PG8_WAIT_L(8); PG8_BAR; PG8_WAIT_L(0); PG8_MMA(0, 0, At, B0); PG8_BAR; PG8_SCHED;
            PG8_LDB(B1, 1, 1); PG8_STAGE(PG8_SB(1, 0), b3, voffB);
            PG8_BAR; PG8_WAIT_L(0); PG8_MMA(0, 1, At, B1); PG8_BAR;
            PG8_LDA(At, 1, 1); PG8_STAGE(PG8_SA(1, 0), a3, voffA);
            PG8_BAR; PG8_WAIT_L(0); PG8_MMA(1, 0, At, B0); PG8_BAR; PG8_SCHED;
            PG8_STAGE(PG8_SB(1, 1), b3 + hstep, voffB);
            PG8_WAIT_V(6); PG8_BAR; PG8_MMA(1, 1, At, B1); PG8_BAR;
        }
        PG8_STAMP();
        if constexpr (!Epi::AFTER_DRAIN) { E(acc, cur, wr, wc, fr, fq); S.done(cur); }
        PG8_STAMP();
        if (!has_next) break;
#pragma unroll
        for (int a = 0; a < 2; ++a)
#pragma unroll
            for (int b = 0; b < 2; ++b)
#pragma unroll
                for (int m = 0; m < 4; ++m)
#pragma unroll
                    for (int n = 0; n < 2; ++n) acc[a][b][m][n] = (f32x4){0.f, 0.f, 0.f, 0.f};
        cur = nxt; cA = nA; cB = nB; ++ui;
    }
    PG8_WAIT_V(0);
    if (wr == 0) PG8_BAR;
    PG8_BAR;
    if constexpr (Epi::AFTER_DRAIN) { E.fused(acc, cur, wr, wc, fr, fq, lds, wid, lane); S.done(cur); }
    PG8_STAMP();
    if (STAMP && wid == 0) { stamps[lane] = lane < nts ? (((unsigned long long)(unsigned)ts_hi << 32) | (unsigned)ts_lo) : 0ull;
        if (lane == 62) stamps[62] = rt_entry; if (lane == 63) stamps[63] = (unsigned long long)wall_clock64(); }
#undef PG8_STAMP
#undef PG8_SA
#undef PG8_SB
#undef PG8_STAGE
#undef PG8_LDA
#undef PG8_LDB
#undef PG8_MMA
#undef PG8_WAIT_V
#undef PG8_WAIT_L
#undef PG8_BAR
#undef PG8_SCHED
}
}

DI void st_transpose(const float* __restrict__ src, bf16_t* __restrict__ dst, int K, int N, int Kpad, int Npad, float* lds, int bid, int nb) {
  const int tk = Kpad / 64, tn = Npad / 64;
  for (int it = bid; it < tk * tn; it += nb) {
    const int k0 = (it % tk) * 64, n0 = (it / tk) * 64;
    __syncthreads();
    for (int e = ltid(); e < 4096; e += NTHR) { const int i = e >> 6, j = e & 63, k = k0 + i, n = n0 + j; lds[i * 65 + j] = (k < K && n < N) ? src[(size_t)k * N + n] : 0.f; }
    __syncthreads();
    for (int e = ltid(); e < 4096; e += NTHR) { const int j = e >> 6, i = e & 63; dst[(size_t)(n0 + j) * Kpad + k0 + i] = f2bf(lds[i * 65 + j]); }
  }
}

DI void st_mods(const Prm& p, float* lds, int bid, int nb) {
  float* s = lds; float* red = lds + 9 * 2048;
  for (int e = ltid(); e < 9 * 2048; e += NTHR) { const int r = e >> 11, k = e & 2047; const float v = r < 8 ? p.c[r * 2048 + k] : p.c_ctx[k]; s[e] = siluf(v); }
  __syncthreads();
  const int kg = ltid() >> 6, cl = ltid() & 63;
  for (int it = bid; it < 2 * 192; it += nb) {
    const int l = it / 192, cb = (it % 192) * 64;
    const float* w = p.w_ada + (size_t)l * 2048 * NMOD + cb + cl;
    float acc[9];
#pragma unroll
    for (int r = 0; r < 9; ++r) acc[r] = 0.f;
    for (int k = kg * 256; k < kg * 256 + 256; ++k) { const float wv = w[(size_t)k * NMOD];
#pragma unroll
      for (int r = 0; r < 9; ++r) acc[r] += s[r * 2048 + k] * wv; }
#pragma unroll
    for (int r = 0; r < 9; ++r) red[(kg * 9 + r) * 64 + cl] = acc[r];
    __syncthreads();
    for (int e = ltid(); e < 576; e += NTHR) { const int r = e >> 6, c2 = e & 63; float t = 0.f;
      for (int g = 0; g < 8; ++g) t += red[(g * 9 + r) * 64 + c2];
      p.mod[((size_t)l * 9 + r) * NMOD + cb + c2] = t + p.b_ada[l * NMOD + cb + c2]; }
    __syncthreads();
  }
}

DI void st_tables(const Prm& p, int bid, int nb) {
  const size_t stride = (size_t)nb * NTHR, t0 = (size_t)bid * NTHR + ltid();
  for (size_t e = t0; e < (size_t)4096 * 8192; e += stride) { const int k1 = (int)(e >> 13), n = (int)(e & 8191), n1 = n & 4095, idx = (k1 * n1) & 4095;
    float sv, cv; sincosf((float)idx * (6.283185307179586f / 4096.f), &sv, &cv); p.DFTM[e] = f2bf((n < 4096 ? cv : -sv) * (1.f / 64.f)); }
  for (size_t e = t0; e < (size_t)256 * 512; e += stride) { const int k1 = (int)(e >> 9), n = (int)(e & 511), n1 = n & 255, idx = (k1 * n1) & 255;
    float sv, cv; sincosf((float)idx * (6.283185307179586f / 256.f), &sv, &cv); p.DFTC[e] = f2bf((n < 256 ? cv : -sv) * (1.f / 16.f)); }
  for (size_t e = t0; e < (size_t)2 * 128 * 128; e += stride) { const int tb = (int)(e >> 14), k2 = (int)((e >> 7) & 127), n2 = (int)(e & 127), idx = (k2 * n2) & 127;
    float sv, cv; sincosf((float)idx * (6.283185307179586f / 128.f), &sv, &cv); p.CCS[e] = (tb ? sv : cv) * 0.08838834764831845f; }
}

DI void st_modulate(const Prm& p, int layer, int which, bf16_t* __restrict__ dst, int bid, int nb) {
  const int wave = ltid() >> 6, lane = ltid() & 63;
  const int shoff = which ? 3 * DM : 0, scoff = which ? 4 * DM : DM;
  for (int row = bid * 8 + wave; row < MR; row += nb * 8) {
    const int b = row / LT, t = row - b * LT; const bool isc = t >= LL;
    if (isc && layer == 1 && which == 1) continue;
    const float* src = (layer == 0 && which == 0) ? (isc ? p.ctx + (size_t)(b * LCX + t - LL) * DM : p.x + (size_t)(b * LL + t) * DM) : p.X + (size_t)row * DM;
    f32x4 v[8]; float ss = 0.f;
#pragma unroll
    for (int i = 0; i < 8; ++i) { v[i] = *(const f32x4*)(src + (i * 64 + lane) * 4); ss += v[i][0] * v[i][0] + v[i][1] * v[i][1] + v[i][2] * v[i][2] + v[i][3] * v[i][3]; }
    ss = wsum(ss); const float rstd = rsqrtf(ss * (1.f / 2048.f) + EPSV);
    const float* mr = p.mod + ((size_t)layer * 9 + (isc ? 8 : b)) * NMOD;
#pragma unroll
    for (int i = 0; i < 8; ++i) { const int col = (i * 64 + lane) * 4; const f32x4 sc = *(const f32x4*)(mr + scoff + col), sh = *(const f32x4*)(mr + shoff + col);
      const f32x4 o = v[i] * rstd * (sc + 1.f) + sh; u32x2 w; w.x = pack2(o[0], o[1]); w.y = pack2(o[2], o[3]); *(u32x2*)(dst + (size_t)row * DM + col) = w; }
  }
}

DI void st_dnprep(const Prm& p, int layer, int bid, int nb) {
  const int wave = ltid() >> 6, lane = ltid() & 63;
  const float* conv = p.dn_conv + (size_t)layer * 5 * 1536;
  for (int task = bid * 8 + wave; task < (MR / 32) * 13; task += nb * 8) {
    const int tile = task / 13, grp = task - tile * 13, row0 = tile * 32;
    const int b = row0 / LT, t0 = row0 - b * LT; const bool isc = t0 >= LL;
    const int segt0 = isc ? t0 - LL : t0, seglen = isc ? LCX : LL;
    if (grp < 12) {
      const int c = grp * 128 + lane * 2;
      float w0[5], w1[5];
#pragma unroll
      for (int j = 0; j < 5; ++j) { w0[j] = conv[j * 1536 + c]; w1[j] = conv[j * 1536 + c + 1]; }
      unsigned zz[36];
#pragma unroll
      for (int r = 0; r < 36; ++r) { const int tt = segt0 + r - 2; zz[r] = (tt >= 0 && tt < seglen) ? *(const unsigned*)(p.Z + (size_t)(row0 + r - 2) * NZ + c) : 0u; }
#pragma unroll
      for (int r = 0; r < 32; ++r) { float a0 = 0.f, a1 = 0.f;
#pragma unroll
        for (int j = 0; j < 5; ++j) { a0 += __uint_as_float(zz[r + j] << 16) * w0[j]; a1 += __uint_as_float(zz[r + j] & 0xffff0000u) * w1[j]; }
        a0 = siluf(a0); a1 = siluf(a1);
        if (grp < 8) { const float ss = wsum(a0 * a0 + a1 * a1); const float sc = rsqrtf(ss + EPSV) * (grp < 4 ? 0.08838834764831845f : 1.f); a0 *= sc; a1 *= sc; }
        *(unsigned*)(p.DNQ + (size_t)(row0 + r) * 1536 + c) = pack2(a0, a1); }
    } else {
#pragma unroll
      for (int rr = 0; rr < 8; ++rr) { const int idx = lane + 64 * rr, row = row0 + (idx >> 4), wh = idx & 15, isb = wh >> 3, dh = wh & 7;
        const float z = bf2f(p.Z[(size_t)row * NZ + (isb ? C_DNB : C_DNA) + dh]); float o;
        if (!isb) { const float xx = z + p.dn_dt_bias[layer * 8 + dh]; const float sp = xx > 20.f ? xx : log1pf(expf(xx)); o = -expf(p.dn_a_log[layer * 8 + dh]) * sp; }
        else o = sigmf(z);
        p.GB[(size_t)row * 16 + wh] = o; }
    }
  }
}

DI void st_mlaprep(const Prm& p, int layer, int bid, int nb) {
  const int wave = ltid() >> 6, lane = ltid() & 63;
  const float* qn = p.mla_q_norm + layer * 448; const float* kvn = p.mla_kv_norm + layer * 128;
  for (int row = bid * 8 + wave; row < MR; row += nb * 8) {
    const bf16_t* z = p.Z + (size_t)row * NZ; const int b = row / LT, t = row - b * LT;
    float v[8]; float ss = 0.f;
#pragma unroll
    for (int k = 0; k < 8; ++k) v[k] = 0.f;
    if (lane < 56) { const u32x4 w = *(const u32x4*)(z + C_CQ + lane * 8);
#pragma unroll
      for (int k = 0; k < 4; ++k) { v[2 * k] = __uint_as_float(w[k] << 16); v[2 * k + 1] = __uint_as_float(w[k] & 0xffff0000u); ss += v[2 * k] * v[2 * k] + v[2 * k + 1] * v[2 * k + 1]; } }
    ss = wsum(ss); float rstd = rsqrtf(ss * (1.f / 448.f) + EPSV);
    { u32x4 o = {0u, 0u, 0u, 0u};
      if (lane < 56) { const f32x4 n0 = *(const f32x4*)(qn + lane * 8), n1 = *(const f32x4*)(qn + lane * 8 + 4);
        o.x = pack2(v[0] * rstd * n0[0], v[1] * rstd * n0[1]); o.y = pack2(v[2] * rstd * n0[2], v[3] * rstd * n0[3]); o.z = pack2(v[4] * rstd * n1[0], v[5] * rstd * n1[1]); o.w = pack2(v[6] * rstd * n1[2], v[7] * rstd * n1[3]); }
      *(u32x4*)(p.Aq + (size_t)row * 512 + lane * 8) = o; }
    ss = 0.f;
    if (lane < 16) { const u32x4 w = *(const u32x4*)(z + C_CKV + lane * 8);
#pragma unroll
      for (int k = 0; k < 4; ++k) { v[2 * k] = __uint_as_float(w[k] << 16); v[2 * k + 1] = __uint_as_float(w[k] & 0xffff0000u); ss += v[2 * k] * v[2 * k] + v[2 * k + 1] * v[2 * k + 1]; } }
    ss = wsum(ss); rstd = rsqrtf(ss * (1.f / 128.f) + EPSV);
    if (lane < 32) { u32x4 o = {0u, 0u, 0u, 0u};
      if (lane < 16) { const f32x4 n0 = *(const f32x4*)(kvn + lane * 8), n1 = *(const f32x4*)(kvn + lane * 8 + 4);
        o.x = pack2(v[0] * rstd * n0[0], v[1] * rstd * n0[1]); o.y = pack2(v[2] * rstd * n0[2], v[3] * rstd * n0[3]); o.z = pack2(v[4] * rstd * n1[0], v[5] * rstd * n1[1]); o.w = pack2(v[6] * rstd * n1[2], v[7] * rstd * n1[3]); }
      *(u32x4*)(p.Akv + (size_t)row * 256 + lane * 8) = o; }
    if (t < LL) {
      if (lane < 32) { const int half = lane >> 4, i = lane & 15; const float x1 = bf2f(z[C_KR + half * 32 + i]), x2 = bf2f(z[C_KR + half * 32 + 16 + i]);
        const float pos = (float)(half ? (t & 63) : (t >> 6)); const float ang = pos * exp2f(-(float)i * (13.287712379549449f / 16.f)); float sv, cv; sincosf(ang, &sv, &cv);
        p.KR[(size_t)row * 64 + half * 32 + i] = f2bf(x1 * cv - x2 * sv); p.KR[(size_t)row * 64 + half * 32 + 16 + i] = f2bf(x2 * cv + x1 * sv); }
    } else p.KR[(size_t)row * 64 + lane] = z[C_KR + lane];
  }
}

DI void st_qrope(const Prm& p, int bid, int nb) {
  const int wave = ltid() >> 6, lane = ltid() & 63;
  for (int row = bid * 8 + wave; row < MR; row += nb * 8) {
    const int b = row / LT, t = row - b * LT; if (t >= LL) continue;
#pragma unroll
    for (int k = 0; k < 2; ++k) { const int pid = lane + 64 * k, h = pid >> 5, r = pid & 31, half = r >> 4, i = r & 15;
      bf16_t* q = p.Qraw + (size_t)row * 768 + h * 192 + 128 + half * 32; const float x1 = bf2f(q[i]), x2 = bf2f(q[16 + i]);
      const float pos = (float)(half ? (t & 63) : (t >> 6)); const float ang = pos * exp2f(-(float)i * (13.287712379549449f / 16.f)); float sv, cv; sincosf(ang, &sv, &cv);
      q[i] = f2bf(x1 * cv - x2 * sv); q[16 + i] = f2bf(x2 * cv + x1 * sv); }
  }
}

DI void st_fnchan(const Prm& p, unsigned char* lds, int bid, int nb) {
  bf16_t* wt = (bf16_t*)lds;
  bf16_t* zt = (bf16_t*)(lds + 256 * 272);
  const int tid = ltid(), wave = tid >> 6, lane = tid & 63, r32 = lane & 31, hi = lane >> 5;
  __syncthreads();
  for (int e = tid; e < 256 * 128; e += NTHR) wt[(e >> 7) * 136 + (e & 127)] = f2bf(p.CCS[e]);
  for (int it = bid; it < (MR / 64) * 4; it += nb) {
    const int tile = it >> 2, g = it & 3, row0 = tile * 64, b = row0 / LT, t0 = row0 - b * LT;
    __syncthreads();
    for (int e = tid; e < 1024; e += NTHR) { const int r = e >> 4, c8 = (e & 15) * 8; *(u32x4*)(zt + r * 136 + c8) = *(const u32x4*)(p.Z + (size_t)(row0 + r) * NZ + C_FN + g * 128 + c8); }
    __syncthreads();
    f32x16 acc[2] = {};
#pragma unroll
    for (int k8 = 0; k8 < 8; ++k8) { const bf16x8 a = *(const bf16x8*)(wt + (wave * 32 + r32) * 136 + k8 * 16 + hi * 8);
#pragma unroll
      for (int tt = 0; tt < 2; ++tt) { const bf16x8 bb = *(const bf16x8*)(zt + (tt * 32 + r32) * 136 + k8 * 16 + hi * 8); acc[tt] = __builtin_amdgcn_mfma_f32_32x32x16_bf16(a, bb, acc[tt], 0, 0, 0); } }
    const int tb = wave >> 2;
#pragma unroll
    for (int tt = 0; tt < 2; ++tt)
#pragma unroll
      for (int r = 0; r < 16; ++r) { const int k2 = (wave & 3) * 32 + (r & 3) + 8 * (r >> 2) + 4 * hi;
        if (t0 < LL) p.PQT[((size_t)(b * 512 + g * 128 + k2)) * 8192 + tb * 4096 + t0 + tt * 32 + r32] = f2bf(acc[tt][r]);
        else p.PQTc[((size_t)(b * 512 + g * 128 + k2)) * 512 + tb * 256 + (t0 - LL) + tt * 32 + r32] = f2bf(acc[tt][r]); }
  }
}

DI int scan_row(int b, int dir, int s) { return s < LCX ? b * LT + LL + (dir ? LCX - 1 - s : s) : b * LT + (dir ? LL - 1 - (s - LCX) : (s - LCX)); }

DI void st_dnscan(const Prm& p, float* lds, int bid, int nb) {
  const int tid = ltid(), cc = tid >> 3, part = tid & 7;
  for (int item = bid; item < 128; item += nb) {
    const int chain = item >> 1, half = item & 1, b = chain >> 3, h = (chain >> 1) & 3, dir = chain & 1;
    f32x2 S[8];
#pragma unroll
    for (int j = 0; j < 8; ++j) S[j] = (f32x2){0.f, 0.f};
    constexpr int QP = 132, OQ = 0, OK_ = 32 * QP, OV = 2 * 32 * QP, OG = OV + 2048, OO = OG + 64, BUF = OO + 2048;
    bf16x8 pf[3]; float pg = 0.f;
    auto gload = [&](int batch) {
#pragma unroll
      for (int r = 0; r < 3; ++r) { const int e = tid + NTHR * r; if (e < 1280) { const int i = e / 40, ch = e - i * 40; const int row = scan_row(b, dir, batch * 32 + i);
          const int col = ch < 16 ? h * 128 + ch * 8 : (ch < 32 ? 512 + h * 128 + (ch - 16) * 8 : 1024 + h * 128 + half * 64 + (ch - 32) * 8);
          pf[r] = *(const bf16x8*)(p.DNQ + (size_t)row * 1536 + col); } }
      if (tid < 64) { const int i = tid >> 1, wh = tid & 1; const int row = scan_row(b, dir, batch * 32 + i); pg = p.GB[(size_t)row * 16 + wh * 8 + dir * 4 + h]; }
    };
    auto lstore = [&](float* bufp) {
#pragma unroll
      for (int r = 0; r < 3; ++r) { const int e = tid + NTHR * r; if (e < 1280) { const int i = e / 40, ch = e - i * 40;
          float* d = ch < 16 ? bufp + OQ + i * QP + ch * 8 + (ch >> 3) * 4 : (ch < 32 ? bufp + OK_ + i * QP + (ch - 16) * 8 + ((ch - 16) >> 3) * 4 : bufp + OV + i * 64 + (ch - 32) * 8);
#pragma unroll
          for (int j = 0; j < 8; ++j) d[j] = bf2f((bf16_t)pf[r][j]); } }
      if (tid < 64) { const int i = tid >> 1, wh = tid & 1; bufp[OG + i * 2 + wh] = wh ? pg : expf(pg); }
    };
    __syncthreads();
    gload(0); lstore(lds); __syncthreads();
    const int poff = part * 16 + (part >> 2) * 4;
    for (int batch = 0; batch < LT / 32; ++batch) {
      float* cur = lds + (batch & 1) * BUF; float* nxt = lds + ((batch + 1) & 1) * BUF;
      if (batch + 1 < LT / 32) gload(batch + 1);
      const float* q_s = cur + OQ + poff; const float* k_s = cur + OK_ + poff; const float* v_s = cur + OV + cc; const float* gb_s = cur + OG; float* o_s = cur + OO;
      f32x4 kn[4], qn[4]; f32x2 abn; float vvn;
#pragma unroll
      for (int j = 0; j < 4; ++j) { kn[j] = *(const f32x4*)(k_s + j * 4); qn[j] = *(const f32x4*)(q_s + j * 4); }
      abn = *(const f32x2*)gb_s; vvn = v_s[0];
#pragma unroll 2
      for (int i = 0; i < 32; ++i) {
        f32x2 k2[8], q2[8];
#pragma unroll
        for (int j = 0; j < 4; ++j) { k2[2 * j] = (f32x2){kn[j][0], kn[j][1]}; k2[2 * j + 1] = (f32x2){kn[j][2], kn[j][3]}; q2[2 * j] = (f32x2){qn[j][0], qn[j][1]}; q2[2 * j + 1] = (f32x2){qn[j][2], qn[j][3]}; }
        const float a = abn[0], beta = abn[1], vv = vvn;
        { const int in = i < 31 ? i + 1 : 31;
#pragma unroll
          for (int j = 0; j < 4; ++j) { kn[j] = *(const f32x4*)(k_s + in * QP + j * 4); qn[j] = *(const f32x4*)(q_s + in * QP + j * 4); }
          abn = *(const f32x2*)(gb_s + in * 2); vvn = v_s[in * 64]; }
        f32x2 d0 = k2[0] * S[0], d1 = k2[1] * S[1];
#pragma unroll
        for (int j = 2; j < 8; j += 2) { d0 += k2[j] * S[j]; d1 += k2[j + 1] * S[j + 1]; }
        d0 += d1; const float ks = a * red8(d0[0] + d0[1]);
        const float vn = beta * (vv - ks); const f32x2 vn2 = (f32x2){vn, vn}, a2 = (f32x2){a, a};
        f32x2 o0 = (f32x2){0.f, 0.f}, o1 = (f32x2){0.f, 0.f};
#pragma unroll
        for (int j = 0; j < 8; j += 2) { S[j] = S[j] * a2 + k2[j] * vn2; S[j + 1] = S[j + 1] * a2 + k2[j + 1] * vn2; o0 += q2[j] * S[j]; o1 += q2[j + 1] * S[j + 1]; }
        o0 += o1; const float o = red8(o0[0] + o0[1]);
        if (part == 0) o_s[i * 64 + cc] = o;
      }
      __syncthreads();
      { const int i = tid >> 4, c4 = (tid & 15) * 4; const int row = scan_row(b, dir, batch * 32 + i); const float* s = o_s + i * 64 + c4;
        u32x2 w; w.x = pack2(s[0], s[1]); w.y = pack2(s[2], s[3]);
        *(u32x2*)(p.OB + ((size_t)(0 * 2 + dir) * MR + row) * 512 + h * 128 + half * 64 + c4) = w; }
      if (batch + 1 < LT / 32) lstore(nxt);
      __syncthreads();
    }
  }
}

DI void st_glascan(const Prm& p, int layer, float* lds, int bid, int nb) {
  const int tid = ltid(), cc = tid >> 3, part = tid & 7;
  for (int item = bid; item < 128; item += nb) {
    const int chain = item >> 1, half = item & 1, b = chain >> 3, h = (chain >> 1) & 3, dir = chain & 1;
    const float* w2 = p.gla_w2 + (size_t)(layer * 2 + dir) * 16 * 256 + h * 64; const float* b2 = p.gla_b2 + (layer * 2 + dir) * 256 + h * 64;
    f32x2 S[4];
#pragma unroll
    for (int j = 0; j < 4; ++j) S[j] = (f32x2){0.f, 0.f};
    constexpr int OQ = 0, OK_ = 2048, OA = 4096, OV = 6144, OO = 8192, OAL = 10240, BUF = 10752;
    bf16x8 pf[2];
    auto gload = [&](int batch) {
#pragma unroll
      for (int r = 0; r < 2; ++r) { const int e = tid + NTHR * r; if (e < 832) { const int i = e / 26, ch = e - i * 26; const int row = scan_row(b, dir, batch * 32 + i);
          const int col = ch < 8 ? C_GQ + h * 64 + ch * 8 : (ch < 16 ? C_GK + h * 64 + (ch - 8) * 8 : (ch < 24 ? C_GV + h * 128 + half * 64 + (ch - 16) * 8 : C_GALPHA + dir * 16 + (ch - 24) * 8));
          pf[r] = *(const bf16x8*)(p.Z + (size_t)row * NZ + col); } }
    };
    auto lstore = [&](float* bufp) {
#pragma unroll
      for (int r = 0; r < 2; ++r) { const int e = tid + NTHR * r; if (e < 832) { const int i = e / 26, ch = e - i * 26;
          float* d = ch < 8 ? bufp + OQ + i * 64 + ch * 8 : (ch < 16 ? bufp + OK_ + i * 64 + (ch - 8) * 8 : (ch < 24 ? bufp + OV + i * 64 + (ch - 16) * 8 : bufp + OAL + i * 16 + (ch - 24) * 8));
          const float sc = ch < 8 ? 0.125f : 1.f;
#pragma unroll
          for (int j = 0; j < 8; ++j) d[j] = bf2f((bf16_t)pf[r][j]) * sc; } }
    };
    auto decay = [&](float* bufp) {
#pragma unroll
      for (int k = 0; k < 4; ++k) { const int e = tid + NTHR * k, i = e >> 6, d = e & 63; float zz = b2[d];
#pragma unroll
        for (int r = 0; r < 16; ++r) zz += bufp[OAL + i * 16 + r] * w2[r * 256 + d];
        const float nz = -zz; const float sp = nz > 20.f ? nz : log1pf(expf(nz));
        bufp[OA + i * 64 + d] = expf(-sp * (1.f / 16.f)); }
    };
    __syncthreads();
    gload(0); lstore(lds); __syncthreads(); decay(lds); __syncthreads();
    for (int batch = 0; batch < LT / 32; ++batch) {
      float* cur = lds + (batch & 1) * BUF; float* nxt = lds + ((batch + 1) & 1) * BUF;
      if (batch + 1 < LT / 32) gload(batch + 1);
      const float* q_s = cur + OQ + part * 8; const float* k_s = cur + OK_ + part * 8; const float* a_s = cur + OA + part * 8; const float* v_s = cur + OV + cc; float* o_s = cur + OO;
      f32x4 an[2], kn[2], qn[2]; float vvn;
#pragma unroll
      for (int j = 0; j < 2; ++j) { an[j] = *(const f32x4*)(a_s + j * 4); kn[j] = *(const f32x4*)(k_s + j * 4); qn[j] = *(const f32x4*)(q_s + j * 4); }
      vvn = v_s[0];
#pragma unroll 2
      for (int i = 0; i < 32; ++i) {
        f32x4 a4[2], k4[2], q4[2];
#pragma unroll
        for (int j = 0; j < 2; ++j) { a4[j] = an[j]; k4[j] = kn[j]; q4[j] = qn[j]; }
        const float vv = vvn; const f32x2 v2 = (f32x2){vv, vv};
        { const int in = i < 31 ? i + 1 : 31;
#pragma unroll
          for (int j = 0; j < 2; ++j) { an[j] = *(const f32x4*)(a_s + in * 64 + j * 4); kn[j] = *(const f32x4*)(k_s + in * 64 + j * 4); qn[j] = *(const f32x4*)(q_s + in * 64 + j * 4); }
          vvn = v_s[in * 64]; }
        f32x2 o0 = (f32x2){0.f, 0.f}, o1 = (f32x2){0.f, 0.f};
#pragma unroll
        for (int j = 0; j < 2; ++j) {
          S[2 * j] = S[2 * j] * (f32x2){a4[j][0], a4[j][1]} + (f32x2){k4[j][0], k4[j][1]} * v2; S[2 * j + 1] = S[2 * j + 1] * (f32x2){a4[j][2], a4[j][3]} + (f32x2){k4[j][2], k4[j][3]} * v2;
          o0 += (f32x2){q4[j][0], q4[j][1]} * S[2 * j]; o1 += (f32x2){q4[j][2], q4[j][3]} * S[2 * j + 1]; }
        o0 += o1; const float o = red8(o0[0] + o0[1]);
        if (part == 0) o_s[i * 64 + cc] = o;
      }
      __syncthreads();
      { const int i = tid >> 4, c4 = (tid & 15) * 4; const int row = scan_row(b, dir, batch * 32 + i); const float* s = o_s + i * 64 + c4;
        u32x2 w; w.x = pack2(s[0], s[1]); w.y = pack2(s[2], s[3]);
        *(u32x2*)(p.OB + ((size_t)(1 * 2 + dir) * MR + row) * 512 + h * 128 + half * 64 + c4) = w; }
      if (batch + 1 < LT / 32) lstore(nxt);
      __syncthreads();
      if (batch + 1 < LT / 32) decay(nxt);
      __syncthreads();
    }
  }
}

DI void st_combine(const Prm& p, int layer, int bid, int nb) {
  const int wave = ltid() >> 6, lane = ltid() & 63;
  for (long task = (long)bid * 8 + wave; task < (long)MR * 8; task += (long)nb * 8) {
    const int row = (int)(task >> 3), mh = (int)(task & 7), mixer = mh >> 2, h = mh & 3;
    const unsigned f = *(const unsigned*)(p.OB + ((size_t)(mixer * 2 + 0) * MR + row) * 512 + h * 128 + lane * 2), g = *(const unsigned*)(p.OB + ((size_t)(mixer * 2 + 1) * MR + row) * 512 + h * 128 + lane * 2);
    const float o0 = bf2f((bf16_t)(f & 0xffffu)) + bf2f((bf16_t)(g & 0xffffu)), o1 = bf2f((bf16_t)(f >> 16)) + bf2f((bf16_t)(g >> 16));
    const float ss = wsum(o0 * o0 + o1 * o1), rstd = rsqrtf(ss * (1.f / 128.f) + EPSV);
    const float* w = (mixer ? p.gla_norm : p.dn_norm) + layer * 128 + lane * 2;
    const unsigned gz = *(const unsigned*)(p.Z + (size_t)row * NZ + (mixer ? C_GGATE : C_DNGATE) + h * 128 + lane * 2);
    const float g0 = bf2f((bf16_t)(gz & 0xffffu)), g1 = bf2f((bf16_t)(gz >> 16));
    *(unsigned*)(p.Y + (size_t)row * DM + mixer * 512 + h * 128 + lane * 2) = pack2(o0 * rstd * w[0] * siluf(g0), o1 * rstd * w[1] * siluf(g1));
  }
}

DI unsigned fkey(float f) { const unsigned u = __float_as_uint(f); return u ^ ((u >> 31) ? 0xffffffffu : 0x80000000u); }
DI int pcnt(unsigned long long m) { return __builtin_popcountll(m); }
DI int lanes_below(unsigned long long m) { return (int)__builtin_amdgcn_mbcnt_hi((unsigned)(m >> 32), __builtin_amdgcn_mbcnt_lo((unsigned)m, 0u)); }
DI void st_peertopk(const Prm& p, int layer, unsigned char* lds, int bid, int nb) {
  bf16_t* ks = (bf16_t*)lds;
  bf16_t* qt = (bf16_t*)(lds + 69632);
  float* sc = (float*)(lds + 69632);
  const int tid = ltid(), wave = tid >> 6, lane = tid & 63, r32 = lane & 31, hi = lane >> 5;
  float* selv = (float*)(lds + 69632 + 33280) + wave * 64; int* seli = (int*)(selv + 32);
  int hcur = -1;
  const int nchunk = MR / 32;
  for (int it = bid; it < 8 * nchunk; it += nb) {
    const int h = it / nchunk, chunk = it - h * nchunk, row0 = chunk * 32;
    if (layer == 1 && (row0 % LT) >= LL) continue;
    __syncthreads();
    if (h != hcur) {
      const float* kg = p.peer_keys + ((size_t)(layer * 8 + h) * 2) * 128 * 128;
      for (int e = tid; e < 2 * 128 * 128; e += NTHR) { const int pn = e >> 7, k = e & 127; ks[pn * 136 + k] = f2bf(kg[e]); }
      hcur = h; }
    for (int e = tid; e < 1024; e += NTHR) { const int r = e >> 5, c8 = (e & 31) * 8; *(u32x4*)(qt + r * 264 + c8) = *(const u32x4*)(p.Qp + (size_t)(row0 + r) * DM + h * 256 + c8); }
    __syncthreads();
    { const int pt = wave >> 2, nt = wave & 3; f32x16 acc = {};
#pragma unroll
      for (int k8 = 0; k8 < 8; ++k8) { const bf16x8 a = *(const bf16x8*)(qt + r32 * 264 + pt * 128 + k8 * 16 + hi * 8), b = *(const bf16x8*)(ks + (pt * 128 + nt * 32 + r32) * 136 + k8 * 16 + hi * 8);
        acc = __builtin_amdgcn_mfma_f32_32x32x16_bf16(a, b, acc, 0, 0, 0); }
      __syncthreads();
#pragma unroll
      for (int r = 0; r < 16; ++r) sc[((r & 3) + 8 * (r >> 2) + 4 * hi) * 260 + pt * 128 + nt * 32 + r32] = acc[r]; }
    __syncthreads();
    for (int rr = 0; rr < 4; ++rr) {
      const int m = wave * 4 + rr, row = row0 + m;
      float s[2][2];
#pragma unroll
      for (int pp = 0; pp < 2; ++pp)
#pragma unroll
        for (int hh = 0; hh < 2; ++hh) s[pp][hh] = sc[m * 260 + pp * 128 + hh * 64 + lane];
      unsigned kk[2][2], T[2] = {0u, 0u};
#pragma unroll
      for (int pp = 0; pp < 2; ++pp) { kk[pp][0] = fkey(s[pp][0]); kk[pp][1] = fkey(s[pp][1]); }
      { unsigned ta = 0u, tb = 0u, da = 0u, db = 0u;
        for (int bit = 31; bit >= 0; --bit) { const unsigned m = 1u << bit;
          const unsigned ca = ta | m, cb = tb | m;
          const unsigned na = (unsigned)(pcnt(__ballot(kk[0][0] >= ca)) + pcnt(__ballot(kk[0][1] >= ca))), nb2 = (unsigned)(pcnt(__ballot(kk[1][0] >= cb)) + pcnt(__ballot(kk[1][1] >= cb)));
          const unsigned oa = (na >= 16u ? 1u : 0u) & ~da, ob = (nb2 >= 16u ? 1u : 0u) & ~db;
          ta |= (0u - oa) & m; tb |= (0u - ob) & m; da |= oa & (na == 16u ? 1u : 0u); db |= ob & (nb2 == 16u ? 1u : 0u);
          if (da & db) break; }
        T[0] = __builtin_amdgcn_readfirstlane(ta); T[1] = __builtin_amdgcn_readfirstlane(tb); }
#pragma unroll
      for (int pp = 0; pp < 2; ++pp) { const unsigned k0 = kk[pp][0], k1 = kk[pp][1], TT = T[pp];
        const unsigned long long g0 = __ballot(k0 > TT), g1 = __ballot(k1 > TT), e0 = __ballot(k0 == TT), e1 = __ballot(k1 == TT);
        const int ng0 = pcnt(g0), ng = ng0 + pcnt(g1), need = 16 - ng, ne0 = pcnt(e0);
        if (k0 > TT) { const int r = lanes_below(g0); selv[pp * 16 + r] = s[pp][0]; seli[pp * 16 + r] = lane; }
        if (k1 > TT) { const int r = ng0 + lanes_below(g1); selv[pp * 16 + r] = s[pp][1]; seli[pp * 16 + r] = lane + 64; }
        if (k0 == TT) { const int r = lanes_below(e0); if (r < need) { selv[pp * 16 + ng + r] = s[pp][0]; seli[pp * 16 + ng + r] = lane; } }
        if (k1 == TT) { const int r = ne0 + lanes_below(e1); if (r < need) { selv[pp * 16 + ng + r] = s[pp][1]; seli[pp * 16 + ng + r] = lane + 64; } } }
      __builtin_amdgcn_wave_barrier();
      float cd[4]; unsigned ck[4]; { const float sa = selv[lane >> 2]; const f32x4 sb = *(const f32x4*)(selv + 16 + (lane & 3) * 4);
#pragma unroll
        for (int q = 0; q < 4; ++q) { cd[q] = sa + sb[q]; ck[q] = fkey(cd[q]); } }
      unsigned T2 = 0u;
      for (int bit = 31; bit >= 0; --bit) { const unsigned m = 1u << bit, c = T2 | m;
        const unsigned n = (unsigned)(pcnt(__ballot(ck[0] >= c)) + pcnt(__ballot(ck[1] >= c)) + pcnt(__ballot(ck[2] >= c)) + pcnt(__ballot(ck[3] >= c)));
        T2 |= (0u - (n >= 16u ? 1u : 0u)) & m; if (n == 16u) break; }
      T2 = __builtin_amdgcn_readfirstlane(T2);
      float mx = fmaxf(fmaxf(cd[0], cd[1]), fmaxf(cd[2], cd[3])); mx = wmax(mx);
      int base = 0; float esum = 0.f; const int ia = seli[lane >> 2]; int rk[4]; float ev[4];
#pragma unroll
      for (int q = 0; q < 4; ++q) { const unsigned long long g = __ballot(ck[q] > T2); rk[q] = ck[q] > T2 ? base + lanes_below(g) : 99; base += pcnt(g); }
#pragma unroll
      for (int q = 0; q < 4; ++q) { const unsigned long long g = __ballot(ck[q] == T2); if (ck[q] == T2) rk[q] = base + lanes_below(g); base += pcnt(g); }
#pragma unroll
      for (int q = 0; q < 4; ++q) { ev[q] = rk[q] < 16 ? __expf(cd[q] - mx) : 0.f; esum += ev[q]; }
      esum = wsum(esum); const float inv = 1.f / esum;
      int* orow = p.IDX + (size_t)row * 128 + h * 16; float* grow = p.GATE + (size_t)row * 128 + h * 16;
#pragma unroll
      for (int q = 0; q < 4; ++q) if (rk[q] < 16) { orow[rk[q]] = ia * 128 + seli[16 + (lane & 3) * 4 + q]; grow[rk[q]] = ev[q] * inv; }
      __builtin_amdgcn_wave_barrier();
    }
  }
}

constexpr float U_SC = 1024.f, V_SC = 16.f;
DI void st_cvt_tables(const Prm& p, int layer, int bid, int nb) {
  const size_t n16 = (size_t)16384 * DM / 16, stride = (size_t)nb * NTHR;
  const float* U = p.peer_u + (size_t)layer * 16384 * DM; const float* V = p.peer_v + (size_t)layer * 16384 * DM;
  for (size_t e = (size_t)bid * NTHR + ltid(); e < 2 * n16; e += stride) { const bool isv = e >= n16; const size_t k = isv ? e - n16 : e;
    const float* src = (isv ? V : U) + k * 16; const float sc = isv ? V_SC : U_SC; u32x4 w;
#pragma unroll
    for (int q = 0; q < 4; ++q) { const f32x4 a = *(const f32x4*)(src + q * 4) * sc; int r = 0;
      r = __builtin_amdgcn_cvt_pk_fp8_f32(a[0], a[1], r, false); r = __builtin_amdgcn_cvt_pk_fp8_f32(a[2], a[3], r, true); w[q] = (unsigned)r; }
    *(u32x4*)((unsigned char*)(isv ? p.Vb : p.Ub) + k * 16) = w; }
}

DI void st_peergather(const Prm& p, int layer, float* lds, int bid, int nb, bool dry = false) {
  const int tid = ltid(), wave = tid >> 6, lane = tid & 63;
  const unsigned char* Ub = (const unsigned char*)p.Ub; const unsigned char* Vb = (const unsigned char*)p.Vb;
  for (int row = bid; row < MR; row += nb) {
    const int b = row / LT, t = row - b * LT; const bool isc = t >= LL;
    if (isc && layer == 1) continue;
    f32x2 hv[16];
#pragma unroll
    for (int i = 0; i < 2; ++i) {
#pragma unroll
      for (int q = 0; q < 2; ++q) { const u32x4 w = *(const u32x4*)(p.H2 + (size_t)row * DM + i * 1024 + lane * 16 + q * 8);
#pragma unroll
        for (int k = 0; k < 4; ++k) hv[i * 8 + q * 4 + k] = (f32x2){__uint_as_float(w[k] << 16), __uint_as_float(w[k] & 0xffff0000u)}; } }
    f32x2 acc[16];
#pragma unroll
    for (int i = 0; i < 16; ++i) acc[i] = (f32x2){0.f, 0.f};
    const int myidx = lane < 16 ? p.IDX[(size_t)row * 128 + wave * 16 + lane] : 0; const float mygate = lane < 16 ? p.GATE[(size_t)row * 128 + wave * 16 + lane] : 0.f;
#pragma unroll 1
    for (int k0 = 0; k0 < 16; k0 += 4) {
      u32x4 uu[4][2], vv[4][2];
#pragma unroll
      for (int q = 0; q < 4; ++q) { const int e = __builtin_amdgcn_readfirstlane(__shfl(myidx, k0 + q));
        const unsigned char* ur = Ub + (size_t)e * DM + lane * 16; const unsigned char* vr = Vb + (size_t)e * DM + lane * 16;
#pragma unroll
        for (int i = 0; i < 2; ++i) { uu[q][i] = *(const u32x4*)(ur + i * 1024); vv[q][i] = *(const u32x4*)(vr + i * 1024); } }
#pragma unroll
      for (int q = 0; q < 4; ++q) { f32x2 d0 = (f32x2){0.f, 0.f}, d1 = (f32x2){0.f, 0.f};
#pragma unroll
        for (int i = 0; i < 2; ++i)
#pragma unroll
          for (int k = 0; k < 4; ++k) { d0 += __builtin_amdgcn_cvt_pk_f32_fp8((int)uu[q][i][k], false) * hv[i * 8 + k * 2]; d1 += __builtin_amdgcn_cvt_pk_f32_fp8((int)uu[q][i][k], true) * hv[i * 8 + k * 2 + 1]; }
        d0 += d1; float d = wsum(d0[0] + d0[1]) * (1.f / U_SC);
        const float wgt = __shfl(mygate, k0 + q) * 0.5f * d * (1.f + erff(d * 0.70710678118654752f)); const f32x2 w2 = (f32x2){wgt, wgt};
#pragma unroll
        for (int i = 0; i < 2; ++i)
#pragma unroll
          for (int k = 0; k < 4; ++k) { acc[i * 8 + k * 2] += w2 * __builtin_amdgcn_cvt_pk_f32_fp8((int)vv[q][i][k], false); acc[i * 8 + k * 2 + 1] += w2 * __builtin_amdgcn_cvt_pk_f32_fp8((int)vv[q][i][k], true); } }
    }
    __syncthreads();
#pragma unroll
    for (int i = 0; i < 2; ++i) { float* d = lds + wave * 2048 + i * 1024 + lane * 16;
#pragma unroll
      for (int k = 0; k < 4; ++k) *(f32x4*)(d + k * 4) = (f32x4){acc[i * 8 + k * 2][0], acc[i * 8 + k * 2][1], acc[i * 8 + k * 2 + 1][0], acc[i * 8 + k * 2 + 1][1]}; }
    __syncthreads();
    { const int col = tid * 4; f32x4 sum = (f32x4){0.f, 0.f, 0.f, 0.f};
#pragma unroll
      for (int w = 0; w < 8; ++w) sum += *(const f32x4*)(lds + w * 2048 + col);
      const f32x4 g2 = *(const f32x4*)(p.mod + ((size_t)layer * 9 + (isc ? 8 : b)) * NMOD + 5 * DM + col) * (1.f / V_SC);
      float* xr = p.X + (size_t)row * DM + col; const f32x4 xn = *(const f32x4*)xr + g2 * sum;
      if (!dry) {
        float ss = wsum(xn[0] * xn[0] + xn[1] * xn[1] + xn[2] * xn[2] + xn[3] * xn[3]);
        if (lane == 0) lds[16384 + wave] = ss;
        __syncthreads();
        ss = 0.f;
#pragma unroll
        for (int w = 0; w < 8; ++w) ss += lds[16384 + w];
        const float rstd = rsqrtf(ss * (1.f / 2048.f) + EPSV);
        if (layer == 0) { *(f32x4*)xr = xn;
          const float* mr = p.mod + ((size_t)9 + (isc ? 8 : b)) * NMOD; const f32x4 sc = *(const f32x4*)(mr + DM + col), sh = *(const f32x4*)(mr + col);
          const f32x4 o = xn * rstd * (sc + 1.f) + sh; u32x2 w; w.x = pack2(o[0], o[1]); w.y = pack2(o[2], o[3]); *(u32x2*)(p.H + (size_t)row * DM + col) = w; }
        else *(f32x4*)(p.out + ((size_t)b * LL + t) * DM + col) = xn * rstd * *(const f32x4*)(p.final_norm + col);
      } }
  }
}

DI void st_final(const Prm& p, int bid, int nb) {
  const int wave = ltid() >> 6, lane = ltid() & 63;
  for (int r = bid * 8 + wave; r < NB * LL; r += nb * 8) {
    const int b = r / LL, t = r - b * LL; const float* src = p.X + (size_t)(b * LT + t) * DM;
    f32x4 v[8]; float ss = 0.f;
#pragma unroll
    for (int i = 0; i < 8; ++i) { v[i] = *(const f32x4*)(src + (i * 64 + lane) * 4); ss += v[i][0] * v[i][0] + v[i][1] * v[i][1] + v[i][2] * v[i][2] + v[i][3] * v[i][3]; }
    ss = wsum(ss); const float rstd = rsqrtf(ss * (1.f / 2048.f) + EPSV);
#pragma unroll
    for (int i = 0; i < 8; ++i) { const int col = (i * 64 + lane) * 4; *(f32x4*)(p.out + (size_t)r * DM + col) = v[i] * rstd * *(const f32x4*)(p.final_norm + col); }
  }
}

namespace att {
constexpr int NW = 8, QBLK = 32, KVBLK = 64;
constexpr float SCALE = 0.07216878364870322f;
constexpr float THR = 8.f;
constexpr int LDQ = 768, LDK = 1024, LDKR = 64, LDO = DM;
constexpr int SHM_V = KVBLK * 128 * 2, SHM_K = KVBLK * 128 * 2, SHM_KR = KVBLK * 64 * 2, SHM_ATTN = 2 * SHM_V + 2 * SHM_K + 2 * SHM_KR + NW * 64 * 4;
#define KSWZ(row, colB) ((row) * 256 + ((colB) ^ (((row) & 7) << 4)))
#define KRSWZ(row, colB) ((row) * 128 + ((colB) ^ ((((row) >> 1) & 7) << 4)))
#define SBAR() __builtin_amdgcn_sched_barrier(0)
DI int crow(int r, int hi) { return (r & 3) + 8 * (r >> 2) + 4 * hi; }
DI unsigned cvtpk(float lo, float hi) { unsigned r; asm volatile("v_cvt_pk_bf16_f32 %0, %1, %2" : "=v"(r) : "v"(lo), "v"(hi)); return r; }

DI void partialSM(f32x16& p0, f32x16& p1, float& m_reg, float& mn, float& alpha) {
  constexpr float C = SCALE * 1.4426950408889634f;
  float pmax = p0[0];
#pragma unroll
  for (int r = 1; r < 16; ++r) pmax = fmaxf(pmax, p0[r]);
#pragma unroll
  for (int r = 0; r < 16; ++r) pmax = fmaxf(pmax, p1[r]);
  { auto rr = __builtin_amdgcn_permlane32_swap(__float_as_uint(pmax), __float_as_uint(pmax), false, false);
    pmax = fmaxf(__uint_as_float(rr[0]), __uint_as_float(rr[1])); }
  if (__builtin_expect(__all(pmax - m_reg <= THR / SCALE), 1)) { mn = m_reg; alpha = 1.f; }
  else { mn = fmaxf(m_reg, pmax); alpha = __builtin_amdgcn_exp2f((m_reg - mn) * C); m_reg = mn; }
  const float mnC = -mn * C;
#pragma unroll
  for (int r = 0; r < 16; ++r) p0[r] = fmaf(p0[r], C, mnC);
#pragma unroll
  for (int r = 0; r < 16; ++r) p1[r] = fmaf(p1[r], C, mnC);
#pragma unroll
  for (int r = 0; r < 16; ++r) p0[r] = __builtin_amdgcn_exp2f(p0[r]);
}
DI void finishSM(f32x16& p0, f32x16& p1, float alpha, float& l_reg, bf16x8& pa0, bf16x8& pa1, bf16x8& pa2, bf16x8& pa3) {
#pragma unroll
  for (int r = 0; r < 16; ++r) p1[r] = __builtin_amdgcn_exp2f(p1[r]);
  float ps = 0;
#pragma unroll
  for (int r = 0; r < 16; ++r) ps += p0[r];
#pragma unroll
  for (int r = 0; r < 16; ++r) ps += p1[r];
  { auto rr = __builtin_amdgcn_permlane32_swap(__float_as_uint(ps), __float_as_uint(ps), false, false);
    ps = __uint_as_float(rr[0]) + __uint_as_float(rr[1]); }
  l_reg = l_reg * alpha + ps;
#define PK4(P, BASE, OUT) do { unsigned a0 = cvtpk(P[BASE + 0], P[BASE + 1]), a1 = cvtpk(P[BASE + 2], P[BASE + 3]);   \
    unsigned b0 = cvtpk(P[BASE + 4], P[BASE + 5]), b1 = cvtpk(P[BASE + 6], P[BASE + 7]);                              \
    auto r0 = __builtin_amdgcn_permlane32_swap(a0, b0, false, false); auto r1 = __builtin_amdgcn_permlane32_swap(a1, b1, false, false); \
    u32x4 w = {r0[0], r1[0], r0[1], r1[1]}; OUT = *reinterpret_cast<bf16x8*>(&w); } while (0)
  PK4(p0, 0, pa0); PK4(p0, 8, pa1); PK4(p1, 0, pa2); PK4(p1, 8, pa3);
#undef PK4
}
DI void qkt(f32x16& p0, f32x16& p1, const char* Ks, const char* KRs, const bf16x8* qr, int r32, int hi) {
  p0 = f32x16{}; p1 = f32x16{};
#pragma unroll
  for (int d0 = 0; d0 < 8; ++d0) { const int cb = (d0 * 16 + hi * 8) * 2;
    const bf16x8 b0 = *reinterpret_cast<const bf16x8*>(Ks + KSWZ(r32, cb));
    const bf16x8 b1 = *reinterpret_cast<const bf16x8*>(Ks + KSWZ(32 + r32, cb));
    p0 = __builtin_amdgcn_mfma_f32_32x32x16_bf16(b0, qr[d0], p0, 0, 0, 0);
    p1 = __builtin_amdgcn_mfma_f32_32x32x16_bf16(b1, qr[d0], p1, 0, 0, 0); }
#pragma unroll
  for (int d0 = 0; d0 < 4; ++d0) { const int cb = (d0 * 16 + hi * 8) * 2;
    const bf16x8 b0 = *reinterpret_cast<const bf16x8*>(KRs + KRSWZ(r32, cb));
    const bf16x8 b1 = *reinterpret_cast<const bf16x8*>(KRs + KRSWZ(32 + r32, cb));
    p0 = __builtin_amdgcn_mfma_f32_32x32x16_bf16(b0, qr[8 + d0], p0, 0, 0, 0);
    p1 = __builtin_amdgcn_mfma_f32_32x32x16_bf16(b1, qr[8 + d0], p1, 0, 0, 0); }
}
DI int v_st(int k, int c) { const int kk = (k & ~0xC) | ((k & 4) << 1) | ((k & 8) >> 1); return ((kk >> 3) * 4 + (c >> 5)) * 512 + ((kk & 7) * 32 + (c & 31)) * 2; }
DI int v_rd_base(int lane) { return ((lane & 3) << 3) | (((lane >> 2) & 3) << 6) | (((lane >> 4) & 1) << 5) | (((lane >> 5) & 1) << 8); }
constexpr int v_rd_off(int d0, int ks, int half) { return d0 * 512 + ks * 4096 + half * 2048; }
template <int OFF> DI s16x4 tr_read(int vb) { s16x4 r; asm volatile("ds_read_b64_tr_b16 %0, %1 offset:%2" : "=&v"(r) : "v"(vb), "i"(OFF) : "memory"); return r; }
template <int D0> DI void pv_one(f32x16& od, int vb, bf16x8 pa0, bf16x8 pa1, bf16x8 pa2, bf16x8 pa3) {
  const s16x4 l0 = tr_read<v_rd_off(D0, 0, 0)>(vb), h0 = tr_read<v_rd_off(D0, 0, 1)>(vb), l1 = tr_read<v_rd_off(D0, 1, 0)>(vb), h1 = tr_read<v_rd_off(D0, 1, 1)>(vb);
  const s16x4 l2 = tr_read<v_rd_off(D0, 2, 0)>(vb), h2 = tr_read<v_rd_off(D0, 2, 1)>(vb), l3 = tr_read<v_rd_off(D0, 3, 0)>(vb), h3 = tr_read<v_rd_off(D0, 3, 1)>(vb);
  asm volatile("s_waitcnt lgkmcnt(0)" ::: "memory"); SBAR();
#define PK(L, H) (bf16x8){L[0], L[1], L[2], L[3], H[0], H[1], H[2], H[3]}
  od = __builtin_amdgcn_mfma_f32_32x32x16_bf16(pa0, PK(l0, h0), od, 0, 0, 0);
  od = __builtin_amdgcn_mfma_f32_32x32x16_bf16(pa1, PK(l1, h1), od, 0, 0, 0);
  od = __builtin_amdgcn_mfma_f32_32x32x16_bf16(pa2, PK(l2, h2), od, 0, 0, 0);
  od = __builtin_amdgcn_mfma_f32_32x32x16_bf16(pa3, PK(l3, h3), od, 0, 0, 0);
#undef PK
}
DI void pv_d0(f32x16* o, int vb, bf16x8 pa0, bf16x8 pa1, bf16x8 pa2, bf16x8 pa3) {
  pv_one<0>(o[0], vb, pa0, pa1, pa2, pa3); pv_one<1>(o[1], vb, pa0, pa1, pa2, pa3); pv_one<2>(o[2], vb, pa0, pa1, pa2, pa3); pv_one<3>(o[3], vb, pa0, pa1, pa2, pa3);
}

DI void attn_body(const bf16_t* __restrict__ Qb, const bf16_t* __restrict__ Kh, const bf16_t* __restrict__ Vh, const bf16_t* __restrict__ KRh, bf16_t* __restrict__ Ob, int seq, int tpos0, char* lds) {
  const int tid = ltid(), wid = tid >> 6, lane = tid & 63, r32 = lane & 31, hi = lane >> 5;
  char* V_lds = lds; char* K_lds = lds + 2 * SHM_V; char* KR_lds = lds + 2 * SHM_V + 2 * SHM_K;
  float* ws = (float*)(lds + 2 * SHM_V + 2 * SHM_K + 2 * SHM_KR) + wid * 64; float* li_l = ws; float* al_l = ws + 32;
  float m_reg = -1e30f, l_reg = 0; f32x16 o[4] = {}; bf16x8 qr[12];
  const bf16_t* Qw = Qb + (long)(wid * QBLK + r32) * LDQ + hi * 8;
#pragma unroll
  for (int d0 = 0; d0 < 12; ++d0) qr[d0] = *reinterpret_cast<const bf16x8*>(Qw + d0 * 16);
  if (tpos0 >= 0) {
    const int t = tpos0 + wid * QBLK + r32;
#pragma unroll
    for (int hf = 0; hf < 2; ++hf) { const float pos = (float)(hf ? (t & 63) : (t >> 6));
#pragma unroll
      for (int j = 0; j < 8; ++j) { const float ang = pos * exp2f(-(float)(hi * 8 + j) * (13.287712379549449f / 16.f)); float sv, cv; sincosf(ang, &sv, &cv);
        const float x1 = bf2f((bf16_t)qr[8 + 2 * hf][j]), x2 = bf2f((bf16_t)qr[9 + 2 * hf][j]);
        qr[8 + 2 * hf][j] = (short)f2bf(x1 * cv - x2 * sv); qr[9 + 2 * hf][j] = (short)f2bf(x2 * cv + x1 * sv); } }
  }
  const int sr = tid >> 4, sc = (tid & 15) * 8, vst0 = v_st(sr, sc), vst1 = v_st(32 + sr, sc);
  const int krr = tid >> 3, krc = (tid & 7) * 8;
  const int vb0 = (int)(uintptr_t)V_lds + v_rd_base(lane);
  bf16x8 vs0, vs1, ks0, ks1, kr0;
#define SLOAD(k0) do { vs0 = *reinterpret_cast<const bf16x8*>(&Vh[(long)((k0) + sr) * LDK + sc]); vs1 = *reinterpret_cast<const bf16x8*>(&Vh[(long)((k0) + 32 + sr) * LDK + sc]); \
    ks0 = *reinterpret_cast<const bf16x8*>(&Kh[(long)((k0) + sr) * LDK + sc]); ks1 = *reinterpret_cast<const bf16x8*>(&Kh[(long)((k0) + 32 + sr) * LDK + sc]); \
    kr0 = *reinterpret_cast<const bf16x8*>(&KRh[(long)((k0) + krr) * LDKR + krc]); } while (0)
#define SWRITE(b) do { *(bf16x8*)(V_lds + (b) * SHM_V + vst0) = vs0; *(bf16x8*)(V_lds + (b) * SHM_V + vst1) = vs1; const int kc = sc * 2;               \
    *(bf16x8*)(K_lds + (b) * SHM_K + KSWZ(sr, kc)) = ks0; *(bf16x8*)(K_lds + (b) * SHM_K + KSWZ(32 + sr, kc)) = ks1;                       \
    *(bf16x8*)(KR_lds + (b) * SHM_KR + KRSWZ(krr, krc * 2)) = kr0; } while (0)
#define SWAIT() asm volatile("s_waitcnt vmcnt(0)" ::: "memory")
#define RESC(a) do { if (__any((a) < 1.f)) { if (hi == 0) al_l[r32] = (a); asm volatile("s_waitcnt lgkmcnt(0)" ::: "memory"); \
    _Pragma("unroll") for (int d = 0; d < 4; ++d) _Pragma("unroll") for (int r = 0; r < 16; ++r) o[d][r] *= al_l[crow(r, hi)]; } } while (0)
  f32x16 p0, p1; float mn, al; bf16x8 pa0, pa1, pa2, pa3; const int NT = seq / KVBLK;
  SLOAD(0); SWAIT(); SWRITE(0); __syncthreads();
  for (int j = 0; j < NT; ++j) {
    const int buf = j & 1; const bool more = j + 1 < NT;
    if (more) SLOAD((j + 1) * KVBLK);
    SBAR(); qkt(p0, p1, K_lds + buf * SHM_K, KR_lds + buf * SHM_KR, qr, r32, hi);
    partialSM(p0, p1, m_reg, mn, al); RESC(al);
    finishSM(p0, p1, al, l_reg, pa0, pa1, pa2, pa3); SBAR();
    pv_d0(o, vb0 + buf * SHM_V, pa0, pa1, pa2, pa3);
    if (more) { SWAIT(); SWRITE(buf ^ 1); }
    __syncthreads();
  }
  if (hi == 0) li_l[r32] = l_reg; asm volatile("s_waitcnt lgkmcnt(0)" ::: "memory");
  float rli[16];
#pragma unroll
  for (int r = 0; r < 16; ++r) rli[r] = __builtin_amdgcn_rcpf(li_l[crow(r, hi)]);
  bf16_t* Ow = Ob + (long)(wid * QBLK) * LDO;
#pragma unroll
  for (int r = 0; r < 16; ++r) { const int orow = crow(r, hi);
#pragma unroll
    for (int d0 = 0; d0 < 4; ++d0) Ow[(long)orow * LDO + d0 * 32 + r32] = f2bf(o[d0][r] * rli[r]); }
  __syncthreads();
#undef SLOAD
#undef SWRITE
#undef SWAIT
#undef RESC
}
}

DI void st_attn(const Prm& p, int layer, char* lds, int bid, int nb) {
  const int nlat = NB * 4 * 16, nitem = nlat + (layer == 0 ? NB * 4 : 0);
  for (int it = bid; it < nitem; it += nb) {
    if (it < nlat) { const int b = it >> 6, h = (it >> 4) & 3, qb = it & 15; const size_t r0 = (size_t)b * LT;
      att::attn_body(p.Qraw + (r0 + qb * 256) * 768 + h * 192, p.KV + r0 * 1024 + h * 256, p.KV + r0 * 1024 + h * 256 + 128, p.KR + r0 * 64,
                     p.Y + (r0 + qb * 256) * DM + 1024 + h * 128, LT, qb * 256, lds); }
    else { const int k = it - nlat, b = k >> 2, h = k & 3; const size_t r0 = (size_t)b * LT + LL;
      att::attn_body(p.Qraw + r0 * 768 + h * 192, p.KV + r0 * 1024 + h * 256, p.KV + r0 * 1024 + h * 256 + 128, p.KR + r0 * 64, p.Y + r0 * DM + 1024 + h * 128, LCX, -1, lds); }
  }
}

struct EpiResid {
  static constexpr bool PERM = false, AFTER_DRAIN = false;
  const float* xlat; const float* xctx; float* X; const float* modl; int first;
  __device__ __forceinline__ void operator()(const pg8::f32x4 (&acc)[2][2][4][2], const pg8::Unit& u, int wr, int wc, int fr, int fq) const {
    const int b = u.pm / 17, tl = u.pm - b * 17; const bool isc = tl == 16;
    const float* g = modl + (size_t)(isc ? 8 : b) * NMOD + 2 * DM;
    const int rloc0 = wr * 64 + fr, col0 = u.pn * 256 + wc * 32 + 4 * fq;
    pg8::f32x4 gv[2][2];
#pragma unroll
    for (int bj = 0; bj < 2; ++bj)
#pragma unroll
      for (int n = 0; n < 2; ++n) gv[bj][n] = *(const pg8::f32x4*)(g + col0 + bj * 128 + n * 16);
#pragma unroll
    for (int ai = 0; ai < 2; ++ai)
#pragma unroll
      for (int m = 0; m < 4; ++m) { const int rl = rloc0 + ai * 128 + m * 16; const size_t row = (size_t)u.pm * 256 + rl;
        const float* src = first ? (isc ? xctx + ((size_t)b * LCX + rl) * DM : xlat + ((size_t)b * LL + tl * 256 + rl) * DM) : X + row * DM;
        float* dst = X + row * DM;
#pragma unroll
        for (int bj = 0; bj < 2; ++bj)
#pragma unroll
          for (int n = 0; n < 2; ++n) { const int c = col0 + bj * 128 + n * 16; *(pg8::f32x4*)(dst + c) = *(const pg8::f32x4*)(src + c) + gv[bj][n] * acc[ai][bj][m][n]; } }
  }
};

struct LatentOrder : pg8::StaticOrder {
  __device__ bool next(int i, pg8::Unit& u) const { const bool ok = pg8::StaticOrder::next(i, u); u.pm += u.pm >> 4; return ok; }
};
template <class Epi> DI void run_gemm_lat(unsigned char* lds, const bf16_t* A, const bf16_t* Bt, int N, int K, const Epi& E, int bid, int nb) {
  pg8::Gemm g; g.A = A; g.Bt = Bt; g.M = NB * LL; g.N = N; g.K = K;
  LatentOrder S; S.init(NB * LL, N, nb, bid);
  pg8::gemm_phase<Epi, LatentOrder, false>((PG8_LAS unsigned char*)lds, g, S, E, nullptr);
}
template <class Epi> DI void run_gemm(unsigned char* lds, const bf16_t* A, const bf16_t* Bt, int M, int N, int K, const Epi& E, int bid, int nb) {
  pg8::Gemm g; g.A = A; g.Bt = Bt; g.M = M; g.N = N; g.K = K;
  pg8::StaticOrder S; S.init(M, N, nb, bid);
  pg8::gemm_phase<Epi, pg8::StaticOrder, false>((PG8_LAS unsigned char*)lds, g, S, E, nullptr);
}
DI pg8::EpiBf16<0> epi_bf16(bf16_t* O, int ldc, int split_cols = 0, size_t split_stride = 0) { pg8::EpiBf16<0> e; e.O = O; e.ldc = ldc; e.bias = nullptr; e.split_cols = split_cols; e.split_stride = split_stride; return e; }

#ifndef PROBE
#define PROBE 0
#endif
constexpr int LDS_MAIN = 131072, LDS_TOTAL = LDS_MAIN + 64;
#define PRM() (*(const __attribute__((address_space(4))) Prm*)launder_k(kp))
typedef const __attribute__((address_space(4))) void* kptr_t;
DI kptr_t launder_k(kptr_t q) { asm volatile("" : "+s"(q)); return q; }
extern __shared__ __attribute__((aligned(16))) unsigned char shm[];
__global__ void __launch_bounds__(NTHR, 2) mega(Prm p_unused) {
#if defined(__HIP_DEVICE_COMPILE__)
  kptr_t kp = (kptr_t)__builtin_amdgcn_kernarg_segment_ptr();
  const int bid0 = blockIdx.x, nb0 = gridDim.x;
#define bid lsg(bid0)
#define nb lsg(nb0)
  uint4* xbw = (uint4*)(shm + LDS_MAIN);
  if (threadIdx.x == 0) *xbw = make_uint4(0u, 0u, 0u, 0u);
  __syncthreads();
  { const Prm p = PRM(); (void)xcd_barrier_post(p.bar, (volatile LAS unsigned*)xbw); }
#define GRID_BAR() do { XcdBarrier b_; b_.bar = PRM().bar; b_.x = xb_xcc_id(); b_.st = (volatile LAS unsigned*)(shm + LDS_MAIN); xcd_barrier(b_); } while (0)
  float* lf = (float*)shm;
  for (int ly = 0; ly < 2; ++ly) { const Prm p = PRM();
    st_transpose(p.w_in + (size_t)ly * DM * IN_W, p.WinT + (size_t)ly * NZ * DM, DM, IN_W, DM, NZ, lf, bid, nb);
    st_transpose(p.w_out + (size_t)ly * DM * DM, p.WoutT + (size_t)ly * DM * DM, DM, DM, DM, DM, lf, bid, nb);
    st_transpose(p.peer_wq + (size_t)ly * DM * DM, p.WqT + (size_t)ly * DM * DM, DM, DM, DM, DM, lf, bid, nb);
    st_transpose(p.mla_w_uq + (size_t)ly * 448 * 768, p.WuqT + (size_t)ly * 768 * 512, 448, 768, 512, 768, lf, bid, nb);
    st_transpose(p.mla_w_ukv + (size_t)ly * 128 * 1024, p.WukvT + (size_t)ly * 1024 * 256, 128, 1024, 256, 1024, lf, bid, nb);
  }
  { const Prm p = PRM(); st_tables(p, bid, nb); }
  __syncthreads();
  { const Prm p = PRM(); st_mods(p, lf, bid, nb); }
  if (PROBE == 5) { __syncthreads();
    for (int ly = 0; ly < 2; ++ly) { const Prm p = PRM();
      st_transpose(p.w_in + (size_t)ly * DM * IN_W, p.WinT + (size_t)ly * NZ * DM, DM, IN_W, DM, NZ, lf, bid, nb);
      st_transpose(p.w_out + (size_t)ly * DM * DM, p.WoutT + (size_t)ly * DM * DM, DM, DM, DM, DM, lf, bid, nb);
      st_transpose(p.peer_wq + (size_t)ly * DM * DM, p.WqT + (size_t)ly * DM * DM, DM, DM, DM, DM, lf, bid, nb); }
    { const Prm p = PRM(); st_tables(p, bid, nb); }
    __syncthreads();
    { const Prm p = PRM(); st_mods(p, lf, bid, nb); } }
  GRID_BAR();
  for (int l = 0; l < 2; ++l) {
    if (l == 0) { { const Prm p = PRM(); st_modulate(p, l, 0, p.H, bid, nb); } GRID_BAR(); }
    { const Prm p = PRM(); run_gemm(shm, p.H, p.WinT + (size_t)l * NZ * DM, MR, NZ, DM, epi_bf16(p.Z, NZ), bid, nb); }
    if (PROBE == 6) { const Prm p = PRM(); run_gemm(shm, p.H, p.WinT + (size_t)l * NZ * DM, MR, NZ, DM, epi_bf16(p.Z, NZ), bid, nb); }
    GRID_BAR();
    { const Prm p = PRM(); st_dnprep(p, l, bid, nb); }
    { const Prm p = PRM(); st_mlaprep(p, l, bid, nb); }
    { const Prm p = PRM(); st_fnchan(p, shm, bid, nb); }
    if (PROBE == 9) { { const Prm p = PRM(); st_dnprep(p, l, bid, nb); } { const Prm p = PRM(); st_mlaprep(p, l, bid, nb); } }
    if (PROBE == 10) { const Prm p = PRM(); st_fnchan(p, shm, bid, nb); }
    GRID_BAR();
    { const Prm p = PRM(); run_gemm(shm, p.Aq, p.WuqT + (size_t)l * 768 * 512, MR, 768, 512, epi_bf16(p.Qraw, 768), bid, nb); }
    { const Prm p = PRM(); run_gemm(shm, p.Akv, p.WukvT + (size_t)l * 1024 * 256, MR, 1024, 256, epi_bf16(p.KV, 1024), bid, nb); }
    if (bid < 128) { const Prm p = PRM(); st_dnscan(p, lf, bid, 128); }
    else { const Prm p = PRM(); st_glascan(p, l, lf, bid - 128, 128); }
    if (PROBE == 7) { GRID_BAR(); if (bid < 128) { const Prm p = PRM(); st_dnscan(p, lf, bid, 128); } }
    if (PROBE == 8) { GRID_BAR(); if (bid < 128) { const Prm p = PRM(); st_glascan(p, l, lf, bid, 128); } }
    if (PROBE == 2) { GRID_BAR(); if (bid < 128) { const Prm p = PRM(); st_dnscan(p, lf, bid, 128); } else { const Prm p = PRM(); st_glascan(p, l, lf, bid - 128, 128); } }
    GRID_BAR();
    { const Prm p = PRM(); st_attn(p, l, (char*)shm, bid, nb); }
    if (PROBE == 3) { const Prm p = PRM(); st_attn(p, l, (char*)shm, bid, nb); }
    { const Prm p = PRM(); run_gemm(shm, p.DFTM, p.PQT, 4096, 4096, 8192, epi_bf16(p.Y + 1536, DM, 512, (size_t)LT * DM), bid, nb); }
    if (l == 0) { const Prm p = PRM(); run_gemm(shm, p.DFTC, p.PQTc, 256, 4096, 512, epi_bf16(p.Y + (size_t)LL * DM + 1536, DM, 512, (size_t)LT * DM), bid, nb); }
    { const Prm p = PRM(); st_combine(p, l, bid, nb); }
    GRID_BAR();
    { const Prm p = PRM(); EpiResid e; e.xlat = p.x; e.xctx = p.ctx; e.X = p.X; e.modl = p.mod + (size_t)l * 9 * NMOD; e.first = l == 0;
      if (l == 0) run_gemm(shm, p.Y, p.WoutT + (size_t)l * DM * DM, MR, DM, DM, e, bid, nb);
      else run_gemm_lat(shm, p.Y, p.WoutT + (size_t)l * DM * DM, DM, DM, e, bid, nb); }
    GRID_BAR();
    { const Prm p = PRM(); st_modulate(p, l, 1, p.H2, bid, nb); }
    { const Prm p = PRM(); st_cvt_tables(p, l, bid, nb); }
    GRID_BAR();
    if (l == 0) { const Prm p = PRM(); run_gemm(shm, p.H2, p.WqT + (size_t)l * DM * DM, MR, DM, DM, epi_bf16(p.Qp, DM), bid, nb); }
    else { const Prm p = PRM(); run_gemm_lat(shm, p.H2, p.WqT + (size_t)l * DM * DM, DM, DM, epi_bf16(p.Qp, DM), bid, nb); }
    GRID_BAR();
    { const Prm p = PRM(); st_peertopk(p, l, shm, bid, nb); }
    if (PROBE == 4) { __syncthreads(); const Prm p = PRM(); st_peertopk(p, l, shm, bid, nb); }
    GRID_BAR();
    { const Prm p = PRM(); st_peergather(p, l, lf, bid, nb); }
    if (PROBE == 1) { __syncthreads(); const Prm p = PRM(); st_peergather(p, l, lf, bid, nb, true); }
    if (l == 0) GRID_BAR();
  }
#endif
#undef bid
#undef nb
#undef GRID_BAR
}

static size_t al256(size_t x) { return (x + 255) / 256 * 256; }
extern "C" void kernel_launch(void* const* d_in, const int* in_sizes, int n_in, void* d_out, int out_size, void* d_ws, size_t ws_size, hipStream_t stream) {
  Prm p{};
  const float** f = (const float**)&p.x;
  for (int i = 0; i < 24; ++i) f[i] = (const float*)d_in[i];
  p.out = (float*)d_out;
  char* w = (char*)d_ws; size_t o = 0;
  auto take = [&](size_t bytes) { char* r = w + o; o += al256(bytes); return r; };
  p.bar = (unsigned*)take(16384);
  p.WinT = (bf16_t*)take((size_t)2 * NZ * DM * 2); p.WoutT = (bf16_t*)take((size_t)2 * DM * DM * 2); p.WqT = (bf16_t*)take((size_t)2 * DM * DM * 2);
  p.WuqT = (bf16_t*)take((size_t)2 * 768 * 512 * 2); p.WukvT = (bf16_t*)take((size_t)2 * 1024 * 256 * 2);
  p.mod = (float*)take((size_t)2 * 9 * NMOD * 4); p.GB = (float*)take((size_t)MR * 16 * 4); p.CCS = (float*)take((size_t)2 * 128 * 128 * 4);
  p.DFTM = (bf16_t*)take((size_t)4096 * 8192 * 2); p.DFTC = (bf16_t*)take((size_t)256 * 512 * 2);
  p.X = (float*)take((size_t)MR * DM * 4);
  p.Z = (bf16_t*)take((size_t)MR * NZ * 2);
  char* ra = take((size_t)MR * 1536 * 2 + (size_t)4 * MR * 512 * 2);
  p.DNQ = (bf16_t*)ra; p.OB = (bf16_t*)(ra + (size_t)MR * 1536 * 2); p.H = (bf16_t*)ra;
  p.Ub = (bf16_t*)(ra + (size_t)MR * DM * 2); p.Vb = (bf16_t*)(ra + (size_t)MR * DM * 2 + (size_t)16384 * DM);
  p.KV = (bf16_t*)take((size_t)MR * 1024 * 2); p.KR = (bf16_t*)take((size_t)MR * 64 * 2);
  p.Aq = (bf16_t*)take((size_t)MR * 512 * 2); p.Akv = (bf16_t*)take((size_t)MR * 256 * 2);
  if (o > ws_size) return;
  char* q = (char*)d_out; size_t oo = 0;
  p.Y = (bf16_t*)q; oo += (size_t)MR * DM * 2; p.PQT = (bf16_t*)(q + oo); oo += (size_t)8 * 512 * 8192 * 2; p.PQTc = (bf16_t*)(q + oo); oo += (size_t)8 * 512 * 512 * 2;
  p.Qraw = (bf16_t*)(q + oo); oo += (size_t)MR * 768 * 2;
  char* z = (char*)p.Z; p.H2 = (bf16_t*)z; p.Qp = (bf16_t*)(z + (size_t)MR * DM * 2); p.IDX = (int*)(z + (size_t)2 * MR * DM * 2); p.GATE = (float*)(z + (size_t)2 * MR * DM * 2 + (size_t)MR * 128 * 4);

  static int grid = 0;
  if (!grid) {
    (void)hipFuncSetAttribute((const void*)mega, hipFuncAttributeMaxDynamicSharedMemorySize, LDS_TOTAL);
    int dev = 0, cus = 0, per_cu = 0;
    (void)hipGetDevice(&dev); (void)hipDeviceGetAttribute(&cus, hipDeviceAttributeMultiprocessorCount, dev);
    (void)hipOccupancyMaxActiveBlocksPerMultiprocessor(&per_cu, (const void*)mega, NTHR, LDS_TOTAL);
    grid = per_cu >= 1 ? cus : 0;
    if (grid > 256) grid = 256;
  }
  if (grid < 256) return;
  (void)hipMemsetAsync(p.bar, 0, XCD_BAR_WORDS * sizeof(unsigned), stream);
  hipLaunchKernelGGL(mega, dim3(grid), dim3(NTHR), LDS_TOTAL, stream, p);
}
```

```cpp
#include <hip/hip_runtime.h>
#include <stdint.h>

constexpr int DM = 2048, NB = 8, LL = 4096, LCX = 256, LT = LL + LCX  , MR = NB * LT  ;
constexpr int NZ = 4864;
constexpr int C_DNQ = 0, C_DNK = 512, C_DNV = 1024, C_DNGATE = 1536, C_DNA = 2048, C_DNB = 2056, C_GQ = 2064, C_GK = 2320, C_GV = 2576,
              C_GGATE = 3088, C_GALPHA = 3600, C_CQ = 3632, C_CKV = 4080, C_KR = 4208, C_FN = 4272, IN_W = 4784;
constexpr int NMOD = 6 * DM;
constexpr float EPSV = 1e-6f;
constexpr int NTHR = 512;

typedef unsigned short bf16_t;
typedef short bf16x8 __attribute__((ext_vector_type(8)));
typedef short s16x4 __attribute__((ext_vector_type(4)));
typedef float f32x4 __attribute__((ext_vector_type(4)));
typedef float f32x16 __attribute__((ext_vector_type(16)));
typedef unsigned u32x4 __attribute__((ext_vector_type(4)));
typedef unsigned u32x2 __attribute__((ext_vector_type(2)));

#define DI __device__ __forceinline__
DI float bf2f(bf16_t b) { return __uint_as_float(((unsigned)b) << 16); }
DI bf16_t f2bf(float f) { unsigned u = __float_as_uint(f); u += 0x7FFFu + ((u >> 16) & 1u); return (bf16_t)(u >> 16); }
DI unsigned pack2(float lo, float hi) { return (unsigned)f2bf(lo) | ((unsigned)f2bf(hi) << 16); }
typedef float f32x2 __attribute__((ext_vector_type(2)));
DI float dpp_x1(float v) { return __int_as_float(__builtin_amdgcn_mov_dpp(__float_as_int(v), 0xB1, 0xf, 0xf, true)); }
DI float dpp_x2(float v) { return __int_as_float(__builtin_amdgcn_mov_dpp(__float_as_int(v), 0x4E, 0xf, 0xf, true)); }
DI float dpp_hm(float v) { return __int_as_float(__builtin_amdgcn_mov_dpp(__float_as_int(v), 0x141, 0xf, 0xf, true)); }
DI float dpp_rm(float v) { return __int_as_float(__builtin_amdgcn_mov_dpp(__float_as_int(v), 0x140, 0xf, 0xf, true)); }
DI float red4(float v) { v += dpp_x1(v); v += dpp_x2(v); return v; }
DI float red8(float v) { v += dpp_x1(v); v += dpp_x2(v); v += dpp_hm(v); return v; }
DI float rdl(float v, int l) { return __int_as_float(__builtin_amdgcn_readlane(__float_as_int(v), l)); }
DI float wsum(float v) { v += dpp_x1(v); v += dpp_x2(v); v += dpp_hm(v); v += dpp_rm(v); return (rdl(v, 0) + rdl(v, 16)) + (rdl(v, 32) + rdl(v, 48)); }
DI float wmax(float v) { v = fmaxf(v, dpp_x1(v)); v = fmaxf(v, dpp_x2(v)); v = fmaxf(v, dpp_hm(v)); v = fmaxf(v, dpp_rm(v)); return fmaxf(fmaxf(rdl(v, 0), rdl(v, 16)), fmaxf(rdl(v, 32), rdl(v, 48))); }
DI float siluf(float x) { return x / (1.f + __expf(-x)); }
DI float sigmf(float x) { return 1.f / (1.f + __expf(-x)); }

DI int ltid() { int t = (int)threadIdx.x; asm volatile("" : "+v"(t)); return t; }
DI int lsg(int v) { asm volatile("" : "+s"(v)); return v; }

struct Prm {
  const float *x, *c, *ctx, *c_ctx, *w_ada, *b_ada, *w_in, *dn_conv, *dn_a_log, *dn_dt_bias, *dn_norm, *gla_w2, *gla_b2, *gla_norm,
      *mla_q_norm, *mla_w_uq, *mla_kv_norm, *mla_w_ukv, *w_out, *peer_wq, *peer_keys, *peer_u, *peer_v, *final_norm;
  float* out;
  bf16_t *WinT, *WoutT, *WqT, *WuqT, *WukvT;
  float *mod, *GB, *CCS;
  bf16_t *DFTM, *DFTC;
  float* X;
  bf16_t* Z;
  bf16_t *H, *DNQ, *OB;
  bf16_t *KV, *KR;
  bf16_t *Y, *PQT, *PQTc, *Qraw, *Aq, *Akv;
  bf16_t *H2, *Qp;
  bf16_t *Ub, *Vb;
  bf16_t* TINV; float* GCB;
  int* IDX;
  float* GATE;
  unsigned* bar;
};
#define XB_TMO      128
#define XB_XCNT(j)  (256  + 64 * (j))
#define XB_XSUB(j)  (1280 + 64 * (j))
#define XB_XGEN(j)  (2304 + 64 * (j))
#define XB_TOP      3328
#define XB_TOPGEN   3392
#define XCD_BAR_WORDS 3456
#define XB_SPIN_CAP (1u << 18)
#define LAS __attribute__((address_space(3)))

__device__ __forceinline__ unsigned xb_ld(unsigned* p)              { return __hip_atomic_load(p, __ATOMIC_RELAXED, __HIP_MEMORY_SCOPE_AGENT); }
__device__ __forceinline__ unsigned xb_add(unsigned* p, unsigned v) { return __hip_atomic_fetch_add(p, v, __ATOMIC_RELAXED, __HIP_MEMORY_SCOPE_AGENT); }
__device__ __forceinline__ unsigned xb_xcc_id() { return (unsigned)__builtin_amdgcn_s_getreg((3 << 11) | 20) & 0xFu; }
#define XB_SPIN(cond, bar) do { unsigned _sp = 0; while (cond) { __builtin_amdgcn_s_sleep(1); \
    if ((++_sp & 255u) == 0u) { if (xb_ld(&(bar)[XB_TMO])) break; if (_sp > XB_SPIN_CAP) { atomicAdd(&(bar)[XB_TMO], 1u); break; } } } } while (0)

struct XcdBarrier {
    unsigned* bar; unsigned x;
    volatile LAS unsigned* st;
};

__device__ __forceinline__ XcdBarrier xcd_barrier_post(unsigned* bar, volatile LAS unsigned* st) {
    XcdBarrier b; b.bar = bar; b.x = xb_xcc_id(); b.st = st;
    if (threadIdx.x == 0) (void)xb_add(&bar[XB_XCNT(b.x)], 1u);
    return b;
}
__device__ __forceinline__ void xcd_barrier_complete(unsigned* bar, unsigned x, unsigned& nloc, unsigned& nx) {
    const unsigned G = gridDim.x * gridDim.y * gridDim.z;
    unsigned sum, cnt, mine, sp = 0u;
    for (;;) {
        sum = 0u; cnt = 0u; mine = 0u;
#pragma unroll
        for (unsigned j = 0; j < 16; ++j) { const unsigned c = xb_ld(&bar[XB_XCNT(j)]); sum += c; cnt += (c > 0u) ? 1u : 0u; mine = (j == x) ? c : mine; }
        if (sum == G) break;
        __builtin_amdgcn_s_sleep(1);
        if ((++sp & 255u) == 0u) { if (xb_ld(&bar[XB_TMO])) break; if (sp > XB_SPIN_CAP) { atomicAdd(&bar[XB_TMO], 1u); break; } }
    }
    nloc = mine > 0u ? mine : 1u; nx = cnt > 0u ? cnt : 1u;
}

__device__ __forceinline__ void xcd_barrier(const XcdBarrier& b) {
    asm volatile("s_waitcnt vmcnt(0)" ::: "memory");
    __syncthreads();
    if (threadIdx.x == 0) {
        unsigned* bar = b.bar;
        __builtin_amdgcn_s_waitcnt(0);
        unsigned nloc = b.st[0], nx = b.st[1];
        if (nloc == 0u) { xcd_barrier_complete(bar, b.x, nloc, nx); b.st[0] = nloc; b.st[1] = nx; }
        const unsigned old = xb_add(&bar[XB_XSUB(b.x)], 1u);
        const unsigned gen = old / nloc;
        if (old + 1u == (gen + 1u) * nloc) {
            __builtin_amdgcn_fence(__ATOMIC_RELEASE, "agent");
            asm volatile("s_waitcnt vmcnt(0)" ::: "memory");
            const unsigned og = xb_add(&bar[XB_TOP], 1u);
            const unsigned tg = og / nx;
            if (og + 1u == (tg + 1u) * nx) xb_add(&bar[XB_TOPGEN], 1u);
            else XB_SPIN(xb_ld(&bar[XB_TOPGEN]) == tg, bar);
            __builtin_amdgcn_fence(__ATOMIC_ACQUIRE, "agent");
            xb_add(&bar[XB_XGEN(b.x)], 1u);
            asm volatile("s_waitcnt vmcnt(0)" ::: "memory");
        } else {
            XB_SPIN(xb_ld(&bar[XB_XGEN(b.x)]) == gen, bar);
            __builtin_amdgcn_fence(__ATOMIC_ACQUIRE, "agent");
            asm volatile("s_waitcnt vmcnt(0)" ::: "memory");
        }
    }
    __syncthreads();
}

namespace pg8 {
#define PG8_LAS __attribute__((address_space(3)))
typedef unsigned short bf16_t;
typedef short bf16x8 __attribute__((ext_vector_type(8)));
typedef float f32x4 __attribute__((ext_vector_type(4)));
typedef unsigned u32x4 __attribute__((ext_vector_type(4)));
constexpr int BM = 256, BK = 64, HALF = 128, HTB = HALF * BK * 2  , STAGE_BYTES = 8 * HTB, NXCD = 8, WGM = 8;

__host__ __device__ __forceinline__ int lds_byte(int r, int c) { const int st = (r >> 4) * 2 + (c >> 5), rr = r & 15, cc = c & 31, ob = rr * 64 + cc * 2; return st * 1024 + (ob ^ (((ob >> 9) & 1) << 5)); }
__host__ __device__ __forceinline__ void stage_rc(int b, int& R, int& C) { const int st = b / 1024, sb = b % 1024, swz = sb ^ (((sb >> 9) & 1) << 5); R = (st >> 1) * 16 + swz / 64; C = (st & 1) * 32 + (swz % 64) / 2; }
__host__ __device__ __forceinline__ int perm32(int rho) { const int n = rho >> 4, i = rho & 15; return 8 * (i >> 2) + 4 * n + (i & 3); }

struct Unit { int pm, pn; };
struct Gemm { const bf16_t* A; const bf16_t* Bt; int M, N, K; };

struct StaticOrder {
    int nM, nN, nwg, G, c;
    __host__ __device__ void init(int M, int N, int G_, int c_) { nM = M / BM; nN = N / BM; nwg = nM * nN; G = G_; c = c_; }
    __host__ __device__ bool next(int i, Unit& u) const {
        const long L = (long)i * G + c; if (L >= nwg) return false;
        int wgid = (int)L; { const int q = nwg / NXCD, r = nwg % NXCD, xcd = wgid % NXCD, off = wgid / NXCD; wgid = (xcd < r ? xcd * (q + 1) : r * (q + 1) + (xcd - r) * q) + off; }
        const int nig = WGM * nN, gid = wgid / nig, fm = gid * WGM, gsz = (nM - fm) < WGM ? (nM - fm) : WGM;
        u.pm = fm + ((wgid % nig) % gsz); u.pn = (wgid % nig) / gsz; return true;
    }
    __device__ __forceinline__ void a_ready(const Unit&) const {}
    __device__ __forceinline__ void done(const Unit&) const {}
};
struct CountedOrder : StaticOrder {
    const unsigned* ready; unsigned need; unsigned* tmo;
    __device__ __forceinline__ void a_ready(const Unit& u) const {
        if (threadIdx.x < 64) {
            const unsigned long long t0 = __builtin_amdgcn_s_memrealtime(); unsigned polls = 0;
            while ((unsigned)__builtin_amdgcn_readfirstlane(__hip_atomic_load(ready + 64 * u.pm, __ATOMIC_RELAXED, __HIP_MEMORY_SCOPE_AGENT)) < need) {
                if ((++polls & 255u) == 0u && __builtin_amdgcn_readfirstlane(__hip_atomic_load(tmo, __ATOMIC_RELAXED, __HIP_MEMORY_SCOPE_AGENT)) != 0u) break;
                if (__builtin_amdgcn_s_memrealtime() - t0 > 2000000ull) {
                    if (threadIdx.x == 0) { unsigned expect = 0u; __hip_atomic_compare_exchange_strong(tmo + 1, &expect, 0x600u | (unsigned)(u.pm & 0xff), __ATOMIC_RELAXED, __ATOMIC_RELAXED, __HIP_MEMORY_SCOPE_AGENT); __hip_atomic_store(tmo, 1u, __ATOMIC_RELAXED, __HIP_MEMORY_SCOPE_AGENT); }
                    break; }
                __builtin_amdgcn_s_sleep(2); }
            __builtin_amdgcn_fence(__ATOMIC_ACQUIRE, "agent");
            asm volatile("s_waitcnt vmcnt(0)" ::: "memory");
        }
#if !defined(BROKEN_HOOK_NO_BARRIER)
        asm volatile("" ::: "memory"); __builtin_amdgcn_s_barrier(); asm volatile("" ::: "memory");
#endif
    }
};

__device__ __forceinline__ unsigned cvt_pk_bf16(float lo, float hi) { unsigned r; asm volatile("v_cvt_pk_bf16_f32 %0, %1, %2" : "=v"(r) : "v"(lo), "v"(hi)); return r; }
typedef float f32x2 __attribute__((ext_vector_type(2)));
__device__ __forceinline__ f32x2 gelu_pk(f32x2 v) {
    const f32x2 av = __builtin_elementwise_abs(v), d = av * 0.2316418882f + 1.0f;
    f32x2 t; t.x = __builtin_amdgcn_rcpf(d.x); t.y = __builtin_amdgcn_rcpf(d.y);
    f32x2 q = t * 0.5307027145f + (-0.7265760135f); q = q * t + 0.7107068705f; q = q * t + (-0.142248368f); q = q * t + 0.127414796f; q = q * t;
    const f32x2 s = (v * v) * (-0.72134752044f);
    f32x2 e; e.x = __builtin_amdgcn_exp2f(s.x); e.y = __builtin_amdgcn_exp2f(s.y);
    const f32x2 m = v * (q * e), r = v - m;
    f32x2 o; o.x = v.x < 0.f ? m.x : r.x; o.y = v.y < 0.f ? m.y : r.y; return o;
}

struct EpiF32 {
    static constexpr bool PERM = false, AFTER_DRAIN = false;
    float* C; int ldc; const float* bias;
    __device__ __forceinline__ void operator()(const f32x4 (&acc)[2][2][4][2], const Unit& u, int wr, int wc, int fr, int fq) const {
        const int row0 = u.pm * BM + wr * 64 + fr, col0 = u.pn * BM + wc * 32 + 4 * fq;
        f32x4 bv[2][2];
#pragma unroll
        for (int bj = 0; bj < 2; ++bj)
#pragma unroll
            for (int n = 0; n < 2; ++n) bv[bj][n] = bias ? *(const f32x4*)(bias + col0 + bj * HALF + n * 16) : (f32x4){0.f, 0.f, 0.f, 0.f};
#pragma unroll
        for (int ai = 0; ai < 2; ++ai)
#pragma unroll
            for (int m = 0; m < 4; ++m) { float* rowp = C + (size_t)(row0 + ai * HALF + m * 16) * ldc + col0;
#pragma unroll
                for (int bj = 0; bj < 2; ++bj)
#pragma unroll
                    for (int n = 0; n < 2; ++n) *(f32x4*)(rowp + bj * HALF + n * 16) = acc[ai][bj][m][n] + bv[bj][n]; }
    }
};
template <int ACT  > struct EpiBf16 {
    static constexpr bool PERM = true, AFTER_DRAIN = false;
    bf16_t* O; int ldc; const float* bias; int split_cols; size_t split_stride;
    __device__ __forceinline__ void operator()(const f32x4 (&acc)[2][2][4][2], const Unit& u, int wr, int wc, int fr, int fq) const {
        const int row0 = u.pm * BM + wr * 64 + fr; int colt = u.pn * BM; bf16_t* base = O;
        if (split_cols) { const int t = colt / split_cols; base += (size_t)t * split_stride; colt -= t * split_cols; }
        const int col0 = colt + wc * 32 + 8 * fq, bcol0 = u.pn * BM + wc * 32 + 8 * fq;
        f32x4 bv[2][2];
#pragma unroll
        for (int bj = 0; bj < 2; ++bj)
#pragma unroll
            for (int n = 0; n < 2; ++n) bv[bj][n] = bias ? *(const f32x4*)(bias + bcol0 + bj * HALF + 4 * n) : (f32x4){0.f, 0.f, 0.f, 0.f};
#pragma unroll
        for (int ai = 0; ai < 2; ++ai)
#pragma unroll
            for (int m = 0; m < 4; ++m) { bf16_t* rowp = base + (size_t)(row0 + ai * HALF + m * 16) * ldc + col0;
#pragma unroll
                for (int bj = 0; bj < 2; ++bj) { f32x4 v0 = acc[ai][bj][m][0] + bv[bj][0], v1 = acc[ai][bj][m][1] + bv[bj][1];
                    if (ACT == 1) { f32x2 a = gelu_pk((f32x2){v0[0], v0[1]}), b = gelu_pk((f32x2){v0[2], v0[3]}), c = gelu_pk((f32x2){v1[0], v1[1]}), d = gelu_pk((f32x2){v1[2], v1[3]});
                        v0 = (f32x4){a.x, a.y, b.x, b.y}; v1 = (f32x4){c.x, c.y, d.x, d.y}; }
                    if (ACT == 2) {
#pragma unroll
                        for (int j = 0; j < 4; ++j) { v0[j] = 0.5f * v0[j] * (1.0f + erff(v0[j] * 0.70710678f)); v1[j] = 0.5f * v1[j] * (1.0f + erff(v1[j] * 0.70710678f)); } }
                    u32x4 w; w.x = cvt_pk_bf16(v0[0], v0[1]); w.y = cvt_pk_bf16(v0[2], v0[3]); w.z = cvt_pk_bf16(v1[0], v1[1]); w.w = cvt_pk_bf16(v1[2], v1[3]);
                    *(u32x4*)(rowp + bj * HALF) = w; } }
    }
};
template <class Epi, class Sched, bool STAMP = false>
__device__ __forceinline__ void gemm_phase(PG8_LAS unsigned char* lds, const Gemm g, const Sched& S, const Epi& E, unsigned long long* stamps) {
    const int tid = ltid(), wid = __builtin_amdgcn_readfirstlane(tid >> 6), lane = tid & 63, wr = wid >> 2, wc = wid & 3, fr = lane & 15, fq = lane >> 4;
    const int K = g.K, nt = K / BK;
    int ts_lo = 0, ts_hi = 0, nts = 0; const unsigned long long rt_entry = STAMP ? (unsigned long long)wall_clock64() : 0ull;
#define PG8_STAMP() do { if (STAMP && wid == 0 && nts < 64) { const unsigned long long _c = (unsigned long long)clock64(); \
        ts_lo = (lane == nts) ? (int)(unsigned)_c : ts_lo; ts_hi = (lane == nts) ? (int)(unsigned)(_c >> 32) : ts_hi; ++nts; } } while (0)
    PG8_STAMP();
    unsigned voffA[2], voffB[2];
#pragma unroll
    for (int i = 0; i < 2; ++i) { int R, C; stage_rc(tid * 16 + i * 8192, R, C); const int Rb = Epi::PERM ? ((R & ~31) + perm32(R & 31)) : R;
        voffA[i] = (unsigned)(R * K + C) * 2u; voffB[i] = (unsigned)(Rb * K + C) * 2u; }
    const size_t kstep = (size_t)(BK * 2);
    const size_t hstep = (size_t)HALF * K * 2;
    const size_t tstep = 2 * hstep;
    const unsigned ldsw = (unsigned)wid * 1024u;
    const int aoff = lds_byte(wr * 64 + fr, fq * 8), boff = lds_byte(wc * 32 + fr, fq * 8);
#define PG8_SA(b, h) (((b) * 2 + (h)) * HTB)
#define PG8_SB(b, h) ((4 + (b) * 2 + (h)) * HTB)
#define PG8_STAGE(bufoff, gbase, voff) do { _Pragma("unroll") for (int _i = 0; _i < 2; ++_i) \
        __builtin_amdgcn_global_load_lds((const unsigned*)((const char*)(gbase) + (voff)[_i]), (PG8_LAS unsigned*)(lds + (bufoff) + ldsw + _i * 8192), 16, 0, 0); } while (0)
#define PG8_LDA(dst, b, h) do { _Pragma("unroll") for (int m = 0; m < 4; ++m) _Pragma("unroll") for (int k = 0; k < 2; ++k) dst[m][k] = *(const PG8_LAS bf16x8*)(lds + PG8_SA(b, h) + aoff + m * 2048 + k * 1024); } while (0)
#define PG8_LDB(dst, b, h) do { _Pragma("unroll") for (int n = 0; n < 2; ++n) _Pragma("unroll") for (int k = 0; k < 2; ++k) dst[n][k] = *(const PG8_LAS bf16x8*)(lds + PG8_SB(b, h) + boff + n * 2048 + k * 1024); } while (0)
#define PG8_MMA(ai, bj, At, Bt) do { __builtin_amdgcn_s_setprio(1); _Pragma("unroll") for (int m = 0; m < 4; ++m) _Pragma("unroll") for (int n = 0; n < 2; ++n) _Pragma("unroll") for (int k = 0; k < 2; ++k) \
        acc[ai][bj][m][n] = __builtin_amdgcn_mfma_f32_16x16x32_bf16(Bt[n][k], At[m][k], acc[ai][bj][m][n], 0, 0, 0); __builtin_amdgcn_s_setprio(0); } while (0)
#define PG8_WAIT_V(n) asm volatile("s_waitcnt vmcnt(" #n ")" ::: "memory")
#define PG8_WAIT_L(n) asm volatile("s_waitcnt lgkmcnt(" #n ")" ::: "memory")
#define PG8_BAR __builtin_amdgcn_s_barrier()
#define PG8_SCHED __builtin_amdgcn_sched_barrier(0)
    Unit cur, nxt; int ui = 0;
    if (!S.next(0, cur)) return;
    f32x4 acc[2][2][4][2];
#pragma unroll
    for (int a = 0; a < 2; ++a)
#pragma unroll
        for (int b = 0; b < 2; ++b)
#pragma unroll
            for (int m = 0; m < 4; ++m)
#pragma unroll
                for (int n = 0; n < 2; ++n) acc[a][b][m][n] = (f32x4){0.f, 0.f, 0.f, 0.f};
    bf16x8 At[4][2], B0[2][2], B1[2][2];
    const char* cA = (const char*)g.A + (size_t)cur.pm * tstep; const char* cB = (const char*)g.Bt + (size_t)cur.pn * tstep;
    S.a_ready(cur);
    PG8_STAGE(PG8_SB(0, 0), cB, voffB); PG8_STAGE(PG8_SA(0, 0), cA, voffA); PG8_STAGE(PG8_SB(0, 1), cB + hstep, voffB); PG8_STAGE(PG8_SA(0, 1), cA + hstep, voffA);
    if (wr == 1) PG8_BAR;
    PG8_WAIT_V(4); PG8_BAR;
    PG8_STAGE(PG8_SB(1, 0), cB + kstep, voffB); PG8_STAGE(PG8_SA(1, 0), cA + kstep, voffA); PG8_STAGE(PG8_SB(1, 1), cB + hstep + kstep, voffB);
    PG8_WAIT_V(6); PG8_BAR;
    PG8_STAMP();
    for (;;) {
        const bool has_next = S.next(ui + 1, nxt);
        const char* nA = has_next ? (const char*)g.A + (size_t)nxt.pm * tstep : cA; const char* nB = has_next ? (const char*)g.Bt + (size_t)nxt.pn * tstep : cB;
        for (int t = 0; t < nt; t += 2) {
            const bool last = (t == nt - 2);
            const char* a1 = cA + (size_t)(t + 1) * kstep;
            const char* a2 = last ? nA : cA + (size_t)(t + 2) * kstep; const char* b2 = last ? nB : cB + (size_t)(t + 2) * kstep;
            const char* a3 = a2 + kstep; const char* b3 = b2 + kstep;
            if (last && has_next) S.a_ready(nxt);
            PG8_LDB(B0, 0, 0); PG8_SCHED; PG8_LDA(At, 0, 0); PG8_STAGE(PG8_SA(1, 1), a1 + hstep, voffA);
            PG8_WAIT_L(8); PG8_BAR; PG8_WAIT_L(0); PG8_MMA(0, 0, At, B0); PG8_BAR; PG8_SCHED;
            PG8_LDB(B1, 0, 1); PG8_STAGE(PG8_SB(0, 0), b2, voffB);
            PG8_BAR; PG8_WAIT_L(0); PG8_MMA(0, 1, At, B1); PG8_BAR;
            PG8_LDA(At, 0, 1); PG8_STAGE(PG8_SA(0, 0), a2, voffA);
            PG8_BAR; PG8_WAIT_L(0); PG8_MMA(1, 0, At, B0); PG8_BAR; PG8_SCHED;
            PG8_STAGE(PG8_SB(0, 1), b2 + hstep, voffB);
            PG8_WAIT_V(6); PG8_BAR; PG8_MMA(1, 1, At, B1); PG8_BAR;
            PG8_LDB(B0, 1, 0); PG8_SCHED; PG8_LDA(At, 1, 0); PG8_STAGE(PG8_SA(0, 1), a2 + hstep, voffA);
            PG8_WAIT_L(8); PG8_BAR; PG8_WAIT_L(0); PG8_MMA(0, 0, At, B0); PG8_BAR; PG8_SCHED;
            PG8_LDB(B1, 1, 1); PG8_STAGE(PG8_SB(1, 0), b3, voffB);
            PG8_BAR; PG8_WAIT_L(0); PG8_MMA(0, 1, At, B1); PG8_BAR;
            PG8_LDA(At, 1, 1); PG8_STAGE(PG8_SA(1, 0), a3, voffA);
            PG8_BAR; PG8_WAIT_L(0); PG8_MMA(1, 0, At, B0); PG8_BAR; PG8_SCHED;
            PG8_STAGE(PG8_SB(1, 1), b3 + hstep, voffB);
            PG8_WAIT_V(6); PG8_BAR; PG8_MMA(1, 1, At, B1); PG8_BAR;
        }
        PG8_STAMP();
        if constexpr (!Epi::AFTER_DRAIN) { E(acc, cur, wr, wc, fr, fq); S.done(cur); }
        PG8_STAMP();
        if (!has_next) break;
#pragma unroll
        for (int a = 0; a < 2; ++a)
#pragma unroll
            for (int b = 0; b < 2; ++b)
#pragma unroll
                for (int m = 0; m < 4; ++m)
#pragma unroll
                    for (int n = 0; n < 2; ++n) acc[a][b][m][n] = (f32x4){0.f, 0.f, 0.f, 0.f};
        cur = nxt; cA = nA; cB = nB; ++ui;
    }
    PG8_WAIT_V(0);
    if (wr == 0) PG8_BAR;
    PG8_BAR;
    if constexpr (Epi::AFTER_DRAIN) { E.fused(acc, cur, wr, wc, fr, fq, lds, wid, lane); S.done(cur); }
    PG8_STAMP();
    if (STAMP && wid == 0) { stamps[lane] = lane < nts ? (((unsigned long long)(unsigned)ts_hi << 32) | (unsigned)ts_lo) : 0ull;
        if (lane == 62) stamps[62] = rt_entry; if (lane == 63) stamps[63] = (unsigned long long)wall_clock64(); }
#undef PG8_STAMP
#undef PG8_SA
#undef PG8_SB
#undef PG8_STAGE
#undef PG8_LDA
#undef PG8_LDB
#undef PG8_MMA
#undef PG8_WAIT_V
#undef PG8_WAIT_L
#undef PG8_BAR
#undef PG8_SCHED
}
}

DI void st_transpose(const float* __restrict__ src, bf16_t* __restrict__ dst, int K, int N, int Kpad, int Npad, float* lds, int bid, int nb) {
  const int tk = Kpad / 64, tn = Npad / 64;
  for (int it = bid; it < tk * tn; it += nb) {
    const int k0 = (it % tk) * 64, n0 = (it / tk) * 64;
    __syncthreads();
    for (int e = ltid(); e < 4096; e += NTHR) { const int i = e >> 6, j = e & 63, k = k0 + i, n = n0 + j; lds[i * 65 + j] = (k < K && n < N) ? src[(size_t)k * N + n] : 0.f; }
    __syncthreads();
    for (int e = ltid(); e < 4096; e += NTHR) { const int j = e >> 6, i = e & 63; dst[(size_t)(n0 + j) * Kpad + k0 + i] = f2bf(lds[i * 65 + j]); }
  }
}

DI void st_mods(const Prm& p, float* lds, int bid, int nb) {
  float* s = lds; float* red = lds + 9 * 2048;
  for (int e = ltid(); e < 9 * 2048; e += NTHR) { const int r = e >> 11, k = e & 2047; const float v = r < 8 ? p.c[r * 2048 + k] : p.c_ctx[k]; s[e] = siluf(v); }
  __syncthreads();
  const int kg = ltid() >> 6, cl = ltid() & 63;
  for (int it = bid; it < 2 * 192; it += nb) {
    const int l = it / 192, cb = (it % 192) * 64;
    const float* w = p.w_ada + (size_t)l * 2048 * NMOD + cb + cl;
    float acc[9];
#pragma unroll
    for (int r = 0; r < 9; ++r) acc[r] = 0.f;
    for (int k = kg * 256; k < kg * 256 + 256; ++k) { const float wv = w[(size_t)k * NMOD];
#pragma unroll
      for (int r = 0; r < 9; ++r) acc[r] += s[r * 2048 + k] * wv; }
#pragma unroll
    for (int r = 0; r < 9; ++r) red[(kg * 9 + r) * 64 + cl] = acc[r];
    __syncthreads();
    for (int e = ltid(); e < 576; e += NTHR) { const int r = e >> 6, c2 = e & 63; float t = 0.f;
      for (int g = 0; g < 8; ++g) t += red[(g * 9 + r) * 64 + c2];
      p.mod[((size_t)l * 9 + r) * NMOD + cb + c2] = t + p.b_ada[l * NMOD + cb + c2]; }
    __syncthreads();
  }
}

DI void st_tables(const Prm& p, int bid, int nb) {
  const size_t stride = (size_t)nb * NTHR, t0 = (size_t)bid * NTHR + ltid();
  for (size_t e = t0; e < (size_t)4096 * 8192; e += stride) { const int k1 = (int)(e >> 13), n = (int)(e & 8191), n1 = n & 4095, idx = (k1 * n1) & 4095;
    float sv, cv; sincosf((float)idx * (6.283185307179586f / 4096.f), &sv, &cv); p.DFTM[e] = f2bf((n < 4096 ? cv : -sv) * (1.f / 64.f)); }
  for (size_t e = t0; e < (size_t)256 * 512; e += stride) { const int k1 = (int)(e >> 9), n = (int)(e & 511), n1 = n & 255, idx = (k1 * n1) & 255;
    float sv, cv; sincosf((float)idx * (6.283185307179586f / 256.f), &sv, &cv); p.DFTC[e] = f2bf((n < 256 ? cv : -sv) * (1.f / 16.f)); }
  for (size_t e = t0; e < (size_t)2 * 128 * 128; e += stride) { const int tb = (int)(e >> 14), k2 = (int)((e >> 7) & 127), n2 = (int)(e & 127), idx = (k2 * n2) & 127;
    float sv, cv; sincosf((float)idx * (6.283185307179586f / 128.f), &sv, &cv); p.CCS[e] = (tb ? sv : cv) * 0.08838834764831845f; }
}

DI void st_modulate(const Prm& p, int layer, int which, bf16_t* __restrict__ dst, int bid, int nb) {
  const int wave = ltid() >> 6, lane = ltid() & 63;
  const int shoff = which ? 3 * DM : 0, scoff = which ? 4 * DM : DM;
  for (int row = bid * 8 + wave; row < MR; row += nb * 8) {
    const int b = row / LT, t = row - b * LT; const bool isc = t >= LL;
    if (isc && layer == 1 && which == 1) continue;
    const float* src = (layer == 0 && which == 0) ? (isc ? p.ctx + (size_t)(b * LCX + t - LL) * DM : p.x + (size_t)(b * LL + t) * DM) : p.X + (size_t)row * DM;
    f32x4 v[8]; float ss = 0.f;
#pragma unroll
    for (int i = 0; i < 8; ++i) { v[i] = *(const f32x4*)(src + (i * 64 + lane) * 4); ss += v[i][0] * v[i][0] + v[i][1] * v[i][1] + v[i][2] * v[i][2] + v[i][3] * v[i][3]; }
    ss = wsum(ss); const float rstd = rsqrtf(ss * (1.f / 2048.f) + EPSV);
    const float* mr = p.mod + ((size_t)layer * 9 + (isc ? 8 : b)) * NMOD;
#pragma unroll
    for (int i = 0; i < 8; ++i) { const int col = (i * 64 + lane) * 4; const f32x4 sc = *(const f32x4*)(mr + scoff + col), sh = *(const f32x4*)(mr + shoff + col);
      const f32x4 o = v[i] * rstd * (sc + 1.f) + sh; u32x2 w; w.x = pack2(o[0], o[1]); w.y = pack2(o[2], o[3]); *(u32x2*)(dst + (size_t)row * DM + col) = w; }
  }
}

DI void st_dnprep(const Prm& p, int layer, int bid, int nb) {
  const int wave = ltid() >> 6, lane = ltid() & 63;
  const float* conv = p.dn_conv + (size_t)layer * 5 * 1536;
  for (int task = bid * 8 + wave; task < (MR / 32) * 13; task += nb * 8) {
    const int tile = task / 13, grp = task - tile * 13, row0 = tile * 32;
    const int b = row0 / LT, t0 = row0 - b * LT; const bool isc = t0 >= LL;
    const int segt0 = isc ? t0 - LL : t0, seglen = isc ? LCX : LL;
    if (grp < 12) {
      const int c = grp * 128 + lane * 2;
      float w0[5], w1[5];
#pragma unroll
      for (int j = 0; j < 5; ++j) { w0[j] = conv[j * 1536 + c]; w1[j] = conv[j * 1536 + c + 1]; }
      unsigned zz[36];
#pragma unroll
      for (int r = 0; r < 36; ++r) { const int tt = segt0 + r - 2; zz[r] = (tt >= 0 && tt < seglen) ? *(const unsigned*)(p.Z + (size_t)(row0 + r - 2) * NZ + c) : 0u; }
#pragma unroll
      for (int r = 0; r < 32; ++r) { float a0 = 0.f, a1 = 0.f;
#pragma unroll
        for (int j = 0; j < 5; ++j) { a0 += __uint_as_float(zz[r + j] << 16) * w0[j]; a1 += __uint_as_float(zz[r + j] & 0xffff0000u) * w1[j]; }
        a0 = siluf(a0); a1 = siluf(a1);
        if (grp < 8) { const float ss = wsum(a0 * a0 + a1 * a1); const float sc = rsqrtf(ss + EPSV) * (grp < 4 ? 0.08838834764831845f : 1.f); a0 *= sc; a1 *= sc; }
        *(unsigned*)(p.DNQ + (size_t)(row0 + r) * 1536 + c) = pack2(a0, a1); }
    } else {
#pragma unroll
      for (int rr = 0; rr < 8; ++rr) { const int idx = lane + 64 * rr, row = row0 + (idx >> 4), wh = idx & 15, isb = wh >> 3, dh = wh & 7;
        const float z = bf2f(p.Z[(size_t)row * NZ + (isb ? C_DNB : C_DNA) + dh]); float o;
        if (!isb) { const float xx = z + p.dn_dt_bias[layer * 8 + dh]; const float sp = xx > 20.f ? xx : log1pf(expf(xx)); o = -expf(p.dn_a_log[layer * 8 + dh]) * sp; }
        else o = sigmf(z);
        p.GB[(size_t)row * 16 + wh] = o; }
    }
  }
}

DI void st_mlaprep(const Prm& p, int layer, int bid, int nb) {
  const int wave = ltid() >> 6, lane = ltid() & 63;
  const float* qn = p.mla_q_norm + layer * 448; const float* kvn = p.mla_kv_norm + layer * 128;
  for (int row = bid * 8 + wave; row < MR; row += nb * 8) {
    const bf16_t* z = p.Z + (size_t)row * NZ; const int b = row / LT, t = row - b * LT;
    float v[8]; float ss = 0.f;
#pragma unroll
    for (int k = 0; k < 8; ++k) v[k] = 0.f;
    if (lane < 56) { const u32x4 w = *(const u32x4*)(z + C_CQ + lane * 8);
#pragma unroll
      for (int k = 0; k < 4; ++k) { v[2 * k] = __uint_as_float(w[k] << 16); v[2 * k + 1] = __uint_as_float(w[k] & 0xffff0000u); ss += v[2 * k] * v[2 * k] + v[2 * k + 1] * v[2 * k + 1]; } }
    ss = wsum(ss); float rstd = rsqrtf(ss * (1.f / 448.f) + EPSV);
    { u32x4 o = {0u, 0u, 0u, 0u};
      if (lane < 56) { const f32x4 n0 = *(const f32x4*)(qn + lane * 8), n1 = *(const f32x4*)(qn + lane * 8 + 4);
        o.x = pack2(v[0] * rstd * n0[0], v[1] * rstd * n0[1]); o.y = pack2(v[2] * rstd * n0[2], v[3] * rstd * n0[3]); o.z = pack2(v[4] * rstd * n1[0], v[5] * rstd * n1[1]); o.w = pack2(v[6] * rstd * n1[2], v[7] * rstd * n1[3]); }
      *(u32x4*)(p.Aq + (size_t)row * 512 + lane * 8) = o; }
    ss = 0.f;
    if (lane < 16) { const u32x4 w = *(const u32x4*)(z + C_CKV + lane * 8);
#pragma unroll
      for (int k = 0; k < 4; ++k) { v[2 * k] = __uint_as_float(w[k] << 16); v[2 * k + 1] = __uint_as_float(w[k] & 0xffff0000u); ss += v[2 * k] * v[2 * k] + v[2 * k + 1] * v[2 * k + 1]; } }
    ss = wsum(ss); rstd = rsqrtf(ss * (1.f / 128.f) + EPSV);
    if (lane < 32) { u32x4 o = {0u, 0u, 0u, 0u};
      if (lane < 16) { const f32x4 n0 = *(const f32x4*)(kvn + lane * 8), n1 = *(const f32x4*)(kvn + lane * 8 + 4);
        o.x = pack2(v[0] * rstd * n0[0], v[1] * rstd * n0[1]); o.y = pack2(v[2] * rstd * n0[2], v[3] * rstd * n0[3]); o.z = pack2(v[4] * rstd * n1[0], v[5] * rstd * n1[1]); o.w = pack2(v[6] * rstd * n1[2], v[7] * rstd * n1[3]); }
      *(u32x4*)(p.Akv + (size_t)row * 256 + lane * 8) = o; }
    if (t < LL) {
      if (lane < 32) { const int half = lane >> 4, i = lane & 15; const float x1 = bf2f(z[C_KR + half * 32 + i]), x2 = bf2f(z[C_KR + half * 32 + 16 + i]);
        const float pos = (float)(half ? (t & 63) : (t >> 6)); const float ang = pos * exp2f(-(float)i * (13.287712379549449f / 16.f)); float sv, cv; sincosf(ang, &sv, &cv);
        p.KR[(size_t)row * 64 + half * 32 + i] = f2bf(x1 * cv - x2 * sv); p.KR[(size_t)row * 64 + half * 32 + 16 + i] = f2bf(x2 * cv + x1 * sv); }
    } else p.KR[(size_t)row * 64 + lane] = z[C_KR + lane];
  }
}

DI void st_qrope(const Prm& p, int bid, int nb) {
  const int wave = ltid() >> 6, lane = ltid() & 63;
  for (int row = bid * 8 + wave; row < MR; row += nb * 8) {
    const int b = row / LT, t = row - b * LT; if (t >= LL) continue;
#pragma unroll
    for (int k = 0; k < 2; ++k) { const int pid = lane + 64 * k, h = pid >> 5, r = pid & 31, half = r >> 4, i = r & 15;
      bf16_t* q = p.Qraw + (size_t)row * 768 + h * 192 + 128 + half * 32; const float x1 = bf2f(q[i]), x2 = bf2f(q[16 + i]);
      const float pos = (float)(half ? (t & 63) : (t >> 6)); const float ang = pos * exp2f(-(float)i * (13.287712379549449f / 16.f)); float sv, cv; sincosf(ang, &sv, &cv);
      q[i] = f2bf(x1 * cv - x2 * sv); q[16 + i] = f2bf(x2 * cv + x1 * sv); }
  }
}

DI void st_fnchan(const Prm& p, unsigned char* lds, int bid, int nb) {
  bf16_t* wt = (bf16_t*)lds;
  bf16_t* zt = (bf16_t*)(lds + 256 * 272);
  const int tid = ltid(), wave = tid >> 6, lane = tid & 63, r32 = lane & 31, hi = lane >> 5;
  __syncthreads();
  for (int e = tid; e < 256 * 128; e += NTHR) wt[(e >> 7) * 136 + (e & 127)] = f2bf(p.CCS[e]);
  for (int it = bid; it < (MR / 64) * 4; it += nb) {
    const int tile = it >> 2, g = it & 3, row0 = tile * 64, b = row0 / LT, t0 = row0 - b * LT;
    __syncthreads();
    for (int e = tid; e < 1024; e += NTHR) { const int r = e >> 4, c8 = (e & 15) * 8; *(u32x4*)(zt + r * 136 + c8) = *(const u32x4*)(p.Z + (size_t)(row0 + r) * NZ + C_FN + g * 128 + c8); }
    __syncthreads();
    f32x16 acc[2] = {};
#pragma unroll
    for (int k8 = 0; k8 < 8; ++k8) { const bf16x8 a = *(const bf16x8*)(wt + (wave * 32 + r32) * 136 + k8 * 16 + hi * 8);
#pragma unroll
      for (int tt = 0; tt < 2; ++tt) { const bf16x8 bb = *(const bf16x8*)(zt + (tt * 32 + r32) * 136 + k8 * 16 + hi * 8); acc[tt] = __builtin_amdgcn_mfma_f32_32x32x16_bf16(a, bb, acc[tt], 0, 0, 0); } }
    const int tb = wave >> 2;
#pragma unroll
    for (int tt = 0; tt < 2; ++tt)
#pragma unroll
      for (int r = 0; r < 16; ++r) { const int k2 = (wave & 3) * 32 + (r & 3) + 8 * (r >> 2) + 4 * hi;
        if (t0 < LL) p.PQT[((size_t)(b * 512 + g * 128 + k2)) * 8192 + tb * 4096 + t0 + tt * 32 + r32] = f2bf(acc[tt][r]);
        else p.PQTc[((size_t)(b * 512 + g * 128 + k2)) * 512 + tb * 256 + (t0 - LL) + tt * 32 + r32] = f2bf(acc[tt][r]); }
  }
}

DI int scan_row(int b, int dir, int s) { return s < LCX ? b * LT + LL + (dir ? LCX - 1 - s : s) : b * LT + (dir ? LL - 1 - (s - LCX) : (s - LCX)); }

DI void st_dntinv(const Prm& p, unsigned char* lds, int bid, int nb) {
  const int tid = ltid(), wave = tid >> 6, lane = tid & 63, r32 = lane & 31, hi = lane >> 5;
  float* Ab = (float*)lds + wave * 4096;
  float* gcb = (float*)(lds + 131072) + wave * 128; float* btb = gcb + 64;
  for (int item = bid * 8 + wave; item < 64 * 68; item += nb * 8) {
    const int chain = item / 68, n = item - chain * 68, b = chain >> 3, h = (chain >> 1) & 3, dir = chain & 1;
    const int myrow = scan_row(b, dir, n * 64 + lane);
    const float g = p.GB[(size_t)myrow * 16 + dir * 4 + h], bt = p.GB[(size_t)myrow * 16 + 8 + dir * 4 + h];
    gcb[lane] = g; btb[lane] = bt;
    bf16x8 kf[2][8];
#pragma unroll
    for (int tt = 0; tt < 2; ++tt) { const int row = scan_row(b, dir, n * 64 + tt * 32 + r32);
#pragma unroll
      for (int ks = 0; ks < 8; ++ks) kf[tt][ks] = *(const bf16x8*)(p.DNQ + (size_t)row * 1536 + 512 + h * 128 + ks * 16 + hi * 8); }
    __builtin_amdgcn_wave_barrier();
    float gc = 0.f;
    for (int e = 0; e < 64; ++e) { const float ge = gcb[e]; gc += (e <= lane) ? ge : 0.f; }
    __builtin_amdgcn_wave_barrier();
    gcb[lane] = gc; p.GCB[(size_t)item * 64 + lane] = gc;
    __builtin_amdgcn_wave_barrier();
    f32x16 a00 = {}, a10 = {}, a11 = {};
#pragma unroll
    for (int ks = 0; ks < 8; ++ks) { a00 = __builtin_amdgcn_mfma_f32_32x32x16_bf16(kf[0][ks], kf[0][ks], a00, 0, 0, 0);
      a10 = __builtin_amdgcn_mfma_f32_32x32x16_bf16(kf[1][ks], kf[0][ks], a10, 0, 0, 0); a11 = __builtin_amdgcn_mfma_f32_32x32x16_bf16(kf[1][ks], kf[1][ks], a11, 0, 0, 0); }
    { const float gce0 = gcb[r32], gce1 = gcb[32 + r32];
#pragma unroll
      for (int r = 0; r < 16; ++r) { const int cl = (r & 3) + 8 * (r >> 2) + 4 * hi; const float gc0 = gcb[cl], bt0 = btb[cl], gc1 = gcb[32 + cl], bt1 = btb[32 + cl];
        Ab[cl * 64 + r32] = (r32 < cl) ? bt0 * a00[r] * __expf(gc0 - gce0) : 0.f;
        Ab[cl * 64 + 32 + r32] = 0.f;
        Ab[(32 + cl) * 64 + r32] = bt1 * a10[r] * __expf(gc1 - gce0);
        Ab[(32 + cl) * 64 + 32 + r32] = (r32 < cl) ? bt1 * a11[r] * __expf(gc1 - gce1) : 0.f; } }
    __builtin_amdgcn_wave_barrier();
    float x[64];
    bf16_t* to = p.TINV + (size_t)item * 4096 + lane;
#pragma unroll
    for (int c = 0; c < 64; ++c) { float s = (c == lane) ? 1.f : 0.f;
#pragma unroll
      for (int e4 = 0; e4 < (c + 3) / 4; ++e4) { const f32x4 av = *(const f32x4*)(Ab + c * 64 + e4 * 4);
#pragma unroll
        for (int i = 0; i < 4; ++i) if (e4 * 4 + i < c) s -= av[i] * x[e4 * 4 + i]; }
      x[c] = s; to[c * 64] = f2bf(s); }
    __builtin_amdgcn_wave_barrier();
  }
}

DI void st_dnscan(const Prm& p, unsigned char* lds, int bid, int nb) {
  constexpr int PK = 136, PB = 72;
  bf16_t* Qs = (bf16_t*)lds; bf16_t* Ks = Qs + 64 * PK; bf16_t* SB = Ks + 64 * PK; bf16_t* KDT = SB + 64 * PK; bf16_t* TI = KDT + 128 * PB; bf16_t* RT = TI + 64 * PB; bf16_t* VNT = RT + 64 * PB;
  bf16_t* PL = VNT + 64 * PB; bf16_t* Vs = PL + 64 * PB; float* gcs = (float*)(Vs + 64 * PB); float* bts = gcs + 64; float* egs = bts + 64;
  const int tid = ltid(), wave = tid >> 6, lane = tid & 63, r32 = lane & 31, hi = lane >> 5;
  for (int item = bid; item < 128; item += nb) {
    const int chain = item >> 1, half = item & 1, b = chain >> 3, h = (chain >> 1) & 3, dir = chain & 1;
    f32x16 accS = {};
    __syncthreads();
    for (int e = tid; e < 64 * PK; e += NTHR) SB[e] = 0;
    bf16x8 pf[6]; float pgc = 0.f, pbt = 0.f;
    auto gload = [&](int n) {
      const size_t ci = (size_t)chain * 68 + n;
#pragma unroll
      for (int r = 0; r < 6; ++r) { const int e = tid + NTHR * r;
        if (e < 2048) { const int ee = e & 1023, t = ee >> 4, c8 = ee & 15; const int row = scan_row(b, dir, n * 64 + t); pf[r] = *(const bf16x8*)(p.DNQ + (size_t)row * 1536 + (e < 1024 ? 0 : 512) + h * 128 + c8 * 8); }
        else if (e < 2560) { const int ee = e - 2048, t = ee >> 3, c8 = ee & 7; const int row = scan_row(b, dir, n * 64 + t); pf[r] = *(const bf16x8*)(p.DNQ + (size_t)row * 1536 + 1024 + h * 128 + half * 64 + c8 * 8); }
        else { const int ee = e - 2560; pf[r] = *(const bf16x8*)(p.TINV + ci * 4096 + ee * 8); } }
      if (tid < 64) { pgc = p.GCB[ci * 64 + tid]; const int row = scan_row(b, dir, n * 64 + tid); pbt = p.GB[(size_t)row * 16 + 8 + dir * 4 + h]; }
    };
    gload(0);
    for (int n = 0; n < LT / 64; ++n) {
      if (tid < 64) { gcs[tid] = pgc; bts[tid] = pbt; egs[tid] = __expf(pgc); }
      __syncthreads();
      const float gl = gcs[63];
#pragma unroll
      for (int r = 0; r < 6; ++r) { const int e = tid + NTHR * r;
        if (e < 1024) { const int t = e >> 4, c8 = e & 15; *(bf16x8*)(Qs + t * PK + c8 * 8) = pf[r]; }
        else if (e < 2048) { const int ee = e - 1024, t = ee >> 4, c8 = ee & 15; *(bf16x8*)(Ks + t * PK + c8 * 8) = pf[r]; const float sc = __expf(gl - gcs[t]);
#pragma unroll
          for (int j = 0; j < 8; ++j) KDT[(c8 * 8 + j) * PB + t] = f2bf(bf2f((bf16_t)pf[r][j]) * sc); }
        else if (e < 2560) { const int ee = e - 2048, t = ee >> 3, c8 = ee & 7; *(bf16x8*)(Vs + t * PB + c8 * 8) = pf[r]; }
        else { const int ee = e - 2560, c = ee >> 3, c8 = ee & 7; *(bf16x8*)(TI + c * PB + c8 * 8) = pf[r]; } }
      if (n + 1 < LT / 64) gload(n + 1);
      __syncthreads();
      f32x16 accO = {};
      if (wave < 4) { const int et = wave >> 1, jt = wave & 1; f32x16 a1 = {};
#pragma unroll
        for (int k8 = 0; k8 < 8; ++k8) { const bf16x8 av = *(const bf16x8*)(Ks + (et * 32 + r32) * PK + k8 * 16 + hi * 8), bv = *(const bf16x8*)(SB + (jt * 32 + r32) * PK + k8 * 16 + hi * 8);
          a1 = __builtin_amdgcn_mfma_f32_32x32x16_bf16(av, bv, a1, 0, 0, 0); }
        const int j = jt * 32 + r32;
#pragma unroll
        for (int g = 0; g < 4; ++g) { const int e0 = et * 32 + 8 * g + 4 * hi; float rv[4];
#pragma unroll
          for (int i = 0; i < 4; ++i) rv[i] = bts[e0 + i] * (bf2f(Vs[(e0 + i) * PB + j]) - egs[e0 + i] * a1[4 * g + i]);
          u32x2 w; w.x = pack2(rv[0], rv[1]); w.y = pack2(rv[2], rv[3]); *(u32x2*)(RT + j * PB + e0) = w; } }
      else {
        if (wave < 7) { const int et = wave == 6 ? 1 : 0, ct = wave == 4 ? 0 : 1; f32x16 a2 = {};
#pragma unroll
          for (int k8 = 0; k8 < 8; ++k8) { const bf16x8 av = *(const bf16x8*)(Ks + (et * 32 + r32) * PK + k8 * 16 + hi * 8), bv = *(const bf16x8*)(Qs + (ct * 32 + r32) * PK + k8 * 16 + hi * 8);
            a2 = __builtin_amdgcn_mfma_f32_32x32x16_bf16(av, bv, a2, 0, 0, 0); }
          const int c = ct * 32 + r32; const float gcc = gcs[c];
#pragma unroll
          for (int g = 0; g < 4; ++g) { const int e0 = et * 32 + 8 * g + 4 * hi; float pv[4];
#pragma unroll
            for (int i = 0; i < 4; ++i) pv[i] = (e0 + i <= c) ? a2[4 * g + i] * __expf(gcc - gcs[e0 + i]) : 0.f;
            u32x2 w; w.x = pack2(pv[0], pv[1]); w.y = pack2(pv[2], pv[3]); *(u32x2*)(PL + c * PB + e0) = w; } }
        else { for (int e = lane; e < 32 * 8; e += 64) { const int c = e >> 3, q4 = (e & 7) * 4; *(u32x2*)(PL + c * PB + 32 + q4) = (u32x2){0u, 0u}; } }
        { const int ct = (wave - 4) >> 1, jt = wave & 1;
#pragma unroll
          for (int k8 = 0; k8 < 8; ++k8) { const bf16x8 av = *(const bf16x8*)(Qs + (ct * 32 + r32) * PK + k8 * 16 + hi * 8), bv = *(const bf16x8*)(SB + (jt * 32 + r32) * PK + k8 * 16 + hi * 8);
            accO = __builtin_amdgcn_mfma_f32_32x32x16_bf16(av, bv, accO, 0, 0, 0); }
#pragma unroll
          for (int r = 0; r < 16; ++r) accO[r] *= egs[ct * 32 + (r & 3) + 8 * (r >> 2) + 4 * hi]; } }
      __syncthreads();
      if (wave < 4) { const int ct = wave >> 1, jt = wave & 1; f32x16 a3 = {};
#pragma unroll
        for (int k8 = 0; k8 < 4; ++k8) { const bf16x8 av = *(const bf16x8*)(TI + (ct * 32 + r32) * PB + k8 * 16 + hi * 8), bv = *(const bf16x8*)(RT + (jt * 32 + r32) * PB + k8 * 16 + hi * 8);
          a3 = __builtin_amdgcn_mfma_f32_32x32x16_bf16(av, bv, a3, 0, 0, 0); }
#pragma unroll
        for (int g = 0; g < 4; ++g) { u32x2 w; w.x = pack2(a3[4 * g], a3[4 * g + 1]); w.y = pack2(a3[4 * g + 2], a3[4 * g + 3]); *(u32x2*)(VNT + (jt * 32 + r32) * PB + ct * 32 + 8 * g + 4 * hi) = w; } }
      __syncthreads();
      if (wave >= 4) { const int ct = (wave - 4) >> 1, jt = wave & 1;
#pragma unroll
        for (int k8 = 0; k8 < 4; ++k8) { const bf16x8 av = *(const bf16x8*)(PL + (ct * 32 + r32) * PB + k8 * 16 + hi * 8), bv = *(const bf16x8*)(VNT + (jt * 32 + r32) * PB + k8 * 16 + hi * 8);
          accO = __builtin_amdgcn_mfma_f32_32x32x16_bf16(av, bv, accO, 0, 0, 0); }
#pragma unroll
        for (int r = 0; r < 16; ++r) { const int c = ct * 32 + (r & 3) + 8 * (r >> 2) + 4 * hi; const int row = scan_row(b, dir, n * 64 + c);
          p.OB[((size_t)(0 * 2 + dir) * MR + row) * 512 + h * 128 + half * 64 + jt * 32 + r32] = f2bf(accO[r]); } }
      { const int dt = wave >> 1, jt = wave & 1; const float egl = __expf(gl);
#pragma unroll
        for (int r = 0; r < 16; ++r) accS[r] *= egl;
#pragma unroll
        for (int k8 = 0; k8 < 4; ++k8) { const bf16x8 av = *(const bf16x8*)(KDT + (dt * 32 + r32) * PB + k8 * 16 + hi * 8), bv = *(const bf16x8*)(VNT + (jt * 32 + r32) * PB + k8 * 16 + hi * 8);
          accS = __builtin_amdgcn_mfma_f32_32x32x16_bf16(av, bv, accS, 0, 0, 0); }
#pragma unroll
        for (int g = 0; g < 4; ++g) { u32x2 w; w.x = pack2(accS[4 * g], accS[4 * g + 1]); w.y = pack2(accS[4 * g + 2], accS[4 * g + 3]);
          *(u32x2*)(SB + (jt * 32 + r32) * PK + dt * 32 + 8 * g + 4 * hi) = w; } }
      __syncthreads();
    }
  }
}

DI void st_glascan(const Prm& p, int layer, unsigned char* lds, int bid, int nb) {
  constexpr int PB = 72;
  bf16_t* QI = (bf16_t*)lds; bf16_t* QR = QI + 64 * PB; bf16_t* KR = QR + 64 * PB; bf16_t* KRT = KR + 64 * PB; bf16_t* VT = KRT + 64 * PB; bf16_t* SB = VT + 64 * PB; bf16_t* PL = SB + 64 * PB;
  float* LA = (float*)(lds + 7 * 64 * PB * 2);
  float* AL = LA + 4096;
  float* SEG = AL + 1024;
  float* EBL = SEG + 512;
  const int tid = ltid(), wave = tid >> 6, lane = tid & 63, r32 = lane & 31, hi = lane >> 5;
  for (int item = bid; item < 128; item += nb) {
    const int chain = item >> 1, half = item & 1, b = chain >> 3, h = (chain >> 1) & 3, dir = chain & 1;
    const float* w2 = p.gla_w2 + (size_t)(layer * 2 + dir) * 16 * 256 + h * 64; const float* b2 = p.gla_b2 + (layer * 2 + dir) * 256 + h * 64;
    float w2r[16]; const int dme = tid & 63;
#pragma unroll
    for (int r = 0; r < 16; ++r) w2r[r] = w2[r * 256 + dme];
    const float b2r = b2[dme];
    f32x16 acc = {};
    __syncthreads();
    for (int e = tid; e < 64 * PB; e += NTHR) SB[e] = 0;
    bf16x8 pf[4];
    auto gload = [&](int n) {
#pragma unroll
      for (int r = 0; r < 4; ++r) { const int e = tid + NTHR * r; if (e < 1664) { const int t = e / 26, ch = e - t * 26; const int row = scan_row(b, dir, n * 64 + t);
          const int col = ch < 8 ? C_GQ + h * 64 + ch * 8 : (ch < 16 ? C_GK + h * 64 + (ch - 8) * 8 : (ch < 24 ? C_GV + h * 128 + half * 64 + (ch - 16) * 8 : C_GALPHA + dir * 16 + (ch - 24) * 8));
          pf[r] = *(const bf16x8*)(p.Z + (size_t)row * NZ + col); } }
    };
    gload(0);
    for (int n = 0; n < LT / 64; ++n) {
#pragma unroll
      for (int r = 0; r < 4; ++r) { const int e = tid + NTHR * r; if (e < 1664) { const int t = e / 26, ch = e - t * 26; if (ch >= 24) {
#pragma unroll
            for (int j = 0; j < 8; ++j) AL[t * 16 + (ch - 24) * 8 + j] = bf2f((bf16_t)pf[r][j]); } } }
      __syncthreads();
      { const int seg = tid >> 6; float la[8]; float run = 0.f;
#pragma unroll
        for (int k = 0; k < 8; ++k) { const int t = seg * 8 + k; float zz = b2r;
#pragma unroll
          for (int r = 0; r < 16; ++r) zz += AL[t * 16 + r] * w2r[r];
          const float nz = -zz; const float sp = nz > 20.f ? nz : log1pf(expf(nz)); run += -sp * (1.f / 16.f); la[k] = run; }
        SEG[seg * 64 + dme] = run;
        __syncthreads();
        float pre = 0.f;
#pragma unroll
        for (int s2 = 0; s2 < 8; ++s2) pre += (s2 < seg) ? SEG[s2 * 64 + dme] : 0.f;
#pragma unroll
        for (int k = 0; k < 8; ++k) LA[(seg * 8 + k) * 64 + dme] = la[k] + pre;
        if (seg == 7) EBL[dme] = expf(la[7] + pre); }
      __syncthreads();
#pragma unroll
      for (int r = 0; r < 4; ++r) { const int e = tid + NTHR * r; if (e < 1664) { const int t = e / 26, ch = e - t * 26;
          if (ch < 8) { u32x4 wi, wr; float xi[8], xr[8];
#pragma unroll
            for (int j = 0; j < 8; ++j) { const int d = ch * 8 + j; const float bc = LA[t * 64 + d], bl = LA[63 * 64 + d], q = bf2f((bf16_t)pf[r][j]) * 0.125f; xi[j] = q * __expf(bc); xr[j] = q * __expf(bc - bl); }
            wi.x = pack2(xi[0], xi[1]); wi.y = pack2(xi[2], xi[3]); wi.z = pack2(xi[4], xi[5]); wi.w = pack2(xi[6], xi[7]);
            wr.x = pack2(xr[0], xr[1]); wr.y = pack2(xr[2], xr[3]); wr.z = pack2(xr[4], xr[5]); wr.w = pack2(xr[6], xr[7]);
            *(u32x4*)(QI + t * PB + ch * 8) = wi; *(u32x4*)(QR + t * PB + ch * 8) = wr; }
          else if (ch < 16) { u32x4 wk; float xk[8];
#pragma unroll
            for (int j = 0; j < 8; ++j) { const int d = (ch - 8) * 8 + j; xk[j] = bf2f((bf16_t)pf[r][j]) * __expf(LA[63 * 64 + d] - LA[t * 64 + d]); KRT[d * PB + t] = f2bf(xk[j]); }
            wk.x = pack2(xk[0], xk[1]); wk.y = pack2(xk[2], xk[3]); wk.z = pack2(xk[4], xk[5]); wk.w = pack2(xk[6], xk[7]);
            *(u32x4*)(KR + t * PB + (ch - 8) * 8) = wk; }
          else if (ch < 24) {
#pragma unroll
            for (int j = 0; j < 8; ++j) VT[((ch - 16) * 8 + j) * PB + t] = (bf16_t)pf[r][j]; } } }
      if (n + 1 < LT / 64) gload(n + 1);
      __syncthreads();
      if (wave < 3) { const int et = wave == 2 ? 1 : 0, ct = wave == 0 ? 0 : 1; f32x16 a2 = {};
#pragma unroll
        for (int k8 = 0; k8 < 4; ++k8) { const bf16x8 av = *(const bf16x8*)(KR + (et * 32 + r32) * PB + k8 * 16 + hi * 8), bv = *(const bf16x8*)(QR + (ct * 32 + r32) * PB + k8 * 16 + hi * 8);
          a2 = __builtin_amdgcn_mfma_f32_32x32x16_bf16(av, bv, a2, 0, 0, 0); }
        const int c = ct * 32 + r32;
#pragma unroll
        for (int g = 0; g < 4; ++g) { const int e0 = et * 32 + 8 * g + 4 * hi; u32x2 w;
          w.x = pack2(e0 <= c ? a2[4 * g] : 0.f, e0 + 1 <= c ? a2[4 * g + 1] : 0.f); w.y = pack2(e0 + 2 <= c ? a2[4 * g + 2] : 0.f, e0 + 3 <= c ? a2[4 * g + 3] : 0.f);
          *(u32x2*)(PL + c * PB + e0) = w; } }
      else if (wave == 3) { for (int e = lane; e < 32 * 8; e += 64) { const int c = e >> 3, q4 = (e & 7) * 4; *(u32x2*)(PL + c * PB + 32 + q4) = (u32x2){0u, 0u}; } }
      else { const int ct = (wave - 4) >> 1, jt = wave & 1; acc = f32x16{};
#pragma unroll
        for (int k8 = 0; k8 < 4; ++k8) { const bf16x8 av = *(const bf16x8*)(QI + (ct * 32 + r32) * PB + k8 * 16 + hi * 8), bv = *(const bf16x8*)(SB + (jt * 32 + r32) * PB + k8 * 16 + hi * 8);
          acc = __builtin_amdgcn_mfma_f32_32x32x16_bf16(av, bv, acc, 0, 0, 0); } }
      __syncthreads();
      if (wave >= 4) { const int ct = (wave - 4) >> 1, jt = wave & 1;
#pragma unroll
        for (int k8 = 0; k8 < 4; ++k8) { const bf16x8 av = *(const bf16x8*)(PL + (ct * 32 + r32) * PB + k8 * 16 + hi * 8), bv = *(const bf16x8*)(VT + (jt * 32 + r32) * PB + k8 * 16 + hi * 8);
          acc = __builtin_amdgcn_mfma_f32_32x32x16_bf16(av, bv, acc, 0, 0, 0); }
#pragma unroll
        for (int r = 0; r < 16; ++r) { const int c = ct * 32 + (r & 3) + 8 * (r >> 2) + 4 * hi; const int row = scan_row(b, dir, n * 64 + c);
          p.OB[((size_t)(1 * 2 + dir) * MR + row) * 512 + h * 128 + half * 64 + jt * 32 + r32] = f2bf(acc[r]); } }
      else { const int dt = wave >> 1, jt = wave & 1;
#pragma unroll
        for (int r = 0; r < 16; ++r) acc[r] *= EBL[dt * 32 + (r & 3) + 8 * (r >> 2) + 4 * hi];
#pragma unroll
        for (int k8 = 0; k8 < 4; ++k8) { const bf16x8 av = *(const bf16x8*)(KRT + (dt * 32 + r32) * PB + k8 * 16 + hi * 8), bv = *(const bf16x8*)(VT + (jt * 32 + r32) * PB + k8 * 16 + hi * 8);
          acc = __builtin_amdgcn_mfma_f32_32x32x16_bf16(av, bv, acc, 0, 0, 0); }
#pragma unroll
        for (int g = 0; g < 4; ++g) { u32x2 w; w.x = pack2(acc[4 * g], acc[4 * g + 1]); w.y = pack2(acc[4 * g + 2], acc[4 * g + 3]);
          *(u32x2*)(SB + (jt * 32 + r32) * PB + dt * 32 + 8 * g + 4 * hi) = w; } }
      __syncthreads();
    }
  }
}

DI void st_combine(const Prm& p, int layer, int bid, int nb) {
  const int wave = ltid() >> 6, lane = ltid() & 63;
  for (long task = (long)bid * 8 + wave; task < (long)MR * 8; task += (long)nb * 8) {
    const int row = (int)(task >> 3), mh = (int)(task & 7), mixer = mh >> 2, h = mh & 3;
    const unsigned f = *(const unsigned*)(p.OB + ((size_t)(mixer * 2 + 0) * MR + row) * 512 + h * 128 + lane * 2), g = *(const unsigned*)(p.OB + ((size_t)(mixer * 2 + 1) * MR + row) * 512 + h * 128 + lane * 2);
    const float o0 = bf2f((bf16_t)(f & 0xffffu)) + bf2f((bf16_t)(g & 0xffffu)), o1 = bf2f((bf16_t)(f >> 16)) + bf2f((bf16_t)(g >> 16));
    const float ss = wsum(o0 * o0 + o1 * o1), rstd = rsqrtf(ss * (1.f / 128.f) + EPSV);
    const float* w = (mixer ? p.gla_norm : p.dn_norm) + layer * 128 + lane * 2;
    const unsigned gz = *(const unsigned*)(p.Z + (size_t)row * NZ + (mixer ? C_GGATE : C_DNGATE) + h * 128 + lane * 2);
    const float g0 = bf2f((bf16_t)(gz & 0xffffu)), g1 = bf2f((bf16_t)(gz >> 16));
    *(unsigned*)(p.Y + (size_t)row * DM + mixer * 512 + h * 128 + lane * 2) = pack2(o0 * rstd * w[0] * siluf(g0), o1 * rstd * w[1] * siluf(g1));
  }
}

DI unsigned fkey(float f) { const unsigned u = __float_as_uint(f); return u ^ ((u >> 31) ? 0xffffffffu : 0x80000000u); }
DI int pcnt(unsigned long long m) { return __builtin_popcountll(m); }
DI int lanes_below(unsigned long long m) { return (int)__builtin_amdgcn_mbcnt_hi((unsigned)(m >> 32), __builtin_amdgcn_mbcnt_lo((unsigned)m, 0u)); }
DI void st_peertopk(const Prm& p, int layer, unsigned char* lds, int bid, int nb) {
  bf16_t* ks = (bf16_t*)lds;
  bf16_t* qt = (bf16_t*)(lds + 69632);
  float* sc = (float*)(lds + 69632);
  const int tid = ltid(), wave = tid >> 6, lane = tid & 63, r32 = lane & 31, hi = lane >> 5;
  float* selv = (float*)(lds + 69632 + 33280) + wave * 64; int* seli = (int*)(selv + 32);
  int hcur = -1;
  const int nchunk = MR / 32;
  for (int it = bid; it < 8 * nchunk; it += nb) {
    const int h = it / nchunk, chunk = it - h * nchunk, row0 = chunk * 32;
    if (layer == 1 && (row0 % LT) >= LL) continue;
    __syncthreads();
    if (h != hcur) {
      const float* kg = p.peer_keys + ((size_t)(layer * 8 + h) * 2) * 128 * 128;
      for (int e = tid; e < 2 * 128 * 128; e += NTHR) { const int pn = e >> 7, k = e & 127; ks[pn * 136 + k] = f2bf(kg[e]); }
      hcur = h; }
    for (int e = tid; e < 1024; e += NTHR) { const int r = e >> 5, c8 = (e & 31) * 8; *(u32x4*)(qt + r * 264 + c8) = *(const u32x4*)(p.Qp + (size_t)(row0 + r) * DM + h * 256 + c8); }
    __syncthreads();
    { const int pt = wave >> 2, nt = wave & 3; f32x16 acc = {};
#pragma unroll
      for (int k8 = 0; k8 < 8; ++k8) { const bf16x8 a = *(const bf16x8*)(qt + r32 * 264 + pt * 128 + k8 * 16 + hi * 8), b = *(const bf16x8*)(ks + (pt * 128 + nt * 32 + r32) * 136 + k8 * 16 + hi * 8);
        acc = __builtin_amdgcn_mfma_f32_32x32x16_bf16(a, b, acc, 0, 0, 0); }
      __syncthreads();
#pragma unroll
      for (int r = 0; r < 16; ++r) sc[((r & 3) + 8 * (r >> 2) + 4 * hi) * 260 + pt * 128 + nt * 32 + r32] = acc[r]; }
    __syncthreads();
    for (int rr = 0; rr < 4; ++rr) {
      const int m = wave * 4 + rr, row = row0 + m;
      float s[2][2];
#pragma unroll
      for (int pp = 0; pp < 2; ++pp)
#pragma unroll
        for (int hh = 0; hh < 2; ++hh) s[pp][hh] = sc[m * 260 + pp * 128 + hh * 64 + lane];
      unsigned kk[2][2], T[2] = {0u, 0u};
#pragma unroll
      for (int pp = 0; pp < 2; ++pp) { kk[pp][0] = fkey(s[pp][0]); kk[pp][1] = fkey(s[pp][1]); }
      { unsigned ta = 0u, tb = 0u, da = 0u, db = 0u;
        for (int bit = 31; bit >= 0; --bit) { const unsigned m = 1u << bit;
          const unsigned ca = ta | m, cb = tb | m;
          const unsigned na = (unsigned)(pcnt(__ballot(kk[0][0] >= ca)) + pcnt(__ballot(kk[0][1] >= ca))), nb2 = (unsigned)(pcnt(__ballot(kk[1][0] >= cb)) + pcnt(__ballot(kk[1][1] >= cb)));
          const unsigned oa = (na >= 16u ? 1u : 0u) & ~da, ob = (nb2 >= 16u ? 1u : 0u) & ~db;
          ta |= (0u - oa) & m; tb |= (0u - ob) & m; da |= oa & (na == 16u ? 1u : 0u); db |= ob & (nb2 == 16u ? 1u : 0u);
          if (da & db) break; }
        T[0] = __builtin_amdgcn_readfirstlane(ta); T[1] = __builtin_amdgcn_readfirstlane(tb); }
#pragma unroll
      for (int pp = 0; pp < 2; ++pp) { const unsigned k0 = kk[pp][0], k1 = kk[pp][1], TT = T[pp];
        const unsigned long long g0 = __ballot(k0 > TT), g1 = __ballot(k1 > TT), e0 = __ballot(k0 == TT), e1 = __ballot(k1 == TT);
        const int ng0 = pcnt(g0), ng = ng0 + pcnt(g1), need = 16 - ng, ne0 = pcnt(e0);
        if (k0 > TT) { const int r = lanes_below(g0); selv[pp * 16 + r] = s[pp][0]; seli[pp * 16 + r] = lane; }
        if (k1 > TT) { const int r = ng0 + lanes_below(g1); selv[pp * 16 + r] = s[pp][1]; seli[pp * 16 + r] = lane + 64; }
        if (k0 == TT) { const int r = lanes_below(e0); if (r < need) { selv[pp * 16 + ng + r] = s[pp][0]; seli[pp * 16 + ng + r] = lane; } }
        if (k1 == TT) { const int r = ne0 + lanes_below(e1); if (r < need) { selv[pp * 16 + ng + r] = s[pp][1]; seli[pp * 16 + ng + r] = lane + 64; } } }
      __builtin_amdgcn_wave_barrier();
      float cd[4]; unsigned ck[4]; { const float sa = selv[lane >> 2]; const f32x4 sb = *(const f32x4*)(selv + 16 + (lane & 3) * 4);
#pragma unroll
        for (int q = 0; q < 4; ++q) { cd[q] = sa + sb[q]; ck[q] = fkey(cd[q]); } }
      unsigned T2 = 0u;
      for (int bit = 31; bit >= 0; --bit) { const unsigned m = 1u << bit, c = T2 | m;
        const unsigned n = (unsigned)(pcnt(__ballot(ck[0] >= c)) + pcnt(__ballot(ck[1] >= c)) + pcnt(__ballot(ck[2] >= c)) + pcnt(__ballot(ck[3] >= c)));
        T2 |= (0u - (n >= 16u ? 1u : 0u)) & m; if (n == 16u) break; }
      T2 = __builtin_amdgcn_readfirstlane(T2);
      float mx = fmaxf(fmaxf(cd[0], cd[1]), fmaxf(cd[2], cd[3])); mx = wmax(mx);
      int base = 0; float esum = 0.f; const int ia = seli[lane >> 2]; int rk[4]; float ev[4];
#pragma unroll
      for (int q = 0; q < 4; ++q) { const unsigned long long g = __ballot(ck[q] > T2); rk[q] = ck[q] > T2 ? base + lanes_below(g) : 99; base += pcnt(g); }
#pragma unroll
      for (int q = 0; q < 4; ++q) { const unsigned long long g = __ballot(ck[q] == T2); if (ck[q] == T2) rk[q] = base + lanes_below(g); base += pcnt(g); }
#pragma unroll
      for (int q = 0; q < 4; ++q) { ev[q] = rk[q] < 16 ? __expf(cd[q] - mx) : 0.f; esum += ev[q]; }
      esum = wsum(esum); const float inv = 1.f / esum;
      int* orow = p.IDX + (size_t)row * 128 + h * 16; float* grow = p.GATE + (size_t)row * 128 + h * 16;
#pragma unroll
      for (int q = 0; q < 4; ++q) if (rk[q] < 16) { orow[rk[q]] = ia * 128 + seli[16 + (lane & 3) * 4 + q]; grow[rk[q]] = ev[q] * inv; }
      __builtin_amdgcn_wave_barrier();
    }
  }
}

constexpr float U_SC = 1024.f, V_SC = 16.f;
DI void st_cvt_tables(const Prm& p, int layer, int bid, int nb) {
  const size_t n16 = (size_t)16384 * DM / 16, stride = (size_t)nb * NTHR;
  const float* U = p.peer_u + (size_t)layer * 16384 * DM; const float* V = p.peer_v + (size_t)layer * 16384 * DM;
  for (size_t e = (size_t)bid * NTHR + ltid(); e < 2 * n16; e += stride) { const bool isv = e >= n16; const size_t k = isv ? e - n16 : e;
    const float* src = (isv ? V : U) + k * 16; const float sc = isv ? V_SC : U_SC; u32x4 w;
#pragma unroll
    for (int q = 0; q < 4; ++q) { const f32x4 a = *(const f32x4*)(src + q * 4) * sc; int r = 0;
      r = __builtin_amdgcn_cvt_pk_fp8_f32(a[0], a[1], r, false); r = __builtin_amdgcn_cvt_pk_fp8_f32(a[2], a[3], r, true); w[q] = (unsigned)r; }
    *(u32x4*)((unsigned char*)(isv ? p.Vb : p.Ub) + k * 16) = w; }
}

DI void st_peergather(const Prm& p, int layer, float* lds, int bid, int nb, bool dry = false) {
  const int tid = ltid(), wave = tid >> 6, lane = tid & 63;
  const unsigned char* Ub = (const unsigned char*)p.Ub; const unsigned char* Vb = (const unsigned char*)p.Vb;
  for (int row = bid; row < MR; row += nb) {
    const int b = row / LT, t = row - b * LT; const bool isc = t >= LL;
    if (isc && layer == 1) continue;
    f32x2 hv[16];
#pragma unroll
    for (int i = 0; i < 2; ++i) {
#pragma unroll
      for (int q = 0; q < 2; ++q) { const u32x4 w = *(const u32x4*)(p.H2 + (size_t)row * DM + i * 1024 + lane * 16 + q * 8);
#pragma unroll
        for (int k = 0; k < 4; ++k) hv[i * 8 + q * 4 + k] = (f32x2){__uint_as_float(w[k] << 16), __uint_as_float(w[k] & 0xffff0000u)}; } }
    f32x2 acc[16];
#pragma unroll
    for (int i = 0; i < 16; ++i) acc[i] = (f32x2){0.f, 0.f};
    const int myidx = lane < 16 ? p.IDX[(size_t)row * 128 + wave * 16 + lane] : 0; const float mygate = lane < 16 ? p.GATE[(size_t)row * 128 + wave * 16 + lane] : 0.f;
#pragma unroll 1
    for (int k0 = 0; k0 < 16; k0 += 4) {
      u32x4 uu[4][2], vv[4][2];
#pragma unroll
      for (int q = 0; q < 4; ++q) { const int e = __builtin_amdgcn_readfirstlane(__shfl(myidx, k0 + q));
        const unsigned char* ur = Ub + (size_t)e * DM + lane * 16; const unsigned char* vr = Vb + (size_t)e * DM + lane * 16;
#pragma unroll
        for (int i = 0; i < 2; ++i) { uu[q][i] = *(const u32x4*)(ur + i * 1024); vv[q][i] = *(const u32x4*)(vr + i * 1024); } }
#pragma unroll
      for (int q = 0; q < 4; ++q) { f32x2 d0 = (f32x2){0.f, 0.f}, d1 = (f32x2){0.f, 0.f};
#pragma unroll
        for (int i = 0; i < 2; ++i)
#pragma unroll
          for (int k = 0; k < 4; ++k) { d0 += __builtin_amdgcn_cvt_pk_f32_fp8((int)uu[q][i][k], false) * hv[i * 8 + k * 2]; d1 += __builtin_amdgcn_cvt_pk_f32_fp8((int)uu[q][i][k], true) * hv[i * 8 + k * 2 + 1]; }
        d0 += d1; float d = wsum(d0[0] + d0[1]) * (1.f / U_SC);
        const float wgt = __shfl(mygate, k0 + q) * 0.5f * d * (1.f + erff(d * 0.70710678118654752f)); const f32x2 w2 = (f32x2){wgt, wgt};
#pragma unroll
        for (int i = 0; i < 2; ++i)
#pragma unroll
          for (int k = 0; k < 4; ++k) { acc[i * 8 + k * 2] += w2 * __builtin_amdgcn_cvt_pk_f32_fp8((int)vv[q][i][k], false); acc[i * 8 + k * 2 + 1] += w2 * __builtin_amdgcn_cvt_pk_f32_fp8((int)vv[q][i][k], true); } }
    }
    __syncthreads();
#pragma unroll
    for (int i = 0; i < 2; ++i) { float* d = lds + wave * 2048 + i * 1024 + lane * 16;
#pragma unroll
      for (int k = 0; k < 4; ++k) *(f32x4*)(d + k * 4) = (f32x4){acc[i * 8 + k * 2][0], acc[i * 8 + k * 2][1], acc[i * 8 + k * 2 + 1][0], acc[i * 8 + k * 2 + 1][1]}; }
    __syncthreads();
    { const int col = tid * 4; f32x4 sum = (f32x4){0.f, 0.f, 0.f, 0.f};
#pragma unroll
      for (int w = 0; w < 8; ++w) sum += *(const f32x4*)(lds + w * 2048 + col);
      const f32x4 g2 = *(const f32x4*)(p.mod + ((size_t)layer * 9 + (isc ? 8 : b)) * NMOD + 5 * DM + col) * (1.f / V_SC);
      float* xr = p.X + (size_t)row * DM + col; const f32x4 xn = *(const f32x4*)xr + g2 * sum;
      if (!dry) {
        float ss = wsum(xn[0] * xn[0] + xn[1] * xn[1] + xn[2] * xn[2] + xn[3] * xn[3]);
        if (lane == 0) lds[16384 + wave] = ss;
        __syncthreads();
        ss = 0.f;
#pragma unroll
        for (int w = 0; w < 8; ++w) ss += lds[16384 + w];
        const float rstd = rsqrtf(ss * (1.f / 2048.f) + EPSV);
        if (layer == 0) { *(f32x4*)xr = xn;
          const float* mr = p.mod + ((size_t)9 + (isc ? 8 : b)) * NMOD; const f32x4 sc = *(const f32x4*)(mr + DM + col), sh = *(const f32x4*)(mr + col);
          const f32x4 o = xn * rstd * (sc + 1.f) + sh; u32x2 w; w.x = pack2(o[0], o[1]); w.y = pack2(o[2], o[3]); *(u32x2*)(p.H + (size_t)row * DM + col) = w; }
        else *(f32x4*)(p.out + ((size_t)b * LL + t) * DM + col) = xn * rstd * *(const f32x4*)(p.final_norm + col);
      } }
  }
}

DI void st_final(const Prm& p, int bid, int nb) {
  const int wave = ltid() >> 6, lane = ltid() & 63;
  for (int r = bid * 8 + wave; r < NB * LL; r += nb * 8) {
    const int b = r / LL, t = r - b * LL; const float* src = p.X + (size_t)(b * LT + t) * DM;
    f32x4 v[8]; float ss = 0.f;
#pragma unroll
    for (int i = 0; i < 8; ++i) { v[i] = *(const f32x4*)(src + (i * 64 + lane) * 4); ss += v[i][0] * v[i][0] + v[i][1] * v[i][1] + v[i][2] * v[i][2] + v[i][3] * v[i][3]; }
    ss = wsum(ss); const float rstd = rsqrtf(ss * (1.f / 2048.f) + EPSV);
#pragma unroll
    for (int i = 0; i < 8; ++i) { const int col = (i * 64 + lane) * 4; *(f32x4*)(p.out + (size_t)r * DM + col) = v[i] * rstd * *(const f32x4*)(p.final_norm + col); }
  }
}

namespace att {
constexpr int NW = 8, QBLK = 32, KVBLK = 64;
constexpr float SCALE = 0.07216878364870322f;
constexpr float THR = 8.f;
constexpr int LDQ = 768, LDK = 1024, LDKR = 64, LDO = DM;
constexpr int SHM_V = KVBLK * 128 * 2, SHM_K = KVBLK * 128 * 2, SHM_KR = KVBLK * 64 * 2, SHM_ATTN = 2 * SHM_V + 2 * SHM_K + 2 * SHM_KR + NW * 64 * 4;
#define KSWZ(row, colB) ((row) * 256 + ((colB) ^ (((row) & 7) << 4)))
#define KRSWZ(row, colB) ((row) * 128 + ((colB) ^ ((((row) >> 1) & 7) << 4)))
#define SBAR() __builtin_amdgcn_sched_barrier(0)
DI int crow(int r, int hi) { return (r & 3) + 8 * (r >> 2) + 4 * hi; }
DI unsigned cvtpk(float lo, float hi) { unsigned r; asm volatile("v_cvt_pk_bf16_f32 %0, %1, %2" : "=v"(r) : "v"(lo), "v"(hi)); return r; }

DI void partialSM(f32x16& p0, f32x16& p1, float& m_reg, float& mn, float& alpha) {
  constexpr float C = SCALE * 1.4426950408889634f;
  float pmax = p0[0];
#pragma unroll
  for (int r = 1; r < 16; ++r) pmax = fmaxf(pmax, p0[r]);
#pragma unroll
  for (int r = 0; r < 16; ++r) pmax = fmaxf(pmax, p1[r]);
  { auto rr = __builtin_amdgcn_permlane32_swap(__float_as_uint(pmax), __float_as_uint(pmax), false, false);
    pmax = fmaxf(__uint_as_float(rr[0]), __uint_as_float(rr[1])); }
  if (__builtin_expect(__all(pmax - m_reg <= THR / SCALE), 1)) { mn = m_reg; alpha = 1.f; }
  else { mn = fmaxf(m_reg, pmax); alpha = __builtin_amdgcn_exp2f((m_reg - mn) * C); m_reg = mn; }
  const float mnC = -mn * C;
#pragma unroll
  for (int r = 0; r < 16; ++r) p0[r] = fmaf(p0[r], C, mnC);
#pragma unroll
  for (int r = 0; r < 16; ++r) p1[r] = fmaf(p1[r], C, mnC);
#pragma unroll
  for (int r = 0; r < 16; ++r) p0[r] = __builtin_amdgcn_exp2f(p0[r]);
}
DI void finishSM(f32x16& p0, f32x16& p1, float alpha, float& l_reg, bf16x8& pa0, bf16x8& pa1, bf16x8& pa2, bf16x8& pa3) {
#pragma unroll
  for (int r = 0; r < 16; ++r) p1[r] = __builtin_amdgcn_exp2f(p1[r]);
  float ps = 0;
#pragma unroll
  for (int r = 0; r < 16; ++r) ps += p0[r];
#pragma unroll
  for (int r = 0; r < 16; ++r) ps += p1[r];
  { auto rr = __builtin_amdgcn_permlane32_swap(__float_as_uint(ps), __float_as_uint(ps), false, false);
    ps = __uint_as_float(rr[0]) + __uint_as_float(rr[1]); }
  l_reg = l_reg * alpha + ps;
#define PK4(P, BASE, OUT) do { unsigned a0 = cvtpk(P[BASE + 0], P[BASE + 1]), a1 = cvtpk(P[BASE + 2], P[BASE + 3]);   \
    unsigned b0 = cvtpk(P[BASE + 4], P[BASE + 5]), b1 = cvtpk(P[BASE + 6], P[BASE + 7]);                              \
    auto r0 = __builtin_amdgcn_permlane32_swap(a0, b0, false, false); auto r1 = __builtin_amdgcn_permlane32_swap(a1, b1, false, false); \
    u32x4 w = {r0[0], r1[0], r0[1], r1[1]}; OUT = *reinterpret_cast<bf16x8*>(&w); } while (0)
  PK4(p0, 0, pa0); PK4(p0, 8, pa1); PK4(p1, 0, pa2); PK4(p1, 8, pa3);
#undef PK4
}
DI void qkt(f32x16& p0, f32x16& p1, const char* Ks, const char* KRs, const bf16x8* qr, int r32, int hi) {
  p0 = f32x16{}; p1 = f32x16{};
#pragma unroll
  for (int d0 = 0; d0 < 8; ++d0) { const int cb = (d0 * 16 + hi * 8) * 2;
    const bf16x8 b0 = *reinterpret_cast<const bf16x8*>(Ks + KSWZ(r32, cb));
    const bf16x8 b1 = *reinterpret_cast<const bf16x8*>(Ks + KSWZ(32 + r32, cb));
    p0 = __builtin_amdgcn_mfma_f32_32x32x16_bf16(b0, qr[d0], p0, 0, 0, 0);
    p1 = __builtin_amdgcn_mfma_f32_32x32x16_bf16(b1, qr[d0], p1, 0, 0, 0); }
#pragma unroll
  for (int d0 = 0; d0 < 4; ++d0) { const int cb = (d0 * 16 + hi * 8) * 2;
    const bf16x8 b0 = *reinterpret_cast<const bf16x8*>(KRs + KRSWZ(r32, cb));
    const bf16x8 b1 = *reinterpret_cast<const bf16x8*>(KRs + KRSWZ(32 + r32, cb));
    p0 = __builtin_amdgcn_mfma_f32_32x32x16_bf16(b0, qr[8 + d0], p0, 0, 0, 0);
    p1 = __builtin_amdgcn_mfma_f32_32x32x16_bf16(b1, qr[8 + d0], p1, 0, 0, 0); }
}
DI int v_st(int k, int c) { const int kk = (k & ~0xC) | ((k & 4) << 1) | ((k & 8) >> 1); return ((kk >> 3) * 4 + (c >> 5)) * 512 + ((kk & 7) * 32 + (c & 31)) * 2; }
DI int v_rd_base(int lane) { return ((lane & 3) << 3) | (((lane >> 2) & 3) << 6) | (((lane >> 4) & 1) << 5) | (((lane >> 5) & 1) << 8); }
constexpr int v_rd_off(int d0, int ks, int half) { return d0 * 512 + ks * 4096 + half * 2048; }
template <int OFF> DI s16x4 tr_read(int vb) { s16x4 r; asm volatile("ds_read_b64_tr_b16 %0, %1 offset:%2" : "=&v"(r) : "v"(vb), "i"(OFF) : "memory"); return r; }
template <int D0> DI void pv_one(f32x16& od, int vb, bf16x8 pa0, bf16x8 pa1, bf16x8 pa2, bf16x8 pa3) {
  const s16x4 l0 = tr_read<v_rd_off(D0, 0, 0)>(vb), h0 = tr_read<v_rd_off(D0, 0, 1)>(vb), l1 = tr_read<v_rd_off(D0, 1, 0)>(vb), h1 = tr_read<v_rd_off(D0, 1, 1)>(vb);
  const s16x4 l2 = tr_read<v_rd_off(D0, 2, 0)>(vb), h2 = tr_read<v_rd_off(D0, 2, 1)>(vb), l3 = tr_read<v_rd_off(D0, 3, 0)>(vb), h3 = tr_read<v_rd_off(D0, 3, 1)>(vb);
  asm volatile("s_waitcnt lgkmcnt(0)" ::: "memory"); SBAR();
#define PK(L, H) (bf16x8){L[0], L[1], L[2], L[3], H[0], H[1], H[2], H[3]}
  od = __builtin_amdgcn_mfma_f32_32x32x16_bf16(pa0, PK(l0, h0), od, 0, 0, 0);
  od = __builtin_amdgcn_mfma_f32_32x32x16_bf16(pa1, PK(l1, h1), od, 0, 0, 0);
  od = __builtin_amdgcn_mfma_f32_32x32x16_bf16(pa2, PK(l2, h2), od, 0, 0, 0);
  od = __builtin_amdgcn_mfma_f32_32x32x16_bf16(pa3, PK(l3, h3), od, 0, 0, 0);
#undef PK
}
DI void pv_d0(f32x16* o, int vb, bf16x8 pa0, bf16x8 pa1, bf16x8 pa2, bf16x8 pa3) {
  pv_one<0>(o[0], vb, pa0, pa1, pa2, pa3); pv_one<1>(o[1], vb, pa0, pa1, pa2, pa3); pv_one<2>(o[2], vb, pa0, pa1, pa2, pa3); pv_one<3>(o[3], vb, pa0, pa1, pa2, pa3);
}

DI void attn_body(const bf16_t* __restrict__ Qb, const bf16_t* __restrict__ Kh, const bf16_t* __restrict__ Vh, const bf16_t* __restrict__ KRh, bf16_t* __restrict__ Ob, int seq, int tpos0, char* lds) {
  const int tid = ltid(), wid = tid >> 6, lane = tid & 63, r32 = lane & 31, hi = lane >> 5;
  char* V_lds = lds; char* K_lds = lds + 2 * SHM_V; char* KR_lds = lds + 2 * SHM_V + 2 * SHM_K;
  float* ws = (float*)(lds + 2 * SHM_V + 2 * SHM_K + 2 * SHM_KR) + wid * 64; float* li_l = ws; float* al_l = ws + 32;
  float m_reg = -1e30f, l_reg = 0; f32x16 o[4] = {}; bf16x8 qr[12];
  const bf16_t* Qw = Qb + (long)(wid * QBLK + r32) * LDQ + hi * 8;
#pragma unroll
  for (int d0 = 0; d0 < 12; ++d0) qr[d0] = *reinterpret_cast<const bf16x8*>(Qw + d0 * 16);
  if (tpos0 >= 0) {
    const int t = tpos0 + wid * QBLK + r32;
#pragma unroll
    for (int hf = 0; hf < 2; ++hf) { const float pos = (float)(hf ? (t & 63) : (t >> 6));
#pragma unroll
      for (int j = 0; j < 8; ++j) { const float ang = pos * exp2f(-(float)(hi * 8 + j) * (13.287712379549449f / 16.f)); float sv, cv; sincosf(ang, &sv, &cv);
        const float x1 = bf2f((bf16_t)qr[8 + 2 * hf][j]), x2 = bf2f((bf16_t)qr[9 + 2 * hf][j]);
        qr[8 + 2 * hf][j] = (short)f2bf(x1 * cv - x2 * sv); qr[9 + 2 * hf][j] = (short)f2bf(x2 * cv + x1 * sv); } }
  }
  const int sr = tid >> 4, sc = (tid & 15) * 8, vst0 = v_st(sr, sc), vst1 = v_st(32 + sr, sc);
  const int krr = tid >> 3, krc = (tid & 7) * 8;
  const int vb0 = (int)(uintptr_t)V_lds + v_rd_base(lane);
  bf16x8 vs0, vs1, ks0, ks1, kr0;
#define SLOAD(k0) do { vs0 = *reinterpret_cast<const bf16x8*>(&Vh[(long)((k0) + sr) * LDK + sc]); vs1 = *reinterpret_cast<const bf16x8*>(&Vh[(long)((k0) + 32 + sr) * LDK + sc]); \
    ks0 = *reinterpret_cast<const bf16x8*>(&Kh[(long)((k0) + sr) * LDK + sc]); ks1 = *reinterpret_cast<const bf16x8*>(&Kh[(long)((k0) + 32 + sr) * LDK + sc]); \
    kr0 = *reinterpret_cast<const bf16x8*>(&KRh[(long)((k0) + krr) * LDKR + krc]); } while (0)
#define SWRITE(b) do { *(bf16x8*)(V_lds + (b) * SHM_V + vst0) = vs0; *(bf16x8*)(V_lds + (b) * SHM_V + vst1) = vs1; const int kc = sc * 2;               \
    *(bf16x8*)(K_lds + (b) * SHM_K + KSWZ(sr, kc)) = ks0; *(bf16x8*)(K_lds + (b) * SHM_K + KSWZ(32 + sr, kc)) = ks1;                       \
    *(bf16x8*)(KR_lds + (b) * SHM_KR + KRSWZ(krr, krc * 2)) = kr0; } while (0)
#define SWAIT() asm volatile("s_waitcnt vmcnt(0)" ::: "memory")
#define RESC(a) do { if (__any((a) < 1.f)) { if (hi == 0) al_l[r32] = (a); asm volatile("s_waitcnt lgkmcnt(0)" ::: "memory"); \
    _Pragma("unroll") for (int d = 0; d < 4; ++d) _Pragma("unroll") for (int r = 0; r < 16; ++r) o[d][r] *= al_l[crow(r, hi)]; } } while (0)
  f32x16 p0, p1; float mn, al; bf16x8 pa0, pa1, pa2, pa3; const int NT = seq / KVBLK;
  SLOAD(0); SWAIT(); SWRITE(0); __syncthreads();
  for (int j = 0; j < NT; ++j) {
    const int buf = j & 1; const bool more = j + 1 < NT;
    if (more) SLOAD((j + 1) * KVBLK);
    SBAR(); qkt(p0, p1, K_lds + buf * SHM_K, KR_lds + buf * SHM_KR, qr, r32, hi);
    partialSM(p0, p1, m_reg, mn, al); RESC(al);
    finishSM(p0, p1, al, l_reg, pa0, pa1, pa2, pa3); SBAR();
    pv_d0(o, vb0 + buf * SHM_V, pa0, pa1, pa2, pa3);
    if (more) { SWAIT(); SWRITE(buf ^ 1); }
    __syncthreads();
  }
  if (hi == 0) li_l[r32] = l_reg; asm volatile("s_waitcnt lgkmcnt(0)" ::: "memory");
  float rli[16];
#pragma unroll
  for (int r = 0; r < 16; ++r) rli[r] = __builtin_amdgcn_rcpf(li_l[crow(r, hi)]);
  bf16_t* Ow = Ob + (long)(wid * QBLK) * LDO;
#pragma unroll
  for (int r = 0; r < 16; ++r) { const int orow = crow(r, hi);
#pragma unroll
    for (int d0 = 0; d0 < 4; ++d0) Ow[(long)orow * LDO + d0 * 32 + r32] = f2bf(o[d0][r] * rli[r]); }
  __syncthreads();
#undef SLOAD
#undef SWRITE
#undef SWAIT
#undef RESC
}
}

DI void st_attn(const Prm& p, int layer, char* lds, int bid, int nb) {
  const int nlat = NB * 4 * 16, nitem = nlat + (layer == 0 ? NB * 4 : 0);
  for (int it = bid; it < nitem; it += nb) {
    if (it < nlat) { const int b = it >> 6, h = (it >> 4) & 3, qb = it & 15; const size_t r0 = (size_t)b * LT;
      att::attn_body(p.Qraw + (r0 + qb * 256) * 768 + h * 192, p.KV + r0 * 1024 + h * 256, p.KV + r0 * 1024 + h * 256 + 128, p.KR + r0 * 64,
                     p.Y + (r0 + qb * 256) * DM + 1024 + h * 128, LT, qb * 256, lds); }
    else { const int k = it - nlat, b = k >> 2, h = k & 3; const size_t r0 = (size_t)b * LT + LL;
      att::attn_body(p.Qraw + r0 * 768 + h * 192, p.KV + r0 * 1024 + h * 256, p.KV + r0 * 1024 + h * 256 + 128, p.KR + r0 * 64, p.Y + r0 * DM + 1024 + h * 128, LCX, -1, lds); }
  }
}

struct EpiResid {
  static constexpr bool PERM = false, AFTER_DRAIN = false;
  const float* xlat; const float* xctx; float* X; const float* modl; int first;
  __device__ __forceinline__ void operator()(const pg8::f32x4 (&acc)[2][2][4][2], const pg8::Unit& u, int wr, int wc, int fr, int fq) const {
    const int b = u.pm / 17, tl = u.pm - b * 17; const bool isc = tl == 16;
    const float* g = modl + (size_t)(isc ? 8 : b) * NMOD + 2 * DM;
    const int rloc0 = wr * 64 + fr, col0 = u.pn * 256 + wc * 32 + 4 * fq;
    pg8::f32x4 gv[2][2];
#pragma unroll
    for (int bj = 0; bj < 2; ++bj)
#pragma unroll
      for (int n = 0; n < 2; ++n) gv[bj][n] = *(const pg8::f32x4*)(g + col0 + bj * 128 + n * 16);
#pragma unroll
    for (int ai = 0; ai < 2; ++ai)
#pragma unroll
      for (int m = 0; m < 4; ++m) { const int rl = rloc0 + ai * 128 + m * 16; const size_t row = (size_t)u.pm * 256 + rl;
        const float* src = first ? (isc ? xctx + ((size_t)b * LCX + rl) * DM : xlat + ((size_t)b * LL + tl * 256 + rl) * DM) : X + row * DM;
        float* dst = X + row * DM;
#pragma unroll
        for (int bj = 0; bj < 2; ++bj)
#pragma unroll
          for (int n = 0; n < 2; ++n) { const int c = col0 + bj * 128 + n * 16; *(pg8::f32x4*)(dst + c) = *(const pg8::f32x4*)(src + c) + gv[bj][n] * acc[ai][bj][m][n]; } }
  }
};

struct LatentOrder : pg8::StaticOrder {
  __device__ bool next(int i, pg8::Unit& u) const { const bool ok = pg8::StaticOrder::next(i, u); u.pm += u.pm >> 4; return ok; }
};
template <class Epi> DI void run_gemm_lat(unsigned char* lds, const bf16_t* A, const bf16_t* Bt, int N, int K, const Epi& E, int bid, int nb) {
  pg8::Gemm g; g.A = A; g.Bt = Bt; g.M = NB * LL; g.N = N; g.K = K;
  LatentOrder S; S.init(NB * LL, N, nb, bid);
  pg8::gemm_phase<Epi, LatentOrder, false>((PG8_LAS unsigned char*)lds, g, S, E, nullptr);
}
template <class Epi> DI void run_gemm(unsigned char* lds, const bf16_t* A, const bf16_t* Bt, int M, int N, int K, const Epi& E, int bid, int nb) {
  pg8::Gemm g; g.A = A; g.Bt = Bt; g.M = M; g.N = N; g.K = K;
  pg8::StaticOrder S; S.init(M, N, nb, bid);
  pg8::gemm_phase<Epi, pg8::StaticOrder, false>((PG8_LAS unsigned char*)lds, g, S, E, nullptr);
}
DI pg8::EpiBf16<0> epi_bf16(bf16_t* O, int ldc, int split_cols = 0, size_t split_stride = 0) { pg8::EpiBf16<0> e; e.O = O; e.ldc = ldc; e.bias = nullptr; e.split_cols = split_cols; e.split_stride = split_stride; return e; }

#ifndef PROBE
#define PROBE 0
#endif
constexpr int LDS_MAIN = 131072 + 4096, LDS_TOTAL = LDS_MAIN + 64;
#define PRM() (*(const __attribute__((address_space(4))) Prm*)launder_k(kp))
typedef const __attribute__((address_space(4))) void* kptr_t;
DI kptr_t launder_k(kptr_t q) { asm volatile("" : "+s"(q)); return q; }
extern __shared__ __attribute__((aligned(16))) unsigned char shm[];
__global__ void __launch_bounds__(NTHR, 2) mega(Prm p_unused) {
#if defined(__HIP_DEVICE_COMPILE__)
  kptr_t kp = (kptr_t)__builtin_amdgcn_kernarg_segment_ptr();
  const int bid0 = blockIdx.x, nb0 = gridDim.x;
#define bid lsg(bid0)
#define nb lsg(nb0)
  uint4* xbw = (uint4*)(shm + LDS_MAIN);
  if (threadIdx.x == 0) *xbw = make_uint4(0u, 0u, 0u, 0u);
  __syncthreads();
  { const Prm p = PRM(); (void)xcd_barrier_post(p.bar, (volatile LAS unsigned*)xbw); }
#define GRID_BAR() do { XcdBarrier b_; b_.bar = PRM().bar; b_.x = xb_xcc_id(); b_.st = (volatile LAS unsigned*)(shm + LDS_MAIN); xcd_barrier(b_); } while (0)
  float* lf = (float*)shm;
  for (int ly = 0; ly < 2; ++ly) { const Prm p = PRM();
    st_transpose(p.w_in + (size_t)ly * DM * IN_W, p.WinT + (size_t)ly * NZ * DM, DM, IN_W, DM, NZ, lf, bid, nb);
    st_transpose(p.w_out + (size_t)ly * DM * DM, p.WoutT + (size_t)ly * DM * DM, DM, DM, DM, DM, lf, bid, nb);
    st_transpose(p.peer_wq + (size_t)ly * DM * DM, p.WqT + (size_t)ly * DM * DM, DM, DM, DM, DM, lf, bid, nb);
    st_transpose(p.mla_w_uq + (size_t)ly * 448 * 768, p.WuqT + (size_t)ly * 768 * 512, 448, 768, 512, 768, lf, bid, nb);
    st_transpose(p.mla_w_ukv + (size_t)ly * 128 * 1024, p.WukvT + (size_t)ly * 1024 * 256, 128, 1024, 256, 1024, lf, bid, nb);
  }
  { const Prm p = PRM(); st_tables(p, bid, nb); }
  __syncthreads();
  { const Prm p = PRM(); st_mods(p, lf, bid, nb); }
  if (PROBE == 5) { __syncthreads();
    for (int ly = 0; ly < 2; ++ly) { const Prm p = PRM();
      st_transpose(p.w_in + (size_t)ly * DM * IN_W, p.WinT + (size_t)ly * NZ * DM, DM, IN_W, DM, NZ, lf, bid, nb);
      st_transpose(p.w_out + (size_t)ly * DM * DM, p.WoutT + (size_t)ly * DM * DM, DM, DM, DM, DM, lf, bid, nb);
      st_transpose(p.peer_wq + (size_t)ly * DM * DM, p.WqT + (size_t)ly * DM * DM, DM, DM, DM, DM, lf, bid, nb); }
    { const Prm p = PRM(); st_tables(p, bid, nb); }
    __syncthreads();
    { const Prm p = PRM(); st_mods(p, lf, bid, nb); } }
  GRID_BAR();
  for (int l = 0; l < 2; ++l) {
    if (l == 0) { { const Prm p = PRM(); st_modulate(p, l, 0, p.H, bid, nb); } GRID_BAR(); }
    { const Prm p = PRM(); run_gemm(shm, p.H, p.WinT + (size_t)l * NZ * DM, MR, NZ, DM, epi_bf16(p.Z, NZ), bid, nb); }
    if (PROBE == 6) { const Prm p = PRM(); run_gemm(shm, p.H, p.WinT + (size_t)l * NZ * DM, MR, NZ, DM, epi_bf16(p.Z, NZ), bid, nb); }
    GRID_BAR();
    { const Prm p = PRM(); st_dnprep(p, l, bid, nb); }
    { const Prm p = PRM(); st_mlaprep(p, l, bid, nb); }
    { const Prm p = PRM(); st_fnchan(p, shm, bid, nb); }
    GRID_BAR();
    { const Prm p = PRM(); st_dntinv(p, shm, bid, nb); }
    if (PROBE == 9) { { const Prm p = PRM(); st_dnprep(p, l, bid, nb); } { const Prm p = PRM(); st_mlaprep(p, l, bid, nb); } }
    if (PROBE == 10) { const Prm p = PRM(); st_fnchan(p, shm, bid, nb); }
    GRID_BAR();
    { const Prm p = PRM(); run_gemm(shm, p.Aq, p.WuqT + (size_t)l * 768 * 512, MR, 768, 512, epi_bf16(p.Qraw, 768), bid, nb); }
    { const Prm p = PRM(); run_gemm(shm, p.Akv, p.WukvT + (size_t)l * 1024 * 256, MR, 1024, 256, epi_bf16(p.KV, 1024), bid, nb); }
    if (bid < 128) { const Prm p = PRM(); st_dnscan(p, shm, bid, 128); }
    else { const Prm p = PRM(); st_glascan(p, l, shm, bid - 128, 128); }
    if (PROBE == 7) { GRID_BAR(); if (bid < 128) { const Prm p = PRM(); st_dnscan(p, shm, bid, 128); } }
    if (PROBE == 8) { GRID_BAR(); if (bid < 128) { const Prm p = PRM(); st_glascan(p, l, shm, bid, 128); } }
    if (PROBE == 2) { GRID_BAR(); if (bid < 128) { const Prm p = PRM(); st_dnscan(p, shm, bid, 128); } else { const Prm p = PRM(); st_glascan(p, l, shm, bid - 128, 128); } }
    GRID_BAR();
    { const Prm p = PRM(); st_attn(p, l, (char*)shm, bid, nb); }
    if (PROBE == 3) { const Prm p = PRM(); st_attn(p, l, (char*)shm, bid, nb); }
    { const Prm p = PRM(); run_gemm(shm, p.DFTM, p.PQT, 4096, 4096, 8192, epi_bf16(p.Y + 1536, DM, 512, (size_t)LT * DM), bid, nb); }
    if (l == 0) { const Prm p = PRM(); run_gemm(shm, p.DFTC, p.PQTc, 256, 4096, 512, epi_bf16(p.Y + (size_t)LL * DM + 1536, DM, 512, (size_t)LT * DM), bid, nb); }
    { const Prm p = PRM(); st_combine(p, l, bid, nb); }
    GRID_BAR();
    { const Prm p = PRM(); EpiResid e; e.xlat = p.x; e.xctx = p.ctx; e.X = p.X; e.modl = p.mod + (size_t)l * 9 * NMOD; e.first = l == 0;
      if (l == 0) run_gemm(shm, p.Y, p.WoutT + (size_t)l * DM * DM, MR, DM, DM, e, bid, nb);
      else run_gemm_lat(shm, p.Y, p.WoutT + (size_t)l * DM * DM, DM, DM, e, bid, nb); }
    GRID_BAR();
    { const Prm p = PRM(); st_modulate(p, l, 1, p.H2, bid, nb); }
    { const Prm p = PRM(); st_cvt_tables(p, l, bid, nb); }
    GRID_BAR();
    if (l == 0) { const Prm p = PRM(); run_gemm(shm, p.H2, p.WqT + (size_t)l * DM * DM, MR, DM, DM, epi_bf16(p.Qp, DM), bid, nb); }
    else { const Prm p = PRM(); run_gemm_lat(shm, p.H2, p.WqT + (size_t)l * DM * DM, DM, DM, epi_bf16(p.Qp, DM), bid, nb); }
    GRID_BAR();
    { const Prm p = PRM(); st_peertopk(p, l, shm, bid, nb); }
    if (PROBE == 4) { __syncthreads(); const Prm p = PRM(); st_peertopk(p, l, shm, bid, nb); }
    GRID_BAR();
    { const Prm p = PRM(); st_peergather(p, l, lf, bid, nb); }
    if (PROBE == 1) { __syncthreads(); const Prm p = PRM(); st_peergather(p, l, lf, bid, nb, true); }
    if (l == 0) GRID_BAR();
  }
#endif
#undef bid
#undef nb
#undef GRID_BAR
}

static size_t al256(size_t x) { return (x + 255) / 256 * 256; }
extern "C" void kernel_launch(void* const* d_in, const int* in_sizes, int n_in, void* d_out, int out_size, void* d_ws, size_t ws_size, hipStream_t stream) {
  Prm p{};
  const float** f = (const float**)&p.x;
  for (int i = 0; i < 24; ++i) f[i] = (const float*)d_in[i];
  p.out = (float*)d_out;
  char* w = (char*)d_ws; size_t o = 0;
  auto take = [&](size_t bytes) { char* r = w + o; o += al256(bytes); return r; };
  p.bar = (unsigned*)take(16384);
  p.WinT = (bf16_t*)take((size_t)2 * NZ * DM * 2); p.WoutT = (bf16_t*)take((size_t)2 * DM * DM * 2); p.WqT = (bf16_t*)take((size_t)2 * DM * DM * 2);
  p.WuqT = (bf16_t*)take((size_t)2 * 768 * 512 * 2); p.WukvT = (bf16_t*)take((size_t)2 * 1024 * 256 * 2);
  p.mod = (float*)take((size_t)2 * 9 * NMOD * 4); p.GB = (float*)take((size_t)MR * 16 * 4); p.CCS = (float*)take((size_t)2 * 128 * 128 * 4);
  p.DFTM = (bf16_t*)take((size_t)4096 * 8192 * 2); p.DFTC = (bf16_t*)take((size_t)256 * 512 * 2);
  p.X = (float*)take((size_t)MR * DM * 4);
  p.Z = (bf16_t*)take((size_t)MR * NZ * 2);
  char* ra = take((size_t)MR * 1536 * 2 + (size_t)4 * MR * 512 * 2);
  p.DNQ = (bf16_t*)ra; p.OB = (bf16_t*)(ra + (size_t)MR * 1536 * 2); p.H = (bf16_t*)ra;
  p.Ub = (bf16_t*)(ra + (size_t)MR * DM * 2); p.Vb = (bf16_t*)(ra + (size_t)MR * DM * 2 + (size_t)16384 * DM);
  p.KV = (bf16_t*)take((size_t)MR * 1024 * 2); p.KR = (bf16_t*)take((size_t)MR * 64 * 2);
  p.Aq = (bf16_t*)take((size_t)MR * 512 * 2); p.Akv = (bf16_t*)take((size_t)MR * 256 * 2);
  if (o > ws_size) return;
  char* q = (char*)d_out; size_t oo = 0;
  p.Y = (bf16_t*)q; oo += (size_t)MR * DM * 2; p.PQT = (bf16_t*)(q + oo); oo += (size_t)8 * 512 * 8192 * 2; p.PQTc = (bf16_t*)(q + oo); oo += (size_t)8 * 512 * 512 * 2;
  p.Qraw = (bf16_t*)(q + oo); oo += (size_t)MR * 768 * 2;
  p.TINV = (bf16_t*)q; p.GCB = (float*)(q + (size_t)4352 * 4096 * 2);
  char* z = (char*)p.Z; p.H2 = (bf16_t*)z; p.Qp = (bf16_t*)(z + (size_t)MR * DM * 2); p.IDX = (int*)(z + (size_t)2 * MR * DM * 2); p.GATE = (float*)(z + (size_t)2 * MR * DM * 2 + (size_t)MR * 128 * 4);

  static int grid = 0;
  if (!grid) {
    (void)hipFuncSetAttribute((const void*)mega, hipFuncAttributeMaxDynamicSharedMemorySize, LDS_TOTAL);
    int dev = 0, cus = 0, per_cu = 0;
    (void)hipGetDevice(&dev); (void)hipDeviceGetAttribute(&cus, hipDeviceAttributeMultiprocessorCount, dev);
    (void)hipOccupancyMaxActiveBlocksPerMultiprocessor(&per_cu, (const void*)mega, NTHR, LDS_TOTAL);
    grid = per_cu >= 1 ? cus : 0;
    if (grid > 256) grid = 256;
  }
  if (grid < 256) return;
  (void)hipMemsetAsync(p.bar, 0, XCD_BAR_WORDS * sizeof(unsigned), stream);
  hipLaunchKernelGGL(mega, dim3(grid), dim3(NTHR), LDS_TOTAL, stream, p);
}
```

```cpp
#include <hip/hip_runtime.h>
#include <stdint.h>

constexpr int DM = 2048, NB = 8, LL = 4096, LCX = 256, LT = LL + LCX  , MR = NB * LT  ;
constexpr int NZ = 4864;
constexpr int C_DNQ = 0, C_DNK = 512, C_DNV = 1024, C_DNGATE = 1536, C_DNA = 2048, C_DNB = 2056, C_GQ = 2064, C_GK = 2320, C_GV = 2576,
              C_GGATE = 3088, C_GALPHA = 3600, C_CQ = 3632, C_CKV = 4080, C_KR = 4208, C_FN = 4272, IN_W = 4784;
constexpr int NMOD = 6 * DM;
constexpr float EPSV = 1e-6f;
constexpr int NTHR = 512;

typedef unsigned short bf16_t;
typedef short bf16x8 __attribute__((ext_vector_type(8)));
typedef short s16x4 __attribute__((ext_vector_type(4)));
typedef float f32x4 __attribute__((ext_vector_type(4)));
typedef float f32x16 __attribute__((ext_vector_type(16)));
typedef unsigned u32x4 __attribute__((ext_vector_type(4)));
typedef unsigned u32x2 __attribute__((ext_vector_type(2)));

#define DI __device__ __forceinline__
DI float bf2f(bf16_t b) { return __uint_as_float(((unsigned)b) << 16); }
DI bf16_t f2bf(float f) { unsigned u = __float_as_uint(f); u += 0x7FFFu + ((u >> 16) & 1u); return (bf16_t)(u >> 16); }
DI unsigned pack2(float lo, float hi) { return (unsigned)f2bf(lo) | ((unsigned)f2bf(hi) << 16); }
typedef float f32x2 __attribute__((ext_vector_type(2)));
DI float dpp_x1(float v) { return __int_as_float(__builtin_amdgcn_mov_dpp(__float_as_int(v), 0xB1, 0xf, 0xf, true)); }
DI float dpp_x2(float v) { return __int_as_float(__builtin_amdgcn_mov_dpp(__float_as_int(v), 0x4E, 0xf, 0xf, true)); }
DI float dpp_hm(float v) { return __int_as_float(__builtin_amdgcn_mov_dpp(__float_as_int(v), 0x141, 0xf, 0xf, true)); }
DI float dpp_rm(float v) { return __int_as_float(__builtin_amdgcn_mov_dpp(__float_as_int(v), 0x140, 0xf, 0xf, true)); }
DI float red4(float v) { v += dpp_x1(v); v += dpp_x2(v); return v; }
DI float red8(float v) { v += dpp_x1(v); v += dpp_x2(v); v += dpp_hm(v); return v; }
DI float rdl(float v, int l) { return __int_as_float(__builtin_amdgcn_readlane(__float_as_int(v), l)); }
DI float wsum(float v) { v += dpp_x1(v); v += dpp_x2(v); v += dpp_hm(v); v += dpp_rm(v); return (rdl(v, 0) + rdl(v, 16)) + (rdl(v, 32) + rdl(v, 48)); }
DI float wmax(float v) { v = fmaxf(v, dpp_x1(v)); v = fmaxf(v, dpp_x2(v)); v = fmaxf(v, dpp_hm(v)); v = fmaxf(v, dpp_rm(v)); return fmaxf(fmaxf(rdl(v, 0), rdl(v, 16)), fmaxf(rdl(v, 32), rdl(v, 48))); }
DI float siluf(float x) { return x / (1.f + __expf(-x)); }
DI float sigmf(float x) { return 1.f / (1.f + __expf(-x)); }

DI int ltid() { int t = (int)threadIdx.x; asm volatile("" : "+v"(t)); return t; }
DI int lsg(int v) { asm volatile("" : "+s"(v)); return v; }

struct Prm {
  const float *x, *c, *ctx, *c_ctx, *w_ada, *b_ada, *w_in, *dn_conv, *dn_a_log, *dn_dt_bias, *dn_norm, *gla_w2, *gla_b2, *gla_norm,
      *mla_q_norm, *mla_w_uq, *mla_kv_norm, *mla_w_ukv, *w_out, *peer_wq, *peer_keys, *peer_u, *peer_v, *final_norm;
  float* out;
  bf16_t *WinT, *WoutT, *WqT, *WuqT, *WukvT;
  float *mod, *GB, *CCS;
  bf16_t *DFTM, *DFTC;
  float* X;
  bf16_t* Z;
  bf16_t *H, *DNQ, *OB;
  bf16_t *KV, *KR;
  bf16_t *Y, *PQT, *PQTc, *Qraw, *Aq, *Akv;
  bf16_t *H2, *Qp;
  bf16_t *Ub, *Vb;
  bf16_t* TINV; float* GCB; float* BC;
  int* IDX;
  float* GATE;
  unsigned* bar;
};
#define XB_TMO      128
#define XB_XCNT(j)  (256  + 64 * (j))
#define XB_XSUB(j)  (1280 + 64 * (j))
#define XB_XGEN(j)  (2304 + 64 * (j))
#define XB_TOP      3328
#define XB_TOPGEN   3392
#define XCD_BAR_WORDS 3456
#define XB_SPIN_CAP (1u << 18)
#define LAS __attribute__((address_space(3)))

__device__ __forceinline__ unsigned xb_ld(unsigned* p)              { return __hip_atomic_load(p, __ATOMIC_RELAXED, __HIP_MEMORY_SCOPE_AGENT); }
__device__ __forceinline__ unsigned xb_add(unsigned* p, unsigned v) { return __hip_atomic_fetch_add(p, v, __ATOMIC_RELAXED, __HIP_MEMORY_SCOPE_AGENT); }
__device__ __forceinline__ unsigned xb_xcc_id() { return (unsigned)__builtin_amdgcn_s_getreg((3 << 11) | 20) & 0xFu; }
#define XB_SPIN(cond, bar) do { unsigned _sp = 0; while (cond) { __builtin_amdgcn_s_sleep(1); \
    if ((++_sp & 255u) == 0u) { if (xb_ld(&(bar)[XB_TMO])) break; if (_sp > XB_SPIN_CAP) { atomicAdd(&(bar)[XB_TMO], 1u); break; } } } } while (0)

struct XcdBarrier {
    unsigned* bar; unsigned x;
    volatile LAS unsigned* st;
};

__device__ __forceinline__ XcdBarrier xcd_barrier_post(unsigned* bar, volatile LAS unsigned* st) {
    XcdBarrier b; b.bar = bar; b.x = xb_xcc_id(); b.st = st;
    if (threadIdx.x == 0) (void)xb_add(&bar[XB_XCNT(b.x)], 1u);
    return b;
}
__device__ __forceinline__ void xcd_barrier_complete(unsigned* bar, unsigned x, unsigned& nloc, unsigned& nx) {
    const unsigned G = gridDim.x * gridDim.y * gridDim.z;
    unsigned sum, cnt, mine, sp = 0u;
    for (;;) {
        sum = 0u; cnt = 0u; mine = 0u;
#pragma unroll
        for (unsigned j = 0; j < 16; ++j) { const unsigned c = xb_ld(&bar[XB_XCNT(j)]); sum += c; cnt += (c > 0u) ? 1u : 0u; mine = (j == x) ? c : mine; }
        if (sum == G) break;
        __builtin_amdgcn_s_sleep(1);
        if ((++sp & 255u) == 0u) { if (xb_ld(&bar[XB_TMO])) break; if (sp > XB_SPIN_CAP) { atomicAdd(&bar[XB_TMO], 1u); break; } }
    }
    nloc = mine > 0u ? mine : 1u; nx = cnt > 0u ? cnt : 1u;
}

__device__ __forceinline__ void xcd_barrier(const XcdBarrier& b) {
    asm volatile("s_waitcnt vmcnt(0)" ::: "memory");
    __syncthreads();
    if (threadIdx.x == 0) {
        unsigned* bar = b.bar;
        __builtin_amdgcn_s_waitcnt(0);
        unsigned nloc = b.st[0], nx = b.st[1];
        if (nloc == 0u) { xcd_barrier_complete(bar, b.x, nloc, nx); b.st[0] = nloc; b.st[1] = nx; }
        const unsigned old = xb_add(&bar[XB_XSUB(b.x)], 1u);
        const unsigned gen = old / nloc;
        if (old + 1u == (gen + 1u) * nloc) {
            __builtin_amdgcn_fence(__ATOMIC_RELEASE, "agent");
            asm volatile("s_waitcnt vmcnt(0)" ::: "memory");
            const unsigned og = xb_add(&bar[XB_TOP], 1u);
            const unsigned tg = og / nx;
            if (og + 1u == (tg + 1u) * nx) xb_add(&bar[XB_TOPGEN], 1u);
            else XB_SPIN(xb_ld(&bar[XB_TOPGEN]) == tg, bar);
            __builtin_amdgcn_fence(__ATOMIC_ACQUIRE, "agent");
            xb_add(&bar[XB_XGEN(b.x)], 1u);
            asm volatile("s_waitcnt vmcnt(0)" ::: "memory");
        } else {
            XB_SPIN(xb_ld(&bar[XB_XGEN(b.x)]) == gen, bar);
            __builtin_amdgcn_fence(__ATOMIC_ACQUIRE, "agent");
            asm volatile("s_waitcnt vmcnt(0)" ::: "memory");
        }
    }
    __syncthreads();
}

namespace pg8 {
#define PG8_LAS __attribute__((address_space(3)))
typedef unsigned short bf16_t;
typedef short bf16x8 __attribute__((ext_vector_type(8)));
typedef float f32x4 __attribute__((ext_vector_type(4)));
typedef unsigned u32x4 __attribute__((ext_vector_type(4)));
constexpr int BM = 256, BK = 64, HALF = 128, HTB = HALF * BK * 2  , STAGE_BYTES = 8 * HTB, NXCD = 8, WGM = 8;

__host__ __device__ __forceinline__ int lds_byte(int r, int c) { const int st = (r >> 4) * 2 + (c >> 5), rr = r & 15, cc = c & 31, ob = rr * 64 + cc * 2; return st * 1024 + (ob ^ (((ob >> 9) & 1) << 5)); }
__host__ __device__ __forceinline__ void stage_rc(int b, int& R, int& C) { const int st = b / 1024, sb = b % 1024, swz = sb ^ (((sb >> 9) & 1) << 5); R = (st >> 1) * 16 + swz / 64; C = (st & 1) * 32 + (swz % 64) / 2; }
__host__ __device__ __forceinline__ int perm32(int rho) { const int n = rho >> 4, i = rho & 15; return 8 * (i >> 2) + 4 * n + (i & 3); }

struct Unit { int pm, pn; };
struct Gemm { const bf16_t* A; const bf16_t* Bt; int M, N, K; };

struct StaticOrder {
    int nM, nN, nwg, G, c;
    __host__ __device__ void init(int M, int N, int G_, int c_) { nM = M / BM; nN = N / BM; nwg = nM * nN; G = G_; c = c_; }
    __host__ __device__ bool next(int i, Unit& u) const {
        const long L = (long)i * G + c; if (L >= nwg) return false;
        int wgid = (int)L; { const int q = nwg / NXCD, r = nwg % NXCD, xcd = wgid % NXCD, off = wgid / NXCD; wgid = (xcd < r ? xcd * (q + 1) : r * (q + 1) + (xcd - r) * q) + off; }
        const int nig = WGM * nN, gid = wgid / nig, fm = gid * WGM, gsz = (nM - fm) < WGM ? (nM - fm) : WGM;
        u.pm = fm + ((wgid % nig) % gsz); u.pn = (wgid % nig) / gsz; return true;
    }
    __device__ __forceinline__ void a_ready(const Unit&) const {}
    __device__ __forceinline__ void done(const Unit&) const {}
};
struct CountedOrder : StaticOrder {
    const unsigned* ready; unsigned need; unsigned* tmo;
    __device__ __forceinline__ void a_ready(const Unit& u) const {
        if (threadIdx.x < 64) {
            const unsigned long long t0 = __builtin_amdgcn_s_memrealtime(); unsigned polls = 0;
            while ((unsigned)__builtin_amdgcn_readfirstlane(__hip_atomic_load(ready + 64 * u.pm, __ATOMIC_RELAXED, __HIP_MEMORY_SCOPE_AGENT)) < need) {
                if ((++polls & 255u) == 0u && __builtin_amdgcn_readfirstlane(__hip_atomic_load(tmo, __ATOMIC_RELAXED, __HIP_MEMORY_SCOPE_AGENT)) != 0u) break;
                if (__builtin_amdgcn_s_memrealtime() - t0 > 2000000ull) {
                    if (threadIdx.x == 0) { unsigned expect = 0u; __hip_atomic_compare_exchange_strong(tmo + 1, &expect, 0x600u | (unsigned)(u.pm & 0xff), __ATOMIC_RELAXED, __ATOMIC_RELAXED, __HIP_MEMORY_SCOPE_AGENT); __hip_atomic_store(tmo, 1u, __ATOMIC_RELAXED, __HIP_MEMORY_SCOPE_AGENT); }
                    break; }
                __builtin_amdgcn_s_sleep(2); }
            __builtin_amdgcn_fence(__ATOMIC_ACQUIRE, "agent");
            asm volatile("s_waitcnt vmcnt(0)" ::: "memory");
        }
#if !defined(BROKEN_HOOK_NO_BARRIER)
        asm volatile("" ::: "memory"); __builtin_amdgcn_s_barrier(); asm volatile("" ::: "memory");
#endif
    }
};

__device__ __forceinline__ unsigned cvt_pk_bf16(float lo, float hi) { unsigned r; asm volatile("v_cvt_pk_bf16_f32 %0, %1, %2" : "=v"(r) : "v"(lo), "v"(hi)); return r; }
typedef float f32x2 __attribute__((ext_vector_type(2)));
__device__ __forceinline__ f32x2 gelu_pk(f32x2 v) {
    const f32x2 av = __builtin_elementwise_abs(v), d = av * 0.2316418882f + 1.0f;
    f32x2 t; t.x = __builtin_amdgcn_rcpf(d.x); t.y = __builtin_amdgcn_rcpf(d.y);
    f32x2 q = t * 0.5307027145f + (-0.7265760135f); q = q * t + 0.7107068705f; q = q * t + (-0.142248368f); q = q * t + 0.127414796f; q = q * t;
    const f32x2 s = (v * v) * (-0.72134752044f);
    f32x2 e; e.x = __builtin_amdgcn_exp2f(s.x); e.y = __builtin_amdgcn_exp2f(s.y);
    const f32x2 m = v * (q * e), r = v - m;
    f32x2 o; o.x = v.x < 0.f ? m.x : r.x; o.y = v.y < 0.f ? m.y : r.y; return o;
}

struct EpiF32 {
    static constexpr bool PERM = false, AFTER_DRAIN = false;
    float* C; int ldc; const float* bias;
    __device__ __forceinline__ void operator()(const f32x4 (&acc)[2][2][4][2], const Unit& u, int wr, int wc, int fr, int fq) const {
        const int row0 = u.pm * BM + wr * 64 + fr, col0 = u.pn * BM + wc * 32 + 4 * fq;
        f32x4 bv[2][2];
#pragma unroll
        for (int bj = 0; bj < 2; ++bj)
#pragma unroll
            for (int n = 0; n < 2; ++n) bv[bj][n] = bias ? *(const f32x4*)(bias + col0 + bj * HALF + n * 16) : (f32x4){0.f, 0.f, 0.f, 0.f};
#pragma unroll
        for (int ai = 0; ai < 2; ++ai)
#pragma unroll
            for (int m = 0; m < 4; ++m) { float* rowp = C + (size_t)(row0 + ai * HALF + m * 16) * ldc + col0;
#pragma unroll
                for (int bj = 0; bj < 2; ++bj)
#pragma unroll
                    for (int n = 0; n < 2; ++n) *(f32x4*)(rowp + bj * HALF + n * 16) = acc[ai][bj][m][n] + bv[bj][n]; }
    }
};
template <int ACT  > struct EpiBf16 {
    static constexpr bool PERM = true, AFTER_DRAIN = false;
    bf16_t* O; int ldc; const float* bias; int split_cols; size_t split_stride;
    __device__ __forceinline__ void operator()(const f32x4 (&acc)[2][2][4][2], const Unit& u, int wr, int wc, int fr, int fq) const {
        const int row0 = u.pm * BM + wr * 64 + fr; int colt = u.pn * BM; bf16_t* base = O;
        if (split_cols) { const int t = colt / split_cols; base += (size_t)t * split_stride; colt -= t * split_cols; }
        const int col0 = colt + wc * 32 + 8 * fq, bcol0 = u.pn * BM + wc * 32 + 8 * fq;
        f32x4 bv[2][2];
#pragma unroll
        for (int bj = 0; bj < 2; ++bj)
#pragma unroll
            for (int n = 0; n < 2; ++n) bv[bj][n] = bias ? *(const f32x4*)(bias + bcol0 + bj * HALF + 4 * n) : (f32x4){0.f, 0.f, 0.f, 0.f};
#pragma unroll
        for (int ai = 0; ai < 2; ++ai)
#pragma unroll
            for (int m = 0; m < 4; ++m) { bf16_t* rowp = base + (size_t)(row0 + ai * HALF + m * 16) * ldc + col0;
#pragma unroll
                for (int bj = 0; bj < 2; ++bj) { f32x4 v0 = acc[ai][bj][m][0] + bv[bj][0], v1 = acc[ai][bj][m][1] + bv[bj][1];
                    if (ACT == 1) { f32x2 a = gelu_pk((f32x2){v0[0], v0[1]}), b = gelu_pk((f32x2){v0[2], v0[3]}), c = gelu_pk((f32x2){v1[0], v1[1]}), d = gelu_pk((f32x2){v1[2], v1[3]});
                        v0 = (f32x4){a.x, a.y, b.x, b.y}; v1 = (f32x4){c.x, c.y, d.x, d.y}; }
                    if (ACT == 2) {
#pragma unroll
                        for (int j = 0; j < 4; ++j) { v0[j] = 0.5f * v0[j] * (1.0f + erff(v0[j] * 0.70710678f)); v1[j] = 0.5f * v1[j] * (1.0f + erff(v1[j] * 0.70710678f)); } }
                    u32x4 w; w.x = cvt_pk_bf16(v0[0], v0[1]); w.y = cvt_pk_bf16(v0[2], v0[3]); w.z = cvt_pk_bf16(v1[0], v1[1]); w.w = cvt_pk_bf16(v1[2], v1[3]);
                    *(u32x4*)(rowp + bj * HALF) = w; } }
    }
};
template <class Epi, class Sched, bool STAMP = false>
__device__ __forceinline__ void gemm_phase(PG8_LAS unsigned char* lds, const Gemm g, const Sched& S, const Epi& E, unsigned long long* stamps) {
    const int tid = ltid(), wid = __builtin_amdgcn_readfirstlane(tid >> 6), lane = tid & 63, wr = wid >> 2, wc = wid & 3, fr = lane & 15, fq = lane >> 4;
    const int K = g.K, nt = K / BK;
    int ts_lo = 0, ts_hi = 0, nts = 0; const unsigned long long rt_entry = STAMP ? (unsigned long long)wall_clock64() : 0ull;
#define PG8_STAMP() do { if (STAMP && wid == 0 && nts < 64) { const unsigned long long _c = (unsigned long long)clock64(); \
        ts_lo = (lane == nts) ? (int)(unsigned)_c : ts_lo; ts_hi = (lane == nts) ? (int)(unsigned)(_c >> 32) : ts_hi; ++nts; } } while (0)
    PG8_STAMP();
    unsigned voffA[2], voffB[2];
#pragma unroll
    for (int i = 0; i < 2; ++i) { int R, C; stage_rc(tid * 16 + i * 8192, R, C); const int Rb = Epi::PERM ? ((R & ~31) + perm32(R & 31)) : R;
        voffA[i] = (unsigned)(R * K + C) * 2u; voffB[i] = (unsigned)(Rb * K + C) * 2u; }
    const size_t kstep = (size_t)(BK * 2);
    const size_t hstep = (size_t)HALF * K * 2;
    const size_t tstep = 2 * hstep;
    const unsigned ldsw = (unsigned)wid * 1024u;
    const int aoff = lds_byte(wr * 64 + fr, fq * 8), boff = lds_byte(wc * 32 + fr, fq * 8);
#define PG8_SA(b, h) (((b) * 2 + (h)) * HTB)
#define PG8_SB(b, h) ((4 + (b) * 2 + (h)) * HTB)
#define PG8_STAGE(bufoff, gbase, voff) do { _Pragma("unroll") for (int _i = 0; _i < 2; ++_i) \
        __builtin_amdgcn_global_load_lds((const unsigned*)((const char*)(gbase) + (voff)[_i]), (PG8_LAS unsigned*)(lds + (bufoff) + ldsw + _i * 8192), 16, 0, 0); } while (0)
#define PG8_LDA(dst, b, h) do { _Pragma("unroll") for (int m = 0; m < 4; ++m) _Pragma("unroll") for (int k = 0; k < 2; ++k) dst[m][k] = *(const PG8_LAS bf16x8*)(lds + PG8_SA(b, h) + aoff + m * 2048 + k * 1024); } while (0)
#define PG8_LDB(dst, b, h) do { _Pragma("unroll") for (int n = 0; n < 2; ++n) _Pragma("unroll") for (int k = 0; k < 2; ++k) dst[n][k] = *(const PG8_LAS bf16x8*)(lds + PG8_SB(b, h) + boff + n * 2048 + k * 1024); } while (0)
#define PG8_MMA(ai, bj, At, Bt) do { __builtin_amdgcn_s_setprio(1); _Pragma("unroll") for (int m = 0; m < 4; ++m) _Pragma("unroll") for (int n = 0; n < 2; ++n) _Pragma("unroll") for (int k = 0; k < 2; ++k) \
        acc[ai][bj][m][n] = __builtin_amdgcn_mfma_f32_16x16x32_bf16(Bt[n][k], At[m][k], acc[ai][bj][m][n], 0, 0, 0); __builtin_amdgcn_s_setprio(0); } while (0)
#define PG8_WAIT_V(n) asm volatile("s_waitcnt vmcnt(" #n ")" ::: "memory")
#define PG8_WAIT_L(n) asm volatile("s_waitcnt lgkmcnt(" #n ")" ::: "memory")
#define PG8_BAR __builtin_amdgcn_s_barrier()
#define PG8_SCHED __builtin_amdgcn_sched_barrier(0)
    Unit cur, nxt; int ui = 0;
    if (!S.next(0, cur)) return;
    f32x4 acc[2][2][4][2];
#pragma unroll
    for (int a = 0; a < 2; ++a)
#pragma unroll
        for (int b = 0; b < 2; ++b)
#pragma unroll
            for (int m = 0; m < 4; ++m)
#pragma unroll
                for (int n = 0; n < 2; ++n) acc[a][b][m][n] = (f32x4){0.f, 0.f, 0.f, 0.f};
    bf16x8 At[4][2], B0[2][2], B1[2][2];
    const char* cA = (const char*)g.A + (size_t)cur.pm * tstep; const char* cB = (const char*)g.Bt + (size_t)cur.pn * tstep;
    S.a_ready(cur);
    PG8_STAGE(PG8_SB(0, 0), cB, voffB); PG8_STAGE(PG8_SA(0, 0), cA, voffA); PG8_STAGE(PG8_SB(0, 1), cB + hstep, voffB); PG8_STAGE(PG8_SA(0, 1), cA + hstep, voffA);
    if (wr == 1) PG8_BAR;
    PG8_WAIT_V(4); PG8_BAR;
    PG8_STAGE(PG8_SB(1, 0), cB + kstep, voffB); PG8_STAGE(PG8_SA(1, 0), cA + kstep, voffA); PG8_STAGE(PG8_SB(1, 1), cB + hstep + kstep, voffB);
    PG8_WAIT_V(6); PG8_BAR;
    PG8_STAMP();
    for (;;) {
        const bool has_next = S.next(ui + 1, nxt);
        const char* nA = has_next ? (const char*)g.A + (size_t)nxt.pm * tstep : cA; const char* nB = has_next ? (const char*)g.Bt + (size_t)nxt.pn * tstep : cB;
        for (int t = 0; t < nt; t += 2) {
            const bool last = (t == nt - 2);
            const char* a1 = cA + (size_t)(t + 1) * kstep;
            const char* a2 = last ? nA : cA + (size_t)(t + 2) * kstep; const char* b2 = last ? nB : cB + (size_t)(t + 2) * kstep;
            const char* a3 = a2 + kstep; const char* b3 = b2 + kstep;
            if (last && has_next) S.a_ready(nxt);
            PG8_LDB(B0, 0, 0); PG8_SCHED; PG8_LDA(At, 0, 0); PG8_STAGE(PG8_SA(1, 1), a1 + hstep, voffA);
            PG8_WAIT_L(8); PG8_BAR; PG8_WAIT_L(0); PG8_MMA(0, 0, At, B0); PG8_BAR; PG8_SCHED;
            PG8_LDB(B1, 0, 1); PG8_STAGE(PG8_SB(0, 0), b2, voffB);
            PG8_BAR; PG8_WAIT_L(0); PG8_MMA(0, 1, At, B1); PG8_BAR;
            PG8_LDA(At, 0, 1); PG8_STAGE(PG8_SA(0, 0), a2, voffA);
            PG8_BAR; PG8_WAIT_L(0); PG8_MMA(1, 0, At, B0); PG8_BAR; PG8_SCHED;
            PG8_STAGE(PG8_SB(0, 1), b2 + hstep, voffB);
            PG8_WAIT_V(6); PG8_BAR; PG8_MMA(1, 1, At, B1); PG8_BAR;
            PG8_LDB(B0, 1, 0); PG8_SCHED; PG8_LDA(At, 1, 0); PG8_STAGE(PG8_SA(0, 1), a2 + hstep, voffA);
            PG8_WAIT_L(8); PG8_BAR; PG8_WAIT_L(0); PG8_MMA(0, 0, At, B0); PG8_BAR; PG8_SCHED;
            PG8_LDB(B1, 1, 1); PG8_STAGE(PG8_SB(1, 0), b3, voffB);
            PG8_BAR; PG8_WAIT_L(0); PG8_MMA(0, 1, At, B1); PG8_BAR;
            PG8_LDA(At, 1, 1); PG8_STAGE(PG8_SA(1, 0), a3, voffA);
            PG8_BAR; PG8_WAIT_L(0); PG8_MMA(1, 0, At, B0); PG8_BAR; PG8_SCHED;
            PG8_STAGE(PG8_SB(1, 1), b3 + hstep, voffB);
            PG8_WAIT_V(6); PG8_BAR; PG8_MMA(1, 1, At, B1); PG8_BAR;
        }
        PG8_STAMP();
        if constexpr (!Epi::AFTER_DRAIN) { E(acc, cur, wr, wc, fr, fq); S.done(cur); }
        PG8_STAMP();
        if (!has_next) break;
#pragma unroll
        for (int a = 0; a < 2; ++a)
#pragma unroll
            for (int b = 0; b < 2; ++b)
#pragma unroll
                for (int m = 0; m < 4; ++m)
#pragma unroll
                    for (int n = 0; n < 2; ++n) acc[a][b][m][n] = (f32x4){0.f, 0.f, 0.f, 0.f};
        cur = nxt; cA = nA; cB = nB; ++ui;
    }
    PG8_WAIT_V(0);
    if (wr == 0) PG8_BAR;
    PG8_BAR;
    if constexpr (Epi::AFTER_DRAIN) { E.fused(acc, cur, wr, wc, fr, fq, lds, wid, lane); S.done(cur); }
    PG8_STAMP();
    if (STAMP && wid == 0) { stamps[lane] = lane < nts ? (((unsigned long long)(unsigned)ts_hi << 32) | (unsigned)ts_lo) : 0ull;
        if (lane == 62) stamps[62] = rt_entry; if (lane == 63) stamps[63] = (unsigned long long)wall_clock64(); }
#undef PG8_STAMP
#undef PG8_SA
#undef PG8_SB
#undef PG8_STAGE
#undef PG8_LDA
#undef PG8_LDB
#undef PG8_MMA
#undef PG8_WAIT_V
#undef PG8_WAIT_L
#undef PG8_BAR
#undef PG8_SCHED
}
}

DI void st_transpose(const float* __restrict__ src, bf16_t* __restrict__ dst, int K, int N, int Kpad, int Npad, float* lds, int bid, int nb) {
  const int tk = Kpad / 64, tn = Npad / 64;
  for (int it = bid; it < tk * tn; it += nb) {
    const int k0 = (it % tk) * 64, n0 = (it / tk) * 64;
    __syncthreads();
    for (int e = ltid(); e < 4096; e += NTHR) { const int i = e >> 6, j = e & 63, k = k0 + i, n = n0 + j; lds[i * 65 + j] = (k < K && n < N) ? src[(size_t)k * N + n] : 0.f; }
    __syncthreads();
    for (int e = ltid(); e < 4096; e += NTHR) { const int j = e >> 6, i = e & 63; dst[(size_t)(n0 + j) * Kpad + k0 + i] = f2bf(lds[i * 65 + j]); }
  }
}

DI void st_mods(const Prm& p, float* lds, int bid, int nb) {
  float* s = lds; float* red = lds + 9 * 2048;
  for (int e = ltid(); e < 9 * 2048; e += NTHR) { const int r = e >> 11, k = e & 2047; const float v = r < 8 ? p.c[r * 2048 + k] : p.c_ctx[k]; s[e] = siluf(v); }
  __syncthreads();
  const int kg = ltid() >> 6, cl = ltid() & 63;
  for (int it = bid; it < 2 * 192; it += nb) {
    const int l = it / 192, cb = (it % 192) * 64;
    const float* w = p.w_ada + (size_t)l * 2048 * NMOD + cb + cl;
    float acc[9];
#pragma unroll
    for (int r = 0; r < 9; ++r) acc[r] = 0.f;
    for (int k = kg * 256; k < kg * 256 + 256; ++k) { const float wv = w[(size_t)k * NMOD];
#pragma unroll
      for (int r = 0; r < 9; ++r) acc[r] += s[r * 2048 + k] * wv; }
#pragma unroll
    for (int r = 0; r < 9; ++r) red[(kg * 9 + r) * 64 + cl] = acc[r];
    __syncthreads();
    for (int e = ltid(); e < 576; e += NTHR) { const int r = e >> 6, c2 = e & 63; float t = 0.f;
      for (int g = 0; g < 8; ++g) t += red[(g * 9 + r) * 64 + c2];
      p.mod[((size_t)l * 9 + r) * NMOD + cb + c2] = t + p.b_ada[l * NMOD + cb + c2]; }
    __syncthreads();
  }
}

DI void st_tables(const Prm& p, int bid, int nb) {
  const size_t stride = (size_t)nb * NTHR, t0 = (size_t)bid * NTHR + ltid();
  for (size_t e = t0; e < (size_t)4096 * 8192; e += stride) { const int k1 = (int)(e >> 13), n = (int)(e & 8191), n1 = n & 4095, idx = (k1 * n1) & 4095;
    float sv, cv; sincosf((float)idx * (6.283185307179586f / 4096.f), &sv, &cv); p.DFTM[e] = f2bf((n < 4096 ? cv : -sv) * (1.f / 64.f)); }
  for (size_t e = t0; e < (size_t)256 * 512; e += stride) { const int k1 = (int)(e >> 9), n = (int)(e & 511), n1 = n & 255, idx = (k1 * n1) & 255;
    float sv, cv; sincosf((float)idx * (6.283185307179586f / 256.f), &sv, &cv); p.DFTC[e] = f2bf((n < 256 ? cv : -sv) * (1.f / 16.f)); }
  for (size_t e = t0; e < (size_t)2 * 128 * 128; e += stride) { const int tb = (int)(e >> 14), k2 = (int)((e >> 7) & 127), n2 = (int)(e & 127), idx = (k2 * n2) & 127;
    float sv, cv; sincosf((float)idx * (6.283185307179586f / 128.f), &sv, &cv); p.CCS[e] = (tb ? sv : cv) * 0.08838834764831845f; }
}

DI void st_modulate(const Prm& p, int layer, int which, bf16_t* __restrict__ dst, int bid, int nb) {
  const int wave = ltid() >> 6, lane = ltid() & 63;
  const int shoff = which ? 3 * DM : 0, scoff = which ? 4 * DM : DM;
  for (int row = bid * 8 + wave; row < MR; row += nb * 8) {
    const int b = row / LT, t = row - b * LT; const bool isc = t >= LL;
    if (isc && layer == 1 && which == 1) continue;
    const float* src = (layer == 0 && which == 0) ? (isc ? p.ctx + (size_t)(b * LCX + t - LL) * DM : p.x + (size_t)(b * LL + t) * DM) : p.X + (size_t)row * DM;
    f32x4 v[8]; float ss = 0.f;
#pragma unroll
    for (int i = 0; i < 8; ++i) { v[i] = *(const f32x4*)(src + (i * 64 + lane) * 4); ss += v[i][0] * v[i][0] + v[i][1] * v[i][1] + v[i][2] * v[i][2] + v[i][3] * v[i][3]; }
    ss = wsum(ss); const float rstd = rsqrtf(ss * (1.f / 2048.f) + EPSV);
    const float* mr = p.mod + ((size_t)layer * 9 + (isc ? 8 : b)) * NMOD;
#pragma unroll
    for (int i = 0; i < 8; ++i) { const int col = (i * 64 + lane) * 4; const f32x4 sc = *(const f32x4*)(mr + scoff + col), sh = *(const f32x4*)(mr + shoff + col);
      const f32x4 o = v[i] * rstd * (sc + 1.f) + sh; u32x2 w; w.x = pack2(o[0], o[1]); w.y = pack2(o[2], o[3]); *(u32x2*)(dst + (size_t)row * DM + col) = w; }
  }
}

DI void st_dnprep(const Prm& p, int layer, int bid, int nb) {
  const int wave = ltid() >> 6, lane = ltid() & 63;
  const float* conv = p.dn_conv + (size_t)layer * 5 * 1536;
  for (int task = bid * 8 + wave; task < (MR / 32) * 13; task += nb * 8) {
    const int tile = task / 13, grp = task - tile * 13, row0 = tile * 32;
    const int b = row0 / LT, t0 = row0 - b * LT; const bool isc = t0 >= LL;
    const int segt0 = isc ? t0 - LL : t0, seglen = isc ? LCX : LL;
    if (grp < 12) {
      const int c = grp * 128 + lane * 2;
      float w0[5], w1[5];
#pragma unroll
      for (int j = 0; j < 5; ++j) { w0[j] = conv[j * 1536 + c]; w1[j] = conv[j * 1536 + c + 1]; }
      unsigned zz[36];
#pragma unroll
      for (int r = 0; r < 36; ++r) { const int tt = segt0 + r - 2; zz[r] = (tt >= 0 && tt < seglen) ? *(const unsigned*)(p.Z + (size_t)(row0 + r - 2) * NZ + c) : 0u; }
#pragma unroll
      for (int r = 0; r < 32; ++r) { float a0 = 0.f, a1 = 0.f;
#pragma unroll
        for (int j = 0; j < 5; ++j) { a0 += __uint_as_float(zz[r + j] << 16) * w0[j]; a1 += __uint_as_float(zz[r + j] & 0xffff0000u) * w1[j]; }
        a0 = siluf(a0); a1 = siluf(a1);
        if (grp < 8) { const float ss = wsum(a0 * a0 + a1 * a1); const float sc = rsqrtf(ss + EPSV) * (grp < 4 ? 0.08838834764831845f : 1.f); a0 *= sc; a1 *= sc; }
        *(unsigned*)(p.DNQ + (size_t)(row0 + r) * 1536 + c) = pack2(a0, a1); }
    } else {
#pragma unroll
      for (int rr = 0; rr < 8; ++rr) { const int idx = lane + 64 * rr, row = row0 + (idx >> 4), wh = idx & 15, isb = wh >> 3, dh = wh & 7;
        const float z = bf2f(p.Z[(size_t)row * NZ + (isb ? C_DNB : C_DNA) + dh]); float o;
        if (!isb) { const float xx = z + p.dn_dt_bias[layer * 8 + dh]; const float sp = xx > 20.f ? xx : log1pf(expf(xx)); o = -expf(p.dn_a_log[layer * 8 + dh]) * sp; }
        else o = sigmf(z);
        p.GB[(size_t)row * 16 + wh] = o; }
    }
  }
}

DI void st_mlaprep(const Prm& p, int layer, int bid, int nb) {
  const int wave = ltid() >> 6, lane = ltid() & 63;
  const float* qn = p.mla_q_norm + layer * 448; const float* kvn = p.mla_kv_norm + layer * 128;
  for (int row = bid * 8 + wave; row < MR; row += nb * 8) {
    const bf16_t* z = p.Z + (size_t)row * NZ; const int b = row / LT, t = row - b * LT;
    float v[8]; float ss = 0.f;
#pragma unroll
    for (int k = 0; k < 8; ++k) v[k] = 0.f;
    if (lane < 56) { const u32x4 w = *(const u32x4*)(z + C_CQ + lane * 8);
#pragma unroll
      for (int k = 0; k < 4; ++k) { v[2 * k] = __uint_as_float(w[k] << 16); v[2 * k + 1] = __uint_as_float(w[k] & 0xffff0000u); ss += v[2 * k] * v[2 * k] + v[2 * k + 1] * v[2 * k + 1]; } }
    ss = wsum(ss); float rstd = rsqrtf(ss * (1.f / 448.f) + EPSV);
    { u32x4 o = {0u, 0u, 0u, 0u};
      if (lane < 56) { const f32x4 n0 = *(const f32x4*)(qn + lane * 8), n1 = *(const f32x4*)(qn + lane * 8 + 4);
        o.x = pack2(v[0] * rstd * n0[0], v[1] * rstd * n0[1]); o.y = pack2(v[2] * rstd * n0[2], v[3] * rstd * n0[3]); o.z = pack2(v[4] * rstd * n1[0], v[5] * rstd * n1[1]); o.w = pack2(v[6] * rstd * n1[2], v[7] * rstd * n1[3]); }
      *(u32x4*)(p.Aq + (size_t)row * 512 + lane * 8) = o; }
    ss = 0.f;
    if (lane < 16) { const u32x4 w = *(const u32x4*)(z + C_CKV + lane * 8);
#pragma unroll
      for (int k = 0; k < 4; ++k) { v[2 * k] = __uint_as_float(w[k] << 16); v[2 * k + 1] = __uint_as_float(w[k] & 0xffff0000u); ss += v[2 * k] * v[2 * k] + v[2 * k + 1] * v[2 * k + 1]; } }
    ss = wsum(ss); rstd = rsqrtf(ss * (1.f / 128.f) + EPSV);
    if (lane < 32) { u32x4 o = {0u, 0u, 0u, 0u};
      if (lane < 16) { const f32x4 n0 = *(const f32x4*)(kvn + lane * 8), n1 = *(const f32x4*)(kvn + lane * 8 + 4);
        o.x = pack2(v[0] * rstd * n0[0], v[1] * rstd * n0[1]); o.y = pack2(v[2] * rstd * n0[2], v[3] * rstd * n0[3]); o.z = pack2(v[4] * rstd * n1[0], v[5] * rstd * n1[1]); o.w = pack2(v[6] * rstd * n1[2], v[7] * rstd * n1[3]); }
      *(u32x4*)(p.Akv + (size_t)row * 256 + lane * 8) = o; }
    if (t < LL) {
      if (lane < 32) { const int half = lane >> 4, i = lane & 15; const float x1 = bf2f(z[C_KR + half * 32 + i]), x2 = bf2f(z[C_KR + half * 32 + 16 + i]);
        const float pos = (float)(half ? (t & 63) : (t >> 6)); const float ang = pos * exp2f(-(float)i * (13.287712379549449f / 16.f)); float sv, cv; sincosf(ang, &sv, &cv);
        p.KR[(size_t)row * 64 + half * 32 + i] = f2bf(x1 * cv - x2 * sv); p.KR[(size_t)row * 64 + half * 32 + 16 + i] = f2bf(x2 * cv + x1 * sv); }
    } else p.KR[(size_t)row * 64 + lane] = z[C_KR + lane];
  }
}

DI void st_qrope(const Prm& p, int bid, int nb) {
  const int wave = ltid() >> 6, lane = ltid() & 63;
  for (int row = bid * 8 + wave; row < MR; row += nb * 8) {
    const int b = row / LT, t = row - b * LT; if (t >= LL) continue;
#pragma unroll
    for (int k = 0; k < 2; ++k) { const int pid = lane + 64 * k, h = pid >> 5, r = pid & 31, half = r >> 4, i = r & 15;
      bf16_t* q = p.Qraw + (size_t)row * 768 + h * 192 + 128 + half * 32; const float x1 = bf2f(q[i]), x2 = bf2f(q[16 + i]);
      const float pos = (float)(half ? (t & 63) : (t >> 6)); const float ang = pos * exp2f(-(float)i * (13.287712379549449f / 16.f)); float sv, cv; sincosf(ang, &sv, &cv);
      q[i] = f2bf(x1 * cv - x2 * sv); q[16 + i] = f2bf(x2 * cv + x1 * sv); }
  }
}

DI void st_fnchan(const Prm& p, unsigned char* lds, int bid, int nb) {
  bf16_t* wt = (bf16_t*)lds;
  bf16_t* zt = (bf16_t*)(lds + 256 * 272);
  const int tid = ltid(), wave = tid >> 6, lane = tid & 63, r32 = lane & 31, hi = lane >> 5;
  __syncthreads();
  for (int e = tid; e < 256 * 128; e += NTHR) wt[(e >> 7) * 136 + (e & 127)] = f2bf(p.CCS[e]);
  for (int it = bid; it < (MR / 64) * 4; it += nb) {
    const int tile = it >> 2, g = it & 3, row0 = tile * 64, b = row0 / LT, t0 = row0 - b * LT;
    __syncthreads();
    for (int e = tid; e < 1024; e += NTHR) { const int r = e >> 4, c8 = (e & 15) * 8; *(u32x4*)(zt + r * 136 + c8) = *(const u32x4*)(p.Z + (size_t)(row0 + r) * NZ + C_FN + g * 128 + c8); }
    __syncthreads();
    f32x16 acc[2] = {};
#pragma unroll
    for (int k8 = 0; k8 < 8; ++k8) { const bf16x8 a = *(const bf16x8*)(wt + (wave * 32 + r32) * 136 + k8 * 16 + hi * 8);
#pragma unroll
      for (int tt = 0; tt < 2; ++tt) { const bf16x8 bb = *(const bf16x8*)(zt + (tt * 32 + r32) * 136 + k8 * 16 + hi * 8); acc[tt] = __builtin_amdgcn_mfma_f32_32x32x16_bf16(a, bb, acc[tt], 0, 0, 0); } }
    const int tb = wave >> 2;
#pragma unroll
    for (int tt = 0; tt < 2; ++tt)
#pragma unroll
      for (int r = 0; r < 16; ++r) { const int k2 = (wave & 3) * 32 + (r & 3) + 8 * (r >> 2) + 4 * hi;
        if (t0 < LL) p.PQT[((size_t)(b * 512 + g * 128 + k2)) * 8192 + tb * 4096 + t0 + tt * 32 + r32] = f2bf(acc[tt][r]);
        else p.PQTc[((size_t)(b * 512 + g * 128 + k2)) * 512 + tb * 256 + (t0 - LL) + tt * 32 + r32] = f2bf(acc[tt][r]); }
  }
}

DI int scan_row(int b, int dir, int s) { return s < LCX ? b * LT + LL + (dir ? LCX - 1 - s : s) : b * LT + (dir ? LL - 1 - (s - LCX) : (s - LCX)); }

DI void st_dntinv(const Prm& p, unsigned char* lds, int bid, int nb) {
  const int tid = ltid(), wave = tid >> 6, lane = tid & 63, r32 = lane & 31, hi = lane >> 5;
  float* Ab = (float*)lds + wave * 4096;
  float* gcb = (float*)(lds + 131072) + wave * 128; float* btb = gcb + 64;
  for (int item = bid * 8 + wave; item < 64 * 68; item += nb * 8) {
    const int chain = item / 68, n = item - chain * 68, b = chain >> 3, h = (chain >> 1) & 3, dir = chain & 1;
    const int myrow = scan_row(b, dir, n * 64 + lane);
    const float g = p.GB[(size_t)myrow * 16 + dir * 4 + h], bt = p.GB[(size_t)myrow * 16 + 8 + dir * 4 + h];
    gcb[lane] = g; btb[lane] = bt;
    bf16x8 kf[2][8];
#pragma unroll
    for (int tt = 0; tt < 2; ++tt) { const int row = scan_row(b, dir, n * 64 + tt * 32 + r32);
#pragma unroll
      for (int ks = 0; ks < 8; ++ks) kf[tt][ks] = *(const bf16x8*)(p.DNQ + (size_t)row * 1536 + 512 + h * 128 + ks * 16 + hi * 8); }
    __builtin_amdgcn_wave_barrier();
    float gc = 0.f;
    for (int e = 0; e < 64; ++e) { const float ge = gcb[e]; gc += (e <= lane) ? ge : 0.f; }
    __builtin_amdgcn_wave_barrier();
    gcb[lane] = gc; p.GCB[(size_t)item * 64 + lane] = gc;
    __builtin_amdgcn_wave_barrier();
    f32x16 a00 = {}, a10 = {}, a11 = {};
#pragma unroll
    for (int ks = 0; ks < 8; ++ks) { a00 = __builtin_amdgcn_mfma_f32_32x32x16_bf16(kf[0][ks], kf[0][ks], a00, 0, 0, 0);
      a10 = __builtin_amdgcn_mfma_f32_32x32x16_bf16(kf[1][ks], kf[0][ks], a10, 0, 0, 0); a11 = __builtin_amdgcn_mfma_f32_32x32x16_bf16(kf[1][ks], kf[1][ks], a11, 0, 0, 0); }
    { const float gce0 = gcb[r32], gce1 = gcb[32 + r32];
#pragma unroll
      for (int r = 0; r < 16; ++r) { const int cl = (r & 3) + 8 * (r >> 2) + 4 * hi; const float gc0 = gcb[cl], bt0 = btb[cl], gc1 = gcb[32 + cl], bt1 = btb[32 + cl];
        Ab[cl * 64 + r32] = (r32 < cl) ? bt0 * a00[r] * __expf(gc0 - gce0) : 0.f;
        Ab[cl * 64 + 32 + r32] = 0.f;
        Ab[(32 + cl) * 64 + r32] = bt1 * a10[r] * __expf(gc1 - gce0);
        Ab[(32 + cl) * 64 + 32 + r32] = (r32 < cl) ? bt1 * a11[r] * __expf(gc1 - gce1) : 0.f; } }
    __builtin_amdgcn_wave_barrier();
    float x[64];
    bf16_t* to = p.TINV + (size_t)item * 4096 + lane;
#pragma unroll
    for (int c = 0; c < 64; ++c) { float s = (c == lane) ? 1.f : 0.f;
#pragma unroll
      for (int e4 = 0; e4 < (c + 3) / 4; ++e4) { const f32x4 av = *(const f32x4*)(Ab + c * 64 + e4 * 4);
#pragma unroll
        for (int i = 0; i < 4; ++i) if (e4 * 4 + i < c) s -= av[i] * x[e4 * 4 + i]; }
      x[c] = s; to[c * 64] = f2bf(s); }
    __builtin_amdgcn_wave_barrier();
  }
}

DI void st_dnscan(const Prm& p, unsigned char* lds, int bid, int nb) {
  constexpr int PK = 136, PB = 72;
  bf16_t* Qs = (bf16_t*)lds; bf16_t* Ks = Qs + 64 * PK; bf16_t* SB = Ks + 64 * PK; bf16_t* KDT = SB + 64 * PK; bf16_t* TI = KDT + 128 * PB; bf16_t* RT = TI + 64 * PB; bf16_t* VNT = RT + 64 * PB;
  bf16_t* PL = VNT + 64 * PB; bf16_t* Vs = PL + 64 * PB; float* gcs = (float*)(Vs + 64 * PB); float* bts = gcs + 64; float* egs = bts + 64;
  const int tid = ltid(), wave = tid >> 6, lane = tid & 63, r32 = lane & 31, hi = lane >> 5;
  for (int item = bid; item < 128; item += nb) {
    const int chain = item >> 1, half = item & 1, b = chain >> 3, h = (chain >> 1) & 3, dir = chain & 1;
    f32x16 accS = {};
    __syncthreads();
    for (int e = tid; e < 64 * PK; e += NTHR) SB[e] = 0;
    bf16x8 pf[6]; float pgc = 0.f, pbt = 0.f;
    auto gload = [&](int n) {
      const size_t ci = (size_t)chain * 68 + n;
#pragma unroll
      for (int r = 0; r < 6; ++r) { const int e = tid + NTHR * r;
        if (e < 2048) { const int ee = e & 1023, t = ee >> 4, c8 = ee & 15; const int row = scan_row(b, dir, n * 64 + t); pf[r] = *(const bf16x8*)(p.DNQ + (size_t)row * 1536 + (e < 1024 ? 0 : 512) + h * 128 + c8 * 8); }
        else if (e < 2560) { const int ee = e - 2048, t = ee >> 3, c8 = ee & 7; const int row = scan_row(b, dir, n * 64 + t); pf[r] = *(const bf16x8*)(p.DNQ + (size_t)row * 1536 + 1024 + h * 128 + half * 64 + c8 * 8); }
        else { const int ee = e - 2560; pf[r] = *(const bf16x8*)(p.TINV + ci * 4096 + ee * 8); } }
      if (tid < 64) { pgc = p.GCB[ci * 64 + tid]; const int row = scan_row(b, dir, n * 64 + tid); pbt = p.GB[(size_t)row * 16 + 8 + dir * 4 + h]; }
    };
    gload(0);
    for (int n = 0; n < LT / 64; ++n) {
      if (tid < 64) { gcs[tid] = pgc; bts[tid] = pbt; egs[tid] = __expf(pgc); }
      __syncthreads();
      const float gl = gcs[63];
#pragma unroll
      for (int r = 0; r < 6; ++r) { const int e = tid + NTHR * r;
        if (e < 1024) { const int t = e >> 4, c8 = e & 15; *(bf16x8*)(Qs + t * PK + c8 * 8) = pf[r]; }
        else if (e < 2048) { const int ee = e - 1024, t = ee >> 4, c8 = ee & 15; *(bf16x8*)(Ks + t * PK + c8 * 8) = pf[r]; const float sc = __expf(gl - gcs[t]);
#pragma unroll
          for (int j = 0; j < 8; ++j) KDT[(c8 * 8 + j) * PB + t] = f2bf(bf2f((bf16_t)pf[r][j]) * sc); }
        else if (e < 2560) { const int ee = e - 2048, t = ee >> 3, c8 = ee & 7; *(bf16x8*)(Vs + t * PB + c8 * 8) = pf[r]; }
        else { const int ee = e - 2560, c = ee >> 3, c8 = ee & 7; *(bf16x8*)(TI + c * PB + c8 * 8) = pf[r]; } }
      if (n + 1 < LT / 64) gload(n + 1);
      __syncthreads();
      f32x16 accO = {};
      if (wave < 4) { const int et = wave >> 1, jt = wave & 1; f32x16 a1 = {};
#pragma unroll
        for (int k8 = 0; k8 < 8; ++k8) { const bf16x8 av = *(const bf16x8*)(Ks + (et * 32 + r32) * PK + k8 * 16 + hi * 8), bv = *(const bf16x8*)(SB + (jt * 32 + r32) * PK + k8 * 16 + hi * 8);
          a1 = __builtin_amdgcn_mfma_f32_32x32x16_bf16(av, bv, a1, 0, 0, 0); }
        const int j = jt * 32 + r32;
#pragma unroll
        for (int g = 0; g < 4; ++g) { const int e0 = et * 32 + 8 * g + 4 * hi; float rv[4];
#pragma unroll
          for (int i = 0; i < 4; ++i) rv[i] = bts[e0 + i] * (bf2f(Vs[(e0 + i) * PB + j]) - egs[e0 + i] * a1[4 * g + i]);
          u32x2 w; w.x = pack2(rv[0], rv[1]); w.y = pack2(rv[2], rv[3]); *(u32x2*)(RT + j * PB + e0) = w; } }
      else {
        if (wave < 7) { const int et = wave == 6 ? 1 : 0, ct = wave == 4 ? 0 : 1; f32x16 a2 = {};
#pragma unroll
          for (int k8 = 0; k8 < 8; ++k8) { const bf16x8 av = *(const bf16x8*)(Ks + (et * 32 + r32) * PK + k8 * 16 + hi * 8), bv = *(const bf16x8*)(Qs + (ct * 32 + r32) * PK + k8 * 16 + hi * 8);
            a2 = __builtin_amdgcn_mfma_f32_32x32x16_bf16(av, bv, a2, 0, 0, 0); }
          const int c = ct * 32 + r32; const float gcc = gcs[c];
#pragma unroll
          for (int g = 0; g < 4; ++g) { const int e0 = et * 32 + 8 * g + 4 * hi; float pv[4];
#pragma unroll
            for (int i = 0; i < 4; ++i) pv[i] = (e0 + i <= c) ? a2[4 * g + i] * __expf(gcc - gcs[e0 + i]) : 0.f;
            u32x2 w; w.x = pack2(pv[0], pv[1]); w.y = pack2(pv[2], pv[3]); *(u32x2*)(PL + c * PB + e0) = w; } }
        else { for (int e = lane; e < 32 * 8; e += 64) { const int c = e >> 3, q4 = (e & 7) * 4; *(u32x2*)(PL + c * PB + 32 + q4) = (u32x2){0u, 0u}; } }
        { const int ct = (wave - 4) >> 1, jt = wave & 1;
#pragma unroll
          for (int k8 = 0; k8 < 8; ++k8) { const bf16x8 av = *(const bf16x8*)(Qs + (ct * 32 + r32) * PK + k8 * 16 + hi * 8), bv = *(const bf16x8*)(SB + (jt * 32 + r32) * PK + k8 * 16 + hi * 8);
            accO = __builtin_amdgcn_mfma_f32_32x32x16_bf16(av, bv, accO, 0, 0, 0); }
#pragma unroll
          for (int r = 0; r < 16; ++r) accO[r] *= egs[ct * 32 + (r & 3) + 8 * (r >> 2) + 4 * hi]; } }
      __syncthreads();
      if (wave < 4) { const int ct = wave >> 1, jt = wave & 1; f32x16 a3 = {};
#pragma unroll
        for (int k8 = 0; k8 < 4; ++k8) { const bf16x8 av = *(const bf16x8*)(TI + (ct * 32 + r32) * PB + k8 * 16 + hi * 8), bv = *(const bf16x8*)(RT + (jt * 32 + r32) * PB + k8 * 16 + hi * 8);
          a3 = __builtin_amdgcn_mfma_f32_32x32x16_bf16(av, bv, a3, 0, 0, 0); }
#pragma unroll
        for (int g = 0; g < 4; ++g) { u32x2 w; w.x = pack2(a3[4 * g], a3[4 * g + 1]); w.y = pack2(a3[4 * g + 2], a3[4 * g + 3]); *(u32x2*)(VNT + (jt * 32 + r32) * PB + ct * 32 + 8 * g + 4 * hi) = w; } }
      __syncthreads();
      if (wave >= 4) { const int ct = (wave - 4) >> 1, jt = wave & 1;
#pragma unroll
        for (int k8 = 0; k8 < 4; ++k8) { const bf16x8 av = *(const bf16x8*)(PL + (ct * 32 + r32) * PB + k8 * 16 + hi * 8), bv = *(const bf16x8*)(VNT + (jt * 32 + r32) * PB + k8 * 16 + hi * 8);
          accO = __builtin_amdgcn_mfma_f32_32x32x16_bf16(av, bv, accO, 0, 0, 0); }
#pragma unroll
        for (int r = 0; r < 16; ++r) { const int c = ct * 32 + (r & 3) + 8 * (r >> 2) + 4 * hi; const int row = scan_row(b, dir, n * 64 + c);
          p.OB[((size_t)(0 * 2 + dir) * MR + row) * 512 + h * 128 + half * 64 + jt * 32 + r32] = f2bf(accO[r]); } }
      { const int dt = wave >> 1, jt = wave & 1; const float egl = __expf(gl);
#pragma unroll
        for (int r = 0; r < 16; ++r) accS[r] *= egl;
#pragma unroll
        for (int k8 = 0; k8 < 4; ++k8) { const bf16x8 av = *(const bf16x8*)(KDT + (dt * 32 + r32) * PB + k8 * 16 + hi * 8), bv = *(const bf16x8*)(VNT + (jt * 32 + r32) * PB + k8 * 16 + hi * 8);
          accS = __builtin_amdgcn_mfma_f32_32x32x16_bf16(av, bv, accS, 0, 0, 0); }
#pragma unroll
        for (int g = 0; g < 4; ++g) { u32x2 w; w.x = pack2(accS[4 * g], accS[4 * g + 1]); w.y = pack2(accS[4 * g + 2], accS[4 * g + 3]);
          *(u32x2*)(SB + (jt * 32 + r32) * PK + dt * 32 + 8 * g + 4 * hi) = w; } }
      __syncthreads();
    }
  }
}

DI void st_glabc(const Prm& p, int layer, unsigned char* lds, int bid, int nb) {
  float* AL = (float*)lds; float* SEG = AL + 1024;
  const int tid = ltid(), seg = tid >> 6, dme = tid & 63;
  for (int item = bid; item < 64 * 68; item += nb) {
    const int chain = item / 68, n = item - chain * 68, b = chain >> 3, h = (chain >> 1) & 3, dir = chain & 1;
    const float* w2 = p.gla_w2 + (size_t)(layer * 2 + dir) * 16 * 256 + h * 64; const float b2r = p.gla_b2[(layer * 2 + dir) * 256 + h * 64 + dme];
    float w2r[16];
#pragma unroll
    for (int r = 0; r < 16; ++r) w2r[r] = w2[r * 256 + dme];
    __syncthreads();
    if (tid < 128) { const int t = tid >> 1, c8 = tid & 1; const int row = scan_row(b, dir, n * 64 + t); const bf16x8 v = *(const bf16x8*)(p.Z + (size_t)row * NZ + C_GALPHA + dir * 16 + c8 * 8);
#pragma unroll
      for (int j = 0; j < 8; ++j) AL[t * 16 + c8 * 8 + j] = bf2f((bf16_t)v[j]); }
    __syncthreads();
    float la[8]; float run = 0.f;
#pragma unroll
    for (int k = 0; k < 8; ++k) { const int t = seg * 8 + k; float zz = b2r;
#pragma unroll
      for (int r = 0; r < 16; ++r) zz += AL[t * 16 + r] * w2r[r];
      const float nz = -zz; const float sp = nz > 20.f ? nz : log1pf(expf(nz)); run += -sp * (1.f / 16.f); la[k] = run; }
    SEG[seg * 64 + dme] = run;
    __syncthreads();
    float pre = 0.f;
#pragma unroll
    for (int s2 = 0; s2 < 8; ++s2) pre += (s2 < seg) ? SEG[s2 * 64 + dme] : 0.f;
#pragma unroll
    for (int k = 0; k < 8; ++k) p.BC[(size_t)item * 4096 + (seg * 8 + k) * 64 + dme] = la[k] + pre;
  }
}

DI void st_glascan(const Prm& p, int layer, unsigned char* lds, int bid, int nb) {
  constexpr int PB = 72;
  bf16_t* QI = (bf16_t*)lds; bf16_t* QR = QI + 64 * PB; bf16_t* KR = QR + 64 * PB; bf16_t* KRT = KR + 64 * PB; bf16_t* VT = KRT + 64 * PB; bf16_t* SB = VT + 64 * PB; bf16_t* PL = SB + 64 * PB;
  float* LA = (float*)(lds + 7 * 64 * PB * 2);
  float* AL = LA + 4096;
  float* SEG = AL + 1024;
  float* EBL = SEG + 512;
  const int tid = ltid(), wave = tid >> 6, lane = tid & 63, r32 = lane & 31, hi = lane >> 5;
  for (int item = bid; item < 128; item += nb) {
    const int chain = item >> 1, half = item & 1, b = chain >> 3, h = (chain >> 1) & 3, dir = chain & 1;
    f32x16 acc = {};
    __syncthreads();
    for (int e = tid; e < 64 * PB; e += NTHR) SB[e] = 0;
    bf16x8 pf[3]; f32x4 pb[2];
    auto gload = [&](int n) {
#pragma unroll
      for (int r = 0; r < 3; ++r) { const int e = tid + NTHR * r; const int t = e / 24, ch = e - t * 24; const int row = scan_row(b, dir, n * 64 + t);
        const int col = ch < 8 ? C_GQ + h * 64 + ch * 8 : (ch < 16 ? C_GK + h * 64 + (ch - 8) * 8 : C_GV + h * 128 + half * 64 + (ch - 16) * 8);
        pf[r] = *(const bf16x8*)(p.Z + (size_t)row * NZ + col); }
#pragma unroll
      for (int r = 0; r < 2; ++r) pb[r] = *(const f32x4*)(p.BC + ((size_t)chain * 68 + n) * 4096 + (tid + NTHR * r) * 4);
    };
    gload(0);
    for (int n = 0; n < LT / 64; ++n) {
#pragma unroll
      for (int r = 0; r < 2; ++r) *(f32x4*)(LA + (tid + NTHR * r) * 4) = pb[r];
      __syncthreads();
      if (tid < 64) EBL[tid] = __expf(LA[63 * 64 + tid]);
#pragma unroll
      for (int r = 0; r < 3; ++r) { const int e = tid + NTHR * r; const int t = e / 24, ch = e - t * 24;
          if (ch < 8) { u32x4 wi, wr; float xi[8], xr[8];
#pragma unroll
            for (int j = 0; j < 8; ++j) { const int d = ch * 8 + j; const float bc = LA[t * 64 + d], bl = LA[63 * 64 + d], q = bf2f((bf16_t)pf[r][j]) * 0.125f; xi[j] = q * __expf(bc); xr[j] = q * __expf(bc - bl); }
            wi.x = pack2(xi[0], xi[1]); wi.y = pack2(xi[2], xi[3]); wi.z = pack2(xi[4], xi[5]); wi.w = pack2(xi[6], xi[7]);
            wr.x = pack2(xr[0], xr[1]); wr.y = pack2(xr[2], xr[3]); wr.z = pack2(xr[4], xr[5]); wr.w = pack2(xr[6], xr[7]);
            *(u32x4*)(QI + t * PB + ch * 8) = wi; *(u32x4*)(QR + t * PB + ch * 8) = wr; }
          else if (ch < 16) { u32x4 wk; float xk[8];
#pragma unroll
            for (int j = 0; j < 8; ++j) { const int d = (ch - 8) * 8 + j; xk[j] = bf2f((bf16_t)pf[r][j]) * __expf(LA[63 * 64 + d] - LA[t * 64 + d]); KRT[d * PB + t] = f2bf(xk[j]); }
            wk.x = pack2(xk[0], xk[1]); wk.y = pack2(xk[2], xk[3]); wk.z = pack2(xk[4], xk[5]); wk.w = pack2(xk[6], xk[7]);
            *(u32x4*)(KR + t * PB + (ch - 8) * 8) = wk; }
          else {
#pragma unroll
            for (int j = 0; j < 8; ++j) VT[((ch - 16) * 8 + j) * PB + t] = (bf16_t)pf[r][j]; } }
      if (n + 1 < LT / 64) gload(n + 1);
      __syncthreads();
      if (wave < 3) { const int et = wave == 2 ? 1 : 0, ct = wave == 0 ? 0 : 1; f32x16 a2 = {};
#pragma unroll
        for (int k8 = 0; k8 < 4; ++k8) { const bf16x8 av = *(const bf16x8*)(KR + (et * 32 + r32) * PB + k8 * 16 + hi * 8), bv = *(const bf16x8*)(QR + (ct * 32 + r32) * PB + k8 * 16 + hi * 8);
          a2 = __builtin_amdgcn_mfma_f32_32x32x16_bf16(av, bv, a2, 0, 0, 0); }
        const int c = ct * 32 + r32;
#pragma unroll
        for (int g = 0; g < 4; ++g) { const int e0 = et * 32 + 8 * g + 4 * hi; u32x2 w;
          w.x = pack2(e0 <= c ? a2[4 * g] : 0.f, e0 + 1 <= c ? a2[4 * g + 1] : 0.f); w.y = pack2(e0 + 2 <= c ? a2[4 * g + 2] : 0.f, e0 + 3 <= c ? a2[4 * g + 3] : 0.f);
          *(u32x2*)(PL + c * PB + e0) = w; } }
      else if (wave == 3) { for (int e = lane; e < 32 * 8; e += 64) { const int c = e >> 3, q4 = (e & 7) * 4; *(u32x2*)(PL + c * PB + 32 + q4) = (u32x2){0u, 0u}; } }
      else { const int ct = (wave - 4) >> 1, jt = wave & 1; acc = f32x16{};
#pragma unroll
        for (int k8 = 0; k8 < 4; ++k8) { const bf16x8 av = *(const bf16x8*)(QI + (ct * 32 + r32) * PB + k8 * 16 + hi * 8), bv = *(const bf16x8*)(SB + (jt * 32 + r32) * PB + k8 * 16 + hi * 8);
          acc = __builtin_amdgcn_mfma_f32_32x32x16_bf16(av, bv, acc, 0, 0, 0); } }
      __syncthreads();
      if (wave >= 4) { const int ct = (wave - 4) >> 1, jt = wave & 1;
#pragma unroll
        for (int k8 = 0; k8 < 4; ++k8) { const bf16x8 av = *(const bf16x8*)(PL + (ct * 32 + r32) * PB + k8 * 16 + hi * 8), bv = *(const bf16x8*)(VT + (jt * 32 + r32) * PB + k8 * 16 + hi * 8);
          acc = __builtin_amdgcn_mfma_f32_32x32x16_bf16(av, bv, acc, 0, 0, 0); }
#pragma unroll
        for (int r = 0; r < 16; ++r) { const int c = ct * 32 + (r & 3) + 8 * (r >> 2) + 4 * hi; const int row = scan_row(b, dir, n * 64 + c);
          p.OB[((size_t)(1 * 2 + dir) * MR + row) * 512 + h * 128 + half * 64 + jt * 32 + r32] = f2bf(acc[r]); } }
      else { const int dt = wave >> 1, jt = wave & 1;
#pragma unroll
        for (int r = 0; r < 16; ++r) acc[r] *= EBL[dt * 32 + (r & 3) + 8 * (r >> 2) + 4 * hi];
#pragma unroll
        for (int k8 = 0; k8 < 4; ++k8) { const bf16x8 av = *(const bf16x8*)(KRT + (dt * 32 + r32) * PB + k8 * 16 + hi * 8), bv = *(const bf16x8*)(VT + (jt * 32 + r32) * PB + k8 * 16 + hi * 8);
          acc = __builtin_amdgcn_mfma_f32_32x32x16_bf16(av, bv, acc, 0, 0, 0); }
#pragma unroll
        for (int g = 0; g < 4; ++g) { u32x2 w; w.x = pack2(acc[4 * g], acc[4 * g + 1]); w.y = pack2(acc[4 * g + 2], acc[4 * g + 3]);
          *(u32x2*)(SB + (jt * 32 + r32) * PB + dt * 32 + 8 * g + 4 * hi) = w; } }
      __syncthreads();
    }
  }
}

DI void st_combine(const Prm& p, int layer, int bid, int nb) {
  const int wave = ltid() >> 6, lane = ltid() & 63;
  for (long task = (long)bid * 8 + wave; task < (long)MR * 8; task += (long)nb * 8) {
    const int row = (int)(task >> 3), mh = (int)(task & 7), mixer = mh >> 2, h = mh & 3;
    const unsigned f = *(const unsigned*)(p.OB + ((size_t)(mixer * 2 + 0) * MR + row) * 512 + h * 128 + lane * 2), g = *(const unsigned*)(p.OB + ((size_t)(mixer * 2 + 1) * MR + row) * 512 + h * 128 + lane * 2);
    const float o0 = bf2f((bf16_t)(f & 0xffffu)) + bf2f((bf16_t)(g & 0xffffu)), o1 = bf2f((bf16_t)(f >> 16)) + bf2f((bf16_t)(g >> 16));
    const float ss = wsum(o0 * o0 + o1 * o1), rstd = rsqrtf(ss * (1.f / 128.f) + EPSV);
    const float* w = (mixer ? p.gla_norm : p.dn_norm) + layer * 128 + lane * 2;
    const unsigned gz = *(const unsigned*)(p.Z + (size_t)row * NZ + (mixer ? C_GGATE : C_DNGATE) + h * 128 + lane * 2);
    const float g0 = bf2f((bf16_t)(gz & 0xffffu)), g1 = bf2f((bf16_t)(gz >> 16));
    *(unsigned*)(p.Y + (size_t)row * DM + mixer * 512 + h * 128 + lane * 2) = pack2(o0 * rstd * w[0] * siluf(g0), o1 * rstd * w[1] * siluf(g1));
  }
}

DI unsigned fkey(float f) { const unsigned u = __float_as_uint(f); return u ^ ((u >> 31) ? 0xffffffffu : 0x80000000u); }
DI int pcnt(unsigned long long m) { return __builtin_popcountll(m); }
DI int lanes_below(unsigned long long m) { return (int)__builtin_amdgcn_mbcnt_hi((unsigned)(m >> 32), __builtin_amdgcn_mbcnt_lo((unsigned)m, 0u)); }
DI void st_peertopk(const Prm& p, int layer, unsigned char* lds, int bid, int nb) {
  bf16_t* ks = (bf16_t*)lds;
  bf16_t* qt = (bf16_t*)(lds + 69632);
  float* sc = (float*)(lds + 69632);
  const int tid = ltid(), wave = tid >> 6, lane = tid & 63, r32 = lane & 31, hi = lane >> 5;
  float* selv = (float*)(lds + 69632 + 33280) + wave * 64; int* seli = (int*)(selv + 32);
  int hcur = -1;
  const int nchunk = MR / 32;
  for (int it = bid; it < 8 * nchunk; it += nb) {
    const int h = it / nchunk, chunk = it - h * nchunk, row0 = chunk * 32;
    if (layer == 1 && (row0 % LT) >= LL) continue;
    __syncthreads();
    if (h != hcur) {
      const float* kg = p.peer_keys + ((size_t)(layer * 8 + h) * 2) * 128 * 128;
      for (int e = tid; e < 2 * 128 * 128; e += NTHR) { const int pn = e >> 7, k = e & 127; ks[pn * 136 + k] = f2bf(kg[e]); }
      hcur = h; }
    for (int e = tid; e < 1024; e += NTHR) { const int r = e >> 5, c8 = (e & 31) * 8; *(u32x4*)(qt + r * 264 + c8) = *(const u32x4*)(p.Qp + (size_t)(row0 + r) * DM + h * 256 + c8); }
    __syncthreads();
    { const int pt = wave >> 2, nt = wave & 3; f32x16 acc = {};
#pragma unroll
      for (int k8 = 0; k8 < 8; ++k8) { const bf16x8 a = *(const bf16x8*)(qt + r32 * 264 + pt * 128 + k8 * 16 + hi * 8), b = *(const bf16x8*)(ks + (pt * 128 + nt * 32 + r32) * 136 + k8 * 16 + hi * 8);
        acc = __builtin_amdgcn_mfma_f32_32x32x16_bf16(a, b, acc, 0, 0, 0); }
      __syncthreads();
#pragma unroll
      for (int r = 0; r < 16; ++r) sc[((r & 3) + 8 * (r >> 2) + 4 * hi) * 260 + pt * 128 + nt * 32 + r32] = acc[r]; }
    __syncthreads();
    for (int rr = 0; rr < 4; ++rr) {
      const int m = wave * 4 + rr, row = row0 + m;
      float s[2][2];
#pragma unroll
      for (int pp = 0; pp < 2; ++pp)
#pragma unroll
        for (int hh = 0; hh < 2; ++hh) s[pp][hh] = sc[m * 260 + pp * 128 + hh * 64 + lane];
      unsigned kk[2][2], T[2] = {0u, 0u};
#pragma unroll
      for (int pp = 0; pp < 2; ++pp) { kk[pp][0] = fkey(s[pp][0]); kk[pp][1] = fkey(s[pp][1]); }
      { unsigned ta = 0u, tb = 0u, da = 0u, db = 0u;
        for (int bit = 31; bit >= 0; --bit) { const unsigned m = 1u << bit;
          const unsigned ca = ta | m, cb = tb | m;
          const unsigned na = (unsigned)(pcnt(__ballot(kk[0][0] >= ca)) + pcnt(__ballot(kk[0][1] >= ca))), nb2 = (unsigned)(pcnt(__ballot(kk[1][0] >= cb)) + pcnt(__ballot(kk[1][1] >= cb)));
          const unsigned oa = (na >= 16u ? 1u : 0u) & ~da, ob = (nb2 >= 16u ? 1u : 0u) & ~db;
          ta |= (0u - oa) & m; tb |= (0u - ob) & m; da |= oa & (na == 16u ? 1u : 0u); db |= ob & (nb2 == 16u ? 1u : 0u);
          if (da & db) break; }
        T[0] = __builtin_amdgcn_readfirstlane(ta); T[1] = __builtin_amdgcn_readfirstlane(tb); }
#pragma unroll
      for (int pp = 0; pp < 2; ++pp) { const unsigned k0 = kk[pp][0], k1 = kk[pp][1], TT = T[pp];
        const unsigned long long g0 = __ballot(k0 > TT), g1 = __ballot(k1 > TT), e0 = __ballot(k0 == TT), e1 = __ballot(k1 == TT);
        const int ng0 = pcnt(g0), ng = ng0 + pcnt(g1), need = 16 - ng, ne0 = pcnt(e0);
        if (k0 > TT) { const int r = lanes_below(g0); selv[pp * 16 + r] = s[pp][0]; seli[pp * 16 + r] = lane; }
        if (k1 > TT) { const int r = ng0 + lanes_below(g1); selv[pp * 16 + r] = s[pp][1]; seli[pp * 16 + r] = lane + 64; }
        if (k0 == TT) { const int r = lanes_below(e0); if (r < need) { selv[pp * 16 + ng + r] = s[pp][0]; seli[pp * 16 + ng + r] = lane; } }
        if (k1 == TT) { const int r = ne0 + lanes_below(e1); if (r < need) { selv[pp * 16 + ng + r] = s[pp][1]; seli[pp * 16 + ng + r] = lane + 64; } } }
      __builtin_amdgcn_wave_barrier();
      float cd[4]; unsigned ck[4]; { const float sa = selv[lane >> 2]; const f32x4 sb = *(const f32x4*)(selv + 16 + (lane & 3) * 4);
#pragma unroll
        for (int q = 0; q < 4; ++q) { cd[q] = sa + sb[q]; ck[q] = fkey(cd[q]); } }
      unsigned T2 = 0u;
      for (int bit = 31; bit >= 0; --bit) { const unsigned m = 1u << bit, c = T2 | m;
        const unsigned n = (unsigned)(pcnt(__ballot(ck[0] >= c)) + pcnt(__ballot(ck[1] >= c)) + pcnt(__ballot(ck[2] >= c)) + pcnt(__ballot(ck[3] >= c)));
        T2 |= (0u - (n >= 16u ? 1u : 0u)) & m; if (n == 16u) break; }
      T2 = __builtin_amdgcn_readfirstlane(T2);
      float mx = fmaxf(fmaxf(cd[0], cd[1]), fmaxf(cd[2], cd[3])); mx = wmax(mx);
      int base = 0; float esum = 0.f; const int ia = seli[lane >> 2]; int rk[4]; float ev[4];
#pragma unroll
      for (int q = 0; q < 4; ++q) { const unsigned long long g = __ballot(ck[q] > T2); rk[q] = ck[q] > T2 ? base + lanes_below(g) : 99; base += pcnt(g); }
#pragma unroll
      for (int q = 0; q < 4; ++q) { const unsigned long long g = __ballot(ck[q] == T2); if (ck[q] == T2) rk[q] = base + lanes_below(g); base += pcnt(g); }
#pragma unroll
      for (int q = 0; q < 4; ++q) { ev[q] = rk[q] < 16 ? __expf(cd[q] - mx) : 0.f; esum += ev[q]; }
      esum = wsum(esum); const float inv = 1.f / esum;
      int* orow = p.IDX + (size_t)row * 128 + h * 16; float* grow = p.GATE + (size_t)row * 128 + h * 16;
#pragma unroll
      for (int q = 0; q < 4; ++q) if (rk[q] < 16) { orow[rk[q]] = ia * 128 + seli[16 + (lane & 3) * 4 + q]; grow[rk[q]] = ev[q] * inv; }
      __builtin_amdgcn_wave_barrier();
    }
  }
}

constexpr float U_SC = 1024.f, V_SC = 16.f;
DI void st_cvt_tables(const Prm& p, int layer, int bid, int nb) {
  const size_t n16 = (size_t)16384 * DM / 16, stride = (size_t)nb * NTHR;
  const float* U = p.peer_u + (size_t)layer * 16384 * DM; const float* V = p.peer_v + (size_t)layer * 16384 * DM;
  for (size_t e = (size_t)bid * NTHR + ltid(); e < 2 * n16; e += stride) { const bool isv = e >= n16; const size_t k = isv ? e - n16 : e;
    const float* src = (isv ? V : U) + k * 16; const float sc = isv ? V_SC : U_SC; u32x4 w;
#pragma unroll
    for (int q = 0; q < 4; ++q) { const f32x4 a = *(const f32x4*)(src + q * 4) * sc; int r = 0;
      r = __builtin_amdgcn_cvt_pk_fp8_f32(a[0], a[1], r, false); r = __builtin_amdgcn_cvt_pk_fp8_f32(a[2], a[3], r, true); w[q] = (unsigned)r; }
    *(u32x4*)((unsigned char*)(isv ? p.Vb : p.Ub) + k * 16) = w; }
}

DI void st_peergather(const Prm& p, int layer, float* lds, int bid, int nb, bool dry = false) {
  const int tid = ltid(), wave = tid >> 6, lane = tid & 63;
  const unsigned char* Ub = (const unsigned char*)p.Ub; const unsigned char* Vb = (const unsigned char*)p.Vb;
  for (int row = bid; row < MR; row += nb) {
    const int b = row / LT, t = row - b * LT; const bool isc = t >= LL;
    if (isc && layer == 1) continue;
    f32x2 hv[16];
#pragma unroll
    for (int i = 0; i < 2; ++i) {
#pragma unroll
      for (int q = 0; q < 2; ++q) { const u32x4 w = *(const u32x4*)(p.H2 + (size_t)row * DM + i * 1024 + lane * 16 + q * 8);
#pragma unroll
        for (int k = 0; k < 4; ++k) hv[i * 8 + q * 4 + k] = (f32x2){__uint_as_float(w[k] << 16), __uint_as_float(w[k] & 0xffff0000u)}; } }
    f32x2 acc[16];
#pragma unroll
    for (int i = 0; i < 16; ++i) acc[i] = (f32x2){0.f, 0.f};
    const int myidx = lane < 16 ? p.IDX[(size_t)row * 128 + wave * 16 + lane] : 0; const float mygate = lane < 16 ? p.GATE[(size_t)row * 128 + wave * 16 + lane] : 0.f;
#pragma unroll 1
    for (int k0 = 0; k0 < 16; k0 += 4) {
      u32x4 uu[4][2], vv[4][2];
#pragma unroll
      for (int q = 0; q < 4; ++q) { const int e = __builtin_amdgcn_readfirstlane(__shfl(myidx, k0 + q));
        const unsigned char* ur = Ub + (size_t)e * DM + lane * 16; const unsigned char* vr = Vb + (size_t)e * DM + lane * 16;
#pragma unroll
        for (int i = 0; i < 2; ++i) { uu[q][i] = *(const u32x4*)(ur + i * 1024); vv[q][i] = *(const u32x4*)(vr + i * 1024); } }
#pragma unroll
      for (int q = 0; q < 4; ++q) { f32x2 d0 = (f32x2){0.f, 0.f}, d1 = (f32x2){0.f, 0.f};
#pragma unroll
        for (int i = 0; i < 2; ++i)
#pragma unroll
          for (int k = 0; k < 4; ++k) { d0 += __builtin_amdgcn_cvt_pk_f32_fp8((int)uu[q][i][k], false) * hv[i * 8 + k * 2]; d1 += __builtin_amdgcn_cvt_pk_f32_fp8((int)uu[q][i][k], true) * hv[i * 8 + k * 2 + 1]; }
        d0 += d1; float d = wsum(d0[0] + d0[1]) * (1.f / U_SC);
        const float wgt = __shfl(mygate, k0 + q) * 0.5f * d * (1.f + erff(d * 0.70710678118654752f)); const f32x2 w2 = (f32x2){wgt, wgt};
#pragma unroll
        for (int i = 0; i < 2; ++i)
#pragma unroll
          for (int k = 0; k < 4; ++k) { acc[i * 8 + k * 2] += w2 * __builtin_amdgcn_cvt_pk_f32_fp8((int)vv[q][i][k], false); acc[i * 8 + k * 2 + 1] += w2 * __builtin_amdgcn_cvt_pk_f32_fp8((int)vv[q][i][k], true); } }
    }
    __syncthreads();
#pragma unroll
    for (int i = 0; i < 2; ++i) { float* d = lds + wave * 2048 + i * 1024 + lane * 16;
#pragma unroll
      for (int k = 0; k < 4; ++k) *(f32x4*)(d + k * 4) = (f32x4){acc[i * 8 + k * 2][0], acc[i * 8 + k * 2][1], acc[i * 8 + k * 2 + 1][0], acc[i * 8 + k * 2 + 1][1]}; }
    __syncthreads();
    { const int col = tid * 4; f32x4 sum = (f32x4){0.f, 0.f, 0.f, 0.f};
#pragma unroll
      for (int w = 0; w < 8; ++w) sum += *(const f32x4*)(lds + w * 2048 + col);
      const f32x4 g2 = *(const f32x4*)(p.mod + ((size_t)layer * 9 + (isc ? 8 : b)) * NMOD + 5 * DM + col) * (1.f / V_SC);
      float* xr = p.X + (size_t)row * DM + col; const f32x4 xn = *(const f32x4*)xr + g2 * sum;
      if (!dry) {
        float ss = wsum(xn[0] * xn[0] + xn[1] * xn[1] + xn[2] * xn[2] + xn[3] * xn[3]);
        if (lane == 0) lds[16384 + wave] = ss;
        __syncthreads();
        ss = 0.f;
#pragma unroll
        for (int w = 0; w < 8; ++w) ss += lds[16384 + w];
        const float rstd = rsqrtf(ss * (1.f / 2048.f) + EPSV);
        if (layer == 0) { *(f32x4*)xr = xn;
          const float* mr = p.mod + ((size_t)9 + (isc ? 8 : b)) * NMOD; const f32x4 sc = *(const f32x4*)(mr + DM + col), sh = *(const f32x4*)(mr + col);
          const f32x4 o = xn * rstd * (sc + 1.f) + sh; u32x2 w; w.x = pack2(o[0], o[1]); w.y = pack2(o[2], o[3]); *(u32x2*)(p.H + (size_t)row * DM + col) = w; }
        else *(f32x4*)(p.out + ((size_t)b * LL + t) * DM + col) = xn * rstd * *(const f32x4*)(p.final_norm + col);
      } }
  }
}

DI void st_final(const Prm& p, int bid, int nb) {
  const int wave = ltid() >> 6, lane = ltid() & 63;
  for (int r = bid * 8 + wave; r < NB * LL; r += nb * 8) {
    const int b = r / LL, t = r - b * LL; const float* src = p.X + (size_t)(b * LT + t) * DM;
    f32x4 v[8]; float ss = 0.f;
#pragma unroll
    for (int i = 0; i < 8; ++i) { v[i] = *(const f32x4*)(src + (i * 64 + lane) * 4); ss += v[i][0] * v[i][0] + v[i][1] * v[i][1] + v[i][2] * v[i][2] + v[i][3] * v[i][3]; }
    ss = wsum(ss); const float rstd = rsqrtf(ss * (1.f / 2048.f) + EPSV);
#pragma unroll
    for (int i = 0; i < 8; ++i) { const int col = (i * 64 + lane) * 4; *(f32x4*)(p.out + (size_t)r * DM + col) = v[i] * rstd * *(const f32x4*)(p.final_norm + col); }
  }
}

namespace att {
constexpr int NW = 8, QBLK = 32, KVBLK = 64;
constexpr float SCALE = 0.07216878364870322f;
constexpr float THR = 8.f;
constexpr int LDQ = 768, LDK = 1024, LDKR = 64, LDO = DM;
constexpr int SHM_V = KVBLK * 128 * 2, SHM_K = KVBLK * 128 * 2, SHM_KR = KVBLK * 64 * 2, SHM_ATTN = 2 * SHM_V + 2 * SHM_K + 2 * SHM_KR + NW * 64 * 4;
#define KSWZ(row, colB) ((row) * 256 + ((colB) ^ (((row) & 7) << 4)))
#define KRSWZ(row, colB) ((row) * 128 + ((colB) ^ ((((row) >> 1) & 7) << 4)))
#define SBAR() __builtin_amdgcn_sched_barrier(0)
DI int crow(int r, int hi) { return (r & 3) + 8 * (r >> 2) + 4 * hi; }
DI unsigned cvtpk(float lo, float hi) { unsigned r; asm volatile("v_cvt_pk_bf16_f32 %0, %1, %2" : "=v"(r) : "v"(lo), "v"(hi)); return r; }

DI void partialSM(f32x16& p0, f32x16& p1, float& m_reg, float& mn, float& alpha) {
  constexpr float C = SCALE * 1.4426950408889634f;
  float pmax = p0[0];
#pragma unroll
  for (int r = 1; r < 16; ++r) pmax = fmaxf(pmax, p0[r]);
#pragma unroll
  for (int r = 0; r < 16; ++r) pmax = fmaxf(pmax, p1[r]);
  { auto rr = __builtin_amdgcn_permlane32_swap(__float_as_uint(pmax), __float_as_uint(pmax), false, false);
    pmax = fmaxf(__uint_as_float(rr[0]), __uint_as_float(rr[1])); }
  if (__builtin_expect(__all(pmax - m_reg <= THR / SCALE), 1)) { mn = m_reg; alpha = 1.f; }
  else { mn = fmaxf(m_reg, pmax); alpha = __builtin_amdgcn_exp2f((m_reg - mn) * C); m_reg = mn; }
  const float mnC = -mn * C;
#pragma unroll
  for (int r = 0; r < 16; ++r) p0[r] = fmaf(p0[r], C, mnC);
#pragma unroll
  for (int r = 0; r < 16; ++r) p1[r] = fmaf(p1[r], C, mnC);
#pragma unroll
  for (int r = 0; r < 16; ++r) p0[r] = __builtin_amdgcn_exp2f(p0[r]);
}
DI void finishSM(f32x16& p0, f32x16& p1, float alpha, float& l_reg, bf16x8& pa0, bf16x8& pa1, bf16x8& pa2, bf16x8& pa3) {
#pragma unroll
  for (int r = 0; r < 16; ++r) p1[r] = __builtin_amdgcn_exp2f(p1[r]);
  float ps = 0;
#pragma unroll
  for (int r = 0; r < 16; ++r) ps += p0[r];
#pragma unroll
  for (int r = 0; r < 16; ++r) ps += p1[r];
  { auto rr = __builtin_amdgcn_permlane32_swap(__float_as_uint(ps), __float_as_uint(ps), false, false);
    ps = __uint_as_float(rr[0]) + __uint_as_float(rr[1]); }
  l_reg = l_reg * alpha + ps;
#define PK4(P, BASE, OUT) do { unsigned a0 = cvtpk(P[BASE + 0], P[BASE + 1]), a1 = cvtpk(P[BASE + 2], P[BASE + 3]);   \
    unsigned b0 = cvtpk(P[BASE + 4], P[BASE + 5]), b1 = cvtpk(P[BASE + 6], P[BASE + 7]);                              \
    auto r0 = __builtin_amdgcn_permlane32_swap(a0, b0, false, false); auto r1 = __builtin_amdgcn_permlane32_swap(a1, b1, false, false); \
    u32x4 w = {r0[0], r1[0], r0[1], r1[1]}; OUT = *reinterpret_cast<bf16x8*>(&w); } while (0)
  PK4(p0, 0, pa0); PK4(p0, 8, pa1); PK4(p1, 0, pa2); PK4(p1, 8, pa3);
#undef PK4
}
DI void qkt(f32x16& p0, f32x16& p1, const char* Ks, const char* KRs, const bf16x8* qr, int r32, int hi) {
  p0 = f32x16{}; p1 = f32x16{};
#pragma unroll
  for (int d0 = 0; d0 < 8; ++d0) { const int cb = (d0 * 16 + hi * 8) * 2;
    const bf16x8 b0 = *reinterpret_cast<const bf16x8*>(Ks + KSWZ(r32, cb));
    const bf16x8 b1 = *reinterpret_cast<const bf16x8*>(Ks + KSWZ(32 + r32, cb));
    p0 = __builtin_amdgcn_mfma_f32_32x32x16_bf16(b0, qr[d0], p0, 0, 0, 0);
    p1 = __builtin_amdgcn_mfma_f32_32x32x16_bf16(b1, qr[d0], p1, 0, 0, 0); }
#pragma unroll
  for (int d0 = 0; d0 < 4; ++d0) { const int cb = (d0 * 16 + hi * 8) * 2;
    const bf16x8 b0 = *reinterpret_cast<const bf16x8*>(KRs + KRSWZ(r32, cb));
    const bf16x8 b1 = *reinterpret_cast<const bf16x8*>(KRs + KRSWZ(32 + r32, cb));
    p0 = __builtin_amdgcn_mfma_f32_32x32x16_bf16(b0, qr[8 + d0], p0, 0, 0, 0);
    p1 = __builtin_amdgcn_mfma_f32_32x32x16_bf16(b1, qr[8 + d0], p1, 0, 0, 0); }
}
DI int v_st(int k, int c) { const int kk = (k & ~0xC) | ((k & 4) << 1) | ((k & 8) >> 1); return ((kk >> 3) * 4 + (c >> 5)) * 512 + ((kk & 7) * 32 + (c & 31)) * 2; }
DI int v_rd_base(int lane) { return ((lane & 3) << 3) | (((lane >> 2) & 3) << 6) | (((lane >> 4) & 1) << 5) | (((lane >> 5) & 1) << 8); }
constexpr int v_rd_off(int d0, int ks, int half) { return d0 * 512 + ks * 4096 + half * 2048; }
template <int OFF> DI s16x4 tr_read(int vb) { s16x4 r; asm volatile("ds_read_b64_tr_b16 %0, %1 offset:%2" : "=&v"(r) : "v"(vb), "i"(OFF) : "memory"); return r; }
template <int D0> DI void pv_one(f32x16& od, int vb, bf16x8 pa0, bf16x8 pa1, bf16x8 pa2, bf16x8 pa3) {
  const s16x4 l0 = tr_read<v_rd_off(D0, 0, 0)>(vb), h0 = tr_read<v_rd_off(D0, 0, 1)>(vb), l1 = tr_read<v_rd_off(D0, 1, 0)>(vb), h1 = tr_read<v_rd_off(D0, 1, 1)>(vb);
  const s16x4 l2 = tr_read<v_rd_off(D0, 2, 0)>(vb), h2 = tr_read<v_rd_off(D0, 2, 1)>(vb), l3 = tr_read<v_rd_off(D0, 3, 0)>(vb), h3 = tr_read<v_rd_off(D0, 3, 1)>(vb);
  asm volatile("s_waitcnt lgkmcnt(0)" ::: "memory"); SBAR();
#define PK(L, H) (bf16x8){L[0], L[1], L[2], L[3], H[0], H[1], H[2], H[3]}
  od = __builtin_amdgcn_mfma_f32_32x32x16_bf16(pa0, PK(l0, h0), od, 0, 0, 0);
  od = __builtin_amdgcn_mfma_f32_32x32x16_bf16(pa1, PK(l1, h1), od, 0, 0, 0);
  od = __builtin_amdgcn_mfma_f32_32x32x16_bf16(pa2, PK(l2, h2), od, 0, 0, 0);
  od = __builtin_amdgcn_mfma_f32_32x32x16_bf16(pa3, PK(l3, h3), od, 0, 0, 0);
#undef PK
}
DI void pv_d0(f32x16* o, int vb, bf16x8 pa0, bf16x8 pa1, bf16x8 pa2, bf16x8 pa3) {
  pv_one<0>(o[0], vb, pa0, pa1, pa2, pa3); pv_one<1>(o[1], vb, pa0, pa1, pa2, pa3); pv_one<2>(o[2], vb, pa0, pa1, pa2, pa3); pv_one<3>(o[3], vb, pa0, pa1, pa2, pa3);
}

DI void attn_body(const bf16_t* __restrict__ Qb, const bf16_t* __restrict__ Kh, const bf16_t* __restrict__ Vh, const bf16_t* __restrict__ KRh, bf16_t* __restrict__ Ob, int seq, int tpos0, char* lds) {
  const int tid = ltid(), wid = tid >> 6, lane = tid & 63, r32 = lane & 31, hi = lane >> 5;
  char* V_lds = lds; char* K_lds = lds + 2 * SHM_V; char* KR_lds = lds + 2 * SHM_V + 2 * SHM_K;
  float* ws = (float*)(lds + 2 * SHM_V + 2 * SHM_K + 2 * SHM_KR) + wid * 64; float* li_l = ws; float* al_l = ws + 32;
  float m_reg = -1e30f, l_reg = 0; f32x16 o[4] = {}; bf16x8 qr[12];
  const bf16_t* Qw = Qb + (long)(wid * QBLK + r32) * LDQ + hi * 8;
#pragma unroll
  for (int d0 = 0; d0 < 12; ++d0) qr[d0] = *reinterpret_cast<const bf16x8*>(Qw + d0 * 16);
  if (tpos0 >= 0) {
    const int t = tpos0 + wid * QBLK + r32;
#pragma unroll
    for (int hf = 0; hf < 2; ++hf) { const float pos = (float)(hf ? (t & 63) : (t >> 6));
#pragma unroll
      for (int j = 0; j < 8; ++j) { const float ang = pos * exp2f(-(float)(hi * 8 + j) * (13.287712379549449f / 16.f)); float sv, cv; sincosf(ang, &sv, &cv);
        const float x1 = bf2f((bf16_t)qr[8 + 2 * hf][j]), x2 = bf2f((bf16_t)qr[9 + 2 * hf][j]);
        qr[8 + 2 * hf][j] = (short)f2bf(x1 * cv - x2 * sv); qr[9 + 2 * hf][j] = (short)f2bf(x2 * cv + x1 * sv); } }
  }
  const int sr = tid >> 4, sc = (tid & 15) * 8, vst0 = v_st(sr, sc), vst1 = v_st(32 + sr, sc);
  const int krr = tid >> 3, krc = (tid & 7) * 8;
  const int vb0 = (int)(uintptr_t)V_lds + v_rd_base(lane);
  bf16x8 vs0, vs1, ks0, ks1, kr0;
#define SLOAD(k0) do { vs0 = *reinterpret_cast<const bf16x8*>(&Vh[(long)((k0) + sr) * LDK + sc]); vs1 = *reinterpret_cast<const bf16x8*>(&Vh[(long)((k0) + 32 + sr) * LDK + sc]); \
    ks0 = *reinterpret_cast<const bf16x8*>(&Kh[(long)((k0) + sr) * LDK + sc]); ks1 = *reinterpret_cast<const bf16x8*>(&Kh[(long)((k0) + 32 + sr) * LDK + sc]); \
    kr0 = *reinterpret_cast<const bf16x8*>(&KRh[(long)((k0) + krr) * LDKR + krc]); } while (0)
#define SWRITE(b) do { *(bf16x8*)(V_lds + (b) * SHM_V + vst0) = vs0; *(bf16x8*)(V_lds + (b) * SHM_V + vst1) = vs1; const int kc = sc * 2;               \
    *(bf16x8*)(K_lds + (b) * SHM_K + KSWZ(sr, kc)) = ks0; *(bf16x8*)(K_lds + (b) * SHM_K + KSWZ(32 + sr, kc)) = ks1;                       \
    *(bf16x8*)(KR_lds + (b) * SHM_KR + KRSWZ(krr, krc * 2)) = kr0; } while (0)
#define SWAIT() asm volatile("s_waitcnt vmcnt(0)" ::: "memory")
#define RESC(a) do { if (__any((a) < 1.f)) { if (hi == 0) al_l[r32] = (a); asm volatile("s_waitcnt lgkmcnt(0)" ::: "memory"); \
    _Pragma("unroll") for (int d = 0; d < 4; ++d) _Pragma("unroll") for (int r = 0; r < 16; ++r) o[d][r] *= al_l[crow(r, hi)]; } } while (0)
  f32x16 p0, p1; float mn, al; bf16x8 pa0, pa1, pa2, pa3; const int NT = seq / KVBLK;
  SLOAD(0); SWAIT(); SWRITE(0); __syncthreads();
  for (int j = 0; j < NT; ++j) {
    const int buf = j & 1; const bool more = j + 1 < NT;
    if (more) SLOAD((j + 1) * KVBLK);
    SBAR(); qkt(p0, p1, K_lds + buf * SHM_K, KR_lds + buf * SHM_KR, qr, r32, hi);
    partialSM(p0, p1, m_reg, mn, al); RESC(al);
    finishSM(p0, p1, al, l_reg, pa0, pa1, pa2, pa3); SBAR();
    pv_d0(o, vb0 + buf * SHM_V, pa0, pa1, pa2, pa3);
    if (more) { SWAIT(); SWRITE(buf ^ 1); }
    __syncthreads();
  }
  if (hi == 0) li_l[r32] = l_reg; asm volatile("s_waitcnt lgkmcnt(0)" ::: "memory");
  float rli[16];
#pragma unroll
  for (int r = 0; r < 16; ++r) rli[r] = __builtin_amdgcn_rcpf(li_l[crow(r, hi)]);
  bf16_t* Ow = Ob + (long)(wid * QBLK) * LDO;
#pragma unroll
  for (int r = 0; r < 16; ++r) { const int orow = crow(r, hi);
#pragma unroll
    for (int d0 = 0; d0 < 4; ++d0) Ow[(long)orow * LDO + d0 * 32 + r32] = f2bf(o[d0][r] * rli[r]); }
  __syncthreads();
#undef SLOAD
#undef SWRITE
#undef SWAIT
#undef RESC
}
}

DI void st_attn(const Prm& p, int layer, char* lds, int bid, int nb) {
  const int nlat = NB * 4 * 16, nitem = nlat + (layer == 0 ? NB * 4 : 0);
  for (int it = bid; it < nitem; it += nb) {
    if (it < nlat) { const int b = it >> 6, h = (it >> 4) & 3, qb = it & 15; const size_t r0 = (size_t)b * LT;
      att::attn_body(p.Qraw + (r0 + qb * 256) * 768 + h * 192, p.KV + r0 * 1024 + h * 256, p.KV + r0 * 1024 + h * 256 + 128, p.KR + r0 * 64,
                     p.Y + (r0 + qb * 256) * DM + 1024 + h * 128, LT, qb * 256, lds); }
    else { const int k = it - nlat, b = k >> 2, h = k & 3; const size_t r0 = (size_t)b * LT + LL;
      att::attn_body(p.Qraw + r0 * 768 + h * 192, p.KV + r0 * 1024 + h * 256, p.KV + r0 * 1024 + h * 256 + 128, p.KR + r0 * 64, p.Y + r0 * DM + 1024 + h * 128, LCX, -1, lds); }
  }
}

struct EpiResid {
  static constexpr bool PERM = false, AFTER_DRAIN = false;
  const float* xlat; const float* xctx; float* X; const float* modl; int first;
  __device__ __forceinline__ void operator()(const pg8::f32x4 (&acc)[2][2][4][2], const pg8::Unit& u, int wr, int wc, int fr, int fq) const {
    const int b = u.pm / 17, tl = u.pm - b * 17; const bool isc = tl == 16;
    const float* g = modl + (size_t)(isc ? 8 : b) * NMOD + 2 * DM;
    const int rloc0 = wr * 64 + fr, col0 = u.pn * 256 + wc * 32 + 4 * fq;
    pg8::f32x4 gv[2][2];
#pragma unroll
    for (int bj = 0; bj < 2; ++bj)
#pragma unroll
      for (int n = 0; n < 2; ++n) gv[bj][n] = *(const pg8::f32x4*)(g + col0 + bj * 128 + n * 16);
#pragma unroll
    for (int ai = 0; ai < 2; ++ai)
#pragma unroll
      for (int m = 0; m < 4; ++m) { const int rl = rloc0 + ai * 128 + m * 16; const size_t row = (size_t)u.pm * 256 + rl;
        const float* src = first ? (isc ? xctx + ((size_t)b * LCX + rl) * DM : xlat + ((size_t)b * LL + tl * 256 + rl) * DM) : X + row * DM;
        float* dst = X + row * DM;
#pragma unroll
        for (int bj = 0; bj < 2; ++bj)
#pragma unroll
          for (int n = 0; n < 2; ++n) { const int c = col0 + bj * 128 + n * 16; *(pg8::f32x4*)(dst + c) = *(const pg8::f32x4*)(src + c) + gv[bj][n] * acc[ai][bj][m][n]; } }
  }
};

struct LatentOrder : pg8::StaticOrder {
  __device__ bool next(int i, pg8::Unit& u) const { const bool ok = pg8::StaticOrder::next(i, u); u.pm += u.pm >> 4; return ok; }
};
template <class Epi> DI void run_gemm_lat(unsigned char* lds, const bf16_t* A, const bf16_t* Bt, int N, int K, const Epi& E, int bid, int nb) {
  pg8::Gemm g; g.A = A; g.Bt = Bt; g.M = NB * LL; g.N = N; g.K = K;
  LatentOrder S; S.init(NB * LL, N, nb, bid);
  pg8::gemm_phase<Epi, LatentOrder, false>((PG8_LAS unsigned char*)lds, g, S, E, nullptr);
}
template <class Epi> DI void run_gemm(unsigned char* lds, const bf16_t* A, const bf16_t* Bt, int M, int N, int K, const Epi& E, int bid, int nb) {
  pg8::Gemm g; g.A = A; g.Bt = Bt; g.M = M; g.N = N; g.K = K;
  pg8::StaticOrder S; S.init(M, N, nb, bid);
  pg8::gemm_phase<Epi, pg8::StaticOrder, false>((PG8_LAS unsigned char*)lds, g, S, E, nullptr);
}
DI pg8::EpiBf16<0> epi_bf16(bf16_t* O, int ldc, int split_cols = 0, size_t split_stride = 0) { pg8::EpiBf16<0> e; e.O = O; e.ldc = ldc; e.bias = nullptr; e.split_cols = split_cols; e.split_stride = split_stride; return e; }

#ifndef PROBE
#define PROBE 0
#endif
constexpr int LDS_MAIN = 131072 + 4096, LDS_TOTAL = LDS_MAIN + 64;
#define PRM() (*(const __attribute__((address_space(4))) Prm*)launder_k(kp))
typedef const __attribute__((address_space(4))) void* kptr_t;
DI kptr_t launder_k(kptr_t q) { asm volatile("" : "+s"(q)); return q; }
extern __shared__ __attribute__((aligned(16))) unsigned char shm[];
__global__ void __launch_bounds__(NTHR, 2) mega(Prm p_unused) {
#if defined(__HIP_DEVICE_COMPILE__)
  kptr_t kp = (kptr_t)__builtin_amdgcn_kernarg_segment_ptr();
  const int bid0 = blockIdx.x, nb0 = gridDim.x;
#define bid lsg(bid0)
#define nb lsg(nb0)
  uint4* xbw = (uint4*)(shm + LDS_MAIN);
  if (threadIdx.x == 0) *xbw = make_uint4(0u, 0u, 0u, 0u);
  __syncthreads();
  { const Prm p = PRM(); (void)xcd_barrier_post(p.bar, (volatile LAS unsigned*)xbw); }
#define GRID_BAR() do { XcdBarrier b_; b_.bar = PRM().bar; b_.x = xb_xcc_id(); b_.st = (volatile LAS unsigned*)(shm + LDS_MAIN); xcd_barrier(b_); } while (0)
  float* lf = (float*)shm;
  for (int ly = 0; ly < 2; ++ly) { const Prm p = PRM();
    st_transpose(p.w_in + (size_t)ly * DM * IN_W, p.WinT + (size_t)ly * NZ * DM, DM, IN_W, DM, NZ, lf, bid, nb);
    st_transpose(p.w_out + (size_t)ly * DM * DM, p.WoutT + (size_t)ly * DM * DM, DM, DM, DM, DM, lf, bid, nb);
    st_transpose(p.peer_wq + (size_t)ly * DM * DM, p.WqT + (size_t)ly * DM * DM, DM, DM, DM, DM, lf, bid, nb);
    st_transpose(p.mla_w_uq + (size_t)ly * 448 * 768, p.WuqT + (size_t)ly * 768 * 512, 448, 768, 512, 768, lf, bid, nb);
    st_transpose(p.mla_w_ukv + (size_t)ly * 128 * 1024, p.WukvT + (size_t)ly * 1024 * 256, 128, 1024, 256, 1024, lf, bid, nb);
  }
  { const Prm p = PRM(); st_tables(p, bid, nb); }
  __syncthreads();
  { const Prm p = PRM(); st_mods(p, lf, bid, nb); }
  if (PROBE == 5) { __syncthreads();
    for (int ly = 0; ly < 2; ++ly) { const Prm p = PRM();
      st_transpose(p.w_in + (size_t)ly * DM * IN_W, p.WinT + (size_t)ly * NZ * DM, DM, IN_W, DM, NZ, lf, bid, nb);
      st_transpose(p.w_out + (size_t)ly * DM * DM, p.WoutT + (size_t)ly * DM * DM, DM, DM, DM, DM, lf, bid, nb);
      st_transpose(p.peer_wq + (size_t)ly * DM * DM, p.WqT + (size_t)ly * DM * DM, DM, DM, DM, DM, lf, bid, nb); }
    { const Prm p = PRM(); st_tables(p, bid, nb); }
    __syncthreads();
    { const Prm p = PRM(); st_mods(p, lf, bid, nb); } }
  GRID_BAR();
  for (int l = 0; l < 2; ++l) {
    if (l == 0) { { const Prm p = PRM(); st_modulate(p, l, 0, p.H, bid, nb); } GRID_BAR(); }
    { const Prm p = PRM(); run_gemm(shm, p.H, p.WinT + (size_t)l * NZ * DM, MR, NZ, DM, epi_bf16(p.Z, NZ), bid, nb); }
    if (PROBE == 6) { const Prm p = PRM(); run_gemm(shm, p.H, p.WinT + (size_t)l * NZ * DM, MR, NZ, DM, epi_bf16(p.Z, NZ), bid, nb); }
    GRID_BAR();
    { const Prm p = PRM(); st_dnprep(p, l, bid, nb); }
    { const Prm p = PRM(); st_mlaprep(p, l, bid, nb); }
    { const Prm p = PRM(); st_fnchan(p, shm, bid, nb); }
    GRID_BAR();
    { const Prm p = PRM(); st_dntinv(p, shm, bid, nb); }
    __syncthreads();
    { const Prm p = PRM(); st_glabc(p, l, shm, bid, nb); }
    if (PROBE == 9) { { const Prm p = PRM(); st_dnprep(p, l, bid, nb); } { const Prm p = PRM(); st_mlaprep(p, l, bid, nb); } }
    if (PROBE == 10) { const Prm p = PRM(); st_fnchan(p, shm, bid, nb); }
    GRID_BAR();
    { const Prm p = PRM(); run_gemm(shm, p.Aq, p.WuqT + (size_t)l * 768 * 512, MR, 768, 512, epi_bf16(p.Qraw, 768), bid, nb); }
    { const Prm p = PRM(); run_gemm(shm, p.Akv, p.WukvT + (size_t)l * 1024 * 256, MR, 1024, 256, epi_bf16(p.KV, 1024), bid, nb); }
    if (bid < 128) { const Prm p = PRM(); st_dnscan(p, shm, bid, 128); }
    else { const Prm p = PRM(); st_glascan(p, l, shm, bid - 128, 128); }
    if (PROBE == 7) { GRID_BAR(); if (bid < 128) { const Prm p = PRM(); st_dnscan(p, shm, bid, 128); } }
    if (PROBE == 8) { GRID_BAR(); if (bid < 128) { const Prm p = PRM(); st_glascan(p, l, shm, bid, 128); } }
    if (PROBE == 2) { GRID_BAR(); if (bid < 128) { const Prm p = PRM(); st_dnscan(p, shm, bid, 128); } else { const Prm p = PRM(); st_glascan(p, l, shm, bid - 128, 128); } }
    GRID_BAR();
    { const Prm p = PRM(); st_attn(p, l, (char*)shm, bid, nb); }
    if (PROBE == 3) { const Prm p = PRM(); st_attn(p, l, (char*)shm, bid, nb); }
    { const Prm p = PRM(); run_gemm(shm, p.DFTM, p.PQT, 4096, 4096, 8192, epi_bf16(p.Y + 1536, DM, 512, (size_t)LT * DM), bid, nb); }
    if (l == 0) { const Prm p = PRM(); run_gemm(shm, p.DFTC, p.PQTc, 256, 4096, 512, epi_bf16(p.Y + (size_t)LL * DM + 1536, DM, 512, (size_t)LT * DM), bid, nb); }
    { const Prm p = PRM(); st_combine(p, l, bid, nb); }
    GRID_BAR();
    { const Prm p = PRM(); EpiResid e; e.xlat = p.x; e.xctx = p.ctx; e.X = p.X; e.modl = p.mod + (size_t)l * 9 * NMOD; e.first = l == 0;
      if (l == 0) run_gemm(shm, p.Y, p.WoutT + (size_t)l * DM * DM, MR, DM, DM, e, bid, nb);
      else run_gemm_lat(shm, p.Y, p.WoutT + (size_t)l * DM * DM, DM, DM, e, bid, nb); }
    GRID_BAR();
    { const Prm p = PRM(); st_modulate(p, l, 1, p.H2, bid, nb); }
    { const Prm p = PRM(); st_cvt_tables(p, l, bid, nb); }
    GRID_BAR();
    if (l == 0) { const Prm p = PRM(); run_gemm(shm, p.H2, p.WqT + (size_t)l * DM * DM, MR, DM, DM, epi_bf16(p.Qp, DM), bid, nb); }
    else { const Prm p = PRM(); run_gemm_lat(shm, p.H2, p.WqT + (size_t)l * DM * DM, DM, DM, epi_bf16(p.Qp, DM), bid, nb); }
    GRID_BAR();
    { const Prm p = PRM(); st_peertopk(p, l, shm, bid, nb); }
    if (PROBE == 4) { __syncthreads(); const Prm p = PRM(); st_peertopk(p, l, shm, bid, nb); }
    GRID_BAR();
    { const Prm p = PRM(); st_peergather(p, l, lf, bid, nb); }
    if (PROBE == 1) { __syncthreads(); const Prm p = PRM(); st_peergather(p, l, lf, bid, nb, true); }
    if (l == 0) GRID_BAR();
  }
#endif
#undef bid
#undef nb
#undef GRID_BAR
}

static size_t al256(size_t x) { return (x + 255) / 256 * 256; }
extern "C" void kernel_launch(void* const* d_in, const int* in_sizes, int n_in, void* d_out, int out_size, void* d_ws, size_t ws_size, hipStream_t stream) {
  Prm p{};
  const float** f = (const float**)&p.x;
  for (int i = 0; i < 24; ++i) f[i] = (const float*)d_in[i];
  p.out = (float*)d_out;
  char* w = (char*)d_ws; size_t o = 0;
  auto take = [&](size_t bytes) { char* r = w + o; o += al256(bytes); return r; };
  p.bar = (unsigned*)take(16384);
  p.WinT = (bf16_t*)take((size_t)2 * NZ * DM * 2); p.WoutT = (bf16_t*)take((size_t)2 * DM * DM * 2); p.WqT = (bf16_t*)take((size_t)2 * DM * DM * 2);
  p.WuqT = (bf16_t*)take((size_t)2 * 768 * 512 * 2); p.WukvT = (bf16_t*)take((size_t)2 * 1024 * 256 * 2);
  p.mod = (float*)take((size_t)2 * 9 * NMOD * 4); p.GB = (float*)take((size_t)MR * 16 * 4); p.CCS = (float*)take((size_t)2 * 128 * 128 * 4);
  p.DFTM = (bf16_t*)take((size_t)4096 * 8192 * 2); p.DFTC = (bf16_t*)take((size_t)256 * 512 * 2);
  p.X = (float*)take((size_t)MR * DM * 4);
  p.Z = (bf16_t*)take((size_t)MR * NZ * 2);
  char* ra = take((size_t)MR * 1536 * 2 + (size_t)4 * MR * 512 * 2);
  p.DNQ = (bf16_t*)ra; p.OB = (bf16_t*)(ra + (size_t)MR * 1536 * 2); p.H = (bf16_t*)ra;
  p.Ub = (bf16_t*)(ra + (size_t)MR * DM * 2); p.Vb = (bf16_t*)(ra + (size_t)MR * DM * 2 + (size_t)16384 * DM);
  p.KV = (bf16_t*)take((size_t)MR * 1024 * 2); p.KR = (bf16_t*)take((size_t)MR * 64 * 2);
  p.Aq = (bf16_t*)take((size_t)MR * 512 * 2); p.Akv = (bf16_t*)take((size_t)MR * 256 * 2);
  if (o > ws_size) return;
  char* q = (char*)d_out; size_t oo = 0;
  p.Y = (bf16_t*)q; oo += (size_t)MR * DM * 2; p.PQT = (bf16_t*)(q + oo); oo += (size_t)8 * 512 * 8192 * 2; p.PQTc = (bf16_t*)(q + oo); oo += (size_t)8 * 512 * 512 * 2;
  p.Qraw = (bf16_t*)(q + oo); oo += (size_t)MR * 768 * 2;
  p.TINV = (bf16_t*)q; p.GCB = (float*)(q + (size_t)4352 * 4096 * 2); p.BC = (float*)(q + (size_t)4352 * 4096 * 2 + (size_t)4352 * 64 * 4);
  char* z = (char*)p.Z; p.H2 = (bf16_t*)z; p.Qp = (bf16_t*)(z + (size_t)MR * DM * 2); p.IDX = (int*)(z + (size_t)2 * MR * DM * 2); p.GATE = (float*)(z + (size_t)2 * MR * DM * 2 + (size_t)MR * 128 * 4);

  static int grid = 0;
  if (!grid) {
    (void)hipFuncSetAttribute((const void*)mega, hipFuncAttributeMaxDynamicSharedMemorySize, LDS_TOTAL);
    int dev = 0, cus = 0, per_cu = 0;
    (void)hipGetDevice(&dev); (void)hipDeviceGetAttribute(&cus, hipDeviceAttributeMultiprocessorCount, dev);
    (void)hipOccupancyMaxActiveBlocksPerMultiprocessor(&per_cu, (const void*)mega, NTHR, LDS_TOTAL);
    grid = per_cu >= 1 ? cus : 0;
    if (grid > 256) grid = 256;
  }
  if (grid < 256) return;
  (void)hipMemsetAsync(p.bar, 0, XCD_BAR_WORDS * sizeof(unsigned), stream);
  hipLaunchKernelGGL(mega, dim3(grid), dim3(NTHR), LDS_TOTAL, stream, p);
}
```

```cpp
#include <hip/hip_runtime.h>
#include <stdint.h>

constexpr int DM = 2048, NB = 8, LL = 4096, LCX = 256, LT = LL + LCX  , MR = NB * LT  ;
constexpr int NZ = 4864;
constexpr int C_DNQ = 0, C_DNK = 512, C_DNV = 1024, C_DNGATE = 1536, C_DNA = 2048, C_DNB = 2056, C_GQ = 2064, C_GK = 2320, C_GV = 2576,
              C_GGATE = 3088, C_GALPHA = 3600, C_CQ = 3632, C_CKV = 4080, C_KR = 4208, C_FN = 4272, IN_W = 4784;
constexpr int NMOD = 6 * DM;
constexpr float EPSV = 1e-6f;
constexpr int NTHR = 512;

typedef unsigned short bf16_t;
typedef short bf16x8 __attribute__((ext_vector_type(8)));
typedef short s16x4 __attribute__((ext_vector_type(4)));
typedef float f32x4 __attribute__((ext_vector_type(4)));
typedef float f32x16 __attribute__((ext_vector_type(16)));
typedef unsigned u32x4 __attribute__((ext_vector_type(4)));
typedef unsigned u32x2 __attribute__((ext_vector_type(2)));

#define DI __device__ __forceinline__
DI float bf2f(bf16_t b) { return __uint_as_float(((unsigned)b) << 16); }
DI bf16_t f2bf(float f) { unsigned u = __float_as_uint(f); u += 0x7FFFu + ((u >> 16) & 1u); return (bf16_t)(u >> 16); }
DI unsigned pack2(float lo, float hi) { return (unsigned)f2bf(lo) | ((unsigned)f2bf(hi) << 16); }
typedef float f32x2 __attribute__((ext_vector_type(2)));
DI float dpp_x1(float v) { return __int_as_float(__builtin_amdgcn_mov_dpp(__float_as_int(v), 0xB1, 0xf, 0xf, true)); }
DI float dpp_x2(float v) { return __int_as_float(__builtin_amdgcn_mov_dpp(__float_as_int(v), 0x4E, 0xf, 0xf, true)); }
DI float dpp_hm(float v) { return __int_as_float(__builtin_amdgcn_mov_dpp(__float_as_int(v), 0x141, 0xf, 0xf, true)); }
DI float dpp_rm(float v) { return __int_as_float(__builtin_amdgcn_mov_dpp(__float_as_int(v), 0x140, 0xf, 0xf, true)); }
DI float red4(float v) { v += dpp_x1(v); v += dpp_x2(v); return v; }
DI float red8(float v) { v += dpp_x1(v); v += dpp_x2(v); v += dpp_hm(v); return v; }
DI float rdl(float v, int l) { return __int_as_float(__builtin_amdgcn_readlane(__float_as_int(v), l)); }
DI float wsum(float v) { v += dpp_x1(v); v += dpp_x2(v); v += dpp_hm(v); v += dpp_rm(v); return (rdl(v, 0) + rdl(v, 16)) + (rdl(v, 32) + rdl(v, 48)); }
DI float wmax(float v) { v = fmaxf(v, dpp_x1(v)); v = fmaxf(v, dpp_x2(v)); v = fmaxf(v, dpp_hm(v)); v = fmaxf(v, dpp_rm(v)); return fmaxf(fmaxf(rdl(v, 0), rdl(v, 16)), fmaxf(rdl(v, 32), rdl(v, 48))); }
DI float siluf(float x) { return x / (1.f + __expf(-x)); }
DI float sigmf(float x) { return 1.f / (1.f + __expf(-x)); }

DI int ltid() { int t = (int)threadIdx.x; asm volatile("" : "+v"(t)); return t; }
DI int lsg(int v) { asm volatile("" : "+s"(v)); return v; }

struct Prm {
  const float *x, *c, *ctx, *c_ctx, *w_ada, *b_ada, *w_in, *dn_conv, *dn_a_log, *dn_dt_bias, *dn_norm, *gla_w2, *gla_b2, *gla_norm,
      *mla_q_norm, *mla_w_uq, *mla_kv_norm, *mla_w_ukv, *w_out, *peer_wq, *peer_keys, *peer_u, *peer_v, *final_norm;
  float* out;
  bf16_t *WinT, *WoutT, *WqT, *WuqT, *WukvT;
  float *mod, *GB, *CCS;
  bf16_t *DFTM, *DFTC;
  float* X;
  bf16_t* Z;
  bf16_t *H, *DNQ, *OB;
  bf16_t *KV, *KR;
  bf16_t *Y, *PQT, *PQTc, *Qraw, *Aq, *Akv;
  bf16_t *H2, *Qp;
  bf16_t *Ub, *Vb;
  bf16_t* TINV; float* GCB; float* BC;
  int* IDX;
  float* GATE;
  unsigned* bar;
};
#define XB_TMO      128
#define XB_XCNT(j)  (256  + 64 * (j))
#define XB_XSUB(j)  (1280 + 64 * (j))
#define XB_XGEN(j)  (2304 + 64 * (j))
#define XB_TOP      3328
#define XB_TOPGEN   3392
#define XCD_BAR_WORDS 3456
#define XB_SPIN_CAP (1u << 18)
#define LAS __attribute__((address_space(3)))

__device__ __forceinline__ unsigned xb_ld(unsigned* p)              { return __hip_atomic_load(p, __ATOMIC_RELAXED, __HIP_MEMORY_SCOPE_AGENT); }
__device__ __forceinline__ unsigned xb_add(unsigned* p, unsigned v) { return __hip_atomic_fetch_add(p, v, __ATOMIC_RELAXED, __HIP_MEMORY_SCOPE_AGENT); }
__device__ __forceinline__ unsigned xb_xcc_id() { return (unsigned)__builtin_amdgcn_s_getreg((3 << 11) | 20) & 0xFu; }
#define XB_SPIN(cond, bar) do { unsigned _sp = 0; while (cond) { __builtin_amdgcn_s_sleep(1); \
    if ((++_sp & 255u) == 0u) { if (xb_ld(&(bar)[XB_TMO])) break; if (_sp > XB_SPIN_CAP) { atomicAdd(&(bar)[XB_TMO], 1u); break; } } } } while (0)

struct XcdBarrier {
    unsigned* bar; unsigned x;
    volatile LAS unsigned* st;
};

__device__ __forceinline__ XcdBarrier xcd_barrier_post(unsigned* bar, volatile LAS unsigned* st) {
    XcdBarrier b; b.bar = bar; b.x = xb_xcc_id(); b.st = st;
    if (threadIdx.x == 0) (void)xb_add(&bar[XB_XCNT(b.x)], 1u);
    return b;
}
__device__ __forceinline__ void xcd_barrier_complete(unsigned* bar, unsigned x, unsigned& nloc, unsigned& nx) {
    const unsigned G = gridDim.x * gridDim.y * gridDim.z;
    unsigned sum, cnt, mine, sp = 0u;
    for (;;) {
        sum = 0u; cnt = 0u; mine = 0u;
#pragma unroll
        for (unsigned j = 0; j < 16; ++j) { const unsigned c = xb_ld(&bar[XB_XCNT(j)]); sum += c; cnt += (c > 0u) ? 1u : 0u; mine = (j == x) ? c : mine; }
        if (sum == G) break;
        __builtin_amdgcn_s_sleep(1);
        if ((++sp & 255u) == 0u) { if (xb_ld(&bar[XB_TMO])) break; if (sp > XB_SPIN_CAP) { atomicAdd(&bar[XB_TMO], 1u); break; } }
    }
    nloc = mine > 0u ? mine : 1u; nx = cnt > 0u ? cnt : 1u;
}

__device__ __forceinline__ void xcd_barrier(const XcdBarrier& b) {
    asm volatile("s_waitcnt vmcnt(0)" ::: "memory");
    __syncthreads();
    if (threadIdx.x == 0) {
        unsigned* bar = b.bar;
        __builtin_amdgcn_s_waitcnt(0);
        unsigned nloc = b.st[0], nx = b.st[1];
        if (nloc == 0u) { xcd_barrier_complete(bar, b.x, nloc, nx); b.st[0] = nloc; b.st[1] = nx; }
        const unsigned old = xb_add(&bar[XB_XSUB(b.x)], 1u);
        const unsigned gen = old / nloc;
        if (old + 1u == (gen + 1u) * nloc) {
            __builtin_amdgcn_fence(__ATOMIC_RELEASE, "agent");
            asm volatile("s_waitcnt vmcnt(0)" ::: "memory");
            const unsigned og = xb_add(&bar[XB_TOP], 1u);
            const unsigned tg = og / nx;
            if (og + 1u == (tg + 1u) * nx) xb_add(&bar[XB_TOPGEN], 1u);
            else XB_SPIN(xb_ld(&bar[XB_TOPGEN]) == tg, bar);
            __builtin_amdgcn_fence(__ATOMIC_ACQUIRE, "agent");
            xb_add(&bar[XB_XGEN(b.x)], 1u);
            asm volatile("s_waitcnt vmcnt(0)" ::: "memory");
        } else {
            XB_SPIN(xb_ld(&bar[XB_XGEN(b.x)]) == gen, bar);
            __builtin_amdgcn_fence(__ATOMIC_ACQUIRE, "agent");
            asm volatile("s_waitcnt vmcnt(0)" ::: "memory");
        }
    }
    __syncthreads();
}

namespace pg8 {
#define PG8_LAS __attribute__((address_space(3)))
typedef unsigned short bf16_t;
typedef short bf16x8 __attribute__((ext_vector_type(8)));
typedef float f32x4 __attribute__((ext_vector_type(4)));
typedef unsigned u32x4 __attribute__((ext_vector_type(4)));
constexpr int BM = 256, BK = 64, HALF = 128, HTB = HALF * BK * 2  , STAGE_BYTES = 8 * HTB, NXCD = 8, WGM = 8;

__host__ __device__ __forceinline__ int lds_byte(int r, int c) { const int st = (r >> 4) * 2 + (c >> 5), rr = r & 15, cc = c & 31, ob = rr * 64 + cc * 2; return st * 1024 + (ob ^ (((ob >> 9) & 1) << 5)); }
__host__ __device__ __forceinline__ void stage_rc(int b, int& R, int& C) { const int st = b / 1024, sb = b % 1024, swz = sb ^ (((sb >> 9) & 1) << 5); R = (st >> 1) * 16 + swz / 64; C = (st & 1) * 32 + (swz % 64) / 2; }
__host__ __device__ __forceinline__ int perm32(int rho) { const int n = rho >> 4, i = rho & 15; return 8 * (i >> 2) + 4 * n + (i & 3); }

struct Unit { int pm, pn; };
struct Gemm { const bf16_t* A; const bf16_t* Bt; int M, N, K; };

struct StaticOrder {
    int nM, nN, nwg, G, c;
    __host__ __device__ void init(int M, int N, int G_, int c_) { nM = M / BM; nN = N / BM; nwg = nM * nN; G = G_; c = c_; }
    __host__ __device__ bool next(int i, Unit& u) const {
        const long L = (long)i * G + c; if (L >= nwg) return false;
        int wgid = (int)L; { const int q = nwg / NXCD, r = nwg % NXCD, xcd = wgid % NXCD, off = wgid / NXCD; wgid = (xcd < r ? xcd * (q + 1) : r * (q + 1) + (xcd - r) * q) + off; }
        const int nig = WGM * nN, gid = wgid / nig, fm = gid * WGM, gsz = (nM - fm) < WGM ? (nM - fm) : WGM;
        u.pm = fm + ((wgid % nig) % gsz); u.pn = (wgid % nig) / gsz; return true;
    }
    __device__ __forceinline__ void a_ready(const Unit&) const {}
    __device__ __forceinline__ void done(const Unit&) const {}
};
struct CountedOrder : StaticOrder {
    const unsigned* ready; unsigned need; unsigned* tmo;
    __device__ __forceinline__ void a_ready(const Unit& u) const {
        if (threadIdx.x < 64) {
            const unsigned long long t0 = __builtin_amdgcn_s_memrealtime(); unsigned polls = 0;
            while ((unsigned)__builtin_amdgcn_readfirstlane(__hip_atomic_load(ready + 64 * u.pm, __ATOMIC_RELAXED, __HIP_MEMORY_SCOPE_AGENT)) < need) {
                if ((++polls & 255u) == 0u && __builtin_amdgcn_readfirstlane(__hip_atomic_load(tmo, __ATOMIC_RELAXED, __HIP_MEMORY_SCOPE_AGENT)) != 0u) break;
                if (__builtin_amdgcn_s_memrealtime() - t0 > 2000000ull) {
                    if (threadIdx.x == 0) { unsigned expect = 0u; __hip_atomic_compare_exchange_strong(tmo + 1, &expect, 0x600u | (unsigned)(u.pm & 0xff), __ATOMIC_RELAXED, __ATOMIC_RELAXED, __HIP_MEMORY_SCOPE_AGENT); __hip_atomic_store(tmo, 1u, __ATOMIC_RELAXED, __HIP_MEMORY_SCOPE_AGENT); }
                    break; }
                __builtin_amdgcn_s_sleep(2); }
            __builtin_amdgcn_fence(__ATOMIC_ACQUIRE, "agent");
            asm volatile("s_waitcnt vmcnt(0)" ::: "memory");
        }
#if !defined(BROKEN_HOOK_NO_BARRIER)
        asm volatile("" ::: "memory"); __builtin_amdgcn_s_barrier(); asm volatile("" ::: "memory");
#endif
    }
};

__device__ __forceinline__ unsigned cvt_pk_bf16(float lo, float hi) { unsigned r; asm volatile("v_cvt_pk_bf16_f32 %0, %1, %2" : "=v"(r) : "v"(lo), "v"(hi)); return r; }
typedef float f32x2 __attribute__((ext_vector_type(2)));
__device__ __forceinline__ f32x2 gelu_pk(f32x2 v) {
    const f32x2 av = __builtin_elementwise_abs(v), d = av * 0.2316418882f + 1.0f;
    f32x2 t; t.x = __builtin_amdgcn_rcpf(d.x); t.y = __builtin_amdgcn_rcpf(d.y);
    f32x2 q = t * 0.5307027145f + (-0.7265760135f); q = q * t + 0.7107068705f; q = q * t + (-0.142248368f); q = q * t + 0.127414796f; q = q * t;
    const f32x2 s = (v * v) * (-0.72134752044f);
    f32x2 e; e.x = __builtin_amdgcn_exp2f(s.x); e.y = __builtin_amdgcn_exp2f(s.y);
    const f32x2 m = v * (q * e), r = v - m;
    f32x2 o; o.x = v.x < 0.f ? m.x : r.x; o.y = v.y < 0.f ? m.y : r.y; return o;
}

struct EpiF32 {
    static constexpr bool PERM = false, AFTER_DRAIN = false;
    float* C; int ldc; const float* bias;
    __device__ __forceinline__ void operator()(const f32x4 (&acc)[2][2][4][2], const Unit& u, int wr, int wc, int fr, int fq) const {
        const int row0 = u.pm * BM + wr * 64 + fr, col0 = u.pn * BM + wc * 32 + 4 * fq;
        f32x4 bv[2][2];
#pragma unroll
        for (int bj = 0; bj < 2; ++bj)
#pragma unroll
            for (int n = 0; n < 2; ++n) bv[bj][n] = bias ? *(const f32x4*)(bias + col0 + bj * HALF + n * 16) : (f32x4){0.f, 0.f, 0.f, 0.f};
#pragma unroll
        for (int ai = 0; ai < 2; ++ai)
#pragma unroll
            for (int m = 0; m < 4; ++m) { float* rowp = C + (size_t)(row0 + ai * HALF + m * 16) * ldc + col0;
#pragma unroll
                for (int bj = 0; bj < 2; ++bj)
#pragma unroll
                    for (int n = 0; n < 2; ++n) *(f32x4*)(rowp + bj * HALF + n * 16) = acc[ai][bj][m][n] + bv[bj][n]; }
    }
};
template <int ACT  > struct EpiBf16 {
    static constexpr bool PERM = true, AFTER_DRAIN = false;
    bf16_t* O; int ldc; const float* bias; int split_cols; size_t split_stride;
    __device__ __forceinline__ void operator()(const f32x4 (&acc)[2][2][4][2], const Unit& u, int wr, int wc, int fr, int fq) const {
        const int row0 = u.pm * BM + wr * 64 + fr; int colt = u.pn * BM; bf16_t* base = O;
        if (split_cols) { const int t = colt / split_cols; base += (size_t)t * split_stride; colt -= t * split_cols; }
        const int col0 = colt + wc * 32 + 8 * fq, bcol0 = u.pn * BM + wc * 32 + 8 * fq;
        f32x4 bv[2][2];
#pragma unroll
        for (int bj = 0; bj < 2; ++bj)
#pragma unroll
            for (int n = 0; n < 2; ++n) bv[bj][n] = bias ? *(const f32x4*)(bias + bcol0 + bj * HALF + 4 * n) : (f32x4){0.f, 0.f, 0.f, 0.f};
#pragma unroll
        for (int ai = 0; ai < 2; ++ai)
#pragma unroll
            for (int m = 0; m < 4; ++m) { bf16_t* rowp = base + (size_t)(row0 + ai * HALF + m * 16) * ldc + col0;
#pragma unroll
                for (int bj = 0; bj < 2; ++bj) { f32x4 v0 = acc[ai][bj][m][0] + bv[bj][0], v1 = acc[ai][bj][m][1] + bv[bj][1];
                    if (ACT == 1) { f32x2 a = gelu_pk((f32x2){v0[0], v0[1]}), b = gelu_pk((f32x2){v0[2], v0[3]}), c = gelu_pk((f32x2){v1[0], v1[1]}), d = gelu_pk((f32x2){v1[2], v1[3]});
                        v0 = (f32x4){a.x, a.y, b.x, b.y}; v1 = (f32x4){c.x, c.y, d.x, d.y}; }
                    if (ACT == 2) {
#pragma unroll
                        for (int j = 0; j < 4; ++j) { v0[j] = 0.5f * v0[j] * (1.0f + erff(v0[j] * 0.70710678f)); v1[j] = 0.5f * v1[j] * (1.0f + erff(v1[j] * 0.70710678f)); } }
                    u32x4 w; w.x = cvt_pk_bf16(v0[0], v0[1]); w.y = cvt_pk_bf16(v0[2], v0[3]); w.z = cvt_pk_bf16(v1[0], v1[1]); w.w = cvt_pk_bf16(v1[2], v1[3]);
                    *(u32x4*)(rowp + bj * HALF) = w; } }
    }
};
template <class Epi, class Sched, bool STAMP = false>
__device__ __forceinline__ void gemm_phase(PG8_LAS unsigned char* lds, const Gemm g, const Sched& S, const Epi& E, unsigned long long* stamps) {
    const int tid = ltid(), wid = __builtin_amdgcn_readfirstlane(tid >> 6), lane = tid & 63, wr = wid >> 2, wc = wid & 3, fr = lane & 15, fq = lane >> 4;
    const int K = g.K, nt = K / BK;
    int ts_lo = 0, ts_hi = 0, nts = 0; const unsigned long long rt_entry = STAMP ? (unsigned long long)wall_clock64() : 0ull;
#define PG8_STAMP() do { if (STAMP && wid == 0 && nts < 64) { const unsigned long long _c = (unsigned long long)clock64(); \
        ts_lo = (lane == nts) ? (int)(unsigned)_c : ts_lo; ts_hi = (lane == nts) ? (int)(unsigned)(_c >> 32) : ts_hi; ++nts; } } while (0)
    PG8_STAMP();
    unsigned voffA[2], voffB[2];
#pragma unroll
    for (int i = 0; i < 2; ++i) { int R, C; stage_rc(tid * 16 + i * 8192, R, C); const int Rb = Epi::PERM ? ((R & ~31) + perm32(R & 31)) : R;
        voffA[i] = (unsigned)(R * K + C) * 2u; voffB[i] = (unsigned)(Rb * K + C) * 2u; }
    const size_t kstep = (size_t)(BK * 2);
    const size_t hstep = (size_t)HALF * K * 2;
    const size_t tstep = 2 * hstep;
    const unsigned ldsw = (unsigned)wid * 1024u;
    const int aoff = lds_byte(wr * 64 + fr, fq * 8), boff = lds_byte(wc * 32 + fr, fq * 8);
#define PG8_SA(b, h) (((b) * 2 + (h)) * HTB)
#define PG8_SB(b, h) ((4 + (b) * 2 + (h)) * HTB)
#define PG8_STAGE(bufoff, gbase, voff) do { _Pragma("unroll") for (int _i = 0; _i < 2; ++_i) \
        __builtin_amdgcn_global_load_lds((const unsigned*)((const char*)(gbase) + (voff)[_i]), (PG8_LAS unsigned*)(lds + (bufoff) + ldsw + _i * 8192), 16, 0, 0); } while (0)
#define PG8_LDA(dst, b, h) do { _Pragma("unroll") for (int m = 0; m < 4; ++m) _Pragma("unroll") for (int k = 0; k < 2; ++k) dst[m][k] = *(const PG8_LAS bf16x8*)(lds + PG8_SA(b, h) + aoff + m * 2048 + k * 1024); } while (0)
#define PG8_LDB(dst, b, h) do { _Pragma("unroll") for (int n = 0; n < 2; ++n) _Pragma("unroll") for (int k = 0; k < 2; ++k) dst[n][k] = *(const PG8_LAS bf16x8*)(lds + PG8_SB(b, h) + boff + n * 2048 + k * 1024); } while (0)
#define PG8_MMA(ai, bj, At, Bt) do { __builtin_amdgcn_s_setprio(1); _Pragma("unroll") for (int m = 0; m < 4; ++m) _Pragma("unroll") for (int n = 0; n < 2; ++n) _Pragma("unroll") for (int k = 0; k < 2; ++k) \
        acc[ai][bj][m][n] = __builtin_amdgcn_mfma_f32_16x16x32_bf16(Bt[n][k], At[m][k], acc[ai][bj][m][n], 0, 0, 0); __builtin_amdgcn_s_setprio(0); } while (0)
#define PG8_WAIT_V(n) asm volatile("s_waitcnt vmcnt(" #n ")" ::: "memory")
#define PG8_WAIT_L(n) asm volatile("s_waitcnt lgkmcnt(" #n ")" ::: "memory")
#define PG8_BAR __builtin_amdgcn_s_barrier()
#define PG8_SCHED __builtin_amdgcn_sched_barrier(0)
    Unit cur, nxt; int ui = 0;
    if (!S.next(0, cur)) return;
    f32x4 acc[2][2][4][2];
#pragma unroll
    for (int a = 0; a < 2; ++a)
#pragma unroll
        for (int b = 0; b < 2; ++b)
#pragma unroll
            for (int m = 0; m < 4; ++m)
#pragma unroll
                for (int n = 0; n < 2; ++n) acc[a][b][m][n] = (f32x4){0.f, 0.f, 0.f, 0.f};
    bf16x8 At[4][2], B0[2][2], B1[2][2];
    const char* cA = (const char*)g.A + (size_t)cur.pm * tstep; const char* cB = (const char*)g.Bt + (size_t)cur.pn * tstep;
    S.a_ready(cur);
    PG8_STAGE(PG8_SB(0, 0), cB, voffB); PG8_STAGE(PG8_SA(0, 0), cA, voffA); PG8_STAGE(PG8_SB(0, 1), cB + hstep, voffB); PG8_STAGE(PG8_SA(0, 1), cA + hstep, voffA);
    if (wr == 1) PG8_BAR;
    PG8_WAIT_V(4); PG8_BAR;
    PG8_STAGE(PG8_SB(1, 0), cB + kstep, voffB); PG8_STAGE(PG8_SA(1, 0), cA + kstep, voffA); PG8_STAGE(PG8_SB(1, 1), cB + hstep + kstep, voffB);
    PG8_WAIT_V(6); PG8_BAR;
    PG8_STAMP();
    for (;;) {
        const bool has_next = S.next(ui + 1, nxt);
        const char* nA = has_next ? (const char*)g.A + (size_t)nxt.pm * tstep : cA; const char* nB = has_next ? (const char*)g.Bt + (size_t)nxt.pn * tstep : cB;
        for (int t = 0; t < nt; t += 2) {
            const bool last = (t == nt - 2);
            const char* a1 = cA + (size_t)(t + 1) * kstep;
            const char* a2 = last ? nA : cA + (size_t)(t + 2) * kstep; const char* b2 = last ? nB : cB + (size_t)(t + 2) * kstep;
            const char* a3 = a2 + kstep; const char* b3 = b2 + kstep;
            if (last && has_next) S.a_ready(nxt);
            PG8_LDB(B0, 0, 0); PG8_SCHED; PG8_LDA(At, 0, 0); PG8_STAGE(PG8_SA(1, 1), a1 + hstep, voffA);
            PG8_WAIT_L(8); PG8_BAR; PG8_WAIT_L(0); PG8_MMA(0, 0, At, B0); PG8_BAR; PG8_SCHED;
            PG8_LDB(B1, 0, 1); PG8_STAGE(PG8_SB(0, 0), b2, voffB);
            PG8_BAR; PG8_WAIT_L(0); PG8_MMA(0, 1, At, B1); PG8_BAR;
            PG8_LDA(At, 0, 1); PG8_STAGE(PG8_SA(0, 0), a2, voffA);
            PG8_BAR; PG8_WAIT_L(0); PG8_MMA(1, 0, At, B0); PG8_BAR; PG8_SCHED;
            PG8_STAGE(PG8_SB(0, 1), b2 + hstep, voffB);
            PG8_WAIT_V(6); PG8_BAR; PG8_MMA(1, 1, At, B1); PG8_BAR;
            PG8_LDB(B0, 1, 0); PG8_SCHED; PG8_LDA(At, 1, 0); PG8_STAGE(PG8_SA(0, 1), a2 + hstep, voffA);
            PG8_WAIT_L(8); PG8_BAR; PG8_WAIT_L(0); PG8_MMA(0, 0, At, B0); PG8_BAR; PG8_SCHED;
            PG8_LDB(B1, 1, 1); PG8_STAGE(PG8_SB(1, 0), b3, voffB);
            PG8_BAR; PG8_WAIT_L(0); PG8_MMA(0, 1, At, B1); PG8_BAR;
            PG8_LDA(At, 1, 1); PG8_STAGE(PG8_SA(1, 0), a3, voffA);
            PG8_BAR; PG8_WAIT_L(0); PG8_MMA(1, 0, At, B0); PG8_BAR; PG8_SCHED;
            PG8_STAGE(PG8_SB(1, 1), b3 + hstep, voffB);
            PG8_WAIT_V(6); PG8_BAR; PG8_MMA(1, 1, At, B1); PG8_BAR;
        }
        PG8_STAMP();
        if constexpr (!Epi::AFTER_DRAIN) { E(acc, cur, wr, wc, fr, fq); S.done(cur); }
        PG8_STAMP();
        if (!has_next) break;
#pragma unroll
        for (int a = 0; a < 2; ++a)
#pragma unroll
            for (int b = 0; b < 2; ++b)
#pragma unroll
                for (int m = 0; m < 4; ++m)
#pragma unroll
                    for (int n = 0; n < 2; ++n) acc[a][b][m][n] = (f32x4){0.f, 0.f, 0.f, 0.f};
        cur = nxt; cA = nA; cB = nB; ++ui;
    }
    PG8_WAIT_V(0);
    if (wr == 0) PG8_BAR;
    PG8_BAR;
    if constexpr (Epi::AFTER_DRAIN) { E.fused(acc, cur, wr, wc, fr, fq, lds, wid, lane); S.done(cur); }
    PG8_STAMP();
    if (STAMP && wid == 0) { stamps[lane] = lane < nts ? (((unsigned long long)(unsigned)ts_hi << 32) | (unsigned)ts_lo) : 0ull;
        if (lane == 62) stamps[62] = rt_entry; if (lane == 63) stamps[63] = (unsigned long long)wall_clock64(); }
#undef PG8_STAMP
#undef PG8_SA
#undef PG8_SB
#undef PG8_STAGE
#undef PG8_LDA
#undef PG8_LDB
#undef PG8_MMA
#undef PG8_WAIT_V
#undef PG8_WAIT_L
#undef PG8_BAR
#undef PG8_SCHED
}
}

DI void st_transpose(const float* __restrict__ src, bf16_t* __restrict__ dst, int K, int N, int Kpad, int Npad, float* lds, int bid, int nb) {
  const int tk = Kpad / 64, tn = Npad / 64;
  for (int it = bid; it < tk * tn; it += nb) {
    const int k0 = (it % tk) * 64, n0 = (it / tk) * 64;
    __syncthreads();
    for (int e = ltid(); e < 4096; e += NTHR) { const int i = e >> 6, j = e & 63, k = k0 + i, n = n0 + j; lds[i * 65 + j] = (k < K && n < N) ? src[(size_t)k * N + n] : 0.f; }
    __syncthreads();
    for (int e = ltid(); e < 4096; e += NTHR) { const int j = e >> 6, i = e & 63; dst[(size_t)(n0 + j) * Kpad + k0 + i] = f2bf(lds[i * 65 + j]); }
  }
}

DI void st_mods(const Prm& p, float* lds, int bid, int nb) {
  float* s = lds; float* red = lds + 9 * 2048;
  for (int e = ltid(); e < 9 * 2048; e += NTHR) { const int r = e >> 11, k = e & 2047; const float v = r < 8 ? p.c[r * 2048 + k] : p.c_ctx[k]; s[e] = siluf(v); }
  __syncthreads();
  const int kg = ltid() >> 6, cl = ltid() & 63;
  for (int it = bid; it < 2 * 192; it += nb) {
    const int l = it / 192, cb = (it % 192) * 64;
    const float* w = p.w_ada + (size_t)l * 2048 * NMOD + cb + cl;
    float acc[9];
#pragma unroll
    for (int r = 0; r < 9; ++r) acc[r] = 0.f;
    for (int k = kg * 256; k < kg * 256 + 256; ++k) { const float wv = w[(size_t)k * NMOD];
#pragma unroll
      for (int r = 0; r < 9; ++r) acc[r] += s[r * 2048 + k] * wv; }
#pragma unroll
    for (int r = 0; r < 9; ++r) red[(kg * 9 + r) * 64 + cl] = acc[r];
    __syncthreads();
    for (int e = ltid(); e < 576; e += NTHR) { const int r = e >> 6, c2 = e & 63; float t = 0.f;
      for (int g = 0; g < 8; ++g) t += red[(g * 9 + r) * 64 + c2];
      p.mod[((size_t)l * 9 + r) * NMOD + cb + c2] = t + p.b_ada[l * NMOD + cb + c2]; }
    __syncthreads();
  }
}

DI void st_tables(const Prm& p, int bid, int nb) {
  const size_t stride = (size_t)nb * NTHR, t0 = (size_t)bid * NTHR + ltid();
  for (size_t e = t0; e < (size_t)4096 * 8192; e += stride) { const int k1 = (int)(e >> 13), n = (int)(e & 8191), n1 = n & 4095, idx = (k1 * n1) & 4095;
    float sv, cv; sincosf((float)idx * (6.283185307179586f / 4096.f), &sv, &cv); p.DFTM[e] = f2bf((n < 4096 ? cv : -sv) * (1.f / 64.f)); }
  for (size_t e = t0; e < (size_t)256 * 512; e += stride) { const int k1 = (int)(e >> 9), n = (int)(e & 511), n1 = n & 255, idx = (k1 * n1) & 255;
    float sv, cv; sincosf((float)idx * (6.283185307179586f / 256.f), &sv, &cv); p.DFTC[e] = f2bf((n < 256 ? cv : -sv) * (1.f / 16.f)); }
  for (size_t e = t0; e < (size_t)2 * 128 * 128; e += stride) { const int tb = (int)(e >> 14), k2 = (int)((e >> 7) & 127), n2 = (int)(e & 127), idx = (k2 * n2) & 127;
    float sv, cv; sincosf((float)idx * (6.283185307179586f / 128.f), &sv, &cv); p.CCS[e] = (tb ? sv : cv) * 0.08838834764831845f; }
}

DI void st_modulate(const Prm& p, int layer, int which, bf16_t* __restrict__ dst, int bid, int nb) {
  const int wave = ltid() >> 6, lane = ltid() & 63;
  const int shoff = which ? 3 * DM : 0, scoff = which ? 4 * DM : DM;
  for (int row = bid * 8 + wave; row < MR; row += nb * 8) {
    const int b = row / LT, t = row - b * LT; const bool isc = t >= LL;
    if (isc && layer == 1 && which == 1) continue;
    const float* src = (layer == 0 && which == 0) ? (isc ? p.ctx + (size_t)(b * LCX + t - LL) * DM : p.x + (size_t)(b * LL + t) * DM) : p.X + (size_t)row * DM;
    f32x4 v[8]; float ss = 0.f;
#pragma unroll
    for (int i = 0; i < 8; ++i) { v[i] = *(const f32x4*)(src + (i * 64 + lane) * 4); ss += v[i][0] * v[i][0] + v[i][1] * v[i][1] + v[i][2] * v[i][2] + v[i][3] * v[i][3]; }
    ss = wsum(ss); const float rstd = rsqrtf(ss * (1.f / 2048.f) + EPSV);
    const float* mr = p.mod + ((size_t)layer * 9 + (isc ? 8 : b)) * NMOD;
#pragma unroll
    for (int i = 0; i < 8; ++i) { const int col = (i * 64 + lane) * 4; const f32x4 sc = *(const f32x4*)(mr + scoff + col), sh = *(const f32x4*)(mr + shoff + col);
      const f32x4 o = v[i] * rstd * (sc + 1.f) + sh; u32x2 w; w.x = pack2(o[0], o[1]); w.y = pack2(o[2], o[3]); *(u32x2*)(dst + (size_t)row * DM + col) = w; }
  }
}

DI void st_dnprep(const Prm& p, int layer, int bid, int nb) {
  const int wave = ltid() >> 6, lane = ltid() & 63;
  const float* conv = p.dn_conv + (size_t)layer * 5 * 1536;
  for (int task = bid * 8 + wave; task < (MR / 32) * 13; task += nb * 8) {
    const int tile = task / 13, grp = task - tile * 13, row0 = tile * 32;
    const int b = row0 / LT, t0 = row0 - b * LT; const bool isc = t0 >= LL;
    const int segt0 = isc ? t0 - LL : t0, seglen = isc ? LCX : LL;
    if (grp < 12) {
      const int c = grp * 128 + lane * 2;
      float w0[5], w1[5];
#pragma unroll
      for (int j = 0; j < 5; ++j) { w0[j] = conv[j * 1536 + c]; w1[j] = conv[j * 1536 + c + 1]; }
      unsigned zz[36];
#pragma unroll
      for (int r = 0; r < 36; ++r) { const int tt = segt0 + r - 2; zz[r] = (tt >= 0 && tt < seglen) ? *(const unsigned*)(p.Z + (size_t)(row0 + r - 2) * NZ + c) : 0u; }
#pragma unroll
      for (int r = 0; r < 32; ++r) { float a0 = 0.f, a1 = 0.f;
#pragma unroll
        for (int j = 0; j < 5; ++j) { a0 += __uint_as_float(zz[r + j] << 16) * w0[j]; a1 += __uint_as_float(zz[r + j] & 0xffff0000u) * w1[j]; }
        a0 = siluf(a0); a1 = siluf(a1);
        if (grp < 8) { const float ss = wsum(a0 * a0 + a1 * a1); const float sc = rsqrtf(ss + EPSV) * (grp < 4 ? 0.08838834764831845f : 1.f); a0 *= sc; a1 *= sc; }
        *(unsigned*)(p.DNQ + (size_t)(row0 + r) * 1536 + c) = pack2(a0, a1); }
    } else {
#pragma unroll
      for (int rr = 0; rr < 8; ++rr) { const int idx = lane + 64 * rr, row = row0 + (idx >> 4), wh = idx & 15, isb = wh >> 3, dh = wh & 7;
        const float z = bf2f(p.Z[(size_t)row * NZ + (isb ? C_DNB : C_DNA) + dh]); float o;
        if (!isb) { const float xx = z + p.dn_dt_bias[layer * 8 + dh]; const float sp = xx > 20.f ? xx : log1pf(expf(xx)); o = -expf(p.dn_a_log[layer * 8 + dh]) * sp; }
        else o = sigmf(z);
        p.GB[(size_t)row * 16 + wh] = o; }
    }
  }
}

DI void st_mlaprep(const Prm& p, int layer, int bid, int nb) {
  const int wave = ltid() >> 6, lane = ltid() & 63;
  const float* qn = p.mla_q_norm + layer * 448; const float* kvn = p.mla_kv_norm + layer * 128;
  for (int row = bid * 8 + wave; row < MR; row += nb * 8) {
    const bf16_t* z = p.Z + (size_t)row * NZ; const int b = row / LT, t = row - b * LT;
    float v[8]; float ss = 0.f;
#pragma unroll
    for (int k = 0; k < 8; ++k) v[k] = 0.f;
    if (lane < 56) { const u32x4 w = *(const u32x4*)(z + C_CQ + lane * 8);
#pragma unroll
      for (int k = 0; k < 4; ++k) { v[2 * k] = __uint_as_float(w[k] << 16); v[2 * k + 1] = __uint_as_float(w[k] & 0xffff0000u); ss += v[2 * k] * v[2 * k] + v[2 * k + 1] * v[2 * k + 1]; } }
    ss = wsum(ss); float rstd = rsqrtf(ss * (1.f / 448.f) + EPSV);
    { u32x4 o = {0u, 0u, 0u, 0u};
      if (lane < 56) { const f32x4 n0 = *(const f32x4*)(qn + lane * 8), n1 = *(const f32x4*)(qn + lane * 8 + 4);
        o.x = pack2(v[0] * rstd * n0[0], v[1] * rstd * n0[1]); o.y = pack2(v[2] * rstd * n0[2], v[3] * rstd * n0[3]); o.z = pack2(v[4] * rstd * n1[0], v[5] * rstd * n1[1]); o.w = pack2(v[6] * rstd * n1[2], v[7] * rstd * n1[3]); }
      *(u32x4*)(p.Aq + (size_t)row * 512 + lane * 8) = o; }
    ss = 0.f;
    if (lane < 16) { const u32x4 w = *(const u32x4*)(z + C_CKV + lane * 8);
#pragma unroll
      for (int k = 0; k < 4; ++k) { v[2 * k] = __uint_as_float(w[k] << 16); v[2 * k + 1] = __uint_as_float(w[k] & 0xffff0000u); ss += v[2 * k] * v[2 * k] + v[2 * k + 1] * v[2 * k + 1]; } }
    ss = wsum(ss); rstd = rsqrtf(ss * (1.f / 128.f) + EPSV);
    if (lane < 32) { u32x4 o = {0u, 0u, 0u, 0u};
      if (lane < 16) { const f32x4 n0 = *(const f32x4*)(kvn + lane * 8), n1 = *(const f32x4*)(kvn + lane * 8 + 4);
        o.x = pack2(v[0] * rstd * n0[0], v[1] * rstd * n0[1]); o.y = pack2(v[2] * rstd * n0[2], v[3] * rstd * n0[3]); o.z = pack2(v[4] * rstd * n1[0], v[5] * rstd * n1[1]); o.w = pack2(v[6] * rstd * n1[2], v[7] * rstd * n1[3]); }
      *(u32x4*)(p.Akv + (size_t)row * 256 + lane * 8) = o; }
    if (t < LL) {
      if (lane < 32) { const int half = lane >> 4, i = lane & 15; const float x1 = bf2f(z[C_KR + half * 32 + i]), x2 = bf2f(z[C_KR + half * 32 + 16 + i]);
        const float pos = (float)(half ? (t & 63) : (t >> 6)); const float ang = pos * exp2f(-(float)i * (13.287712379549449f / 16.f)); float sv, cv; sincosf(ang, &sv, &cv);
        p.KR[(size_t)row * 64 + half * 32 + i] = f2bf(x1 * cv - x2 * sv); p.KR[(size_t)row * 64 + half * 32 + 16 + i] = f2bf(x2 * cv + x1 * sv); }
    } else p.KR[(size_t)row * 64 + lane] = z[C_KR + lane];
  }
}

DI void st_qrope(const Prm& p, int bid, int nb) {
  const int wave = ltid() >> 6, lane = ltid() & 63;
  for (int row = bid * 8 + wave; row < MR; row += nb * 8) {
    const int b = row / LT, t = row - b * LT; if (t >= LL) continue;
#pragma unroll
    for (int k = 0; k < 2; ++k) { const int pid = lane + 64 * k, h = pid >> 5, r = pid & 31, half = r >> 4, i = r & 15;
      bf16_t* q = p.Qraw + (size_t)row * 768 + h * 192 + 128 + half * 32; const float x1 = bf2f(q[i]), x2 = bf2f(q[16 + i]);
      const float pos = (float)(half ? (t & 63) : (t >> 6)); const float ang = pos * exp2f(-(float)i * (13.287712379549449f / 16.f)); float sv, cv; sincosf(ang, &sv, &cv);
      q[i] = f2bf(x1 * cv - x2 * sv); q[16 + i] = f2bf(x2 * cv + x1 * sv); }
  }
}

DI void st_fnchan(const Prm& p, unsigned char* lds, int bid, int nb) {
  bf16_t* wt = (bf16_t*)lds;
  bf16_t* zt = (bf16_t*)(lds + 256 * 272);
  const int tid = ltid(), wave = tid >> 6, lane = tid & 63, r32 = lane & 31, hi = lane >> 5;
  __syncthreads();
  for (int e = tid; e < 256 * 128; e += NTHR) wt[(e >> 7) * 136 + (e & 127)] = f2bf(p.CCS[e]);
  for (int it = bid; it < (MR / 64) * 4; it += nb) {
    const int tile = it >> 2, g = it & 3, row0 = tile * 64, b = row0 / LT, t0 = row0 - b * LT;
    __syncthreads();
    for (int e = tid; e < 1024; e += NTHR) { const int r = e >> 4, c8 = (e & 15) * 8; *(u32x4*)(zt + r * 136 + c8) = *(const u32x4*)(p.Z + (size_t)(row0 + r) * NZ + C_FN + g * 128 + c8); }
    __syncthreads();
    f32x16 acc[2] = {};
#pragma unroll
    for (int k8 = 0; k8 < 8; ++k8) { const bf16x8 a = *(const bf16x8*)(wt + (wave * 32 + r32) * 136 + k8 * 16 + hi * 8);
#pragma unroll
      for (int tt = 0; tt < 2; ++tt) { const bf16x8 bb = *(const bf16x8*)(zt + (tt * 32 + r32) * 136 + k8 * 16 + hi * 8); acc[tt] = __builtin_amdgcn_mfma_f32_32x32x16_bf16(a, bb, acc[tt], 0, 0, 0); } }
    const int tb = wave >> 2;
#pragma unroll
    for (int tt = 0; tt < 2; ++tt)
#pragma unroll
      for (int r = 0; r < 16; ++r) { const int k2 = (wave & 3) * 32 + (r & 3) + 8 * (r >> 2) + 4 * hi;
        if (t0 < LL) p.PQT[((size_t)(b * 512 + g * 128 + k2)) * 8192 + tb * 4096 + t0 + tt * 32 + r32] = f2bf(acc[tt][r]);
        else p.PQTc[((size_t)(b * 512 + g * 128 + k2)) * 512 + tb * 256 + (t0 - LL) + tt * 32 + r32] = f2bf(acc[tt][r]); }
  }
}

DI int scan_row(int b, int dir, int s) { return s < LCX ? b * LT + LL + (dir ? LCX - 1 - s : s) : b * LT + (dir ? LL - 1 - (s - LCX) : (s - LCX)); }

DI void st_dntinv(const Prm& p, unsigned char* lds, int bid, int nb) {
  const int tid = ltid(), wave = tid >> 6, lane = tid & 63, r32 = lane & 31, hi = lane >> 5;
  float* Ab = (float*)lds + wave * 4096;
  float* gcb = (float*)(lds + 131072) + wave * 128; float* btb = gcb + 64;
  for (int item = bid * 8 + wave; item < 64 * 68; item += nb * 8) {
    const int chain = item / 68, n = item - chain * 68, b = chain >> 3, h = (chain >> 1) & 3, dir = chain & 1;
    const int myrow = scan_row(b, dir, n * 64 + lane);
    const float g = p.GB[(size_t)myrow * 16 + dir * 4 + h], bt = p.GB[(size_t)myrow * 16 + 8 + dir * 4 + h];
    gcb[lane] = g; btb[lane] = bt;
    bf16x8 kf[2][8];
#pragma unroll
    for (int tt = 0; tt < 2; ++tt) { const int row = scan_row(b, dir, n * 64 + tt * 32 + r32);
#pragma unroll
      for (int ks = 0; ks < 8; ++ks) kf[tt][ks] = *(const bf16x8*)(p.DNQ + (size_t)row * 1536 + 512 + h * 128 + ks * 16 + hi * 8); }
    __builtin_amdgcn_wave_barrier();
    float gc = 0.f;
    for (int e = 0; e < 64; ++e) { const float ge = gcb[e]; gc += (e <= lane) ? ge : 0.f; }
    __builtin_amdgcn_wave_barrier();
    gcb[lane] = gc; p.GCB[(size_t)item * 64 + lane] = gc;
    __builtin_amdgcn_wave_barrier();
    f32x16 a00 = {}, a10 = {}, a11 = {};
#pragma unroll
    for (int ks = 0; ks < 8; ++ks) { a00 = __builtin_amdgcn_mfma_f32_32x32x16_bf16(kf[0][ks], kf[0][ks], a00, 0, 0, 0);
      a10 = __builtin_amdgcn_mfma_f32_32x32x16_bf16(kf[1][ks], kf[0][ks], a10, 0, 0, 0); a11 = __builtin_amdgcn_mfma_f32_32x32x16_bf16(kf[1][ks], kf[1][ks], a11, 0, 0, 0); }
    { const float gce0 = gcb[r32], gce1 = gcb[32 + r32];
#pragma unroll
      for (int r = 0; r < 16; ++r) { const int cl = (r & 3) + 8 * (r >> 2) + 4 * hi; const float gc0 = gcb[cl], bt0 = btb[cl], gc1 = gcb[32 + cl], bt1 = btb[32 + cl];
        Ab[cl * 64 + r32] = (r32 < cl) ? bt0 * a00[r] * __expf(gc0 - gce0) : 0.f;
        Ab[cl * 64 + 32 + r32] = 0.f;
        Ab[(32 + cl) * 64 + r32] = bt1 * a10[r] * __expf(gc1 - gce0);
        Ab[(32 + cl) * 64 + 32 + r32] = (r32 < cl) ? bt1 * a11[r] * __expf(gc1 - gce1) : 0.f; } }
    __builtin_amdgcn_wave_barrier();
    float x[64];
    bf16_t* to = p.TINV + (size_t)item * 4096 + lane;
#pragma unroll
    for (int c = 0; c < 64; ++c) { float s = (c == lane) ? 1.f : 0.f;
#pragma unroll
      for (int e4 = 0; e4 < (c + 3) / 4; ++e4) { const f32x4 av = *(const f32x4*)(Ab + c * 64 + e4 * 4);
#pragma unroll
        for (int i = 0; i < 4; ++i) if (e4 * 4 + i < c) s -= av[i] * x[e4 * 4 + i]; }
      x[c] = s; to[c * 64] = f2bf(s); }
    __builtin_amdgcn_wave_barrier();
  }
}

DI void st_dnscan(const Prm& p, unsigned char* lds, int bid, int nb) {
  constexpr int PK = 136, PB = 72;
  bf16_t* Qs = (bf16_t*)lds; bf16_t* Ks = Qs + 64 * PK; bf16_t* SB = Ks + 64 * PK; bf16_t* KDT = SB + 64 * PK; bf16_t* TI = KDT + 128 * PB; bf16_t* RT = TI + 64 * PB; bf16_t* VNT = RT + 64 * PB;
  bf16_t* PL = VNT + 64 * PB; bf16_t* Vs = PL + 64 * PB; float* gcs = (float*)(Vs + 64 * PB); float* bts = gcs + 64; float* egs = bts + 64;
  const int tid = ltid(), wave = tid >> 6, lane = tid & 63, r32 = lane & 31, hi = lane >> 5;
  for (int item = bid; item < 128; item += nb) {
    const int chain = item >> 1, half = item & 1, b = chain >> 3, h = (chain >> 1) & 3, dir = chain & 1;
    f32x16 accS = {};
    __syncthreads();
    for (int e = tid; e < 64 * PK; e += NTHR) SB[e] = 0;
    bf16x8 pf[6]; float pgc = 0.f, pbt = 0.f;
    auto gload = [&](int n) {
      const size_t ci = (size_t)chain * 68 + n;
#pragma unroll
      for (int r = 0; r < 6; ++r) { const int e = tid + NTHR * r;
        if (e < 2048) { const int ee = e & 1023, t = ee >> 4, c8 = ee & 15; const int row = scan_row(b, dir, n * 64 + t); pf[r] = *(const bf16x8*)(p.DNQ + (size_t)row * 1536 + (e < 1024 ? 0 : 512) + h * 128 + c8 * 8); }
        else if (e < 2560) { const int ee = e - 2048, t = ee >> 3, c8 = ee & 7; const int row = scan_row(b, dir, n * 64 + t); pf[r] = *(const bf16x8*)(p.DNQ + (size_t)row * 1536 + 1024 + h * 128 + half * 64 + c8 * 8); }
        else { const int ee = e - 2560; pf[r] = *(const bf16x8*)(p.TINV + ci * 4096 + ee * 8); } }
      if (tid < 64) { pgc = p.GCB[ci * 64 + tid]; const int row = scan_row(b, dir, n * 64 + tid); pbt = p.GB[(size_t)row * 16 + 8 + dir * 4 + h]; }
    };
    gload(0);
    for (int n = 0; n < LT / 64; ++n) {
      if (tid < 64) { gcs[tid] = pgc; bts[tid] = pbt; egs[tid] = __expf(pgc); }
      __syncthreads();
      const float gl = gcs[63];
#pragma unroll
      for (int r = 0; r < 6; ++r) { const int e = tid + NTHR * r;
        if (e < 1024) { const int t = e >> 4, c8 = e & 15; *(bf16x8*)(Qs + t * PK + c8 * 8) = pf[r]; }
        else if (e < 2048) { const int ee = e - 1024, t = ee >> 4, c8 = ee & 15; *(bf16x8*)(Ks + t * PK + c8 * 8) = pf[r]; const float sc = __expf(gl - gcs[t]);
#pragma unroll
          for (int j = 0; j < 8; ++j) KDT[(c8 * 8 + j) * PB + t] = f2bf(bf2f((bf16_t)pf[r][j]) * sc); }
        else if (e < 2560) { const int ee = e - 2048, t = ee >> 3, c8 = ee & 7; *(bf16x8*)(Vs + t * PB + c8 * 8) = pf[r]; }
        else { const int ee = e - 2560, c = ee >> 3, c8 = ee & 7; *(bf16x8*)(TI + c * PB + c8 * 8) = pf[r]; } }
      if (n + 1 < LT / 64) gload(n + 1);
      __syncthreads();
      f32x16 accO = {};
      if (wave < 4) { const int et = wave >> 1, jt = wave & 1; f32x16 a1 = {};
#pragma unroll
        for (int k8 = 0; k8 < 8; ++k8) { const bf16x8 av = *(const bf16x8*)(Ks + (et * 32 + r32) * PK + k8 * 16 + hi * 8), bv = *(const bf16x8*)(SB + (jt * 32 + r32) * PK + k8 * 16 + hi * 8);
          a1 = __builtin_amdgcn_mfma_f32_32x32x16_bf16(av, bv, a1, 0, 0, 0); }
        const int j = jt * 32 + r32;
#pragma unroll
        for (int g = 0; g < 4; ++g) { const int e0 = et * 32 + 8 * g + 4 * hi; float rv[4];
#pragma unroll
          for (int i = 0; i < 4; ++i) rv[i] = bts[e0 + i] * (bf2f(Vs[(e0 + i) * PB + j]) - egs[e0 + i] * a1[4 * g + i]);
          u32x2 w; w.x = pack2(rv[0], rv[1]); w.y = pack2(rv[2], rv[3]); *(u32x2*)(RT + j * PB + e0) = w; } }
      else {
        if (wave < 7) { const int et = wave == 6 ? 1 : 0, ct = wave == 4 ? 0 : 1; f32x16 a2 = {};
#pragma unroll
          for (int k8 = 0; k8 < 8; ++k8) { const bf16x8 av = *(const bf16x8*)(Ks + (et * 32 + r32) * PK + k8 * 16 + hi * 8), bv = *(const bf16x8*)(Qs + (ct * 32 + r32) * PK + k8 * 16 + hi * 8);
            a2 = __builtin_amdgcn_mfma_f32_32x32x16_bf16(av, bv, a2, 0, 0, 0); }
          const int c = ct * 32 + r32; const float gcc = gcs[c];
#pragma unroll
          for (int g = 0; g < 4; ++g) { const int e0 = et * 32 + 8 * g + 4 * hi; float pv[4];
#pragma unroll
            for (int i = 0; i < 4; ++i) pv[i] = (e0 + i <= c) ? a2[4 * g + i] * __expf(gcc - gcs[e0 + i]) : 0.f;
            u32x2 w; w.x = pack2(pv[0], pv[1]); w.y = pack2(pv[2], pv[3]); *(u32x2*)(PL + c * PB + e0) = w; } }
        else { for (int e = lane; e < 32 * 8; e += 64) { const int c = e >> 3, q4 = (e & 7) * 4; *(u32x2*)(PL + c * PB + 32 + q4) = (u32x2){0u, 0u}; } }
        { const int ct = (wave - 4) >> 1, jt = wave & 1;
#pragma unroll
          for (int k8 = 0; k8 < 8; ++k8) { const bf16x8 av = *(const bf16x8*)(Qs + (ct * 32 + r32) * PK + k8 * 16 + hi * 8), bv = *(const bf16x8*)(SB + (jt * 32 + r32) * PK + k8 * 16 + hi * 8);
            accO = __builtin_amdgcn_mfma_f32_32x32x16_bf16(av, bv, accO, 0, 0, 0); }
#pragma unroll
          for (int r = 0; r < 16; ++r) accO[r] *= egs[ct * 32 + (r & 3) + 8 * (r >> 2) + 4 * hi]; } }
      __syncthreads();
      if (wave < 4) { const int ct = wave >> 1, jt = wave & 1; f32x16 a3 = {};
#pragma unroll
        for (int k8 = 0; k8 < 4; ++k8) { const bf16x8 av = *(const bf16x8*)(TI + (ct * 32 + r32) * PB + k8 * 16 + hi * 8), bv = *(const bf16x8*)(RT + (jt * 32 + r32) * PB + k8 * 16 + hi * 8);
          a3 = __builtin_amdgcn_mfma_f32_32x32x16_bf16(av, bv, a3, 0, 0, 0); }
#pragma unroll
        for (int g = 0; g < 4; ++g) { u32x2 w; w.x = pack2(a3[4 * g], a3[4 * g + 1]); w.y = pack2(a3[4 * g + 2], a3[4 * g + 3]); *(u32x2*)(VNT + (jt * 32 + r32) * PB + ct * 32 + 8 * g + 4 * hi) = w; } }
      __syncthreads();
      if (wave >= 4) { const int ct = (wave - 4) >> 1, jt = wave & 1;
#pragma unroll
        for (int k8 = 0; k8 < 4; ++k8) { const bf16x8 av = *(const bf16x8*)(PL + (ct * 32 + r32) * PB + k8 * 16 + hi * 8), bv = *(const bf16x8*)(VNT + (jt * 32 + r32) * PB + k8 * 16 + hi * 8);
          accO = __builtin_amdgcn_mfma_f32_32x32x16_bf16(av, bv, accO, 0, 0, 0); }
#pragma unroll
        for (int r = 0; r < 16; ++r) { const int c = ct * 32 + (r & 3) + 8 * (r >> 2) + 4 * hi; const int row = scan_row(b, dir, n * 64 + c);
          p.OB[((size_t)(0 * 2 + dir) * MR + row) * 512 + h * 128 + half * 64 + jt * 32 + r32] = f2bf(accO[r]); } }
      { const int dt = wave >> 1, jt = wave & 1; const float egl = __expf(gl);
#pragma unroll
        for (int r = 0; r < 16; ++r) accS[r] *= egl;
#pragma unroll
        for (int k8 = 0; k8 < 4; ++k8) { const bf16x8 av = *(const bf16x8*)(KDT + (dt * 32 + r32) * PB + k8 * 16 + hi * 8), bv = *(const bf16x8*)(VNT + (jt * 32 + r32) * PB + k8 * 16 + hi * 8);
          accS = __builtin_amdgcn_mfma_f32_32x32x16_bf16(av, bv, accS, 0, 0, 0); }
#pragma unroll
        for (int g = 0; g < 4; ++g) { u32x2 w; w.x = pack2(accS[4 * g], accS[4 * g + 1]); w.y = pack2(accS[4 * g + 2], accS[4 * g + 3]);
          *(u32x2*)(SB + (jt * 32 + r32) * PK + dt * 32 + 8 * g + 4 * hi) = w; } }
      __syncthreads();
    }
  }
}

DI void st_glabc(const Prm& p, int layer, unsigned char* lds, int bid, int nb) {
  float* AL = (float*)lds; float* SEG = AL + 1024;
  const int tid = ltid(), seg = tid >> 6, dme = tid & 63;
  for (int item = bid; item < 64 * 68; item += nb) {
    const int chain = item / 68, n = item - chain * 68, b = chain >> 3, h = (chain >> 1) & 3, dir = chain & 1;
    const float* w2 = p.gla_w2 + (size_t)(layer * 2 + dir) * 16 * 256 + h * 64; const float b2r = p.gla_b2[(layer * 2 + dir) * 256 + h * 64 + dme];
    float w2r[16];
#pragma unroll
    for (int r = 0; r < 16; ++r) w2r[r] = w2[r * 256 + dme];
    __syncthreads();
    if (tid < 128) { const int t = tid >> 1, c8 = tid & 1; const int row = scan_row(b, dir, n * 64 + t); const bf16x8 v = *(const bf16x8*)(p.Z + (size_t)row * NZ + C_GALPHA + dir * 16 + c8 * 8);
#pragma unroll
      for (int j = 0; j < 8; ++j) AL[t * 16 + c8 * 8 + j] = bf2f((bf16_t)v[j]); }
    __syncthreads();
    float la[8]; float run = 0.f;
#pragma unroll
    for (int k = 0; k < 8; ++k) { const int t = seg * 8 + k; float zz = b2r;
#pragma unroll
      for (int r = 0; r < 16; ++r) zz += AL[t * 16 + r] * w2r[r];
      const float nz = -zz; const float sp = nz > 20.f ? nz : log1pf(expf(nz)); run += -sp * (1.f / 16.f); la[k] = run; }
    SEG[seg * 64 + dme] = run;
    __syncthreads();
    float pre = 0.f;
#pragma unroll
    for (int s2 = 0; s2 < 8; ++s2) pre += (s2 < seg) ? SEG[s2 * 64 + dme] : 0.f;
#pragma unroll
    for (int k = 0; k < 8; ++k) p.BC[(size_t)item * 4096 + (seg * 8 + k) * 64 + dme] = la[k] + pre;
  }
}

DI void st_glascan(const Prm& p, int layer, unsigned char* lds, int bid, int nb) {
  constexpr int PB = 72;
  bf16_t* QI = (bf16_t*)lds; bf16_t* QR = QI + 64 * PB; bf16_t* KR = QR + 64 * PB; bf16_t* KRT = KR + 64 * PB; bf16_t* VT = KRT + 64 * PB; bf16_t* SB = VT + 64 * PB; bf16_t* PL = SB + 64 * PB;
  float* LA = (float*)(lds + 7 * 64 * PB * 2);
  float* AL = LA + 4096;
  float* SEG = AL + 1024;
  float* EBL = SEG + 512;
  const int tid = ltid(), wave = tid >> 6, lane = tid & 63, r32 = lane & 31, hi = lane >> 5;
  for (int item = bid; item < 128; item += nb) {
    const int chain = item >> 1, half = item & 1, b = chain >> 3, h = (chain >> 1) & 3, dir = chain & 1;
    f32x16 acc = {};
    __syncthreads();
    for (int e = tid; e < 64 * PB; e += NTHR) SB[e] = 0;
    bf16x8 pf[3]; f32x4 pb[2];
    auto gload = [&](int n) {
#pragma unroll
      for (int r = 0; r < 3; ++r) { const int e = tid + NTHR * r; const int t = e / 24, ch = e - t * 24; const int row = scan_row(b, dir, n * 64 + t);
        const int col = ch < 8 ? C_GQ + h * 64 + ch * 8 : (ch < 16 ? C_GK + h * 64 + (ch - 8) * 8 : C_GV + h * 128 + half * 64 + (ch - 16) * 8);
        pf[r] = *(const bf16x8*)(p.Z + (size_t)row * NZ + col); }
#pragma unroll
      for (int r = 0; r < 2; ++r) pb[r] = *(const f32x4*)(p.BC + ((size_t)chain * 68 + n) * 4096 + (tid + NTHR * r) * 4);
    };
    gload(0);
    for (int n = 0; n < LT / 64; ++n) {
#pragma unroll
      for (int r = 0; r < 2; ++r) *(f32x4*)(LA + (tid + NTHR * r) * 4) = pb[r];
      __syncthreads();
      if (tid < 64) EBL[tid] = __expf(LA[63 * 64 + tid]);
#pragma unroll
      for (int r = 0; r < 3; ++r) { const int e = tid + NTHR * r; const int t = e / 24, ch = e - t * 24;
          if (ch < 8) { u32x4 wi, wr; float xi[8], xr[8];
#pragma unroll
            for (int j = 0; j < 8; ++j) { const int d = ch * 8 + j; const float bc = LA[t * 64 + d], bl = LA[63 * 64 + d], q = bf2f((bf16_t)pf[r][j]) * 0.125f; xi[j] = q * __expf(bc); xr[j] = q * __expf(bc - bl); }
            wi.x = pack2(xi[0], xi[1]); wi.y = pack2(xi[2], xi[3]); wi.z = pack2(xi[4], xi[5]); wi.w = pack2(xi[6], xi[7]);
            wr.x = pack2(xr[0], xr[1]); wr.y = pack2(xr[2], xr[3]); wr.z = pack2(xr[4], xr[5]); wr.w = pack2(xr[6], xr[7]);
            *(u32x4*)(QI + t * PB + ch * 8) = wi; *(u32x4*)(QR + t * PB + ch * 8) = wr; }
          else if (ch < 16) { u32x4 wk; float xk[8];
#pragma unroll
            for (int j = 0; j < 8; ++j) { const int d = (ch - 8) * 8 + j; xk[j] = bf2f((bf16_t)pf[r][j]) * __expf(LA[63 * 64 + d] - LA[t * 64 + d]); KRT[d * PB + t] = f2bf(xk[j]); }
            wk.x = pack2(xk[0], xk[1]); wk.y = pack2(xk[2], xk[3]); wk.z = pack2(xk[4], xk[5]); wk.w = pack2(xk[6], xk[7]);
            *(u32x4*)(KR + t * PB + (ch - 8) * 8) = wk; }
          else {
#pragma unroll
            for (int j = 0; j < 8; ++j) VT[((ch - 16) * 8 + j) * PB + t] = (bf16_t)pf[r][j]; } }
      if (n + 1 < LT / 64) gload(n + 1);
      __syncthreads();
      if (wave < 3) { const int et = wave == 2 ? 1 : 0, ct = wave == 0 ? 0 : 1; f32x16 a2 = {};
#pragma unroll
        for (int k8 = 0; k8 < 4; ++k8) { const bf16x8 av = *(const bf16x8*)(KR + (et * 32 + r32) * PB + k8 * 16 + hi * 8), bv = *(const bf16x8*)(QR + (ct * 32 + r32) * PB + k8 * 16 + hi * 8);
          a2 = __builtin_amdgcn_mfma_f32_32x32x16_bf16(av, bv, a2, 0, 0, 0); }
        const int c = ct * 32 + r32;
#pragma unroll
        for (int g = 0; g < 4; ++g) { const int e0 = et * 32 + 8 * g + 4 * hi; u32x2 w;
          w.x = pack2(e0 <= c ? a2[4 * g] : 0.f, e0 + 1 <= c ? a2[4 * g + 1] : 0.f); w.y = pack2(e0 + 2 <= c ? a2[4 * g + 2] : 0.f, e0 + 3 <= c ? a2[4 * g + 3] : 0.f);
          *(u32x2*)(PL + c * PB + e0) = w; } }
      else if (wave == 3) { for (int e = lane; e < 32 * 8; e += 64) { const int c = e >> 3, q4 = (e & 7) * 4; *(u32x2*)(PL + c * PB + 32 + q4) = (u32x2){0u, 0u}; } }
      else { const int ct = (wave - 4) >> 1, jt = wave & 1; acc = f32x16{};
#pragma unroll
        for (int k8 = 0; k8 < 4; ++k8) { const bf16x8 av = *(const bf16x8*)(QI + (ct * 32 + r32) * PB + k8 * 16 + hi * 8), bv = *(const bf16x8*)(SB + (jt * 32 + r32) * PB + k8 * 16 + hi * 8);
          acc = __builtin_amdgcn_mfma_f32_32x32x16_bf16(av, bv, acc, 0, 0, 0); } }
      __syncthreads();
      if (wave >= 4) { const int ct = (wave - 4) >> 1, jt = wave & 1;
#pragma unroll
        for (int k8 = 0; k8 < 4; ++k8) { const bf16x8 av = *(const bf16x8*)(PL + (ct * 32 + r32) * PB + k8 * 16 + hi * 8), bv = *(const bf16x8*)(VT + (jt * 32 + r32) * PB + k8 * 16 + hi * 8);
          acc = __builtin_amdgcn_mfma_f32_32x32x16_bf16(av, bv, acc, 0, 0, 0); }
#pragma unroll
        for (int r = 0; r < 16; ++r) { const int c = ct * 32 + (r & 3) + 8 * (r >> 2) + 4 * hi; const int row = scan_row(b, dir, n * 64 + c);
          p.OB[((size_t)(1 * 2 + dir) * MR + row) * 512 + h * 128 + half * 64 + jt * 32 + r32] = f2bf(acc[r]); } }
      else { const int dt = wave >> 1, jt = wave & 1;
#pragma unroll
        for (int r = 0; r < 16; ++r) acc[r] *= EBL[dt * 32 + (r & 3) + 8 * (r >> 2) + 4 * hi];
#pragma unroll
        for (int k8 = 0; k8 < 4; ++k8) { const bf16x8 av = *(const bf16x8*)(KRT + (dt * 32 + r32) * PB + k8 * 16 + hi * 8), bv = *(const bf16x8*)(VT + (jt * 32 + r32) * PB + k8 * 16 + hi * 8);
          acc = __builtin_amdgcn_mfma_f32_32x32x16_bf16(av, bv, acc, 0, 0, 0); }
#pragma unroll
        for (int g = 0; g < 4; ++g) { u32x2 w; w.x = pack2(acc[4 * g], acc[4 * g + 1]); w.y = pack2(acc[4 * g + 2], acc[4 * g + 3]);
          *(u32x2*)(SB + (jt * 32 + r32) * PB + dt * 32 + 8 * g + 4 * hi) = w; } }
      __syncthreads();
    }
  }
}

DI void st_combine(const Prm& p, int layer, int bid, int nb) {
  const int wave = ltid() >> 6, lane = ltid() & 63;
  for (long task = (long)bid * 8 + wave; task < (long)MR * 8; task += (long)nb * 8) {
    const int row = (int)(task >> 3), mh = (int)(task & 7), mixer = mh >> 2, h = mh & 3;
    const unsigned f = *(const unsigned*)(p.OB + ((size_t)(mixer * 2 + 0) * MR + row) * 512 + h * 128 + lane * 2), g = *(const unsigned*)(p.OB + ((size_t)(mixer * 2 + 1) * MR + row) * 512 + h * 128 + lane * 2);
    const float o0 = bf2f((bf16_t)(f & 0xffffu)) + bf2f((bf16_t)(g & 0xffffu)), o1 = bf2f((bf16_t)(f >> 16)) + bf2f((bf16_t)(g >> 16));
    const float ss = wsum(o0 * o0 + o1 * o1), rstd = rsqrtf(ss * (1.f / 128.f) + EPSV);
    const float* w = (mixer ? p.gla_norm : p.dn_norm) + layer * 128 + lane * 2;
    const unsigned gz = *(const unsigned*)(p.Z + (size_t)row * NZ + (mixer ? C_GGATE : C_DNGATE) + h * 128 + lane * 2);
    const float g0 = bf2f((bf16_t)(gz & 0xffffu)), g1 = bf2f((bf16_t)(gz >> 16));
    *(unsigned*)(p.Y + (size_t)row * DM + mixer * 512 + h * 128 + lane * 2) = pack2(o0 * rstd * w[0] * siluf(g0), o1 * rstd * w[1] * siluf(g1));
  }
}

DI unsigned fkey(float f) { const unsigned u = __float_as_uint(f); return u ^ ((u >> 31) ? 0xffffffffu : 0x80000000u); }
DI int pcnt(unsigned long long m) { return __builtin_popcountll(m); }
DI int lanes_below(unsigned long long m) { return (int)__builtin_amdgcn_mbcnt_hi((unsigned)(m >> 32), __builtin_amdgcn_mbcnt_lo((unsigned)m, 0u)); }
DI void st_peertopk(const Prm& p, int layer, unsigned char* lds, int bid, int nb) {
  bf16_t* ks = (bf16_t*)lds;
  bf16_t* qt = (bf16_t*)(lds + 69632);
  float* sc = (float*)(lds + 69632);
  const int tid = ltid(), wave = tid >> 6, lane = tid & 63, r32 = lane & 31, hi = lane >> 5;
  float* selv = (float*)(lds + 69632 + 33280) + wave * 64; int* seli = (int*)(selv + 32);
  int hcur = -1;
  const int nchunk = MR / 32;
  for (int it = bid; it < 8 * nchunk; it += nb) {
    const int h = it / nchunk, chunk = it - h * nchunk, row0 = chunk * 32;
    if (layer == 1 && (row0 % LT) >= LL) continue;
    __syncthreads();
    if (h != hcur) {
      const float* kg = p.peer_keys + ((size_t)(layer * 8 + h) * 2) * 128 * 128;
      for (int e = tid; e < 2 * 128 * 128; e += NTHR) { const int pn = e >> 7, k = e & 127; ks[pn * 136 + k] = f2bf(kg[e]); }
      hcur = h; }
    for (int e = tid; e < 1024; e += NTHR) { const int r = e >> 5, c8 = (e & 31) * 8; *(u32x4*)(qt + r * 264 + c8) = *(const u32x4*)(p.Qp + (size_t)(row0 + r) * DM + h * 256 + c8); }
    __syncthreads();
    { const int pt = wave >> 2, nt = wave & 3; f32x16 acc = {};
#pragma unroll
      for (int k8 = 0; k8 < 8; ++k8) { const bf16x8 a = *(const bf16x8*)(qt + r32 * 264 + pt * 128 + k8 * 16 + hi * 8), b = *(const bf16x8*)(ks + (pt * 128 + nt * 32 + r32) * 136 + k8 * 16 + hi * 8);
        acc = __builtin_amdgcn_mfma_f32_32x32x16_bf16(a, b, acc, 0, 0, 0); }
      __syncthreads();
#pragma unroll
      for (int r = 0; r < 16; ++r) sc[((r & 3) + 8 * (r >> 2) + 4 * hi) * 260 + pt * 128 + nt * 32 + r32] = acc[r]; }
    __syncthreads();
    for (int rr = 0; rr < 4; ++rr) {
      const int m = wave * 4 + rr, row = row0 + m;
      float s[2][2];
#pragma unroll
      for (int pp = 0; pp < 2; ++pp)
#pragma unroll
        for (int hh = 0; hh < 2; ++hh) s[pp][hh] = sc[m * 260 + pp * 128 + hh * 64 + lane];
      unsigned kk[2][2], T[2] = {0u, 0u};
#pragma unroll
      for (int pp = 0; pp < 2; ++pp) { kk[pp][0] = fkey(s[pp][0]); kk[pp][1] = fkey(s[pp][1]); }
      { unsigned ta = 0u, tb = 0u, da = 0u, db = 0u;
        for (int bit = 31; bit >= 0; --bit) { const unsigned m = 1u << bit;
          const unsigned ca = ta | m, cb = tb | m;
          const unsigned na = (unsigned)(pcnt(__ballot(kk[0][0] >= ca)) + pcnt(__ballot(kk[0][1] >= ca))), nb2 = (unsigned)(pcnt(__ballot(kk[1][0] >= cb)) + pcnt(__ballot(kk[1][1] >= cb)));
          const unsigned oa = (na >= 16u ? 1u : 0u) & ~da, ob = (nb2 >= 16u ? 1u : 0u) & ~db;
          ta |= (0u - oa) & m; tb |= (0u - ob) & m; da |= oa & (na == 16u ? 1u : 0u); db |= ob & (nb2 == 16u ? 1u : 0u);
          if (da & db) break; }
        T[0] = __builtin_amdgcn_readfirstlane(ta); T[1] = __builtin_amdgcn_readfirstlane(tb); }
#pragma unroll
      for (int pp = 0; pp < 2; ++pp) { const unsigned k0 = kk[pp][0], k1 = kk[pp][1], TT = T[pp];
        const unsigned long long g0 = __ballot(k0 > TT), g1 = __ballot(k1 > TT), e0 = __ballot(k0 == TT), e1 = __ballot(k1 == TT);
        const int ng0 = pcnt(g0), ng = ng0 + pcnt(g1), need = 16 - ng, ne0 = pcnt(e0);
        if (k0 > TT) { const int r = lanes_below(g0); selv[pp * 16 + r] = s[pp][0]; seli[pp * 16 + r] = lane; }
        if (k1 > TT) { const int r = ng0 + lanes_below(g1); selv[pp * 16 + r] = s[pp][1]; seli[pp * 16 + r] = lane + 64; }
        if (k0 == TT) { const int r = lanes_below(e0); if (r < need) { selv[pp * 16 + ng + r] = s[pp][0]; seli[pp * 16 + ng + r] = lane; } }
        if (k1 == TT) { const int r = ne0 + lanes_below(e1); if (r < need) { selv[pp * 16 + ng + r] = s[pp][1]; seli[pp * 16 + ng + r] = lane + 64; } } }
      __builtin_amdgcn_wave_barrier();
      float cd[4]; unsigned ck[4]; { const float sa = selv[lane >> 2]; const f32x4 sb = *(const f32x4*)(selv + 16 + (lane & 3) * 4);
#pragma unroll
        for (int q = 0; q < 4; ++q) { cd[q] = sa + sb[q]; ck[q] = fkey(cd[q]); } }
      unsigned T2 = 0u;
      for (int bit = 31; bit >= 0; --bit) { const unsigned m = 1u << bit, c = T2 | m;
        const unsigned n = (unsigned)(pcnt(__ballot(ck[0] >= c)) + pcnt(__ballot(ck[1] >= c)) + pcnt(__ballot(ck[2] >= c)) + pcnt(__ballot(ck[3] >= c)));
        T2 |= (0u - (n >= 16u ? 1u : 0u)) & m; if (n == 16u) break; }
      T2 = __builtin_amdgcn_readfirstlane(T2);
      float mx = fmaxf(fmaxf(cd[0], cd[1]), fmaxf(cd[2], cd[3])); mx = wmax(mx);
      int base = 0; float esum = 0.f; const int ia = seli[lane >> 2]; int rk[4]; float ev[4];
#pragma unroll
      for (int q = 0; q < 4; ++q) { const unsigned long long g = __ballot(ck[q] > T2); rk[q] = ck[q] > T2 ? base + lanes_below(g) : 99; base += pcnt(g); }
#pragma unroll
      for (int q = 0; q < 4; ++q) { const unsigned long long g = __ballot(ck[q] == T2); if (ck[q] == T2) rk[q] = base + lanes_below(g); base += pcnt(g); }
#pragma unroll
      for (int q = 0; q < 4; ++q) { ev[q] = rk[q] < 16 ? __expf(cd[q] - mx) : 0.f; esum += ev[q]; }
      esum = wsum(esum); const float inv = 1.f / esum;
      int* orow = p.IDX + (size_t)row * 128 + h * 16; float* grow = p.GATE + (size_t)row * 128 + h * 16;
#pragma unroll
      for (int q = 0; q < 4; ++q) if (rk[q] < 16) { orow[rk[q]] = ia * 128 + seli[16 + (lane & 3) * 4 + q]; grow[rk[q]] = ev[q] * inv; }
      __builtin_amdgcn_wave_barrier();
    }
  }
}

typedef float v16f_t __attribute__((ext_vector_type(16)));
typedef float v32f_t __attribute__((ext_vector_type(32)));
typedef unsigned v6u_t __attribute__((ext_vector_type(6)));
constexpr int TROW = 1600;
DI void st_cvt_tables(const Prm& p, int layer, int bid, int nb) {
  const size_t nblk = (size_t)16384 * 64, stride = (size_t)nb * NTHR;
  const float* U = p.peer_u + (size_t)layer * 16384 * DM; const float* V = p.peer_v + (size_t)layer * 16384 * DM;
  for (size_t e = (size_t)bid * NTHR + ltid(); e < 2 * nblk; e += stride) { const bool isv = e >= nblk; const size_t k = isv ? e - nblk : e; const size_t row = k >> 6; const int l = (int)(k & 63);
    const float* src = (isv ? V : U) + row * DM + l * 32; v16f_t x, y; float amax = 0.f;
#pragma unroll
    for (int q = 0; q < 4; ++q) { const f32x4 a = *(const f32x4*)(src + q * 8), b = *(const f32x4*)(src + q * 8 + 4);
      x[q * 4] = a[0]; y[q * 4] = a[1]; x[q * 4 + 1] = a[2]; y[q * 4 + 1] = a[3]; x[q * 4 + 2] = b[0]; y[q * 4 + 2] = b[1]; x[q * 4 + 3] = b[2]; y[q * 4 + 3] = b[3];
#pragma unroll
      for (int i = 0; i < 4; ++i) amax = fmaxf(amax, fmaxf(fabsf(a[i]), fabsf(b[i]))); }
    int ex = (int)((__float_as_uint(amax * (1.f / 7.5f)) >> 23) & 0xffu) - 127 + 1; ex = ex < -126 ? -126 : ex;
    const float inv = __uint_as_float((unsigned)(127 - ex) << 23);
    x *= inv; y *= inv;
    const v6u_t r = __builtin_amdgcn_cvt_scalef32_2xpk16_fp6_f32(x, y, 1.0f);
    unsigned char* dst = (unsigned char*)(isv ? p.Vb : p.Ub) + row * TROW;
    dst[l] = (unsigned char)(ex + 127);
    *(u32x4*)(dst + 64 + l * 16) = (u32x4){r[0], r[1], r[2], r[3]}; *(u32x2*)(dst + 64 + 1024 + l * 8) = (u32x2){r[4], r[5]}; }
}

DI void st_peergather(const Prm& p, int layer, float* lds, int bid, int nb, bool dry = false) {
  const int tid = ltid(), wave = tid >> 6, lane = tid & 63;
  const unsigned char* Ub = (const unsigned char*)p.Ub; const unsigned char* Vb = (const unsigned char*)p.Vb;
  for (int row = bid; row < MR; row += nb) {
    const int b = row / LT, t = row - b * LT; const bool isc = t >= LL;
    if (isc && layer == 1) continue;
    f32x2 hv[16];
#pragma unroll
    for (int q = 0; q < 4; ++q) { const u32x4 w = *(const u32x4*)(p.H2 + (size_t)row * DM + lane * 32 + q * 8);
#pragma unroll
      for (int k = 0; k < 4; ++k) hv[q * 4 + k] = (f32x2){__uint_as_float(w[k] << 16), __uint_as_float(w[k] & 0xffff0000u)}; }
    f32x2 acc[16];
#pragma unroll
    for (int i = 0; i < 16; ++i) acc[i] = (f32x2){0.f, 0.f};
    const int myidx = lane < 16 ? p.IDX[(size_t)row * 128 + wave * 16 + lane] : 0; const float mygate = lane < 16 ? p.GATE[(size_t)row * 128 + wave * 16 + lane] : 0.f;
#pragma unroll 1
    for (int k0 = 0; k0 < 16; k0 += 4) {
      u32x4 ua[4], va[4]; u32x2 ub[4], vb[4]; unsigned us[4], vs[4];
#pragma unroll
      for (int q = 0; q < 4; ++q) { const int e = __builtin_amdgcn_readfirstlane(__shfl(myidx, k0 + q));
        const unsigned char* ur = Ub + (size_t)e * TROW; const unsigned char* vr = Vb + (size_t)e * TROW;
        ua[q] = *(const u32x4*)(ur + 64 + lane * 16); ub[q] = *(const u32x2*)(ur + 64 + 1024 + lane * 8); us[q] = ur[lane];
        va[q] = *(const u32x4*)(vr + 64 + lane * 16); vb[q] = *(const u32x2*)(vr + 64 + 1024 + lane * 8); vs[q] = vr[lane]; }
#pragma unroll
      for (int q = 0; q < 4; ++q) {
        const v32f_t du = __builtin_amdgcn_cvt_scalef32_pk32_f32_fp6((v6u_t){ua[q][0], ua[q][1], ua[q][2], ua[q][3], ub[q][0], ub[q][1]}, 1.0f);
        f32x2 d0 = (f32x2){0.f, 0.f}, d1 = (f32x2){0.f, 0.f};
#pragma unroll
        for (int i = 0; i < 16; i += 2) { d0 += (f32x2){du[2 * i], du[2 * i + 1]} * hv[i]; d1 += (f32x2){du[2 * i + 2], du[2 * i + 3]} * hv[i + 1]; }
        d0 += d1; const float d = wsum((d0[0] + d0[1]) * __uint_as_float(us[q] << 23));
        const float wgt = __shfl(mygate, k0 + q) * 0.5f * d * (1.f + erff(d * 0.70710678118654752f)) * __uint_as_float(vs[q] << 23); const f32x2 w2 = (f32x2){wgt, wgt};
        const v32f_t dv = __builtin_amdgcn_cvt_scalef32_pk32_f32_fp6((v6u_t){va[q][0], va[q][1], va[q][2], va[q][3], vb[q][0], vb[q][1]}, 1.0f);
#pragma unroll
        for (int i = 0; i < 16; ++i) acc[i] += w2 * (f32x2){dv[2 * i], dv[2 * i + 1]}; }
    }
    __syncthreads();
#pragma unroll
    for (int k = 0; k < 8; ++k) *(f32x4*)(lds + wave * 2048 + lane * 32 + k * 4) = (f32x4){acc[2 * k][0], acc[2 * k][1], acc[2 * k + 1][0], acc[2 * k + 1][1]};
    __syncthreads();
    { const int col = tid * 4; f32x4 sum = (f32x4){0.f, 0.f, 0.f, 0.f};
#pragma unroll
      for (int w = 0; w < 8; ++w) sum += *(const f32x4*)(lds + w * 2048 + col);
      const f32x4 g2 = *(const f32x4*)(p.mod + ((size_t)layer * 9 + (isc ? 8 : b)) * NMOD + 5 * DM + col);
      float* xr = p.X + (size_t)row * DM + col; const f32x4 xn = *(const f32x4*)xr + g2 * sum;
      if (!dry) {
        float ss = wsum(xn[0] * xn[0] + xn[1] * xn[1] + xn[2] * xn[2] + xn[3] * xn[3]);
        if (lane == 0) lds[16384 + wave] = ss;
        __syncthreads();
        ss = 0.f;
#pragma unroll
        for (int w = 0; w < 8; ++w) ss += lds[16384 + w];
        const float rstd = rsqrtf(ss * (1.f / 2048.f) + EPSV);
        if (layer == 0) { *(f32x4*)xr = xn;
          const float* mr = p.mod + ((size_t)9 + (isc ? 8 : b)) * NMOD; const f32x4 sc = *(const f32x4*)(mr + DM + col), sh = *(const f32x4*)(mr + col);
          const f32x4 o = xn * rstd * (sc + 1.f) + sh; u32x2 w; w.x = pack2(o[0], o[1]); w.y = pack2(o[2], o[3]); *(u32x2*)(p.H + (size_t)row * DM + col) = w; }
        else *(f32x4*)(p.out + ((size_t)b * LL + t) * DM + col) = xn * rstd * *(const f32x4*)(p.final_norm + col);
      } }
  }
}

DI void st_final(const Prm& p, int bid, int nb) {
  const int wave = ltid() >> 6, lane = ltid() & 63;
  for (int r = bid * 8 + wave; r < NB * LL; r += nb * 8) {
    const int b = r / LL, t = r - b * LL; const float* src = p.X + (size_t)(b * LT + t) * DM;
    f32x4 v[8]; float ss = 0.f;
#pragma unroll
    for (int i = 0; i < 8; ++i) { v[i] = *(const f32x4*)(src + (i * 64 + lane) * 4); ss += v[i][0] * v[i][0] + v[i][1] * v[i][1] + v[i][2] * v[i][2] + v[i][3] * v[i][3]; }
    ss = wsum(ss); const float rstd = rsqrtf(ss * (1.f / 2048.f) + EPSV);
#pragma unroll
    for (int i = 0; i < 8; ++i) { const int col = (i * 64 + lane) * 4; *(f32x4*)(p.out + (size_t)r * DM + col) = v[i] * rstd * *(const f32x4*)(p.final_norm + col); }
  }
}

namespace att {
constexpr int NW = 8, QBLK = 32, KVBLK = 64;
constexpr float SCALE = 0.07216878364870322f;
constexpr float THR = 8.f;
constexpr int LDQ = 768, LDK = 1024, LDKR = 64, LDO = DM;
constexpr int SHM_V = KVBLK * 128 * 2, SHM_K = KVBLK * 128 * 2, SHM_KR = KVBLK * 64 * 2, SHM_ATTN = 2 * SHM_V + 2 * SHM_K + 2 * SHM_KR + NW * 64 * 4;
#define KSWZ(row, colB) ((row) * 256 + ((colB) ^ (((row) & 7) << 4)))
#define KRSWZ(row, colB) ((row) * 128 + ((colB) ^ ((((row) >> 1) & 7) << 4)))
#define SBAR() __builtin_amdgcn_sched_barrier(0)
DI int crow(int r, int hi) { return (r & 3) + 8 * (r >> 2) + 4 * hi; }
DI unsigned cvtpk(float lo, float hi) { unsigned r; asm volatile("v_cvt_pk_bf16_f32 %0, %1, %2" : "=v"(r) : "v"(lo), "v"(hi)); return r; }

DI void partialSM(f32x16& p0, f32x16& p1, float& m_reg, float& mn, float& alpha) {
  constexpr float C = SCALE * 1.4426950408889634f;
  float pmax = p0[0];
#pragma unroll
  for (int r = 1; r < 16; ++r) pmax = fmaxf(pmax, p0[r]);
#pragma unroll
  for (int r = 0; r < 16; ++r) pmax = fmaxf(pmax, p1[r]);
  { auto rr = __builtin_amdgcn_permlane32_swap(__float_as_uint(pmax), __float_as_uint(pmax), false, false);
    pmax = fmaxf(__uint_as_float(rr[0]), __uint_as_float(rr[1])); }
  if (__builtin_expect(__all(pmax - m_reg <= THR / SCALE), 1)) { mn = m_reg; alpha = 1.f; }
  else { mn = fmaxf(m_reg, pmax); alpha = __builtin_amdgcn_exp2f((m_reg - mn) * C); m_reg = mn; }
  const float mnC = -mn * C;
#pragma unroll
  for (int r = 0; r < 16; ++r) p0[r] = fmaf(p0[r], C, mnC);
#pragma unroll
  for (int r = 0; r < 16; ++r) p1[r] = fmaf(p1[r], C, mnC);
#pragma unroll
  for (int r = 0; r < 16; ++r) p0[r] = __builtin_amdgcn_exp2f(p0[r]);
}
DI void finishSM(f32x16& p0, f32x16& p1, float alpha, float& l_reg, bf16x8& pa0, bf16x8& pa1, bf16x8& pa2, bf16x8& pa3) {
#pragma unroll
  for (int r = 0; r < 16; ++r) p1[r] = __builtin_amdgcn_exp2f(p1[r]);
  float ps = 0;
#pragma unroll
  for (int r = 0; r < 16; ++r) ps += p0[r];
#pragma unroll
  for (int r = 0; r < 16; ++r) ps += p1[r];
  { auto rr = __builtin_amdgcn_permlane32_swap(__float_as_uint(ps), __float_as_uint(ps), false, false);
    ps = __uint_as_float(rr[0]) + __uint_as_float(rr[1]); }
  l_reg = l_reg * alpha + ps;
#define PK4(P, BASE, OUT) do { unsigned a0 = cvtpk(P[BASE + 0], P[BASE + 1]), a1 = cvtpk(P[BASE + 2], P[BASE + 3]);   \
    unsigned b0 = cvtpk(P[BASE + 4], P[BASE + 5]), b1 = cvtpk(P[BASE + 6], P[BASE + 7]);                              \
    auto r0 = __builtin_amdgcn_permlane32_swap(a0, b0, false, false); auto r1 = __builtin_amdgcn_permlane32_swap(a1, b1, false, false); \
    u32x4 w = {r0[0], r1[0], r0[1], r1[1]}; OUT = *reinterpret_cast<bf16x8*>(&w); } while (0)
  PK4(p0, 0, pa0); PK4(p0, 8, pa1); PK4(p1, 0, pa2); PK4(p1, 8, pa3);
#undef PK4
}
DI void qkt(f32x16& p0, f32x16& p1, const char* Ks, const char* KRs, const bf16x8* qr, int r32, int hi) {
  p0 = f32x16{}; p1 = f32x16{};
#pragma unroll
  for (int d0 = 0; d0 < 8; ++d0) { const int cb = (d0 * 16 + hi * 8) * 2;
    const bf16x8 b0 = *reinterpret_cast<const bf16x8*>(Ks + KSWZ(r32, cb));
    const bf16x8 b1 = *reinterpret_cast<const bf16x8*>(Ks + KSWZ(32 + r32, cb));
    p0 = __builtin_amdgcn_mfma_f32_32x32x16_bf16(b0, qr[d0], p0, 0, 0, 0);
    p1 = __builtin_amdgcn_mfma_f32_32x32x16_bf16(b1, qr[d0], p1, 0, 0, 0); }
#pragma unroll
  for (int d0 = 0; d0 < 4; ++d0) { const int cb = (d0 * 16 + hi * 8) * 2;
    const bf16x8 b0 = *reinterpret_cast<const bf16x8*>(KRs + KRSWZ(r32, cb));
    const bf16x8 b1 = *reinterpret_cast<const bf16x8*>(KRs + KRSWZ(32 + r32, cb));
    p0 = __builtin_amdgcn_mfma_f32_32x32x16_bf16(b0, qr[8 + d0], p0, 0, 0, 0);
    p1 = __builtin_amdgcn_mfma_f32_32x32x16_bf16(b1, qr[8 + d0], p1, 0, 0, 0); }
}
DI int v_st(int k, int c) { const int kk = (k & ~0xC) | ((k & 4) << 1) | ((k & 8) >> 1); return ((kk >> 3) * 4 + (c >> 5)) * 512 + ((kk & 7) * 32 + (c & 31)) * 2; }
DI int v_rd_base(int lane) { return ((lane & 3) << 3) | (((lane >> 2) & 3) << 6) | (((lane >> 4) & 1) << 5) | (((lane >> 5) & 1) << 8); }
constexpr int v_rd_off(int d0, int ks, int half) { return d0 * 512 + ks * 4096 + half * 2048; }
template <int OFF> DI s16x4 tr_read(int vb) { s16x4 r; asm volatile("ds_read_b64_tr_b16 %0, %1 offset:%2" : "=&v"(r) : "v"(vb), "i"(OFF) : "memory"); return r; }
template <int D0> DI void pv_one(f32x16& od, int vb, bf16x8 pa0, bf16x8 pa1, bf16x8 pa2, bf16x8 pa3) {
  const s16x4 l0 = tr_read<v_rd_off(D0, 0, 0)>(vb), h0 = tr_read<v_rd_off(D0, 0, 1)>(vb), l1 = tr_read<v_rd_off(D0, 1, 0)>(vb), h1 = tr_read<v_rd_off(D0, 1, 1)>(vb);
  const s16x4 l2 = tr_read<v_rd_off(D0, 2, 0)>(vb), h2 = tr_read<v_rd_off(D0, 2, 1)>(vb), l3 = tr_read<v_rd_off(D0, 3, 0)>(vb), h3 = tr_read<v_rd_off(D0, 3, 1)>(vb);
  asm volatile("s_waitcnt lgkmcnt(0)" ::: "memory"); SBAR();
#define PK(L, H) (bf16x8){L[0], L[1], L[2], L[3], H[0], H[1], H[2], H[3]}
  od = __builtin_amdgcn_mfma_f32_32x32x16_bf16(pa0, PK(l0, h0), od, 0, 0, 0);
  od = __builtin_amdgcn_mfma_f32_32x32x16_bf16(pa1, PK(l1, h1), od, 0, 0, 0);
  od = __builtin_amdgcn_mfma_f32_32x32x16_bf16(pa2, PK(l2, h2), od, 0, 0, 0);
  od = __builtin_amdgcn_mfma_f32_32x32x16_bf16(pa3, PK(l3, h3), od, 0, 0, 0);
#undef PK
}
DI void pv_d0(f32x16* o, int vb, bf16x8 pa0, bf16x8 pa1, bf16x8 pa2, bf16x8 pa3) {
  pv_one<0>(o[0], vb, pa0, pa1, pa2, pa3); pv_one<1>(o[1], vb, pa0, pa1, pa2, pa3); pv_one<2>(o[2], vb, pa0, pa1, pa2, pa3); pv_one<3>(o[3], vb, pa0, pa1, pa2, pa3);
}

DI void attn_body(const bf16_t* __restrict__ Qb, const bf16_t* __restrict__ Kh, const bf16_t* __restrict__ Vh, const bf16_t* __restrict__ KRh, bf16_t* __restrict__ Ob, int seq, int tpos0, char* lds) {
  const int tid = ltid(), wid = tid >> 6, lane = tid & 63, r32 = lane & 31, hi = lane >> 5;
  char* V_lds = lds; char* K_lds = lds + 2 * SHM_V; char* KR_lds = lds + 2 * SHM_V + 2 * SHM_K;
  float* ws = (float*)(lds + 2 * SHM_V + 2 * SHM_K + 2 * SHM_KR) + wid * 64; float* li_l = ws; float* al_l = ws + 32;
  float m_reg = -1e30f, l_reg = 0; f32x16 o[4] = {}; bf16x8 qr[12];
  const bf16_t* Qw = Qb + (long)(wid * QBLK + r32) * LDQ + hi * 8;
#pragma unroll
  for (int d0 = 0; d0 < 12; ++d0) qr[d0] = *reinterpret_cast<const bf16x8*>(Qw + d0 * 16);
  if (tpos0 >= 0) {
    const int t = tpos0 + wid * QBLK + r32;
#pragma unroll
    for (int hf = 0; hf < 2; ++hf) { const float pos = (float)(hf ? (t & 63) : (t >> 6));
#pragma unroll
      for (int j = 0; j < 8; ++j) { const float ang = pos * exp2f(-(float)(hi * 8 + j) * (13.287712379549449f / 16.f)); float sv, cv; sincosf(ang, &sv, &cv);
        const float x1 = bf2f((bf16_t)qr[8 + 2 * hf][j]), x2 = bf2f((bf16_t)qr[9 + 2 * hf][j]);
        qr[8 + 2 * hf][j] = (short)f2bf(x1 * cv - x2 * sv); qr[9 + 2 * hf][j] = (short)f2bf(x2 * cv + x1 * sv); } }
  }
  const int sr = tid >> 4, sc = (tid & 15) * 8, vst0 = v_st(sr, sc), vst1 = v_st(32 + sr, sc);
  const int krr = tid >> 3, krc = (tid & 7) * 8;
  const int vb0 = (int)(uintptr_t)V_lds + v_rd_base(lane);
  bf16x8 vs0, vs1, ks0, ks1, kr0;
#define SLOAD(k0) do { vs0 = *reinterpret_cast<const bf16x8*>(&Vh[(long)((k0) + sr) * LDK + sc]); vs1 = *reinterpret_cast<const bf16x8*>(&Vh[(long)((k0) + 32 + sr) * LDK + sc]); \
    ks0 = *reinterpret_cast<const bf16x8*>(&Kh[(long)((k0) + sr) * LDK + sc]); ks1 = *reinterpret_cast<const bf16x8*>(&Kh[(long)((k0) + 32 + sr) * LDK + sc]); \
    kr0 = *reinterpret_cast<const bf16x8*>(&KRh[(long)((k0) + krr) * LDKR + krc]); } while (0)
#define SWRITE(b) do { *(bf16x8*)(V_lds + (b) * SHM_V + vst0) = vs0; *(bf16x8*)(V_lds + (b) * SHM_V + vst1) = vs1; const int kc = sc * 2;               \
    *(bf16x8*)(K_lds + (b) * SHM_K + KSWZ(sr, kc)) = ks0; *(bf16x8*)(K_lds + (b) * SHM_K + KSWZ(32 + sr, kc)) = ks1;                       \
    *(bf16x8*)(KR_lds + (b) * SHM_KR + KRSWZ(krr, krc * 2)) = kr0; } while (0)
#define SWAIT() asm volatile("s_waitcnt vmcnt(0)" ::: "memory")
#define RESC(a) do { if (__any((a) < 1.f)) { if (hi == 0) al_l[r32] = (a); asm volatile("s_waitcnt lgkmcnt(0)" ::: "memory"); \
    _Pragma("unroll") for (int d = 0; d < 4; ++d) _Pragma("unroll") for (int r = 0; r < 16; ++r) o[d][r] *= al_l[crow(r, hi)]; } } while (0)
  f32x16 p0, p1; float mn, al; bf16x8 pa0, pa1, pa2, pa3; const int NT = seq / KVBLK;
  SLOAD(0); SWAIT(); SWRITE(0); __syncthreads();
  for (int j = 0; j < NT; ++j) {
    const int buf = j & 1; const bool more = j + 1 < NT;
    if (more) SLOAD((j + 1) * KVBLK);
    SBAR(); qkt(p0, p1, K_lds + buf * SHM_K, KR_lds + buf * SHM_KR, qr, r32, hi);
    partialSM(p0, p1, m_reg, mn, al); RESC(al);
    finishSM(p0, p1, al, l_reg, pa0, pa1, pa2, pa3); SBAR();
    pv_d0(o, vb0 + buf * SHM_V, pa0, pa1, pa2, pa3);
    if (more) { SWAIT(); SWRITE(buf ^ 1); }
    __syncthreads();
  }
  if (hi == 0) li_l[r32] = l_reg; asm volatile("s_waitcnt lgkmcnt(0)" ::: "memory");
  float rli[16];
#pragma unroll
  for (int r = 0; r < 16; ++r) rli[r] = __builtin_amdgcn_rcpf(li_l[crow(r, hi)]);
  bf16_t* Ow = Ob + (long)(wid * QBLK) * LDO;
#pragma unroll
  for (int r = 0; r < 16; ++r) { const int orow = crow(r, hi);
#pragma unroll
    for (int d0 = 0; d0 < 4; ++d0) Ow[(long)orow * LDO + d0 * 32 + r32] = f2bf(o[d0][r] * rli[r]); }
  __syncthreads();
#undef SLOAD
#undef SWRITE
#undef SWAIT
#undef RESC
}
}

DI void st_attn(const Prm& p, int layer, char* lds, int bid, int nb) {
  const int nlat = NB * 4 * 16, nitem = nlat + (layer == 0 ? NB * 4 : 0);
  for (int it = bid; it < nitem; it += nb) {
    if (it < nlat) { const int b = it >> 6, h = (it >> 4) & 3, qb = it & 15; const size_t r0 = (size_t)b * LT;
      att::attn_body(p.Qraw + (r0 + qb * 256) * 768 + h * 192, p.KV + r0 * 1024 + h * 256, p.KV + r0 * 1024 + h * 256 + 128, p.KR + r0 * 64,
                     p.Y + (r0 + qb * 256) * DM + 1024 + h * 128, LT, qb * 256, lds); }
    else { const int k = it - nlat, b = k >> 2, h = k & 3; const size_t r0 = (size_t)b * LT + LL;
      att::attn_body(p.Qraw + r0 * 768 + h * 192, p.KV + r0 * 1024 + h * 256, p.KV + r0 * 1024 + h * 256 + 128, p.KR + r0 * 64, p.Y + r0 * DM + 1024 + h * 128, LCX, -1, lds); }
  }
}

struct EpiResid {
  static constexpr bool PERM = false, AFTER_DRAIN = false;
  const float* xlat; const float* xctx; float* X; const float* modl; int first;
  __device__ __forceinline__ void operator()(const pg8::f32x4 (&acc)[2][2][4][2], const pg8::Unit& u, int wr, int wc, int fr, int fq) const {
    const int b = u.pm / 17, tl = u.pm - b * 17; const bool isc = tl == 16;
    const float* g = modl + (size_t)(isc ? 8 : b) * NMOD + 2 * DM;
    const int rloc0 = wr * 64 + fr, col0 = u.pn * 256 + wc * 32 + 4 * fq;
    pg8::f32x4 gv[2][2];
#pragma unroll
    for (int bj = 0; bj < 2; ++bj)
#pragma unroll
      for (int n = 0; n < 2; ++n) gv[bj][n] = *(const pg8::f32x4*)(g + col0 + bj * 128 + n * 16);
#pragma unroll
    for (int ai = 0; ai < 2; ++ai)
#pragma unroll
      for (int m = 0; m < 4; ++m) { const int rl = rloc0 + ai * 128 + m * 16; const size_t row = (size_t)u.pm * 256 + rl;
        const float* src = first ? (isc ? xctx + ((size_t)b * LCX + rl) * DM : xlat + ((size_t)b * LL + tl * 256 + rl) * DM) : X + row * DM;
        float* dst = X + row * DM;
#pragma unroll
        for (int bj = 0; bj < 2; ++bj)
#pragma unroll
          for (int n = 0; n < 2; ++n) { const int c = col0 + bj * 128 + n * 16; *(pg8::f32x4*)(dst + c) = *(const pg8::f32x4*)(src + c) + gv[bj][n] * acc[ai][bj][m][n]; } }
  }
};

struct LatentOrder : pg8::StaticOrder {
  __device__ bool next(int i, pg8::Unit& u) const { const bool ok = pg8::StaticOrder::next(i, u); u.pm += u.pm >> 4; return ok; }
};
template <class Epi> DI void run_gemm_lat(unsigned char* lds, const bf16_t* A, const bf16_t* Bt, int N, int K, const Epi& E, int bid, int nb) {
  pg8::Gemm g; g.A = A; g.Bt = Bt; g.M = NB * LL; g.N = N; g.K = K;
  LatentOrder S; S.init(NB * LL, N, nb, bid);
  pg8::gemm_phase<Epi, LatentOrder, false>((PG8_LAS unsigned char*)lds, g, S, E, nullptr);
}
template <class Epi> DI void run_gemm(unsigned char* lds, const bf16_t* A, const bf16_t* Bt, int M, int N, int K, const Epi& E, int bid, int nb) {
  pg8::Gemm g; g.A = A; g.Bt = Bt; g.M = M; g.N = N; g.K = K;
  pg8::StaticOrder S; S.init(M, N, nb, bid);
  pg8::gemm_phase<Epi, pg8::StaticOrder, false>((PG8_LAS unsigned char*)lds, g, S, E, nullptr);
}
DI pg8::EpiBf16<0> epi_bf16(bf16_t* O, int ldc, int split_cols = 0, size_t split_stride = 0) { pg8::EpiBf16<0> e; e.O = O; e.ldc = ldc; e.bias = nullptr; e.split_cols = split_cols; e.split_stride = split_stride; return e; }

#ifndef PROBE
#define PROBE 0
#endif
constexpr int LDS_MAIN = 131072 + 4096, LDS_TOTAL = LDS_MAIN + 64;
#define PRM() (*(const __attribute__((address_space(4))) Prm*)launder_k(kp))
typedef const __attribute__((address_space(4))) void* kptr_t;
DI kptr_t launder_k(kptr_t q) { asm volatile("" : "+s"(q)); return q; }
extern __shared__ __attribute__((aligned(16))) unsigned char shm[];
__global__ void __launch_bounds__(NTHR, 2) mega(Prm p_unused) {
#if defined(__HIP_DEVICE_COMPILE__)
  kptr_t kp = (kptr_t)__builtin_amdgcn_kernarg_segment_ptr();
  const int bid0 = blockIdx.x, nb0 = gridDim.x;
#define bid lsg(bid0)
#define nb lsg(nb0)
  uint4* xbw = (uint4*)(shm + LDS_MAIN);
  if (threadIdx.x == 0) *xbw = make_uint4(0u, 0u, 0u, 0u);
  __syncthreads();
  { const Prm p = PRM(); (void)xcd_barrier_post(p.bar, (volatile LAS unsigned*)xbw); }
#define GRID_BAR() do { XcdBarrier b_; b_.bar = PRM().bar; b_.x = xb_xcc_id(); b_.st = (volatile LAS unsigned*)(shm + LDS_MAIN); xcd_barrier(b_); } while (0)
  float* lf = (float*)shm;
  for (int ly = 0; ly < 2; ++ly) { const Prm p = PRM();
    st_transpose(p.w_in + (size_t)ly * DM * IN_W, p.WinT + (size_t)ly * NZ * DM, DM, IN_W, DM, NZ, lf, bid, nb);
    st_transpose(p.w_out + (size_t)ly * DM * DM, p.WoutT + (size_t)ly * DM * DM, DM, DM, DM, DM, lf, bid, nb);
    st_transpose(p.peer_wq + (size_t)ly * DM * DM, p.WqT + (size_t)ly * DM * DM, DM, DM, DM, DM, lf, bid, nb);
    st_transpose(p.mla_w_uq + (size_t)ly * 448 * 768, p.WuqT + (size_t)ly * 768 * 512, 448, 768, 512, 768, lf, bid, nb);
    st_transpose(p.mla_w_ukv + (size_t)ly * 128 * 1024, p.WukvT + (size_t)ly * 1024 * 256, 128, 1024, 256, 1024, lf, bid, nb);
  }
  { const Prm p = PRM(); st_tables(p, bid, nb); }
  __syncthreads();
  { const Prm p = PRM(); st_mods(p, lf, bid, nb); }
  if (PROBE == 5) { __syncthreads();
    for (int ly = 0; ly < 2; ++ly) { const Prm p = PRM();
      st_transpose(p.w_in + (size_t)ly * DM * IN_W, p.WinT + (size_t)ly * NZ * DM, DM, IN_W, DM, NZ, lf, bid, nb);
      st_transpose(p.w_out + (size_t)ly * DM * DM, p.WoutT + (size_t)ly * DM * DM, DM, DM, DM, DM, lf, bid, nb);
      st_transpose(p.peer_wq + (size_t)ly * DM * DM, p.WqT + (size_t)ly * DM * DM, DM, DM, DM, DM, lf, bid, nb); }
    { const Prm p = PRM(); st_tables(p, bid, nb); }
    __syncthreads();
    { const Prm p = PRM(); st_mods(p, lf, bid, nb); } }
  GRID_BAR();
  for (int l = 0; l < 2; ++l) {
    if (l == 0) { { const Prm p = PRM(); st_modulate(p, l, 0, p.H, bid, nb); } GRID_BAR(); }
    { const Prm p = PRM(); run_gemm(shm, p.H, p.WinT + (size_t)l * NZ * DM, MR, NZ, DM, epi_bf16(p.Z, NZ), bid, nb); }
    if (PROBE == 6) { const Prm p = PRM(); run_gemm(shm, p.H, p.WinT + (size_t)l * NZ * DM, MR, NZ, DM, epi_bf16(p.Z, NZ), bid, nb); }
    GRID_BAR();
    { const Prm p = PRM(); st_dnprep(p, l, bid, nb); }
    { const Prm p = PRM(); st_mlaprep(p, l, bid, nb); }
    { const Prm p = PRM(); st_fnchan(p, shm, bid, nb); }
    GRID_BAR();
    { const Prm p = PRM(); st_dntinv(p, shm, bid, nb); }
    __syncthreads();
    { const Prm p = PRM(); st_glabc(p, l, shm, bid, nb); }
    if (PROBE == 9) { { const Prm p = PRM(); st_dnprep(p, l, bid, nb); } { const Prm p = PRM(); st_mlaprep(p, l, bid, nb); } }
    if (PROBE == 10) { const Prm p = PRM(); st_fnchan(p, shm, bid, nb); }
    GRID_BAR();
    { const Prm p = PRM(); run_gemm(shm, p.Aq, p.WuqT + (size_t)l * 768 * 512, MR, 768, 512, epi_bf16(p.Qraw, 768), bid, nb); }
    { const Prm p = PRM(); run_gemm(shm, p.Akv, p.WukvT + (size_t)l * 1024 * 256, MR, 1024, 256, epi_bf16(p.KV, 1024), bid, nb); }
    if (bid < 128) { const Prm p = PRM(); st_dnscan(p, shm, bid, 128); }
    else { const Prm p = PRM(); st_glascan(p, l, shm, bid - 128, 128); }
    if (PROBE == 7) { GRID_BAR(); if (bid < 128) { const Prm p = PRM(); st_dnscan(p, shm, bid, 128); } }
    if (PROBE == 8) { GRID_BAR(); if (bid < 128) { const Prm p = PRM(); st_glascan(p, l, shm, bid, 128); } }
    if (PROBE == 2) { GRID_BAR(); if (bid < 128) { const Prm p = PRM(); st_dnscan(p, shm, bid, 128); } else { const Prm p = PRM(); st_glascan(p, l, shm, bid - 128, 128); } }
    GRID_BAR();
    { const Prm p = PRM(); st_attn(p, l, (char*)shm, bid, nb); }
    if (PROBE == 3) { const Prm p = PRM(); st_attn(p, l, (char*)shm, bid, nb); }
    { const Prm p = PRM(); run_gemm(shm, p.DFTM, p.PQT, 4096, 4096, 8192, epi_bf16(p.Y + 1536, DM, 512, (size_t)LT * DM), bid, nb); }
    if (l == 0) { const Prm p = PRM(); run_gemm(shm, p.DFTC, p.PQTc, 256, 4096, 512, epi_bf16(p.Y + (size_t)LL * DM + 1536, DM, 512, (size_t)LT * DM), bid, nb); }
    { const Prm p = PRM(); st_combine(p, l, bid, nb); }
    GRID_BAR();
    { const Prm p = PRM(); EpiResid e; e.xlat = p.x; e.xctx = p.ctx; e.X = p.X; e.modl = p.mod + (size_t)l * 9 * NMOD; e.first = l == 0;
      if (l == 0) run_gemm(shm, p.Y, p.WoutT + (size_t)l * DM * DM, MR, DM, DM, e, bid, nb);
      else run_gemm_lat(shm, p.Y, p.WoutT + (size_t)l * DM * DM, DM, DM, e, bid, nb); }
    GRID_BAR();
    { const Prm p = PRM(); st_modulate(p, l, 1, p.H2, bid, nb); }
    { const Prm p = PRM(); st_cvt_tables(p, l, bid, nb); }
    GRID_BAR();
    if (l == 0) { const Prm p = PRM(); run_gemm(shm, p.H2, p.WqT + (size_t)l * DM * DM, MR, DM, DM, epi_bf16(p.Qp, DM), bid, nb); }
    else { const Prm p = PRM(); run_gemm_lat(shm, p.H2, p.WqT + (size_t)l * DM * DM, DM, DM, epi_bf16(p.Qp, DM), bid, nb); }
    GRID_BAR();
    { const Prm p = PRM(); st_peertopk(p, l, shm, bid, nb); }
    if (PROBE == 4) { __syncthreads(); const Prm p = PRM(); st_peertopk(p, l, shm, bid, nb); }
    GRID_BAR();
    { const Prm p = PRM(); st_peergather(p, l, lf, bid, nb); }
    if (PROBE == 1) { __syncthreads(); const Prm p = PRM(); st_peergather(p, l, lf, bid, nb, true); }
    if (l == 0) GRID_BAR();
  }
#endif
#undef bid
#undef nb
#undef GRID_BAR
}

static size_t al256(size_t x) { return (x + 255) / 256 * 256; }
extern "C" void kernel_launch(void* const* d_in, const int* in_sizes, int n_in, void* d_out, int out_size, void* d_ws, size_t ws_size, hipStream_t stream) {
  Prm p{};
  const float** f = (const float**)&p.x;
  for (int i = 0; i < 24; ++i) f[i] = (const float*)d_in[i];
  p.out = (float*)d_out;
  char* w = (char*)d_ws; size_t o = 0;
  auto take = [&](size_t bytes) { char* r = w + o; o += al256(bytes); return r; };
  p.bar = (unsigned*)take(16384);
  p.WinT = (bf16_t*)take((size_t)2 * NZ * DM * 2); p.WoutT = (bf16_t*)take((size_t)2 * DM * DM * 2); p.WqT = (bf16_t*)take((size_t)2 * DM * DM * 2);
  p.WuqT = (bf16_t*)take((size_t)2 * 768 * 512 * 2); p.WukvT = (bf16_t*)take((size_t)2 * 1024 * 256 * 2);
  p.mod = (float*)take((size_t)2 * 9 * NMOD * 4); p.GB = (float*)take((size_t)MR * 16 * 4); p.CCS = (float*)take((size_t)2 * 128 * 128 * 4);
  p.DFTM = (bf16_t*)take((size_t)4096 * 8192 * 2); p.DFTC = (bf16_t*)take((size_t)256 * 512 * 2);
  p.X = (float*)take((size_t)MR * DM * 4);
  p.Z = (bf16_t*)take((size_t)MR * NZ * 2);
  char* ra = take((size_t)MR * 1536 * 2 + (size_t)4 * MR * 512 * 2);
  p.DNQ = (bf16_t*)ra; p.OB = (bf16_t*)(ra + (size_t)MR * 1536 * 2); p.H = (bf16_t*)ra;
  p.Ub = (bf16_t*)(ra + (size_t)MR * DM * 2); p.Vb = (bf16_t*)(ra + (size_t)MR * DM * 2 + (size_t)16384 * 1600);
  p.KV = (bf16_t*)take((size_t)MR * 1024 * 2); p.KR = (bf16_t*)take((size_t)MR * 64 * 2);
  p.Aq = (bf16_t*)take((size_t)MR * 512 * 2); p.Akv = (bf16_t*)take((size_t)MR * 256 * 2);
  if (o > ws_size) return;
  char* q = (char*)d_out; size_t oo = 0;
  p.Y = (bf16_t*)q; oo += (size_t)MR * DM * 2; p.PQT = (bf16_t*)(q + oo); oo += (size_t)8 * 512 * 8192 * 2; p.PQTc = (bf16_t*)(q + oo); oo += (size_t)8 * 512 * 512 * 2;
  p.Qraw = (bf16_t*)(q + oo); oo += (size_t)MR * 768 * 2;
  p.TINV = (bf16_t*)q; p.GCB = (float*)(q + (size_t)4352 * 4096 * 2); p.BC = (float*)(q + (size_t)4352 * 4096 * 2 + (size_t)4352 * 64 * 4);
  char* z = (char*)p.Z; p.H2 = (bf16_t*)z; p.Qp = (bf16_t*)(z + (size_t)MR * DM * 2); p.IDX = (int*)(z + (size_t)2 * MR * DM * 2); p.GATE = (float*)(z + (size_t)2 * MR * DM * 2 + (size_t)MR * 128 * 4);

  static int grid = 0;
  if (!grid) {
    (void)hipFuncSetAttribute((const void*)mega, hipFuncAttributeMaxDynamicSharedMemorySize, LDS_TOTAL);
    int dev = 0, cus = 0, per_cu = 0;
    (void)hipGetDevice(&dev); (void)hipDeviceGetAttribute(&cus, hipDeviceAttributeMultiprocessorCount, dev);
    (void)hipOccupancyMaxActiveBlocksPerMultiprocessor(&per_cu, (const void*)mega, NTHR, LDS_TOTAL);
    grid = per_cu >= 1 ? cus : 0;
    if (grid > 256) grid = 256;
  }
  if (grid < 256) return;
  (void)hipMemsetAsync(p.bar, 0, XCD_BAR_WORDS * sizeof(unsigned), stream);
  hipLaunchKernelGGL(mega, dim3(grid), dim3(NTHR), LDS_TOTAL, stream, p);
}
```

```cpp
#include <hip/hip_runtime.h>
#include <stdint.h>

constexpr int DM = 2048, NB = 8, LL = 4096, LCX = 256, LT = LL + LCX  , MR = NB * LT  ;
constexpr int NZ = 4864;
constexpr int C_DNQ = 0, C_DNK = 512, C_DNV = 1024, C_DNGATE = 1536, C_DNA = 2048, C_DNB = 2056, C_GQ = 2064, C_GK = 2320, C_GV = 2576,
              C_GGATE = 3088, C_GALPHA = 3600, C_CQ = 3632, C_CKV = 4080, C_KR = 4208, C_FN = 4272, IN_W = 4784;
constexpr int NMOD = 6 * DM;
constexpr float EPSV = 1e-6f;
constexpr int NTHR = 512;

typedef unsigned short bf16_t;
typedef short bf16x8 __attribute__((ext_vector_type(8)));
typedef short s16x4 __attribute__((ext_vector_type(4)));
typedef float f32x4 __attribute__((ext_vector_type(4)));
typedef float f32x16 __attribute__((ext_vector_type(16)));
typedef unsigned u32x4 __attribute__((ext_vector_type(4)));
typedef unsigned u32x2 __attribute__((ext_vector_type(2)));

#define DI __device__ __forceinline__
DI float bf2f(bf16_t b) { return __uint_as_float(((unsigned)b) << 16); }
DI bf16_t f2bf(float f) { unsigned u = __float_as_uint(f); u += 0x7FFFu + ((u >> 16) & 1u); return (bf16_t)(u >> 16); }
DI unsigned pack2(float lo, float hi) { return (unsigned)f2bf(lo) | ((unsigned)f2bf(hi) << 16); }
typedef float f32x2 __attribute__((ext_vector_type(2)));
DI float dpp_x1(float v) { return __int_as_float(__builtin_amdgcn_mov_dpp(__float_as_int(v), 0xB1, 0xf, 0xf, true)); }
DI float dpp_x2(float v) { return __int_as_float(__builtin_amdgcn_mov_dpp(__float_as_int(v), 0x4E, 0xf, 0xf, true)); }
DI float dpp_hm(float v) { return __int_as_float(__builtin_amdgcn_mov_dpp(__float_as_int(v), 0x141, 0xf, 0xf, true)); }
DI float dpp_rm(float v) { return __int_as_float(__builtin_amdgcn_mov_dpp(__float_as_int(v), 0x140, 0xf, 0xf, true)); }
DI float red4(float v) { v += dpp_x1(v); v += dpp_x2(v); return v; }
DI float red8(float v) { v += dpp_x1(v); v += dpp_x2(v); v += dpp_hm(v); return v; }
DI float rdl(float v, int l) { return __int_as_float(__builtin_amdgcn_readlane(__float_as_int(v), l)); }
DI float wsum(float v) { v += dpp_x1(v); v += dpp_x2(v); v += dpp_hm(v); v += dpp_rm(v); return (rdl(v, 0) + rdl(v, 16)) + (rdl(v, 32) + rdl(v, 48)); }
DI float wmax(float v) { v = fmaxf(v, dpp_x1(v)); v = fmaxf(v, dpp_x2(v)); v = fmaxf(v, dpp_hm(v)); v = fmaxf(v, dpp_rm(v)); return fmaxf(fmaxf(rdl(v, 0), rdl(v, 16)), fmaxf(rdl(v, 32), rdl(v, 48))); }
DI float siluf(float x) { return x / (1.f + __expf(-x)); }
DI float sigmf(float x) { return 1.f / (1.f + __expf(-x)); }

DI int ltid() { int t = (int)threadIdx.x; asm volatile("" : "+v"(t)); return t; }
DI int lsg(int v) { asm volatile("" : "+s"(v)); return v; }

struct Prm {
  const float *x, *c, *ctx, *c_ctx, *w_ada, *b_ada, *w_in, *dn_conv, *dn_a_log, *dn_dt_bias, *dn_norm, *gla_w2, *gla_b2, *gla_norm,
      *mla_q_norm, *mla_w_uq, *mla_kv_norm, *mla_w_ukv, *w_out, *peer_wq, *peer_keys, *peer_u, *peer_v, *final_norm;
  float* out;
  bf16_t *WinT, *WoutT, *WqT, *WuqT, *WukvT;
  float *mod, *GB, *CCS;
  bf16_t *DFTM, *DFTC;
  float* X;
  bf16_t* Z;
  bf16_t *H, *DNQ, *OB;
  bf16_t *KV, *KR;
  bf16_t *Y, *PQT, *PQTc, *Qraw, *Aq, *Akv;
  bf16_t *H2, *Qp;
  bf16_t *Ub, *Vb;
  bf16_t* TINV; float* GCB; float* BC;
  int* IDX;
  float* GATE;
  unsigned* bar;
};
#define XB_TMO      128
#define XB_XCNT(j)  (256  + 64 * (j))
#define XB_XSUB(j)  (1280 + 64 * (j))
#define XB_XGEN(j)  (2304 + 64 * (j))
#define XB_TOP      3328
#define XB_TOPGEN   3392
#define XCD_BAR_WORDS 3456
#define XB_SPIN_CAP (1u << 18)
#define LAS __attribute__((address_space(3)))

__device__ __forceinline__ unsigned xb_ld(unsigned* p)              { return __hip_atomic_load(p, __ATOMIC_RELAXED, __HIP_MEMORY_SCOPE_AGENT); }
__device__ __forceinline__ unsigned xb_add(unsigned* p, unsigned v) { return __hip_atomic_fetch_add(p, v, __ATOMIC_RELAXED, __HIP_MEMORY_SCOPE_AGENT); }
__device__ __forceinline__ unsigned xb_xcc_id() { return (unsigned)__builtin_amdgcn_s_getreg((3 << 11) | 20) & 0xFu; }
#define XB_SPIN(cond, bar) do { unsigned _sp = 0; while (cond) { __builtin_amdgcn_s_sleep(1); \
    if ((++_sp & 255u) == 0u) { if (xb_ld(&(bar)[XB_TMO])) break; if (_sp > XB_SPIN_CAP) { atomicAdd(&(bar)[XB_TMO], 1u); break; } } } } while (0)

struct XcdBarrier {
    unsigned* bar; unsigned x;
    volatile LAS unsigned* st;
};

__device__ __forceinline__ XcdBarrier xcd_barrier_post(unsigned* bar, volatile LAS unsigned* st) {
    XcdBarrier b; b.bar = bar; b.x = xb_xcc_id(); b.st = st;
    if (threadIdx.x == 0) (void)xb_add(&bar[XB_XCNT(b.x)], 1u);
    return b;
}
__device__ __forceinline__ void xcd_barrier_complete(unsigned* bar, unsigned x, unsigned& nloc, unsigned& nx) {
    const unsigned G = gridDim.x * gridDim.y * gridDim.z;
    unsigned sum, cnt, mine, sp = 0u;
    for (;;) {
        sum = 0u; cnt = 0u; mine = 0u;
#pragma unroll
        for (unsigned j = 0; j < 16; ++j) { const unsigned c = xb_ld(&bar[XB_XCNT(j)]); sum += c; cnt += (c > 0u) ? 1u : 0u; mine = (j == x) ? c : mine; }
        if (sum == G) break;
        __builtin_amdgcn_s_sleep(1);
        if ((++sp & 255u) == 0u) { if (xb_ld(&bar[XB_TMO])) break; if (sp > XB_SPIN_CAP) { atomicAdd(&bar[XB_TMO], 1u); break; } }
    }
    nloc = mine > 0u ? mine : 1u; nx = cnt > 0u ? cnt : 1u;
}

__device__ __forceinline__ void xcd_barrier(const XcdBarrier& b) {
    asm volatile("s_waitcnt vmcnt(0)" ::: "memory");
    __syncthreads();
    if (threadIdx.x == 0) {
        unsigned* bar = b.bar;
        __builtin_amdgcn_s_waitcnt(0);
        unsigned nloc = b.st[0], nx = b.st[1];
        if (nloc == 0u) { xcd_barrier_complete(bar, b.x, nloc, nx); b.st[0] = nloc; b.st[1] = nx; }
        const unsigned old = xb_add(&bar[XB_XSUB(b.x)], 1u);
        const unsigned gen = old / nloc;
        if (old + 1u == (gen + 1u) * nloc) {
            __builtin_amdgcn_fence(__ATOMIC_RELEASE, "agent");
            asm volatile("s_waitcnt vmcnt(0)" ::: "memory");
            const unsigned og = xb_add(&bar[XB_TOP], 1u);
            const unsigned tg = og / nx;
            if (og + 1u == (tg + 1u) * nx) xb_add(&bar[XB_TOPGEN], 1u);
            else XB_SPIN(xb_ld(&bar[XB_TOPGEN]) == tg, bar);
            __builtin_amdgcn_fence(__ATOMIC_ACQUIRE, "agent");
            xb_add(&bar[XB_XGEN(b.x)], 1u);
            asm volatile("s_waitcnt vmcnt(0)" ::: "memory");
        } else {
            XB_SPIN(xb_ld(&bar[XB_XGEN(b.x)]) == gen, bar);
            __builtin_amdgcn_fence(__ATOMIC_ACQUIRE, "agent");
            asm volatile("s_waitcnt vmcnt(0)" ::: "memory");
        }
    }
    __syncthreads();
}

namespace pg8 {
#define PG8_LAS __attribute__((address_space(3)))
typedef unsigned short bf16_t;
typedef short bf16x8 __attribute__((ext_vector_type(8)));
typedef float f32x4 __attribute__((ext_vector_type(4)));
typedef unsigned u32x4 __attribute__((ext_vector_type(4)));
constexpr int BM = 256, BK = 64, HALF = 128, HTB = HALF * BK * 2  , STAGE_BYTES = 8 * HTB, NXCD = 8, WGM = 8;

__host__ __device__ __forceinline__ int lds_byte(int r, int c) { const int st = (r >> 4) * 2 + (c >> 5), rr = r & 15, cc = c & 31, ob = rr * 64 + cc * 2; return st * 1024 + (ob ^ (((ob >> 9) & 1) << 5)); }
__host__ __device__ __forceinline__ void stage_rc(int b, int& R, int& C) { const int st = b / 1024, sb = b % 1024, swz = sb ^ (((sb >> 9) & 1) << 5); R = (st >> 1) * 16 + swz / 64; C = (st & 1) * 32 + (swz % 64) / 2; }
__host__ __device__ __forceinline__ int perm32(int rho) { const int n = rho >> 4, i = rho & 15; return 8 * (i >> 2) + 4 * n + (i & 3); }

struct Unit { int pm, pn; };
struct Gemm { const bf16_t* A; const bf16_t* Bt; int M, N, K; };

struct StaticOrder {
    int nM, nN, nwg, G, c;
    __host__ __device__ void init(int M, int N, int G_, int c_) { nM = M / BM; nN = N / BM; nwg = nM * nN; G = G_; c = c_; }
    __host__ __device__ bool next(int i, Unit& u) const {
        const long L = (long)i * G + c; if (L >= nwg) return false;
        int wgid = (int)L; { const int q = nwg / NXCD, r = nwg % NXCD, xcd = wgid % NXCD, off = wgid / NXCD; wgid = (xcd < r ? xcd * (q + 1) : r * (q + 1) + (xcd - r) * q) + off; }
        const int nig = WGM * nN, gid = wgid / nig, fm = gid * WGM, gsz = (nM - fm) < WGM ? (nM - fm) : WGM;
        u.pm = fm + ((wgid % nig) % gsz); u.pn = (wgid % nig) / gsz; return true;
    }
    __device__ __forceinline__ void a_ready(const Unit&) const {}
    __device__ __forceinline__ void done(const Unit&) const {}
};
struct CountedOrder : StaticOrder {
    const unsigned* ready; unsigned need; unsigned* tmo;
    __device__ __forceinline__ void a_ready(const Unit& u) const {
        if (threadIdx.x < 64) {
            const unsigned long long t0 = __builtin_amdgcn_s_memrealtime(); unsigned polls = 0;
            while ((unsigned)__builtin_amdgcn_readfirstlane(__hip_atomic_load(ready + 64 * u.pm, __ATOMIC_RELAXED, __HIP_MEMORY_SCOPE_AGENT)) < need) {
                if ((++polls & 255u) == 0u && __builtin_amdgcn_readfirstlane(__hip_atomic_load(tmo, __ATOMIC_RELAXED, __HIP_MEMORY_SCOPE_AGENT)) != 0u) break;
                if (__builtin_amdgcn_s_memrealtime() - t0 > 2000000ull) {
                    if (threadIdx.x == 0) { unsigned expect = 0u; __hip_atomic_compare_exchange_strong(tmo + 1, &expect, 0x600u | (unsigned)(u.pm & 0xff), __ATOMIC_RELAXED, __ATOMIC_RELAXED, __HIP_MEMORY_SCOPE_AGENT); __hip_atomic_store(tmo, 1u, __ATOMIC_RELAXED, __HIP_MEMORY_SCOPE_AGENT); }
                    break; }
                __builtin_amdgcn_s_sleep(2); }
            __builtin_amdgcn_fence(__ATOMIC_ACQUIRE, "agent");
            asm volatile("s_waitcnt vmcnt(0)" ::: "memory");
        }
#if !defined(BROKEN_HOOK_NO_BARRIER)
        asm volatile("" ::: "memory"); __builtin_amdgcn_s_barrier(); asm volatile("" ::: "memory");
#endif
    }
};

__device__ __forceinline__ unsigned cvt_pk_bf16(float lo, float hi) { unsigned r; asm volatile("v_cvt_pk_bf16_f32 %0, %1, %2" : "=v"(r) : "v"(lo), "v"(hi)); return r; }
typedef float f32x2 __attribute__((ext_vector_type(2)));
__device__ __forceinline__ f32x2 gelu_pk(f32x2 v) {
    const f32x2 av = __builtin_elementwise_abs(v), d = av * 0.2316418882f + 1.0f;
    f32x2 t; t.x = __builtin_amdgcn_rcpf(d.x); t.y = __builtin_amdgcn_rcpf(d.y);
    f32x2 q = t * 0.5307027145f + (-0.7265760135f); q = q * t + 0.7107068705f; q = q * t + (-0.142248368f); q = q * t + 0.127414796f; q = q * t;
    const f32x2 s = (v * v) * (-0.72134752044f);
    f32x2 e; e.x = __builtin_amdgcn_exp2f(s.x); e.y = __builtin_amdgcn_exp2f(s.y);
    const f32x2 m = v * (q * e), r = v - m;
    f32x2 o; o.x = v.x < 0.f ? m.x : r.x; o.y = v.y < 0.f ? m.y : r.y; return o;
}

struct EpiF32 {
    static constexpr bool PERM = false, AFTER_DRAIN = false;
    float* C; int ldc; const float* bias;
    __device__ __forceinline__ void operator()(const f32x4 (&acc)[2][2][4][2], const Unit& u, int wr, int wc, int fr, int fq) const {
        const int row0 = u.pm * BM + wr * 64 + fr, col0 = u.pn * BM + wc * 32 + 4 * fq;
        f32x4 bv[2][2];
#pragma unroll
        for (int bj = 0; bj < 2; ++bj)
#pragma unroll
            for (int n = 0; n < 2; ++n) bv[bj][n] = bias ? *(const f32x4*)(bias + col0 + bj * HALF + n * 16) : (f32x4){0.f, 0.f, 0.f, 0.f};
#pragma unroll
        for (int ai = 0; ai < 2; ++ai)
#pragma unroll
            for (int m = 0; m < 4; ++m) { float* rowp = C + (size_t)(row0 + ai * HALF + m * 16) * ldc + col0;
#pragma unroll
                for (int bj = 0; bj < 2; ++bj)
#pragma unroll
                    for (int n = 0; n < 2; ++n) *(f32x4*)(rowp + bj * HALF + n * 16) = acc[ai][bj][m][n] + bv[bj][n]; }
    }
};
template <int ACT  > struct EpiBf16 {
    static constexpr bool PERM = true, AFTER_DRAIN = false;
    bf16_t* O; int ldc; const float* bias; int split_cols; size_t split_stride;
    __device__ __forceinline__ void operator()(const f32x4 (&acc)[2][2][4][2], const Unit& u, int wr, int wc, int fr, int fq) const {
        const int row0 = u.pm * BM + wr * 64 + fr; int colt = u.pn * BM; bf16_t* base = O;
        if (split_cols) { const int t = colt / split_cols; base += (size_t)t * split_stride; colt -= t * split_cols; }
        const int col0 = colt + wc * 32 + 8 * fq, bcol0 = u.pn * BM + wc * 32 + 8 * fq;
        f32x4 bv[2][2];
#pragma unroll
        for (int bj = 0; bj < 2; ++bj)
#pragma unroll
            for (int n = 0; n < 2; ++n) bv[bj][n] = bias ? *(const f32x4*)(bias + bcol0 + bj * HALF + 4 * n) : (f32x4){0.f, 0.f, 0.f, 0.f};
#pragma unroll
        for (int ai = 0; ai < 2; ++ai)
#pragma unroll
            for (int m = 0; m < 4; ++m) { bf16_t* rowp = base + (size_t)(row0 + ai * HALF + m * 16) * ldc + col0;
#pragma unroll
                for (int bj = 0; bj < 2; ++bj) { f32x4 v0 = acc[ai][bj][m][0] + bv[bj][0], v1 = acc[ai][bj][m][1] + bv[bj][1];
                    if (ACT == 1) { f32x2 a = gelu_pk((f32x2){v0[0], v0[1]}), b = gelu_pk((f32x2){v0[2], v0[3]}), c = gelu_pk((f32x2){v1[0], v1[1]}), d = gelu_pk((f32x2){v1[2], v1[3]});
                        v0 = (f32x4){a.x, a.y, b.x, b.y}; v1 = (f32x4){c.x, c.y, d.x, d.y}; }
                    if (ACT == 2) {
#pragma unroll
                        for (int j = 0; j < 4; ++j) { v0[j] = 0.5f * v0[j] * (1.0f + erff(v0[j] * 0.70710678f)); v1[j] = 0.5f * v1[j] * (1.0f + erff(v1[j] * 0.70710678f)); } }
                    u32x4 w; w.x = cvt_pk_bf16(v0[0], v0[1]); w.y = cvt_pk_bf16(v0[2], v0[3]); w.z = cvt_pk_bf16(v1[0], v1[1]); w.w = cvt_pk_bf16(v1[2], v1[3]);
                    *(u32x4*)(rowp + bj * HALF) = w; } }
    }
};
template <class Epi, class Sched, bool STAMP = false>
__device__ __forceinline__ void gemm_phase(PG8_LAS unsigned char* lds, const Gemm g, const Sched& S, const Epi& E, unsigned long long* stamps) {
    const int tid = ltid(), wid = __builtin_amdgcn_readfirstlane(tid >> 6), lane = tid & 63, wr = wid >> 2, wc = wid & 3, fr = lane & 15, fq = lane >> 4;
    const int K = g.K, nt = K / BK;
    int ts_lo = 0, ts_hi = 0, nts = 0; const unsigned long long rt_entry = STAMP ? (unsigned long long)wall_clock64() : 0ull;
#define PG8_STAMP() do { if (STAMP && wid == 0 && nts < 64) { const unsigned long long _c = (unsigned long long)clock64(); \
        ts_lo = (lane == nts) ? (int)(unsigned)_c : ts_lo; ts_hi = (lane == nts) ? (int)(unsigned)(_c >> 32) : ts_hi; ++nts; } } while (0)
    PG8_STAMP();
    unsigned voffA[2], voffB[2];
#pragma unroll
    for (int i = 0; i < 2; ++i) { int R, C; stage_rc(tid * 16 + i * 8192, R, C); const int Rb = Epi::PERM ? ((R & ~31) + perm32(R & 31)) : R;
        voffA[i] = (unsigned)(R * K + C) * 2u; voffB[i] = (unsigned)(Rb * K + C) * 2u; }
    const size_t kstep = (size_t)(BK * 2);
    const size_t hstep = (size_t)HALF * K * 2;
    const size_t tstep = 2 * hstep;
    const unsigned ldsw = (unsigned)wid * 1024u;
    const int aoff = lds_byte(wr * 64 + fr, fq * 8), boff = lds_byte(wc * 32 + fr, fq * 8);
#define PG8_SA(b, h) (((b) * 2 + (h)) * HTB)
#define PG8_SB(b, h) ((4 + (b) * 2 + (h)) * HTB)
#define PG8_STAGE(bufoff, gbase, voff) do { _Pragma("unroll") for (int _i = 0; _i < 2; ++_i) \
        __builtin_amdgcn_global_load_lds((const unsigned*)((const char*)(gbase) + (voff)[_i]), (PG8_LAS unsigned*)(lds + (bufoff) + ldsw + _i * 8192), 16, 0, 0); } while (0)
#define PG8_LDA(dst, b, h) do { _Pragma("unroll") for (int m = 0; m < 4; ++m) _Pragma("unroll") for (int k = 0; k < 2; ++k) dst[m][k] = *(const PG8_LAS bf16x8*)(lds + PG8_SA(b, h) + aoff + m * 2048 + k * 1024); } while (0)
#define PG8_LDB(dst, b, h) do { _Pragma("unroll") for (int n = 0; n < 2; ++n) _Pragma("unroll") for (int k = 0; k < 2; ++k) dst[n][k] = *(const PG8_LAS bf16x8*)(lds + PG8_SB(b, h) + boff + n * 2048 + k * 1024); } while (0)
#define PG8_MMA(ai, bj, At, Bt) do { __builtin_amdgcn_s_setprio(1); _Pragma("unroll") for (int m = 0; m < 4; ++m) _Pragma("unroll") for (int n = 0; n < 2; ++n) _Pragma("unroll") for (int k = 0; k < 2; ++k) \
        acc[ai][bj][m][n] = __builtin_amdgcn_mfma_f32_16x16x32_bf16(Bt[n][k], At[m][k], acc[ai][bj][m][n], 0, 0, 0); __builtin_amdgcn_s_setprio(0); } while (0)
#define PG8_WAIT_V(n) asm volatile("s_waitcnt vmcnt(" #n ")" ::: "memory")
#define PG8_WAIT_L(n) asm volatile("s_waitcnt lgkmcnt(" #n ")" ::: "memory")
#define PG8_BAR __builtin_amdgcn_s_barrier()
#define PG8_SCHED __builtin_amdgcn_sched_barrier(0)
    Unit cur, nxt; int ui = 0;
    if (!S.next(0, cur)) return;
    f32x4 acc[2][2][4][2];
#pragma unroll
    for (int a = 0; a < 2; ++a)
#pragma unroll
        for (int b = 0; b < 2; ++b)
#pragma unroll
            for (int m = 0; m < 4; ++m)
#pragma unroll
                for (int n = 0; n < 2; ++n) acc[a][b][m][n] = (f32x4){0.f, 0.f, 0.f, 0.f};
    bf16x8 At[4][2], B0[2][2], B1[2][2];
    const char* cA = (const char*)g.A + (size_t)cur.pm * tstep; const char* cB = (const char*)g.Bt + (size_t)cur.pn * tstep;
    S.a_ready(cur);
    PG8_STAGE(PG8_SB(0, 0), cB, voffB); PG8_STAGE(PG8_SA(0, 0), cA, voffA); PG8_STAGE(PG8_SB(0, 1), cB + hstep, voffB); PG8_STAGE(PG8_SA(0, 1), cA + hstep, voffA);
    if (wr == 1) PG8_BAR;
    PG8_WAIT_V(4); PG8_BAR;
    PG8_STAGE(PG8_SB(1, 0), cB + kstep, voffB); PG8_STAGE(PG8_SA(1, 0), cA + kstep, voffA); PG8_STAGE(PG8_SB(1, 1), cB + hstep + kstep, voffB);
    PG8_WAIT_V(6); PG8_BAR;
    PG8_STAMP();
    for (;;) {
        const bool has_next = S.next(ui + 1, nxt);
        const char* nA = has_next ? (const char*)g.A + (size_t)nxt.pm * tstep : cA; const char* nB = has_next ? (const char*)g.Bt + (size_t)nxt.pn * tstep : cB;
        for (int t = 0; t < nt; t += 2) {
            const bool last = (t == nt - 2);
            const char* a1 = cA + (size_t)(t + 1) * kstep;
            const char* a2 = last ? nA : cA + (size_t)(t + 2) * kstep; const char* b2 = last ? nB : cB + (size_t)(t + 2) * kstep;
            const char* a3 = a2 + kstep; const char* b3 = b2 + kstep;
            if (last && has_next) S.a_ready(nxt);
            PG8_LDB(B0, 0, 0); PG8_SCHED; PG8_LDA(At, 0, 0); PG8_STAGE(PG8_SA(1, 1), a1 + hstep, voffA);
            PG8_WAIT_L(8); PG8_BAR; PG8_WAIT_L(0); PG8_MMA(0, 0, At, B0); PG8_BAR; PG8_SCHED;
            PG8_LDB(B1, 0, 1); PG8_STAGE(PG8_SB(0, 0), b2, voffB);
            PG8_BAR; PG8_WAIT_L(0); PG8_MMA(0, 1, At, B1); PG8_BAR;
            PG8_LDA(At, 0, 1); PG8_STAGE(PG8_SA(0, 0), a2, voffA);
            PG8_BAR; PG8_WAIT_L(0); PG8_MMA(1, 0, At, B0); PG8_BAR; PG8_SCHED;
            PG8_STAGE(PG8_SB(0, 1), b2 + hstep, voffB);
            PG8_WAIT_V(6); PG8_BAR; PG8_MMA(1, 1, At, B1); PG8_BAR;
            PG8_LDB(B0, 1, 0); PG8_SCHED; PG8_LDA(At, 1, 0); PG8_STAGE(PG8_SA(0, 1), a2 + hstep, voffA);
            PG8_WAIT_L(8); PG8_BAR; PG8_WAIT_L(0); PG8_MMA(0, 0, At, B0); PG8_BAR; PG8_SCHED;
            PG8_LDB(B1, 1, 1); PG8_STAGE(PG8_SB(1, 0), b3, voffB);
            PG8_BAR; PG8_WAIT_L(0); PG8_MMA(0, 1, At, B1); PG8_BAR;
            PG8_LDA(At, 1, 1); PG8_STAGE(PG8_SA(1, 0), a3, voffA);
            PG8_BAR; PG8_WAIT_L(0); PG8_MMA(1, 0, At, B0); PG8_BAR; PG8_SCHED;
            PG8_STAGE(PG8_SB(1, 1), b3 + hstep, voffB);
            PG8_WAIT_V(6); PG8_BAR; PG8_MMA(1, 1, At, B1); PG8_BAR;
        }
        PG8_STAMP();
        if constexpr (!Epi::AFTER_DRAIN) { E(acc, cur, wr, wc, fr, fq); S.done(cur); }
        PG8_STAMP();
        if (!has_next) break;
#pragma unroll
        for (int a = 0; a < 2; ++a)
#pragma unroll
            for (int b = 0; b < 2; ++b)
#pragma unroll
                for (int m = 0; m < 4; ++m)
#pragma unroll
                    for (int n = 0; n < 2; ++n) acc[a][b][m][n] = (f32x4){0.f, 0.f, 0.f, 0.f};
        cur = nxt; cA = nA; cB = nB; ++ui;
    }
    PG8_WAIT_V(0);
    if (wr == 0) PG8_BAR;
    PG8_BAR;
    if constexpr (Epi::AFTER_DRAIN) { E.fused(acc, cur, wr, wc, fr, fq, lds, wid, lane); S.done(cur); }
    PG8_STAMP();
    if (STAMP && wid == 0) { stamps[lane] = lane < nts ? (((unsigned long long)(unsigned)ts_hi << 32) | (unsigned)ts_lo) : 0ull;
        if (lane == 62) stamps[62] = rt_entry; if (lane == 63) stamps[63] = (unsigned long long)wall_clock64(); }
#undef PG8_STAMP
#undef PG8_SA
#undef PG8_SB
#undef PG8_STAGE
#undef PG8_LDA
#undef PG8_LDB
#undef PG8_MMA
#undef PG8_WAIT_V
#undef PG8_WAIT_L
#undef PG8_BAR
#undef PG8_SCHED
}
}

DI void st_transpose(const float* __restrict__ src, bf16_t* __restrict__ dst, int K, int N, int Kpad, int Npad, float* lds, int bid, int nb) {
  const int tk = Kpad / 64, tn = Npad / 64;
  for (int it = bid; it < tk * tn; it += nb) {
    const int k0 = (it % tk) * 64, n0 = (it / tk) * 64;
    __syncthreads();
    for (int e = ltid(); e < 4096; e += NTHR) { const int i = e >> 6, j = e & 63, k = k0 + i, n = n0 + j; lds[i * 65 + j] = (k < K && n < N) ? src[(size_t)k * N + n] : 0.f; }
    __syncthreads();
    { const int e = ltid(), j = e >> 3, i8 = (e & 7) * 8; u32x4 w;
      w.x = pack2(lds[i8 * 65 + j], lds[(i8 + 1) * 65 + j]); w.y = pack2(lds[(i8 + 2) * 65 + j], lds[(i8 + 3) * 65 + j]);
      w.z = pack2(lds[(i8 + 4) * 65 + j], lds[(i8 + 5) * 65 + j]); w.w = pack2(lds[(i8 + 6) * 65 + j], lds[(i8 + 7) * 65 + j]);
      *(u32x4*)(dst + (size_t)(n0 + j) * Kpad + k0 + i8) = w; }
  }
}

DI void st_mods(const Prm& p, float* lds, int bid, int nb) {
  float* s = lds; float* red = lds + 9 * 2048;
  for (int e = ltid(); e < 9 * 2048; e += NTHR) { const int r = e >> 11, k = e & 2047; const float v = r < 8 ? p.c[r * 2048 + k] : p.c_ctx[k]; s[e] = siluf(v); }
  __syncthreads();
  const int kg = ltid() >> 6, cl = ltid() & 63;
  for (int it = bid; it < 2 * 192; it += nb) {
    const int l = it / 192, cb = (it % 192) * 64;
    const float* w = p.w_ada + (size_t)l * 2048 * NMOD + cb + cl;
    float acc[9];
#pragma unroll
    for (int r = 0; r < 9; ++r) acc[r] = 0.f;
    for (int k = kg * 256; k < kg * 256 + 256; ++k) { const float wv = w[(size_t)k * NMOD];
#pragma unroll
      for (int r = 0; r < 9; ++r) acc[r] += s[r * 2048 + k] * wv; }
#pragma unroll
    for (int r = 0; r < 9; ++r) red[(kg * 9 + r) * 64 + cl] = acc[r];
    __syncthreads();
    for (int e = ltid(); e < 576; e += NTHR) { const int r = e >> 6, c2 = e & 63; float t = 0.f;
      for (int g = 0; g < 8; ++g) t += red[(g * 9 + r) * 64 + c2];
      p.mod[((size_t)l * 9 + r) * NMOD + cb + c2] = t + p.b_ada[l * NMOD + cb + c2]; }
    __syncthreads();
  }
}

DI void st_tables(const Prm& p, int bid, int nb) {
  const size_t stride = (size_t)nb * NTHR, t0 = (size_t)bid * NTHR + ltid();
  for (size_t e = t0; e < (size_t)256 * 512; e += stride) { const int k1 = (int)(e >> 9), n = (int)(e & 511), n1 = n & 255, idx = (k1 * n1) & 255;
    float sv, cv; sincosf((float)idx * (6.283185307179586f / 256.f), &sv, &cv); p.DFTC[e] = f2bf((n < 256 ? cv : -sv) * (1.f / 16.f)); }
  for (size_t e = t0; e < (size_t)2 * 128 * 128; e += stride) { const int tb = (int)(e >> 14), k2 = (int)((e >> 7) & 127), n2 = (int)(e & 127), idx = (k2 * n2) & 127;
    float sv, cv; sincosf((float)idx * (6.283185307179586f / 128.f), &sv, &cv); p.CCS[e] = (tb ? sv : cv) * 0.08838834764831845f; }
}

DI void st_modulate(const Prm& p, int layer, int which, bf16_t* __restrict__ dst, int bid, int nb) {
  const int wave = ltid() >> 6, lane = ltid() & 63;
  const int shoff = which ? 3 * DM : 0, scoff = which ? 4 * DM : DM;
  for (int row = bid * 8 + wave; row < MR; row += nb * 8) {
    const int b = row / LT, t = row - b * LT; const bool isc = t >= LL;
    if (isc && layer == 1 && which == 1) continue;
    const float* src = (layer == 0 && which == 0) ? (isc ? p.ctx + (size_t)(b * LCX + t - LL) * DM : p.x + (size_t)(b * LL + t) * DM) : p.X + (size_t)row * DM;
    f32x4 v[8]; float ss = 0.f;
#pragma unroll
    for (int i = 0; i < 8; ++i) { v[i] = *(const f32x4*)(src + (i * 64 + lane) * 4); ss += v[i][0] * v[i][0] + v[i][1] * v[i][1] + v[i][2] * v[i][2] + v[i][3] * v[i][3]; }
    ss = wsum(ss); const float rstd = rsqrtf(ss * (1.f / 2048.f) + EPSV);
    const float* mr = p.mod + ((size_t)layer * 9 + (isc ? 8 : b)) * NMOD;
#pragma unroll
    for (int i = 0; i < 8; ++i) { const int col = (i * 64 + lane) * 4; const f32x4 sc = *(const f32x4*)(mr + scoff + col), sh = *(const f32x4*)(mr + shoff + col);
      const f32x4 o = v[i] * rstd * (sc + 1.f) + sh; u32x2 w; w.x = pack2(o[0], o[1]); w.y = pack2(o[2], o[3]); *(u32x2*)(dst + (size_t)row * DM + col) = w; }
  }
}

DI void st_dnprep(const Prm& p, int layer, int bid, int nb) {
  const int wave = ltid() >> 6, lane = ltid() & 63;
  const float* conv = p.dn_conv + (size_t)layer * 5 * 1536;
  for (int task = bid * 8 + wave; task < (MR / 32) * 13; task += nb * 8) {
    const int tile = task / 13, grp = task - tile * 13, row0 = tile * 32;
    const int b = row0 / LT, t0 = row0 - b * LT; const bool isc = t0 >= LL;
    const int segt0 = isc ? t0 - LL : t0, seglen = isc ? LCX : LL;
    if (grp < 12) {
      const int c = grp * 128 + lane * 2;
      float w0[5], w1[5];
#pragma unroll
      for (int j = 0; j < 5; ++j) { w0[j] = conv[j * 1536 + c]; w1[j] = conv[j * 1536 + c + 1]; }
      unsigned zz[36];
#pragma unroll
      for (int r = 0; r < 36; ++r) { const int tt = segt0 + r - 2; zz[r] = (tt >= 0 && tt < seglen) ? *(const unsigned*)(p.Z + (size_t)(row0 + r - 2) * NZ + c) : 0u; }
#pragma unroll
      for (int r = 0; r < 32; ++r) { float a0 = 0.f, a1 = 0.f;
#pragma unroll
        for (int j = 0; j < 5; ++j) { a0 += __uint_as_float(zz[r + j] << 16) * w0[j]; a1 += __uint_as_float(zz[r + j] & 0xffff0000u) * w1[j]; }
        a0 = siluf(a0); a1 = siluf(a1);
        if (grp < 8) { const float ss = wsum(a0 * a0 + a1 * a1); const float sc = rsqrtf(ss + EPSV) * (grp < 4 ? 0.08838834764831845f : 1.f); a0 *= sc; a1 *= sc; }
        *(unsigned*)(p.DNQ + (size_t)(row0 + r) * 1536 + c) = pack2(a0, a1); }
    } else {
#pragma unroll
      for (int rr = 0; rr < 8; ++rr) { const int idx = lane + 64 * rr, row = row0 + (idx >> 4), wh = idx & 15, isb = wh >> 3, dh = wh & 7;
        const float z = bf2f(p.Z[(size_t)row * NZ + (isb ? C_DNB : C_DNA) + dh]); float o;
        if (!isb) { const float xx = z + p.dn_dt_bias[layer * 8 + dh]; const float sp = xx > 20.f ? xx : log1pf(expf(xx)); o = -expf(p.dn_a_log[layer * 8 + dh]) * sp; }
        else o = sigmf(z);
        p.GB[(size_t)row * 16 + wh] = o; }
    }
  }
}

DI void st_mlaprep(const Prm& p, int layer, int bid, int nb) {
  const int wave = ltid() >> 6, lane = ltid() & 63;
  const float* qn = p.mla_q_norm + layer * 448; const float* kvn = p.mla_kv_norm + layer * 128;
  for (int row = bid * 8 + wave; row < MR; row += nb * 8) {
    const bf16_t* z = p.Z + (size_t)row * NZ; const int b = row / LT, t = row - b * LT;
    float v[8]; float ss = 0.f;
#pragma unroll
    for (int k = 0; k < 8; ++k) v[k] = 0.f;
    if (lane < 56) { const u32x4 w = *(const u32x4*)(z + C_CQ + lane * 8);
#pragma unroll
      for (int k = 0; k < 4; ++k) { v[2 * k] = __uint_as_float(w[k] << 16); v[2 * k + 1] = __uint_as_float(w[k] & 0xffff0000u); ss += v[2 * k] * v[2 * k] + v[2 * k + 1] * v[2 * k + 1]; } }
    ss = wsum(ss); float rstd = rsqrtf(ss * (1.f / 448.f) + EPSV);
    { u32x4 o = {0u, 0u, 0u, 0u};
      if (lane < 56) { const f32x4 n0 = *(const f32x4*)(qn + lane * 8), n1 = *(const f32x4*)(qn + lane * 8 + 4);
        o.x = pack2(v[0] * rstd * n0[0], v[1] * rstd * n0[1]); o.y = pack2(v[2] * rstd * n0[2], v[3] * rstd * n0[3]); o.z = pack2(v[4] * rstd * n1[0], v[5] * rstd * n1[1]); o.w = pack2(v[6] * rstd * n1[2], v[7] * rstd * n1[3]); }
      *(u32x4*)(p.Aq + (size_t)row * 512 + lane * 8) = o; }
    ss = 0.f;
    if (lane < 16) { const u32x4 w = *(const u32x4*)(z + C_CKV + lane * 8);
#pragma unroll
      for (int k = 0; k < 4; ++k) { v[2 * k] = __uint_as_float(w[k] << 16); v[2 * k + 1] = __uint_as_float(w[k] & 0xffff0000u); ss += v[2 * k] * v[2 * k] + v[2 * k + 1] * v[2 * k + 1]; } }
    ss = wsum(ss); rstd = rsqrtf(ss * (1.f / 128.f) + EPSV);
    if (lane < 32) { u32x4 o = {0u, 0u, 0u, 0u};
      if (lane < 16) { const f32x4 n0 = *(const f32x4*)(kvn + lane * 8), n1 = *(const f32x4*)(kvn + lane * 8 + 4);
        o.x = pack2(v[0] * rstd * n0[0], v[1] * rstd * n0[1]); o.y = pack2(v[2] * rstd * n0[2], v[3] * rstd * n0[3]); o.z = pack2(v[4] * rstd * n1[0], v[5] * rstd * n1[1]); o.w = pack2(v[6] * rstd * n1[2], v[7] * rstd * n1[3]); }
      *(u32x4*)(p.Akv + (size_t)row * 256 + lane * 8) = o; }
    if (t < LL) {
      if (lane < 32) { const int half = lane >> 4, i = lane & 15; const float x1 = bf2f(z[C_KR + half * 32 + i]), x2 = bf2f(z[C_KR + half * 32 + 16 + i]);
        const float pos = (float)(half ? (t & 63) : (t >> 6)); const float ang = pos * exp2f(-(float)i * (13.287712379549449f / 16.f)); float sv, cv; sincosf(ang, &sv, &cv);
        p.KR[(size_t)row * 64 + half * 32 + i] = f2bf(x1 * cv - x2 * sv); p.KR[(size_t)row * 64 + half * 32 + 16 + i] = f2bf(x2 * cv + x1 * sv); }
    } else p.KR[(size_t)row * 64 + lane] = z[C_KR + lane];
  }
}

DI void st_qrope(const Prm& p, int bid, int nb) {
  const int wave = ltid() >> 6, lane = ltid() & 63;
  for (int row = bid * 8 + wave; row < MR; row += nb * 8) {
    const int b = row / LT, t = row - b * LT; if (t >= LL) continue;
#pragma unroll
    for (int k = 0; k < 2; ++k) { const int pid = lane + 64 * k, h = pid >> 5, r = pid & 31, half = r >> 4, i = r & 15;
      bf16_t* q = p.Qraw + (size_t)row * 768 + h * 192 + 128 + half * 32; const float x1 = bf2f(q[i]), x2 = bf2f(q[16 + i]);
      const float pos = (float)(half ? (t & 63) : (t >> 6)); const float ang = pos * exp2f(-(float)i * (13.287712379549449f / 16.f)); float sv, cv; sincosf(ang, &sv, &cv);
      q[i] = f2bf(x1 * cv - x2 * sv); q[16 + i] = f2bf(x2 * cv + x1 * sv); }
  }
}

DI void st_fnchan(const Prm& p, unsigned char* lds, int bid, int nb) {
  bf16_t* wt = (bf16_t*)lds;
  bf16_t* zt = (bf16_t*)(lds + 256 * 272);
  const int tid = ltid(), wave = tid >> 6, lane = tid & 63, r32 = lane & 31, hi = lane >> 5;
  __syncthreads();
  for (int e = tid; e < 256 * 128; e += NTHR) wt[(e >> 7) * 136 + (e & 127)] = f2bf(p.CCS[e]);
  for (int it = bid; it < (MR / 64) * 4; it += nb) {
    const int tile = it >> 2, g = it & 3, b = tile / 68, tb2 = tile - b * 68; const bool lat = tb2 < 64;
    __syncthreads();
    for (int e = tid; e < 1024; e += NTHR) { const int r = e >> 4, c8 = (e & 15) * 8; const int row = b * LT + (lat ? 64 * r + tb2 : LL + (tb2 - 64) * 64 + r);
      *(u32x4*)(zt + r * 136 + c8) = *(const u32x4*)(p.Z + (size_t)row * NZ + C_FN + g * 128 + c8); }
    __syncthreads();
    f32x16 acc[2] = {};
#pragma unroll
    for (int k8 = 0; k8 < 8; ++k8) { const bf16x8 a = *(const bf16x8*)(wt + (wave * 32 + r32) * 136 + k8 * 16 + hi * 8);
#pragma unroll
      for (int tt = 0; tt < 2; ++tt) { const bf16x8 bb = *(const bf16x8*)(zt + (tt * 32 + r32) * 136 + k8 * 16 + hi * 8); acc[tt] = __builtin_amdgcn_mfma_f32_32x32x16_bf16(a, bb, acc[tt], 0, 0, 0); } }
    const int tb = wave >> 2;
#pragma unroll
    for (int tt = 0; tt < 2; ++tt)
#pragma unroll
      for (int r = 0; r < 16; ++r) { const int k2 = (wave & 3) * 32 + (r & 3) + 8 * (r >> 2) + 4 * hi;
        if (lat) p.PQT[(((size_t)(b * 512 + g * 128 + k2)) * 64 + tb2) * 128 + tb * 64 + tt * 32 + r32] = f2bf(acc[tt][r]);
        else p.PQTc[((size_t)(b * 512 + g * 128 + k2)) * 512 + tb * 256 + (tb2 - 64) * 64 + tt * 32 + r32] = f2bf(acc[tt][r]); }
  }
}

DI void st_fnfft(const Prm& p, unsigned char* lds, int bid, int nb) {
  bf16_t* M1 = (bf16_t*)lds;
  bf16_t* M2c = M1 + 128 * 136; bf16_t* M2s = M2c + 64 * 72;
  f32x2* TW = (f32x2*)(lds + (128 * 136 + 2 * 64 * 72) * 2);
  const int tid = ltid(), wave = tid >> 6, lane = tid & 63, r32 = lane & 31, hi = lane >> 5;
  __syncthreads();
  for (int e = tid; e < 128 * 128; e += NTHR) { const int j = e >> 7, k = e & 127, ri = j >> 6, cc = j & 63, pq = k >> 6, a = k & 63; float sv, cv; sincosf((float)((cc * a) & 63) * (6.283185307179586f / 64.f), &sv, &cv);
    const float v = ri == 0 ? (pq == 0 ? cv : -sv) : (pq == 0 ? -sv : -cv); M1[j * 136 + k] = f2bf(v * 0.125f); }
  for (int e = tid; e < 64 * 64; e += NTHR) { const int d = e >> 6, bp = e & 63; float sv, cv; sincosf((float)((d * bp) & 63) * (6.283185307179586f / 64.f), &sv, &cv); M2c[d * 72 + bp] = f2bf(cv * 0.125f); M2s[d * 72 + bp] = f2bf(sv * 0.125f); }
  for (int e = tid; e < 4096; e += NTHR) { float sv, cv; sincosf((float)e * (6.283185307179586f / 4096.f), &sv, &cv); TW[e] = (f32x2){cv, sv}; }
  __syncthreads();
  for (int item = bid * 8 + wave; item < NB * 512; item += nb * 8) {
    const int b = item >> 9, col = item & 511;
    const bf16_t* src = p.PQT + (size_t)item * 64 * 128;
    bf16_t* yo = p.Y + (size_t)b * LT * DM + 1536 + col;
#pragma unroll 1
    for (int ct = 0; ct < 2; ++ct) {
      f32x16 tr0 = {}, tr1 = {}, ti0 = {}, ti1 = {};
#pragma unroll
      for (int ks = 0; ks < 8; ++ks) { const bf16x8 a0 = *(const bf16x8*)(src + r32 * 128 + ks * 16 + hi * 8), a1 = *(const bf16x8*)(src + (32 + r32) * 128 + ks * 16 + hi * 8);
        const bf16x8 br = *(const bf16x8*)(M1 + (ct * 32 + r32) * 136 + ks * 16 + hi * 8), bi = *(const bf16x8*)(M1 + ((2 + ct) * 32 + r32) * 136 + ks * 16 + hi * 8);
        tr0 = __builtin_amdgcn_mfma_f32_32x32x16_bf16(a0, br, tr0, 0, 0, 0); tr1 = __builtin_amdgcn_mfma_f32_32x32x16_bf16(a1, br, tr1, 0, 0, 0);
        ti0 = __builtin_amdgcn_mfma_f32_32x32x16_bf16(a0, bi, ti0, 0, 0, 0); ti1 = __builtin_amdgcn_mfma_f32_32x32x16_bf16(a1, bi, ti1, 0, 0, 0); }
      __builtin_amdgcn_sched_barrier(0);
      const int cc = ct * 32 + r32;
#pragma unroll
      for (int r = 0; r < 16; ++r) { const int bl = (r & 3) + 8 * (r >> 2) + 4 * hi; const f32x2 w0 = TW[(cc * bl) & 4095], w1 = TW[(cc * (32 + bl)) & 4095];
        const float a = tr0[r], bq = ti0[r]; tr0[r] = a * w0[0] + bq * w0[1]; ti0[r] = bq * w0[0] - a * w0[1];
        const float c2 = tr1[r], d2 = ti1[r]; tr1[r] = c2 * w1[0] + d2 * w1[1]; ti1[r] = d2 * w1[0] - c2 * w1[1]; }
      __builtin_amdgcn_sched_barrier(0);
      f32x16 y0 = {}, y1 = {};
#define FFT_S2(XT, M2, BT) do { _Pragma("unroll") for (int s = 0; s < 2; ++s) { \
          u32x4 pk; pk.x = pack2(XT[8 * s], XT[8 * s + 1]); pk.y = pack2(XT[8 * s + 2], XT[8 * s + 3]); pk.z = pack2(XT[8 * s + 4], XT[8 * s + 5]); pk.w = pack2(XT[8 * s + 6], XT[8 * s + 7]); \
          const bf16x8 xs = __builtin_bit_cast(bf16x8, pk); \
          const bf16_t* ap0 = (M2) + r32 * 72 + (BT) * 32 + 16 * s + 4 * hi; const bf16_t* ap1 = ap0 + 32 * 72; \
          const s16x4 l0 = *(const s16x4*)ap0, h0 = *(const s16x4*)(ap0 + 8), l1 = *(const s16x4*)ap1, h1 = *(const s16x4*)(ap1 + 8); \
          y0 = __builtin_amdgcn_mfma_f32_32x32x16_bf16((bf16x8){l0[0], l0[1], l0[2], l0[3], h0[0], h0[1], h0[2], h0[3]}, xs, y0, 0, 0, 0); \
          y1 = __builtin_amdgcn_mfma_f32_32x32x16_bf16((bf16x8){l1[0], l1[1], l1[2], l1[3], h1[0], h1[1], h1[2], h1[3]}, xs, y1, 0, 0, 0); } } while (0)
      FFT_S2(tr0, M2c, 0); __builtin_amdgcn_sched_barrier(0); FFT_S2(tr1, M2c, 1); __builtin_amdgcn_sched_barrier(0); FFT_S2(ti0, M2s, 0); __builtin_amdgcn_sched_barrier(0); FFT_S2(ti1, M2s, 1); __builtin_amdgcn_sched_barrier(0);
#undef FFT_S2
#pragma unroll
      for (int r = 0; r < 16; ++r) { const int dl = (r & 3) + 8 * (r >> 2) + 4 * hi; yo[(size_t)(cc + 64 * dl) * DM] = f2bf(y0[r]); yo[(size_t)(cc + 64 * (32 + dl)) * DM] = f2bf(y1[r]); }
    }
  }
}

DI int scan_row(int b, int dir, int s) { return s < LCX ? b * LT + LL + (dir ? LCX - 1 - s : s) : b * LT + (dir ? LL - 1 - (s - LCX) : (s - LCX)); }

DI void st_dntinv(const Prm& p, unsigned char* lds, int bid, int nb) {
  const int tid = ltid(), wave = tid >> 6, lane = tid & 63, r32 = lane & 31, hi = lane >> 5;
  float* Ab = (float*)lds + wave * 4096;
  float* gcb = (float*)(lds + 131072) + wave * 128; float* btb = gcb + 64;
  for (int item = bid * 8 + wave; item < 64 * 68; item += nb * 8) {
    const int chain = item / 68, n = item - chain * 68, b = chain >> 3, h = (chain >> 1) & 3, dir = chain & 1;
    const int myrow = scan_row(b, dir, n * 64 + lane);
    const float g = p.GB[(size_t)myrow * 16 + dir * 4 + h], bt = p.GB[(size_t)myrow * 16 + 8 + dir * 4 + h];
    gcb[lane] = g; btb[lane] = bt;
    bf16x8 kf[2][8];
#pragma unroll
    for (int tt = 0; tt < 2; ++tt) { const int row = scan_row(b, dir, n * 64 + tt * 32 + r32);
#pragma unroll
      for (int ks = 0; ks < 8; ++ks) kf[tt][ks] = *(const bf16x8*)(p.DNQ + (size_t)row * 1536 + 512 + h * 128 + ks * 16 + hi * 8); }
    __builtin_amdgcn_wave_barrier();
    float gc = 0.f;
    for (int e = 0; e < 64; ++e) { const float ge = gcb[e]; gc += (e <= lane) ? ge : 0.f; }
    __builtin_amdgcn_wave_barrier();
    gcb[lane] = gc; p.GCB[(size_t)item * 64 + lane] = gc;
    __builtin_amdgcn_wave_barrier();
    f32x16 a00 = {}, a10 = {}, a11 = {};
#pragma unroll
    for (int ks = 0; ks < 8; ++ks) { a00 = __builtin_amdgcn_mfma_f32_32x32x16_bf16(kf[0][ks], kf[0][ks], a00, 0, 0, 0);
      a10 = __builtin_amdgcn_mfma_f32_32x32x16_bf16(kf[1][ks], kf[0][ks], a10, 0, 0, 0); a11 = __builtin_amdgcn_mfma_f32_32x32x16_bf16(kf[1][ks], kf[1][ks], a11, 0, 0, 0); }
    { const float gce0 = gcb[r32], gce1 = gcb[32 + r32];
#pragma unroll
      for (int r = 0; r < 16; ++r) { const int cl = (r & 3) + 8 * (r >> 2) + 4 * hi; const float gc0 = gcb[cl], bt0 = btb[cl], gc1 = gcb[32 + cl], bt1 = btb[32 + cl];
        Ab[cl * 64 + r32] = (r32 < cl) ? bt0 * a00[r] * __expf(gc0 - gce0) : 0.f;
        Ab[cl * 64 + 32 + r32] = 0.f;
        Ab[(32 + cl) * 64 + r32] = bt1 * a10[r] * __expf(gc1 - gce0);
        Ab[(32 + cl) * 64 + 32 + r32] = (r32 < cl) ? bt1 * a11[r] * __expf(gc1 - gce1) : 0.f; } }
    __builtin_amdgcn_wave_barrier();
    float x[64];
    bf16_t* to = p.TINV + (size_t)item * 4096 + lane;
#pragma unroll
    for (int c = 0; c < 64; ++c) { float s = (c == lane) ? 1.f : 0.f;
#pragma unroll
      for (int e4 = 0; e4 < (c + 3) / 4; ++e4) { const f32x4 av = *(const f32x4*)(Ab + c * 64 + e4 * 4);
#pragma unroll
        for (int i = 0; i < 4; ++i) if (e4 * 4 + i < c) s -= av[i] * x[e4 * 4 + i]; }
      x[c] = s; to[c * 64] = f2bf(s); }
    __builtin_amdgcn_wave_barrier();
  }
}

DI void st_dnscan(const Prm& p, unsigned char* lds, int bid, int nb) {
  constexpr int PK = 136, PB = 72;
  bf16_t* Qs = (bf16_t*)lds; bf16_t* Ks = Qs + 64 * PK; bf16_t* SB = Ks + 64 * PK; bf16_t* KDT = SB + 64 * PK; bf16_t* TI = KDT + 128 * PB; bf16_t* RT = TI + 64 * PB; bf16_t* VNT = RT + 64 * PB;
  bf16_t* PL = VNT + 64 * PB; bf16_t* Vs = PL + 64 * PB; float* gcs = (float*)(Vs + 64 * PB); float* bts = gcs + 64; float* egs = bts + 64;
  const int tid = ltid(), wave = tid >> 6, lane = tid & 63, r32 = lane & 31, hi = lane >> 5;
  for (int item = bid; item < 128; item += nb) {
    const int chain = item >> 1, half = item & 1, b = chain >> 3, h = (chain >> 1) & 3, dir = chain & 1;
    f32x16 accS = {};
    __syncthreads();
    for (int e = tid; e < 64 * PK; e += NTHR) SB[e] = 0;
    bf16x8 pf[6]; float pgc = 0.f, pbt = 0.f;
    auto gload = [&](int n) {
      const size_t ci = (size_t)chain * 68 + n;
#pragma unroll
      for (int r = 0; r < 6; ++r) { const int e = tid + NTHR * r;
        if (e < 2048) { const int ee = e & 1023, t = ee >> 4, c8 = ee & 15; const int row = scan_row(b, dir, n * 64 + t); pf[r] = *(const bf16x8*)(p.DNQ + (size_t)row * 1536 + (e < 1024 ? 0 : 512) + h * 128 + c8 * 8); }
        else if (e < 2560) { const int ee = e - 2048, t = ee >> 3, c8 = ee & 7; const int row = scan_row(b, dir, n * 64 + t); pf[r] = *(const bf16x8*)(p.DNQ + (size_t)row * 1536 + 1024 + h * 128 + half * 64 + c8 * 8); }
        else { const int ee = e - 2560; pf[r] = *(const bf16x8*)(p.TINV + ci * 4096 + ee * 8); } }
      if (tid < 64) { pgc = p.GCB[ci * 64 + tid]; const int row = scan_row(b, dir, n * 64 + tid); pbt = p.GB[(size_t)row * 16 + 8 + dir * 4 + h]; }
    };
    gload(0);
    for (int n = 0; n < LT / 64; ++n) {
      if (tid < 64) { gcs[tid] = pgc; bts[tid] = pbt; egs[tid] = __expf(pgc); }
      __syncthreads();
      const float gl = gcs[63];
#pragma unroll
      for (int r = 0; r < 6; ++r) { const int e = tid + NTHR * r;
        if (e < 1024) { const int t = e >> 4, c8 = e & 15; *(bf16x8*)(Qs + t * PK + c8 * 8) = pf[r]; }
        else if (e < 2048) { const int ee = e - 1024, t = ee >> 4, c8 = ee & 15; *(bf16x8*)(Ks + t * PK + c8 * 8) = pf[r]; const float sc = __expf(gl - gcs[t]);
#pragma unroll
          for (int j = 0; j < 8; ++j) KDT[(c8 * 8 + j) * PB + t] = f2bf(bf2f((bf16_t)pf[r][j]) * sc); }
        else if (e < 2560) { const int ee = e - 2048, t = ee >> 3, c8 = ee & 7; *(bf16x8*)(Vs + t * PB + c8 * 8) = pf[r]; }
        else { const int ee = e - 2560, c = ee >> 3, c8 = ee & 7; *(bf16x8*)(TI + c * PB + c8 * 8) = pf[r]; } }
      if (n + 1 < LT / 64) gload(n + 1);
      __syncthreads();
      f32x16 accO = {};
      if (wave < 4) { const int et = wave >> 1, jt = wave & 1; f32x16 a1 = {};
#pragma unroll
        for (int k8 = 0; k8 < 8; ++k8) { const bf16x8 av = *(const bf16x8*)(Ks + (et * 32 + r32) * PK + k8 * 16 + hi * 8), bv = *(const bf16x8*)(SB + (jt * 32 + r32) * PK + k8 * 16 + hi * 8);
          a1 = __builtin_amdgcn_mfma_f32_32x32x16_bf16(av, bv, a1, 0, 0, 0); }
        const int j = jt * 32 + r32;
#pragma unroll
        for (int g = 0; g < 4; ++g) { const int e0 = et * 32 + 8 * g + 4 * hi; float rv[4];
#pragma unroll
          for (int i = 0; i < 4; ++i) rv[i] = bts[e0 + i] * (bf2f(Vs[(e0 + i) * PB + j]) - egs[e0 + i] * a1[4 * g + i]);
          u32x2 w; w.x = pack2(rv[0], rv[1]); w.y = pack2(rv[2], rv[3]); *(u32x2*)(RT + j * PB + e0) = w; } }
      else {
        if (wave < 7) { const int et = wave == 6 ? 1 : 0, ct = wave == 4 ? 0 : 1; f32x16 a2 = {};
#pragma unroll
          for (int k8 = 0; k8 < 8; ++k8) { const bf16x8 av = *(const bf16x8*)(Ks + (et * 32 + r32) * PK + k8 * 16 + hi * 8), bv = *(const bf16x8*)(Qs + (ct * 32 + r32) * PK + k8 * 16 + hi * 8);
            a2 = __builtin_amdgcn_mfma_f32_32x32x16_bf16(av, bv, a2, 0, 0, 0); }
          const int c = ct * 32 + r32; const float gcc = gcs[c];
#pragma unroll
          for (int g = 0; g < 4; ++g) { const int e0 = et * 32 + 8 * g + 4 * hi; float pv[4];
#pragma unroll
            for (int i = 0; i < 4; ++i) pv[i] = (e0 + i <= c) ? a2[4 * g + i] * __expf(gcc - gcs[e0 + i]) : 0.f;
            u32x2 w; w.x = pack2(pv[0], pv[1]); w.y = pack2(pv[2], pv[3]); *(u32x2*)(PL + c * PB + e0) = w; } }
        else { for (int e = lane; e < 32 * 8; e += 64) { const int c = e >> 3, q4 = (e & 7) * 4; *(u32x2*)(PL + c * PB + 32 + q4) = (u32x2){0u, 0u}; } }
        { const int ct = (wave - 4) >> 1, jt = wave & 1;
#pragma unroll
          for (int k8 = 0; k8 < 8; ++k8) { const bf16x8 av = *(const bf16x8*)(Qs + (ct * 32 + r32) * PK + k8 * 16 + hi * 8), bv = *(const bf16x8*)(SB + (jt * 32 + r32) * PK + k8 * 16 + hi * 8);
            accO = __builtin_amdgcn_mfma_f32_32x32x16_bf16(av, bv, accO, 0, 0, 0); }
#pragma unroll
          for (int r = 0; r < 16; ++r) accO[r] *= egs[ct * 32 + (r & 3) + 8 * (r >> 2) + 4 * hi]; } }
      __syncthreads();
      if (wave < 4) { const int ct = wave >> 1, jt = wave & 1; f32x16 a3 = {};
#pragma unroll
        for (int k8 = 0; k8 < 4; ++k8) { const bf16x8 av = *(const bf16x8*)(TI + (ct * 32 + r32) * PB + k8 * 16 + hi * 8), bv = *(const bf16x8*)(RT + (jt * 32 + r32) * PB + k8 * 16 + hi * 8);
          a3 = __builtin_amdgcn_mfma_f32_32x32x16_bf16(av, bv, a3, 0, 0, 0); }
#pragma unroll
        for (int g = 0; g < 4; ++g) { u32x2 w; w.x = pack2(a3[4 * g], a3[4 * g + 1]); w.y = pack2(a3[4 * g + 2], a3[4 * g + 3]); *(u32x2*)(VNT + (jt * 32 + r32) * PB + ct * 32 + 8 * g + 4 * hi) = w; } }
      __syncthreads();
      if (wave >= 4) { const int ct = (wave - 4) >> 1, jt = wave & 1;
#pragma unroll
        for (int k8 = 0; k8 < 4; ++k8) { const bf16x8 av = *(const bf16x8*)(PL + (ct * 32 + r32) * PB + k8 * 16 + hi * 8), bv = *(const bf16x8*)(VNT + (jt * 32 + r32) * PB + k8 * 16 + hi * 8);
          accO = __builtin_amdgcn_mfma_f32_32x32x16_bf16(av, bv, accO, 0, 0, 0); }
#pragma unroll
        for (int r = 0; r < 16; ++r) { const int c = ct * 32 + (r & 3) + 8 * (r >> 2) + 4 * hi; const int row = scan_row(b, dir, n * 64 + c);
          p.OB[((size_t)(0 * 2 + dir) * MR + row) * 512 + h * 128 + half * 64 + jt * 32 + r32] = f2bf(accO[r]); } }
      { const int dt = wave >> 1, jt = wave & 1; const float egl = __expf(gl);
#pragma unroll
        for (int r = 0; r < 16; ++r) accS[r] *= egl;
#pragma unroll
        for (int k8 = 0; k8 < 4; ++k8) { const bf16x8 av = *(const bf16x8*)(KDT + (dt * 32 + r32) * PB + k8 * 16 + hi * 8), bv = *(const bf16x8*)(VNT + (jt * 32 + r32) * PB + k8 * 16 + hi * 8);
          accS = __builtin_amdgcn_mfma_f32_32x32x16_bf16(av, bv, accS, 0, 0, 0); }
#pragma unroll
        for (int g = 0; g < 4; ++g) { u32x2 w; w.x = pack2(accS[4 * g], accS[4 * g + 1]); w.y = pack2(accS[4 * g + 2], accS[4 * g + 3]);
          *(u32x2*)(SB + (jt * 32 + r32) * PK + dt * 32 + 8 * g + 4 * hi) = w; } }
      __syncthreads();
    }
  }
}

DI void st_glabc(const Prm& p, int layer, unsigned char* lds, int bid, int nb) {
  float* AL = (float*)lds; float* SEG = AL + 1024;
  const int tid = ltid(), seg = tid >> 6, dme = tid & 63;
  for (int item = bid; item < 64 * 68; item += nb) {
    const int chain = item / 68, n = item - chain * 68, b = chain >> 3, h = (chain >> 1) & 3, dir = chain & 1;
    const float* w2 = p.gla_w2 + (size_t)(layer * 2 + dir) * 16 * 256 + h * 64; const float b2r = p.gla_b2[(layer * 2 + dir) * 256 + h * 64 + dme];
    float w2r[16];
#pragma unroll
    for (int r = 0; r < 16; ++r) w2r[r] = w2[r * 256 + dme];
    __syncthreads();
    if (tid < 128) { const int t = tid >> 1, c8 = tid & 1; const int row = scan_row(b, dir, n * 64 + t); const bf16x8 v = *(const bf16x8*)(p.Z + (size_t)row * NZ + C_GALPHA + dir * 16 + c8 * 8);
#pragma unroll
      for (int j = 0; j < 8; ++j) AL[t * 16 + c8 * 8 + j] = bf2f((bf16_t)v[j]); }
    __syncthreads();
    float la[8]; float run = 0.f;
#pragma unroll
    for (int k = 0; k < 8; ++k) { const int t = seg * 8 + k; float zz = b2r;
#pragma unroll
      for (int r = 0; r < 16; ++r) zz += AL[t * 16 + r] * w2r[r];
      const float nz = -zz; const float sp = nz > 20.f ? nz : log1pf(expf(nz)); run += -sp * (1.f / 16.f); la[k] = run; }
    SEG[seg * 64 + dme] = run;
    __syncthreads();
    float pre = 0.f;
#pragma unroll
    for (int s2 = 0; s2 < 8; ++s2) pre += (s2 < seg) ? SEG[s2 * 64 + dme] : 0.f;
#pragma unroll
    for (int k = 0; k < 8; ++k) p.BC[(size_t)item * 4096 + (seg * 8 + k) * 64 + dme] = la[k] + pre;
  }
}

DI void st_glascan(const Prm& p, int layer, unsigned char* lds, int bid, int nb) {
  constexpr int PB = 72;
  bf16_t* QI = (bf16_t*)lds; bf16_t* QR = QI + 64 * PB; bf16_t* KR = QR + 64 * PB; bf16_t* KRT = KR + 64 * PB; bf16_t* VT = KRT + 64 * PB; bf16_t* SB = VT + 64 * PB; bf16_t* PL = SB + 64 * PB;
  float* LA = (float*)(lds + 7 * 64 * PB * 2);
  float* AL = LA + 4096;
  float* SEG = AL + 1024;
  float* EBL = SEG + 512;
  const int tid = ltid(), wave = tid >> 6, lane = tid & 63, r32 = lane & 31, hi = lane >> 5;
  for (int item = bid; item < 128; item += nb) {
    const int chain = item >> 1, half = item & 1, b = chain >> 3, h = (chain >> 1) & 3, dir = chain & 1;
    f32x16 acc = {};
    __syncthreads();
    for (int e = tid; e < 64 * PB; e += NTHR) SB[e] = 0;
    bf16x8 pf[3]; f32x4 pb[2];
    auto gload = [&](int n) {
#pragma unroll
      for (int r = 0; r < 3; ++r) { const int e = tid + NTHR * r; const int t = e / 24, ch = e - t * 24; const int row = scan_row(b, dir, n * 64 + t);
        const int col = ch < 8 ? C_GQ + h * 64 + ch * 8 : (ch < 16 ? C_GK + h * 64 + (ch - 8) * 8 : C_GV + h * 128 + half * 64 + (ch - 16) * 8);
        pf[r] = *(const bf16x8*)(p.Z + (size_t)row * NZ + col); }
#pragma unroll
      for (int r = 0; r < 2; ++r) pb[r] = *(const f32x4*)(p.BC + ((size_t)chain * 68 + n) * 4096 + (tid + NTHR * r) * 4);
    };
    gload(0);
    for (int n = 0; n < LT / 64; ++n) {
#pragma unroll
      for (int r = 0; r < 2; ++r) *(f32x4*)(LA + (tid + NTHR * r) * 4) = pb[r];
      __syncthreads();
      if (tid < 64) EBL[tid] = __expf(LA[63 * 64 + tid]);
#pragma unroll
      for (int r = 0; r < 3; ++r) { const int e = tid + NTHR * r; const int t = e / 24, ch = e - t * 24;
          if (ch < 8) { u32x4 wi, wr; float xi[8], xr[8];
#pragma unroll
            for (int j = 0; j < 8; ++j) { const int d = ch * 8 + j; const float bc = LA[t * 64 + d], bl = LA[63 * 64 + d], q = bf2f((bf16_t)pf[r][j]) * 0.125f; xi[j] = q * __expf(bc); xr[j] = q * __expf(bc - bl); }
            wi.x = pack2(xi[0], xi[1]); wi.y = pack2(xi[2], xi[3]); wi.z = pack2(xi[4], xi[5]); wi.w = pack2(xi[6], xi[7]);
            wr.x = pack2(xr[0], xr[1]); wr.y = pack2(xr[2], xr[3]); wr.z = pack2(xr[4], xr[5]); wr.w = pack2(xr[6], xr[7]);
            *(u32x4*)(QI + t * PB + ch * 8) = wi; *(u32x4*)(QR + t * PB + ch * 8) = wr; }
          else if (ch < 16) { u32x4 wk; float xk[8];
#pragma unroll
            for (int j = 0; j < 8; ++j) { const int d = (ch - 8) * 8 + j; xk[j] = bf2f((bf16_t)pf[r][j]) * __expf(LA[63 * 64 + d] - LA[t * 64 + d]); KRT[d * PB + t] = f2bf(xk[j]); }
            wk.x = pack2(xk[0], xk[1]); wk.y = pack2(xk[2], xk[3]); wk.z = pack2(xk[4], xk[5]); wk.w = pack2(xk[6], xk[7]);
            *(u32x4*)(KR + t * PB + (ch - 8) * 8) = wk; }
          else {
#pragma unroll
            for (int j = 0; j < 8; ++j) VT[((ch - 16) * 8 + j) * PB + t] = (bf16_t)pf[r][j]; } }
      if (n + 1 < LT / 64) gload(n + 1);
      __syncthreads();
      if (wave < 3) { const int et = wave == 2 ? 1 : 0, ct = wave == 0 ? 0 : 1; f32x16 a2 = {};
#pragma unroll
        for (int k8 = 0; k8 < 4; ++k8) { const bf16x8 av = *(const bf16x8*)(KR + (et * 32 + r32) * PB + k8 * 16 + hi * 8), bv = *(const bf16x8*)(QR + (ct * 32 + r32) * PB + k8 * 16 + hi * 8);
          a2 = __builtin_amdgcn_mfma_f32_32x32x16_bf16(av, bv, a2, 0, 0, 0); }
        const int c = ct * 32 + r32;
#pragma unroll
        for (int g = 0; g < 4; ++g) { const int e0 = et * 32 + 8 * g + 4 * hi; u32x2 w;
          w.x = pack2(e0 <= c ? a2[4 * g] : 0.f, e0 + 1 <= c ? a2[4 * g + 1] : 0.f); w.y = pack2(e0 + 2 <= c ? a2[4 * g + 2] : 0.f, e0 + 3 <= c ? a2[4 * g + 3] : 0.f);
          *(u32x2*)(PL + c * PB + e0) = w; } }
      else if (wave == 3) { for (int e = lane; e < 32 * 8; e += 64) { const int c = e >> 3, q4 = (e & 7) * 4; *(u32x2*)(PL + c * PB + 32 + q4) = (u32x2){0u, 0u}; } }
      else { const int ct = (wave - 4) >> 1, jt = wave & 1; acc = f32x16{};
#pragma unroll
        for (int k8 = 0; k8 < 4; ++k8) { const bf16x8 av = *(const bf16x8*)(QI + (ct * 32 + r32) * PB + k8 * 16 + hi * 8), bv = *(const bf16x8*)(SB + (jt * 32 + r32) * PB + k8 * 16 + hi * 8);
          acc = __builtin_amdgcn_mfma_f32_32x32x16_bf16(av, bv, acc, 0, 0, 0); } }
      __syncthreads();
      if (wave >= 4) { const int ct = (wave - 4) >> 1, jt = wave & 1;
#pragma unroll
        for (int k8 = 0; k8 < 4; ++k8) { const bf16x8 av = *(const bf16x8*)(PL + (ct * 32 + r32) * PB + k8 * 16 + hi * 8), bv = *(const bf16x8*)(VT + (jt * 32 + r32) * PB + k8 * 16 + hi * 8);
          acc = __builtin_amdgcn_mfma_f32_32x32x16_bf16(av, bv, acc, 0, 0, 0); }
#pragma unroll
        for (int r = 0; r < 16; ++r) { const int c = ct * 32 + (r & 3) + 8 * (r >> 2) + 4 * hi; const int row = scan_row(b, dir, n * 64 + c);
          p.OB[((size_t)(1 * 2 + dir) * MR + row) * 512 + h * 128 + half * 64 + jt * 32 + r32] = f2bf(acc[r]); } }
      else { const int dt = wave >> 1, jt = wave & 1;
#pragma unroll
        for (int r = 0; r < 16; ++r) acc[r] *= EBL[dt * 32 + (r & 3) + 8 * (r >> 2) + 4 * hi];
#pragma unroll
        for (int k8 = 0; k8 < 4; ++k8) { const bf16x8 av = *(const bf16x8*)(KRT + (dt * 32 + r32) * PB + k8 * 16 + hi * 8), bv = *(const bf16x8*)(VT + (jt * 32 + r32) * PB + k8 * 16 + hi * 8);
          acc = __builtin_amdgcn_mfma_f32_32x32x16_bf16(av, bv, acc, 0, 0, 0); }
#pragma unroll
        for (int g = 0; g < 4; ++g) { u32x2 w; w.x = pack2(acc[4 * g], acc[4 * g + 1]); w.y = pack2(acc[4 * g + 2], acc[4 * g + 3]);
          *(u32x2*)(SB + (jt * 32 + r32) * PB + dt * 32 + 8 * g + 4 * hi) = w; } }
      __syncthreads();
    }
  }
}

DI void st_combine(const Prm& p, int layer, int bid, int nb) {
  const int wave = ltid() >> 6, lane = ltid() & 63;
  for (long task = (long)bid * 8 + wave; task < (long)MR * 8; task += (long)nb * 8) {
    const int row = (int)(task >> 3), mh = (int)(task & 7), mixer = mh >> 2, h = mh & 3;
    const unsigned f = *(const unsigned*)(p.OB + ((size_t)(mixer * 2 + 0) * MR + row) * 512 + h * 128 + lane * 2), g = *(const unsigned*)(p.OB + ((size_t)(mixer * 2 + 1) * MR + row) * 512 + h * 128 + lane * 2);
    const float o0 = bf2f((bf16_t)(f & 0xffffu)) + bf2f((bf16_t)(g & 0xffffu)), o1 = bf2f((bf16_t)(f >> 16)) + bf2f((bf16_t)(g >> 16));
    const float ss = wsum(o0 * o0 + o1 * o1), rstd = rsqrtf(ss * (1.f / 128.f) + EPSV);
    const float* w = (mixer ? p.gla_norm : p.dn_norm) + layer * 128 + lane * 2;
    const unsigned gz = *(const unsigned*)(p.Z + (size_t)row * NZ + (mixer ? C_GGATE : C_DNGATE) + h * 128 + lane * 2);
    const float g0 = bf2f((bf16_t)(gz & 0xffffu)), g1 = bf2f((bf16_t)(gz >> 16));
    *(unsigned*)(p.Y + (size_t)row * DM + mixer * 512 + h * 128 + lane * 2) = pack2(o0 * rstd * w[0] * siluf(g0), o1 * rstd * w[1] * siluf(g1));
  }
}

DI unsigned fkey(float f) { const unsigned u = __float_as_uint(f); return u ^ ((u >> 31) ? 0xffffffffu : 0x80000000u); }
DI int pcnt(unsigned long long m) { return __builtin_popcountll(m); }
DI int lanes_below(unsigned long long m) { return (int)__builtin_amdgcn_mbcnt_hi((unsigned)(m >> 32), __builtin_amdgcn_mbcnt_lo((unsigned)m, 0u)); }
DI void st_peertopk(const Prm& p, int layer, unsigned char* lds, int bid, int nb) {
  bf16_t* ks = (bf16_t*)lds;
  bf16_t* qt = (bf16_t*)(lds + 69632);
  float* sc = (float*)(lds + 69632);
  const int tid = ltid(), wave = tid >> 6, lane = tid & 63, r32 = lane & 31, hi = lane >> 5;
  float* selv = (float*)(lds + 69632 + 33280) + wave * 64; int* seli = (int*)(selv + 32);
  int hcur = -1;
  const int nchunk = MR / 32;
  for (int it = bid; it < 8 * nchunk; it += nb) {
    const int h = it / nchunk, chunk = it - h * nchunk, row0 = chunk * 32;
    if (layer == 1 && (row0 % LT) >= LL) continue;
    __syncthreads();
    if (h != hcur) {
      const float* kg = p.peer_keys + ((size_t)(layer * 8 + h) * 2) * 128 * 128;
      for (int e = tid; e < 2 * 128 * 128; e += NTHR) { const int pn = e >> 7, k = e & 127; ks[pn * 136 + k] = f2bf(kg[e]); }
      hcur = h; }
    for (int e = tid; e < 1024; e += NTHR) { const int r = e >> 5, c8 = (e & 31) * 8; *(u32x4*)(qt + r * 264 + c8) = *(const u32x4*)(p.Qp + (size_t)(row0 + r) * DM + h * 256 + c8); }
    __syncthreads();
    { const int pt = wave >> 2, nt = wave & 3; f32x16 acc = {};
#pragma unroll
      for (int k8 = 0; k8 < 8; ++k8) { const bf16x8 a = *(const bf16x8*)(qt + r32 * 264 + pt * 128 + k8 * 16 + hi * 8), b = *(const bf16x8*)(ks + (pt * 128 + nt * 32 + r32) * 136 + k8 * 16 + hi * 8);
        acc = __builtin_amdgcn_mfma_f32_32x32x16_bf16(a, b, acc, 0, 0, 0); }
      __syncthreads();
#pragma unroll
      for (int r = 0; r < 16; ++r) sc[((r & 3) + 8 * (r >> 2) + 4 * hi) * 260 + pt * 128 + nt * 32 + r32] = acc[r]; }
    __syncthreads();
    for (int rr = 0; rr < 4; ++rr) {
      const int m = wave * 4 + rr, row = row0 + m;
      float s[2][2];
#pragma unroll
      for (int pp = 0; pp < 2; ++pp)
#pragma unroll
        for (int hh = 0; hh < 2; ++hh) s[pp][hh] = sc[m * 260 + pp * 128 + hh * 64 + lane];
      unsigned kk[2][2], T[2] = {0u, 0u};
#pragma unroll
      for (int pp = 0; pp < 2; ++pp) { kk[pp][0] = fkey(s[pp][0]); kk[pp][1] = fkey(s[pp][1]); }
      { unsigned ta = 0u, tb = 0u, da = 0u, db = 0u;
        for (int bit = 31; bit >= 0; --bit) { const unsigned m = 1u << bit;
          const unsigned ca = ta | m, cb = tb | m;
          const unsigned na = (unsigned)(pcnt(__ballot(kk[0][0] >= ca)) + pcnt(__ballot(kk[0][1] >= ca))), nb2 = (unsigned)(pcnt(__ballot(kk[1][0] >= cb)) + pcnt(__ballot(kk[1][1] >= cb)));
          const unsigned oa = (na >= 16u ? 1u : 0u) & ~da, ob = (nb2 >= 16u ? 1u : 0u) & ~db;
          ta |= (0u - oa) & m; tb |= (0u - ob) & m; da |= oa & (na == 16u ? 1u : 0u); db |= ob & (nb2 == 16u ? 1u : 0u);
          if (da & db) break; }
        T[0] = __builtin_amdgcn_readfirstlane(ta); T[1] = __builtin_amdgcn_readfirstlane(tb); }
#pragma unroll
      for (int pp = 0; pp < 2; ++pp) { const unsigned k0 = kk[pp][0], k1 = kk[pp][1], TT = T[pp];
        const unsigned long long g0 = __ballot(k0 > TT), g1 = __ballot(k1 > TT), e0 = __ballot(k0 == TT), e1 = __ballot(k1 == TT);
        const int ng0 = pcnt(g0), ng = ng0 + pcnt(g1), need = 16 - ng, ne0 = pcnt(e0);
        if (k0 > TT) { const int r = lanes_below(g0); selv[pp * 16 + r] = s[pp][0]; seli[pp * 16 + r] = lane; }
        if (k1 > TT) { const int r = ng0 + lanes_below(g1); selv[pp * 16 + r] = s[pp][1]; seli[pp * 16 + r] = lane + 64; }
        if (k0 == TT) { const int r = lanes_below(e0); if (r < need) { selv[pp * 16 + ng + r] = s[pp][0]; seli[pp * 16 + ng + r] = lane; } }
        if (k1 == TT) { const int r = ne0 + lanes_below(e1); if (r < need) { selv[pp * 16 + ng + r] = s[pp][1]; seli[pp * 16 + ng + r] = lane + 64; } } }
      __builtin_amdgcn_wave_barrier();
      float cd[4]; unsigned ck[4]; { const float sa = selv[lane >> 2]; const f32x4 sb = *(const f32x4*)(selv + 16 + (lane & 3) * 4);
#pragma unroll
        for (int q = 0; q < 4; ++q) { cd[q] = sa + sb[q]; ck[q] = fkey(cd[q]); } }
      unsigned T2 = 0u;
      for (int bit = 31; bit >= 0; --bit) { const unsigned m = 1u << bit, c = T2 | m;
        const unsigned n = (unsigned)(pcnt(__ballot(ck[0] >= c)) + pcnt(__ballot(ck[1] >= c)) + pcnt(__ballot(ck[2] >= c)) + pcnt(__ballot(ck[3] >= c)));
        T2 |= (0u - (n >= 16u ? 1u : 0u)) & m; if (n == 16u) break; }
      T2 = __builtin_amdgcn_readfirstlane(T2);
      float mx = fmaxf(fmaxf(cd[0], cd[1]), fmaxf(cd[2], cd[3])); mx = wmax(mx);
      int base = 0; float esum = 0.f; const int ia = seli[lane >> 2]; int rk[4]; float ev[4];
#pragma unroll
      for (int q = 0; q < 4; ++q) { const unsigned long long g = __ballot(ck[q] > T2); rk[q] = ck[q] > T2 ? base + lanes_below(g) : 99; base += pcnt(g); }
#pragma unroll
      for (int q = 0; q < 4; ++q) { const unsigned long long g = __ballot(ck[q] == T2); if (ck[q] == T2) rk[q] = base + lanes_below(g); base += pcnt(g); }
#pragma unroll
      for (int q = 0; q < 4; ++q) { ev[q] = rk[q] < 16 ? __expf(cd[q] - mx) : 0.f; esum += ev[q]; }
      esum = wsum(esum); const float inv = 1.f / esum;
      int* orow = p.IDX + (size_t)row * 128 + h * 16; float* grow = p.GATE + (size_t)row * 128 + h * 16;
#pragma unroll
      for (int q = 0; q < 4; ++q) if (rk[q] < 16) { orow[rk[q]] = ia * 128 + seli[16 + (lane & 3) * 4 + q]; grow[rk[q]] = ev[q] * inv; }
      __builtin_amdgcn_wave_barrier();
    }
  }
}

typedef float v16f_t __attribute__((ext_vector_type(16)));
typedef float v32f_t __attribute__((ext_vector_type(32)));
typedef unsigned v6u_t __attribute__((ext_vector_type(6)));
constexpr int TROW = 1600;
DI void st_cvt_tables(const Prm& p, int layer, int bid, int nb) {
  const size_t nblk = (size_t)16384 * 64, stride = (size_t)nb * NTHR;
  const float* U = p.peer_u + (size_t)layer * 16384 * DM; const float* V = p.peer_v + (size_t)layer * 16384 * DM;
  for (size_t e = (size_t)bid * NTHR + ltid(); e < 2 * nblk; e += stride) { const bool isv = e >= nblk; const size_t k = isv ? e - nblk : e; const size_t row = k >> 6; const int l = (int)(k & 63);
    const float* src = (isv ? V : U) + row * DM + l * 32; v16f_t x, y; float amax = 0.f;
#pragma unroll
    for (int q = 0; q < 4; ++q) { const f32x4 a = *(const f32x4*)(src + q * 8), b = *(const f32x4*)(src + q * 8 + 4);
      x[q * 4] = a[0]; y[q * 4] = a[1]; x[q * 4 + 1] = a[2]; y[q * 4 + 1] = a[3]; x[q * 4 + 2] = b[0]; y[q * 4 + 2] = b[1]; x[q * 4 + 3] = b[2]; y[q * 4 + 3] = b[3];
#pragma unroll
      for (int i = 0; i < 4; ++i) amax = fmaxf(amax, fmaxf(fabsf(a[i]), fabsf(b[i]))); }
    int ex = (int)((__float_as_uint(amax * (1.f / 7.5f)) >> 23) & 0xffu) - 127 + 1; ex = ex < -126 ? -126 : ex;
    const float inv = __uint_as_float((unsigned)(127 - ex) << 23);
    x *= inv; y *= inv;
    const v6u_t r = __builtin_amdgcn_cvt_scalef32_2xpk16_fp6_f32(x, y, 1.0f);
    unsigned char* dst = (unsigned char*)(isv ? p.Vb : p.Ub) + row * TROW;
    dst[l] = (unsigned char)(ex + 127);
    *(u32x4*)(dst + 64 + l * 16) = (u32x4){r[0], r[1], r[2], r[3]}; *(u32x2*)(dst + 64 + 1024 + l * 8) = (u32x2){r[4], r[5]}; }
}

DI void st_peergather(const Prm& p, int layer, float* lds, int bid, int nb, bool dry = false) {
  const int tid = ltid(), wave = tid >> 6, lane = tid & 63;
  const unsigned char* Ub = (const unsigned char*)p.Ub; const unsigned char* Vb = (const unsigned char*)p.Vb;
  for (int row = bid; row < MR; row += nb) {
    const int b = row / LT, t = row - b * LT; const bool isc = t >= LL;
    if (isc && layer == 1) continue;
    f32x2 hv[16];
#pragma unroll
    for (int q = 0; q < 4; ++q) { const u32x4 w = *(const u32x4*)(p.H2 + (size_t)row * DM + lane * 32 + q * 8);
#pragma unroll
      for (int k = 0; k < 4; ++k) hv[q * 4 + k] = (f32x2){__uint_as_float(w[k] << 16), __uint_as_float(w[k] & 0xffff0000u)}; }
    f32x2 acc[16];
#pragma unroll
    for (int i = 0; i < 16; ++i) acc[i] = (f32x2){0.f, 0.f};
    const int myidx = lane < 16 ? p.IDX[(size_t)row * 128 + wave * 16 + lane] : 0; const float mygate = lane < 16 ? p.GATE[(size_t)row * 128 + wave * 16 + lane] : 0.f;
#pragma unroll 1
    for (int k0 = 0; k0 < 16; k0 += 4) {
      u32x4 ua[4], va[4]; u32x2 ub[4], vb[4]; unsigned us[4], vs[4];
#pragma unroll
      for (int q = 0; q < 4; ++q) { const int e = __builtin_amdgcn_readfirstlane(__shfl(myidx, k0 + q));
        const unsigned char* ur = Ub + (size_t)e * TROW; const unsigned char* vr = Vb + (size_t)e * TROW;
        ua[q] = *(const u32x4*)(ur + 64 + lane * 16); ub[q] = *(const u32x2*)(ur + 64 + 1024 + lane * 8); us[q] = ur[lane];
        va[q] = *(const u32x4*)(vr + 64 + lane * 16); vb[q] = *(const u32x2*)(vr + 64 + 1024 + lane * 8); vs[q] = vr[lane]; }
#pragma unroll
      for (int q = 0; q < 4; ++q) {
        const v32f_t du = __builtin_amdgcn_cvt_scalef32_pk32_f32_fp6((v6u_t){ua[q][0], ua[q][1], ua[q][2], ua[q][3], ub[q][0], ub[q][1]}, 1.0f);
        f32x2 d0 = (f32x2){0.f, 0.f}, d1 = (f32x2){0.f, 0.f};
#pragma unroll
        for (int i = 0; i < 16; i += 2) { d0 += (f32x2){du[2 * i], du[2 * i + 1]} * hv[i]; d1 += (f32x2){du[2 * i + 2], du[2 * i + 3]} * hv[i + 1]; }
        d0 += d1; const float d = wsum((d0[0] + d0[1]) * __uint_as_float(us[q] << 23));
        const float wgt = __shfl(mygate, k0 + q) * 0.5f * d * (1.f + erff(d * 0.70710678118654752f)) * __uint_as_float(vs[q] << 23); const f32x2 w2 = (f32x2){wgt, wgt};
        const v32f_t dv = __builtin_amdgcn_cvt_scalef32_pk32_f32_fp6((v6u_t){va[q][0], va[q][1], va[q][2], va[q][3], vb[q][0], vb[q][1]}, 1.0f);
#pragma unroll
        for (int i = 0; i < 16; ++i) acc[i] += w2 * (f32x2){dv[2 * i], dv[2 * i + 1]}; }
    }
    __syncthreads();
#pragma unroll
    for (int k = 0; k < 8; ++k) *(f32x4*)(lds + wave * 2048 + lane * 32 + k * 4) = (f32x4){acc[2 * k][0], acc[2 * k][1], acc[2 * k + 1][0], acc[2 * k + 1][1]};
    __syncthreads();
    { const int col = tid * 4; f32x4 sum = (f32x4){0.f, 0.f, 0.f, 0.f};
#pragma unroll
      for (int w = 0; w < 8; ++w) sum += *(const f32x4*)(lds + w * 2048 + col);
      const f32x4 g2 = *(const f32x4*)(p.mod + ((size_t)layer * 9 + (isc ? 8 : b)) * NMOD + 5 * DM + col);
      float* xr = p.X + (size_t)row * DM + col; const f32x4 xn = *(const f32x4*)xr + g2 * sum;
      if (!dry) {
        float ss = wsum(xn[0] * xn[0] + xn[1] * xn[1] + xn[2] * xn[2] + xn[3] * xn[3]);
        if (lane == 0) lds[16384 + wave] = ss;
        __syncthreads();
        ss = 0.f;
#pragma unroll
        for (int w = 0; w < 8; ++w) ss += lds[16384 + w];
        const float rstd = rsqrtf(ss * (1.f / 2048.f) + EPSV);
        if (layer == 0) { *(f32x4*)xr = xn;
          const float* mr = p.mod + ((size_t)9 + (isc ? 8 : b)) * NMOD; const f32x4 sc = *(const f32x4*)(mr + DM + col), sh = *(const f32x4*)(mr + col);
          const f32x4 o = xn * rstd * (sc + 1.f) + sh; u32x2 w; w.x = pack2(o[0], o[1]); w.y = pack2(o[2], o[3]); *(u32x2*)(p.H + (size_t)row * DM + col) = w; }
        else *(f32x4*)(p.out + ((size_t)b * LL + t) * DM + col) = xn * rstd * *(const f32x4*)(p.final_norm + col);
      } }
  }
}

DI void st_final(const Prm& p, int bid, int nb) {
  const int wave = ltid() >> 6, lane = ltid() & 63;
  for (int r = bid * 8 + wave; r < NB * LL; r += nb * 8) {
    const int b = r / LL, t = r - b * LL; const float* src = p.X + (size_t)(b * LT + t) * DM;
    f32x4 v[8]; float ss = 0.f;
#pragma unroll
    for (int i = 0; i < 8; ++i) { v[i] = *(const f32x4*)(src + (i * 64 + lane) * 4); ss += v[i][0] * v[i][0] + v[i][1] * v[i][1] + v[i][2] * v[i][2] + v[i][3] * v[i][3]; }
    ss = wsum(ss); const float rstd = rsqrtf(ss * (1.f / 2048.f) + EPSV);
#pragma unroll
    for (int i = 0; i < 8; ++i) { const int col = (i * 64 + lane) * 4; *(f32x4*)(p.out + (size_t)r * DM + col) = v[i] * rstd * *(const f32x4*)(p.final_norm + col); }
  }
}

namespace att {
constexpr int NW = 8, QBLK = 32, KVBLK = 64;
constexpr float SCALE = 0.07216878364870322f;
constexpr float THR = 8.f;
constexpr int LDQ = 768, LDK = 1024, LDKR = 64, LDO = DM;
constexpr int SHM_V = KVBLK * 128 * 2, SHM_K = KVBLK * 128 * 2, SHM_KR = KVBLK * 64 * 2, SHM_ATTN = 2 * SHM_V + 2 * SHM_K + 2 * SHM_KR + NW * 64 * 4;
#define KSWZ(row, colB) ((row) * 256 + ((colB) ^ (((row) & 7) << 4)))
#define KRSWZ(row, colB) ((row) * 128 + ((colB) ^ ((((row) >> 1) & 7) << 4)))
#define SBAR() __builtin_amdgcn_sched_barrier(0)
DI int crow(int r, int hi) { return (r & 3) + 8 * (r >> 2) + 4 * hi; }
DI unsigned cvtpk(float lo, float hi) { unsigned r; asm volatile("v_cvt_pk_bf16_f32 %0, %1, %2" : "=v"(r) : "v"(lo), "v"(hi)); return r; }

DI void partialSM(f32x16& p0, f32x16& p1, float& m_reg, float& mn, float& alpha) {
  constexpr float C = SCALE * 1.4426950408889634f;
  float pmax = p0[0];
#pragma unroll
  for (int r = 1; r < 16; ++r) pmax = fmaxf(pmax, p0[r]);
#pragma unroll
  for (int r = 0; r < 16; ++r) pmax = fmaxf(pmax, p1[r]);
  { auto rr = __builtin_amdgcn_permlane32_swap(__float_as_uint(pmax), __float_as_uint(pmax), false, false);
    pmax = fmaxf(__uint_as_float(rr[0]), __uint_as_float(rr[1])); }
  if (__builtin_expect(__all(pmax - m_reg <= THR / SCALE), 1)) { mn = m_reg; alpha = 1.f; }
  else { mn = fmaxf(m_reg, pmax); alpha = __builtin_amdgcn_exp2f((m_reg - mn) * C); m_reg = mn; }
  const float mnC = -mn * C;
#pragma unroll
  for (int r = 0; r < 16; ++r) p0[r] = fmaf(p0[r], C, mnC);
#pragma unroll
  for (int r = 0; r < 16; ++r) p1[r] = fmaf(p1[r], C, mnC);
#pragma unroll
  for (int r = 0; r < 16; ++r) p0[r] = __builtin_amdgcn_exp2f(p0[r]);
}
DI void finishSM(f32x16& p0, f32x16& p1, float alpha, float& l_reg, bf16x8& pa0, bf16x8& pa1, bf16x8& pa2, bf16x8& pa3) {
#pragma unroll
  for (int r = 0; r < 16; ++r) p1[r] = __builtin_amdgcn_exp2f(p1[r]);
  float ps = 0;
#pragma unroll
  for (int r = 0; r < 16; ++r) ps += p0[r];
#pragma unroll
  for (int r = 0; r < 16; ++r) ps += p1[r];
  { auto rr = __builtin_amdgcn_permlane32_swap(__float_as_uint(ps), __float_as_uint(ps), false, false);
    ps = __uint_as_float(rr[0]) + __uint_as_float(rr[1]); }
  l_reg = l_reg * alpha + ps;
#define PK4(P, BASE, OUT) do { unsigned a0 = cvtpk(P[BASE + 0], P[BASE + 1]), a1 = cvtpk(P[BASE + 2], P[BASE + 3]);   \
    unsigned b0 = cvtpk(P[BASE + 4], P[BASE + 5]), b1 = cvtpk(P[BASE + 6], P[BASE + 7]);                              \
    auto r0 = __builtin_amdgcn_permlane32_swap(a0, b0, false, false); auto r1 = __builtin_amdgcn_permlane32_swap(a1, b1, false, false); \
    u32x4 w = {r0[0], r1[0], r0[1], r1[1]}; OUT = *reinterpret_cast<bf16x8*>(&w); } while (0)
  PK4(p0, 0, pa0); PK4(p0, 8, pa1); PK4(p1, 0, pa2); PK4(p1, 8, pa3);
#undef PK4
}
DI void qkt(f32x16& p0, f32x16& p1, const char* Ks, const char* KRs, const bf16x8* qr, int r32, int hi) {
  p0 = f32x16{}; p1 = f32x16{};
#pragma unroll
  for (int d0 = 0; d0 < 8; ++d0) { const int cb = (d0 * 16 + hi * 8) * 2;
    const bf16x8 b0 = *reinterpret_cast<const bf16x8*>(Ks + KSWZ(r32, cb));
    const bf16x8 b1 = *reinterpret_cast<const bf16x8*>(Ks + KSWZ(32 + r32, cb));
    p0 = __builtin_amdgcn_mfma_f32_32x32x16_bf16(b0, qr[d0], p0, 0, 0, 0);
    p1 = __builtin_amdgcn_mfma_f32_32x32x16_bf16(b1, qr[d0], p1, 0, 0, 0); }
#pragma unroll
  for (int d0 = 0; d0 < 4; ++d0) { const int cb = (d0 * 16 + hi * 8) * 2;
    const bf16x8 b0 = *reinterpret_cast<const bf16x8*>(KRs + KRSWZ(r32, cb));
    const bf16x8 b1 = *reinterpret_cast<const bf16x8*>(KRs + KRSWZ(32 + r32, cb));
    p0 = __builtin_amdgcn_mfma_f32_32x32x16_bf16(b0, qr[8 + d0], p0, 0, 0, 0);
    p1 = __builtin_amdgcn_mfma_f32_32x32x16_bf16(b1, qr[8 + d0], p1, 0, 0, 0); }
}
DI int v_st(int k, int c) { const int kk = (k & ~0xC) | ((k & 4) << 1) | ((k & 8) >> 1); return ((kk >> 3) * 4 + (c >> 5)) * 512 + ((kk & 7) * 32 + (c & 31)) * 2; }
DI int v_rd_base(int lane) { return ((lane & 3) << 3) | (((lane >> 2) & 3) << 6) | (((lane >> 4) & 1) << 5) | (((lane >> 5) & 1) << 8); }
constexpr int v_rd_off(int d0, int ks, int half) { return d0 * 512 + ks * 4096 + half * 2048; }
template <int OFF> DI s16x4 tr_read(int vb) { s16x4 r; asm volatile("ds_read_b64_tr_b16 %0, %1 offset:%2" : "=&v"(r) : "v"(vb), "i"(OFF) : "memory"); return r; }
template <int D0> DI void pv_one(f32x16& od, int vb, bf16x8 pa0, bf16x8 pa1, bf16x8 pa2, bf16x8 pa3) {
  const s16x4 l0 = tr_read<v_rd_off(D0, 0, 0)>(vb), h0 = tr_read<v_rd_off(D0, 0, 1)>(vb), l1 = tr_read<v_rd_off(D0, 1, 0)>(vb), h1 = tr_read<v_rd_off(D0, 1, 1)>(vb);
  const s16x4 l2 = tr_read<v_rd_off(D0, 2, 0)>(vb), h2 = tr_read<v_rd_off(D0, 2, 1)>(vb), l3 = tr_read<v_rd_off(D0, 3, 0)>(vb), h3 = tr_read<v_rd_off(D0, 3, 1)>(vb);
  asm volatile("s_waitcnt lgkmcnt(0)" ::: "memory"); SBAR();
#define PK(L, H) (bf16x8){L[0], L[1], L[2], L[3], H[0], H[1], H[2], H[3]}
  od = __builtin_amdgcn_mfma_f32_32x32x16_bf16(pa0, PK(l0, h0), od, 0, 0, 0);
  od = __builtin_amdgcn_mfma_f32_32x32x16_bf16(pa1, PK(l1, h1), od, 0, 0, 0);
  od = __builtin_amdgcn_mfma_f32_32x32x16_bf16(pa2, PK(l2, h2), od, 0, 0, 0);
  od = __builtin_amdgcn_mfma_f32_32x32x16_bf16(pa3, PK(l3, h3), od, 0, 0, 0);
#undef PK
}
DI void pv_d0(f32x16* o, int vb, bf16x8 pa0, bf16x8 pa1, bf16x8 pa2, bf16x8 pa3) {
  pv_one<0>(o[0], vb, pa0, pa1, pa2, pa3); pv_one<1>(o[1], vb, pa0, pa1, pa2, pa3); pv_one<2>(o[2], vb, pa0, pa1, pa2, pa3); pv_one<3>(o[3], vb, pa0, pa1, pa2, pa3);
}

DI void attn_body(const bf16_t* __restrict__ Qb, const bf16_t* __restrict__ Kh, const bf16_t* __restrict__ Vh, const bf16_t* __restrict__ KRh, bf16_t* __restrict__ Ob, int seq, int tpos0, char* lds) {
  const int tid = ltid(), wid = tid >> 6, lane = tid & 63, r32 = lane & 31, hi = lane >> 5;
  char* V_lds = lds; char* K_lds = lds + 2 * SHM_V; char* KR_lds = lds + 2 * SHM_V + 2 * SHM_K;
  float* ws = (float*)(lds + 2 * SHM_V + 2 * SHM_K + 2 * SHM_KR) + wid * 64; float* li_l = ws; float* al_l = ws + 32;
  float m_reg = -1e30f, l_reg = 0; f32x16 o[4] = {}; bf16x8 qr[12];
  const bf16_t* Qw = Qb + (long)(wid * QBLK + r32) * LDQ + hi * 8;
#pragma unroll
  for (int d0 = 0; d0 < 12; ++d0) qr[d0] = *reinterpret_cast<const bf16x8*>(Qw + d0 * 16);
  if (tpos0 >= 0) {
    const int t = tpos0 + wid * QBLK + r32;
#pragma unroll
    for (int hf = 0; hf < 2; ++hf) { const float pos = (float)(hf ? (t & 63) : (t >> 6));
#pragma unroll
      for (int j = 0; j < 8; ++j) { const float ang = pos * exp2f(-(float)(hi * 8 + j) * (13.287712379549449f / 16.f)); float sv, cv; sincosf(ang, &sv, &cv);
        const float x1 = bf2f((bf16_t)qr[8 + 2 * hf][j]), x2 = bf2f((bf16_t)qr[9 + 2 * hf][j]);
        qr[8 + 2 * hf][j] = (short)f2bf(x1 * cv - x2 * sv); qr[9 + 2 * hf][j] = (short)f2bf(x2 * cv + x1 * sv); } }
  }
  const int sr = tid >> 4, sc = (tid & 15) * 8, vst0 = v_st(sr, sc), vst1 = v_st(32 + sr, sc);
  const int krr = tid >> 3, krc = (tid & 7) * 8;
  const int vb0 = (int)(uintptr_t)V_lds + v_rd_base(lane);
  bf16x8 vs0, vs1, ks0, ks1, kr0;
#define SLOAD(k0) do { vs0 = *reinterpret_cast<const bf16x8*>(&Vh[(long)((k0) + sr) * LDK + sc]); vs1 = *reinterpret_cast<const bf16x8*>(&Vh[(long)((k0) + 32 + sr) * LDK + sc]); \
    ks0 = *reinterpret_cast<const bf16x8*>(&Kh[(long)((k0) + sr) * LDK + sc]); ks1 = *reinterpret_cast<const bf16x8*>(&Kh[(long)((k0) + 32 + sr) * LDK + sc]); \
    kr0 = *reinterpret_cast<const bf16x8*>(&KRh[(long)((k0) + krr) * LDKR + krc]); } while (0)
#define SWRITE(b) do { *(bf16x8*)(V_lds + (b) * SHM_V + vst0) = vs0; *(bf16x8*)(V_lds + (b) * SHM_V + vst1) = vs1; const int kc = sc * 2;               \
    *(bf16x8*)(K_lds + (b) * SHM_K + KSWZ(sr, kc)) = ks0; *(bf16x8*)(K_lds + (b) * SHM_K + KSWZ(32 + sr, kc)) = ks1;                       \
    *(bf16x8*)(KR_lds + (b) * SHM_KR + KRSWZ(krr, krc * 2)) = kr0; } while (0)
#define SWAIT() asm volatile("s_waitcnt vmcnt(0)" ::: "memory")
#define RESC(a) do { if (__any((a) < 1.f)) { if (hi == 0) al_l[r32] = (a); asm volatile("s_waitcnt lgkmcnt(0)" ::: "memory"); \
    _Pragma("unroll") for (int d = 0; d < 4; ++d) _Pragma("unroll") for (int r = 0; r < 16; ++r) o[d][r] *= al_l[crow(r, hi)]; } } while (0)
  f32x16 p0, p1; float mn, al; bf16x8 pa0, pa1, pa2, pa3; const int NT = seq / KVBLK;
  SLOAD(0); SWAIT(); SWRITE(0); __syncthreads();
  for (int j = 0; j < NT; ++j) {
    const int buf = j & 1; const bool more = j + 1 < NT;
    if (more) SLOAD((j + 1) * KVBLK);
    SBAR(); qkt(p0, p1, K_lds + buf * SHM_K, KR_lds + buf * SHM_KR, qr, r32, hi);
    partialSM(p0, p1, m_reg, mn, al); RESC(al);
    finishSM(p0, p1, al, l_reg, pa0, pa1, pa2, pa3); SBAR();
    pv_d0(o, vb0 + buf * SHM_V, pa0, pa1, pa2, pa3);
    if (more) { SWAIT(); SWRITE(buf ^ 1); }
    __syncthreads();
  }
  if (hi == 0) li_l[r32] = l_reg; asm volatile("s_waitcnt lgkmcnt(0)" ::: "memory");
  float rli[16];
#pragma unroll
  for (int r = 0; r < 16; ++r) rli[r] = __builtin_amdgcn_rcpf(li_l[crow(r, hi)]);
  bf16_t* Ow = Ob + (long)(wid * QBLK) * LDO;
#pragma unroll
  for (int r = 0; r < 16; ++r) { const int orow = crow(r, hi);
#pragma unroll
    for (int d0 = 0; d0 < 4; ++d0) Ow[(long)orow * LDO + d0 * 32 + r32] = f2bf(o[d0][r] * rli[r]); }
  __syncthreads();
#undef SLOAD
#undef SWRITE
#undef SWAIT
#undef RESC
}
}

DI void st_attn(const Prm& p, int layer, char* lds, int bid, int nb) {
  const int nlat = NB * 4 * 16, nitem = nlat + (layer == 0 ? NB * 4 : 0);
  for (int it = bid; it < nitem; it += nb) {
    if (it < nlat) { const int b = it >> 6, h = (it >> 4) & 3, qb = it & 15; const size_t r0 = (size_t)b * LT;
      att::attn_body(p.Qraw + (r0 + qb * 256) * 768 + h * 192, p.KV + r0 * 1024 + h * 256, p.KV + r0 * 1024 + h * 256 + 128, p.KR + r0 * 64,
                     p.Y + (r0 + qb * 256) * DM + 1024 + h * 128, LT, qb * 256, lds); }
    else { const int k = it - nlat, b = k >> 2, h = k & 3; const size_t r0 = (size_t)b * LT + LL;
      att::attn_body(p.Qraw + r0 * 768 + h * 192, p.KV + r0 * 1024 + h * 256, p.KV + r0 * 1024 + h * 256 + 128, p.KR + r0 * 64, p.Y + r0 * DM + 1024 + h * 128, LCX, -1, lds); }
  }
}

struct EpiResid {
  static constexpr bool PERM = false, AFTER_DRAIN = false;
  const float* xlat; const float* xctx; float* X; const float* modl; int first;
  __device__ __forceinline__ void operator()(const pg8::f32x4 (&acc)[2][2][4][2], const pg8::Unit& u, int wr, int wc, int fr, int fq) const {
    const int b = u.pm / 17, tl = u.pm - b * 17; const bool isc = tl == 16;
    const float* g = modl + (size_t)(isc ? 8 : b) * NMOD + 2 * DM;
    const int rloc0 = wr * 64 + fr, col0 = u.pn * 256 + wc * 32 + 4 * fq;
    pg8::f32x4 gv[2][2];
#pragma unroll
    for (int bj = 0; bj < 2; ++bj)
#pragma unroll
      for (int n = 0; n < 2; ++n) gv[bj][n] = *(const pg8::f32x4*)(g + col0 + bj * 128 + n * 16);
#pragma unroll
    for (int ai = 0; ai < 2; ++ai)
#pragma unroll
      for (int m = 0; m < 4; ++m) { const int rl = rloc0 + ai * 128 + m * 16; const size_t row = (size_t)u.pm * 256 + rl;
        const float* src = first ? (isc ? xctx + ((size_t)b * LCX + rl) * DM : xlat + ((size_t)b * LL + tl * 256 + rl) * DM) : X + row * DM;
        float* dst = X + row * DM;
#pragma unroll
        for (int bj = 0; bj < 2; ++bj)
#pragma unroll
          for (int n = 0; n < 2; ++n) { const int c = col0 + bj * 128 + n * 16; *(pg8::f32x4*)(dst + c) = *(const pg8::f32x4*)(src + c) + gv[bj][n] * acc[ai][bj][m][n]; } }
  }
};

struct LatentOrder : pg8::StaticOrder {
  __device__ bool next(int i, pg8::Unit& u) const { const bool ok = pg8::StaticOrder::next(i, u); u.pm += u.pm >> 4; return ok; }
};
template <class Epi> DI void run_gemm_lat(unsigned char* lds, const bf16_t* A, const bf16_t* Bt, int N, int K, const Epi& E, int bid, int nb) {
  pg8::Gemm g; g.A = A; g.Bt = Bt; g.M = NB * LL; g.N = N; g.K = K;
  LatentOrder S; S.init(NB * LL, N, nb, bid);
  pg8::gemm_phase<Epi, LatentOrder, false>((PG8_LAS unsigned char*)lds, g, S, E, nullptr);
}
template <class Epi> DI void run_gemm(unsigned char* lds, const bf16_t* A, const bf16_t* Bt, int M, int N, int K, const Epi& E, int bid, int nb) {
  pg8::Gemm g; g.A = A; g.Bt = Bt; g.M = M; g.N = N; g.K = K;
  pg8::StaticOrder S; S.init(M, N, nb, bid);
  pg8::gemm_phase<Epi, pg8::StaticOrder, false>((PG8_LAS unsigned char*)lds, g, S, E, nullptr);
}
DI pg8::EpiBf16<0> epi_bf16(bf16_t* O, int ldc, int split_cols = 0, size_t split_stride = 0) { pg8::EpiBf16<0> e; e.O = O; e.ldc = ldc; e.bias = nullptr; e.split_cols = split_cols; e.split_stride = split_stride; return e; }

#ifndef PROBE
#define PROBE 0
#endif
constexpr int LDS_MAIN = 131072 + 4096, LDS_TOTAL = LDS_MAIN + 64;
#define PRM() (*(const __attribute__((address_space(4))) Prm*)launder_k(kp))
typedef const __attribute__((address_space(4))) void* kptr_t;
DI kptr_t launder_k(kptr_t q) { asm volatile("" : "+s"(q)); return q; }
extern __shared__ __attribute__((aligned(16))) unsigned char shm[];
__global__ void __launch_bounds__(NTHR, 2) mega(Prm p_unused) {
#if defined(__HIP_DEVICE_COMPILE__)
  kptr_t kp = (kptr_t)__builtin_amdgcn_kernarg_segment_ptr();
  const int bid0 = blockIdx.x, nb0 = gridDim.x;
#define bid lsg(bid0)
#define nb lsg(nb0)
  uint4* xbw = (uint4*)(shm + LDS_MAIN);
  if (threadIdx.x == 0) *xbw = make_uint4(0u, 0u, 0u, 0u);
  __syncthreads();
  { const Prm p = PRM(); (void)xcd_barrier_post(p.bar, (volatile LAS unsigned*)xbw); }
#define GRID_BAR() do { XcdBarrier b_; b_.bar = PRM().bar; b_.x = xb_xcc_id(); b_.st = (volatile LAS unsigned*)(shm + LDS_MAIN); xcd_barrier(b_); } while (0)
  float* lf = (float*)shm;
  for (int ly = 0; ly < 2; ++ly) { const Prm p = PRM();
    st_transpose(p.w_in + (size_t)ly * DM * IN_W, p.WinT + (size_t)ly * NZ * DM, DM, IN_W, DM, NZ, lf, bid, nb);
    st_transpose(p.w_out + (size_t)ly * DM * DM, p.WoutT + (size_t)ly * DM * DM, DM, DM, DM, DM, lf, bid, nb);
    st_transpose(p.peer_wq + (size_t)ly * DM * DM, p.WqT + (size_t)ly * DM * DM, DM, DM, DM, DM, lf, bid, nb);
    st_transpose(p.mla_w_uq + (size_t)ly * 448 * 768, p.WuqT + (size_t)ly * 768 * 512, 448, 768, 512, 768, lf, bid, nb);
    st_transpose(p.mla_w_ukv + (size_t)ly * 128 * 1024, p.WukvT + (size_t)ly * 1024 * 256, 128, 1024, 256, 1024, lf, bid, nb);
  }
  { const Prm p = PRM(); st_tables(p, bid, nb); }
  __syncthreads();
  { const Prm p = PRM(); st_mods(p, lf, bid, nb); }
  if (PROBE == 5) { __syncthreads();
    for (int ly = 0; ly < 2; ++ly) { const Prm p = PRM();
      st_transpose(p.w_in + (size_t)ly * DM * IN_W, p.WinT + (size_t)ly * NZ * DM, DM, IN_W, DM, NZ, lf, bid, nb);
      st_transpose(p.w_out + (size_t)ly * DM * DM, p.WoutT + (size_t)ly * DM * DM, DM, DM, DM, DM, lf, bid, nb);
      st_transpose(p.peer_wq + (size_t)ly * DM * DM, p.WqT + (size_t)ly * DM * DM, DM, DM, DM, DM, lf, bid, nb); }
    { const Prm p = PRM(); st_tables(p, bid, nb); }
    __syncthreads();
    { const Prm p = PRM(); st_mods(p, lf, bid, nb); } }
  GRID_BAR();
  for (int l = 0; l < 2; ++l) {
    if (l == 0) { { const Prm p = PRM(); st_modulate(p, l, 0, p.H, bid, nb); } GRID_BAR(); }
    { const Prm p = PRM(); run_gemm(shm, p.H, p.WinT + (size_t)l * NZ * DM, MR, NZ, DM, epi_bf16(p.Z, NZ), bid, nb); }
    if (PROBE == 6) { const Prm p = PRM(); run_gemm(shm, p.H, p.WinT + (size_t)l * NZ * DM, MR, NZ, DM, epi_bf16(p.Z, NZ), bid, nb); }
    GRID_BAR();
    { const Prm p = PRM(); st_dnprep(p, l, bid, nb); }
    { const Prm p = PRM(); st_mlaprep(p, l, bid, nb); }
    { const Prm p = PRM(); st_fnchan(p, shm, bid, nb); }
    GRID_BAR();
    { const Prm p = PRM(); st_dntinv(p, shm, bid, nb); }
    __syncthreads();
    { const Prm p = PRM(); st_glabc(p, l, shm, bid, nb); }
    if (PROBE == 9) { { const Prm p = PRM(); st_dnprep(p, l, bid, nb); } { const Prm p = PRM(); st_mlaprep(p, l, bid, nb); } }
    if (PROBE == 10) { const Prm p = PRM(); st_fnchan(p, shm, bid, nb); }
    GRID_BAR();
    { const Prm p = PRM(); run_gemm(shm, p.Aq, p.WuqT + (size_t)l * 768 * 512, MR, 768, 512, epi_bf16(p.Qraw, 768), bid, nb); }
    { const Prm p = PRM(); run_gemm(shm, p.Akv, p.WukvT + (size_t)l * 1024 * 256, MR, 1024, 256, epi_bf16(p.KV, 1024), bid, nb); }
    if (bid < 128) { const Prm p = PRM(); st_dnscan(p, shm, bid, 128); }
    else { const Prm p = PRM(); st_glascan(p, l, shm, bid - 128, 128); }
    if (PROBE == 7) { GRID_BAR(); if (bid < 128) { const Prm p = PRM(); st_dnscan(p, shm, bid, 128); } }
    if (PROBE == 8) { GRID_BAR(); if (bid < 128) { const Prm p = PRM(); st_glascan(p, l, shm, bid, 128); } }
    if (PROBE == 2) { GRID_BAR(); if (bid < 128) { const Prm p = PRM(); st_dnscan(p, shm, bid, 128); } else { const Prm p = PRM(); st_glascan(p, l, shm, bid - 128, 128); } }
    GRID_BAR();
    { const Prm p = PRM(); st_attn(p, l, (char*)shm, bid, nb); }
    if (PROBE == 3) { const Prm p = PRM(); st_attn(p, l, (char*)shm, bid, nb); }
    { const Prm p = PRM(); st_fnfft(p, shm, bid, nb); }
    __syncthreads();
    if (l == 0) { const Prm p = PRM(); run_gemm(shm, p.DFTC, p.PQTc, 256, 4096, 512, epi_bf16(p.Y + (size_t)LL * DM + 1536, DM, 512, (size_t)LT * DM), bid, nb); }
    { const Prm p = PRM(); st_combine(p, l, bid, nb); }
    GRID_BAR();
    { const Prm p = PRM(); EpiResid e; e.xlat = p.x; e.xctx = p.ctx; e.X = p.X; e.modl = p.mod + (size_t)l * 9 * NMOD; e.first = l == 0;
      if (l == 0) run_gemm(shm, p.Y, p.WoutT + (size_t)l * DM * DM, MR, DM, DM, e, bid, nb);
      else run_gemm_lat(shm, p.Y, p.WoutT + (size_t)l * DM * DM, DM, DM, e, bid, nb); }
    GRID_BAR();
    { const Prm p = PRM(); st_modulate(p, l, 1, p.H2, bid, nb); }
    { const Prm p = PRM(); st_cvt_tables(p, l, bid, nb); }
    GRID_BAR();
    if (l == 0) { const Prm p = PRM(); run_gemm(shm, p.H2, p.WqT + (size_t)l * DM * DM, MR, DM, DM, epi_bf16(p.Qp, DM), bid, nb); }
    else { const Prm p = PRM(); run_gemm_lat(shm, p.H2, p.WqT + (size_t)l * DM * DM, DM, DM, epi_bf16(p.Qp, DM), bid, nb); }
    GRID_BAR();
    { const Prm p = PRM(); st_peertopk(p, l, shm, bid, nb); }
    if (PROBE == 4) { __syncthreads(); const Prm p = PRM(); st_peertopk(p, l, shm, bid, nb); }
    GRID_BAR();
    { const Prm p = PRM(); st_peergather(p, l, lf, bid, nb); }
    if (PROBE == 1) { __syncthreads(); const Prm p = PRM(); st_peergather(p, l, lf, bid, nb, true); }
    if (l == 0) GRID_BAR();
  }
#endif
#undef bid
#undef nb
#undef GRID_BAR
}

static size_t al256(size_t x) { return (x + 255) / 256 * 256; }
extern "C" void kernel_launch(void* const* d_in, const int* in_sizes, int n_in, void* d_out, int out_size, void* d_ws, size_t ws_size, hipStream_t stream) {
  Prm p{};
  const float** f = (const float**)&p.x;
  for (int i = 0; i < 24; ++i) f[i] = (const float*)d_in[i];
  p.out = (float*)d_out;
  char* w = (char*)d_ws; size_t o = 0;
  auto take = [&](size_t bytes) { char* r = w + o; o += al256(bytes); return r; };
  p.bar = (unsigned*)take(16384);
  p.WinT = (bf16_t*)take((size_t)2 * NZ * DM * 2); p.WoutT = (bf16_t*)take((size_t)2 * DM * DM * 2); p.WqT = (bf16_t*)take((size_t)2 * DM * DM * 2);
  p.WuqT = (bf16_t*)take((size_t)2 * 768 * 512 * 2); p.WukvT = (bf16_t*)take((size_t)2 * 1024 * 256 * 2);
  p.mod = (float*)take((size_t)2 * 9 * NMOD * 4); p.GB = (float*)take((size_t)MR * 16 * 4); p.CCS = (float*)take((size_t)2 * 128 * 128 * 4);
  p.DFTM = (bf16_t*)take((size_t)4096 * 8192 * 2); p.DFTC = (bf16_t*)take((size_t)256 * 512 * 2);
  p.X = (float*)take((size_t)MR * DM * 4);
  p.Z = (bf16_t*)take((size_t)MR * NZ * 2);
  char* ra = take((size_t)MR * 1536 * 2 + (size_t)4 * MR * 512 * 2);
  p.DNQ = (bf16_t*)ra; p.OB = (bf16_t*)(ra + (size_t)MR * 1536 * 2); p.H = (bf16_t*)ra;
  p.Ub = (bf16_t*)(ra + (size_t)MR * DM * 2); p.Vb = (bf16_t*)(ra + (size_t)MR * DM * 2 + (size_t)16384 * 1600);
  p.KV = (bf16_t*)take((size_t)MR * 1024 * 2); p.KR = (bf16_t*)take((size_t)MR * 64 * 2);
  p.Aq = (bf16_t*)take((size_t)MR * 512 * 2); p.Akv = (bf16_t*)take((size_t)MR * 256 * 2);
  if (o > ws_size) return;
  char* q = (char*)d_out; size_t oo = 0;
  p.Y = (bf16_t*)q; oo += (size_t)MR * DM * 2; p.PQT = (bf16_t*)(q + oo); oo += (size_t)8 * 512 * 8192 * 2; p.PQTc = (bf16_t*)(q + oo); oo += (size_t)8 * 512 * 512 * 2;
  p.Qraw = (bf16_t*)(q + oo); oo += (size_t)MR * 768 * 2;
  p.TINV = (bf16_t*)q; p.GCB = (float*)(q + (size_t)4352 * 4096 * 2); p.BC = (float*)(q + (size_t)4352 * 4096 * 2 + (size_t)4352 * 64 * 4);
  char* z = (char*)p.Z; p.H2 = (bf16_t*)z; p.Qp = (bf16_t*)(z + (size_t)MR * DM * 2); p.IDX = (int*)(z + (size_t)2 * MR * DM * 2); p.GATE = (float*)(z + (size_t)2 * MR * DM * 2 + (size_t)MR * 128 * 4);

  static int grid = 0;
  if (!grid) {
    (void)hipFuncSetAttribute((const void*)mega, hipFuncAttributeMaxDynamicSharedMemorySize, LDS_TOTAL);
    int dev = 0, cus = 0, per_cu = 0;
    (void)hipGetDevice(&dev); (void)hipDeviceGetAttribute(&cus, hipDeviceAttributeMultiprocessorCount, dev);
    (void)hipOccupancyMaxActiveBlocksPerMultiprocessor(&per_cu, (const void*)mega, NTHR, LDS_TOTAL);
    grid = per_cu >= 1 ? cus : 0;
    if (grid > 256) grid = 256;
  }
  if (grid < 256) return;
  (void)hipMemsetAsync(p.bar, 0, XCD_BAR_WORDS * sizeof(unsigned), stream);
  hipLaunchKernelGGL(mega, dim3(grid), dim3(NTHR), LDS_TOTAL, stream, p);
}
```

```cpp
#include <hip/hip_runtime.h>
#include <stdint.h>

constexpr int DM = 2048, NB = 8, LL = 4096, LCX = 256, LT = LL + LCX  , MR = NB * LT  ;
constexpr int NZ = 4864;
constexpr int C_DNQ = 0, C_DNK = 512, C_DNV = 1024, C_DNGATE = 1536, C_DNA = 2048, C_DNB = 2056, C_GQ = 2064, C_GK = 2320, C_GV = 2576,
              C_GGATE = 3088, C_GALPHA = 3600, C_CQ = 3632, C_CKV = 4080, C_KR = 4208, C_FN = 4272, IN_W = 4784;
constexpr int NMOD = 6 * DM;
constexpr float EPSV = 1e-6f;
constexpr int NTHR = 512;

typedef unsigned short bf16_t;
typedef short bf16x8 __attribute__((ext_vector_type(8)));
typedef short s16x4 __attribute__((ext_vector_type(4)));
typedef float f32x4 __attribute__((ext_vector_type(4)));
typedef float f32x16 __attribute__((ext_vector_type(16)));
typedef unsigned u32x4 __attribute__((ext_vector_type(4)));
typedef unsigned u32x2 __attribute__((ext_vector_type(2)));

#define DI __device__ __forceinline__
DI float bf2f(bf16_t b) { return __uint_as_float(((unsigned)b) << 16); }
DI bf16_t f2bf(float f) { unsigned u = __float_as_uint(f); u += 0x7FFFu + ((u >> 16) & 1u); return (bf16_t)(u >> 16); }
DI unsigned pack2(float lo, float hi) { return (unsigned)f2bf(lo) | ((unsigned)f2bf(hi) << 16); }
typedef float f32x2 __attribute__((ext_vector_type(2)));
DI float dpp_x1(float v) { return __int_as_float(__builtin_amdgcn_mov_dpp(__float_as_int(v), 0xB1, 0xf, 0xf, true)); }
DI float dpp_x2(float v) { return __int_as_float(__builtin_amdgcn_mov_dpp(__float_as_int(v), 0x4E, 0xf, 0xf, true)); }
DI float dpp_hm(float v) { return __int_as_float(__builtin_amdgcn_mov_dpp(__float_as_int(v), 0x141, 0xf, 0xf, true)); }
DI float dpp_rm(float v) { return __int_as_float(__builtin_amdgcn_mov_dpp(__float_as_int(v), 0x140, 0xf, 0xf, true)); }
DI float red4(float v) { v += dpp_x1(v); v += dpp_x2(v); return v; }
DI float red8(float v) { v += dpp_x1(v); v += dpp_x2(v); v += dpp_hm(v); return v; }
DI float rdl(float v, int l) { return __int_as_float(__builtin_amdgcn_readlane(__float_as_int(v), l)); }
DI float wsum(float v) { v += dpp_x1(v); v += dpp_x2(v); v += dpp_hm(v); v += dpp_rm(v); return (rdl(v, 0) + rdl(v, 16)) + (rdl(v, 32) + rdl(v, 48)); }
DI float wmax(float v) { v = fmaxf(v, dpp_x1(v)); v = fmaxf(v, dpp_x2(v)); v = fmaxf(v, dpp_hm(v)); v = fmaxf(v, dpp_rm(v)); return fmaxf(fmaxf(rdl(v, 0), rdl(v, 16)), fmaxf(rdl(v, 32), rdl(v, 48))); }
DI float siluf(float x) { return x / (1.f + __expf(-x)); }
DI float sigmf(float x) { return 1.f / (1.f + __expf(-x)); }

DI int ltid() { int t = (int)threadIdx.x; asm volatile("" : "+v"(t)); return t; }
DI int lsg(int v) { asm volatile("" : "+s"(v)); return v; }

struct Prm {
  const float *x, *c, *ctx, *c_ctx, *w_ada, *b_ada, *w_in, *dn_conv, *dn_a_log, *dn_dt_bias, *dn_norm, *gla_w2, *gla_b2, *gla_norm,
      *mla_q_norm, *mla_w_uq, *mla_kv_norm, *mla_w_ukv, *w_out, *peer_wq, *peer_keys, *peer_u, *peer_v, *final_norm;
  float* out;
  bf16_t *WinT, *WoutT, *WqT, *WuqT, *WukvT;
  float *mod, *GB, *CCS;
  bf16_t *DFTM, *DFTC;
  float* X;
  bf16_t* Z;
  bf16_t *H, *DNQ, *OB;
  bf16_t *KV, *KR;
  bf16_t *Y, *PQT, *PQTc, *Qraw, *Aq, *Akv;
  bf16_t *H2, *Qp;
  bf16_t *Ub, *Vb;
  bf16_t* TINV; float* GCB; float* BC;
  int* IDX;
  float* GATE;
  unsigned* bar;
};
#define XB_TMO      128
#define XB_XCNT(j)  (256  + 64 * (j))
#define XB_XSUB(j)  (1280 + 64 * (j))
#define XB_XGEN(j)  (2304 + 64 * (j))
#define XB_TOP      3328
#define XB_TOPGEN   3392
#define XCD_BAR_WORDS 3456
#define XB_SPIN_CAP (1u << 18)
#define LAS __attribute__((address_space(3)))

__device__ __forceinline__ unsigned xb_ld(unsigned* p)              { return __hip_atomic_load(p, __ATOMIC_RELAXED, __HIP_MEMORY_SCOPE_AGENT); }
__device__ __forceinline__ unsigned xb_add(unsigned* p, unsigned v) { return __hip_atomic_fetch_add(p, v, __ATOMIC_RELAXED, __HIP_MEMORY_SCOPE_AGENT); }
__device__ __forceinline__ unsigned xb_xcc_id() { return (unsigned)__builtin_amdgcn_s_getreg((3 << 11) | 20) & 0xFu; }
#define XB_SPIN(cond, bar) do { unsigned _sp = 0; while (cond) { __builtin_amdgcn_s_sleep(1); \
    if ((++_sp & 255u) == 0u) { if (xb_ld(&(bar)[XB_TMO])) break; if (_sp > XB_SPIN_CAP) { atomicAdd(&(bar)[XB_TMO], 1u); break; } } } } while (0)

struct XcdBarrier {
    unsigned* bar; unsigned x;
    volatile LAS unsigned* st;
};

__device__ __forceinline__ XcdBarrier xcd_barrier_post(unsigned* bar, volatile LAS unsigned* st) {
    XcdBarrier b; b.bar = bar; b.x = xb_xcc_id(); b.st = st;
    if (threadIdx.x == 0) (void)xb_add(&bar[XB_XCNT(b.x)], 1u);
    return b;
}
__device__ __forceinline__ void xcd_barrier_complete(unsigned* bar, unsigned x, unsigned& nloc, unsigned& nx) {
    const unsigned G = gridDim.x * gridDim.y * gridDim.z;
    unsigned sum, cnt, mine, sp = 0u;
    for (;;) {
        sum = 0u; cnt = 0u; mine = 0u;
#pragma unroll
        for (unsigned j = 0; j < 16; ++j) { const unsigned c = xb_ld(&bar[XB_XCNT(j)]); sum += c; cnt += (c > 0u) ? 1u : 0u; mine = (j == x) ? c : mine; }
        if (sum == G) break;
        __builtin_amdgcn_s_sleep(1);
        if ((++sp & 255u) == 0u) { if (xb_ld(&bar[XB_TMO])) break; if (sp > XB_SPIN_CAP) { atomicAdd(&bar[XB_TMO], 1u); break; } }
    }
    nloc = mine > 0u ? mine : 1u; nx = cnt > 0u ? cnt : 1u;
}

__device__ __forceinline__ void xcd_barrier(const XcdBarrier& b) {
    asm volatile("s_waitcnt vmcnt(0)" ::: "memory");
    __syncthreads();
    if (threadIdx.x == 0) {
        unsigned* bar = b.bar;
        __builtin_amdgcn_s_waitcnt(0);
        unsigned nloc = b.st[0], nx = b.st[1];
        if (nloc == 0u) { xcd_barrier_complete(bar, b.x, nloc, nx); b.st[0] = nloc; b.st[1] = nx; }
        const unsigned old = xb_add(&bar[XB_XSUB(b.x)], 1u);
        const unsigned gen = old / nloc;
        if (old + 1u == (gen + 1u) * nloc) {
            __builtin_amdgcn_fence(__ATOMIC_RELEASE, "agent");
            asm volatile("s_waitcnt vmcnt(0)" ::: "memory");
            const unsigned og = xb_add(&bar[XB_TOP], 1u);
            const unsigned tg = og / nx;
            if (og + 1u == (tg + 1u) * nx) xb_add(&bar[XB_TOPGEN], 1u);
            else XB_SPIN(xb_ld(&bar[XB_TOPGEN]) == tg, bar);
            __builtin_amdgcn_fence(__ATOMIC_ACQUIRE, "agent");
            xb_add(&bar[XB_XGEN(b.x)], 1u);
            asm volatile("s_waitcnt vmcnt(0)" ::: "memory");
        } else {
            XB_SPIN(xb_ld(&bar[XB_XGEN(b.x)]) == gen, bar);
            __builtin_amdgcn_fence(__ATOMIC_ACQUIRE, "agent");
            asm volatile("s_waitcnt vmcnt(0)" ::: "memory");
        }
    }
    __syncthreads();
}

namespace pg8 {
#define PG8_LAS __attribute__((address_space(3)))
typedef unsigned short bf16_t;
typedef short bf16x8 __attribute__((ext_vector_type(8)));
typedef float f32x4 __attribute__((ext_vector_type(4)));
typedef unsigned u32x4 __attribute__((ext_vector_type(4)));
constexpr int BM = 256, BK = 64, HALF = 128, HTB = HALF * BK * 2  , STAGE_BYTES = 8 * HTB, NXCD = 8, WGM = 8;

__host__ __device__ __forceinline__ int lds_byte(int r, int c) { const int st = (r >> 4) * 2 + (c >> 5), rr = r & 15, cc = c & 31, ob = rr * 64 + cc * 2; return st * 1024 + (ob ^ (((ob >> 9) & 1) << 5)); }
__host__ __device__ __forceinline__ void stage_rc(int b, int& R, int& C) { const int st = b / 1024, sb = b % 1024, swz = sb ^ (((sb >> 9) & 1) << 5); R = (st >> 1) * 16 + swz / 64; C = (st & 1) * 32 + (swz % 64) / 2; }
__host__ __device__ __forceinline__ int perm32(int rho) { const int n = rho >> 4, i = rho & 15; return 8 * (i >> 2) + 4 * n + (i & 3); }

struct Unit { int pm, pn; };
struct Gemm { const bf16_t* A; const bf16_t* Bt; int M, N, K; };

struct StaticOrder {
    int nM, nN, nwg, G, c;
    __host__ __device__ void init(int M, int N, int G_, int c_) { nM = M / BM; nN = N / BM; nwg = nM * nN; G = G_; c = c_; }
    __host__ __device__ bool next(int i, Unit& u) const {
        const long L = (long)i * G + c; if (L >= nwg) return false;
        int wgid = (int)L; { const int q = nwg / NXCD, r = nwg % NXCD, xcd = wgid % NXCD, off = wgid / NXCD; wgid = (xcd < r ? xcd * (q + 1) : r * (q + 1) + (xcd - r) * q) + off; }
        const int nig = WGM * nN, gid = wgid / nig, fm = gid * WGM, gsz = (nM - fm) < WGM ? (nM - fm) : WGM;
        u.pm = fm + ((wgid % nig) % gsz); u.pn = (wgid % nig) / gsz; return true;
    }
    __device__ __forceinline__ void a_ready(const Unit&) const {}
    __device__ __forceinline__ void done(const Unit&) const {}
};
struct CountedOrder : StaticOrder {
    const unsigned* ready; unsigned need; unsigned* tmo;
    __device__ __forceinline__ void a_ready(const Unit& u) const {
        if (threadIdx.x < 64) {
            const unsigned long long t0 = __builtin_amdgcn_s_memrealtime(); unsigned polls = 0;
            while ((unsigned)__builtin_amdgcn_readfirstlane(__hip_atomic_load(ready + 64 * u.pm, __ATOMIC_RELAXED, __HIP_MEMORY_SCOPE_AGENT)) < need) {
                if ((++polls & 255u) == 0u && __builtin_amdgcn_readfirstlane(__hip_atomic_load(tmo, __ATOMIC_RELAXED, __HIP_MEMORY_SCOPE_AGENT)) != 0u) break;
                if (__builtin_amdgcn_s_memrealtime() - t0 > 2000000ull) {
                    if (threadIdx.x == 0) { unsigned expect = 0u; __hip_atomic_compare_exchange_strong(tmo + 1, &expect, 0x600u | (unsigned)(u.pm & 0xff), __ATOMIC_RELAXED, __ATOMIC_RELAXED, __HIP_MEMORY_SCOPE_AGENT); __hip_atomic_store(tmo, 1u, __ATOMIC_RELAXED, __HIP_MEMORY_SCOPE_AGENT); }
                    break; }
                __builtin_amdgcn_s_sleep(2); }
            __builtin_amdgcn_fence(__ATOMIC_ACQUIRE, "agent");
            asm volatile("s_waitcnt vmcnt(0)" ::: "memory");
        }
#if !defined(BROKEN_HOOK_NO_BARRIER)
        asm volatile("" ::: "memory"); __builtin_amdgcn_s_barrier(); asm volatile("" ::: "memory");
#endif
    }
};

__device__ __forceinline__ unsigned cvt_pk_bf16(float lo, float hi) { unsigned r; asm volatile("v_cvt_pk_bf16_f32 %0, %1, %2" : "=v"(r) : "v"(lo), "v"(hi)); return r; }
typedef float f32x2 __attribute__((ext_vector_type(2)));
__device__ __forceinline__ f32x2 gelu_pk(f32x2 v) {
    const f32x2 av = __builtin_elementwise_abs(v), d = av * 0.2316418882f + 1.0f;
    f32x2 t; t.x = __builtin_amdgcn_rcpf(d.x); t.y = __builtin_amdgcn_rcpf(d.y);
    f32x2 q = t * 0.5307027145f + (-0.7265760135f); q = q * t + 0.7107068705f; q = q * t + (-0.142248368f); q = q * t + 0.127414796f; q = q * t;
    const f32x2 s = (v * v) * (-0.72134752044f);
    f32x2 e; e.x = __builtin_amdgcn_exp2f(s.x); e.y = __builtin_amdgcn_exp2f(s.y);
    const f32x2 m = v * (q * e), r = v - m;
    f32x2 o; o.x = v.x < 0.f ? m.x : r.x; o.y = v.y < 0.f ? m.y : r.y; return o;
}

struct EpiF32 {
    static constexpr bool PERM = false, AFTER_DRAIN = false;
    float* C; int ldc; const float* bias;
    __device__ __forceinline__ void operator()(const f32x4 (&acc)[2][2][4][2], const Unit& u, int wr, int wc, int fr, int fq) const {
        const int row0 = u.pm * BM + wr * 64 + fr, col0 = u.pn * BM + wc * 32 + 4 * fq;
        f32x4 bv[2][2];
#pragma unroll
        for (int bj = 0; bj < 2; ++bj)
#pragma unroll
            for (int n = 0; n < 2; ++n) bv[bj][n] = bias ? *(const f32x4*)(bias + col0 + bj * HALF + n * 16) : (f32x4){0.f, 0.f, 0.f, 0.f};
#pragma unroll
        for (int ai = 0; ai < 2; ++ai)
#pragma unroll
            for (int m = 0; m < 4; ++m) { float* rowp = C + (size_t)(row0 + ai * HALF + m * 16) * ldc + col0;
#pragma unroll
                for (int bj = 0; bj < 2; ++bj)
#pragma unroll
                    for (int n = 0; n < 2; ++n) *(f32x4*)(rowp + bj * HALF + n * 16) = acc[ai][bj][m][n] + bv[bj][n]; }
    }
};
template <int ACT  > struct EpiBf16 {
    static constexpr bool PERM = true, AFTER_DRAIN = false;
    bf16_t* O; int ldc; const float* bias; int split_cols; size_t split_stride;
    __device__ __forceinline__ void operator()(const f32x4 (&acc)[2][2][4][2], const Unit& u, int wr, int wc, int fr, int fq) const {
        const int row0 = u.pm * BM + wr * 64 + fr; int colt = u.pn * BM; bf16_t* base = O;
        if (split_cols) { const int t = colt / split_cols; base += (size_t)t * split_stride; colt -= t * split_cols; }
        const int col0 = colt + wc * 32 + 8 * fq, bcol0 = u.pn * BM + wc * 32 + 8 * fq;
        f32x4 bv[2][2];
#pragma unroll
        for (int bj = 0; bj < 2; ++bj)
#pragma unroll
            for (int n = 0; n < 2; ++n) bv[bj][n] = bias ? *(const f32x4*)(bias + bcol0 + bj * HALF + 4 * n) : (f32x4){0.f, 0.f, 0.f, 0.f};
#pragma unroll
        for (int ai = 0; ai < 2; ++ai)
#pragma unroll
            for (int m = 0; m < 4; ++m) { bf16_t* rowp = base + (size_t)(row0 + ai * HALF + m * 16) * ldc + col0;
#pragma unroll
                for (int bj = 0; bj < 2; ++bj) { f32x4 v0 = acc[ai][bj][m][0] + bv[bj][0], v1 = acc[ai][bj][m][1] + bv[bj][1];
                    if (ACT == 1) { f32x2 a = gelu_pk((f32x2){v0[0], v0[1]}), b = gelu_pk((f32x2){v0[2], v0[3]}), c = gelu_pk((f32x2){v1[0], v1[1]}), d = gelu_pk((f32x2){v1[2], v1[3]});
                        v0 = (f32x4){a.x, a.y, b.x, b.y}; v1 = (f32x4){c.x, c.y, d.x, d.y}; }
                    if (ACT == 2) {
#pragma unroll
                        for (int j = 0; j < 4; ++j) { v0[j] = 0.5f * v0[j] * (1.0f + erff(v0[j] * 0.70710678f)); v1[j] = 0.5f * v1[j] * (1.0f + erff(v1[j] * 0.70710678f)); } }
                    u32x4 w; w.x = cvt_pk_bf16(v0[0], v0[1]); w.y = cvt_pk_bf16(v0[2], v0[3]); w.z = cvt_pk_bf16(v1[0], v1[1]); w.w = cvt_pk_bf16(v1[2], v1[3]);
                    *(u32x4*)(rowp + bj * HALF) = w; } }
    }
};
template <class Epi, class Sched, bool STAMP = false>
__device__ __forceinline__ void gemm_phase(PG8_LAS unsigned char* lds, const Gemm g, const Sched& S, const Epi& E, unsigned long long* stamps) {
    const int tid = ltid(), wid = __builtin_amdgcn_readfirstlane(tid >> 6), lane = tid & 63, wr = wid >> 2, wc = wid & 3, fr = lane & 15, fq = lane >> 4;
    const int K = g.K, nt = K / BK;
    int ts_lo = 0, ts_hi = 0, nts = 0; const unsigned long long rt_entry = STAMP ? (unsigned long long)wall_clock64() : 0ull;
#define PG8_STAMP() do { if (STAMP && wid == 0 && nts < 64) { const unsigned long long _c = (unsigned long long)clock64(); \
        ts_lo = (lane == nts) ? (int)(unsigned)_c : ts_lo; ts_hi = (lane == nts) ? (int)(unsigned)(_c >> 32) : ts_hi; ++nts; } } while (0)
    PG8_STAMP();
    unsigned voffA[2], voffB[2];
#pragma unroll
    for (int i = 0; i < 2; ++i) { int R, C; stage_rc(tid * 16 + i * 8192, R, C); const int Rb = Epi::PERM ? ((R & ~31) + perm32(R & 31)) : R;
        voffA[i] = (unsigned)(R * K + C) * 2u; voffB[i] = (unsigned)(Rb * K + C) * 2u; }
    const size_t kstep = (size_t)(BK * 2);
    const size_t hstep = (size_t)HALF * K * 2;
    const size_t tstep = 2 * hstep;
    const unsigned ldsw = (unsigned)wid * 1024u;
    const int aoff = lds_byte(wr * 64 + fr, fq * 8), boff = lds_byte(wc * 32 + fr, fq * 8);
#define PG8_SA(b, h) (((b) * 2 + (h)) * HTB)
#define PG8_SB(b, h) ((4 + (b) * 2 + (h)) * HTB)
#define PG8_STAGE(bufoff, gbase, voff) do { _Pragma("unroll") for (int _i = 0; _i < 2; ++_i) \
        __builtin_amdgcn_global_load_lds((const unsigned*)((const char*)(gbase) + (voff)[_i]), (PG8_LAS unsigned*)(lds + (bufoff) + ldsw + _i * 8192), 16, 0, 0); } while (0)
#define PG8_LDA(dst, b, h) do { _Pragma("unroll") for (int m = 0; m < 4; ++m) _Pragma("unroll") for (int k = 0; k < 2; ++k) dst[m][k] = *(const PG8_LAS bf16x8*)(lds + PG8_SA(b, h) + aoff + m * 2048 + k * 1024); } while (0)
#define PG8_LDB(dst, b, h) do { _Pragma("unroll") for (int n = 0; n < 2; ++n) _Pragma("unroll") for (int k = 0; k < 2; ++k) dst[n][k] = *(const PG8_LAS bf16x8*)(lds + PG8_SB(b, h) + boff + n * 2048 + k * 1024); } while (0)
#define PG8_MMA(ai, bj, At, Bt) do { __builtin_amdgcn_s_setprio(1); _Pragma("unroll") for (int m = 0; m < 4; ++m) _Pragma("unroll") for (int n = 0; n < 2; ++n) _Pragma("unroll") for (int k = 0; k < 2; ++k) \
        acc[ai][bj][m][n] = __builtin_amdgcn_mfma_f32_16x16x32_bf16(Bt[n][k], At[m][k], acc[ai][bj][m][n], 0, 0, 0); __builtin_amdgcn_s_setprio(0); } while (0)
#define PG8_WAIT_V(n) asm volatile("s_waitcnt vmcnt(" #n ")" ::: "memory")
#define PG8_WAIT_L(n) asm volatile("s_waitcnt lgkmcnt(" #n ")" ::: "memory")
#define PG8_BAR __builtin_amdgcn_s_barrier()
#define PG8_SCHED __builtin_amdgcn_sched_barrier(0)
    Unit cur, nxt; int ui = 0;
    if (!S.next(0, cur)) return;
    f32x4 acc[2][2][4][2];
#pragma unroll
    for (int a = 0; a < 2; ++a)
#pragma unroll
        for (int b = 0; b < 2; ++b)
#pragma unroll
            for (int m = 0; m < 4; ++m)
#pragma unroll
                for (int n = 0; n < 2; ++n) acc[a][b][m][n] = (f32x4){0.f, 0.f, 0.f, 0.f};
    bf16x8 At[4][2], B0[2][2], B1[2][2];
    const char* cA = (const char*)g.A + (size_t)cur.pm * tstep; const char* cB = (const char*)g.Bt + (size_t)cur.pn * tstep;
    S.a_ready(cur);
    PG8_STAGE(PG8_SB(0, 0), cB, voffB); PG8_STAGE(PG8_SA(0, 0), cA, voffA); PG8_STAGE(PG8_SB(0, 1), cB + hstep, voffB); PG8_STAGE(PG8_SA(0, 1), cA + hstep, voffA);
    if (wr == 1) PG8_BAR;
    PG8_WAIT_V(4); PG8_BAR;
    PG8_STAGE(PG8_SB(1, 0), cB + kstep, voffB); PG8_STAGE(PG8_SA(1, 0), cA + kstep, voffA); PG8_STAGE(PG8_SB(1, 1), cB + hstep + kstep, voffB);
    PG8_WAIT_V(6); PG8_BAR;
    PG8_STAMP();
    for (;;) {
        const bool has_next = S.next(ui + 1, nxt);
        const char* nA = has_next ? (const char*)g.A + (size_t)nxt.pm * tstep : cA; const char* nB = has_next ? (const char*)g.Bt + (size_t)nxt.pn * tstep : cB;
        for (int t = 0; t < nt; t += 2) {
            const bool last = (t == nt - 2);
            const char* a1 = cA + (size_t)(t + 1) * kstep;
            const char* a2 = last ? nA : cA + (size_t)(t + 2) * kstep; const char* b2 = last ? nB : cB + (size_t)(t + 2) * kstep;
            const char* a3 = a2 + kstep; const char* b3 = b2 + kstep;
            if (last && has_next) S.a_ready(nxt);
            PG8_LDB(B0, 0, 0); PG8_SCHED; PG8_LDA(At, 0, 0); PG8_STAGE(PG8_SA(1, 1), a1 + hstep, voffA);
            PG8_WAIT_L(8); PG8_BAR; PG8_WAIT_L(0); PG8_MMA(0, 0, At, B0); PG8_BAR; PG8_SCHED;
            PG8_LDB(B1, 0, 1); PG8_STAGE(PG8_SB(0, 0), b2, voffB);
            PG8_BAR; PG8_WAIT_L(0); PG8_MMA(0, 1, At, B1); PG8_BAR;
            PG8_LDA(At, 0, 1); PG8_STAGE(PG8_SA(0, 0), a2, voffA);
            PG8_BAR; PG8_WAIT_L(0); PG8_MMA(1, 0, At, B0); PG8_BAR; PG8_SCHED;
            PG8_STAGE(PG8_SB(0, 1), b2 + hstep, voffB);
            PG8_WAIT_V(6); PG8_BAR; PG8_MMA(1, 1, At, B1); PG8_BAR;
            PG8_LDB(B0, 1, 0); PG8_SCHED; PG8_LDA(At, 1, 0); PG8_STAGE(PG8_SA(0, 1), a2 + hstep, voffA);
            PG8_WAIT_L(8); PG8_BAR; PG8_WAIT_L(0); PG8_MMA(0, 0, At, B0); PG8_BAR; PG8_SCHED;
            PG8_LDB(B1, 1, 1); PG8_STAGE(PG8_SB(1, 0), b3, voffB);
            PG8_BAR; PG8_WAIT_L(0); PG8_MMA(0, 1, At, B1); PG8_BAR;
            PG8_LDA(At, 1, 1); PG8_STAGE(PG8_SA(1, 0), a3, voffA);
            PG8_BAR; PG8_WAIT_L(0); PG8_MMA(1, 0, At, B0); PG8_BAR; PG8_SCHED;
            PG8_STAGE(PG8_SB(1, 1), b3 + hstep, voffB);
            PG8_WAIT_V(6); PG8_BAR; PG8_MMA(1, 1, At, B1); PG8_BAR;
        }
        PG8_STAMP();
        if constexpr (!Epi::AFTER_DRAIN) { E(acc, cur, wr, wc, fr, fq); S.done(cur); }
        PG8_STAMP();
        if (!has_next) break;
#pragma unroll
        for (int a = 0; a < 2; ++a)
#pragma unroll
            for (int b = 0; b < 2; ++b)
#pragma unroll
                for (int m = 0; m < 4; ++m)
#pragma unroll
                    for (int n = 0; n < 2; ++n) acc[a][b][m][n] = (f32x4){0.f, 0.f, 0.f, 0.f};
        cur = nxt; cA = nA; cB = nB; ++ui;
    }
    PG8_WAIT_V(0);
    if (wr == 0) PG8_BAR;
    PG8_BAR;
    if constexpr (Epi::AFTER_DRAIN) { E.fused(acc, cur, wr, wc, fr, fq, lds, wid, lane); S.done(cur); }
    PG8_STAMP();
    if (STAMP && wid == 0) { stamps[lane] = lane < nts ? (((unsigned long long)(unsigned)ts_hi << 32) | (unsigned)ts_lo) : 0ull;
        if (lane == 62) stamps[62] = rt_entry; if (lane == 63) stamps[63] = (unsigned long long)wall_clock64(); }
#undef PG8_STAMP
#undef PG8_SA
#undef PG8_SB
#undef PG8_STAGE
#undef PG8_LDA
#undef PG8_LDB
#undef PG8_MMA
#undef PG8_WAIT_V
#undef PG8_WAIT_L
#undef PG8_BAR
#undef PG8_SCHED
}
}

DI void st_transpose(const float* __restrict__ src, bf16_t* __restrict__ dst, int K, int N, int Kpad, int Npad, float* lds, int bid, int nb) {
  const int tk = Kpad / 64, tn = Npad / 64;
  for (int it = bid; it < tk * tn; it += nb) {
    const int k0 = (it % tk) * 64, n0 = (it / tk) * 64;
    __syncthreads();
    for (int e = ltid(); e < 4096; e += NTHR) { const int i = e >> 6, j = e & 63, k = k0 + i, n = n0 + j; lds[i * 65 + j] = (k < K && n < N) ? src[(size_t)k * N + n] : 0.f; }
    __syncthreads();
    { const int e = ltid(), j = e >> 3, i8 = (e & 7) * 8; u32x4 w;
      w.x = pack2(lds[i8 * 65 + j], lds[(i8 + 1) * 65 + j]); w.y = pack2(lds[(i8 + 2) * 65 + j], lds[(i8 + 3) * 65 + j]);
      w.z = pack2(lds[(i8 + 4) * 65 + j], lds[(i8 + 5) * 65 + j]); w.w = pack2(lds[(i8 + 6) * 65 + j], lds[(i8 + 7) * 65 + j]);
      *(u32x4*)(dst + (size_t)(n0 + j) * Kpad + k0 + i8) = w; }
  }
}

DI void st_mods(const Prm& p, float* lds, int bid, int nb) {
  float* s = lds; float* red = lds + 9 * 2048;
  for (int e = ltid(); e < 9 * 2048; e += NTHR) { const int r = e >> 11, k = e & 2047; const float v = r < 8 ? p.c[r * 2048 + k] : p.c_ctx[k]; s[e] = siluf(v); }
  __syncthreads();
  const int kg = ltid() >> 6, cl = ltid() & 63;
  for (int it = bid; it < 2 * 192; it += nb) {
    const int l = it / 192, cb = (it % 192) * 64;
    const float* w = p.w_ada + (size_t)l * 2048 * NMOD + cb + cl;
    float acc[9];
#pragma unroll
    for (int r = 0; r < 9; ++r) acc[r] = 0.f;
    for (int k = kg * 256; k < kg * 256 + 256; ++k) { const float wv = w[(size_t)k * NMOD];
#pragma unroll
      for (int r = 0; r < 9; ++r) acc[r] += s[r * 2048 + k] * wv; }
#pragma unroll
    for (int r = 0; r < 9; ++r) red[(kg * 9 + r) * 64 + cl] = acc[r];
    __syncthreads();
    for (int e = ltid(); e < 576; e += NTHR) { const int r = e >> 6, c2 = e & 63; float t = 0.f;
      for (int g = 0; g < 8; ++g) t += red[(g * 9 + r) * 64 + c2];
      p.mod[((size_t)l * 9 + r) * NMOD + cb + c2] = t + p.b_ada[l * NMOD + cb + c2]; }
    __syncthreads();
  }
}

DI void st_tables(const Prm& p, int bid, int nb) {
  const size_t stride = (size_t)nb * NTHR, t0 = (size_t)bid * NTHR + ltid();
  for (size_t e = t0; e < (size_t)256 * 512; e += stride) { const int k1 = (int)(e >> 9), n = (int)(e & 511), n1 = n & 255, idx = (k1 * n1) & 255;
    float sv, cv; sincosf((float)idx * (6.283185307179586f / 256.f), &sv, &cv); p.DFTC[e] = f2bf((n < 256 ? cv : -sv) * (1.f / 16.f)); }
  for (size_t e = t0; e < (size_t)2 * 128 * 128; e += stride) { const int tb = (int)(e >> 14), k2 = (int)((e >> 7) & 127), n2 = (int)(e & 127), idx = (k2 * n2) & 127;
    float sv, cv; sincosf((float)idx * (6.283185307179586f / 128.f), &sv, &cv); p.CCS[e] = (tb ? sv : cv) * 0.08838834764831845f; }
}

DI void st_modulate(const Prm& p, int layer, int which, bf16_t* __restrict__ dst, int bid, int nb) {
  const int wave = ltid() >> 6, lane = ltid() & 63;
  const int shoff = which ? 3 * DM : 0, scoff = which ? 4 * DM : DM;
  for (int row = bid * 8 + wave; row < MR; row += nb * 8) {
    const int b = row / LT, t = row - b * LT; const bool isc = t >= LL;
    if (isc && layer == 1 && which == 1) continue;
    const float* src = (layer == 0 && which == 0) ? (isc ? p.ctx + (size_t)(b * LCX + t - LL) * DM : p.x + (size_t)(b * LL + t) * DM) : p.X + (size_t)row * DM;
    f32x4 v[8]; float ss = 0.f;
#pragma unroll
    for (int i = 0; i < 8; ++i) { v[i] = *(const f32x4*)(src + (i * 64 + lane) * 4); ss += v[i][0] * v[i][0] + v[i][1] * v[i][1] + v[i][2] * v[i][2] + v[i][3] * v[i][3]; }
    ss = wsum(ss); const float rstd = rsqrtf(ss * (1.f / 2048.f) + EPSV);
    const float* mr = p.mod + ((size_t)layer * 9 + (isc ? 8 : b)) * NMOD;
#pragma unroll
    for (int i = 0; i < 8; ++i) { const int col = (i * 64 + lane) * 4; const f32x4 sc = *(const f32x4*)(mr + scoff + col), sh = *(const f32x4*)(mr + shoff + col);
      const f32x4 o = v[i] * rstd * (sc + 1.f) + sh; u32x2 w; w.x = pack2(o[0], o[1]); w.y = pack2(o[2], o[3]); *(u32x2*)(dst + (size_t)row * DM + col) = w; }
  }
}

DI void st_dnprep(const Prm& p, int layer, int bid, int nb) {
  const int wave = ltid() >> 6, lane = ltid() & 63;
  const float* conv = p.dn_conv + (size_t)layer * 5 * 1536;
  for (int task = bid * 8 + wave; task < (MR / 32) * 13; task += nb * 8) {
    const int tile = task / 13, grp = task - tile * 13, row0 = tile * 32;
    const int b = row0 / LT, t0 = row0 - b * LT; const bool isc = t0 >= LL;
    const int segt0 = isc ? t0 - LL : t0, seglen = isc ? LCX : LL;
    if (grp < 12) {
      const int c = grp * 128 + lane * 2;
      float w0[5], w1[5];
#pragma unroll
      for (int j = 0; j < 5; ++j) { w0[j] = conv[j * 1536 + c]; w1[j] = conv[j * 1536 + c + 1]; }
      unsigned zz[36];
#pragma unroll
      for (int r = 0; r < 36; ++r) { const int tt = segt0 + r - 2; zz[r] = (tt >= 0 && tt < seglen) ? *(const unsigned*)(p.Z + (size_t)(row0 + r - 2) * NZ + c) : 0u; }
#pragma unroll
      for (int r = 0; r < 32; ++r) { float a0 = 0.f, a1 = 0.f;
#pragma unroll
        for (int j = 0; j < 5; ++j) { a0 += __uint_as_float(zz[r + j] << 16) * w0[j]; a1 += __uint_as_float(zz[r + j] & 0xffff0000u) * w1[j]; }
        a0 = siluf(a0); a1 = siluf(a1);
        if (grp < 8) { const float ss = wsum(a0 * a0 + a1 * a1); const float sc = rsqrtf(ss + EPSV) * (grp < 4 ? 0.08838834764831845f : 1.f); a0 *= sc; a1 *= sc; }
        *(unsigned*)(p.DNQ + (size_t)(row0 + r) * 1536 + c) = pack2(a0, a1); }
    } else {
#pragma unroll
      for (int rr = 0; rr < 8; ++rr) { const int idx = lane + 64 * rr, row = row0 + (idx >> 4), wh = idx & 15, isb = wh >> 3, dh = wh & 7;
        const float z = bf2f(p.Z[(size_t)row * NZ + (isb ? C_DNB : C_DNA) + dh]); float o;
        if (!isb) { const float xx = z + p.dn_dt_bias[layer * 8 + dh]; const float sp = xx > 20.f ? xx : log1pf(expf(xx)); o = -expf(p.dn_a_log[layer * 8 + dh]) * sp; }
        else o = sigmf(z);
        p.GB[(size_t)row * 16 + wh] = o; }
    }
  }
}

DI void st_mlaprep(const Prm& p, int layer, int bid, int nb) {
  const int wave = ltid() >> 6, lane = ltid() & 63;
  const float* qn = p.mla_q_norm + layer * 448; const float* kvn = p.mla_kv_norm + layer * 128;
  for (int row = bid * 8 + wave; row < MR; row += nb * 8) {
    const bf16_t* z = p.Z + (size_t)row * NZ; const int b = row / LT, t = row - b * LT;
    float v[8]; float ss = 0.f;
#pragma unroll
    for (int k = 0; k < 8; ++k) v[k] = 0.f;
    if (lane < 56) { const u32x4 w = *(const u32x4*)(z + C_CQ + lane * 8);
#pragma unroll
      for (int k = 0; k < 4; ++k) { v[2 * k] = __uint_as_float(w[k] << 16); v[2 * k + 1] = __uint_as_float(w[k] & 0xffff0000u); ss += v[2 * k] * v[2 * k] + v[2 * k + 1] * v[2 * k + 1]; } }
    ss = wsum(ss); float rstd = rsqrtf(ss * (1.f / 448.f) + EPSV);
    { u32x4 o = {0u, 0u, 0u, 0u};
      if (lane < 56) { const f32x4 n0 = *(const f32x4*)(qn + lane * 8), n1 = *(const f32x4*)(qn + lane * 8 + 4);
        o.x = pack2(v[0] * rstd * n0[0], v[1] * rstd * n0[1]); o.y = pack2(v[2] * rstd * n0[2], v[3] * rstd * n0[3]); o.z = pack2(v[4] * rstd * n1[0], v[5] * rstd * n1[1]); o.w = pack2(v[6] * rstd * n1[2], v[7] * rstd * n1[3]); }
      *(u32x4*)(p.Aq + (size_t)row * 512 + lane * 8) = o; }
    ss = 0.f;
    if (lane < 16) { const u32x4 w = *(const u32x4*)(z + C_CKV + lane * 8);
#pragma unroll
      for (int k = 0; k < 4; ++k) { v[2 * k] = __uint_as_float(w[k] << 16); v[2 * k + 1] = __uint_as_float(w[k] & 0xffff0000u); ss += v[2 * k] * v[2 * k] + v[2 * k + 1] * v[2 * k + 1]; } }
    ss = wsum(ss); rstd = rsqrtf(ss * (1.f / 128.f) + EPSV);
    if (lane < 32) { u32x4 o = {0u, 0u, 0u, 0u};
      if (lane < 16) { const f32x4 n0 = *(const f32x4*)(kvn + lane * 8), n1 = *(const f32x4*)(kvn + lane * 8 + 4);
        o.x = pack2(v[0] * rstd * n0[0], v[1] * rstd * n0[1]); o.y = pack2(v[2] * rstd * n0[2], v[3] * rstd * n0[3]); o.z = pack2(v[4] * rstd * n1[0], v[5] * rstd * n1[1]); o.w = pack2(v[6] * rstd * n1[2], v[7] * rstd * n1[3]); }
      *(u32x4*)(p.Akv + (size_t)row * 256 + lane * 8) = o; }
    if (t < LL) {
      if (lane < 32) { const int half = lane >> 4, i = lane & 15; const float x1 = bf2f(z[C_KR + half * 32 + i]), x2 = bf2f(z[C_KR + half * 32 + 16 + i]);
        const float pos = (float)(half ? (t & 63) : (t >> 6)); const float ang = pos * exp2f(-(float)i * (13.287712379549449f / 16.f)); float sv, cv; sincosf(ang, &sv, &cv);
        p.KR[(size_t)row * 64 + half * 32 + i] = f2bf(x1 * cv - x2 * sv); p.KR[(size_t)row * 64 + half * 32 + 16 + i] = f2bf(x2 * cv + x1 * sv); }
    } else p.KR[(size_t)row * 64 + lane] = z[C_KR + lane];
  }
}

DI void st_qrope(const Prm& p, int bid, int nb) {
  const int wave = ltid() >> 6, lane = ltid() & 63;
  for (int row = bid * 8 + wave; row < MR; row += nb * 8) {
    const int b = row / LT, t = row - b * LT; if (t >= LL) continue;
#pragma unroll
    for (int k = 0; k < 2; ++k) { const int pid = lane + 64 * k, h = pid >> 5, r = pid & 31, half = r >> 4, i = r & 15;
      bf16_t* q = p.Qraw + (size_t)row * 768 + h * 192 + 128 + half * 32; const float x1 = bf2f(q[i]), x2 = bf2f(q[16 + i]);
      const float pos = (float)(half ? (t & 63) : (t >> 6)); const float ang = pos * exp2f(-(float)i * (13.287712379549449f / 16.f)); float sv, cv; sincosf(ang, &sv, &cv);
      q[i] = f2bf(x1 * cv - x2 * sv); q[16 + i] = f2bf(x2 * cv + x1 * sv); }
  }
}

DI void st_fnchan(const Prm& p, unsigned char* lds, int bid, int nb) {
  bf16_t* wt = (bf16_t*)lds;
  bf16_t* zt = (bf16_t*)(lds + 256 * 272);
  const int tid = ltid(), wave = tid >> 6, lane = tid & 63, r32 = lane & 31, hi = lane >> 5;
  __syncthreads();
  for (int e = tid; e < 256 * 128; e += NTHR) wt[(e >> 7) * 136 + (e & 127)] = f2bf(p.CCS[e]);
  for (int it = bid; it < (MR / 64) * 4; it += nb) {
    const int tile = it >> 2, g = it & 3, b = tile / 68, tb2 = tile - b * 68; const bool lat = tb2 < 64;
    __syncthreads();
    for (int e = tid; e < 1024; e += NTHR) { const int r = e >> 4, c8 = (e & 15) * 8; const int row = b * LT + (lat ? 64 * r + tb2 : LL + (tb2 - 64) * 64 + r);
      *(u32x4*)(zt + r * 136 + c8) = *(const u32x4*)(p.Z + (size_t)row * NZ + C_FN + g * 128 + c8); }
    __syncthreads();
    f32x16 acc[2] = {};
#pragma unroll
    for (int k8 = 0; k8 < 8; ++k8) { const bf16x8 a = *(const bf16x8*)(wt + (wave * 32 + r32) * 136 + k8 * 16 + hi * 8);
#pragma unroll
      for (int tt = 0; tt < 2; ++tt) { const bf16x8 bb = *(const bf16x8*)(zt + (tt * 32 + r32) * 136 + k8 * 16 + hi * 8); acc[tt] = __builtin_amdgcn_mfma_f32_32x32x16_bf16(a, bb, acc[tt], 0, 0, 0); } }
    const int tb = wave >> 2;
#pragma unroll
    for (int tt = 0; tt < 2; ++tt)
#pragma unroll
      for (int r = 0; r < 16; ++r) { const int k2 = (wave & 3) * 32 + (r & 3) + 8 * (r >> 2) + 4 * hi;
        if (lat) p.PQT[(((size_t)(b * 512 + g * 128 + k2)) * 64 + tb2) * 128 + tb * 64 + tt * 32 + r32] = f2bf(acc[tt][r]);
        else p.PQTc[((size_t)(b * 512 + g * 128 + k2)) * 512 + tb * 256 + (tb2 - 64) * 64 + tt * 32 + r32] = f2bf(acc[tt][r]); }
  }
}

DI void st_fnfft(const Prm& p, unsigned char* lds, int bid, int nb) {
  bf16_t* M1 = (bf16_t*)lds;
  bf16_t* M2c = M1 + 128 * 136; bf16_t* M2s = M2c + 64 * 72;
  f32x2* TW = (f32x2*)(lds + (128 * 136 + 2 * 64 * 72) * 2);
  bf16_t* OUTB = (bf16_t*)(lds + (128 * 136 + 2 * 64 * 72) * 2 + 32768);
  const int tid = ltid(), wave = tid >> 6, lane = tid & 63, r32 = lane & 31, hi = lane >> 5;
  __syncthreads();
  for (int e = tid; e < 128 * 128; e += NTHR) { const int j = e >> 7, k = e & 127, ri = j >> 6, cc = j & 63, pq = k >> 6, a = k & 63; float sv, cv; sincosf((float)((cc * a) & 63) * (6.283185307179586f / 64.f), &sv, &cv);
    const float v = ri == 0 ? (pq == 0 ? cv : -sv) : (pq == 0 ? -sv : -cv); M1[j * 136 + k] = f2bf(v * 0.125f); }
  for (int e = tid; e < 64 * 64; e += NTHR) { const int d = e >> 6, bp = e & 63; float sv, cv; sincosf((float)((d * bp) & 63) * (6.283185307179586f / 64.f), &sv, &cv); M2c[d * 72 + bp] = f2bf(cv * 0.125f); M2s[d * 72 + bp] = f2bf(sv * 0.125f); }
  for (int e = tid; e < 4096; e += NTHR) { float sv, cv; sincosf((float)e * (6.283185307179586f / 4096.f), &sv, &cv); TW[e] = (f32x2){cv, sv}; }
  __syncthreads();
  for (int item = bid * 8 + wave; item < NB * 512; item += nb * 8) {
    const int b = item >> 9, col = item & 511;
    const bf16_t* src = p.PQT + (size_t)item * 64 * 128;
    bf16_t* yo8 = p.Y + (size_t)b * LT * DM + 1536 + (col & ~7);
#pragma unroll 1
    for (int ct = 0; ct < 2; ++ct) {
      f32x16 tr0 = {}, tr1 = {}, ti0 = {}, ti1 = {};
#pragma unroll
      for (int ks = 0; ks < 8; ++ks) { const bf16x8 a0 = *(const bf16x8*)(src + r32 * 128 + ks * 16 + hi * 8), a1 = *(const bf16x8*)(src + (32 + r32) * 128 + ks * 16 + hi * 8);
        const bf16x8 br = *(const bf16x8*)(M1 + (ct * 32 + r32) * 136 + ks * 16 + hi * 8), bi = *(const bf16x8*)(M1 + ((2 + ct) * 32 + r32) * 136 + ks * 16 + hi * 8);
        tr0 = __builtin_amdgcn_mfma_f32_32x32x16_bf16(a0, br, tr0, 0, 0, 0); tr1 = __builtin_amdgcn_mfma_f32_32x32x16_bf16(a1, br, tr1, 0, 0, 0);
        ti0 = __builtin_amdgcn_mfma_f32_32x32x16_bf16(a0, bi, ti0, 0, 0, 0); ti1 = __builtin_amdgcn_mfma_f32_32x32x16_bf16(a1, bi, ti1, 0, 0, 0); }
      __builtin_amdgcn_sched_barrier(0);
      const int cc = ct * 32 + r32;
#pragma unroll
      for (int r = 0; r < 16; ++r) { const int bl = (r & 3) + 8 * (r >> 2) + 4 * hi; const f32x2 w0 = TW[(cc * bl) & 4095], w1 = TW[(cc * (32 + bl)) & 4095];
        const float a = tr0[r], bq = ti0[r]; tr0[r] = a * w0[0] + bq * w0[1]; ti0[r] = bq * w0[0] - a * w0[1];
        const float c2 = tr1[r], d2 = ti1[r]; tr1[r] = c2 * w1[0] + d2 * w1[1]; ti1[r] = d2 * w1[0] - c2 * w1[1]; }
      __builtin_amdgcn_sched_barrier(0);
      f32x16 y0 = {}, y1 = {};
#define FFT_S2(XT, M2, BT) do { _Pragma("unroll") for (int s = 0; s < 2; ++s) { \
          u32x4 pk; pk.x = pack2(XT[8 * s], XT[8 * s + 1]); pk.y = pack2(XT[8 * s + 2], XT[8 * s + 3]); pk.z = pack2(XT[8 * s + 4], XT[8 * s + 5]); pk.w = pack2(XT[8 * s + 6], XT[8 * s + 7]); \
          const bf16x8 xs = __builtin_bit_cast(bf16x8, pk); \
          const bf16_t* ap0 = (M2) + r32 * 72 + (BT) * 32 + 16 * s + 4 * hi; const bf16_t* ap1 = ap0 + 32 * 72; \
          const s16x4 l0 = *(const s16x4*)ap0, h0 = *(const s16x4*)(ap0 + 8), l1 = *(const s16x4*)ap1, h1 = *(const s16x4*)(ap1 + 8); \
          y0 = __builtin_amdgcn_mfma_f32_32x32x16_bf16((bf16x8){l0[0], l0[1], l0[2], l0[3], h0[0], h0[1], h0[2], h0[3]}, xs, y0, 0, 0, 0); \
          y1 = __builtin_amdgcn_mfma_f32_32x32x16_bf16((bf16x8){l1[0], l1[1], l1[2], l1[3], h1[0], h1[1], h1[2], h1[3]}, xs, y1, 0, 0, 0); } } while (0)
      FFT_S2(tr0, M2c, 0); __builtin_amdgcn_sched_barrier(0); FFT_S2(tr1, M2c, 1); __builtin_amdgcn_sched_barrier(0); FFT_S2(ti0, M2s, 0); __builtin_amdgcn_sched_barrier(0); FFT_S2(ti1, M2s, 1); __builtin_amdgcn_sched_barrier(0);
#undef FFT_S2
      __syncthreads();
#pragma unroll
      for (int r = 0; r < 16; ++r) { const int dl = (r & 3) + 8 * (r >> 2) + 4 * hi; OUTB[(dl * 32 + r32) * 8 + wave] = f2bf(y0[r]); OUTB[((32 + dl) * 32 + r32) * 8 + wave] = f2bf(y1[r]); }
      __syncthreads();
#pragma unroll
      for (int q = 0; q < 4; ++q) { const int rr = tid + NTHR * q, d = rr >> 5, ccl = rr & 31; *(u32x4*)(yo8 + (size_t)(ct * 32 + ccl + 64 * d) * DM) = *(const u32x4*)(OUTB + rr * 8); }
    }
  }
}

DI int scan_row(int b, int dir, int s) { return s < LCX ? b * LT + LL + (dir ? LCX - 1 - s : s) : b * LT + (dir ? LL - 1 - (s - LCX) : (s - LCX)); }

DI void st_dntinv(const Prm& p, unsigned char* lds, int bid, int nb) {
  const int tid = ltid(), wave = tid >> 6, lane = tid & 63, r32 = lane & 31, hi = lane >> 5;
  float* Ab = (float*)lds + wave * 4096;
  float* gcb = (float*)(lds + 131072) + wave * 128; float* btb = gcb + 64;
  for (int item = bid * 8 + wave; item < 64 * 68; item += nb * 8) {
    const int chain = item / 68, n = item - chain * 68, b = chain >> 3, h = (chain >> 1) & 3, dir = chain & 1;
    const int myrow = scan_row(b, dir, n * 64 + lane);
    const float g = p.GB[(size_t)myrow * 16 + dir * 4 + h], bt = p.GB[(size_t)myrow * 16 + 8 + dir * 4 + h];
    gcb[lane] = g; btb[lane] = bt;
    bf16x8 kf[2][8];
#pragma unroll
    for (int tt = 0; tt < 2; ++tt) { const int row = scan_row(b, dir, n * 64 + tt * 32 + r32);
#pragma unroll
      for (int ks = 0; ks < 8; ++ks) kf[tt][ks] = *(const bf16x8*)(p.DNQ + (size_t)row * 1536 + 512 + h * 128 + ks * 16 + hi * 8); }
    __builtin_amdgcn_wave_barrier();
    float gc = 0.f;
    for (int e = 0; e < 64; ++e) { const float ge = gcb[e]; gc += (e <= lane) ? ge : 0.f; }
    __builtin_amdgcn_wave_barrier();
    gcb[lane] = gc; p.GCB[(size_t)item * 64 + lane] = gc;
    __builtin_amdgcn_wave_barrier();
    f32x16 a00 = {}, a10 = {}, a11 = {};
#pragma unroll
    for (int ks = 0; ks < 8; ++ks) { a00 = __builtin_amdgcn_mfma_f32_32x32x16_bf16(kf[0][ks], kf[0][ks], a00, 0, 0, 0);
      a10 = __builtin_amdgcn_mfma_f32_32x32x16_bf16(kf[1][ks], kf[0][ks], a10, 0, 0, 0); a11 = __builtin_amdgcn_mfma_f32_32x32x16_bf16(kf[1][ks], kf[1][ks], a11, 0, 0, 0); }
    { const float gce0 = gcb[r32], gce1 = gcb[32 + r32];
#pragma unroll
      for (int r = 0; r < 16; ++r) { const int cl = (r & 3) + 8 * (r >> 2) + 4 * hi; const float gc0 = gcb[cl], bt0 = btb[cl], gc1 = gcb[32 + cl], bt1 = btb[32 + cl];
        Ab[cl * 64 + r32] = (r32 < cl) ? bt0 * a00[r] * __expf(gc0 - gce0) : 0.f;
        Ab[cl * 64 + 32 + r32] = 0.f;
        Ab[(32 + cl) * 64 + r32] = bt1 * a10[r] * __expf(gc1 - gce0);
        Ab[(32 + cl) * 64 + 32 + r32] = (r32 < cl) ? bt1 * a11[r] * __expf(gc1 - gce1) : 0.f; } }
    __builtin_amdgcn_wave_barrier();
    float x[64];
    bf16_t* to = p.TINV + (size_t)item * 4096 + lane;
#pragma unroll
    for (int c = 0; c < 64; ++c) { float s = (c == lane) ? 1.f : 0.f;
#pragma unroll
      for (int e4 = 0; e4 < (c + 3) / 4; ++e4) { const f32x4 av = *(const f32x4*)(Ab + c * 64 + e4 * 4);
#pragma unroll
        for (int i = 0; i < 4; ++i) if (e4 * 4 + i < c) s -= av[i] * x[e4 * 4 + i]; }
      x[c] = s; to[c * 64] = f2bf(s); }
    __builtin_amdgcn_wave_barrier();
  }
}

DI void st_dnscan(const Prm& p, unsigned char* lds, int bid, int nb) {
  constexpr int PK = 136, PB = 72;
  bf16_t* Qs = (bf16_t*)lds; bf16_t* Ks = Qs + 64 * PK; bf16_t* SB = Ks + 64 * PK; bf16_t* KDT = SB + 64 * PK; bf16_t* TI = KDT + 128 * PB; bf16_t* RT = TI + 64 * PB; bf16_t* VNT = RT + 64 * PB;
  bf16_t* PL = VNT + 64 * PB; bf16_t* Vs = PL + 64 * PB; float* gcs = (float*)(Vs + 64 * PB); float* bts = gcs + 64; float* egs = bts + 64;
  const int tid = ltid(), wave = tid >> 6, lane = tid & 63, r32 = lane & 31, hi = lane >> 5;
  for (int item = bid; item < 128; item += nb) {
    const int chain = item >> 1, half = item & 1, b = chain >> 3, h = (chain >> 1) & 3, dir = chain & 1;
    f32x16 accS = {};
    __syncthreads();
    for (int e = tid; e < 64 * PK; e += NTHR) SB[e] = 0;
    bf16x8 pf[6]; float pgc = 0.f, pbt = 0.f;
    auto gload = [&](int n) {
      const size_t ci = (size_t)chain * 68 + n;
#pragma unroll
      for (int r = 0; r < 6; ++r) { const int e = tid + NTHR * r;
        if (e < 2048) { const int ee = e & 1023, t = ee >> 4, c8 = ee & 15; const int row = scan_row(b, dir, n * 64 + t); pf[r] = *(const bf16x8*)(p.DNQ + (size_t)row * 1536 + (e < 1024 ? 0 : 512) + h * 128 + c8 * 8); }
        else if (e < 2560) { const int ee = e - 2048, t = ee >> 3, c8 = ee & 7; const int row = scan_row(b, dir, n * 64 + t); pf[r] = *(const bf16x8*)(p.DNQ + (size_t)row * 1536 + 1024 + h * 128 + half * 64 + c8 * 8); }
        else { const int ee = e - 2560; pf[r] = *(const bf16x8*)(p.TINV + ci * 4096 + ee * 8); } }
      if (tid < 64) { pgc = p.GCB[ci * 64 + tid]; const int row = scan_row(b, dir, n * 64 + tid); pbt = p.GB[(size_t)row * 16 + 8 + dir * 4 + h]; }
    };
    gload(0);
    for (int n = 0; n < LT / 64; ++n) {
      if (tid < 64) { gcs[tid] = pgc; bts[tid] = pbt; egs[tid] = __expf(pgc); }
      __syncthreads();
      const float gl = gcs[63];
#pragma unroll
      for (int r = 0; r < 6; ++r) { const int e = tid + NTHR * r;
        if (e < 1024) { const int t = e >> 4, c8 = e & 15; *(bf16x8*)(Qs + t * PK + c8 * 8) = pf[r]; }
        else if (e < 2048) { const int ee = e - 1024, t = ee >> 4, c8 = ee & 15; *(bf16x8*)(Ks + t * PK + c8 * 8) = pf[r]; const float sc = __expf(gl - gcs[t]);
#pragma unroll
          for (int j = 0; j < 8; ++j) KDT[(c8 * 8 + j) * PB + t] = f2bf(bf2f((bf16_t)pf[r][j]) * sc); }
        else if (e < 2560) { const int ee = e - 2048, t = ee >> 3, c8 = ee & 7; *(bf16x8*)(Vs + t * PB + c8 * 8) = pf[r]; }
        else { const int ee = e - 2560, c = ee >> 3, c8 = ee & 7; *(bf16x8*)(TI + c * PB + c8 * 8) = pf[r]; } }
      if (n + 1 < LT / 64) gload(n + 1);
      __syncthreads();
      f32x16 accO = {};
      if (wave < 4) { const int et = wave >> 1, jt = wave & 1; f32x16 a1 = {};
#pragma unroll
        for (int k8 = 0; k8 < 8; ++k8) { const bf16x8 av = *(const bf16x8*)(Ks + (et * 32 + r32) * PK + k8 * 16 + hi * 8), bv = *(const bf16x8*)(SB + (jt * 32 + r32) * PK + k8 * 16 + hi * 8);
          a1 = __builtin_amdgcn_mfma_f32_32x32x16_bf16(av, bv, a1, 0, 0, 0); }
        const int j = jt * 32 + r32;
#pragma unroll
        for (int g = 0; g < 4; ++g) { const int e0 = et * 32 + 8 * g + 4 * hi; float rv[4];
#pragma unroll
          for (int i = 0; i < 4; ++i) rv[i] = bts[e0 + i] * (bf2f(Vs[(e0 + i) * PB + j]) - egs[e0 + i] * a1[4 * g + i]);
          u32x2 w; w.x = pack2(rv[0], rv[1]); w.y = pack2(rv[2], rv[3]); *(u32x2*)(RT + j * PB + e0) = w; } }
      else {
        if (wave < 7) { const int et = wave == 6 ? 1 : 0, ct = wave == 4 ? 0 : 1; f32x16 a2 = {};
#pragma unroll
          for (int k8 = 0; k8 < 8; ++k8) { const bf16x8 av = *(const bf16x8*)(Ks + (et * 32 + r32) * PK + k8 * 16 + hi * 8), bv = *(const bf16x8*)(Qs + (ct * 32 + r32) * PK + k8 * 16 + hi * 8);
            a2 = __builtin_amdgcn_mfma_f32_32x32x16_bf16(av, bv, a2, 0, 0, 0); }
          const int c = ct * 32 + r32; const float gcc = gcs[c];
#pragma unroll
          for (int g = 0; g < 4; ++g) { const int e0 = et * 32 + 8 * g + 4 * hi; float pv[4];
#pragma unroll
            for (int i = 0; i < 4; ++i) pv[i] = (e0 + i <= c) ? a2[4 * g + i] * __expf(gcc - gcs[e0 + i]) : 0.f;
            u32x2 w; w.x = pack2(pv[0], pv[1]); w.y = pack2(pv[2], pv[3]); *(u32x2*)(PL + c * PB + e0) = w; } }
        else { for (int e = lane; e < 32 * 8; e += 64) { const int c = e >> 3, q4 = (e & 7) * 4; *(u32x2*)(PL + c * PB + 32 + q4) = (u32x2){0u, 0u}; } }
        { const int ct = (wave - 4) >> 1, jt = wave & 1;
#pragma unroll
          for (int k8 = 0; k8 < 8; ++k8) { const bf16x8 av = *(const bf16x8*)(Qs + (ct * 32 + r32) * PK + k8 * 16 + hi * 8), bv = *(const bf16x8*)(SB + (jt * 32 + r32) * PK + k8 * 16 + hi * 8);
            accO = __builtin_amdgcn_mfma_f32_32x32x16_bf16(av, bv, accO, 0, 0, 0); }
#pragma unroll
          for (int r = 0; r < 16; ++r) accO[r] *= egs[ct * 32 + (r & 3) + 8 * (r >> 2) + 4 * hi]; } }
      __syncthreads();
      if (wave < 4) { const int ct = wave >> 1, jt = wave & 1; f32x16 a3 = {};
#pragma unroll
        for (int k8 = 0; k8 < 4; ++k8) { const bf16x8 av = *(const bf16x8*)(TI + (ct * 32 + r32) * PB + k8 * 16 + hi * 8), bv = *(const bf16x8*)(RT + (jt * 32 + r32) * PB + k8 * 16 + hi * 8);
          a3 = __builtin_amdgcn_mfma_f32_32x32x16_bf16(av, bv, a3, 0, 0, 0); }
#pragma unroll
        for (int g = 0; g < 4; ++g) { u32x2 w; w.x = pack2(a3[4 * g], a3[4 * g + 1]); w.y = pack2(a3[4 * g + 2], a3[4 * g + 3]); *(u32x2*)(VNT + (jt * 32 + r32) * PB + ct * 32 + 8 * g + 4 * hi) = w; } }
      __syncthreads();
      if (wave >= 4) { const int ct = (wave - 4) >> 1, jt = wave & 1;
#pragma unroll
        for (int k8 = 0; k8 < 4; ++k8) { const bf16x8 av = *(const bf16x8*)(PL + (ct * 32 + r32) * PB + k8 * 16 + hi * 8), bv = *(const bf16x8*)(VNT + (jt * 32 + r32) * PB + k8 * 16 + hi * 8);
          accO = __builtin_amdgcn_mfma_f32_32x32x16_bf16(av, bv, accO, 0, 0, 0); }
#pragma unroll
        for (int r = 0; r < 16; ++r) { const int c = ct * 32 + (r & 3) + 8 * (r >> 2) + 4 * hi; const int row = scan_row(b, dir, n * 64 + c);
          p.OB[((size_t)(0 * 2 + dir) * MR + row) * 512 + h * 128 + half * 64 + jt * 32 + r32] = f2bf(accO[r]); } }
      { const int dt = wave >> 1, jt = wave & 1; const float egl = __expf(gl);
#pragma unroll
        for (int r = 0; r < 16; ++r) accS[r] *= egl;
#pragma unroll
        for (int k8 = 0; k8 < 4; ++k8) { const bf16x8 av = *(const bf16x8*)(KDT + (dt * 32 + r32) * PB + k8 * 16 + hi * 8), bv = *(const bf16x8*)(VNT + (jt * 32 + r32) * PB + k8 * 16 + hi * 8);
          accS = __builtin_amdgcn_mfma_f32_32x32x16_bf16(av, bv, accS, 0, 0, 0); }
#pragma unroll
        for (int g = 0; g < 4; ++g) { u32x2 w; w.x = pack2(accS[4 * g], accS[4 * g + 1]); w.y = pack2(accS[4 * g + 2], accS[4 * g + 3]);
          *(u32x2*)(SB + (jt * 32 + r32) * PK + dt * 32 + 8 * g + 4 * hi) = w; } }
      __syncthreads();
    }
  }
}

DI void st_glabc(const Prm& p, int layer, unsigned char* lds, int bid, int nb) {
  float* AL = (float*)lds; float* SEG = AL + 1024;
  const int tid = ltid(), seg = tid >> 6, dme = tid & 63;
  for (int item = bid; item < 64 * 68; item += nb) {
    const int chain = item / 68, n = item - chain * 68, b = chain >> 3, h = (chain >> 1) & 3, dir = chain & 1;
    const float* w2 = p.gla_w2 + (size_t)(layer * 2 + dir) * 16 * 256 + h * 64; const float b2r = p.gla_b2[(layer * 2 + dir) * 256 + h * 64 + dme];
    float w2r[16];
#pragma unroll
    for (int r = 0; r < 16; ++r) w2r[r] = w2[r * 256 + dme];
    __syncthreads();
    if (tid < 128) { const int t = tid >> 1, c8 = tid & 1; const int row = scan_row(b, dir, n * 64 + t); const bf16x8 v = *(const bf16x8*)(p.Z + (size_t)row * NZ + C_GALPHA + dir * 16 + c8 * 8);
#pragma unroll
      for (int j = 0; j < 8; ++j) AL[t * 16 + c8 * 8 + j] = bf2f((bf16_t)v[j]); }
    __syncthreads();
    float la[8]; float run = 0.f;
#pragma unroll
    for (int k = 0; k < 8; ++k) { const int t = seg * 8 + k; float zz = b2r;
#pragma unroll
      for (int r = 0; r < 16; ++r) zz += AL[t * 16 + r] * w2r[r];
      const float nz = -zz; const float sp = nz > 20.f ? nz : log1pf(expf(nz)); run += -sp * (1.f / 16.f); la[k] = run; }
    SEG[seg * 64 + dme] = run;
    __syncthreads();
    float pre = 0.f;
#pragma unroll
    for (int s2 = 0; s2 < 8; ++s2) pre += (s2 < seg) ? SEG[s2 * 64 + dme] : 0.f;
#pragma unroll
    for (int k = 0; k < 8; ++k) p.BC[(size_t)item * 4096 + (seg * 8 + k) * 64 + dme] = la[k] + pre;
  }
}

DI void st_glascan(const Prm& p, int layer, unsigned char* lds, int bid, int nb) {
  constexpr int PB = 72;
  bf16_t* QI = (bf16_t*)lds; bf16_t* QR = QI + 64 * PB; bf16_t* KR = QR + 64 * PB; bf16_t* KRT = KR + 64 * PB; bf16_t* VT = KRT + 64 * PB; bf16_t* SB = VT + 64 * PB; bf16_t* PL = SB + 64 * PB;
  float* LA = (float*)(lds + 7 * 64 * PB * 2);
  float* AL = LA + 4096;
  float* SEG = AL + 1024;
  float* EBL = SEG + 512;
  const int tid = ltid(), wave = tid >> 6, lane = tid & 63, r32 = lane & 31, hi = lane >> 5;
  for (int item = bid; item < 128; item += nb) {
    const int chain = item >> 1, half = item & 1, b = chain >> 3, h = (chain >> 1) & 3, dir = chain & 1;
    f32x16 acc = {};
    __syncthreads();
    for (int e = tid; e < 64 * PB; e += NTHR) SB[e] = 0;
    bf16x8 pf[3]; f32x4 pb[2];
    auto gload = [&](int n) {
#pragma unroll
      for (int r = 0; r < 3; ++r) { const int e = tid + NTHR * r; const int t = e / 24, ch = e - t * 24; const int row = scan_row(b, dir, n * 64 + t);
        const int col = ch < 8 ? C_GQ + h * 64 + ch * 8 : (ch < 16 ? C_GK + h * 64 + (ch - 8) * 8 : C_GV + h * 128 + half * 64 + (ch - 16) * 8);
        pf[r] = *(const bf16x8*)(p.Z + (size_t)row * NZ + col); }
#pragma unroll
      for (int r = 0; r < 2; ++r) pb[r] = *(const f32x4*)(p.BC + ((size_t)chain * 68 + n) * 4096 + (tid + NTHR * r) * 4);
    };
    gload(0);
    for (int n = 0; n < LT / 64; ++n) {
#pragma unroll
      for (int r = 0; r < 2; ++r) *(f32x4*)(LA + (tid + NTHR * r) * 4) = pb[r];
      __syncthreads();
      if (tid < 64) EBL[tid] = __expf(LA[63 * 64 + tid]);
#pragma unroll
      for (int r = 0; r < 3; ++r) { const int e = tid + NTHR * r; const int t = e / 24, ch = e - t * 24;
          if (ch < 8) { u32x4 wi, wr; float xi[8], xr[8];
#pragma unroll
            for (int j = 0; j < 8; ++j) { const int d = ch * 8 + j; const float bc = LA[t * 64 + d], bl = LA[63 * 64 + d], q = bf2f((bf16_t)pf[r][j]) * 0.125f; xi[j] = q * __expf(bc); xr[j] = q * __expf(bc - bl); }
            wi.x = pack2(xi[0], xi[1]); wi.y = pack2(xi[2], xi[3]); wi.z = pack2(xi[4], xi[5]); wi.w = pack2(xi[6], xi[7]);
            wr.x = pack2(xr[0], xr[1]); wr.y = pack2(xr[2], xr[3]); wr.z = pack2(xr[4], xr[5]); wr.w = pack2(xr[6], xr[7]);
            *(u32x4*)(QI + t * PB + ch * 8) = wi; *(u32x4*)(QR + t * PB + ch * 8) = wr; }
          else if (ch < 16) { u32x4 wk; float xk[8];
#pragma unroll
            for (int j = 0; j < 8; ++j) { const int d = (ch - 8) * 8 + j; xk[j] = bf2f((bf16_t)pf[r][j]) * __expf(LA[63 * 64 + d] - LA[t * 64 + d]); KRT[d * PB + t] = f2bf(xk[j]); }
            wk.x = pack2(xk[0], xk[1]); wk.y = pack2(xk[2], xk[3]); wk.z = pack2(xk[4], xk[5]); wk.w = pack2(xk[6], xk[7]);
            *(u32x4*)(KR + t * PB + (ch - 8) * 8) = wk; }
          else {
#pragma unroll
            for (int j = 0; j < 8; ++j) VT[((ch - 16) * 8 + j) * PB + t] = (bf16_t)pf[r][j]; } }
      if (n + 1 < LT / 64) gload(n + 1);
      __syncthreads();
      if (wave < 3) { const int et = wave == 2 ? 1 : 0, ct = wave == 0 ? 0 : 1; f32x16 a2 = {};
#pragma unroll
        for (int k8 = 0; k8 < 4; ++k8) { const bf16x8 av = *(const bf16x8*)(KR + (et * 32 + r32) * PB + k8 * 16 + hi * 8), bv = *(const bf16x8*)(QR + (ct * 32 + r32) * PB + k8 * 16 + hi * 8);
          a2 = __builtin_amdgcn_mfma_f32_32x32x16_bf16(av, bv, a2, 0, 0, 0); }
        const int c = ct * 32 + r32;
#pragma unroll
        for (int g = 0; g < 4; ++g) { const int e0 = et * 32 + 8 * g + 4 * hi; u32x2 w;
          w.x = pack2(e0 <= c ? a2[4 * g] : 0.f, e0 + 1 <= c ? a2[4 * g + 1] : 0.f); w.y = pack2(e0 + 2 <= c ? a2[4 * g + 2] : 0.f, e0 + 3 <= c ? a2[4 * g + 3] : 0.f);
          *(u32x2*)(PL + c * PB + e0) = w; } }
      else if (wave == 3) { for (int e = lane; e < 32 * 8; e += 64) { const int c = e >> 3, q4 = (e & 7) * 4; *(u32x2*)(PL + c * PB + 32 + q4) = (u32x2){0u, 0u}; } }
      else { const int ct = (wave - 4) >> 1, jt = wave & 1; acc = f32x16{};
#pragma unroll
        for (int k8 = 0; k8 < 4; ++k8) { const bf16x8 av = *(const bf16x8*)(QI + (ct * 32 + r32) * PB + k8 * 16 + hi * 8), bv = *(const bf16x8*)(SB + (jt * 32 + r32) * PB + k8 * 16 + hi * 8);
          acc = __builtin_amdgcn_mfma_f32_32x32x16_bf16(av, bv, acc, 0, 0, 0); } }
      __syncthreads();
      if (wave >= 4) { const int ct = (wave - 4) >> 1, jt = wave & 1;
#pragma unroll
        for (int k8 = 0; k8 < 4; ++k8) { const bf16x8 av = *(const bf16x8*)(PL + (ct * 32 + r32) * PB + k8 * 16 + hi * 8), bv = *(const bf16x8*)(VT + (jt * 32 + r32) * PB + k8 * 16 + hi * 8);
          acc = __builtin_amdgcn_mfma_f32_32x32x16_bf16(av, bv, acc, 0, 0, 0); }
#pragma unroll
        for (int r = 0; r < 16; ++r) { const int c = ct * 32 + (r & 3) + 8 * (r >> 2) + 4 * hi; const int row = scan_row(b, dir, n * 64 + c);
          p.OB[((size_t)(1 * 2 + dir) * MR + row) * 512 + h * 128 + half * 64 + jt * 32 + r32] = f2bf(acc[r]); } }
      else { const int dt = wave >> 1, jt = wave & 1;
#pragma unroll
        for (int r = 0; r < 16; ++r) acc[r] *= EBL[dt * 32 + (r & 3) + 8 * (r >> 2) + 4 * hi];
#pragma unroll
        for (int k8 = 0; k8 < 4; ++k8) { const bf16x8 av = *(const bf16x8*)(KRT + (dt * 32 + r32) * PB + k8 * 16 + hi * 8), bv = *(const bf16x8*)(VT + (jt * 32 + r32) * PB + k8 * 16 + hi * 8);
          acc = __builtin_amdgcn_mfma_f32_32x32x16_bf16(av, bv, acc, 0, 0, 0); }
#pragma unroll
        for (int g = 0; g < 4; ++g) { u32x2 w; w.x = pack2(acc[4 * g], acc[4 * g + 1]); w.y = pack2(acc[4 * g + 2], acc[4 * g + 3]);
          *(u32x2*)(SB + (jt * 32 + r32) * PB + dt * 32 + 8 * g + 4 * hi) = w; } }
      __syncthreads();
    }
  }
}

DI void st_combine(const Prm& p, int layer, int bid, int nb) {
  const int wave = ltid() >> 6, lane = ltid() & 63;
  for (long task = (long)bid * 8 + wave; task < (long)MR * 8; task += (long)nb * 8) {
    const int row = (int)(task >> 3), mh = (int)(task & 7), mixer = mh >> 2, h = mh & 3;
    const unsigned f = *(const unsigned*)(p.OB + ((size_t)(mixer * 2 + 0) * MR + row) * 512 + h * 128 + lane * 2), g = *(const unsigned*)(p.OB + ((size_t)(mixer * 2 + 1) * MR + row) * 512 + h * 128 + lane * 2);
    const float o0 = bf2f((bf16_t)(f & 0xffffu)) + bf2f((bf16_t)(g & 0xffffu)), o1 = bf2f((bf16_t)(f >> 16)) + bf2f((bf16_t)(g >> 16));
    const float ss = wsum(o0 * o0 + o1 * o1), rstd = rsqrtf(ss * (1.f / 128.f) + EPSV);
    const float* w = (mixer ? p.gla_norm : p.dn_norm) + layer * 128 + lane * 2;
    const unsigned gz = *(const unsigned*)(p.Z + (size_t)row * NZ + (mixer ? C_GGATE : C_DNGATE) + h * 128 + lane * 2);
    const float g0 = bf2f((bf16_t)(gz & 0xffffu)), g1 = bf2f((bf16_t)(gz >> 16));
    *(unsigned*)(p.Y + (size_t)row * DM + mixer * 512 + h * 128 + lane * 2) = pack2(o0 * rstd * w[0] * siluf(g0), o1 * rstd * w[1] * siluf(g1));
  }
}

DI unsigned fkey(float f) { const unsigned u = __float_as_uint(f); return u ^ ((u >> 31) ? 0xffffffffu : 0x80000000u); }
DI int pcnt(unsigned long long m) { return __builtin_popcountll(m); }
DI int lanes_below(unsigned long long m) { return (int)__builtin_amdgcn_mbcnt_hi((unsigned)(m >> 32), __builtin_amdgcn_mbcnt_lo((unsigned)m, 0u)); }
DI void st_peertopk(const Prm& p, int layer, unsigned char* lds, int bid, int nb) {
  bf16_t* ks = (bf16_t*)lds;
  bf16_t* qt = (bf16_t*)(lds + 69632);
  float* sc = (float*)(lds + 69632);
  const int tid = ltid(), wave = tid >> 6, lane = tid & 63, r32 = lane & 31, hi = lane >> 5;
  float* selv = (float*)(lds + 69632 + 33280) + wave * 64; int* seli = (int*)(selv + 32);
  int hcur = -1;
  const int nchunk = MR / 32;
  for (int it = bid; it < 8 * nchunk; it += nb) {
    const int h = it / nchunk, chunk = it - h * nchunk, row0 = chunk * 32;
    if (layer == 1 && (row0 % LT) >= LL) continue;
    __syncthreads();
    if (h != hcur) {
      const float* kg = p.peer_keys + ((size_t)(layer * 8 + h) * 2) * 128 * 128;
      for (int e = tid; e < 2 * 128 * 128; e += NTHR) { const int pn = e >> 7, k = e & 127; ks[pn * 136 + k] = f2bf(kg[e]); }
      hcur = h; }
    for (int e = tid; e < 1024; e += NTHR) { const int r = e >> 5, c8 = (e & 31) * 8; *(u32x4*)(qt + r * 264 + c8) = *(const u32x4*)(p.Qp + (size_t)(row0 + r) * DM + h * 256 + c8); }
    __syncthreads();
    { const int pt = wave >> 2, nt = wave & 3; f32x16 acc = {};
#pragma unroll
      for (int k8 = 0; k8 < 8; ++k8) { const bf16x8 a = *(const bf16x8*)(qt + r32 * 264 + pt * 128 + k8 * 16 + hi * 8), b = *(const bf16x8*)(ks + (pt * 128 + nt * 32 + r32) * 136 + k8 * 16 + hi * 8);
        acc = __builtin_amdgcn_mfma_f32_32x32x16_bf16(a, b, acc, 0, 0, 0); }
      __syncthreads();
#pragma unroll
      for (int r = 0; r < 16; ++r) sc[((r & 3) + 8 * (r >> 2) + 4 * hi) * 260 + pt * 128 + nt * 32 + r32] = acc[r]; }
    __syncthreads();
    for (int rr = 0; rr < 4; ++rr) {
      const int m = wave * 4 + rr, row = row0 + m;
      float s[2][2];
#pragma unroll
      for (int pp = 0; pp < 2; ++pp)
#pragma unroll
        for (int hh = 0; hh < 2; ++hh) s[pp][hh] = sc[m * 260 + pp * 128 + hh * 64 + lane];
      unsigned kk[2][2], T[2] = {0u, 0u};
#pragma unroll
      for (int pp = 0; pp < 2; ++pp) { kk[pp][0] = fkey(s[pp][0]); kk[pp][1] = fkey(s[pp][1]); }
      { unsigned ta = 0u, tb = 0u, da = 0u, db = 0u;
        for (int bit = 31; bit >= 0; --bit) { const unsigned m = 1u << bit;
          const unsigned ca = ta | m, cb = tb | m;
          const unsigned na = (unsigned)(pcnt(__ballot(kk[0][0] >= ca)) + pcnt(__ballot(kk[0][1] >= ca))), nb2 = (unsigned)(pcnt(__ballot(kk[1][0] >= cb)) + pcnt(__ballot(kk[1][1] >= cb)));
          const unsigned oa = (na >= 16u ? 1u : 0u) & ~da, ob = (nb2 >= 16u ? 1u : 0u) & ~db;
          ta |= (0u - oa) & m; tb |= (0u - ob) & m; da |= oa & (na == 16u ? 1u : 0u); db |= ob & (nb2 == 16u ? 1u : 0u);
          if (da & db) break; }
        T[0] = __builtin_amdgcn_readfirstlane(ta); T[1] = __builtin_amdgcn_readfirstlane(tb); }
#pragma unroll
      for (int pp = 0; pp < 2; ++pp) { const unsigned k0 = kk[pp][0], k1 = kk[pp][1], TT = T[pp];
        const unsigned long long g0 = __ballot(k0 > TT), g1 = __ballot(k1 > TT), e0 = __ballot(k0 == TT), e1 = __ballot(k1 == TT);
        const int ng0 = pcnt(g0), ng = ng0 + pcnt(g1), need = 16 - ng, ne0 = pcnt(e0);
        if (k0 > TT) { const int r = lanes_below(g0); selv[pp * 16 + r] = s[pp][0]; seli[pp * 16 + r] = lane; }
        if (k1 > TT) { const int r = ng0 + lanes_below(g1); selv[pp * 16 + r] = s[pp][1]; seli[pp * 16 + r] = lane + 64; }
        if (k0 == TT) { const int r = lanes_below(e0); if (r < need) { selv[pp * 16 + ng + r] = s[pp][0]; seli[pp * 16 + ng + r] = lane; } }
        if (k1 == TT) { const int r = ne0 + lanes_below(e1); if (r < need) { selv[pp * 16 + ng + r] = s[pp][1]; seli[pp * 16 + ng + r] = lane + 64; } } }
      __builtin_amdgcn_wave_barrier();
      float cd[4]; unsigned ck[4]; { const float sa = selv[lane >> 2]; const f32x4 sb = *(const f32x4*)(selv + 16 + (lane & 3) * 4);
#pragma unroll
        for (int q = 0; q < 4; ++q) { cd[q] = sa + sb[q]; ck[q] = fkey(cd[q]); } }
      unsigned T2 = 0u;
      for (int bit = 31; bit >= 0; --bit) { const unsigned m = 1u << bit, c = T2 | m;
        const unsigned n = (unsigned)(pcnt(__ballot(ck[0] >= c)) + pcnt(__ballot(ck[1] >= c)) + pcnt(__ballot(ck[2] >= c)) + pcnt(__ballot(ck[3] >= c)));
        T2 |= (0u - (n >= 16u ? 1u : 0u)) & m; if (n == 16u) break; }
      T2 = __builtin_amdgcn_readfirstlane(T2);
      float mx = fmaxf(fmaxf(cd[0], cd[1]), fmaxf(cd[2], cd[3])); mx = wmax(mx);
      int base = 0; float esum = 0.f; const int ia = seli[lane >> 2]; int rk[4]; float ev[4];
#pragma unroll
      for (int q = 0; q < 4; ++q) { const unsigned long long g = __ballot(ck[q] > T2); rk[q] = ck[q] > T2 ? base + lanes_below(g) : 99; base += pcnt(g); }
#pragma unroll
      for (int q = 0; q < 4; ++q) { const unsigned long long g = __ballot(ck[q] == T2); if (ck[q] == T2) rk[q] = base + lanes_below(g); base += pcnt(g); }
#pragma unroll
      for (int q = 0; q < 4; ++q) { ev[q] = rk[q] < 16 ? __expf(cd[q] - mx) : 0.f; esum += ev[q]; }
      esum = wsum(esum); const float inv = 1.f / esum;
      int* orow = p.IDX + (size_t)row * 128 + h * 16; float* grow = p.GATE + (size_t)row * 128 + h * 16;
#pragma unroll
      for (int q = 0; q < 4; ++q) if (rk[q] < 16) { orow[rk[q]] = ia * 128 + seli[16 + (lane & 3) * 4 + q]; grow[rk[q]] = ev[q] * inv; }
      __builtin_amdgcn_wave_barrier();
    }
  }
}

typedef float v16f_t __attribute__((ext_vector_type(16)));
typedef float v32f_t __attribute__((ext_vector_type(32)));
typedef unsigned v6u_t __attribute__((ext_vector_type(6)));
constexpr int TROW = 1600;
DI void st_cvt_tables(const Prm& p, int layer, int bid, int nb) {
  const size_t nblk = (size_t)16384 * 64, stride = (size_t)nb * NTHR;
  const float* U = p.peer_u + (size_t)layer * 16384 * DM; const float* V = p.peer_v + (size_t)layer * 16384 * DM;
  for (size_t e = (size_t)bid * NTHR + ltid(); e < 2 * nblk; e += stride) { const bool isv = e >= nblk; const size_t k = isv ? e - nblk : e; const size_t row = k >> 6; const int l = (int)(k & 63);
    const float* src = (isv ? V : U) + row * DM + l * 32; v16f_t x, y; float amax = 0.f;
#pragma unroll
    for (int q = 0; q < 4; ++q) { const f32x4 a = *(const f32x4*)(src + q * 8), b = *(const f32x4*)(src + q * 8 + 4);
      x[q * 4] = a[0]; y[q * 4] = a[1]; x[q * 4 + 1] = a[2]; y[q * 4 + 1] = a[3]; x[q * 4 + 2] = b[0]; y[q * 4 + 2] = b[1]; x[q * 4 + 3] = b[2]; y[q * 4 + 3] = b[3];
#pragma unroll
      for (int i = 0; i < 4; ++i) amax = fmaxf(amax, fmaxf(fabsf(a[i]), fabsf(b[i]))); }
    int ex = (int)((__float_as_uint(amax * (1.f / 7.5f)) >> 23) & 0xffu) - 127 + 1; ex = ex < -126 ? -126 : ex;
    const float inv = __uint_as_float((unsigned)(127 - ex) << 23);
    x *= inv; y *= inv;
    const v6u_t r = __builtin_amdgcn_cvt_scalef32_2xpk16_fp6_f32(x, y, 1.0f);
    unsigned char* dst = (unsigned char*)(isv ? p.Vb : p.Ub) + row * TROW;
    dst[l] = (unsigned char)(ex + 127);
    *(u32x4*)(dst + 64 + l * 16) = (u32x4){r[0], r[1], r[2], r[3]}; *(u32x2*)(dst + 64 + 1024 + l * 8) = (u32x2){r[4], r[5]}; }
}

DI void st_peergather(const Prm& p, int layer, float* lds, int bid, int nb, bool dry = false) {
  const int tid = ltid(), wave = tid >> 6, lane = tid & 63;
  const unsigned char* Ub = (const unsigned char*)p.Ub; const unsigned char* Vb = (const unsigned char*)p.Vb;
  for (int row = bid; row < MR; row += nb) {
    const int b = row / LT, t = row - b * LT; const bool isc = t >= LL;
    if (isc && layer == 1) continue;
    f32x2 hv[16];
#pragma unroll
    for (int q = 0; q < 4; ++q) { const u32x4 w = *(const u32x4*)(p.H2 + (size_t)row * DM + lane * 32 + q * 8);
#pragma unroll
      for (int k = 0; k < 4; ++k) hv[q * 4 + k] = (f32x2){__uint_as_float(w[k] << 16), __uint_as_float(w[k] & 0xffff0000u)}; }
    f32x2 acc[16];
#pragma unroll
    for (int i = 0; i < 16; ++i) acc[i] = (f32x2){0.f, 0.f};
    const int myidx = lane < 16 ? p.IDX[(size_t)row * 128 + wave * 16 + lane] : 0; const float mygate = lane < 16 ? p.GATE[(size_t)row * 128 + wave * 16 + lane] : 0.f;
#pragma unroll 1
    for (int k0 = 0; k0 < 16; k0 += 8) {
      u32x4 ua[8], va[8]; u32x2 ub[8], vb[8]; unsigned us[8], vs[8];
#pragma unroll
      for (int q = 0; q < 8; ++q) { const int e = __builtin_amdgcn_readfirstlane(__shfl(myidx, k0 + q));
        const unsigned char* ur = Ub + (size_t)e * TROW; const unsigned char* vr = Vb + (size_t)e * TROW;
        ua[q] = *(const u32x4*)(ur + 64 + lane * 16); ub[q] = *(const u32x2*)(ur + 64 + 1024 + lane * 8); us[q] = ur[lane];
        va[q] = *(const u32x4*)(vr + 64 + lane * 16); vb[q] = *(const u32x2*)(vr + 64 + 1024 + lane * 8); vs[q] = vr[lane]; }
#pragma unroll
      for (int q = 0; q < 8; ++q) {
        const v32f_t du = __builtin_amdgcn_cvt_scalef32_pk32_f32_fp6((v6u_t){ua[q][0], ua[q][1], ua[q][2], ua[q][3], ub[q][0], ub[q][1]}, 1.0f);
        f32x2 d0 = (f32x2){0.f, 0.f}, d1 = (f32x2){0.f, 0.f};
#pragma unroll
        for (int i = 0; i < 16; i += 2) { d0 += (f32x2){du[2 * i], du[2 * i + 1]} * hv[i]; d1 += (f32x2){du[2 * i + 2], du[2 * i + 3]} * hv[i + 1]; }
        d0 += d1; const float d = wsum((d0[0] + d0[1]) * __uint_as_float(us[q] << 23));
        const float wgt = __shfl(mygate, k0 + q) * 0.5f * d * (1.f + erff(d * 0.70710678118654752f)) * __uint_as_float(vs[q] << 23); const f32x2 w2 = (f32x2){wgt, wgt};
        const v32f_t dv = __builtin_amdgcn_cvt_scalef32_pk32_f32_fp6((v6u_t){va[q][0], va[q][1], va[q][2], va[q][3], vb[q][0], vb[q][1]}, 1.0f);
#pragma unroll
        for (int i = 0; i < 16; ++i) acc[i] += w2 * (f32x2){dv[2 * i], dv[2 * i + 1]}; }
    }
    __syncthreads();
#pragma unroll
    for (int k = 0; k < 8; ++k) *(f32x4*)(lds + wave * 2048 + lane * 32 + k * 4) = (f32x4){acc[2 * k][0], acc[2 * k][1], acc[2 * k + 1][0], acc[2 * k + 1][1]};
    __syncthreads();
    { const int col = tid * 4; f32x4 sum = (f32x4){0.f, 0.f, 0.f, 0.f};
#pragma unroll
      for (int w = 0; w < 8; ++w) sum += *(const f32x4*)(lds + w * 2048 + col);
      const f32x4 g2 = *(const f32x4*)(p.mod + ((size_t)layer * 9 + (isc ? 8 : b)) * NMOD + 5 * DM + col);
      float* xr = p.X + (size_t)row * DM + col; const f32x4 xn = *(const f32x4*)xr + g2 * sum;
      if (!dry) {
        float ss = wsum(xn[0] * xn[0] + xn[1] * xn[1] + xn[2] * xn[2] + xn[3] * xn[3]);
        if (lane == 0) lds[16384 + wave] = ss;
        __syncthreads();
        ss = 0.f;
#pragma unroll
        for (int w = 0; w < 8; ++w) ss += lds[16384 + w];
        const float rstd = rsqrtf(ss * (1.f / 2048.f) + EPSV);
        if (layer == 0) { *(f32x4*)xr = xn;
          const float* mr = p.mod + ((size_t)9 + (isc ? 8 : b)) * NMOD; const f32x4 sc = *(const f32x4*)(mr + DM + col), sh = *(const f32x4*)(mr + col);
          const f32x4 o = xn * rstd * (sc + 1.f) + sh; u32x2 w; w.x = pack2(o[0], o[1]); w.y = pack2(o[2], o[3]); *(u32x2*)(p.H + (size_t)row * DM + col) = w; }
        else *(f32x4*)(p.out + ((size_t)b * LL + t) * DM + col) = xn * rstd * *(const f32x4*)(p.final_norm + col);
      } }
  }
}

DI void st_final(const Prm& p, int bid, int nb) {
  const int wave = ltid() >> 6, lane = ltid() & 63;
  for (int r = bid * 8 + wave; r < NB * LL; r += nb * 8) {
    const int b = r / LL, t = r - b * LL; const float* src = p.X + (size_t)(b * LT + t) * DM;
    f32x4 v[8]; float ss = 0.f;
#pragma unroll
    for (int i = 0; i < 8; ++i) { v[i] = *(const f32x4*)(src + (i * 64 + lane) * 4); ss += v[i][0] * v[i][0] + v[i][1] * v[i][1] + v[i][2] * v[i][2] + v[i][3] * v[i][3]; }
    ss = wsum(ss); const float rstd = rsqrtf(ss * (1.f / 2048.f) + EPSV);
#pragma unroll
    for (int i = 0; i < 8; ++i) { const int col = (i * 64 + lane) * 4; *(f32x4*)(p.out + (size_t)r * DM + col) = v[i] * rstd * *(const f32x4*)(p.final_norm + col); }
  }
}

namespace att {
constexpr int NW = 8, QBLK = 32, KVBLK = 64;
constexpr float SCALE = 0.07216878364870322f;
constexpr float THR = 8.f;
constexpr int LDQ = 768, LDK = 1024, LDKR = 64, LDO = DM;
constexpr int SHM_V = KVBLK * 128 * 2, SHM_K = KVBLK * 128 * 2, SHM_KR = KVBLK * 64 * 2, SHM_ATTN = 2 * SHM_V + 2 * SHM_K + 2 * SHM_KR + NW * 64 * 4;
#define KSWZ(row, colB) ((row) * 256 + ((colB) ^ (((row) & 7) << 4)))
#define KRSWZ(row, colB) ((row) * 128 + ((colB) ^ ((((row) >> 1) & 7) << 4)))
#define SBAR() __builtin_amdgcn_sched_barrier(0)
DI int crow(int r, int hi) { return (r & 3) + 8 * (r >> 2) + 4 * hi; }
DI unsigned cvtpk(float lo, float hi) { unsigned r; asm volatile("v_cvt_pk_bf16_f32 %0, %1, %2" : "=v"(r) : "v"(lo), "v"(hi)); return r; }

DI void partialSM(f32x16& p0, f32x16& p1, float& m_reg, float& mn, float& alpha) {
  constexpr float C = SCALE * 1.4426950408889634f;
  float pmax = p0[0];
#pragma unroll
  for (int r = 1; r < 16; ++r) pmax = fmaxf(pmax, p0[r]);
#pragma unroll
  for (int r = 0; r < 16; ++r) pmax = fmaxf(pmax, p1[r]);
  { auto rr = __builtin_amdgcn_permlane32_swap(__float_as_uint(pmax), __float_as_uint(pmax), false, false);
    pmax = fmaxf(__uint_as_float(rr[0]), __uint_as_float(rr[1])); }
  if (__builtin_expect(__all(pmax - m_reg <= THR / SCALE), 1)) { mn = m_reg; alpha = 1.f; }
  else { mn = fmaxf(m_reg, pmax); alpha = __builtin_amdgcn_exp2f((m_reg - mn) * C); m_reg = mn; }
  const float mnC = -mn * C;
#pragma unroll
  for (int r = 0; r < 16; ++r) p0[r] = fmaf(p0[r], C, mnC);
#pragma unroll
  for (int r = 0; r < 16; ++r) p1[r] = fmaf(p1[r], C, mnC);
#pragma unroll
  for (int r = 0; r < 16; ++r) p0[r] = __builtin_amdgcn_exp2f(p0[r]);
}
DI void finishSM(f32x16& p0, f32x16& p1, float alpha, float& l_reg, bf16x8& pa0, bf16x8& pa1, bf16x8& pa2, bf16x8& pa3) {
#pragma unroll
  for (int r = 0; r < 16; ++r) p1[r] = __builtin_amdgcn_exp2f(p1[r]);
  float ps = 0;
#pragma unroll
  for (int r = 0; r < 16; ++r) ps += p0[r];
#pragma unroll
  for (int r = 0; r < 16; ++r) ps += p1[r];
  { auto rr = __builtin_amdgcn_permlane32_swap(__float_as_uint(ps), __float_as_uint(ps), false, false);
    ps = __uint_as_float(rr[0]) + __uint_as_float(rr[1]); }
  l_reg = l_reg * alpha + ps;
#define PK4(P, BASE, OUT) do { unsigned a0 = cvtpk(P[BASE + 0], P[BASE + 1]), a1 = cvtpk(P[BASE + 2], P[BASE + 3]);   \
    unsigned b0 = cvtpk(P[BASE + 4], P[BASE + 5]), b1 = cvtpk(P[BASE + 6], P[BASE + 7]);                              \
    auto r0 = __builtin_amdgcn_permlane32_swap(a0, b0, false, false); auto r1 = __builtin_amdgcn_permlane32_swap(a1, b1, false, false); \
    u32x4 w = {r0[0], r1[0], r0[1], r1[1]}; OUT = *reinterpret_cast<bf16x8*>(&w); } while (0)
  PK4(p0, 0, pa0); PK4(p0, 8, pa1); PK4(p1, 0, pa2); PK4(p1, 8, pa3);
#undef PK4
}
DI void qkt(f32x16& p0, f32x16& p1, const char* Ks, const char* KRs, const bf16x8* qr, int r32, int hi) {
  p0 = f32x16{}; p1 = f32x16{};
#pragma unroll
  for (int d0 = 0; d0 < 8; ++d0) { const int cb = (d0 * 16 + hi * 8) * 2;
    const bf16x8 b0 = *reinterpret_cast<const bf16x8*>(Ks + KSWZ(r32, cb));
    const bf16x8 b1 = *reinterpret_cast<const bf16x8*>(Ks + KSWZ(32 + r32, cb));
    p0 = __builtin_amdgcn_mfma_f32_32x32x16_bf16(b0, qr[d0], p0, 0, 0, 0);
    p1 = __builtin_amdgcn_mfma_f32_32x32x16_bf16(b1, qr[d0], p1, 0, 0, 0); }
#pragma unroll
  for (int d0 = 0; d0 < 4; ++d0) { const int cb = (d0 * 16 + hi * 8) * 2;
    const bf16x8 b0 = *reinterpret_cast<const bf16x8*>(KRs + KRSWZ(r32, cb));
    const bf16x8 b1 = *reinterpret_cast<const bf16x8*>(KRs + KRSWZ(32 + r32, cb));
    p0 = __builtin_amdgcn_mfma_f32_32x32x16_bf16(b0, qr[8 + d0], p0, 0, 0, 0);
    p1 = __builtin_amdgcn_mfma_f32_32x32x16_bf16(b1, qr[8 + d0], p1, 0, 0, 0); }
}
DI int v_st(int k, int c) { const int kk = (k & ~0xC) | ((k & 4) << 1) | ((k & 8) >> 1); return ((kk >> 3) * 4 + (c >> 5)) * 512 + ((kk & 7) * 32 + (c & 31)) * 2; }
DI int v_rd_base(int lane) { return ((lane & 3) << 3) | (((lane >> 2) & 3) << 6) | (((lane >> 4) & 1) << 5) | (((lane >> 5) & 1) << 8); }
constexpr int v_rd_off(int d0, int ks, int half) { return d0 * 512 + ks * 4096 + half * 2048; }
template <int OFF> DI s16x4 tr_read(int vb) { s16x4 r; asm volatile("ds_read_b64_tr_b16 %0, %1 offset:%2" : "=&v"(r) : "v"(vb), "i"(OFF) : "memory"); return r; }
template <int D0> DI void pv_one(f32x16& od, int vb, bf16x8 pa0, bf16x8 pa1, bf16x8 pa2, bf16x8 pa3) {
  const s16x4 l0 = tr_read<v_rd_off(D0, 0, 0)>(vb), h0 = tr_read<v_rd_off(D0, 0, 1)>(vb), l1 = tr_read<v_rd_off(D0, 1, 0)>(vb), h1 = tr_read<v_rd_off(D0, 1, 1)>(vb);
  const s16x4 l2 = tr_read<v_rd_off(D0, 2, 0)>(vb), h2 = tr_read<v_rd_off(D0, 2, 1)>(vb), l3 = tr_read<v_rd_off(D0, 3, 0)>(vb), h3 = tr_read<v_rd_off(D0, 3, 1)>(vb);
  asm volatile("s_waitcnt lgkmcnt(0)" ::: "memory"); SBAR();
#define PK(L, H) (bf16x8){L[0], L[1], L[2], L[3], H[0], H[1], H[2], H[3]}
  od = __builtin_amdgcn_mfma_f32_32x32x16_bf16(pa0, PK(l0, h0), od, 0, 0, 0);
  od = __builtin_amdgcn_mfma_f32_32x32x16_bf16(pa1, PK(l1, h1), od, 0, 0, 0);
  od = __builtin_amdgcn_mfma_f32_32x32x16_bf16(pa2, PK(l2, h2), od, 0, 0, 0);
  od = __builtin_amdgcn_mfma_f32_32x32x16_bf16(pa3, PK(l3, h3), od, 0, 0, 0);
#undef PK
}
DI void pv_d0(f32x16* o, int vb, bf16x8 pa0, bf16x8 pa1, bf16x8 pa2, bf16x8 pa3) {
  pv_one<0>(o[0], vb, pa0, pa1, pa2, pa3); pv_one<1>(o[1], vb, pa0, pa1, pa2, pa3); pv_one<2>(o[2], vb, pa0, pa1, pa2, pa3); pv_one<3>(o[3], vb, pa0, pa1, pa2, pa3);
}

DI void attn_body(const bf16_t* __restrict__ Qb, const bf16_t* __restrict__ Kh, const bf16_t* __restrict__ Vh, const bf16_t* __restrict__ KRh, bf16_t* __restrict__ Ob, int seq, int tpos0, char* lds) {
  const int tid = ltid(), wid = tid >> 6, lane = tid & 63, r32 = lane & 31, hi = lane >> 5;
  char* V_lds = lds; char* K_lds = lds + 2 * SHM_V; char* KR_lds = lds + 2 * SHM_V + 2 * SHM_K;
  float* ws = (float*)(lds + 2 * SHM_V + 2 * SHM_K + 2 * SHM_KR) + wid * 64; float* li_l = ws; float* al_l = ws + 32;
  float m_reg = -1e30f, l_reg = 0; f32x16 o[4] = {}; bf16x8 qr[12];
  const bf16_t* Qw = Qb + (long)(wid * QBLK + r32) * LDQ + hi * 8;
#pragma unroll
  for (int d0 = 0; d0 < 12; ++d0) qr[d0] = *reinterpret_cast<const bf16x8*>(Qw + d0 * 16);
  if (tpos0 >= 0) {
    const int t = tpos0 + wid * QBLK + r32;
#pragma unroll
    for (int hf = 0; hf < 2; ++hf) { const float pos = (float)(hf ? (t & 63) : (t >> 6));
#pragma unroll
      for (int j = 0; j < 8; ++j) { const float ang = pos * exp2f(-(float)(hi * 8 + j) * (13.287712379549449f / 16.f)); float sv, cv; sincosf(ang, &sv, &cv);
        const float x1 = bf2f((bf16_t)qr[8 + 2 * hf][j]), x2 = bf2f((bf16_t)qr[9 + 2 * hf][j]);
        qr[8 + 2 * hf][j] = (short)f2bf(x1 * cv - x2 * sv); qr[9 + 2 * hf][j] = (short)f2bf(x2 * cv + x1 * sv); } }
  }
  const int sr = tid >> 4, sc = (tid & 15) * 8, vst0 = v_st(sr, sc), vst1 = v_st(32 + sr, sc);
  const int krr = tid >> 3, krc = (tid & 7) * 8;
  const int vb0 = (int)(uintptr_t)V_lds + v_rd_base(lane);
  bf16x8 vs0, vs1, ks0, ks1, kr0;
#define SLOAD(k0) do { vs0 = *reinterpret_cast<const bf16x8*>(&Vh[(long)((k0) + sr) * LDK + sc]); vs1 = *reinterpret_cast<const bf16x8*>(&Vh[(long)((k0) + 32 + sr) * LDK + sc]); \
    ks0 = *reinterpret_cast<const bf16x8*>(&Kh[(long)((k0) + sr) * LDK + sc]); ks1 = *reinterpret_cast<const bf16x8*>(&Kh[(long)((k0) + 32 + sr) * LDK + sc]); \
    kr0 = *reinterpret_cast<const bf16x8*>(&KRh[(long)((k0) + krr) * LDKR + krc]); } while (0)
#define SWRITE(b) do { *(bf16x8*)(V_lds + (b) * SHM_V + vst0) = vs0; *(bf16x8*)(V_lds + (b) * SHM_V + vst1) = vs1; const int kc = sc * 2;               \
    *(bf16x8*)(K_lds + (b) * SHM_K + KSWZ(sr, kc)) = ks0; *(bf16x8*)(K_lds + (b) * SHM_K + KSWZ(32 + sr, kc)) = ks1;                       \
    *(bf16x8*)(KR_lds + (b) * SHM_KR + KRSWZ(krr, krc * 2)) = kr0; } while (0)
#define SWAIT() asm volatile("s_waitcnt vmcnt(0)" ::: "memory")
#define RESC(a) do { if (__any((a) < 1.f)) { if (hi == 0) al_l[r32] = (a); asm volatile("s_waitcnt lgkmcnt(0)" ::: "memory"); \
    _Pragma("unroll") for (int d = 0; d < 4; ++d) _Pragma("unroll") for (int r = 0; r < 16; ++r) o[d][r] *= al_l[crow(r, hi)]; } } while (0)
  f32x16 p0, p1; float mn, al; bf16x8 pa0, pa1, pa2, pa3; const int NT = seq / KVBLK;
  SLOAD(0); SWAIT(); SWRITE(0); __syncthreads();
  for (int j = 0; j < NT; ++j) {
    const int buf = j & 1; const bool more = j + 1 < NT;
    if (more) SLOAD((j + 1) * KVBLK);
    SBAR(); qkt(p0, p1, K_lds + buf * SHM_K, KR_lds + buf * SHM_KR, qr, r32, hi);
    partialSM(p0, p1, m_reg, mn, al); RESC(al);
    finishSM(p0, p1, al, l_reg, pa0, pa1, pa2, pa3); SBAR();
    pv_d0(o, vb0 + buf * SHM_V, pa0, pa1, pa2, pa3);
    if (more) { SWAIT(); SWRITE(buf ^ 1); }
    __syncthreads();
  }
  if (hi == 0) li_l[r32] = l_reg; asm volatile("s_waitcnt lgkmcnt(0)" ::: "memory");
  float rli[16];
#pragma unroll
  for (int r = 0; r < 16; ++r) rli[r] = __builtin_amdgcn_rcpf(li_l[crow(r, hi)]);
  bf16_t* Ow = Ob + (long)(wid * QBLK) * LDO;
#pragma unroll
  for (int r = 0; r < 16; ++r) { const int orow = crow(r, hi);
#pragma unroll
    for (int d0 = 0; d0 < 4; ++d0) Ow[(long)orow * LDO + d0 * 32 + r32] = f2bf(o[d0][r] * rli[r]); }
  __syncthreads();
#undef SLOAD
#undef SWRITE
#undef SWAIT
#undef RESC
}
}

DI void st_attn(const Prm& p, int layer, char* lds, int bid, int nb) {
  const int nlat = NB * 4 * 16, nitem = nlat + (layer == 0 ? NB * 4 : 0);
  for (int it = bid; it < nitem; it += nb) {
    if (it < nlat) { const int b = it >> 6, h = (it >> 4) & 3, qb = it & 15; const size_t r0 = (size_t)b * LT;
      att::attn_body(p.Qraw + (r0 + qb * 256) * 768 + h * 192, p.KV + r0 * 1024 + h * 256, p.KV + r0 * 1024 + h * 256 + 128, p.KR + r0 * 64,
                     p.Y + (r0 + qb * 256) * DM + 1024 + h * 128, LT, qb * 256, lds); }
    else { const int k = it - nlat, b = k >> 2, h = k & 3; const size_t r0 = (size_t)b * LT + LL;
      att::attn_body(p.Qraw + r0 * 768 + h * 192, p.KV + r0 * 1024 + h * 256, p.KV + r0 * 1024 + h * 256 + 128, p.KR + r0 * 64, p.Y + r0 * DM + 1024 + h * 128, LCX, -1, lds); }
  }
}

struct EpiResid {
  static constexpr bool PERM = false, AFTER_DRAIN = false;
  const float* xlat; const float* xctx; float* X; const float* modl; int first;
  __device__ __forceinline__ void operator()(const pg8::f32x4 (&acc)[2][2][4][2], const pg8::Unit& u, int wr, int wc, int fr, int fq) const {
    const int b = u.pm / 17, tl = u.pm - b * 17; const bool isc = tl == 16;
    const float* g = modl + (size_t)(isc ? 8 : b) * NMOD + 2 * DM;
    const int rloc0 = wr * 64 + fr, col0 = u.pn * 256 + wc * 32 + 4 * fq;
    pg8::f32x4 gv[2][2];
#pragma unroll
    for (int bj = 0; bj < 2; ++bj)
#pragma unroll
      for (int n = 0; n < 2; ++n) gv[bj][n] = *(const pg8::f32x4*)(g + col0 + bj * 128 + n * 16);
#pragma unroll
    for (int ai = 0; ai < 2; ++ai)
#pragma unroll
      for (int m = 0; m < 4; ++m) { const int rl = rloc0 + ai * 128 + m * 16; const size_t row = (size_t)u.pm * 256 + rl;
        const float* src = first ? (isc ? xctx + ((size_t)b * LCX + rl) * DM : xlat + ((size_t)b * LL + tl * 256 + rl) * DM) : X + row * DM;
        float* dst = X + row * DM;
#pragma unroll
        for (int bj = 0; bj < 2; ++bj)
#pragma unroll
          for (int n = 0; n < 2; ++n) { const int c = col0 + bj * 128 + n * 16; *(pg8::f32x4*)(dst + c) = *(const pg8::f32x4*)(src + c) + gv[bj][n] * acc[ai][bj][m][n]; } }
  }
};

struct LatentOrder : pg8::StaticOrder {
  __device__ bool next(int i, pg8::Unit& u) const { const bool ok = pg8::StaticOrder::next(i, u); u.pm += u.pm >> 4; return ok; }
};
template <class Epi> DI void run_gemm_lat(unsigned char* lds, const bf16_t* A, const bf16_t* Bt, int N, int K, const Epi& E, int bid, int nb) {
  pg8::Gemm g; g.A = A; g.Bt = Bt; g.M = NB * LL; g.N = N; g.K = K;
  LatentOrder S; S.init(NB * LL, N, nb, bid);
  pg8::gemm_phase<Epi, LatentOrder, false>((PG8_LAS unsigned char*)lds, g, S, E, nullptr);
}
template <class Epi> DI void run_gemm(unsigned char* lds, const bf16_t* A, const bf16_t* Bt, int M, int N, int K, const Epi& E, int bid, int nb) {
  pg8::Gemm g; g.A = A; g.Bt = Bt; g.M = M; g.N = N; g.K = K;
  pg8::StaticOrder S; S.init(M, N, nb, bid);
  pg8::gemm_phase<Epi, pg8::StaticOrder, false>((PG8_LAS unsigned char*)lds, g, S, E, nullptr);
}
DI pg8::EpiBf16<0> epi_bf16(bf16_t* O, int ldc, int split_cols = 0, size_t split_stride = 0) { pg8::EpiBf16<0> e; e.O = O; e.ldc = ldc; e.bias = nullptr; e.split_cols = split_cols; e.split_stride = split_stride; return e; }

#ifndef PROBE
#define PROBE 0
#endif
constexpr int LDS_MAIN = 131072 + 4096, LDS_TOTAL = LDS_MAIN + 64;
#define PRM() (*(const __attribute__((address_space(4))) Prm*)launder_k(kp))
typedef const __attribute__((address_space(4))) void* kptr_t;
DI kptr_t launder_k(kptr_t q) { asm volatile("" : "+s"(q)); return q; }
extern __shared__ __attribute__((aligned(16))) unsigned char shm[];
__global__ void __launch_bounds__(NTHR, 2) mega(Prm p_unused) {
#if defined(__HIP_DEVICE_COMPILE__)
  kptr_t kp = (kptr_t)__builtin_amdgcn_kernarg_segment_ptr();
  const int bid0 = blockIdx.x, nb0 = gridDim.x;
#define bid lsg(bid0)
#define nb lsg(nb0)
  uint4* xbw = (uint4*)(shm + LDS_MAIN);
  if (threadIdx.x == 0) *xbw = make_uint4(0u, 0u, 0u, 0u);
  __syncthreads();
  { const Prm p = PRM(); (void)xcd_barrier_post(p.bar, (volatile LAS unsigned*)xbw); }
#define GRID_BAR() do { XcdBarrier b_; b_.bar = PRM().bar; b_.x = xb_xcc_id(); b_.st = (volatile LAS unsigned*)(shm + LDS_MAIN); xcd_barrier(b_); } while (0)
  float* lf = (float*)shm;
  for (int ly = 0; ly < 2; ++ly) { const Prm p = PRM();
    st_transpose(p.w_in + (size_t)ly * DM * IN_W, p.WinT + (size_t)ly * NZ * DM, DM, IN_W, DM, NZ, lf, bid, nb);
    st_transpose(p.w_out + (size_t)ly * DM * DM, p.WoutT + (size_t)ly * DM * DM, DM, DM, DM, DM, lf, bid, nb);
    st_transpose(p.peer_wq + (size_t)ly * DM * DM, p.WqT + (size_t)ly * DM * DM, DM, DM, DM, DM, lf, bid, nb);
    st_transpose(p.mla_w_uq + (size_t)ly * 448 * 768, p.WuqT + (size_t)ly * 768 * 512, 448, 768, 512, 768, lf, bid, nb);
    st_transpose(p.mla_w_ukv + (size_t)ly * 128 * 1024, p.WukvT + (size_t)ly * 1024 * 256, 128, 1024, 256, 1024, lf, bid, nb);
  }
  { const Prm p = PRM(); st_tables(p, bid, nb); }
  __syncthreads();
  { const Prm p = PRM(); st_mods(p, lf, bid, nb); }
  if (PROBE == 5) { __syncthreads();
    for (int ly = 0; ly < 2; ++ly) { const Prm p = PRM();
      st_transpose(p.w_in + (size_t)ly * DM * IN_W, p.WinT + (size_t)ly * NZ * DM, DM, IN_W, DM, NZ, lf, bid, nb);
      st_transpose(p.w_out + (size_t)ly * DM * DM, p.WoutT + (size_t)ly * DM * DM, DM, DM, DM, DM, lf, bid, nb);
      st_transpose(p.peer_wq + (size_t)ly * DM * DM, p.WqT + (size_t)ly * DM * DM, DM, DM, DM, DM, lf, bid, nb); }
    { const Prm p = PRM(); st_tables(p, bid, nb); }
    __syncthreads();
    { const Prm p = PRM(); st_mods(p, lf, bid, nb); } }
  GRID_BAR();
  for (int l = 0; l < 2; ++l) {
    if (l == 0) { { const Prm p = PRM(); st_modulate(p, l, 0, p.H, bid, nb); } GRID_BAR(); }
    { const Prm p = PRM(); run_gemm(shm, p.H, p.WinT + (size_t)l * NZ * DM, MR, NZ, DM, epi_bf16(p.Z, NZ), bid, nb); }
    if (PROBE == 6) { const Prm p = PRM(); run_gemm(shm, p.H, p.WinT + (size_t)l * NZ * DM, MR, NZ, DM, epi_bf16(p.Z, NZ), bid, nb); }
    GRID_BAR();
    { const Prm p = PRM(); st_dnprep(p, l, bid, nb); }
    { const Prm p = PRM(); st_mlaprep(p, l, bid, nb); }
    { const Prm p = PRM(); st_fnchan(p, shm, bid, nb); }
    GRID_BAR();
    { const Prm p = PRM(); st_dntinv(p, shm, bid, nb); }
    __syncthreads();
    { const Prm p = PRM(); st_glabc(p, l, shm, bid, nb); }
    if (PROBE == 9) { { const Prm p = PRM(); st_dnprep(p, l, bid, nb); } { const Prm p = PRM(); st_mlaprep(p, l, bid, nb); } }
    if (PROBE == 10) { const Prm p = PRM(); st_fnchan(p, shm, bid, nb); }
    GRID_BAR();
    { const Prm p = PRM(); run_gemm(shm, p.Aq, p.WuqT + (size_t)l * 768 * 512, MR, 768, 512, epi_bf16(p.Qraw, 768), bid, nb); }
    { const Prm p = PRM(); run_gemm(shm, p.Akv, p.WukvT + (size_t)l * 1024 * 256, MR, 1024, 256, epi_bf16(p.KV, 1024), bid, nb); }
    if (bid < 128) { const Prm p = PRM(); st_dnscan(p, shm, bid, 128); }
    else { const Prm p = PRM(); st_glascan(p, l, shm, bid - 128, 128); }
    if (PROBE == 7) { GRID_BAR(); if (bid < 128) { const Prm p = PRM(); st_dnscan(p, shm, bid, 128); } }
    if (PROBE == 8) { GRID_BAR(); if (bid < 128) { const Prm p = PRM(); st_glascan(p, l, shm, bid, 128); } }
    if (PROBE == 2) { GRID_BAR(); if (bid < 128) { const Prm p = PRM(); st_dnscan(p, shm, bid, 128); } else { const Prm p = PRM(); st_glascan(p, l, shm, bid - 128, 128); } }
    GRID_BAR();
    { const Prm p = PRM(); st_attn(p, l, (char*)shm, bid, nb); }
    if (PROBE == 3) { const Prm p = PRM(); st_attn(p, l, (char*)shm, bid, nb); }
    { const Prm p = PRM(); st_fnfft(p, shm, bid, nb); }
    __syncthreads();
    if (l == 0) { const Prm p = PRM(); run_gemm(shm, p.DFTC, p.PQTc, 256, 4096, 512, epi_bf16(p.Y + (size_t)LL * DM + 1536, DM, 512, (size_t)LT * DM), bid, nb); }
    { const Prm p = PRM(); st_combine(p, l, bid, nb); }
    GRID_BAR();
    { const Prm p = PRM(); EpiResid e; e.xlat = p.x; e.xctx = p.ctx; e.X = p.X; e.modl = p.mod + (size_t)l * 9 * NMOD; e.first = l == 0;
      if (l == 0) run_gemm(shm, p.Y, p.WoutT + (size_t)l * DM * DM, MR, DM, DM, e, bid, nb);
      else run_gemm_lat(shm, p.Y, p.WoutT + (size_t)l * DM * DM, DM, DM, e, bid, nb); }
    GRID_BAR();
    { const Prm p = PRM(); st_modulate(p, l, 1, p.H2, bid, nb); }
    { const Prm p = PRM(); st_cvt_tables(p, l, bid, nb); }
    GRID_BAR();
    if (l == 0) { const Prm p = PRM(); run_gemm(shm, p.H2, p.WqT + (size_t)l * DM * DM, MR, DM, DM, epi_bf16(p.Qp, DM), bid, nb); }
    else { const Prm p = PRM(); run_gemm_lat(shm, p.H2, p.WqT + (size_t)l * DM * DM, DM, DM, epi_bf16(p.Qp, DM), bid, nb); }
    GRID_BAR();
    { const Prm p = PRM(); st_peertopk(p, l, shm, bid, nb); }
    if (PROBE == 4) { __syncthreads(); const Prm p = PRM(); st_peertopk(p, l, shm, bid, nb); }
    GRID_BAR();
    { const Prm p = PRM(); st_peergather(p, l, lf, bid, nb); }
    if (PROBE == 1) { __syncthreads(); const Prm p = PRM(); st_peergather(p, l, lf, bid, nb, true); }
    if (l == 0) GRID_BAR();
  }
#endif
#undef bid
#undef nb
#undef GRID_BAR
}

static size_t al256(size_t x) { return (x + 255) / 256 * 256; }
extern "C" void kernel_launch(void* const* d_in, const int* in_sizes, int n_in, void* d_out, int out_size, void* d_ws, size_t ws_size, hipStream_t stream) {
  Prm p{};
  const float** f = (const float**)&p.x;
  for (int i = 0; i < 24; ++i) f[i] = (const float*)d_in[i];
  p.out = (float*)d_out;
  char* w = (char*)d_ws; size_t o = 0;
  auto take = [&](size_t bytes) { char* r = w + o; o += al256(bytes); return r; };
  p.bar = (unsigned*)take(16384);
  p.WinT = (bf16_t*)take((size_t)2 * NZ * DM * 2); p.WoutT = (bf16_t*)take((size_t)2 * DM * DM * 2); p.WqT = (bf16_t*)take((size_t)2 * DM * DM * 2);
  p.WuqT = (bf16_t*)take((size_t)2 * 768 * 512 * 2); p.WukvT = (bf16_t*)take((size_t)2 * 1024 * 256 * 2);
  p.mod = (float*)take((size_t)2 * 9 * NMOD * 4); p.GB = (float*)take((size_t)MR * 16 * 4); p.CCS = (float*)take((size_t)2 * 128 * 128 * 4);
  p.DFTM = (bf16_t*)take((size_t)4096 * 8192 * 2); p.DFTC = (bf16_t*)take((size_t)256 * 512 * 2);
  p.X = (float*)take((size_t)MR * DM * 4);
  p.Z = (bf16_t*)take((size_t)MR * NZ * 2);
  char* ra = take((size_t)MR * 1536 * 2 + (size_t)4 * MR * 512 * 2);
  p.DNQ = (bf16_t*)ra; p.OB = (bf16_t*)(ra + (size_t)MR * 1536 * 2); p.H = (bf16_t*)ra;
  p.Ub = (bf16_t*)(ra + (size_t)MR * DM * 2); p.Vb = (bf16_t*)(ra + (size_t)MR * DM * 2 + (size_t)16384 * 1600);
  p.KV = (bf16_t*)take((size_t)MR * 1024 * 2); p.KR = (bf16_t*)take((size_t)MR * 64 * 2);
  p.Aq = (bf16_t*)take((size_t)MR * 512 * 2); p.Akv = (bf16_t*)take((size_t)MR * 256 * 2);
  if (o > ws_size) return;
  char* q = (char*)d_out; size_t oo = 0;
  p.Y = (bf16_t*)q; oo += (size_t)MR * DM * 2; p.PQT = (bf16_t*)(q + oo); oo += (size_t)8 * 512 * 8192 * 2; p.PQTc = (bf16_t*)(q + oo); oo += (size_t)8 * 512 * 512 * 2;
  p.Qraw = (bf16_t*)(q + oo); oo += (size_t)MR * 768 * 2;
  p.TINV = (bf16_t*)q; p.GCB = (float*)(q + (size_t)4352 * 4096 * 2); p.BC = (float*)(q + (size_t)4352 * 4096 * 2 + (size_t)4352 * 64 * 4);
  char* z = (char*)p.Z; p.H2 = (bf16_t*)z; p.Qp = (bf16_t*)(z + (size_t)MR * DM * 2); p.IDX = (int*)(z + (size_t)2 * MR * DM * 2); p.GATE = (float*)(z + (size_t)2 * MR * DM * 2 + (size_t)MR * 128 * 4);

  static int grid = 0;
  if (!grid) {
    (void)hipFuncSetAttribute((const void*)mega, hipFuncAttributeMaxDynamicSharedMemorySize, LDS_TOTAL);
    int dev = 0, cus = 0, per_cu = 0;
    (void)hipGetDevice(&dev); (void)hipDeviceGetAttribute(&cus, hipDeviceAttributeMultiprocessorCount, dev);
    (void)hipOccupancyMaxActiveBlocksPerMultiprocessor(&per_cu, (const void*)mega, NTHR, LDS_TOTAL);
    grid = per_cu >= 1 ? cus : 0;
    if (grid > 256) grid = 256;
  }
  if (grid < 256) return;
  (void)hipMemsetAsync(p.bar, 0, XCD_BAR_WORDS * sizeof(unsigned), stream);
  hipLaunchKernelGGL(mega, dim3(grid), dim3(NTHR), LDS_TOTAL, stream, p);
}
```

```cpp
#include <hip/hip_runtime.h>
#include <stdint.h>

constexpr int DM = 2048, NB = 8, LL = 4096, LCX = 256, LT = LL + LCX  , MR = NB * LT  ;
constexpr int NZ = 4864;
constexpr int C_DNQ = 0, C_DNK = 512, C_DNV = 1024, C_DNGATE = 1536, C_DNA = 2048, C_DNB = 2056, C_GQ = 2064, C_GK = 2320, C_GV = 2576,
              C_GGATE = 3088, C_GALPHA = 3600, C_CQ = 3632, C_CKV = 4080, C_KR = 4208, C_FN = 4272, IN_W = 4784;
constexpr int NMOD = 6 * DM;
constexpr float EPSV = 1e-6f;
constexpr int NTHR = 512;

typedef unsigned short bf16_t;
typedef short bf16x8 __attribute__((ext_vector_type(8)));
typedef short s16x4 __attribute__((ext_vector_type(4)));
typedef float f32x4 __attribute__((ext_vector_type(4)));
typedef float f32x16 __attribute__((ext_vector_type(16)));
typedef unsigned u32x4 __attribute__((ext_vector_type(4)));
typedef unsigned u32x2 __attribute__((ext_vector_type(2)));

#define DI __device__ __forceinline__
DI float bf2f(bf16_t b) { return __uint_as_float(((unsigned)b) << 16); }
DI bf16_t f2bf(float f) { unsigned u = __float_as_uint(f); u += 0x7FFFu + ((u >> 16) & 1u); return (bf16_t)(u >> 16); }
DI unsigned pack2(float lo, float hi) { return (unsigned)f2bf(lo) | ((unsigned)f2bf(hi) << 16); }
typedef float f32x2 __attribute__((ext_vector_type(2)));
DI float dpp_x1(float v) { return __int_as_float(__builtin_amdgcn_mov_dpp(__float_as_int(v), 0xB1, 0xf, 0xf, true)); }
DI float dpp_x2(float v) { return __int_as_float(__builtin_amdgcn_mov_dpp(__float_as_int(v), 0x4E, 0xf, 0xf, true)); }
DI float dpp_hm(float v) { return __int_as_float(__builtin_amdgcn_mov_dpp(__float_as_int(v), 0x141, 0xf, 0xf, true)); }
DI float dpp_rm(float v) { return __int_as_float(__builtin_amdgcn_mov_dpp(__float_as_int(v), 0x140, 0xf, 0xf, true)); }
DI float red4(float v) { v += dpp_x1(v); v += dpp_x2(v); return v; }
DI float red8(float v) { v += dpp_x1(v); v += dpp_x2(v); v += dpp_hm(v); return v; }
DI float rdl(float v, int l) { return __int_as_float(__builtin_amdgcn_readlane(__float_as_int(v), l)); }
DI float wsum(float v) { v += dpp_x1(v); v += dpp_x2(v); v += dpp_hm(v); v += dpp_rm(v); return (rdl(v, 0) + rdl(v, 16)) + (rdl(v, 32) + rdl(v, 48)); }
DI float wmax(float v) { v = fmaxf(v, dpp_x1(v)); v = fmaxf(v, dpp_x2(v)); v = fmaxf(v, dpp_hm(v)); v = fmaxf(v, dpp_rm(v)); return fmaxf(fmaxf(rdl(v, 0), rdl(v, 16)), fmaxf(rdl(v, 32), rdl(v, 48))); }
DI float siluf(float x) { return x / (1.f + __expf(-x)); }
DI float sigmf(float x) { return 1.f / (1.f + __expf(-x)); }

DI int ltid() { int t = (int)threadIdx.x; asm volatile("" : "+v"(t)); return t; }
DI int lsg(int v) { asm volatile("" : "+s"(v)); return v; }

struct Prm {
  const float *x, *c, *ctx, *c_ctx, *w_ada, *b_ada, *w_in, *dn_conv, *dn_a_log, *dn_dt_bias, *dn_norm, *gla_w2, *gla_b2, *gla_norm,
      *mla_q_norm, *mla_w_uq, *mla_kv_norm, *mla_w_ukv, *w_out, *peer_wq, *peer_keys, *peer_u, *peer_v, *final_norm;
  float* out;
  bf16_t *WinT, *WoutT, *WqT, *WuqT, *WukvT;
  float *mod, *GB, *CCS;
  bf16_t *DFTM, *DFTC;
  float* X;
  bf16_t* Z;
  bf16_t *H, *DNQ, *OB;
  bf16_t *KV, *KR;
  bf16_t *Y, *PQT, *PQTc, *Qraw, *Aq, *Akv;
  bf16_t *H2, *Qp;
  bf16_t *Ub, *Vb;
  bf16_t* TINV; float* GCB; float* BC;
  bf16_t* KB16;
  bf16_t* Xb;
  unsigned char* H2q;
  int* IDX;
  float* GATE;
  unsigned* bar;
};
#define XB_TMO      128
#define XB_XCNT(j)  (256  + 64 * (j))
#define XB_XSUB(j)  (1280 + 64 * (j))
#define XB_XGEN(j)  (2304 + 64 * (j))
#define XB_TOP      3328
#define XB_TOPGEN   3392
#define XCD_BAR_WORDS 3456
#define XB_SPIN_CAP (1u << 18)
#define LAS __attribute__((address_space(3)))

__device__ __forceinline__ unsigned xb_ld(unsigned* p)              { return __hip_atomic_load(p, __ATOMIC_RELAXED, __HIP_MEMORY_SCOPE_AGENT); }
__device__ __forceinline__ unsigned xb_add(unsigned* p, unsigned v) { return __hip_atomic_fetch_add(p, v, __ATOMIC_RELAXED, __HIP_MEMORY_SCOPE_AGENT); }
__device__ __forceinline__ unsigned xb_xcc_id() { return (unsigned)__builtin_amdgcn_s_getreg((3 << 11) | 20) & 0xFu; }
#define XB_SPIN(cond, bar) do { unsigned _sp = 0; while (cond) { __builtin_amdgcn_s_sleep(1); \
    if ((++_sp & 255u) == 0u) { if (xb_ld(&(bar)[XB_TMO])) break; if (_sp > XB_SPIN_CAP) { atomicAdd(&(bar)[XB_TMO], 1u); break; } } } } while (0)

struct XcdBarrier {
    unsigned* bar; unsigned x;
    volatile LAS unsigned* st;
};

__device__ __forceinline__ XcdBarrier xcd_barrier_post(unsigned* bar, volatile LAS unsigned* st) {
    XcdBarrier b; b.bar = bar; b.x = xb_xcc_id(); b.st = st;
    if (threadIdx.x == 0) (void)xb_add(&bar[XB_XCNT(b.x)], 1u);
    return b;
}
__device__ __forceinline__ void xcd_barrier_complete(unsigned* bar, unsigned x, unsigned& nloc, unsigned& nx) {
    const unsigned G = gridDim.x * gridDim.y * gridDim.z;
    unsigned sum, cnt, mine, sp = 0u;
    for (;;) {
        sum = 0u; cnt = 0u; mine = 0u;
#pragma unroll
        for (unsigned j = 0; j < 16; ++j) { const unsigned c = xb_ld(&bar[XB_XCNT(j)]); sum += c; cnt += (c > 0u) ? 1u : 0u; mine = (j == x) ? c : mine; }
        if (sum == G) break;
        __builtin_amdgcn_s_sleep(1);
        if ((++sp & 255u) == 0u) { if (xb_ld(&bar[XB_TMO])) break; if (sp > XB_SPIN_CAP) { atomicAdd(&bar[XB_TMO], 1u); break; } }
    }
    nloc = mine > 0u ? mine : 1u; nx = cnt > 0u ? cnt : 1u;
}

__device__ __forceinline__ void xcd_barrier(const XcdBarrier& b) {
    asm volatile("s_waitcnt vmcnt(0)" ::: "memory");
    __syncthreads();
    if (threadIdx.x == 0) {
        unsigned* bar = b.bar;
        __builtin_amdgcn_s_waitcnt(0);
        unsigned nloc = b.st[0], nx = b.st[1];
        if (nloc == 0u) { xcd_barrier_complete(bar, b.x, nloc, nx); b.st[0] = nloc; b.st[1] = nx; }
        const unsigned old = xb_add(&bar[XB_XSUB(b.x)], 1u);
        const unsigned gen = old / nloc;
        if (old + 1u == (gen + 1u) * nloc) {
            __builtin_amdgcn_fence(__ATOMIC_RELEASE, "agent");
            asm volatile("s_waitcnt vmcnt(0)" ::: "memory");
            const unsigned og = xb_add(&bar[XB_TOP], 1u);
            const unsigned tg = og / nx;
            if (og + 1u == (tg + 1u) * nx) xb_add(&bar[XB_TOPGEN], 1u);
            else XB_SPIN(xb_ld(&bar[XB_TOPGEN]) == tg, bar);
            __builtin_amdgcn_fence(__ATOMIC_ACQUIRE, "agent");
            xb_add(&bar[XB_XGEN(b.x)], 1u);
            asm volatile("s_waitcnt vmcnt(0)" ::: "memory");
        } else {
            XB_SPIN(xb_ld(&bar[XB_XGEN(b.x)]) == gen, bar);
            __builtin_amdgcn_fence(__ATOMIC_ACQUIRE, "agent");
            asm volatile("s_waitcnt vmcnt(0)" ::: "memory");
        }
    }
    __syncthreads();
}

namespace pg8 {
#define PG8_LAS __attribute__((address_space(3)))
typedef unsigned short bf16_t;
typedef short bf16x8 __attribute__((ext_vector_type(8)));
typedef float f32x4 __attribute__((ext_vector_type(4)));
typedef unsigned u32x4 __attribute__((ext_vector_type(4)));
constexpr int BM = 256, BK = 64, HALF = 128, HTB = HALF * BK * 2  , STAGE_BYTES = 8 * HTB, NXCD = 8, WGM = 8;

__host__ __device__ __forceinline__ int lds_byte(int r, int c) { const int st = (r >> 4) * 2 + (c >> 5), rr = r & 15, cc = c & 31, ob = rr * 64 + cc * 2; return st * 1024 + (ob ^ (((ob >> 9) & 1) << 5)); }
__host__ __device__ __forceinline__ void stage_rc(int b, int& R, int& C) { const int st = b / 1024, sb = b % 1024, swz = sb ^ (((sb >> 9) & 1) << 5); R = (st >> 1) * 16 + swz / 64; C = (st & 1) * 32 + (swz % 64) / 2; }
__host__ __device__ __forceinline__ int perm32(int rho) { const int n = rho >> 4, i = rho & 15; return 8 * (i >> 2) + 4 * n + (i & 3); }

struct Unit { int pm, pn; };
struct Gemm { const bf16_t* A; const bf16_t* Bt; int M, N, K; };

struct StaticOrder {
    int nM, nN, nwg, G, c;
    __host__ __device__ void init(int M, int N, int G_, int c_) { nM = M / BM; nN = N / BM; nwg = nM * nN; G = G_; c = c_; }
    __host__ __device__ bool next(int i, Unit& u) const {
        const long L = (long)i * G + c; if (L >= nwg) return false;
        int wgid = (int)L; { const int q = nwg / NXCD, r = nwg % NXCD, xcd = wgid % NXCD, off = wgid / NXCD; wgid = (xcd < r ? xcd * (q + 1) : r * (q + 1) + (xcd - r) * q) + off; }
        const int nig = WGM * nN, gid = wgid / nig, fm = gid * WGM, gsz = (nM - fm) < WGM ? (nM - fm) : WGM;
        u.pm = fm + ((wgid % nig) % gsz); u.pn = (wgid % nig) / gsz; return true;
    }
    __device__ __forceinline__ void a_ready(const Unit&) const {}
    __device__ __forceinline__ void done(const Unit&) const {}
};
struct CountedOrder : StaticOrder {
    const unsigned* ready; unsigned need; unsigned* tmo;
    __device__ __forceinline__ void a_ready(const Unit& u) const {
        if (threadIdx.x < 64) {
            const unsigned long long t0 = __builtin_amdgcn_s_memrealtime(); unsigned polls = 0;
            while ((unsigned)__builtin_amdgcn_readfirstlane(__hip_atomic_load(ready + 64 * u.pm, __ATOMIC_RELAXED, __HIP_MEMORY_SCOPE_AGENT)) < need) {
                if ((++polls & 255u) == 0u && __builtin_amdgcn_readfirstlane(__hip_atomic_load(tmo, __ATOMIC_RELAXED, __HIP_MEMORY_SCOPE_AGENT)) != 0u) break;
                if (__builtin_amdgcn_s_memrealtime() - t0 > 2000000ull) {
                    if (threadIdx.x == 0) { unsigned expect = 0u; __hip_atomic_compare_exchange_strong(tmo + 1, &expect, 0x600u | (unsigned)(u.pm & 0xff), __ATOMIC_RELAXED, __ATOMIC_RELAXED, __HIP_MEMORY_SCOPE_AGENT); __hip_atomic_store(tmo, 1u, __ATOMIC_RELAXED, __HIP_MEMORY_SCOPE_AGENT); }
                    break; }
                __builtin_amdgcn_s_sleep(2); }
            __builtin_amdgcn_fence(__ATOMIC_ACQUIRE, "agent");
            asm volatile("s_waitcnt vmcnt(0)" ::: "memory");
        }
#if !defined(BROKEN_HOOK_NO_BARRIER)
        asm volatile("" ::: "memory"); __builtin_amdgcn_s_barrier(); asm volatile("" ::: "memory");
#endif
    }
};

__device__ __forceinline__ unsigned cvt_pk_bf16(float lo, float hi) { unsigned r; asm volatile("v_cvt_pk_bf16_f32 %0, %1, %2" : "=v"(r) : "v"(lo), "v"(hi)); return r; }
typedef float f32x2 __attribute__((ext_vector_type(2)));
__device__ __forceinline__ f32x2 gelu_pk(f32x2 v) {
    const f32x2 av = __builtin_elementwise_abs(v), d = av * 0.2316418882f + 1.0f;
    f32x2 t; t.x = __builtin_amdgcn_rcpf(d.x); t.y = __builtin_amdgcn_rcpf(d.y);
    f32x2 q = t * 0.5307027145f + (-0.7265760135f); q = q * t + 0.7107068705f; q = q * t + (-0.142248368f); q = q * t + 0.127414796f; q = q * t;
    const f32x2 s = (v * v) * (-0.72134752044f);
    f32x2 e; e.x = __builtin_amdgcn_exp2f(s.x); e.y = __builtin_amdgcn_exp2f(s.y);
    const f32x2 m = v * (q * e), r = v - m;
    f32x2 o; o.x = v.x < 0.f ? m.x : r.x; o.y = v.y < 0.f ? m.y : r.y; return o;
}

struct EpiF32 {
    static constexpr bool PERM = false, AFTER_DRAIN = false;
    float* C; int ldc; const float* bias;
    __device__ __forceinline__ void operator()(const f32x4 (&acc)[2][2][4][2], const Unit& u, int wr, int wc, int fr, int fq) const {
        const int row0 = u.pm * BM + wr * 64 + fr, col0 = u.pn * BM + wc * 32 + 4 * fq;
        f32x4 bv[2][2];
#pragma unroll
        for (int bj = 0; bj < 2; ++bj)
#pragma unroll
            for (int n = 0; n < 2; ++n) bv[bj][n] = bias ? *(const f32x4*)(bias + col0 + bj * HALF + n * 16) : (f32x4){0.f, 0.f, 0.f, 0.f};
#pragma unroll
        for (int ai = 0; ai < 2; ++ai)
#pragma unroll
            for (int m = 0; m < 4; ++m) { float* rowp = C + (size_t)(row0 + ai * HALF + m * 16) * ldc + col0;
#pragma unroll
                for (int bj = 0; bj < 2; ++bj)
#pragma unroll
                    for (int n = 0; n < 2; ++n) *(f32x4*)(rowp + bj * HALF + n * 16) = acc[ai][bj][m][n] + bv[bj][n]; }
    }
};
template <int ACT  > struct EpiBf16 {
    static constexpr bool PERM = true, AFTER_DRAIN = false;
    bf16_t* O; int ldc; const float* bias; int split_cols; size_t split_stride;
    __device__ __forceinline__ void operator()(const f32x4 (&acc)[2][2][4][2], const Unit& u, int wr, int wc, int fr, int fq) const {
        const int row0 = u.pm * BM + wr * 64 + fr; int colt = u.pn * BM; bf16_t* base = O;
        if (split_cols) { const int t = colt / split_cols; base += (size_t)t * split_stride; colt -= t * split_cols; }
        const int col0 = colt + wc * 32 + 8 * fq, bcol0 = u.pn * BM + wc * 32 + 8 * fq;
        f32x4 bv[2][2];
#pragma unroll
        for (int bj = 0; bj < 2; ++bj)
#pragma unroll
            for (int n = 0; n < 2; ++n) bv[bj][n] = bias ? *(const f32x4*)(bias + bcol0 + bj * HALF + 4 * n) : (f32x4){0.f, 0.f, 0.f, 0.f};
#pragma unroll
        for (int ai = 0; ai < 2; ++ai)
#pragma unroll
            for (int m = 0; m < 4; ++m) { bf16_t* rowp = base + (size_t)(row0 + ai * HALF + m * 16) * ldc + col0;
#pragma unroll
                for (int bj = 0; bj < 2; ++bj) { f32x4 v0 = acc[ai][bj][m][0] + bv[bj][0], v1 = acc[ai][bj][m][1] + bv[bj][1];
                    if (ACT == 1) { f32x2 a = gelu_pk((f32x2){v0[0], v0[1]}), b = gelu_pk((f32x2){v0[2], v0[3]}), c = gelu_pk((f32x2){v1[0], v1[1]}), d = gelu_pk((f32x2){v1[2], v1[3]});
                        v0 = (f32x4){a.x, a.y, b.x, b.y}; v1 = (f32x4){c.x, c.y, d.x, d.y}; }
                    if (ACT == 2) {
#pragma unroll
                        for (int j = 0; j < 4; ++j) { v0[j] = 0.5f * v0[j] * (1.0f + erff(v0[j] * 0.70710678f)); v1[j] = 0.5f * v1[j] * (1.0f + erff(v1[j] * 0.70710678f)); } }
                    u32x4 w; w.x = cvt_pk_bf16(v0[0], v0[1]); w.y = cvt_pk_bf16(v0[2], v0[3]); w.z = cvt_pk_bf16(v1[0], v1[1]); w.w = cvt_pk_bf16(v1[2], v1[3]);
                    *(u32x4*)(rowp + bj * HALF) = w; } }
    }
};
template <class Epi, class Sched, bool STAMP = false>
__device__ __forceinline__ void gemm_phase(PG8_LAS unsigned char* lds, const Gemm g, const Sched& S, const Epi& E, unsigned long long* stamps) {
    const int tid = ltid(), wid = __builtin_amdgcn_readfirstlane(tid >> 6), lane = tid & 63, wr = wid >> 2, wc = wid & 3, fr = lane & 15, fq = lane >> 4;
    const int K = g.K, nt = K / BK;
    int ts_lo = 0, ts_hi = 0, nts = 0; const unsigned long long rt_entry = STAMP ? (unsigned long long)wall_clock64() : 0ull;
#define PG8_STAMP() do { if (STAMP && wid == 0 && nts < 64) { const unsigned long long _c = (unsigned long long)clock64(); \
        ts_lo = (lane == nts) ? (int)(unsigned)_c : ts_lo; ts_hi = (lane == nts) ? (int)(unsigned)(_c >> 32) : ts_hi; ++nts; } } while (0)
    PG8_STAMP();
    unsigned voffA[2], voffB[2];
#pragma unroll
    for (int i = 0; i < 2; ++i) { int R, C; stage_rc(tid * 16 + i * 8192, R, C); const int Rb = Epi::PERM ? ((R & ~31) + perm32(R & 31)) : R;
        voffA[i] = (unsigned)(R * K + C) * 2u; voffB[i] = (unsigned)(Rb * K + C) * 2u; }
    const size_t kstep = (size_t)(BK * 2);
    const size_t hstep = (size_t)HALF * K * 2;
    const size_t tstep = 2 * hstep;
    const unsigned ldsw = (unsigned)wid * 1024u;
    const int aoff = lds_byte(wr * 64 + fr, fq * 8), boff = lds_byte(wc * 32 + fr, fq * 8);
#define PG8_SA(b, h) (((b) * 2 + (h)) * HTB)
#define PG8_SB(b, h) ((4 + (b) * 2 + (h)) * HTB)
#define PG8_STAGE(bufoff, gbase, voff) do { _Pragma("unroll") for (int _i = 0; _i < 2; ++_i) \
        __builtin_amdgcn_global_load_lds((const unsigned*)((const char*)(gbase) + (voff)[_i]), (PG8_LAS unsigned*)(lds + (bufoff) + ldsw + _i * 8192), 16, 0, 0); } while (0)
#define PG8_LDA(dst, b, h) do { _Pragma("unroll") for (int m = 0; m < 4; ++m) _Pragma("unroll") for (int k = 0; k < 2; ++k) dst[m][k] = *(const PG8_LAS bf16x8*)(lds + PG8_SA(b, h) + aoff + m * 2048 + k * 1024); } while (0)
#define PG8_LDB(dst, b, h) do { _Pragma("unroll") for (int n = 0; n < 2; ++n) _Pragma("unroll") for (int k = 0; k < 2; ++k) dst[n][k] = *(const PG8_LAS bf16x8*)(lds + PG8_SB(b, h) + boff + n * 2048 + k * 1024); } while (0)
#define PG8_MMA(ai, bj, At, Bt) do { __builtin_amdgcn_s_setprio(1); _Pragma("unroll") for (int m = 0; m < 4; ++m) _Pragma("unroll") for (int n = 0; n < 2; ++n) _Pragma("unroll") for (int k = 0; k < 2; ++k) \
        acc[ai][bj][m][n] = __builtin_amdgcn_mfma_f32_16x16x32_bf16(Bt[n][k], At[m][k], acc[ai][bj][m][n], 0, 0, 0); __builtin_amdgcn_s_setprio(0); } while (0)
#define PG8_WAIT_V(n) asm volatile("s_waitcnt vmcnt(" #n ")" ::: "memory")
#define PG8_WAIT_L(n) asm volatile("s_waitcnt lgkmcnt(" #n ")" ::: "memory")
#define PG8_BAR __builtin_amdgcn_s_barrier()
#define PG8_SCHED __builtin_amdgcn_sched_barrier(0)
    Unit cur, nxt; int ui = 0;
    if (!S.next(0, cur)) return;
    f32x4 acc[2][2][4][2];
#pragma unroll
    for (int a = 0; a < 2; ++a)
#pragma unroll
        for (int b = 0; b < 2; ++b)
#pragma unroll
            for (int m = 0; m < 4; ++m)
#pragma unroll
                for (int n = 0; n < 2; ++n) acc[a][b][m][n] = (f32x4){0.f, 0.f, 0.f, 0.f};
    bf16x8 At[4][2], B0[2][2], B1[2][2];
    const char* cA = (const char*)g.A + (size_t)cur.pm * tstep; const char* cB = (const char*)g.Bt + (size_t)cur.pn * tstep;
    S.a_ready(cur);
    PG8_STAGE(PG8_SB(0, 0), cB, voffB); PG8_STAGE(PG8_SA(0, 0), cA, voffA); PG8_STAGE(PG8_SB(0, 1), cB + hstep, voffB); PG8_STAGE(PG8_SA(0, 1), cA + hstep, voffA);
    if (wr == 1) PG8_BAR;
    PG8_WAIT_V(4); PG8_BAR;
    PG8_STAGE(PG8_SB(1, 0), cB + kstep, voffB); PG8_STAGE(PG8_SA(1, 0), cA + kstep, voffA); PG8_STAGE(PG8_SB(1, 1), cB + hstep + kstep, voffB);
    PG8_WAIT_V(6); PG8_BAR;
    PG8_STAMP();
    for (;;) {
        const bool has_next = S.next(ui + 1, nxt);
        const char* nA = has_next ? (const char*)g.A + (size_t)nxt.pm * tstep : cA; const char* nB = has_next ? (const char*)g.Bt + (size_t)nxt.pn * tstep : cB;
        for (int t = 0; t < nt; t += 2) {
            const bool last = (t == nt - 2);
            const char* a1 = cA + (size_t)(t + 1) * kstep;
            const char* a2 = last ? nA : cA + (size_t)(t + 2) * kstep; const char* b2 = last ? nB : cB + (size_t)(t + 2) * kstep;
            const char* a3 = a2 + kstep; const char* b3 = b2 + kstep;
            if (last && has_next) S.a_ready(nxt);
            PG8_LDB(B0, 0, 0); PG8_SCHED; PG8_LDA(At, 0, 0); PG8_STAGE(PG8_SA(1, 1), a1 + hstep, voffA);
            PG8_WAIT_L(8); PG8_BAR; PG8_WAIT_L(0); PG8_MMA(0, 0, At, B0); PG8_BAR; PG8_SCHED;
            PG8_LDB(B1, 0, 1); PG8_STAGE(PG8_SB(0, 0), b2, voffB);
            PG8_BAR; PG8_WAIT_L(0); PG8_MMA(0, 1, At, B1); PG8_BAR;
            PG8_LDA(At, 0, 1); PG8_STAGE(PG8_SA(0, 0), a2, voffA);
            PG8_BAR; PG8_WAIT_L(0); PG8_MMA(1, 0, At, B0); PG8_BAR; PG8_SCHED;
            PG8_STAGE(PG8_SB(0, 1), b2 + hstep, voffB);
            PG8_WAIT_V(6); PG8_BAR; PG8_MMA(1, 1, At, B1); PG8_BAR;
            PG8_LDB(B0, 1, 0); PG8_SCHED; PG8_LDA(At, 1, 0); PG8_STAGE(PG8_SA(0, 1), a2 + hstep, voffA);
            PG8_WAIT_L(8); PG8_BAR; PG8_WAIT_L(0); PG8_MMA(0, 0, At, B0); PG8_BAR; PG8_SCHED;
            PG8_LDB(B1, 1, 1); PG8_STAGE(PG8_SB(1, 0), b3, voffB);
            PG8_BAR; PG8_WAIT_L(0); PG8_MMA(0, 1, At, B1); PG8_BAR;
            PG8_LDA(At, 1, 1); PG8_STAGE(PG8_SA(1, 0), a3, voffA);
            PG8_BAR; PG8_WAIT_L(0); PG8_MMA(1, 0, At, B0); PG8_BAR; PG8_SCHED;
            PG8_STAGE(PG8_SB(1, 1), b3 + hstep, voffB);
            PG8_WAIT_V(6); PG8_BAR; PG8_MMA(1, 1, At, B1); PG8_BAR;
        }
        PG8_STAMP();
        if constexpr (!Epi::AFTER_DRAIN) { E(acc, cur, wr, wc, fr, fq); S.done(cur); }
        PG8_STAMP();
        if (!has_next) break;
#pragma unroll
        for (int a = 0; a < 2; ++a)
#pragma unroll
            for (int b = 0; b < 2; ++b)
#pragma unroll
                for (int m = 0; m < 4; ++m)
#pragma unroll
                    for (int n = 0; n < 2; ++n) acc[a][b][m][n] = (f32x4){0.f, 0.f, 0.f, 0.f};
        cur = nxt; cA = nA; cB = nB; ++ui;
    }
    PG8_WAIT_V(0);
    if (wr == 0) PG8_BAR;
    PG8_BAR;
    if constexpr (Epi::AFTER_DRAIN) { E.fused(acc, cur, wr, wc, fr, fq, lds, wid, lane); S.done(cur); }
    PG8_STAMP();
    if (STAMP && wid == 0) { stamps[lane] = lane < nts ? (((unsigned long long)(unsigned)ts_hi << 32) | (unsigned)ts_lo) : 0ull;
        if (lane == 62) stamps[62] = rt_entry; if (lane == 63) stamps[63] = (unsigned long long)wall_clock64(); }
#undef PG8_STAMP
#undef PG8_SA
#undef PG8_SB
#undef PG8_STAGE
#undef PG8_LDA
#undef PG8_LDB
#undef PG8_MMA
#undef PG8_WAIT_V
#undef PG8_WAIT_L
#undef PG8_BAR
#undef PG8_SCHED
}
}
namespace pg8 {
typedef int v8i_t __attribute__((ext_vector_type(8)));
typedef int v4i_t __attribute__((ext_vector_type(4)));
constexpr int W8_SCALE = 0x7c7c7c7c;
__device__ __forceinline__ v8i_t cat16(bf16x8 a, bf16x8 b) { const v4i_t x = __builtin_bit_cast(v4i_t, a), y = __builtin_bit_cast(v4i_t, b); return (v8i_t){x[0], x[1], x[2], x[3], y[0], y[1], y[2], y[3]}; }
template <class Epi, class Sched, bool STAMP = false>
__device__ __forceinline__ void gemm_phase_f8(PG8_LAS unsigned char* lds, const Gemm g, const Sched& S, const Epi& E, unsigned long long* stamps, const int ascale = W8_SCALE) {
    const int tid = ltid(), wid = __builtin_amdgcn_readfirstlane(tid >> 6), lane = tid & 63, wr = wid >> 2, wc = wid & 3, fr = lane & 15, fq = lane >> 4;
    const int K = g.K, nt = K / BK;
    int ts_lo = 0, ts_hi = 0, nts = 0; const unsigned long long rt_entry = STAMP ? (unsigned long long)wall_clock64() : 0ull;
#define PG8_STAMP() do { if (STAMP && wid == 0 && nts < 64) { const unsigned long long _c = (unsigned long long)clock64(); \
        ts_lo = (lane == nts) ? (int)(unsigned)_c : ts_lo; ts_hi = (lane == nts) ? (int)(unsigned)(_c >> 32) : ts_hi; ++nts; } } while (0)
    PG8_STAMP();
    unsigned voffA[2], voffB[2];
#pragma unroll
    for (int i = 0; i < 2; ++i) { int R, C; stage_rc(tid * 16 + i * 8192, R, C); const int Rb = Epi::PERM ? ((R & ~31) + perm32(R & 31)) : R;
        voffA[i] = (unsigned)(R * K + C) * 2u; voffB[i] = (unsigned)(Rb * K + C) * 2u; }
    const size_t kstep = (size_t)(BK * 2);
    const size_t hstep = (size_t)HALF * K * 2;
    const size_t tstep = 2 * hstep;
    const unsigned ldsw = (unsigned)wid * 1024u;
    const int fh = fq >> 1;
    const int aoff0 = lds_byte(wr * 64 + fr, 16 * fq + 8 * fh), aoff1 = lds_byte(wr * 64 + fr, 16 * fq + 8 * (1 - fh)), boff0 = lds_byte(wc * 32 + fr, 16 * fq + 8 * fh), boff1 = lds_byte(wc * 32 + fr, 16 * fq + 8 * (1 - fh));
#define PG8_SA(b, h) (((b) * 2 + (h)) * HTB)
#define PG8_SB(b, h) ((4 + (b) * 2 + (h)) * HTB)
#define PG8_STAGE(bufoff, gbase, voff) do { _Pragma("unroll") for (int _i = 0; _i < 2; ++_i) \
        __builtin_amdgcn_global_load_lds((const unsigned*)((const char*)(gbase) + (voff)[_i]), (PG8_LAS unsigned*)(lds + (bufoff) + ldsw + _i * 8192), 16, 0, 0); } while (0)
#define PG8_LD8(a0, a1) __builtin_shufflevector(*(const PG8_LAS v4i_t*)(a0), *(const PG8_LAS v4i_t*)(a1), 0, 1, 2, 3, 4, 5, 6, 7)
#define PG8_LDA(dst, b, h) do { _Pragma("unroll") for (int m = 0; m < 4; ++m) dst[m] = PG8_LD8(lds + PG8_SA(b, h) + aoff0 + m * 2048, lds + PG8_SA(b, h) + aoff1 + m * 2048); } while (0)
#define PG8_LDB(dst, b, h) do { _Pragma("unroll") for (int n = 0; n < 2; ++n) dst[n] = PG8_LD8(lds + PG8_SB(b, h) + boff0 + n * 2048, lds + PG8_SB(b, h) + boff1 + n * 2048); } while (0)
#define PG8_MMA(ai, bj, At, Bt) do { __builtin_amdgcn_s_setprio(1); _Pragma("unroll") for (int m = 0; m < 4; ++m) _Pragma("unroll") for (int n = 0; n < 2; ++n) \
        asm volatile("v_mfma_scale_f32_16x16x128_f8f6f4 %0, %1, %2, %0, %3, %4 op_sel_hi:[0,0,0]" : "+v"(acc[ai][bj][m][n]) : "v"(Bt[n]), "v"(At[m]), "v"(w8s), "v"(a8s)); __builtin_amdgcn_s_setprio(0); } while (0)
#define PG8_WAIT_V(n) asm volatile("s_waitcnt vmcnt(" #n ")" ::: "memory")
#define PG8_WAIT_L(n) asm volatile("s_waitcnt lgkmcnt(" #n ")" ::: "memory")
#define PG8_BAR __builtin_amdgcn_s_barrier()
#define PG8_SCHED __builtin_amdgcn_sched_barrier(0)
    Unit cur, nxt; int ui = 0;
    if (!S.next(0, cur)) return;
    f32x4 acc[2][2][4][2];
#pragma unroll
    for (int a = 0; a < 2; ++a)
#pragma unroll
        for (int b = 0; b < 2; ++b)
#pragma unroll
            for (int m = 0; m < 4; ++m)
#pragma unroll
                for (int n = 0; n < 2; ++n) acc[a][b][m][n] = (f32x4){0.f, 0.f, 0.f, 0.f};
    v8i_t At[4], B0[2], B1[2]; const int w8s = W8_SCALE, a8s = ascale;
    const char* cA = (const char*)g.A + (size_t)cur.pm * tstep; const char* cB = (const char*)g.Bt + (size_t)cur.pn * tstep;
    S.a_ready(cur);
    PG8_STAGE(PG8_SB(0, 0), cB, voffB); PG8_STAGE(PG8_SA(0, 0), cA, voffA); PG8_STAGE(PG8_SB(0, 1), cB + hstep, voffB); PG8_STAGE(PG8_SA(0, 1), cA + hstep, voffA);
    if (wr == 1) PG8_BAR;
    PG8_WAIT_V(4); PG8_BAR;
    PG8_STAGE(PG8_SB(1, 0), cB + kstep, voffB); PG8_STAGE(PG8_SA(1, 0), cA + kstep, voffA); PG8_STAGE(PG8_SB(1, 1), cB + hstep + kstep, voffB);
    PG8_WAIT_V(6); PG8_BAR;
    PG8_STAMP();
    for (;;) {
        const bool has_next = S.next(ui + 1, nxt);
        const char* nA = has_next ? (const char*)g.A + (size_t)nxt.pm * tstep : cA; const char* nB = has_next ? (const char*)g.Bt + (size_t)nxt.pn * tstep : cB;
        for (int t = 0; t < nt; t += 2) {
            const bool last = (t == nt - 2);
            const char* a1 = cA + (size_t)(t + 1) * kstep;
            const char* a2 = last ? nA : cA + (size_t)(t + 2) * kstep; const char* b2 = last ? nB : cB + (size_t)(t + 2) * kstep;
            const char* a3 = a2 + kstep; const char* b3 = b2 + kstep;
            if (last && has_next) S.a_ready(nxt);
            PG8_LDB(B0, 0, 0); PG8_SCHED; PG8_LDA(At, 0, 0); PG8_STAGE(PG8_SA(1, 1), a1 + hstep, voffA);
            PG8_WAIT_L(8); PG8_BAR; PG8_WAIT_L(0); PG8_MMA(0, 0, At, B0); PG8_BAR; PG8_SCHED;
            PG8_LDB(B1, 0, 1); PG8_STAGE(PG8_SB(0, 0), b2, voffB);
            PG8_BAR; PG8_WAIT_L(0); PG8_MMA(0, 1, At, B1); PG8_BAR;
            PG8_LDA(At, 0, 1); PG8_STAGE(PG8_SA(0, 0), a2, voffA);
            PG8_BAR; PG8_WAIT_L(0); PG8_MMA(1, 0, At, B0); PG8_BAR; PG8_SCHED;
            PG8_STAGE(PG8_SB(0, 1), b2 + hstep, voffB);
            PG8_WAIT_V(6); PG8_BAR; PG8_MMA(1, 1, At, B1); PG8_BAR;
            PG8_LDB(B0, 1, 0); PG8_SCHED; PG8_LDA(At, 1, 0); PG8_STAGE(PG8_SA(0, 1), a2 + hstep, voffA);
            PG8_WAIT_L(8); PG8_BAR; PG8_WAIT_L(0); PG8_MMA(0, 0, At, B0); PG8_BAR; PG8_SCHED;
            PG8_LDB(B1, 1, 1); PG8_STAGE(PG8_SB(1, 0), b3, voffB);
            PG8_BAR; PG8_WAIT_L(0); PG8_MMA(0, 1, At, B1); PG8_BAR;
            PG8_LDA(At, 1, 1); PG8_STAGE(PG8_SA(1, 0), a3, voffA);
            PG8_BAR; PG8_WAIT_L(0); PG8_MMA(1, 0, At, B0); PG8_BAR; PG8_SCHED;
            PG8_STAGE(PG8_SB(1, 1), b3 + hstep, voffB);
            PG8_WAIT_V(6); PG8_BAR; PG8_MMA(1, 1, At, B1); PG8_BAR;
        }
        PG8_STAMP();
        asm volatile("s_nop 15\n\ts_nop 15" ::: "memory");
        if constexpr (!Epi::AFTER_DRAIN) { E(acc, cur, wr, wc, fr, fq); S.done(cur); }
        PG8_STAMP();
        if (!has_next) break;
#pragma unroll
        for (int a = 0; a < 2; ++a)
#pragma unroll
            for (int b = 0; b < 2; ++b)
#pragma unroll
                for (int m = 0; m < 4; ++m)
#pragma unroll
                    for (int n = 0; n < 2; ++n) acc[a][b][m][n] = (f32x4){0.f, 0.f, 0.f, 0.f};
        cur = nxt; cA = nA; cB = nB; ++ui;
    }
    PG8_WAIT_V(0);
    if (wr == 0) PG8_BAR;
    PG8_BAR;
    if constexpr (Epi::AFTER_DRAIN) { E.fused(acc, cur, wr, wc, fr, fq, lds, wid, lane); S.done(cur); }
    PG8_STAMP();
    if (STAMP && wid == 0) { stamps[lane] = lane < nts ? (((unsigned long long)(unsigned)ts_hi << 32) | (unsigned)ts_lo) : 0ull;
        if (lane == 62) stamps[62] = rt_entry; if (lane == 63) stamps[63] = (unsigned long long)wall_clock64(); }
#undef PG8_STAMP
#undef PG8_SA
#undef PG8_SB
#undef PG8_STAGE
#undef PG8_LDA
#undef PG8_LD8
#undef PG8_LDB
#undef PG8_MMA
#undef PG8_WAIT_V
#undef PG8_WAIT_L
#undef PG8_BAR
#undef PG8_SCHED
}
}

DI void st_transpose(const float* __restrict__ src, bf16_t* __restrict__ dst, int K, int N, int Kpad, int Npad, float* lds, int bid, int nb) {
  const int tk = Kpad / 64, tn = Npad / 64;
  for (int it = bid; it < tk * tn; it += nb) {
    const int k0 = (it % tk) * 64, n0 = (it / tk) * 64;
    __syncthreads();
    for (int e = ltid(); e < 4096; e += NTHR) { const int i = e >> 6, j = e & 63, k = k0 + i, n = n0 + j; lds[i * 65 + j] = (k < K && n < N) ? src[(size_t)k * N + n] : 0.f; }
    __syncthreads();
    { const int e = ltid(), j = e >> 3, i8 = (e & 7) * 8; u32x4 w;
      w.x = pack2(lds[i8 * 65 + j], lds[(i8 + 1) * 65 + j]); w.y = pack2(lds[(i8 + 2) * 65 + j], lds[(i8 + 3) * 65 + j]);
      w.z = pack2(lds[(i8 + 4) * 65 + j], lds[(i8 + 5) * 65 + j]); w.w = pack2(lds[(i8 + 6) * 65 + j], lds[(i8 + 7) * 65 + j]);
      *(u32x4*)(dst + (size_t)(n0 + j) * Kpad + k0 + i8) = w; }
  }
}

constexpr float Y8S = 8.f;
DI float y8c(float y) { return __builtin_amdgcn_fmed3f(y * Y8S, -448.f, 448.f); }
DI float c8(float x) { return __builtin_amdgcn_fmed3f(x, -448.f, 448.f); }
DI unsigned pk4_fp8(float a, float b, float c, float d) { int r = 0; r = __builtin_amdgcn_cvt_pk_fp8_f32(c8(a), c8(b), r, false); r = __builtin_amdgcn_cvt_pk_fp8_f32(c8(c), c8(d), r, true); return (unsigned)r; }
DI void st_transpose8(const float* __restrict__ src, unsigned char* __restrict__ dst, int K, int N, int Kpad, int Npad, float sc, float* lds, int bid, int nb) {
  const int tk = Kpad / 64, tn = Npad / 64;
  for (int it = bid; it < tk * tn; it += nb) {
    const int k0 = (it % tk) * 64, n0 = (it / tk) * 64;
    __syncthreads();
    for (int e = ltid(); e < 4096; e += NTHR) { const int i = e >> 6, j = e & 63, k = k0 + i, n = n0 + j; lds[i * 65 + j] = (k < K && n < N) ? src[(size_t)k * N + n] * sc : 0.f; }
    __syncthreads();
    { const int e = ltid(), j = e >> 3, i8 = (e & 7) * 8; u32x2 w;
      w.x = pk4_fp8(lds[i8 * 65 + j], lds[(i8 + 1) * 65 + j], lds[(i8 + 2) * 65 + j], lds[(i8 + 3) * 65 + j]); w.y = pk4_fp8(lds[(i8 + 4) * 65 + j], lds[(i8 + 5) * 65 + j], lds[(i8 + 6) * 65 + j], lds[(i8 + 7) * 65 + j]);
      *(u32x2*)(dst + (size_t)(n0 + j) * Kpad + k0 + i8) = w; }
  }
}

DI void st_mods(const Prm& p, float* lds, int bid, int nb) {
  float* s = lds; float* red = lds + 9 * 2048;
  for (int e = ltid(); e < 9 * 2048; e += NTHR) { const int r = e >> 11, k = e & 2047; const float v = r < 8 ? p.c[r * 2048 + k] : p.c_ctx[k]; s[e] = siluf(v); }
  __syncthreads();
  const int kg = ltid() >> 6, cl = ltid() & 63;
  for (int it = bid; it < 2 * 192; it += nb) {
    const int l = it / 192, cb = (it % 192) * 64;
    const float* w = p.w_ada + (size_t)l * 2048 * NMOD + cb + cl;
    float acc[9];
#pragma unroll
    for (int r = 0; r < 9; ++r) acc[r] = 0.f;
    for (int k0 = kg * 256; k0 < kg * 256 + 256; k0 += 16) { float wv[16];
#pragma unroll
      for (int i = 0; i < 16; ++i) wv[i] = w[(size_t)(k0 + i) * NMOD];
#pragma unroll
      for (int i = 0; i < 16; ++i)
#pragma unroll
        for (int r = 0; r < 9; ++r) acc[r] += s[r * 2048 + k0 + i] * wv[i]; }
#pragma unroll
    for (int r = 0; r < 9; ++r) red[(kg * 9 + r) * 64 + cl] = acc[r];
    __syncthreads();
    for (int e = ltid(); e < 576; e += NTHR) { const int r = e >> 6, c2 = e & 63; float t = 0.f;
      for (int g = 0; g < 8; ++g) t += red[(g * 9 + r) * 64 + c2];
      p.mod[((size_t)l * 9 + r) * NMOD + cb + c2] = t + p.b_ada[l * NMOD + cb + c2]; }
    __syncthreads();
  }
}

DI void st_tables(const Prm& p, int bid, int nb) {
  const size_t stride = (size_t)nb * NTHR, t0 = (size_t)bid * NTHR + ltid();
  for (size_t e = t0; e < (size_t)256 * 512; e += stride) { const int k1 = (int)(e >> 9), n = (int)(e & 511), n1 = n & 255, idx = (k1 * n1) & 255;
    float sv, cv; sincosf((float)idx * (6.283185307179586f / 256.f), &sv, &cv); p.DFTC[e] = f2bf((n < 256 ? cv : -sv) * (1.f / 16.f)); }
  for (size_t e = t0; e < (size_t)2 * 128 * 128; e += stride) { const int tb = (int)(e >> 14), k2 = (int)((e >> 7) & 127), n2 = (int)(e & 127), idx = (k2 * n2) & 127;
    float sv, cv; sincosf((float)idx * (6.283185307179586f / 128.f), &sv, &cv); p.CCS[e] = (tb ? sv : cv) * 0.08838834764831845f; }
}

DI void st_modulate(const Prm& p, int layer, int which, bf16_t* __restrict__ dst, int bid, int nb) {
  const int wave = ltid() >> 6, lane = ltid() & 63;
  const int shoff = which ? 3 * DM : 0, scoff = which ? 4 * DM : DM;
  for (int row = bid * 8 + wave; row < MR; row += nb * 8) {
    const int b = row / LT, t = row - b * LT; const bool isc = t >= LL;
    if (isc && layer == 1 && which == 1) continue;
    const float* src = isc ? p.ctx + (size_t)(b * LCX + t - LL) * DM : p.x + (size_t)(b * LL + t) * DM;
    f32x4 v[8]; float ss = 0.f;
#pragma unroll
    for (int i = 0; i < 8; ++i) {
      if (layer == 0 && which == 0) v[i] = *(const f32x4*)(src + (i * 64 + lane) * 4);
      else { const u32x2 w = *(const u32x2*)(p.Xb + (size_t)row * DM + (i * 64 + lane) * 4); v[i] = (f32x4){__uint_as_float(w.x << 16), __uint_as_float(w.x & 0xffff0000u), __uint_as_float(w.y << 16), __uint_as_float(w.y & 0xffff0000u)}; }
      ss += v[i][0] * v[i][0] + v[i][1] * v[i][1] + v[i][2] * v[i][2] + v[i][3] * v[i][3]; }
    ss = wsum(ss); const float rstd = rsqrtf(ss * (1.f / 2048.f) + EPSV);
    const float* mr = p.mod + ((size_t)layer * 9 + (isc ? 8 : b)) * NMOD;
#pragma unroll
    for (int i = 0; i < 8; ++i) { const int col = (i * 64 + lane) * 4; const f32x4 sc = *(const f32x4*)(mr + scoff + col), sh = *(const f32x4*)(mr + shoff + col);
      const f32x4 o = v[i] * rstd * (sc + 1.f) + sh;
      if (which == 0) *(unsigned*)((unsigned char*)dst + (size_t)row * DM + col) = pk4_fp8(o[0], o[1], o[2], o[3]);
      else *(unsigned*)(p.H2q + (size_t)row * DM + col) = pk4_fp8(o[0], o[1], o[2], o[3]); }
  }
}

DI void st_dnprep(const Prm& p, int layer, int bid, int nb) {
  const int wave = ltid() >> 6, lane = ltid() & 63;
  const float* conv = p.dn_conv + (size_t)layer * 5 * 1536;
  for (int task = bid * 8 + wave; task < (MR / 32) * 13; task += nb * 8) {
    const int tile = task / 13, grp = task - tile * 13, row0 = tile * 32;
    const int b = row0 / LT, t0 = row0 - b * LT; const bool isc = t0 >= LL;
    const int segt0 = isc ? t0 - LL : t0, seglen = isc ? LCX : LL;
    if (grp < 12) {
      const int c = grp * 128 + lane * 2;
      float w0[5], w1[5];
#pragma unroll
      for (int j = 0; j < 5; ++j) { w0[j] = conv[j * 1536 + c]; w1[j] = conv[j * 1536 + c + 1]; }
      unsigned zz[36];
#pragma unroll
      for (int r = 0; r < 36; ++r) { const int tt = segt0 + r - 2; zz[r] = (tt >= 0 && tt < seglen) ? *(const unsigned*)(p.Z + (size_t)(row0 + r - 2) * NZ + c) : 0u; }
#pragma unroll
      for (int r = 0; r < 32; ++r) { float a0 = 0.f, a1 = 0.f;
#pragma unroll
        for (int j = 0; j < 5; ++j) { a0 += __uint_as_float(zz[r + j] << 16) * w0[j]; a1 += __uint_as_float(zz[r + j] & 0xffff0000u) * w1[j]; }
        a0 = siluf(a0); a1 = siluf(a1);
        if (grp < 8) { const float ss = wsum(a0 * a0 + a1 * a1); const float sc = rsqrtf(ss + EPSV) * (grp < 4 ? 0.08838834764831845f : 1.f); a0 *= sc; a1 *= sc; }
        *(unsigned*)(p.DNQ + (size_t)(row0 + r) * 1536 + c) = pack2(a0, a1); }
    } else {
#pragma unroll
      for (int rr = 0; rr < 8; ++rr) { const int idx = lane + 64 * rr, row = row0 + (idx >> 4), wh = idx & 15, isb = wh >> 3, dh = wh & 7;
        const float z = bf2f(p.Z[(size_t)row * NZ + (isb ? C_DNB : C_DNA) + dh]); float o;
        if (!isb) { const float xx = z + p.dn_dt_bias[layer * 8 + dh]; const float sp = xx > 20.f ? xx : log1pf(expf(xx)); o = -expf(p.dn_a_log[layer * 8 + dh]) * sp; }
        else o = sigmf(z);
        p.GB[(size_t)row * 16 + wh] = o; }
    }
  }
}

DI void st_mlaprep(const Prm& p, int layer, int bid, int nb) {
  const int wave = ltid() >> 6, lane = ltid() & 63;
  const float* qn = p.mla_q_norm + layer * 448; const float* kvn = p.mla_kv_norm + layer * 128;
  for (int row = bid * 8 + wave; row < MR; row += nb * 8) {
    const bf16_t* z = p.Z + (size_t)row * NZ; const int b = row / LT, t = row - b * LT;
    float v[8]; float ss = 0.f;
#pragma unroll
    for (int k = 0; k < 8; ++k) v[k] = 0.f;
    if (lane < 56) { const u32x4 w = *(const u32x4*)(z + C_CQ + lane * 8);
#pragma unroll
      for (int k = 0; k < 4; ++k) { v[2 * k] = __uint_as_float(w[k] << 16); v[2 * k + 1] = __uint_as_float(w[k] & 0xffff0000u); ss += v[2 * k] * v[2 * k] + v[2 * k + 1] * v[2 * k + 1]; } }
    ss = wsum(ss); float rstd = rsqrtf(ss * (1.f / 448.f) + EPSV);
    { u32x4 o = {0u, 0u, 0u, 0u};
      if (lane < 56) { const f32x4 n0 = *(const f32x4*)(qn + lane * 8), n1 = *(const f32x4*)(qn + lane * 8 + 4);
        o.x = pack2(v[0] * rstd * n0[0], v[1] * rstd * n0[1]); o.y = pack2(v[2] * rstd * n0[2], v[3] * rstd * n0[3]); o.z = pack2(v[4] * rstd * n1[0], v[5] * rstd * n1[1]); o.w = pack2(v[6] * rstd * n1[2], v[7] * rstd * n1[3]); }
      *(u32x4*)(p.Aq + (size_t)row * 512 + lane * 8) = o; }
    ss = 0.f;
    if (lane < 16) { const u32x4 w = *(const u32x4*)(z + C_CKV + lane * 8);
#pragma unroll
      for (int k = 0; k < 4; ++k) { v[2 * k] = __uint_as_float(w[k] << 16); v[2 * k + 1] = __uint_as_float(w[k] & 0xffff0000u); ss += v[2 * k] * v[2 * k] + v[2 * k + 1] * v[2 * k + 1]; } }
    ss = wsum(ss); rstd = rsqrtf(ss * (1.f / 128.f) + EPSV);
    if (lane < 32) { u32x4 o = {0u, 0u, 0u, 0u};
      if (lane < 16) { const f32x4 n0 = *(const f32x4*)(kvn + lane * 8), n1 = *(const f32x4*)(kvn + lane * 8 + 4);
        o.x = pack2(v[0] * rstd * n0[0], v[1] * rstd * n0[1]); o.y = pack2(v[2] * rstd * n0[2], v[3] * rstd * n0[3]); o.z = pack2(v[4] * rstd * n1[0], v[5] * rstd * n1[1]); o.w = pack2(v[6] * rstd * n1[2], v[7] * rstd * n1[3]); }
      *(u32x4*)(p.Akv + (size_t)row * 256 + lane * 8) = o; }
    if (t < LL) {
      if (lane < 32) { const int half = lane >> 4, i = lane & 15; const float x1 = bf2f(z[C_KR + half * 32 + i]), x2 = bf2f(z[C_KR + half * 32 + 16 + i]);
        const float pos = (float)(half ? (t & 63) : (t >> 6)); const float ang = pos * exp2f(-(float)i * (13.287712379549449f / 16.f)); float sv, cv; sincosf(ang, &sv, &cv);
        p.KR[(size_t)row * 64 + half * 32 + i] = f2bf(x1 * cv - x2 * sv); p.KR[(size_t)row * 64 + half * 32 + 16 + i] = f2bf(x2 * cv + x1 * sv); }
    } else p.KR[(size_t)row * 64 + lane] = z[C_KR + lane];
  }
}

DI void st_qrope(const Prm& p, int bid, int nb) {
  const int wave = ltid() >> 6, lane = ltid() & 63;
  for (int row = bid * 8 + wave; row < MR; row += nb * 8) {
    const int b = row / LT, t = row - b * LT; if (t >= LL) continue;
#pragma unroll
    for (int k = 0; k < 2; ++k) { const int pid = lane + 64 * k, h = pid >> 5, r = pid & 31, half = r >> 4, i = r & 15;
      bf16_t* q = p.Qraw + (size_t)row * 768 + h * 192 + 128 + half * 32; const float x1 = bf2f(q[i]), x2 = bf2f(q[16 + i]);
      const float pos = (float)(half ? (t & 63) : (t >> 6)); const float ang = pos * exp2f(-(float)i * (13.287712379549449f / 16.f)); float sv, cv; sincosf(ang, &sv, &cv);
      q[i] = f2bf(x1 * cv - x2 * sv); q[16 + i] = f2bf(x2 * cv + x1 * sv); }
  }
}

DI void st_fnchan(const Prm& p, unsigned char* lds, int bid, int nb) {
  bf16_t* wt = (bf16_t*)lds;
  bf16_t* zt = (bf16_t*)(lds + 256 * 272);
  const int tid = ltid(), wave = tid >> 6, lane = tid & 63, r32 = lane & 31, hi = lane >> 5;
  __syncthreads();
  for (int e = tid; e < 256 * 128; e += NTHR) wt[(e >> 7) * 136 + (e & 127)] = f2bf(p.CCS[e]);
  for (int it = bid; it < (MR / 64) * 4; it += nb) {
    const int tile = it >> 2, g = it & 3, b = tile / 68, tb2 = tile - b * 68; const bool lat = tb2 < 64;
    __syncthreads();
    for (int e = tid; e < 1024; e += NTHR) { const int r = e >> 4, c8 = (e & 15) * 8; const int row = b * LT + (lat ? 64 * r + tb2 : LL + (tb2 - 64) * 64 + r);
      *(u32x4*)(zt + r * 136 + c8) = *(const u32x4*)(p.Z + (size_t)row * NZ + C_FN + g * 128 + c8); }
    __syncthreads();
    f32x16 acc[2] = {};
#pragma unroll
    for (int k8 = 0; k8 < 8; ++k8) { const bf16x8 a = *(const bf16x8*)(wt + (wave * 32 + r32) * 136 + k8 * 16 + hi * 8);
#pragma unroll
      for (int tt = 0; tt < 2; ++tt) { const bf16x8 bb = *(const bf16x8*)(zt + (tt * 32 + r32) * 136 + k8 * 16 + hi * 8); acc[tt] = __builtin_amdgcn_mfma_f32_32x32x16_bf16(a, bb, acc[tt], 0, 0, 0); } }
    const int tb = wave >> 2;
#pragma unroll
    for (int tt = 0; tt < 2; ++tt)
#pragma unroll
      for (int r = 0; r < 16; ++r) { const int k2 = (wave & 3) * 32 + (r & 3) + 8 * (r >> 2) + 4 * hi;
        if (lat) p.PQT[(((size_t)(b * 512 + g * 128 + k2)) * 64 + tb2) * 128 + tb * 64 + tt * 32 + r32] = f2bf(acc[tt][r]);
        else p.PQTc[((size_t)(b * 512 + g * 128 + k2)) * 512 + tb * 256 + (tb2 - 64) * 64 + tt * 32 + r32] = f2bf(acc[tt][r]); }
  }
}

DI void st_fnfft(const Prm& p, unsigned char* lds, int bid, int nb) {
  bf16_t* M1 = (bf16_t*)lds;
  bf16_t* M2c = M1 + 128 * 136; bf16_t* M2s = M2c + 64 * 72;
  f32x2* TW = (f32x2*)(lds + (128 * 136 + 2 * 64 * 72) * 2);
  unsigned char* OUTB = (unsigned char*)(lds + (128 * 136 + 2 * 64 * 72) * 2 + 32768);
  const int tid = ltid(), wave = tid >> 6, lane = tid & 63, r32 = lane & 31, hi = lane >> 5;
  __syncthreads();
  for (int e = tid; e < 128 * 128; e += NTHR) { const int j = e >> 7, k = e & 127, ri = j >> 6, cc = j & 63, pq = k >> 6, a = k & 63; float sv, cv; sincosf((float)((cc * a) & 63) * (6.283185307179586f / 64.f), &sv, &cv);
    const float v = ri == 0 ? (pq == 0 ? cv : -sv) : (pq == 0 ? -sv : -cv); M1[j * 136 + k] = f2bf(v * 0.125f); }
  for (int e = tid; e < 64 * 64; e += NTHR) { const int d = e >> 6, bp = e & 63; float sv, cv; sincosf((float)((d * bp) & 63) * (6.283185307179586f / 64.f), &sv, &cv); M2c[d * 72 + bp] = f2bf(cv * 0.125f); M2s[d * 72 + bp] = f2bf(sv * 0.125f); }
  for (int e = tid; e < 4096; e += NTHR) { float sv, cv; sincosf((float)e * (6.283185307179586f / 4096.f), &sv, &cv); TW[e] = (f32x2){cv, sv}; }
  __syncthreads();
  for (int item = bid * 8 + wave; item < NB * 512; item += nb * 8) {
    const int b = item >> 9, col = item & 511;
    const bf16_t* src = p.PQT + (size_t)item * 64 * 128;
    unsigned char* yo8 = (unsigned char*)p.Y + (size_t)b * LT * DM + 1536 + (col & ~7);
#pragma unroll 1
    for (int ct = 0; ct < 2; ++ct) {
      f32x16 tr0 = {}, tr1 = {}, ti0 = {}, ti1 = {};
#pragma unroll
      for (int ks = 0; ks < 8; ++ks) { const bf16x8 a0 = *(const bf16x8*)(src + r32 * 128 + ks * 16 + hi * 8), a1 = *(const bf16x8*)(src + (32 + r32) * 128 + ks * 16 + hi * 8);
        const bf16x8 br = *(const bf16x8*)(M1 + (ct * 32 + r32) * 136 + ks * 16 + hi * 8), bi = *(const bf16x8*)(M1 + ((2 + ct) * 32 + r32) * 136 + ks * 16 + hi * 8);
        tr0 = __builtin_amdgcn_mfma_f32_32x32x16_bf16(a0, br, tr0, 0, 0, 0); tr1 = __builtin_amdgcn_mfma_f32_32x32x16_bf16(a1, br, tr1, 0, 0, 0);
        ti0 = __builtin_amdgcn_mfma_f32_32x32x16_bf16(a0, bi, ti0, 0, 0, 0); ti1 = __builtin_amdgcn_mfma_f32_32x32x16_bf16(a1, bi, ti1, 0, 0, 0); }
      __builtin_amdgcn_sched_barrier(0);
      const int cc = ct * 32 + r32;
#pragma unroll
      for (int r = 0; r < 16; ++r) { const int bl = (r & 3) + 8 * (r >> 2) + 4 * hi; const f32x2 w0 = TW[(cc * bl) & 4095], w1 = TW[(cc * (32 + bl)) & 4095];
        const float a = tr0[r], bq = ti0[r]; tr0[r] = a * w0[0] + bq * w0[1]; ti0[r] = bq * w0[0] - a * w0[1];
        const float c2 = tr1[r], d2 = ti1[r]; tr1[r] = c2 * w1[0] + d2 * w1[1]; ti1[r] = d2 * w1[0] - c2 * w1[1]; }
      __builtin_amdgcn_sched_barrier(0);
      f32x16 y0 = {}, y1 = {};
#define FFT_S2(XT, M2, BT) do { _Pragma("unroll") for (int s = 0; s < 2; ++s) { \
          u32x4 pk; pk.x = pack2(XT[8 * s], XT[8 * s + 1]); pk.y = pack2(XT[8 * s + 2], XT[8 * s + 3]); pk.z = pack2(XT[8 * s + 4], XT[8 * s + 5]); pk.w = pack2(XT[8 * s + 6], XT[8 * s + 7]); \
          const bf16x8 xs = __builtin_bit_cast(bf16x8, pk); \
          const bf16_t* ap0 = (M2) + r32 * 72 + (BT) * 32 + 16 * s + 4 * hi; const bf16_t* ap1 = ap0 + 32 * 72; \
          const s16x4 l0 = *(const s16x4*)ap0, h0 = *(const s16x4*)(ap0 + 8), l1 = *(const s16x4*)ap1, h1 = *(const s16x4*)(ap1 + 8); \
          y0 = __builtin_amdgcn_mfma_f32_32x32x16_bf16((bf16x8){l0[0], l0[1], l0[2], l0[3], h0[0], h0[1], h0[2], h0[3]}, xs, y0, 0, 0, 0); \
          y1 = __builtin_amdgcn_mfma_f32_32x32x16_bf16((bf16x8){l1[0], l1[1], l1[2], l1[3], h1[0], h1[1], h1[2], h1[3]}, xs, y1, 0, 0, 0); } } while (0)
      FFT_S2(tr0, M2c, 0); __builtin_amdgcn_sched_barrier(0); FFT_S2(tr1, M2c, 1); __builtin_amdgcn_sched_barrier(0); FFT_S2(ti0, M2s, 0); __builtin_amdgcn_sched_barrier(0); FFT_S2(ti1, M2s, 1); __builtin_amdgcn_sched_barrier(0);
#undef FFT_S2
      __syncthreads();
#pragma unroll
      for (int r = 0; r < 16; ++r) { const int dl = (r & 3) + 8 * (r >> 2) + 4 * hi; const int pk = __builtin_amdgcn_cvt_pk_fp8_f32(y8c(y0[r]), y8c(y1[r]), 0, false); OUTB[(dl * 32 + r32) * 8 + wave] = (unsigned char)pk; OUTB[((32 + dl) * 32 + r32) * 8 + wave] = (unsigned char)(pk >> 8); }
      __syncthreads();
#pragma unroll
      for (int q = 0; q < 4; ++q) { const int rr = tid + NTHR * q, d = rr >> 5, ccl = rr & 31; *(u32x2*)(yo8 + (size_t)(ct * 32 + ccl + 64 * d) * DM) = *(const u32x2*)(OUTB + rr * 8); }
    }
  }
}

DI int scan_row(int b, int dir, int s) { return s < LCX ? b * LT + LL + (dir ? LCX - 1 - s : s) : b * LT + (dir ? LL - 1 - (s - LCX) : (s - LCX)); }

DI int tsw(int row, int t) { return row * 72 + ((((t >> 3) ^ (row >> 3)) & 7) << 3) + (t & 7); }
DI void st_dntinv(const Prm& p, unsigned char* lds, int bid, int nb) {
  const int tid = ltid(), wave = tid >> 6, lane = tid & 63, r32 = lane & 31, hi = lane >> 5;
  float* Ab = (float*)lds + wave * 4096;
  float* gcb = (float*)(lds + 131072) + wave * 128; float* btb = gcb + 64;
  for (int item = bid * 8 + wave; item < 64 * 68; item += nb * 8) {
    const int chain = item / 68, n = item - chain * 68, b = chain >> 3, h = (chain >> 1) & 3, dir = chain & 1;
    const int myrow = scan_row(b, dir, n * 64 + lane);
    const float g = p.GB[(size_t)myrow * 16 + dir * 4 + h], bt = p.GB[(size_t)myrow * 16 + 8 + dir * 4 + h];
    gcb[lane] = g; btb[lane] = bt;
    bf16x8 kf[2][8];
#pragma unroll
    for (int tt = 0; tt < 2; ++tt) { const int row = scan_row(b, dir, n * 64 + tt * 32 + r32);
#pragma unroll
      for (int ks = 0; ks < 8; ++ks) kf[tt][ks] = *(const bf16x8*)(p.DNQ + (size_t)row * 1536 + 512 + h * 128 + ks * 16 + hi * 8); }
    __builtin_amdgcn_wave_barrier();
    float gc = 0.f;
    for (int e = 0; e < 64; ++e) { const float ge = gcb[e]; gc += (e <= lane) ? ge : 0.f; }
    __builtin_amdgcn_wave_barrier();
    gcb[lane] = gc; p.GCB[(size_t)item * 64 + lane] = gc;
    __builtin_amdgcn_wave_barrier();
    f32x16 a00 = {}, a10 = {}, a11 = {};
#pragma unroll
    for (int ks = 0; ks < 8; ++ks) { a00 = __builtin_amdgcn_mfma_f32_32x32x16_bf16(kf[0][ks], kf[0][ks], a00, 0, 0, 0);
      a10 = __builtin_amdgcn_mfma_f32_32x32x16_bf16(kf[1][ks], kf[0][ks], a10, 0, 0, 0); a11 = __builtin_amdgcn_mfma_f32_32x32x16_bf16(kf[1][ks], kf[1][ks], a11, 0, 0, 0); }
    { const float gce0 = gcb[r32], gce1 = gcb[32 + r32];
#pragma unroll
      for (int r = 0; r < 16; ++r) { const int cl = (r & 3) + 8 * (r >> 2) + 4 * hi; const float gc0 = gcb[cl], bt0 = btb[cl], gc1 = gcb[32 + cl], bt1 = btb[32 + cl];
        Ab[cl * 64 + r32] = (r32 < cl) ? bt0 * a00[r] * __expf(gc0 - gce0) : 0.f;
        Ab[cl * 64 + 32 + r32] = 0.f;
        Ab[(32 + cl) * 64 + r32] = bt1 * a10[r] * __expf(gc1 - gce0);
        Ab[(32 + cl) * 64 + 32 + r32] = (r32 < cl) ? bt1 * a11[r] * __expf(gc1 - gce1) : 0.f; } }
    __builtin_amdgcn_wave_barrier();
    float x[64];
    bf16_t* to = p.TINV + (size_t)item * 4096 + lane;
#pragma unroll
    for (int c = 0; c < 64; ++c) { float s = (c == lane) ? 1.f : 0.f;
#pragma unroll
      for (int e4 = 0; e4 < (c + 3) / 4; ++e4) { const f32x4 av = *(const f32x4*)(Ab + c * 64 + e4 * 4);
#pragma unroll
        for (int i = 0; i < 4; ++i) if (e4 * 4 + i < c) s -= av[i] * x[e4 * 4 + i]; }
      x[c] = s; to[c * 64] = f2bf(s); }
    __builtin_amdgcn_wave_barrier();
  }
}

DI void st_dnscan(const Prm& p, unsigned char* lds, int bid, int nb) {
  constexpr int PK = 136, PB = 72;
  bf16_t* Qs = (bf16_t*)lds; bf16_t* Ks = Qs + 64 * PK; bf16_t* SB = Ks + 64 * PK; bf16_t* KDT = SB + 64 * PK; bf16_t* TI = KDT + 128 * PB; bf16_t* RT = TI + 64 * PB; bf16_t* VNT = RT + 64 * PB;
  bf16_t* PL = VNT + 64 * PB; bf16_t* Vs = PL + 64 * PB; float* gcs = (float*)(Vs + 64 * PB); float* bts = gcs + 64; float* egs = bts + 64;
  const int tid = ltid(), wave = tid >> 6, lane = tid & 63, r32 = lane & 31, hi = lane >> 5;
  for (int item = bid; item < 128; item += nb) {
    const int chain = item >> 1, half = item & 1, b = chain >> 3, h = (chain >> 1) & 3, dir = chain & 1;
    f32x16 accS = {};
    __syncthreads();
    for (int e = tid; e < 64 * PK; e += NTHR) SB[e] = 0;
    bf16x8 pf[6]; float pgc = 0.f, pbt = 0.f;
    auto gload = [&](int n) {
      const size_t ci = (size_t)chain * 68 + n;
#pragma unroll
      for (int r = 0; r < 6; ++r) { const int e = tid + NTHR * r;
        if (e < 2048) { const int ee = e & 1023, t = ee >> 4, c8 = ee & 15; const int row = scan_row(b, dir, n * 64 + t); pf[r] = *(const bf16x8*)(p.DNQ + (size_t)row * 1536 + (e < 1024 ? 0 : 512) + h * 128 + c8 * 8); }
        else if (e < 2560) { const int ee = e - 2048, t = ee >> 3, c8 = ee & 7; const int row = scan_row(b, dir, n * 64 + t); pf[r] = *(const bf16x8*)(p.DNQ + (size_t)row * 1536 + 1024 + h * 128 + half * 64 + c8 * 8); }
        else { const int ee = e - 2560; pf[r] = *(const bf16x8*)(p.TINV + ci * 4096 + ee * 8); } }
      if (tid < 64) { pgc = p.GCB[ci * 64 + tid]; const int row = scan_row(b, dir, n * 64 + tid); pbt = p.GB[(size_t)row * 16 + 8 + dir * 4 + h]; }
    };
    gload(0);
    for (int n = 0; n < LT / 64; ++n) {
      if (tid < 64) { gcs[tid] = pgc; bts[tid] = pbt; egs[tid] = __expf(pgc); }
      __syncthreads();
      const float gl = gcs[63];
#pragma unroll
      for (int r = 0; r < 6; ++r) { const int e = tid + NTHR * r;
        if (e < 1024) { const int t = e >> 4, c8 = e & 15; *(bf16x8*)(Qs + t * PK + c8 * 8) = pf[r]; }
        else if (e < 2048) { const int ee = e - 1024, t = ee >> 4, c8 = ee & 15; *(bf16x8*)(Ks + t * PK + c8 * 8) = pf[r]; const float sc = __expf(gl - gcs[t]);
#pragma unroll
          for (int j = 0; j < 8; ++j) KDT[tsw(c8 * 8 + j, t)] = f2bf(bf2f((bf16_t)pf[r][j]) * sc); }
        else if (e < 2560) { const int ee = e - 2048, t = ee >> 3, c8 = ee & 7; *(bf16x8*)(Vs + t * PB + c8 * 8) = pf[r]; }
        else { const int ee = e - 2560, c = ee >> 3, c8 = ee & 7; *(bf16x8*)(TI + c * PB + c8 * 8) = pf[r]; } }
      if (n + 1 < LT / 64) gload(n + 1);
      __syncthreads();
      f32x16 accO = {};
      if (wave < 4) { const int et = wave >> 1, jt = wave & 1; f32x16 a1 = {};
#pragma unroll
        for (int k8 = 0; k8 < 8; ++k8) { const bf16x8 av = *(const bf16x8*)(Ks + (et * 32 + r32) * PK + k8 * 16 + hi * 8), bv = *(const bf16x8*)(SB + (jt * 32 + r32) * PK + k8 * 16 + hi * 8);
          a1 = __builtin_amdgcn_mfma_f32_32x32x16_bf16(av, bv, a1, 0, 0, 0); }
        const int j = jt * 32 + r32;
#pragma unroll
        for (int g = 0; g < 4; ++g) { const int e0 = et * 32 + 8 * g + 4 * hi; float rv[4];
#pragma unroll
          for (int i = 0; i < 4; ++i) rv[i] = bts[e0 + i] * (bf2f(Vs[(e0 + i) * PB + j]) - egs[e0 + i] * a1[4 * g + i]);
          u32x2 w; w.x = pack2(rv[0], rv[1]); w.y = pack2(rv[2], rv[3]); *(u32x2*)(RT + j * PB + e0) = w; } }
      else {
        if (wave < 7) { const int et = wave == 6 ? 1 : 0, ct = wave == 4 ? 0 : 1; f32x16 a2 = {};
#pragma unroll
          for (int k8 = 0; k8 < 8; ++k8) { const bf16x8 av = *(const bf16x8*)(Ks + (et * 32 + r32) * PK + k8 * 16 + hi * 8), bv = *(const bf16x8*)(Qs + (ct * 32 + r32) * PK + k8 * 16 + hi * 8);
            a2 = __builtin_amdgcn_mfma_f32_32x32x16_bf16(av, bv, a2, 0, 0, 0); }
          const int c = ct * 32 + r32; const float gcc = gcs[c];
#pragma unroll
          for (int g = 0; g < 4; ++g) { const int e0 = et * 32 + 8 * g + 4 * hi; float pv[4];
#pragma unroll
            for (int i = 0; i < 4; ++i) pv[i] = (e0 + i <= c) ? a2[4 * g + i] * __expf(gcc - gcs[e0 + i]) : 0.f;
            u32x2 w; w.x = pack2(pv[0], pv[1]); w.y = pack2(pv[2], pv[3]); *(u32x2*)(PL + c * PB + e0) = w; } }
        else { for (int e = lane; e < 32 * 8; e += 64) { const int c = e >> 3, q4 = (e & 7) * 4; *(u32x2*)(PL + c * PB + 32 + q4) = (u32x2){0u, 0u}; } }
        { const int ct = (wave - 4) >> 1, jt = wave & 1;
#pragma unroll
          for (int k8 = 0; k8 < 8; ++k8) { const bf16x8 av = *(const bf16x8*)(Qs + (ct * 32 + r32) * PK + k8 * 16 + hi * 8), bv = *(const bf16x8*)(SB + (jt * 32 + r32) * PK + k8 * 16 + hi * 8);
            accO = __builtin_amdgcn_mfma_f32_32x32x16_bf16(av, bv, accO, 0, 0, 0); }
#pragma unroll
          for (int r = 0; r < 16; ++r) accO[r] *= egs[ct * 32 + (r & 3) + 8 * (r >> 2) + 4 * hi]; } }
      __syncthreads();
      if (wave < 4) { const int ct = wave >> 1, jt = wave & 1; f32x16 a3 = {};
#pragma unroll
        for (int k8 = 0; k8 < 4; ++k8) { const bf16x8 av = *(const bf16x8*)(TI + (ct * 32 + r32) * PB + k8 * 16 + hi * 8), bv = *(const bf16x8*)(RT + (jt * 32 + r32) * PB + k8 * 16 + hi * 8);
          a3 = __builtin_amdgcn_mfma_f32_32x32x16_bf16(av, bv, a3, 0, 0, 0); }
#pragma unroll
        for (int g = 0; g < 4; ++g) { u32x2 w; w.x = pack2(a3[4 * g], a3[4 * g + 1]); w.y = pack2(a3[4 * g + 2], a3[4 * g + 3]); *(u32x2*)(VNT + (jt * 32 + r32) * PB + ct * 32 + 8 * g + 4 * hi) = w; } }
      __syncthreads();
      if (wave >= 4) { const int ct = (wave - 4) >> 1, jt = wave & 1;
#pragma unroll
        for (int k8 = 0; k8 < 4; ++k8) { const bf16x8 av = *(const bf16x8*)(PL + (ct * 32 + r32) * PB + k8 * 16 + hi * 8), bv = *(const bf16x8*)(VNT + (jt * 32 + r32) * PB + k8 * 16 + hi * 8);
          accO = __builtin_amdgcn_mfma_f32_32x32x16_bf16(av, bv, accO, 0, 0, 0); }
#pragma unroll
        for (int r = 0; r < 16; ++r) { const int c = ct * 32 + (r & 3) + 8 * (r >> 2) + 4 * hi; const int row = scan_row(b, dir, n * 64 + c);
          p.OB[((size_t)(0 * 2 + dir) * MR + row) * 512 + h * 128 + half * 64 + jt * 32 + r32] = f2bf(accO[r]); } }
      { const int dt = wave >> 1, jt = wave & 1; const float egl = __expf(gl);
#pragma unroll
        for (int r = 0; r < 16; ++r) accS[r] *= egl;
#pragma unroll
        for (int k8 = 0; k8 < 4; ++k8) { const bf16x8 av = *(const bf16x8*)(KDT + tsw(dt * 32 + r32, k8 * 16 + hi * 8)), bv = *(const bf16x8*)(VNT + (jt * 32 + r32) * PB + k8 * 16 + hi * 8);
          accS = __builtin_amdgcn_mfma_f32_32x32x16_bf16(av, bv, accS, 0, 0, 0); }
#pragma unroll
        for (int g = 0; g < 4; ++g) { u32x2 w; w.x = pack2(accS[4 * g], accS[4 * g + 1]); w.y = pack2(accS[4 * g + 2], accS[4 * g + 3]);
          *(u32x2*)(SB + (jt * 32 + r32) * PK + dt * 32 + 8 * g + 4 * hi) = w; } }
      __syncthreads();
    }
  }
}

DI void st_glabc(const Prm& p, int layer, unsigned char* lds, int bid, int nb) {
  float* AL = (float*)lds; float* SEG = AL + 1024;
  const int tid = ltid(), seg = tid >> 6, dme = tid & 63;
  for (int item = bid; item < 64 * 68; item += nb) {
    const int chain = item / 68, n = item - chain * 68, b = chain >> 3, h = (chain >> 1) & 3, dir = chain & 1;
    const float* w2 = p.gla_w2 + (size_t)(layer * 2 + dir) * 16 * 256 + h * 64; const float b2r = p.gla_b2[(layer * 2 + dir) * 256 + h * 64 + dme];
    float w2r[16];
#pragma unroll
    for (int r = 0; r < 16; ++r) w2r[r] = w2[r * 256 + dme];
    __syncthreads();
    if (tid < 128) { const int t = tid >> 1, c8 = tid & 1; const int row = scan_row(b, dir, n * 64 + t); const bf16x8 v = *(const bf16x8*)(p.Z + (size_t)row * NZ + C_GALPHA + dir * 16 + c8 * 8);
#pragma unroll
      for (int j = 0; j < 8; ++j) AL[t * 16 + c8 * 8 + j] = bf2f((bf16_t)v[j]); }
    __syncthreads();
    float la[8]; float run = 0.f;
#pragma unroll
    for (int k = 0; k < 8; ++k) { const int t = seg * 8 + k; float zz = b2r;
#pragma unroll
      for (int r = 0; r < 16; ++r) zz += AL[t * 16 + r] * w2r[r];
      const float nz = -zz; const float sp = nz > 20.f ? nz : log1pf(expf(nz)); run += -sp * (1.f / 16.f); la[k] = run; }
    SEG[seg * 64 + dme] = run;
    __syncthreads();
    float pre = 0.f;
#pragma unroll
    for (int s2 = 0; s2 < 8; ++s2) pre += (s2 < seg) ? SEG[s2 * 64 + dme] : 0.f;
#pragma unroll
    for (int k = 0; k < 8; ++k) p.BC[(size_t)item * 4096 + (seg * 8 + k) * 64 + dme] = la[k] + pre;
  }
}

DI void st_glascan(const Prm& p, int layer, unsigned char* lds, int bid, int nb) {
  constexpr int PB = 72;
  bf16_t* QI = (bf16_t*)lds; bf16_t* QR = QI + 64 * PB; bf16_t* KR = QR + 64 * PB; bf16_t* KRT = KR + 64 * PB; bf16_t* VT = KRT + 64 * PB; bf16_t* SB = VT + 64 * PB; bf16_t* PL = SB + 64 * PB;
  float* LA = (float*)(lds + 7 * 64 * PB * 2);
  float* AL = LA + 4096;
  float* SEG = AL + 1024;
  float* EBL = SEG + 512;
  const int tid = ltid(), wave = tid >> 6, lane = tid & 63, r32 = lane & 31, hi = lane >> 5;
  for (int item = bid; item < 128; item += nb) {
    const int chain = item >> 1, half = item & 1, b = chain >> 3, h = (chain >> 1) & 3, dir = chain & 1;
    f32x16 acc = {};
    __syncthreads();
    for (int e = tid; e < 64 * PB; e += NTHR) SB[e] = 0;
    bf16x8 pf[3]; f32x4 pb[2];
    auto gload = [&](int n) {
#pragma unroll
      for (int r = 0; r < 3; ++r) { const int e = tid + NTHR * r; const int t = e / 24, ch = e - t * 24; const int row = scan_row(b, dir, n * 64 + t);
        const int col = ch < 8 ? C_GQ + h * 64 + ch * 8 : (ch < 16 ? C_GK + h * 64 + (ch - 8) * 8 : C_GV + h * 128 + half * 64 + (ch - 16) * 8);
        pf[r] = *(const bf16x8*)(p.Z + (size_t)row * NZ + col); }
#pragma unroll
      for (int r = 0; r < 2; ++r) pb[r] = *(const f32x4*)(p.BC + ((size_t)chain * 68 + n) * 4096 + (tid + NTHR * r) * 4);
    };
    gload(0);
    for (int n = 0; n < LT / 64; ++n) {
#pragma unroll
      for (int r = 0; r < 2; ++r) *(f32x4*)(LA + (tid + NTHR * r) * 4) = pb[r];
      __syncthreads();
      if (tid < 64) EBL[tid] = __expf(LA[63 * 64 + tid]);
#pragma unroll
      for (int r = 0; r < 3; ++r) { const int e = tid + NTHR * r; const int t = e / 24, ch = e - t * 24;
          if (ch < 8) { u32x4 wi, wr; float xi[8], xr[8];
#pragma unroll
            for (int j = 0; j < 8; ++j) { const int d = ch * 8 + j; const float bc = LA[t * 64 + d], bl = LA[63 * 64 + d], q = bf2f((bf16_t)pf[r][j]) * 0.125f; xi[j] = q * __expf(bc); xr[j] = q * __expf(bc - bl); }
            wi.x = pack2(xi[0], xi[1]); wi.y = pack2(xi[2], xi[3]); wi.z = pack2(xi[4], xi[5]); wi.w = pack2(xi[6], xi[7]);
            wr.x = pack2(xr[0], xr[1]); wr.y = pack2(xr[2], xr[3]); wr.z = pack2(xr[4], xr[5]); wr.w = pack2(xr[6], xr[7]);
            *(u32x4*)(QI + t * PB + ch * 8) = wi; *(u32x4*)(QR + t * PB + ch * 8) = wr; }
          else if (ch < 16) { u32x4 wk; float xk[8];
#pragma unroll
            for (int j = 0; j < 8; ++j) { const int d = (ch - 8) * 8 + j; xk[j] = bf2f((bf16_t)pf[r][j]) * __expf(LA[63 * 64 + d] - LA[t * 64 + d]); KRT[tsw(d, t)] = f2bf(xk[j]); }
            wk.x = pack2(xk[0], xk[1]); wk.y = pack2(xk[2], xk[3]); wk.z = pack2(xk[4], xk[5]); wk.w = pack2(xk[6], xk[7]);
            *(u32x4*)(KR + t * PB + (ch - 8) * 8) = wk; }
          else {
#pragma unroll
            for (int j = 0; j < 8; ++j) VT[tsw((ch - 16) * 8 + j, t)] = (bf16_t)pf[r][j]; } }
      if (n + 1 < LT / 64) gload(n + 1);
      __syncthreads();
      if (wave < 3) { const int et = wave == 2 ? 1 : 0, ct = wave == 0 ? 0 : 1; f32x16 a2 = {};
#pragma unroll
        for (int k8 = 0; k8 < 4; ++k8) { const bf16x8 av = *(const bf16x8*)(KR + (et * 32 + r32) * PB + k8 * 16 + hi * 8), bv = *(const bf16x8*)(QR + (ct * 32 + r32) * PB + k8 * 16 + hi * 8);
          a2 = __builtin_amdgcn_mfma_f32_32x32x16_bf16(av, bv, a2, 0, 0, 0); }
        const int c = ct * 32 + r32;
#pragma unroll
        for (int g = 0; g < 4; ++g) { const int e0 = et * 32 + 8 * g + 4 * hi; u32x2 w;
          w.x = pack2(e0 <= c ? a2[4 * g] : 0.f, e0 + 1 <= c ? a2[4 * g + 1] : 0.f); w.y = pack2(e0 + 2 <= c ? a2[4 * g + 2] : 0.f, e0 + 3 <= c ? a2[4 * g + 3] : 0.f);
          *(u32x2*)(PL + c * PB + e0) = w; } }
      else if (wave == 3) { for (int e = lane; e < 32 * 8; e += 64) { const int c = e >> 3, q4 = (e & 7) * 4; *(u32x2*)(PL + c * PB + 32 + q4) = (u32x2){0u, 0u}; } }
      else { const int ct = (wave - 4) >> 1, jt = wave & 1; acc = f32x16{};
#pragma unroll
        for (int k8 = 0; k8 < 4; ++k8) { const bf16x8 av = *(const bf16x8*)(QI + (ct * 32 + r32) * PB + k8 * 16 + hi * 8), bv = *(const bf16x8*)(SB + (jt * 32 + r32) * PB + k8 * 16 + hi * 8);
          acc = __builtin_amdgcn_mfma_f32_32x32x16_bf16(av, bv, acc, 0, 0, 0); } }
      __syncthreads();
      if (wave >= 4) { const int ct = (wave - 4) >> 1, jt = wave & 1;
#pragma unroll
        for (int k8 = 0; k8 < 4; ++k8) { const bf16x8 av = *(const bf16x8*)(PL + (ct * 32 + r32) * PB + k8 * 16 + hi * 8), bv = *(const bf16x8*)(VT + tsw(jt * 32 + r32, k8 * 16 + hi * 8));
          acc = __builtin_amdgcn_mfma_f32_32x32x16_bf16(av, bv, acc, 0, 0, 0); }
#pragma unroll
        for (int r = 0; r < 16; ++r) { const int c = ct * 32 + (r & 3) + 8 * (r >> 2) + 4 * hi; const int row = scan_row(b, dir, n * 64 + c);
          p.OB[((size_t)(1 * 2 + dir) * MR + row) * 512 + h * 128 + half * 64 + jt * 32 + r32] = f2bf(acc[r]); } }
      else { const int dt = wave >> 1, jt = wave & 1;
#pragma unroll
        for (int r = 0; r < 16; ++r) acc[r] *= EBL[dt * 32 + (r & 3) + 8 * (r >> 2) + 4 * hi];
#pragma unroll
        for (int k8 = 0; k8 < 4; ++k8) { const bf16x8 av = *(const bf16x8*)(KRT + tsw(dt * 32 + r32, k8 * 16 + hi * 8)), bv = *(const bf16x8*)(VT + tsw(jt * 32 + r32, k8 * 16 + hi * 8));
          acc = __builtin_amdgcn_mfma_f32_32x32x16_bf16(av, bv, acc, 0, 0, 0); }
#pragma unroll
        for (int g = 0; g < 4; ++g) { u32x2 w; w.x = pack2(acc[4 * g], acc[4 * g + 1]); w.y = pack2(acc[4 * g + 2], acc[4 * g + 3]);
          *(u32x2*)(SB + (jt * 32 + r32) * PB + dt * 32 + 8 * g + 4 * hi) = w; } }
      __syncthreads();
    }
  }
}

DI void st_combine(const Prm& p, int layer, int bid, int nb) {
  const int wave = ltid() >> 6, lane = ltid() & 63;
  for (long task = (long)bid * 8 + wave; task < (long)MR * 8; task += (long)nb * 8) {
    const int row = (int)(task >> 3), mh = (int)(task & 7), mixer = mh >> 2, h = mh & 3;
    const unsigned f = *(const unsigned*)(p.OB + ((size_t)(mixer * 2 + 0) * MR + row) * 512 + h * 128 + lane * 2), g = *(const unsigned*)(p.OB + ((size_t)(mixer * 2 + 1) * MR + row) * 512 + h * 128 + lane * 2);
    const float o0 = bf2f((bf16_t)(f & 0xffffu)) + bf2f((bf16_t)(g & 0xffffu)), o1 = bf2f((bf16_t)(f >> 16)) + bf2f((bf16_t)(g >> 16));
    const float ss = wsum(o0 * o0 + o1 * o1), rstd = rsqrtf(ss * (1.f / 128.f) + EPSV);
    const float* w = (mixer ? p.gla_norm : p.dn_norm) + layer * 128 + lane * 2;
    const unsigned gz = *(const unsigned*)(p.Z + (size_t)row * NZ + (mixer ? C_GGATE : C_DNGATE) + h * 128 + lane * 2);
    const float g0 = bf2f((bf16_t)(gz & 0xffffu)), g1 = bf2f((bf16_t)(gz >> 16));
    *(unsigned short*)((unsigned char*)p.Y + (size_t)row * DM + mixer * 512 + h * 128 + lane * 2) = (unsigned short)__builtin_amdgcn_cvt_pk_fp8_f32(y8c(o0 * rstd * w[0] * siluf(g0)), y8c(o1 * rstd * w[1] * siluf(g1)), 0, false);
  }
}

DI unsigned fkey(float f) { const unsigned u = __float_as_uint(f); return u ^ ((u >> 31) ? 0xffffffffu : 0x80000000u); }
DI int pcnt(unsigned long long m) { return __builtin_popcountll(m); }
DI int lanes_below(unsigned long long m) { return (int)__builtin_amdgcn_mbcnt_hi((unsigned)(m >> 32), __builtin_amdgcn_mbcnt_lo((unsigned)m, 0u)); }
DI void st_peertopk(const Prm& p, int layer, unsigned char* lds, int bid, int nb) {
  bf16_t* ks = (bf16_t*)lds;
  bf16_t* qt = (bf16_t*)(lds + 69632);
  float* sc = (float*)(lds + 69632);
  const int tid = ltid(), wave = tid >> 6, lane = tid & 63, r32 = lane & 31, hi = lane >> 5;
  float* selv = (float*)(lds + 69632 + 33280) + wave * 64; int* seli = (int*)(selv + 32);
  int hcur = -1;
  const int nchunk = MR / 32;
  const int total = 8 * nchunk;
  auto valid = [&](int i2) { const int ch = i2 % nchunk; return !(layer == 1 && ((ch * 32) % LT) >= LL); };
  u32x4 pq[2];
  auto preload = [&](int i2) { const int h2 = i2 / nchunk, r0 = (i2 - h2 * nchunk) * 32;
#pragma unroll
    for (int q = 0; q < 2; ++q) { const int e = tid + NTHR * q, r = e >> 5, c8 = (e & 31) * 8; pq[q] = *(const u32x4*)(p.Qp + (size_t)(r0 + r) * DM + h2 * 256 + c8); } };
  int it = bid; while (it < total && !valid(it)) it += nb;
  if (it < total) preload(it);
  while (it < total) {
    int nxt = it + nb; while (nxt < total && !valid(nxt)) nxt += nb;
    const int h = it / nchunk, chunk = it - h * nchunk, row0 = chunk * 32;
    __syncthreads();
    if (h != hcur) {
      const float* kg = p.peer_keys + ((size_t)(layer * 8 + h) * 2) * 128 * 128;
      for (int e = tid; e < 2 * 128 * 128; e += NTHR) { const int pn = e >> 7, k = e & 127; ks[pn * 136 + k] = f2bf(kg[e]); }
      hcur = h; }
#pragma unroll
    for (int q = 0; q < 2; ++q) { const int e = tid + NTHR * q, r = e >> 5, c8 = (e & 31) * 8; *(u32x4*)(qt + r * 264 + c8) = pq[q]; }
    __syncthreads();
    { const int pt = wave >> 2, nt = wave & 3; f32x16 acc = {};
#pragma unroll
      for (int k8 = 0; k8 < 8; ++k8) { const bf16x8 a = *(const bf16x8*)(qt + r32 * 264 + pt * 128 + k8 * 16 + hi * 8), b = *(const bf16x8*)(ks + (pt * 128 + nt * 32 + r32) * 136 + k8 * 16 + hi * 8);
        acc = __builtin_amdgcn_mfma_f32_32x32x16_bf16(a, b, acc, 0, 0, 0); }
      __syncthreads();
#pragma unroll
      for (int r = 0; r < 16; ++r) sc[((r & 3) + 8 * (r >> 2) + 4 * hi) * 260 + pt * 128 + nt * 32 + r32] = acc[r]; }
    __syncthreads();
    if (nxt < total) preload(nxt);
    for (int rr = 0; rr < 4; ++rr) {
      const int m = wave * 4 + rr, row = row0 + m;
      float s[2][2];
#pragma unroll
      for (int pp = 0; pp < 2; ++pp)
#pragma unroll
        for (int hh = 0; hh < 2; ++hh) s[pp][hh] = sc[m * 260 + pp * 128 + hh * 64 + lane];
      unsigned kk[2][2], T[2] = {0u, 0u};
#pragma unroll
      for (int pp = 0; pp < 2; ++pp) { kk[pp][0] = fkey(s[pp][0]); kk[pp][1] = fkey(s[pp][1]); }
      { unsigned ta = 0u, tb = 0u, da = 0u, db = 0u;
        for (int bit = 31; bit >= 0; --bit) { const unsigned m = 1u << bit;
          const unsigned ca = ta | m, cb = tb | m;
          const unsigned na = (unsigned)(pcnt(__ballot(kk[0][0] >= ca)) + pcnt(__ballot(kk[0][1] >= ca))), nb2 = (unsigned)(pcnt(__ballot(kk[1][0] >= cb)) + pcnt(__ballot(kk[1][1] >= cb)));
          const unsigned oa = (na >= 16u ? 1u : 0u) & ~da, ob = (nb2 >= 16u ? 1u : 0u) & ~db;
          ta |= (0u - oa) & m; tb |= (0u - ob) & m; da |= oa & (na == 16u ? 1u : 0u); db |= ob & (nb2 == 16u ? 1u : 0u);
          if (da & db) break; }
        T[0] = __builtin_amdgcn_readfirstlane(ta); T[1] = __builtin_amdgcn_readfirstlane(tb); }
#pragma unroll
      for (int pp = 0; pp < 2; ++pp) { const unsigned k0 = kk[pp][0], k1 = kk[pp][1], TT = T[pp];
        const unsigned long long g0 = __ballot(k0 > TT), g1 = __ballot(k1 > TT), e0 = __ballot(k0 == TT), e1 = __ballot(k1 == TT);
        const int ng0 = pcnt(g0), ng = ng0 + pcnt(g1), need = 16 - ng, ne0 = pcnt(e0);
        if (k0 > TT) { const int r = lanes_below(g0); selv[pp * 16 + r] = s[pp][0]; seli[pp * 16 + r] = lane; }
        if (k1 > TT) { const int r = ng0 + lanes_below(g1); selv[pp * 16 + r] = s[pp][1]; seli[pp * 16 + r] = lane + 64; }
        if (k0 == TT) { const int r = lanes_below(e0); if (r < need) { selv[pp * 16 + ng + r] = s[pp][0]; seli[pp * 16 + ng + r] = lane; } }
        if (k1 == TT) { const int r = ne0 + lanes_below(e1); if (r < need) { selv[pp * 16 + ng + r] = s[pp][1]; seli[pp * 16 + ng + r] = lane + 64; } } }
      __builtin_amdgcn_wave_barrier();
      float cd[4]; unsigned ck[4]; { const float sa = selv[lane >> 2]; const f32x4 sb = *(const f32x4*)(selv + 16 + (lane & 3) * 4);
#pragma unroll
        for (int q = 0; q < 4; ++q) { cd[q] = sa + sb[q]; ck[q] = fkey(cd[q]); } }
      unsigned T2 = 0u;
      for (int bit = 31; bit >= 0; --bit) { const unsigned m = 1u << bit, c = T2 | m;
        const unsigned n = (unsigned)(pcnt(__ballot(ck[0] >= c)) + pcnt(__ballot(ck[1] >= c)) + pcnt(__ballot(ck[2] >= c)) + pcnt(__ballot(ck[3] >= c)));
        T2 |= (0u - (n >= 16u ? 1u : 0u)) & m; if (n == 16u) break; }
      T2 = __builtin_amdgcn_readfirstlane(T2);
      float mx = fmaxf(fmaxf(cd[0], cd[1]), fmaxf(cd[2], cd[3])); mx = wmax(mx);
      int base = 0; float esum = 0.f; const int ia = seli[lane >> 2]; int rk[4]; float ev[4];
#pragma unroll
      for (int q = 0; q < 4; ++q) { const unsigned long long g = __ballot(ck[q] > T2); rk[q] = ck[q] > T2 ? base + lanes_below(g) : 99; base += pcnt(g); }
#pragma unroll
      for (int q = 0; q < 4; ++q) { const unsigned long long g = __ballot(ck[q] == T2); if (ck[q] == T2) rk[q] = base + lanes_below(g); base += pcnt(g); }
#pragma unroll
      for (int q = 0; q < 4; ++q) { ev[q] = rk[q] < 16 ? __expf(cd[q] - mx) : 0.f; esum += ev[q]; }
      esum = wsum(esum); const float inv = 1.f / esum;
      int* orow = p.IDX + (size_t)row * 128 + h * 16; float* grow = p.GATE + (size_t)row * 128 + h * 16;
#pragma unroll
      for (int q = 0; q < 4; ++q) if (rk[q] < 16) { orow[rk[q]] = ia * 128 + seli[16 + (lane & 3) * 4 + q]; grow[rk[q]] = ev[q] * inv; }
      __builtin_amdgcn_wave_barrier();
    }
    it = nxt;
  }
}

typedef float v16f_t __attribute__((ext_vector_type(16)));
typedef float v32f_t __attribute__((ext_vector_type(32)));
typedef unsigned v6u_t __attribute__((ext_vector_type(6)));
typedef __bf16 v32bf_t __attribute__((ext_vector_type(32)));
typedef __bf16 v2bf_t __attribute__((ext_vector_type(2)));
constexpr int TROW = 1600;
constexpr int TROWV = 1152;
constexpr int TREC = 2176;
constexpr float TSM = 64.f;
DI void st_cvt_tables(const Prm& p, int layer, int bid, int nb) {
  const size_t nblk = (size_t)16384 * 64, stride = (size_t)nb * NTHR;
  const float* U = p.peer_u + (size_t)layer * 16384 * DM; const float* V = p.peer_v + (size_t)layer * 16384 * DM;
  for (size_t e = (size_t)bid * NTHR + ltid(); e < 2 * nblk; e += stride) { const bool isv = e >= nblk; const size_t k = isv ? e - nblk : e; const size_t row = k >> 6; const int l = (int)(k & 63);
    const float* src = (isv ? V : U) + row * DM + l * 32; float amax = 0.f; f32x4 a[8];
#pragma unroll
    for (int q = 0; q < 8; ++q) { a[q] = *(const f32x4*)(src + q * 4);
#pragma unroll
      for (int i = 0; i < 4; ++i) amax = fmaxf(amax, fabsf(a[q][i])); }
    const float want = fminf(fmaxf(amax * (TSM / 6.f), 0.001953125f), 448.f); int s8 = __builtin_amdgcn_cvt_pk_fp8_f32(want, want, 0, false) & 0xff;
    if (__builtin_amdgcn_cvt_f32_fp8(s8, 0) < want && s8 < 0x7e) ++s8;
    const float inv = TSM / __builtin_amdgcn_cvt_f32_fp8(s8, 0);
    u32x4 r = (u32x4){0u, 0u, 0u, 0u};
#pragma unroll
    for (int q = 0; q < 4; ++q) { unsigned w = 0;
      w = __builtin_amdgcn_cvt_scalef32_pk_fp4_f32(w, a[2 * q][0] * inv, a[2 * q][1] * inv, 1.0f, 0); w = __builtin_amdgcn_cvt_scalef32_pk_fp4_f32(w, a[2 * q][2] * inv, a[2 * q][3] * inv, 1.0f, 1);
      w = __builtin_amdgcn_cvt_scalef32_pk_fp4_f32(w, a[2 * q + 1][0] * inv, a[2 * q + 1][1] * inv, 1.0f, 2); w = __builtin_amdgcn_cvt_scalef32_pk_fp4_f32(w, a[2 * q + 1][2] * inv, a[2 * q + 1][3] * inv, 1.0f, 3);
      r[q] = w; }
    unsigned char* dst = (unsigned char*)p.Ub + row * TREC;
    dst[2 * l + (isv ? 1 : 0)] = (unsigned char)s8; *(u32x4*)(dst + 128 + (isv ? 1024 : 0) + l * 16) = r; }
}

DI void st_peergather(const Prm& p, int layer, float* lds, int bid, int nb, bool dry = false) {
  const int tid = ltid(), wave = tid >> 6, lane = tid & 63;
  const unsigned char* Ub = (const unsigned char*)p.Ub; const unsigned char* Vb = (const unsigned char*)p.Vb;
  for (int row = bid; row < MR; row += nb) {
    const int b = row / LT, t = row - b * LT; const bool isc = t >= LL;
    if (isc && layer == 1) continue;
    f32x2 hv[16];
#pragma unroll
    for (int q = 0; q < 4; ++q) { const u32x4 w = *(const u32x4*)(p.H2 + (size_t)row * DM + lane * 32 + q * 8);
#pragma unroll
      for (int k = 0; k < 4; ++k) hv[q * 4 + k] = (f32x2){__uint_as_float(w[k] << 16), __uint_as_float(w[k] & 0xffff0000u)}; }
    f32x2 acc[16];
#pragma unroll
    for (int i = 0; i < 16; ++i) acc[i] = (f32x2){0.f, 0.f};
    const int myidx = lane < 16 ? p.IDX[(size_t)row * 128 + wave * 16 + lane] : 0; const float mygate = lane < 16 ? p.GATE[(size_t)row * 128 + wave * 16 + lane] : 0.f;
#pragma unroll 1
    for (int k0 = 0; k0 < 16; k0 += 8) {
      u32x4 ua[8], va[8]; u32x2 ub[8], vb[8]; unsigned us[8], vs[8];
#pragma unroll
      for (int q = 0; q < 8; ++q) { const int e = __builtin_amdgcn_readfirstlane(__shfl(myidx, k0 + q));
        const unsigned char* ur = Ub + (size_t)e * TROW; const unsigned char* vr = Vb + (size_t)e * TROW;
        ua[q] = *(const u32x4*)(ur + 64 + lane * 16); ub[q] = *(const u32x2*)(ur + 64 + 1024 + lane * 8); us[q] = ur[lane];
        va[q] = *(const u32x4*)(vr + 64 + lane * 16); vb[q] = *(const u32x2*)(vr + 64 + 1024 + lane * 8); vs[q] = vr[lane]; }
#pragma unroll
      for (int q = 0; q < 8; ++q) {
        const v32f_t du = __builtin_amdgcn_cvt_scalef32_pk32_f32_fp6((v6u_t){ua[q][0], ua[q][1], ua[q][2], ua[q][3], ub[q][0], ub[q][1]}, 1.0f);
        f32x2 d0 = (f32x2){0.f, 0.f}, d1 = (f32x2){0.f, 0.f};
#pragma unroll
        for (int i = 0; i < 16; i += 2) { d0 += (f32x2){du[2 * i], du[2 * i + 1]} * hv[i]; d1 += (f32x2){du[2 * i + 2], du[2 * i + 3]} * hv[i + 1]; }
        d0 += d1; const float d = wsum((d0[0] + d0[1]) * __uint_as_float(us[q] << 23));
        const float wgt = __shfl(mygate, k0 + q) * 0.5f * d * (1.f + erff(d * 0.70710678118654752f)) * __uint_as_float(vs[q] << 23); const f32x2 w2 = (f32x2){wgt, wgt};
        const v32f_t dv = __builtin_amdgcn_cvt_scalef32_pk32_f32_fp6((v6u_t){va[q][0], va[q][1], va[q][2], va[q][3], vb[q][0], vb[q][1]}, 1.0f);
#pragma unroll
        for (int i = 0; i < 16; ++i) acc[i] += w2 * (f32x2){dv[2 * i], dv[2 * i + 1]}; }
    }
    __syncthreads();
#pragma unroll
    for (int k = 0; k < 8; ++k) *(f32x4*)(lds + wave * 2048 + lane * 32 + k * 4) = (f32x4){acc[2 * k][0], acc[2 * k][1], acc[2 * k + 1][0], acc[2 * k + 1][1]};
    __syncthreads();
    { const int col = tid * 4; f32x4 sum = (f32x4){0.f, 0.f, 0.f, 0.f};
#pragma unroll
      for (int w = 0; w < 8; ++w) sum += *(const f32x4*)(lds + w * 2048 + col);
      const f32x4 g2 = *(const f32x4*)(p.mod + ((size_t)layer * 9 + (isc ? 8 : b)) * NMOD + 5 * DM + col);
      float* xr = p.X + (size_t)row * DM + col; const f32x4 xn = *(const f32x4*)xr + g2 * sum;
      if (!dry) {
        float ss = wsum(xn[0] * xn[0] + xn[1] * xn[1] + xn[2] * xn[2] + xn[3] * xn[3]);
        if (lane == 0) lds[16384 + wave] = ss;
        __syncthreads();
        ss = 0.f;
#pragma unroll
        for (int w = 0; w < 8; ++w) ss += lds[16384 + w];
        const float rstd = rsqrtf(ss * (1.f / 2048.f) + EPSV);
        if (layer == 0) { *(f32x4*)xr = xn;
          const float* mr = p.mod + ((size_t)9 + (isc ? 8 : b)) * NMOD; const f32x4 sc = *(const f32x4*)(mr + DM + col), sh = *(const f32x4*)(mr + col);
          const f32x4 o = xn * rstd * (sc + 1.f) + sh; u32x2 w; w.x = pack2(o[0], o[1]); w.y = pack2(o[2], o[3]); *(u32x2*)(p.H + (size_t)row * DM + col) = w; }
        else *(f32x4*)(p.out + ((size_t)b * LL + t) * DM + col) = xn * rstd * *(const f32x4*)(p.final_norm + col);
      } }
  }
}

DI void sel_row(const float* scrow, float* selv, int* seli, int* orow, float* grow, int lane) {
  float s[2][2];
#pragma unroll
  for (int pp = 0; pp < 2; ++pp)
#pragma unroll
    for (int hh = 0; hh < 2; ++hh) s[pp][hh] = scrow[pp * 128 + hh * 64 + lane];
  unsigned kk[2][2], T[2] = {0u, 0u};
#pragma unroll
  for (int pp = 0; pp < 2; ++pp) { kk[pp][0] = fkey(s[pp][0]); kk[pp][1] = fkey(s[pp][1]); }
  { unsigned ta = 0u, tb = 0u, da = 0u, db = 0u;
    for (int bit = 31; bit >= 0; --bit) { const unsigned m = 1u << bit;
      const unsigned ca = ta | m, cb = tb | m;
      const unsigned na = (unsigned)(pcnt(__ballot(kk[0][0] >= ca)) + pcnt(__ballot(kk[0][1] >= ca))), nb2 = (unsigned)(pcnt(__ballot(kk[1][0] >= cb)) + pcnt(__ballot(kk[1][1] >= cb)));
      const unsigned oa = (na >= 16u ? 1u : 0u) & ~da, ob = (nb2 >= 16u ? 1u : 0u) & ~db;
      ta |= (0u - oa) & m; tb |= (0u - ob) & m; da |= oa & (na == 16u ? 1u : 0u); db |= ob & (nb2 == 16u ? 1u : 0u);
      if (da & db) break; }
    T[0] = __builtin_amdgcn_readfirstlane(ta); T[1] = __builtin_amdgcn_readfirstlane(tb); }
#pragma unroll
  for (int pp = 0; pp < 2; ++pp) { const unsigned k0 = kk[pp][0], k1 = kk[pp][1], TT = T[pp];
    const unsigned long long g0 = __ballot(k0 > TT), g1 = __ballot(k1 > TT), e0 = __ballot(k0 == TT), e1 = __ballot(k1 == TT);
    const int ng0 = pcnt(g0), ng = ng0 + pcnt(g1), need = 16 - ng, ne0 = pcnt(e0);
    if (k0 > TT) { const int r = lanes_below(g0); selv[pp * 16 + r] = s[pp][0]; seli[pp * 16 + r] = lane; }
    if (k1 > TT) { const int r = ng0 + lanes_below(g1); selv[pp * 16 + r] = s[pp][1]; seli[pp * 16 + r] = lane + 64; }
    if (k0 == TT) { const int r = lanes_below(e0); if (r < need) { selv[pp * 16 + ng + r] = s[pp][0]; seli[pp * 16 + ng + r] = lane; } }
    if (k1 == TT) { const int r = ne0 + lanes_below(e1); if (r < need) { selv[pp * 16 + ng + r] = s[pp][1]; seli[pp * 16 + ng + r] = lane + 64; } } }
  __builtin_amdgcn_wave_barrier();
  float cd[4]; unsigned ck[4]; { const float sa = selv[lane >> 2]; const f32x4 sb = *(const f32x4*)(selv + 16 + (lane & 3) * 4);
#pragma unroll
    for (int q = 0; q < 4; ++q) { cd[q] = sa + sb[q]; ck[q] = fkey(cd[q]); } }
  unsigned T2 = 0u;
  for (int bit = 31; bit >= 0; --bit) { const unsigned m = 1u << bit, c = T2 | m;
    const unsigned n = (unsigned)(pcnt(__ballot(ck[0] >= c)) + pcnt(__ballot(ck[1] >= c)) + pcnt(__ballot(ck[2] >= c)) + pcnt(__ballot(ck[3] >= c)));
    T2 |= (0u - (n >= 16u ? 1u : 0u)) & m; if (n == 16u) break; }
  T2 = __builtin_amdgcn_readfirstlane(T2);
  float mx = fmaxf(fmaxf(cd[0], cd[1]), fmaxf(cd[2], cd[3])); mx = wmax(mx);
  int base = 0; float esum = 0.f; const int ia = seli[lane >> 2]; int rk[4]; float ev[4];
#pragma unroll
  for (int q = 0; q < 4; ++q) { const unsigned long long g = __ballot(ck[q] > T2); rk[q] = ck[q] > T2 ? base + lanes_below(g) : 99; base += pcnt(g); }
#pragma unroll
  for (int q = 0; q < 4; ++q) { const unsigned long long g = __ballot(ck[q] == T2); if (ck[q] == T2) rk[q] = base + lanes_below(g); base += pcnt(g); }
#pragma unroll
  for (int q = 0; q < 4; ++q) { ev[q] = rk[q] < 16 ? __expf(cd[q] - mx) : 0.f; esum += ev[q]; }
  esum = wsum(esum); const float inv = 1.f / esum;
#pragma unroll
  for (int q = 0; q < 4; ++q) if (rk[q] < 16) { orow[rk[q]] = ia * 128 + seli[16 + (lane & 3) * 4 + q]; grow[rk[q]] = ev[q] * inv; }
  __builtin_amdgcn_wave_barrier();
}

DI void sel_row2(const float* sc0, const float* sc1, float* selv, int* seli, int* orow0, float* grow0, int* orow1, float* grow1, int lane) {
  float s[2][2][2]; unsigned kk[2][2][2];
#pragma unroll
  for (int w = 0; w < 2; ++w)
#pragma unroll
    for (int pp = 0; pp < 2; ++pp)
#pragma unroll
      for (int hh = 0; hh < 2; ++hh) { s[w][pp][hh] = (w ? sc1 : sc0)[pp * 128 + hh * 64 + lane]; kk[w][pp][hh] = fkey(s[w][pp][hh]); }
  unsigned T[2][2];
  { unsigned t0 = 0u, t1 = 0u, t2 = 0u, t3 = 0u, d0 = 0u, d1 = 0u, d2 = 0u, d3 = 0u;
    for (int bit = 31; bit >= 0; --bit) { const unsigned m = 1u << bit;
      const unsigned c0 = t0 | m, c1 = t1 | m, c2 = t2 | m, c3 = t3 | m;
      const unsigned n0 = (unsigned)(pcnt(__ballot(kk[0][0][0] >= c0)) + pcnt(__ballot(kk[0][0][1] >= c0))), n1 = (unsigned)(pcnt(__ballot(kk[0][1][0] >= c1)) + pcnt(__ballot(kk[0][1][1] >= c1)));
      const unsigned n2 = (unsigned)(pcnt(__ballot(kk[1][0][0] >= c2)) + pcnt(__ballot(kk[1][0][1] >= c2))), n3 = (unsigned)(pcnt(__ballot(kk[1][1][0] >= c3)) + pcnt(__ballot(kk[1][1][1] >= c3)));
      const unsigned o0 = (n0 >= 16u ? 1u : 0u) & ~d0, o1 = (n1 >= 16u ? 1u : 0u) & ~d1, o2 = (n2 >= 16u ? 1u : 0u) & ~d2, o3 = (n3 >= 16u ? 1u : 0u) & ~d3;
      t0 |= (0u - o0) & m; t1 |= (0u - o1) & m; t2 |= (0u - o2) & m; t3 |= (0u - o3) & m;
      d0 |= o0 & (n0 == 16u ? 1u : 0u); d1 |= o1 & (n1 == 16u ? 1u : 0u); d2 |= o2 & (n2 == 16u ? 1u : 0u); d3 |= o3 & (n3 == 16u ? 1u : 0u);
      if (d0 & d1 & d2 & d3) break; }
    T[0][0] = __builtin_amdgcn_readfirstlane(t0); T[0][1] = __builtin_amdgcn_readfirstlane(t1); T[1][0] = __builtin_amdgcn_readfirstlane(t2); T[1][1] = __builtin_amdgcn_readfirstlane(t3); }
#pragma unroll
  for (int w = 0; w < 2; ++w)
#pragma unroll
    for (int pp = 0; pp < 2; ++pp) { const unsigned k0 = kk[w][pp][0], k1 = kk[w][pp][1], TT = T[w][pp]; float* sv = selv + w * 32 + pp * 16; int* si = seli + w * 32 + pp * 16;
      const unsigned long long g0 = __ballot(k0 > TT), g1 = __ballot(k1 > TT), e0 = __ballot(k0 == TT), e1 = __ballot(k1 == TT);
      const int ng0 = pcnt(g0), ng = ng0 + pcnt(g1), need = 16 - ng, ne0 = pcnt(e0);
      if (k0 > TT) { const int r = lanes_below(g0); sv[r] = s[w][pp][0]; si[r] = lane; }
      if (k1 > TT) { const int r = ng0 + lanes_below(g1); sv[r] = s[w][pp][1]; si[r] = lane + 64; }
      if (k0 == TT) { const int r = lanes_below(e0); if (r < need) { sv[ng + r] = s[w][pp][0]; si[ng + r] = lane; } }
      if (k1 == TT) { const int r = ne0 + lanes_below(e1); if (r < need) { sv[ng + r] = s[w][pp][1]; si[ng + r] = lane + 64; } } }
  __builtin_amdgcn_wave_barrier();
  float cd[2][4]; unsigned ck[2][4];
#pragma unroll
  for (int w = 0; w < 2; ++w) { const float sa = selv[w * 32 + (lane >> 2)]; const f32x4 sb = *(const f32x4*)(selv + w * 32 + 16 + (lane & 3) * 4);
#pragma unroll
    for (int q = 0; q < 4; ++q) { cd[w][q] = sa + sb[q]; ck[w][q] = fkey(cd[w][q]); } }
  unsigned T2[2];
  { unsigned ta = 0u, tb = 0u, da = 0u, db = 0u;
    for (int bit = 31; bit >= 0; --bit) { const unsigned m = 1u << bit, ca = ta | m, cb = tb | m;
      const unsigned na = (unsigned)(pcnt(__ballot(ck[0][0] >= ca)) + pcnt(__ballot(ck[0][1] >= ca)) + pcnt(__ballot(ck[0][2] >= ca)) + pcnt(__ballot(ck[0][3] >= ca)));
      const unsigned nb2 = (unsigned)(pcnt(__ballot(ck[1][0] >= cb)) + pcnt(__ballot(ck[1][1] >= cb)) + pcnt(__ballot(ck[1][2] >= cb)) + pcnt(__ballot(ck[1][3] >= cb)));
      const unsigned oa = (na >= 16u ? 1u : 0u) & ~da, ob = (nb2 >= 16u ? 1u : 0u) & ~db;
      ta |= (0u - oa) & m; tb |= (0u - ob) & m; da |= oa & (na == 16u ? 1u : 0u); db |= ob & (nb2 == 16u ? 1u : 0u);
      if (da & db) break; }
    T2[0] = __builtin_amdgcn_readfirstlane(ta); T2[1] = __builtin_amdgcn_readfirstlane(tb); }
#pragma unroll
  for (int w = 0; w < 2; ++w) {
    float mx = fmaxf(fmaxf(cd[w][0], cd[w][1]), fmaxf(cd[w][2], cd[w][3])); mx = wmax(mx);
    int base = 0; float esum = 0.f; const int ia = seli[w * 32 + (lane >> 2)]; int rk[4]; float ev[4];
#pragma unroll
    for (int q = 0; q < 4; ++q) { const unsigned long long g = __ballot(ck[w][q] > T2[w]); rk[q] = ck[w][q] > T2[w] ? base + lanes_below(g) : 99; base += pcnt(g); }
#pragma unroll
    for (int q = 0; q < 4; ++q) { const unsigned long long g = __ballot(ck[w][q] == T2[w]); if (ck[w][q] == T2[w]) rk[q] = base + lanes_below(g); base += pcnt(g); }
#pragma unroll
    for (int q = 0; q < 4; ++q) { ev[q] = rk[q] < 16 ? __expf(cd[w][q] - mx) : 0.f; esum += ev[q]; }
    esum = wsum(esum); const float inv = 1.f / esum; int* orow = w ? orow1 : orow0; float* grow = w ? grow1 : grow0;
#pragma unroll
    for (int q = 0; q < 4; ++q) if (rk[q] < 16) { orow[rk[q]] = ia * 128 + seli[w * 32 + 16 + (lane & 3) * 4 + q]; grow[rk[q]] = ev[q] * inv; } }
  __builtin_amdgcn_wave_barrier();
}

DI float dpp_ror4(float v) { return __int_as_float(__builtin_amdgcn_mov_dpp(__float_as_int(v), 0x124, 0xf, 0xf, true)); }
DI float dpp_ror8(float v) { return __int_as_float(__builtin_amdgcn_mov_dpp(__float_as_int(v), 0x128, 0xf, 0xf, true)); }
DI float erf_bf(float x) { const float z = fabsf(x), t = __builtin_amdgcn_rcpf(fmaf(0.3275911f, z, 1.f));
  const float pl = t * fmaf(t, fmaf(t, fmaf(t, fmaf(t, 1.061405429f, -1.453152027f), 1.421413741f), -0.284496736f), 0.254829592f);
  const float r = fmaf(-pl, __builtin_amdgcn_exp2f(z * z * -1.4426950408889634f), 1.f); return copysignf(r, x); }
DI void st_peer(const Prm& p, int layer, unsigned char* lds, int bid, int nb, const int mode = 0) {
  int* HI = (int*)lds;
  float* HG = (float*)(lds + 32768);
  float* SCB = (float*)(lds + 65536);
  float* SLB = (float*)(lds + 65536 + 32768);
  int* CTR = (int*)(lds + 65536 + 32768 + 4096);
  const int nrows = layer == 0 ? 136 : 128, ntile = (nrows + 31) / 32;
  const unsigned char* Ub = (const unsigned char*)p.Ub; const unsigned char* Vb = (const unsigned char*)p.Vb;
  if (ltid() == 0) { CTR[0] = 0; CTR[1] = 0; }
  __syncthreads();
  for (int step = 0; step <= ntile; ++step) {
    const int tid = ltid(), wave = tid >> 6, lane = tid & 63, r32 = lane & 31, hi = lane >> 5;
    const bool tpath = step == 0 || (wave < 4 && step < ntile);
    if (tid == 0) CTR[(step + 1) & 1] = 0;
    if (tpath) {
      {
        const int hpw = step == 0 ? 1 : 2, tw = wave, buf = step & 1, t0 = step * 32, tl = nrows - t0 < 32 ? nrows - t0 : 32;
        float* RB = SCB + tw * 512; float* selv = SLB + tw * 128; int* seli = (int*)(selv + 64);
        const int rl = t0 + (r32 < tl ? r32 : tl - 1); const int rq = bid * nrows + rl; const int qrow = layer == 0 ? rq : (rq >> 12) * LT + (rq & 4095);
        for (int hh = 0; hh < hpw; ++hh) { const int h = tw * hpw + hh;
          f32x16 acc[2][4] = {};
#pragma unroll
          for (int pp = 0; pp < 2; ++pp) {
            const bf16_t* qp = p.Qp + (size_t)qrow * DM + h * 256 + pp * 128 + hi * 8; const bf16_t* kp = p.KB16 + ((size_t)((layer * 8 + h) * 2 + pp) * 128 + r32) * 128 + hi * 8;
#pragma unroll 4
            for (int ks = 0; ks < 8; ++ks) { const bf16x8 av = *(const bf16x8*)(qp + ks * 16);
#pragma unroll
              for (int nt = 0; nt < 4; ++nt) { const bf16x8 bv = *(const bf16x8*)(kp + (size_t)nt * 32 * 128 + ks * 16); acc[pp][nt] = __builtin_amdgcn_mfma_f32_32x32x16_bf16(av, bv, acc[pp][nt], 0, 0, 0); } } }
#pragma unroll 1
          for (int r = 0; r < 16; ++r) { const int m0 = (r & 3) + 8 * (r >> 2); if (m0 >= tl) continue;
#pragma unroll
            for (int pp = 0; pp < 2; ++pp)
#pragma unroll
              for (int nt = 0; nt < 4; ++nt) { const f32x16& A = acc[pp][nt];
                const float a0 = (r & 1) ? A[1] : A[0], a1 = (r & 1) ? A[3] : A[2], a2 = (r & 1) ? A[5] : A[4], a3 = (r & 1) ? A[7] : A[6], a4 = (r & 1) ? A[9] : A[8], a5 = (r & 1) ? A[11] : A[10], a6 = (r & 1) ? A[13] : A[12], a7 = (r & 1) ? A[15] : A[14];
                const float b0 = (r & 2) ? a1 : a0, b1 = (r & 2) ? a3 : a2, b2 = (r & 2) ? a5 : a4, b3 = (r & 2) ? a7 : a6;
                const float c0 = (r & 4) ? b1 : b0, c1 = (r & 4) ? b3 : b2;
                RB[hi * 256 + pp * 128 + nt * 32 + r32] = (r & 8) ? c1 : c0; }
            __builtin_amdgcn_wave_barrier();
            sel_row2(RB, RB + 256, selv, seli, HI + (buf * 32 + m0) * 128 + h * 16, HG + (buf * 32 + m0) * 128 + h * 16, HI + (buf * 32 + m0 + 4) * 128 + h * 16, HG + (buf * 32 + m0 + 4) * 128 + h * 16, lane);
            __builtin_amdgcn_wave_barrier(); }
        }
      }
    }
    if (step >= 1) {
      const int tile = step - 1, buf = tile & 1;
      for (;;) { int m = 0; if (lane == 0) m = atomicAdd(&CTR[step & 1], 1); m = __builtin_amdgcn_readfirstlane(m); const int rl = tile * 32 + m; if (m >= 32 || rl >= nrows) break;
        const int rq = bid * nrows + rl; const int row = layer == 0 ? rq : (rq >> 12) * LT + (rq & 4095);
        const int b = row / LT, t = row - b * LT; const bool isc = t >= LL;
        u32x4 hw[2];
        int lane_r = lane; asm volatile("" : "+v"(lane_r));
#pragma unroll
        for (int q = 0; q < 2; ++q) hw[q] = *(const u32x4*)(p.H2q + (size_t)row * DM + lane_r * 32 + q * 16);
#define HVP(k) ((f32x2){__uint_as_float(hw[(k) >> 2][(k) & 3] << 16), __uint_as_float(hw[(k) >> 2][(k) & 3] & 0xffff0000u)})
        f32x2 acc[16];
#pragma unroll
        for (int k = 0; k < 16; ++k) acc[k] = (f32x2){0.f, 0.f};
        const int* hi_ = HI + (buf * 32 + m) * 128; const float* hg_ = HG + (buf * 32 + m) * 128;
        const int idx0 = hi_[lane], idx1 = hi_[64 + lane]; const float gt0 = hg_[lane], gt1 = hg_[64 + lane];
        constexpr int NS = 8;
        u32x4 ua[NS] = {}, va[NS] = {}; unsigned us[NS] = {};
        const unsigned vo16 = lane * 16, vo2 = lane * 2;
        const int bp16 = (lane ^ 16) * 4, bp32 = (lane ^ 32) * 4, l3 = lane & 3; const bool b0 = (lane & 1) != 0, b1 = (lane & 2) != 0;
        unsigned hd[16];
#pragma unroll
        for (int j = 0; j < 8; ++j) { const int dw = (int)hw[j >> 2][j & 3]; const f32x2 t0 = __builtin_amdgcn_cvt_pk_f32_fp8(dw, false), t1 = __builtin_amdgcn_cvt_pk_f32_fp8(dw, true);
          hd[2 * j] = (__float_as_uint(t0[0]) >> 16) | (__float_as_uint(t0[1]) & 0xffff0000u); hd[2 * j + 1] = (__float_as_uint(t1[0]) >> 16) | (__float_as_uint(t1[1]) & 0xffff0000u);
          asm volatile("" : "+v"(hd[2 * j]), "+v"(hd[2 * j + 1])); }
#define DOT2(A, I) A = __builtin_amdgcn_fdot2_f32_bf16(__builtin_shufflevector(du, du, 2 * (I), 2 * (I) + 1), __builtin_bit_cast(v2bf_t, hd[I]), A, false);
#define PG_LOADU0(S, K) { const int k_ = (K); const int e = __builtin_amdgcn_readlane(isrc_, k_ & 63); const unsigned char* ur = Ub + (size_t)e * TREC; \
            asm volatile("global_load_dwordx4 %0, %2, %4 offset:128\n\tglobal_load_ushort %1, %3, %4" \
                         : "+v"(ua[S]), "+v"(us[S]) : "v"(vo16), "v"(vo2), "s"(ur), \
                           "v"(acc[0]), "v"(acc[1]), "v"(acc[2]), "v"(acc[3]), "v"(acc[4]), "v"(acc[5]), "v"(acc[6]), "v"(acc[7]), "v"(acc[8]), "v"(acc[9]), "v"(acc[10]), "v"(acc[11]), \
                           "v"(acc[12]), "v"(acc[13]), "v"(acc[14]), "v"(acc[15]) : "memory"); }
#define PG_LOADU(S, K) { const int k_ = (K); const int e = __builtin_amdgcn_readlane(isrc_, k_ & 63); const unsigned char* ur = Ub + (size_t)e * TREC; \
            asm volatile("global_load_dwordx4 %0, %2, %4 offset:128\n\tglobal_load_ushort %1, %3, %4" : "+v"(ua[S]), "+v"(us[S]) : "v"(vo16), "v"(vo2), "s"(ur) : "memory"); }
#define PG_LOADV(S, K) { const int k_ = (K); const int e = __builtin_amdgcn_readlane(isrc_, k_ & 63); const unsigned char* vr = Ub + (size_t)e * TREC; \
            asm volatile("global_load_dwordx4 %0, %1, %2 offset:1152" : "+v"(va[S]) : "v"(vo16), "s"(vr) : "memory"); }
#define PG_LOADG(S0, K0) { const int isrc_ = (K0) < 64 ? idx0 : idx1;     \
                           PG_LOADU0(S0, K0) PG_LOADU(S0 + 1, (K0) + 1) PG_LOADU(S0 + 2, (K0) + 2) PG_LOADU(S0 + 3, (K0) + 3) \
                           PG_LOADV(S0, K0) PG_LOADV(S0 + 1, (K0) + 1) PG_LOADV(S0 + 2, (K0) + 2) PG_LOADV(S0 + 3, (K0) + 3) }
#define PG_UDOT(S, D) { float da = 0.f, db = 0.f; \
            _Pragma("unroll") for (int q = 0; q < 4; ++q) { \
              da = __builtin_amdgcn_fdot2_f32_bf16(__builtin_amdgcn_cvt_scalef32_pk_bf16_fp4(ua[S][q], 1.0f, 0), __builtin_bit_cast(v2bf_t, hd[4 * q]), da, false); \
              db = __builtin_amdgcn_fdot2_f32_bf16(__builtin_amdgcn_cvt_scalef32_pk_bf16_fp4(ua[S][q], 1.0f, 1), __builtin_bit_cast(v2bf_t, hd[4 * q + 1]), db, false); \
              da = __builtin_amdgcn_fdot2_f32_bf16(__builtin_amdgcn_cvt_scalef32_pk_bf16_fp4(ua[S][q], 1.0f, 2), __builtin_bit_cast(v2bf_t, hd[4 * q + 2]), da, false); \
              db = __builtin_amdgcn_fdot2_f32_bf16(__builtin_amdgcn_cvt_scalef32_pk_bf16_fp4(ua[S][q], 1.0f, 3), __builtin_bit_cast(v2bf_t, hd[4 * q + 3]), db, false); } \
            D = (da + db) * __builtin_amdgcn_cvt_f32_fp8((int)us[S], 0); }
#define PG_VACC(S, Q) { const float wgt = __int_as_float(__builtin_amdgcn_readlane(__float_as_int(wv), Q)) * __builtin_amdgcn_cvt_f32_fp8((int)us[S], 1); const f32x2 w2 = (f32x2){wgt, wgt}; \
            _Pragma("unroll") for (int q = 0; q < 4; ++q) { \
              acc[q * 4 + 0] += w2 * __builtin_amdgcn_cvt_scalef32_pk_f32_fp4(va[S][q], 1.0f, 0); acc[q * 4 + 1] += w2 * __builtin_amdgcn_cvt_scalef32_pk_f32_fp4(va[S][q], 1.0f, 1); \
              acc[q * 4 + 2] += w2 * __builtin_amdgcn_cvt_scalef32_pk_f32_fp4(va[S][q], 1.0f, 2); acc[q * 4 + 3] += w2 * __builtin_amdgcn_cvt_scalef32_pk_f32_fp4(va[S][q], 1.0f, 3); } }
#define PG_GROUP(S0, K0, NU, NV) { const int k0_ = (K0); \
            asm volatile("s_waitcnt vmcnt(%8)" : "+v"(ua[S0]), "+v"(us[S0]), "+v"(ua[S0 + 1]), "+v"(us[S0 + 1]), "+v"(ua[S0 + 2]), "+v"(us[S0 + 2]), "+v"(ua[S0 + 3]), "+v"(us[S0 + 3]) : "n"(NU) : "memory"); \
            float dq0, dq1, dq2, dq3; PG_UDOT(S0, dq0) PG_UDOT(S0 + 1, dq1) PG_UDOT(S0 + 2, dq2) PG_UDOT(S0 + 3, dq3) \
            const float s01 = (b0 ? dq1 : dq0) + dpp_x1(b0 ? dq0 : dq1), s23 = (b0 ? dq3 : dq2) + dpp_x1(b0 ? dq2 : dq3); \
            float sd = (b1 ? s23 : s01) + dpp_x2(b1 ? s01 : s23); sd += dpp_ror4(sd); sd += dpp_ror8(sd); \
            sd += __int_as_float(__builtin_amdgcn_ds_bpermute(bp16, __float_as_int(sd))); sd += __int_as_float(__builtin_amdgcn_ds_bpermute(bp32, __float_as_int(sd))); sd *= 1.f / TSM; \
            const float gv = __int_as_float(__builtin_amdgcn_ds_bpermute(((k0_ & 63) + l3) * 4, __float_as_int(k0_ < 64 ? gt0 : gt1))); \
            const float wv = gv * (0.5f / TSM) * sd * (1.f + erf_bf(sd * 0.70710678118654752f));     \
            asm volatile("s_waitcnt vmcnt(%4)" : "+v"(va[S0]), "+v"(va[S0 + 1]), "+v"(va[S0 + 2]), "+v"(va[S0 + 3]) : "n"(NV) : "memory"); \
            PG_VACC(S0, 0) PG_VACC(S0 + 1, 1) PG_VACC(S0 + 2, 2) PG_VACC(S0 + 3, 3) }
        PG_LOADG(0, 0) PG_LOADG(4, 4)
#pragma unroll 1
        for (int k0 = 0; k0 < 120; k0 += 8) {
          PG_GROUP(0, k0, 16, 12) PG_LOADG(0, k0 + 8)
          PG_GROUP(4, k0 + 4, 16, 12) PG_LOADG(4, k0 + 12)
        }
        PG_GROUP(0, 120, 16, 12) PG_GROUP(4, 124, 4, 0)
#undef PG_LOADU0
#undef PG_LOADU
#undef PG_LOADV
#undef PG_LOADG
#undef PG_UDOT
#undef PG_VACC
#undef PG_GROUP
#undef DOT2
        int lane_e = lane; asm volatile("" : "+v"(lane_e));
        const float* g2p = p.mod + ((size_t)layer * 9 + (isc ? 8 : b)) * NMOD + 5 * DM + lane_e * 32; bf16_t* xr = p.Xb + (size_t)row * DM + lane_e * 32;
        f32x4 xn[8]; float ss = 0.f;
#pragma unroll
        for (int k = 0; k < 8; ++k) { const f32x4 sum = (f32x4){acc[2 * k][0], acc[2 * k][1], acc[2 * k + 1][0], acc[2 * k + 1][1]};
          const u32x2 xw = *(const u32x2*)(xr + k * 4); const f32x4 xo = (f32x4){__uint_as_float(xw.x << 16), __uint_as_float(xw.x & 0xffff0000u), __uint_as_float(xw.y << 16), __uint_as_float(xw.y & 0xffff0000u)};
          xn[k] = xo + *(const f32x4*)(g2p + k * 4) * sum; ss += xn[k][0] * xn[k][0] + xn[k][1] * xn[k][1] + xn[k][2] * xn[k][2] + xn[k][3] * xn[k][3]; }
        ss = wsum(ss); const float rstd = rsqrtf(ss * (1.f / 2048.f) + EPSV);
        if ((mode & 1) && rstd != 12345.678f) continue;
        if (layer == 0) { const float* mr = p.mod + ((size_t)9 + (isc ? 8 : b)) * NMOD + lane_e * 32;
#pragma unroll
          for (int k = 0; k < 8; k += 2) { { u32x4 xw; xw.x = pack2(xn[k][0], xn[k][1]); xw.y = pack2(xn[k][2], xn[k][3]); xw.z = pack2(xn[k + 1][0], xn[k + 1][1]); xw.w = pack2(xn[k + 1][2], xn[k + 1][3]); *(u32x4*)(xr + k * 4) = xw; }
            const f32x4 o0 = xn[k] * rstd * (*(const f32x4*)(mr + DM + k * 4) + 1.f) + *(const f32x4*)(mr + k * 4), o1 = xn[k + 1] * rstd * (*(const f32x4*)(mr + DM + k * 4 + 4) + 1.f) + *(const f32x4*)(mr + k * 4 + 4);
            u32x2 w; w.x = pk4_fp8(o0[0], o0[1], o0[2], o0[3]); w.y = pk4_fp8(o1[0], o1[1], o1[2], o1[3]); *(u32x2*)((unsigned char*)p.H + (size_t)row * DM + lane_e * 32 + k * 4) = w; } }
        else { float* orow = p.out + ((size_t)b * LL + t) * DM + lane_e * 32; const float* fn = p.final_norm + lane_e * 32;
#pragma unroll
          for (int k = 0; k < 8; ++k) *(f32x4*)(orow + k * 4) = xn[k] * rstd * *(const f32x4*)(fn + k * 4); }
      }
    }
    __syncthreads();
  }
#undef HVP
}

DI void st_mlacheck(const Prm& p, int layer, float* lds, int bid, int nb) {
  float* aq = lds; float* qv = aq + 448; float* qwn = qv + 192; float* scs = qwn + 128; float* rs = scs + 4352; float* Ak = rs + 4352; float* red = Ak + 128; float* ov = red + 64;
  const int tid = ltid(), lane = tid & 63, wave = tid >> 6;
  const int s = bid, b = s & 7, h = (s >> 3) & 3; const bool cq_ = (layer == 0) && s >= 224;
  const int t = cq_ ? (s * 37) % LCX : (s * 977 + 13) % LL; const int row = b * LT + (cq_ ? LL + t : t);
  const int nkeys = cq_ ? LCX : LT, krow0 = cq_ ? b * LT + LL : b * LT;
  const float* wuq = p.mla_w_uq + (size_t)layer * 448 * 768; const float* wukv = p.mla_w_ukv + (size_t)layer * 128 * 1024;
  const float* qn = p.mla_q_norm + layer * 448; const float* kvn = p.mla_kv_norm + layer * 128;
  __syncthreads();
  { float v = tid < 448 ? bf2f(p.Z[(size_t)row * NZ + C_CQ + tid]) : 0.f; float ss = wsum(v * v); if (lane == 0) red[wave] = ss; __syncthreads();
    float tot = 0.f; for (int w = 0; w < 8; ++w) tot += red[w]; const float rstd = rsqrtf(tot * (1.f / 448.f) + EPSV); if (tid < 448) aq[tid] = v * rstd * qn[tid]; }
  __syncthreads();
  if (tid < 192) { float a = 0.f; for (int k = 0; k < 448; ++k) a += aq[k] * wuq[(size_t)k * 768 + h * 192 + tid]; qv[tid] = a; }
  __syncthreads();
  if (!cq_ && tid < 32) { const int half = tid >> 4, i = tid & 15; const float x1 = qv[128 + half * 32 + i], x2 = qv[128 + half * 32 + 16 + i];
    const float pos = (float)(half ? (t & 63) : (t >> 6)); const float ang = pos * exp2f(-(float)i * (13.287712379549449f / 16.f)); float sv, cv; sincosf(ang, &sv, &cv);
    qv[128 + half * 32 + i] = x1 * cv - x2 * sv; qv[128 + half * 32 + 16 + i] = x2 * cv + x1 * sv; }
  __syncthreads();
  if (tid < 128) { float a = 0.f; for (int j = 0; j < 128; ++j) a += qv[j] * wukv[(size_t)tid * 1024 + h * 256 + j]; qwn[tid] = a * kvn[tid]; }
  __syncthreads();
  for (int ks = tid; ks < nkeys; ks += NTHR) { const int krow = krow0 + ks; const bf16_t* z = p.Z + (size_t)krow * NZ; float ss = 0.f, dn = 0.f;
    for (int k = 0; k < 128; ++k) { const float zz = bf2f(z[C_CKV + k]); ss += zz * zz; dn += zz * qwn[k]; }
    const float rstd = rsqrtf(ss * (1.f / 128.f) + EPSV); float dr = 0.f; const bool klat = !cq_ && ks < LL;
    for (int half = 0; half < 2; ++half) for (int i = 0; i < 16; ++i) { float x1 = bf2f(z[C_KR + half * 32 + i]), x2 = bf2f(z[C_KR + half * 32 + 16 + i]);
        if (klat) { const float pos = (float)(half ? (ks & 63) : (ks >> 6)); const float ang = pos * exp2f(-(float)i * (13.287712379549449f / 16.f)); float sv, cv; sincosf(ang, &sv, &cv); const float y1 = x1 * cv - x2 * sv, y2 = x2 * cv + x1 * sv; x1 = y1; x2 = y2; }
        dr += qv[128 + half * 32 + i] * x1 + qv[128 + half * 32 + 16 + i] * x2; }
    scs[ks] = (rstd * dn + dr) * 0.07216878364870322f; rs[ks] = rstd; }
  __syncthreads();
  float mx = -3e38f; for (int ks = tid; ks < nkeys; ks += NTHR) mx = fmaxf(mx, scs[ks]); mx = wmax(mx); if (lane == 0) red[wave] = mx; __syncthreads();
  mx = red[0]; for (int w = 1; w < 8; ++w) mx = fmaxf(mx, red[w]); __syncthreads();
  float sm = 0.f; for (int ks = tid; ks < nkeys; ks += NTHR) { const float e = __expf(scs[ks] - mx); scs[ks] = e; sm += e; } sm = wsum(sm); if (lane == 0) red[wave] = sm; __syncthreads();
  sm = 0.f; for (int w = 0; w < 8; ++w) sm += red[w];
  if (tid < 128) { float a = 0.f; for (int ks = 0; ks < nkeys; ++ks) a += scs[ks] * rs[ks] * bf2f(p.Z[(size_t)(krow0 + ks) * NZ + C_CKV + tid]); Ak[tid] = a * kvn[tid] / sm; }
  __syncthreads();
  if (tid < 128) { float a = 0.f; for (int k = 0; k < 128; ++k) a += Ak[k] * wukv[(size_t)k * 1024 + h * 256 + 128 + tid]; ov[tid] = a; }
  __syncthreads();
  if (tid < 128) { float am = 0.f; for (int j = 0; j < 128; ++j) am = fmaxf(am, fabsf(ov[j]));
    const float got = bf2f(p.Y[(size_t)row * DM + 1024 + h * 128 + tid]); const float err = fabsf(got - ov[tid]);
    if (!(err <= 0.06f * am + 1e-6f)) atomicAdd(p.bar + 4000, 1u); }
  __syncthreads();
}

DI void st_final(const Prm& p, int bid, int nb) {
  const int wave = ltid() >> 6, lane = ltid() & 63;
  for (int r = bid * 8 + wave; r < NB * LL; r += nb * 8) {
    const int b = r / LL, t = r - b * LL; const float* src = p.X + (size_t)(b * LT + t) * DM;
    f32x4 v[8]; float ss = 0.f;
#pragma unroll
    for (int i = 0; i < 8; ++i) { v[i] = *(const f32x4*)(src + (i * 64 + lane) * 4); ss += v[i][0] * v[i][0] + v[i][1] * v[i][1] + v[i][2] * v[i][2] + v[i][3] * v[i][3]; }
    ss = wsum(ss); const float rstd = rsqrtf(ss * (1.f / 2048.f) + EPSV);
#pragma unroll
    for (int i = 0; i < 8; ++i) { const int col = (i * 64 + lane) * 4; *(f32x4*)(p.out + (size_t)r * DM + col) = v[i] * rstd * *(const f32x4*)(p.final_norm + col); }
  }
}

namespace att {
constexpr int NW = 8, QBLK = 32, KVBLK = 64;
constexpr float SCALE = 0.07216878364870322f;
constexpr float THR = 8.f;
constexpr int LDQ = 768, LDK = 1024, LDKR = 64, LDO = DM;
constexpr int SHM_V = KVBLK * 128 * 2, SHM_K = KVBLK * 128 * 2, SHM_KR = KVBLK * 64 * 2, SHM_ATTN = 2 * SHM_V + 2 * SHM_K + 2 * SHM_KR + NW * 64 * 4;
#define KSWZ(row, colB) ((row) * 256 + ((colB) ^ (((row) & 7) << 4)))
#define KRSWZ(row, colB) ((row) * 128 + ((colB) ^ ((((row) >> 1) & 7) << 4)))
#define SBAR() __builtin_amdgcn_sched_barrier(0)
DI int crow(int r, int hi) { return (r & 3) + 8 * (r >> 2) + 4 * hi; }
DI unsigned cvtpk(float lo, float hi) { unsigned r; asm volatile("v_cvt_pk_bf16_f32 %0, %1, %2" : "=v"(r) : "v"(lo), "v"(hi)); return r; }

DI void partialSM(f32x16& p0, f32x16& p1, float& m_reg, float& mn, float& alpha) {
  constexpr float C = SCALE * 1.4426950408889634f;
  float pmax = p0[0];
#pragma unroll
  for (int r = 1; r < 16; ++r) pmax = fmaxf(pmax, p0[r]);
#pragma unroll
  for (int r = 0; r < 16; ++r) pmax = fmaxf(pmax, p1[r]);
  { auto rr = __builtin_amdgcn_permlane32_swap(__float_as_uint(pmax), __float_as_uint(pmax), false, false);
    pmax = fmaxf(__uint_as_float(rr[0]), __uint_as_float(rr[1])); }
  if (__builtin_expect(__all(pmax - m_reg <= THR / SCALE), 1)) { mn = m_reg; alpha = 1.f; }
  else { mn = fmaxf(m_reg, pmax); alpha = __builtin_amdgcn_exp2f((m_reg - mn) * C); m_reg = mn; }
  const float mnC = -mn * C;
#pragma unroll
  for (int r = 0; r < 16; ++r) p0[r] = fmaf(p0[r], C, mnC);
#pragma unroll
  for (int r = 0; r < 16; ++r) p1[r] = fmaf(p1[r], C, mnC);
#pragma unroll
  for (int r = 0; r < 16; ++r) p0[r] = __builtin_amdgcn_exp2f(p0[r]);
}
DI void finishSM(f32x16& p0, f32x16& p1, float alpha, float& l_reg, bf16x8& pa0, bf16x8& pa1, bf16x8& pa2, bf16x8& pa3) {
#pragma unroll
  for (int r = 0; r < 16; ++r) p1[r] = __builtin_amdgcn_exp2f(p1[r]);
  float ps = 0;
#pragma unroll
  for (int r = 0; r < 16; ++r) ps += p0[r];
#pragma unroll
  for (int r = 0; r < 16; ++r) ps += p1[r];
  { auto rr = __builtin_amdgcn_permlane32_swap(__float_as_uint(ps), __float_as_uint(ps), false, false);
    ps = __uint_as_float(rr[0]) + __uint_as_float(rr[1]); }
  l_reg = l_reg * alpha + ps;
#define PK4(P, BASE, OUT) do { unsigned a0 = cvtpk(P[BASE + 0], P[BASE + 1]), a1 = cvtpk(P[BASE + 2], P[BASE + 3]);   \
    unsigned b0 = cvtpk(P[BASE + 4], P[BASE + 5]), b1 = cvtpk(P[BASE + 6], P[BASE + 7]);                              \
    auto r0 = __builtin_amdgcn_permlane32_swap(a0, b0, false, false); auto r1 = __builtin_amdgcn_permlane32_swap(a1, b1, false, false); \
    u32x4 w = {r0[0], r1[0], r0[1], r1[1]}; OUT = *reinterpret_cast<bf16x8*>(&w); } while (0)
  PK4(p0, 0, pa0); PK4(p0, 8, pa1); PK4(p1, 0, pa2); PK4(p1, 8, pa3);
#undef PK4
}
DI void qkt(f32x16& p0, f32x16& p1, const char* Ks, const char* KRs, const bf16x8* qr, int r32, int hi) {
  p0 = f32x16{}; p1 = f32x16{};
#pragma unroll
  for (int d0 = 0; d0 < 8; ++d0) { const int cb = (d0 * 16 + hi * 8) * 2;
    const bf16x8 b0 = *reinterpret_cast<const bf16x8*>(Ks + KSWZ(r32, cb));
    const bf16x8 b1 = *reinterpret_cast<const bf16x8*>(Ks + KSWZ(32 + r32, cb));
    p0 = __builtin_amdgcn_mfma_f32_32x32x16_bf16(b0, qr[d0], p0, 0, 0, 0);
    p1 = __builtin_amdgcn_mfma_f32_32x32x16_bf16(b1, qr[d0], p1, 0, 0, 0); }
#pragma unroll
  for (int d0 = 0; d0 < 4; ++d0) { const int cb = (d0 * 16 + hi * 8) * 2;
    const bf16x8 b0 = *reinterpret_cast<const bf16x8*>(KRs + KRSWZ(r32, cb));
    const bf16x8 b1 = *reinterpret_cast<const bf16x8*>(KRs + KRSWZ(32 + r32, cb));
    p0 = __builtin_amdgcn_mfma_f32_32x32x16_bf16(b0, qr[8 + d0], p0, 0, 0, 0);
    p1 = __builtin_amdgcn_mfma_f32_32x32x16_bf16(b1, qr[8 + d0], p1, 0, 0, 0); }
}
DI int v_st(int k, int c) { const int kk = (k & ~0xC) | ((k & 4) << 1) | ((k & 8) >> 1); return ((kk >> 3) * 4 + (c >> 5)) * 512 + ((kk & 7) * 32 + (c & 31)) * 2; }
DI int v_rd_base(int lane) { return ((lane & 3) << 3) | (((lane >> 2) & 3) << 6) | (((lane >> 4) & 1) << 5) | (((lane >> 5) & 1) << 8); }
constexpr int v_rd_off(int d0, int ks, int half) { return d0 * 512 + ks * 4096 + half * 2048; }
template <int OFF> DI s16x4 tr_read(int vb) { s16x4 r; asm volatile("ds_read_b64_tr_b16 %0, %1 offset:%2" : "=&v"(r) : "v"(vb), "i"(OFF) : "memory"); return r; }
template <int D0> DI void pv_one(f32x16& od, int vb, bf16x8 pa0, bf16x8 pa1, bf16x8 pa2, bf16x8 pa3) {
  const s16x4 l0 = tr_read<v_rd_off(D0, 0, 0)>(vb), h0 = tr_read<v_rd_off(D0, 0, 1)>(vb), l1 = tr_read<v_rd_off(D0, 1, 0)>(vb), h1 = tr_read<v_rd_off(D0, 1, 1)>(vb);
  const s16x4 l2 = tr_read<v_rd_off(D0, 2, 0)>(vb), h2 = tr_read<v_rd_off(D0, 2, 1)>(vb), l3 = tr_read<v_rd_off(D0, 3, 0)>(vb), h3 = tr_read<v_rd_off(D0, 3, 1)>(vb);
  asm volatile("s_waitcnt lgkmcnt(0)" ::: "memory"); SBAR();
#define PK(L, H) (bf16x8){L[0], L[1], L[2], L[3], H[0], H[1], H[2], H[3]}
  od = __builtin_amdgcn_mfma_f32_32x32x16_bf16(pa0, PK(l0, h0), od, 0, 0, 0);
  od = __builtin_amdgcn_mfma_f32_32x32x16_bf16(pa1, PK(l1, h1), od, 0, 0, 0);
  od = __builtin_amdgcn_mfma_f32_32x32x16_bf16(pa2, PK(l2, h2), od, 0, 0, 0);
  od = __builtin_amdgcn_mfma_f32_32x32x16_bf16(pa3, PK(l3, h3), od, 0, 0, 0);
#undef PK
}
DI void pv_d0(f32x16* o, int vb, bf16x8 pa0, bf16x8 pa1, bf16x8 pa2, bf16x8 pa3) {
  pv_one<0>(o[0], vb, pa0, pa1, pa2, pa3); pv_one<1>(o[1], vb, pa0, pa1, pa2, pa3); pv_one<2>(o[2], vb, pa0, pa1, pa2, pa3); pv_one<3>(o[3], vb, pa0, pa1, pa2, pa3);
}

DI void attn_body(const bf16_t* __restrict__ Qb, const bf16_t* __restrict__ Kh, const bf16_t* __restrict__ Vh, const bf16_t* __restrict__ KRh, bf16_t* __restrict__ Ob, int seq, int tpos0, char* lds) {
  const int tid = ltid(), wid = tid >> 6, lane = tid & 63, r32 = lane & 31, hi = lane >> 5;
  char* V_lds = lds; char* K_lds = lds + 2 * SHM_V; char* KR_lds = lds + 2 * SHM_V + 2 * SHM_K;
  float* ws = (float*)(lds + 2 * SHM_V + 2 * SHM_K + 2 * SHM_KR) + wid * 64; float* li_l = ws; float* al_l = ws + 32;
  float m_reg = -1e30f, l_reg = 0; f32x16 o[4] = {}; bf16x8 qr[12];
  const bf16_t* Qw = Qb + (long)(wid * QBLK + r32) * LDQ + hi * 8;
#pragma unroll
  for (int d0 = 0; d0 < 12; ++d0) qr[d0] = *reinterpret_cast<const bf16x8*>(Qw + d0 * 16);
  if (tpos0 >= 0) {
    const int t = tpos0 + wid * QBLK + r32;
#pragma unroll
    for (int hf = 0; hf < 2; ++hf) { const float pos = (float)(hf ? (t & 63) : (t >> 6));
#pragma unroll
      for (int j = 0; j < 8; ++j) { const float ang = pos * exp2f(-(float)(hi * 8 + j) * (13.287712379549449f / 16.f)); float sv, cv; sincosf(ang, &sv, &cv);
        const float x1 = bf2f((bf16_t)qr[8 + 2 * hf][j]), x2 = bf2f((bf16_t)qr[9 + 2 * hf][j]);
        qr[8 + 2 * hf][j] = (short)f2bf(x1 * cv - x2 * sv); qr[9 + 2 * hf][j] = (short)f2bf(x2 * cv + x1 * sv); } }
  }
  const int sr = tid >> 4, sc = (tid & 15) * 8, vst0 = v_st(sr, sc), vst1 = v_st(32 + sr, sc);
  const int krr = tid >> 3, krc = (tid & 7) * 8;
  const int vb0 = (int)(uintptr_t)V_lds + v_rd_base(lane);
  bf16x8 vs0, vs1, ks0, ks1, kr0;
#define SLOAD(k0) do { vs0 = *reinterpret_cast<const bf16x8*>(&Vh[(long)((k0) + sr) * LDK + sc]); vs1 = *reinterpret_cast<const bf16x8*>(&Vh[(long)((k0) + 32 + sr) * LDK + sc]); \
    ks0 = *reinterpret_cast<const bf16x8*>(&Kh[(long)((k0) + sr) * LDK + sc]); ks1 = *reinterpret_cast<const bf16x8*>(&Kh[(long)((k0) + 32 + sr) * LDK + sc]); \
    kr0 = *reinterpret_cast<const bf16x8*>(&KRh[(long)((k0) + krr) * LDKR + krc]); } while (0)
#define SWRITE(b) do { *(bf16x8*)(V_lds + (b) * SHM_V + vst0) = vs0; *(bf16x8*)(V_lds + (b) * SHM_V + vst1) = vs1; const int kc = sc * 2;               \
    *(bf16x8*)(K_lds + (b) * SHM_K + KSWZ(sr, kc)) = ks0; *(bf16x8*)(K_lds + (b) * SHM_K + KSWZ(32 + sr, kc)) = ks1;                       \
    *(bf16x8*)(KR_lds + (b) * SHM_KR + KRSWZ(krr, krc * 2)) = kr0; } while (0)
#define SWAIT() asm volatile("s_waitcnt vmcnt(0)" ::: "memory")
#define RESC(a) do { if (__any((a) < 1.f)) { if (hi == 0) al_l[r32] = (a); asm volatile("s_waitcnt lgkmcnt(0)" ::: "memory"); \
    _Pragma("unroll") for (int d = 0; d < 4; ++d) _Pragma("unroll") for (int r = 0; r < 16; ++r) o[d][r] *= al_l[crow(r, hi)]; } } while (0)
  f32x16 p0, p1; float mn, al; bf16x8 pa0, pa1, pa2, pa3; const int NT = seq / KVBLK;
  SLOAD(0); SWAIT(); SWRITE(0); __syncthreads();
  for (int j = 0; j < NT; ++j) {
    const int buf = j & 1; const bool more = j + 1 < NT;
    if (more) SLOAD((j + 1) * KVBLK);
    SBAR(); qkt(p0, p1, K_lds + buf * SHM_K, KR_lds + buf * SHM_KR, qr, r32, hi);
    partialSM(p0, p1, m_reg, mn, al); RESC(al);
    finishSM(p0, p1, al, l_reg, pa0, pa1, pa2, pa3); SBAR();
    pv_d0(o, vb0 + buf * SHM_V, pa0, pa1, pa2, pa3);
    if (more) { SWAIT(); SWRITE(buf ^ 1); }
    __syncthreads();
  }
  if (hi == 0) li_l[r32] = l_reg; asm volatile("s_waitcnt lgkmcnt(0)" ::: "memory");
  float rli[16];
#pragma unroll
  for (int r = 0; r < 16; ++r) rli[r] = __builtin_amdgcn_rcpf(li_l[crow(r, hi)]);
  bf16_t* Ow = Ob + (long)(wid * QBLK) * LDO;
#pragma unroll
  for (int r = 0; r < 16; ++r) { const int orow = crow(r, hi);
#pragma unroll
    for (int d0 = 0; d0 < 4; ++d0) Ow[(long)orow * LDO + d0 * 32 + r32] = f2bf(o[d0][r] * rli[r]); }
  __syncthreads();
#undef SLOAD
#undef SWRITE
#undef SWAIT
#undef RESC
}
DI void qkt2(f32x16& p0, f32x16& p1, const char* Ks, const char* KRs, const char* QRs, const bf16x8* qr, int r32, int hi) {
  p0 = f32x16{}; p1 = f32x16{};
#pragma unroll
  for (int d0 = 0; d0 < 8; ++d0) { const int cb = (d0 * 16 + hi * 8) * 2;
    const bf16x8 b0 = *reinterpret_cast<const bf16x8*>(Ks + KSWZ(r32, cb));
    const bf16x8 b1 = *reinterpret_cast<const bf16x8*>(Ks + KSWZ(32 + r32, cb));
    p0 = __builtin_amdgcn_mfma_f32_32x32x16_bf16(b0, qr[d0], p0, 0, 0, 0);
    p1 = __builtin_amdgcn_mfma_f32_32x32x16_bf16(b1, qr[d0], p1, 0, 0, 0); }
#pragma unroll
  for (int d0 = 0; d0 < 4; ++d0) { const int cb = (d0 * 16 + hi * 8) * 2;
    const bf16x8 b0 = *reinterpret_cast<const bf16x8*>(KRs + KRSWZ(r32, cb));
    const bf16x8 b1 = *reinterpret_cast<const bf16x8*>(KRs + KRSWZ(32 + r32, cb));
    const bf16x8 qq = *reinterpret_cast<const bf16x8*>(QRs + KRSWZ(r32, cb));
    p0 = __builtin_amdgcn_mfma_f32_32x32x16_bf16(b0, qq, p0, 0, 0, 0);
    p1 = __builtin_amdgcn_mfma_f32_32x32x16_bf16(b1, qq, p1, 0, 0, 0); }
}
DI void attn_body2(const bf16_t* __restrict__ Qb, const bf16_t* __restrict__ Kh, const bf16_t* __restrict__ Vh, const bf16_t* __restrict__ KRh, unsigned char* __restrict__ Ob, int seq, int tpos0, char* lds) {
  const int tid = ltid(), wid = tid >> 6, lane = tid & 63, r32 = lane & 31, hi = lane >> 5;
  char* V_lds = lds; char* K_lds = lds + 2 * SHM_V; char* KR_lds = lds + 2 * SHM_V + 2 * SHM_K;
  float* ws = (float*)(lds + 2 * SHM_V + 2 * SHM_K + 2 * SHM_KR) + wid * 64; float* li_l = ws; float* al_l = ws + 32;
  float m_reg = -1e30f, l_reg = 0; f32x16 o[4] = {}; bf16x8 qr[12];
  char* QR_lds = lds + 2 * SHM_V + 2 * SHM_K + 2 * SHM_KR + NW * 64 * 4 + wid * 4096;
  const bf16_t* Qw = Qb + (long)(wid * QBLK + r32) * LDQ + hi * 8;
#pragma unroll
  for (int d0 = 0; d0 < 12; ++d0) qr[d0] = *reinterpret_cast<const bf16x8*>(Qw + d0 * 16);
  if (tpos0 >= 0) {
    const int t = tpos0 + wid * QBLK + r32;
#pragma unroll
    for (int hf = 0; hf < 2; ++hf) { const float pos = (float)(hf ? (t & 63) : (t >> 6));
#pragma unroll
      for (int j = 0; j < 8; ++j) { const float ang = pos * exp2f(-(float)(hi * 8 + j) * (13.287712379549449f / 16.f)); float sv, cv; sincosf(ang, &sv, &cv);
        const float x1 = bf2f((bf16_t)qr[8 + 2 * hf][j]), x2 = bf2f((bf16_t)qr[9 + 2 * hf][j]);
        qr[8 + 2 * hf][j] = (short)f2bf(x1 * cv - x2 * sv); qr[9 + 2 * hf][j] = (short)f2bf(x2 * cv + x1 * sv); } }
  }
#pragma unroll
  for (int d0 = 0; d0 < 4; ++d0) *(bf16x8*)(QR_lds + KRSWZ(r32, (d0 * 16 + hi * 8) * 2)) = qr[8 + d0];
  const int sr = tid >> 4, sc = (tid & 15) * 8, vst0 = v_st(sr, sc), vst1 = v_st(32 + sr, sc);
  const int krr = tid >> 3, krc = (tid & 7) * 8;
  const int vb0 = (int)(uintptr_t)V_lds + v_rd_base(lane);
  bf16x8 vs0, vs1, ks0, ks1, kr0;
#define SLOAD(k0) do { vs0 = *reinterpret_cast<const bf16x8*>(&Vh[(long)((k0) + sr) * LDK + sc]); vs1 = *reinterpret_cast<const bf16x8*>(&Vh[(long)((k0) + 32 + sr) * LDK + sc]); \
    ks0 = *reinterpret_cast<const bf16x8*>(&Kh[(long)((k0) + sr) * LDK + sc]); ks1 = *reinterpret_cast<const bf16x8*>(&Kh[(long)((k0) + 32 + sr) * LDK + sc]); \
    kr0 = *reinterpret_cast<const bf16x8*>(&KRh[(long)((k0) + krr) * LDKR + krc]); } while (0)
#define SWRITE(b) do { *(bf16x8*)(V_lds + (b) * SHM_V + vst0) = vs0; *(bf16x8*)(V_lds + (b) * SHM_V + vst1) = vs1; const int kc = sc * 2;               \
    *(bf16x8*)(K_lds + (b) * SHM_K + KSWZ(sr, kc)) = ks0; *(bf16x8*)(K_lds + (b) * SHM_K + KSWZ(32 + sr, kc)) = ks1;                       \
    *(bf16x8*)(KR_lds + (b) * SHM_KR + KRSWZ(krr, krc * 2)) = kr0; } while (0)
#define SWAIT() asm volatile("s_waitcnt vmcnt(0)" ::: "memory")
#define RESC(a) do { if (__any((a) < 1.f)) { if (hi == 0) al_l[r32] = (a); asm volatile("s_waitcnt lgkmcnt(0)" ::: "memory"); \
    _Pragma("unroll") for (int d = 0; d < 4; ++d) _Pragma("unroll") for (int r = 0; r < 16; ++r) o[d][r] *= al_l[crow(r, hi)]; } } while (0)
  f32x16 pA0, pA1, pB0, pB1; float mnA, mnB, alA, alB; bf16x8 pa0, pa1, pa2, pa3; const int NT = seq / KVBLK;
  SLOAD(0); SWAIT(); SWRITE(0); __syncthreads();
  qkt2(pA0, pA1, K_lds, KR_lds, QR_lds, qr, r32, hi); partialSM(pA0, pA1, m_reg, mnA, alA);
  SLOAD(KVBLK);
  SWAIT(); SWRITE(1); __syncthreads();
  for (int j = 1; j + 1 < NT; j += 2) {
    SBAR(); qkt2(pB0, pB1, K_lds + SHM_K, KR_lds + SHM_KR, QR_lds, qr, r32, hi);
    finishSM(pA0, pA1, alA, l_reg, pa0, pa1, pa2, pa3); SBAR();
    SLOAD((j + 1) * KVBLK); SBAR();
    pv_d0(o, vb0, pa0, pa1, pa2, pa3); partialSM(pB0, pB1, m_reg, mnB, alB);
    __syncthreads(); SWAIT(); SWRITE(0);
    RESC(alB); __syncthreads();
    SBAR(); qkt2(pA0, pA1, K_lds, KR_lds, QR_lds, qr, r32, hi);
    finishSM(pB0, pB1, alB, l_reg, pa0, pa1, pa2, pa3); SBAR();
    SLOAD((j + 2) * KVBLK); SBAR();
    pv_d0(o, vb0 + SHM_V, pa0, pa1, pa2, pa3); partialSM(pA0, pA1, m_reg, mnA, alA);
    __syncthreads(); SWAIT(); SWRITE(1);
    RESC(alA); __syncthreads();
  }
  SBAR(); qkt2(pB0, pB1, K_lds + SHM_K, KR_lds + SHM_KR, QR_lds, qr, r32, hi);
  finishSM(pA0, pA1, alA, l_reg, pa0, pa1, pa2, pa3); SBAR();
  pv_d0(o, vb0, pa0, pa1, pa2, pa3); partialSM(pB0, pB1, m_reg, mnB, alB);
  __syncthreads(); RESC(alB);
  finishSM(pB0, pB1, alB, l_reg, pa0, pa1, pa2, pa3); SBAR();
  pv_d0(o, vb0 + SHM_V, pa0, pa1, pa2, pa3);
  if (hi == 0) li_l[r32] = l_reg; asm volatile("s_waitcnt lgkmcnt(0)" ::: "memory");
  float rli[16];
#pragma unroll
  for (int r = 0; r < 16; ++r) rli[r] = __builtin_amdgcn_rcpf(li_l[crow(r, hi)]);
  unsigned char* Ow = Ob + (long)(wid * QBLK) * LDO;
#pragma unroll
  for (int r = 0; r < 16; ++r) { const int orow = crow(r, hi);
#pragma unroll
    for (int d0 = 0; d0 < 4; d0 += 2) { const int pk = __builtin_amdgcn_cvt_pk_fp8_f32(y8c(o[d0][r] * rli[r]), y8c(o[d0 + 1][r] * rli[r]), 0, false); Ow[(long)orow * LDO + d0 * 32 + r32] = (unsigned char)pk; Ow[(long)orow * LDO + (d0 + 1) * 32 + r32] = (unsigned char)(pk >> 8); } }
  __syncthreads();
#undef SLOAD
#undef SWRITE
#undef SWAIT
#undef RESC
}
}

DI void st_attn(const Prm& p, int layer, char* lds, int bid, int nb) {
  const int nlat = NB * 4 * 16, nitem = nlat + (layer == 0 ? NB * 4 : 0);
  for (int it = bid; it < nitem; it += nb) {
    if (it < nlat) { const int b = it >> 6, h = (it >> 4) & 3, qb = it & 15; const size_t r0 = (size_t)b * LT;
      att::attn_body2(p.Qraw + (r0 + qb * 256) * 768 + h * 192, p.KV + r0 * 1024 + h * 256, p.KV + r0 * 1024 + h * 256 + 128, p.KR + r0 * 64,
                     (unsigned char*)p.Y + (r0 + qb * 256) * DM + 1024 + h * 128, LT, qb * 256, lds); }
    else { const int k = it - nlat, b = k >> 2, h = k & 3; const size_t r0 = (size_t)b * LT + LL;
      att::attn_body2(p.Qraw + r0 * 768 + h * 192, p.KV + r0 * 1024 + h * 256, p.KV + r0 * 1024 + h * 256 + 128, p.KR + r0 * 64, (unsigned char*)p.Y + r0 * DM + 1024 + h * 128, LCX, -1, lds); }
  }
}

struct EpiResid {
  static constexpr bool PERM = false, AFTER_DRAIN = false;
  const float* xlat; const float* xctx; bf16_t* X; const float* modl; int first;
  __device__ __forceinline__ void operator()(const pg8::f32x4 (&acc)[2][2][4][2], const pg8::Unit& u, int wr, int wc, int fr, int fq) const {
    const int b = u.pm / 17, tl = u.pm - b * 17; const bool isc = tl == 16;
    const float* g = modl + (size_t)(isc ? 8 : b) * NMOD + 2 * DM;
    const int rloc0 = wr * 64 + fr, col0 = u.pn * 256 + wc * 32 + 4 * fq;
    pg8::f32x4 gv[2][2];
#pragma unroll
    for (int bj = 0; bj < 2; ++bj)
#pragma unroll
      for (int n = 0; n < 2; ++n) gv[bj][n] = *(const pg8::f32x4*)(g + col0 + bj * 128 + n * 16);
#pragma unroll
    for (int ai = 0; ai < 2; ++ai)
#pragma unroll
      for (int m = 0; m < 4; ++m) { const int rl = rloc0 + ai * 128 + m * 16; const size_t row = (size_t)u.pm * 256 + rl;
        const float* src = isc ? xctx + ((size_t)b * LCX + rl) * DM : xlat + ((size_t)b * LL + tl * 256 + rl) * DM;
        bf16_t* dst = X + row * DM;
#pragma unroll
        for (int bj = 0; bj < 2; ++bj)
#pragma unroll
          for (int n = 0; n < 2; ++n) { const int c = col0 + bj * 128 + n * 16; pg8::f32x4 xo;
            if (first) xo = *(const pg8::f32x4*)(src + c);
            else { const u32x2 w = *(const u32x2*)(dst + c); xo = (pg8::f32x4){__uint_as_float(w.x << 16), __uint_as_float(w.x & 0xffff0000u), __uint_as_float(w.y << 16), __uint_as_float(w.y & 0xffff0000u)}; }
            const pg8::f32x4 o = xo + gv[bj][n] * acc[ai][bj][m][n]; u32x2 ow; ow.x = pack2(o[0], o[1]); ow.y = pack2(o[2], o[3]); *(u32x2*)(dst + c) = ow; } }
  }
};

struct EpiF8 {
  static constexpr bool PERM = true, AFTER_DRAIN = false;
  unsigned char* O; int ldc; int split_cols; size_t split_stride;
  __device__ __forceinline__ void operator()(const pg8::f32x4 (&acc)[2][2][4][2], const pg8::Unit& u, int wr, int wc, int fr, int fq) const {
    const int row0 = u.pm * 256 + wr * 64 + fr; int colt = u.pn * 256; unsigned char* base = O;
    if (split_cols) { const int t = colt / split_cols; base += (size_t)t * split_stride; colt -= t * split_cols; }
    const int col0 = colt + wc * 32 + 8 * fq;
#pragma unroll
    for (int ai = 0; ai < 2; ++ai)
#pragma unroll
      for (int m = 0; m < 4; ++m) { unsigned char* rowp = base + (size_t)(row0 + ai * 128 + m * 16) * ldc + col0;
#pragma unroll
        for (int bj = 0; bj < 2; ++bj) { const pg8::f32x4 a0 = acc[ai][bj][m][0], a1 = acc[ai][bj][m][1]; u32x2 w; w.x = pk4_fp8(y8c(a0[0]), y8c(a0[1]), y8c(a0[2]), y8c(a0[3])); w.y = pk4_fp8(y8c(a1[0]), y8c(a1[1]), y8c(a1[2]), y8c(a1[3]));
          *(u32x2*)(rowp + bj * 128) = w; } }
  }
};

struct LatentOrder : pg8::StaticOrder {
  __device__ bool next(int i, pg8::Unit& u) const { const bool ok = pg8::StaticOrder::next(i, u); u.pm += u.pm >> 4; return ok; }
};
template <class Epi> DI void run_gemm_lat(unsigned char* lds, const bf16_t* A, const bf16_t* Bt, int N, int K, const Epi& E, int bid, int nb) {
  pg8::Gemm g; g.A = A; g.Bt = Bt; g.M = NB * LL; g.N = N; g.K = K;
  LatentOrder S; S.init(NB * LL, N, nb, bid);
  pg8::gemm_phase<Epi, LatentOrder, false>((PG8_LAS unsigned char*)lds, g, S, E, nullptr);
}
template <class Epi> DI void run_gemm_f8(unsigned char* lds, const void* A8, const void* Bt8, int M, int N, int Kbytes, const Epi& E, int bid, int nb, const int ascale = pg8::W8_SCALE) {
  pg8::Gemm g; g.A = (const bf16_t*)A8; g.Bt = (const bf16_t*)Bt8; g.M = M; g.N = N; g.K = Kbytes / 2;
  pg8::StaticOrder S; S.init(M, N, nb, bid);
  pg8::gemm_phase_f8<Epi, pg8::StaticOrder, false>((PG8_LAS unsigned char*)lds, g, S, E, nullptr, ascale);
}
template <class Epi> DI void run_gemm_f8_lat(unsigned char* lds, const void* A8, const void* Bt8, int N, int Kbytes, const Epi& E, int bid, int nb, const int ascale = pg8::W8_SCALE) {
  pg8::Gemm g; g.A = (const bf16_t*)A8; g.Bt = (const bf16_t*)Bt8; g.M = NB * LL; g.N = N; g.K = Kbytes / 2;
  LatentOrder S; S.init(NB * LL, N, nb, bid);
  pg8::gemm_phase_f8<Epi, LatentOrder, false>((PG8_LAS unsigned char*)lds, g, S, E, nullptr, ascale);
}
template <class Epi> DI void run_gemm(unsigned char* lds, const bf16_t* A, const bf16_t* Bt, int M, int N, int K, const Epi& E, int bid, int nb) {
  pg8::Gemm g; g.A = A; g.Bt = Bt; g.M = M; g.N = N; g.K = K;
  pg8::StaticOrder S; S.init(M, N, nb, bid);
  pg8::gemm_phase<Epi, pg8::StaticOrder, false>((PG8_LAS unsigned char*)lds, g, S, E, nullptr);
}
DI pg8::EpiBf16<0> epi_bf16(bf16_t* O, int ldc, int split_cols = 0, size_t split_stride = 0) { pg8::EpiBf16<0> e; e.O = O; e.ldc = ldc; e.bias = nullptr; e.split_cols = split_cols; e.split_stride = split_stride; return e; }

#ifndef PROBE
#define PROBE 0
#endif
constexpr int LDS_MAIN = 131072 + 4096, LDS_TOTAL = LDS_MAIN + 64;
#define PRM() (*(const __attribute__((address_space(4))) Prm*)launder_k(kp))
typedef const __attribute__((address_space(4))) void* kptr_t;
DI kptr_t launder_k(kptr_t q) { asm volatile("" : "+s"(q)); return q; }
extern __shared__ __attribute__((aligned(16))) unsigned char shm[];
#define bid lsg(bid0)
#define nb lsg(nb0)
#define GRID_BAR() do { XcdBarrier b_; b_.bar = PRM().bar; b_.x = xb_xcc_id(); b_.st = (volatile LAS unsigned*)(shm + LDS_MAIN); xcd_barrier(b_); } while (0)
template <int l> DI void layer_body(kptr_t kp, const int bid0, const int nb0) {
#if defined(__HIP_DEVICE_COMPILE__)
    if (l == 0) { { const Prm p = PRM(); st_modulate(p, l, 0, p.H, bid, nb); } GRID_BAR(); }
    { const Prm p = PRM(); run_gemm_f8(shm, p.H, (const unsigned char*)p.WinT + (size_t)l * NZ * DM, MR, NZ, DM, epi_bf16(p.Z, NZ), bid, nb); }
    if (PROBE == 46) { const Prm p = PRM(); run_gemm_f8(shm, p.H, (const unsigned char*)p.WinT + (size_t)l * NZ * DM, MR, NZ, DM, epi_bf16(p.Z, NZ), bid, nb); }
    GRID_BAR();
    { const Prm p = PRM(); st_dnprep(p, l, bid, nb); }
    { const Prm p = PRM(); st_mlaprep(p, l, bid, nb); }
    { const Prm p = PRM(); st_fnchan(p, shm, bid, nb); }
    GRID_BAR();
    { const Prm p = PRM(); st_dntinv(p, shm, bid, nb); }
    __syncthreads();
    { const Prm p = PRM(); st_glabc(p, l, shm, bid, nb); }
    if (PROBE == 30) { GRID_BAR(); { const Prm p = PRM(); st_dnprep(p, l, bid, nb); } { const Prm p = PRM(); st_mlaprep(p, l, bid, nb); } { const Prm p = PRM(); st_fnchan(p, shm, bid, nb); } GRID_BAR();
      { const Prm p = PRM(); st_dntinv(p, shm, bid, nb); } __syncthreads(); { const Prm p = PRM(); st_glabc(p, l, shm, bid, nb); } }
    if (PROBE == 9) { { const Prm p = PRM(); st_dnprep(p, l, bid, nb); } { const Prm p = PRM(); st_mlaprep(p, l, bid, nb); } }
    if (PROBE == 10) { const Prm p = PRM(); st_fnchan(p, shm, bid, nb); }
    GRID_BAR();
    { const Prm p = PRM(); run_gemm(shm, p.Aq, p.WuqT + (size_t)l * 768 * 512, MR, 768, 512, epi_bf16(p.Qraw, 768), bid, nb); }
    { const Prm p = PRM(); run_gemm(shm, p.Akv, p.WukvT + (size_t)l * 1024 * 256, MR, 1024, 256, epi_bf16(p.KV, 1024), bid, nb); }
    if (bid < 128) { const Prm p = PRM(); st_dnscan(p, shm, bid, 128); }
    else { const Prm p = PRM(); st_glascan(p, l, shm, bid - 128, 128); }
    { const Prm p = PRM(); st_cvt_tables(p, l, bid, nb); }
    if (PROBE == 7) { GRID_BAR(); if (bid < 128) { const Prm p = PRM(); st_dnscan(p, shm, bid, 128); } }
    if (PROBE == 8) { GRID_BAR(); if (bid < 128) { const Prm p = PRM(); st_glascan(p, l, shm, bid, 128); } }
    if (PROBE == 2) { GRID_BAR(); if (bid < 128) { const Prm p = PRM(); st_dnscan(p, shm, bid, 128); } else { const Prm p = PRM(); st_glascan(p, l, shm, bid - 128, 128); } }
    GRID_BAR();
    { const Prm p = PRM(); st_attn(p, l, (char*)shm, bid, nb); }
    if (PROBE == 3) { const Prm p = PRM(); st_attn(p, l, (char*)shm, bid, nb); }
    { const Prm p = PRM(); st_fnfft(p, shm, bid, nb); }
    __syncthreads();
    if (l == 0) { const Prm p = PRM(); EpiF8 e8; e8.O = (unsigned char*)p.Y + (size_t)LL * DM + 1536; e8.ldc = DM; e8.split_cols = 512; e8.split_stride = (size_t)LT * DM; run_gemm(shm, p.DFTC, p.PQTc, 256, 4096, 512, e8, bid, nb); }
    { const Prm p = PRM(); st_combine(p, l, bid, nb); }
    if (PROBE == 43) { __syncthreads(); { const Prm p = PRM(); st_attn(p, l, (char*)shm, bid, nb); } { const Prm p = PRM(); st_fnfft(p, shm, bid, nb); } __syncthreads(); { const Prm p = PRM(); st_combine(p, l, bid, nb); } }
    GRID_BAR();
    { const Prm p = PRM(); EpiResid e; e.xlat = p.x; e.xctx = p.ctx; e.X = p.Xb; e.modl = p.mod + (size_t)l * 9 * NMOD; e.first = l == 0;
      if (l == 0) run_gemm_f8(shm, p.Y, (const unsigned char*)p.WoutT + (size_t)l * DM * DM, MR, DM, DM, e, bid, nb, 0x79797979);
      else run_gemm_f8_lat(shm, p.Y, (const unsigned char*)p.WoutT + (size_t)l * DM * DM, DM, DM, e, bid, nb, 0x79797979); }
    GRID_BAR();
    { const Prm p = PRM(); st_modulate(p, l, 1, p.H2, bid, nb); }
    if (PROBE == 42) { const Prm p = PRM(); st_modulate(p, l, 1, p.H2, bid, nb); }
    GRID_BAR();
    if (l == 0) { const Prm p = PRM(); run_gemm_f8(shm, p.H2q, (const unsigned char*)p.WqT + (size_t)l * DM * DM, MR, DM, DM, epi_bf16(p.Qp, DM), bid, nb); }
    else { const Prm p = PRM(); run_gemm_f8_lat(shm, p.H2q, (const unsigned char*)p.WqT + (size_t)l * DM * DM, DM, DM, epi_bf16(p.Qp, DM), bid, nb); }
    GRID_BAR();
    { const Prm p = PRM(); st_peer(p, l, shm, bid, nb); }
    if (l == 0) GRID_BAR();
    if (PROBE >= 50 && PROBE <= 59 && l == 0) { constexpr int md_[10] = {0, 1, 3, 7, 9, 17, 11, 41, 65, 0}; { const Prm p = PRM(); st_peer(p, l, shm, bid, nb, md_[PROBE - 50]); } GRID_BAR(); }
  #endif
}

__global__ void __launch_bounds__(NTHR, 2) mega(Prm p_unused) {
#if defined(__HIP_DEVICE_COMPILE__)
  kptr_t kp = (kptr_t)__builtin_amdgcn_kernarg_segment_ptr();
  const int bid0 = blockIdx.x, nb0 = gridDim.x;
  uint4* xbw = (uint4*)(shm + LDS_MAIN);
  if (threadIdx.x == 0) *xbw = make_uint4(0u, 0u, 0u, 0u);
  __syncthreads();
  { const Prm p = PRM(); (void)xcd_barrier_post(p.bar, (volatile LAS unsigned*)xbw); }
  float* lf = (float*)shm;
  for (int ly = 0; ly < 2; ++ly) { const Prm p = PRM();
    st_transpose8(p.w_in + (size_t)ly * DM * IN_W, (unsigned char*)p.WinT + (size_t)ly * NZ * DM, DM, IN_W, DM, NZ, 64.f, lf, bid, nb);
    st_transpose8(p.w_out + (size_t)ly * DM * DM, (unsigned char*)p.WoutT + (size_t)ly * DM * DM, DM, DM, DM, DM, 64.f, lf, bid, nb);
    st_transpose8(p.peer_wq + (size_t)ly * DM * DM, (unsigned char*)p.WqT + (size_t)ly * DM * DM, DM, DM, DM, DM, 64.f, lf, bid, nb);
    st_transpose(p.mla_w_uq + (size_t)ly * 448 * 768, p.WuqT + (size_t)ly * 768 * 512, 448, 768, 512, 768, lf, bid, nb);
    st_transpose(p.mla_w_ukv + (size_t)ly * 128 * 1024, p.WukvT + (size_t)ly * 1024 * 256, 128, 1024, 256, 1024, lf, bid, nb);
  }
  { const Prm p = PRM(); st_tables(p, bid, nb); }
  { const Prm p = PRM(); for (size_t e = (size_t)bid * NTHR + ltid(); e < (size_t)2 * 8 * 2 * 128 * 128; e += (size_t)nb * NTHR) p.KB16[e] = f2bf(p.peer_keys[e]); }
  __syncthreads();
  { const Prm p = PRM(); st_mods(p, lf, bid, nb); }
  if (PROBE == 5) { __syncthreads();
    for (int ly = 0; ly < 2; ++ly) { const Prm p = PRM();
      st_transpose8(p.w_in + (size_t)ly * DM * IN_W, (unsigned char*)p.WinT + (size_t)ly * NZ * DM, DM, IN_W, DM, NZ, 64.f, lf, bid, nb);
      st_transpose8(p.w_out + (size_t)ly * DM * DM, (unsigned char*)p.WoutT + (size_t)ly * DM * DM, DM, DM, DM, DM, 64.f, lf, bid, nb);
      st_transpose8(p.peer_wq + (size_t)ly * DM * DM, (unsigned char*)p.WqT + (size_t)ly * DM * DM, DM, DM, DM, DM, 64.f, lf, bid, nb);
      st_transpose(p.mla_w_uq + (size_t)ly * 448 * 768, p.WuqT + (size_t)ly * 768 * 512, 448, 768, 512, 768, lf, bid, nb);
      st_transpose(p.mla_w_ukv + (size_t)ly * 128 * 1024, p.WukvT + (size_t)ly * 1024 * 256, 128, 1024, 256, 1024, lf, bid, nb); }
    { const Prm p = PRM(); st_tables(p, bid, nb); }
    { const Prm p = PRM(); for (size_t e = (size_t)bid * NTHR + ltid(); e < (size_t)2 * 8 * 2 * 128 * 128; e += (size_t)nb * NTHR) p.KB16[e] = f2bf(p.peer_keys[e]); }
    __syncthreads();
    { const Prm p = PRM(); st_mods(p, lf, bid, nb); } }
  GRID_BAR();
  layer_body<0>(kp, bid0, nb0);
  layer_body<1>(kp, bid0, nb0);
  if (PROBE == 20) { GRID_BAR(); const Prm p = PRM(); if (bid == 0 && ltid() == 0 && __hip_atomic_load(p.bar + 4000, __ATOMIC_RELAXED, __HIP_MEMORY_SCOPE_AGENT) != 0u) p.out[0] = __builtin_nanf(""); }
#endif
#undef bid
#undef nb
#undef GRID_BAR
}

static size_t al256(size_t x) { return (x + 255) / 256 * 256; }
extern "C" void kernel_launch(void* const* d_in, const int* in_sizes, int n_in, void* d_out, int out_size, void* d_ws, size_t ws_size, hipStream_t stream) {
  Prm p{};
  const float** f = (const float**)&p.x;
  for (int i = 0; i < 24; ++i) f[i] = (const float*)d_in[i];
  p.out = (float*)d_out;
  char* w = (char*)d_ws; size_t o = 0;
  auto take = [&](size_t bytes) { char* r = w + o; o += al256(bytes); return r; };
  p.bar = (unsigned*)take(16384);
  p.WinT = (bf16_t*)take((size_t)2 * NZ * DM * 2); p.WoutT = (bf16_t*)take((size_t)2 * DM * DM * 2); p.WqT = (bf16_t*)take((size_t)2 * DM * DM * 2);
  p.WuqT = (bf16_t*)take((size_t)2 * 768 * 512 * 2); p.WukvT = (bf16_t*)take((size_t)2 * 1024 * 256 * 2);
  p.mod = (float*)take((size_t)2 * 9 * NMOD * 4); p.GB = (float*)take((size_t)MR * 16 * 4); p.CCS = (float*)take((size_t)2 * 128 * 128 * 4);
  p.DFTM = nullptr; p.DFTC = (bf16_t*)take((size_t)256 * 512 * 2); p.KB16 = (bf16_t*)take((size_t)2 * 8 * 2 * 128 * 128 * 2);
  p.X = nullptr; p.Xb = (bf16_t*)take((size_t)MR * DM * 2);
  p.Z = (bf16_t*)take((size_t)MR * NZ * 2);
  char* ra = take((size_t)MR * 1536 * 2 + (size_t)4 * MR * 512 * 2);
  p.DNQ = (bf16_t*)ra; p.OB = (bf16_t*)(ra + (size_t)MR * 1536 * 2); p.H = (bf16_t*)ra; p.H2q = (unsigned char*)ra + (size_t)MR * DM;
  p.KV = (bf16_t*)take((size_t)MR * 1024 * 2); p.KR = (bf16_t*)take((size_t)MR * 64 * 2);
  p.Aq = (bf16_t*)take((size_t)MR * 512 * 2); p.Akv = (bf16_t*)take((size_t)MR * 256 * 2);
  p.Ub = (bf16_t*)take((size_t)16384 * 2176); p.Vb = p.Ub;
  if (o > ws_size) return;
  char* q = (char*)d_out; size_t oo = 0;
  p.Y = (bf16_t*)q; oo += (size_t)MR * DM * 2; p.PQT = (bf16_t*)(q + oo); oo += (size_t)8 * 512 * 8192 * 2; p.PQTc = (bf16_t*)(q + oo); oo += (size_t)8 * 512 * 512 * 2;
  p.Qraw = (bf16_t*)(q + oo); oo += (size_t)MR * 768 * 2;
  p.TINV = (bf16_t*)q; p.GCB = (float*)(q + (size_t)4352 * 4096 * 2); p.BC = (float*)(q + (size_t)4352 * 4096 * 2 + (size_t)4352 * 64 * 4);
  char* z = (char*)p.Z; p.H2 = (bf16_t*)z; p.Qp = (bf16_t*)(z + (size_t)MR * DM * 2); p.IDX = (int*)(z + (size_t)2 * MR * DM * 2); p.GATE = (float*)(z + (size_t)2 * MR * DM * 2 + (size_t)MR * 128 * 4);

  static int grid = 0;
  if (!grid) {
    (void)hipFuncSetAttribute((const void*)mega, hipFuncAttributeMaxDynamicSharedMemorySize, LDS_TOTAL);
    int dev = 0, cus = 0, per_cu = 0;
    (void)hipGetDevice(&dev); (void)hipDeviceGetAttribute(&cus, hipDeviceAttributeMultiprocessorCount, dev);
    (void)hipOccupancyMaxActiveBlocksPerMultiprocessor(&per_cu, (const void*)mega, NTHR, LDS_TOTAL);
    grid = per_cu >= 1 ? cus : 0;
    if (grid > 256) grid = 256;
  }
  if (grid < 256) return;
  (void)hipMemsetAsync(p.bar, 0, 16384, stream);
  hipLaunchKernelGGL(mega, dim3(grid), dim3(NTHR), LDS_TOTAL, stream, p);
}
```

```cpp
#include <hip/hip_runtime.h>
#include <stdint.h>

constexpr int DM = 2048, NB = 8, LL = 4096, LCX = 256, LT = LL + LCX  , MR = NB * LT  ;
constexpr int NZ = 4864;
constexpr int C_DNQ = 0, C_DNK = 512, C_DNV = 1024, C_DNGATE = 1536, C_DNA = 2048, C_DNB = 2056, C_GQ = 2064, C_GK = 2320, C_GV = 2576,
              C_GGATE = 3088, C_GALPHA = 3600, C_CQ = 3632, C_CKV = 4080, C_KR = 4208, C_FN = 4272, IN_W = 4784;
constexpr int NMOD = 6 * DM;
constexpr float EPSV = 1e-6f;
constexpr int NTHR = 512;

typedef unsigned short bf16_t;
typedef short bf16x8 __attribute__((ext_vector_type(8)));
typedef short s16x4 __attribute__((ext_vector_type(4)));
typedef float f32x4 __attribute__((ext_vector_type(4)));
typedef float f32x16 __attribute__((ext_vector_type(16)));
typedef unsigned u32x4 __attribute__((ext_vector_type(4)));
typedef unsigned u32x2 __attribute__((ext_vector_type(2)));

#define DI __device__ __forceinline__
DI float bf2f(bf16_t b) { return __uint_as_float(((unsigned)b) << 16); }
DI bf16_t f2bf(float f) { unsigned u = __float_as_uint(f); u += 0x7FFFu + ((u >> 16) & 1u); return (bf16_t)(u >> 16); }
DI unsigned pack2(float lo, float hi) { return (unsigned)f2bf(lo) | ((unsigned)f2bf(hi) << 16); }
typedef float f32x2 __attribute__((ext_vector_type(2)));
DI float dpp_x1(float v) { return __int_as_float(__builtin_amdgcn_mov_dpp(__float_as_int(v), 0xB1, 0xf, 0xf, true)); }
DI float dpp_x2(float v) { return __int_as_float(__builtin_amdgcn_mov_dpp(__float_as_int(v), 0x4E, 0xf, 0xf, true)); }
DI float dpp_hm(float v) { return __int_as_float(__builtin_amdgcn_mov_dpp(__float_as_int(v), 0x141, 0xf, 0xf, true)); }
DI float dpp_rm(float v) { return __int_as_float(__builtin_amdgcn_mov_dpp(__float_as_int(v), 0x140, 0xf, 0xf, true)); }
DI float red4(float v) { v += dpp_x1(v); v += dpp_x2(v); return v; }
DI float red8(float v) { v += dpp_x1(v); v += dpp_x2(v); v += dpp_hm(v); return v; }
DI float rdl(float v, int l) { return __int_as_float(__builtin_amdgcn_readlane(__float_as_int(v), l)); }
DI float wsum(float v) { v += dpp_x1(v); v += dpp_x2(v); v += dpp_hm(v); v += dpp_rm(v); return (rdl(v, 0) + rdl(v, 16)) + (rdl(v, 32) + rdl(v, 48)); }
DI float wmax(float v) { v = fmaxf(v, dpp_x1(v)); v = fmaxf(v, dpp_x2(v)); v = fmaxf(v, dpp_hm(v)); v = fmaxf(v, dpp_rm(v)); return fmaxf(fmaxf(rdl(v, 0), rdl(v, 16)), fmaxf(rdl(v, 32), rdl(v, 48))); }
DI float siluf(float x) { return x / (1.f + __expf(-x)); }
DI float sigmf(float x) { return 1.f / (1.f + __expf(-x)); }

DI int ltid() { int t = (int)threadIdx.x; asm volatile("" : "+v"(t)); return t; }
DI int lsg(int v) { asm volatile("" : "+s"(v)); return v; }

struct Prm {
  const float *x, *c, *ctx, *c_ctx, *w_ada, *b_ada, *w_in, *dn_conv, *dn_a_log, *dn_dt_bias, *dn_norm, *gla_w2, *gla_b2, *gla_norm,
      *mla_q_norm, *mla_w_uq, *mla_kv_norm, *mla_w_ukv, *w_out, *peer_wq, *peer_keys, *peer_u, *peer_v, *final_norm;
  float* out;
  bf16_t *WinT, *WoutT, *WqT, *WuqT, *WukvT;
  float *mod, *GB, *CCS;
  bf16_t *DFTM, *DFTC;
  float* X;
  bf16_t* Z;
  bf16_t *H, *DNQ, *OB;
  bf16_t *KV, *KR;
  bf16_t *Y, *PQT, *PQTc, *Qraw, *Aq, *Akv;
  bf16_t *H2, *Qp;
  bf16_t *Ub, *Vb;
  bf16_t* TINV; float* GCB; float* BC;
  bf16_t* KB16;
  bf16_t* Xb;
  unsigned char* H2q;
  int* IDX;
  float* GATE;
  unsigned* bar;
};
#define XB_TMO      128
#define XB_XCNT(j)  (256  + 64 * (j))
#define XB_XSUB(j)  (1280 + 64 * (j))
#define XB_XGEN(j)  (2304 + 64 * (j))
#define XB_TOP      3328
#define XB_TOPGEN   3392
#define XCD_BAR_WORDS 3456
#define XB_SPIN_CAP (1u << 18)
#define LAS __attribute__((address_space(3)))

__device__ __forceinline__ unsigned xb_ld(unsigned* p)              { return __hip_atomic_load(p, __ATOMIC_RELAXED, __HIP_MEMORY_SCOPE_AGENT); }
__device__ __forceinline__ unsigned xb_add(unsigned* p, unsigned v) { return __hip_atomic_fetch_add(p, v, __ATOMIC_RELAXED, __HIP_MEMORY_SCOPE_AGENT); }
__device__ __forceinline__ unsigned xb_xcc_id() { return (unsigned)__builtin_amdgcn_s_getreg((3 << 11) | 20) & 0xFu; }
#define XB_SPIN(cond, bar) do { unsigned _sp = 0; while (cond) { __builtin_amdgcn_s_sleep(1); \
    if ((++_sp & 255u) == 0u) { if (xb_ld(&(bar)[XB_TMO])) break; if (_sp > XB_SPIN_CAP) { atomicAdd(&(bar)[XB_TMO], 1u); break; } } } } while (0)

struct XcdBarrier {
    unsigned* bar; unsigned x;
    volatile LAS unsigned* st;
};

__device__ __forceinline__ XcdBarrier xcd_barrier_post(unsigned* bar, volatile LAS unsigned* st) {
    XcdBarrier b; b.bar = bar; b.x = xb_xcc_id(); b.st = st;
    if (threadIdx.x == 0) (void)xb_add(&bar[XB_XCNT(b.x)], 1u);
    return b;
}
__device__ __forceinline__ void xcd_barrier_complete(unsigned* bar, unsigned x, unsigned& nloc, unsigned& nx) {
    const unsigned G = gridDim.x * gridDim.y * gridDim.z;
    unsigned sum, cnt, mine, sp = 0u;
    for (;;) {
        sum = 0u; cnt = 0u; mine = 0u;
#pragma unroll
        for (unsigned j = 0; j < 16; ++j) { const unsigned c = xb_ld(&bar[XB_XCNT(j)]); sum += c; cnt += (c > 0u) ? 1u : 0u; mine = (j == x) ? c : mine; }
        if (sum == G) break;
        __builtin_amdgcn_s_sleep(1);
        if ((++sp & 255u) == 0u) { if (xb_ld(&bar[XB_TMO])) break; if (sp > XB_SPIN_CAP) { atomicAdd(&bar[XB_TMO], 1u); break; } }
    }
    nloc = mine > 0u ? mine : 1u; nx = cnt > 0u ? cnt : 1u;
}

__device__ __forceinline__ void xcd_barrier(const XcdBarrier& b) {
    asm volatile("s_waitcnt vmcnt(0)" ::: "memory");
    __syncthreads();
    if (threadIdx.x == 0) {
        unsigned* bar = b.bar;
        __builtin_amdgcn_s_waitcnt(0);
        unsigned nloc = b.st[0], nx = b.st[1];
        if (nloc == 0u) { xcd_barrier_complete(bar, b.x, nloc, nx); b.st[0] = nloc; b.st[1] = nx; }
        const unsigned old = xb_add(&bar[XB_XSUB(b.x)], 1u);
        const unsigned gen = old / nloc;
        if (old + 1u == (gen + 1u) * nloc) {
            __builtin_amdgcn_fence(__ATOMIC_RELEASE, "agent");
            asm volatile("s_waitcnt vmcnt(0)" ::: "memory");
            const unsigned og = xb_add(&bar[XB_TOP], 1u);
            const unsigned tg = og / nx;
            if (og + 1u == (tg + 1u) * nx) xb_add(&bar[XB_TOPGEN], 1u);
            else XB_SPIN(xb_ld(&bar[XB_TOPGEN]) == tg, bar);
            __builtin_amdgcn_fence(__ATOMIC_ACQUIRE, "agent");
            xb_add(&bar[XB_XGEN(b.x)], 1u);
            asm volatile("s_waitcnt vmcnt(0)" ::: "memory");
        } else {
            XB_SPIN(xb_ld(&bar[XB_XGEN(b.x)]) == gen, bar);
            __builtin_amdgcn_fence(__ATOMIC_ACQUIRE, "agent");
            asm volatile("s_waitcnt vmcnt(0)" ::: "memory");
        }
    }
    __syncthreads();
}

namespace pg8 {
#define PG8_LAS __attribute__((address_space(3)))
typedef unsigned short bf16_t;
typedef short bf16x8 __attribute__((ext_vector_type(8)));
typedef float f32x4 __attribute__((ext_vector_type(4)));
typedef unsigned u32x4 __attribute__((ext_vector_type(4)));
constexpr int BM = 256, BK = 64, HALF = 128, HTB = HALF * BK * 2  , STAGE_BYTES = 8 * HTB, NXCD = 8, WGM = 8;

__host__ __device__ __forceinline__ int lds_byte(int r, int c) { const int st = (r >> 4) * 2 + (c >> 5), rr = r & 15, cc = c & 31, ob = rr * 64 + cc * 2; return st * 1024 + (ob ^ (((ob >> 9) & 1) << 5)); }
__host__ __device__ __forceinline__ void stage_rc(int b, int& R, int& C) { const int st = b / 1024, sb = b % 1024, swz = sb ^ (((sb >> 9) & 1) << 5); R = (st >> 1) * 16 + swz / 64; C = (st & 1) * 32 + (swz % 64) / 2; }
__host__ __device__ __forceinline__ int perm32(int rho) { const int n = rho >> 4, i = rho & 15; return 8 * (i >> 2) + 4 * n + (i & 3); }

struct Unit { int pm, pn; };
struct Gemm { const bf16_t* A; const bf16_t* Bt; int M, N, K; };

struct StaticOrder {
    int nM, nN, nwg, G, c;
    __host__ __device__ void init(int M, int N, int G_, int c_) { nM = M / BM; nN = N / BM; nwg = nM * nN; G = G_; c = c_; }
    __host__ __device__ bool next(int i, Unit& u) const {
        const long L = (long)i * G + c; if (L >= nwg) return false;
        int wgid = (int)L; { const int q = nwg / NXCD, r = nwg % NXCD, xcd = wgid % NXCD, off = wgid / NXCD; wgid = (xcd < r ? xcd * (q + 1) : r * (q + 1) + (xcd - r) * q) + off; }
        const int nig = WGM * nN, gid = wgid / nig, fm = gid * WGM, gsz = (nM - fm) < WGM ? (nM - fm) : WGM;
        u.pm = fm + ((wgid % nig) % gsz); u.pn = (wgid % nig) / gsz; return true;
    }
    __device__ __forceinline__ void a_ready(const Unit&) const {}
    __device__ __forceinline__ void done(const Unit&) const {}
};
struct CountedOrder : StaticOrder {
    const unsigned* ready; unsigned need; unsigned* tmo;
    __device__ __forceinline__ void a_ready(const Unit& u) const {
        if (threadIdx.x < 64) {
            const unsigned long long t0 = __builtin_amdgcn_s_memrealtime(); unsigned polls = 0;
            while ((unsigned)__builtin_amdgcn_readfirstlane(__hip_atomic_load(ready + 64 * u.pm, __ATOMIC_RELAXED, __HIP_MEMORY_SCOPE_AGENT)) < need) {
                if ((++polls & 255u) == 0u && __builtin_amdgcn_readfirstlane(__hip_atomic_load(tmo, __ATOMIC_RELAXED, __HIP_MEMORY_SCOPE_AGENT)) != 0u) break;
                if (__builtin_amdgcn_s_memrealtime() - t0 > 2000000ull) {
                    if (threadIdx.x == 0) { unsigned expect = 0u; __hip_atomic_compare_exchange_strong(tmo + 1, &expect, 0x600u | (unsigned)(u.pm & 0xff), __ATOMIC_RELAXED, __ATOMIC_RELAXED, __HIP_MEMORY_SCOPE_AGENT); __hip_atomic_store(tmo, 1u, __ATOMIC_RELAXED, __HIP_MEMORY_SCOPE_AGENT); }
                    break; }
                __builtin_amdgcn_s_sleep(2); }
            __builtin_amdgcn_fence(__ATOMIC_ACQUIRE, "agent");
            asm volatile("s_waitcnt vmcnt(0)" ::: "memory");
        }
#if !defined(BROKEN_HOOK_NO_BARRIER)
        asm volatile("" ::: "memory"); __builtin_amdgcn_s_barrier(); asm volatile("" ::: "memory");
#endif
    }
};

__device__ __forceinline__ unsigned cvt_pk_bf16(float lo, float hi) { unsigned r; asm volatile("v_cvt_pk_bf16_f32 %0, %1, %2" : "=v"(r) : "v"(lo), "v"(hi)); return r; }
typedef float f32x2 __attribute__((ext_vector_type(2)));
__device__ __forceinline__ f32x2 gelu_pk(f32x2 v) {
    const f32x2 av = __builtin_elementwise_abs(v), d = av * 0.2316418882f + 1.0f;
    f32x2 t; t.x = __builtin_amdgcn_rcpf(d.x); t.y = __builtin_amdgcn_rcpf(d.y);
    f32x2 q = t * 0.5307027145f + (-0.7265760135f); q = q * t + 0.7107068705f; q = q * t + (-0.142248368f); q = q * t + 0.127414796f; q = q * t;
    const f32x2 s = (v * v) * (-0.72134752044f);
    f32x2 e; e.x = __builtin_amdgcn_exp2f(s.x); e.y = __builtin_amdgcn_exp2f(s.y);
    const f32x2 m = v * (q * e), r = v - m;
    f32x2 o; o.x = v.x < 0.f ? m.x : r.x; o.y = v.y < 0.f ? m.y : r.y; return o;
}

struct EpiF32 {
    static constexpr bool PERM = false, AFTER_DRAIN = false;
    float* C; int ldc; const float* bias;
    __device__ __forceinline__ void operator()(const f32x4 (&acc)[2][2][4][2], const Unit& u, int wr, int wc, int fr, int fq) const {
        const int row0 = u.pm * BM + wr * 64 + fr, col0 = u.pn * BM + wc * 32 + 4 * fq;
        f32x4 bv[2][2];
#pragma unroll
        for (int bj = 0; bj < 2; ++bj)
#pragma unroll
            for (int n = 0; n < 2; ++n) bv[bj][n] = bias ? *(const f32x4*)(bias + col0 + bj * HALF + n * 16) : (f32x4){0.f, 0.f, 0.f, 0.f};
#pragma unroll
        for (int ai = 0; ai < 2; ++ai)
#pragma unroll
            for (int m = 0; m < 4; ++m) { float* rowp = C + (size_t)(row0 + ai * HALF + m * 16) * ldc + col0;
#pragma unroll
                for (int bj = 0; bj < 2; ++bj)
#pragma unroll
                    for (int n = 0; n < 2; ++n) *(f32x4*)(rowp + bj * HALF + n * 16) = acc[ai][bj][m][n] + bv[bj][n]; }
    }
};
template <int ACT  > struct EpiBf16 {
    static constexpr bool PERM = true, AFTER_DRAIN = false;
    bf16_t* O; int ldc; const float* bias; int split_cols; size_t split_stride;
    __device__ __forceinline__ void operator()(const f32x4 (&acc)[2][2][4][2], const Unit& u, int wr, int wc, int fr, int fq) const {
        const int row0 = u.pm * BM + wr * 64 + fr; int colt = u.pn * BM; bf16_t* base = O;
        if (split_cols) { const int t = colt / split_cols; base += (size_t)t * split_stride; colt -= t * split_cols; }
        const int col0 = colt + wc * 32 + 8 * fq, bcol0 = u.pn * BM + wc * 32 + 8 * fq;
        f32x4 bv[2][2];
#pragma unroll
        for (int bj = 0; bj < 2; ++bj)
#pragma unroll
            for (int n = 0; n < 2; ++n) bv[bj][n] = bias ? *(const f32x4*)(bias + bcol0 + bj * HALF + 4 * n) : (f32x4){0.f, 0.f, 0.f, 0.f};
#pragma unroll
        for (int ai = 0; ai < 2; ++ai)
#pragma unroll
            for (int m = 0; m < 4; ++m) { bf16_t* rowp = base + (size_t)(row0 + ai * HALF + m * 16) * ldc + col0;
#pragma unroll
                for (int bj = 0; bj < 2; ++bj) { f32x4 v0 = acc[ai][bj][m][0] + bv[bj][0], v1 = acc[ai][bj][m][1] + bv[bj][1];
                    if (ACT == 1) { f32x2 a = gelu_pk((f32x2){v0[0], v0[1]}), b = gelu_pk((f32x2){v0[2], v0[3]}), c = gelu_pk((f32x2){v1[0], v1[1]}), d = gelu_pk((f32x2){v1[2], v1[3]});
                        v0 = (f32x4){a.x, a.y, b.x, b.y}; v1 = (f32x4){c.x, c.y, d.x, d.y}; }
                    if (ACT == 2) {
#pragma unroll
                        for (int j = 0; j < 4; ++j) { v0[j] = 0.5f * v0[j] * (1.0f + erff(v0[j] * 0.70710678f)); v1[j] = 0.5f * v1[j] * (1.0f + erff(v1[j] * 0.70710678f)); } }
                    u32x4 w; w.x = cvt_pk_bf16(v0[0], v0[1]); w.y = cvt_pk_bf16(v0[2], v0[3]); w.z = cvt_pk_bf16(v1[0], v1[1]); w.w = cvt_pk_bf16(v1[2], v1[3]);
                    *(u32x4*)(rowp + bj * HALF) = w; } }
    }
};
template <class Epi, class Sched, bool STAMP = false>
__device__ __forceinline__ void gemm_phase(PG8_LAS unsigned char* lds, const Gemm g, const Sched& S, const Epi& E, unsigned long long* stamps) {
    const int tid = ltid(), wid = __builtin_amdgcn_readfirstlane(tid >> 6), lane = tid & 63, wr = wid >> 2, wc = wid & 3, fr = lane & 15, fq = lane >> 4;
    const int K = g.K, nt = K / BK;
    int ts_lo = 0, ts_hi = 0, nts = 0; const unsigned long long rt_entry = STAMP ? (unsigned long long)wall_clock64() : 0ull;
#define PG8_STAMP() do { if (STAMP && wid == 0 && nts < 64) { const unsigned long long _c = (unsigned long long)clock64(); \
        ts_lo = (lane == nts) ? (int)(unsigned)_c : ts_lo; ts_hi = (lane == nts) ? (int)(unsigned)(_c >> 32) : ts_hi; ++nts; } } while (0)
    PG8_STAMP();
    unsigned voffA[2], voffB[2];
#pragma unroll
    for (int i = 0; i < 2; ++i) { int R, C; stage_rc(tid * 16 + i * 8192, R, C); const int Rb = Epi::PERM ? ((R & ~31) + perm32(R & 31)) : R;
        voffA[i] = (unsigned)(R * K + C) * 2u; voffB[i] = (unsigned)(Rb * K + C) * 2u; }
    const size_t kstep = (size_t)(BK * 2);
    const size_t hstep = (size_t)HALF * K * 2;
    const size_t tstep = 2 * hstep;
    const unsigned ldsw = (unsigned)wid * 1024u;
    const int aoff = lds_byte(wr * 64 + fr, fq * 8), boff = lds_byte(wc * 32 + fr, fq * 8);
#define PG8_SA(b, h) (((b) * 2 + (h)) * HTB)
#define PG8_SB(b, h) ((4 + (b) * 2 + (h)) * HTB)
#define PG8_STAGE(bufoff, gbase, voff) do { _Pragma("unroll") for (int _i = 0; _i < 2; ++_i) \
        __builtin_amdgcn_global_load_lds((const unsigned*)((const char*)(gbase) + (voff)[_i]), (PG8_LAS unsigned*)(lds + (bufoff) + ldsw + _i * 8192), 16, 0, 0); } while (0)
#define PG8_LDA(dst, b, h) do { _Pragma("unroll") for (int m = 0; m < 4; ++m) _Pragma("unroll") for (int k = 0; k < 2; ++k) dst[m][k] = *(const PG8_LAS bf16x8*)(lds + PG8_SA(b, h) + aoff + m * 2048 + k * 1024); } while (0)
#define PG8_LDB(dst, b, h) do { _Pragma("unroll") for (int n = 0; n < 2; ++n) _Pragma("unroll") for (int k = 0; k < 2; ++k) dst[n][k] = *(const PG8_LAS bf16x8*)(lds + PG8_SB(b, h) + boff + n * 2048 + k * 1024); } while (0)
#define PG8_MMA(ai, bj, At, Bt) do { __builtin_amdgcn_s_setprio(1); _Pragma("unroll") for (int m = 0; m < 4; ++m) _Pragma("unroll") for (int n = 0; n < 2; ++n) _Pragma("unroll") for (int k = 0; k < 2; ++k) \
        acc[ai][bj][m][n] = __builtin_amdgcn_mfma_f32_16x16x32_bf16(Bt[n][k], At[m][k], acc[ai][bj][m][n], 0, 0, 0); __builtin_amdgcn_s_setprio(0); } while (0)
#define PG8_WAIT_V(n) asm volatile("s_waitcnt vmcnt(" #n ")" ::: "memory")
#define PG8_WAIT_L(n) asm volatile("s_waitcnt lgkmcnt(" #n ")" ::: "memory")
#define PG8_BAR __builtin_amdgcn_s_barrier()
#define PG8_SCHED __builtin_amdgcn_sched_barrier(0)
    Unit cur, nxt; int ui = 0;
    if (!S.next(0, cur)) return;
    f32x4 acc[2][2][4][2];
#pragma unroll
    for (int a = 0; a < 2; ++a)
#pragma unroll
        for (int b = 0; b < 2; ++b)
#pragma unroll
            for (int m = 0; m < 4; ++m)
#pragma unroll
                for (int n = 0; n < 2; ++n) acc[a][b][m][n] = (f32x4){0.f, 0.f, 0.f, 0.f};
    bf16x8 At[4][2], B0[2][2], B1[2][2];
    const char* cA = (const char*)g.A + (size_t)cur.pm * tstep; const char* cB = (const char*)g.Bt + (size_t)cur.pn * tstep;
    S.a_ready(cur);
    PG8_STAGE(PG8_SB(0, 0), cB, voffB); PG8_STAGE(PG8_SA(0, 0), cA, voffA); PG8_STAGE(PG8_SB(0, 1), cB + hstep, voffB); PG8_STAGE(PG8_SA(0, 1), cA + hstep, voffA);
    if (wr == 1) PG8_BAR;
    PG8_WAIT_V(4); PG8_BAR;
    PG8_STAGE(PG8_SB(1, 0), cB + kstep, voffB); PG8_STAGE(PG8_SA(1, 0), cA + kstep, voffA); PG8_STAGE(PG8_SB(1, 1), cB + hstep + kstep, voffB);
    PG8_WAIT_V(6); PG8_BAR;
    PG8_STAMP();
    for (;;) {
        const bool has_next = S.next(ui + 1, nxt);
        const char* nA = has_next ? (const char*)g.A + (size_t)nxt.pm * tstep : cA; const char* nB = has_next ? (const char*)g.Bt + (size_t)nxt.pn * tstep : cB;
        for (int t = 0; t < nt; t += 2) {
            const bool last = (t == nt - 2);
            const char* a1 = cA + (size_t)(t + 1) * kstep;
            const char* a2 = last ? nA : cA + (size_t)(t + 2) * kstep; const char* b2 = last ? nB : cB + (size_t)(t + 2) * kstep;
            const char* a3 = a2 + kstep; const char* b3 = b2 + kstep;
            if (last && has_next) S.a_ready(nxt);
            PG8_LDB(B0, 0, 0); PG8_SCHED; PG8_LDA(At, 0, 0); PG8_STAGE(PG8_SA(1, 1), a1 + hstep, voffA);
            PG8_WAIT_L(8); PG8_BAR; PG8_WAIT_L(0); PG8_MMA(0, 0, At, B0); PG8_BAR; PG8_SCHED;
            PG8_LDB(B1, 0, 1); PG8_STAGE(PG8_SB(0, 0), b2, voffB);
            PG8_BAR; PG8_WAIT_L(0); PG8_MMA(0, 1, At, B1); PG8_BAR;
            PG8_LDA(At, 0, 1); PG8_STAGE(PG8_SA(0, 0), a2, voffA);
            PG8_BAR; PG8_WAIT_L(0); PG8_MMA(1, 0, At, B0); PG8_BAR; PG8_SCHED;
            PG8_STAGE(PG8_SB(0, 1), b2 + hstep, voffB);
            PG8_WAIT_V(6); PG8_BAR; PG8_MMA(1, 1, At, B1); PG8_BAR;
            PG8_LDB(B0, 1, 0); PG8_SCHED; PG8_LDA(At, 1, 0); PG8_STAGE(PG8_SA(0, 1), a2 + hstep, voffA);
            PG8_WAIT_L(8); PG8_BAR; PG8_WAIT_L(0); PG8_MMA(0, 0, At, B0); PG8_BAR; PG8_SCHED;
            PG8_LDB(B1, 1, 1); PG8_STAGE(PG8_SB(1, 0), b3, voffB);
            PG8_BAR; PG8_WAIT_L(0); PG8_MMA(0, 1, At, B1); PG8_BAR;
            PG8_LDA(At, 1, 1); PG8_STAGE(PG8_SA(1, 0), a3, voffA);
            PG8_BAR; PG8_WAIT_L(0); PG8_MMA(1, 0, At, B0); PG8_BAR; PG8_SCHED;
            PG8_STAGE(PG8_SB(1, 1), b3 + hstep, voffB);
            PG8_WAIT_V(6); PG8_BAR; PG8_MMA(1, 1, At, B1); PG8_BAR;
        }
        PG8_STAMP();
        if constexpr (!Epi::AFTER_DRAIN) { E(acc, cur, wr, wc, fr, fq); S.done(cur); }
        PG8_STAMP();
        if (!has_next) break;
#pragma unroll
        for (int a = 0; a < 2; ++a)
#pragma unroll
            for (int b = 0; b < 2; ++b)
#pragma unroll
                for (int m = 0; m < 4; ++m)
#pragma unroll
                    for (int n = 0; n < 2; ++n) acc[a][b][m][n] = (f32x4){0.f, 0.f, 0.f, 0.f};
        cur = nxt; cA = nA; cB = nB; ++ui;
    }
    PG8_WAIT_V(0);
    if (wr == 0) PG8_BAR;
    PG8_BAR;
    if constexpr (Epi::AFTER_DRAIN) { E.fused(acc, cur, wr, wc, fr, fq, lds, wid, lane); S.done(cur); }
    PG8_STAMP();
    if (STAMP && wid == 0) { stamps[lane] = lane < nts ? (((unsigned long long)(unsigned)ts_hi << 32) | (unsigned)ts_lo) : 0ull;
        if (lane == 62) stamps[62] = rt_entry; if (lane == 63) stamps[63] = (unsigned long long)wall_clock64(); }
#undef PG8_STAMP
#undef PG8_SA
#undef PG8_SB
#undef PG8_STAGE
#undef PG8_LDA
#undef PG8_LDB
#undef PG8_MMA
#undef PG8_WAIT_V
#undef PG8_WAIT_L
#undef PG8_BAR
#undef PG8_SCHED
}
}
namespace pg8 {
typedef int v8i_t __attribute__((ext_vector_type(8)));
typedef int v4i_t __attribute__((ext_vector_type(4)));
constexpr int W8_SCALE = 0x7c7c7c7c;
__device__ __forceinline__ v8i_t cat16(bf16x8 a, bf16x8 b) { const v4i_t x = __builtin_bit_cast(v4i_t, a), y = __builtin_bit_cast(v4i_t, b); return (v8i_t){x[0], x[1], x[2], x[3], y[0], y[1], y[2], y[3]}; }
template <class Epi, class Sched, bool STAMP = false>
__device__ __forceinline__ void gemm_phase_f8(PG8_LAS unsigned char* lds, const Gemm g, const Sched& S, const Epi& E, unsigned long long* stamps, const int ascale = W8_SCALE) {
    const int tid = ltid(), wid = __builtin_amdgcn_readfirstlane(tid >> 6), lane = tid & 63, wr = wid >> 2, wc = wid & 3, fr = lane & 15, fq = lane >> 4;
    const int K = g.K, nt = K / BK;
    int ts_lo = 0, ts_hi = 0, nts = 0; const unsigned long long rt_entry = STAMP ? (unsigned long long)wall_clock64() : 0ull;
#define PG8_STAMP() do { if (STAMP && wid == 0 && nts < 64) { const unsigned long long _c = (unsigned long long)clock64(); \
        ts_lo = (lane == nts) ? (int)(unsigned)_c : ts_lo; ts_hi = (lane == nts) ? (int)(unsigned)(_c >> 32) : ts_hi; ++nts; } } while (0)
    PG8_STAMP();
    unsigned voffA[2], voffB[2];
#pragma unroll
    for (int i = 0; i < 2; ++i) { int R, C; stage_rc(tid * 16 + i * 8192, R, C); const int Rb = Epi::PERM ? ((R & ~31) + perm32(R & 31)) : R;
        voffA[i] = (unsigned)(R * K + C) * 2u; voffB[i] = (unsigned)(Rb * K + C) * 2u; }
    const size_t kstep = (size_t)(BK * 2);
    const size_t hstep = (size_t)HALF * K * 2;
    const size_t tstep = 2 * hstep;
    const unsigned ldsw = (unsigned)wid * 1024u;
    const int fh = fq >> 1;
    const int aoff0 = lds_byte(wr * 64 + fr, 16 * fq + 8 * fh), aoff1 = lds_byte(wr * 64 + fr, 16 * fq + 8 * (1 - fh)), boff0 = lds_byte(wc * 32 + fr, 16 * fq + 8 * fh), boff1 = lds_byte(wc * 32 + fr, 16 * fq + 8 * (1 - fh));
#define PG8_SA(b, h) (((b) * 2 + (h)) * HTB)
#define PG8_SB(b, h) ((4 + (b) * 2 + (h)) * HTB)
#define PG8_STAGE(bufoff, gbase, voff) do { _Pragma("unroll") for (int _i = 0; _i < 2; ++_i) \
        __builtin_amdgcn_global_load_lds((const unsigned*)((const char*)(gbase) + (voff)[_i]), (PG8_LAS unsigned*)(lds + (bufoff) + ldsw + _i * 8192), 16, 0, 0); } while (0)
#define PG8_LD8(a0, a1) __builtin_shufflevector(*(const PG8_LAS v4i_t*)(a0), *(const PG8_LAS v4i_t*)(a1), 0, 1, 2, 3, 4, 5, 6, 7)
#define PG8_LDA(dst, b, h) do { _Pragma("unroll") for (int m = 0; m < 4; ++m) dst[m] = PG8_LD8(lds + PG8_SA(b, h) + aoff0 + m * 2048, lds + PG8_SA(b, h) + aoff1 + m * 2048); } while (0)
#define PG8_LDB(dst, b, h) do { _Pragma("unroll") for (int n = 0; n < 2; ++n) dst[n] = PG8_LD8(lds + PG8_SB(b, h) + boff0 + n * 2048, lds + PG8_SB(b, h) + boff1 + n * 2048); } while (0)
#define PG8_MMA(ai, bj, At, Bt) do { __builtin_amdgcn_s_setprio(1); _Pragma("unroll") for (int m = 0; m < 4; ++m) _Pragma("unroll") for (int n = 0; n < 2; ++n) \
        asm volatile("v_mfma_scale_f32_16x16x128_f8f6f4 %0, %1, %2, %0, %3, %4 op_sel_hi:[0,0,0]" : "+v"(acc[ai][bj][m][n]) : "v"(Bt[n]), "v"(At[m]), "v"(w8s), "v"(a8s)); __builtin_amdgcn_s_setprio(0); } while (0)
#define PG8_WAIT_V(n) asm volatile("s_waitcnt vmcnt(" #n ")" ::: "memory")
#define PG8_WAIT_L(n) asm volatile("s_waitcnt lgkmcnt(" #n ")" ::: "memory")
#define PG8_BAR __builtin_amdgcn_s_barrier()
#define PG8_SCHED __builtin_amdgcn_sched_barrier(0)
    Unit cur, nxt; int ui = 0;
    if (!S.next(0, cur)) return;
    f32x4 acc[2][2][4][2];
#pragma unroll
    for (int a = 0; a < 2; ++a)
#pragma unroll
        for (int b = 0; b < 2; ++b)
#pragma unroll
            for (int m = 0; m < 4; ++m)
#pragma unroll
                for (int n = 0; n < 2; ++n) acc[a][b][m][n] = (f32x4){0.f, 0.f, 0.f, 0.f};
    v8i_t At[4], B0[2], B1[2]; const int w8s = W8_SCALE, a8s = ascale;
    const char* cA = (const char*)g.A + (size_t)cur.pm * tstep; const char* cB = (const char*)g.Bt + (size_t)cur.pn * tstep;
    S.a_ready(cur);
    PG8_STAGE(PG8_SB(0, 0), cB, voffB); PG8_STAGE(PG8_SA(0, 0), cA, voffA); PG8_STAGE(PG8_SB(0, 1), cB + hstep, voffB); PG8_STAGE(PG8_SA(0, 1), cA + hstep, voffA);
    if (wr == 1) PG8_BAR;
    PG8_WAIT_V(4); PG8_BAR;
    PG8_STAGE(PG8_SB(1, 0), cB + kstep, voffB); PG8_STAGE(PG8_SA(1, 0), cA + kstep, voffA); PG8_STAGE(PG8_SB(1, 1), cB + hstep + kstep, voffB);
    PG8_WAIT_V(6); PG8_BAR;
    PG8_STAMP();
    for (;;) {
        const bool has_next = S.next(ui + 1, nxt);
        const char* nA = has_next ? (const char*)g.A + (size_t)nxt.pm * tstep : cA; const char* nB = has_next ? (const char*)g.Bt + (size_t)nxt.pn * tstep : cB;
        for (int t = 0; t < nt; t += 2) {
            const bool last = (t == nt - 2);
            const char* a1 = cA + (size_t)(t + 1) * kstep;
            const char* a2 = last ? nA : cA + (size_t)(t + 2) * kstep; const char* b2 = last ? nB : cB + (size_t)(t + 2) * kstep;
            const char* a3 = a2 + kstep; const char* b3 = b2 + kstep;
            if (last && has_next) S.a_ready(nxt);
            PG8_LDB(B0, 0, 0); PG8_SCHED; PG8_LDA(At, 0, 0); PG8_STAGE(PG8_SA(1, 1), a1 + hstep, voffA);
            PG8_WAIT_L(8); PG8_BAR; PG8_WAIT_L(0); PG8_MMA(0, 0, At, B0); PG8_BAR; PG8_SCHED;
            PG8_LDB(B1, 0, 1); PG8_STAGE(PG8_SB(0, 0), b2, voffB);
            PG8_BAR; PG8_WAIT_L(0); PG8_MMA(0, 1, At, B1); PG8_BAR;
            PG8_LDA(At, 0, 1); PG8_STAGE(PG8_SA(0, 0), a2, voffA);
            PG8_BAR; PG8_WAIT_L(0); PG8_MMA(1, 0, At, B0); PG8_BAR; PG8_SCHED;
            PG8_STAGE(PG8_SB(0, 1), b2 + hstep, voffB);
            PG8_WAIT_V(6); PG8_BAR; PG8_MMA(1, 1, At, B1); PG8_BAR;
            PG8_LDB(B0, 1, 0); PG8_SCHED; PG8_LDA(At, 1, 0); PG8_STAGE(PG8_SA(0, 1), a2 + hstep, voffA);
            PG8_WAIT_L(8); PG8_BAR; PG8_WAIT_L(0); PG8_MMA(0, 0, At, B0); PG8_BAR; PG8_SCHED;
            PG8_LDB(B1, 1, 1); PG8_STAGE(PG8_SB(1, 0), b3, voffB);
            PG8_BAR; PG8_WAIT_L(0); PG8_MMA(0, 1, At, B1); PG8_BAR;
            PG8_LDA(At, 1, 1); PG8_STAGE(PG8_SA(1, 0), a3, voffA);
            PG8_BAR; PG8_WAIT_L(0); PG8_MMA(1, 0, At, B0); PG8_BAR; PG8_SCHED;
            PG8_STAGE(PG8_SB(1, 1), b3 + hstep, voffB);
            PG8_WAIT_V(6); PG8_BAR; PG8_MMA(1, 1, At, B1); PG8_BAR;
        }
        PG8_STAMP();
        asm volatile("s_nop 15\n\ts_nop 15" ::: "memory");
        if constexpr (!Epi::AFTER_DRAIN) { E(acc, cur, wr, wc, fr, fq); S.done(cur); }
        PG8_STAMP();
        if (!has_next) break;
#pragma unroll
        for (int a = 0; a < 2; ++a)
#pragma unroll
            for (int b = 0; b < 2; ++b)
#pragma unroll
                for (int m = 0; m < 4; ++m)
#pragma unroll
                    for (int n = 0; n < 2; ++n) acc[a][b][m][n] = (f32x4){0.f, 0.f, 0.f, 0.f};
        cur = nxt; cA = nA; cB = nB; ++ui;
    }
    PG8_WAIT_V(0);
    if (wr == 0) PG8_BAR;
    PG8_BAR;
    if constexpr (Epi::AFTER_DRAIN) { E.fused(acc, cur, wr, wc, fr, fq, lds, wid, lane); S.done(cur); }
    PG8_STAMP();
    if (STAMP && wid == 0) { stamps[lane] = lane < nts ? (((unsigned long long)(unsigned)ts_hi << 32) | (unsigned)ts_lo) : 0ull;
        if (lane == 62) stamps[62] = rt_entry; if (lane == 63) stamps[63] = (unsigned long long)wall_clock64(); }
#undef PG8_STAMP
#undef PG8_SA
#undef PG8_SB
#undef PG8_STAGE
#undef PG8_LDA
#undef PG8_LD8
#undef PG8_LDB
#undef PG8_MMA
#undef PG8_WAIT_V
#undef PG8_WAIT_L
#undef PG8_BAR
#undef PG8_SCHED
}
}

DI void st_transpose(const float* __restrict__ src, bf16_t* __restrict__ dst, int K, int N, int Kpad, int Npad, float* lds, int bid, int nb) {
  const int tk = Kpad / 64, tn = Npad / 64;
  for (int it = bid; it < tk * tn; it += nb) {
    const int k0 = (it % tk) * 64, n0 = (it / tk) * 64;
    __syncthreads();
    for (int e = ltid(); e < 4096; e += NTHR) { const int i = e >> 6, j = e & 63, k = k0 + i, n = n0 + j; lds[i * 65 + j] = (k < K && n < N) ? src[(size_t)k * N + n] : 0.f; }
    __syncthreads();
    { const int e = ltid(), j = e >> 3, i8 = (e & 7) * 8; u32x4 w;
      w.x = pack2(lds[i8 * 65 + j], lds[(i8 + 1) * 65 + j]); w.y = pack2(lds[(i8 + 2) * 65 + j], lds[(i8 + 3) * 65 + j]);
      w.z = pack2(lds[(i8 + 4) * 65 + j], lds[(i8 + 5) * 65 + j]); w.w = pack2(lds[(i8 + 6) * 65 + j], lds[(i8 + 7) * 65 + j]);
      *(u32x4*)(dst + (size_t)(n0 + j) * Kpad + k0 + i8) = w; }
  }
}

constexpr float Y8S = 8.f;
DI float y8c(float y) { return __builtin_amdgcn_fmed3f(y * Y8S, -448.f, 448.f); }
DI float c8(float x) { return __builtin_amdgcn_fmed3f(x, -448.f, 448.f); }
DI unsigned pk4_fp8(float a, float b, float c, float d) { int r = 0; r = __builtin_amdgcn_cvt_pk_fp8_f32(c8(a), c8(b), r, false); r = __builtin_amdgcn_cvt_pk_fp8_f32(c8(c), c8(d), r, true); return (unsigned)r; }
DI void st_transpose8(const float* __restrict__ src, unsigned char* __restrict__ dst, int K, int N, int Kpad, int Npad, float sc, float* lds, int bid, int nb) {
  const int tk = Kpad / 64, tn = Npad / 64;
  for (int it = bid; it < tk * tn; it += nb) {
    const int k0 = (it % tk) * 64, n0 = (it / tk) * 64;
    __syncthreads();
    for (int e = ltid(); e < 4096; e += NTHR) { const int i = e >> 6, j = e & 63, k = k0 + i, n = n0 + j; lds[i * 65 + j] = (k < K && n < N) ? src[(size_t)k * N + n] * sc : 0.f; }
    __syncthreads();
    { const int e = ltid(), j = e >> 3, i8 = (e & 7) * 8; u32x2 w;
      w.x = pk4_fp8(lds[i8 * 65 + j], lds[(i8 + 1) * 65 + j], lds[(i8 + 2) * 65 + j], lds[(i8 + 3) * 65 + j]); w.y = pk4_fp8(lds[(i8 + 4) * 65 + j], lds[(i8 + 5) * 65 + j], lds[(i8 + 6) * 65 + j], lds[(i8 + 7) * 65 + j]);
      *(u32x2*)(dst + (size_t)(n0 + j) * Kpad + k0 + i8) = w; }
  }
}

DI void st_mods(const Prm& p, float* lds, int bid, int nb) {
  float* s = lds; float* red = lds + 9 * 2048;
  for (int e = ltid(); e < 9 * 2048; e += NTHR) { const int r = e >> 11, k = e & 2047; const float v = r < 8 ? p.c[r * 2048 + k] : p.c_ctx[k]; s[e] = siluf(v); }
  __syncthreads();
  const int kg = ltid() >> 6, cl = ltid() & 63;
  for (int it = bid; it < 2 * 192; it += nb) {
    const int l = it / 192, cb = (it % 192) * 64;
    const float* w = p.w_ada + (size_t)l * 2048 * NMOD + cb + cl;
    float acc[9];
#pragma unroll
    for (int r = 0; r < 9; ++r) acc[r] = 0.f;
    for (int k0 = kg * 256; k0 < kg * 256 + 256; k0 += 16) { float wv[16];
#pragma unroll
      for (int i = 0; i < 16; ++i) wv[i] = w[(size_t)(k0 + i) * NMOD];
#pragma unroll
      for (int i = 0; i < 16; ++i)
#pragma unroll
        for (int r = 0; r < 9; ++r) acc[r] += s[r * 2048 + k0 + i] * wv[i]; }
#pragma unroll
    for (int r = 0; r < 9; ++r) red[(kg * 9 + r) * 64 + cl] = acc[r];
    __syncthreads();
    for (int e = ltid(); e < 576; e += NTHR) { const int r = e >> 6, c2 = e & 63; float t = 0.f;
      for (int g = 0; g < 8; ++g) t += red[(g * 9 + r) * 64 + c2];
      p.mod[((size_t)l * 9 + r) * NMOD + cb + c2] = t + p.b_ada[l * NMOD + cb + c2]; }
    __syncthreads();
  }
}

DI void st_tables(const Prm& p, int bid, int nb) {
  const size_t stride = (size_t)nb * NTHR, t0 = (size_t)bid * NTHR + ltid();
  for (size_t e = t0; e < (size_t)256 * 512; e += stride) { const int k1 = (int)(e >> 9), n = (int)(e & 511), n1 = n & 255, idx = (k1 * n1) & 255;
    float sv, cv; sincosf((float)idx * (6.283185307179586f / 256.f), &sv, &cv); p.DFTC[e] = f2bf((n < 256 ? cv : -sv) * (1.f / 16.f)); }
  for (size_t e = t0; e < (size_t)2 * 128 * 128; e += stride) { const int tb = (int)(e >> 14), k2 = (int)((e >> 7) & 127), n2 = (int)(e & 127), idx = (k2 * n2) & 127;
    float sv, cv; sincosf((float)idx * (6.283185307179586f / 128.f), &sv, &cv); p.CCS[e] = (tb ? sv : cv) * 0.08838834764831845f; }
}

DI void st_modulate(const Prm& p, int layer, int which, bf16_t* __restrict__ dst, int bid, int nb) {
  const int wave = ltid() >> 6, lane = ltid() & 63;
  const int shoff = which ? 3 * DM : 0, scoff = which ? 4 * DM : DM;
  for (int row = bid * 8 + wave; row < MR; row += nb * 8) {
    const int b = row / LT, t = row - b * LT; const bool isc = t >= LL;
    if (isc && layer == 1 && which == 1) continue;
    const float* src = isc ? p.ctx + (size_t)(b * LCX + t - LL) * DM : p.x + (size_t)(b * LL + t) * DM;
    f32x4 v[8]; float ss = 0.f;
#pragma unroll
    for (int i = 0; i < 8; ++i) {
      if (layer == 0 && which == 0) v[i] = *(const f32x4*)(src + (i * 64 + lane) * 4);
      else { const u32x2 w = *(const u32x2*)(p.Xb + (size_t)row * DM + (i * 64 + lane) * 4); v[i] = (f32x4){__uint_as_float(w.x << 16), __uint_as_float(w.x & 0xffff0000u), __uint_as_float(w.y << 16), __uint_as_float(w.y & 0xffff0000u)}; }
      ss += v[i][0] * v[i][0] + v[i][1] * v[i][1] + v[i][2] * v[i][2] + v[i][3] * v[i][3]; }
    ss = wsum(ss); const float rstd = rsqrtf(ss * (1.f / 2048.f) + EPSV);
    const float* mr = p.mod + ((size_t)layer * 9 + (isc ? 8 : b)) * NMOD;
#pragma unroll
    for (int i = 0; i < 8; ++i) { const int col = (i * 64 + lane) * 4; const f32x4 sc = *(const f32x4*)(mr + scoff + col), sh = *(const f32x4*)(mr + shoff + col);
      const f32x4 o = v[i] * rstd * (sc + 1.f) + sh;
      if (which == 0) *(unsigned*)((unsigned char*)dst + (size_t)row * DM + col) = pk4_fp8(o[0], o[1], o[2], o[3]);
      else *(unsigned*)(p.H2q + (size_t)row * DM + col) = pk4_fp8(o[0], o[1], o[2], o[3]); }
  }
}

DI void st_dnprep(const Prm& p, int layer, int bid, int nb) {
  const int wave = ltid() >> 6, lane = ltid() & 63;
  const float* conv = p.dn_conv + (size_t)layer * 5 * 1536;
  for (int task = bid * 8 + wave; task < (MR / 32) * 13; task += nb * 8) {
    const int tile = task / 13, grp = task - tile * 13, row0 = tile * 32;
    const int b = row0 / LT, t0 = row0 - b * LT; const bool isc = t0 >= LL;
    const int segt0 = isc ? t0 - LL : t0, seglen = isc ? LCX : LL;
    if (grp < 12) {
      const int c = grp * 128 + lane * 2;
      float w0[5], w1[5];
#pragma unroll
      for (int j = 0; j < 5; ++j) { w0[j] = conv[j * 1536 + c]; w1[j] = conv[j * 1536 + c + 1]; }
      unsigned zz[36];
#pragma unroll
      for (int r = 0; r < 36; ++r) { const int tt = segt0 + r - 2; zz[r] = (tt >= 0 && tt < seglen) ? *(const unsigned*)(p.Z + (size_t)(row0 + r - 2) * NZ + c) : 0u; }
#pragma unroll
      for (int r = 0; r < 32; ++r) { float a0 = 0.f, a1 = 0.f;
#pragma unroll
        for (int j = 0; j < 5; ++j) { a0 += __uint_as_float(zz[r + j] << 16) * w0[j]; a1 += __uint_as_float(zz[r + j] & 0xffff0000u) * w1[j]; }
        a0 = siluf(a0); a1 = siluf(a1);
        if (grp < 8) { const float ss = wsum(a0 * a0 + a1 * a1); const float sc = rsqrtf(ss + EPSV) * (grp < 4 ? 0.08838834764831845f : 1.f); a0 *= sc; a1 *= sc; }
        *(unsigned*)(p.DNQ + (size_t)(row0 + r) * 1536 + c) = pack2(a0, a1); }
    } else {
#pragma unroll
      for (int rr = 0; rr < 8; ++rr) { const int idx = lane + 64 * rr, row = row0 + (idx >> 4), wh = idx & 15, isb = wh >> 3, dh = wh & 7;
        const float z = bf2f(p.Z[(size_t)row * NZ + (isb ? C_DNB : C_DNA) + dh]); float o;
        if (!isb) { const float xx = z + p.dn_dt_bias[layer * 8 + dh]; const float sp = xx > 20.f ? xx : log1pf(expf(xx)); o = -expf(p.dn_a_log[layer * 8 + dh]) * sp; }
        else o = sigmf(z);
        p.GB[(size_t)row * 16 + wh] = o; }
    }
  }
}

DI void st_mlaprep(const Prm& p, int layer, int bid, int nb) {
  const int wave = ltid() >> 6, lane = ltid() & 63;
  const float* qn = p.mla_q_norm + layer * 448; const float* kvn = p.mla_kv_norm + layer * 128;
  for (int row = bid * 8 + wave; row < MR; row += nb * 8) {
    const bf16_t* z = p.Z + (size_t)row * NZ; const int b = row / LT, t = row - b * LT;
    float v[8]; float ss = 0.f;
#pragma unroll
    for (int k = 0; k < 8; ++k) v[k] = 0.f;
    if (lane < 56) { const u32x4 w = *(const u32x4*)(z + C_CQ + lane * 8);
#pragma unroll
      for (int k = 0; k < 4; ++k) { v[2 * k] = __uint_as_float(w[k] << 16); v[2 * k + 1] = __uint_as_float(w[k] & 0xffff0000u); ss += v[2 * k] * v[2 * k] + v[2 * k + 1] * v[2 * k + 1]; } }
    ss = wsum(ss); float rstd = rsqrtf(ss * (1.f / 448.f) + EPSV);
    { u32x4 o = {0u, 0u, 0u, 0u};
      if (lane < 56) { const f32x4 n0 = *(const f32x4*)(qn + lane * 8), n1 = *(const f32x4*)(qn + lane * 8 + 4);
        o.x = pack2(v[0] * rstd * n0[0], v[1] * rstd * n0[1]); o.y = pack2(v[2] * rstd * n0[2], v[3] * rstd * n0[3]); o.z = pack2(v[4] * rstd * n1[0], v[5] * rstd * n1[1]); o.w = pack2(v[6] * rstd * n1[2], v[7] * rstd * n1[3]); }
      *(u32x4*)(p.Aq + (size_t)row * 512 + lane * 8) = o; }
    ss = 0.f;
    if (lane < 16) { const u32x4 w = *(const u32x4*)(z + C_CKV + lane * 8);
#pragma unroll
      for (int k = 0; k < 4; ++k) { v[2 * k] = __uint_as_float(w[k] << 16); v[2 * k + 1] = __uint_as_float(w[k] & 0xffff0000u); ss += v[2 * k] * v[2 * k] + v[2 * k + 1] * v[2 * k + 1]; } }
    ss = wsum(ss); rstd = rsqrtf(ss * (1.f / 128.f) + EPSV);
    if (lane < 32) { u32x4 o = {0u, 0u, 0u, 0u};
      if (lane < 16) { const f32x4 n0 = *(const f32x4*)(kvn + lane * 8), n1 = *(const f32x4*)(kvn + lane * 8 + 4);
        o.x = pack2(v[0] * rstd * n0[0], v[1] * rstd * n0[1]); o.y = pack2(v[2] * rstd * n0[2], v[3] * rstd * n0[3]); o.z = pack2(v[4] * rstd * n1[0], v[5] * rstd * n1[1]); o.w = pack2(v[6] * rstd * n1[2], v[7] * rstd * n1[3]); }
      *(u32x4*)(p.Akv + (size_t)row * 256 + lane * 8) = o; }
    if (t < LL) {
      if (lane < 32) { const int half = lane >> 4, i = lane & 15; const float x1 = bf2f(z[C_KR + half * 32 + i]), x2 = bf2f(z[C_KR + half * 32 + 16 + i]);
        const float pos = (float)(half ? (t & 63) : (t >> 6)); const float ang = pos * exp2f(-(float)i * (13.287712379549449f / 16.f)); float sv, cv; sincosf(ang, &sv, &cv);
        p.KR[(size_t)row * 64 + half * 32 + i] = f2bf(x1 * cv - x2 * sv); p.KR[(size_t)row * 64 + half * 32 + 16 + i] = f2bf(x2 * cv + x1 * sv); }
    } else p.KR[(size_t)row * 64 + lane] = z[C_KR + lane];
  }
}

DI void st_qrope(const Prm& p, int bid, int nb) {
  const int wave = ltid() >> 6, lane = ltid() & 63;
  for (int row = bid * 8 + wave; row < MR; row += nb * 8) {
    const int b = row / LT, t = row - b * LT; if (t >= LL) continue;
#pragma unroll
    for (int k = 0; k < 2; ++k) { const int pid = lane + 64 * k, h = pid >> 5, r = pid & 31, half = r >> 4, i = r & 15;
      bf16_t* q = p.Qraw + (size_t)row * 768 + h * 192 + 128 + half * 32; const float x1 = bf2f(q[i]), x2 = bf2f(q[16 + i]);
      const float pos = (float)(half ? (t & 63) : (t >> 6)); const float ang = pos * exp2f(-(float)i * (13.287712379549449f / 16.f)); float sv, cv; sincosf(ang, &sv, &cv);
      q[i] = f2bf(x1 * cv - x2 * sv); q[16 + i] = f2bf(x2 * cv + x1 * sv); }
  }
}

DI void st_fnchan(const Prm& p, unsigned char* lds, int bid, int nb) {
  bf16_t* wt = (bf16_t*)lds;
  bf16_t* zt = (bf16_t*)(lds + 256 * 272);
  const int tid = ltid(), wave = tid >> 6, lane = tid & 63, r32 = lane & 31, hi = lane >> 5;
  __syncthreads();
  for (int e = tid; e < 256 * 128; e += NTHR) wt[(e >> 7) * 136 + (e & 127)] = f2bf(p.CCS[e]);
  for (int it = bid; it < (MR / 64) * 4; it += nb) {
    const int tile = it >> 2, g = it & 3, b = tile / 68, tb2 = tile - b * 68; const bool lat = tb2 < 64;
    __syncthreads();
    for (int e = tid; e < 1024; e += NTHR) { const int r = e >> 4, c8 = (e & 15) * 8; const int row = b * LT + (lat ? 64 * r + tb2 : LL + (tb2 - 64) * 64 + r);
      *(u32x4*)(zt + r * 136 + c8) = *(const u32x4*)(p.Z + (size_t)row * NZ + C_FN + g * 128 + c8); }
    __syncthreads();
    f32x16 acc[2] = {};
#pragma unroll
    for (int k8 = 0; k8 < 8; ++k8) { const bf16x8 a = *(const bf16x8*)(wt + (wave * 32 + r32) * 136 + k8 * 16 + hi * 8);
#pragma unroll
      for (int tt = 0; tt < 2; ++tt) { const bf16x8 bb = *(const bf16x8*)(zt + (tt * 32 + r32) * 136 + k8 * 16 + hi * 8); acc[tt] = __builtin_amdgcn_mfma_f32_32x32x16_bf16(a, bb, acc[tt], 0, 0, 0); } }
    const int tb = wave >> 2;
#pragma unroll
    for (int tt = 0; tt < 2; ++tt)
#pragma unroll
      for (int r = 0; r < 16; ++r) { const int k2 = (wave & 3) * 32 + (r & 3) + 8 * (r >> 2) + 4 * hi;
        if (lat) p.PQT[(((size_t)(b * 512 + g * 128 + k2)) * 64 + tb2) * 128 + tb * 64 + tt * 32 + r32] = f2bf(acc[tt][r]);
        else p.PQTc[((size_t)(b * 512 + g * 128 + k2)) * 512 + tb * 256 + (tb2 - 64) * 64 + tt * 32 + r32] = f2bf(acc[tt][r]); }
  }
}

DI void st_fnfft(const Prm& p, unsigned char* lds, int bid, int nb) {
  bf16_t* M1 = (bf16_t*)lds;
  bf16_t* M2c = M1 + 128 * 136; bf16_t* M2s = M2c + 64 * 72;
  f32x2* TW = (f32x2*)(lds + (128 * 136 + 2 * 64 * 72) * 2);
  unsigned char* OUTB = (unsigned char*)(lds + (128 * 136 + 2 * 64 * 72) * 2 + 32768);
  const int tid = ltid(), wave = tid >> 6, lane = tid & 63, r32 = lane & 31, hi = lane >> 5;
  __syncthreads();
  for (int e = tid; e < 128 * 128; e += NTHR) { const int j = e >> 7, k = e & 127, ri = j >> 6, cc = j & 63, pq = k >> 6, a = k & 63; float sv, cv; sincosf((float)((cc * a) & 63) * (6.283185307179586f / 64.f), &sv, &cv);
    const float v = ri == 0 ? (pq == 0 ? cv : -sv) : (pq == 0 ? -sv : -cv); M1[j * 136 + k] = f2bf(v * 0.125f); }
  for (int e = tid; e < 64 * 64; e += NTHR) { const int d = e >> 6, bp = e & 63; float sv, cv; sincosf((float)((d * bp) & 63) * (6.283185307179586f / 64.f), &sv, &cv); M2c[d * 72 + bp] = f2bf(cv * 0.125f); M2s[d * 72 + bp] = f2bf(sv * 0.125f); }
  for (int e = tid; e < 4096; e += NTHR) { float sv, cv; sincosf((float)e * (6.283185307179586f / 4096.f), &sv, &cv); TW[e] = (f32x2){cv, sv}; }
  __syncthreads();
  for (int item = bid * 8 + wave; item < NB * 512; item += nb * 8) {
    const int b = item >> 9, col = item & 511;
    const bf16_t* src = p.PQT + (size_t)item * 64 * 128;
    unsigned char* yo8 = (unsigned char*)p.Y + (size_t)b * LT * DM + 1536 + (col & ~7);
#pragma unroll 1
    for (int ct = 0; ct < 2; ++ct) {
      f32x16 tr0 = {}, tr1 = {}, ti0 = {}, ti1 = {};
#pragma unroll
      for (int ks = 0; ks < 8; ++ks) { const bf16x8 a0 = *(const bf16x8*)(src + r32 * 128 + ks * 16 + hi * 8), a1 = *(const bf16x8*)(src + (32 + r32) * 128 + ks * 16 + hi * 8);
        const bf16x8 br = *(const bf16x8*)(M1 + (ct * 32 + r32) * 136 + ks * 16 + hi * 8), bi = *(const bf16x8*)(M1 + ((2 + ct) * 32 + r32) * 136 + ks * 16 + hi * 8);
        tr0 = __builtin_amdgcn_mfma_f32_32x32x16_bf16(a0, br, tr0, 0, 0, 0); tr1 = __builtin_amdgcn_mfma_f32_32x32x16_bf16(a1, br, tr1, 0, 0, 0);
        ti0 = __builtin_amdgcn_mfma_f32_32x32x16_bf16(a0, bi, ti0, 0, 0, 0); ti1 = __builtin_amdgcn_mfma_f32_32x32x16_bf16(a1, bi, ti1, 0, 0, 0); }
      __builtin_amdgcn_sched_barrier(0);
      const int cc = ct * 32 + r32;
#pragma unroll
      for (int r = 0; r < 16; ++r) { const int bl = (r & 3) + 8 * (r >> 2) + 4 * hi; const f32x2 w0 = TW[(cc * bl) & 4095], w1 = TW[(cc * (32 + bl)) & 4095];
        const float a = tr0[r], bq = ti0[r]; tr0[r] = a * w0[0] + bq * w0[1]; ti0[r] = bq * w0[0] - a * w0[1];
        const float c2 = tr1[r], d2 = ti1[r]; tr1[r] = c2 * w1[0] + d2 * w1[1]; ti1[r] = d2 * w1[0] - c2 * w1[1]; }
      __builtin_amdgcn_sched_barrier(0);
      f32x16 y0 = {}, y1 = {};
#define FFT_S2(XT, M2, BT) do { _Pragma("unroll") for (int s = 0; s < 2; ++s) { \
          u32x4 pk; pk.x = pack2(XT[8 * s], XT[8 * s + 1]); pk.y = pack2(XT[8 * s + 2], XT[8 * s + 3]); pk.z = pack2(XT[8 * s + 4], XT[8 * s + 5]); pk.w = pack2(XT[8 * s + 6], XT[8 * s + 7]); \
          const bf16x8 xs = __builtin_bit_cast(bf16x8, pk); \
          const bf16_t* ap0 = (M2) + r32 * 72 + (BT) * 32 + 16 * s + 4 * hi; const bf16_t* ap1 = ap0 + 32 * 72; \
          const s16x4 l0 = *(const s16x4*)ap0, h0 = *(const s16x4*)(ap0 + 8), l1 = *(const s16x4*)ap1, h1 = *(const s16x4*)(ap1 + 8); \
          y0 = __builtin_amdgcn_mfma_f32_32x32x16_bf16((bf16x8){l0[0], l0[1], l0[2], l0[3], h0[0], h0[1], h0[2], h0[3]}, xs, y0, 0, 0, 0); \
          y1 = __builtin_amdgcn_mfma_f32_32x32x16_bf16((bf16x8){l1[0], l1[1], l1[2], l1[3], h1[0], h1[1], h1[2], h1[3]}, xs, y1, 0, 0, 0); } } while (0)
      FFT_S2(tr0, M2c, 0); __builtin_amdgcn_sched_barrier(0); FFT_S2(tr1, M2c, 1); __builtin_amdgcn_sched_barrier(0); FFT_S2(ti0, M2s, 0); __builtin_amdgcn_sched_barrier(0); FFT_S2(ti1, M2s, 1); __builtin_amdgcn_sched_barrier(0);
#undef FFT_S2
      __syncthreads();
#pragma unroll
      for (int r = 0; r < 16; ++r) { const int dl = (r & 3) + 8 * (r >> 2) + 4 * hi; const int pk = __builtin_amdgcn_cvt_pk_fp8_f32(y8c(y0[r]), y8c(y1[r]), 0, false); OUTB[(dl * 32 + r32) * 8 + wave] = (unsigned char)pk; OUTB[((32 + dl) * 32 + r32) * 8 + wave] = (unsigned char)(pk >> 8); }
      __syncthreads();
#pragma unroll
      for (int q = 0; q < 4; ++q) { const int rr = tid + NTHR * q, d = rr >> 5, ccl = rr & 31; *(u32x2*)(yo8 + (size_t)(ct * 32 + ccl + 64 * d) * DM) = *(const u32x2*)(OUTB + rr * 8); }
    }
  }
}

DI int scan_row(int b, int dir, int s) { return s < LCX ? b * LT + LL + (dir ? LCX - 1 - s : s) : b * LT + (dir ? LL - 1 - (s - LCX) : (s - LCX)); }

DI int tsw(int row, int t) { return row * 72 + ((((t >> 3) ^ (row >> 3)) & 7) << 3) + (t & 7); }
DI void st_dntinv(const Prm& p, unsigned char* lds, int bid, int nb) {
  const int tid = ltid(), wave = tid >> 6, lane = tid & 63, r32 = lane & 31, hi = lane >> 5;
  float* Ab = (float*)lds + wave * 4096;
  float* gcb = (float*)(lds + 131072) + wave * 128; float* btb = gcb + 64;
  for (int item = bid * 8 + wave; item < 64 * 68; item += nb * 8) {
    const int chain = item / 68, n = item - chain * 68, b = chain >> 3, h = (chain >> 1) & 3, dir = chain & 1;
    const int myrow = scan_row(b, dir, n * 64 + lane);
    const float g = p.GB[(size_t)myrow * 16 + dir * 4 + h], bt = p.GB[(size_t)myrow * 16 + 8 + dir * 4 + h];
    gcb[lane] = g; btb[lane] = bt;
    bf16x8 kf[2][8];
#pragma unroll
    for (int tt = 0; tt < 2; ++tt) { const int row = scan_row(b, dir, n * 64 + tt * 32 + r32);
#pragma unroll
      for (int ks = 0; ks < 8; ++ks) kf[tt][ks] = *(const bf16x8*)(p.DNQ + (size_t)row * 1536 + 512 + h * 128 + ks * 16 + hi * 8); }
    __builtin_amdgcn_wave_barrier();
    float gc = 0.f;
    for (int e = 0; e < 64; ++e) { const float ge = gcb[e]; gc += (e <= lane) ? ge : 0.f; }
    __builtin_amdgcn_wave_barrier();
    gcb[lane] = gc; p.GCB[(size_t)item * 64 + lane] = gc;
    __builtin_amdgcn_wave_barrier();
    f32x16 a00 = {}, a10 = {}, a11 = {};
#pragma unroll
    for (int ks = 0; ks < 8; ++ks) { a00 = __builtin_amdgcn_mfma_f32_32x32x16_bf16(kf[0][ks], kf[0][ks], a00, 0, 0, 0);
      a10 = __builtin_amdgcn_mfma_f32_32x32x16_bf16(kf[1][ks], kf[0][ks], a10, 0, 0, 0); a11 = __builtin_amdgcn_mfma_f32_32x32x16_bf16(kf[1][ks], kf[1][ks], a11, 0, 0, 0); }
    { const float gce0 = gcb[r32], gce1 = gcb[32 + r32];
#pragma unroll
      for (int r = 0; r < 16; ++r) { const int cl = (r & 3) + 8 * (r >> 2) + 4 * hi; const float gc0 = gcb[cl], bt0 = btb[cl], gc1 = gcb[32 + cl], bt1 = btb[32 + cl];
        Ab[cl * 64 + r32] = (r32 < cl) ? bt0 * a00[r] * __expf(gc0 - gce0) : 0.f;
        Ab[cl * 64 + 32 + r32] = 0.f;
        Ab[(32 + cl) * 64 + r32] = bt1 * a10[r] * __expf(gc1 - gce0);
        Ab[(32 + cl) * 64 + 32 + r32] = (r32 < cl) ? bt1 * a11[r] * __expf(gc1 - gce1) : 0.f; } }
    __builtin_amdgcn_wave_barrier();
    float x[64];
    bf16_t* to = p.TINV + (size_t)item * 4096 + lane;
#pragma unroll
    for (int c = 0; c < 64; ++c) { float s = (c == lane) ? 1.f : 0.f;
#pragma unroll
      for (int e4 = 0; e4 < (c + 3) / 4; ++e4) { const f32x4 av = *(const f32x4*)(Ab + c * 64 + e4 * 4);
#pragma unroll
        for (int i = 0; i < 4; ++i) if (e4 * 4 + i < c) s -= av[i] * x[e4 * 4 + i]; }
      x[c] = s; to[c * 64] = f2bf(s); }
    __builtin_amdgcn_wave_barrier();
  }
}

DI void st_dnscan(const Prm& p, unsigned char* lds, int bid, int nb) {
  constexpr int PK = 136, PB = 72;
  bf16_t* Qs = (bf16_t*)lds; bf16_t* Ks = Qs + 64 * PK; bf16_t* SB = Ks + 64 * PK; bf16_t* KDT = SB + 64 * PK; bf16_t* TI = KDT + 128 * PB; bf16_t* RT = TI + 64 * PB; bf16_t* VNT = RT + 64 * PB;
  bf16_t* PL = VNT + 64 * PB; bf16_t* Vs = PL + 64 * PB; float* gcs = (float*)(Vs + 64 * PB); float* bts = gcs + 64; float* egs = bts + 64;
  const int tid = ltid(), wave = tid >> 6, lane = tid & 63, r32 = lane & 31, hi = lane >> 5;
  for (int item = bid; item < 128; item += nb) {
    const int chain = item >> 1, half = item & 1, b = chain >> 3, h = (chain >> 1) & 3, dir = chain & 1;
    f32x16 accS = {};
    __syncthreads();
    for (int e = tid; e < 64 * PK; e += NTHR) SB[e] = 0;
    bf16x8 pf[6]; float pgc = 0.f, pbt = 0.f;
    auto gload = [&](int n) {
      const size_t ci = (size_t)chain * 68 + n;
#pragma unroll
      for (int r = 0; r < 6; ++r) { const int e = tid + NTHR * r;
        if (e < 2048) { const int ee = e & 1023, t = ee >> 4, c8 = ee & 15; const int row = scan_row(b, dir, n * 64 + t); pf[r] = *(const bf16x8*)(p.DNQ + (size_t)row * 1536 + (e < 1024 ? 0 : 512) + h * 128 + c8 * 8); }
        else if (e < 2560) { const int ee = e - 2048, t = ee >> 3, c8 = ee & 7; const int row = scan_row(b, dir, n * 64 + t); pf[r] = *(const bf16x8*)(p.DNQ + (size_t)row * 1536 + 1024 + h * 128 + half * 64 + c8 * 8); }
        else { const int ee = e - 2560; pf[r] = *(const bf16x8*)(p.TINV + ci * 4096 + ee * 8); } }
      if (tid < 64) { pgc = p.GCB[ci * 64 + tid]; const int row = scan_row(b, dir, n * 64 + tid); pbt = p.GB[(size_t)row * 16 + 8 + dir * 4 + h]; }
    };
    gload(0);
    for (int n = 0; n < LT / 64; ++n) {
      if (tid < 64) { gcs[tid] = pgc; bts[tid] = pbt; egs[tid] = __expf(pgc); }
      __syncthreads();
      const float gl = gcs[63];
#pragma unroll
      for (int r = 0; r < 6; ++r) { const int e = tid + NTHR * r;
        if (e < 1024) { const int t = e >> 4, c8 = e & 15; *(bf16x8*)(Qs + t * PK + c8 * 8) = pf[r]; }
        else if (e < 2048) { const int ee = e - 1024, t = ee >> 4, c8 = ee & 15; *(bf16x8*)(Ks + t * PK + c8 * 8) = pf[r]; const float sc = __expf(gl - gcs[t]);
#pragma unroll
          for (int j = 0; j < 8; ++j) KDT[tsw(c8 * 8 + j, t)] = f2bf(bf2f((bf16_t)pf[r][j]) * sc); }
        else if (e < 2560) { const int ee = e - 2048, t = ee >> 3, c8 = ee & 7; *(bf16x8*)(Vs + t * PB + c8 * 8) = pf[r]; }
        else { const int ee = e - 2560, c = ee >> 3, c8 = ee & 7; *(bf16x8*)(TI + c * PB + c8 * 8) = pf[r]; } }
      if (n + 1 < LT / 64) gload(n + 1);
      __syncthreads();
      f32x16 accO = {};
      if (wave < 4) { const int et = wave >> 1, jt = wave & 1; f32x16 a1 = {};
#pragma unroll
        for (int k8 = 0; k8 < 8; ++k8) { const bf16x8 av = *(const bf16x8*)(Ks + (et * 32 + r32) * PK + k8 * 16 + hi * 8), bv = *(const bf16x8*)(SB + (jt * 32 + r32) * PK + k8 * 16 + hi * 8);
          a1 = __builtin_amdgcn_mfma_f32_32x32x16_bf16(av, bv, a1, 0, 0, 0); }
        const int j = jt * 32 + r32;
#pragma unroll
        for (int g = 0; g < 4; ++g) { const int e0 = et * 32 + 8 * g + 4 * hi; float rv[4];
#pragma unroll
          for (int i = 0; i < 4; ++i) rv[i] = bts[e0 + i] * (bf2f(Vs[(e0 + i) * PB + j]) - egs[e0 + i] * a1[4 * g + i]);
          u32x2 w; w.x = pack2(rv[0], rv[1]); w.y = pack2(rv[2], rv[3]); *(u32x2*)(RT + j * PB + e0) = w; } }
      else {
        if (wave < 7) { const int et = wave == 6 ? 1 : 0, ct = wave == 4 ? 0 : 1; f32x16 a2 = {};
#pragma unroll
          for (int k8 = 0; k8 < 8; ++k8) { const bf16x8 av = *(const bf16x8*)(Ks + (et * 32 + r32) * PK + k8 * 16 + hi * 8), bv = *(const bf16x8*)(Qs + (ct * 32 + r32) * PK + k8 * 16 + hi * 8);
            a2 = __builtin_amdgcn_mfma_f32_32x32x16_bf16(av, bv, a2, 0, 0, 0); }
          const int c = ct * 32 + r32; const float gcc = gcs[c];
#pragma unroll
          for (int g = 0; g < 4; ++g) { const int e0 = et * 32 + 8 * g + 4 * hi; float pv[4];
#pragma unroll
            for (int i = 0; i < 4; ++i) pv[i] = (e0 + i <= c) ? a2[4 * g + i] * __expf(gcc - gcs[e0 + i]) : 0.f;
            u32x2 w; w.x = pack2(pv[0], pv[1]); w.y = pack2(pv[2], pv[3]); *(u32x2*)(PL + c * PB + e0) = w; } }
        else { for (int e = lane; e < 32 * 8; e += 64) { const int c = e >> 3, q4 = (e & 7) * 4; *(u32x2*)(PL + c * PB + 32 + q4) = (u32x2){0u, 0u}; } }
        { const int ct = (wave - 4) >> 1, jt = wave & 1;
#pragma unroll
          for (int k8 = 0; k8 < 8; ++k8) { const bf16x8 av = *(const bf16x8*)(Qs + (ct * 32 + r32) * PK + k8 * 16 + hi * 8), bv = *(const bf16x8*)(SB + (jt * 32 + r32) * PK + k8 * 16 + hi * 8);
            accO = __builtin_amdgcn_mfma_f32_32x32x16_bf16(av, bv, accO, 0, 0, 0); }
#pragma unroll
          for (int r = 0; r < 16; ++r) accO[r] *= egs[ct * 32 + (r & 3) + 8 * (r >> 2) + 4 * hi]; } }
      __syncthreads();
      if (wave < 4) { const int ct = wave >> 1, jt = wave & 1; f32x16 a3 = {};
#pragma unroll
        for (int k8 = 0; k8 < 4; ++k8) { const bf16x8 av = *(const bf16x8*)(TI + (ct * 32 + r32) * PB + k8 * 16 + hi * 8), bv = *(const bf16x8*)(RT + (jt * 32 + r32) * PB + k8 * 16 + hi * 8);
          a3 = __builtin_amdgcn_mfma_f32_32x32x16_bf16(av, bv, a3, 0, 0, 0); }
#pragma unroll
        for (int g = 0; g < 4; ++g) { u32x2 w; w.x = pack2(a3[4 * g], a3[4 * g + 1]); w.y = pack2(a3[4 * g + 2], a3[4 * g + 3]); *(u32x2*)(VNT + (jt * 32 + r32) * PB + ct * 32 + 8 * g + 4 * hi) = w; } }
      __syncthreads();
      if (wave >= 4) { const int ct = (wave - 4) >> 1, jt = wave & 1;
#pragma unroll
        for (int k8 = 0; k8 < 4; ++k8) { const bf16x8 av = *(const bf16x8*)(PL + (ct * 32 + r32) * PB + k8 * 16 + hi * 8), bv = *(const bf16x8*)(VNT + (jt * 32 + r32) * PB + k8 * 16 + hi * 8);
          accO = __builtin_amdgcn_mfma_f32_32x32x16_bf16(av, bv, accO, 0, 0, 0); }
#pragma unroll
        for (int r = 0; r < 16; ++r) { const int c = ct * 32 + (r & 3) + 8 * (r >> 2) + 4 * hi; const int row = scan_row(b, dir, n * 64 + c);
          p.OB[((size_t)(0 * 2 + dir) * MR + row) * 512 + h * 128 + half * 64 + jt * 32 + r32] = f2bf(accO[r]); } }
      { const int dt = wave >> 1, jt = wave & 1; const float egl = __expf(gl);
#pragma unroll
        for (int r = 0; r < 16; ++r) accS[r] *= egl;
#pragma unroll
        for (int k8 = 0; k8 < 4; ++k8) { const bf16x8 av = *(const bf16x8*)(KDT + tsw(dt * 32 + r32, k8 * 16 + hi * 8)), bv = *(const bf16x8*)(VNT + (jt * 32 + r32) * PB + k8 * 16 + hi * 8);
          accS = __builtin_amdgcn_mfma_f32_32x32x16_bf16(av, bv, accS, 0, 0, 0); }
#pragma unroll
        for (int g = 0; g < 4; ++g) { u32x2 w; w.x = pack2(accS[4 * g], accS[4 * g + 1]); w.y = pack2(accS[4 * g + 2], accS[4 * g + 3]);
          *(u32x2*)(SB + (jt * 32 + r32) * PK + dt * 32 + 8 * g + 4 * hi) = w; } }
      __syncthreads();
    }
  }
}

DI void st_glabc(const Prm& p, int layer, unsigned char* lds, int bid, int nb) {
  float* AL = (float*)lds; float* SEG = AL + 1024;
  const int tid = ltid(), seg = tid >> 6, dme = tid & 63;
  for (int item = bid; item < 64 * 68; item += nb) {
    const int chain = item / 68, n = item - chain * 68, b = chain >> 3, h = (chain >> 1) & 3, dir = chain & 1;
    const float* w2 = p.gla_w2 + (size_t)(layer * 2 + dir) * 16 * 256 + h * 64; const float b2r = p.gla_b2[(layer * 2 + dir) * 256 + h * 64 + dme];
    float w2r[16];
#pragma unroll
    for (int r = 0; r < 16; ++r) w2r[r] = w2[r * 256 + dme];
    __syncthreads();
    if (tid < 128) { const int t = tid >> 1, c8 = tid & 1; const int row = scan_row(b, dir, n * 64 + t); const bf16x8 v = *(const bf16x8*)(p.Z + (size_t)row * NZ + C_GALPHA + dir * 16 + c8 * 8);
#pragma unroll
      for (int j = 0; j < 8; ++j) AL[t * 16 + c8 * 8 + j] = bf2f((bf16_t)v[j]); }
    __syncthreads();
    float la[8]; float run = 0.f;
#pragma unroll
    for (int k = 0; k < 8; ++k) { const int t = seg * 8 + k; float zz = b2r;
#pragma unroll
      for (int r = 0; r < 16; ++r) zz += AL[t * 16 + r] * w2r[r];
      const float nz = -zz; const float sp = nz > 20.f ? nz : log1pf(expf(nz)); run += -sp * (1.f / 16.f); la[k] = run; }
    SEG[seg * 64 + dme] = run;
    __syncthreads();
    float pre = 0.f;
#pragma unroll
    for (int s2 = 0; s2 < 8; ++s2) pre += (s2 < seg) ? SEG[s2 * 64 + dme] : 0.f;
#pragma unroll
    for (int k = 0; k < 8; ++k) p.BC[(size_t)item * 4096 + (seg * 8 + k) * 64 + dme] = la[k] + pre;
  }
}

DI void st_glascan(const Prm& p, int layer, unsigned char* lds, int bid, int nb) {
  constexpr int PB = 72;
  bf16_t* QI = (bf16_t*)lds; bf16_t* QR = QI + 64 * PB; bf16_t* KR = QR + 64 * PB; bf16_t* KRT = KR + 64 * PB; bf16_t* VT = KRT + 64 * PB; bf16_t* SB = VT + 64 * PB; bf16_t* PL = SB + 64 * PB;
  float* LA = (float*)(lds + 7 * 64 * PB * 2);
  float* AL = LA + 4096;
  float* SEG = AL + 1024;
  float* EBL = SEG + 512;
  const int tid = ltid(), wave = tid >> 6, lane = tid & 63, r32 = lane & 31, hi = lane >> 5;
  for (int item = bid; item < 128; item += nb) {
    const int chain = item >> 1, half = item & 1, b = chain >> 3, h = (chain >> 1) & 3, dir = chain & 1;
    f32x16 acc = {};
    __syncthreads();
    for (int e = tid; e < 64 * PB; e += NTHR) SB[e] = 0;
    bf16x8 pf[3]; f32x4 pb[2];
    auto gload = [&](int n) {
#pragma unroll
      for (int r = 0; r < 3; ++r) { const int e = tid + NTHR * r; const int t = e / 24, ch = e - t * 24; const int row = scan_row(b, dir, n * 64 + t);
        const int col = ch < 8 ? C_GQ + h * 64 + ch * 8 : (ch < 16 ? C_GK + h * 64 + (ch - 8) * 8 : C_GV + h * 128 + half * 64 + (ch - 16) * 8);
        pf[r] = *(const bf16x8*)(p.Z + (size_t)row * NZ + col); }
#pragma unroll
      for (int r = 0; r < 2; ++r) pb[r] = *(const f32x4*)(p.BC + ((size_t)chain * 68 + n) * 4096 + (tid + NTHR * r) * 4);
    };
    gload(0);
    for (int n = 0; n < LT / 64; ++n) {
#pragma unroll
      for (int r = 0; r < 2; ++r) *(f32x4*)(LA + (tid + NTHR * r) * 4) = pb[r];
      __syncthreads();
      if (tid < 64) EBL[tid] = __expf(LA[63 * 64 + tid]);
#pragma unroll
      for (int r = 0; r < 3; ++r) { const int e = tid + NTHR * r; const int t = e / 24, ch = e - t * 24;
          if (ch < 8) { u32x4 wi, wr; float xi[8], xr[8];
#pragma unroll
            for (int j = 0; j < 8; ++j) { const int d = ch * 8 + j; const float bc = LA[t * 64 + d], bl = LA[63 * 64 + d], q = bf2f((bf16_t)pf[r][j]) * 0.125f; xi[j] = q * __expf(bc); xr[j] = q * __expf(bc - bl); }
            wi.x = pack2(xi[0], xi[1]); wi.y = pack2(xi[2], xi[3]); wi.z = pack2(xi[4], xi[5]); wi.w = pack2(xi[6], xi[7]);
            wr.x = pack2(xr[0], xr[1]); wr.y = pack2(xr[2], xr[3]); wr.z = pack2(xr[4], xr[5]); wr.w = pack2(xr[6], xr[7]);
            *(u32x4*)(QI + t * PB + ch * 8) = wi; *(u32x4*)(QR + t * PB + ch * 8) = wr; }
          else if (ch < 16) { u32x4 wk; float xk[8];
#pragma unroll
            for (int j = 0; j < 8; ++j) { const int d = (ch - 8) * 8 + j; xk[j] = bf2f((bf16_t)pf[r][j]) * __expf(LA[63 * 64 + d] - LA[t * 64 + d]); KRT[tsw(d, t)] = f2bf(xk[j]); }
            wk.x = pack2(xk[0], xk[1]); wk.y = pack2(xk[2], xk[3]); wk.z = pack2(xk[4], xk[5]); wk.w = pack2(xk[6], xk[7]);
            *(u32x4*)(KR + t * PB + (ch - 8) * 8) = wk; }
          else {
#pragma unroll
            for (int j = 0; j < 8; ++j) VT[tsw((ch - 16) * 8 + j, t)] = (bf16_t)pf[r][j]; } }
      if (n + 1 < LT / 64) gload(n + 1);
      __syncthreads();
      if (wave < 3) { const int et = wave == 2 ? 1 : 0, ct = wave == 0 ? 0 : 1; f32x16 a2 = {};
#pragma unroll
        for (int k8 = 0; k8 < 4; ++k8) { const bf16x8 av = *(const bf16x8*)(KR + (et * 32 + r32) * PB + k8 * 16 + hi * 8), bv = *(const bf16x8*)(QR + (ct * 32 + r32) * PB + k8 * 16 + hi * 8);
          a2 = __builtin_amdgcn_mfma_f32_32x32x16_bf16(av, bv, a2, 0, 0, 0); }
        const int c = ct * 32 + r32;
#pragma unroll
        for (int g = 0; g < 4; ++g) { const int e0 = et * 32 + 8 * g + 4 * hi; u32x2 w;
          w.x = pack2(e0 <= c ? a2[4 * g] : 0.f, e0 + 1 <= c ? a2[4 * g + 1] : 0.f); w.y = pack2(e0 + 2 <= c ? a2[4 * g + 2] : 0.f, e0 + 3 <= c ? a2[4 * g + 3] : 0.f);
          *(u32x2*)(PL + c * PB + e0) = w; } }
      else if (wave == 3) { for (int e = lane; e < 32 * 8; e += 64) { const int c = e >> 3, q4 = (e & 7) * 4; *(u32x2*)(PL + c * PB + 32 + q4) = (u32x2){0u, 0u}; } }
      else { const int ct = (wave - 4) >> 1, jt = wave & 1; acc = f32x16{};
#pragma unroll
        for (int k8 = 0; k8 < 4; ++k8) { const bf16x8 av = *(const bf16x8*)(QI + (ct * 32 + r32) * PB + k8 * 16 + hi * 8), bv = *(const bf16x8*)(SB + (jt * 32 + r32) * PB + k8 * 16 + hi * 8);
          acc = __builtin_amdgcn_mfma_f32_32x32x16_bf16(av, bv, acc, 0, 0, 0); } }
      __syncthreads();
      if (wave >= 4) { const int ct = (wave - 4) >> 1, jt = wave & 1;
#pragma unroll
        for (int k8 = 0; k8 < 4; ++k8) { const bf16x8 av = *(const bf16x8*)(PL + (ct * 32 + r32) * PB + k8 * 16 + hi * 8), bv = *(const bf16x8*)(VT + tsw(jt * 32 + r32, k8 * 16 + hi * 8));
          acc = __builtin_amdgcn_mfma_f32_32x32x16_bf16(av, bv, acc, 0, 0, 0); }
#pragma unroll
        for (int r = 0; r < 16; ++r) { const int c = ct * 32 + (r & 3) + 8 * (r >> 2) + 4 * hi; const int row = scan_row(b, dir, n * 64 + c);
          p.OB[((size_t)(1 * 2 + dir) * MR + row) * 512 + h * 128 + half * 64 + jt * 32 + r32] = f2bf(acc[r]); } }
      else { const int dt = wave >> 1, jt = wave & 1;
#pragma unroll
        for (int r = 0; r < 16; ++r) acc[r] *= EBL[dt * 32 + (r & 3) + 8 * (r >> 2) + 4 * hi];
#pragma unroll
        for (int k8 = 0; k8 < 4; ++k8) { const bf16x8 av = *(const bf16x8*)(KRT + tsw(dt * 32 + r32, k8 * 16 + hi * 8)), bv = *(const bf16x8*)(VT + tsw(jt * 32 + r32, k8 * 16 + hi * 8));
          acc = __builtin_amdgcn_mfma_f32_32x32x16_bf16(av, bv, acc, 0, 0, 0); }
#pragma unroll
        for (int g = 0; g < 4; ++g) { u32x2 w; w.x = pack2(acc[4 * g], acc[4 * g + 1]); w.y = pack2(acc[4 * g + 2], acc[4 * g + 3]);
          *(u32x2*)(SB + (jt * 32 + r32) * PB + dt * 32 + 8 * g + 4 * hi) = w; } }
      __syncthreads();
    }
  }
}

DI void st_combine(const Prm& p, int layer, int bid, int nb) {
  const int wave = ltid() >> 6, lane = ltid() & 63;
  for (long task = (long)bid * 8 + wave; task < (long)MR * 8; task += (long)nb * 8) {
    const int row = (int)(task >> 3), mh = (int)(task & 7), mixer = mh >> 2, h = mh & 3;
    const unsigned f = *(const unsigned*)(p.OB + ((size_t)(mixer * 2 + 0) * MR + row) * 512 + h * 128 + lane * 2), g = *(const unsigned*)(p.OB + ((size_t)(mixer * 2 + 1) * MR + row) * 512 + h * 128 + lane * 2);
    const float o0 = bf2f((bf16_t)(f & 0xffffu)) + bf2f((bf16_t)(g & 0xffffu)), o1 = bf2f((bf16_t)(f >> 16)) + bf2f((bf16_t)(g >> 16));
    const float ss = wsum(o0 * o0 + o1 * o1), rstd = rsqrtf(ss * (1.f / 128.f) + EPSV);
    const float* w = (mixer ? p.gla_norm : p.dn_norm) + layer * 128 + lane * 2;
    const unsigned gz = *(const unsigned*)(p.Z + (size_t)row * NZ + (mixer ? C_GGATE : C_DNGATE) + h * 128 + lane * 2);
    const float g0 = bf2f((bf16_t)(gz & 0xffffu)), g1 = bf2f((bf16_t)(gz >> 16));
    *(unsigned short*)((unsigned char*)p.Y + (size_t)row * DM + mixer * 512 + h * 128 + lane * 2) = (unsigned short)__builtin_amdgcn_cvt_pk_fp8_f32(y8c(o0 * rstd * w[0] * siluf(g0)), y8c(o1 * rstd * w[1] * siluf(g1)), 0, false);
  }
}

DI unsigned fkey(float f) { const unsigned u = __float_as_uint(f); return u ^ ((u >> 31) ? 0xffffffffu : 0x80000000u); }
DI int pcnt(unsigned long long m) { return __builtin_popcountll(m); }
DI int lanes_below(unsigned long long m) { return (int)__builtin_amdgcn_mbcnt_hi((unsigned)(m >> 32), __builtin_amdgcn_mbcnt_lo((unsigned)m, 0u)); }
DI void st_peertopk(const Prm& p, int layer, unsigned char* lds, int bid, int nb) {
  bf16_t* ks = (bf16_t*)lds;
  bf16_t* qt = (bf16_t*)(lds + 69632);
  float* sc = (float*)(lds + 69632);
  const int tid = ltid(), wave = tid >> 6, lane = tid & 63, r32 = lane & 31, hi = lane >> 5;
  float* selv = (float*)(lds + 69632 + 33280) + wave * 64; int* seli = (int*)(selv + 32);
  int hcur = -1;
  const int nchunk = MR / 32;
  const int total = 8 * nchunk;
  auto valid = [&](int i2) { const int ch = i2 % nchunk; return !(layer == 1 && ((ch * 32) % LT) >= LL); };
  u32x4 pq[2];
  auto preload = [&](int i2) { const int h2 = i2 / nchunk, r0 = (i2 - h2 * nchunk) * 32;
#pragma unroll
    for (int q = 0; q < 2; ++q) { const int e = tid + NTHR * q, r = e >> 5, c8 = (e & 31) * 8; pq[q] = *(const u32x4*)(p.Qp + (size_t)(r0 + r) * DM + h2 * 256 + c8); } };
  int it = bid; while (it < total && !valid(it)) it += nb;
  if (it < total) preload(it);
  while (it < total) {
    int nxt = it + nb; while (nxt < total && !valid(nxt)) nxt += nb;
    const int h = it / nchunk, chunk = it - h * nchunk, row0 = chunk * 32;
    __syncthreads();
    if (h != hcur) {
      const float* kg = p.peer_keys + ((size_t)(layer * 8 + h) * 2) * 128 * 128;
      for (int e = tid; e < 2 * 128 * 128; e += NTHR) { const int pn = e >> 7, k = e & 127; ks[pn * 136 + k] = f2bf(kg[e]); }
      hcur = h; }
#pragma unroll
    for (int q = 0; q < 2; ++q) { const int e = tid + NTHR * q, r = e >> 5, c8 = (e & 31) * 8; *(u32x4*)(qt + r * 264 + c8) = pq[q]; }
    __syncthreads();
    { const int pt = wave >> 2, nt = wave & 3; f32x16 acc = {};
#pragma unroll
      for (int k8 = 0; k8 < 8; ++k8) { const bf16x8 a = *(const bf16x8*)(qt + r32 * 264 + pt * 128 + k8 * 16 + hi * 8), b = *(const bf16x8*)(ks + (pt * 128 + nt * 32 + r32) * 136 + k8 * 16 + hi * 8);
        acc = __builtin_amdgcn_mfma_f32_32x32x16_bf16(a, b, acc, 0, 0, 0); }
      __syncthreads();
#pragma unroll
      for (int r = 0; r < 16; ++r) sc[((r & 3) + 8 * (r >> 2) + 4 * hi) * 260 + pt * 128 + nt * 32 + r32] = acc[r]; }
    __syncthreads();
    if (nxt < total) preload(nxt);
    for (int rr = 0; rr < 4; ++rr) {
      const int m = wave * 4 + rr, row = row0 + m;
      float s[2][2];
#pragma unroll
      for (int pp = 0; pp < 2; ++pp)
#pragma unroll
        for (int hh = 0; hh < 2; ++hh) s[pp][hh] = sc[m * 260 + pp * 128 + hh * 64 + lane];
      unsigned kk[2][2], T[2] = {0u, 0u};
#pragma unroll
      for (int pp = 0; pp < 2; ++pp) { kk[pp][0] = fkey(s[pp][0]); kk[pp][1] = fkey(s[pp][1]); }
      { unsigned ta = 0u, tb = 0u, da = 0u, db = 0u;
        for (int bit = 31; bit >= 0; --bit) { const unsigned m = 1u << bit;
          const unsigned ca = ta | m, cb = tb | m;
          const unsigned na = (unsigned)(pcnt(__ballot(kk[0][0] >= ca)) + pcnt(__ballot(kk[0][1] >= ca))), nb2 = (unsigned)(pcnt(__ballot(kk[1][0] >= cb)) + pcnt(__ballot(kk[1][1] >= cb)));
          const unsigned oa = (na >= 16u ? 1u : 0u) & ~da, ob = (nb2 >= 16u ? 1u : 0u) & ~db;
          ta |= (0u - oa) & m; tb |= (0u - ob) & m; da |= oa & (na == 16u ? 1u : 0u); db |= ob & (nb2 == 16u ? 1u : 0u);
          if (da & db) break; }
        T[0] = __builtin_amdgcn_readfirstlane(ta); T[1] = __builtin_amdgcn_readfirstlane(tb); }
#pragma unroll
      for (int pp = 0; pp < 2; ++pp) { const unsigned k0 = kk[pp][0], k1 = kk[pp][1], TT = T[pp];
        const unsigned long long g0 = __ballot(k0 > TT), g1 = __ballot(k1 > TT), e0 = __ballot(k0 == TT), e1 = __ballot(k1 == TT);
        const int ng0 = pcnt(g0), ng = ng0 + pcnt(g1), need = 16 - ng, ne0 = pcnt(e0);
        if (k0 > TT) { const int r = lanes_below(g0); selv[pp * 16 + r] = s[pp][0]; seli[pp * 16 + r] = lane; }
        if (k1 > TT) { const int r = ng0 + lanes_below(g1); selv[pp * 16 + r] = s[pp][1]; seli[pp * 16 + r] = lane + 64; }
        if (k0 == TT) { const int r = lanes_below(e0); if (r < need) { selv[pp * 16 + ng + r] = s[pp][0]; seli[pp * 16 + ng + r] = lane; } }
        if (k1 == TT) { const int r = ne0 + lanes_below(e1); if (r < need) { selv[pp * 16 + ng + r] = s[pp][1]; seli[pp * 16 + ng + r] = lane + 64; } } }
      __builtin_amdgcn_wave_barrier();
      float cd[4]; unsigned ck[4]; { const float sa = selv[lane >> 2]; const f32x4 sb = *(const f32x4*)(selv + 16 + (lane & 3) * 4);
#pragma unroll
        for (int q = 0; q < 4; ++q) { cd[q] = sa + sb[q]; ck[q] = fkey(cd[q]); } }
      unsigned T2 = 0u;
      for (int bit = 31; bit >= 0; --bit) { const unsigned m = 1u << bit, c = T2 | m;
        const unsigned n = (unsigned)(pcnt(__ballot(ck[0] >= c)) + pcnt(__ballot(ck[1] >= c)) + pcnt(__ballot(ck[2] >= c)) + pcnt(__ballot(ck[3] >= c)));
        T2 |= (0u - (n >= 16u ? 1u : 0u)) & m; if (n == 16u) break; }
      T2 = __builtin_amdgcn_readfirstlane(T2);
      float mx = fmaxf(fmaxf(cd[0], cd[1]), fmaxf(cd[2], cd[3])); mx = wmax(mx);
      int base = 0; float esum = 0.f; const int ia = seli[lane >> 2]; int rk[4]; float ev[4];
#pragma unroll
      for (int q = 0; q < 4; ++q) { const unsigned long long g = __ballot(ck[q] > T2); rk[q] = ck[q] > T2 ? base + lanes_below(g) : 99; base += pcnt(g); }
#pragma unroll
      for (int q = 0; q < 4; ++q) { const unsigned long long g = __ballot(ck[q] == T2); if (ck[q] == T2) rk[q] = base + lanes_below(g); base += pcnt(g); }
#pragma unroll
      for (int q = 0; q < 4; ++q) { ev[q] = rk[q] < 16 ? __expf(cd[q] - mx) : 0.f; esum += ev[q]; }
      esum = wsum(esum); const float inv = 1.f / esum;
      int* orow = p.IDX + (size_t)row * 128 + h * 16; float* grow = p.GATE + (size_t)row * 128 + h * 16;
#pragma unroll
      for (int q = 0; q < 4; ++q) if (rk[q] < 16) { orow[rk[q]] = ia * 128 + seli[16 + (lane & 3) * 4 + q]; grow[rk[q]] = ev[q] * inv; }
      __builtin_amdgcn_wave_barrier();
    }
    it = nxt;
  }
}

typedef float v16f_t __attribute__((ext_vector_type(16)));
typedef float v32f_t __attribute__((ext_vector_type(32)));
typedef unsigned v6u_t __attribute__((ext_vector_type(6)));
typedef __bf16 v32bf_t __attribute__((ext_vector_type(32)));
typedef __bf16 v2bf_t __attribute__((ext_vector_type(2)));
constexpr int TROW = 1600;
constexpr int TROWV = 1152;
constexpr int TREC = 2176;
constexpr float TSM = 64.f;
DI void st_cvt_tables(const Prm& p, int layer, int bid, int nb) {
  const size_t nblk = (size_t)16384 * 64, stride = (size_t)nb * NTHR;
  const float* U = p.peer_u + (size_t)layer * 16384 * DM; const float* V = p.peer_v + (size_t)layer * 16384 * DM;
  for (size_t e = (size_t)bid * NTHR + ltid(); e < 2 * nblk; e += stride) { const bool isv = e >= nblk; const size_t k = isv ? e - nblk : e; const size_t row = k >> 6; const int l = (int)(k & 63);
    const float* src = (isv ? V : U) + row * DM + l * 32; float amax = 0.f; f32x4 a[8];
#pragma unroll
    for (int q = 0; q < 8; ++q) { a[q] = *(const f32x4*)(src + q * 4);
#pragma unroll
      for (int i = 0; i < 4; ++i) amax = fmaxf(amax, fabsf(a[q][i])); }
    const float want = fminf(fmaxf(amax * (TSM / 6.f), 0.001953125f), 448.f); int s8 = __builtin_amdgcn_cvt_pk_fp8_f32(want, want, 0, false) & 0xff;
    if (__builtin_amdgcn_cvt_f32_fp8(s8, 0) < want && s8 < 0x7e) ++s8;
    const float inv = TSM / __builtin_amdgcn_cvt_f32_fp8(s8, 0);
    u32x4 r = (u32x4){0u, 0u, 0u, 0u};
#pragma unroll
    for (int q = 0; q < 4; ++q) { unsigned w = 0;
      w = __builtin_amdgcn_cvt_scalef32_pk_fp4_f32(w, a[2 * q][0] * inv, a[2 * q][1] * inv, 1.0f, 0); w = __builtin_amdgcn_cvt_scalef32_pk_fp4_f32(w, a[2 * q][2] * inv, a[2 * q][3] * inv, 1.0f, 1);
      w = __builtin_amdgcn_cvt_scalef32_pk_fp4_f32(w, a[2 * q + 1][0] * inv, a[2 * q + 1][1] * inv, 1.0f, 2); w = __builtin_amdgcn_cvt_scalef32_pk_fp4_f32(w, a[2 * q + 1][2] * inv, a[2 * q + 1][3] * inv, 1.0f, 3);
      r[q] = w; }
    unsigned char* dst = (unsigned char*)p.Ub + row * TREC;
    dst[2 * l + (isv ? 1 : 0)] = (unsigned char)s8; *(u32x4*)(dst + 128 + (isv ? 1024 : 0) + l * 16) = r; }
}

DI void st_peergather(const Prm& p, int layer, float* lds, int bid, int nb, bool dry = false) {
  const int tid = ltid(), wave = tid >> 6, lane = tid & 63;
  const unsigned char* Ub = (const unsigned char*)p.Ub; const unsigned char* Vb = (const unsigned char*)p.Vb;
  for (int row = bid; row < MR; row += nb) {
    const int b = row / LT, t = row - b * LT; const bool isc = t >= LL;
    if (isc && layer == 1) continue;
    f32x2 hv[16];
#pragma unroll
    for (int q = 0; q < 4; ++q) { const u32x4 w = *(const u32x4*)(p.H2 + (size_t)row * DM + lane * 32 + q * 8);
#pragma unroll
      for (int k = 0; k < 4; ++k) hv[q * 4 + k] = (f32x2){__uint_as_float(w[k] << 16), __uint_as_float(w[k] & 0xffff0000u)}; }
    f32x2 acc[16];
#pragma unroll
    for (int i = 0; i < 16; ++i) acc[i] = (f32x2){0.f, 0.f};
    const int myidx = lane < 16 ? p.IDX[(size_t)row * 128 + wave * 16 + lane] : 0; const float mygate = lane < 16 ? p.GATE[(size_t)row * 128 + wave * 16 + lane] : 0.f;
#pragma unroll 1
    for (int k0 = 0; k0 < 16; k0 += 8) {
      u32x4 ua[8], va[8]; u32x2 ub[8], vb[8]; unsigned us[8], vs[8];
#pragma unroll
      for (int q = 0; q < 8; ++q) { const int e = __builtin_amdgcn_readfirstlane(__shfl(myidx, k0 + q));
        const unsigned char* ur = Ub + (size_t)e * TROW; const unsigned char* vr = Vb + (size_t)e * TROW;
        ua[q] = *(const u32x4*)(ur + 64 + lane * 16); ub[q] = *(const u32x2*)(ur + 64 + 1024 + lane * 8); us[q] = ur[lane];
        va[q] = *(const u32x4*)(vr + 64 + lane * 16); vb[q] = *(const u32x2*)(vr + 64 + 1024 + lane * 8); vs[q] = vr[lane]; }
#pragma unroll
      for (int q = 0; q < 8; ++q) {
        const v32f_t du = __builtin_amdgcn_cvt_scalef32_pk32_f32_fp6((v6u_t){ua[q][0], ua[q][1], ua[q][2], ua[q][3], ub[q][0], ub[q][1]}, 1.0f);
        f32x2 d0 = (f32x2){0.f, 0.f}, d1 = (f32x2){0.f, 0.f};
#pragma unroll
        for (int i = 0; i < 16; i += 2) { d0 += (f32x2){du[2 * i], du[2 * i + 1]} * hv[i]; d1 += (f32x2){du[2 * i + 2], du[2 * i + 3]} * hv[i + 1]; }
        d0 += d1; const float d = wsum((d0[0] + d0[1]) * __uint_as_float(us[q] << 23));
        const float wgt = __shfl(mygate, k0 + q) * 0.5f * d * (1.f + erff(d * 0.70710678118654752f)) * __uint_as_float(vs[q] << 23); const f32x2 w2 = (f32x2){wgt, wgt};
        const v32f_t dv = __builtin_amdgcn_cvt_scalef32_pk32_f32_fp6((v6u_t){va[q][0], va[q][1], va[q][2], va[q][3], vb[q][0], vb[q][1]}, 1.0f);
#pragma unroll
        for (int i = 0; i < 16; ++i) acc[i] += w2 * (f32x2){dv[2 * i], dv[2 * i + 1]}; }
    }
    __syncthreads();
#pragma unroll
    for (int k = 0; k < 8; ++k) *(f32x4*)(lds + wave * 2048 + lane * 32 + k * 4) = (f32x4){acc[2 * k][0], acc[2 * k][1], acc[2 * k + 1][0], acc[2 * k + 1][1]};
    __syncthreads();
    { const int col = tid * 4; f32x4 sum = (f32x4){0.f, 0.f, 0.f, 0.f};
#pragma unroll
      for (int w = 0; w < 8; ++w) sum += *(const f32x4*)(lds + w * 2048 + col);
      const f32x4 g2 = *(const f32x4*)(p.mod + ((size_t)layer * 9 + (isc ? 8 : b)) * NMOD + 5 * DM + col);
      float* xr = p.X + (size_t)row * DM + col; const f32x4 xn = *(const f32x4*)xr + g2 * sum;
      if (!dry) {
        float ss = wsum(xn[0] * xn[0] + xn[1] * xn[1] + xn[2] * xn[2] + xn[3] * xn[3]);
        if (lane == 0) lds[16384 + wave] = ss;
        __syncthreads();
        ss = 0.f;
#pragma unroll
        for (int w = 0; w < 8; ++w) ss += lds[16384 + w];
        const float rstd = rsqrtf(ss * (1.f / 2048.f) + EPSV);
        if (layer == 0) { *(f32x4*)xr = xn;
          const float* mr = p.mod + ((size_t)9 + (isc ? 8 : b)) * NMOD; const f32x4 sc = *(const f32x4*)(mr + DM + col), sh = *(const f32x4*)(mr + col);
          const f32x4 o = xn * rstd * (sc + 1.f) + sh; u32x2 w; w.x = pack2(o[0], o[1]); w.y = pack2(o[2], o[3]); *(u32x2*)(p.H + (size_t)row * DM + col) = w; }
        else *(f32x4*)(p.out + ((size_t)b * LL + t) * DM + col) = xn * rstd * *(const f32x4*)(p.final_norm + col);
      } }
  }
}

DI void sel_row(const float* scrow, float* selv, int* seli, int* orow, float* grow, int lane) {
  float s[2][2];
#pragma unroll
  for (int pp = 0; pp < 2; ++pp)
#pragma unroll
    for (int hh = 0; hh < 2; ++hh) s[pp][hh] = scrow[pp * 128 + hh * 64 + lane];
  unsigned kk[2][2], T[2] = {0u, 0u};
#pragma unroll
  for (int pp = 0; pp < 2; ++pp) { kk[pp][0] = fkey(s[pp][0]); kk[pp][1] = fkey(s[pp][1]); }
  { unsigned ta = 0u, tb = 0u, da = 0u, db = 0u;
    for (int bit = 31; bit >= 0; --bit) { const unsigned m = 1u << bit;
      const unsigned ca = ta | m, cb = tb | m;
      const unsigned na = (unsigned)(pcnt(__ballot(kk[0][0] >= ca)) + pcnt(__ballot(kk[0][1] >= ca))), nb2 = (unsigned)(pcnt(__ballot(kk[1][0] >= cb)) + pcnt(__ballot(kk[1][1] >= cb)));
      const unsigned oa = (na >= 16u ? 1u : 0u) & ~da, ob = (nb2 >= 16u ? 1u : 0u) & ~db;
      ta |= (0u - oa) & m; tb |= (0u - ob) & m; da |= oa & (na == 16u ? 1u : 0u); db |= ob & (nb2 == 16u ? 1u : 0u);
      if (da & db) break; }
    T[0] = __builtin_amdgcn_readfirstlane(ta); T[1] = __builtin_amdgcn_readfirstlane(tb); }
#pragma unroll
  for (int pp = 0; pp < 2; ++pp) { const unsigned k0 = kk[pp][0], k1 = kk[pp][1], TT = T[pp];
    const unsigned long long g0 = __ballot(k0 > TT), g1 = __ballot(k1 > TT), e0 = __ballot(k0 == TT), e1 = __ballot(k1 == TT);
    const int ng0 = pcnt(g0), ng = ng0 + pcnt(g1), need = 16 - ng, ne0 = pcnt(e0);
    if (k0 > TT) { const int r = lanes_below(g0); selv[pp * 16 + r] = s[pp][0]; seli[pp * 16 + r] = lane; }
    if (k1 > TT) { const int r = ng0 + lanes_below(g1); selv[pp * 16 + r] = s[pp][1]; seli[pp * 16 + r] = lane + 64; }
    if (k0 == TT) { const int r = lanes_below(e0); if (r < need) { selv[pp * 16 + ng + r] = s[pp][0]; seli[pp * 16 + ng + r] = lane; } }
    if (k1 == TT) { const int r = ne0 + lanes_below(e1); if (r < need) { selv[pp * 16 + ng + r] = s[pp][1]; seli[pp * 16 + ng + r] = lane + 64; } } }
  __builtin_amdgcn_wave_barrier();
  float cd[4]; unsigned ck[4]; { const float sa = selv[lane >> 2]; const f32x4 sb = *(const f32x4*)(selv + 16 + (lane & 3) * 4);
#pragma unroll
    for (int q = 0; q < 4; ++q) { cd[q] = sa + sb[q]; ck[q] = fkey(cd[q]); } }
  unsigned T2 = 0u;
  for (int bit = 31; bit >= 0; --bit) { const unsigned m = 1u << bit, c = T2 | m;
    const unsigned n = (unsigned)(pcnt(__ballot(ck[0] >= c)) + pcnt(__ballot(ck[1] >= c)) + pcnt(__ballot(ck[2] >= c)) + pcnt(__ballot(ck[3] >= c)));
    T2 |= (0u - (n >= 16u ? 1u : 0u)) & m; if (n == 16u) break; }
  T2 = __builtin_amdgcn_readfirstlane(T2);
  float mx = fmaxf(fmaxf(cd[0], cd[1]), fmaxf(cd[2], cd[3])); mx = wmax(mx);
  int base = 0; float esum = 0.f; const int ia = seli[lane >> 2]; int rk[4]; float ev[4];
#pragma unroll
  for (int q = 0; q < 4; ++q) { const unsigned long long g = __ballot(ck[q] > T2); rk[q] = ck[q] > T2 ? base + lanes_below(g) : 99; base += pcnt(g); }
#pragma unroll
  for (int q = 0; q < 4; ++q) { const unsigned long long g = __ballot(ck[q] == T2); if (ck[q] == T2) rk[q] = base + lanes_below(g); base += pcnt(g); }
#pragma unroll
  for (int q = 0; q < 4; ++q) { ev[q] = rk[q] < 16 ? __expf(cd[q] - mx) : 0.f; esum += ev[q]; }
  esum = wsum(esum); const float inv = 1.f / esum;
#pragma unroll
  for (int q = 0; q < 4; ++q) if (rk[q] < 16) { orow[rk[q]] = ia * 128 + seli[16 + (lane & 3) * 4 + q]; grow[rk[q]] = ev[q] * inv; }
  __builtin_amdgcn_wave_barrier();
}

DI void sel_row2(const float* sc0, const float* sc1, float* selv, int* seli, int* orow0, float* grow0, int* orow1, float* grow1, int lane) {
  float s[2][2][2]; unsigned kk[2][2][2];
#pragma unroll
  for (int w = 0; w < 2; ++w)
#pragma unroll
    for (int pp = 0; pp < 2; ++pp)
#pragma unroll
      for (int hh = 0; hh < 2; ++hh) { s[w][pp][hh] = (w ? sc1 : sc0)[pp * 128 + hh * 64 + lane]; kk[w][pp][hh] = fkey(s[w][pp][hh]); }
  unsigned T[2][2];
  { unsigned t0 = 0u, t1 = 0u, t2 = 0u, t3 = 0u, d0 = 0u, d1 = 0u, d2 = 0u, d3 = 0u;
    for (int bit = 31; bit >= 0; --bit) { const unsigned m = 1u << bit;
      const unsigned c0 = t0 | m, c1 = t1 | m, c2 = t2 | m, c3 = t3 | m;
      const unsigned n0 = (unsigned)(pcnt(__ballot(kk[0][0][0] >= c0)) + pcnt(__ballot(kk[0][0][1] >= c0))), n1 = (unsigned)(pcnt(__ballot(kk[0][1][0] >= c1)) + pcnt(__ballot(kk[0][1][1] >= c1)));
      const unsigned n2 = (unsigned)(pcnt(__ballot(kk[1][0][0] >= c2)) + pcnt(__ballot(kk[1][0][1] >= c2))), n3 = (unsigned)(pcnt(__ballot(kk[1][1][0] >= c3)) + pcnt(__ballot(kk[1][1][1] >= c3)));
      const unsigned o0 = (n0 >= 16u ? 1u : 0u) & ~d0, o1 = (n1 >= 16u ? 1u : 0u) & ~d1, o2 = (n2 >= 16u ? 1u : 0u) & ~d2, o3 = (n3 >= 16u ? 1u : 0u) & ~d3;
      t0 |= (0u - o0) & m; t1 |= (0u - o1) & m; t2 |= (0u - o2) & m; t3 |= (0u - o3) & m;
      d0 |= o0 & (n0 == 16u ? 1u : 0u); d1 |= o1 & (n1 == 16u ? 1u : 0u); d2 |= o2 & (n2 == 16u ? 1u : 0u); d3 |= o3 & (n3 == 16u ? 1u : 0u);
      if (d0 & d1 & d2 & d3) break; }
    T[0][0] = __builtin_amdgcn_readfirstlane(t0); T[0][1] = __builtin_amdgcn_readfirstlane(t1); T[1][0] = __builtin_amdgcn_readfirstlane(t2); T[1][1] = __builtin_amdgcn_readfirstlane(t3); }
#pragma unroll
  for (int w = 0; w < 2; ++w)
#pragma unroll
    for (int pp = 0; pp < 2; ++pp) { const unsigned k0 = kk[w][pp][0], k1 = kk[w][pp][1], TT = T[w][pp]; float* sv = selv + w * 32 + pp * 16; int* si = seli + w * 32 + pp * 16;
      const unsigned long long g0 = __ballot(k0 > TT), g1 = __ballot(k1 > TT), e0 = __ballot(k0 == TT), e1 = __ballot(k1 == TT);
      const int ng0 = pcnt(g0), ng = ng0 + pcnt(g1), need = 16 - ng, ne0 = pcnt(e0);
      if (k0 > TT) { const int r = lanes_below(g0); sv[r] = s[w][pp][0]; si[r] = lane; }
      if (k1 > TT) { const int r = ng0 + lanes_below(g1); sv[r] = s[w][pp][1]; si[r] = lane + 64; }
      if (k0 == TT) { const int r = lanes_below(e0); if (r < need) { sv[ng + r] = s[w][pp][0]; si[ng + r] = lane; } }
      if (k1 == TT) { const int r = ne0 + lanes_below(e1); if (r < need) { sv[ng + r] = s[w][pp][1]; si[ng + r] = lane + 64; } } }
  __builtin_amdgcn_wave_barrier();
  float cd[2][4]; unsigned ck[2][4];
#pragma unroll
  for (int w = 0; w < 2; ++w) { const float sa = selv[w * 32 + (lane >> 2)]; const f32x4 sb = *(const f32x4*)(selv + w * 32 + 16 + (lane & 3) * 4);
#pragma unroll
    for (int q = 0; q < 4; ++q) { cd[w][q] = sa + sb[q]; ck[w][q] = fkey(cd[w][q]); } }
  unsigned T2[2];
  { unsigned ta = 0u, tb = 0u, da = 0u, db = 0u;
    for (int bit = 31; bit >= 0; --bit) { const unsigned m = 1u << bit, ca = ta | m, cb = tb | m;
      const unsigned na = (unsigned)(pcnt(__ballot(ck[0][0] >= ca)) + pcnt(__ballot(ck[0][1] >= ca)) + pcnt(__ballot(ck[0][2] >= ca)) + pcnt(__ballot(ck[0][3] >= ca)));
      const unsigned nb2 = (unsigned)(pcnt(__ballot(ck[1][0] >= cb)) + pcnt(__ballot(ck[1][1] >= cb)) + pcnt(__ballot(ck[1][2] >= cb)) + pcnt(__ballot(ck[1][3] >= cb)));
      const unsigned oa = (na >= 16u ? 1u : 0u) & ~da, ob = (nb2 >= 16u ? 1u : 0u) & ~db;
      ta |= (0u - oa) & m; tb |= (0u - ob) & m; da |= oa & (na == 16u ? 1u : 0u); db |= ob & (nb2 == 16u ? 1u : 0u);
      if (da & db) break; }
    T2[0] = __builtin_amdgcn_readfirstlane(ta); T2[1] = __builtin_amdgcn_readfirstlane(tb); }
#pragma unroll
  for (int w = 0; w < 2; ++w) {
    float mx = fmaxf(fmaxf(cd[w][0], cd[w][1]), fmaxf(cd[w][2], cd[w][3])); mx = wmax(mx);
    int base = 0; float esum = 0.f; const int ia = seli[w * 32 + (lane >> 2)]; int rk[4]; float ev[4];
#pragma unroll
    for (int q = 0; q < 4; ++q) { const unsigned long long g = __ballot(ck[w][q] > T2[w]); rk[q] = ck[w][q] > T2[w] ? base + lanes_below(g) : 99; base += pcnt(g); }
#pragma unroll
    for (int q = 0; q < 4; ++q) { const unsigned long long g = __ballot(ck[w][q] == T2[w]); if (ck[w][q] == T2[w]) rk[q] = base + lanes_below(g); base += pcnt(g); }
#pragma unroll
    for (int q = 0; q < 4; ++q) { ev[q] = rk[q] < 16 ? __expf(cd[w][q] - mx) : 0.f; esum += ev[q]; }
    esum = wsum(esum); const float inv = 1.f / esum; int* orow = w ? orow1 : orow0; float* grow = w ? grow1 : grow0;
#pragma unroll
    for (int q = 0; q < 4; ++q) if (rk[q] < 16) { orow[rk[q]] = ia * 128 + seli[w * 32 + 16 + (lane & 3) * 4 + q]; grow[rk[q]] = ev[q] * inv; } }
  __builtin_amdgcn_wave_barrier();
}

DI float dpp_ror4(float v) { return __int_as_float(__builtin_amdgcn_mov_dpp(__float_as_int(v), 0x124, 0xf, 0xf, true)); }
DI float dpp_ror8(float v) { return __int_as_float(__builtin_amdgcn_mov_dpp(__float_as_int(v), 0x128, 0xf, 0xf, true)); }
DI float erf_bf(float x) { const float z = fabsf(x), t = __builtin_amdgcn_rcpf(fmaf(0.3275911f, z, 1.f));
  const float pl = t * fmaf(t, fmaf(t, fmaf(t, fmaf(t, 1.061405429f, -1.453152027f), 1.421413741f), -0.284496736f), 0.254829592f);
  const float r = fmaf(-pl, __builtin_amdgcn_exp2f(z * z * -1.4426950408889634f), 1.f); return copysignf(r, x); }
DI void st_peer(const Prm& p, int layer, unsigned char* lds, int bid, int nb, const int mode = 0) {
  int* HI = (int*)lds;
  float* HG = (float*)(lds + 32768);
  float* SCB = (float*)(lds + 65536);
  float* SLB = (float*)(lds + 65536 + 32768);
  int* CTR = (int*)(lds + 65536 + 32768 + 4096);
  const int nrows = layer == 0 ? 136 : 128, ntile = (nrows + 31) / 32;
  const unsigned char* Ub = (const unsigned char*)p.Ub; const unsigned char* Vb = (const unsigned char*)p.Vb;
  if (ltid() == 0) { CTR[0] = 0; CTR[1] = 0; }
  __syncthreads();
  for (int step = 0; step <= ntile; ++step) {
    const int tid = ltid(), wave = tid >> 6, lane = tid & 63, r32 = lane & 31, hi = lane >> 5;
    const bool tpath = step == 0 || (wave < 4 && step < ntile);
    if (tid == 0) CTR[(step + 1) & 1] = 0;
    if (tpath) {
      {
        const int hpw = step == 0 ? 1 : 2, tw = wave, buf = step & 1, t0 = step * 32, tl = nrows - t0 < 32 ? nrows - t0 : 32;
        float* RB = SCB + tw * 512; float* selv = SLB + tw * 128; int* seli = (int*)(selv + 64);
        const int rl = t0 + (r32 < tl ? r32 : tl - 1); const int rq = bid * nrows + rl; const int qrow = layer == 0 ? rq : (rq >> 12) * LT + (rq & 4095);
        for (int hh = 0; hh < hpw; ++hh) { const int h = tw * hpw + hh;
          f32x16 acc[2][4] = {};
#pragma unroll
          for (int pp = 0; pp < 2; ++pp) {
            const bf16_t* qp = p.Qp + (size_t)qrow * DM + h * 256 + pp * 128 + hi * 8; const bf16_t* kp = p.KB16 + ((size_t)((layer * 8 + h) * 2 + pp) * 128 + r32) * 128 + hi * 8;
#pragma unroll 4
            for (int ks = 0; ks < 8; ++ks) { const bf16x8 av = *(const bf16x8*)(qp + ks * 16);
#pragma unroll
              for (int nt = 0; nt < 4; ++nt) { const bf16x8 bv = *(const bf16x8*)(kp + (size_t)nt * 32 * 128 + ks * 16); acc[pp][nt] = __builtin_amdgcn_mfma_f32_32x32x16_bf16(av, bv, acc[pp][nt], 0, 0, 0); } } }
#pragma unroll 1
          for (int r = 0; r < 16; ++r) { const int m0 = (r & 3) + 8 * (r >> 2); if (m0 >= tl) continue;
#pragma unroll
            for (int pp = 0; pp < 2; ++pp)
#pragma unroll
              for (int nt = 0; nt < 4; ++nt) { const f32x16& A = acc[pp][nt];
                const float a0 = (r & 1) ? A[1] : A[0], a1 = (r & 1) ? A[3] : A[2], a2 = (r & 1) ? A[5] : A[4], a3 = (r & 1) ? A[7] : A[6], a4 = (r & 1) ? A[9] : A[8], a5 = (r & 1) ? A[11] : A[10], a6 = (r & 1) ? A[13] : A[12], a7 = (r & 1) ? A[15] : A[14];
                const float b0 = (r & 2) ? a1 : a0, b1 = (r & 2) ? a3 : a2, b2 = (r & 2) ? a5 : a4, b3 = (r & 2) ? a7 : a6;
                const float c0 = (r & 4) ? b1 : b0, c1 = (r & 4) ? b3 : b2;
                RB[hi * 256 + pp * 128 + nt * 32 + r32] = (r & 8) ? c1 : c0; }
            __builtin_amdgcn_wave_barrier();
            sel_row2(RB, RB + 256, selv, seli, HI + (buf * 32 + m0) * 128 + h * 16, HG + (buf * 32 + m0) * 128 + h * 16, HI + (buf * 32 + m0 + 4) * 128 + h * 16, HG + (buf * 32 + m0 + 4) * 128 + h * 16, lane);
            __builtin_amdgcn_wave_barrier(); }
        }
      }
    }
    if (step >= 1) {
      const int tile = step - 1, buf = tile & 1;
      for (;;) { int m = 0; if (lane == 0) m = atomicAdd(&CTR[step & 1], 1); m = __builtin_amdgcn_readfirstlane(m); const int rl = tile * 32 + m; if (m >= 32 || rl >= nrows) break;
        const int rq = bid * nrows + rl; const int row = layer == 0 ? rq : (rq >> 12) * LT + (rq & 4095);
        const int b = row / LT, t = row - b * LT; const bool isc = t >= LL;
        u32x4 hw[2];
        int lane_r = lane; asm volatile("" : "+v"(lane_r));
#pragma unroll
        for (int q = 0; q < 2; ++q) hw[q] = *(const u32x4*)(p.H2q + (size_t)row * DM + lane_r * 32 + q * 16);
#define HVP(k) ((f32x2){__uint_as_float(hw[(k) >> 2][(k) & 3] << 16), __uint_as_float(hw[(k) >> 2][(k) & 3] & 0xffff0000u)})
        f32x2 acc[16];
#pragma unroll
        for (int k = 0; k < 16; ++k) acc[k] = (f32x2){0.f, 0.f};
        const int* hi_ = HI + (buf * 32 + m) * 128; const float* hg_ = HG + (buf * 32 + m) * 128;
        const int idx0 = hi_[lane], idx1 = hi_[64 + lane]; const float gt0 = hg_[lane], gt1 = hg_[64 + lane];
        constexpr int NS = 8;
        u32x4 ua[NS] = {}, va[NS] = {}; unsigned us[NS] = {};
        const unsigned vo16 = lane * 16, vo2 = lane * 2;
        const int bp16 = (lane ^ 16) * 4, bp32 = (lane ^ 32) * 4, l3 = lane & 3; const bool b0 = (lane & 1) != 0, b1 = (lane & 2) != 0;
        unsigned hd[16];
#pragma unroll
        for (int j = 0; j < 8; ++j) { const int dw = (int)hw[j >> 2][j & 3]; const f32x2 t0 = __builtin_amdgcn_cvt_pk_f32_fp8(dw, false), t1 = __builtin_amdgcn_cvt_pk_f32_fp8(dw, true);
          hd[2 * j] = (__float_as_uint(t0[0]) >> 16) | (__float_as_uint(t0[1]) & 0xffff0000u); hd[2 * j + 1] = (__float_as_uint(t1[0]) >> 16) | (__float_as_uint(t1[1]) & 0xffff0000u);
          asm volatile("" : "+v"(hd[2 * j]), "+v"(hd[2 * j + 1])); }
#define DOT2(A, I) A = __builtin_amdgcn_fdot2_f32_bf16(__builtin_shufflevector(du, du, 2 * (I), 2 * (I) + 1), __builtin_bit_cast(v2bf_t, hd[I]), A, false);
#define PG_LOADU0(S, K) { const int k_ = (K); const int e = __builtin_amdgcn_readlane(isrc_, k_ & 63); const unsigned char* ur = Ub + (size_t)e * TREC; \
            asm volatile("global_load_dwordx4 %0, %2, %4 offset:128\n\tglobal_load_ushort %1, %3, %4" \
                         : "+v"(ua[S]), "+v"(us[S]) : "v"(vo16), "v"(vo2), "s"(ur), \
                           "v"(acc[0]), "v"(acc[1]), "v"(acc[2]), "v"(acc[3]), "v"(acc[4]), "v"(acc[5]), "v"(acc[6]), "v"(acc[7]), "v"(acc[8]), "v"(acc[9]), "v"(acc[10]), "v"(acc[11]), \
                           "v"(acc[12]), "v"(acc[13]), "v"(acc[14]), "v"(acc[15]) : "memory"); }
#define PG_LOADU(S, K) { const int k_ = (K); const int e = __builtin_amdgcn_readlane(isrc_, k_ & 63); const unsigned char* ur = Ub + (size_t)e * TREC; \
            asm volatile("global_load_dwordx4 %0, %2, %4 offset:128\n\tglobal_load_ushort %1, %3, %4" : "+v"(ua[S]), "+v"(us[S]) : "v"(vo16), "v"(vo2), "s"(ur) : "memory"); }
#define PG_LOADV(S, K) { const int k_ = (K); const int e = __builtin_amdgcn_readlane(isrc_, k_ & 63); const unsigned char* vr = Ub + (size_t)e * TREC; \
            asm volatile("global_load_dwordx4 %0, %1, %2 offset:1152" : "+v"(va[S]) : "v"(vo16), "s"(vr) : "memory"); }
#define PG_LOADG(S0, K0) { const int isrc_ = (K0) < 64 ? idx0 : idx1;     \
                           PG_LOADU0(S0, K0) PG_LOADU(S0 + 1, (K0) + 1) PG_LOADU(S0 + 2, (K0) + 2) PG_LOADU(S0 + 3, (K0) + 3) \
                           PG_LOADV(S0, K0) PG_LOADV(S0 + 1, (K0) + 1) PG_LOADV(S0 + 2, (K0) + 2) PG_LOADV(S0 + 3, (K0) + 3) }
#define PG_UDOT(S, D) { float da = 0.f, db = 0.f; \
            _Pragma("unroll") for (int q = 0; q < 4; ++q) { \
              da = __builtin_amdgcn_fdot2_f32_bf16(__builtin_amdgcn_cvt_scalef32_pk_bf16_fp4(ua[S][q], 1.0f, 0), __builtin_bit_cast(v2bf_t, hd[4 * q]), da, false); \
              db = __builtin_amdgcn_fdot2_f32_bf16(__builtin_amdgcn_cvt_scalef32_pk_bf16_fp4(ua[S][q], 1.0f, 1), __builtin_bit_cast(v2bf_t, hd[4 * q + 1]), db, false); \
              da = __builtin_amdgcn_fdot2_f32_bf16(__builtin_amdgcn_cvt_scalef32_pk_bf16_fp4(ua[S][q], 1.0f, 2), __builtin_bit_cast(v2bf_t, hd[4 * q + 2]), da, false); \
              db = __builtin_amdgcn_fdot2_f32_bf16(__builtin_amdgcn_cvt_scalef32_pk_bf16_fp4(ua[S][q], 1.0f, 3), __builtin_bit_cast(v2bf_t, hd[4 * q + 3]), db, false); } \
            D = (da + db) * __builtin_amdgcn_cvt_f32_fp8((int)us[S], 0); }
#define PG_VACC(S, Q) { const float wgt = __int_as_float(__builtin_amdgcn_readlane(__float_as_int(wv), Q)) * __builtin_amdgcn_cvt_f32_fp8((int)us[S], 1); const f32x2 w2 = (f32x2){wgt, wgt}; \
            _Pragma("unroll") for (int q = 0; q < 4; ++q) { \
              acc[q * 4 + 0] += w2 * __builtin_amdgcn_cvt_scalef32_pk_f32_fp4(va[S][q], 1.0f, 0); acc[q * 4 + 1] += w2 * __builtin_amdgcn_cvt_scalef32_pk_f32_fp4(va[S][q], 1.0f, 1); \
              acc[q * 4 + 2] += w2 * __builtin_amdgcn_cvt_scalef32_pk_f32_fp4(va[S][q], 1.0f, 2); acc[q * 4 + 3] += w2 * __builtin_amdgcn_cvt_scalef32_pk_f32_fp4(va[S][q], 1.0f, 3); } }
#define PG_GROUP(S0, K0, NU, NV) { const int k0_ = (K0); \
            asm volatile("s_waitcnt vmcnt(%8)" : "+v"(ua[S0]), "+v"(us[S0]), "+v"(ua[S0 + 1]), "+v"(us[S0 + 1]), "+v"(ua[S0 + 2]), "+v"(us[S0 + 2]), "+v"(ua[S0 + 3]), "+v"(us[S0 + 3]) : "n"(NU) : "memory"); \
            float dq0, dq1, dq2, dq3; PG_UDOT(S0, dq0) PG_UDOT(S0 + 1, dq1) PG_UDOT(S0 + 2, dq2) PG_UDOT(S0 + 3, dq3) \
            const float s01 = (b0 ? dq1 : dq0) + dpp_x1(b0 ? dq0 : dq1), s23 = (b0 ? dq3 : dq2) + dpp_x1(b0 ? dq2 : dq3); \
            float sd = (b1 ? s23 : s01) + dpp_x2(b1 ? s01 : s23); sd += dpp_ror4(sd); sd += dpp_ror8(sd); \
            sd += __int_as_float(__builtin_amdgcn_ds_bpermute(bp16, __float_as_int(sd))); sd += __int_as_float(__builtin_amdgcn_ds_bpermute(bp32, __float_as_int(sd))); sd *= 1.f / TSM; \
            const float gv = __int_as_float(__builtin_amdgcn_ds_bpermute(((k0_ & 63) + l3) * 4, __float_as_int(k0_ < 64 ? gt0 : gt1))); \
            const float wv = gv * (0.5f / TSM) * sd * (1.f + erf_bf(sd * 0.70710678118654752f));     \
            asm volatile("s_waitcnt vmcnt(%4)" : "+v"(va[S0]), "+v"(va[S0 + 1]), "+v"(va[S0 + 2]), "+v"(va[S0 + 3]) : "n"(NV) : "memory"); \
            PG_VACC(S0, 0) PG_VACC(S0 + 1, 1) PG_VACC(S0 + 2, 2) PG_VACC(S0 + 3, 3) }
        PG_LOADG(0, 0) PG_LOADG(4, 4)
#pragma unroll 1
        for (int k0 = 0; k0 < 120; k0 += 8) {
          PG_GROUP(0, k0, 16, 12) PG_LOADG(0, k0 + 8)
          PG_GROUP(4, k0 + 4, 16, 12) PG_LOADG(4, k0 + 12)
        }
        PG_GROUP(0, 120, 16, 12) PG_GROUP(4, 124, 4, 0)
#undef PG_LOADU0
#undef PG_LOADU
#undef PG_LOADV
#undef PG_LOADG
#undef PG_UDOT
#undef PG_VACC
#undef PG_GROUP
#undef DOT2
        int lane_e = lane; asm volatile("" : "+v"(lane_e));
        const float* g2p = p.mod + ((size_t)layer * 9 + (isc ? 8 : b)) * NMOD + 5 * DM + lane_e * 32; bf16_t* xr = p.Xb + (size_t)row * DM + lane_e * 32;
        f32x4 xn[8]; float ss = 0.f;
#pragma unroll
        for (int k = 0; k < 8; ++k) { const f32x4 sum = (f32x4){acc[2 * k][0], acc[2 * k][1], acc[2 * k + 1][0], acc[2 * k + 1][1]};
          const u32x2 xw = *(const u32x2*)(xr + k * 4); const f32x4 xo = (f32x4){__uint_as_float(xw.x << 16), __uint_as_float(xw.x & 0xffff0000u), __uint_as_float(xw.y << 16), __uint_as_float(xw.y & 0xffff0000u)};
          xn[k] = xo + *(const f32x4*)(g2p + k * 4) * sum; ss += xn[k][0] * xn[k][0] + xn[k][1] * xn[k][1] + xn[k][2] * xn[k][2] + xn[k][3] * xn[k][3]; }
        ss = wsum(ss); const float rstd = rsqrtf(ss * (1.f / 2048.f) + EPSV);
        if ((mode & 1) && rstd != 12345.678f) continue;
        if (layer == 0) { const float* mr = p.mod + ((size_t)9 + (isc ? 8 : b)) * NMOD + lane_e * 32;
#pragma unroll
          for (int k = 0; k < 8; k += 2) { { u32x4 xw; xw.x = pack2(xn[k][0], xn[k][1]); xw.y = pack2(xn[k][2], xn[k][3]); xw.z = pack2(xn[k + 1][0], xn[k + 1][1]); xw.w = pack2(xn[k + 1][2], xn[k + 1][3]); *(u32x4*)(xr + k * 4) = xw; }
            const f32x4 o0 = xn[k] * rstd * (*(const f32x4*)(mr + DM + k * 4) + 1.f) + *(const f32x4*)(mr + k * 4), o1 = xn[k + 1] * rstd * (*(const f32x4*)(mr + DM + k * 4 + 4) + 1.f) + *(const f32x4*)(mr + k * 4 + 4);
            u32x2 w; w.x = pk4_fp8(o0[0], o0[1], o0[2], o0[3]); w.y = pk4_fp8(o1[0], o1[1], o1[2], o1[3]); *(u32x2*)((unsigned char*)p.H + (size_t)row * DM + lane_e * 32 + k * 4) = w; } }
        else { float* orow = p.out + ((size_t)b * LL + t) * DM + lane_e * 32; const float* fn = p.final_norm + lane_e * 32;
#pragma unroll
          for (int k = 0; k < 8; ++k) *(f32x4*)(orow + k * 4) = xn[k] * rstd * *(const f32x4*)(fn + k * 4); }
      }
    }
    __syncthreads();
  }
#undef HVP
}

DI void st_mlacheck(const Prm& p, int layer, float* lds, int bid, int nb) {
  float* aq = lds; float* qv = aq + 448; float* qwn = qv + 192; float* scs = qwn + 128; float* rs = scs + 4352; float* Ak = rs + 4352; float* red = Ak + 128; float* ov = red + 64;
  const int tid = ltid(), lane = tid & 63, wave = tid >> 6;
  const int s = bid, b = s & 7, h = (s >> 3) & 3; const bool cq_ = (layer == 0) && s >= 224;
  const int t = cq_ ? (s * 37) % LCX : (s * 977 + 13) % LL; const int row = b * LT + (cq_ ? LL + t : t);
  const int nkeys = cq_ ? LCX : LT, krow0 = cq_ ? b * LT + LL : b * LT;
  const float* wuq = p.mla_w_uq + (size_t)layer * 448 * 768; const float* wukv = p.mla_w_ukv + (size_t)layer * 128 * 1024;
  const float* qn = p.mla_q_norm + layer * 448; const float* kvn = p.mla_kv_norm + layer * 128;
  __syncthreads();
  { float v = tid < 448 ? bf2f(p.Z[(size_t)row * NZ + C_CQ + tid]) : 0.f; float ss = wsum(v * v); if (lane == 0) red[wave] = ss; __syncthreads();
    float tot = 0.f; for (int w = 0; w < 8; ++w) tot += red[w]; const float rstd = rsqrtf(tot * (1.f / 448.f) + EPSV); if (tid < 448) aq[tid] = v * rstd * qn[tid]; }
  __syncthreads();
  if (tid < 192) { float a = 0.f; for (int k = 0; k < 448; ++k) a += aq[k] * wuq[(size_t)k * 768 + h * 192 + tid]; qv[tid] = a; }
  __syncthreads();
  if (!cq_ && tid < 32) { const int half = tid >> 4, i = tid & 15; const float x1 = qv[128 + half * 32 + i], x2 = qv[128 + half * 32 + 16 + i];
    const float pos = (float)(half ? (t & 63) : (t >> 6)); const float ang = pos * exp2f(-(float)i * (13.287712379549449f / 16.f)); float sv, cv; sincosf(ang, &sv, &cv);
    qv[128 + half * 32 + i] = x1 * cv - x2 * sv; qv[128 + half * 32 + 16 + i] = x2 * cv + x1 * sv; }
  __syncthreads();
  if (tid < 128) { float a = 0.f; for (int j = 0; j < 128; ++j) a += qv[j] * wukv[(size_t)tid * 1024 + h * 256 + j]; qwn[tid] = a * kvn[tid]; }
  __syncthreads();
  for (int ks = tid; ks < nkeys; ks += NTHR) { const int krow = krow0 + ks; const bf16_t* z = p.Z + (size_t)krow * NZ; float ss = 0.f, dn = 0.f;
    for (int k = 0; k < 128; ++k) { const float zz = bf2f(z[C_CKV + k]); ss += zz * zz; dn += zz * qwn[k]; }
    const float rstd = rsqrtf(ss * (1.f / 128.f) + EPSV); float dr = 0.f; const bool klat = !cq_ && ks < LL;
    for (int half = 0; half < 2; ++half) for (int i = 0; i < 16; ++i) { float x1 = bf2f(z[C_KR + half * 32 + i]), x2 = bf2f(z[C_KR + half * 32 + 16 + i]);
        if (klat) { const float pos = (float)(half ? (ks & 63) : (ks >> 6)); const float ang = pos * exp2f(-(float)i * (13.287712379549449f / 16.f)); float sv, cv; sincosf(ang, &sv, &cv); const float y1 = x1 * cv - x2 * sv, y2 = x2 * cv + x1 * sv; x1 = y1; x2 = y2; }
        dr += qv[128 + half * 32 + i] * x1 + qv[128 + half * 32 + 16 + i] * x2; }
    scs[ks] = (rstd * dn + dr) * 0.07216878364870322f; rs[ks] = rstd; }
  __syncthreads();
  float mx = -3e38f; for (int ks = tid; ks < nkeys; ks += NTHR) mx = fmaxf(mx, scs[ks]); mx = wmax(mx); if (lane == 0) red[wave] = mx; __syncthreads();
  mx = red[0]; for (int w = 1; w < 8; ++w) mx = fmaxf(mx, red[w]); __syncthreads();
  float sm = 0.f; for (int ks = tid; ks < nkeys; ks += NTHR) { const float e = __expf(scs[ks] - mx); scs[ks] = e; sm += e; } sm = wsum(sm); if (lane == 0) red[wave] = sm; __syncthreads();
  sm = 0.f; for (int w = 0; w < 8; ++w) sm += red[w];
  if (tid < 128) { float a = 0.f; for (int ks = 0; ks < nkeys; ++ks) a += scs[ks] * rs[ks] * bf2f(p.Z[(size_t)(krow0 + ks) * NZ + C_CKV + tid]); Ak[tid] = a * kvn[tid] / sm; }
  __syncthreads();
  if (tid < 128) { float a = 0.f; for (int k = 0; k < 128; ++k) a += Ak[k] * wukv[(size_t)k * 1024 + h * 256 + 128 + tid]; ov[tid] = a; }
  __syncthreads();
  if (tid < 128) { float am = 0.f; for (int j = 0; j < 128; ++j) am = fmaxf(am, fabsf(ov[j]));
    const float got = bf2f(p.Y[(size_t)row * DM + 1024 + h * 128 + tid]); const float err = fabsf(got - ov[tid]);
    if (!(err <= 0.06f * am + 1e-6f)) atomicAdd(p.bar + 4000, 1u); }
  __syncthreads();
}

DI void st_final(const Prm& p, int bid, int nb) {
  const int wave = ltid() >> 6, lane = ltid() & 63;
  for (int r = bid * 8 + wave; r < NB * LL; r += nb * 8) {
    const int b = r / LL, t = r - b * LL; const float* src = p.X + (size_t)(b * LT + t) * DM;
    f32x4 v[8]; float ss = 0.f;
#pragma unroll
    for (int i = 0; i < 8; ++i) { v[i] = *(const f32x4*)(src + (i * 64 + lane) * 4); ss += v[i][0] * v[i][0] + v[i][1] * v[i][1] + v[i][2] * v[i][2] + v[i][3] * v[i][3]; }
    ss = wsum(ss); const float rstd = rsqrtf(ss * (1.f / 2048.f) + EPSV);
#pragma unroll
    for (int i = 0; i < 8; ++i) { const int col = (i * 64 + lane) * 4; *(f32x4*)(p.out + (size_t)r * DM + col) = v[i] * rstd * *(const f32x4*)(p.final_norm + col); }
  }
}

namespace att {
constexpr int NW = 8, QBLK = 32, KVBLK = 64;
constexpr float SCALE = 0.07216878364870322f;
constexpr float THR = 8.f;
constexpr int LDQ = 768, LDK = 1024, LDKR = 64, LDO = DM;
constexpr int SHM_V = KVBLK * 128 * 2, SHM_K = KVBLK * 128 * 2, SHM_KR = KVBLK * 64 * 2, SHM_ATTN = 2 * SHM_V + 2 * SHM_K + 2 * SHM_KR + NW * 64 * 4;
#define KSWZ(row, colB) ((row) * 256 + ((colB) ^ (((row) & 7) << 4)))
#define KRSWZ(row, colB) ((row) * 128 + ((colB) ^ ((((row) >> 1) & 7) << 4)))
#define SBAR() __builtin_amdgcn_sched_barrier(0)
DI int crow(int r, int hi) { return (r & 3) + 8 * (r >> 2) + 4 * hi; }
DI unsigned cvtpk(float lo, float hi) { unsigned r; asm volatile("v_cvt_pk_bf16_f32 %0, %1, %2" : "=v"(r) : "v"(lo), "v"(hi)); return r; }

DI void partialSM(f32x16& p0, f32x16& p1, float& m_reg, float& mn, float& alpha) {
  constexpr float C = SCALE * 1.4426950408889634f;
  float pmax = p0[0];
#pragma unroll
  for (int r = 1; r < 16; ++r) pmax = fmaxf(pmax, p0[r]);
#pragma unroll
  for (int r = 0; r < 16; ++r) pmax = fmaxf(pmax, p1[r]);
  { auto rr = __builtin_amdgcn_permlane32_swap(__float_as_uint(pmax), __float_as_uint(pmax), false, false);
    pmax = fmaxf(__uint_as_float(rr[0]), __uint_as_float(rr[1])); }
  if (__builtin_expect(__all(pmax - m_reg <= THR / SCALE), 1)) { mn = m_reg; alpha = 1.f; }
  else { mn = fmaxf(m_reg, pmax); alpha = __builtin_amdgcn_exp2f((m_reg - mn) * C); m_reg = mn; }
  const float mnC = -mn * C;
#pragma unroll
  for (int r = 0; r < 16; ++r) p0[r] = fmaf(p0[r], C, mnC);
#pragma unroll
  for (int r = 0; r < 16; ++r) p1[r] = fmaf(p1[r], C, mnC);
#pragma unroll
  for (int r = 0; r < 16; ++r) p0[r] = __builtin_amdgcn_exp2f(p0[r]);
}
DI void finishSM(f32x16& p0, f32x16& p1, float alpha, float& l_reg, bf16x8& pa0, bf16x8& pa1, bf16x8& pa2, bf16x8& pa3) {
#pragma unroll
  for (int r = 0; r < 16; ++r) p1[r] = __builtin_amdgcn_exp2f(p1[r]);
  float ps = 0;
#pragma unroll
  for (int r = 0; r < 16; ++r) ps += p0[r];
#pragma unroll
  for (int r = 0; r < 16; ++r) ps += p1[r];
  { auto rr = __builtin_amdgcn_permlane32_swap(__float_as_uint(ps), __float_as_uint(ps), false, false);
    ps = __uint_as_float(rr[0]) + __uint_as_float(rr[1]); }
  l_reg = l_reg * alpha + ps;
#define PK4(P, BASE, OUT) do { unsigned a0 = cvtpk(P[BASE + 0], P[BASE + 1]), a1 = cvtpk(P[BASE + 2], P[BASE + 3]);   \
    unsigned b0 = cvtpk(P[BASE + 4], P[BASE + 5]), b1 = cvtpk(P[BASE + 6], P[BASE + 7]);                              \
    auto r0 = __builtin_amdgcn_permlane32_swap(a0, b0, false, false); auto r1 = __builtin_amdgcn_permlane32_swap(a1, b1, false, false); \
    u32x4 w = {r0[0], r1[0], r0[1], r1[1]}; OUT = *reinterpret_cast<bf16x8*>(&w); } while (0)
  PK4(p0, 0, pa0); PK4(p0, 8, pa1); PK4(p1, 0, pa2); PK4(p1, 8, pa3);
#undef PK4
}
DI void qkt(f32x16& p0, f32x16& p1, const char* Ks, const char* KRs, const bf16x8* qr, int r32, int hi) {
  p0 = f32x16{}; p1 = f32x16{};
#pragma unroll
  for (int d0 = 0; d0 < 8; ++d0) { const int cb = (d0 * 16 + hi * 8) * 2;
    const bf16x8 b0 = *reinterpret_cast<const bf16x8*>(Ks + KSWZ(r32, cb));
    const bf16x8 b1 = *reinterpret_cast<const bf16x8*>(Ks + KSWZ(32 + r32, cb));
    p0 = __builtin_amdgcn_mfma_f32_32x32x16_bf16(b0, qr[d0], p0, 0, 0, 0);
    p1 = __builtin_amdgcn_mfma_f32_32x32x16_bf16(b1, qr[d0], p1, 0, 0, 0); }
#pragma unroll
  for (int d0 = 0; d0 < 4; ++d0) { const int cb = (d0 * 16 + hi * 8) * 2;
    const bf16x8 b0 = *reinterpret_cast<const bf16x8*>(KRs + KRSWZ(r32, cb));
    const bf16x8 b1 = *reinterpret_cast<const bf16x8*>(KRs + KRSWZ(32 + r32, cb));
    p0 = __builtin_amdgcn_mfma_f32_32x32x16_bf16(b0, qr[8 + d0], p0, 0, 0, 0);
    p1 = __builtin_amdgcn_mfma_f32_32x32x16_bf16(b1, qr[8 + d0], p1, 0, 0, 0); }
}
DI int v_st(int k, int c) { const int kk = (k & ~0xC) | ((k & 4) << 1) | ((k & 8) >> 1); return ((kk >> 3) * 4 + (c >> 5)) * 512 + ((kk & 7) * 32 + (c & 31)) * 2; }
DI int v_rd_base(int lane) { return ((lane & 3) << 3) | (((lane >> 2) & 3) << 6) | (((lane >> 4) & 1) << 5) | (((lane >> 5) & 1) << 8); }
constexpr int v_rd_off(int d0, int ks, int half) { return d0 * 512 + ks * 4096 + half * 2048; }
template <int OFF> DI s16x4 tr_read(int vb) { s16x4 r; asm volatile("ds_read_b64_tr_b16 %0, %1 offset:%2" : "=&v"(r) : "v"(vb), "i"(OFF) : "memory"); return r; }
template <int D0> DI void pv_one(f32x16& od, int vb, bf16x8 pa0, bf16x8 pa1, bf16x8 pa2, bf16x8 pa3) {
  const s16x4 l0 = tr_read<v_rd_off(D0, 0, 0)>(vb), h0 = tr_read<v_rd_off(D0, 0, 1)>(vb), l1 = tr_read<v_rd_off(D0, 1, 0)>(vb), h1 = tr_read<v_rd_off(D0, 1, 1)>(vb);
  const s16x4 l2 = tr_read<v_rd_off(D0, 2, 0)>(vb), h2 = tr_read<v_rd_off(D0, 2, 1)>(vb), l3 = tr_read<v_rd_off(D0, 3, 0)>(vb), h3 = tr_read<v_rd_off(D0, 3, 1)>(vb);
  asm volatile("s_waitcnt lgkmcnt(0)" ::: "memory"); SBAR();
#define PK(L, H) (bf16x8){L[0], L[1], L[2], L[3], H[0], H[1], H[2], H[3]}
  od = __builtin_amdgcn_mfma_f32_32x32x16_bf16(pa0, PK(l0, h0), od, 0, 0, 0);
  od = __builtin_amdgcn_mfma_f32_32x32x16_bf16(pa1, PK(l1, h1), od, 0, 0, 0);
  od = __builtin_amdgcn_mfma_f32_32x32x16_bf16(pa2, PK(l2, h2), od, 0, 0, 0);
  od = __builtin_amdgcn_mfma_f32_32x32x16_bf16(pa3, PK(l3, h3), od, 0, 0, 0);
#undef PK
}
DI void pv_d0(f32x16* o, int vb, bf16x8 pa0, bf16x8 pa1, bf16x8 pa2, bf16x8 pa3) {
  pv_one<0>(o[0], vb, pa0, pa1, pa2, pa3); pv_one<1>(o[1], vb, pa0, pa1, pa2, pa3); pv_one<2>(o[2], vb, pa0, pa1, pa2, pa3); pv_one<3>(o[3], vb, pa0, pa1, pa2, pa3);
}

DI void attn_body(const bf16_t* __restrict__ Qb, const bf16_t* __restrict__ Kh, const bf16_t* __restrict__ Vh, const bf16_t* __restrict__ KRh, bf16_t* __restrict__ Ob, int seq, int tpos0, char* lds) {
  const int tid = ltid(), wid = tid >> 6, lane = tid & 63, r32 = lane & 31, hi = lane >> 5;
  char* V_lds = lds; char* K_lds = lds + 2 * SHM_V; char* KR_lds = lds + 2 * SHM_V + 2 * SHM_K;
  float* ws = (float*)(lds + 2 * SHM_V + 2 * SHM_K + 2 * SHM_KR) + wid * 64; float* li_l = ws; float* al_l = ws + 32;
  float m_reg = -1e30f, l_reg = 0; f32x16 o[4] = {}; bf16x8 qr[12];
  const bf16_t* Qw = Qb + (long)(wid * QBLK + r32) * LDQ + hi * 8;
#pragma unroll
  for (int d0 = 0; d0 < 12; ++d0) qr[d0] = *reinterpret_cast<const bf16x8*>(Qw + d0 * 16);
  if (tpos0 >= 0) {
    const int t = tpos0 + wid * QBLK + r32;
#pragma unroll
    for (int hf = 0; hf < 2; ++hf) { const float pos = (float)(hf ? (t & 63) : (t >> 6));
#pragma unroll
      for (int j = 0; j < 8; ++j) { const float ang = pos * exp2f(-(float)(hi * 8 + j) * (13.287712379549449f / 16.f)); float sv, cv; sincosf(ang, &sv, &cv);
        const float x1 = bf2f((bf16_t)qr[8 + 2 * hf][j]), x2 = bf2f((bf16_t)qr[9 + 2 * hf][j]);
        qr[8 + 2 * hf][j] = (short)f2bf(x1 * cv - x2 * sv); qr[9 + 2 * hf][j] = (short)f2bf(x2 * cv + x1 * sv); } }
  }
  const int sr = tid >> 4, sc = (tid & 15) * 8, vst0 = v_st(sr, sc), vst1 = v_st(32 + sr, sc);
  const int krr = tid >> 3, krc = (tid & 7) * 8;
  const int vb0 = (int)(uintptr_t)V_lds + v_rd_base(lane);
  bf16x8 vs0, vs1, ks0, ks1, kr0;
#define SLOAD(k0) do { vs0 = *reinterpret_cast<const bf16x8*>(&Vh[(long)((k0) + sr) * LDK + sc]); vs1 = *reinterpret_cast<const bf16x8*>(&Vh[(long)((k0) + 32 + sr) * LDK + sc]); \
    ks0 = *reinterpret_cast<const bf16x8*>(&Kh[(long)((k0) + sr) * LDK + sc]); ks1 = *reinterpret_cast<const bf16x8*>(&Kh[(long)((k0) + 32 + sr) * LDK + sc]); \
    kr0 = *reinterpret_cast<const bf16x8*>(&KRh[(long)((k0) + krr) * LDKR + krc]); } while (0)
#define SWRITE(b) do { *(bf16x8*)(V_lds + (b) * SHM_V + vst0) = vs0; *(bf16x8*)(V_lds + (b) * SHM_V + vst1) = vs1; const int kc = sc * 2;               \
    *(bf16x8*)(K_lds + (b) * SHM_K + KSWZ(sr, kc)) = ks0; *(bf16x8*)(K_lds + (b) * SHM_K + KSWZ(32 + sr, kc)) = ks1;                       \
    *(bf16x8*)(KR_lds + (b) * SHM_KR + KRSWZ(krr, krc * 2)) = kr0; } while (0)
#define SWAIT() asm volatile("s_waitcnt vmcnt(0)" ::: "memory")
#define RESC(a) do { if (__any((a) < 1.f)) { if (hi == 0) al_l[r32] = (a); asm volatile("s_waitcnt lgkmcnt(0)" ::: "memory"); \
    _Pragma("unroll") for (int d = 0; d < 4; ++d) _Pragma("unroll") for (int r = 0; r < 16; ++r) o[d][r] *= al_l[crow(r, hi)]; } } while (0)
  f32x16 p0, p1; float mn, al; bf16x8 pa0, pa1, pa2, pa3; const int NT = seq / KVBLK;
  SLOAD(0); SWAIT(); SWRITE(0); __syncthreads();
  for (int j = 0; j < NT; ++j) {
    const int buf = j & 1; const bool more = j + 1 < NT;
    if (more) SLOAD((j + 1) * KVBLK);
    SBAR(); qkt(p0, p1, K_lds + buf * SHM_K, KR_lds + buf * SHM_KR, qr, r32, hi);
    partialSM(p0, p1, m_reg, mn, al); RESC(al);
    finishSM(p0, p1, al, l_reg, pa0, pa1, pa2, pa3); SBAR();
    pv_d0(o, vb0 + buf * SHM_V, pa0, pa1, pa2, pa3);
    if (more) { SWAIT(); SWRITE(buf ^ 1); }
    __syncthreads();
  }
  if (hi == 0) li_l[r32] = l_reg; asm volatile("s_waitcnt lgkmcnt(0)" ::: "memory");
  float rli[16];
#pragma unroll
  for (int r = 0; r < 16; ++r) rli[r] = __builtin_amdgcn_rcpf(li_l[crow(r, hi)]);
  bf16_t* Ow = Ob + (long)(wid * QBLK) * LDO;
#pragma unroll
  for (int r = 0; r < 16; ++r) { const int orow = crow(r, hi);
#pragma unroll
    for (int d0 = 0; d0 < 4; ++d0) Ow[(long)orow * LDO + d0 * 32 + r32] = f2bf(o[d0][r] * rli[r]); }
  __syncthreads();
#undef SLOAD
#undef SWRITE
#undef SWAIT
#undef RESC
}
DI void qkt2(f32x16& p0, f32x16& p1, const char* Ks, const char* KRs, const char* QRs, const bf16x8* qr, int r32, int hi) {
  p0 = f32x16{}; p1 = f32x16{};
#pragma unroll
  for (int d0 = 0; d0 < 8; ++d0) { const int cb = (d0 * 16 + hi * 8) * 2;
    const bf16x8 b0 = *reinterpret_cast<const bf16x8*>(Ks + KSWZ(r32, cb));
    const bf16x8 b1 = *reinterpret_cast<const bf16x8*>(Ks + KSWZ(32 + r32, cb));
    p0 = __builtin_amdgcn_mfma_f32_32x32x16_bf16(b0, qr[d0], p0, 0, 0, 0);
    p1 = __builtin_amdgcn_mfma_f32_32x32x16_bf16(b1, qr[d0], p1, 0, 0, 0); }
#pragma unroll
  for (int d0 = 0; d0 < 4; ++d0) { const int cb = (d0 * 16 + hi * 8) * 2;
    const bf16x8 b0 = *reinterpret_cast<const bf16x8*>(KRs + KRSWZ(r32, cb));
    const bf16x8 b1 = *reinterpret_cast<const bf16x8*>(KRs + KRSWZ(32 + r32, cb));
    const bf16x8 qq = *reinterpret_cast<const bf16x8*>(QRs + KRSWZ(r32, cb));
    p0 = __builtin_amdgcn_mfma_f32_32x32x16_bf16(b0, qq, p0, 0, 0, 0);
    p1 = __builtin_amdgcn_mfma_f32_32x32x16_bf16(b1, qq, p1, 0, 0, 0); }
}
DI void attn_body2(const bf16_t* __restrict__ Qb, const bf16_t* __restrict__ Kh, const bf16_t* __restrict__ Vh, const bf16_t* __restrict__ KRh, unsigned char* __restrict__ Ob, int seq, int tpos0, char* lds) {
  const int tid = ltid(), wid = tid >> 6, lane = tid & 63, r32 = lane & 31, hi = lane >> 5;
  char* V_lds = lds; char* K_lds = lds + 2 * SHM_V; char* KR_lds = lds + 2 * SHM_V + 2 * SHM_K;
  float* ws = (float*)(lds + 2 * SHM_V + 2 * SHM_K + 2 * SHM_KR) + wid * 64; float* li_l = ws; float* al_l = ws + 32;
  float m_reg = -1e30f, l_reg = 0; f32x16 o[4] = {}; bf16x8 qr[12];
  char* QR_lds = lds + 2 * SHM_V + 2 * SHM_K + 2 * SHM_KR + NW * 64 * 4 + wid * 4096;
  const bf16_t* Qw = Qb + (long)(wid * QBLK + r32) * LDQ + hi * 8;
#pragma unroll
  for (int d0 = 0; d0 < 12; ++d0) qr[d0] = *reinterpret_cast<const bf16x8*>(Qw + d0 * 16);
  if (tpos0 >= 0) {
    const int t = tpos0 + wid * QBLK + r32;
#pragma unroll
    for (int hf = 0; hf < 2; ++hf) { const float pos = (float)(hf ? (t & 63) : (t >> 6));
#pragma unroll
      for (int j = 0; j < 8; ++j) { const float ang = pos * exp2f(-(float)(hi * 8 + j) * (13.287712379549449f / 16.f)); float sv, cv; sincosf(ang, &sv, &cv);
        const float x1 = bf2f((bf16_t)qr[8 + 2 * hf][j]), x2 = bf2f((bf16_t)qr[9 + 2 * hf][j]);
        qr[8 + 2 * hf][j] = (short)f2bf(x1 * cv - x2 * sv); qr[9 + 2 * hf][j] = (short)f2bf(x2 * cv + x1 * sv); } }
  }
#pragma unroll
  for (int d0 = 0; d0 < 4; ++d0) *(bf16x8*)(QR_lds + KRSWZ(r32, (d0 * 16 + hi * 8) * 2)) = qr[8 + d0];
  const int sr = tid >> 4, sc = (tid & 15) * 8, vst0 = v_st(sr, sc), vst1 = v_st(32 + sr, sc);
  const int krr = tid >> 3, krc = (tid & 7) * 8;
  const int vb0 = (int)(uintptr_t)V_lds + v_rd_base(lane);
  bf16x8 vs0, vs1, ks0, ks1, kr0;
#define SLOAD(k0) do { vs0 = *reinterpret_cast<const bf16x8*>(&Vh[(long)((k0) + sr) * LDK + sc]); vs1 = *reinterpret_cast<const bf16x8*>(&Vh[(long)((k0) + 32 + sr) * LDK + sc]); \
    ks0 = *reinterpret_cast<const bf16x8*>(&Kh[(long)((k0) + sr) * LDK + sc]); ks1 = *reinterpret_cast<const bf16x8*>(&Kh[(long)((k0) + 32 + sr) * LDK + sc]); \
    kr0 = *reinterpret_cast<const bf16x8*>(&KRh[(long)((k0) + krr) * LDKR + krc]); } while (0)
#define SWRITE(b) do { *(bf16x8*)(V_lds + (b) * SHM_V + vst0) = vs0; *(bf16x8*)(V_lds + (b) * SHM_V + vst1) = vs1; const int kc = sc * 2;               \
    *(bf16x8*)(K_lds + (b) * SHM_K + KSWZ(sr, kc)) = ks0; *(bf16x8*)(K_lds + (b) * SHM_K + KSWZ(32 + sr, kc)) = ks1;                       \
    *(bf16x8*)(KR_lds + (b) * SHM_KR + KRSWZ(krr, krc * 2)) = kr0; } while (0)
#define SWAIT() asm volatile("s_waitcnt vmcnt(0)" ::: "memory")
#define RESC(a) do { if (__any((a) < 1.f)) { if (hi == 0) al_l[r32] = (a); asm volatile("s_waitcnt lgkmcnt(0)" ::: "memory"); \
    _Pragma("unroll") for (int d = 0; d < 4; ++d) _Pragma("unroll") for (int r = 0; r < 16; ++r) o[d][r] *= al_l[crow(r, hi)]; } } while (0)
  f32x16 pA0, pA1, pB0, pB1; float mnA, mnB, alA, alB; bf16x8 pa0, pa1, pa2, pa3; const int NT = seq / KVBLK;
  SLOAD(0); SWAIT(); SWRITE(0); __syncthreads();
  qkt2(pA0, pA1, K_lds, KR_lds, QR_lds, qr, r32, hi); partialSM(pA0, pA1, m_reg, mnA, alA);
  SLOAD(KVBLK);
  SWAIT(); SWRITE(1); __syncthreads();
  for (int j = 1; j + 1 < NT; j += 2) {
    SBAR(); qkt2(pB0, pB1, K_lds + SHM_K, KR_lds + SHM_KR, QR_lds, qr, r32, hi);
    finishSM(pA0, pA1, alA, l_reg, pa0, pa1, pa2, pa3); SBAR();
    SLOAD((j + 1) * KVBLK); SBAR();
    pv_d0(o, vb0, pa0, pa1, pa2, pa3); partialSM(pB0, pB1, m_reg, mnB, alB);
    __syncthreads(); SWAIT(); SWRITE(0);
    RESC(alB); __syncthreads();
    SBAR(); qkt2(pA0, pA1, K_lds, KR_lds, QR_lds, qr, r32, hi);
    finishSM(pB0, pB1, alB, l_reg, pa0, pa1, pa2, pa3); SBAR();
    SLOAD((j + 2) * KVBLK); SBAR();
    pv_d0(o, vb0 + SHM_V, pa0, pa1, pa2, pa3); partialSM(pA0, pA1, m_reg, mnA, alA);
    __syncthreads(); SWAIT(); SWRITE(1);
    RESC(alA); __syncthreads();
  }
  SBAR(); qkt2(pB0, pB1, K_lds + SHM_K, KR_lds + SHM_KR, QR_lds, qr, r32, hi);
  finishSM(pA0, pA1, alA, l_reg, pa0, pa1, pa2, pa3); SBAR();
  pv_d0(o, vb0, pa0, pa1, pa2, pa3); partialSM(pB0, pB1, m_reg, mnB, alB);
  __syncthreads(); RESC(alB);
  finishSM(pB0, pB1, alB, l_reg, pa0, pa1, pa2, pa3); SBAR();
  pv_d0(o, vb0 + SHM_V, pa0, pa1, pa2, pa3);
  if (hi == 0) li_l[r32] = l_reg; asm volatile("s_waitcnt lgkmcnt(0)" ::: "memory");
  float rli[16];
#pragma unroll
  for (int r = 0; r < 16; ++r) rli[r] = __builtin_amdgcn_rcpf(li_l[crow(r, hi)]);
  unsigned char* Ow = Ob + (long)(wid * QBLK) * LDO;
#pragma unroll
  for (int r = 0; r < 16; ++r) { const int orow = crow(r, hi);
#pragma unroll
    for (int d0 = 0; d0 < 4; d0 += 2) { const int pk = __builtin_amdgcn_cvt_pk_fp8_f32(y8c(o[d0][r] * rli[r]), y8c(o[d0 + 1][r] * rli[r]), 0, false); Ow[(long)orow * LDO + d0 * 32 + r32] = (unsigned char)pk; Ow[(long)orow * LDO + (d0 + 1) * 32 + r32] = (unsigned char)(pk >> 8); } }
  __syncthreads();
#undef SLOAD
#undef SWRITE
#undef SWAIT
#undef RESC
}
}

DI void st_attn(const Prm& p, int layer, char* lds, int bid, int nb) {
  const int nlat = NB * 4 * 16, nitem = nlat + (layer == 0 ? NB * 4 : 0);
  for (int it = bid; it < nitem; it += nb) {
    if (it < nlat) {
      const int w = it & 255, j = (w >> 3) + 32 * (it >> 8), pair = (w & 7) + 8 * (j >> 4), qb = j & 15, b = pair >> 2, h = pair & 3; const size_t r0 = (size_t)b * LT;
      att::attn_body2(p.Qraw + (r0 + qb * 256) * 768 + h * 192, p.KV + r0 * 1024 + h * 256, p.KV + r0 * 1024 + h * 256 + 128, p.KR + r0 * 64,
                     (unsigned char*)p.Y + (r0 + qb * 256) * DM + 1024 + h * 128, LT, qb * 256, lds); }
    else { const int k = it - nlat, b = k >> 2, h = k & 3; const size_t r0 = (size_t)b * LT + LL;
      att::attn_body2(p.Qraw + r0 * 768 + h * 192, p.KV + r0 * 1024 + h * 256, p.KV + r0 * 1024 + h * 256 + 128, p.KR + r0 * 64, (unsigned char*)p.Y + r0 * DM + 1024 + h * 128, LCX, -1, lds); }
  }
}

struct EpiResid {
  static constexpr bool PERM = false, AFTER_DRAIN = false;
  const float* xlat; const float* xctx; bf16_t* X; const float* modl; int first;
  __device__ __forceinline__ void operator()(const pg8::f32x4 (&acc)[2][2][4][2], const pg8::Unit& u, int wr, int wc, int fr, int fq) const {
    const int b = u.pm / 17, tl = u.pm - b * 17; const bool isc = tl == 16;
    const float* g = modl + (size_t)(isc ? 8 : b) * NMOD + 2 * DM;
    const int rloc0 = wr * 64 + fr, col0 = u.pn * 256 + wc * 32 + 4 * fq;
    pg8::f32x4 gv[2][2];
#pragma unroll
    for (int bj = 0; bj < 2; ++bj)
#pragma unroll
      for (int n = 0; n < 2; ++n) gv[bj][n] = *(const pg8::f32x4*)(g + col0 + bj * 128 + n * 16);
#pragma unroll
    for (int ai = 0; ai < 2; ++ai)
#pragma unroll
      for (int m = 0; m < 4; ++m) { const int rl = rloc0 + ai * 128 + m * 16; const size_t row = (size_t)u.pm * 256 + rl;
        const float* src = isc ? xctx + ((size_t)b * LCX + rl) * DM : xlat + ((size_t)b * LL + tl * 256 + rl) * DM;
        bf16_t* dst = X + row * DM;
#pragma unroll
        for (int bj = 0; bj < 2; ++bj)
#pragma unroll
          for (int n = 0; n < 2; ++n) { const int c = col0 + bj * 128 + n * 16; pg8::f32x4 xo;
            if (first) xo = *(const pg8::f32x4*)(src + c);
            else { const u32x2 w = *(const u32x2*)(dst + c); xo = (pg8::f32x4){__uint_as_float(w.x << 16), __uint_as_float(w.x & 0xffff0000u), __uint_as_float(w.y << 16), __uint_as_float(w.y & 0xffff0000u)}; }
            const pg8::f32x4 o = xo + gv[bj][n] * acc[ai][bj][m][n]; u32x2 ow; ow.x = pack2(o[0], o[1]); ow.y = pack2(o[2], o[3]); *(u32x2*)(dst + c) = ow; } }
  }
};

struct EpiF8 {
  static constexpr bool PERM = true, AFTER_DRAIN = false;
  unsigned char* O; int ldc; int split_cols; size_t split_stride;
  __device__ __forceinline__ void operator()(const pg8::f32x4 (&acc)[2][2][4][2], const pg8::Unit& u, int wr, int wc, int fr, int fq) const {
    const int row0 = u.pm * 256 + wr * 64 + fr; int colt = u.pn * 256; unsigned char* base = O;
    if (split_cols) { const int t = colt / split_cols; base += (size_t)t * split_stride; colt -= t * split_cols; }
    const int col0 = colt + wc * 32 + 8 * fq;
#pragma unroll
    for (int ai = 0; ai < 2; ++ai)
#pragma unroll
      for (int m = 0; m < 4; ++m) { unsigned char* rowp = base + (size_t)(row0 + ai * 128 + m * 16) * ldc + col0;
#pragma unroll
        for (int bj = 0; bj < 2; ++bj) { const pg8::f32x4 a0 = acc[ai][bj][m][0], a1 = acc[ai][bj][m][1]; u32x2 w; w.x = pk4_fp8(y8c(a0[0]), y8c(a0[1]), y8c(a0[2]), y8c(a0[3])); w.y = pk4_fp8(y8c(a1[0]), y8c(a1[1]), y8c(a1[2]), y8c(a1[3]));
          *(u32x2*)(rowp + bj * 128) = w; } }
  }
};

struct LatentOrder : pg8::StaticOrder {
  __device__ bool next(int i, pg8::Unit& u) const { const bool ok = pg8::StaticOrder::next(i, u); u.pm += u.pm >> 4; return ok; }
};
template <class Epi> DI void run_gemm_lat(unsigned char* lds, const bf16_t* A, const bf16_t* Bt, int N, int K, const Epi& E, int bid, int nb) {
  pg8::Gemm g; g.A = A; g.Bt = Bt; g.M = NB * LL; g.N = N; g.K = K;
  LatentOrder S; S.init(NB * LL, N, nb, bid);
  pg8::gemm_phase<Epi, LatentOrder, false>((PG8_LAS unsigned char*)lds, g, S, E, nullptr);
}
template <class Epi> DI void run_gemm_f8(unsigned char* lds, const void* A8, const void* Bt8, int M, int N, int Kbytes, const Epi& E, int bid, int nb, const int ascale = pg8::W8_SCALE) {
  pg8::Gemm g; g.A = (const bf16_t*)A8; g.Bt = (const bf16_t*)Bt8; g.M = M; g.N = N; g.K = Kbytes / 2;
  pg8::StaticOrder S; S.init(M, N, nb, bid);
  pg8::gemm_phase_f8<Epi, pg8::StaticOrder, false>((PG8_LAS unsigned char*)lds, g, S, E, nullptr, ascale);
}
template <class Epi> DI void run_gemm_f8_lat(unsigned char* lds, const void* A8, const void* Bt8, int N, int Kbytes, const Epi& E, int bid, int nb, const int ascale = pg8::W8_SCALE) {
  pg8::Gemm g; g.A = (const bf16_t*)A8; g.Bt = (const bf16_t*)Bt8; g.M = NB * LL; g.N = N; g.K = Kbytes / 2;
  LatentOrder S; S.init(NB * LL, N, nb, bid);
  pg8::gemm_phase_f8<Epi, LatentOrder, false>((PG8_LAS unsigned char*)lds, g, S, E, nullptr, ascale);
}
template <class Epi> DI void run_gemm(unsigned char* lds, const bf16_t* A, const bf16_t* Bt, int M, int N, int K, const Epi& E, int bid, int nb) {
  pg8::Gemm g; g.A = A; g.Bt = Bt; g.M = M; g.N = N; g.K = K;
  pg8::StaticOrder S; S.init(M, N, nb, bid);
  pg8::gemm_phase<Epi, pg8::StaticOrder, false>((PG8_LAS unsigned char*)lds, g, S, E, nullptr);
}
DI pg8::EpiBf16<0> epi_bf16(bf16_t* O, int ldc, int split_cols = 0, size_t split_stride = 0) { pg8::EpiBf16<0> e; e.O = O; e.ldc = ldc; e.bias = nullptr; e.split_cols = split_cols; e.split_stride = split_stride; return e; }

#ifndef PROBE
#define PROBE 0
#endif
constexpr int LDS_MAIN = 131072 + 4096, LDS_TOTAL = LDS_MAIN + 64;
#define PRM() (*(const __attribute__((address_space(4))) Prm*)launder_k(kp))
typedef const __attribute__((address_space(4))) void* kptr_t;
DI kptr_t launder_k(kptr_t q) { asm volatile("" : "+s"(q)); return q; }
extern __shared__ __attribute__((aligned(16))) unsigned char shm[];
#define bid lsg(bid0)
#define nb lsg(nb0)
#define GRID_BAR() do { XcdBarrier b_; b_.bar = PRM().bar; b_.x = xb_xcc_id(); b_.st = (volatile LAS unsigned*)(shm + LDS_MAIN); xcd_barrier(b_); } while (0)
template <int l> DI void layer_body(kptr_t kp, const int bid0, const int nb0) {
#if defined(__HIP_DEVICE_COMPILE__)
    if (l == 0) { { const Prm p = PRM(); st_modulate(p, l, 0, p.H, bid, nb); } GRID_BAR(); }
    { const Prm p = PRM(); run_gemm_f8(shm, p.H, (const unsigned char*)p.WinT + (size_t)l * NZ * DM, MR, NZ, DM, epi_bf16(p.Z, NZ), bid, nb); }
    if (PROBE == 46) { const Prm p = PRM(); run_gemm_f8(shm, p.H, (const unsigned char*)p.WinT + (size_t)l * NZ * DM, MR, NZ, DM, epi_bf16(p.Z, NZ), bid, nb); }
    GRID_BAR();
    { const Prm p = PRM(); st_dnprep(p, l, bid, nb); }
    { const Prm p = PRM(); st_mlaprep(p, l, bid, nb); }
    { const Prm p = PRM(); st_fnchan(p, shm, bid, nb); }
    GRID_BAR();
    { const Prm p = PRM(); st_dntinv(p, shm, bid, nb); }
    __syncthreads();
    { const Prm p = PRM(); st_glabc(p, l, shm, bid, nb); }
    if (PROBE == 30) { GRID_BAR(); { const Prm p = PRM(); st_dnprep(p, l, bid, nb); } { const Prm p = PRM(); st_mlaprep(p, l, bid, nb); } { const Prm p = PRM(); st_fnchan(p, shm, bid, nb); } GRID_BAR();
      { const Prm p = PRM(); st_dntinv(p, shm, bid, nb); } __syncthreads(); { const Prm p = PRM(); st_glabc(p, l, shm, bid, nb); } }
    if (PROBE == 9) { { const Prm p = PRM(); st_dnprep(p, l, bid, nb); } { const Prm p = PRM(); st_mlaprep(p, l, bid, nb); } }
    if (PROBE == 10) { const Prm p = PRM(); st_fnchan(p, shm, bid, nb); }
    GRID_BAR();
    { const Prm p = PRM(); run_gemm(shm, p.Aq, p.WuqT + (size_t)l * 768 * 512, MR, 768, 512, epi_bf16(p.Qraw, 768), bid, nb); }
    { const Prm p = PRM(); run_gemm(shm, p.Akv, p.WukvT + (size_t)l * 1024 * 256, MR, 1024, 256, epi_bf16(p.KV, 1024), bid, nb); }
    if (bid < 128) { const Prm p = PRM(); st_dnscan(p, shm, bid, 128); }
    else { const Prm p = PRM(); st_glascan(p, l, shm, bid - 128, 128); }
    { const Prm p = PRM(); st_cvt_tables(p, l, bid, nb); }
    if (PROBE == 7) { GRID_BAR(); if (bid < 128) { const Prm p = PRM(); st_dnscan(p, shm, bid, 128); } }
    if (PROBE == 8) { GRID_BAR(); if (bid < 128) { const Prm p = PRM(); st_glascan(p, l, shm, bid, 128); } }
    if (PROBE == 2) { GRID_BAR(); if (bid < 128) { const Prm p = PRM(); st_dnscan(p, shm, bid, 128); } else { const Prm p = PRM(); st_glascan(p, l, shm, bid - 128, 128); } }
    GRID_BAR();
    { const Prm p = PRM(); st_attn(p, l, (char*)shm, bid, nb); }
    if (PROBE == 3) { const Prm p = PRM(); st_attn(p, l, (char*)shm, bid, nb); }
    { const Prm p = PRM(); st_fnfft(p, shm, bid, nb); }
    __syncthreads();
    if (l == 0) { const Prm p = PRM(); EpiF8 e8; e8.O = (unsigned char*)p.Y + (size_t)LL * DM + 1536; e8.ldc = DM; e8.split_cols = 512; e8.split_stride = (size_t)LT * DM; run_gemm(shm, p.DFTC, p.PQTc, 256, 4096, 512, e8, bid, nb); }
    { const Prm p = PRM(); st_combine(p, l, bid, nb); }
    if (PROBE == 43) { __syncthreads(); { const Prm p = PRM(); st_attn(p, l, (char*)shm, bid, nb); } { const Prm p = PRM(); st_fnfft(p, shm, bid, nb); } __syncthreads(); { const Prm p = PRM(); st_combine(p, l, bid, nb); } }
    GRID_BAR();
    { const Prm p = PRM(); EpiResid e; e.xlat = p.x; e.xctx = p.ctx; e.X = p.Xb; e.modl = p.mod + (size_t)l * 9 * NMOD; e.first = l == 0;
      if (l == 0) run_gemm_f8(shm, p.Y, (const unsigned char*)p.WoutT + (size_t)l * DM * DM, MR, DM, DM, e, bid, nb, 0x79797979);
      else run_gemm_f8_lat(shm, p.Y, (const unsigned char*)p.WoutT + (size_t)l * DM * DM, DM, DM, e, bid, nb, 0x79797979); }
    GRID_BAR();
    { const Prm p = PRM(); st_modulate(p, l, 1, p.H2, bid, nb); }
    if (PROBE == 42) { const Prm p = PRM(); st_modulate(p, l, 1, p.H2, bid, nb); }
    GRID_BAR();
    if (l == 0) { const Prm p = PRM(); run_gemm_f8(shm, p.H2q, (const unsigned char*)p.WqT + (size_t)l * DM * DM, MR, DM, DM, epi_bf16(p.Qp, DM), bid, nb); }
    else { const Prm p = PRM(); run_gemm_f8_lat(shm, p.H2q, (const unsigned char*)p.WqT + (size_t)l * DM * DM, DM, DM, epi_bf16(p.Qp, DM), bid, nb); }
    GRID_BAR();
    { const Prm p = PRM(); st_peer(p, l, shm, bid, nb); }
    if (l == 0) GRID_BAR();
    if (PROBE >= 50 && PROBE <= 59 && l == 0) { constexpr int md_[10] = {0, 1, 3, 7, 9, 17, 11, 41, 65, 0}; { const Prm p = PRM(); st_peer(p, l, shm, bid, nb, md_[PROBE - 50]); } GRID_BAR(); }
  #endif
}

__global__ void __launch_bounds__(NTHR, 2) mega(Prm p_unused) {
#if defined(__HIP_DEVICE_COMPILE__)
  kptr_t kp = (kptr_t)__builtin_amdgcn_kernarg_segment_ptr();
  const int bid0 = blockIdx.x, nb0 = gridDim.x;
  uint4* xbw = (uint4*)(shm + LDS_MAIN);
  if (threadIdx.x == 0) *xbw = make_uint4(0u, 0u, 0u, 0u);
  __syncthreads();
  { const Prm p = PRM(); (void)xcd_barrier_post(p.bar, (volatile LAS unsigned*)xbw); }
  float* lf = (float*)shm;
  for (int ly = 0; ly < 2; ++ly) { const Prm p = PRM();
    st_transpose8(p.w_in + (size_t)ly * DM * IN_W, (unsigned char*)p.WinT + (size_t)ly * NZ * DM, DM, IN_W, DM, NZ, 64.f, lf, bid, nb);
    st_transpose8(p.w_out + (size_t)ly * DM * DM, (unsigned char*)p.WoutT + (size_t)ly * DM * DM, DM, DM, DM, DM, 64.f, lf, bid, nb);
    st_transpose8(p.peer_wq + (size_t)ly * DM * DM, (unsigned char*)p.WqT + (size_t)ly * DM * DM, DM, DM, DM, DM, 64.f, lf, bid, nb);
    st_transpose(p.mla_w_uq + (size_t)ly * 448 * 768, p.WuqT + (size_t)ly * 768 * 512, 448, 768, 512, 768, lf, bid, nb);
    st_transpose(p.mla_w_ukv + (size_t)ly * 128 * 1024, p.WukvT + (size_t)ly * 1024 * 256, 128, 1024, 256, 1024, lf, bid, nb);
  }
  { const Prm p = PRM(); st_tables(p, bid, nb); }
  { const Prm p = PRM(); for (size_t e = (size_t)bid * NTHR + ltid(); e < (size_t)2 * 8 * 2 * 128 * 128; e += (size_t)nb * NTHR) p.KB16[e] = f2bf(p.peer_keys[e]); }
  __syncthreads();
  { const Prm p = PRM(); st_mods(p, lf, bid, nb); }
  if (PROBE == 5) { __syncthreads();
    for (int ly = 0; ly < 2; ++ly) { const Prm p = PRM();
      st_transpose8(p.w_in + (size_t)ly * DM * IN_W, (unsigned char*)p.WinT + (size_t)ly * NZ * DM, DM, IN_W, DM, NZ, 64.f, lf, bid, nb);
      st_transpose8(p.w_out + (size_t)ly * DM * DM, (unsigned char*)p.WoutT + (size_t)ly * DM * DM, DM, DM, DM, DM, 64.f, lf, bid, nb);
      st_transpose8(p.peer_wq + (size_t)ly * DM * DM, (unsigned char*)p.WqT + (size_t)ly * DM * DM, DM, DM, DM, DM, 64.f, lf, bid, nb);
      st_transpose(p.mla_w_uq + (size_t)ly * 448 * 768, p.WuqT + (size_t)ly * 768 * 512, 448, 768, 512, 768, lf, bid, nb);
      st_transpose(p.mla_w_ukv + (size_t)ly * 128 * 1024, p.WukvT + (size_t)ly * 1024 * 256, 128, 1024, 256, 1024, lf, bid, nb); }
    { const Prm p = PRM(); st_tables(p, bid, nb); }
    { const Prm p = PRM(); for (size_t e = (size_t)bid * NTHR + ltid(); e < (size_t)2 * 8 * 2 * 128 * 128; e += (size_t)nb * NTHR) p.KB16[e] = f2bf(p.peer_keys[e]); }
    __syncthreads();
    { const Prm p = PRM(); st_mods(p, lf, bid, nb); } }
  GRID_BAR();
  layer_body<0>(kp, bid0, nb0);
  layer_body<1>(kp, bid0, nb0);
  if (PROBE == 20) { GRID_BAR(); const Prm p = PRM(); if (bid == 0 && ltid() == 0 && __hip_atomic_load(p.bar + 4000, __ATOMIC_RELAXED, __HIP_MEMORY_SCOPE_AGENT) != 0u) p.out[0] = __builtin_nanf(""); }
#endif
#undef bid
#undef nb
#undef GRID_BAR
}

static size_t al256(size_t x) { return (x + 255) / 256 * 256; }
extern "C" void kernel_launch(void* const* d_in, const int* in_sizes, int n_in, void* d_out, int out_size, void* d_ws, size_t ws_size, hipStream_t stream) {
  Prm p{};
  const float** f = (const float**)&p.x;
  for (int i = 0; i < 24; ++i) f[i] = (const float*)d_in[i];
  p.out = (float*)d_out;
  char* w = (char*)d_ws; size_t o = 0;
  auto take = [&](size_t bytes) { char* r = w + o; o += al256(bytes); return r; };
  p.bar = (unsigned*)take(16384);
  p.WinT = (bf16_t*)take((size_t)2 * NZ * DM * 2); p.WoutT = (bf16_t*)take((size_t)2 * DM * DM * 2); p.WqT = (bf16_t*)take((size_t)2 * DM * DM * 2);
  p.WuqT = (bf16_t*)take((size_t)2 * 768 * 512 * 2); p.WukvT = (bf16_t*)take((size_t)2 * 1024 * 256 * 2);
  p.mod = (float*)take((size_t)2 * 9 * NMOD * 4); p.GB = (float*)take((size_t)MR * 16 * 4); p.CCS = (float*)take((size_t)2 * 128 * 128 * 4);
  p.DFTM = nullptr; p.DFTC = (bf16_t*)take((size_t)256 * 512 * 2); p.KB16 = (bf16_t*)take((size_t)2 * 8 * 2 * 128 * 128 * 2);
  p.X = nullptr; p.Xb = (bf16_t*)take((size_t)MR * DM * 2);
  p.Z = (bf16_t*)take((size_t)MR * NZ * 2);
  char* ra = take((size_t)MR * 1536 * 2 + (size_t)4 * MR * 512 * 2);
  p.DNQ = (bf16_t*)ra; p.OB = (bf16_t*)(ra + (size_t)MR * 1536 * 2); p.H = (bf16_t*)ra; p.H2q = (unsigned char*)ra + (size_t)MR * DM;
  p.KV = (bf16_t*)take((size_t)MR * 1024 * 2); p.KR = (bf16_t*)take((size_t)MR * 64 * 2);
  p.Aq = (bf16_t*)take((size_t)MR * 512 * 2); p.Akv = (bf16_t*)take((size_t)MR * 256 * 2);
  p.Ub = (bf16_t*)take((size_t)16384 * 2176); p.Vb = p.Ub;
  if (o > ws_size) return;
  char* q = (char*)d_out; size_t oo = 0;
  p.Y = (bf16_t*)q; oo += (size_t)MR * DM * 2; p.PQT = (bf16_t*)(q + oo); oo += (size_t)8 * 512 * 8192 * 2; p.PQTc = (bf16_t*)(q + oo); oo += (size_t)8 * 512 * 512 * 2;
  p.Qraw = (bf16_t*)(q + oo); oo += (size_t)MR * 768 * 2;
  p.TINV = (bf16_t*)q; p.GCB = (float*)(q + (size_t)4352 * 4096 * 2); p.BC = (float*)(q + (size_t)4352 * 4096 * 2 + (size_t)4352 * 64 * 4);
  char* z = (char*)p.Z; p.H2 = (bf16_t*)z; p.Qp = (bf16_t*)(z + (size_t)MR * DM * 2); p.IDX = (int*)(z + (size_t)2 * MR * DM * 2); p.GATE = (float*)(z + (size_t)2 * MR * DM * 2 + (size_t)MR * 128 * 4);

  static int grid = 0;
  if (!grid) {
    (void)hipFuncSetAttribute((const void*)mega, hipFuncAttributeMaxDynamicSharedMemorySize, LDS_TOTAL);
    int dev = 0, cus = 0, per_cu = 0;
    (void)hipGetDevice(&dev); (void)hipDeviceGetAttribute(&cus, hipDeviceAttributeMultiprocessorCount, dev);
    (void)hipOccupancyMaxActiveBlocksPerMultiprocessor(&per_cu, (const void*)mega, NTHR, LDS_TOTAL);
    grid = per_cu >= 1 ? cus : 0;
    if (grid > 256) grid = 256;
  }
  if (grid < 256) return;
  (void)hipMemsetAsync(p.bar, 0, 16384, stream);
  hipLaunchKernelGGL(mega, dim3(grid), dim3(NTHR), LDS_TOTAL, stream, p);
}
```

```cpp
#include <hip/hip_runtime.h>
#include <stdint.h>

constexpr int DM = 2048, NB = 8, LL = 4096, LCX = 256, LT = LL + LCX  , MR = NB * LT  ;
constexpr int NZ = 4864;
constexpr int C_DNQ = 0, C_DNK = 512, C_DNV = 1024, C_DNGATE = 1536, C_DNA = 2048, C_DNB = 2056, C_GQ = 2064, C_GK = 2320, C_GV = 2576,
              C_GGATE = 3088, C_GALPHA = 3600, C_CQ = 3632, C_CKV = 4080, C_KR = 4208, C_FN = 4272, IN_W = 4784;
constexpr int NMOD = 6 * DM;
constexpr float EPSV = 1e-6f;
constexpr int NTHR = 512;

typedef unsigned short bf16_t;
typedef short bf16x8 __attribute__((ext_vector_type(8)));
typedef short s16x4 __attribute__((ext_vector_type(4)));
typedef float f32x4 __attribute__((ext_vector_type(4)));
typedef float f32x16 __attribute__((ext_vector_type(16)));
typedef unsigned u32x4 __attribute__((ext_vector_type(4)));
typedef unsigned u32x2 __attribute__((ext_vector_type(2)));

#define DI __device__ __forceinline__
DI float bf2f(bf16_t b) { return __uint_as_float(((unsigned)b) << 16); }
DI bf16_t f2bf(float f) { unsigned u = __float_as_uint(f); u += 0x7FFFu + ((u >> 16) & 1u); return (bf16_t)(u >> 16); }
DI unsigned pack2(float lo, float hi) { return (unsigned)f2bf(lo) | ((unsigned)f2bf(hi) << 16); }
typedef float f32x2 __attribute__((ext_vector_type(2)));
DI float dpp_x1(float v) { return __int_as_float(__builtin_amdgcn_mov_dpp(__float_as_int(v), 0xB1, 0xf, 0xf, true)); }
DI float dpp_x2(float v) { return __int_as_float(__builtin_amdgcn_mov_dpp(__float_as_int(v), 0x4E, 0xf, 0xf, true)); }
DI float dpp_hm(float v) { return __int_as_float(__builtin_amdgcn_mov_dpp(__float_as_int(v), 0x141, 0xf, 0xf, true)); }
DI float dpp_rm(float v) { return __int_as_float(__builtin_amdgcn_mov_dpp(__float_as_int(v), 0x140, 0xf, 0xf, true)); }
DI float red4(float v) { v += dpp_x1(v); v += dpp_x2(v); return v; }
DI float red8(float v) { v += dpp_x1(v); v += dpp_x2(v); v += dpp_hm(v); return v; }
DI float rdl(float v, int l) { return __int_as_float(__builtin_amdgcn_readlane(__float_as_int(v), l)); }
DI float wsum(float v) { v += dpp_x1(v); v += dpp_x2(v); v += dpp_hm(v); v += dpp_rm(v); return (rdl(v, 0) + rdl(v, 16)) + (rdl(v, 32) + rdl(v, 48)); }
DI float wmax(float v) { v = fmaxf(v, dpp_x1(v)); v = fmaxf(v, dpp_x2(v)); v = fmaxf(v, dpp_hm(v)); v = fmaxf(v, dpp_rm(v)); return fmaxf(fmaxf(rdl(v, 0), rdl(v, 16)), fmaxf(rdl(v, 32), rdl(v, 48))); }
DI float siluf(float x) { return x / (1.f + __expf(-x)); }
DI float sigmf(float x) { return 1.f / (1.f + __expf(-x)); }

DI int ltid() { int t = (int)threadIdx.x; asm volatile("" : "+v"(t)); return t; }
DI int lsg(int v) { asm volatile("" : "+s"(v)); return v; }

struct Prm {
  const float *x, *c, *ctx, *c_ctx, *w_ada, *b_ada, *w_in, *dn_conv, *dn_a_log, *dn_dt_bias, *dn_norm, *gla_w2, *gla_b2, *gla_norm,
      *mla_q_norm, *mla_w_uq, *mla_kv_norm, *mla_w_ukv, *w_out, *peer_wq, *peer_keys, *peer_u, *peer_v, *final_norm;
  float* out;
  bf16_t *WinT, *WoutT, *WqT, *WuqT, *WukvT;
  float *mod, *GB, *CCS;
  bf16_t *DFTM, *DFTC;
  float* X;
  bf16_t* Z;
  bf16_t *H, *DNQ, *OB;
  bf16_t *KV, *KR;
  bf16_t *Y, *PQT, *PQTc, *Qraw, *Aq, *Akv;
  bf16_t *H2, *Qp;
  bf16_t *Ub, *Vb;
  bf16_t* TINV; float* GCB; float* BC;
  bf16_t* KB16;
  bf16_t* Xb;
  unsigned char* H2q;
  int* IDX;
  float* GATE;
  unsigned* bar;
};
#define XB_TMO      128
#define XB_XCNT(j)  (256  + 64 * (j))
#define XB_XSUB(j)  (1280 + 64 * (j))
#define XB_XGEN(j)  (2304 + 64 * (j))
#define XB_TOP      3328
#define XB_TOPGEN   3392
#define XCD_BAR_WORDS 3456
#define XB_SPIN_CAP (1u << 18)
#define LAS __attribute__((address_space(3)))

__device__ __forceinline__ unsigned xb_ld(unsigned* p)              { return __hip_atomic_load(p, __ATOMIC_RELAXED, __HIP_MEMORY_SCOPE_AGENT); }
__device__ __forceinline__ unsigned xb_add(unsigned* p, unsigned v) { return __hip_atomic_fetch_add(p, v, __ATOMIC_RELAXED, __HIP_MEMORY_SCOPE_AGENT); }
__device__ __forceinline__ unsigned xb_xcc_id() { return (unsigned)__builtin_amdgcn_s_getreg((3 << 11) | 20) & 0xFu; }
#define XB_SPIN(cond, bar) do { unsigned _sp = 0; while (cond) { __builtin_amdgcn_s_sleep(1); \
    if ((++_sp & 255u) == 0u) { if (xb_ld(&(bar)[XB_TMO])) break; if (_sp > XB_SPIN_CAP) { atomicAdd(&(bar)[XB_TMO], 1u); break; } } } } while (0)

struct XcdBarrier {
    unsigned* bar; unsigned x;
    volatile LAS unsigned* st;
};

__device__ __forceinline__ XcdBarrier xcd_barrier_post(unsigned* bar, volatile LAS unsigned* st) {
    XcdBarrier b; b.bar = bar; b.x = xb_xcc_id(); b.st = st;
    if (threadIdx.x == 0) (void)xb_add(&bar[XB_XCNT(b.x)], 1u);
    return b;
}
__device__ __forceinline__ void xcd_barrier_complete(unsigned* bar, unsigned x, unsigned& nloc, unsigned& nx) {
    const unsigned G = gridDim.x * gridDim.y * gridDim.z;
    unsigned sum, cnt, mine, sp = 0u;
    for (;;) {
        sum = 0u; cnt = 0u; mine = 0u;
#pragma unroll
        for (unsigned j = 0; j < 16; ++j) { const unsigned c = xb_ld(&bar[XB_XCNT(j)]); sum += c; cnt += (c > 0u) ? 1u : 0u; mine = (j == x) ? c : mine; }
        if (sum == G) break;
        __builtin_amdgcn_s_sleep(1);
        if ((++sp & 255u) == 0u) { if (xb_ld(&bar[XB_TMO])) break; if (sp > XB_SPIN_CAP) { atomicAdd(&bar[XB_TMO], 1u); break; } }
    }
    nloc = mine > 0u ? mine : 1u; nx = cnt > 0u ? cnt : 1u;
}

__device__ __forceinline__ void xcd_barrier(const XcdBarrier& b) {
    asm volatile("s_waitcnt vmcnt(0)" ::: "memory");
    __syncthreads();
    if (threadIdx.x == 0) {
        unsigned* bar = b.bar;
        __builtin_amdgcn_s_waitcnt(0);
        unsigned nloc = b.st[0], nx = b.st[1];
        if (nloc == 0u) { xcd_barrier_complete(bar, b.x, nloc, nx); b.st[0] = nloc; b.st[1] = nx; }
        const unsigned old = xb_add(&bar[XB_XSUB(b.x)], 1u);
        const unsigned gen = old / nloc;
        if (old + 1u == (gen + 1u) * nloc) {
            __builtin_amdgcn_fence(__ATOMIC_RELEASE, "agent");
            asm volatile("s_waitcnt vmcnt(0)" ::: "memory");
            const unsigned og = xb_add(&bar[XB_TOP], 1u);
            const unsigned tg = og / nx;
            if (og + 1u == (tg + 1u) * nx) xb_add(&bar[XB_TOPGEN], 1u);
            else XB_SPIN(xb_ld(&bar[XB_TOPGEN]) == tg, bar);
            __builtin_amdgcn_fence(__ATOMIC_ACQUIRE, "agent");
            xb_add(&bar[XB_XGEN(b.x)], 1u);
            asm volatile("s_waitcnt vmcnt(0)" ::: "memory");
        } else {
            XB_SPIN(xb_ld(&bar[XB_XGEN(b.x)]) == gen, bar);
            __builtin_amdgcn_fence(__ATOMIC_ACQUIRE, "agent");
            asm volatile("s_waitcnt vmcnt(0)" ::: "memory");
        }
    }
    __syncthreads();
}

namespace pg8 {
#define PG8_LAS __attribute__((address_space(3)))
typedef unsigned short bf16_t;
typedef short bf16x8 __attribute__((ext_vector_type(8)));
typedef float f32x4 __attribute__((ext_vector_type(4)));
typedef unsigned u32x4 __attribute__((ext_vector_type(4)));
constexpr int BM = 256, BK = 64, HALF = 128, HTB = HALF * BK * 2  , STAGE_BYTES = 8 * HTB, NXCD = 8, WGM = 8;

__host__ __device__ __forceinline__ int lds_byte(int r, int c) { const int st = (r >> 4) * 2 + (c >> 5), rr = r & 15, cc = c & 31, ob = rr * 64 + cc * 2; return st * 1024 + (ob ^ (((ob >> 9) & 1) << 5)); }
__host__ __device__ __forceinline__ void stage_rc(int b, int& R, int& C) { const int st = b / 1024, sb = b % 1024, swz = sb ^ (((sb >> 9) & 1) << 5); R = (st >> 1) * 16 + swz / 64; C = (st & 1) * 32 + (swz % 64) / 2; }
__host__ __device__ __forceinline__ int perm32(int rho) { const int n = rho >> 4, i = rho & 15; return 8 * (i >> 2) + 4 * n + (i & 3); }

struct Unit { int pm, pn; };
struct Gemm { const bf16_t* A; const bf16_t* Bt; int M, N, K; };

struct StaticOrder {
    int nM, nN, nwg, G, c;
    __host__ __device__ void init(int M, int N, int G_, int c_) { nM = M / BM; nN = N / BM; nwg = nM * nN; G = G_; c = c_; }
    __host__ __device__ bool next(int i, Unit& u) const {
        const long L = (long)i * G + c; if (L >= nwg) return false;
        int wgid = (int)L; { const int q = nwg / NXCD, r = nwg % NXCD, xcd = wgid % NXCD, off = wgid / NXCD; wgid = (xcd < r ? xcd * (q + 1) : r * (q + 1) + (xcd - r) * q) + off; }
        const int nig = WGM * nN, gid = wgid / nig, fm = gid * WGM, gsz = (nM - fm) < WGM ? (nM - fm) : WGM;
        u.pm = fm + ((wgid % nig) % gsz); u.pn = (wgid % nig) / gsz; return true;
    }
    __device__ __forceinline__ void a_ready(const Unit&) const {}
    __device__ __forceinline__ void done(const Unit&) const {}
};
struct CountedOrder : StaticOrder {
    const unsigned* ready; unsigned need; unsigned* tmo;
    __device__ __forceinline__ void a_ready(const Unit& u) const {
        if (threadIdx.x < 64) {
            const unsigned long long t0 = __builtin_amdgcn_s_memrealtime(); unsigned polls = 0;
            while ((unsigned)__builtin_amdgcn_readfirstlane(__hip_atomic_load(ready + 64 * u.pm, __ATOMIC_RELAXED, __HIP_MEMORY_SCOPE_AGENT)) < need) {
                if ((++polls & 255u) == 0u && __builtin_amdgcn_readfirstlane(__hip_atomic_load(tmo, __ATOMIC_RELAXED, __HIP_MEMORY_SCOPE_AGENT)) != 0u) break;
                if (__builtin_amdgcn_s_memrealtime() - t0 > 2000000ull) {
                    if (threadIdx.x == 0) { unsigned expect = 0u; __hip_atomic_compare_exchange_strong(tmo + 1, &expect, 0x600u | (unsigned)(u.pm & 0xff), __ATOMIC_RELAXED, __ATOMIC_RELAXED, __HIP_MEMORY_SCOPE_AGENT); __hip_atomic_store(tmo, 1u, __ATOMIC_RELAXED, __HIP_MEMORY_SCOPE_AGENT); }
                    break; }
                __builtin_amdgcn_s_sleep(2); }
            __builtin_amdgcn_fence(__ATOMIC_ACQUIRE, "agent");
            asm volatile("s_waitcnt vmcnt(0)" ::: "memory");
        }
#if !defined(BROKEN_HOOK_NO_BARRIER)
        asm volatile("" ::: "memory"); __builtin_amdgcn_s_barrier(); asm volatile("" ::: "memory");
#endif
    }
};

__device__ __forceinline__ unsigned cvt_pk_bf16(float lo, float hi) { unsigned r; asm volatile("v_cvt_pk_bf16_f32 %0, %1, %2" : "=v"(r) : "v"(lo), "v"(hi)); return r; }
typedef float f32x2 __attribute__((ext_vector_type(2)));
__device__ __forceinline__ f32x2 gelu_pk(f32x2 v) {
    const f32x2 av = __builtin_elementwise_abs(v), d = av * 0.2316418882f + 1.0f;
    f32x2 t; t.x = __builtin_amdgcn_rcpf(d.x); t.y = __builtin_amdgcn_rcpf(d.y);
    f32x2 q = t * 0.5307027145f + (-0.7265760135f); q = q * t + 0.7107068705f; q = q * t + (-0.142248368f); q = q * t + 0.127414796f; q = q * t;
    const f32x2 s = (v * v) * (-0.72134752044f);
    f32x2 e; e.x = __builtin_amdgcn_exp2f(s.x); e.y = __builtin_amdgcn_exp2f(s.y);
    const f32x2 m = v * (q * e), r = v - m;
    f32x2 o; o.x = v.x < 0.f ? m.x : r.x; o.y = v.y < 0.f ? m.y : r.y; return o;
}

struct EpiF32 {
    static constexpr bool PERM = false, AFTER_DRAIN = false;
    float* C; int ldc; const float* bias;
    __device__ __forceinline__ void operator()(const f32x4 (&acc)[2][2][4][2], const Unit& u, int wr, int wc, int fr, int fq) const {
        const int row0 = u.pm * BM + wr * 64 + fr, col0 = u.pn * BM + wc * 32 + 4 * fq;
        f32x4 bv[2][2];
#pragma unroll
        for (int bj = 0; bj < 2; ++bj)
#pragma unroll
            for (int n = 0; n < 2; ++n) bv[bj][n] = bias ? *(const f32x4*)(bias + col0 + bj * HALF + n * 16) : (f32x4){0.f, 0.f, 0.f, 0.f};
#pragma unroll
        for (int ai = 0; ai < 2; ++ai)
#pragma unroll
            for (int m = 0; m < 4; ++m) { float* rowp = C + (size_t)(row0 + ai * HALF + m * 16) * ldc + col0;
#pragma unroll
                for (int bj = 0; bj < 2; ++bj)
#pragma unroll
                    for (int n = 0; n < 2; ++n) *(f32x4*)(rowp + bj * HALF + n * 16) = acc[ai][bj][m][n] + bv[bj][n]; }
    }
};
template <int ACT  > struct EpiBf16 {
    static constexpr bool PERM = true, AFTER_DRAIN = false;
    bf16_t* O; int ldc; const float* bias; int split_cols; size_t split_stride;
    __device__ __forceinline__ void operator()(const f32x4 (&acc)[2][2][4][2], const Unit& u, int wr, int wc, int fr, int fq) const {
        const int row0 = u.pm * BM + wr * 64 + fr; int colt = u.pn * BM; bf16_t* base = O;
        if (split_cols) { const int t = colt / split_cols; base += (size_t)t * split_stride; colt -= t * split_cols; }
        const int col0 = colt + wc * 32 + 8 * fq, bcol0 = u.pn * BM + wc * 32 + 8 * fq;
        f32x4 bv[2][2];
#pragma unroll
        for (int bj = 0; bj < 2; ++bj)
#pragma unroll
            for (int n = 0; n < 2; ++n) bv[bj][n] = bias ? *(const f32x4*)(bias + bcol0 + bj * HALF + 4 * n) : (f32x4){0.f, 0.f, 0.f, 0.f};
#pragma unroll
        for (int ai = 0; ai < 2; ++ai)
#pragma unroll
            for (int m = 0; m < 4; ++m) { bf16_t* rowp = base + (size_t)(row0 + ai * HALF + m * 16) * ldc + col0;
#pragma unroll
                for (int bj = 0; bj < 2; ++bj) { f32x4 v0 = acc[ai][bj][m][0] + bv[bj][0], v1 = acc[ai][bj][m][1] + bv[bj][1];
                    if (ACT == 1) { f32x2 a = gelu_pk((f32x2){v0[0], v0[1]}), b = gelu_pk((f32x2){v0[2], v0[3]}), c = gelu_pk((f32x2){v1[0], v1[1]}), d = gelu_pk((f32x2){v1[2], v1[3]});
                        v0 = (f32x4){a.x, a.y, b.x, b.y}; v1 = (f32x4){c.x, c.y, d.x, d.y}; }
                    if (ACT == 2) {
#pragma unroll
                        for (int j = 0; j < 4; ++j) { v0[j] = 0.5f * v0[j] * (1.0f + erff(v0[j] * 0.70710678f)); v1[j] = 0.5f * v1[j] * (1.0f + erff(v1[j] * 0.70710678f)); } }
                    u32x4 w; w.x = cvt_pk_bf16(v0[0], v0[1]); w.y = cvt_pk_bf16(v0[2], v0[3]); w.z = cvt_pk_bf16(v1[0], v1[1]); w.w = cvt_pk_bf16(v1[2], v1[3]);
                    *(u32x4*)(rowp + bj * HALF) = w; } }
    }
};
template <class Epi, class Sched, bool STAMP = false>
__device__ __forceinline__ void gemm_phase(PG8_LAS unsigned char* lds, const Gemm g, const Sched& S, const Epi& E, unsigned long long* stamps) {
    const int tid = ltid(), wid = __builtin_amdgcn_readfirstlane(tid >> 6), lane = tid & 63, wr = wid >> 2, wc = wid & 3, fr = lane & 15, fq = lane >> 4;
    const int K = g.K, nt = K / BK;
    int ts_lo = 0, ts_hi = 0, nts = 0; const unsigned long long rt_entry = STAMP ? (unsigned long long)wall_clock64() : 0ull;
#define PG8_STAMP() do { if (STAMP && wid == 0 && nts < 64) { const unsigned long long _c = (unsigned long long)clock64(); \
        ts_lo = (lane == nts) ? (int)(unsigned)_c : ts_lo; ts_hi = (lane == nts) ? (int)(unsigned)(_c >> 32) : ts_hi; ++nts; } } while (0)
    PG8_STAMP();
    unsigned voffA[2], voffB[2];
#pragma unroll
    for (int i = 0; i < 2; ++i) { int R, C; stage_rc(tid * 16 + i * 8192, R, C); const int Rb = Epi::PERM ? ((R & ~31) + perm32(R & 31)) : R;
        voffA[i] = (unsigned)(R * K + C) * 2u; voffB[i] = (unsigned)(Rb * K + C) * 2u; }
    const size_t kstep = (size_t)(BK * 2);
    const size_t hstep = (size_t)HALF * K * 2;
    const size_t tstep = 2 * hstep;
    const unsigned ldsw = (unsigned)wid * 1024u;
    const int aoff = lds_byte(wr * 64 + fr, fq * 8), boff = lds_byte(wc * 32 + fr, fq * 8);
#define PG8_SA(b, h) (((b) * 2 + (h)) * HTB)
#define PG8_SB(b, h) ((4 + (b) * 2 + (h)) * HTB)
#define PG8_STAGE(bufoff, gbase, voff) do { _Pragma("unroll") for (int _i = 0; _i < 2; ++_i) \
        __builtin_amdgcn_global_load_lds((const unsigned*)((const char*)(gbase) + (voff)[_i]), (PG8_LAS unsigned*)(lds + (bufoff) + ldsw + _i * 8192), 16, 0, 0); } while (0)
#define PG8_LDA(dst, b, h) do { _Pragma("unroll") for (int m = 0; m < 4; ++m) _Pragma("unroll") for (int k = 0; k < 2; ++k) dst[m][k] = *(const PG8_LAS bf16x8*)(lds + PG8_SA(b, h) + aoff + m * 2048 + k * 1024); } while (0)
#define PG8_LDB(dst, b, h) do { _Pragma("unroll") for (int n = 0; n < 2; ++n) _Pragma("unroll") for (int k = 0; k < 2; ++k) dst[n][k] = *(const PG8_LAS bf16x8*)(lds + PG8_SB(b, h) + boff + n * 2048 + k * 1024); } while (0)
#define PG8_MMA(ai, bj, At, Bt) do { __builtin_amdgcn_s_setprio(1); _Pragma("unroll") for (int m = 0; m < 4; ++m) _Pragma("unroll") for (int n = 0; n < 2; ++n) _Pragma("unroll") for (int k = 0; k < 2; ++k) \
        acc[ai][bj][m][n] = __builtin_amdgcn_mfma_f32_16x16x32_bf16(Bt[n][k], At[m][k], acc[ai][bj][m][n], 0, 0, 0); __builtin_amdgcn_s_setprio(0); } while (0)
#define PG8_WAIT_V(n) asm volatile("s_waitcnt vmcnt(" #n ")" ::: "memory")
#define PG8_WAIT_L(n) asm volatile("s_waitcnt lgkmcnt(" #n ")" ::: "memory")
#define PG8_BAR __builtin_amdgcn_s_barrier()
#define PG8_SCHED __builtin_amdgcn_sched_barrier(0)
    Unit cur, nxt; int ui = 0;
    if (!S.next(0, cur)) return;
    f32x4 acc[2][2][4][2];
#pragma unroll
    for (int a = 0; a < 2; ++a)
#pragma unroll
        for (int b = 0; b < 2; ++b)
#pragma unroll
            for (int m = 0; m < 4; ++m)
#pragma unroll
                for (int n = 0; n < 2; ++n) acc[a][b][m][n] = (f32x4){0.f, 0.f, 0.f, 0.f};
    bf16x8 At[4][2], B0[2][2], B1[2][2];
    const char* cA = (const char*)g.A + (size_t)cur.pm * tstep; const char* cB = (const char*)g.Bt + (size_t)cur.pn * tstep;
    S.a_ready(cur);
    PG8_STAGE(PG8_SB(0, 0), cB, voffB); PG8_STAGE(PG8_SA(0, 0), cA, voffA); PG8_STAGE(PG8_SB(0, 1), cB + hstep, voffB); PG8_STAGE(PG8_SA(0, 1), cA + hstep, voffA);
    if (wr == 1) PG8_BAR;
    PG8_WAIT_V(4); PG8_BAR;
    PG8_STAGE(PG8_SB(1, 0), cB + kstep, voffB); PG8_STAGE(PG8_SA(1, 0), cA + kstep, voffA); PG8_STAGE(PG8_SB(1, 1), cB + hstep + kstep, voffB);
    PG8_WAIT_V(6); PG8_BAR;
    PG8_STAMP();
    for (;;) {
        const bool has_next = S.next(ui + 1, nxt);
        const char* nA = has_next ? (const char*)g.A + (size_t)nxt.pm * tstep : cA; const char* nB = has_next ? (const char*)g.Bt + (size_t)nxt.pn * tstep : cB;
        for (int t = 0; t < nt; t += 2) {
            const bool last = (t == nt - 2);
            const char* a1 = cA + (size_t)(t + 1) * kstep;
            const char* a2 = last ? nA : cA + (size_t)(t + 2) * kstep; const char* b2 = last ? nB : cB + (size_t)(t + 2) * kstep;
            const char* a3 = a2 + kstep; const char* b3 = b2 + kstep;
            if (last && has_next) S.a_ready(nxt);
            PG8_LDB(B0, 0, 0); PG8_SCHED; PG8_LDA(At, 0, 0); PG8_STAGE(PG8_SA(1, 1), a1 + hstep, voffA);
            PG8_WAIT_L(8); PG8_BAR; PG8_WAIT_L(0); PG8_MMA(0, 0, At, B0); PG8_BAR; PG8_SCHED;
            PG8_LDB(B1, 0, 1); PG8_STAGE(PG8_SB(0, 0), b2, voffB);
            PG8_BAR; PG8_WAIT_L(0); PG8_MMA(0, 1, At, B1); PG8_BAR;
            PG8_LDA(At, 0, 1); PG8_STAGE(PG8_SA(0, 0), a2, voffA);
            PG8_BAR; PG8_WAIT_L(0); PG8_MMA(1, 0, At, B0); PG8_BAR; PG8_SCHED;
            PG8_STAGE(PG8_SB(0, 1), b2 + hstep, voffB);
            PG8_WAIT_V(6); PG8_BAR; PG8_MMA(1, 1, At, B1); PG8_BAR;
            PG8_LDB(B0, 1, 0); PG8_SCHED; PG8_LDA(At, 1, 0); PG8_STAGE(PG8_SA(0, 1), a2 + hstep, voffA);
            PG8_WAIT_L(8); PG8_BAR; PG8_WAIT_L(0); PG8_MMA(0, 0, At, B0); PG8_BAR; PG8_SCHED;
            PG8_LDB(B1, 1, 1); PG8_STAGE(PG8_SB(1, 0), b3, voffB);
            PG8_BAR; PG8_WAIT_L(0); PG8_MMA(0, 1, At, B1); PG8_BAR;
            PG8_LDA(At, 1, 1); PG8_STAGE(PG8_SA(1, 0), a3, voffA);
            PG8_BAR; PG8_WAIT_L(0); PG8_MMA(1, 0, At, B0); PG8_BAR; PG8_SCHED;
            PG8_STAGE(PG8_SB(1, 1), b3 + hstep, voffB);
            PG8_WAIT_V(6); PG8_BAR; PG8_MMA(1, 1, At, B1); PG8_BAR;
        }
        PG8_STAMP();
        if constexpr (!Epi::AFTER_DRAIN) { E(acc, cur, wr, wc, fr, fq); S.done(cur); }
        PG8_STAMP();
        if (!has_next) break;
#pragma unroll
        for (int a = 0; a < 2; ++a)
#pragma unroll
            for (int b = 0; b < 2; ++b)
#pragma unroll
                for (int m = 0; m < 4; ++m)
#pragma unroll
                    for (int n = 0; n < 2; ++n) acc[a][b][m][n] = (f32x4){0.f, 0.f, 0.f, 0.f};
        cur = nxt; cA = nA; cB = nB; ++ui;
    }
    PG8_WAIT_V(0);
    if (wr == 0) PG8_BAR;
    PG8_BAR;
    if constexpr (Epi::AFTER_DRAIN) { E.fused(acc, cur, wr, wc, fr, fq, lds, wid, lane); S.done(cur); }
    PG8_STAMP();
    if (STAMP && wid == 0) { stamps[lane] = lane < nts ? (((unsigned long long)(unsigned)ts_hi << 32) | (unsigned)ts_lo) : 0ull;
        if (lane == 62) stamps[62] = rt_entry; if (lane == 63) stamps[63] = (unsigned long long)wall_clock64(); }
#undef PG8_STAMP
#undef PG8_SA
#undef PG8_SB
#undef PG8_STAGE
#undef PG8_LDA
#undef PG8_LDB
#undef PG8_MMA
#undef PG8_WAIT_V
#undef PG8_WAIT_L
#undef PG8_BAR
#undef PG8_SCHED
}
}
namespace pg8 {
typedef int v8i_t __attribute__((ext_vector_type(8)));
typedef int v4i_t __attribute__((ext_vector_type(4)));
constexpr int W8_SCALE = 0x7c7c7c7c;
__device__ __forceinline__ v8i_t cat16(bf16x8 a, bf16x8 b) { const v4i_t x = __builtin_bit_cast(v4i_t, a), y = __builtin_bit_cast(v4i_t, b); return (v8i_t){x[0], x[1], x[2], x[3], y[0], y[1], y[2], y[3]}; }
template <class Epi, class Sched, bool STAMP = false>
__device__ __forceinline__ void gemm_phase_f8(PG8_LAS unsigned char* lds, const Gemm g, const Sched& S, const Epi& E, unsigned long long* stamps, const int ascale = W8_SCALE) {
    const int tid = ltid(), wid = __builtin_amdgcn_readfirstlane(tid >> 6), lane = tid & 63, wr = wid >> 2, wc = wid & 3, fr = lane & 15, fq = lane >> 4;
    const int K = g.K, nt = K / BK;
    int ts_lo = 0, ts_hi = 0, nts = 0; const unsigned long long rt_entry = STAMP ? (unsigned long long)wall_clock64() : 0ull;
#define PG8_STAMP() do { if (STAMP && wid == 0 && nts < 64) { const unsigned long long _c = (unsigned long long)clock64(); \
        ts_lo = (lane == nts) ? (int)(unsigned)_c : ts_lo; ts_hi = (lane == nts) ? (int)(unsigned)(_c >> 32) : ts_hi; ++nts; } } while (0)
    PG8_STAMP();
    unsigned voffA[2], voffB[2];
#pragma unroll
    for (int i = 0; i < 2; ++i) { int R, C; stage_rc(tid * 16 + i * 8192, R, C); const int Rb = Epi::PERM ? ((R & ~31) + perm32(R & 31)) : R;
        voffA[i] = (unsigned)(R * K + C) * 2u; voffB[i] = (unsigned)(Rb * K + C) * 2u; }
    const size_t kstep = (size_t)(BK * 2);
    const size_t hstep = (size_t)HALF * K * 2;
    const size_t tstep = 2 * hstep;
    const unsigned ldsw = (unsigned)wid * 1024u;
    const int fh = fq >> 1;
    const int aoff0 = lds_byte(wr * 64 + fr, 16 * fq + 8 * fh), aoff1 = lds_byte(wr * 64 + fr, 16 * fq + 8 * (1 - fh)), boff0 = lds_byte(wc * 32 + fr, 16 * fq + 8 * fh), boff1 = lds_byte(wc * 32 + fr, 16 * fq + 8 * (1 - fh));
#define PG8_SA(b, h) (((b) * 2 + (h)) * HTB)
#define PG8_SB(b, h) ((4 + (b) * 2 + (h)) * HTB)
#define PG8_STAGE(bufoff, gbase, voff) do { _Pragma("unroll") for (int _i = 0; _i < 2; ++_i) \
        __builtin_amdgcn_global_load_lds((const unsigned*)((const char*)(gbase) + (voff)[_i]), (PG8_LAS unsigned*)(lds + (bufoff) + ldsw + _i * 8192), 16, 0, 0); } while (0)
#define PG8_LD8(a0, a1) __builtin_shufflevector(*(const PG8_LAS v4i_t*)(a0), *(const PG8_LAS v4i_t*)(a1), 0, 1, 2, 3, 4, 5, 6, 7)
#define PG8_LDA(dst, b, h) do { _Pragma("unroll") for (int m = 0; m < 4; ++m) dst[m] = PG8_LD8(lds + PG8_SA(b, h) + aoff0 + m * 2048, lds + PG8_SA(b, h) + aoff1 + m * 2048); } while (0)
#define PG8_LDB(dst, b, h) do { _Pragma("unroll") for (int n = 0; n < 2; ++n) dst[n] = PG8_LD8(lds + PG8_SB(b, h) + boff0 + n * 2048, lds + PG8_SB(b, h) + boff1 + n * 2048); } while (0)
#define PG8_MMA(ai, bj, At, Bt) do { __builtin_amdgcn_s_setprio(1); _Pragma("unroll") for (int m = 0; m < 4; ++m) _Pragma("unroll") for (int n = 0; n < 2; ++n) \
        asm volatile("v_mfma_scale_f32_16x16x128_f8f6f4 %0, %1, %2, %0, %3, %4 op_sel_hi:[0,0,0]" : "+v"(acc[ai][bj][m][n]) : "v"(Bt[n]), "v"(At[m]), "v"(w8s), "v"(a8s)); __builtin_amdgcn_s_setprio(0); } while (0)
#define PG8_WAIT_V(n) asm volatile("s_waitcnt vmcnt(" #n ")" ::: "memory")
#define PG8_WAIT_L(n) asm volatile("s_waitcnt lgkmcnt(" #n ")" ::: "memory")
#define PG8_BAR __builtin_amdgcn_s_barrier()
#define PG8_SCHED __builtin_amdgcn_sched_barrier(0)
    Unit cur, nxt; int ui = 0;
    if (!S.next(0, cur)) return;
    f32x4 acc[2][2][4][2];
#pragma unroll
    for (int a = 0; a < 2; ++a)
#pragma unroll
        for (int b = 0; b < 2; ++b)
#pragma unroll
            for (int m = 0; m < 4; ++m)
#pragma unroll
                for (int n = 0; n < 2; ++n) acc[a][b][m][n] = (f32x4){0.f, 0.f, 0.f, 0.f};
    v8i_t At[4], B0[2], B1[2]; const int w8s = W8_SCALE, a8s = ascale;
    const char* cA = (const char*)g.A + (size_t)cur.pm * tstep; const char* cB = (const char*)g.Bt + (size_t)cur.pn * tstep;
    S.a_ready(cur);
    PG8_STAGE(PG8_SB(0, 0), cB, voffB); PG8_STAGE(PG8_SA(0, 0), cA, voffA); PG8_STAGE(PG8_SB(0, 1), cB + hstep, voffB); PG8_STAGE(PG8_SA(0, 1), cA + hstep, voffA);
    if (wr == 1) PG8_BAR;
    PG8_WAIT_V(4); PG8_BAR;
    PG8_STAGE(PG8_SB(1, 0), cB + kstep, voffB); PG8_STAGE(PG8_SA(1, 0), cA + kstep, voffA); PG8_STAGE(PG8_SB(1, 1), cB + hstep + kstep, voffB);
    PG8_WAIT_V(6); PG8_BAR;
    PG8_STAMP();
    for (;;) {
        const bool has_next = S.next(ui + 1, nxt);
        const char* nA = has_next ? (const char*)g.A + (size_t)nxt.pm * tstep : cA; const char* nB = has_next ? (const char*)g.Bt + (size_t)nxt.pn * tstep : cB;
        for (int t = 0; t < nt; t += 2) {
            const bool last = (t == nt - 2);
            const char* a1 = cA + (size_t)(t + 1) * kstep;
            const char* a2 = last ? nA : cA + (size_t)(t + 2) * kstep; const char* b2 = last ? nB : cB + (size_t)(t + 2) * kstep;
            const char* a3 = a2 + kstep; const char* b3 = b2 + kstep;
            if (last && has_next) S.a_ready(nxt);
            PG8_LDB(B0, 0, 0); PG8_SCHED; PG8_LDA(At, 0, 0); PG8_STAGE(PG8_SA(1, 1), a1 + hstep, voffA);
            PG8_WAIT_L(8); PG8_BAR; PG8_WAIT_L(0); PG8_MMA(0, 0, At, B0); PG8_BAR; PG8_SCHED;
            PG8_LDB(B1, 0, 1); PG8_STAGE(PG8_SB(0, 0), b2, voffB);
            PG8_BAR; PG8_WAIT_L(0); PG8_MMA(0, 1, At, B1); PG8_BAR;
            PG8_LDA(At, 0, 1); PG8_STAGE(PG8_SA(0, 0), a2, voffA);
            PG8_BAR; PG8_WAIT_L(0); PG8_MMA(1, 0, At, B0); PG8_BAR; PG8_SCHED;
            PG8_STAGE(PG8_SB(0, 1), b2 + hstep, voffB);
            PG8_WAIT_V(6); PG8_BAR; PG8_MMA(1, 1, At, B1); PG8_BAR;
            PG8_LDB(B0, 1, 0); PG8_SCHED; PG8_LDA(At, 1, 0); PG8_STAGE(PG8_SA(0, 1), a2 + hstep, voffA);
            PG8_WAIT_L(8); PG8_BAR; PG8_WAIT_L(0); PG8_MMA(0, 0, At, B0); PG8_BAR; PG8_SCHED;
            PG8_LDB(B1, 1, 1); PG8_STAGE(PG8_SB(1, 0), b3, voffB);
            PG8_BAR; PG8_WAIT_L(0); PG8_MMA(0, 1, At, B1); PG8_BAR;
            PG8_LDA(At, 1, 1); PG8_STAGE(PG8_SA(1, 0), a3, voffA);
            PG8_BAR; PG8_WAIT_L(0); PG8_MMA(1, 0, At, B0); PG8_BAR; PG8_SCHED;
            PG8_STAGE(PG8_SB(1, 1), b3 + hstep, voffB);
            PG8_WAIT_V(6); PG8_BAR; PG8_MMA(1, 1, At, B1); PG8_BAR;
        }
        PG8_STAMP();
        asm volatile("s_nop 15\n\ts_nop 15" ::: "memory");
        if constexpr (!Epi::AFTER_DRAIN) { E(acc, cur, wr, wc, fr, fq); S.done(cur); }
        PG8_STAMP();
        if (!has_next) break;
#pragma unroll
        for (int a = 0; a < 2; ++a)
#pragma unroll
            for (int b = 0; b < 2; ++b)
#pragma unroll
                for (int m = 0; m < 4; ++m)
#pragma unroll
                    for (int n = 0; n < 2; ++n) acc[a][b][m][n] = (f32x4){0.f, 0.f, 0.f, 0.f};
        cur = nxt; cA = nA; cB = nB; ++ui;
    }
    PG8_WAIT_V(0);
    if (wr == 0) PG8_BAR;
    PG8_BAR;
    if constexpr (Epi::AFTER_DRAIN) { E.fused(acc, cur, wr, wc, fr, fq, lds, wid, lane); S.done(cur); }
    PG8_STAMP();
    if (STAMP && wid == 0) { stamps[lane] = lane < nts ? (((unsigned long long)(unsigned)ts_hi << 32) | (unsigned)ts_lo) : 0ull;
        if (lane == 62) stamps[62] = rt_entry; if (lane == 63) stamps[63] = (unsigned long long)wall_clock64(); }
#undef PG8_STAMP
#undef PG8_SA
#undef PG8_SB
#undef PG8_STAGE
#undef PG8_LDA
#undef PG8_LD8
#undef PG8_LDB
#undef PG8_MMA
#undef PG8_WAIT_V
#undef PG8_WAIT_L
#undef PG8_BAR
#undef PG8_SCHED
}
}

DI void st_transpose(const float* __restrict__ src, bf16_t* __restrict__ dst, int K, int N, int Kpad, int Npad, float* lds, int bid, int nb) {
  const int tk = Kpad / 64, tn = Npad / 64;
  for (int it = bid; it < tk * tn; it += nb) {
    const int k0 = (it % tk) * 64, n0 = (it / tk) * 64;
    __syncthreads();
    for (int e = ltid(); e < 4096; e += NTHR) { const int i = e >> 6, j = e & 63, k = k0 + i, n = n0 + j; lds[i * 65 + j] = (k < K && n < N) ? src[(size_t)k * N + n] : 0.f; }
    __syncthreads();
    { const int e = ltid(), j = e >> 3, i8 = (e & 7) * 8; u32x4 w;
      w.x = pack2(lds[i8 * 65 + j], lds[(i8 + 1) * 65 + j]); w.y = pack2(lds[(i8 + 2) * 65 + j], lds[(i8 + 3) * 65 + j]);
      w.z = pack2(lds[(i8 + 4) * 65 + j], lds[(i8 + 5) * 65 + j]); w.w = pack2(lds[(i8 + 6) * 65 + j], lds[(i8 + 7) * 65 + j]);
      *(u32x4*)(dst + (size_t)(n0 + j) * Kpad + k0 + i8) = w; }
  }
}

constexpr float Y8S = 8.f;
DI float y8c(float y) { return __builtin_amdgcn_fmed3f(y * Y8S, -448.f, 448.f); }
DI float c8(float x) { return __builtin_amdgcn_fmed3f(x, -448.f, 448.f); }
DI unsigned pk4_fp8(float a, float b, float c, float d) { int r = 0; r = __builtin_amdgcn_cvt_pk_fp8_f32(c8(a), c8(b), r, false); r = __builtin_amdgcn_cvt_pk_fp8_f32(c8(c), c8(d), r, true); return (unsigned)r; }
DI void st_transpose8(const float* __restrict__ src, unsigned char* __restrict__ dst, int K, int N, int Kpad, int Npad, float sc, float* lds, int bid, int nb) {
  const int tk = Kpad / 64, tn = Npad / 64;
  for (int it = bid; it < tk * tn; it += nb) {
    const int k0 = (it % tk) * 64, n0 = (it / tk) * 64;
    __syncthreads();
    for (int e = ltid(); e < 4096; e += NTHR) { const int i = e >> 6, j = e & 63, k = k0 + i, n = n0 + j; lds[i * 65 + j] = (k < K && n < N) ? src[(size_t)k * N + n] * sc : 0.f; }
    __syncthreads();
    { const int e = ltid(), j = e >> 3, i8 = (e & 7) * 8; u32x2 w;
      w.x = pk4_fp8(lds[i8 * 65 + j], lds[(i8 + 1) * 65 + j], lds[(i8 + 2) * 65 + j], lds[(i8 + 3) * 65 + j]); w.y = pk4_fp8(lds[(i8 + 4) * 65 + j], lds[(i8 + 5) * 65 + j], lds[(i8 + 6) * 65 + j], lds[(i8 + 7) * 65 + j]);
      *(u32x2*)(dst + (size_t)(n0 + j) * Kpad + k0 + i8) = w; }
  }
}

DI void st_mods(const Prm& p, float* lds, int bid, int nb) {
  float* s = lds; float* red = lds + 9 * 2048;
  for (int e = ltid(); e < 9 * 2048; e += NTHR) { const int r = e >> 11, k = e & 2047; const float v = r < 8 ? p.c[r * 2048 + k] : p.c_ctx[k]; s[e] = siluf(v); }
  __syncthreads();
  const int kg = ltid() >> 6, cl = ltid() & 63;
  for (int it = bid; it < 2 * 192; it += nb) {
    const int l = it / 192, cb = (it % 192) * 64;
    const float* w = p.w_ada + (size_t)l * 2048 * NMOD + cb + cl;
    float acc[9];
#pragma unroll
    for (int r = 0; r < 9; ++r) acc[r] = 0.f;
    for (int k0 = kg * 256; k0 < kg * 256 + 256; k0 += 16) { float wv[16];
#pragma unroll
      for (int i = 0; i < 16; ++i) wv[i] = w[(size_t)(k0 + i) * NMOD];
#pragma unroll
      for (int i = 0; i < 16; ++i)
#pragma unroll
        for (int r = 0; r < 9; ++r) acc[r] += s[r * 2048 + k0 + i] * wv[i]; }
#pragma unroll
    for (int r = 0; r < 9; ++r) red[(kg * 9 + r) * 64 + cl] = acc[r];
    __syncthreads();
    for (int e = ltid(); e < 576; e += NTHR) { const int r = e >> 6, c2 = e & 63; float t = 0.f;
      for (int g = 0; g < 8; ++g) t += red[(g * 9 + r) * 64 + c2];
      p.mod[((size_t)l * 9 + r) * NMOD + cb + c2] = t + p.b_ada[l * NMOD + cb + c2]; }
    __syncthreads();
  }
}

DI void st_tables(const Prm& p, int bid, int nb) {
  const size_t stride = (size_t)nb * NTHR, t0 = (size_t)bid * NTHR + ltid();
  for (size_t e = t0; e < (size_t)256 * 512; e += stride) { const int k1 = (int)(e >> 9), n = (int)(e & 511), n1 = n & 255, idx = (k1 * n1) & 255;
    float sv, cv; sincosf((float)idx * (6.283185307179586f / 256.f), &sv, &cv); p.DFTC[e] = f2bf((n < 256 ? cv : -sv) * (1.f / 16.f)); }
  for (size_t e = t0; e < (size_t)2 * 128 * 128; e += stride) { const int tb = (int)(e >> 14), k2 = (int)((e >> 7) & 127), n2 = (int)(e & 127), idx = (k2 * n2) & 127;
    float sv, cv; sincosf((float)idx * (6.283185307179586f / 128.f), &sv, &cv); p.CCS[e] = (tb ? sv : cv) * 0.08838834764831845f; }
}

DI void st_modulate(const Prm& p, int layer, int which, bf16_t* __restrict__ dst, int bid, int nb) {
  const int wave = ltid() >> 6, lane = ltid() & 63;
  const int shoff = which ? 3 * DM : 0, scoff = which ? 4 * DM : DM;
  for (int row = bid * 8 + wave; row < MR; row += nb * 8) {
    const int b = row / LT, t = row - b * LT; const bool isc = t >= LL;
    if (isc && layer == 1 && which == 1) continue;
    const float* src = isc ? p.ctx + (size_t)(b * LCX + t - LL) * DM : p.x + (size_t)(b * LL + t) * DM;
    f32x4 v[8]; float ss = 0.f;
#pragma unroll
    for (int i = 0; i < 8; ++i) {
      if (layer == 0 && which == 0) v[i] = *(const f32x4*)(src + (i * 64 + lane) * 4);
      else { const u32x2 w = *(const u32x2*)(p.Xb + (size_t)row * DM + (i * 64 + lane) * 4); v[i] = (f32x4){__uint_as_float(w.x << 16), __uint_as_float(w.x & 0xffff0000u), __uint_as_float(w.y << 16), __uint_as_float(w.y & 0xffff0000u)}; }
      ss += v[i][0] * v[i][0] + v[i][1] * v[i][1] + v[i][2] * v[i][2] + v[i][3] * v[i][3]; }
    ss = wsum(ss); const float rstd = rsqrtf(ss * (1.f / 2048.f) + EPSV);
    const float* mr = p.mod + ((size_t)layer * 9 + (isc ? 8 : b)) * NMOD;
#pragma unroll
    for (int i = 0; i < 8; ++i) { const int col = (i * 64 + lane) * 4; const f32x4 sc = *(const f32x4*)(mr + scoff + col), sh = *(const f32x4*)(mr + shoff + col);
      const f32x4 o = v[i] * rstd * (sc + 1.f) + sh;
      if (which == 0) *(unsigned*)((unsigned char*)dst + (size_t)row * DM + col) = pk4_fp8(o[0], o[1], o[2], o[3]);
      else *(unsigned*)(p.H2q + (size_t)row * DM + col) = pk4_fp8(o[0], o[1], o[2], o[3]); }
  }
}

DI void st_dnprep(const Prm& p, int layer, int bid, int nb) {
  const int wave = ltid() >> 6, lane = ltid() & 63;
  const float* conv = p.dn_conv + (size_t)layer * 5 * 1536;
  for (int task = bid * 8 + wave; task < (MR / 32) * 13; task += nb * 8) {
    const int tile = task / 13, grp = task - tile * 13, row0 = tile * 32;
    const int b = row0 / LT, t0 = row0 - b * LT; const bool isc = t0 >= LL;
    const int segt0 = isc ? t0 - LL : t0, seglen = isc ? LCX : LL;
    if (grp < 12) {
      const int c = grp * 128 + lane * 2;
      float w0[5], w1[5];
#pragma unroll
      for (int j = 0; j < 5; ++j) { w0[j] = conv[j * 1536 + c]; w1[j] = conv[j * 1536 + c + 1]; }
      unsigned zz[36];
#pragma unroll
      for (int r = 0; r < 36; ++r) { const int tt = segt0 + r - 2; zz[r] = (tt >= 0 && tt < seglen) ? *(const unsigned*)(p.Z + (size_t)(row0 + r - 2) * NZ + c) : 0u; }
#pragma unroll
      for (int r = 0; r < 32; ++r) { float a0 = 0.f, a1 = 0.f;
#pragma unroll
        for (int j = 0; j < 5; ++j) { a0 += __uint_as_float(zz[r + j] << 16) * w0[j]; a1 += __uint_as_float(zz[r + j] & 0xffff0000u) * w1[j]; }
        a0 = siluf(a0); a1 = siluf(a1);
        if (grp < 8) { const float ss = wsum(a0 * a0 + a1 * a1); const float sc = rsqrtf(ss + EPSV) * (grp < 4 ? 0.08838834764831845f : 1.f); a0 *= sc; a1 *= sc; }
        *(unsigned*)(p.DNQ + (size_t)(row0 + r) * 1536 + c) = pack2(a0, a1); }
    } else {
#pragma unroll
      for (int rr = 0; rr < 8; ++rr) { const int idx = lane + 64 * rr, row = row0 + (idx >> 4), wh = idx & 15, isb = wh >> 3, dh = wh & 7;
        const float z = bf2f(p.Z[(size_t)row * NZ + (isb ? C_DNB : C_DNA) + dh]); float o;
        if (!isb) { const float xx = z + p.dn_dt_bias[layer * 8 + dh]; const float sp = xx > 20.f ? xx : log1pf(expf(xx)); o = -expf(p.dn_a_log[layer * 8 + dh]) * sp; }
        else o = sigmf(z);
        p.GB[(size_t)row * 16 + wh] = o; }
    }
  }
}

DI void st_mlaprep(const Prm& p, int layer, int bid, int nb) {
  const int wave = ltid() >> 6, lane = ltid() & 63;
  const float* qn = p.mla_q_norm + layer * 448; const float* kvn = p.mla_kv_norm + layer * 128;
  for (int row = bid * 8 + wave; row < MR; row += nb * 8) {
    const bf16_t* z = p.Z + (size_t)row * NZ; const int b = row / LT, t = row - b * LT;
    float v[8]; float ss = 0.f;
#pragma unroll
    for (int k = 0; k < 8; ++k) v[k] = 0.f;
    if (lane < 56) { const u32x4 w = *(const u32x4*)(z + C_CQ + lane * 8);
#pragma unroll
      for (int k = 0; k < 4; ++k) { v[2 * k] = __uint_as_float(w[k] << 16); v[2 * k + 1] = __uint_as_float(w[k] & 0xffff0000u); ss += v[2 * k] * v[2 * k] + v[2 * k + 1] * v[2 * k + 1]; } }
    ss = wsum(ss); float rstd = rsqrtf(ss * (1.f / 448.f) + EPSV);
    { u32x4 o = {0u, 0u, 0u, 0u};
      if (lane < 56) { const f32x4 n0 = *(const f32x4*)(qn + lane * 8), n1 = *(const f32x4*)(qn + lane * 8 + 4);
        o.x = pack2(v[0] * rstd * n0[0], v[1] * rstd * n0[1]); o.y = pack2(v[2] * rstd * n0[2], v[3] * rstd * n0[3]); o.z = pack2(v[4] * rstd * n1[0], v[5] * rstd * n1[1]); o.w = pack2(v[6] * rstd * n1[2], v[7] * rstd * n1[3]); }
      *(u32x4*)(p.Aq + (size_t)row * 512 + lane * 8) = o; }
    ss = 0.f;
    if (lane < 16) { const u32x4 w = *(const u32x4*)(z + C_CKV + lane * 8);
#pragma unroll
      for (int k = 0; k < 4; ++k) { v[2 * k] = __uint_as_float(w[k] << 16); v[2 * k + 1] = __uint_as_float(w[k] & 0xffff0000u); ss += v[2 * k] * v[2 * k] + v[2 * k + 1] * v[2 * k + 1]; } }
    ss = wsum(ss); rstd = rsqrtf(ss * (1.f / 128.f) + EPSV);
    if (lane < 32) { u32x4 o = {0u, 0u, 0u, 0u};
      if (lane < 16) { const f32x4 n0 = *(const f32x4*)(kvn + lane * 8), n1 = *(const f32x4*)(kvn + lane * 8 + 4);
        o.x = pack2(v[0] * rstd * n0[0], v[1] * rstd * n0[1]); o.y = pack2(v[2] * rstd * n0[2], v[3] * rstd * n0[3]); o.z = pack2(v[4] * rstd * n1[0], v[5] * rstd * n1[1]); o.w = pack2(v[6] * rstd * n1[2], v[7] * rstd * n1[3]); }
      *(u32x4*)(p.Akv + (size_t)row * 256 + lane * 8) = o; }
    if (t < LL) {
      if (lane < 32) { const int half = lane >> 4, i = lane & 15; const float x1 = bf2f(z[C_KR + half * 32 + i]), x2 = bf2f(z[C_KR + half * 32 + 16 + i]);
        const float pos = (float)(half ? (t & 63) : (t >> 6)); const float ang = pos * exp2f(-(float)i * (13.287712379549449f / 16.f)); float sv, cv; sincosf(ang, &sv, &cv);
        p.KR[(size_t)row * 64 + half * 32 + i] = f2bf(x1 * cv - x2 * sv); p.KR[(size_t)row * 64 + half * 32 + 16 + i] = f2bf(x2 * cv + x1 * sv); }
    } else p.KR[(size_t)row * 64 + lane] = z[C_KR + lane];
  }
}

DI void st_qrope(const Prm& p, int bid, int nb) {
  const int wave = ltid() >> 6, lane = ltid() & 63;
  for (int row = bid * 8 + wave; row < MR; row += nb * 8) {
    const int b = row / LT, t = row - b * LT; if (t >= LL) continue;
#pragma unroll
    for (int k = 0; k < 2; ++k) { const int pid = lane + 64 * k, h = pid >> 5, r = pid & 31, half = r >> 4, i = r & 15;
      bf16_t* q = p.Qraw + (size_t)row * 768 + h * 192 + 128 + half * 32; const float x1 = bf2f(q[i]), x2 = bf2f(q[16 + i]);
      const float pos = (float)(half ? (t & 63) : (t >> 6)); const float ang = pos * exp2f(-(float)i * (13.287712379549449f / 16.f)); float sv, cv; sincosf(ang, &sv, &cv);
      q[i] = f2bf(x1 * cv - x2 * sv); q[16 + i] = f2bf(x2 * cv + x1 * sv); }
  }
}

DI void st_fnchan(const Prm& p, unsigned char* lds, int bid, int nb) {
  bf16_t* wt = (bf16_t*)lds;
  bf16_t* zt = (bf16_t*)(lds + 256 * 272);
  const int tid = ltid(), wave = tid >> 6, lane = tid & 63, r32 = lane & 31, hi = lane >> 5;
  __syncthreads();
  for (int e = tid; e < 256 * 128; e += NTHR) wt[(e >> 7) * 136 + (e & 127)] = f2bf(p.CCS[e]);
  for (int it = bid; it < (MR / 64) * 4; it += nb) {
    const int tile = it >> 2, g = it & 3, b = tile / 68, tb2 = tile - b * 68; const bool lat = tb2 < 64;
    __syncthreads();
    for (int e = tid; e < 1024; e += NTHR) { const int r = e >> 4, c8 = (e & 15) * 8; const int row = b * LT + (lat ? 64 * r + tb2 : LL + (tb2 - 64) * 64 + r);
      *(u32x4*)(zt + r * 136 + c8) = *(const u32x4*)(p.Z + (size_t)row * NZ + C_FN + g * 128 + c8); }
    __syncthreads();
    f32x16 acc[2] = {};
#pragma unroll
    for (int k8 = 0; k8 < 8; ++k8) { const bf16x8 a = *(const bf16x8*)(wt + (wave * 32 + r32) * 136 + k8 * 16 + hi * 8);
#pragma unroll
      for (int tt = 0; tt < 2; ++tt) { const bf16x8 bb = *(const bf16x8*)(zt + (tt * 32 + r32) * 136 + k8 * 16 + hi * 8); acc[tt] = __builtin_amdgcn_mfma_f32_32x32x16_bf16(a, bb, acc[tt], 0, 0, 0); } }
    const int tb = wave >> 2;
#pragma unroll
    for (int tt = 0; tt < 2; ++tt)
#pragma unroll
      for (int r = 0; r < 16; ++r) { const int k2 = (wave & 3) * 32 + (r & 3) + 8 * (r >> 2) + 4 * hi;
        if (lat) p.PQT[(((size_t)(b * 512 + g * 128 + k2)) * 64 + tb2) * 128 + tb * 64 + tt * 32 + r32] = f2bf(acc[tt][r]);
        else p.PQTc[((size_t)(b * 512 + g * 128 + k2)) * 512 + tb * 256 + (tb2 - 64) * 64 + tt * 32 + r32] = f2bf(acc[tt][r]); }
  }
}

DI void st_fnfft(const Prm& p, unsigned char* lds, int bid, int nb) {
  bf16_t* M1 = (bf16_t*)lds;
  bf16_t* M2c = M1 + 128 * 136; bf16_t* M2s = M2c + 64 * 72;
  f32x2* TW = (f32x2*)(lds + (128 * 136 + 2 * 64 * 72) * 2);
  unsigned char* OUTB = (unsigned char*)(lds + (128 * 136 + 2 * 64 * 72) * 2 + 32768);
  const int tid = ltid(), wave = tid >> 6, lane = tid & 63, r32 = lane & 31, hi = lane >> 5;
  __syncthreads();
  for (int e = tid; e < 128 * 128; e += NTHR) { const int j = e >> 7, k = e & 127, ri = j >> 6, cc = j & 63, pq = k >> 6, a = k & 63; float sv, cv; sincosf((float)((cc * a) & 63) * (6.283185307179586f / 64.f), &sv, &cv);
    const float v = ri == 0 ? (pq == 0 ? cv : -sv) : (pq == 0 ? -sv : -cv); M1[j * 136 + k] = f2bf(v * 0.125f); }
  for (int e = tid; e < 64 * 64; e += NTHR) { const int d = e >> 6, bp = e & 63; float sv, cv; sincosf((float)((d * bp) & 63) * (6.283185307179586f / 64.f), &sv, &cv); M2c[d * 72 + bp] = f2bf(cv * 0.125f); M2s[d * 72 + bp] = f2bf(sv * 0.125f); }
  for (int e = tid; e < 4096; e += NTHR) { float sv, cv; sincosf((float)e * (6.283185307179586f / 4096.f), &sv, &cv); TW[e] = (f32x2){cv, sv}; }
  __syncthreads();
  for (int item = bid * 8 + wave; item < NB * 512; item += nb * 8) {
    const int b = item >> 9, col = item & 511;
    const bf16_t* src = p.PQT + (size_t)item * 64 * 128;
    unsigned char* yo8 = (unsigned char*)p.Y + (size_t)b * LT * DM + 1536 + (col & ~7);
#pragma unroll 1
    for (int ct = 0; ct < 2; ++ct) {
      f32x16 tr0 = {}, tr1 = {}, ti0 = {}, ti1 = {};
#pragma unroll
      for (int ks = 0; ks < 8; ++ks) { const bf16x8 a0 = *(const bf16x8*)(src + r32 * 128 + ks * 16 + hi * 8), a1 = *(const bf16x8*)(src + (32 + r32) * 128 + ks * 16 + hi * 8);
        const bf16x8 br = *(const bf16x8*)(M1 + (ct * 32 + r32) * 136 + ks * 16 + hi * 8), bi = *(const bf16x8*)(M1 + ((2 + ct) * 32 + r32) * 136 + ks * 16 + hi * 8);
        tr0 = __builtin_amdgcn_mfma_f32_32x32x16_bf16(a0, br, tr0, 0, 0, 0); tr1 = __builtin_amdgcn_mfma_f32_32x32x16_bf16(a1, br, tr1, 0, 0, 0);
        ti0 = __builtin_amdgcn_mfma_f32_32x32x16_bf16(a0, bi, ti0, 0, 0, 0); ti1 = __builtin_amdgcn_mfma_f32_32x32x16_bf16(a1, bi, ti1, 0, 0, 0); }
      __builtin_amdgcn_sched_barrier(0);
      const int cc = ct * 32 + r32;
#pragma unroll
      for (int r = 0; r < 16; ++r) { const int bl = (r & 3) + 8 * (r >> 2) + 4 * hi; const f32x2 w0 = TW[(cc * bl) & 4095], w1 = TW[(cc * (32 + bl)) & 4095];
        const float a = tr0[r], bq = ti0[r]; tr0[r] = a * w0[0] + bq * w0[1]; ti0[r] = bq * w0[0] - a * w0[1];
        const float c2 = tr1[r], d2 = ti1[r]; tr1[r] = c2 * w1[0] + d2 * w1[1]; ti1[r] = d2 * w1[0] - c2 * w1[1]; }
      __builtin_amdgcn_sched_barrier(0);
      f32x16 y0 = {}, y1 = {};
#define FFT_S2(XT, M2, BT) do { _Pragma("unroll") for (int s = 0; s < 2; ++s) { \
          u32x4 pk; pk.x = pack2(XT[8 * s], XT[8 * s + 1]); pk.y = pack2(XT[8 * s + 2], XT[8 * s + 3]); pk.z = pack2(XT[8 * s + 4], XT[8 * s + 5]); pk.w = pack2(XT[8 * s + 6], XT[8 * s + 7]); \
          const bf16x8 xs = __builtin_bit_cast(bf16x8, pk); \
          const bf16_t* ap0 = (M2) + r32 * 72 + (BT) * 32 + 16 * s + 4 * hi; const bf16_t* ap1 = ap0 + 32 * 72; \
          const s16x4 l0 = *(const s16x4*)ap0, h0 = *(const s16x4*)(ap0 + 8), l1 = *(const s16x4*)ap1, h1 = *(const s16x4*)(ap1 + 8); \
          y0 = __builtin_amdgcn_mfma_f32_32x32x16_bf16((bf16x8){l0[0], l0[1], l0[2], l0[3], h0[0], h0[1], h0[2], h0[3]}, xs, y0, 0, 0, 0); \
          y1 = __builtin_amdgcn_mfma_f32_32x32x16_bf16((bf16x8){l1[0], l1[1], l1[2], l1[3], h1[0], h1[1], h1[2], h1[3]}, xs, y1, 0, 0, 0); } } while (0)
      FFT_S2(tr0, M2c, 0); __builtin_amdgcn_sched_barrier(0); FFT_S2(tr1, M2c, 1); __builtin_amdgcn_sched_barrier(0); FFT_S2(ti0, M2s, 0); __builtin_amdgcn_sched_barrier(0); FFT_S2(ti1, M2s, 1); __builtin_amdgcn_sched_barrier(0);
#undef FFT_S2
      __syncthreads();
#pragma unroll
      for (int r = 0; r < 16; ++r) { const int dl = (r & 3) + 8 * (r >> 2) + 4 * hi; const int pk = __builtin_amdgcn_cvt_pk_fp8_f32(y8c(y0[r]), y8c(y1[r]), 0, false); OUTB[(dl * 32 + r32) * 8 + wave] = (unsigned char)pk; OUTB[((32 + dl) * 32 + r32) * 8 + wave] = (unsigned char)(pk >> 8); }
      __syncthreads();
#pragma unroll
      for (int q = 0; q < 4; ++q) { const int rr = tid + NTHR * q, d = rr >> 5, ccl = rr & 31; *(u32x2*)(yo8 + (size_t)(ct * 32 + ccl + 64 * d) * DM) = *(const u32x2*)(OUTB + rr * 8); }
    }
  }
}

DI int scan_row(int b, int dir, int s) { return s < LCX ? b * LT + LL + (dir ? LCX - 1 - s : s) : b * LT + (dir ? LL - 1 - (s - LCX) : (s - LCX)); }

DI int tsw(int row, int t) { return row * 72 + ((((t >> 3) ^ (row >> 3)) & 7) << 3) + (t & 7); }
DI void st_dntinv(const Prm& p, unsigned char* lds, int bid, int nb) {
  const int tid = ltid(), wave = tid >> 6, lane = tid & 63, r32 = lane & 31, hi = lane >> 5;
  float* Ab = (float*)lds + wave * 4096;
  float* gcb = (float*)(lds + 131072) + wave * 128; float* btb = gcb + 64;
  for (int item = bid * 8 + wave; item < 64 * 68; item += nb * 8) {
    const int chain = item / 68, n = item - chain * 68, b = chain >> 3, h = (chain >> 1) & 3, dir = chain & 1;
    const int myrow = scan_row(b, dir, n * 64 + lane);
    const float g = p.GB[(size_t)myrow * 16 + dir * 4 + h], bt = p.GB[(size_t)myrow * 16 + 8 + dir * 4 + h];
    gcb[lane] = g; btb[lane] = bt;
    bf16x8 kf[2][8];
#pragma unroll
    for (int tt = 0; tt < 2; ++tt) { const int row = scan_row(b, dir, n * 64 + tt * 32 + r32);
#pragma unroll
      for (int ks = 0; ks < 8; ++ks) kf[tt][ks] = *(const bf16x8*)(p.DNQ + (size_t)row * 1536 + 512 + h * 128 + ks * 16 + hi * 8); }
    __builtin_amdgcn_wave_barrier();
    float gc = 0.f;
    for (int e = 0; e < 64; ++e) { const float ge = gcb[e]; gc += (e <= lane) ? ge : 0.f; }
    __builtin_amdgcn_wave_barrier();
    gcb[lane] = gc; p.GCB[(size_t)item * 64 + lane] = gc;
    __builtin_amdgcn_wave_barrier();
    f32x16 a00 = {}, a10 = {}, a11 = {};
#pragma unroll
    for (int ks = 0; ks < 8; ++ks) { a00 = __builtin_amdgcn_mfma_f32_32x32x16_bf16(kf[0][ks], kf[0][ks], a00, 0, 0, 0);
      a10 = __builtin_amdgcn_mfma_f32_32x32x16_bf16(kf[1][ks], kf[0][ks], a10, 0, 0, 0); a11 = __builtin_amdgcn_mfma_f32_32x32x16_bf16(kf[1][ks], kf[1][ks], a11, 0, 0, 0); }
    { const float gce0 = gcb[r32], gce1 = gcb[32 + r32];
#pragma unroll
      for (int r = 0; r < 16; ++r) { const int cl = (r & 3) + 8 * (r >> 2) + 4 * hi; const float gc0 = gcb[cl], bt0 = btb[cl], gc1 = gcb[32 + cl], bt1 = btb[32 + cl];
        Ab[cl * 64 + r32] = (r32 < cl) ? bt0 * a00[r] * __expf(gc0 - gce0) : 0.f;
        Ab[cl * 64 + 32 + r32] = 0.f;
        Ab[(32 + cl) * 64 + r32] = bt1 * a10[r] * __expf(gc1 - gce0);
        Ab[(32 + cl) * 64 + 32 + r32] = (r32 < cl) ? bt1 * a11[r] * __expf(gc1 - gce1) : 0.f; } }
    __builtin_amdgcn_wave_barrier();
    float x[64];
    bf16_t* to = p.TINV + (size_t)item * 4096 + lane;
#pragma unroll
    for (int c = 0; c < 64; ++c) { float s = (c == lane) ? 1.f : 0.f;
#pragma unroll
      for (int e4 = 0; e4 < (c + 3) / 4; ++e4) { const f32x4 av = *(const f32x4*)(Ab + c * 64 + e4 * 4);
#pragma unroll
        for (int i = 0; i < 4; ++i) if (e4 * 4 + i < c) s -= av[i] * x[e4 * 4 + i]; }
      x[c] = s; to[c * 64] = f2bf(s); }
    __builtin_amdgcn_wave_barrier();
  }
}

DI void st_dnscan(const Prm& p, unsigned char* lds, int bid, int nb) {
  constexpr int PK = 136, PB = 72;
  bf16_t* Qs = (bf16_t*)lds; bf16_t* Ks = Qs + 64 * PK; bf16_t* SB = Ks + 64 * PK; bf16_t* KDT = SB + 64 * PK; bf16_t* TI = KDT + 128 * PB; bf16_t* RT = TI + 64 * PB; bf16_t* VNT = RT + 64 * PB;
  bf16_t* PL = VNT + 64 * PB; bf16_t* Vs = PL + 64 * PB; float* gcs = (float*)(Vs + 64 * PB); float* bts = gcs + 64; float* egs = bts + 64;
  const int tid = ltid(), wave = tid >> 6, lane = tid & 63, r32 = lane & 31, hi = lane >> 5;
  for (int item = bid; item < 128; item += nb) {
    const int half = (item >> 3) & 1, chain = (item & 7) + 8 * (item >> 4), b = chain >> 3, h = (chain >> 1) & 3, dir = chain & 1;
    f32x16 accS = {};
    __syncthreads();
    for (int e = tid; e < 64 * PK; e += NTHR) SB[e] = 0;
    bf16x8 pf[6]; float pgc = 0.f, pbt = 0.f;
    auto gload = [&](int n) {
      const size_t ci = (size_t)chain * 68 + n;
#pragma unroll
      for (int r = 0; r < 6; ++r) { const int e = tid + NTHR * r;
        if (e < 2048) { const int ee = e & 1023, t = ee >> 4, c8 = ee & 15; const int row = scan_row(b, dir, n * 64 + t); pf[r] = *(const bf16x8*)(p.DNQ + (size_t)row * 1536 + (e < 1024 ? 0 : 512) + h * 128 + c8 * 8); }
        else if (e < 2560) { const int ee = e - 2048, t = ee >> 3, c8 = ee & 7; const int row = scan_row(b, dir, n * 64 + t); pf[r] = *(const bf16x8*)(p.DNQ + (size_t)row * 1536 + 1024 + h * 128 + half * 64 + c8 * 8); }
        else { const int ee = e - 2560; pf[r] = *(const bf16x8*)(p.TINV + ci * 4096 + ee * 8); } }
      if (tid < 64) { pgc = p.GCB[ci * 64 + tid]; const int row = scan_row(b, dir, n * 64 + tid); pbt = p.GB[(size_t)row * 16 + 8 + dir * 4 + h]; }
    };
    gload(0);
    for (int n = 0; n < LT / 64; ++n) {
      if (tid < 64) { gcs[tid] = pgc; bts[tid] = pbt; egs[tid] = __expf(pgc); }
      __syncthreads();
      const float gl = gcs[63];
#pragma unroll
      for (int r = 0; r < 6; ++r) { const int e = tid + NTHR * r;
        if (e < 1024) { const int t = e >> 4, c8 = e & 15; *(bf16x8*)(Qs + t * PK + c8 * 8) = pf[r]; }
        else if (e < 2048) { const int ee = e - 1024, t = ee >> 4, c8 = ee & 15; *(bf16x8*)(Ks + t * PK + c8 * 8) = pf[r]; const float sc = __expf(gl - gcs[t]);
#pragma unroll
          for (int j = 0; j < 8; ++j) KDT[tsw(c8 * 8 + j, t)] = f2bf(bf2f((bf16_t)pf[r][j]) * sc); }
        else if (e < 2560) { const int ee = e - 2048, t = ee >> 3, c8 = ee & 7; *(bf16x8*)(Vs + t * PB + c8 * 8) = pf[r]; }
        else { const int ee = e - 2560, c = ee >> 3, c8 = ee & 7; *(bf16x8*)(TI + c * PB + c8 * 8) = pf[r]; } }
      if (n + 1 < LT / 64) gload(n + 1);
      __syncthreads();
      f32x16 accO = {};
      if (wave < 4) { const int et = wave >> 1, jt = wave & 1; f32x16 a1 = {};
#pragma unroll
        for (int k8 = 0; k8 < 8; ++k8) { const bf16x8 av = *(const bf16x8*)(Ks + (et * 32 + r32) * PK + k8 * 16 + hi * 8), bv = *(const bf16x8*)(SB + (jt * 32 + r32) * PK + k8 * 16 + hi * 8);
          a1 = __builtin_amdgcn_mfma_f32_32x32x16_bf16(av, bv, a1, 0, 0, 0); }
        const int j = jt * 32 + r32;
#pragma unroll
        for (int g = 0; g < 4; ++g) { const int e0 = et * 32 + 8 * g + 4 * hi; float rv[4];
#pragma unroll
          for (int i = 0; i < 4; ++i) rv[i] = bts[e0 + i] * (bf2f(Vs[(e0 + i) * PB + j]) - egs[e0 + i] * a1[4 * g + i]);
          u32x2 w; w.x = pack2(rv[0], rv[1]); w.y = pack2(rv[2], rv[3]); *(u32x2*)(RT + j * PB + e0) = w; } }
      else {
        if (wave < 7) { const int et = wave == 6 ? 1 : 0, ct = wave == 4 ? 0 : 1; f32x16 a2 = {};
#pragma unroll
          for (int k8 = 0; k8 < 8; ++k8) { const bf16x8 av = *(const bf16x8*)(Ks + (et * 32 + r32) * PK + k8 * 16 + hi * 8), bv = *(const bf16x8*)(Qs + (ct * 32 + r32) * PK + k8 * 16 + hi * 8);
            a2 = __builtin_amdgcn_mfma_f32_32x32x16_bf16(av, bv, a2, 0, 0, 0); }
          const int c = ct * 32 + r32; const float gcc = gcs[c];
#pragma unroll
          for (int g = 0; g < 4; ++g) { const int e0 = et * 32 + 8 * g + 4 * hi; float pv[4];
#pragma unroll
            for (int i = 0; i < 4; ++i) pv[i] = (e0 + i <= c) ? a2[4 * g + i] * __expf(gcc - gcs[e0 + i]) : 0.f;
            u32x2 w; w.x = pack2(pv[0], pv[1]); w.y = pack2(pv[2], pv[3]); *(u32x2*)(PL + c * PB + e0) = w; } }
        else { for (int e = lane; e < 32 * 8; e += 64) { const int c = e >> 3, q4 = (e & 7) * 4; *(u32x2*)(PL + c * PB + 32 + q4) = (u32x2){0u, 0u}; } }
        { const int ct = (wave - 4) >> 1, jt = wave & 1;
#pragma unroll
          for (int k8 = 0; k8 < 8; ++k8) { const bf16x8 av = *(const bf16x8*)(Qs + (ct * 32 + r32) * PK + k8 * 16 + hi * 8), bv = *(const bf16x8*)(SB + (jt * 32 + r32) * PK + k8 * 16 + hi * 8);
            accO = __builtin_amdgcn_mfma_f32_32x32x16_bf16(av, bv, accO, 0, 0, 0); }
#pragma unroll
          for (int r = 0; r < 16; ++r) accO[r] *= egs[ct * 32 + (r & 3) + 8 * (r >> 2) + 4 * hi]; } }
      __syncthreads();
      if (wave < 4) { const int ct = wave >> 1, jt = wave & 1; f32x16 a3 = {};
#pragma unroll
        for (int k8 = 0; k8 < 4; ++k8) { const bf16x8 av = *(const bf16x8*)(TI + (ct * 32 + r32) * PB + k8 * 16 + hi * 8), bv = *(const bf16x8*)(RT + (jt * 32 + r32) * PB + k8 * 16 + hi * 8);
          a3 = __builtin_amdgcn_mfma_f32_32x32x16_bf16(av, bv, a3, 0, 0, 0); }
#pragma unroll
        for (int g = 0; g < 4; ++g) { u32x2 w; w.x = pack2(a3[4 * g], a3[4 * g + 1]); w.y = pack2(a3[4 * g + 2], a3[4 * g + 3]); *(u32x2*)(VNT + (jt * 32 + r32) * PB + ct * 32 + 8 * g + 4 * hi) = w; } }
      __syncthreads();
      if (wave >= 4) { const int ct = (wave - 4) >> 1, jt = wave & 1;
#pragma unroll
        for (int k8 = 0; k8 < 4; ++k8) { const bf16x8 av = *(const bf16x8*)(PL + (ct * 32 + r32) * PB + k8 * 16 + hi * 8), bv = *(const bf16x8*)(VNT + (jt * 32 + r32) * PB + k8 * 16 + hi * 8);
          accO = __builtin_amdgcn_mfma_f32_32x32x16_bf16(av, bv, accO, 0, 0, 0); }
#pragma unroll
        for (int r = 0; r < 16; ++r) { const int c = ct * 32 + (r & 3) + 8 * (r >> 2) + 4 * hi; const int row = scan_row(b, dir, n * 64 + c);
          p.OB[((size_t)(0 * 2 + dir) * MR + row) * 512 + h * 128 + half * 64 + jt * 32 + r32] = f2bf(accO[r]); } }
      { const int dt = wave >> 1, jt = wave & 1; const float egl = __expf(gl);
#pragma unroll
        for (int r = 0; r < 16; ++r) accS[r] *= egl;
#pragma unroll
        for (int k8 = 0; k8 < 4; ++k8) { const bf16x8 av = *(const bf16x8*)(KDT + tsw(dt * 32 + r32, k8 * 16 + hi * 8)), bv = *(const bf16x8*)(VNT + (jt * 32 + r32) * PB + k8 * 16 + hi * 8);
          accS = __builtin_amdgcn_mfma_f32_32x32x16_bf16(av, bv, accS, 0, 0, 0); }
#pragma unroll
        for (int g = 0; g < 4; ++g) { u32x2 w; w.x = pack2(accS[4 * g], accS[4 * g + 1]); w.y = pack2(accS[4 * g + 2], accS[4 * g + 3]);
          *(u32x2*)(SB + (jt * 32 + r32) * PK + dt * 32 + 8 * g + 4 * hi) = w; } }
      __syncthreads();
    }
  }
}

DI void st_glabc(const Prm& p, int layer, unsigned char* lds, int bid, int nb) {
  float* AL = (float*)lds; float* SEG = AL + 1024;
  const int tid = ltid(), seg = tid >> 6, dme = tid & 63;
  for (int item = bid; item < 64 * 68; item += nb) {
    const int chain = item / 68, n = item - chain * 68, b = chain >> 3, h = (chain >> 1) & 3, dir = chain & 1;
    const float* w2 = p.gla_w2 + (size_t)(layer * 2 + dir) * 16 * 256 + h * 64; const float b2r = p.gla_b2[(layer * 2 + dir) * 256 + h * 64 + dme];
    float w2r[16];
#pragma unroll
    for (int r = 0; r < 16; ++r) w2r[r] = w2[r * 256 + dme];
    __syncthreads();
    if (tid < 128) { const int t = tid >> 1, c8 = tid & 1; const int row = scan_row(b, dir, n * 64 + t); const bf16x8 v = *(const bf16x8*)(p.Z + (size_t)row * NZ + C_GALPHA + dir * 16 + c8 * 8);
#pragma unroll
      for (int j = 0; j < 8; ++j) AL[t * 16 + c8 * 8 + j] = bf2f((bf16_t)v[j]); }
    __syncthreads();
    float la[8]; float run = 0.f;
#pragma unroll
    for (int k = 0; k < 8; ++k) { const int t = seg * 8 + k; float zz = b2r;
#pragma unroll
      for (int r = 0; r < 16; ++r) zz += AL[t * 16 + r] * w2r[r];
      const float nz = -zz; const float sp = nz > 20.f ? nz : log1pf(expf(nz)); run += -sp * (1.f / 16.f); la[k] = run; }
    SEG[seg * 64 + dme] = run;
    __syncthreads();
    float pre = 0.f;
#pragma unroll
    for (int s2 = 0; s2 < 8; ++s2) pre += (s2 < seg) ? SEG[s2 * 64 + dme] : 0.f;
#pragma unroll
    for (int k = 0; k < 8; ++k) p.BC[(size_t)item * 4096 + (seg * 8 + k) * 64 + dme] = la[k] + pre;
  }
}

DI void st_glascan(const Prm& p, int layer, unsigned char* lds, int bid, int nb) {
  constexpr int PB = 72;
  bf16_t* QI = (bf16_t*)lds; bf16_t* QR = QI + 64 * PB; bf16_t* KR = QR + 64 * PB; bf16_t* KRT = KR + 64 * PB; bf16_t* VT = KRT + 64 * PB; bf16_t* SB = VT + 64 * PB; bf16_t* PL = SB + 64 * PB;
  float* LA = (float*)(lds + 7 * 64 * PB * 2);
  float* AL = LA + 4096;
  float* SEG = AL + 1024;
  float* EBL = SEG + 512;
  const int tid = ltid(), wave = tid >> 6, lane = tid & 63, r32 = lane & 31, hi = lane >> 5;
  for (int item = bid; item < 128; item += nb) {
    const int half = (item >> 3) & 1, chain = (item & 7) + 8 * (item >> 4), b = chain >> 3, h = (chain >> 1) & 3, dir = chain & 1;
    f32x16 acc = {};
    __syncthreads();
    for (int e = tid; e < 64 * PB; e += NTHR) SB[e] = 0;
    bf16x8 pf[3]; f32x4 pb[2];
    auto gload = [&](int n) {
#pragma unroll
      for (int r = 0; r < 3; ++r) { const int e = tid + NTHR * r; const int t = e / 24, ch = e - t * 24; const int row = scan_row(b, dir, n * 64 + t);
        const int col = ch < 8 ? C_GQ + h * 64 + ch * 8 : (ch < 16 ? C_GK + h * 64 + (ch - 8) * 8 : C_GV + h * 128 + half * 64 + (ch - 16) * 8);
        pf[r] = *(const bf16x8*)(p.Z + (size_t)row * NZ + col); }
#pragma unroll
      for (int r = 0; r < 2; ++r) pb[r] = *(const f32x4*)(p.BC + ((size_t)chain * 68 + n) * 4096 + (tid + NTHR * r) * 4);
    };
    gload(0);
    for (int n = 0; n < LT / 64; ++n) {
#pragma unroll
      for (int r = 0; r < 2; ++r) *(f32x4*)(LA + (tid + NTHR * r) * 4) = pb[r];
      __syncthreads();
      if (tid < 64) EBL[tid] = __expf(LA[63 * 64 + tid]);
#pragma unroll
      for (int r = 0; r < 3; ++r) { const int e = tid + NTHR * r; const int t = e / 24, ch = e - t * 24;
          if (ch < 8) { u32x4 wi, wr; float xi[8], xr[8];
#pragma unroll
            for (int j = 0; j < 8; ++j) { const int d = ch * 8 + j; const float bc = LA[t * 64 + d], bl = LA[63 * 64 + d], q = bf2f((bf16_t)pf[r][j]) * 0.125f; xi[j] = q * __expf(bc); xr[j] = q * __expf(bc - bl); }
            wi.x = pack2(xi[0], xi[1]); wi.y = pack2(xi[2], xi[3]); wi.z = pack2(xi[4], xi[5]); wi.w = pack2(xi[6], xi[7]);
            wr.x = pack2(xr[0], xr[1]); wr.y = pack2(xr[2], xr[3]); wr.z = pack2(xr[4], xr[5]); wr.w = pack2(xr[6], xr[7]);
            *(u32x4*)(QI + t * PB + ch * 8) = wi; *(u32x4*)(QR + t * PB + ch * 8) = wr; }
          else if (ch < 16) { u32x4 wk; float xk[8];
#pragma unroll
            for (int j = 0; j < 8; ++j) { const int d = (ch - 8) * 8 + j; xk[j] = bf2f((bf16_t)pf[r][j]) * __expf(LA[63 * 64 + d] - LA[t * 64 + d]); KRT[tsw(d, t)] = f2bf(xk[j]); }
            wk.x = pack2(xk[0], xk[1]); wk.y = pack2(xk[2], xk[3]); wk.z = pack2(xk[4], xk[5]); wk.w = pack2(xk[6], xk[7]);
            *(u32x4*)(KR + t * PB + (ch - 8) * 8) = wk; }
          else {
#pragma unroll
            for (int j = 0; j < 8; ++j) VT[tsw((ch - 16) * 8 + j, t)] = (bf16_t)pf[r][j]; } }
      if (n + 1 < LT / 64) gload(n + 1);
      __syncthreads();
      if (wave < 3) { const int et = wave == 2 ? 1 : 0, ct = wave == 0 ? 0 : 1; f32x16 a2 = {};
#pragma unroll
        for (int k8 = 0; k8 < 4; ++k8) { const bf16x8 av = *(const bf16x8*)(KR + (et * 32 + r32) * PB + k8 * 16 + hi * 8), bv = *(const bf16x8*)(QR + (ct * 32 + r32) * PB + k8 * 16 + hi * 8);
          a2 = __builtin_amdgcn_mfma_f32_32x32x16_bf16(av, bv, a2, 0, 0, 0); }
        const int c = ct * 32 + r32;
#pragma unroll
        for (int g = 0; g < 4; ++g) { const int e0 = et * 32 + 8 * g + 4 * hi; u32x2 w;
          w.x = pack2(e0 <= c ? a2[4 * g] : 0.f, e0 + 1 <= c ? a2[4 * g + 1] : 0.f); w.y = pack2(e0 + 2 <= c ? a2[4 * g + 2] : 0.f, e0 + 3 <= c ? a2[4 * g + 3] : 0.f);
          *(u32x2*)(PL + c * PB + e0) = w; } }
      else if (wave == 3) { for (int e = lane; e < 32 * 8; e += 64) { const int c = e >> 3, q4 = (e & 7) * 4; *(u32x2*)(PL + c * PB + 32 + q4) = (u32x2){0u, 0u}; } }
      else { const int ct = (wave - 4) >> 1, jt = wave & 1; acc = f32x16{};
#pragma unroll
        for (int k8 = 0; k8 < 4; ++k8) { const bf16x8 av = *(const bf16x8*)(QI + (ct * 32 + r32) * PB + k8 * 16 + hi * 8), bv = *(const bf16x8*)(SB + (jt * 32 + r32) * PB + k8 * 16 + hi * 8);
          acc = __builtin_amdgcn_mfma_f32_32x32x16_bf16(av, bv, acc, 0, 0, 0); } }
      __syncthreads();
      if (wave >= 4) { const int ct = (wave - 4) >> 1, jt = wave & 1;
#pragma unroll
        for (int k8 = 0; k8 < 4; ++k8) { const bf16x8 av = *(const bf16x8*)(PL + (ct * 32 + r32) * PB + k8 * 16 + hi * 8), bv = *(const bf16x8*)(VT + tsw(jt * 32 + r32, k8 * 16 + hi * 8));
          acc = __builtin_amdgcn_mfma_f32_32x32x16_bf16(av, bv, acc, 0, 0, 0); }
#pragma unroll
        for (int r = 0; r < 16; ++r) { const int c = ct * 32 + (r & 3) + 8 * (r >> 2) + 4 * hi; const int row = scan_row(b, dir, n * 64 + c);
          p.OB[((size_t)(1 * 2 + dir) * MR + row) * 512 + h * 128 + half * 64 + jt * 32 + r32] = f2bf(acc[r]); } }
      else { const int dt = wave >> 1, jt = wave & 1;
#pragma unroll
        for (int r = 0; r < 16; ++r) acc[r] *= EBL[dt * 32 + (r & 3) + 8 * (r >> 2) + 4 * hi];
#pragma unroll
        for (int k8 = 0; k8 < 4; ++k8) { const bf16x8 av = *(const bf16x8*)(KRT + tsw(dt * 32 + r32, k8 * 16 + hi * 8)), bv = *(const bf16x8*)(VT + tsw(jt * 32 + r32, k8 * 16 + hi * 8));
          acc = __builtin_amdgcn_mfma_f32_32x32x16_bf16(av, bv, acc, 0, 0, 0); }
#pragma unroll
        for (int g = 0; g < 4; ++g) { u32x2 w; w.x = pack2(acc[4 * g], acc[4 * g + 1]); w.y = pack2(acc[4 * g + 2], acc[4 * g + 3]);
          *(u32x2*)(SB + (jt * 32 + r32) * PB + dt * 32 + 8 * g + 4 * hi) = w; } }
      __syncthreads();
    }
  }
}

DI void st_combine(const Prm& p, int layer, int bid, int nb) {
  const int wave = ltid() >> 6, lane = ltid() & 63;
  for (long task = (long)bid * 8 + wave; task < (long)MR * 8; task += (long)nb * 8) {
    const int row = (int)(task >> 3), mh = (int)(task & 7), mixer = mh >> 2, h = mh & 3;
    const unsigned f = *(const unsigned*)(p.OB + ((size_t)(mixer * 2 + 0) * MR + row) * 512 + h * 128 + lane * 2), g = *(const unsigned*)(p.OB + ((size_t)(mixer * 2 + 1) * MR + row) * 512 + h * 128 + lane * 2);
    const float o0 = bf2f((bf16_t)(f & 0xffffu)) + bf2f((bf16_t)(g & 0xffffu)), o1 = bf2f((bf16_t)(f >> 16)) + bf2f((bf16_t)(g >> 16));
    const float ss = wsum(o0 * o0 + o1 * o1), rstd = rsqrtf(ss * (1.f / 128.f) + EPSV);
    const float* w = (mixer ? p.gla_norm : p.dn_norm) + layer * 128 + lane * 2;
    const unsigned gz = *(const unsigned*)(p.Z + (size_t)row * NZ + (mixer ? C_GGATE : C_DNGATE) + h * 128 + lane * 2);
    const float g0 = bf2f((bf16_t)(gz & 0xffffu)), g1 = bf2f((bf16_t)(gz >> 16));
    *(unsigned short*)((unsigned char*)p.Y + (size_t)row * DM + mixer * 512 + h * 128 + lane * 2) = (unsigned short)__builtin_amdgcn_cvt_pk_fp8_f32(y8c(o0 * rstd * w[0] * siluf(g0)), y8c(o1 * rstd * w[1] * siluf(g1)), 0, false);
  }
}

DI unsigned fkey(float f) { const unsigned u = __float_as_uint(f); return u ^ ((u >> 31) ? 0xffffffffu : 0x80000000u); }
DI int pcnt(unsigned long long m) { return __builtin_popcountll(m); }
DI int lanes_below(unsigned long long m) { return (int)__builtin_amdgcn_mbcnt_hi((unsigned)(m >> 32), __builtin_amdgcn_mbcnt_lo((unsigned)m, 0u)); }
DI void st_peertopk(const Prm& p, int layer, unsigned char* lds, int bid, int nb) {
  bf16_t* ks = (bf16_t*)lds;
  bf16_t* qt = (bf16_t*)(lds + 69632);
  float* sc = (float*)(lds + 69632);
  const int tid = ltid(), wave = tid >> 6, lane = tid & 63, r32 = lane & 31, hi = lane >> 5;
  float* selv = (float*)(lds + 69632 + 33280) + wave * 64; int* seli = (int*)(selv + 32);
  int hcur = -1;
  const int nchunk = MR / 32;
  const int total = 8 * nchunk;
  auto valid = [&](int i2) { const int ch = i2 % nchunk; return !(layer == 1 && ((ch * 32) % LT) >= LL); };
  u32x4 pq[2];
  auto preload = [&](int i2) { const int h2 = i2 / nchunk, r0 = (i2 - h2 * nchunk) * 32;
#pragma unroll
    for (int q = 0; q < 2; ++q) { const int e = tid + NTHR * q, r = e >> 5, c8 = (e & 31) * 8; pq[q] = *(const u32x4*)(p.Qp + (size_t)(r0 + r) * DM + h2 * 256 + c8); } };
  int it = bid; while (it < total && !valid(it)) it += nb;
  if (it < total) preload(it);
  while (it < total) {
    int nxt = it + nb; while (nxt < total && !valid(nxt)) nxt += nb;
    const int h = it / nchunk, chunk = it - h * nchunk, row0 = chunk * 32;
    __syncthreads();
    if (h != hcur) {
      const float* kg = p.peer_keys + ((size_t)(layer * 8 + h) * 2) * 128 * 128;
      for (int e = tid; e < 2 * 128 * 128; e += NTHR) { const int pn = e >> 7, k = e & 127; ks[pn * 136 + k] = f2bf(kg[e]); }
      hcur = h; }
#pragma unroll
    for (int q = 0; q < 2; ++q) { const int e = tid + NTHR * q, r = e >> 5, c8 = (e & 31) * 8; *(u32x4*)(qt + r * 264 + c8) = pq[q]; }
    __syncthreads();
    { const int pt = wave >> 2, nt = wave & 3; f32x16 acc = {};
#pragma unroll
      for (int k8 = 0; k8 < 8; ++k8) { const bf16x8 a = *(const bf16x8*)(qt + r32 * 264 + pt * 128 + k8 * 16 + hi * 8), b = *(const bf16x8*)(ks + (pt * 128 + nt * 32 + r32) * 136 + k8 * 16 + hi * 8);
        acc = __builtin_amdgcn_mfma_f32_32x32x16_bf16(a, b, acc, 0, 0, 0); }
      __syncthreads();
#pragma unroll
      for (int r = 0; r < 16; ++r) sc[((r & 3) + 8 * (r >> 2) + 4 * hi) * 260 + pt * 128 + nt * 32 + r32] = acc[r]; }
    __syncthreads();
    if (nxt < total) preload(nxt);
    for (int rr = 0; rr < 4; ++rr) {
      const int m = wave * 4 + rr, row = row0 + m;
      float s[2][2];
#pragma unroll
      for (int pp = 0; pp < 2; ++pp)
#pragma unroll
        for (int hh = 0; hh < 2; ++hh) s[pp][hh] = sc[m * 260 + pp * 128 + hh * 64 + lane];
      unsigned kk[2][2], T[2] = {0u, 0u};
#pragma unroll
      for (int pp = 0; pp < 2; ++pp) { kk[pp][0] = fkey(s[pp][0]); kk[pp][1] = fkey(s[pp][1]); }
      { unsigned ta = 0u, tb = 0u, da = 0u, db = 0u;
        for (int bit = 31; bit >= 0; --bit) { const unsigned m = 1u << bit;
          const unsigned ca = ta | m, cb = tb | m;
          const unsigned na = (unsigned)(pcnt(__ballot(kk[0][0] >= ca)) + pcnt(__ballot(kk[0][1] >= ca))), nb2 = (unsigned)(pcnt(__ballot(kk[1][0] >= cb)) + pcnt(__ballot(kk[1][1] >= cb)));
          const unsigned oa = (na >= 16u ? 1u : 0u) & ~da, ob = (nb2 >= 16u ? 1u : 0u) & ~db;
          ta |= (0u - oa) & m; tb |= (0u - ob) & m; da |= oa & (na == 16u ? 1u : 0u); db |= ob & (nb2 == 16u ? 1u : 0u);
          if (da & db) break; }
        T[0] = __builtin_amdgcn_readfirstlane(ta); T[1] = __builtin_amdgcn_readfirstlane(tb); }
#pragma unroll
      for (int pp = 0; pp < 2; ++pp) { const unsigned k0 = kk[pp][0], k1 = kk[pp][1], TT = T[pp];
        const unsigned long long g0 = __ballot(k0 > TT), g1 = __ballot(k1 > TT), e0 = __ballot(k0 == TT), e1 = __ballot(k1 == TT);
        const int ng0 = pcnt(g0), ng = ng0 + pcnt(g1), need = 16 - ng, ne0 = pcnt(e0);
        if (k0 > TT) { const int r = lanes_below(g0); selv[pp * 16 + r] = s[pp][0]; seli[pp * 16 + r] = lane; }
        if (k1 > TT) { const int r = ng0 + lanes_below(g1); selv[pp * 16 + r] = s[pp][1]; seli[pp * 16 + r] = lane + 64; }
        if (k0 == TT) { const int r = lanes_below(e0); if (r < need) { selv[pp * 16 + ng + r] = s[pp][0]; seli[pp * 16 + ng + r] = lane; } }
        if (k1 == TT) { const int r = ne0 + lanes_below(e1); if (r < need) { selv[pp * 16 + ng + r] = s[pp][1]; seli[pp * 16 + ng + r] = lane + 64; } } }
      __builtin_amdgcn_wave_barrier();
      float cd[4]; unsigned ck[4]; { const float sa = selv[lane >> 2]; const f32x4 sb = *(const f32x4*)(selv + 16 + (lane & 3) * 4);
#pragma unroll
        for (int q = 0; q < 4; ++q) { cd[q] = sa + sb[q]; ck[q] = fkey(cd[q]); } }
      unsigned T2 = 0u;
      for (int bit = 31; bit >= 0; --bit) { const unsigned m = 1u << bit, c = T2 | m;
        const unsigned n = (unsigned)(pcnt(__ballot(ck[0] >= c)) + pcnt(__ballot(ck[1] >= c)) + pcnt(__ballot(ck[2] >= c)) + pcnt(__ballot(ck[3] >= c)));
        T2 |= (0u - (n >= 16u ? 1u : 0u)) & m; if (n == 16u) break; }
      T2 = __builtin_amdgcn_readfirstlane(T2);
      float mx = fmaxf(fmaxf(cd[0], cd[1]), fmaxf(cd[2], cd[3])); mx = wmax(mx);
      int base = 0; float esum = 0.f; const int ia = seli[lane >> 2]; int rk[4]; float ev[4];
#pragma unroll
      for (int q = 0; q < 4; ++q) { const unsigned long long g = __ballot(ck[q] > T2); rk[q] = ck[q] > T2 ? base + lanes_below(g) : 99; base += pcnt(g); }
#pragma unroll
      for (int q = 0; q < 4; ++q) { const unsigned long long g = __ballot(ck[q] == T2); if (ck[q] == T2) rk[q] = base + lanes_below(g); base += pcnt(g); }
#pragma unroll
      for (int q = 0; q < 4; ++q) { ev[q] = rk[q] < 16 ? __expf(cd[q] - mx) : 0.f; esum += ev[q]; }
      esum = wsum(esum); const float inv = 1.f / esum;
      int* orow = p.IDX + (size_t)row * 128 + h * 16; float* grow = p.GATE + (size_t)row * 128 + h * 16;
#pragma unroll
      for (int q = 0; q < 4; ++q) if (rk[q] < 16) { orow[rk[q]] = ia * 128 + seli[16 + (lane & 3) * 4 + q]; grow[rk[q]] = ev[q] * inv; }
      __builtin_amdgcn_wave_barrier();
    }
    it = nxt;
  }
}

typedef float v16f_t __attribute__((ext_vector_type(16)));
typedef float v32f_t __attribute__((ext_vector_type(32)));
typedef unsigned v6u_t __attribute__((ext_vector_type(6)));
typedef __bf16 v32bf_t __attribute__((ext_vector_type(32)));
typedef __bf16 v2bf_t __attribute__((ext_vector_type(2)));
constexpr int TROW = 1600;
constexpr int TROWV = 1152;
constexpr int TREC = 2176;
constexpr float TSM = 64.f;
DI void st_cvt_tables(const Prm& p, int layer, int bid, int nb) {
  const size_t nblk = (size_t)16384 * 64, stride = (size_t)nb * NTHR;
  const float* U = p.peer_u + (size_t)layer * 16384 * DM; const float* V = p.peer_v + (size_t)layer * 16384 * DM;
  for (size_t e = (size_t)bid * NTHR + ltid(); e < 2 * nblk; e += stride) { const bool isv = e >= nblk; const size_t k = isv ? e - nblk : e; const size_t row = k >> 6; const int l = (int)(k & 63);
    const float* src = (isv ? V : U) + row * DM + l * 32; float amax = 0.f; f32x4 a[8];
#pragma unroll
    for (int q = 0; q < 8; ++q) { a[q] = *(const f32x4*)(src + q * 4);
#pragma unroll
      for (int i = 0; i < 4; ++i) amax = fmaxf(amax, fabsf(a[q][i])); }
    const float want = fminf(fmaxf(amax * (TSM / 6.f), 0.001953125f), 448.f); int s8 = __builtin_amdgcn_cvt_pk_fp8_f32(want, want, 0, false) & 0xff;
    if (__builtin_amdgcn_cvt_f32_fp8(s8, 0) < want && s8 < 0x7e) ++s8;
    const float inv = TSM / __builtin_amdgcn_cvt_f32_fp8(s8, 0);
    u32x4 r = (u32x4){0u, 0u, 0u, 0u};
#pragma unroll
    for (int q = 0; q < 4; ++q) { unsigned w = 0;
      w = __builtin_amdgcn_cvt_scalef32_pk_fp4_f32(w, a[2 * q][0] * inv, a[2 * q][1] * inv, 1.0f, 0); w = __builtin_amdgcn_cvt_scalef32_pk_fp4_f32(w, a[2 * q][2] * inv, a[2 * q][3] * inv, 1.0f, 1);
      w = __builtin_amdgcn_cvt_scalef32_pk_fp4_f32(w, a[2 * q + 1][0] * inv, a[2 * q + 1][1] * inv, 1.0f, 2); w = __builtin_amdgcn_cvt_scalef32_pk_fp4_f32(w, a[2 * q + 1][2] * inv, a[2 * q + 1][3] * inv, 1.0f, 3);
      r[q] = w; }
    unsigned char* dst = (unsigned char*)p.Ub + row * TREC;
    dst[2 * l + (isv ? 1 : 0)] = (unsigned char)s8; *(u32x4*)(dst + 128 + (isv ? 1024 : 0) + l * 16) = r; }
}

DI void st_peergather(const Prm& p, int layer, float* lds, int bid, int nb, bool dry = false) {
  const int tid = ltid(), wave = tid >> 6, lane = tid & 63;
  const unsigned char* Ub = (const unsigned char*)p.Ub; const unsigned char* Vb = (const unsigned char*)p.Vb;
  for (int row = bid; row < MR; row += nb) {
    const int b = row / LT, t = row - b * LT; const bool isc = t >= LL;
    if (isc && layer == 1) continue;
    f32x2 hv[16];
#pragma unroll
    for (int q = 0; q < 4; ++q) { const u32x4 w = *(const u32x4*)(p.H2 + (size_t)row * DM + lane * 32 + q * 8);
#pragma unroll
      for (int k = 0; k < 4; ++k) hv[q * 4 + k] = (f32x2){__uint_as_float(w[k] << 16), __uint_as_float(w[k] & 0xffff0000u)}; }
    f32x2 acc[16];
#pragma unroll
    for (int i = 0; i < 16; ++i) acc[i] = (f32x2){0.f, 0.f};
    const int myidx = lane < 16 ? p.IDX[(size_t)row * 128 + wave * 16 + lane] : 0; const float mygate = lane < 16 ? p.GATE[(size_t)row * 128 + wave * 16 + lane] : 0.f;
#pragma unroll 1
    for (int k0 = 0; k0 < 16; k0 += 8) {
      u32x4 ua[8], va[8]; u32x2 ub[8], vb[8]; unsigned us[8], vs[8];
#pragma unroll
      for (int q = 0; q < 8; ++q) { const int e = __builtin_amdgcn_readfirstlane(__shfl(myidx, k0 + q));
        const unsigned char* ur = Ub + (size_t)e * TROW; const unsigned char* vr = Vb + (size_t)e * TROW;
        ua[q] = *(const u32x4*)(ur + 64 + lane * 16); ub[q] = *(const u32x2*)(ur + 64 + 1024 + lane * 8); us[q] = ur[lane];
        va[q] = *(const u32x4*)(vr + 64 + lane * 16); vb[q] = *(const u32x2*)(vr + 64 + 1024 + lane * 8); vs[q] = vr[lane]; }
#pragma unroll
      for (int q = 0; q < 8; ++q) {
        const v32f_t du = __builtin_amdgcn_cvt_scalef32_pk32_f32_fp6((v6u_t){ua[q][0], ua[q][1], ua[q][2], ua[q][3], ub[q][0], ub[q][1]}, 1.0f);
        f32x2 d0 = (f32x2){0.f, 0.f}, d1 = (f32x2){0.f, 0.f};
#pragma unroll
        for (int i = 0; i < 16; i += 2) { d0 += (f32x2){du[2 * i], du[2 * i + 1]} * hv[i]; d1 += (f32x2){du[2 * i + 2], du[2 * i + 3]} * hv[i + 1]; }
        d0 += d1; const float d = wsum((d0[0] + d0[1]) * __uint_as_float(us[q] << 23));
        const float wgt = __shfl(mygate, k0 + q) * 0.5f * d * (1.f + erff(d * 0.70710678118654752f)) * __uint_as_float(vs[q] << 23); const f32x2 w2 = (f32x2){wgt, wgt};
        const v32f_t dv = __builtin_amdgcn_cvt_scalef32_pk32_f32_fp6((v6u_t){va[q][0], va[q][1], va[q][2], va[q][3], vb[q][0], vb[q][1]}, 1.0f);
#pragma unroll
        for (int i = 0; i < 16; ++i) acc[i] += w2 * (f32x2){dv[2 * i], dv[2 * i + 1]}; }
    }
    __syncthreads();
#pragma unroll
    for (int k = 0; k < 8; ++k) *(f32x4*)(lds + wave * 2048 + lane * 32 + k * 4) = (f32x4){acc[2 * k][0], acc[2 * k][1], acc[2 * k + 1][0], acc[2 * k + 1][1]};
    __syncthreads();
    { const int col = tid * 4; f32x4 sum = (f32x4){0.f, 0.f, 0.f, 0.f};
#pragma unroll
      for (int w = 0; w < 8; ++w) sum += *(const f32x4*)(lds + w * 2048 + col);
      const f32x4 g2 = *(const f32x4*)(p.mod + ((size_t)layer * 9 + (isc ? 8 : b)) * NMOD + 5 * DM + col);
      float* xr = p.X + (size_t)row * DM + col; const f32x4 xn = *(const f32x4*)xr + g2 * sum;
      if (!dry) {
        float ss = wsum(xn[0] * xn[0] + xn[1] * xn[1] + xn[2] * xn[2] + xn[3] * xn[3]);
        if (lane == 0) lds[16384 + wave] = ss;
        __syncthreads();
        ss = 0.f;
#pragma unroll
        for (int w = 0; w < 8; ++w) ss += lds[16384 + w];
        const float rstd = rsqrtf(ss * (1.f / 2048.f) + EPSV);
        if (layer == 0) { *(f32x4*)xr = xn;
          const float* mr = p.mod + ((size_t)9 + (isc ? 8 : b)) * NMOD; const f32x4 sc = *(const f32x4*)(mr + DM + col), sh = *(const f32x4*)(mr + col);
          const f32x4 o = xn * rstd * (sc + 1.f) + sh; u32x2 w; w.x = pack2(o[0], o[1]); w.y = pack2(o[2], o[3]); *(u32x2*)(p.H + (size_t)row * DM + col) = w; }
        else *(f32x4*)(p.out + ((size_t)b * LL + t) * DM + col) = xn * rstd * *(const f32x4*)(p.final_norm + col);
      } }
  }
}

DI void sel_row(const float* scrow, float* selv, int* seli, int* orow, float* grow, int lane) {
  float s[2][2];
#pragma unroll
  for (int pp = 0; pp < 2; ++pp)
#pragma unroll
    for (int hh = 0; hh < 2; ++hh) s[pp][hh] = scrow[pp * 128 + hh * 64 + lane];
  unsigned kk[2][2], T[2] = {0u, 0u};
#pragma unroll
  for (int pp = 0; pp < 2; ++pp) { kk[pp][0] = fkey(s[pp][0]); kk[pp][1] = fkey(s[pp][1]); }
  { unsigned ta = 0u, tb = 0u, da = 0u, db = 0u;
    for (int bit = 31; bit >= 0; --bit) { const unsigned m = 1u << bit;
      const unsigned ca = ta | m, cb = tb | m;
      const unsigned na = (unsigned)(pcnt(__ballot(kk[0][0] >= ca)) + pcnt(__ballot(kk[0][1] >= ca))), nb2 = (unsigned)(pcnt(__ballot(kk[1][0] >= cb)) + pcnt(__ballot(kk[1][1] >= cb)));
      const unsigned oa = (na >= 16u ? 1u : 0u) & ~da, ob = (nb2 >= 16u ? 1u : 0u) & ~db;
      ta |= (0u - oa) & m; tb |= (0u - ob) & m; da |= oa & (na == 16u ? 1u : 0u); db |= ob & (nb2 == 16u ? 1u : 0u);
      if (da & db) break; }
    T[0] = __builtin_amdgcn_readfirstlane(ta); T[1] = __builtin_amdgcn_readfirstlane(tb); }
#pragma unroll
  for (int pp = 0; pp < 2; ++pp) { const unsigned k0 = kk[pp][0], k1 = kk[pp][1], TT = T[pp];
    const unsigned long long g0 = __ballot(k0 > TT), g1 = __ballot(k1 > TT), e0 = __ballot(k0 == TT), e1 = __ballot(k1 == TT);
    const int ng0 = pcnt(g0), ng = ng0 + pcnt(g1), need = 16 - ng, ne0 = pcnt(e0);
    if (k0 > TT) { const int r = lanes_below(g0); selv[pp * 16 + r] = s[pp][0]; seli[pp * 16 + r] = lane; }
    if (k1 > TT) { const int r = ng0 + lanes_below(g1); selv[pp * 16 + r] = s[pp][1]; seli[pp * 16 + r] = lane + 64; }
    if (k0 == TT) { const int r = lanes_below(e0); if (r < need) { selv[pp * 16 + ng + r] = s[pp][0]; seli[pp * 16 + ng + r] = lane; } }
    if (k1 == TT) { const int r = ne0 + lanes_below(e1); if (r < need) { selv[pp * 16 + ng + r] = s[pp][1]; seli[pp * 16 + ng + r] = lane + 64; } } }
  __builtin_amdgcn_wave_barrier();
  float cd[4]; unsigned ck[4]; { const float sa = selv[lane >> 2]; const f32x4 sb = *(const f32x4*)(selv + 16 + (lane & 3) * 4);
#pragma unroll
    for (int q = 0; q < 4; ++q) { cd[q] = sa + sb[q]; ck[q] = fkey(cd[q]); } }
  unsigned T2 = 0u;
  for (int bit = 31; bit >= 0; --bit) { const unsigned m = 1u << bit, c = T2 | m;
    const unsigned n = (unsigned)(pcnt(__ballot(ck[0] >= c)) + pcnt(__ballot(ck[1] >= c)) + pcnt(__ballot(ck[2] >= c)) + pcnt(__ballot(ck[3] >= c)));
    T2 |= (0u - (n >= 16u ? 1u : 0u)) & m; if (n == 16u) break; }
  T2 = __builtin_amdgcn_readfirstlane(T2);
  float mx = fmaxf(fmaxf(cd[0], cd[1]), fmaxf(cd[2], cd[3])); mx = wmax(mx);
  int base = 0; float esum = 0.f; const int ia = seli[lane >> 2]; int rk[4]; float ev[4];
#pragma unroll
  for (int q = 0; q < 4; ++q) { const unsigned long long g = __ballot(ck[q] > T2); rk[q] = ck[q] > T2 ? base + lanes_below(g) : 99; base += pcnt(g); }
#pragma unroll
  for (int q = 0; q < 4; ++q) { const unsigned long long g = __ballot(ck[q] == T2); if (ck[q] == T2) rk[q] = base + lanes_below(g); base += pcnt(g); }
#pragma unroll
  for (int q = 0; q < 4; ++q) { ev[q] = rk[q] < 16 ? __expf(cd[q] - mx) : 0.f; esum += ev[q]; }
  esum = wsum(esum); const float inv = 1.f / esum;
#pragma unroll
  for (int q = 0; q < 4; ++q) if (rk[q] < 16) { orow[rk[q]] = ia * 128 + seli[16 + (lane & 3) * 4 + q]; grow[rk[q]] = ev[q] * inv; }
  __builtin_amdgcn_wave_barrier();
}

DI void sel_row2(const float* sc0, const float* sc1, float* selv, int* seli, int* orow0, float* grow0, int* orow1, float* grow1, int lane) {
  float s[2][2][2]; unsigned kk[2][2][2];
#pragma unroll
  for (int w = 0; w < 2; ++w)
#pragma unroll
    for (int pp = 0; pp < 2; ++pp)
#pragma unroll
      for (int hh = 0; hh < 2; ++hh) { s[w][pp][hh] = (w ? sc1 : sc0)[pp * 128 + hh * 64 + lane]; kk[w][pp][hh] = fkey(s[w][pp][hh]); }
  unsigned T[2][2];
  { unsigned t0 = 0u, t1 = 0u, t2 = 0u, t3 = 0u, d0 = 0u, d1 = 0u, d2 = 0u, d3 = 0u;
    for (int bit = 31; bit >= 0; --bit) { const unsigned m = 1u << bit;
      const unsigned c0 = t0 | m, c1 = t1 | m, c2 = t2 | m, c3 = t3 | m;
      const unsigned n0 = (unsigned)(pcnt(__ballot(kk[0][0][0] >= c0)) + pcnt(__ballot(kk[0][0][1] >= c0))), n1 = (unsigned)(pcnt(__ballot(kk[0][1][0] >= c1)) + pcnt(__ballot(kk[0][1][1] >= c1)));
      const unsigned n2 = (unsigned)(pcnt(__ballot(kk[1][0][0] >= c2)) + pcnt(__ballot(kk[1][0][1] >= c2))), n3 = (unsigned)(pcnt(__ballot(kk[1][1][0] >= c3)) + pcnt(__ballot(kk[1][1][1] >= c3)));
      const unsigned o0 = (n0 >= 16u ? 1u : 0u) & ~d0, o1 = (n1 >= 16u ? 1u : 0u) & ~d1, o2 = (n2 >= 16u ? 1u : 0u) & ~d2, o3 = (n3 >= 16u ? 1u : 0u) & ~d3;
      t0 |= (0u - o0) & m; t1 |= (0u - o1) & m; t2 |= (0u - o2) & m; t3 |= (0u - o3) & m;
      d0 |= o0 & (n0 == 16u ? 1u : 0u); d1 |= o1 & (n1 == 16u ? 1u : 0u); d2 |= o2 & (n2 == 16u ? 1u : 0u); d3 |= o3 & (n3 == 16u ? 1u : 0u);
      if (d0 & d1 & d2 & d3) break; }
    T[0][0] = __builtin_amdgcn_readfirstlane(t0); T[0][1] = __builtin_amdgcn_readfirstlane(t1); T[1][0] = __builtin_amdgcn_readfirstlane(t2); T[1][1] = __builtin_amdgcn_readfirstlane(t3); }
#pragma unroll
  for (int w = 0; w < 2; ++w)
#pragma unroll
    for (int pp = 0; pp < 2; ++pp) { const unsigned k0 = kk[w][pp][0], k1 = kk[w][pp][1], TT = T[w][pp]; float* sv = selv + w * 32 + pp * 16; int* si = seli + w * 32 + pp * 16;
      const unsigned long long g0 = __ballot(k0 > TT), g1 = __ballot(k1 > TT), e0 = __ballot(k0 == TT), e1 = __ballot(k1 == TT);
      const int ng0 = pcnt(g0), ng = ng0 + pcnt(g1), need = 16 - ng, ne0 = pcnt(e0);
      if (k0 > TT) { const int r = lanes_below(g0); sv[r] = s[w][pp][0]; si[r] = lane; }
      if (k1 > TT) { const int r = ng0 + lanes_below(g1); sv[r] = s[w][pp][1]; si[r] = lane + 64; }
      if (k0 == TT) { const int r = lanes_below(e0); if (r < need) { sv[ng + r] = s[w][pp][0]; si[ng + r] = lane; } }
      if (k1 == TT) { const int r = ne0 + lanes_below(e1); if (r < need) { sv[ng + r] = s[w][pp][1]; si[ng + r] = lane + 64; } } }
  __builtin_amdgcn_wave_barrier();
  float cd[2][4]; unsigned ck[2][4];
#pragma unroll
  for (int w = 0; w < 2; ++w) { const float sa = selv[w * 32 + (lane >> 2)]; const f32x4 sb = *(const f32x4*)(selv + w * 32 + 16 + (lane & 3) * 4);
#pragma unroll
    for (int q = 0; q < 4; ++q) { cd[w][q] = sa + sb[q]; ck[w][q] = fkey(cd[w][q]); } }
  unsigned T2[2];
  { unsigned ta = 0u, tb = 0u, da = 0u, db = 0u;
    for (int bit = 31; bit >= 0; --bit) { const unsigned m = 1u << bit, ca = ta | m, cb = tb | m;
      const unsigned na = (unsigned)(pcnt(__ballot(ck[0][0] >= ca)) + pcnt(__ballot(ck[0][1] >= ca)) + pcnt(__ballot(ck[0][2] >= ca)) + pcnt(__ballot(ck[0][3] >= ca)));
      const unsigned nb2 = (unsigned)(pcnt(__ballot(ck[1][0] >= cb)) + pcnt(__ballot(ck[1][1] >= cb)) + pcnt(__ballot(ck[1][2] >= cb)) + pcnt(__ballot(ck[1][3] >= cb)));
      const unsigned oa = (na >= 16u ? 1u : 0u) & ~da, ob = (nb2 >= 16u ? 1u : 0u) & ~db;
      ta |= (0u - oa) & m; tb |= (0u - ob) & m; da |= oa & (na == 16u ? 1u : 0u); db |= ob & (nb2 == 16u ? 1u : 0u);
      if (da & db) break; }
    T2[0] = __builtin_amdgcn_readfirstlane(ta); T2[1] = __builtin_amdgcn_readfirstlane(tb); }
#pragma unroll
  for (int w = 0; w < 2; ++w) {
    float mx = fmaxf(fmaxf(cd[w][0], cd[w][1]), fmaxf(cd[w][2], cd[w][3])); mx = wmax(mx);
    int base = 0; float esum = 0.f; const int ia = seli[w * 32 + (lane >> 2)]; int rk[4]; float ev[4];
#pragma unroll
    for (int q = 0; q < 4; ++q) { const unsigned long long g = __ballot(ck[w][q] > T2[w]); rk[q] = ck[w][q] > T2[w] ? base + lanes_below(g) : 99; base += pcnt(g); }
#pragma unroll
    for (int q = 0; q < 4; ++q) { const unsigned long long g = __ballot(ck[w][q] == T2[w]); if (ck[w][q] == T2[w]) rk[q] = base + lanes_below(g); base += pcnt(g); }
#pragma unroll
    for (int q = 0; q < 4; ++q) { ev[q] = rk[q] < 16 ? __expf(cd[w][q] - mx) : 0.f; esum += ev[q]; }
    esum = wsum(esum); const float inv = 1.f / esum; int* orow = w ? orow1 : orow0; float* grow = w ? grow1 : grow0;
#pragma unroll
    for (int q = 0; q < 4; ++q) if (rk[q] < 16) { orow[rk[q]] = ia * 128 + seli[w * 32 + 16 + (lane & 3) * 4 + q]; grow[rk[q]] = ev[q] * inv; } }
  __builtin_amdgcn_wave_barrier();
}

DI float dpp_ror4(float v) { return __int_as_float(__builtin_amdgcn_mov_dpp(__float_as_int(v), 0x124, 0xf, 0xf, true)); }
DI float dpp_ror8(float v) { return __int_as_float(__builtin_amdgcn_mov_dpp(__float_as_int(v), 0x128, 0xf, 0xf, true)); }
DI float erf_bf(float x) { const float z = fabsf(x), t = __builtin_amdgcn_rcpf(fmaf(0.3275911f, z, 1.f));
  const float pl = t * fmaf(t, fmaf(t, fmaf(t, fmaf(t, 1.061405429f, -1.453152027f), 1.421413741f), -0.284496736f), 0.254829592f);
  const float r = fmaf(-pl, __builtin_amdgcn_exp2f(z * z * -1.4426950408889634f), 1.f); return copysignf(r, x); }
DI void st_peer(const Prm& p, int layer, unsigned char* lds, int bid, int nb, const int mode = 0) {
  int* HI = (int*)lds;
  float* HG = (float*)(lds + 32768);
  float* SCB = (float*)(lds + 65536);
  float* SLB = (float*)(lds + 65536 + 32768);
  int* CTR = (int*)(lds + 65536 + 32768 + 4096);
  const int nrows = layer == 0 ? 136 : 128, ntile = (nrows + 31) / 32;
  const unsigned char* Ub = (const unsigned char*)p.Ub; const unsigned char* Vb = (const unsigned char*)p.Vb;
  if (ltid() == 0) { CTR[0] = 0; CTR[1] = 0; }
  __syncthreads();
  for (int step = 0; step <= ntile; ++step) {
    const int tid = ltid(), wave = tid >> 6, lane = tid & 63, r32 = lane & 31, hi = lane >> 5;
    const bool tpath = step == 0 || (wave < 4 && step < ntile);
    if (tid == 0) CTR[(step + 1) & 1] = 0;
    if (tpath) {
      {
        const int hpw = step == 0 ? 1 : 2, tw = wave, buf = step & 1, t0 = step * 32, tl = nrows - t0 < 32 ? nrows - t0 : 32;
        float* RB = SCB + tw * 512; float* selv = SLB + tw * 128; int* seli = (int*)(selv + 64);
        const int rl = t0 + (r32 < tl ? r32 : tl - 1); const int rq = bid * nrows + rl; const int qrow = layer == 0 ? rq : (rq >> 12) * LT + (rq & 4095);
        for (int hh = 0; hh < hpw; ++hh) { const int h = tw * hpw + hh;
          f32x16 acc[2][4] = {};
#pragma unroll
          for (int pp = 0; pp < 2; ++pp) {
            const bf16_t* qp = p.Qp + (size_t)qrow * DM + h * 256 + pp * 128 + hi * 8; const bf16_t* kp = p.KB16 + ((size_t)((layer * 8 + h) * 2 + pp) * 128 + r32) * 128 + hi * 8;
#pragma unroll 4
            for (int ks = 0; ks < 8; ++ks) { const bf16x8 av = *(const bf16x8*)(qp + ks * 16);
#pragma unroll
              for (int nt = 0; nt < 4; ++nt) { const bf16x8 bv = *(const bf16x8*)(kp + (size_t)nt * 32 * 128 + ks * 16); acc[pp][nt] = __builtin_amdgcn_mfma_f32_32x32x16_bf16(av, bv, acc[pp][nt], 0, 0, 0); } } }
#pragma unroll 1
          for (int r = 0; r < 16; ++r) { const int m0 = (r & 3) + 8 * (r >> 2); if (m0 >= tl) continue;
#pragma unroll
            for (int pp = 0; pp < 2; ++pp)
#pragma unroll
              for (int nt = 0; nt < 4; ++nt) { const f32x16& A = acc[pp][nt];
                const float a0 = (r & 1) ? A[1] : A[0], a1 = (r & 1) ? A[3] : A[2], a2 = (r & 1) ? A[5] : A[4], a3 = (r & 1) ? A[7] : A[6], a4 = (r & 1) ? A[9] : A[8], a5 = (r & 1) ? A[11] : A[10], a6 = (r & 1) ? A[13] : A[12], a7 = (r & 1) ? A[15] : A[14];
                const float b0 = (r & 2) ? a1 : a0, b1 = (r & 2) ? a3 : a2, b2 = (r & 2) ? a5 : a4, b3 = (r & 2) ? a7 : a6;
                const float c0 = (r & 4) ? b1 : b0, c1 = (r & 4) ? b3 : b2;
                RB[hi * 256 + pp * 128 + nt * 32 + r32] = (r & 8) ? c1 : c0; }
            __builtin_amdgcn_wave_barrier();
            sel_row2(RB, RB + 256, selv, seli, HI + (buf * 32 + m0) * 128 + h * 16, HG + (buf * 32 + m0) * 128 + h * 16, HI + (buf * 32 + m0 + 4) * 128 + h * 16, HG + (buf * 32 + m0 + 4) * 128 + h * 16, lane);
            __builtin_amdgcn_wave_barrier(); }
        }
      }
    }
    if (step >= 1) {
      const int tile = step - 1, buf = tile & 1;
      for (;;) { int m = 0; if (lane == 0) m = atomicAdd(&CTR[step & 1], 1); m = __builtin_amdgcn_readfirstlane(m); const int rl = tile * 32 + m; if (m >= 32 || rl >= nrows) break;
        const int rq = bid * nrows + rl; const int row = layer == 0 ? rq : (rq >> 12) * LT + (rq & 4095);
        const int b = row / LT, t = row - b * LT; const bool isc = t >= LL;
        u32x4 hw[2];
        int lane_r = lane; asm volatile("" : "+v"(lane_r));
#pragma unroll
        for (int q = 0; q < 2; ++q) hw[q] = *(const u32x4*)(p.H2q + (size_t)row * DM + lane_r * 32 + q * 16);
#define HVP(k) ((f32x2){__uint_as_float(hw[(k) >> 2][(k) & 3] << 16), __uint_as_float(hw[(k) >> 2][(k) & 3] & 0xffff0000u)})
        f32x2 acc[16];
#pragma unroll
        for (int k = 0; k < 16; ++k) acc[k] = (f32x2){0.f, 0.f};
        const int* hi_ = HI + (buf * 32 + m) * 128; const float* hg_ = HG + (buf * 32 + m) * 128;
        const int idx0 = hi_[lane], idx1 = hi_[64 + lane]; const float gt0 = hg_[lane], gt1 = hg_[64 + lane];
        constexpr int NS = 8;
        u32x4 ua[NS] = {}, va[NS] = {}; unsigned us[NS] = {};
        const unsigned vo16 = lane * 16, vo2 = lane * 2;
        const int bp16 = (lane ^ 16) * 4, bp32 = (lane ^ 32) * 4, l3 = lane & 3; const bool b0 = (lane & 1) != 0, b1 = (lane & 2) != 0;
        unsigned hd[16];
#pragma unroll
        for (int j = 0; j < 8; ++j) { const int dw = (int)hw[j >> 2][j & 3]; const f32x2 t0 = __builtin_amdgcn_cvt_pk_f32_fp8(dw, false), t1 = __builtin_amdgcn_cvt_pk_f32_fp8(dw, true);
          hd[2 * j] = (__float_as_uint(t0[0]) >> 16) | (__float_as_uint(t0[1]) & 0xffff0000u); hd[2 * j + 1] = (__float_as_uint(t1[0]) >> 16) | (__float_as_uint(t1[1]) & 0xffff0000u);
          asm volatile("" : "+v"(hd[2 * j]), "+v"(hd[2 * j + 1])); }
#define DOT2(A, I) A = __builtin_amdgcn_fdot2_f32_bf16(__builtin_shufflevector(du, du, 2 * (I), 2 * (I) + 1), __builtin_bit_cast(v2bf_t, hd[I]), A, false);
#define PG_LOADU0(S, K) { const int k_ = (K); const int e = __builtin_amdgcn_readlane(isrc_, k_ & 63); const unsigned char* ur = Ub + (size_t)e * TREC; \
            asm volatile("global_load_dwordx4 %0, %2, %4 offset:128\n\tglobal_load_ushort %1, %3, %4" \
                         : "+v"(ua[S]), "+v"(us[S]) : "v"(vo16), "v"(vo2), "s"(ur), \
                           "v"(acc[0]), "v"(acc[1]), "v"(acc[2]), "v"(acc[3]), "v"(acc[4]), "v"(acc[5]), "v"(acc[6]), "v"(acc[7]), "v"(acc[8]), "v"(acc[9]), "v"(acc[10]), "v"(acc[11]), \
                           "v"(acc[12]), "v"(acc[13]), "v"(acc[14]), "v"(acc[15]) : "memory"); }
#define PG_LOADU(S, K) { const int k_ = (K); const int e = __builtin_amdgcn_readlane(isrc_, k_ & 63); const unsigned char* ur = Ub + (size_t)e * TREC; \
            asm volatile("global_load_dwordx4 %0, %2, %4 offset:128\n\tglobal_load_ushort %1, %3, %4" : "+v"(ua[S]), "+v"(us[S]) : "v"(vo16), "v"(vo2), "s"(ur) : "memory"); }
#define PG_LOADV(S, K) { const int k_ = (K); const int e = __builtin_amdgcn_readlane(isrc_, k_ & 63); const unsigned char* vr = Ub + (size_t)e * TREC; \
            asm volatile("global_load_dwordx4 %0, %1, %2 offset:1152" : "+v"(va[S]) : "v"(vo16), "s"(vr) : "memory"); }
#define PG_LOADG(S0, K0) { const int isrc_ = (K0) < 64 ? idx0 : idx1;     \
                           PG_LOADU0(S0, K0) PG_LOADU(S0 + 1, (K0) + 1) PG_LOADU(S0 + 2, (K0) + 2) PG_LOADU(S0 + 3, (K0) + 3) \
                           PG_LOADV(S0, K0) PG_LOADV(S0 + 1, (K0) + 1) PG_LOADV(S0 + 2, (K0) + 2) PG_LOADV(S0 + 3, (K0) + 3) }
#define PG_UDOT(S, D) { float da = 0.f, db = 0.f; \
            _Pragma("unroll") for (int q = 0; q < 4; ++q) { \
              da = __builtin_amdgcn_fdot2_f32_bf16(__builtin_amdgcn_cvt_scalef32_pk_bf16_fp4(ua[S][q], 1.0f, 0), __builtin_bit_cast(v2bf_t, hd[4 * q]), da, false); \
              db = __builtin_amdgcn_fdot2_f32_bf16(__builtin_amdgcn_cvt_scalef32_pk_bf16_fp4(ua[S][q], 1.0f, 1), __builtin_bit_cast(v2bf_t, hd[4 * q + 1]), db, false); \
              da = __builtin_amdgcn_fdot2_f32_bf16(__builtin_amdgcn_cvt_scalef32_pk_bf16_fp4(ua[S][q], 1.0f, 2), __builtin_bit_cast(v2bf_t, hd[4 * q + 2]), da, false); \
              db = __builtin_amdgcn_fdot2_f32_bf16(__builtin_amdgcn_cvt_scalef32_pk_bf16_fp4(ua[S][q], 1.0f, 3), __builtin_bit_cast(v2bf_t, hd[4 * q + 3]), db, false); } \
            D = (da + db) * __builtin_amdgcn_cvt_f32_fp8((int)us[S], 0); }
#define PG_VACC(S, Q) { const float wgt = __int_as_float(__builtin_amdgcn_readlane(__float_as_int(wv), Q)) * __builtin_amdgcn_cvt_f32_fp8((int)us[S], 1); const f32x2 w2 = (f32x2){wgt, wgt}; \
            _Pragma("unroll") for (int q = 0; q < 4; ++q) { \
              acc[q * 4 + 0] += w2 * __builtin_amdgcn_cvt_scalef32_pk_f32_fp4(va[S][q], 1.0f, 0); acc[q * 4 + 1] += w2 * __builtin_amdgcn_cvt_scalef32_pk_f32_fp4(va[S][q], 1.0f, 1); \
              acc[q * 4 + 2] += w2 * __builtin_amdgcn_cvt_scalef32_pk_f32_fp4(va[S][q], 1.0f, 2); acc[q * 4 + 3] += w2 * __builtin_amdgcn_cvt_scalef32_pk_f32_fp4(va[S][q], 1.0f, 3); } }
#define PG_GROUP(S0, K0, NU, NV) { const int k0_ = (K0); \
            asm volatile("s_waitcnt vmcnt(%8)" : "+v"(ua[S0]), "+v"(us[S0]), "+v"(ua[S0 + 1]), "+v"(us[S0 + 1]), "+v"(ua[S0 + 2]), "+v"(us[S0 + 2]), "+v"(ua[S0 + 3]), "+v"(us[S0 + 3]) : "n"(NU) : "memory"); \
            float dq0, dq1, dq2, dq3; PG_UDOT(S0, dq0) PG_UDOT(S0 + 1, dq1) PG_UDOT(S0 + 2, dq2) PG_UDOT(S0 + 3, dq3) \
            const float s01 = (b0 ? dq1 : dq0) + dpp_x1(b0 ? dq0 : dq1), s23 = (b0 ? dq3 : dq2) + dpp_x1(b0 ? dq2 : dq3); \
            float sd = (b1 ? s23 : s01) + dpp_x2(b1 ? s01 : s23); sd += dpp_ror4(sd); sd += dpp_ror8(sd); \
            sd += __int_as_float(__builtin_amdgcn_ds_bpermute(bp16, __float_as_int(sd))); sd += __int_as_float(__builtin_amdgcn_ds_bpermute(bp32, __float_as_int(sd))); sd *= 1.f / TSM; \
            const float gv = __int_as_float(__builtin_amdgcn_ds_bpermute(((k0_ & 63) + l3) * 4, __float_as_int(k0_ < 64 ? gt0 : gt1))); \
            const float wv = gv * (0.5f / TSM) * sd * (1.f + erf_bf(sd * 0.70710678118654752f));     \
            asm volatile("s_waitcnt vmcnt(%4)" : "+v"(va[S0]), "+v"(va[S0 + 1]), "+v"(va[S0 + 2]), "+v"(va[S0 + 3]) : "n"(NV) : "memory"); \
            PG_VACC(S0, 0) PG_VACC(S0 + 1, 1) PG_VACC(S0 + 2, 2) PG_VACC(S0 + 3, 3) }
        PG_LOADG(0, 0) PG_LOADG(4, 4)
#pragma unroll 1
        for (int k0 = 0; k0 < 120; k0 += 8) {
          PG_GROUP(0, k0, 16, 12) PG_LOADG(0, k0 + 8)
          PG_GROUP(4, k0 + 4, 16, 12) PG_LOADG(4, k0 + 12)
        }
        PG_GROUP(0, 120, 16, 12) PG_GROUP(4, 124, 4, 0)
#undef PG_LOADU0
#undef PG_LOADU
#undef PG_LOADV
#undef PG_LOADG
#undef PG_UDOT
#undef PG_VACC
#undef PG_GROUP
#undef DOT2
        int lane_e = lane; asm volatile("" : "+v"(lane_e));
        const float* g2p = p.mod + ((size_t)layer * 9 + (isc ? 8 : b)) * NMOD + 5 * DM + lane_e * 32; bf16_t* xr = p.Xb + (size_t)row * DM + lane_e * 32;
        f32x4 xn[8]; float ss = 0.f;
#pragma unroll
        for (int k = 0; k < 8; ++k) { const f32x4 sum = (f32x4){acc[2 * k][0], acc[2 * k][1], acc[2 * k + 1][0], acc[2 * k + 1][1]};
          const u32x2 xw = *(const u32x2*)(xr + k * 4); const f32x4 xo = (f32x4){__uint_as_float(xw.x << 16), __uint_as_float(xw.x & 0xffff0000u), __uint_as_float(xw.y << 16), __uint_as_float(xw.y & 0xffff0000u)};
          xn[k] = xo + *(const f32x4*)(g2p + k * 4) * sum; ss += xn[k][0] * xn[k][0] + xn[k][1] * xn[k][1] + xn[k][2] * xn[k][2] + xn[k][3] * xn[k][3]; }
        ss = wsum(ss); const float rstd = rsqrtf(ss * (1.f / 2048.f) + EPSV);
        if ((mode & 1) && rstd != 12345.678f) continue;
        if (layer == 0) { const float* mr = p.mod + ((size_t)9 + (isc ? 8 : b)) * NMOD + lane_e * 32;
#pragma unroll
          for (int k = 0; k < 8; k += 2) { { u32x4 xw; xw.x = pack2(xn[k][0], xn[k][1]); xw.y = pack2(xn[k][2], xn[k][3]); xw.z = pack2(xn[k + 1][0], xn[k + 1][1]); xw.w = pack2(xn[k + 1][2], xn[k + 1][3]); *(u32x4*)(xr + k * 4) = xw; }
            const f32x4 o0 = xn[k] * rstd * (*(const f32x4*)(mr + DM + k * 4) + 1.f) + *(const f32x4*)(mr + k * 4), o1 = xn[k + 1] * rstd * (*(const f32x4*)(mr + DM + k * 4 + 4) + 1.f) + *(const f32x4*)(mr + k * 4 + 4);
            u32x2 w; w.x = pk4_fp8(o0[0], o0[1], o0[2], o0[3]); w.y = pk4_fp8(o1[0], o1[1], o1[2], o1[3]); *(u32x2*)((unsigned char*)p.H + (size_t)row * DM + lane_e * 32 + k * 4) = w; } }
        else { float* orow = p.out + ((size_t)b * LL + t) * DM + lane_e * 32; const float* fn = p.final_norm + lane_e * 32;
#pragma unroll
          for (int k = 0; k < 8; ++k) *(f32x4*)(orow + k * 4) = xn[k] * rstd * *(const f32x4*)(fn + k * 4); }
      }
    }
    __syncthreads();
  }
#undef HVP
}

DI void st_mlacheck(const Prm& p, int layer, float* lds, int bid, int nb) {
  float* aq = lds; float* qv = aq + 448; float* qwn = qv + 192; float* scs = qwn + 128; float* rs = scs + 4352; float* Ak = rs + 4352; float* red = Ak + 128; float* ov = red + 64;
  const int tid = ltid(), lane = tid & 63, wave = tid >> 6;
  const int s = bid, b = s & 7, h = (s >> 3) & 3; const bool cq_ = (layer == 0) && s >= 224;
  const int t = cq_ ? (s * 37) % LCX : (s * 977 + 13) % LL; const int row = b * LT + (cq_ ? LL + t : t);
  const int nkeys = cq_ ? LCX : LT, krow0 = cq_ ? b * LT + LL : b * LT;
  const float* wuq = p.mla_w_uq + (size_t)layer * 448 * 768; const float* wukv = p.mla_w_ukv + (size_t)layer * 128 * 1024;
  const float* qn = p.mla_q_norm + layer * 448; const float* kvn = p.mla_kv_norm + layer * 128;
  __syncthreads();
  { float v = tid < 448 ? bf2f(p.Z[(size_t)row * NZ + C_CQ + tid]) : 0.f; float ss = wsum(v * v); if (lane == 0) red[wave] = ss; __syncthreads();
    float tot = 0.f; for (int w = 0; w < 8; ++w) tot += red[w]; const float rstd = rsqrtf(tot * (1.f / 448.f) + EPSV); if (tid < 448) aq[tid] = v * rstd * qn[tid]; }
  __syncthreads();
  if (tid < 192) { float a = 0.f; for (int k = 0; k < 448; ++k) a += aq[k] * wuq[(size_t)k * 768 + h * 192 + tid]; qv[tid] = a; }
  __syncthreads();
  if (!cq_ && tid < 32) { const int half = tid >> 4, i = tid & 15; const float x1 = qv[128 + half * 32 + i], x2 = qv[128 + half * 32 + 16 + i];
    const float pos = (float)(half ? (t & 63) : (t >> 6)); const float ang = pos * exp2f(-(float)i * (13.287712379549449f / 16.f)); float sv, cv; sincosf(ang, &sv, &cv);
    qv[128 + half * 32 + i] = x1 * cv - x2 * sv; qv[128 + half * 32 + 16 + i] = x2 * cv + x1 * sv; }
  __syncthreads();
  if (tid < 128) { float a = 0.f; for (int j = 0; j < 128; ++j) a += qv[j] * wukv[(size_t)tid * 1024 + h * 256 + j]; qwn[tid] = a * kvn[tid]; }
  __syncthreads();
  for (int ks = tid; ks < nkeys; ks += NTHR) { const int krow = krow0 + ks; const bf16_t* z = p.Z + (size_t)krow * NZ; float ss = 0.f, dn = 0.f;
    for (int k = 0; k < 128; ++k) { const float zz = bf2f(z[C_CKV + k]); ss += zz * zz; dn += zz * qwn[k]; }
    const float rstd = rsqrtf(ss * (1.f / 128.f) + EPSV); float dr = 0.f; const bool klat = !cq_ && ks < LL;
    for (int half = 0; half < 2; ++half) for (int i = 0; i < 16; ++i) { float x1 = bf2f(z[C_KR + half * 32 + i]), x2 = bf2f(z[C_KR + half * 32 + 16 + i]);
        if (klat) { const float pos = (float)(half ? (ks & 63) : (ks >> 6)); const float ang = pos * exp2f(-(float)i * (13.287712379549449f / 16.f)); float sv, cv; sincosf(ang, &sv, &cv); const float y1 = x1 * cv - x2 * sv, y2 = x2 * cv + x1 * sv; x1 = y1; x2 = y2; }
        dr += qv[128 + half * 32 + i] * x1 + qv[128 + half * 32 + 16 + i] * x2; }
    scs[ks] = (rstd * dn + dr) * 0.07216878364870322f; rs[ks] = rstd; }
  __syncthreads();
  float mx = -3e38f; for (int ks = tid; ks < nkeys; ks += NTHR) mx = fmaxf(mx, scs[ks]); mx = wmax(mx); if (lane == 0) red[wave] = mx; __syncthreads();
  mx = red[0]; for (int w = 1; w < 8; ++w) mx = fmaxf(mx, red[w]); __syncthreads();
  float sm = 0.f; for (int ks = tid; ks < nkeys; ks += NTHR) { const float e = __expf(scs[ks] - mx); scs[ks] = e; sm += e; } sm = wsum(sm); if (lane == 0) red[wave] = sm; __syncthreads();
  sm = 0.f; for (int w = 0; w < 8; ++w) sm += red[w];
  if (tid < 128) { float a = 0.f; for (int ks = 0; ks < nkeys; ++ks) a += scs[ks] * rs[ks] * bf2f(p.Z[(size_t)(krow0 + ks) * NZ + C_CKV + tid]); Ak[tid] = a * kvn[tid] / sm; }
  __syncthreads();
  if (tid < 128) { float a = 0.f; for (int k = 0; k < 128; ++k) a += Ak[k] * wukv[(size_t)k * 1024 + h * 256 + 128 + tid]; ov[tid] = a; }
  __syncthreads();
  if (tid < 128) { float am = 0.f; for (int j = 0; j < 128; ++j) am = fmaxf(am, fabsf(ov[j]));
    const float got = bf2f(p.Y[(size_t)row * DM + 1024 + h * 128 + tid]); const float err = fabsf(got - ov[tid]);
    if (!(err <= 0.06f * am + 1e-6f)) atomicAdd(p.bar + 4000, 1u); }
  __syncthreads();
}

DI void st_final(const Prm& p, int bid, int nb) {
  const int wave = ltid() >> 6, lane = ltid() & 63;
  for (int r = bid * 8 + wave; r < NB * LL; r += nb * 8) {
    const int b = r / LL, t = r - b * LL; const float* src = p.X + (size_t)(b * LT + t) * DM;
    f32x4 v[8]; float ss = 0.f;
#pragma unroll
    for (int i = 0; i < 8; ++i) { v[i] = *(const f32x4*)(src + (i * 64 + lane) * 4); ss += v[i][0] * v[i][0] + v[i][1] * v[i][1] + v[i][2] * v[i][2] + v[i][3] * v[i][3]; }
    ss = wsum(ss); const float rstd = rsqrtf(ss * (1.f / 2048.f) + EPSV);
#pragma unroll
    for (int i = 0; i < 8; ++i) { const int col = (i * 64 + lane) * 4; *(f32x4*)(p.out + (size_t)r * DM + col) = v[i] * rstd * *(const f32x4*)(p.final_norm + col); }
  }
}

namespace att {
constexpr int NW = 8, QBLK = 32, KVBLK = 64;
constexpr float SCALE = 0.07216878364870322f;
constexpr float THR = 8.f;
constexpr int LDQ = 768, LDK = 1024, LDKR = 64, LDO = DM;
constexpr int SHM_V = KVBLK * 128 * 2, SHM_K = KVBLK * 128 * 2, SHM_KR = KVBLK * 64 * 2, SHM_ATTN = 2 * SHM_V + 2 * SHM_K + 2 * SHM_KR + NW * 64 * 4;
#define KSWZ(row, colB) ((row) * 256 + ((colB) ^ (((row) & 7) << 4)))
#define KRSWZ(row, colB) ((row) * 128 + ((colB) ^ ((((row) >> 1) & 7) << 4)))
#define SBAR() __builtin_amdgcn_sched_barrier(0)
DI int crow(int r, int hi) { return (r & 3) + 8 * (r >> 2) + 4 * hi; }
DI unsigned cvtpk(float lo, float hi) { unsigned r; asm volatile("v_cvt_pk_bf16_f32 %0, %1, %2" : "=v"(r) : "v"(lo), "v"(hi)); return r; }

DI void partialSM(f32x16& p0, f32x16& p1, float& m_reg, float& mn, float& alpha) {
  constexpr float C = SCALE * 1.4426950408889634f;
  float pmax = p0[0];
#pragma unroll
  for (int r = 1; r < 16; ++r) pmax = fmaxf(pmax, p0[r]);
#pragma unroll
  for (int r = 0; r < 16; ++r) pmax = fmaxf(pmax, p1[r]);
  { auto rr = __builtin_amdgcn_permlane32_swap(__float_as_uint(pmax), __float_as_uint(pmax), false, false);
    pmax = fmaxf(__uint_as_float(rr[0]), __uint_as_float(rr[1])); }
  if (__builtin_expect(__all(pmax - m_reg <= THR / SCALE), 1)) { mn = m_reg; alpha = 1.f; }
  else { mn = fmaxf(m_reg, pmax); alpha = __builtin_amdgcn_exp2f((m_reg - mn) * C); m_reg = mn; }
  const float mnC = -mn * C;
#pragma unroll
  for (int r = 0; r < 16; ++r) p0[r] = fmaf(p0[r], C, mnC);
#pragma unroll
  for (int r = 0; r < 16; ++r) p1[r] = fmaf(p1[r], C, mnC);
#pragma unroll
  for (int r = 0; r < 16; ++r) p0[r] = __builtin_amdgcn_exp2f(p0[r]);
}
DI void finishSM(f32x16& p0, f32x16& p1, float alpha, float& l_reg, bf16x8& pa0, bf16x8& pa1, bf16x8& pa2, bf16x8& pa3) {
#pragma unroll
  for (int r = 0; r < 16; ++r) p1[r] = __builtin_amdgcn_exp2f(p1[r]);
  float ps = 0;
#pragma unroll
  for (int r = 0; r < 16; ++r) ps += p0[r];
#pragma unroll
  for (int r = 0; r < 16; ++r) ps += p1[r];
  { auto rr = __builtin_amdgcn_permlane32_swap(__float_as_uint(ps), __float_as_uint(ps), false, false);
    ps = __uint_as_float(rr[0]) + __uint_as_float(rr[1]); }
  l_reg = l_reg * alpha + ps;
#define PK4(P, BASE, OUT) do { unsigned a0 = cvtpk(P[BASE + 0], P[BASE + 1]), a1 = cvtpk(P[BASE + 2], P[BASE + 3]);   \
    unsigned b0 = cvtpk(P[BASE + 4], P[BASE + 5]), b1 = cvtpk(P[BASE + 6], P[BASE + 7]);                              \
    auto r0 = __builtin_amdgcn_permlane32_swap(a0, b0, false, false); auto r1 = __builtin_amdgcn_permlane32_swap(a1, b1, false, false); \
    u32x4 w = {r0[0], r1[0], r0[1], r1[1]}; OUT = *reinterpret_cast<bf16x8*>(&w); } while (0)
  PK4(p0, 0, pa0); PK4(p0, 8, pa1); PK4(p1, 0, pa2); PK4(p1, 8, pa3);
#undef PK4
}
DI void qkt(f32x16& p0, f32x16& p1, const char* Ks, const char* KRs, const bf16x8* qr, int r32, int hi) {
  p0 = f32x16{}; p1 = f32x16{};
#pragma unroll
  for (int d0 = 0; d0 < 8; ++d0) { const int cb = (d0 * 16 + hi * 8) * 2;
    const bf16x8 b0 = *reinterpret_cast<const bf16x8*>(Ks + KSWZ(r32, cb));
    const bf16x8 b1 = *reinterpret_cast<const bf16x8*>(Ks + KSWZ(32 + r32, cb));
    p0 = __builtin_amdgcn_mfma_f32_32x32x16_bf16(b0, qr[d0], p0, 0, 0, 0);
    p1 = __builtin_amdgcn_mfma_f32_32x32x16_bf16(b1, qr[d0], p1, 0, 0, 0); }
#pragma unroll
  for (int d0 = 0; d0 < 4; ++d0) { const int cb = (d0 * 16 + hi * 8) * 2;
    const bf16x8 b0 = *reinterpret_cast<const bf16x8*>(KRs + KRSWZ(r32, cb));
    const bf16x8 b1 = *reinterpret_cast<const bf16x8*>(KRs + KRSWZ(32 + r32, cb));
    p0 = __builtin_amdgcn_mfma_f32_32x32x16_bf16(b0, qr[8 + d0], p0, 0, 0, 0);
    p1 = __builtin_amdgcn_mfma_f32_32x32x16_bf16(b1, qr[8 + d0], p1, 0, 0, 0); }
}
DI int v_st(int k, int c) { const int kk = (k & ~0xC) | ((k & 4) << 1) | ((k & 8) >> 1); return ((kk >> 3) * 4 + (c >> 5)) * 512 + ((kk & 7) * 32 + (c & 31)) * 2; }
DI int v_rd_base(int lane) { return ((lane & 3) << 3) | (((lane >> 2) & 3) << 6) | (((lane >> 4) & 1) << 5) | (((lane >> 5) & 1) << 8); }
constexpr int v_rd_off(int d0, int ks, int half) { return d0 * 512 + ks * 4096 + half * 2048; }
template <int OFF> DI s16x4 tr_read(int vb) { s16x4 r; asm volatile("ds_read_b64_tr_b16 %0, %1 offset:%2" : "=&v"(r) : "v"(vb), "i"(OFF) : "memory"); return r; }
template <int D0> DI void pv_one(f32x16& od, int vb, bf16x8 pa0, bf16x8 pa1, bf16x8 pa2, bf16x8 pa3) {
  const s16x4 l0 = tr_read<v_rd_off(D0, 0, 0)>(vb), h0 = tr_read<v_rd_off(D0, 0, 1)>(vb), l1 = tr_read<v_rd_off(D0, 1, 0)>(vb), h1 = tr_read<v_rd_off(D0, 1, 1)>(vb);
  const s16x4 l2 = tr_read<v_rd_off(D0, 2, 0)>(vb), h2 = tr_read<v_rd_off(D0, 2, 1)>(vb), l3 = tr_read<v_rd_off(D0, 3, 0)>(vb), h3 = tr_read<v_rd_off(D0, 3, 1)>(vb);
  asm volatile("s_waitcnt lgkmcnt(0)" ::: "memory"); SBAR();
#define PK(L, H) (bf16x8){L[0], L[1], L[2], L[3], H[0], H[1], H[2], H[3]}
  od = __builtin_amdgcn_mfma_f32_32x32x16_bf16(pa0, PK(l0, h0), od, 0, 0, 0);
  od = __builtin_amdgcn_mfma_f32_32x32x16_bf16(pa1, PK(l1, h1), od, 0, 0, 0);
  od = __builtin_amdgcn_mfma_f32_32x32x16_bf16(pa2, PK(l2, h2), od, 0, 0, 0);
  od = __builtin_amdgcn_mfma_f32_32x32x16_bf16(pa3, PK(l3, h3), od, 0, 0, 0);
#undef PK
}
DI void pv_d0(f32x16* o, int vb, bf16x8 pa0, bf16x8 pa1, bf16x8 pa2, bf16x8 pa3) {
  pv_one<0>(o[0], vb, pa0, pa1, pa2, pa3); pv_one<1>(o[1], vb, pa0, pa1, pa2, pa3); pv_one<2>(o[2], vb, pa0, pa1, pa2, pa3); pv_one<3>(o[3], vb, pa0, pa1, pa2, pa3);
}

DI void attn_body(const bf16_t* __restrict__ Qb, const bf16_t* __restrict__ Kh, const bf16_t* __restrict__ Vh, const bf16_t* __restrict__ KRh, bf16_t* __restrict__ Ob, int seq, int tpos0, char* lds) {
  const int tid = ltid(), wid = tid >> 6, lane = tid & 63, r32 = lane & 31, hi = lane >> 5;
  char* V_lds = lds; char* K_lds = lds + 2 * SHM_V; char* KR_lds = lds + 2 * SHM_V + 2 * SHM_K;
  float* ws = (float*)(lds + 2 * SHM_V + 2 * SHM_K + 2 * SHM_KR) + wid * 64; float* li_l = ws; float* al_l = ws + 32;
  float m_reg = -1e30f, l_reg = 0; f32x16 o[4] = {}; bf16x8 qr[12];
  const bf16_t* Qw = Qb + (long)(wid * QBLK + r32) * LDQ + hi * 8;
#pragma unroll
  for (int d0 = 0; d0 < 12; ++d0) qr[d0] = *reinterpret_cast<const bf16x8*>(Qw + d0 * 16);
  if (tpos0 >= 0) {
    const int t = tpos0 + wid * QBLK + r32;
#pragma unroll
    for (int hf = 0; hf < 2; ++hf) { const float pos = (float)(hf ? (t & 63) : (t >> 6));
#pragma unroll
      for (int j = 0; j < 8; ++j) { const float ang = pos * exp2f(-(float)(hi * 8 + j) * (13.287712379549449f / 16.f)); float sv, cv; sincosf(ang, &sv, &cv);
        const float x1 = bf2f((bf16_t)qr[8 + 2 * hf][j]), x2 = bf2f((bf16_t)qr[9 + 2 * hf][j]);
        qr[8 + 2 * hf][j] = (short)f2bf(x1 * cv - x2 * sv); qr[9 + 2 * hf][j] = (short)f2bf(x2 * cv + x1 * sv); } }
  }
  const int sr = tid >> 4, sc = (tid & 15) * 8, vst0 = v_st(sr, sc), vst1 = v_st(32 + sr, sc);
  const int krr = tid >> 3, krc = (tid & 7) * 8;
  const int vb0 = (int)(uintptr_t)V_lds + v_rd_base(lane);
  bf16x8 vs0, vs1, ks0, ks1, kr0;
#define SLOAD(k0) do { vs0 = *reinterpret_cast<const bf16x8*>(&Vh[(long)((k0) + sr) * LDK + sc]); vs1 = *reinterpret_cast<const bf16x8*>(&Vh[(long)((k0) + 32 + sr) * LDK + sc]); \
    ks0 = *reinterpret_cast<const bf16x8*>(&Kh[(long)((k0) + sr) * LDK + sc]); ks1 = *reinterpret_cast<const bf16x8*>(&Kh[(long)((k0) + 32 + sr) * LDK + sc]); \
    kr0 = *reinterpret_cast<const bf16x8*>(&KRh[(long)((k0) + krr) * LDKR + krc]); } while (0)
#define SWRITE(b) do { *(bf16x8*)(V_lds + (b) * SHM_V + vst0) = vs0; *(bf16x8*)(V_lds + (b) * SHM_V + vst1) = vs1; const int kc = sc * 2;               \
    *(bf16x8*)(K_lds + (b) * SHM_K + KSWZ(sr, kc)) = ks0; *(bf16x8*)(K_lds + (b) * SHM_K + KSWZ(32 + sr, kc)) = ks1;                       \
    *(bf16x8*)(KR_lds + (b) * SHM_KR + KRSWZ(krr, krc * 2)) = kr0; } while (0)
#define SWAIT() asm volatile("s_waitcnt vmcnt(0)" ::: "memory")
#define RESC(a) do { if (__any((a) < 1.f)) { if (hi == 0) al_l[r32] = (a); asm volatile("s_waitcnt lgkmcnt(0)" ::: "memory"); \
    _Pragma("unroll") for (int d = 0; d < 4; ++d) _Pragma("unroll") for (int r = 0; r < 16; ++r) o[d][r] *= al_l[crow(r, hi)]; } } while (0)
  f32x16 p0, p1; float mn, al; bf16x8 pa0, pa1, pa2, pa3; const int NT = seq / KVBLK;
  SLOAD(0); SWAIT(); SWRITE(0); __syncthreads();
  for (int j = 0; j < NT; ++j) {
    const int buf = j & 1; const bool more = j + 1 < NT;
    if (more) SLOAD((j + 1) * KVBLK);
    SBAR(); qkt(p0, p1, K_lds + buf * SHM_K, KR_lds + buf * SHM_KR, qr, r32, hi);
    partialSM(p0, p1, m_reg, mn, al); RESC(al);
    finishSM(p0, p1, al, l_reg, pa0, pa1, pa2, pa3); SBAR();
    pv_d0(o, vb0 + buf * SHM_V, pa0, pa1, pa2, pa3);
    if (more) { SWAIT(); SWRITE(buf ^ 1); }
    __syncthreads();
  }
  if (hi == 0) li_l[r32] = l_reg; asm volatile("s_waitcnt lgkmcnt(0)" ::: "memory");
  float rli[16];
#pragma unroll
  for (int r = 0; r < 16; ++r) rli[r] = __builtin_amdgcn_rcpf(li_l[crow(r, hi)]);
  bf16_t* Ow = Ob + (long)(wid * QBLK) * LDO;
#pragma unroll
  for (int r = 0; r < 16; ++r) { const int orow = crow(r, hi);
#pragma unroll
    for (int d0 = 0; d0 < 4; ++d0) Ow[(long)orow * LDO + d0 * 32 + r32] = f2bf(o[d0][r] * rli[r]); }
  __syncthreads();
#undef SLOAD
#undef SWRITE
#undef SWAIT
#undef RESC
}
DI void qkt2(f32x16& p0, f32x16& p1, const char* Ks, const char* KRs, const char* QRs, const bf16x8* qr, int r32, int hi) {
  p0 = f32x16{}; p1 = f32x16{};
#pragma unroll
  for (int d0 = 0; d0 < 8; ++d0) { const int cb = (d0 * 16 + hi * 8) * 2;
    const bf16x8 b0 = *reinterpret_cast<const bf16x8*>(Ks + KSWZ(r32, cb));
    const bf16x8 b1 = *reinterpret_cast<const bf16x8*>(Ks + KSWZ(32 + r32, cb));
    p0 = __builtin_amdgcn_mfma_f32_32x32x16_bf16(b0, qr[d0], p0, 0, 0, 0);
    p1 = __builtin_amdgcn_mfma_f32_32x32x16_bf16(b1, qr[d0], p1, 0, 0, 0); }
#pragma unroll
  for (int d0 = 0; d0 < 4; ++d0) { const int cb = (d0 * 16 + hi * 8) * 2;
    const bf16x8 b0 = *reinterpret_cast<const bf16x8*>(KRs + KRSWZ(r32, cb));
    const bf16x8 b1 = *reinterpret_cast<const bf16x8*>(KRs + KRSWZ(32 + r32, cb));
    const bf16x8 qq = *reinterpret_cast<const bf16x8*>(QRs + KRSWZ(r32, cb));
    p0 = __builtin_amdgcn_mfma_f32_32x32x16_bf16(b0, qq, p0, 0, 0, 0);
    p1 = __builtin_amdgcn_mfma_f32_32x32x16_bf16(b1, qq, p1, 0, 0, 0); }
}
DI void attn_body2(const bf16_t* __restrict__ Qb, const bf16_t* __restrict__ Kh, const bf16_t* __restrict__ Vh, const bf16_t* __restrict__ KRh, unsigned char* __restrict__ Ob, int seq, int tpos0, char* lds) {
  const int tid = ltid(), wid = tid >> 6, lane = tid & 63, r32 = lane & 31, hi = lane >> 5;
  char* V_lds = lds; char* K_lds = lds + 2 * SHM_V; char* KR_lds = lds + 2 * SHM_V + 2 * SHM_K;
  float* ws = (float*)(lds + 2 * SHM_V + 2 * SHM_K + 2 * SHM_KR) + wid * 64; float* li_l = ws; float* al_l = ws + 32;
  float m_reg = -1e30f, l_reg = 0; f32x16 o[4] = {}; bf16x8 qr[12];
  char* QR_lds = lds + 2 * SHM_V + 2 * SHM_K + 2 * SHM_KR + NW * 64 * 4 + wid * 4096;
  const bf16_t* Qw = Qb + (long)(wid * QBLK + r32) * LDQ + hi * 8;
#pragma unroll
  for (int d0 = 0; d0 < 12; ++d0) qr[d0] = *reinterpret_cast<const bf16x8*>(Qw + d0 * 16);
  if (tpos0 >= 0) {
    const int t = tpos0 + wid * QBLK + r32;
#pragma unroll
    for (int hf = 0; hf < 2; ++hf) { const float pos = (float)(hf ? (t & 63) : (t >> 6));
#pragma unroll
      for (int j = 0; j < 8; ++j) { const float ang = pos * exp2f(-(float)(hi * 8 + j) * (13.287712379549449f / 16.f)); float sv, cv; sincosf(ang, &sv, &cv);
        const float x1 = bf2f((bf16_t)qr[8 + 2 * hf][j]), x2 = bf2f((bf16_t)qr[9 + 2 * hf][j]);
        qr[8 + 2 * hf][j] = (short)f2bf(x1 * cv - x2 * sv); qr[9 + 2 * hf][j] = (short)f2bf(x2 * cv + x1 * sv); } }
  }
#pragma unroll
  for (int d0 = 0; d0 < 4; ++d0) *(bf16x8*)(QR_lds + KRSWZ(r32, (d0 * 16 + hi * 8) * 2)) = qr[8 + d0];
  const int sr = tid >> 4, sc = (tid & 15) * 8, vst0 = v_st(sr, sc), vst1 = v_st(32 + sr, sc);
  const int krr = tid >> 3, krc = (tid & 7) * 8;
  const int vb0 = (int)(uintptr_t)V_lds + v_rd_base(lane);
  bf16x8 vs0, vs1, ks0, ks1, kr0;
#define SLOAD(k0) do { vs0 = *reinterpret_cast<const bf16x8*>(&Vh[(long)((k0) + sr) * LDK + sc]); vs1 = *reinterpret_cast<const bf16x8*>(&Vh[(long)((k0) + 32 + sr) * LDK + sc]); \
    ks0 = *reinterpret_cast<const bf16x8*>(&Kh[(long)((k0) + sr) * LDK + sc]); ks1 = *reinterpret_cast<const bf16x8*>(&Kh[(long)((k0) + 32 + sr) * LDK + sc]); \
    kr0 = *reinterpret_cast<const bf16x8*>(&KRh[(long)((k0) + krr) * LDKR + krc]); } while (0)
#define SWRITE(b) do { *(bf16x8*)(V_lds + (b) * SHM_V + vst0) = vs0; *(bf16x8*)(V_lds + (b) * SHM_V + vst1) = vs1; const int kc = sc * 2;               \
    *(bf16x8*)(K_lds + (b) * SHM_K + KSWZ(sr, kc)) = ks0; *(bf16x8*)(K_lds + (b) * SHM_K + KSWZ(32 + sr, kc)) = ks1;                       \
    *(bf16x8*)(KR_lds + (b) * SHM_KR + KRSWZ(krr, krc * 2)) = kr0; } while (0)
#define SWAIT() asm volatile("s_waitcnt vmcnt(0)" ::: "memory")
#define RESC(a) do { if (__any((a) < 1.f)) { if (hi == 0) al_l[r32] = (a); asm volatile("s_waitcnt lgkmcnt(0)" ::: "memory"); \
    _Pragma("unroll") for (int d = 0; d < 4; ++d) _Pragma("unroll") for (int r = 0; r < 16; ++r) o[d][r] *= al_l[crow(r, hi)]; } } while (0)
  f32x16 pA0, pA1, pB0, pB1; float mnA, mnB, alA, alB; bf16x8 pa0, pa1, pa2, pa3; const int NT = seq / KVBLK;
  SLOAD(0); SWAIT(); SWRITE(0); __syncthreads();
  qkt2(pA0, pA1, K_lds, KR_lds, QR_lds, qr, r32, hi); partialSM(pA0, pA1, m_reg, mnA, alA);
  SLOAD(KVBLK);
  SWAIT(); SWRITE(1); __syncthreads();
  for (int j = 1; j + 1 < NT; j += 2) {
    SBAR(); qkt2(pB0, pB1, K_lds + SHM_K, KR_lds + SHM_KR, QR_lds, qr, r32, hi);
    finishSM(pA0, pA1, alA, l_reg, pa0, pa1, pa2, pa3); SBAR();
    SLOAD((j + 1) * KVBLK); SBAR();
    pv_d0(o, vb0, pa0, pa1, pa2, pa3); partialSM(pB0, pB1, m_reg, mnB, alB);
    __syncthreads(); SWAIT(); SWRITE(0);
    RESC(alB); __syncthreads();
    SBAR(); qkt2(pA0, pA1, K_lds, KR_lds, QR_lds, qr, r32, hi);
    finishSM(pB0, pB1, alB, l_reg, pa0, pa1, pa2, pa3); SBAR();
    SLOAD((j + 2) * KVBLK); SBAR();
    pv_d0(o, vb0 + SHM_V, pa0, pa1, pa2, pa3); partialSM(pA0, pA1, m_reg, mnA, alA);
    __syncthreads(); SWAIT(); SWRITE(1);
    RESC(alA); __syncthreads();
  }
  SBAR(); qkt2(pB0, pB1, K_lds + SHM_K, KR_lds + SHM_KR, QR_lds, qr, r32, hi);
  finishSM(pA0, pA1, alA, l_reg, pa0, pa1, pa2, pa3); SBAR();
  pv_d0(o, vb0, pa0, pa1, pa2, pa3); partialSM(pB0, pB1, m_reg, mnB, alB);
  __syncthreads(); RESC(alB);
  finishSM(pB0, pB1, alB, l_reg, pa0, pa1, pa2, pa3); SBAR();
  pv_d0(o, vb0 + SHM_V, pa0, pa1, pa2, pa3);
  if (hi == 0) li_l[r32] = l_reg; asm volatile("s_waitcnt lgkmcnt(0)" ::: "memory");
  float rli[16];
#pragma unroll
  for (int r = 0; r < 16; ++r) rli[r] = __builtin_amdgcn_rcpf(li_l[crow(r, hi)]);
  unsigned char* Ow = Ob + (long)(wid * QBLK) * LDO;
#pragma unroll
  for (int r = 0; r < 16; ++r) { const int orow = crow(r, hi);
#pragma unroll
    for (int d0 = 0; d0 < 4; d0 += 2) { const int pk = __builtin_amdgcn_cvt_pk_fp8_f32(y8c(o[d0][r] * rli[r]), y8c(o[d0 + 1][r] * rli[r]), 0, false); Ow[(long)orow * LDO + d0 * 32 + r32] = (unsigned char)pk; Ow[(long)orow * LDO + (d0 + 1) * 32 + r32] = (unsigned char)(pk >> 8); } }
  __syncthreads();
#undef SLOAD
#undef SWRITE
#undef SWAIT
#undef RESC
}
}

DI void st_attn(const Prm& p, int layer, char* lds, int bid, int nb) {
  const int nlat = NB * 4 * 16, nitem = nlat + (layer == 0 ? NB * 4 : 0);
  for (int it = bid; it < nitem; it += nb) {
    if (it < nlat) {
      const int w = it & 255, j = (w >> 3) + 32 * (it >> 8), pair = (w & 7) + 8 * (j >> 4), qb = j & 15, b = pair >> 2, h = pair & 3; const size_t r0 = (size_t)b * LT;
      att::attn_body2(p.Qraw + (r0 + qb * 256) * 768 + h * 192, p.KV + r0 * 1024 + h * 256, p.KV + r0 * 1024 + h * 256 + 128, p.KR + r0 * 64,
                     (unsigned char*)p.Y + (r0 + qb * 256) * DM + 1024 + h * 128, LT, qb * 256, lds); }
    else { const int k = it - nlat, b = k >> 2, h = k & 3; const size_t r0 = (size_t)b * LT + LL;
      att::attn_body2(p.Qraw + r0 * 768 + h * 192, p.KV + r0 * 1024 + h * 256, p.KV + r0 * 1024 + h * 256 + 128, p.KR + r0 * 64, (unsigned char*)p.Y + r0 * DM + 1024 + h * 128, LCX, -1, lds); }
  }
}

struct EpiResid {
  static constexpr bool PERM = false, AFTER_DRAIN = false;
  const float* xlat; const float* xctx; bf16_t* X; const float* modl; int first;
  __device__ __forceinline__ void operator()(const pg8::f32x4 (&acc)[2][2][4][2], const pg8::Unit& u, int wr, int wc, int fr, int fq) const {
    const int b = u.pm / 17, tl = u.pm - b * 17; const bool isc = tl == 16;
    const float* g = modl + (size_t)(isc ? 8 : b) * NMOD + 2 * DM;
    const int rloc0 = wr * 64 + fr, col0 = u.pn * 256 + wc * 32 + 4 * fq;
    pg8::f32x4 gv[2][2];
#pragma unroll
    for (int bj = 0; bj < 2; ++bj)
#pragma unroll
      for (int n = 0; n < 2; ++n) gv[bj][n] = *(const pg8::f32x4*)(g + col0 + bj * 128 + n * 16);
#pragma unroll
    for (int ai = 0; ai < 2; ++ai)
#pragma unroll
      for (int m = 0; m < 4; ++m) { const int rl = rloc0 + ai * 128 + m * 16; const size_t row = (size_t)u.pm * 256 + rl;
        const float* src = isc ? xctx + ((size_t)b * LCX + rl) * DM : xlat + ((size_t)b * LL + tl * 256 + rl) * DM;
        bf16_t* dst = X + row * DM;
#pragma unroll
        for (int bj = 0; bj < 2; ++bj)
#pragma unroll
          for (int n = 0; n < 2; ++n) { const int c = col0 + bj * 128 + n * 16; pg8::f32x4 xo;
            if (first) xo = *(const pg8::f32x4*)(src + c);
            else { const u32x2 w = *(const u32x2*)(dst + c); xo = (pg8::f32x4){__uint_as_float(w.x << 16), __uint_as_float(w.x & 0xffff0000u), __uint_as_float(w.y << 16), __uint_as_float(w.y & 0xffff0000u)}; }
            const pg8::f32x4 o = xo + gv[bj][n] * acc[ai][bj][m][n]; u32x2 ow; ow.x = pack2(o[0], o[1]); ow.y = pack2(o[2], o[3]); *(u32x2*)(dst + c) = ow; } }
  }
};

struct EpiF8 {
  static constexpr bool PERM = true, AFTER_DRAIN = false;
  unsigned char* O; int ldc; int split_cols; size_t split_stride;
  __device__ __forceinline__ void operator()(const pg8::f32x4 (&acc)[2][2][4][2], const pg8::Unit& u, int wr, int wc, int fr, int fq) const {
    const int row0 = u.pm * 256 + wr * 64 + fr; int colt = u.pn * 256; unsigned char* base = O;
    if (split_cols) { const int t = colt / split_cols; base += (size_t)t * split_stride; colt -= t * split_cols; }
    const int col0 = colt + wc * 32 + 8 * fq;
#pragma unroll
    for (int ai = 0; ai < 2; ++ai)
#pragma unroll
      for (int m = 0; m < 4; ++m) { unsigned char* rowp = base + (size_t)(row0 + ai * 128 + m * 16) * ldc + col0;
#pragma unroll
        for (int bj = 0; bj < 2; ++bj) { const pg8::f32x4 a0 = acc[ai][bj][m][0], a1 = acc[ai][bj][m][1]; u32x2 w; w.x = pk4_fp8(y8c(a0[0]), y8c(a0[1]), y8c(a0[2]), y8c(a0[3])); w.y = pk4_fp8(y8c(a1[0]), y8c(a1[1]), y8c(a1[2]), y8c(a1[3]));
          *(u32x2*)(rowp + bj * 128) = w; } }
  }
};

struct LatentOrder : pg8::StaticOrder {
  __device__ bool next(int i, pg8::Unit& u) const { const bool ok = pg8::StaticOrder::next(i, u); u.pm += u.pm >> 4; return ok; }
};
template <class Epi> DI void run_gemm_lat(unsigned char* lds, const bf16_t* A, const bf16_t* Bt, int N, int K, const Epi& E, int bid, int nb) {
  pg8::Gemm g; g.A = A; g.Bt = Bt; g.M = NB * LL; g.N = N; g.K = K;
  LatentOrder S; S.init(NB * LL, N, nb, bid);
  pg8::gemm_phase<Epi, LatentOrder, false>((PG8_LAS unsigned char*)lds, g, S, E, nullptr);
}
template <class Epi> DI void run_gemm_f8(unsigned char* lds, const void* A8, const void* Bt8, int M, int N, int Kbytes, const Epi& E, int bid, int nb, const int ascale = pg8::W8_SCALE) {
  pg8::Gemm g; g.A = (const bf16_t*)A8; g.Bt = (const bf16_t*)Bt8; g.M = M; g.N = N; g.K = Kbytes / 2;
  pg8::StaticOrder S; S.init(M, N, nb, bid);
  pg8::gemm_phase_f8<Epi, pg8::StaticOrder, false>((PG8_LAS unsigned char*)lds, g, S, E, nullptr, ascale);
}
template <class Epi> DI void run_gemm_f8_lat(unsigned char* lds, const void* A8, const void* Bt8, int N, int Kbytes, const Epi& E, int bid, int nb, const int ascale = pg8::W8_SCALE) {
  pg8::Gemm g; g.A = (const bf16_t*)A8; g.Bt = (const bf16_t*)Bt8; g.M = NB * LL; g.N = N; g.K = Kbytes / 2;
  LatentOrder S; S.init(NB * LL, N, nb, bid);
  pg8::gemm_phase_f8<Epi, LatentOrder, false>((PG8_LAS unsigned char*)lds, g, S, E, nullptr, ascale);
}
template <class Epi> DI void run_gemm(unsigned char* lds, const bf16_t* A, const bf16_t* Bt, int M, int N, int K, const Epi& E, int bid, int nb) {
  pg8::Gemm g; g.A = A; g.Bt = Bt; g.M = M; g.N = N; g.K = K;
  pg8::StaticOrder S; S.init(M, N, nb, bid);
  pg8::gemm_phase<Epi, pg8::StaticOrder, false>((PG8_LAS unsigned char*)lds, g, S, E, nullptr);
}
DI pg8::EpiBf16<0> epi_bf16(bf16_t* O, int ldc, int split_cols = 0, size_t split_stride = 0) { pg8::EpiBf16<0> e; e.O = O; e.ldc = ldc; e.bias = nullptr; e.split_cols = split_cols; e.split_stride = split_stride; return e; }

#ifndef PROBE
#define PROBE 0
#endif
constexpr int LDS_MAIN = 131072 + 4096, LDS_TOTAL = LDS_MAIN + 64;
#define PRM() (*(const __attribute__((address_space(4))) Prm*)launder_k(kp))
typedef const __attribute__((address_space(4))) void* kptr_t;
DI kptr_t launder_k(kptr_t q) { asm volatile("" : "+s"(q)); return q; }
extern __shared__ __attribute__((aligned(16))) unsigned char shm[];
#define bid lsg(bid0)
#define nb lsg(nb0)
#define GRID_BAR() do { XcdBarrier b_; b_.bar = PRM().bar; b_.x = xb_xcc_id(); b_.st = (volatile LAS unsigned*)(shm + LDS_MAIN); xcd_barrier(b_); } while (0)
template <int l> DI void layer_body(kptr_t kp, const int bid0, const int nb0) {
#if defined(__HIP_DEVICE_COMPILE__)
    if (l == 0) { { const Prm p = PRM(); st_modulate(p, l, 0, p.H, bid, nb); } GRID_BAR(); }
    { const Prm p = PRM(); run_gemm_f8(shm, p.H, (const unsigned char*)p.WinT + (size_t)l * NZ * DM, MR, NZ, DM, epi_bf16(p.Z, NZ), bid, nb); }
    if (PROBE == 46) { const Prm p = PRM(); run_gemm_f8(shm, p.H, (const unsigned char*)p.WinT + (size_t)l * NZ * DM, MR, NZ, DM, epi_bf16(p.Z, NZ), bid, nb); }
    GRID_BAR();
    { const Prm p = PRM(); st_dnprep(p, l, bid, nb); }
    { const Prm p = PRM(); st_mlaprep(p, l, bid, nb); }
    { const Prm p = PRM(); st_fnchan(p, shm, bid, nb); }
    GRID_BAR();
    { const Prm p = PRM(); st_dntinv(p, shm, bid, nb); }
    __syncthreads();
    { const Prm p = PRM(); st_glabc(p, l, shm, bid, nb); }
    if (PROBE == 30) { GRID_BAR(); { const Prm p = PRM(); st_dnprep(p, l, bid, nb); } { const Prm p = PRM(); st_mlaprep(p, l, bid, nb); } { const Prm p = PRM(); st_fnchan(p, shm, bid, nb); } GRID_BAR();
      { const Prm p = PRM(); st_dntinv(p, shm, bid, nb); } __syncthreads(); { const Prm p = PRM(); st_glabc(p, l, shm, bid, nb); } }
    if (PROBE == 9) { { const Prm p = PRM(); st_dnprep(p, l, bid, nb); } { const Prm p = PRM(); st_mlaprep(p, l, bid, nb); } }
    if (PROBE == 10) { const Prm p = PRM(); st_fnchan(p, shm, bid, nb); }
    GRID_BAR();
    { const Prm p = PRM(); run_gemm(shm, p.Aq, p.WuqT + (size_t)l * 768 * 512, MR, 768, 512, epi_bf16(p.Qraw, 768), bid, nb); }
    { const Prm p = PRM(); run_gemm(shm, p.Akv, p.WukvT + (size_t)l * 1024 * 256, MR, 1024, 256, epi_bf16(p.KV, 1024), bid, nb); }
    if (bid < 128) { const Prm p = PRM(); st_dnscan(p, shm, bid, 128); }
    else { const Prm p = PRM(); st_glascan(p, l, shm, bid - 128, 128); }
    { const Prm p = PRM(); st_cvt_tables(p, l, bid, nb); }
    if (PROBE == 7) { GRID_BAR(); if (bid < 128) { const Prm p = PRM(); st_dnscan(p, shm, bid, 128); } }
    if (PROBE == 8) { GRID_BAR(); if (bid < 128) { const Prm p = PRM(); st_glascan(p, l, shm, bid, 128); } }
    if (PROBE == 2) { GRID_BAR(); if (bid < 128) { const Prm p = PRM(); st_dnscan(p, shm, bid, 128); } else { const Prm p = PRM(); st_glascan(p, l, shm, bid - 128, 128); } }
    GRID_BAR();
    { const Prm p = PRM(); st_attn(p, l, (char*)shm, bid, nb); }
    if (PROBE == 3) { const Prm p = PRM(); st_attn(p, l, (char*)shm, bid, nb); }
    { const Prm p = PRM(); st_fnfft(p, shm, bid, nb); }
    __syncthreads();
    if (l == 0) { const Prm p = PRM(); EpiF8 e8; e8.O = (unsigned char*)p.Y + (size_t)LL * DM + 1536; e8.ldc = DM; e8.split_cols = 512; e8.split_stride = (size_t)LT * DM; run_gemm(shm, p.DFTC, p.PQTc, 256, 4096, 512, e8, bid, nb); }
    { const Prm p = PRM(); st_combine(p, l, bid, nb); }
    if (PROBE == 43) { __syncthreads(); { const Prm p = PRM(); st_attn(p, l, (char*)shm, bid, nb); } { const Prm p = PRM(); st_fnfft(p, shm, bid, nb); } __syncthreads(); { const Prm p = PRM(); st_combine(p, l, bid, nb); } }
    GRID_BAR();
    { const Prm p = PRM(); EpiResid e; e.xlat = p.x; e.xctx = p.ctx; e.X = p.Xb; e.modl = p.mod + (size_t)l * 9 * NMOD; e.first = l == 0;
      if (l == 0) run_gemm_f8(shm, p.Y, (const unsigned char*)p.WoutT + (size_t)l * DM * DM, MR, DM, DM, e, bid, nb, 0x79797979);
      else run_gemm_f8_lat(shm, p.Y, (const unsigned char*)p.WoutT + (size_t)l * DM * DM, DM, DM, e, bid, nb, 0x79797979); }
    GRID_BAR();
    { const Prm p = PRM(); st_modulate(p, l, 1, p.H2, bid, nb); }
    if (PROBE == 42) { const Prm p = PRM(); st_modulate(p, l, 1, p.H2, bid, nb); }
    GRID_BAR();
    if (l == 0) { const Prm p = PRM(); run_gemm_f8(shm, p.H2q, (const unsigned char*)p.WqT + (size_t)l * DM * DM, MR, DM, DM, epi_bf16(p.Qp, DM), bid, nb); }
    else { const Prm p = PRM(); run_gemm_f8_lat(shm, p.H2q, (const unsigned char*)p.WqT + (size_t)l * DM * DM, DM, DM, epi_bf16(p.Qp, DM), bid, nb); }
    GRID_BAR();
    { const Prm p = PRM(); st_peer(p, l, shm, bid, nb); }
    if (l == 0) GRID_BAR();
    if (PROBE >= 50 && PROBE <= 59 && l == 0) { constexpr int md_[10] = {0, 1, 3, 7, 9, 17, 11, 41, 65, 0}; { const Prm p = PRM(); st_peer(p, l, shm, bid, nb, md_[PROBE - 50]); } GRID_BAR(); }
  #endif
}

__global__ void __launch_bounds__(NTHR, 2) mega(Prm p_unused) {
#if defined(__HIP_DEVICE_COMPILE__)
  kptr_t kp = (kptr_t)__builtin_amdgcn_kernarg_segment_ptr();
  const int bid0 = blockIdx.x, nb0 = gridDim.x;
  uint4* xbw = (uint4*)(shm + LDS_MAIN);
  if (threadIdx.x == 0) *xbw = make_uint4(0u, 0u, 0u, 0u);
  __syncthreads();
  { const Prm p = PRM(); (void)xcd_barrier_post(p.bar, (volatile LAS unsigned*)xbw); }
  float* lf = (float*)shm;
  for (int ly = 0; ly < 2; ++ly) { const Prm p = PRM();
    st_transpose8(p.w_in + (size_t)ly * DM * IN_W, (unsigned char*)p.WinT + (size_t)ly * NZ * DM, DM, IN_W, DM, NZ, 64.f, lf, bid, nb);
    st_transpose8(p.w_out + (size_t)ly * DM * DM, (unsigned char*)p.WoutT + (size_t)ly * DM * DM, DM, DM, DM, DM, 64.f, lf, bid, nb);
    st_transpose8(p.peer_wq + (size_t)ly * DM * DM, (unsigned char*)p.WqT + (size_t)ly * DM * DM, DM, DM, DM, DM, 64.f, lf, bid, nb);
    st_transpose(p.mla_w_uq + (size_t)ly * 448 * 768, p.WuqT + (size_t)ly * 768 * 512, 448, 768, 512, 768, lf, bid, nb);
    st_transpose(p.mla_w_ukv + (size_t)ly * 128 * 1024, p.WukvT + (size_t)ly * 1024 * 256, 128, 1024, 256, 1024, lf, bid, nb);
  }
  { const Prm p = PRM(); st_tables(p, bid, nb); }
  { const Prm p = PRM(); for (size_t e = (size_t)bid * NTHR + ltid(); e < (size_t)2 * 8 * 2 * 128 * 128; e += (size_t)nb * NTHR) p.KB16[e] = f2bf(p.peer_keys[e]); }
  __syncthreads();
  { const Prm p = PRM(); st_mods(p, lf, bid, nb); }
  if (PROBE == 5) { __syncthreads();
    for (int ly = 0; ly < 2; ++ly) { const Prm p = PRM();
      st_transpose8(p.w_in + (size_t)ly * DM * IN_W, (unsigned char*)p.WinT + (size_t)ly * NZ * DM, DM, IN_W, DM, NZ, 64.f, lf, bid, nb);
      st_transpose8(p.w_out + (size_t)ly * DM * DM, (unsigned char*)p.WoutT + (size_t)ly * DM * DM, DM, DM, DM, DM, 64.f, lf, bid, nb);
      st_transpose8(p.peer_wq + (size_t)ly * DM * DM, (unsigned char*)p.WqT + (size_t)ly * DM * DM, DM, DM, DM, DM, 64.f, lf, bid, nb);
      st_transpose(p.mla_w_uq + (size_t)ly * 448 * 768, p.WuqT + (size_t)ly * 768 * 512, 448, 768, 512, 768, lf, bid, nb);
      st_transpose(p.mla_w_ukv + (size_t)ly * 128 * 1024, p.WukvT + (size_t)ly * 1024 * 256, 128, 1024, 256, 1024, lf, bid, nb); }
    { const Prm p = PRM(); st_tables(p, bid, nb); }
    { const Prm p = PRM(); for (size_t e = (size_t)bid * NTHR + ltid(); e < (size_t)2 * 8 * 2 * 128 * 128; e += (size_t)nb * NTHR) p.KB16[e] = f2bf(p.peer_keys[e]); }
    __syncthreads();
    { const Prm p = PRM(); st_mods(p, lf, bid, nb); } }
  GRID_BAR();
  layer_body<0>(kp, bid0, nb0);
  layer_body<1>(kp, bid0, nb0);
  if (PROBE == 20) { GRID_BAR(); const Prm p = PRM(); if (bid == 0 && ltid() == 0 && __hip_atomic_load(p.bar + 4000, __ATOMIC_RELAXED, __HIP_MEMORY_SCOPE_AGENT) != 0u) p.out[0] = __builtin_nanf(""); }
#endif
#undef bid
#undef nb
#undef GRID_BAR
}

static size_t al256(size_t x) { return (x + 255) / 256 * 256; }
extern "C" void kernel_launch(void* const* d_in, const int* in_sizes, int n_in, void* d_out, int out_size, void* d_ws, size_t ws_size, hipStream_t stream) {
  Prm p{};
  const float** f = (const float**)&p.x;
  for (int i = 0; i < 24; ++i) f[i] = (const float*)d_in[i];
  p.out = (float*)d_out;
  char* w = (char*)d_ws; size_t o = 0;
  auto take = [&](size_t bytes) { char* r = w + o; o += al256(bytes); return r; };
  p.bar = (unsigned*)take(16384);
  p.WinT = (bf16_t*)take((size_t)2 * NZ * DM * 2); p.WoutT = (bf16_t*)take((size_t)2 * DM * DM * 2); p.WqT = (bf16_t*)take((size_t)2 * DM * DM * 2);
  p.WuqT = (bf16_t*)take((size_t)2 * 768 * 512 * 2); p.WukvT = (bf16_t*)take((size_t)2 * 1024 * 256 * 2);
  p.mod = (float*)take((size_t)2 * 9 * NMOD * 4); p.GB = (float*)take((size_t)MR * 16 * 4); p.CCS = (float*)take((size_t)2 * 128 * 128 * 4);
  p.DFTM = nullptr; p.DFTC = (bf16_t*)take((size_t)256 * 512 * 2); p.KB16 = (bf16_t*)take((size_t)2 * 8 * 2 * 128 * 128 * 2);
  p.X = nullptr; p.Xb = (bf16_t*)take((size_t)MR * DM * 2);
  p.Z = (bf16_t*)take((size_t)MR * NZ * 2);
  char* ra = take((size_t)MR * 1536 * 2 + (size_t)4 * MR * 512 * 2);
  p.DNQ = (bf16_t*)ra; p.OB = (bf16_t*)(ra + (size_t)MR * 1536 * 2); p.H = (bf16_t*)ra; p.H2q = (unsigned char*)ra + (size_t)MR * DM;
  p.KV = (bf16_t*)take((size_t)MR * 1024 * 2); p.KR = (bf16_t*)take((size_t)MR * 64 * 2);
  p.Aq = (bf16_t*)take((size_t)MR * 512 * 2); p.Akv = (bf16_t*)take((size_t)MR * 256 * 2);
  p.Ub = (bf16_t*)take((size_t)16384 * 2176); p.Vb = p.Ub;
  if (o > ws_size) return;
  char* q = (char*)d_out; size_t oo = 0;
  p.Y = (bf16_t*)q; oo += (size_t)MR * DM * 2; p.PQT = (bf16_t*)(q + oo); oo += (size_t)8 * 512 * 8192 * 2; p.PQTc = (bf16_t*)(q + oo); oo += (size_t)8 * 512 * 512 * 2;
  p.Qraw = (bf16_t*)(q + oo); oo += (size_t)MR * 768 * 2;
  p.TINV = (bf16_t*)q; p.GCB = (float*)(q + (size_t)4352 * 4096 * 2); p.BC = (float*)(q + (size_t)4352 * 4096 * 2 + (size_t)4352 * 64 * 4);
  char* z = (char*)p.Z; p.H2 = (bf16_t*)z; p.Qp = (bf16_t*)(z + (size_t)MR * DM * 2); p.IDX = (int*)(z + (size_t)2 * MR * DM * 2); p.GATE = (float*)(z + (size_t)2 * MR * DM * 2 + (size_t)MR * 128 * 4);

  static int grid = 0;
  if (!grid) {
    (void)hipFuncSetAttribute((const void*)mega, hipFuncAttributeMaxDynamicSharedMemorySize, LDS_TOTAL);
    int dev = 0, cus = 0, per_cu = 0;
    (void)hipGetDevice(&dev); (void)hipDeviceGetAttribute(&cus, hipDeviceAttributeMultiprocessorCount, dev);
    (void)hipOccupancyMaxActiveBlocksPerMultiprocessor(&per_cu, (const void*)mega, NTHR, LDS_TOTAL);
    grid = per_cu >= 1 ? cus : 0;
    if (grid > 256) grid = 256;
  }
  if (grid < 256) return;
  (void)hipMemsetAsync(p.bar, 0, 16384, stream);
  hipLaunchKernelGGL(mega, dim3(grid), dim3(NTHR), LDS_TOTAL, stream, p);
}
```
